# Optimizing an MI355X kernel written in HIP

```python
import math
import jax, jax.numpy as jnp
from jax import lax
import numpy as np

D_MODEL = 1024
BATCH = 16
SEQ = 2048
DEPTH = 1

D_MIX = D_MODEL
HEAD_DIM = 64
NSA_HEADS = 8
NSA_KV_HEADS = 2
NSA_WIDTH = NSA_HEADS * HEAD_DIM
KV_W = NSA_KV_HEADS * HEAD_DIM
CONV_GROUPS = 8
CONV_WIDTH = D_MIX - NSA_WIDTH
CONV_K = 3
CMP_BLK = 32
CMP_STRIDE = 16
SEL_BLK = 64
SEL_TOPN = 8
WINDOW = 512
Q_BLK = 64
FORCE_SCORE = 1e4
REL_BUCKETS = 32
REL_MAX_DIST = 128
PEER_HEADS = 8
PEER_NKEYS = 128
PEER_EXPERTS = PEER_NKEYS * PEER_NKEYS
PEER_QDIM = 128
PEER_TOPK = 16
PEER_CHUNK = 128
EPS = 1e-6

IN_SIZES = (NSA_WIDTH, KV_W, KV_W, KV_W, KV_W, KV_W, KV_W, NSA_HEADS * 3,
            CONV_WIDTH, CONV_WIDTH, CONV_WIDTH)
IN_COLS = sum(IN_SIZES)
SPLIT_POINTS = tuple(int(v) for v in np.cumsum(IN_SIZES)[:-1])

kernel_name = 'hybrid_nsa_shortconv_peer'


def rmsnorm(x, g):
    x32 = x.astype(jnp.float32)
    y = x32 * lax.rsqrt(jnp.mean(x32 * x32, axis=-1, keepdims=True) + EPS)
    return y.astype(x.dtype) * g


def masked_softmax(logits, mask):
    logits = jnp.where(mask, logits.astype(jnp.float32), -1e30)
    p = jax.nn.softmax(logits, axis=-1)
    return jnp.where(jnp.any(mask, axis=-1, keepdims=True), p, 0.0)


def rel_bucket(dist):
    n = jnp.maximum(dist, 0)
    exact = REL_BUCKETS // 2
    log_ratio = jnp.log(jnp.maximum(n, 1).astype(jnp.float32) / exact) / math.log(REL_MAX_DIST / exact)
    large = exact + (log_ratio * (REL_BUCKETS - exact)).astype(jnp.int32)
    return jnp.where(n < exact, n, jnp.minimum(large, REL_BUCKETS - 1))


def nsa_mixer(q, kc_tok, vc_tok, ks_tok, vs_tok, kw_tok, vw_tok, gates,
              cmp_pe_k, cmp_pe_v, cmp_wk1, cmp_wk2, cmp_wv1, cmp_wv2, rel_table):
    B, S = q.shape[0], q.shape[1]
    G, R, dh = NSA_KV_HEADS, NSA_HEADS // NSA_KV_HEADS, HEAD_DIM

    n_cmp = (S - CMP_BLK) // CMP_STRIDE + 1
    cmp_start = np.arange(n_cmp) * CMP_STRIDE
    tok_idx = cmp_start[:, None] + np.arange(CMP_BLK)[None, :]
    cmp_end = jnp.asarray(cmp_start + CMP_BLK - 1, jnp.int32)

    def compress(tok, pe, w1, w2):
        blk = tok[:, tok_idx] + pe[None, None, :, None, :]
        flat = blk.transpose(0, 1, 3, 2, 4).reshape(B, n_cmp, G, CMP_BLK * dh)
        return jax.nn.gelu(flat @ w1) @ w2

    kc = compress(kc_tok, cmp_pe_k, cmp_wk1, cmp_wk2)
    vc = compress(vc_tok, cmp_pe_v, cmp_wv1, cmp_wv2)

    n_slc = S // SEL_BLK
    n_sel = min(SEL_TOPN, n_slc)
    slc_start = np.arange(n_slc) * SEL_BLK
    overlap = (cmp_start[:, None] < slc_start[None, :] + SEL_BLK) & (cmp_start[:, None] + CMP_BLK > slc_start[None, :])
    cmp_to_slc = jnp.asarray(overlap, jnp.float32)
    ks_blk = ks_tok.reshape(B, n_slc, SEL_BLK, G, dh).transpose(0, 3, 1, 2, 4)
    vs_blk = vs_tok.reshape(B, n_slc, SEL_BLK, G, dh).transpose(0, 3, 1, 2, 4)

    kw_pad = jnp.pad(kw_tok, ((0, 0), (WINDOW, 0), (0, 0), (0, 0)))
    vw_pad = jnp.pad(vw_tok, ((0, 0), (WINDOW, 0), (0, 0), (0, 0)))

    b_ix = jnp.arange(B)[:, None, None]
    g_ix = jnp.arange(G)[None, :, None]
    rel_g = rel_table.reshape(REL_BUCKETS, G, R)
    blk_ids = jnp.arange(n_slc)
    scale = HEAD_DIM ** -0.5

    def head_bias(dist):
        return jnp.transpose(rel_table[rel_bucket(dist)], (2, 0, 1)).reshape(G, R, *dist.shape)

    def query_block(i):
        t0 = i * Q_BLK
        t = t0 + jnp.arange(Q_BLK)
        qb = lax.dynamic_slice_in_dim(q, t0, Q_BLK, axis=1).reshape(B, Q_BLK, G, R, dh) * scale
        gb = jax.nn.sigmoid(lax.dynamic_slice_in_dim(gates, t0, Q_BLK, axis=1).astype(jnp.float32))
        gb = gb.reshape(B, Q_BLK, G, R, 3)

        s = jnp.einsum('bqgrd,bngd->bgrqn', qb, kc) + head_bias(t[:, None] - cmp_end[None, :])
        p_cmp = masked_softmax(s, cmp_end[None, :] <= t[:, None])
        o_cmp = jnp.einsum('bgrqn,bngd->bqgrd', p_cmp, vc)

        imp = jnp.einsum('bgrqn,nj->bgqj', p_cmp, cmp_to_slc)
        cur = t // SEL_BLK
        forced = (blk_ids[None, :] == 0) | (blk_ids[None, :] == cur[:, None]) | (blk_ids[None, :] == cur[:, None] - 1)
        allowed = blk_ids[None, :] * SEL_BLK <= t[:, None]
        imp = jnp.where(forced, FORCE_SCORE, jnp.where(allowed, imp, -jnp.inf))
        _, sel = lax.top_k(imp, n_sel)
        L = n_sel * SEL_BLK
        sel_flat = sel.reshape(B, G, Q_BLK * n_sel)
        ks = ks_blk[b_ix, g_ix, sel_flat].reshape(B, G, Q_BLK, L, dh)
        vs = vs_blk[b_ix, g_ix, sel_flat].reshape(B, G, Q_BLK, L, dh)
        kpos = (sel[..., None] * SEL_BLK + jnp.arange(SEL_BLK)).reshape(B, G, Q_BLK, L)
        dist = t[:, None] - kpos
        bias = rel_g[rel_bucket(dist), jnp.arange(G)[:, None, None]]
        s = jnp.einsum('bqgrd,bgqld->bgrql', qb, ks) + bias.transpose(0, 1, 4, 2, 3)
        p = masked_softmax(s, (dist >= 0)[:, :, None])
        o_slc = jnp.einsum('bgrql,bgqld->bqgrd', p, vs)

        kw = lax.dynamic_slice_in_dim(kw_pad, t0, Q_BLK + WINDOW, axis=1)
        vw = lax.dynamic_slice_in_dim(vw_pad, t0, Q_BLK + WINDOW, axis=1)
        kpos_w = t0 - WINDOW + jnp.arange(Q_BLK + WINDOW)
        dist_w = t[:, None] - kpos_w[None, :]
        mask_w = (dist_w >= 0) & (dist_w < WINDOW) & (kpos_w[None, :] >= 0)
        s = jnp.einsum('bqgrd,blgd->bgrql', qb, kw) + head_bias(dist_w)
        p = masked_softmax(s, mask_w)
        o_win = jnp.einsum('bgrql,blgd->bqgrd', p, vw)

        o = gb[..., 0:1] * o_cmp + gb[..., 1:2] * o_slc + gb[..., 2:3] * o_win
        return o.reshape(B, Q_BLK, NSA_WIDTH)

    out = lax.map(query_block, jnp.arange(S // Q_BLK))
    return out.transpose(1, 0, 2, 3).reshape(B, S, NSA_WIDTH)


def short_conv_mixer(h, b_gate, c_gate, conv_w):
    z = c_gate * h
    y = lax.conv_general_dilated(z, conv_w.astype(z.dtype), window_strides=(1,),
                                 padding=((CONV_K - 1, 0),),
                                 dimension_numbers=('NWC', 'WIO', 'NWC'),
                                 feature_group_count=CONV_WIDTH)
    return b_gate * y


def peer_ffn(xn, w_q, sub_keys, expert_u, expert_v):
    B, S, D = xn.shape
    q = (xn @ w_q).reshape(B, S, PEER_HEADS, 2, PEER_QDIM // 2)
    s = jnp.einsum('bshpd,hpkd->bshpk', q, sub_keys)
    v_half, i_half = lax.top_k(s, PEER_TOPK)
    cand = v_half[..., 0, :, None] + v_half[..., 1, None, :]
    top_s, top_c = lax.top_k(cand.reshape(B, S, PEER_HEADS, PEER_TOPK * PEER_TOPK), PEER_TOPK)
    i1 = jnp.take_along_axis(i_half[..., 0, :], top_c // PEER_TOPK, axis=-1)
    i2 = jnp.take_along_axis(i_half[..., 1, :], top_c % PEER_TOPK, axis=-1)
    experts = i1 * PEER_NKEYS + i2
    g = jax.nn.softmax(top_s.astype(jnp.float32), axis=-1)
    E = PEER_HEADS * PEER_TOPK
    n_chunk = (B * S) // PEER_CHUNK
    xs = xn.reshape(n_chunk, PEER_CHUNK, D)
    es = experts.reshape(n_chunk, PEER_CHUNK, E)
    gs = g.reshape(n_chunk, PEER_CHUNK, E)

    def chunk(args):
        xc, ec, gc = args
        u = expert_u[ec]
        act = jax.nn.gelu(jnp.einsum('cd,ced->ce', xc, u).astype(jnp.float32))
        return jnp.einsum('ce,ced->cd', gc * act, expert_v[ec])

    return lax.map(chunk, (xs, es, gs)).reshape(B, S, D)


def setup_inputs(seed: int = 0) -> dict:
    key = jax.random.key(seed)
    ks = jax.random.split(key, 24)
    L, D, dh = DEPTH, D_MODEL, HEAD_DIM

    def nrm(k, shape, s):
        return jax.random.normal(k, shape, jnp.float32) * s

    def gain(k, shape):
        return 1.0 + 0.05 * jax.random.normal(k, shape, jnp.float32)

    return {
        'x': nrm(ks[0], (BATCH, SEQ, D), 1.0),
        'c': nrm(ks[1], (BATCH, D), 1.0),
        'ln_mix_g': gain(ks[2], (L, D)),
        'ln_ffn_g': gain(ks[3], (L, D)),
        'w_mod': nrm(ks[4], (L, D, 6 * D), 0.5 * D ** -0.5),
        'b_mod': nrm(ks[5], (L, 6 * D), 0.02),
        'w_in': nrm(ks[6], (L, D, IN_COLS), D ** -0.5),
        'cmp_pe_k': nrm(ks[7], (L, CMP_BLK, dh), 0.1),
        'cmp_pe_v': nrm(ks[8], (L, CMP_BLK, dh), 0.1),
        'cmp_wk1': nrm(ks[9], (L, CMP_BLK * dh, dh), (CMP_BLK * dh) ** -0.5),
        'cmp_wk2': nrm(ks[10], (L, dh, dh), dh ** -0.5),
        'cmp_wv1': nrm(ks[11], (L, CMP_BLK * dh, dh), (CMP_BLK * dh) ** -0.5),
        'cmp_wv2': nrm(ks[12], (L, dh, dh), dh ** -0.5),
        'conv_w': nrm(ks[13], (L, CONV_K, 1, CONV_WIDTH), CONV_K ** -0.5),
        'norm_attn_g': gain(ks[14], (L, NSA_WIDTH)),
        'norm_conv_g': gain(ks[15], (L, CONV_WIDTH)),
        'w_out': nrm(ks[16], (L, D_MIX, D), D_MIX ** -0.5),
        'peer_wq': nrm(ks[17], (L, D, PEER_HEADS * PEER_QDIM), D ** -0.5),
        'peer_keys': nrm(ks[18], (L, PEER_HEADS, 2, PEER_NKEYS, PEER_QDIM // 2), (PEER_QDIM // 2) ** -0.5),
        'peer_u': nrm(ks[19], (L, PEER_EXPERTS, D), D ** -0.5),
        'peer_v': nrm(ks[20], (L, PEER_EXPERTS, D), PEER_HEADS ** -0.5),
        'rel_table': nrm(ks[21], (REL_BUCKETS, NSA_HEADS), 0.5),
        'ln_final_g': gain(ks[22], (D,)),
    }


def reference(x, c, ln_mix_g, ln_ffn_g, w_mod, b_mod, w_in, cmp_pe_k, cmp_pe_v,
              cmp_wk1, cmp_wk2, cmp_wv1, cmp_wv2, conv_w, norm_attn_g, norm_conv_g,
              w_out, peer_wq, peer_keys, peer_u, peer_v, rel_table, ln_final_g):
    B, S = x.shape[0], x.shape[1]
    c_act = jax.nn.silu(c)
    for l in range(DEPTH):
        mod = (c_act @ w_mod[l] + b_mod[l])[:, None, :]
        sh1, sc1, gt1, sh2, sc2, gt2 = jnp.split(mod, 6, axis=-1)

        h = rmsnorm(x, ln_mix_g[l]) * (1 + sc1) + sh1
        proj = h @ w_in[l]
        q, kc, vc, ksl, vsl, kw, vw, gts, cb, cc, ch = jnp.split(proj, SPLIT_POINTS, axis=-1)
        kv = lambda a: a.reshape(B, S, NSA_KV_HEADS, HEAD_DIM)
        o_attn = nsa_mixer(q.reshape(B, S, NSA_HEADS, HEAD_DIM), kv(kc), kv(vc), kv(ksl), kv(vsl),
                           kv(kw), kv(vw), gts.reshape(B, S, NSA_HEADS, 3),
                           cmp_pe_k[l], cmp_pe_v[l], cmp_wk1[l], cmp_wk2[l], cmp_wv1[l], cmp_wv2[l],
                           rel_table)
        o_conv = short_conv_mixer(ch, cb, cc, conv_w[l])
        mixed = jnp.concatenate([rmsnorm(o_attn, norm_attn_g[l]), rmsnorm(o_conv, norm_conv_g[l])], axis=-1)
        x = x + gt1 * (mixed @ w_out[l])

        h2 = rmsnorm(x, ln_ffn_g[l]) * (1 + sc2) + sh2
        x = x + gt2 * peer_ffn(h2, peer_wq[l], peer_keys[l], peer_u[l], peer_v[l])
    return rmsnorm(x, ln_final_g)
```

```cpp
#include <hip/hip_runtime.h>
#include <cstdio>
#include <cstdint>
#include <cstdlib>

#ifndef MK_N_LAUNCHES
#define MK_N_LAUNCHES 0
#endif
#define XB_TMO      128
#define XB_XCNT(j)  (256  + 64 * (j))
#define XB_XSUB(j)  (1280 + 64 * (j))
#define XB_XGEN(j)  (2304 + 64 * (j))
#define XB_TOP      3328
#define XB_TOPGEN   3392
#define XCD_BAR_WORDS 3456
#define XB_SPIN_CAP (1u << 18)
#define LAS __attribute__((address_space(3)))

__device__ __forceinline__ unsigned xb_ld(unsigned* p)              { return __hip_atomic_load(p, __ATOMIC_RELAXED, __HIP_MEMORY_SCOPE_AGENT); }
__device__ __forceinline__ unsigned xb_add(unsigned* p, unsigned v) { return __hip_atomic_fetch_add(p, v, __ATOMIC_RELAXED, __HIP_MEMORY_SCOPE_AGENT); }
__device__ __forceinline__ unsigned xb_xcc_id() { return (unsigned)__builtin_amdgcn_s_getreg((3 << 11) | 20) & 0xFu; }
#define XB_SPIN(cond, bar) do { unsigned _sp = 0; while (cond) { __builtin_amdgcn_s_sleep(1); \
    if ((++_sp & 255u) == 0u) { if (xb_ld(&(bar)[XB_TMO])) break; if (_sp > XB_SPIN_CAP) { atomicAdd(&(bar)[XB_TMO], 1u); break; } } } } while (0)

struct XcdBarrier {
    unsigned* bar; unsigned x;
    volatile LAS unsigned* st;
};

__device__ __forceinline__ XcdBarrier xcd_barrier_post(unsigned* bar, volatile LAS unsigned* st) {
    XcdBarrier b; b.bar = bar; b.x = xb_xcc_id(); b.st = st;
    if (threadIdx.x == 0) (void)xb_add(&bar[XB_XCNT(b.x)], 1u);
    return b;
}
__device__ __forceinline__ void xcd_barrier_complete(unsigned* bar, unsigned x, unsigned& nloc, unsigned& nx) {
    const unsigned G = gridDim.x * gridDim.y * gridDim.z;
    unsigned sum, cnt, mine, sp = 0u;
    for (;;) {
        sum = 0u; cnt = 0u; mine = 0u;
#pragma unroll
        for (unsigned j = 0; j < 16; ++j) { const unsigned c = xb_ld(&bar[XB_XCNT(j)]); sum += c; cnt += (c > 0u) ? 1u : 0u; mine = (j == x) ? c : mine; }
        if (sum == G) break;
        __builtin_amdgcn_s_sleep(1);
        if ((++sp & 255u) == 0u) { if (xb_ld(&bar[XB_TMO])) break; if (sp > XB_SPIN_CAP) { atomicAdd(&bar[XB_TMO], 1u); break; } }
    }
    nloc = mine > 0u ? mine : 1u; nx = cnt > 0u ? cnt : 1u;
}

__device__ __forceinline__ void xcd_barrier(const XcdBarrier& b) {
    asm volatile("s_waitcnt vmcnt(0)" ::: "memory");
    __syncthreads();
    if (threadIdx.x == 0) {
        unsigned* bar = b.bar;
        __builtin_amdgcn_s_waitcnt(0);
        unsigned nloc = b.st[0], nx = b.st[1];
        if (nloc == 0u) { xcd_barrier_complete(bar, b.x, nloc, nx); b.st[0] = nloc; b.st[1] = nx; }
        const unsigned old = xb_add(&bar[XB_XSUB(b.x)], 1u);
        const unsigned gen = old / nloc;
        if (old + 1u == (gen + 1u) * nloc) {
            __builtin_amdgcn_fence(__ATOMIC_RELEASE, "agent");
            asm volatile("s_waitcnt vmcnt(0)" ::: "memory");
            const unsigned og = xb_add(&bar[XB_TOP], 1u);
            const unsigned tg = og / nx;
            if (og + 1u == (tg + 1u) * nx) xb_add(&bar[XB_TOPGEN], 1u);
            else XB_SPIN(xb_ld(&bar[XB_TOPGEN]) == tg, bar);
            __builtin_amdgcn_fence(__ATOMIC_ACQUIRE, "agent");
            xb_add(&bar[XB_XGEN(b.x)], 1u);
            asm volatile("s_waitcnt vmcnt(0)" ::: "memory");
        } else {
            XB_SPIN(xb_ld(&bar[XB_XGEN(b.x)]) == gen, bar);
            __builtin_amdgcn_fence(__ATOMIC_ACQUIRE, "agent");
            asm volatile("s_waitcnt vmcnt(0)" ::: "memory");
        }
    }
    __syncthreads();
}

namespace pg8 {
#define PG8_LAS __attribute__((address_space(3)))
typedef unsigned short bf16_t;
typedef short bf16x8 __attribute__((ext_vector_type(8)));
typedef float f32x4 __attribute__((ext_vector_type(4)));
typedef unsigned u32x4 __attribute__((ext_vector_type(4)));
constexpr int BM = 256, BK = 64, HALF = 128, HTB = HALF * BK * 2  , STAGE_BYTES = 8 * HTB, NXCD = 8, WGM = 8;

__host__ __device__ __forceinline__ int lds_byte(int r, int c) { const int st = (r >> 4) * 2 + (c >> 5), rr = r & 15, cc = c & 31, ob = rr * 64 + cc * 2; return st * 1024 + (ob ^ (((ob >> 9) & 1) << 5)); }
__host__ __device__ __forceinline__ void stage_rc(int b, int& R, int& C) { const int st = b / 1024, sb = b % 1024, swz = sb ^ (((sb >> 9) & 1) << 5); R = (st >> 1) * 16 + swz / 64; C = (st & 1) * 32 + (swz % 64) / 2; }
__host__ __device__ __forceinline__ int perm32(int rho) { const int n = rho >> 4, i = rho & 15; return 8 * (i >> 2) + 4 * n + (i & 3); }

struct Unit { int pm, pn; };
struct Gemm { const bf16_t* A; const bf16_t* Bt; int M, N, K; };

struct StaticOrder {
    int nM, nN, nwg, G, c;
    __host__ __device__ void init(int M, int N, int G_, int c_) { nM = M / BM; nN = N / BM; nwg = nM * nN; G = G_; c = c_; }
    __host__ __device__ bool next(int i, Unit& u) const {
        const long L = (long)i * G + c; if (L >= nwg) return false;
        int wgid = (int)L; { const int q = nwg / NXCD, r = nwg % NXCD, xcd = wgid % NXCD, off = wgid / NXCD; wgid = (xcd < r ? xcd * (q + 1) : r * (q + 1) + (xcd - r) * q) + off; }
        const int nig = WGM * nN, gid = wgid / nig, fm = gid * WGM, gsz = (nM - fm) < WGM ? (nM - fm) : WGM;
        u.pm = fm + ((wgid % nig) % gsz); u.pn = (wgid % nig) / gsz; return true;
    }
    __device__ __forceinline__ void a_ready(const Unit&) const {}
    __device__ __forceinline__ void done(const Unit&) const {}
};
struct CountedOrder : StaticOrder {
    const unsigned* ready; unsigned need; unsigned* tmo;
    __device__ __forceinline__ void a_ready(const Unit& u) const {
        if (threadIdx.x < 64) {
            const unsigned long long t0 = __builtin_amdgcn_s_memrealtime(); unsigned polls = 0;
            while ((unsigned)__builtin_amdgcn_readfirstlane(__hip_atomic_load(ready + 64 * u.pm, __ATOMIC_RELAXED, __HIP_MEMORY_SCOPE_AGENT)) < need) {
                if ((++polls & 255u) == 0u && __builtin_amdgcn_readfirstlane(__hip_atomic_load(tmo, __ATOMIC_RELAXED, __HIP_MEMORY_SCOPE_AGENT)) != 0u) break;
                if (__builtin_amdgcn_s_memrealtime() - t0 > 2000000ull) {
                    if (threadIdx.x == 0) { unsigned expect = 0u; __hip_atomic_compare_exchange_strong(tmo + 1, &expect, 0x600u | (unsigned)(u.pm & 0xff), __ATOMIC_RELAXED, __ATOMIC_RELAXED, __HIP_MEMORY_SCOPE_AGENT); __hip_atomic_store(tmo, 1u, __ATOMIC_RELAXED, __HIP_MEMORY_SCOPE_AGENT); }
                    break; }
                __builtin_amdgcn_s_sleep(2); }
            __builtin_amdgcn_fence(__ATOMIC_ACQUIRE, "agent");
            asm volatile("s_waitcnt vmcnt(0)" ::: "memory");
        }
#if !defined(BROKEN_HOOK_NO_BARRIER)
        asm volatile("" ::: "memory"); __builtin_amdgcn_s_barrier(); asm volatile("" ::: "memory");
#endif
    }
};

__device__ __forceinline__ unsigned cvt_pk_bf16(float lo, float hi) { unsigned r; asm volatile("v_cvt_pk_bf16_f32 %0, %1, %2" : "=v"(r) : "v"(lo), "v"(hi)); return r; }
typedef float f32x2 __attribute__((ext_vector_type(2)));
__device__ __forceinline__ f32x2 gelu_pk(f32x2 v) {
    const f32x2 av = __builtin_elementwise_abs(v), d = av * 0.2316418882f + 1.0f;
    f32x2 t; t.x = __builtin_amdgcn_rcpf(d.x); t.y = __builtin_amdgcn_rcpf(d.y);
    f32x2 q = t * 0.5307027145f + (-0.7265760135f); q = q * t + 0.7107068705f; q = q * t + (-0.142248368f); q = q * t + 0.127414796f; q = q * t;
    const f32x2 s = (v * v) * (-0.72134752044f);
    f32x2 e; e.x = __builtin_amdgcn_exp2f(s.x); e.y = __builtin_amdgcn_exp2f(s.y);
    const f32x2 m = v * (q * e), r = v - m;
    f32x2 o; o.x = v.x < 0.f ? m.x : r.x; o.y = v.y < 0.f ? m.y : r.y; return o;
}

struct EpiF32 {
    static constexpr bool PERM = false, AFTER_DRAIN = false;
    float* C; int ldc; const float* bias;
    __device__ __forceinline__ void operator()(const f32x4 (&acc)[2][2][4][2], const Unit& u, int wr, int wc, int fr, int fq) const {
        const int row0 = u.pm * BM + wr * 64 + fr, col0 = u.pn * BM + wc * 32 + 4 * fq;
        f32x4 bv[2][2];
#pragma unroll
        for (int bj = 0; bj < 2; ++bj)
#pragma unroll
            for (int n = 0; n < 2; ++n) bv[bj][n] = bias ? *(const f32x4*)(bias + col0 + bj * HALF + n * 16) : (f32x4){0.f, 0.f, 0.f, 0.f};
#pragma unroll
        for (int ai = 0; ai < 2; ++ai)
#pragma unroll
            for (int m = 0; m < 4; ++m) { float* rowp = C + (size_t)(row0 + ai * HALF + m * 16) * ldc + col0;
#pragma unroll
                for (int bj = 0; bj < 2; ++bj)
#pragma unroll
                    for (int n = 0; n < 2; ++n) *(f32x4*)(rowp + bj * HALF + n * 16) = acc[ai][bj][m][n] + bv[bj][n]; }
    }
};
template <int ACT  > struct EpiBf16 {
    static constexpr bool PERM = true, AFTER_DRAIN = false;
    bf16_t* O; int ldc; const float* bias; int split_cols; size_t split_stride;
    __device__ __forceinline__ void operator()(const f32x4 (&acc)[2][2][4][2], const Unit& u, int wr, int wc, int fr, int fq) const {
        const int row0 = u.pm * BM + wr * 64 + fr; int colt = u.pn * BM; bf16_t* base = O;
        if (split_cols) { const int t = colt / split_cols; base += (size_t)t * split_stride; colt -= t * split_cols; }
        const int col0 = colt + wc * 32 + 8 * fq, bcol0 = u.pn * BM + wc * 32 + 8 * fq;
        f32x4 bv[2][2];
#pragma unroll
        for (int bj = 0; bj < 2; ++bj)
#pragma unroll
            for (int n = 0; n < 2; ++n) bv[bj][n] = bias ? *(const f32x4*)(bias + bcol0 + bj * HALF + 4 * n) : (f32x4){0.f, 0.f, 0.f, 0.f};
#pragma unroll
        for (int ai = 0; ai < 2; ++ai)
#pragma unroll
            for (int m = 0; m < 4; ++m) { bf16_t* rowp = base + (size_t)(row0 + ai * HALF + m * 16) * ldc + col0;
#pragma unroll
                for (int bj = 0; bj < 2; ++bj) { f32x4 v0 = acc[ai][bj][m][0] + bv[bj][0], v1 = acc[ai][bj][m][1] + bv[bj][1];
                    if (ACT == 1) { f32x2 a = gelu_pk((f32x2){v0[0], v0[1]}), b = gelu_pk((f32x2){v0[2], v0[3]}), c = gelu_pk((f32x2){v1[0], v1[1]}), d = gelu_pk((f32x2){v1[2], v1[3]});
                        v0 = (f32x4){a.x, a.y, b.x, b.y}; v1 = (f32x4){c.x, c.y, d.x, d.y}; }
                    if (ACT == 2) {
#pragma unroll
                        for (int j = 0; j < 4; ++j) { v0[j] = 0.5f * v0[j] * (1.0f + erff(v0[j] * 0.70710678f)); v1[j] = 0.5f * v1[j] * (1.0f + erff(v1[j] * 0.70710678f)); } }
                    u32x4 w; w.x = cvt_pk_bf16(v0[0], v0[1]); w.y = cvt_pk_bf16(v0[2], v0[3]); w.z = cvt_pk_bf16(v1[0], v1[1]); w.w = cvt_pk_bf16(v1[2], v1[3]);
                    *(u32x4*)(rowp + bj * HALF) = w; } }
    }
};

struct PanelStats {
    unsigned* xbuf;
    unsigned* cnt;
    unsigned* tmo;
    int ntn; float eps;
    unsigned code;
    __device__ __forceinline__ bool run(const f32x4 (&v)[2][2][4][2], const Unit& u, int wr, int wc, int fr, int fq, PG8_LAS unsigned char* lds, int wid, int lane) const {
        typedef float f32x2v __attribute__((ext_vector_type(2)));
        PG8_LAS f32x2v* P = (PG8_LAS f32x2v*)lds;
        PG8_LAS f32x2v* S = (PG8_LAS f32x2v*)(lds + 8192);
        PG8_LAS unsigned* flag = (PG8_LAS unsigned*)(lds + 8192 + 2048);
#pragma unroll
        for (int ai = 0; ai < 2; ++ai)
#pragma unroll
            for (int m = 0; m < 4; ++m) {
                float s = 0.f;
#pragma unroll
                for (int bj = 0; bj < 2; ++bj)
#pragma unroll
                    for (int n = 0; n < 2; ++n) { const f32x4 x = v[ai][bj][m][n]; s += (x[0] + x[1]) + (x[2] + x[3]); }
                s += __shfl_xor(s, 16); s += __shfl_xor(s, 32);
                const float mw = s * (1.0f / 64.0f); float q = 0.f;
#pragma unroll
                for (int bj = 0; bj < 2; ++bj)
#pragma unroll
                    for (int n = 0; n < 2; ++n) { const f32x4 d = v[ai][bj][m][n] - mw; q += (d[0] * d[0] + d[1] * d[1]) + (d[2] * d[2] + d[3] * d[3]); }
                q += __shfl_xor(q, 16); q += __shfl_xor(q, 32);
                if (fq == 0) P[(ai * HALF + wr * 64 + m * 16 + fr) * 4 + wc] = (f32x2v){mw, q};
            }
        asm volatile("s_waitcnt lgkmcnt(0)" ::: "memory"); __builtin_amdgcn_s_barrier(); asm volatile("" ::: "memory");
#if defined(BROKEN_NO_WAIT)
        if (blockIdx.x >= 64) { const long long t0 = clock64(); while (clock64() - t0 < 60000) __builtin_amdgcn_s_sleep(8); }
#endif
        const int row = wid * 32 + (lane & 31);
        if (lane < 32) {
            const f32x2v a = P[row * 4 + 0], b = P[row * 4 + 1], c = P[row * 4 + 2], d = P[row * 4 + 3];
            const float mt = (a.x + b.x + c.x + d.x) * 0.25f;
            const float da = a.x - mt, db = b.x - mt, dc = c.x - mt, dd = d.x - mt;
            const float m2 = (a.y + b.y) + (c.y + d.y) + 64.0f * ((da * da + db * db) + (dc * dc + dd * dd));
            unsigned long long* slot = (unsigned long long*)xbuf + ((size_t)(u.pm * BM + row) * 4 + u.pn);
            __hip_atomic_store(slot, ((unsigned long long)__float_as_uint(m2) << 32) | __float_as_uint(mt), __ATOMIC_RELAXED, __HIP_MEMORY_SCOPE_AGENT);
        }
        asm volatile("s_waitcnt vmcnt(0)" ::: "memory");
        if (lane == 0) __hip_atomic_fetch_add(cnt + 64 * u.pm, 1u, __ATOMIC_RELAXED, __HIP_MEMORY_SCOPE_AGENT);
        if (wid == 0) {
            bool dead = false; const unsigned long long t0 = __builtin_amdgcn_s_memrealtime(); const unsigned want = 8u * (unsigned)ntn;
            for (;;) {
#if defined(BROKEN_NO_WAIT)
                break;
#endif
                if ((unsigned)__builtin_amdgcn_readfirstlane(__hip_atomic_load(cnt + 64 * u.pm, __ATOMIC_RELAXED, __HIP_MEMORY_SCOPE_AGENT)) >= want) break;
                if (__builtin_amdgcn_s_memrealtime() - t0 > 2000000ull) {
                    if (lane == 0) { unsigned expect = 0u; __hip_atomic_compare_exchange_strong(tmo + 1, &expect, code | (unsigned)(u.pm & 0xff), __ATOMIC_RELAXED, __ATOMIC_RELAXED, __HIP_MEMORY_SCOPE_AGENT);
                                     __hip_atomic_store(tmo, 1u, __ATOMIC_RELAXED, __HIP_MEMORY_SCOPE_AGENT); }
                    dead = true; break; }
                __builtin_amdgcn_s_sleep(2);
            }
            __builtin_amdgcn_fence(__ATOMIC_ACQUIRE, "agent");
            if (lane == 0) flag[0] = dead ? 1u : 0u;
        }
        asm volatile("s_waitcnt vmcnt(0) lgkmcnt(0)" ::: "memory"); __builtin_amdgcn_s_barrier(); asm volatile("" ::: "memory");
        const bool bad = flag[0] != 0u;
        if (lane < 32) {
            const unsigned long long* slot = (const unsigned long long*)xbuf + (size_t)(u.pm * BM + row) * 4; float mt[4], m2[4]; float ms = 0.f;
#pragma unroll
            for (int t = 0; t < 4; ++t) { if (t < ntn) { const unsigned long long w = __hip_atomic_load(slot + t, __ATOMIC_RELAXED, __HIP_MEMORY_SCOPE_AGENT); mt[t] = __uint_as_float((unsigned)w); m2[t] = __uint_as_float((unsigned)(w >> 32)); } else { mt[t] = 0.f; m2[t] = 0.f; } ms += mt[t]; }
            const float mean = ms / (float)ntn; float q = 0.f;
#pragma unroll
            for (int t = 0; t < 4; ++t) if (t < ntn) { const float dm = mt[t] - mean; q += m2[t] + 256.0f * dm * dm; }
            S[row] = (f32x2v){mean, 1.0f / sqrtf(q / (256.0f * (float)ntn) + eps)};
        }
        asm volatile("s_waitcnt lgkmcnt(0)" ::: "memory"); __builtin_amdgcn_s_barrier(); asm volatile("" ::: "memory");
        return bad;
    }
};
struct EpiLnRes {
    static constexpr bool PERM = false, AFTER_DRAIN = true;
    const float* base; float* out; int ldc; const float* bias; PanelStats st; unsigned poison;
    __device__ __forceinline__ void refuse(size_t i0, size_t stride, int M, int N) const { const float q = __builtin_nanf(""); for (size_t i = i0; i < (size_t)M * N; i += stride) out[(i / N) * ldc + i % N] = q;
        if (i0 == 0) { unsigned expect = 0u; __hip_atomic_compare_exchange_strong(st.tmo + 1, &expect, 0x7f0u, __ATOMIC_RELAXED, __ATOMIC_RELAXED, __HIP_MEMORY_SCOPE_AGENT); __hip_atomic_store(st.tmo, 1u, __ATOMIC_RELAXED, __HIP_MEMORY_SCOPE_AGENT); } }
    __device__ __forceinline__ void fused(f32x4 (&acc)[2][2][4][2], const Unit& u, int wr, int wc, int fr, int fq, PG8_LAS unsigned char* lds, int wid, int lane) const {
        typedef float f32x2v __attribute__((ext_vector_type(2)));
        const PG8_LAS f32x2v* S = (const PG8_LAS f32x2v*)(lds + 8192);
        const int col0 = u.pn * BM + wc * 32 + 4 * fq;
#pragma unroll
        for (int bj = 0; bj < 2; ++bj)
#pragma unroll
            for (int n = 0; n < 2; ++n) { const f32x4 bv = bias ? *(const f32x4*)(bias + col0 + bj * HALF + n * 16) : (f32x4){0.f, 0.f, 0.f, 0.f};
#pragma unroll
                for (int ai = 0; ai < 2; ++ai)
#pragma unroll
                    for (int m = 0; m < 4; ++m) acc[ai][bj][m][n] += bv; }
        const bool bad = st.run(acc, u, wr, wc, fr, fq, lds, wid, lane) || poison != 0u;
        const float qnan = __builtin_nanf("");
#pragma unroll
        for (int ai = 0; ai < 2; ++ai)
#pragma unroll
            for (int m = 0; m < 4; ++m) { const int r = ai * HALF + wr * 64 + m * 16 + fr; const f32x2v sr = S[r]; const size_t off = (size_t)(u.pm * BM + r) * ldc + col0;
#pragma unroll
                for (int bj = 0; bj < 2; ++bj)
#pragma unroll
                    for (int n = 0; n < 2; ++n) { const f32x4 bs = *(const f32x4*)(base + off + bj * HALF + n * 16); f32x4 o = bs + (acc[ai][bj][m][n] - sr.x) * sr.y;
                        if (bad) o = (f32x4){qnan, qnan, qnan, qnan}; *(f32x4*)(out + off + bj * HALF + n * 16) = o; }
                asm volatile("" ::: "memory"); }
    }
};
struct EpiLnResLn {
    static constexpr bool PERM = false, AFTER_DRAIN = true;
    const float* base; float* out; bf16_t* xn; int ldc; const float* bias; PanelStats st1, st2; unsigned poison;
    __device__ __forceinline__ void refuse(size_t i0, size_t stride, int M, int N) const { const float q = __builtin_nanf(""); for (size_t i = i0; i < (size_t)M * N; i += stride) { const size_t o = (i / N) * ldc + i % N; out[o] = q; xn[o] = (bf16_t)0x7fc0u; }
        if (i0 == 0) { unsigned expect = 0u; __hip_atomic_compare_exchange_strong(st1.tmo + 1, &expect, 0x7f0u, __ATOMIC_RELAXED, __ATOMIC_RELAXED, __HIP_MEMORY_SCOPE_AGENT); __hip_atomic_store(st1.tmo, 1u, __ATOMIC_RELAXED, __HIP_MEMORY_SCOPE_AGENT); } }
    __device__ __forceinline__ void fused(f32x4 (&acc)[2][2][4][2], const Unit& u, int wr, int wc, int fr, int fq, PG8_LAS unsigned char* lds, int wid, int lane) const {
        typedef float f32x2v __attribute__((ext_vector_type(2))); typedef unsigned u32x2v __attribute__((ext_vector_type(2)));
        const PG8_LAS f32x2v* S = (const PG8_LAS f32x2v*)(lds + 8192);
        const int col0 = u.pn * BM + wc * 32 + 4 * fq;
#pragma unroll
        for (int bj = 0; bj < 2; ++bj)
#pragma unroll
            for (int n = 0; n < 2; ++n) { const f32x4 bv = bias ? *(const f32x4*)(bias + col0 + bj * HALF + n * 16) : (f32x4){0.f, 0.f, 0.f, 0.f};
#pragma unroll
                for (int ai = 0; ai < 2; ++ai)
#pragma unroll
                    for (int m = 0; m < 4; ++m) acc[ai][bj][m][n] += bv; }
        bool bad = st1.run(acc, u, wr, wc, fr, fq, lds, wid, lane) || poison != 0u;
        const float qnan = __builtin_nanf("");
#pragma unroll
        for (int ai = 0; ai < 2; ++ai)
#pragma unroll
            for (int m = 0; m < 4; ++m) { const int r = ai * HALF + wr * 64 + m * 16 + fr; const f32x2v sr = S[r]; const size_t off = (size_t)(u.pm * BM + r) * ldc + col0;
#pragma unroll
                for (int bj = 0; bj < 2; ++bj)
#pragma unroll
                    for (int n = 0; n < 2; ++n) { const f32x4 bs = *(const f32x4*)(base + off + bj * HALF + n * 16); acc[ai][bj][m][n] = bs + (acc[ai][bj][m][n] - sr.x) * sr.y; }
                asm volatile("" : "+v"(acc[ai][0][m][0]), "+v"(acc[ai][0][m][1]), "+v"(acc[ai][1][m][0]), "+v"(acc[ai][1][m][1]));
                if (m & 1) asm volatile("" ::: "memory"); }
        const bool bad1 = bad;
        bad = st2.run(acc, u, wr, wc, fr, fq, lds, wid, lane) || bad;
#pragma unroll
        for (int ai = 0; ai < 2; ++ai)
#pragma unroll
            for (int m = 0; m < 4; ++m) { const int r = ai * HALF + wr * 64 + m * 16 + fr; const f32x2v sr = S[r]; const size_t off = (size_t)(u.pm * BM + r) * ldc + col0;
#pragma unroll
                for (int bj = 0; bj < 2; ++bj)
#pragma unroll
                    for (int n = 0; n < 2; ++n) { const f32x4 x1 = acc[ai][bj][m][n]; *(f32x4*)(out + off + bj * HALF + n * 16) = bad1 ? (f32x4){qnan, qnan, qnan, qnan} : x1;
                        const f32x4 o = (x1 - sr.x) * sr.y; u32x2v w; w.x = cvt_pk_bf16(o[0], o[1]); w.y = cvt_pk_bf16(o[2], o[3]);
                        if (bad) { w.x = 0x7fc07fc0u; w.y = 0x7fc07fc0u; } *(u32x2v*)(xn + off + bj * HALF + n * 16) = w; }
                asm volatile("" ::: "memory"); }
    }
};

template <class Epi, class Sched, bool STAMP = false>
__device__ __forceinline__ void gemm_phase(PG8_LAS unsigned char* lds, const Gemm g, const Sched& S, const Epi& E, unsigned long long* stamps) {
    const int tid = threadIdx.x, wid = __builtin_amdgcn_readfirstlane(tid >> 6), lane = tid & 63, wr = wid >> 2, wc = wid & 3, fr = lane & 15, fq = lane >> 4;
    const int K = g.K, nt = K / BK;
    int ts_lo = 0, ts_hi = 0, nts = 0; const unsigned long long rt_entry = STAMP ? (unsigned long long)wall_clock64() : 0ull;
#define PG8_STAMP() do { if (STAMP && wid == 0 && nts < 64) { const unsigned long long _c = (unsigned long long)clock64(); \
        ts_lo = (lane == nts) ? (int)(unsigned)_c : ts_lo; ts_hi = (lane == nts) ? (int)(unsigned)(_c >> 32) : ts_hi; ++nts; } } while (0)
    PG8_STAMP();
    unsigned voffA[2], voffB[2];
#pragma unroll
    for (int i = 0; i < 2; ++i) { int R, C; stage_rc(tid * 16 + i * 8192, R, C); const int Rb = Epi::PERM ? ((R & ~31) + perm32(R & 31)) : R;
        voffA[i] = (unsigned)(R * K + C) * 2u; voffB[i] = (unsigned)(Rb * K + C) * 2u; }
    const size_t kstep = (size_t)(BK * 2);
    const size_t hstep = (size_t)HALF * K * 2;
    const size_t tstep = 2 * hstep;
    const unsigned ldsw = (unsigned)wid * 1024u;
    const int aoff = lds_byte(wr * 64 + fr, fq * 8), boff = lds_byte(wc * 32 + fr, fq * 8);
#define PG8_SA(b, h) (((b) * 2 + (h)) * HTB)
#define PG8_SB(b, h) ((4 + (b) * 2 + (h)) * HTB)
#define PG8_STAGE(bufoff, gbase, voff) do { _Pragma("unroll") for (int _i = 0; _i < 2; ++_i) \
        __builtin_amdgcn_global_load_lds((const unsigned*)((const char*)(gbase) + (voff)[_i]), (PG8_LAS unsigned*)(lds + (bufoff) + ldsw + _i * 8192), 16, 0, 0); } while (0)
#define PG8_LDA(dst, b, h) do { _Pragma("unroll") for (int m = 0; m < 4; ++m) _Pragma("unroll") for (int k = 0; k < 2; ++k) dst[m][k] = *(const PG8_LAS bf16x8*)(lds + PG8_SA(b, h) + aoff + m * 2048 + k * 1024); } while (0)
#define PG8_LDB(dst, b, h) do { _Pragma("unroll") for (int n = 0; n < 2; ++n) _Pragma("unroll") for (int k = 0; k < 2; ++k) dst[n][k] = *(const PG8_LAS bf16x8*)(lds + PG8_SB(b, h) + boff + n * 2048 + k * 1024); } while (0)
#define PG8_MMA(ai, bj, At, Bt) do { __builtin_amdgcn_s_setprio(1); _Pragma("unroll") for (int m = 0; m < 4; ++m) _Pragma("unroll") for (int n = 0; n < 2; ++n) _Pragma("unroll") for (int k = 0; k < 2; ++k) \
        acc[ai][bj][m][n] = __builtin_amdgcn_mfma_f32_16x16x32_bf16(Bt[n][k], At[m][k], acc[ai][bj][m][n], 0, 0, 0); __builtin_amdgcn_s_setprio(0); } while (0)
#define PG8_WAIT_V(n) asm volatile("s_waitcnt vmcnt(" #n ")" ::: "memory")
#define PG8_WAIT_L(n) asm volatile("s_waitcnt lgkmcnt(" #n ")" ::: "memory")
#define PG8_BAR __builtin_amdgcn_s_barrier()
#define PG8_SCHED __builtin_amdgcn_sched_barrier(0)
    Unit cur, nxt; int ui = 0;
    if (!S.next(0, cur)) return;
    f32x4 acc[2][2][4][2];
#pragma unroll
    for (int a = 0; a < 2; ++a)
#pragma unroll
        for (int b = 0; b < 2; ++b)
#pragma unroll
            for (int m = 0; m < 4; ++m)
#pragma unroll
                for (int n = 0; n < 2; ++n) acc[a][b][m][n] = (f32x4){0.f, 0.f, 0.f, 0.f};
    bf16x8 At[4][2], B0[2][2], B1[2][2];
    const char* cA = (const char*)g.A + (size_t)cur.pm * tstep; const char* cB = (const char*)g.Bt + (size_t)cur.pn * tstep;
    S.a_ready(cur);
    PG8_STAGE(PG8_SB(0, 0), cB, voffB); PG8_STAGE(PG8_SA(0, 0), cA, voffA); PG8_STAGE(PG8_SB(0, 1), cB + hstep, voffB); PG8_STAGE(PG8_SA(0, 1), cA + hstep, voffA);
    if (wr == 1) PG8_BAR;
    PG8_WAIT_V(4); PG8_BAR;
    PG8_STAGE(PG8_SB(1, 0), cB + kstep, voffB); PG8_STAGE(PG8_SA(1, 0), cA + kstep, voffA); PG8_STAGE(PG8_SB(1, 1), cB + hstep + kstep, voffB);
    PG8_WAIT_V(6); PG8_BAR;
    PG8_STAMP();
    for (;;) {
        const bool has_next = S.next(ui + 1, nxt);
        const char* nA = has_next ? (const char*)g.A + (size_t)nxt.pm * tstep : cA; const char* nB = has_next ? (const char*)g.Bt + (size_t)nxt.pn * tstep : cB;
        for (int t = 0; t < nt; t += 2) {
            const bool last = (t == nt - 2);
            const char* a1 = cA + (size_t)(t + 1) * kstep;
            const char* a2 = last ? nA : cA + (size_t)(t + 2) * kstep; const char* b2 = last ? nB : cB + (size_t)(t + 2) * kstep;
            const char* a3 = a2 + kstep; const char* b3 = b2 + kstep;
            if (last && has_next) S.a_ready(nxt);
            PG8_LDB(B0, 0, 0); PG8_SCHED; PG8_LDA(At, 0, 0); PG8_STAGE(PG8_SA(1, 1), a1 + hstep, voffA);
            PG8_WAIT_L(8); PG8_BAR; PG8_WAIT_L(0); PG8_MMA(0, 0, At, B0); PG8_BAR; PG8_SCHED;
            PG8_LDB(B1, 0, 1); PG8_STAGE(PG8_SB(0, 0), b2, voffB);
            PG8_BAR; PG8_WAIT_L(0); PG8_MMA(0, 1, At, B1); PG8_BAR;
            PG8_LDA(At, 0, 1); PG8_STAGE(PG8_SA(0, 0), a2, voffA);
            PG8_BAR; PG8_WAIT_L(0); PG8_MMA(1, 0, At, B0); PG8_BAR; PG8_SCHED;
            PG8_STAGE(PG8_SB(0, 1), b2 + hstep, voffB);
            PG8_WAIT_V(6); PG8_BAR; PG8_MMA(1, 1, At, B1); PG8_BAR;
            PG8_LDB(B0, 1, 0); PG8_SCHED; PG8_LDA(At, 1, 0); PG8_STAGE(PG8_SA(0, 1), a2 + hstep, voffA);
            PG8_WAIT_L(8); PG8_BAR; PG8_WAIT_L(0); PG8_MMA(0, 0, At, B0); PG8_BAR; PG8_SCHED;
            PG8_LDB(B1, 1, 1); PG8_STAGE(PG8_SB(1, 0), b3, voffB);
            PG8_BAR; PG8_WAIT_L(0); PG8_MMA(0, 1, At, B1); PG8_BAR;
            PG8_LDA(At, 1, 1); PG8_STAGE(PG8_SA(1, 0), a3, voffA);
            PG8_BAR; PG8_WAIT_L(0); PG8_MMA(1, 0, At, B0); PG8_BAR; PG8_SCHED;
            PG8_STAGE(PG8_SB(1, 1), b3 + hstep, voffB);
            PG8_WAIT_V(6); PG8_BAR; PG8_MMA(1, 1, At, B1); PG8_BAR;
        }
        PG8_STAMP();
        if constexpr (!Epi::AFTER_DRAIN) { E(acc, cur, wr, wc, fr, fq); S.done(cur); }
        PG8_STAMP();
        if (!has_next) break;
#pragma unroll
        for (int a = 0; a < 2; ++a)
#pragma unroll
            for (int b = 0; b < 2; ++b)
#pragma unroll
                for (int m = 0; m < 4; ++m)
#pragma unroll
                    for (int n = 0; n < 2; ++n) acc[a][b][m][n] = (f32x4){0.f, 0.f, 0.f, 0.f};
        cur = nxt; cA = nA; cB = nB; ++ui;
    }
    PG8_WAIT_V(0);
    if (wr == 0) PG8_BAR;
    PG8_BAR;
    if constexpr (Epi::AFTER_DRAIN) { E.fused(acc, cur, wr, wc, fr, fq, lds, wid, lane); S.done(cur); }
    PG8_STAMP();
    if (STAMP && wid == 0) { stamps[lane] = lane < nts ? (((unsigned long long)(unsigned)ts_hi << 32) | (unsigned)ts_lo) : 0ull;
        if (lane == 62) stamps[62] = rt_entry; if (lane == 63) stamps[63] = (unsigned long long)wall_clock64(); }
#undef PG8_STAMP
#undef PG8_SA
#undef PG8_SB
#undef PG8_STAGE
#undef PG8_LDA
#undef PG8_LDB
#undef PG8_MMA
#undef PG8_WAIT_V
#undef PG8_WAIT_L
#undef PG8_BAR
#undef PG8_SCHED
}
}

constexpr int D = 1024, NB = 16, S = 2048, T = NB * S;
constexpr int NCOL = 2840, NPAD = 3072;
constexpr int C_Q = 0, C_KC = 512, C_VC = 640, C_KS = 768, C_VS = 896, C_KW = 1024, C_VW = 1152, C_GT = 1280, C_CB = 1304, C_CC = 1816, C_CH = 2328;
constexpr int NCMP = 127;
constexpr int NEXP = 16384;
constexpr float EPS = 1e-6f;
constexpr int NTHREADS = 512, NWAVES = 8;

constexpr size_t al256(size_t x) { return (x + 255) & ~(size_t)255; }
constexpr size_t WS_CTL   = 0;                                   constexpr size_t CTL_BYTES = 65536;
constexpr size_t WS_MOD   = WS_CTL + CTL_BYTES;
constexpr size_t WS_WIN   = al256(WS_MOD + (size_t)16 * 6144 * 4);
constexpr size_t WS_WOUT  = al256(WS_WIN + (size_t)NPAD * D * 2);
constexpr size_t WS_WQ    = al256(WS_WOUT + (size_t)D * D * 2);
constexpr size_t WS_KEYS  = al256(WS_WQ + (size_t)D * D * 2);
constexpr size_t WS_UB    = al256(WS_KEYS + (size_t)16 * 128 * 64 * 2);
constexpr size_t WS_VB    = al256(WS_UB + (size_t)NEXP * D * 2);
constexpr size_t WS_KC    = al256(WS_VB + (size_t)NEXP * D * 2);
constexpr size_t WS_VC    = al256(WS_KC + (size_t)16 * 2 * 128 * 64 * 2);
constexpr size_t WS_H     = al256(WS_VC + (size_t)16 * 2 * 128 * 64 * 2);
constexpr size_t WS_OATT  = al256(WS_H + (size_t)T * D * 2);
constexpr size_t WS_PROJ  = al256(WS_OATT + (size_t)T * 512 * 2);
constexpr size_t WS_QP    = WS_PROJ;
constexpr size_t WS_EIDX  = al256(WS_QP + (size_t)T * D * 2);
constexpr size_t WS_EW    = al256(WS_EIDX + (size_t)T * 128 * 4);
constexpr size_t WS_END   = al256(WS_PROJ + (size_t)T * NPAD * 2);
static_assert(WS_EW + (size_t)T * 128 * 4 <= WS_END, "alias region");

constexpr int LDS_STAGE = 131072;
constexpr int LDS_MISC_OFF = LDS_STAGE;
constexpr int LDS_BYTES = LDS_STAGE + 256;

typedef unsigned short bf16_t;
__device__ __forceinline__ float bf2f(bf16_t b) { return __uint_as_float(((unsigned)b) << 16); }
__device__ __forceinline__ bf16_t f2bf(float f) { unsigned u = __float_as_uint(f); u += 0x7FFFu + ((u >> 16) & 1u); return (bf16_t)(u >> 16); }
__device__ __forceinline__ float bflo(unsigned w) { return __uint_as_float(w << 16); }
__device__ __forceinline__ float bfhi(unsigned w) { return __uint_as_float(w & 0xFFFF0000u); }
__device__ __forceinline__ unsigned pack2(float lo, float hi) { return (unsigned)f2bf(lo) | ((unsigned)f2bf(hi) << 16); }
__device__ __forceinline__ float gelu_tanh(float x) { const float u = 0.7978845608028654f * (x + 0.044715f * x * x * x); return 0.5f * x * (1.0f + tanhf(u)); }
__device__ __forceinline__ float sigmoidf_(float x) { return 1.0f / (1.0f + __expf(-x)); }
__device__ __forceinline__ float wave_sum(float v) {
#pragma unroll
    for (int o = 32; o >= 1; o >>= 1) v += __shfl_xor(v, o);
    return v; }
__device__ __forceinline__ float wave_max(float v) {
#pragma unroll
    for (int o = 32; o >= 1; o >>= 1) v = fmaxf(v, __shfl_xor(v, o));
    return v; }
__device__ __forceinline__ void lds_wave_sync() { asm volatile("s_waitcnt lgkmcnt(0)" ::: "memory"); }
__device__ __forceinline__ int rel_bucket(int dist) {
    const int n = dist > 0 ? dist : 0;
    if (n < 16) return n;
    const float lr = logf((float)n / 16.0f) / 2.0794415416798357f;
    const int large = 16 + (int)(lr * 16.0f);
    return large < 31 ? large : 31;
}

struct Frame {
    const float* in[23]; float* out; unsigned char* ws;
    LAS unsigned char* lds; int tid, lane, wave, G;
};

__device__ __forceinline__ void transpose_tile(const Frame& F, const float* src, int srcK, int srcN, bf16_t* dst, int dstK, int kt, int nt) {
    LAS float* tile = (LAS float*)F.lds;
    const int k0 = kt * 64, n0 = nt * 64;
    for (int i = F.tid; i < 4096; i += NTHREADS) { const int r = i >> 6, c = i & 63; const int k = k0 + r, n = n0 + c;
        tile[r * 65 + c] = (k < srcK && n < srcN) ? src[(size_t)k * srcN + n] : 0.0f; }
    __syncthreads();
    for (int i = F.tid; i < 4096; i += NTHREADS) { const int r = i >> 6, c = i & 63;
        dst[(size_t)(n0 + r) * dstK + k0 + c] = f2bf(tile[c * 65 + r]); }
    __syncthreads();
}
__device__ __forceinline__ void p0_prologue(const Frame& F) {
    const float* c = F.in[1]; const float* w_mod = F.in[4]; const float* b_mod = F.in[5];
    float* MOD = (float*)(F.ws + WS_MOD);
    constexpr int I_MOD = 192, I_WIN = 16 * 48, I_WOUT = 256, I_WQ = 256, I_U = 256, I_V = 256, I_KEYS = 2;
    constexpr int O_WIN = I_MOD, O_WOUT = O_WIN + I_WIN, O_WQ = O_WOUT + I_WOUT, O_U = O_WQ + I_WQ, O_V = O_U + I_U, O_KEYS = O_V + I_V, N_ITEMS = O_KEYS + I_KEYS;
    for (int it = blockIdx.x; it < N_ITEMS; it += F.G) {
        if (it < O_WIN) {
            const int idx = it * NTHREADS + F.tid; const int b = idx / 6144, j = idx % 6144;
            float acc = 0.f;
            for (int k = 0; k < D; ++k) { const float cv = c[b * D + k]; const float sv = cv / (1.0f + __expf(-cv)); acc += sv * w_mod[(size_t)k * 6144 + j]; }
            MOD[b * 6144 + j] = acc + b_mod[j];
        } else if (it < O_WOUT) { const int i = it - O_WIN; transpose_tile(F, F.in[6], D, NCOL, (bf16_t*)(F.ws + WS_WIN), D, i % 16, i / 16); }
        else if (it < O_WQ) { const int i = it - O_WOUT; transpose_tile(F, F.in[16], D, D, (bf16_t*)(F.ws + WS_WOUT), D, i % 16, i / 16); }
        else if (it < O_U) { const int i = it - O_WQ; transpose_tile(F, F.in[17], D, D, (bf16_t*)(F.ws + WS_WQ), D, i % 16, i / 16); }
        else if (it < O_KEYS) {
            const bool isv = it >= O_V; const int i = isv ? it - O_V : it - O_U;
            const float4* src = (const float4*)(isv ? F.in[20] : F.in[19]) + (size_t)i * 16384;
            uint2* dst = (uint2*)(F.ws + (isv ? WS_VB : WS_UB)) + (size_t)i * 16384;
            for (int q = F.tid; q < 16384; q += NTHREADS) { const float4 v = src[q]; dst[q] = make_uint2(pack2(v.x, v.y), pack2(v.z, v.w)); }
        } else {
            const int i = it - O_KEYS; const float4* src = (const float4*)F.in[18] + (size_t)i * 16384; uint2* dst = (uint2*)(F.ws + WS_KEYS) + (size_t)i * 16384;
            for (int q = F.tid; q < 16384; q += NTHREADS) { const float4 v = src[q]; dst[q] = make_uint2(pack2(v.x, v.y), pack2(v.z, v.w)); }
        }
    }
}

__device__ __forceinline__ void norm_mod_rows(const Frame& F, const float* x, const float* g, int sh_off, int sc_off, bf16_t* dst) {
    const float* MOD = (const float*)(F.ws + WS_MOD);
    const int gw = blockIdx.x * NWAVES + F.wave, nw = F.G * NWAVES;
    for (int t = gw; t < T; t += nw) {
        const int b = t / S; const float4* xr = (const float4*)(x + (size_t)t * D);
        float4 v[4]; float ss = 0.f;
#pragma unroll
        for (int i = 0; i < 4; ++i) { v[i] = xr[F.lane + 64 * i]; ss += v[i].x * v[i].x + v[i].y * v[i].y + v[i].z * v[i].z + v[i].w * v[i].w; }
        ss = wave_sum(ss); const float rstd = rsqrtf(ss * (1.0f / D) + EPS);
#pragma unroll
        for (int i = 0; i < 4; ++i) { const int col = (F.lane + 64 * i) * 4;
            const float4 gg = *(const float4*)(g + col), sc = *(const float4*)(MOD + b * 6144 + sc_off + col), sh = *(const float4*)(MOD + b * 6144 + sh_off + col);
            const float o0 = v[i].x * rstd * gg.x * (1.f + sc.x) + sh.x, o1 = v[i].y * rstd * gg.y * (1.f + sc.y) + sh.y, o2 = v[i].z * rstd * gg.z * (1.f + sc.z) + sh.z, o3 = v[i].w * rstd * gg.w * (1.f + sc.w) + sh.w;
            *(uint2*)(dst + (size_t)t * D + col) = make_uint2(pack2(o0, o1), pack2(o2, o3)); }
    }
}

__device__ __forceinline__ void p3_compress_naive(const Frame& F) {
    const bf16_t* PROJ = (const bf16_t*)(F.ws + WS_PROJ);
    LAS float* hid = (LAS float*)F.lds + F.wave * 64;
    const int gw = blockIdx.x * NWAVES + F.wave, nw = F.G * NWAVES;
    for (int u = gw; u < NB * NCMP * 2 * 2; u += nw) {
        const int kv = u & 1, g = (u >> 1) & 1, n = (u >> 2) % NCMP, b = (u >> 2) / NCMP;
        const float* pe = kv ? F.in[8] : F.in[7]; const float* w1 = kv ? F.in[11] : F.in[9]; const float* w2 = kv ? F.in[12] : F.in[10];
        const int cbase = (kv ? C_VC : C_KC) + g * 64;
        float acc = 0.f;
        for (int l = 0; l < 32; ++l) {
            const bf16_t* row = PROJ + (size_t)(b * S + 16 * n + l) * NPAD + cbase;
            for (int d = 0; d < 64; ++d) { const float a = bf2f(row[d]) + pe[l * 64 + d]; acc += a * w1[(size_t)(l * 64 + d) * 64 + F.lane]; }
        }
        hid[F.lane] = gelu_tanh(acc); lds_wave_sync();
        float o = 0.f;
        for (int j = 0; j < 64; ++j) o += hid[j] * w2[j * 64 + F.lane];
        bf16_t* dst = (bf16_t*)(F.ws + (kv ? WS_VC : WS_KC)); dst[((size_t)(b * 2 + g) * 128 + n) * 64 + F.lane] = f2bf(o);
        lds_wave_sync();
    }
}

__device__ __forceinline__ void dot4_row(const bf16_t* krow, const LAS float* qs, float (&acc)[4]) {
    const uint4* kr = (const uint4*)krow;
#pragma unroll 1
    for (int c = 0; c < 8; ++c) { asm volatile("" ::: "memory"); const uint4 w = kr[c]; const unsigned ww[4] = {w.x, w.y, w.z, w.w};
#pragma unroll
        for (int e = 0; e < 4; ++e) { const float k0 = bflo(ww[e]), k1 = bfhi(ww[e]); const int d = c * 8 + e * 2;
#pragma unroll
            for (int r = 0; r < 4; ++r) acc[r] += qs[r * 64 + d] * k0 + qs[r * 64 + d + 1] * k1; } }
}
__device__ __forceinline__ void p4_attn_naive(const Frame& F) {
    const bf16_t* PROJ = (const bf16_t*)(F.ws + WS_PROJ); const bf16_t* KC = (const bf16_t*)(F.ws + WS_KC); const bf16_t* VC = (const bf16_t*)(F.ws + WS_VC);
    bf16_t* OATT = (bf16_t*)(F.ws + WS_OATT); const float* rel = F.in[21];
    LAS float* wl = (LAS float*)F.lds + F.wave * (256 + 512 + 2048 + 16);
    LAS float* qs = wl; LAS float* pc = wl + 256; LAS float* ps = wl + 768; LAS int* pbase = (LAS int*)(wl + 768 + 2048);
    const int gw = blockIdx.x * NWAVES + F.wave, nw = F.G * NWAVES, lane = F.lane;
    for (int u = gw; u < T * 2; u += nw) {
        const int g = u & 1, tok = u >> 1, b = tok / S, t = tok % S;
        const bf16_t* prow = PROJ + (size_t)tok * NPAD;
#pragma unroll
        for (int r = 0; r < 4; ++r) qs[r * 64 + lane] = bf2f(prow[C_Q + (g * 4 + r) * 64 + lane]) * 0.125f;
        lds_wave_sync();
        const int nv = t >= 31 ? ((t - 31) >> 4) + 1 : 0;
        float sc[2][4]; bool va[2];
#pragma unroll
        for (int i = 0; i < 2; ++i) { const int n = lane + 64 * i; va[i] = n < nv; float a[4] = {0.f, 0.f, 0.f, 0.f};
            if (va[i]) { dot4_row(KC + ((size_t)(b * 2 + g) * 128 + n) * 64, qs, a); const int bk = rel_bucket(t - (16 * n + 31));
#pragma unroll
                for (int r = 0; r < 4; ++r) a[r] += rel[bk * 8 + g * 4 + r]; }
#pragma unroll
            for (int r = 0; r < 4; ++r) sc[i][r] = va[i] ? a[r] : -1e30f; }
        float ocmp[4];
#pragma unroll
        for (int r = 0; r < 4; ++r) { const float m = wave_max(fmaxf(sc[0][r], sc[1][r]));
            const float e0 = va[0] ? __expf(sc[0][r] - m) : 0.f, e1 = va[1] ? __expf(sc[1][r] - m) : 0.f; const float sum = wave_sum(e0 + e1);
            const float inv = nv > 0 ? 1.0f / sum : 0.f; pc[r * 128 + lane] = e0 * inv; pc[r * 128 + 64 + lane] = e1 * inv; }
        lds_wave_sync();
        { float o[4] = {0.f, 0.f, 0.f, 0.f}; const bf16_t* vb = VC + ((size_t)(b * 2 + g) * 128) * 64 + lane;
            for (int n = 0; n < nv; ++n) { const float v = bf2f(vb[n * 64]);
#pragma unroll
                for (int r = 0; r < 4; ++r) o[r] += pc[r * 128 + n] * v; }
#pragma unroll
            for (int r = 0; r < 4; ++r) ocmp[r] = o[r]; }
        const int cur = t >> 6; float val;
        { const int j = lane & 31; float imp = 0.f;
#pragma unroll
            for (int r = 0; r < 4; ++r) for (int n = 4 * j - 1; n <= 4 * j + 3; ++n) if (n >= 0 && n < NCMP) imp += pc[r * 128 + n];
            const bool forced = (j == 0) || (j == cur) || (j == cur - 1); const bool allowed = j <= cur;
            val = forced ? 1e4f : (allowed ? imp : -INFINITY); }
        int rank = 0;
        for (int jp = 0; jp < 32; ++jp) { const float vp = __shfl(val, jp); rank += ((vp > val) || (vp == val && jp < (lane & 31))) ? 1 : 0; }
        unsigned selmask = (unsigned)(__ballot(lane < 32 && rank < 8) & 0xFFFFFFFFull);
        float oslc[4], owin[4];
#pragma unroll
        for (int br = 0; br < 2; ++br) {
            const int ck = br == 0 ? C_KS : C_KW, cv = br == 0 ? C_VS : C_VW;
            unsigned mk = selmask;
#pragma unroll 1
            for (int c = 0; c < 8; ++c) {
                int kpos, bs;
                if (br == 0) { const int j = __builtin_ctz(mk | 0x80000000u); mk &= mk - 1; bs = 64 * j; } else { bs = t - 511 + 64 * c; }
                kpos = bs + lane; if (lane == 0) pbase[c] = bs;
                const int dist = t - kpos; const bool vv = (dist >= 0) && (kpos >= 0) && (kpos < S);
                float a[4] = {0.f, 0.f, 0.f, 0.f};
                if (vv) { dot4_row(PROJ + (size_t)(b * S + kpos) * NPAD + ck + g * 64, qs, a); const int bk = rel_bucket(dist);
#pragma unroll
                    for (int r = 0; r < 4; ++r) a[r] += rel[bk * 8 + g * 4 + r]; }
#pragma unroll
                for (int r = 0; r < 4; ++r) ps[r * 512 + c * 64 + lane] = vv ? a[r] : -1e30f;
            }
            lds_wave_sync();
#pragma unroll 1
            for (int r = 0; r < 4; ++r) { float m = -1e30f;
#pragma unroll
                for (int c = 0; c < 8; ++c) m = fmaxf(m, ps[r * 512 + c * 64 + lane]);
                m = wave_max(m); float e[8], sum = 0.f;
#pragma unroll
                for (int c = 0; c < 8; ++c) { const float sv = ps[r * 512 + c * 64 + lane]; e[c] = sv > -1e29f ? __expf(sv - m) : 0.f; sum += e[c]; }
                sum = wave_sum(sum); const float inv = sum > 0.f ? 1.0f / sum : 0.f;
#pragma unroll
                for (int c = 0; c < 8; ++c) ps[r * 512 + c * 64 + lane] = e[c] * inv; }
            lds_wave_sync();
            float o[4] = {0.f, 0.f, 0.f, 0.f};
#pragma unroll 1
            for (int c = 0; c < 8; ++c) {
                const int bsc = pbase[c];
                for (int kk = 0; kk < 64; ++kk) { const int kpos = bsc + kk; if (kpos < 0 || kpos > t) continue;
                    const float v = bf2f(PROJ[(size_t)(b * S + kpos) * NPAD + cv + g * 64 + lane]);
#pragma unroll
                    for (int r = 0; r < 4; ++r) o[r] += ps[r * 512 + c * 64 + kk] * v; } }
            lds_wave_sync();
#pragma unroll
            for (int r = 0; r < 4; ++r) { if (br == 0) oslc[r] = o[r]; else owin[r] = o[r]; }
        }
#pragma unroll
        for (int r = 0; r < 4; ++r) { const int h = g * 4 + r;
            const float g0 = sigmoidf_(bf2f(prow[C_GT + h * 3 + 0])), g1 = sigmoidf_(bf2f(prow[C_GT + h * 3 + 1])), g2 = sigmoidf_(bf2f(prow[C_GT + h * 3 + 2]));
            OATT[(size_t)tok * 512 + h * 64 + lane] = f2bf(g0 * ocmp[r] + g1 * oslc[r] + g2 * owin[r]); }
    }
}

__device__ __forceinline__ void p5_mixed(const Frame& F) {
    const bf16_t* PROJ = (const bf16_t*)(F.ws + WS_PROJ); const bf16_t* OATT = (const bf16_t*)(F.ws + WS_OATT); bf16_t* MIX = (bf16_t*)(F.ws + WS_H);
    const float* cw = F.in[13]; const float* ga = F.in[14]; const float* gc = F.in[15];
    const int gw = blockIdx.x * NWAVES + F.wave, nw = F.G * NWAVES, lane = F.lane;
    for (int tok = gw; tok < T; tok += nw) {
        const int s = tok % S; const int c0 = lane * 8;
        float a[8], y[8];
        { const uint4 w = *(const uint4*)(OATT + (size_t)tok * 512 + c0); const unsigned ww[4] = {w.x, w.y, w.z, w.w};
#pragma unroll
            for (int e = 0; e < 4; ++e) { a[2 * e] = bflo(ww[e]); a[2 * e + 1] = bfhi(ww[e]); } }
#pragma unroll
        for (int e = 0; e < 8; ++e) y[e] = 0.f;
#pragma unroll
        for (int dt = 0; dt < 3; ++dt) { if (s - 2 + dt >= 0) { const bf16_t* row = PROJ + (size_t)(tok - 2 + dt) * NPAD;
                const uint4 wc = *(const uint4*)(row + C_CC + c0), wh = *(const uint4*)(row + C_CH + c0); const unsigned c4[4] = {wc.x, wc.y, wc.z, wc.w}, h4[4] = {wh.x, wh.y, wh.z, wh.w};
#pragma unroll
                for (int e = 0; e < 4; ++e) { y[2 * e] += cw[dt * 512 + c0 + 2 * e] * (bflo(c4[e]) * bflo(h4[e])); y[2 * e + 1] += cw[dt * 512 + c0 + 2 * e + 1] * (bfhi(c4[e]) * bfhi(h4[e])); } } }
        { const uint4 wb = *(const uint4*)(PROJ + (size_t)tok * NPAD + C_CB + c0); const unsigned b4[4] = {wb.x, wb.y, wb.z, wb.w};
#pragma unroll
            for (int e = 0; e < 4; ++e) { y[2 * e] *= bflo(b4[e]); y[2 * e + 1] *= bfhi(b4[e]); } }
        float sa = 0.f, sy = 0.f;
#pragma unroll
        for (int e = 0; e < 8; ++e) { sa += a[e] * a[e]; sy += y[e] * y[e]; }
        sa = wave_sum(sa); sy = wave_sum(sy);
        const float ra = rsqrtf(sa * (1.0f / 512) + EPS), ry = rsqrtf(sy * (1.0f / 512) + EPS);
        unsigned oa[4], oy[4];
#pragma unroll
        for (int e = 0; e < 4; ++e) { oa[e] = pack2(a[2 * e] * ra * ga[c0 + 2 * e], a[2 * e + 1] * ra * ga[c0 + 2 * e + 1]); oy[e] = pack2(y[2 * e] * ry * gc[c0 + 2 * e], y[2 * e + 1] * ry * gc[c0 + 2 * e + 1]); }
        *(uint4*)(MIX + (size_t)tok * D + c0) = make_uint4(oa[0], oa[1], oa[2], oa[3]);
        *(uint4*)(MIX + (size_t)tok * D + 512 + c0) = make_uint4(oy[0], oy[1], oy[2], oy[3]);
    }
}

struct EpiResGate {
    static constexpr bool PERM = false, AFTER_DRAIN = false;
    float* C; const float* X; const float* MOD; int gate_off;
    __device__ __forceinline__ void operator()(const pg8::f32x4 (&acc)[2][2][4][2], const pg8::Unit& u, int wr, int wc, int fr, int fq) const {
        using pg8::f32x4; using pg8::HALF; using pg8::BM;
        const int row0 = u.pm * BM + wr * 64 + fr, col0 = u.pn * BM + wc * 32 + 4 * fq;
        const int b = (u.pm * BM) / S;
        f32x4 gv[2][2];
#pragma unroll
        for (int bj = 0; bj < 2; ++bj)
#pragma unroll
            for (int n = 0; n < 2; ++n) gv[bj][n] = *(const f32x4*)(MOD + b * 6144 + gate_off + col0 + bj * HALF + n * 16);
#pragma unroll
        for (int ai = 0; ai < 2; ++ai)
#pragma unroll
            for (int m = 0; m < 4; ++m) { const size_t ro = (size_t)(row0 + ai * HALF + m * 16) * D + col0;
#pragma unroll
                for (int bj = 0; bj < 2; ++bj)
#pragma unroll
                    for (int n = 0; n < 2; ++n) { const f32x4 xv = *(const f32x4*)(X + ro + bj * HALF + n * 16); *(f32x4*)(C + ro + bj * HALF + n * 16) = xv + gv[bj][n] * acc[ai][bj][m][n]; } }
    }
};

__device__ __forceinline__ void argmax_bfly(float& v, int& i) {
#pragma unroll
    for (int o = 32; o >= 1; o >>= 1) { const float ov = __shfl_xor(v, o); const int oi = __shfl_xor(i, o); if (ov > v || (ov == v && oi < i)) { v = ov; i = oi; } }
}
__device__ __forceinline__ void p9_route_naive(const Frame& F) {
    const bf16_t* QP = (const bf16_t*)(F.ws + WS_QP); const bf16_t* KEYS = (const bf16_t*)(F.ws + WS_KEYS);
    int* EIDX = (int*)(F.ws + WS_EIDX); float* EW = (float*)(F.ws + WS_EW);
    LAS float* ql = (LAS float*)F.lds + F.wave * 128;
    const int gw = blockIdx.x * NWAVES + F.wave, nw = F.G * NWAVES, lane = F.lane;
    for (int u = gw; u < T * 8; u += nw) {
        const int h = u & 7, tok = u >> 3;
        ql[lane] = bf2f(QP[(size_t)tok * D + h * 128 + lane]); ql[64 + lane] = bf2f(QP[(size_t)tok * D + h * 128 + 64 + lane]);
        lds_wave_sync();
        float tv[2]; int ti[2];
#pragma unroll
        for (int p = 0; p < 2; ++p) {
            float s[2];
#pragma unroll
            for (int kk = 0; kk < 2; ++kk) { const uint4* kr = (const uint4*)(KEYS + ((size_t)(h * 2 + p) * 128 + lane + 64 * kk) * 64); float a = 0.f;
#pragma unroll
                for (int c = 0; c < 8; ++c) { const uint4 w = kr[c]; const unsigned ww[4] = {w.x, w.y, w.z, w.w};
#pragma unroll
                    for (int e = 0; e < 4; ++e) a += ql[p * 64 + c * 8 + 2 * e] * bflo(ww[e]) + ql[p * 64 + c * 8 + 2 * e + 1] * bfhi(ww[e]); }
                s[kk] = a; }
            tv[p] = 0.f; ti[p] = 0;
            for (int i = 0; i < 16; ++i) {
                float v = s[0]; int ix = lane; if (s[1] > v) { v = s[1]; ix = lane + 64; }
                argmax_bfly(v, ix);
                if (lane == i) { tv[p] = v; ti[p] = ix; }
                if (ix == lane) s[0] = -INFINITY; if (ix == lane + 64) s[1] = -INFINITY;
            }
        }
        float cd[4];
        { const float va = __shfl(tv[0], lane >> 2);
#pragma unroll
            for (int i = 0; i < 4; ++i) cd[i] = va + __shfl(tv[1], (lane & 3) * 4 + i); }
        float cs = 0.f; int cc = 0;
        for (int it = 0; it < 16; ++it) {
            float v = cd[0]; int ix = lane * 4;
#pragma unroll
            for (int i = 1; i < 4; ++i) if (cd[i] > v) { v = cd[i]; ix = lane * 4 + i; }
            argmax_bfly(v, ix);
            if (lane == it) { cs = v; cc = ix; }
#pragma unroll
            for (int i = 0; i < 4; ++i) if (ix == lane * 4 + i) cd[i] = -INFINITY;
        }
        const int i1 = __shfl(ti[0], cc >> 4), i2 = __shfl(ti[1], cc & 15);
        const float m = __shfl(cs, 0); float ex = lane < 16 ? __expf(cs - m) : 0.f; const float sum = wave_sum(ex);
        if (lane < 16) { EIDX[(size_t)tok * 128 + h * 16 + lane] = i1 * 128 + i2; EW[(size_t)tok * 128 + h * 16 + lane] = ex / sum; }
        lds_wave_sync();
    }
}

__device__ __forceinline__ void p10_peer_naive(const Frame& F) {
    const bf16_t* H2 = (const bf16_t*)(F.ws + WS_H); const bf16_t* UB = (const bf16_t*)(F.ws + WS_UB); const bf16_t* VB = (const bf16_t*)(F.ws + WS_VB);
    const int* EIDX = (const int*)(F.ws + WS_EIDX); const float* EW = (const float*)(F.ws + WS_EW); const float* MOD = (const float*)(F.ws + WS_MOD);
    const float* gfin = F.in[22]; float* out = F.out;
    const int gw = blockIdx.x * NWAVES + F.wave, nw = F.G * NWAVES, lane = F.lane;
    for (int tok = gw; tok < T; tok += nw) {
        const int b = tok / S;
        float xr[16], acc[16];
#pragma unroll
        for (int hlf = 0; hlf < 2; ++hlf) { const uint4 w = *(const uint4*)(H2 + (size_t)tok * D + hlf * 512 + lane * 8); const unsigned ww[4] = {w.x, w.y, w.z, w.w};
#pragma unroll
            for (int e = 0; e < 4; ++e) { xr[hlf * 8 + 2 * e] = bflo(ww[e]); xr[hlf * 8 + 2 * e + 1] = bfhi(ww[e]); } }
#pragma unroll
        for (int e = 0; e < 16; ++e) acc[e] = 0.f;
        for (int i0 = 0; i0 < 128; i0 += 4) {
            int ei[4]; float wi[4], dt[4];
#pragma unroll
            for (int i = 0; i < 4; ++i) { ei[i] = __builtin_amdgcn_readfirstlane(EIDX[(size_t)tok * 128 + i0 + i]); wi[i] = EW[(size_t)tok * 128 + i0 + i]; }
#pragma unroll
            for (int i = 0; i < 4; ++i) { float d = 0.f;
#pragma unroll
                for (int hlf = 0; hlf < 2; ++hlf) { const uint4 w = *(const uint4*)(UB + (size_t)ei[i] * D + hlf * 512 + lane * 8); const unsigned ww[4] = {w.x, w.y, w.z, w.w};
#pragma unroll
                    for (int e = 0; e < 4; ++e) d += xr[hlf * 8 + 2 * e] * bflo(ww[e]) + xr[hlf * 8 + 2 * e + 1] * bfhi(ww[e]); }
                dt[i] = d; }
#pragma unroll
            for (int i = 0; i < 4; ++i) { const float dot = wave_sum(dt[i]); const float cf = wi[i] * gelu_tanh(dot);
#pragma unroll
                for (int hlf = 0; hlf < 2; ++hlf) { const uint4 w = *(const uint4*)(VB + (size_t)ei[i] * D + hlf * 512 + lane * 8); const unsigned ww[4] = {w.x, w.y, w.z, w.w};
#pragma unroll
                    for (int e = 0; e < 4; ++e) { acc[hlf * 8 + 2 * e] += cf * bflo(ww[e]); acc[hlf * 8 + 2 * e + 1] += cf * bfhi(ww[e]); } } }
        }
        float x2[16], ss = 0.f;
#pragma unroll
        for (int hlf = 0; hlf < 2; ++hlf)
#pragma unroll
            for (int q = 0; q < 2; ++q) { const int col = hlf * 512 + lane * 8 + q * 4; const float4 x1 = *(const float4*)(out + (size_t)tok * D + col); const float4 gt = *(const float4*)(MOD + b * 6144 + 5120 + col);
                const int e = hlf * 8 + q * 4;
                x2[e] = x1.x + gt.x * acc[e]; x2[e + 1] = x1.y + gt.y * acc[e + 1]; x2[e + 2] = x1.z + gt.z * acc[e + 2]; x2[e + 3] = x1.w + gt.w * acc[e + 3];
                ss += x2[e] * x2[e] + x2[e + 1] * x2[e + 1] + x2[e + 2] * x2[e + 2] + x2[e + 3] * x2[e + 3]; }
        ss = wave_sum(ss); const float rstd = rsqrtf(ss * (1.0f / D) + EPS);
#pragma unroll
        for (int hlf = 0; hlf < 2; ++hlf)
#pragma unroll
            for (int q = 0; q < 2; ++q) { const int col = hlf * 512 + lane * 8 + q * 4; const float4 gg = *(const float4*)(gfin + col); const int e = hlf * 8 + q * 4;
                *(float4*)(out + (size_t)tok * D + col) = make_float4(x2[e] * rstd * gg.x, x2[e + 1] * rstd * gg.y, x2[e + 2] * rstd * gg.z, x2[e + 3] * rstd * gg.w); }
    }
}

constexpr int N_PHASES = 11;
struct Args { const float* in[23]; float* out; unsigned char* ws; int ph_lo, ph_hi; };
__global__ void __launch_bounds__(NTHREADS, 2) fwd(Args args) {
    extern __shared__ __attribute__((aligned(16))) unsigned char lds_raw[];
    Frame F;
#pragma unroll
    for (int i = 0; i < 23; ++i) F.in[i] = args.in[i];
    F.out = args.out; F.ws = args.ws; F.lds = (LAS unsigned char*)lds_raw;
    F.tid = threadIdx.x; F.lane = F.tid & 63; F.wave = __builtin_amdgcn_readfirstlane(F.tid >> 6); F.G = gridDim.x;
    volatile LAS unsigned* misc = (volatile LAS unsigned*)(F.lds + LDS_MISC_OFF);
    if (F.tid < 64) misc[F.tid] = 0u;
    __syncthreads();
    XcdBarrier bar; bar.bar = (unsigned*)(F.ws + WS_CTL); bar.x = 0; bar.st = misc;
    const int lo = args.ph_lo, hi = args.ph_hi;
    if (hi - lo > 1) bar = xcd_barrier_post((unsigned*)(F.ws + WS_CTL), misc);
#ifndef PH_MASK
#define PH_MASK 0xFFFF
#endif
#define IN(k) (((PH_MASK >> (k)) & 1) && lo <= (k) && (k) < hi)
#define SEAM(k) do { if (IN(k) && IN((k) + 1)) xcd_barrier(bar); } while (0)
    const float* MOD = (const float*)(F.ws + WS_MOD);
    if (IN(0)) { p0_prologue(F); } SEAM(0);
    if (IN(1)) { norm_mod_rows(F, F.in[0], F.in[2], 0, 1024, (bf16_t*)(F.ws + WS_H)); } SEAM(1);
    if (IN(2)) { pg8::Gemm g{(const pg8::bf16_t*)(F.ws + WS_H), (const pg8::bf16_t*)(F.ws + WS_WIN), T, NPAD, D}; pg8::StaticOrder So; So.init(T, NPAD, F.G, (int)blockIdx.x);
        pg8::EpiBf16<0> E{(pg8::bf16_t*)(F.ws + WS_PROJ), NPAD, nullptr, 0, 0};
        pg8::gemm_phase<pg8::EpiBf16<0>, pg8::StaticOrder>(F.lds, g, So, E, nullptr); } SEAM(2);
    if (IN(3)) { p3_compress_naive(F); } SEAM(3);
    if (IN(4)) { p4_attn_naive(F); } SEAM(4);
    if (IN(5)) { p5_mixed(F); } SEAM(5);
    if (IN(6)) { pg8::Gemm g{(const pg8::bf16_t*)(F.ws + WS_H), (const pg8::bf16_t*)(F.ws + WS_WOUT), T, D, D}; pg8::StaticOrder So; So.init(T, D, F.G, (int)blockIdx.x);
        EpiResGate E{F.out, F.in[0], MOD, 2048};
        pg8::gemm_phase<EpiResGate, pg8::StaticOrder>(F.lds, g, So, E, nullptr); } SEAM(6);
    if (IN(7)) { norm_mod_rows(F, F.out, F.in[3], 3072, 4096, (bf16_t*)(F.ws + WS_H)); } SEAM(7);
    if (IN(8)) { pg8::Gemm g{(const pg8::bf16_t*)(F.ws + WS_H), (const pg8::bf16_t*)(F.ws + WS_WQ), T, D, D}; pg8::StaticOrder So; So.init(T, D, F.G, (int)blockIdx.x);
        pg8::EpiBf16<0> E{(pg8::bf16_t*)(F.ws + WS_QP), D, nullptr, 0, 0};
        pg8::gemm_phase<pg8::EpiBf16<0>, pg8::StaticOrder>(F.lds, g, So, E, nullptr); } SEAM(8);
    if (IN(9)) { p9_route_naive(F); } SEAM(9);
    if (IN(10)) { p10_peer_naive(F); }
#undef IN
#undef SEAM
}

extern "C" void kernel_launch(void* const* d_in, const int* in_sizes, int n_in, void* d_out, int out_size, void* d_ws, size_t ws_size, hipStream_t stream) {
    static int grid = 0;
    if (grid == 0) {
        if (n_in != 23 || out_size != T * D || ws_size < WS_END) { fprintf(stderr, "kernel_launch: unexpected shapes: n_in %d out %d ws %zu (need %zu)\n", n_in, out_size, ws_size, (size_t)WS_END); grid = -1; return; }
        int dev = 0, cus = 0, per_cu = 0;
        if (hipGetDevice(&dev) != hipSuccess || hipDeviceGetAttribute(&cus, hipDeviceAttributeMultiprocessorCount, dev) != hipSuccess) { grid = -1; return; }
        if (hipFuncSetAttribute((const void*)fwd, hipFuncAttributeMaxDynamicSharedMemorySize, LDS_BYTES) != hipSuccess) { fprintf(stderr, "kernel_launch: hipFuncSetAttribute failed\n"); grid = -1; return; }
        if (hipOccupancyMaxActiveBlocksPerMultiprocessor(&per_cu, (const void*)fwd, NTHREADS, LDS_BYTES) != hipSuccess || per_cu < 1) { fprintf(stderr, "kernel_launch: occupancy query says %d\n", per_cu); (void)hipGetLastError(); per_cu = 1; }
        grid = cus;
    }
    if (grid < 0) return;
    (void)hipMemsetAsync((char*)d_ws + WS_CTL, 0, CTL_BYTES, stream);
    Args a{};
    for (int i = 0; i < 23; ++i) a.in[i] = (const float*)d_in[i];
    a.out = (float*)d_out; a.ws = (unsigned char*)d_ws;
#if MK_N_LAUNCHES == 1
    a.ph_lo = 0; a.ph_hi = N_PHASES;
    hipLaunchKernelGGL(fwd, dim3(grid), dim3(NTHREADS), LDS_BYTES, stream, a);
#else
    for (int p = 0; p < N_PHASES; ++p) { a.ph_lo = p; a.ph_hi = p + 1; hipLaunchKernelGGL(fwd, dim3(grid), dim3(NTHREADS), LDS_BYTES, stream, a); }
#endif
}
```

```cpp
#include <hip/hip_runtime.h>
#include <cstdio>
#include <cstdint>
#include <cstdlib>

#ifndef MK_N_LAUNCHES
#define MK_N_LAUNCHES 1
#endif
#define XB_TMO      128
#define XB_XCNT(j)  (256  + 64 * (j))
#define XB_XSUB(j)  (1280 + 64 * (j))
#define XB_XGEN(j)  (2304 + 64 * (j))
#define XB_TOP      3328
#define XB_TOPGEN   3392
#define XCD_BAR_WORDS 3456
#define XB_SPIN_CAP (1u << 18)
#define LAS __attribute__((address_space(3)))

__device__ __forceinline__ unsigned xb_ld(unsigned* p)              { return __hip_atomic_load(p, __ATOMIC_RELAXED, __HIP_MEMORY_SCOPE_AGENT); }
__device__ __forceinline__ unsigned xb_add(unsigned* p, unsigned v) { return __hip_atomic_fetch_add(p, v, __ATOMIC_RELAXED, __HIP_MEMORY_SCOPE_AGENT); }
__device__ __forceinline__ unsigned xb_xcc_id() { return (unsigned)__builtin_amdgcn_s_getreg((3 << 11) | 20) & 0xFu; }
#define XB_SPIN(cond, bar) do { unsigned _sp = 0; while (cond) { __builtin_amdgcn_s_sleep(1); \
    if ((++_sp & 255u) == 0u) { if (xb_ld(&(bar)[XB_TMO])) break; if (_sp > XB_SPIN_CAP) { atomicAdd(&(bar)[XB_TMO], 1u); break; } } } } while (0)

struct XcdBarrier {
    unsigned* bar; unsigned x;
    volatile LAS unsigned* st;
};

__device__ __forceinline__ XcdBarrier xcd_barrier_post(unsigned* bar, volatile LAS unsigned* st) {
    XcdBarrier b; b.bar = bar; b.x = xb_xcc_id(); b.st = st;
    if (threadIdx.x == 0) (void)xb_add(&bar[XB_XCNT(b.x)], 1u);
    return b;
}
__device__ __forceinline__ void xcd_barrier_complete(unsigned* bar, unsigned x, unsigned& nloc, unsigned& nx) {
    const unsigned G = gridDim.x * gridDim.y * gridDim.z;
    unsigned sum, cnt, mine, sp = 0u;
    for (;;) {
        sum = 0u; cnt = 0u; mine = 0u;
#pragma unroll
        for (unsigned j = 0; j < 16; ++j) { const unsigned c = xb_ld(&bar[XB_XCNT(j)]); sum += c; cnt += (c > 0u) ? 1u : 0u; mine = (j == x) ? c : mine; }
        if (sum == G) break;
        __builtin_amdgcn_s_sleep(1);
        if ((++sp & 255u) == 0u) { if (xb_ld(&bar[XB_TMO])) break; if (sp > XB_SPIN_CAP) { atomicAdd(&bar[XB_TMO], 1u); break; } }
    }
    nloc = mine > 0u ? mine : 1u; nx = cnt > 0u ? cnt : 1u;
}

__device__ __forceinline__ void xcd_barrier(const XcdBarrier& b) {
    asm volatile("s_waitcnt vmcnt(0)" ::: "memory");
    __syncthreads();
    if (threadIdx.x == 0) {
        unsigned* bar = b.bar;
        __builtin_amdgcn_s_waitcnt(0);
        unsigned nloc = b.st[0], nx = b.st[1];
        if (nloc == 0u) { xcd_barrier_complete(bar, b.x, nloc, nx); b.st[0] = nloc; b.st[1] = nx; }
        const unsigned old = xb_add(&bar[XB_XSUB(b.x)], 1u);
        const unsigned gen = old / nloc;
        if (old + 1u == (gen + 1u) * nloc) {
            __builtin_amdgcn_fence(__ATOMIC_RELEASE, "agent");
            asm volatile("s_waitcnt vmcnt(0)" ::: "memory");
            const unsigned og = xb_add(&bar[XB_TOP], 1u);
            const unsigned tg = og / nx;
            if (og + 1u == (tg + 1u) * nx) xb_add(&bar[XB_TOPGEN], 1u);
            else XB_SPIN(xb_ld(&bar[XB_TOPGEN]) == tg, bar);
            __builtin_amdgcn_fence(__ATOMIC_ACQUIRE, "agent");
            xb_add(&bar[XB_XGEN(b.x)], 1u);
            asm volatile("s_waitcnt vmcnt(0)" ::: "memory");
        } else {
            XB_SPIN(xb_ld(&bar[XB_XGEN(b.x)]) == gen, bar);
            __builtin_amdgcn_fence(__ATOMIC_ACQUIRE, "agent");
            asm volatile("s_waitcnt vmcnt(0)" ::: "memory");
        }
    }
    __syncthreads();
}

namespace pg8 {
#define PG8_LAS __attribute__((address_space(3)))
typedef unsigned short bf16_t;
typedef short bf16x8 __attribute__((ext_vector_type(8)));
typedef float f32x4 __attribute__((ext_vector_type(4)));
typedef unsigned u32x4 __attribute__((ext_vector_type(4)));
constexpr int BM = 256, BK = 64, HALF = 128, HTB = HALF * BK * 2  , STAGE_BYTES = 8 * HTB, NXCD = 8, WGM = 8;

__host__ __device__ __forceinline__ int lds_byte(int r, int c) { const int st = (r >> 4) * 2 + (c >> 5), rr = r & 15, cc = c & 31, ob = rr * 64 + cc * 2; return st * 1024 + (ob ^ (((ob >> 9) & 1) << 5)); }
__host__ __device__ __forceinline__ void stage_rc(int b, int& R, int& C) { const int st = b / 1024, sb = b % 1024, swz = sb ^ (((sb >> 9) & 1) << 5); R = (st >> 1) * 16 + swz / 64; C = (st & 1) * 32 + (swz % 64) / 2; }
__host__ __device__ __forceinline__ int perm32(int rho) { const int n = rho >> 4, i = rho & 15; return 8 * (i >> 2) + 4 * n + (i & 3); }

struct Unit { int pm, pn; };
struct Gemm { const bf16_t* A; const bf16_t* Bt; int M, N, K; };

struct StaticOrder {
    int nM, nN, nwg, G, c;
    __host__ __device__ void init(int M, int N, int G_, int c_) { nM = M / BM; nN = N / BM; nwg = nM * nN; G = G_; c = c_; }
    __host__ __device__ bool next(int i, Unit& u) const {
        const long L = (long)i * G + c; if (L >= nwg) return false;
        int wgid = (int)L; { const int q = nwg / NXCD, r = nwg % NXCD, xcd = wgid % NXCD, off = wgid / NXCD; wgid = (xcd < r ? xcd * (q + 1) : r * (q + 1) + (xcd - r) * q) + off; }
        const int nig = WGM * nN, gid = wgid / nig, fm = gid * WGM, gsz = (nM - fm) < WGM ? (nM - fm) : WGM;
        u.pm = fm + ((wgid % nig) % gsz); u.pn = (wgid % nig) / gsz; return true;
    }
    __device__ __forceinline__ void a_ready(const Unit&) const {}
    __device__ __forceinline__ void done(const Unit&) const {}
};
struct CountedOrder : StaticOrder {
    const unsigned* ready; unsigned need; unsigned* tmo;
    __device__ __forceinline__ void a_ready(const Unit& u) const {
        if (threadIdx.x < 64) {
            const unsigned long long t0 = __builtin_amdgcn_s_memrealtime(); unsigned polls = 0;
            while ((unsigned)__builtin_amdgcn_readfirstlane(__hip_atomic_load(ready + 64 * u.pm, __ATOMIC_RELAXED, __HIP_MEMORY_SCOPE_AGENT)) < need) {
                if ((++polls & 255u) == 0u && __builtin_amdgcn_readfirstlane(__hip_atomic_load(tmo, __ATOMIC_RELAXED, __HIP_MEMORY_SCOPE_AGENT)) != 0u) break;
                if (__builtin_amdgcn_s_memrealtime() - t0 > 2000000ull) {
                    if (threadIdx.x == 0) { unsigned expect = 0u; __hip_atomic_compare_exchange_strong(tmo + 1, &expect, 0x600u | (unsigned)(u.pm & 0xff), __ATOMIC_RELAXED, __ATOMIC_RELAXED, __HIP_MEMORY_SCOPE_AGENT); __hip_atomic_store(tmo, 1u, __ATOMIC_RELAXED, __HIP_MEMORY_SCOPE_AGENT); }
                    break; }
                __builtin_amdgcn_s_sleep(2); }
            __builtin_amdgcn_fence(__ATOMIC_ACQUIRE, "agent");
            asm volatile("s_waitcnt vmcnt(0)" ::: "memory");
        }
#if !defined(BROKEN_HOOK_NO_BARRIER)
        asm volatile("" ::: "memory"); __builtin_amdgcn_s_barrier(); asm volatile("" ::: "memory");
#endif
    }
};

__device__ __forceinline__ unsigned cvt_pk_bf16(float lo, float hi) { unsigned r; asm volatile("v_cvt_pk_bf16_f32 %0, %1, %2" : "=v"(r) : "v"(lo), "v"(hi)); return r; }
typedef float f32x2 __attribute__((ext_vector_type(2)));
__device__ __forceinline__ f32x2 gelu_pk(f32x2 v) {
    const f32x2 av = __builtin_elementwise_abs(v), d = av * 0.2316418882f + 1.0f;
    f32x2 t; t.x = __builtin_amdgcn_rcpf(d.x); t.y = __builtin_amdgcn_rcpf(d.y);
    f32x2 q = t * 0.5307027145f + (-0.7265760135f); q = q * t + 0.7107068705f; q = q * t + (-0.142248368f); q = q * t + 0.127414796f; q = q * t;
    const f32x2 s = (v * v) * (-0.72134752044f);
    f32x2 e; e.x = __builtin_amdgcn_exp2f(s.x); e.y = __builtin_amdgcn_exp2f(s.y);
    const f32x2 m = v * (q * e), r = v - m;
    f32x2 o; o.x = v.x < 0.f ? m.x : r.x; o.y = v.y < 0.f ? m.y : r.y; return o;
}

struct EpiF32 {
    static constexpr bool PERM = false, AFTER_DRAIN = false;
    float* C; int ldc; const float* bias;
    __device__ __forceinline__ void operator()(const f32x4 (&acc)[2][2][4][2], const Unit& u, int wr, int wc, int fr, int fq) const {
        const int row0 = u.pm * BM + wr * 64 + fr, col0 = u.pn * BM + wc * 32 + 4 * fq;
        f32x4 bv[2][2];
#pragma unroll
        for (int bj = 0; bj < 2; ++bj)
#pragma unroll
            for (int n = 0; n < 2; ++n) bv[bj][n] = bias ? *(const f32x4*)(bias + col0 + bj * HALF + n * 16) : (f32x4){0.f, 0.f, 0.f, 0.f};
#pragma unroll
        for (int ai = 0; ai < 2; ++ai)
#pragma unroll
            for (int m = 0; m < 4; ++m) { float* rowp = C + (size_t)(row0 + ai * HALF + m * 16) * ldc + col0;
#pragma unroll
                for (int bj = 0; bj < 2; ++bj)
#pragma unroll
                    for (int n = 0; n < 2; ++n) *(f32x4*)(rowp + bj * HALF + n * 16) = acc[ai][bj][m][n] + bv[bj][n]; }
    }
};
template <int ACT  > struct EpiBf16 {
    static constexpr bool PERM = true, AFTER_DRAIN = false;
    bf16_t* O; int ldc; const float* bias; int split_cols; size_t split_stride;
    __device__ __forceinline__ void operator()(const f32x4 (&acc)[2][2][4][2], const Unit& u, int wr, int wc, int fr, int fq) const {
        const int row0 = u.pm * BM + wr * 64 + fr; int colt = u.pn * BM; bf16_t* base = O;
        if (split_cols) { const int t = colt / split_cols; base += (size_t)t * split_stride; colt -= t * split_cols; }
        const int col0 = colt + wc * 32 + 8 * fq, bcol0 = u.pn * BM + wc * 32 + 8 * fq;
        f32x4 bv[2][2];
#pragma unroll
        for (int bj = 0; bj < 2; ++bj)
#pragma unroll
            for (int n = 0; n < 2; ++n) bv[bj][n] = bias ? *(const f32x4*)(bias + bcol0 + bj * HALF + 4 * n) : (f32x4){0.f, 0.f, 0.f, 0.f};
#pragma unroll
        for (int ai = 0; ai < 2; ++ai)
#pragma unroll
            for (int m = 0; m < 4; ++m) { bf16_t* rowp = base + (size_t)(row0 + ai * HALF + m * 16) * ldc + col0;
#pragma unroll
                for (int bj = 0; bj < 2; ++bj) { f32x4 v0 = acc[ai][bj][m][0] + bv[bj][0], v1 = acc[ai][bj][m][1] + bv[bj][1];
                    if (ACT == 1) { f32x2 a = gelu_pk((f32x2){v0[0], v0[1]}), b = gelu_pk((f32x2){v0[2], v0[3]}), c = gelu_pk((f32x2){v1[0], v1[1]}), d = gelu_pk((f32x2){v1[2], v1[3]});
                        v0 = (f32x4){a.x, a.y, b.x, b.y}; v1 = (f32x4){c.x, c.y, d.x, d.y}; }
                    if (ACT == 2) {
#pragma unroll
                        for (int j = 0; j < 4; ++j) { v0[j] = 0.5f * v0[j] * (1.0f + erff(v0[j] * 0.70710678f)); v1[j] = 0.5f * v1[j] * (1.0f + erff(v1[j] * 0.70710678f)); } }
                    u32x4 w; w.x = cvt_pk_bf16(v0[0], v0[1]); w.y = cvt_pk_bf16(v0[2], v0[3]); w.z = cvt_pk_bf16(v1[0], v1[1]); w.w = cvt_pk_bf16(v1[2], v1[3]);
                    *(u32x4*)(rowp + bj * HALF) = w; } }
    }
};

struct PanelStats {
    unsigned* xbuf;
    unsigned* cnt;
    unsigned* tmo;
    int ntn; float eps;
    unsigned code;
    __device__ __forceinline__ bool run(const f32x4 (&v)[2][2][4][2], const Unit& u, int wr, int wc, int fr, int fq, PG8_LAS unsigned char* lds, int wid, int lane) const {
        typedef float f32x2v __attribute__((ext_vector_type(2)));
        PG8_LAS f32x2v* P = (PG8_LAS f32x2v*)lds;
        PG8_LAS f32x2v* S = (PG8_LAS f32x2v*)(lds + 8192);
        PG8_LAS unsigned* flag = (PG8_LAS unsigned*)(lds + 8192 + 2048);
#pragma unroll
        for (int ai = 0; ai < 2; ++ai)
#pragma unroll
            for (int m = 0; m < 4; ++m) {
                float s = 0.f;
#pragma unroll
                for (int bj = 0; bj < 2; ++bj)
#pragma unroll
                    for (int n = 0; n < 2; ++n) { const f32x4 x = v[ai][bj][m][n]; s += (x[0] + x[1]) + (x[2] + x[3]); }
                s += __shfl_xor(s, 16); s += __shfl_xor(s, 32);
                const float mw = s * (1.0f / 64.0f); float q = 0.f;
#pragma unroll
                for (int bj = 0; bj < 2; ++bj)
#pragma unroll
                    for (int n = 0; n < 2; ++n) { const f32x4 d = v[ai][bj][m][n] - mw; q += (d[0] * d[0] + d[1] * d[1]) + (d[2] * d[2] + d[3] * d[3]); }
                q += __shfl_xor(q, 16); q += __shfl_xor(q, 32);
                if (fq == 0) P[(ai * HALF + wr * 64 + m * 16 + fr) * 4 + wc] = (f32x2v){mw, q};
            }
        asm volatile("s_waitcnt lgkmcnt(0)" ::: "memory"); __builtin_amdgcn_s_barrier(); asm volatile("" ::: "memory");
#if defined(BROKEN_NO_WAIT)
        if (blockIdx.x >= 64) { const long long t0 = clock64(); while (clock64() - t0 < 60000) __builtin_amdgcn_s_sleep(8); }
#endif
        const int row = wid * 32 + (lane & 31);
        if (lane < 32) {
            const f32x2v a = P[row * 4 + 0], b = P[row * 4 + 1], c = P[row * 4 + 2], d = P[row * 4 + 3];
            const float mt = (a.x + b.x + c.x + d.x) * 0.25f;
            const float da = a.x - mt, db = b.x - mt, dc = c.x - mt, dd = d.x - mt;
            const float m2 = (a.y + b.y) + (c.y + d.y) + 64.0f * ((da * da + db * db) + (dc * dc + dd * dd));
            unsigned long long* slot = (unsigned long long*)xbuf + ((size_t)(u.pm * BM + row) * 4 + u.pn);
            __hip_atomic_store(slot, ((unsigned long long)__float_as_uint(m2) << 32) | __float_as_uint(mt), __ATOMIC_RELAXED, __HIP_MEMORY_SCOPE_AGENT);
        }
        asm volatile("s_waitcnt vmcnt(0)" ::: "memory");
        if (lane == 0) __hip_atomic_fetch_add(cnt + 64 * u.pm, 1u, __ATOMIC_RELAXED, __HIP_MEMORY_SCOPE_AGENT);
        if (wid == 0) {
            bool dead = false; const unsigned long long t0 = __builtin_amdgcn_s_memrealtime(); const unsigned want = 8u * (unsigned)ntn;
            for (;;) {
#if defined(BROKEN_NO_WAIT)
                break;
#endif
                if ((unsigned)__builtin_amdgcn_readfirstlane(__hip_atomic_load(cnt + 64 * u.pm, __ATOMIC_RELAXED, __HIP_MEMORY_SCOPE_AGENT)) >= want) break;
                if (__builtin_amdgcn_s_memrealtime() - t0 > 2000000ull) {
                    if (lane == 0) { unsigned expect = 0u; __hip_atomic_compare_exchange_strong(tmo + 1, &expect, code | (unsigned)(u.pm & 0xff), __ATOMIC_RELAXED, __ATOMIC_RELAXED, __HIP_MEMORY_SCOPE_AGENT);
                                     __hip_atomic_store(tmo, 1u, __ATOMIC_RELAXED, __HIP_MEMORY_SCOPE_AGENT); }
                    dead = true; break; }
                __builtin_amdgcn_s_sleep(2);
            }
            __builtin_amdgcn_fence(__ATOMIC_ACQUIRE, "agent");
            if (lane == 0) flag[0] = dead ? 1u : 0u;
        }
        asm volatile("s_waitcnt vmcnt(0) lgkmcnt(0)" ::: "memory"); __builtin_amdgcn_s_barrier(); asm volatile("" ::: "memory");
        const bool bad = flag[0] != 0u;
        if (lane < 32) {
            const unsigned long long* slot = (const unsigned long long*)xbuf + (size_t)(u.pm * BM + row) * 4; float mt[4], m2[4]; float ms = 0.f;
#pragma unroll
            for (int t = 0; t < 4; ++t) { if (t < ntn) { const unsigned long long w = __hip_atomic_load(slot + t, __ATOMIC_RELAXED, __HIP_MEMORY_SCOPE_AGENT); mt[t] = __uint_as_float((unsigned)w); m2[t] = __uint_as_float((unsigned)(w >> 32)); } else { mt[t] = 0.f; m2[t] = 0.f; } ms += mt[t]; }
            const float mean = ms / (float)ntn; float q = 0.f;
#pragma unroll
            for (int t = 0; t < 4; ++t) if (t < ntn) { const float dm = mt[t] - mean; q += m2[t] + 256.0f * dm * dm; }
            S[row] = (f32x2v){mean, 1.0f / sqrtf(q / (256.0f * (float)ntn) + eps)};
        }
        asm volatile("s_waitcnt lgkmcnt(0)" ::: "memory"); __builtin_amdgcn_s_barrier(); asm volatile("" ::: "memory");
        return bad;
    }
};
struct EpiLnRes {
    static constexpr bool PERM = false, AFTER_DRAIN = true;
    const float* base; float* out; int ldc; const float* bias; PanelStats st; unsigned poison;
    __device__ __forceinline__ void refuse(size_t i0, size_t stride, int M, int N) const { const float q = __builtin_nanf(""); for (size_t i = i0; i < (size_t)M * N; i += stride) out[(i / N) * ldc + i % N] = q;
        if (i0 == 0) { unsigned expect = 0u; __hip_atomic_compare_exchange_strong(st.tmo + 1, &expect, 0x7f0u, __ATOMIC_RELAXED, __ATOMIC_RELAXED, __HIP_MEMORY_SCOPE_AGENT); __hip_atomic_store(st.tmo, 1u, __ATOMIC_RELAXED, __HIP_MEMORY_SCOPE_AGENT); } }
    __device__ __forceinline__ void fused(f32x4 (&acc)[2][2][4][2], const Unit& u, int wr, int wc, int fr, int fq, PG8_LAS unsigned char* lds, int wid, int lane) const {
        typedef float f32x2v __attribute__((ext_vector_type(2)));
        const PG8_LAS f32x2v* S = (const PG8_LAS f32x2v*)(lds + 8192);
        const int col0 = u.pn * BM + wc * 32 + 4 * fq;
#pragma unroll
        for (int bj = 0; bj < 2; ++bj)
#pragma unroll
            for (int n = 0; n < 2; ++n) { const f32x4 bv = bias ? *(const f32x4*)(bias + col0 + bj * HALF + n * 16) : (f32x4){0.f, 0.f, 0.f, 0.f};
#pragma unroll
                for (int ai = 0; ai < 2; ++ai)
#pragma unroll
                    for (int m = 0; m < 4; ++m) acc[ai][bj][m][n] += bv; }
        const bool bad = st.run(acc, u, wr, wc, fr, fq, lds, wid, lane) || poison != 0u;
        const float qnan = __builtin_nanf("");
#pragma unroll
        for (int ai = 0; ai < 2; ++ai)
#pragma unroll
            for (int m = 0; m < 4; ++m) { const int r = ai * HALF + wr * 64 + m * 16 + fr; const f32x2v sr = S[r]; const size_t off = (size_t)(u.pm * BM + r) * ldc + col0;
#pragma unroll
                for (int bj = 0; bj < 2; ++bj)
#pragma unroll
                    for (int n = 0; n < 2; ++n) { const f32x4 bs = *(const f32x4*)(base + off + bj * HALF + n * 16); f32x4 o = bs + (acc[ai][bj][m][n] - sr.x) * sr.y;
                        if (bad) o = (f32x4){qnan, qnan, qnan, qnan}; *(f32x4*)(out + off + bj * HALF + n * 16) = o; }
                asm volatile("" ::: "memory"); }
    }
};
struct EpiLnResLn {
    static constexpr bool PERM = false, AFTER_DRAIN = true;
    const float* base; float* out; bf16_t* xn; int ldc; const float* bias; PanelStats st1, st2; unsigned poison;
    __device__ __forceinline__ void refuse(size_t i0, size_t stride, int M, int N) const { const float q = __builtin_nanf(""); for (size_t i = i0; i < (size_t)M * N; i += stride) { const size_t o = (i / N) * ldc + i % N; out[o] = q; xn[o] = (bf16_t)0x7fc0u; }
        if (i0 == 0) { unsigned expect = 0u; __hip_atomic_compare_exchange_strong(st1.tmo + 1, &expect, 0x7f0u, __ATOMIC_RELAXED, __ATOMIC_RELAXED, __HIP_MEMORY_SCOPE_AGENT); __hip_atomic_store(st1.tmo, 1u, __ATOMIC_RELAXED, __HIP_MEMORY_SCOPE_AGENT); } }
    __device__ __forceinline__ void fused(f32x4 (&acc)[2][2][4][2], const Unit& u, int wr, int wc, int fr, int fq, PG8_LAS unsigned char* lds, int wid, int lane) const {
        typedef float f32x2v __attribute__((ext_vector_type(2))); typedef unsigned u32x2v __attribute__((ext_vector_type(2)));
        const PG8_LAS f32x2v* S = (const PG8_LAS f32x2v*)(lds + 8192);
        const int col0 = u.pn * BM + wc * 32 + 4 * fq;
#pragma unroll
        for (int bj = 0; bj < 2; ++bj)
#pragma unroll
            for (int n = 0; n < 2; ++n) { const f32x4 bv = bias ? *(const f32x4*)(bias + col0 + bj * HALF + n * 16) : (f32x4){0.f, 0.f, 0.f, 0.f};
#pragma unroll
                for (int ai = 0; ai < 2; ++ai)
#pragma unroll
                    for (int m = 0; m < 4; ++m) acc[ai][bj][m][n] += bv; }
        bool bad = st1.run(acc, u, wr, wc, fr, fq, lds, wid, lane) || poison != 0u;
        const float qnan = __builtin_nanf("");
#pragma unroll
        for (int ai = 0; ai < 2; ++ai)
#pragma unroll
            for (int m = 0; m < 4; ++m) { const int r = ai * HALF + wr * 64 + m * 16 + fr; const f32x2v sr = S[r]; const size_t off = (size_t)(u.pm * BM + r) * ldc + col0;
#pragma unroll
                for (int bj = 0; bj < 2; ++bj)
#pragma unroll
                    for (int n = 0; n < 2; ++n) { const f32x4 bs = *(const f32x4*)(base + off + bj * HALF + n * 16); acc[ai][bj][m][n] = bs + (acc[ai][bj][m][n] - sr.x) * sr.y; }
                asm volatile("" : "+v"(acc[ai][0][m][0]), "+v"(acc[ai][0][m][1]), "+v"(acc[ai][1][m][0]), "+v"(acc[ai][1][m][1]));
                if (m & 1) asm volatile("" ::: "memory"); }
        const bool bad1 = bad;
        bad = st2.run(acc, u, wr, wc, fr, fq, lds, wid, lane) || bad;
#pragma unroll
        for (int ai = 0; ai < 2; ++ai)
#pragma unroll
            for (int m = 0; m < 4; ++m) { const int r = ai * HALF + wr * 64 + m * 16 + fr; const f32x2v sr = S[r]; const size_t off = (size_t)(u.pm * BM + r) * ldc + col0;
#pragma unroll
                for (int bj = 0; bj < 2; ++bj)
#pragma unroll
                    for (int n = 0; n < 2; ++n) { const f32x4 x1 = acc[ai][bj][m][n]; *(f32x4*)(out + off + bj * HALF + n * 16) = bad1 ? (f32x4){qnan, qnan, qnan, qnan} : x1;
                        const f32x4 o = (x1 - sr.x) * sr.y; u32x2v w; w.x = cvt_pk_bf16(o[0], o[1]); w.y = cvt_pk_bf16(o[2], o[3]);
                        if (bad) { w.x = 0x7fc07fc0u; w.y = 0x7fc07fc0u; } *(u32x2v*)(xn + off + bj * HALF + n * 16) = w; }
                asm volatile("" ::: "memory"); }
    }
};

template <class Epi, class Sched, bool STAMP = false>
__device__ __forceinline__ void gemm_phase(PG8_LAS unsigned char* lds, const Gemm g, const Sched& S, const Epi& E, unsigned long long* stamps) {
    const int tid = threadIdx.x, wid = __builtin_amdgcn_readfirstlane(tid >> 6), lane = tid & 63, wr = wid >> 2, wc = wid & 3, fr = lane & 15, fq = lane >> 4;
    const int K = g.K, nt = K / BK;
    int ts_lo = 0, ts_hi = 0, nts = 0; const unsigned long long rt_entry = STAMP ? (unsigned long long)wall_clock64() : 0ull;
#define PG8_STAMP() do { if (STAMP && wid == 0 && nts < 64) { const unsigned long long _c = (unsigned long long)clock64(); \
        ts_lo = (lane == nts) ? (int)(unsigned)_c : ts_lo; ts_hi = (lane == nts) ? (int)(unsigned)(_c >> 32) : ts_hi; ++nts; } } while (0)
    PG8_STAMP();
    unsigned voffA[2], voffB[2];
#pragma unroll
    for (int i = 0; i < 2; ++i) { int R, C; stage_rc(tid * 16 + i * 8192, R, C); const int Rb = Epi::PERM ? ((R & ~31) + perm32(R & 31)) : R;
        voffA[i] = (unsigned)(R * K + C) * 2u; voffB[i] = (unsigned)(Rb * K + C) * 2u; }
    const size_t kstep = (size_t)(BK * 2);
    const size_t hstep = (size_t)HALF * K * 2;
    const size_t tstep = 2 * hstep;
    const unsigned ldsw = (unsigned)wid * 1024u;
    const int aoff = lds_byte(wr * 64 + fr, fq * 8), boff = lds_byte(wc * 32 + fr, fq * 8);
#define PG8_SA(b, h) (((b) * 2 + (h)) * HTB)
#define PG8_SB(b, h) ((4 + (b) * 2 + (h)) * HTB)
#define PG8_STAGE(bufoff, gbase, voff) do { _Pragma("unroll") for (int _i = 0; _i < 2; ++_i) \
        __builtin_amdgcn_global_load_lds((const unsigned*)((const char*)(gbase) + (voff)[_i]), (PG8_LAS unsigned*)(lds + (bufoff) + ldsw + _i * 8192), 16, 0, 0); } while (0)
#define PG8_LDA(dst, b, h) do { _Pragma("unroll") for (int m = 0; m < 4; ++m) _Pragma("unroll") for (int k = 0; k < 2; ++k) dst[m][k] = *(const PG8_LAS bf16x8*)(lds + PG8_SA(b, h) + aoff + m * 2048 + k * 1024); } while (0)
#define PG8_LDB(dst, b, h) do { _Pragma("unroll") for (int n = 0; n < 2; ++n) _Pragma("unroll") for (int k = 0; k < 2; ++k) dst[n][k] = *(const PG8_LAS bf16x8*)(lds + PG8_SB(b, h) + boff + n * 2048 + k * 1024); } while (0)
#define PG8_MMA(ai, bj, At, Bt) do { __builtin_amdgcn_s_setprio(1); _Pragma("unroll") for (int m = 0; m < 4; ++m) _Pragma("unroll") for (int n = 0; n < 2; ++n) _Pragma("unroll") for (int k = 0; k < 2; ++k) \
        acc[ai][bj][m][n] = __builtin_amdgcn_mfma_f32_16x16x32_bf16(Bt[n][k], At[m][k], acc[ai][bj][m][n], 0, 0, 0); __builtin_amdgcn_s_setprio(0); } while (0)
#define PG8_WAIT_V(n) asm volatile("s_waitcnt vmcnt(" #n ")" ::: "memory")
#define PG8_WAIT_L(n) asm volatile("s_waitcnt lgkmcnt(" #n ")" ::: "memory")
#define PG8_BAR __builtin_amdgcn_s_barrier()
#define PG8_SCHED __builtin_amdgcn_sched_barrier(0)
    Unit cur, nxt; int ui = 0;
    if (!S.next(0, cur)) return;
    f32x4 acc[2][2][4][2];
#pragma unroll
    for (int a = 0; a < 2; ++a)
#pragma unroll
        for (int b = 0; b < 2; ++b)
#pragma unroll
            for (int m = 0; m < 4; ++m)
#pragma unroll
                for (int n = 0; n < 2; ++n) acc[a][b][m][n] = (f32x4){0.f, 0.f, 0.f, 0.f};
    bf16x8 At[4][2], B0[2][2], B1[2][2];
    const char* cA = (const char*)g.A + (size_t)cur.pm * tstep; const char* cB = (const char*)g.Bt + (size_t)cur.pn * tstep;
    S.a_ready(cur);
    PG8_STAGE(PG8_SB(0, 0), cB, voffB); PG8_STAGE(PG8_SA(0, 0), cA, voffA); PG8_STAGE(PG8_SB(0, 1), cB + hstep, voffB); PG8_STAGE(PG8_SA(0, 1), cA + hstep, voffA);
    if (wr == 1) PG8_BAR;
    PG8_WAIT_V(4); PG8_BAR;
    PG8_STAGE(PG8_SB(1, 0), cB + kstep, voffB); PG8_STAGE(PG8_SA(1, 0), cA + kstep, voffA); PG8_STAGE(PG8_SB(1, 1), cB + hstep + kstep, voffB);
    PG8_WAIT_V(6); PG8_BAR;
    PG8_STAMP();
    for (;;) {
        const bool has_next = S.next(ui + 1, nxt);
        const char* nA = has_next ? (const char*)g.A + (size_t)nxt.pm * tstep : cA; const char* nB = has_next ? (const char*)g.Bt + (size_t)nxt.pn * tstep : cB;
        for (int t = 0; t < nt; t += 2) {
            const bool last = (t == nt - 2);
            const char* a1 = cA + (size_t)(t + 1) * kstep;
            const char* a2 = last ? nA : cA + (size_t)(t + 2) * kstep; const char* b2 = last ? nB : cB + (size_t)(t + 2) * kstep;
            const char* a3 = a2 + kstep; const char* b3 = b2 + kstep;
            if (last && has_next) S.a_ready(nxt);
            PG8_LDB(B0, 0, 0); PG8_SCHED; PG8_LDA(At, 0, 0); PG8_STAGE(PG8_SA(1, 1), a1 + hstep, voffA);
            PG8_WAIT_L(8); PG8_BAR; PG8_WAIT_L(0); PG8_MMA(0, 0, At, B0); PG8_BAR; PG8_SCHED;
            PG8_LDB(B1, 0, 1); PG8_STAGE(PG8_SB(0, 0), b2, voffB);
            PG8_BAR; PG8_WAIT_L(0); PG8_MMA(0, 1, At, B1); PG8_BAR;
            PG8_LDA(At, 0, 1); PG8_STAGE(PG8_SA(0, 0), a2, voffA);
            PG8_BAR; PG8_WAIT_L(0); PG8_MMA(1, 0, At, B0); PG8_BAR; PG8_SCHED;
            PG8_STAGE(PG8_SB(0, 1), b2 + hstep, voffB);
            PG8_WAIT_V(6); PG8_BAR; PG8_MMA(1, 1, At, B1); PG8_BAR;
            PG8_LDB(B0, 1, 0); PG8_SCHED; PG8_LDA(At, 1, 0); PG8_STAGE(PG8_SA(0, 1), a2 + hstep, voffA);
            PG8_WAIT_L(8); PG8_BAR; PG8_WAIT_L(0); PG8_MMA(0, 0, At, B0); PG8_BAR; PG8_SCHED;
            PG8_LDB(B1, 1, 1); PG8_STAGE(PG8_SB(1, 0), b3, voffB);
            PG8_BAR; PG8_WAIT_L(0); PG8_MMA(0, 1, At, B1); PG8_BAR;
            PG8_LDA(At, 1, 1); PG8_STAGE(PG8_SA(1, 0), a3, voffA);
            PG8_BAR; PG8_WAIT_L(0); PG8_MMA(1, 0, At, B0); PG8_BAR; PG8_SCHED;
            PG8_STAGE(PG8_SB(1, 1), b3 + hstep, voffB);
            PG8_WAIT_V(6); PG8_BAR; PG8_MMA(1, 1, At, B1); PG8_BAR;
        }
        PG8_STAMP();
        if constexpr (!Epi::AFTER_DRAIN) { E(acc, cur, wr, wc, fr, fq); S.done(cur); }
        PG8_STAMP();
        if (!has_next) break;
#pragma unroll
        for (int a = 0; a < 2; ++a)
#pragma unroll
            for (int b = 0; b < 2; ++b)
#pragma unroll
                for (int m = 0; m < 4; ++m)
#pragma unroll
                    for (int n = 0; n < 2; ++n) acc[a][b][m][n] = (f32x4){0.f, 0.f, 0.f, 0.f};
        cur = nxt; cA = nA; cB = nB; ++ui;
    }
    PG8_WAIT_V(0);
    if (wr == 0) PG8_BAR;
    PG8_BAR;
    if constexpr (Epi::AFTER_DRAIN) { E.fused(acc, cur, wr, wc, fr, fq, lds, wid, lane); S.done(cur); }
    PG8_STAMP();
    if (STAMP && wid == 0) { stamps[lane] = lane < nts ? (((unsigned long long)(unsigned)ts_hi << 32) | (unsigned)ts_lo) : 0ull;
        if (lane == 62) stamps[62] = rt_entry; if (lane == 63) stamps[63] = (unsigned long long)wall_clock64(); }
#undef PG8_STAMP
#undef PG8_SA
#undef PG8_SB
#undef PG8_STAGE
#undef PG8_LDA
#undef PG8_LDB
#undef PG8_MMA
#undef PG8_WAIT_V
#undef PG8_WAIT_L
#undef PG8_BAR
#undef PG8_SCHED
}
}

constexpr int D = 1024, NB = 16, S = 2048, T = NB * S;
constexpr int NCOL = 2840, NPAD = 3072;
constexpr int C_Q = 0, C_KC = 512, C_VC = 640, C_KS = 768, C_VS = 896, C_KW = 1024, C_VW = 1152, C_GT = 1280, C_CB = 1304, C_CC = 1816, C_CH = 2328;
constexpr int NCMP = 127;
constexpr int NEXP = 16384;
constexpr float EPS = 1e-6f;
constexpr int NTHREADS = 512, NWAVES = 8;

constexpr size_t al256(size_t x) { return (x + 255) & ~(size_t)255; }
constexpr size_t WS_CTL   = 0;                                   constexpr size_t CTL_BYTES = 65536;
constexpr size_t WS_MOD   = WS_CTL + CTL_BYTES;
constexpr size_t WS_WIN   = al256(WS_MOD + (size_t)16 * 6144 * 4);
constexpr size_t WS_WOUT  = al256(WS_WIN + (size_t)NPAD * D * 2);
constexpr size_t WS_WQ    = al256(WS_WOUT + (size_t)D * D * 2);
constexpr size_t WS_KEYS  = al256(WS_WQ + (size_t)D * D * 2);
constexpr size_t WS_UB    = al256(WS_KEYS + (size_t)16 * 128 * 64 * 2);
constexpr size_t WS_VB    = al256(WS_UB + (size_t)NEXP * D * 2);
constexpr size_t WS_KC    = al256(WS_VB + (size_t)NEXP * D * 2);
constexpr size_t WS_VC    = al256(WS_KC + (size_t)16 * 2 * 128 * 64 * 2);
constexpr size_t WS_H     = al256(WS_VC + (size_t)16 * 2 * 128 * 64 * 2);
constexpr size_t WS_OATT  = al256(WS_H + (size_t)T * D * 2);
constexpr size_t WS_PROJ  = al256(WS_OATT + (size_t)T * 512 * 2);
constexpr size_t WS_QP    = WS_PROJ;
constexpr size_t WS_EIDX  = al256(WS_QP + (size_t)T * D * 2);
constexpr size_t WS_EW    = al256(WS_EIDX + (size_t)T * 128 * 4);
constexpr size_t WS_END   = al256(WS_PROJ + (size_t)T * NPAD * 2);
static_assert(WS_EW + (size_t)T * 128 * 4 <= WS_END, "alias region");

constexpr int LDS_STAGE = 131072;
constexpr int LDS_MISC_OFF = LDS_STAGE;
constexpr int LDS_BYTES = LDS_STAGE + 256;

typedef unsigned short bf16_t;
__device__ __forceinline__ float bf2f(bf16_t b) { return __uint_as_float(((unsigned)b) << 16); }
__device__ __forceinline__ bf16_t f2bf(float f) { unsigned u = __float_as_uint(f); u += 0x7FFFu + ((u >> 16) & 1u); return (bf16_t)(u >> 16); }
__device__ __forceinline__ float bflo(unsigned w) { return __uint_as_float(w << 16); }
__device__ __forceinline__ float bfhi(unsigned w) { return __uint_as_float(w & 0xFFFF0000u); }
__device__ __forceinline__ unsigned pack2(float lo, float hi) { return (unsigned)f2bf(lo) | ((unsigned)f2bf(hi) << 16); }
__device__ __forceinline__ float gelu_tanh(float x) { const float u = 0.7978845608028654f * (x + 0.044715f * x * x * x); return 0.5f * x * (1.0f + tanhf(u)); }
__device__ __forceinline__ float sigmoidf_(float x) { return 1.0f / (1.0f + __expf(-x)); }
__device__ __forceinline__ float wave_sum(float v) {
#pragma unroll
    for (int o = 32; o >= 1; o >>= 1) v += __shfl_xor(v, o);
    return v; }
__device__ __forceinline__ float wave_max(float v) {
#pragma unroll
    for (int o = 32; o >= 1; o >>= 1) v = fmaxf(v, __shfl_xor(v, o));
    return v; }
__device__ __forceinline__ void lds_wave_sync() { asm volatile("s_waitcnt lgkmcnt(0)" ::: "memory"); }
__device__ __forceinline__ int rel_bucket(int dist) {
    const int n = dist > 0 ? dist : 0;
    if (n < 16) return n;
    const float lr = logf((float)n / 16.0f) / 2.0794415416798357f;
    const int large = 16 + (int)(lr * 16.0f);
    return large < 31 ? large : 31;
}

struct Frame {
    const float* in[23]; float* out; unsigned char* ws;
    LAS unsigned char* lds; int tid, lane, wave, G;
};

__device__ __forceinline__ void transpose_tile(const Frame& F, const float* src, int srcK, int srcN, bf16_t* dst, int dstK, int kt, int nt) {
    LAS float* tile = (LAS float*)F.lds;
    const int k0 = kt * 64, n0 = nt * 64;
    for (int i = F.tid; i < 4096; i += NTHREADS) { const int r = i >> 6, c = i & 63; const int k = k0 + r, n = n0 + c;
        tile[r * 65 + c] = (k < srcK && n < srcN) ? src[(size_t)k * srcN + n] : 0.0f; }
    __syncthreads();
    for (int i = F.tid; i < 4096; i += NTHREADS) { const int r = i >> 6, c = i & 63;
        dst[(size_t)(n0 + r) * dstK + k0 + c] = f2bf(tile[c * 65 + r]); }
    __syncthreads();
}
__device__ __forceinline__ void p0_prologue(const Frame& F) {
    const float* c = F.in[1]; const float* w_mod = F.in[4]; const float* b_mod = F.in[5];
    float* MOD = (float*)(F.ws + WS_MOD);
    constexpr int I_MOD = 192, I_WIN = 16 * 48, I_WOUT = 256, I_WQ = 256, I_U = 256, I_V = 256, I_KEYS = 2;
    constexpr int O_WIN = I_MOD, O_WOUT = O_WIN + I_WIN, O_WQ = O_WOUT + I_WOUT, O_U = O_WQ + I_WQ, O_V = O_U + I_U, O_KEYS = O_V + I_V, N_ITEMS = O_KEYS + I_KEYS;
    for (int it = blockIdx.x; it < N_ITEMS; it += F.G) {
        if (it < O_WIN) {
            const int idx = it * NTHREADS + F.tid; const int b = idx / 6144, j = idx % 6144;
            float acc = 0.f;
            for (int k = 0; k < D; ++k) { const float cv = c[b * D + k]; const float sv = cv / (1.0f + __expf(-cv)); acc += sv * w_mod[(size_t)k * 6144 + j]; }
            MOD[b * 6144 + j] = acc + b_mod[j];
        } else if (it < O_WOUT) { const int i = it - O_WIN; transpose_tile(F, F.in[6], D, NCOL, (bf16_t*)(F.ws + WS_WIN), D, i % 16, i / 16); }
        else if (it < O_WQ) { const int i = it - O_WOUT; transpose_tile(F, F.in[16], D, D, (bf16_t*)(F.ws + WS_WOUT), D, i % 16, i / 16); }
        else if (it < O_U) { const int i = it - O_WQ; transpose_tile(F, F.in[17], D, D, (bf16_t*)(F.ws + WS_WQ), D, i % 16, i / 16); }
        else if (it < O_KEYS) {
            const bool isv = it >= O_V; const int i = isv ? it - O_V : it - O_U;
            const float4* src = (const float4*)(isv ? F.in[20] : F.in[19]) + (size_t)i * 16384;
            uint2* dst = (uint2*)(F.ws + (isv ? WS_VB : WS_UB)) + (size_t)i * 16384;
            for (int q = F.tid; q < 16384; q += NTHREADS) { const float4 v = src[q]; dst[q] = make_uint2(pack2(v.x, v.y), pack2(v.z, v.w)); }
        } else {
            const int i = it - O_KEYS; const float4* src = (const float4*)F.in[18] + (size_t)i * 16384; uint2* dst = (uint2*)(F.ws + WS_KEYS) + (size_t)i * 16384;
            for (int q = F.tid; q < 16384; q += NTHREADS) { const float4 v = src[q]; dst[q] = make_uint2(pack2(v.x, v.y), pack2(v.z, v.w)); }
        }
    }
}

__device__ __forceinline__ void norm_mod_rows(const Frame& F, const float* x, const float* g, int sh_off, int sc_off, bf16_t* dst) {
    const float* MOD = (const float*)(F.ws + WS_MOD);
    const int gw = blockIdx.x * NWAVES + F.wave, nw = F.G * NWAVES;
    for (int t = gw; t < T; t += nw) {
        const int b = t / S; const float4* xr = (const float4*)(x + (size_t)t * D);
        float4 v[4]; float ss = 0.f;
#pragma unroll
        for (int i = 0; i < 4; ++i) { v[i] = xr[F.lane + 64 * i]; ss += v[i].x * v[i].x + v[i].y * v[i].y + v[i].z * v[i].z + v[i].w * v[i].w; }
        ss = wave_sum(ss); const float rstd = rsqrtf(ss * (1.0f / D) + EPS);
#pragma unroll
        for (int i = 0; i < 4; ++i) { const int col = (F.lane + 64 * i) * 4;
            const float4 gg = *(const float4*)(g + col), sc = *(const float4*)(MOD + b * 6144 + sc_off + col), sh = *(const float4*)(MOD + b * 6144 + sh_off + col);
            const float o0 = v[i].x * rstd * gg.x * (1.f + sc.x) + sh.x, o1 = v[i].y * rstd * gg.y * (1.f + sc.y) + sh.y, o2 = v[i].z * rstd * gg.z * (1.f + sc.z) + sh.z, o3 = v[i].w * rstd * gg.w * (1.f + sc.w) + sh.w;
            *(uint2*)(dst + (size_t)t * D + col) = make_uint2(pack2(o0, o1), pack2(o2, o3)); }
    }
}

__device__ __forceinline__ void p3_compress_naive(const Frame& F) {
    const bf16_t* PROJ = (const bf16_t*)(F.ws + WS_PROJ);
    LAS float* hid = (LAS float*)F.lds + F.wave * 64;
    const int gw = blockIdx.x * NWAVES + F.wave, nw = F.G * NWAVES;
    for (int u = gw; u < NB * NCMP * 2 * 2; u += nw) {
        const int kv = u & 1, g = (u >> 1) & 1, n = (u >> 2) % NCMP, b = (u >> 2) / NCMP;
        const float* pe = kv ? F.in[8] : F.in[7]; const float* w1 = kv ? F.in[11] : F.in[9]; const float* w2 = kv ? F.in[12] : F.in[10];
        const int cbase = (kv ? C_VC : C_KC) + g * 64;
        float acc = 0.f;
        for (int l = 0; l < 32; ++l) {
            const bf16_t* row = PROJ + (size_t)(b * S + 16 * n + l) * NPAD + cbase;
            for (int d = 0; d < 64; ++d) { const float a = bf2f(row[d]) + pe[l * 64 + d]; acc += a * w1[(size_t)(l * 64 + d) * 64 + F.lane]; }
        }
        hid[F.lane] = gelu_tanh(acc); lds_wave_sync();
        float o = 0.f;
        for (int j = 0; j < 64; ++j) o += hid[j] * w2[j * 64 + F.lane];
        bf16_t* dst = (bf16_t*)(F.ws + (kv ? WS_VC : WS_KC)); dst[((size_t)(b * 2 + g) * 128 + n) * 64 + F.lane] = f2bf(o);
        lds_wave_sync();
    }
}

__device__ __forceinline__ void dot4_row(const bf16_t* krow, const LAS float* qs, float (&acc)[4]) {
    const uint4* kr = (const uint4*)krow;
#pragma unroll 1
    for (int c = 0; c < 8; ++c) { asm volatile("" ::: "memory"); const uint4 w = kr[c]; const unsigned ww[4] = {w.x, w.y, w.z, w.w};
#pragma unroll
        for (int e = 0; e < 4; ++e) { const float k0 = bflo(ww[e]), k1 = bfhi(ww[e]); const int d = c * 8 + e * 2;
#pragma unroll
            for (int r = 0; r < 4; ++r) acc[r] += qs[r * 64 + d] * k0 + qs[r * 64 + d + 1] * k1; } }
}
__device__ __forceinline__ void p4_attn_naive(const Frame& F) {
    const bf16_t* PROJ = (const bf16_t*)(F.ws + WS_PROJ); const bf16_t* KC = (const bf16_t*)(F.ws + WS_KC); const bf16_t* VC = (const bf16_t*)(F.ws + WS_VC);
    bf16_t* OATT = (bf16_t*)(F.ws + WS_OATT); const float* rel = F.in[21];
    LAS float* wl = (LAS float*)F.lds + F.wave * (256 + 512 + 2048 + 16);
    LAS float* qs = wl; LAS float* pc = wl + 256; LAS float* ps = wl + 768; LAS int* pbase = (LAS int*)(wl + 768 + 2048);
    const int gw = blockIdx.x * NWAVES + F.wave, nw = F.G * NWAVES, lane = F.lane;
    for (int u = gw; u < T * 2; u += nw) {
        const int g = u & 1, tok = u >> 1, b = tok / S, t = tok % S;
        const bf16_t* prow = PROJ + (size_t)tok * NPAD;
#pragma unroll
        for (int r = 0; r < 4; ++r) qs[r * 64 + lane] = bf2f(prow[C_Q + (g * 4 + r) * 64 + lane]) * 0.125f;
        lds_wave_sync();
        const int nv = t >= 31 ? ((t - 31) >> 4) + 1 : 0;
        float sc[2][4]; bool va[2];
#pragma unroll
        for (int i = 0; i < 2; ++i) { const int n = lane + 64 * i; va[i] = n < nv; float a[4] = {0.f, 0.f, 0.f, 0.f};
            if (va[i]) { dot4_row(KC + ((size_t)(b * 2 + g) * 128 + n) * 64, qs, a); const int bk = rel_bucket(t - (16 * n + 31));
#pragma unroll
                for (int r = 0; r < 4; ++r) a[r] += rel[bk * 8 + g * 4 + r]; }
#pragma unroll
            for (int r = 0; r < 4; ++r) sc[i][r] = va[i] ? a[r] : -1e30f; }
        float ocmp[4];
#pragma unroll
        for (int r = 0; r < 4; ++r) { const float m = wave_max(fmaxf(sc[0][r], sc[1][r]));
            const float e0 = va[0] ? __expf(sc[0][r] - m) : 0.f, e1 = va[1] ? __expf(sc[1][r] - m) : 0.f; const float sum = wave_sum(e0 + e1);
            const float inv = nv > 0 ? 1.0f / sum : 0.f; pc[r * 128 + lane] = e0 * inv; pc[r * 128 + 64 + lane] = e1 * inv; }
        lds_wave_sync();
        { float o[4] = {0.f, 0.f, 0.f, 0.f}; const bf16_t* vb = VC + ((size_t)(b * 2 + g) * 128) * 64 + lane;
            for (int n = 0; n < nv; ++n) { const float v = bf2f(vb[n * 64]);
#pragma unroll
                for (int r = 0; r < 4; ++r) o[r] += pc[r * 128 + n] * v; }
#pragma unroll
            for (int r = 0; r < 4; ++r) ocmp[r] = o[r]; }
        const int cur = t >> 6; float val;
        { const int j = lane & 31; float imp = 0.f;
#pragma unroll
            for (int r = 0; r < 4; ++r) for (int n = 4 * j - 1; n <= 4 * j + 3; ++n) if (n >= 0 && n < NCMP) imp += pc[r * 128 + n];
            const bool forced = (j == 0) || (j == cur) || (j == cur - 1); const bool allowed = j <= cur;
            val = forced ? 1e4f : (allowed ? imp : -INFINITY); }
        int rank = 0;
        for (int jp = 0; jp < 32; ++jp) { const float vp = __shfl(val, jp); rank += ((vp > val) || (vp == val && jp < (lane & 31))) ? 1 : 0; }
        unsigned selmask = (unsigned)(__ballot(lane < 32 && rank < 8) & 0xFFFFFFFFull);
        float oslc[4], owin[4];
#pragma unroll
        for (int br = 0; br < 2; ++br) {
            const int ck = br == 0 ? C_KS : C_KW, cv = br == 0 ? C_VS : C_VW;
            unsigned mk = selmask;
#pragma unroll 1
            for (int c = 0; c < 8; ++c) {
                int kpos, bs;
                if (br == 0) { const int j = __builtin_ctz(mk | 0x80000000u); mk &= mk - 1; bs = 64 * j; } else { bs = t - 511 + 64 * c; }
                kpos = bs + lane; if (lane == 0) pbase[c] = bs;
                const int dist = t - kpos; const bool vv = (dist >= 0) && (kpos >= 0) && (kpos < S);
                float a[4] = {0.f, 0.f, 0.f, 0.f};
                if (vv) { dot4_row(PROJ + (size_t)(b * S + kpos) * NPAD + ck + g * 64, qs, a); const int bk = rel_bucket(dist);
#pragma unroll
                    for (int r = 0; r < 4; ++r) a[r] += rel[bk * 8 + g * 4 + r]; }
#pragma unroll
                for (int r = 0; r < 4; ++r) ps[r * 512 + c * 64 + lane] = vv ? a[r] : -1e30f;
            }
            lds_wave_sync();
#pragma unroll 1
            for (int r = 0; r < 4; ++r) { float m = -1e30f;
#pragma unroll
                for (int c = 0; c < 8; ++c) m = fmaxf(m, ps[r * 512 + c * 64 + lane]);
                m = wave_max(m); float e[8], sum = 0.f;
#pragma unroll
                for (int c = 0; c < 8; ++c) { const float sv = ps[r * 512 + c * 64 + lane]; e[c] = sv > -1e29f ? __expf(sv - m) : 0.f; sum += e[c]; }
                sum = wave_sum(sum); const float inv = sum > 0.f ? 1.0f / sum : 0.f;
#pragma unroll
                for (int c = 0; c < 8; ++c) ps[r * 512 + c * 64 + lane] = e[c] * inv; }
            lds_wave_sync();
            float o[4] = {0.f, 0.f, 0.f, 0.f};
#pragma unroll 1
            for (int c = 0; c < 8; ++c) {
                const int bsc = pbase[c];
                for (int kk = 0; kk < 64; ++kk) { const int kpos = bsc + kk; if (kpos < 0 || kpos > t) continue;
                    const float v = bf2f(PROJ[(size_t)(b * S + kpos) * NPAD + cv + g * 64 + lane]);
#pragma unroll
                    for (int r = 0; r < 4; ++r) o[r] += ps[r * 512 + c * 64 + kk] * v; } }
            lds_wave_sync();
#pragma unroll
            for (int r = 0; r < 4; ++r) { if (br == 0) oslc[r] = o[r]; else owin[r] = o[r]; }
        }
#pragma unroll
        for (int r = 0; r < 4; ++r) { const int h = g * 4 + r;
            const float g0 = sigmoidf_(bf2f(prow[C_GT + h * 3 + 0])), g1 = sigmoidf_(bf2f(prow[C_GT + h * 3 + 1])), g2 = sigmoidf_(bf2f(prow[C_GT + h * 3 + 2]));
            OATT[(size_t)tok * 512 + h * 64 + lane] = f2bf(g0 * ocmp[r] + g1 * oslc[r] + g2 * owin[r]); }
    }
}

__device__ __forceinline__ void p5_mixed(const Frame& F) {
    const bf16_t* PROJ = (const bf16_t*)(F.ws + WS_PROJ); const bf16_t* OATT = (const bf16_t*)(F.ws + WS_OATT); bf16_t* MIX = (bf16_t*)(F.ws + WS_H);
    const float* cw = F.in[13]; const float* ga = F.in[14]; const float* gc = F.in[15];
    const int gw = blockIdx.x * NWAVES + F.wave, nw = F.G * NWAVES, lane = F.lane;
    for (int tok = gw; tok < T; tok += nw) {
        const int s = tok % S; const int c0 = lane * 8;
        float a[8], y[8];
        { const uint4 w = *(const uint4*)(OATT + (size_t)tok * 512 + c0); const unsigned ww[4] = {w.x, w.y, w.z, w.w};
#pragma unroll
            for (int e = 0; e < 4; ++e) { a[2 * e] = bflo(ww[e]); a[2 * e + 1] = bfhi(ww[e]); } }
#pragma unroll
        for (int e = 0; e < 8; ++e) y[e] = 0.f;
#pragma unroll
        for (int dt = 0; dt < 3; ++dt) { if (s - 2 + dt >= 0) { const bf16_t* row = PROJ + (size_t)(tok - 2 + dt) * NPAD;
                const uint4 wc = *(const uint4*)(row + C_CC + c0), wh = *(const uint4*)(row + C_CH + c0); const unsigned c4[4] = {wc.x, wc.y, wc.z, wc.w}, h4[4] = {wh.x, wh.y, wh.z, wh.w};
#pragma unroll
                for (int e = 0; e < 4; ++e) { y[2 * e] += cw[dt * 512 + c0 + 2 * e] * (bflo(c4[e]) * bflo(h4[e])); y[2 * e + 1] += cw[dt * 512 + c0 + 2 * e + 1] * (bfhi(c4[e]) * bfhi(h4[e])); } } }
        { const uint4 wb = *(const uint4*)(PROJ + (size_t)tok * NPAD + C_CB + c0); const unsigned b4[4] = {wb.x, wb.y, wb.z, wb.w};
#pragma unroll
            for (int e = 0; e < 4; ++e) { y[2 * e] *= bflo(b4[e]); y[2 * e + 1] *= bfhi(b4[e]); } }
        float sa = 0.f, sy = 0.f;
#pragma unroll
        for (int e = 0; e < 8; ++e) { sa += a[e] * a[e]; sy += y[e] * y[e]; }
        sa = wave_sum(sa); sy = wave_sum(sy);
        const float ra = rsqrtf(sa * (1.0f / 512) + EPS), ry = rsqrtf(sy * (1.0f / 512) + EPS);
        unsigned oa[4], oy[4];
#pragma unroll
        for (int e = 0; e < 4; ++e) { oa[e] = pack2(a[2 * e] * ra * ga[c0 + 2 * e], a[2 * e + 1] * ra * ga[c0 + 2 * e + 1]); oy[e] = pack2(y[2 * e] * ry * gc[c0 + 2 * e], y[2 * e + 1] * ry * gc[c0 + 2 * e + 1]); }
        *(uint4*)(MIX + (size_t)tok * D + c0) = make_uint4(oa[0], oa[1], oa[2], oa[3]);
        *(uint4*)(MIX + (size_t)tok * D + 512 + c0) = make_uint4(oy[0], oy[1], oy[2], oy[3]);
    }
}

struct EpiResGate {
    static constexpr bool PERM = false, AFTER_DRAIN = false;
    float* C; const float* X; const float* MOD; int gate_off;
    __device__ __forceinline__ void operator()(const pg8::f32x4 (&acc)[2][2][4][2], const pg8::Unit& u, int wr, int wc, int fr, int fq) const {
        using pg8::f32x4; using pg8::HALF; using pg8::BM;
        const int row0 = u.pm * BM + wr * 64 + fr, col0 = u.pn * BM + wc * 32 + 4 * fq;
        const int b = (u.pm * BM) / S;
        f32x4 gv[2][2];
#pragma unroll
        for (int bj = 0; bj < 2; ++bj)
#pragma unroll
            for (int n = 0; n < 2; ++n) gv[bj][n] = *(const f32x4*)(MOD + b * 6144 + gate_off + col0 + bj * HALF + n * 16);
#pragma unroll
        for (int ai = 0; ai < 2; ++ai)
#pragma unroll
            for (int m = 0; m < 4; ++m) { const size_t ro = (size_t)(row0 + ai * HALF + m * 16) * D + col0;
#pragma unroll
                for (int bj = 0; bj < 2; ++bj)
#pragma unroll
                    for (int n = 0; n < 2; ++n) { const f32x4 xv = *(const f32x4*)(X + ro + bj * HALF + n * 16); *(f32x4*)(C + ro + bj * HALF + n * 16) = xv + gv[bj][n] * acc[ai][bj][m][n]; } }
    }
};

__device__ __forceinline__ void argmax_bfly(float& v, int& i) {
#pragma unroll
    for (int o = 32; o >= 1; o >>= 1) { const float ov = __shfl_xor(v, o); const int oi = __shfl_xor(i, o); if (ov > v || (ov == v && oi < i)) { v = ov; i = oi; } }
}
__device__ __forceinline__ void p9_route_naive(const Frame& F) {
    const bf16_t* QP = (const bf16_t*)(F.ws + WS_QP); const bf16_t* KEYS = (const bf16_t*)(F.ws + WS_KEYS);
    int* EIDX = (int*)(F.ws + WS_EIDX); float* EW = (float*)(F.ws + WS_EW);
    LAS float* ql = (LAS float*)F.lds + F.wave * 128;
    const int gw = blockIdx.x * NWAVES + F.wave, nw = F.G * NWAVES, lane = F.lane;
    for (int u = gw; u < T * 8; u += nw) {
        const int h = u & 7, tok = u >> 3;
        ql[lane] = bf2f(QP[(size_t)tok * D + h * 128 + lane]); ql[64 + lane] = bf2f(QP[(size_t)tok * D + h * 128 + 64 + lane]);
        lds_wave_sync();
        float tv[2]; int ti[2];
#pragma unroll
        for (int p = 0; p < 2; ++p) {
            float s[2];
#pragma unroll
            for (int kk = 0; kk < 2; ++kk) { const uint4* kr = (const uint4*)(KEYS + ((size_t)(h * 2 + p) * 128 + lane + 64 * kk) * 64); float a = 0.f;
#pragma unroll
                for (int c = 0; c < 8; ++c) { const uint4 w = kr[c]; const unsigned ww[4] = {w.x, w.y, w.z, w.w};
#pragma unroll
                    for (int e = 0; e < 4; ++e) a += ql[p * 64 + c * 8 + 2 * e] * bflo(ww[e]) + ql[p * 64 + c * 8 + 2 * e + 1] * bfhi(ww[e]); }
                s[kk] = a; }
            tv[p] = 0.f; ti[p] = 0;
            for (int i = 0; i < 16; ++i) {
                float v = s[0]; int ix = lane; if (s[1] > v) { v = s[1]; ix = lane + 64; }
                argmax_bfly(v, ix);
                if (lane == i) { tv[p] = v; ti[p] = ix; }
                if (ix == lane) s[0] = -INFINITY; if (ix == lane + 64) s[1] = -INFINITY;
            }
        }
        float cd[4];
        { const float va = __shfl(tv[0], lane >> 2);
#pragma unroll
            for (int i = 0; i < 4; ++i) cd[i] = va + __shfl(tv[1], (lane & 3) * 4 + i); }
        float cs = 0.f; int cc = 0;
        for (int it = 0; it < 16; ++it) {
            float v = cd[0]; int ix = lane * 4;
#pragma unroll
            for (int i = 1; i < 4; ++i) if (cd[i] > v) { v = cd[i]; ix = lane * 4 + i; }
            argmax_bfly(v, ix);
            if (lane == it) { cs = v; cc = ix; }
#pragma unroll
            for (int i = 0; i < 4; ++i) if (ix == lane * 4 + i) cd[i] = -INFINITY;
        }
        const int i1 = __shfl(ti[0], cc >> 4), i2 = __shfl(ti[1], cc & 15);
        const float m = __shfl(cs, 0); float ex = lane < 16 ? __expf(cs - m) : 0.f; const float sum = wave_sum(ex);
        if (lane < 16) { EIDX[(size_t)tok * 128 + h * 16 + lane] = i1 * 128 + i2; EW[(size_t)tok * 128 + h * 16 + lane] = ex / sum; }
        lds_wave_sync();
    }
}

__device__ __forceinline__ void p10_peer_naive(const Frame& F) {
    const bf16_t* H2 = (const bf16_t*)(F.ws + WS_H); const bf16_t* UB = (const bf16_t*)(F.ws + WS_UB); const bf16_t* VB = (const bf16_t*)(F.ws + WS_VB);
    const int* EIDX = (const int*)(F.ws + WS_EIDX); const float* EW = (const float*)(F.ws + WS_EW); const float* MOD = (const float*)(F.ws + WS_MOD);
    const float* gfin = F.in[22]; float* out = F.out;
    const int gw = blockIdx.x * NWAVES + F.wave, nw = F.G * NWAVES, lane = F.lane;
    for (int tok = gw; tok < T; tok += nw) {
        const int b = tok / S;
        float xr[16], acc[16];
#pragma unroll
        for (int hlf = 0; hlf < 2; ++hlf) { const uint4 w = *(const uint4*)(H2 + (size_t)tok * D + hlf * 512 + lane * 8); const unsigned ww[4] = {w.x, w.y, w.z, w.w};
#pragma unroll
            for (int e = 0; e < 4; ++e) { xr[hlf * 8 + 2 * e] = bflo(ww[e]); xr[hlf * 8 + 2 * e + 1] = bfhi(ww[e]); } }
#pragma unroll
        for (int e = 0; e < 16; ++e) acc[e] = 0.f;
        for (int i0 = 0; i0 < 128; i0 += 4) {
            int ei[4]; float wi[4], dt[4];
#pragma unroll
            for (int i = 0; i < 4; ++i) { ei[i] = __builtin_amdgcn_readfirstlane(EIDX[(size_t)tok * 128 + i0 + i]); wi[i] = EW[(size_t)tok * 128 + i0 + i]; }
#pragma unroll
            for (int i = 0; i < 4; ++i) { float d = 0.f;
#pragma unroll
                for (int hlf = 0; hlf < 2; ++hlf) { const uint4 w = *(const uint4*)(UB + (size_t)ei[i] * D + hlf * 512 + lane * 8); const unsigned ww[4] = {w.x, w.y, w.z, w.w};
#pragma unroll
                    for (int e = 0; e < 4; ++e) d += xr[hlf * 8 + 2 * e] * bflo(ww[e]) + xr[hlf * 8 + 2 * e + 1] * bfhi(ww[e]); }
                dt[i] = d; }
#pragma unroll
            for (int i = 0; i < 4; ++i) { const float dot = wave_sum(dt[i]); const float cf = wi[i] * gelu_tanh(dot);
#pragma unroll
                for (int hlf = 0; hlf < 2; ++hlf) { const uint4 w = *(const uint4*)(VB + (size_t)ei[i] * D + hlf * 512 + lane * 8); const unsigned ww[4] = {w.x, w.y, w.z, w.w};
#pragma unroll
                    for (int e = 0; e < 4; ++e) { acc[hlf * 8 + 2 * e] += cf * bflo(ww[e]); acc[hlf * 8 + 2 * e + 1] += cf * bfhi(ww[e]); } } }
        }
        float x2[16], ss = 0.f;
#pragma unroll
        for (int hlf = 0; hlf < 2; ++hlf)
#pragma unroll
            for (int q = 0; q < 2; ++q) { const int col = hlf * 512 + lane * 8 + q * 4; const float4 x1 = *(const float4*)(out + (size_t)tok * D + col); const float4 gt = *(const float4*)(MOD + b * 6144 + 5120 + col);
                const int e = hlf * 8 + q * 4;
                x2[e] = x1.x + gt.x * acc[e]; x2[e + 1] = x1.y + gt.y * acc[e + 1]; x2[e + 2] = x1.z + gt.z * acc[e + 2]; x2[e + 3] = x1.w + gt.w * acc[e + 3];
                ss += x2[e] * x2[e] + x2[e + 1] * x2[e + 1] + x2[e + 2] * x2[e + 2] + x2[e + 3] * x2[e + 3]; }
        ss = wave_sum(ss); const float rstd = rsqrtf(ss * (1.0f / D) + EPS);
#pragma unroll
        for (int hlf = 0; hlf < 2; ++hlf)
#pragma unroll
            for (int q = 0; q < 2; ++q) { const int col = hlf * 512 + lane * 8 + q * 4; const float4 gg = *(const float4*)(gfin + col); const int e = hlf * 8 + q * 4;
                *(float4*)(out + (size_t)tok * D + col) = make_float4(x2[e] * rstd * gg.x, x2[e + 1] * rstd * gg.y, x2[e + 2] * rstd * gg.z, x2[e + 3] * rstd * gg.w); }
    }
}

constexpr int N_PHASES = 11;
struct Args { const float* in[23]; float* out; unsigned char* ws; int ph_lo, ph_hi; };
__global__ void __launch_bounds__(NTHREADS, 2) fwd(Args args) {
    extern __shared__ __attribute__((aligned(16))) unsigned char lds_raw[];
    Frame F;
#pragma unroll
    for (int i = 0; i < 23; ++i) F.in[i] = args.in[i];
    F.out = args.out; F.ws = args.ws; F.lds = (LAS unsigned char*)lds_raw;
    F.tid = threadIdx.x; F.lane = F.tid & 63; F.wave = __builtin_amdgcn_readfirstlane(F.tid >> 6); F.G = gridDim.x;
    volatile LAS unsigned* misc = (volatile LAS unsigned*)(F.lds + LDS_MISC_OFF);
    if (F.tid < 64) misc[F.tid] = 0u;
    __syncthreads();
    XcdBarrier bar; bar.bar = (unsigned*)(F.ws + WS_CTL); bar.x = 0; bar.st = misc;
    const int lo = args.ph_lo, hi = args.ph_hi;
    if (hi - lo > 1) bar = xcd_barrier_post((unsigned*)(F.ws + WS_CTL), misc);
#ifndef PH_MASK
#define PH_MASK 0xFFFF
#endif
#define IN(k) (((PH_MASK >> (k)) & 1) && lo <= (k) && (k) < hi)
#define SEAM(k) do { if (IN(k) && IN((k) + 1)) xcd_barrier(bar); } while (0)
    const float* MOD = (const float*)(F.ws + WS_MOD);
    if (IN(0)) { p0_prologue(F); } SEAM(0);
    if (IN(1)) { norm_mod_rows(F, F.in[0], F.in[2], 0, 1024, (bf16_t*)(F.ws + WS_H)); } SEAM(1);
    if (IN(2)) { pg8::Gemm g{(const pg8::bf16_t*)(F.ws + WS_H), (const pg8::bf16_t*)(F.ws + WS_WIN), T, NPAD, D}; pg8::StaticOrder So; So.init(T, NPAD, F.G, (int)blockIdx.x);
        pg8::EpiBf16<0> E{(pg8::bf16_t*)(F.ws + WS_PROJ), NPAD, nullptr, 0, 0};
        pg8::gemm_phase<pg8::EpiBf16<0>, pg8::StaticOrder>(F.lds, g, So, E, nullptr); } SEAM(2);
    if (IN(3)) { p3_compress_naive(F); } SEAM(3);
    if (IN(4)) { p4_attn_naive(F); } SEAM(4);
    if (IN(5)) { p5_mixed(F); } SEAM(5);
    if (IN(6)) { pg8::Gemm g{(const pg8::bf16_t*)(F.ws + WS_H), (const pg8::bf16_t*)(F.ws + WS_WOUT), T, D, D}; pg8::StaticOrder So; So.init(T, D, F.G, (int)blockIdx.x);
        EpiResGate E{F.out, F.in[0], MOD, 2048};
        pg8::gemm_phase<EpiResGate, pg8::StaticOrder>(F.lds, g, So, E, nullptr); } SEAM(6);
    if (IN(7)) { norm_mod_rows(F, F.out, F.in[3], 3072, 4096, (bf16_t*)(F.ws + WS_H)); } SEAM(7);
    if (IN(8)) { pg8::Gemm g{(const pg8::bf16_t*)(F.ws + WS_H), (const pg8::bf16_t*)(F.ws + WS_WQ), T, D, D}; pg8::StaticOrder So; So.init(T, D, F.G, (int)blockIdx.x);
        pg8::EpiBf16<0> E{(pg8::bf16_t*)(F.ws + WS_QP), D, nullptr, 0, 0};
        pg8::gemm_phase<pg8::EpiBf16<0>, pg8::StaticOrder>(F.lds, g, So, E, nullptr); } SEAM(8);
    if (IN(9)) { p9_route_naive(F); } SEAM(9);
    if (IN(10)) { p10_peer_naive(F); }
#undef IN
#undef SEAM
}

extern "C" void kernel_launch(void* const* d_in, const int* in_sizes, int n_in, void* d_out, int out_size, void* d_ws, size_t ws_size, hipStream_t stream) {
    static int grid = 0;
    if (grid == 0) {
        if (n_in != 23 || out_size != T * D || ws_size < WS_END) { fprintf(stderr, "kernel_launch: unexpected shapes: n_in %d out %d ws %zu (need %zu)\n", n_in, out_size, ws_size, (size_t)WS_END); grid = -1; return; }
        int dev = 0, cus = 0, per_cu = 0;
        if (hipGetDevice(&dev) != hipSuccess || hipDeviceGetAttribute(&cus, hipDeviceAttributeMultiprocessorCount, dev) != hipSuccess) { grid = -1; return; }
        if (hipFuncSetAttribute((const void*)fwd, hipFuncAttributeMaxDynamicSharedMemorySize, LDS_BYTES) != hipSuccess) { fprintf(stderr, "kernel_launch: hipFuncSetAttribute failed\n"); grid = -1; return; }
        if (hipOccupancyMaxActiveBlocksPerMultiprocessor(&per_cu, (const void*)fwd, NTHREADS, LDS_BYTES) != hipSuccess || per_cu < 1) { fprintf(stderr, "kernel_launch: occupancy query says %d\n", per_cu); (void)hipGetLastError(); per_cu = 1; }
        grid = cus;
    }
    if (grid < 0) return;
    (void)hipMemsetAsync((char*)d_ws + WS_CTL, 0, CTL_BYTES, stream);
    Args a{};
    for (int i = 0; i < 23; ++i) a.in[i] = (const float*)d_in[i];
    a.out = (float*)d_out; a.ws = (unsigned char*)d_ws;
#if MK_N_LAUNCHES == 1
    a.ph_lo = 0; a.ph_hi = N_PHASES;
    hipLaunchKernelGGL(fwd, dim3(grid), dim3(NTHREADS), LDS_BYTES, stream, a);
#else
    for (int p = 0; p < N_PHASES; ++p) { a.ph_lo = p; a.ph_hi = p + 1; hipLaunchKernelGGL(fwd, dim3(grid), dim3(NTHREADS), LDS_BYTES, stream, a); }
#endif
}
```

```cpp
#include <hip/hip_runtime.h>
#include <cstdio>
#include <cstdint>
#include <cstdlib>

#ifndef MK_N_LAUNCHES
#define MK_N_LAUNCHES 1
#endif
#define XB_TMO      128
#define XB_XCNT(j)  (256  + 64 * (j))
#define XB_XSUB(j)  (1280 + 64 * (j))
#define XB_XGEN(j)  (2304 + 64 * (j))
#define XB_TOP      3328
#define XB_TOPGEN   3392
#define XCD_BAR_WORDS 3456
#define XB_SPIN_CAP (1u << 18)
#define LAS __attribute__((address_space(3)))

__device__ __forceinline__ unsigned xb_ld(unsigned* p)              { return __hip_atomic_load(p, __ATOMIC_RELAXED, __HIP_MEMORY_SCOPE_AGENT); }
__device__ __forceinline__ unsigned xb_add(unsigned* p, unsigned v) { return __hip_atomic_fetch_add(p, v, __ATOMIC_RELAXED, __HIP_MEMORY_SCOPE_AGENT); }
__device__ __forceinline__ unsigned xb_xcc_id() { return (unsigned)__builtin_amdgcn_s_getreg((3 << 11) | 20) & 0xFu; }
#define XB_SPIN(cond, bar) do { unsigned _sp = 0; while (cond) { __builtin_amdgcn_s_sleep(1); \
    if ((++_sp & 255u) == 0u) { if (xb_ld(&(bar)[XB_TMO])) break; if (_sp > XB_SPIN_CAP) { atomicAdd(&(bar)[XB_TMO], 1u); break; } } } } while (0)

struct XcdBarrier {
    unsigned* bar; unsigned x;
    volatile LAS unsigned* st;
};

__device__ __forceinline__ XcdBarrier xcd_barrier_post(unsigned* bar, volatile LAS unsigned* st) {
    XcdBarrier b; b.bar = bar; b.x = xb_xcc_id(); b.st = st;
    if (threadIdx.x == 0) (void)xb_add(&bar[XB_XCNT(b.x)], 1u);
    return b;
}
__device__ __forceinline__ void xcd_barrier_complete(unsigned* bar, unsigned x, unsigned& nloc, unsigned& nx) {
    const unsigned G = gridDim.x * gridDim.y * gridDim.z;
    unsigned sum, cnt, mine, sp = 0u;
    for (;;) {
        sum = 0u; cnt = 0u; mine = 0u;
#pragma unroll
        for (unsigned j = 0; j < 16; ++j) { const unsigned c = xb_ld(&bar[XB_XCNT(j)]); sum += c; cnt += (c > 0u) ? 1u : 0u; mine = (j == x) ? c : mine; }
        if (sum == G) break;
        __builtin_amdgcn_s_sleep(1);
        if ((++sp & 255u) == 0u) { if (xb_ld(&bar[XB_TMO])) break; if (sp > XB_SPIN_CAP) { atomicAdd(&bar[XB_TMO], 1u); break; } }
    }
    nloc = mine > 0u ? mine : 1u; nx = cnt > 0u ? cnt : 1u;
}

__device__ __forceinline__ void xcd_barrier(const XcdBarrier& b) {
    asm volatile("s_waitcnt vmcnt(0)" ::: "memory");
    __syncthreads();
    if (threadIdx.x == 0) {
        unsigned* bar = b.bar;
        __builtin_amdgcn_s_waitcnt(0);
        unsigned nloc = b.st[0], nx = b.st[1];
        if (nloc == 0u) { xcd_barrier_complete(bar, b.x, nloc, nx); b.st[0] = nloc; b.st[1] = nx; }
        const unsigned old = xb_add(&bar[XB_XSUB(b.x)], 1u);
        const unsigned gen = old / nloc;
        if (old + 1u == (gen + 1u) * nloc) {
            __builtin_amdgcn_fence(__ATOMIC_RELEASE, "agent");
            asm volatile("s_waitcnt vmcnt(0)" ::: "memory");
            const unsigned og = xb_add(&bar[XB_TOP], 1u);
            const unsigned tg = og / nx;
            if (og + 1u == (tg + 1u) * nx) xb_add(&bar[XB_TOPGEN], 1u);
            else XB_SPIN(xb_ld(&bar[XB_TOPGEN]) == tg, bar);
            __builtin_amdgcn_fence(__ATOMIC_ACQUIRE, "agent");
            xb_add(&bar[XB_XGEN(b.x)], 1u);
            asm volatile("s_waitcnt vmcnt(0)" ::: "memory");
        } else {
            XB_SPIN(xb_ld(&bar[XB_XGEN(b.x)]) == gen, bar);
            __builtin_amdgcn_fence(__ATOMIC_ACQUIRE, "agent");
            asm volatile("s_waitcnt vmcnt(0)" ::: "memory");
        }
    }
    __syncthreads();
}

namespace pg8 {
#define PG8_LAS __attribute__((address_space(3)))
typedef unsigned short bf16_t;
typedef short bf16x8 __attribute__((ext_vector_type(8)));
typedef float f32x4 __attribute__((ext_vector_type(4)));
typedef unsigned u32x4 __attribute__((ext_vector_type(4)));
constexpr int BM = 256, BK = 64, HALF = 128, HTB = HALF * BK * 2  , STAGE_BYTES = 8 * HTB, NXCD = 8, WGM = 8;

__host__ __device__ __forceinline__ int lds_byte(int r, int c) { const int st = (r >> 4) * 2 + (c >> 5), rr = r & 15, cc = c & 31, ob = rr * 64 + cc * 2; return st * 1024 + (ob ^ (((ob >> 9) & 1) << 5)); }
__host__ __device__ __forceinline__ void stage_rc(int b, int& R, int& C) { const int st = b / 1024, sb = b % 1024, swz = sb ^ (((sb >> 9) & 1) << 5); R = (st >> 1) * 16 + swz / 64; C = (st & 1) * 32 + (swz % 64) / 2; }
__host__ __device__ __forceinline__ int perm32(int rho) { const int n = rho >> 4, i = rho & 15; return 8 * (i >> 2) + 4 * n + (i & 3); }

struct Unit { int pm, pn; };
struct Gemm { const bf16_t* A; const bf16_t* Bt; int M, N, K; };

struct StaticOrder {
    int nM, nN, nwg, G, c;
    __host__ __device__ void init(int M, int N, int G_, int c_) { nM = M / BM; nN = N / BM; nwg = nM * nN; G = G_; c = c_; }
    __host__ __device__ bool next(int i, Unit& u) const {
        const long L = (long)i * G + c; if (L >= nwg) return false;
        int wgid = (int)L; { const int q = nwg / NXCD, r = nwg % NXCD, xcd = wgid % NXCD, off = wgid / NXCD; wgid = (xcd < r ? xcd * (q + 1) : r * (q + 1) + (xcd - r) * q) + off; }
        const int nig = WGM * nN, gid = wgid / nig, fm = gid * WGM, gsz = (nM - fm) < WGM ? (nM - fm) : WGM;
        u.pm = fm + ((wgid % nig) % gsz); u.pn = (wgid % nig) / gsz; return true;
    }
    __device__ __forceinline__ void a_ready(const Unit&) const {}
    __device__ __forceinline__ void done(const Unit&) const {}
};
struct CountedOrder : StaticOrder {
    const unsigned* ready; unsigned need; unsigned* tmo;
    __device__ __forceinline__ void a_ready(const Unit& u) const {
        if (threadIdx.x < 64) {
            const unsigned long long t0 = __builtin_amdgcn_s_memrealtime(); unsigned polls = 0;
            while ((unsigned)__builtin_amdgcn_readfirstlane(__hip_atomic_load(ready + 64 * u.pm, __ATOMIC_RELAXED, __HIP_MEMORY_SCOPE_AGENT)) < need) {
                if ((++polls & 255u) == 0u && __builtin_amdgcn_readfirstlane(__hip_atomic_load(tmo, __ATOMIC_RELAXED, __HIP_MEMORY_SCOPE_AGENT)) != 0u) break;
                if (__builtin_amdgcn_s_memrealtime() - t0 > 2000000ull) {
                    if (threadIdx.x == 0) { unsigned expect = 0u; __hip_atomic_compare_exchange_strong(tmo + 1, &expect, 0x600u | (unsigned)(u.pm & 0xff), __ATOMIC_RELAXED, __ATOMIC_RELAXED, __HIP_MEMORY_SCOPE_AGENT); __hip_atomic_store(tmo, 1u, __ATOMIC_RELAXED, __HIP_MEMORY_SCOPE_AGENT); }
                    break; }
                __builtin_amdgcn_s_sleep(2); }
            __builtin_amdgcn_fence(__ATOMIC_ACQUIRE, "agent");
            asm volatile("s_waitcnt vmcnt(0)" ::: "memory");
        }
#if !defined(BROKEN_HOOK_NO_BARRIER)
        asm volatile("" ::: "memory"); __builtin_amdgcn_s_barrier(); asm volatile("" ::: "memory");
#endif
    }
};

__device__ __forceinline__ unsigned cvt_pk_bf16(float lo, float hi) { unsigned r; asm volatile("v_cvt_pk_bf16_f32 %0, %1, %2" : "=v"(r) : "v"(lo), "v"(hi)); return r; }
typedef float f32x2 __attribute__((ext_vector_type(2)));
__device__ __forceinline__ f32x2 gelu_pk(f32x2 v) {
    const f32x2 av = __builtin_elementwise_abs(v), d = av * 0.2316418882f + 1.0f;
    f32x2 t; t.x = __builtin_amdgcn_rcpf(d.x); t.y = __builtin_amdgcn_rcpf(d.y);
    f32x2 q = t * 0.5307027145f + (-0.7265760135f); q = q * t + 0.7107068705f; q = q * t + (-0.142248368f); q = q * t + 0.127414796f; q = q * t;
    const f32x2 s = (v * v) * (-0.72134752044f);
    f32x2 e; e.x = __builtin_amdgcn_exp2f(s.x); e.y = __builtin_amdgcn_exp2f(s.y);
    const f32x2 m = v * (q * e), r = v - m;
    f32x2 o; o.x = v.x < 0.f ? m.x : r.x; o.y = v.y < 0.f ? m.y : r.y; return o;
}

struct EpiF32 {
    static constexpr bool PERM = false, AFTER_DRAIN = false;
    float* C; int ldc; const float* bias;
    __device__ __forceinline__ void operator()(const f32x4 (&acc)[2][2][4][2], const Unit& u, int wr, int wc, int fr, int fq) const {
        const int row0 = u.pm * BM + wr * 64 + fr, col0 = u.pn * BM + wc * 32 + 4 * fq;
        f32x4 bv[2][2];
#pragma unroll
        for (int bj = 0; bj < 2; ++bj)
#pragma unroll
            for (int n = 0; n < 2; ++n) bv[bj][n] = bias ? *(const f32x4*)(bias + col0 + bj * HALF + n * 16) : (f32x4){0.f, 0.f, 0.f, 0.f};
#pragma unroll
        for (int ai = 0; ai < 2; ++ai)
#pragma unroll
            for (int m = 0; m < 4; ++m) { float* rowp = C + (size_t)(row0 + ai * HALF + m * 16) * ldc + col0;
#pragma unroll
                for (int bj = 0; bj < 2; ++bj)
#pragma unroll
                    for (int n = 0; n < 2; ++n) *(f32x4*)(rowp + bj * HALF + n * 16) = acc[ai][bj][m][n] + bv[bj][n]; }
    }
};
template <int ACT  > struct EpiBf16 {
    static constexpr bool PERM = true, AFTER_DRAIN = false;
    bf16_t* O; int ldc; const float* bias; int split_cols; size_t split_stride;
    __device__ __forceinline__ void operator()(const f32x4 (&acc)[2][2][4][2], const Unit& u, int wr, int wc, int fr, int fq) const {
        const int row0 = u.pm * BM + wr * 64 + fr; int colt = u.pn * BM; bf16_t* base = O;
        if (split_cols) { const int t = colt / split_cols; base += (size_t)t * split_stride; colt -= t * split_cols; }
        const int col0 = colt + wc * 32 + 8 * fq, bcol0 = u.pn * BM + wc * 32 + 8 * fq;
        f32x4 bv[2][2];
#pragma unroll
        for (int bj = 0; bj < 2; ++bj)
#pragma unroll
            for (int n = 0; n < 2; ++n) bv[bj][n] = bias ? *(const f32x4*)(bias + bcol0 + bj * HALF + 4 * n) : (f32x4){0.f, 0.f, 0.f, 0.f};
#pragma unroll
        for (int ai = 0; ai < 2; ++ai)
#pragma unroll
            for (int m = 0; m < 4; ++m) { bf16_t* rowp = base + (size_t)(row0 + ai * HALF + m * 16) * ldc + col0;
#pragma unroll
                for (int bj = 0; bj < 2; ++bj) { f32x4 v0 = acc[ai][bj][m][0] + bv[bj][0], v1 = acc[ai][bj][m][1] + bv[bj][1];
                    if (ACT == 1) { f32x2 a = gelu_pk((f32x2){v0[0], v0[1]}), b = gelu_pk((f32x2){v0[2], v0[3]}), c = gelu_pk((f32x2){v1[0], v1[1]}), d = gelu_pk((f32x2){v1[2], v1[3]});
                        v0 = (f32x4){a.x, a.y, b.x, b.y}; v1 = (f32x4){c.x, c.y, d.x, d.y}; }
                    if (ACT == 2) {
#pragma unroll
                        for (int j = 0; j < 4; ++j) { v0[j] = 0.5f * v0[j] * (1.0f + erff(v0[j] * 0.70710678f)); v1[j] = 0.5f * v1[j] * (1.0f + erff(v1[j] * 0.70710678f)); } }
                    u32x4 w; w.x = cvt_pk_bf16(v0[0], v0[1]); w.y = cvt_pk_bf16(v0[2], v0[3]); w.z = cvt_pk_bf16(v1[0], v1[1]); w.w = cvt_pk_bf16(v1[2], v1[3]);
                    *(u32x4*)(rowp + bj * HALF) = w; } }
    }
};

struct PanelStats {
    unsigned* xbuf;
    unsigned* cnt;
    unsigned* tmo;
    int ntn; float eps;
    unsigned code;
    __device__ __forceinline__ bool run(const f32x4 (&v)[2][2][4][2], const Unit& u, int wr, int wc, int fr, int fq, PG8_LAS unsigned char* lds, int wid, int lane) const {
        typedef float f32x2v __attribute__((ext_vector_type(2)));
        PG8_LAS f32x2v* P = (PG8_LAS f32x2v*)lds;
        PG8_LAS f32x2v* S = (PG8_LAS f32x2v*)(lds + 8192);
        PG8_LAS unsigned* flag = (PG8_LAS unsigned*)(lds + 8192 + 2048);
#pragma unroll
        for (int ai = 0; ai < 2; ++ai)
#pragma unroll
            for (int m = 0; m < 4; ++m) {
                float s = 0.f;
#pragma unroll
                for (int bj = 0; bj < 2; ++bj)
#pragma unroll
                    for (int n = 0; n < 2; ++n) { const f32x4 x = v[ai][bj][m][n]; s += (x[0] + x[1]) + (x[2] + x[3]); }
                s += __shfl_xor(s, 16); s += __shfl_xor(s, 32);
                const float mw = s * (1.0f / 64.0f); float q = 0.f;
#pragma unroll
                for (int bj = 0; bj < 2; ++bj)
#pragma unroll
                    for (int n = 0; n < 2; ++n) { const f32x4 d = v[ai][bj][m][n] - mw; q += (d[0] * d[0] + d[1] * d[1]) + (d[2] * d[2] + d[3] * d[3]); }
                q += __shfl_xor(q, 16); q += __shfl_xor(q, 32);
                if (fq == 0) P[(ai * HALF + wr * 64 + m * 16 + fr) * 4 + wc] = (f32x2v){mw, q};
            }
        asm volatile("s_waitcnt lgkmcnt(0)" ::: "memory"); __builtin_amdgcn_s_barrier(); asm volatile("" ::: "memory");
#if defined(BROKEN_NO_WAIT)
        if (blockIdx.x >= 64) { const long long t0 = clock64(); while (clock64() - t0 < 60000) __builtin_amdgcn_s_sleep(8); }
#endif
        const int row = wid * 32 + (lane & 31);
        if (lane < 32) {
            const f32x2v a = P[row * 4 + 0], b = P[row * 4 + 1], c = P[row * 4 + 2], d = P[row * 4 + 3];
            const float mt = (a.x + b.x + c.x + d.x) * 0.25f;
            const float da = a.x - mt, db = b.x - mt, dc = c.x - mt, dd = d.x - mt;
            const float m2 = (a.y + b.y) + (c.y + d.y) + 64.0f * ((da * da + db * db) + (dc * dc + dd * dd));
            unsigned long long* slot = (unsigned long long*)xbuf + ((size_t)(u.pm * BM + row) * 4 + u.pn);
            __hip_atomic_store(slot, ((unsigned long long)__float_as_uint(m2) << 32) | __float_as_uint(mt), __ATOMIC_RELAXED, __HIP_MEMORY_SCOPE_AGENT);
        }
        asm volatile("s_waitcnt vmcnt(0)" ::: "memory");
        if (lane == 0) __hip_atomic_fetch_add(cnt + 64 * u.pm, 1u, __ATOMIC_RELAXED, __HIP_MEMORY_SCOPE_AGENT);
        if (wid == 0) {
            bool dead = false; const unsigned long long t0 = __builtin_amdgcn_s_memrealtime(); const unsigned want = 8u * (unsigned)ntn;
            for (;;) {
#if defined(BROKEN_NO_WAIT)
                break;
#endif
                if ((unsigned)__builtin_amdgcn_readfirstlane(__hip_atomic_load(cnt + 64 * u.pm, __ATOMIC_RELAXED, __HIP_MEMORY_SCOPE_AGENT)) >= want) break;
                if (__builtin_amdgcn_s_memrealtime() - t0 > 2000000ull) {
                    if (lane == 0) { unsigned expect = 0u; __hip_atomic_compare_exchange_strong(tmo + 1, &expect, code | (unsigned)(u.pm & 0xff), __ATOMIC_RELAXED, __ATOMIC_RELAXED, __HIP_MEMORY_SCOPE_AGENT);
                                     __hip_atomic_store(tmo, 1u, __ATOMIC_RELAXED, __HIP_MEMORY_SCOPE_AGENT); }
                    dead = true; break; }
                __builtin_amdgcn_s_sleep(2);
            }
            __builtin_amdgcn_fence(__ATOMIC_ACQUIRE, "agent");
            if (lane == 0) flag[0] = dead ? 1u : 0u;
        }
        asm volatile("s_waitcnt vmcnt(0) lgkmcnt(0)" ::: "memory"); __builtin_amdgcn_s_barrier(); asm volatile("" ::: "memory");
        const bool bad = flag[0] != 0u;
        if (lane < 32) {
            const unsigned long long* slot = (const unsigned long long*)xbuf + (size_t)(u.pm * BM + row) * 4; float mt[4], m2[4]; float ms = 0.f;
#pragma unroll
            for (int t = 0; t < 4; ++t) { if (t < ntn) { const unsigned long long w = __hip_atomic_load(slot + t, __ATOMIC_RELAXED, __HIP_MEMORY_SCOPE_AGENT); mt[t] = __uint_as_float((unsigned)w); m2[t] = __uint_as_float((unsigned)(w >> 32)); } else { mt[t] = 0.f; m2[t] = 0.f; } ms += mt[t]; }
            const float mean = ms / (float)ntn; float q = 0.f;
#pragma unroll
            for (int t = 0; t < 4; ++t) if (t < ntn) { const float dm = mt[t] - mean; q += m2[t] + 256.0f * dm * dm; }
            S[row] = (f32x2v){mean, 1.0f / sqrtf(q / (256.0f * (float)ntn) + eps)};
        }
        asm volatile("s_waitcnt lgkmcnt(0)" ::: "memory"); __builtin_amdgcn_s_barrier(); asm volatile("" ::: "memory");
        return bad;
    }
};
struct EpiLnRes {
    static constexpr bool PERM = false, AFTER_DRAIN = true;
    const float* base; float* out; int ldc; const float* bias; PanelStats st; unsigned poison;
    __device__ __forceinline__ void refuse(size_t i0, size_t stride, int M, int N) const { const float q = __builtin_nanf(""); for (size_t i = i0; i < (size_t)M * N; i += stride) out[(i / N) * ldc + i % N] = q;
        if (i0 == 0) { unsigned expect = 0u; __hip_atomic_compare_exchange_strong(st.tmo + 1, &expect, 0x7f0u, __ATOMIC_RELAXED, __ATOMIC_RELAXED, __HIP_MEMORY_SCOPE_AGENT); __hip_atomic_store(st.tmo, 1u, __ATOMIC_RELAXED, __HIP_MEMORY_SCOPE_AGENT); } }
    __device__ __forceinline__ void fused(f32x4 (&acc)[2][2][4][2], const Unit& u, int wr, int wc, int fr, int fq, PG8_LAS unsigned char* lds, int wid, int lane) const {
        typedef float f32x2v __attribute__((ext_vector_type(2)));
        const PG8_LAS f32x2v* S = (const PG8_LAS f32x2v*)(lds + 8192);
        const int col0 = u.pn * BM + wc * 32 + 4 * fq;
#pragma unroll
        for (int bj = 0; bj < 2; ++bj)
#pragma unroll
            for (int n = 0; n < 2; ++n) { const f32x4 bv = bias ? *(const f32x4*)(bias + col0 + bj * HALF + n * 16) : (f32x4){0.f, 0.f, 0.f, 0.f};
#pragma unroll
                for (int ai = 0; ai < 2; ++ai)
#pragma unroll
                    for (int m = 0; m < 4; ++m) acc[ai][bj][m][n] += bv; }
        const bool bad = st.run(acc, u, wr, wc, fr, fq, lds, wid, lane) || poison != 0u;
        const float qnan = __builtin_nanf("");
#pragma unroll
        for (int ai = 0; ai < 2; ++ai)
#pragma unroll
            for (int m = 0; m < 4; ++m) { const int r = ai * HALF + wr * 64 + m * 16 + fr; const f32x2v sr = S[r]; const size_t off = (size_t)(u.pm * BM + r) * ldc + col0;
#pragma unroll
                for (int bj = 0; bj < 2; ++bj)
#pragma unroll
                    for (int n = 0; n < 2; ++n) { const f32x4 bs = *(const f32x4*)(base + off + bj * HALF + n * 16); f32x4 o = bs + (acc[ai][bj][m][n] - sr.x) * sr.y;
                        if (bad) o = (f32x4){qnan, qnan, qnan, qnan}; *(f32x4*)(out + off + bj * HALF + n * 16) = o; }
                asm volatile("" ::: "memory"); }
    }
};
struct EpiLnResLn {
    static constexpr bool PERM = false, AFTER_DRAIN = true;
    const float* base; float* out; bf16_t* xn; int ldc; const float* bias; PanelStats st1, st2; unsigned poison;
    __device__ __forceinline__ void refuse(size_t i0, size_t stride, int M, int N) const { const float q = __builtin_nanf(""); for (size_t i = i0; i < (size_t)M * N; i += stride) { const size_t o = (i / N) * ldc + i % N; out[o] = q; xn[o] = (bf16_t)0x7fc0u; }
        if (i0 == 0) { unsigned expect = 0u; __hip_atomic_compare_exchange_strong(st1.tmo + 1, &expect, 0x7f0u, __ATOMIC_RELAXED, __ATOMIC_RELAXED, __HIP_MEMORY_SCOPE_AGENT); __hip_atomic_store(st1.tmo, 1u, __ATOMIC_RELAXED, __HIP_MEMORY_SCOPE_AGENT); } }
    __device__ __forceinline__ void fused(f32x4 (&acc)[2][2][4][2], const Unit& u, int wr, int wc, int fr, int fq, PG8_LAS unsigned char* lds, int wid, int lane) const {
        typedef float f32x2v __attribute__((ext_vector_type(2))); typedef unsigned u32x2v __attribute__((ext_vector_type(2)));
        const PG8_LAS f32x2v* S = (const PG8_LAS f32x2v*)(lds + 8192);
        const int col0 = u.pn * BM + wc * 32 + 4 * fq;
#pragma unroll
        for (int bj = 0; bj < 2; ++bj)
#pragma unroll
            for (int n = 0; n < 2; ++n) { const f32x4 bv = bias ? *(const f32x4*)(bias + col0 + bj * HALF + n * 16) : (f32x4){0.f, 0.f, 0.f, 0.f};
#pragma unroll
                for (int ai = 0; ai < 2; ++ai)
#pragma unroll
                    for (int m = 0; m < 4; ++m) acc[ai][bj][m][n] += bv; }
        bool bad = st1.run(acc, u, wr, wc, fr, fq, lds, wid, lane) || poison != 0u;
        const float qnan = __builtin_nanf("");
#pragma unroll
        for (int ai = 0; ai < 2; ++ai)
#pragma unroll
            for (int m = 0; m < 4; ++m) { const int r = ai * HALF + wr * 64 + m * 16 + fr; const f32x2v sr = S[r]; const size_t off = (size_t)(u.pm * BM + r) * ldc + col0;
#pragma unroll
                for (int bj = 0; bj < 2; ++bj)
#pragma unroll
                    for (int n = 0; n < 2; ++n) { const f32x4 bs = *(const f32x4*)(base + off + bj * HALF + n * 16); acc[ai][bj][m][n] = bs + (acc[ai][bj][m][n] - sr.x) * sr.y; }
                asm volatile("" : "+v"(acc[ai][0][m][0]), "+v"(acc[ai][0][m][1]), "+v"(acc[ai][1][m][0]), "+v"(acc[ai][1][m][1]));
                if (m & 1) asm volatile("" ::: "memory"); }
        const bool bad1 = bad;
        bad = st2.run(acc, u, wr, wc, fr, fq, lds, wid, lane) || bad;
#pragma unroll
        for (int ai = 0; ai < 2; ++ai)
#pragma unroll
            for (int m = 0; m < 4; ++m) { const int r = ai * HALF + wr * 64 + m * 16 + fr; const f32x2v sr = S[r]; const size_t off = (size_t)(u.pm * BM + r) * ldc + col0;
#pragma unroll
                for (int bj = 0; bj < 2; ++bj)
#pragma unroll
                    for (int n = 0; n < 2; ++n) { const f32x4 x1 = acc[ai][bj][m][n]; *(f32x4*)(out + off + bj * HALF + n * 16) = bad1 ? (f32x4){qnan, qnan, qnan, qnan} : x1;
                        const f32x4 o = (x1 - sr.x) * sr.y; u32x2v w; w.x = cvt_pk_bf16(o[0], o[1]); w.y = cvt_pk_bf16(o[2], o[3]);
                        if (bad) { w.x = 0x7fc07fc0u; w.y = 0x7fc07fc0u; } *(u32x2v*)(xn + off + bj * HALF + n * 16) = w; }
                asm volatile("" ::: "memory"); }
    }
};

template <class Epi, class Sched, bool STAMP = false>
__device__ __forceinline__ void gemm_phase(PG8_LAS unsigned char* lds, const Gemm g, const Sched& S, const Epi& E, unsigned long long* stamps) {
    const int tid = threadIdx.x, wid = __builtin_amdgcn_readfirstlane(tid >> 6), lane = tid & 63, wr = wid >> 2, wc = wid & 3, fr = lane & 15, fq = lane >> 4;
    const int K = g.K, nt = K / BK;
    int ts_lo = 0, ts_hi = 0, nts = 0; const unsigned long long rt_entry = STAMP ? (unsigned long long)wall_clock64() : 0ull;
#define PG8_STAMP() do { if (STAMP && wid == 0 && nts < 64) { const unsigned long long _c = (unsigned long long)clock64(); \
        ts_lo = (lane == nts) ? (int)(unsigned)_c : ts_lo; ts_hi = (lane == nts) ? (int)(unsigned)(_c >> 32) : ts_hi; ++nts; } } while (0)
    PG8_STAMP();
    unsigned voffA[2], voffB[2];
#pragma unroll
    for (int i = 0; i < 2; ++i) { int R, C; stage_rc(tid * 16 + i * 8192, R, C); const int Rb = Epi::PERM ? ((R & ~31) + perm32(R & 31)) : R;
        voffA[i] = (unsigned)(R * K + C) * 2u; voffB[i] = (unsigned)(Rb * K + C) * 2u; }
    const size_t kstep = (size_t)(BK * 2);
    const size_t hstep = (size_t)HALF * K * 2;
    const size_t tstep = 2 * hstep;
    const unsigned ldsw = (unsigned)wid * 1024u;
    const int aoff = lds_byte(wr * 64 + fr, fq * 8), boff = lds_byte(wc * 32 + fr, fq * 8);
#define PG8_SA(b, h) (((b) * 2 + (h)) * HTB)
#define PG8_SB(b, h) ((4 + (b) * 2 + (h)) * HTB)
#define PG8_STAGE(bufoff, gbase, voff) do { _Pragma("unroll") for (int _i = 0; _i < 2; ++_i) \
        __builtin_amdgcn_global_load_lds((const unsigned*)((const char*)(gbase) + (voff)[_i]), (PG8_LAS unsigned*)(lds + (bufoff) + ldsw + _i * 8192), 16, 0, 0); } while (0)
#define PG8_LDA(dst, b, h) do { _Pragma("unroll") for (int m = 0; m < 4; ++m) _Pragma("unroll") for (int k = 0; k < 2; ++k) dst[m][k] = *(const PG8_LAS bf16x8*)(lds + PG8_SA(b, h) + aoff + m * 2048 + k * 1024); } while (0)
#define PG8_LDB(dst, b, h) do { _Pragma("unroll") for (int n = 0; n < 2; ++n) _Pragma("unroll") for (int k = 0; k < 2; ++k) dst[n][k] = *(const PG8_LAS bf16x8*)(lds + PG8_SB(b, h) + boff + n * 2048 + k * 1024); } while (0)
#define PG8_MMA(ai, bj, At, Bt) do { __builtin_amdgcn_s_setprio(1); _Pragma("unroll") for (int m = 0; m < 4; ++m) _Pragma("unroll") for (int n = 0; n < 2; ++n) _Pragma("unroll") for (int k = 0; k < 2; ++k) \
        acc[ai][bj][m][n] = __builtin_amdgcn_mfma_f32_16x16x32_bf16(Bt[n][k], At[m][k], acc[ai][bj][m][n], 0, 0, 0); __builtin_amdgcn_s_setprio(0); } while (0)
#define PG8_WAIT_V(n) asm volatile("s_waitcnt vmcnt(" #n ")" ::: "memory")
#define PG8_WAIT_L(n) asm volatile("s_waitcnt lgkmcnt(" #n ")" ::: "memory")
#define PG8_BAR __builtin_amdgcn_s_barrier()
#define PG8_SCHED __builtin_amdgcn_sched_barrier(0)
    Unit cur, nxt; int ui = 0;
    if (!S.next(0, cur)) return;
    f32x4 acc[2][2][4][2];
#pragma unroll
    for (int a = 0; a < 2; ++a)
#pragma unroll
        for (int b = 0; b < 2; ++b)
#pragma unroll
            for (int m = 0; m < 4; ++m)
#pragma unroll
                for (int n = 0; n < 2; ++n) acc[a][b][m][n] = (f32x4){0.f, 0.f, 0.f, 0.f};
    bf16x8 At[4][2], B0[2][2], B1[2][2];
    const char* cA = (const char*)g.A + (size_t)cur.pm * tstep; const char* cB = (const char*)g.Bt + (size_t)cur.pn * tstep;
    S.a_ready(cur);
    PG8_STAGE(PG8_SB(0, 0), cB, voffB); PG8_STAGE(PG8_SA(0, 0), cA, voffA); PG8_STAGE(PG8_SB(0, 1), cB + hstep, voffB); PG8_STAGE(PG8_SA(0, 1), cA + hstep, voffA);
    if (wr == 1) PG8_BAR;
    PG8_WAIT_V(4); PG8_BAR;
    PG8_STAGE(PG8_SB(1, 0), cB + kstep, voffB); PG8_STAGE(PG8_SA(1, 0), cA + kstep, voffA); PG8_STAGE(PG8_SB(1, 1), cB + hstep + kstep, voffB);
    PG8_WAIT_V(6); PG8_BAR;
    PG8_STAMP();
    for (;;) {
        const bool has_next = S.next(ui + 1, nxt);
        const char* nA = has_next ? (const char*)g.A + (size_t)nxt.pm * tstep : cA; const char* nB = has_next ? (const char*)g.Bt + (size_t)nxt.pn * tstep : cB;
        for (int t = 0; t < nt; t += 2) {
            const bool last = (t == nt - 2);
            const char* a1 = cA + (size_t)(t + 1) * kstep;
            const char* a2 = last ? nA : cA + (size_t)(t + 2) * kstep; const char* b2 = last ? nB : cB + (size_t)(t + 2) * kstep;
            const char* a3 = a2 + kstep; const char* b3 = b2 + kstep;
            if (last && has_next) S.a_ready(nxt);
            PG8_LDB(B0, 0, 0); PG8_SCHED; PG8_LDA(At, 0, 0); PG8_STAGE(PG8_SA(1, 1), a1 + hstep, voffA);
            PG8_WAIT_L(8); PG8_BAR; PG8_WAIT_L(0); PG8_MMA(0, 0, At, B0); PG8_BAR; PG8_SCHED;
            PG8_LDB(B1, 0, 1); PG8_STAGE(PG8_SB(0, 0), b2, voffB);
            PG8_BAR; PG8_WAIT_L(0); PG8_MMA(0, 1, At, B1); PG8_BAR;
            PG8_LDA(At, 0, 1); PG8_STAGE(PG8_SA(0, 0), a2, voffA);
            PG8_BAR; PG8_WAIT_L(0); PG8_MMA(1, 0, At, B0); PG8_BAR; PG8_SCHED;
            PG8_STAGE(PG8_SB(0, 1), b2 + hstep, voffB);
            PG8_WAIT_V(6); PG8_BAR; PG8_MMA(1, 1, At, B1); PG8_BAR;
            PG8_LDB(B0, 1, 0); PG8_SCHED; PG8_LDA(At, 1, 0); PG8_STAGE(PG8_SA(0, 1), a2 + hstep, voffA);
            PG8_WAIT_L(8); PG8_BAR; PG8_WAIT_L(0); PG8_MMA(0, 0, At, B0); PG8_BAR; PG8_SCHED;
            PG8_LDB(B1, 1, 1); PG8_STAGE(PG8_SB(1, 0), b3, voffB);
            PG8_BAR; PG8_WAIT_L(0); PG8_MMA(0, 1, At, B1); PG8_BAR;
            PG8_LDA(At, 1, 1); PG8_STAGE(PG8_SA(1, 0), a3, voffA);
            PG8_BAR; PG8_WAIT_L(0); PG8_MMA(1, 0, At, B0); PG8_BAR; PG8_SCHED;
            PG8_STAGE(PG8_SB(1, 1), b3 + hstep, voffB);
            PG8_WAIT_V(6); PG8_BAR; PG8_MMA(1, 1, At, B1); PG8_BAR;
        }
        PG8_STAMP();
        if constexpr (!Epi::AFTER_DRAIN) { E(acc, cur, wr, wc, fr, fq); S.done(cur); }
        PG8_STAMP();
        if (!has_next) break;
#pragma unroll
        for (int a = 0; a < 2; ++a)
#pragma unroll
            for (int b = 0; b < 2; ++b)
#pragma unroll
                for (int m = 0; m < 4; ++m)
#pragma unroll
                    for (int n = 0; n < 2; ++n) acc[a][b][m][n] = (f32x4){0.f, 0.f, 0.f, 0.f};
        cur = nxt; cA = nA; cB = nB; ++ui;
    }
    PG8_WAIT_V(0);
    if (wr == 0) PG8_BAR;
    PG8_BAR;
    if constexpr (Epi::AFTER_DRAIN) { E.fused(acc, cur, wr, wc, fr, fq, lds, wid, lane); S.done(cur); }
    PG8_STAMP();
    if (STAMP && wid == 0) { stamps[lane] = lane < nts ? (((unsigned long long)(unsigned)ts_hi << 32) | (unsigned)ts_lo) : 0ull;
        if (lane == 62) stamps[62] = rt_entry; if (lane == 63) stamps[63] = (unsigned long long)wall_clock64(); }
#undef PG8_STAMP
#undef PG8_SA
#undef PG8_SB
#undef PG8_STAGE
#undef PG8_LDA
#undef PG8_LDB
#undef PG8_MMA
#undef PG8_WAIT_V
#undef PG8_WAIT_L
#undef PG8_BAR
#undef PG8_SCHED
}
}

constexpr int D = 1024, NB = 16, S = 2048, T = NB * S;
constexpr int NCOL = 2840, NPAD = 3072;
constexpr int C_Q = 0, C_KC = 512, C_VC = 640, C_KS = 768, C_VS = 896, C_KW = 1024, C_VW = 1152, C_GT = 1280, C_CB = 1304, C_CC = 1816, C_CH = 2328;
constexpr int NCMP = 127;
constexpr int NEXP = 16384;
constexpr float EPS = 1e-6f;
constexpr int NTHREADS = 512, NWAVES = 8;

constexpr size_t al256(size_t x) { return (x + 255) & ~(size_t)255; }
constexpr size_t WS_CTL   = 0;                                   constexpr size_t CTL_BYTES = 65536;
constexpr size_t WS_MOD   = WS_CTL + CTL_BYTES;
constexpr size_t WS_WIN   = al256(WS_MOD + (size_t)16 * 6144 * 4);
constexpr size_t WS_WOUT  = al256(WS_WIN + (size_t)NPAD * D * 2);
constexpr size_t WS_WQ    = al256(WS_WOUT + (size_t)D * D * 2);
constexpr size_t WS_KEYS  = al256(WS_WQ + (size_t)D * D * 2);
constexpr size_t WS_UB    = al256(WS_KEYS + (size_t)16 * 128 * 64 * 2);
constexpr size_t WS_VB    = al256(WS_UB + (size_t)NEXP * D * 2);
constexpr size_t WS_KC    = al256(WS_VB + (size_t)NEXP * D * 2);
constexpr size_t WS_VC    = al256(WS_KC + (size_t)16 * 2 * 128 * 64 * 2);
constexpr size_t WS_H     = al256(WS_VC + (size_t)16 * 2 * 128 * 64 * 2);
constexpr size_t WS_OATT  = al256(WS_H + (size_t)T * D * 2);
constexpr size_t WS_PROJ  = al256(WS_OATT + (size_t)T * 512 * 2);
constexpr size_t WS_QP    = WS_PROJ;
constexpr size_t WS_EIDX  = al256(WS_QP + (size_t)T * D * 2);
constexpr size_t WS_EW    = al256(WS_EIDX + (size_t)T * 128 * 4);
constexpr size_t WS_END   = al256(WS_PROJ + (size_t)T * NPAD * 2);
static_assert(WS_EW + (size_t)T * 128 * 4 <= WS_END, "alias region");

constexpr int LDS_STAGE = 147456;
constexpr int LDS_MISC_OFF = LDS_STAGE;
constexpr int LDS_BYTES = LDS_STAGE + 256;

typedef unsigned short bf16_t;
__device__ __forceinline__ float bf2f(bf16_t b) { return __uint_as_float(((unsigned)b) << 16); }
__device__ __forceinline__ bf16_t f2bf(float f) { unsigned u = __float_as_uint(f); u += 0x7FFFu + ((u >> 16) & 1u); return (bf16_t)(u >> 16); }
__device__ __forceinline__ float bflo(unsigned w) { return __uint_as_float(w << 16); }
__device__ __forceinline__ float bfhi(unsigned w) { return __uint_as_float(w & 0xFFFF0000u); }
__device__ __forceinline__ unsigned pack2(float lo, float hi) { return (unsigned)f2bf(lo) | ((unsigned)f2bf(hi) << 16); }
__device__ __forceinline__ float gelu_tanh(float x) { const float u = 0.7978845608028654f * (x + 0.044715f * x * x * x); return 0.5f * x * (1.0f + tanhf(u)); }
__device__ __forceinline__ float sigmoidf_(float x) { return 1.0f / (1.0f + __expf(-x)); }
__device__ __forceinline__ float wave_sum(float v) {
#pragma unroll
    for (int o = 32; o >= 1; o >>= 1) v += __shfl_xor(v, o);
    return v; }
__device__ __forceinline__ float wave_max(float v) {
#pragma unroll
    for (int o = 32; o >= 1; o >>= 1) v = fmaxf(v, __shfl_xor(v, o));
    return v; }
__device__ __forceinline__ void lds_wave_sync() { asm volatile("s_waitcnt lgkmcnt(0)" ::: "memory"); }
__device__ __forceinline__ int rel_bucket(int dist) {
    const int n = dist > 0 ? dist : 0;
    if (n < 16) return n;
    const float lr = logf((float)n / 16.0f) / 2.0794415416798357f;
    const int large = 16 + (int)(lr * 16.0f);
    return large < 31 ? large : 31;
}

struct Frame {
    const float* in[23]; float* out; unsigned char* ws;
    LAS unsigned char* lds; int tid, lane, wave, G;
};

__device__ __forceinline__ void transpose_tile(const Frame& F, const float* src, int srcK, int srcN, bf16_t* dst, int dstK, int kt, int nt) {
    LAS float* tile = (LAS float*)F.lds;
    const int k0 = kt * 64, n0 = nt * 64;
    for (int i = F.tid; i < 4096; i += NTHREADS) { const int r = i >> 6, c = i & 63; const int k = k0 + r, n = n0 + c;
        tile[r * 65 + c] = (k < srcK && n < srcN) ? src[(size_t)k * srcN + n] : 0.0f; }
    __syncthreads();
    for (int i = F.tid; i < 4096; i += NTHREADS) { const int r = i >> 6, c = i & 63;
        dst[(size_t)(n0 + r) * dstK + k0 + c] = f2bf(tile[c * 65 + r]); }
    __syncthreads();
}
__device__ __forceinline__ void p0_prologue(const Frame& F) {
    const float* c = F.in[1]; const float* w_mod = F.in[4]; const float* b_mod = F.in[5];
    float* MOD = (float*)(F.ws + WS_MOD);
    constexpr int I_MOD = 192, I_WIN = 16 * 48, I_WOUT = 256, I_WQ = 256, I_U = 256, I_V = 256, I_KEYS = 2;
    constexpr int O_WIN = I_MOD, O_WOUT = O_WIN + I_WIN, O_WQ = O_WOUT + I_WOUT, O_U = O_WQ + I_WQ, O_V = O_U + I_U, O_KEYS = O_V + I_V, N_ITEMS = O_KEYS + I_KEYS;
    for (int it = blockIdx.x; it < N_ITEMS; it += F.G) {
        if (it < O_WIN) {
            const int idx = it * NTHREADS + F.tid; const int b = idx / 6144, j = idx % 6144;
            float acc = 0.f;
            for (int k = 0; k < D; ++k) { const float cv = c[b * D + k]; const float sv = cv / (1.0f + __expf(-cv)); acc += sv * w_mod[(size_t)k * 6144 + j]; }
            MOD[b * 6144 + j] = acc + b_mod[j];
        } else if (it < O_WOUT) { const int i = it - O_WIN; transpose_tile(F, F.in[6], D, NCOL, (bf16_t*)(F.ws + WS_WIN), D, i % 16, i / 16); }
        else if (it < O_WQ) { const int i = it - O_WOUT; transpose_tile(F, F.in[16], D, D, (bf16_t*)(F.ws + WS_WOUT), D, i % 16, i / 16); }
        else if (it < O_U) { const int i = it - O_WQ; transpose_tile(F, F.in[17], D, D, (bf16_t*)(F.ws + WS_WQ), D, i % 16, i / 16); }
        else if (it < O_KEYS) {
            const bool isv = it >= O_V; const int i = isv ? it - O_V : it - O_U;
            const float4* src = (const float4*)(isv ? F.in[20] : F.in[19]) + (size_t)i * 16384;
            uint2* dst = (uint2*)(F.ws + (isv ? WS_VB : WS_UB)) + (size_t)i * 16384;
            for (int q = F.tid; q < 16384; q += NTHREADS) { const float4 v = src[q]; dst[q] = make_uint2(pack2(v.x, v.y), pack2(v.z, v.w)); }
        } else {
            const int i = it - O_KEYS; const float4* src = (const float4*)F.in[18] + (size_t)i * 16384; uint2* dst = (uint2*)(F.ws + WS_KEYS) + (size_t)i * 16384;
            for (int q = F.tid; q < 16384; q += NTHREADS) { const float4 v = src[q]; dst[q] = make_uint2(pack2(v.x, v.y), pack2(v.z, v.w)); }
        }
    }
}

__device__ __forceinline__ void norm_mod_rows(const Frame& F, const float* x, const float* g, int sh_off, int sc_off, bf16_t* dst) {
    const float* MOD = (const float*)(F.ws + WS_MOD);
    const int gw = blockIdx.x * NWAVES + F.wave, nw = F.G * NWAVES;
    for (int t = gw; t < T; t += nw) {
        const int b = t / S; const float4* xr = (const float4*)(x + (size_t)t * D);
        float4 v[4]; float ss = 0.f;
#pragma unroll
        for (int i = 0; i < 4; ++i) { v[i] = xr[F.lane + 64 * i]; ss += v[i].x * v[i].x + v[i].y * v[i].y + v[i].z * v[i].z + v[i].w * v[i].w; }
        ss = wave_sum(ss); const float rstd = rsqrtf(ss * (1.0f / D) + EPS);
#pragma unroll
        for (int i = 0; i < 4; ++i) { const int col = (F.lane + 64 * i) * 4;
            const float4 gg = *(const float4*)(g + col), sc = *(const float4*)(MOD + b * 6144 + sc_off + col), sh = *(const float4*)(MOD + b * 6144 + sh_off + col);
            const float o0 = v[i].x * rstd * gg.x * (1.f + sc.x) + sh.x, o1 = v[i].y * rstd * gg.y * (1.f + sc.y) + sh.y, o2 = v[i].z * rstd * gg.z * (1.f + sc.z) + sh.z, o3 = v[i].w * rstd * gg.w * (1.f + sc.w) + sh.w;
            *(uint2*)(dst + (size_t)t * D + col) = make_uint2(pack2(o0, o1), pack2(o2, o3)); }
    }
}

__device__ __forceinline__ void p3_compress_naive(const Frame& F) {
    const bf16_t* PROJ = (const bf16_t*)(F.ws + WS_PROJ);
    LAS float* hid = (LAS float*)F.lds + F.wave * 64;
    const int gw = blockIdx.x * NWAVES + F.wave, nw = F.G * NWAVES;
    if (gw < 64) { bf16_t* dz = (bf16_t*)(F.ws + ((gw & 1) ? WS_VC : WS_KC)); dz[((size_t)(gw >> 1) * 128 + 127) * 64 + F.lane] = 0; }
    for (int u = gw; u < NB * NCMP * 2 * 2; u += nw) {
        const int kv = u & 1, g = (u >> 1) & 1, n = (u >> 2) % NCMP, b = (u >> 2) / NCMP;
        const float* pe = kv ? F.in[8] : F.in[7]; const float* w1 = kv ? F.in[11] : F.in[9]; const float* w2 = kv ? F.in[12] : F.in[10];
        const int cbase = (kv ? C_VC : C_KC) + g * 64;
        float acc = 0.f;
        for (int l = 0; l < 32; ++l) {
            const bf16_t* row = PROJ + (size_t)(b * S + 16 * n + l) * NPAD + cbase;
            for (int d = 0; d < 64; ++d) { const float a = bf2f(row[d]) + pe[l * 64 + d]; acc += a * w1[(size_t)(l * 64 + d) * 64 + F.lane]; }
        }
        hid[F.lane] = gelu_tanh(acc); lds_wave_sync();
        float o = 0.f;
        for (int j = 0; j < 64; ++j) o += hid[j] * w2[j * 64 + F.lane];
        bf16_t* dst = (bf16_t*)(F.ws + (kv ? WS_VC : WS_KC)); dst[((size_t)(b * 2 + g) * 128 + n) * 64 + F.lane] = f2bf(o);
        lds_wave_sync();
    }
}

__device__ __forceinline__ void dot4_row(const bf16_t* krow, const LAS float* qs, float (&acc)[4]) {
    const uint4* kr = (const uint4*)krow;
#pragma unroll 1
    for (int c = 0; c < 8; ++c) { asm volatile("" ::: "memory"); const uint4 w = kr[c]; const unsigned ww[4] = {w.x, w.y, w.z, w.w};
#pragma unroll
        for (int e = 0; e < 4; ++e) { const float k0 = bflo(ww[e]), k1 = bfhi(ww[e]); const int d = c * 8 + e * 2;
#pragma unroll
            for (int r = 0; r < 4; ++r) acc[r] += qs[r * 64 + d] * k0 + qs[r * 64 + d + 1] * k1; } }
}
__device__ __forceinline__ void p4_attn_naive(const Frame& F) {
    const bf16_t* PROJ = (const bf16_t*)(F.ws + WS_PROJ); const bf16_t* KC = (const bf16_t*)(F.ws + WS_KC); const bf16_t* VC = (const bf16_t*)(F.ws + WS_VC);
    bf16_t* OATT = (bf16_t*)(F.ws + WS_OATT); const float* rel = F.in[21];
    LAS float* wl = (LAS float*)F.lds + F.wave * (256 + 512 + 2048 + 16);
    LAS float* qs = wl; LAS float* pc = wl + 256; LAS float* ps = wl + 768; LAS int* pbase = (LAS int*)(wl + 768 + 2048);
    const int gw = blockIdx.x * NWAVES + F.wave, nw = F.G * NWAVES, lane = F.lane;
    for (int u = gw; u < T * 2; u += nw) {
        const int g = u & 1, tok = u >> 1, b = tok / S, t = tok % S;
        const bf16_t* prow = PROJ + (size_t)tok * NPAD;
#pragma unroll
        for (int r = 0; r < 4; ++r) qs[r * 64 + lane] = bf2f(prow[C_Q + (g * 4 + r) * 64 + lane]) * 0.125f;
        lds_wave_sync();
        const int nv = t >= 31 ? ((t - 31) >> 4) + 1 : 0;
        float sc[2][4]; bool va[2];
#pragma unroll
        for (int i = 0; i < 2; ++i) { const int n = lane + 64 * i; va[i] = n < nv; float a[4] = {0.f, 0.f, 0.f, 0.f};
            if (va[i]) { dot4_row(KC + ((size_t)(b * 2 + g) * 128 + n) * 64, qs, a); const int bk = rel_bucket(t - (16 * n + 31));
#pragma unroll
                for (int r = 0; r < 4; ++r) a[r] += rel[bk * 8 + g * 4 + r]; }
#pragma unroll
            for (int r = 0; r < 4; ++r) sc[i][r] = va[i] ? a[r] : -1e30f; }
        float ocmp[4];
#pragma unroll
        for (int r = 0; r < 4; ++r) { const float m = wave_max(fmaxf(sc[0][r], sc[1][r]));
            const float e0 = va[0] ? __expf(sc[0][r] - m) : 0.f, e1 = va[1] ? __expf(sc[1][r] - m) : 0.f; const float sum = wave_sum(e0 + e1);
            const float inv = nv > 0 ? 1.0f / sum : 0.f; pc[r * 128 + lane] = e0 * inv; pc[r * 128 + 64 + lane] = e1 * inv; }
        lds_wave_sync();
        { float o[4] = {0.f, 0.f, 0.f, 0.f}; const bf16_t* vb = VC + ((size_t)(b * 2 + g) * 128) * 64 + lane;
            for (int n = 0; n < nv; ++n) { const float v = bf2f(vb[n * 64]);
#pragma unroll
                for (int r = 0; r < 4; ++r) o[r] += pc[r * 128 + n] * v; }
#pragma unroll
            for (int r = 0; r < 4; ++r) ocmp[r] = o[r]; }
        const int cur = t >> 6; float val;
        { const int j = lane & 31; float imp = 0.f;
#pragma unroll
            for (int r = 0; r < 4; ++r) for (int n = 4 * j - 1; n <= 4 * j + 3; ++n) if (n >= 0 && n < NCMP) imp += pc[r * 128 + n];
            const bool forced = (j == 0) || (j == cur) || (j == cur - 1); const bool allowed = j <= cur;
            val = forced ? 1e4f : (allowed ? imp : -INFINITY); }
        int rank = 0;
        for (int jp = 0; jp < 32; ++jp) { const float vp = __shfl(val, jp); rank += ((vp > val) || (vp == val && jp < (lane & 31))) ? 1 : 0; }
        unsigned selmask = (unsigned)(__ballot(lane < 32 && rank < 8) & 0xFFFFFFFFull);
        float oslc[4], owin[4];
#pragma unroll
        for (int br = 0; br < 2; ++br) {
            const int ck = br == 0 ? C_KS : C_KW, cv = br == 0 ? C_VS : C_VW;
            unsigned mk = selmask;
#pragma unroll 1
            for (int c = 0; c < 8; ++c) {
                int kpos, bs;
                if (br == 0) { const int j = __builtin_ctz(mk | 0x80000000u); mk &= mk - 1; bs = 64 * j; } else { bs = t - 511 + 64 * c; }
                kpos = bs + lane; if (lane == 0) pbase[c] = bs;
                const int dist = t - kpos; const bool vv = (dist >= 0) && (kpos >= 0) && (kpos < S);
                float a[4] = {0.f, 0.f, 0.f, 0.f};
                if (vv) { dot4_row(PROJ + (size_t)(b * S + kpos) * NPAD + ck + g * 64, qs, a); const int bk = rel_bucket(dist);
#pragma unroll
                    for (int r = 0; r < 4; ++r) a[r] += rel[bk * 8 + g * 4 + r]; }
#pragma unroll
                for (int r = 0; r < 4; ++r) ps[r * 512 + c * 64 + lane] = vv ? a[r] : -1e30f;
            }
            lds_wave_sync();
#pragma unroll 1
            for (int r = 0; r < 4; ++r) { float m = -1e30f;
#pragma unroll
                for (int c = 0; c < 8; ++c) m = fmaxf(m, ps[r * 512 + c * 64 + lane]);
                m = wave_max(m); float e[8], sum = 0.f;
#pragma unroll
                for (int c = 0; c < 8; ++c) { const float sv = ps[r * 512 + c * 64 + lane]; e[c] = sv > -1e29f ? __expf(sv - m) : 0.f; sum += e[c]; }
                sum = wave_sum(sum); const float inv = sum > 0.f ? 1.0f / sum : 0.f;
#pragma unroll
                for (int c = 0; c < 8; ++c) ps[r * 512 + c * 64 + lane] = e[c] * inv; }
            lds_wave_sync();
            float o[4] = {0.f, 0.f, 0.f, 0.f};
#pragma unroll 1
            for (int c = 0; c < 8; ++c) {
                const int bsc = pbase[c];
                for (int kk = 0; kk < 64; ++kk) { const int kpos = bsc + kk; if (kpos < 0 || kpos > t) continue;
                    const float v = bf2f(PROJ[(size_t)(b * S + kpos) * NPAD + cv + g * 64 + lane]);
#pragma unroll
                    for (int r = 0; r < 4; ++r) o[r] += ps[r * 512 + c * 64 + kk] * v; } }
            lds_wave_sync();
#pragma unroll
            for (int r = 0; r < 4; ++r) { if (br == 0) oslc[r] = o[r]; else owin[r] = o[r]; }
        }
#pragma unroll
        for (int r = 0; r < 4; ++r) { const int h = g * 4 + r;
            const float g0 = sigmoidf_(bf2f(prow[C_GT + h * 3 + 0])), g1 = sigmoidf_(bf2f(prow[C_GT + h * 3 + 1])), g2 = sigmoidf_(bf2f(prow[C_GT + h * 3 + 2]));
            OATT[(size_t)tok * 512 + h * 64 + lane] = f2bf(g0 * ocmp[r] + g1 * oslc[r] + g2 * owin[r]); }
    }
}


typedef short bf16x8 __attribute__((ext_vector_type(8)));
typedef short s16x4 __attribute__((ext_vector_type(4)));
typedef float f32x4 __attribute__((ext_vector_type(4)));
typedef unsigned u32x4v __attribute__((ext_vector_type(4)));
constexpr float LOG2E = 1.4426950408889634f;
constexpr int AT_KC = 0, AT_VC = 16384, AT_KV = 32768  , AT_BTAB = 65536, AT_IMP = 69888, AT_SEL = 78336, AT_OUT = 78592  , AT_END = 78592 + 65536;
constexpr int BT_STRIDE = 132;
__device__ __forceinline__ int tile_off(int row, int chunk) { return row * 128 + ((chunk ^ (row & 7)) << 4); }
__device__ __forceinline__ bf16x8 mk_frag(unsigned a, unsigned b, unsigned c, unsigned d) { u32x4v v = {a, b, c, d}; return __builtin_bit_cast(bf16x8, v); }
struct LaneOffs { int koff[2]; int voff[4]; int soff; };
__device__ __forceinline__ LaneOffs lane_offs(int lane, int tid) {
    LaneOffs L; const int grp = lane >> 4, rowi = lane & 15, q4 = rowi >> 2, p = lane & 3;
#pragma unroll
    for (int ks = 0; ks < 2; ++ks) L.koff[ks] = tile_off(rowi, ks * 4 + grp);
#pragma unroll
    for (int dt = 0; dt < 4; ++dt) L.voff[dt] = tile_off(4 * grp + q4, 2 * dt + (p >> 1)) + 8 * (p & 1);
    L.soff = tile_off(tid >> 3, tid & 7); return L;
}
__device__ __forceinline__ bf16x8 vfrag_read(const LAS unsigned char* vt, int voff_dt, int row0) {
    const s16x4 a = __builtin_amdgcn_ds_read_tr16_b64_v4i16((LAS s16x4*)(vt + voff_dt + row0 * 128));
    const s16x4 b = __builtin_amdgcn_ds_read_tr16_b64_v4i16((LAS s16x4*)(vt + voff_dt + row0 * 128 + 2048));
    bf16x8 f = {a[0], a[1], a[2], a[3], b[0], b[1], b[2], b[3]}; return f;
}

struct AttnState {
    f32x4 o[4][2]; float m[2], l[2];
};

template <int BR>
__device__ __forceinline__ void attn_tile(const LAS unsigned char* kt_lds, const LAS unsigned char* vt_lds, const LAS float* btab_h, const bf16x8 (&qf)[2][2], const int (&tq)[2], const unsigned (&sel)[2],
                                          int j, bool near, AttnState& st, int lane, const LaneOffs& L) {
    const int grp = lane >> 4, kbase = 64 * j;
    f32x4 sacc[4][2];
#pragma unroll
    for (int kt = 0; kt < 4; ++kt) { sacc[kt][0] = (f32x4){0.f, 0.f, 0.f, 0.f}; sacc[kt][1] = (f32x4){0.f, 0.f, 0.f, 0.f}; }
#pragma unroll
    for (int kt = 0; kt < 4; ++kt)
#pragma unroll
        for (int ks = 0; ks < 2; ++ks) { const bf16x8 kf = *(const LAS bf16x8*)(kt_lds + L.koff[ks] + kt * 2048);
            sacc[kt][0] = __builtin_amdgcn_mfma_f32_16x16x32_bf16(kf, qf[0][ks], sacc[kt][0], 0, 0, 0);
            sacc[kt][1] = __builtin_amdgcn_mfma_f32_16x16x32_bf16(kf, qf[1][ks], sacc[kt][1], 0, 0, 0); }
    __builtin_amdgcn_sched_barrier(0);
    const float SC = 0.125f * LOG2E; const float bfar = btab_h[128];
    bf16x8 pf[2][2];
#pragma unroll
    for (int qt = 0; qt < 2; ++qt) {
        const int t = tq[qt]; const bool selq = BR == 0 ? ((sel[qt] >> j) & 1u) != 0u : true;
        float sv[4][4]; float tmax = -1e30f;
        int d0 = t - 4 * grp - kbase; asm volatile("" : "+v"(d0));
        if (near) {
#pragma unroll
            for (int kt = 0; kt < 4; ++kt)
#pragma unroll
                for (int rg = 0; rg < 4; ++rg) { const int dist = d0 - (kt * 16 + rg); const int dd = dist < 0 ? 0 : (dist > 128 ? 128 : dist); sv[kt][rg] = btab_h[dd]; }
        } else {
#pragma unroll
            for (int kt = 0; kt < 4; ++kt)
#pragma unroll
                for (int rg = 0; rg < 4; ++rg) sv[kt][rg] = bfar;
        }
#pragma unroll
        for (int kt = 0; kt < 4; ++kt)
#pragma unroll
            for (int rg = 0; rg < 4; ++rg) { const int c = kt * 16 + rg;
                const bool valid = BR == 0 ? (selq && d0 >= c) : (d0 >= c && d0 < 512 + c);
                const float sx = sacc[kt][qt][rg] * SC + sv[kt][rg]; const float s = valid ? sx : -1e30f; sv[kt][rg] = s; tmax = fmaxf(tmax, s); }
        tmax = fmaxf(tmax, __shfl_xor(tmax, 16)); tmax = fmaxf(tmax, __shfl_xor(tmax, 32));
        const float mnew = fmaxf(st.m[qt], tmax); const float alpha = __builtin_amdgcn_exp2f(st.m[qt] - mnew); st.m[qt] = mnew;
        const float muse = mnew < -1e29f ? 0.f : mnew;
        float ls = 0.f; unsigned pk[4][2];
#pragma unroll
        for (int kt = 0; kt < 4; ++kt) { float e[4];
#pragma unroll
            for (int rg = 0; rg < 4; ++rg) { e[rg] = __builtin_amdgcn_exp2f(sv[kt][rg] - muse); ls += e[rg]; }
            pk[kt][0] = pg8::cvt_pk_bf16(e[0], e[1]); pk[kt][1] = pg8::cvt_pk_bf16(e[2], e[3]); }
        st.l[qt] = st.l[qt] * alpha + ls;
#pragma unroll
        for (int dt = 0; dt < 4; ++dt) st.o[dt][qt] *= alpha;
        pf[qt][0] = mk_frag(pk[0][0], pk[0][1], pk[1][0], pk[1][1]); pf[qt][1] = mk_frag(pk[2][0], pk[2][1], pk[3][0], pk[3][1]);
        __builtin_amdgcn_sched_barrier(0);
    }
#pragma unroll
    for (int ks = 0; ks < 2; ++ks)
#pragma unroll
        for (int dt = 0; dt < 4; ++dt) { const bf16x8 vf = vfrag_read(vt_lds, L.voff[dt], 32 * ks);
            st.o[dt][0] = __builtin_amdgcn_mfma_f32_16x16x32_bf16(vf, pf[0][ks], st.o[dt][0], 0, 0, 0);
            st.o[dt][1] = __builtin_amdgcn_mfma_f32_16x16x32_bf16(vf, pf[1][ks], st.o[dt][1], 0, 0, 0); }
}

template <int BR>
__device__ __forceinline__ void attn_branch(const Frame& F, const bf16_t* PROJ, int b, int g, int t0, unsigned tiles  , const LAS float* btab_h,
                                            const bf16x8 (&qf)[2][2], const int (&tq)[2], const unsigned (&sel)[2], const float (&gate)[2], const LaneOffs& L) {
    const int lane = F.lane, tid = F.tid;
    const int ck = (BR == 0 ? C_KS : C_KW) + g * 64, cv = (BR == 0 ? C_VS : C_VW) + g * 64;
    const int srow = tid >> 3, sch = tid & 7;
    AttnState st;
#pragma unroll
    for (int dt = 0; dt < 4; ++dt) { st.o[dt][0] = (f32x4){0.f, 0.f, 0.f, 0.f}; st.o[dt][1] = (f32x4){0.f, 0.f, 0.f, 0.f}; }
    st.m[0] = st.m[1] = -1e30f; st.l[0] = st.l[1] = 0.f;
    unsigned rem = tiles; int cur = 0;
    u32x4v rk, rv;
    { const int j = __builtin_ctz(rem); const bf16_t* rowp = PROJ + (size_t)(b * S + 64 * j + srow) * NPAD + sch * 8;
        rk = *(const u32x4v*)(rowp + ck); rv = *(const u32x4v*)(rowp + cv);
        *(LAS u32x4v*)(F.lds + AT_KV + L.soff) = rk; *(LAS u32x4v*)(F.lds + AT_KV + 8192 + L.soff) = rv; }
    __syncthreads();
    while (rem) {
        const int j = __builtin_ctz(rem); rem &= rem - 1;
        const bool has_next = rem != 0u;
        if (has_next) { const int jn = __builtin_ctz(rem); const bf16_t* rowp = PROJ + (size_t)(b * S + 64 * jn + srow) * NPAD + sch * 8; rk = *(const u32x4v*)(rowp + ck); rv = *(const u32x4v*)(rowp + cv); }
        const bool near = (t0 + 8 * F.wave) - (64 * j + 63) < 128;
        attn_tile<BR>(F.lds + AT_KV + cur * 16384, F.lds + AT_KV + cur * 16384 + 8192, btab_h, qf, tq, sel, j, near, st, lane, L);
        if (has_next) { *(LAS u32x4v*)(F.lds + AT_KV + (cur ^ 1) * 16384 + L.soff) = rk; *(LAS u32x4v*)(F.lds + AT_KV + (cur ^ 1) * 16384 + 8192 + L.soff) = rv; }
        __syncthreads();
        cur ^= 1;
    }
    int pob = AT_OUT + tid * 4; asm volatile("" : "+v"(pob));
    LAS float* po = (LAS float*)(F.lds + pob);
#pragma unroll
    for (int qt = 0; qt < 2; ++qt) { float l = st.l[qt]; l += __shfl_xor(l, 16); l += __shfl_xor(l, 32); const float sc = l > 0.f ? gate[qt] / l : 0.f;
#pragma unroll
        for (int dt = 0; dt < 4; ++dt)
#pragma unroll
            for (int e = 0; e < 4; ++e) po[((qt * 4 + dt) * 4 + e) * 512] += st.o[dt][qt][e] * sc; }
}

__device__ __forceinline__ void p4_attn_mfma(const Frame& F) {
    const bf16_t* PROJ = (const bf16_t*)(F.ws + WS_PROJ); const bf16_t* KC = (const bf16_t*)(F.ws + WS_KC); const bf16_t* VC = (const bf16_t*)(F.ws + WS_VC);
    bf16_t* OATT = (bf16_t*)(F.ws + WS_OATT); const float* rel = F.in[21];
    const int lane = F.lane, tid = F.tid, wave = F.wave, grp = lane >> 4, col = lane & 15, qi = col >> 2, r = col & 3;
    LAS float* btab = (LAS float*)(F.lds + AT_BTAB); LAS float* impq = (LAS float*)(F.lds + AT_IMP); LAS unsigned* selm = (LAS unsigned*)(F.lds + AT_SEL);
    const LaneOffs L = lane_offs(lane, tid);
    for (int i = tid; i < 8 * 129; i += NTHREADS) { const int hh = i / 129, dd = i % 129; btab[hh * BT_STRIDE + dd] = rel[rel_bucket(dd) * 8 + hh] * LOG2E; }
    __syncthreads();
    for (int uu = blockIdx.x; uu < 1024; uu += F.G) {
        int sidx = uu;
        if (F.G == 256) { const int round = uu >> 8, k = uu & 255; sidx = (round == 0) ? k : (round == 1) ? 511 - k : (round == 2) ? 512 + k : 1023 - k; }
        const int qb = 31 - (sidx >> 5), bg = sidx & 31, b = bg >> 1, g = bg & 1, t0 = qb * 64, h = g * 4 + r;
        const LAS float* btab_h = btab + h * BT_STRIDE;
        int tq[2]; bf16x8 qf[2][2]; float gate[3][2];
#pragma unroll
        for (int qt = 0; qt < 2; ++qt) { tq[qt] = t0 + 8 * wave + 4 * qt + qi; const bf16_t* prow = PROJ + (size_t)(b * S + tq[qt]) * NPAD;
#pragma unroll
            for (int ks = 0; ks < 2; ++ks) qf[qt][ks] = *(const bf16x8*)(prow + C_Q + h * 64 + ks * 32 + 8 * grp);
#pragma unroll
            for (int jg = 0; jg < 3; ++jg) gate[jg][qt] = sigmoidf_(bf2f(prow[C_GT + h * 3 + jg])); }
#pragma unroll
        for (int i = 0; i < 2; ++i) { const int c2 = tid + 512 * i, row = c2 >> 3, ch = c2 & 7; const size_t src = ((size_t)(b * 2 + g) * 128 + row) * 64 + ch * 8;
            *(LAS u32x4v*)(F.lds + AT_KC + L.soff + 8192 * i) = *(const u32x4v*)(KC + src); *(LAS u32x4v*)(F.lds + AT_VC + L.soff + 8192 * i) = *(const u32x4v*)(VC + src); }
        __syncthreads();
#ifndef AT_SKIP_CMP
        {
            const int nvmax = t0 + 63 >= 31 ? ((t0 + 63 - 31) >> 4) + 1 : 0;
            const float SC = 0.125f * LOG2E; const int srcl = (lane + 48) & 63;
            int pob = AT_OUT + tid * 4; asm volatile("" : "+v"(pob));
            LAS float* po = (LAS float*)(F.lds + pob);
#pragma unroll
            for (int qt = 0; qt < 2; ++qt) {
                f32x4 sa[8];
#pragma unroll
                for (int kt = 0; kt < 8; ++kt) sa[kt] = (f32x4){0.f, 0.f, 0.f, 0.f};
#pragma unroll
                for (int kt = 0; kt < 8; ++kt) if (kt * 16 < nvmax) {
#pragma unroll
                    for (int ks = 0; ks < 2; ++ks) { const bf16x8 kf = *(const LAS bf16x8*)(F.lds + AT_KC + L.koff[ks] + kt * 2048);
                        sa[kt] = __builtin_amdgcn_mfma_f32_16x16x32_bf16(kf, qf[qt][ks], sa[kt], 0, 0, 0); } }
                __builtin_amdgcn_sched_barrier(0);
                int d0 = tq[qt] - 31 - 64 * grp; asm volatile("" : "+v"(d0));
                float mx = -1e30f;
#pragma unroll
                for (int kt = 0; kt < 8; ++kt)
#pragma unroll
                    for (int rg = 0; rg < 4; ++rg) { const int c = 256 * kt + 16 * rg; const int dist = d0 - c; const int dd = dist < 0 ? 0 : (dist > 128 ? 128 : dist);
                        const float sx = sa[kt][rg] * SC + btab_h[dd]; const float s = d0 >= c ? sx : -1e30f; sa[kt][rg] = s; mx = fmaxf(mx, s); }
                mx = fmaxf(mx, __shfl_xor(mx, 16)); mx = fmaxf(mx, __shfl_xor(mx, 32));
                float sum = 0.f;
#pragma unroll
                for (int kt = 0; kt < 8; ++kt)
#pragma unroll
                    for (int rg = 0; rg < 4; ++rg) { const int c = 256 * kt + 16 * rg; const float ex = __builtin_amdgcn_exp2f(sa[kt][rg] - mx); const float e = d0 >= c ? ex : 0.f; sa[kt][rg] = e; sum += e; }
                __builtin_amdgcn_sched_barrier(0);
                sum += __shfl_xor(sum, 16); sum += __shfl_xor(sum, 32);
                const float inv = sum > 0.f ? 1.0f / sum : 0.f;
                float prev3 = 0.f;
#pragma unroll
                for (int kt = 0; kt < 8; ++kt) { const float p3 = sa[kt][3] * inv; const float part = (sa[kt][0] * inv + sa[kt][1] * inv) + (sa[kt][2] * inv + p3);
                    const float xa = __shfl(p3, srcl), xb = __shfl(prev3, srcl); float tot = part + (grp >= 1 ? xa : xb);
                    tot += __shfl_xor(tot, 1); tot += __shfl_xor(tot, 2);
                    if (r == 0) impq[(8 * wave + 4 * qt + qi) * 33 + 4 * kt + grp] = tot;
                    prev3 = p3; }
                __builtin_amdgcn_sched_barrier(0);
                f32x4 oc[4];
#pragma unroll
                for (int dt = 0; dt < 4; ++dt) oc[dt] = (f32x4){0.f, 0.f, 0.f, 0.f};
#pragma unroll
                for (int ks = 0; ks < 4; ++ks) if (ks * 32 < nvmax) {
                    const bf16x8 pfr = mk_frag(pg8::cvt_pk_bf16(sa[2 * ks][0], sa[2 * ks][1]), pg8::cvt_pk_bf16(sa[2 * ks][2], sa[2 * ks][3]),
                                               pg8::cvt_pk_bf16(sa[2 * ks + 1][0], sa[2 * ks + 1][1]), pg8::cvt_pk_bf16(sa[2 * ks + 1][2], sa[2 * ks + 1][3]));
#pragma unroll
                    for (int dt = 0; dt < 4; ++dt) { const bf16x8 vf = vfrag_read(F.lds + AT_VC, L.voff[dt], 32 * ks); oc[dt] = __builtin_amdgcn_mfma_f32_16x16x32_bf16(vf, pfr, oc[dt], 0, 0, 0); } }
                const float scq = inv * gate[0][qt];
#pragma unroll
                for (int dt = 0; dt < 4; ++dt)
#pragma unroll
                    for (int e = 0; e < 4; ++e) po[((qt * 4 + dt) * 4 + e) * 512] = oc[dt][e] * scq;
                __builtin_amdgcn_sched_barrier(0);
            }
        }
#endif
        __syncthreads();
#ifndef AT_SKIP_SEL
        {
            const int q = tid >> 3, jj = tid & 7, cur = qb; unsigned bits = 0u;
            float vj[4];
#pragma unroll
            for (int e = 0; e < 4; ++e) { const int j = jj * 4 + e; const bool forced = (j == 0) || (j == cur) || (j == cur - 1); vj[e] = forced ? 1e4f : (j <= cur ? impq[q * 33 + j] : -INFINITY); }
            int rk[4] = {0, 0, 0, 0};
            for (int jp = 0; jp < 32; ++jp) { const bool forced = (jp == 0) || (jp == cur) || (jp == cur - 1); const float vp = forced ? 1e4f : (jp <= cur ? impq[q * 33 + jp] : -INFINITY);
#pragma unroll
                for (int e = 0; e < 4; ++e) rk[e] += ((vp > vj[e]) || (vp == vj[e] && jp < jj * 4 + e)) ? 1 : 0; }
#pragma unroll
            for (int e = 0; e < 4; ++e) bits |= (rk[e] < 8 ? 1u : 0u) << (jj * 4 + e);
            bits |= __shfl_xor(bits, 1); bits |= __shfl_xor(bits, 2); bits |= __shfl_xor(bits, 4);
            if (jj == 0) selm[q] = bits;
        }
#endif
        __syncthreads();
        unsigned sel[2] = {selm[8 * wave + qi], selm[8 * wave + 4 + qi]};
        unsigned un = selm[lane];
#pragma unroll
        for (int o = 32; o >= 1; o >>= 1) un |= __shfl_xor(un, o);
        un = __builtin_amdgcn_readfirstlane(un);
        const unsigned causal = qb == 31 ? 0xFFFFFFFFu : ((2u << qb) - 1u);
#ifndef AT_SKIP_BR0
        { const float gt1[2] = {gate[1][0], gate[1][1]}; attn_branch<0>(F, PROJ, b, g, t0, un & causal, btab_h, qf, tq, sel, gt1, L); }
#endif
#ifndef AT_SKIP_BR1
        { const int jlo = qb >= 8 ? qb - 8 : 0; const unsigned wmask = causal & ~((1u << jlo) - 1u); const float gt2[2] = {gate[2][0], gate[2][1]};
            attn_branch<1>(F, PROJ, b, g, t0, wmask, btab_h, qf, tq, sel, gt2, L); }
#endif
        int pob2 = AT_OUT + tid * 4; asm volatile("" : "+v"(pob2));
#pragma unroll
        for (int qt = 0; qt < 2; ++qt) { bf16_t* orow = OATT + (size_t)(b * S + tq[qt]) * 512 + h * 64 + 4 * grp;
#pragma unroll
            for (int dt = 0; dt < 4; ++dt) { const LAS float* po = (const LAS float*)(F.lds + pob2) + (qt * 4 + dt) * 4 * 512;
                *(uint2*)(orow + dt * 16) = make_uint2(pg8::cvt_pk_bf16(po[0], po[512]), pg8::cvt_pk_bf16(po[1024], po[1536])); } }
    }
}
__device__ __forceinline__ void p5_mixed(const Frame& F) {
    const bf16_t* PROJ = (const bf16_t*)(F.ws + WS_PROJ); const bf16_t* OATT = (const bf16_t*)(F.ws + WS_OATT); bf16_t* MIX = (bf16_t*)(F.ws + WS_H);
    const float* cw = F.in[13]; const float* ga = F.in[14]; const float* gc = F.in[15];
    const int gw = blockIdx.x * NWAVES + F.wave, nw = F.G * NWAVES, lane = F.lane;
    for (int tok = gw; tok < T; tok += nw) {
        const int s = tok % S; const int c0 = lane * 8;
        float a[8], y[8];
        { const uint4 w = *(const uint4*)(OATT + (size_t)tok * 512 + c0); const unsigned ww[4] = {w.x, w.y, w.z, w.w};
#pragma unroll
            for (int e = 0; e < 4; ++e) { a[2 * e] = bflo(ww[e]); a[2 * e + 1] = bfhi(ww[e]); } }
#pragma unroll
        for (int e = 0; e < 8; ++e) y[e] = 0.f;
#pragma unroll
        for (int dt = 0; dt < 3; ++dt) { if (s - 2 + dt >= 0) { const bf16_t* row = PROJ + (size_t)(tok - 2 + dt) * NPAD;
                const uint4 wc = *(const uint4*)(row + C_CC + c0), wh = *(const uint4*)(row + C_CH + c0); const unsigned c4[4] = {wc.x, wc.y, wc.z, wc.w}, h4[4] = {wh.x, wh.y, wh.z, wh.w};
#pragma unroll
                for (int e = 0; e < 4; ++e) { y[2 * e] += cw[dt * 512 + c0 + 2 * e] * (bflo(c4[e]) * bflo(h4[e])); y[2 * e + 1] += cw[dt * 512 + c0 + 2 * e + 1] * (bfhi(c4[e]) * bfhi(h4[e])); } } }
        { const uint4 wb = *(const uint4*)(PROJ + (size_t)tok * NPAD + C_CB + c0); const unsigned b4[4] = {wb.x, wb.y, wb.z, wb.w};
#pragma unroll
            for (int e = 0; e < 4; ++e) { y[2 * e] *= bflo(b4[e]); y[2 * e + 1] *= bfhi(b4[e]); } }
        float sa = 0.f, sy = 0.f;
#pragma unroll
        for (int e = 0; e < 8; ++e) { sa += a[e] * a[e]; sy += y[e] * y[e]; }
        sa = wave_sum(sa); sy = wave_sum(sy);
        const float ra = rsqrtf(sa * (1.0f / 512) + EPS), ry = rsqrtf(sy * (1.0f / 512) + EPS);
        unsigned oa[4], oy[4];
#pragma unroll
        for (int e = 0; e < 4; ++e) { oa[e] = pack2(a[2 * e] * ra * ga[c0 + 2 * e], a[2 * e + 1] * ra * ga[c0 + 2 * e + 1]); oy[e] = pack2(y[2 * e] * ry * gc[c0 + 2 * e], y[2 * e + 1] * ry * gc[c0 + 2 * e + 1]); }
        *(uint4*)(MIX + (size_t)tok * D + c0) = make_uint4(oa[0], oa[1], oa[2], oa[3]);
        *(uint4*)(MIX + (size_t)tok * D + 512 + c0) = make_uint4(oy[0], oy[1], oy[2], oy[3]);
    }
}

struct EpiResGate {
    static constexpr bool PERM = false, AFTER_DRAIN = false;
    float* C; const float* X; const float* MOD; int gate_off;
    __device__ __forceinline__ void operator()(const pg8::f32x4 (&acc)[2][2][4][2], const pg8::Unit& u, int wr, int wc, int fr, int fq) const {
        using pg8::f32x4; using pg8::HALF; using pg8::BM;
        const int row0 = u.pm * BM + wr * 64 + fr, col0 = u.pn * BM + wc * 32 + 4 * fq;
        const int b = (u.pm * BM) / S;
        f32x4 gv[2][2];
#pragma unroll
        for (int bj = 0; bj < 2; ++bj)
#pragma unroll
            for (int n = 0; n < 2; ++n) gv[bj][n] = *(const f32x4*)(MOD + b * 6144 + gate_off + col0 + bj * HALF + n * 16);
#pragma unroll
        for (int ai = 0; ai < 2; ++ai)
#pragma unroll
            for (int m = 0; m < 4; ++m) { const size_t ro = (size_t)(row0 + ai * HALF + m * 16) * D + col0;
#pragma unroll
                for (int bj = 0; bj < 2; ++bj)
#pragma unroll
                    for (int n = 0; n < 2; ++n) { const f32x4 xv = *(const f32x4*)(X + ro + bj * HALF + n * 16); *(f32x4*)(C + ro + bj * HALF + n * 16) = xv + gv[bj][n] * acc[ai][bj][m][n]; } }
    }
};

__device__ __forceinline__ void argmax_bfly(float& v, int& i) {
#pragma unroll
    for (int o = 32; o >= 1; o >>= 1) { const float ov = __shfl_xor(v, o); const int oi = __shfl_xor(i, o); if (ov > v || (ov == v && oi < i)) { v = ov; i = oi; } }
}
__device__ __forceinline__ void p9_route_naive(const Frame& F) {
    const bf16_t* QP = (const bf16_t*)(F.ws + WS_QP); const bf16_t* KEYS = (const bf16_t*)(F.ws + WS_KEYS);
    int* EIDX = (int*)(F.ws + WS_EIDX); float* EW = (float*)(F.ws + WS_EW);
    LAS float* ql = (LAS float*)F.lds + F.wave * 128;
    const int gw = blockIdx.x * NWAVES + F.wave, nw = F.G * NWAVES, lane = F.lane;
    for (int u = gw; u < T * 8; u += nw) {
        const int h = u & 7, tok = u >> 3;
        ql[lane] = bf2f(QP[(size_t)tok * D + h * 128 + lane]); ql[64 + lane] = bf2f(QP[(size_t)tok * D + h * 128 + 64 + lane]);
        lds_wave_sync();
        float tv[2]; int ti[2];
#pragma unroll
        for (int p = 0; p < 2; ++p) {
            float s[2];
#pragma unroll
            for (int kk = 0; kk < 2; ++kk) { const uint4* kr = (const uint4*)(KEYS + ((size_t)(h * 2 + p) * 128 + lane + 64 * kk) * 64); float a = 0.f;
#pragma unroll
                for (int c = 0; c < 8; ++c) { const uint4 w = kr[c]; const unsigned ww[4] = {w.x, w.y, w.z, w.w};
#pragma unroll
                    for (int e = 0; e < 4; ++e) a += ql[p * 64 + c * 8 + 2 * e] * bflo(ww[e]) + ql[p * 64 + c * 8 + 2 * e + 1] * bfhi(ww[e]); }
                s[kk] = a; }
            tv[p] = 0.f; ti[p] = 0;
            for (int i = 0; i < 16; ++i) {
                float v = s[0]; int ix = lane; if (s[1] > v) { v = s[1]; ix = lane + 64; }
                argmax_bfly(v, ix);
                if (lane == i) { tv[p] = v; ti[p] = ix; }
                if (ix == lane) s[0] = -INFINITY; if (ix == lane + 64) s[1] = -INFINITY;
            }
        }
        float cd[4];
        { const float va = __shfl(tv[0], lane >> 2);
#pragma unroll
            for (int i = 0; i < 4; ++i) cd[i] = va + __shfl(tv[1], (lane & 3) * 4 + i); }
        float cs = 0.f; int cc = 0;
        for (int it = 0; it < 16; ++it) {
            float v = cd[0]; int ix = lane * 4;
#pragma unroll
            for (int i = 1; i < 4; ++i) if (cd[i] > v) { v = cd[i]; ix = lane * 4 + i; }
            argmax_bfly(v, ix);
            if (lane == it) { cs = v; cc = ix; }
#pragma unroll
            for (int i = 0; i < 4; ++i) if (ix == lane * 4 + i) cd[i] = -INFINITY;
        }
        const int i1 = __shfl(ti[0], cc >> 4), i2 = __shfl(ti[1], cc & 15);
        const float m = __shfl(cs, 0); float ex = lane < 16 ? __expf(cs - m) : 0.f; const float sum = wave_sum(ex);
        if (lane < 16) { EIDX[(size_t)tok * 128 + h * 16 + lane] = i1 * 128 + i2; EW[(size_t)tok * 128 + h * 16 + lane] = ex / sum; }
        lds_wave_sync();
    }
}

__device__ __forceinline__ void p10_peer_naive(const Frame& F) {
    const bf16_t* H2 = (const bf16_t*)(F.ws + WS_H); const bf16_t* UB = (const bf16_t*)(F.ws + WS_UB); const bf16_t* VB = (const bf16_t*)(F.ws + WS_VB);
    const int* EIDX = (const int*)(F.ws + WS_EIDX); const float* EW = (const float*)(F.ws + WS_EW); const float* MOD = (const float*)(F.ws + WS_MOD);
    const float* gfin = F.in[22]; float* out = F.out;
    const int gw = blockIdx.x * NWAVES + F.wave, nw = F.G * NWAVES, lane = F.lane;
    for (int tok = gw; tok < T; tok += nw) {
        const int b = tok / S;
        float xr[16], acc[16];
#pragma unroll
        for (int hlf = 0; hlf < 2; ++hlf) { const uint4 w = *(const uint4*)(H2 + (size_t)tok * D + hlf * 512 + lane * 8); const unsigned ww[4] = {w.x, w.y, w.z, w.w};
#pragma unroll
            for (int e = 0; e < 4; ++e) { xr[hlf * 8 + 2 * e] = bflo(ww[e]); xr[hlf * 8 + 2 * e + 1] = bfhi(ww[e]); } }
#pragma unroll
        for (int e = 0; e < 16; ++e) acc[e] = 0.f;
        for (int i0 = 0; i0 < 128; i0 += 4) {
            int ei[4]; float wi[4], dt[4];
#pragma unroll
            for (int i = 0; i < 4; ++i) { ei[i] = __builtin_amdgcn_readfirstlane(EIDX[(size_t)tok * 128 + i0 + i]); wi[i] = EW[(size_t)tok * 128 + i0 + i]; }
#pragma unroll
            for (int i = 0; i < 4; ++i) { float d = 0.f;
#pragma unroll
                for (int hlf = 0; hlf < 2; ++hlf) { const uint4 w = *(const uint4*)(UB + (size_t)ei[i] * D + hlf * 512 + lane * 8); const unsigned ww[4] = {w.x, w.y, w.z, w.w};
#pragma unroll
                    for (int e = 0; e < 4; ++e) d += xr[hlf * 8 + 2 * e] * bflo(ww[e]) + xr[hlf * 8 + 2 * e + 1] * bfhi(ww[e]); }
                dt[i] = d; }
#pragma unroll
            for (int i = 0; i < 4; ++i) { const float dot = wave_sum(dt[i]); const float cf = wi[i] * gelu_tanh(dot);
#pragma unroll
                for (int hlf = 0; hlf < 2; ++hlf) { const uint4 w = *(const uint4*)(VB + (size_t)ei[i] * D + hlf * 512 + lane * 8); const unsigned ww[4] = {w.x, w.y, w.z, w.w};
#pragma unroll
                    for (int e = 0; e < 4; ++e) { acc[hlf * 8 + 2 * e] += cf * bflo(ww[e]); acc[hlf * 8 + 2 * e + 1] += cf * bfhi(ww[e]); } } }
        }
        float x2[16], ss = 0.f;
#pragma unroll
        for (int hlf = 0; hlf < 2; ++hlf)
#pragma unroll
            for (int q = 0; q < 2; ++q) { const int col = hlf * 512 + lane * 8 + q * 4; const float4 x1 = *(const float4*)(out + (size_t)tok * D + col); const float4 gt = *(const float4*)(MOD + b * 6144 + 5120 + col);
                const int e = hlf * 8 + q * 4;
                x2[e] = x1.x + gt.x * acc[e]; x2[e + 1] = x1.y + gt.y * acc[e + 1]; x2[e + 2] = x1.z + gt.z * acc[e + 2]; x2[e + 3] = x1.w + gt.w * acc[e + 3];
                ss += x2[e] * x2[e] + x2[e + 1] * x2[e + 1] + x2[e + 2] * x2[e + 2] + x2[e + 3] * x2[e + 3]; }
        ss = wave_sum(ss); const float rstd = rsqrtf(ss * (1.0f / D) + EPS);
#pragma unroll
        for (int hlf = 0; hlf < 2; ++hlf)
#pragma unroll
            for (int q = 0; q < 2; ++q) { const int col = hlf * 512 + lane * 8 + q * 4; const float4 gg = *(const float4*)(gfin + col); const int e = hlf * 8 + q * 4;
                *(float4*)(out + (size_t)tok * D + col) = make_float4(x2[e] * rstd * gg.x, x2[e + 1] * rstd * gg.y, x2[e + 2] * rstd * gg.z, x2[e + 3] * rstd * gg.w); }
    }
}

constexpr int N_PHASES = 11;
struct Args { const float* in[23]; float* out; unsigned char* ws; int ph_lo, ph_hi; };
__global__ void __launch_bounds__(NTHREADS, 2) fwd(Args args) {
    extern __shared__ __attribute__((aligned(16))) unsigned char lds_raw[];
    Frame F;
#pragma unroll
    for (int i = 0; i < 23; ++i) F.in[i] = args.in[i];
    F.out = args.out; F.ws = args.ws; F.lds = (LAS unsigned char*)lds_raw;
    F.tid = threadIdx.x; F.lane = F.tid & 63; F.wave = __builtin_amdgcn_readfirstlane(F.tid >> 6); F.G = gridDim.x;
    volatile LAS unsigned* misc = (volatile LAS unsigned*)(F.lds + LDS_MISC_OFF);
    if (F.tid < 64) misc[F.tid] = 0u;
    __syncthreads();
    XcdBarrier bar; bar.bar = (unsigned*)(F.ws + WS_CTL); bar.x = 0; bar.st = misc;
    const int lo = args.ph_lo, hi = args.ph_hi;
    if (hi - lo > 1) bar = xcd_barrier_post((unsigned*)(F.ws + WS_CTL), misc);
#ifndef PH_MASK
#define PH_MASK 0xFFFF
#endif
#define IN(k) (((PH_MASK >> (k)) & 1) && lo <= (k) && (k) < hi)
#define SEAM(k) do { if (IN(k) && IN((k) + 1)) xcd_barrier(bar); } while (0)
    const float* MOD = (const float*)(F.ws + WS_MOD);
    if (IN(0)) { p0_prologue(F); } SEAM(0);
    if (IN(1)) { norm_mod_rows(F, F.in[0], F.in[2], 0, 1024, (bf16_t*)(F.ws + WS_H)); } SEAM(1);
    if (IN(2)) { pg8::Gemm g{(const pg8::bf16_t*)(F.ws + WS_H), (const pg8::bf16_t*)(F.ws + WS_WIN), T, NPAD, D}; pg8::StaticOrder So; So.init(T, NPAD, F.G, (int)blockIdx.x);
        pg8::EpiBf16<0> E{(pg8::bf16_t*)(F.ws + WS_PROJ), NPAD, nullptr, 0, 0};
        pg8::gemm_phase<pg8::EpiBf16<0>, pg8::StaticOrder>(F.lds, g, So, E, nullptr); } SEAM(2);
    if (IN(3)) { p3_compress_naive(F); } SEAM(3);
    #ifdef ATTN_NAIVE
    if (IN(4)) { p4_attn_naive(F); } SEAM(4);
#else
    if (IN(4)) { p4_attn_mfma(F); } SEAM(4);
#endif
    if (IN(5)) { p5_mixed(F); } SEAM(5);
    if (IN(6)) { pg8::Gemm g{(const pg8::bf16_t*)(F.ws + WS_H), (const pg8::bf16_t*)(F.ws + WS_WOUT), T, D, D}; pg8::StaticOrder So; So.init(T, D, F.G, (int)blockIdx.x);
        EpiResGate E{F.out, F.in[0], MOD, 2048};
        pg8::gemm_phase<EpiResGate, pg8::StaticOrder>(F.lds, g, So, E, nullptr); } SEAM(6);
    if (IN(7)) { norm_mod_rows(F, F.out, F.in[3], 3072, 4096, (bf16_t*)(F.ws + WS_H)); } SEAM(7);
    if (IN(8)) { pg8::Gemm g{(const pg8::bf16_t*)(F.ws + WS_H), (const pg8::bf16_t*)(F.ws + WS_WQ), T, D, D}; pg8::StaticOrder So; So.init(T, D, F.G, (int)blockIdx.x);
        pg8::EpiBf16<0> E{(pg8::bf16_t*)(F.ws + WS_QP), D, nullptr, 0, 0};
        pg8::gemm_phase<pg8::EpiBf16<0>, pg8::StaticOrder>(F.lds, g, So, E, nullptr); } SEAM(8);
    if (IN(9)) { p9_route_naive(F); } SEAM(9);
    if (IN(10)) { p10_peer_naive(F); }
#undef IN
#undef SEAM
}

extern "C" void kernel_launch(void* const* d_in, const int* in_sizes, int n_in, void* d_out, int out_size, void* d_ws, size_t ws_size, hipStream_t stream) {
    static int grid = 0;
    if (grid == 0) {
        if (n_in != 23 || out_size != T * D || ws_size < WS_END) { fprintf(stderr, "kernel_launch: unexpected shapes: n_in %d out %d ws %zu (need %zu)\n", n_in, out_size, ws_size, (size_t)WS_END); grid = -1; return; }
        int dev = 0, cus = 0, per_cu = 0;
        if (hipGetDevice(&dev) != hipSuccess || hipDeviceGetAttribute(&cus, hipDeviceAttributeMultiprocessorCount, dev) != hipSuccess) { grid = -1; return; }
        if (hipFuncSetAttribute((const void*)fwd, hipFuncAttributeMaxDynamicSharedMemorySize, LDS_BYTES) != hipSuccess) { fprintf(stderr, "kernel_launch: hipFuncSetAttribute failed\n"); grid = -1; return; }
        if (hipOccupancyMaxActiveBlocksPerMultiprocessor(&per_cu, (const void*)fwd, NTHREADS, LDS_BYTES) != hipSuccess || per_cu < 1) { fprintf(stderr, "kernel_launch: occupancy query says %d\n", per_cu); (void)hipGetLastError(); per_cu = 1; }
        grid = cus;
    }
    if (grid < 0) return;
    (void)hipMemsetAsync((char*)d_ws + WS_CTL, 0, CTL_BYTES, stream);
    Args a{};
    for (int i = 0; i < 23; ++i) a.in[i] = (const float*)d_in[i];
    a.out = (float*)d_out; a.ws = (unsigned char*)d_ws;
#if MK_N_LAUNCHES == 1
    a.ph_lo = 0; a.ph_hi = N_PHASES;
    hipLaunchKernelGGL(fwd, dim3(grid), dim3(NTHREADS), LDS_BYTES, stream, a);
#else
    for (int p = 0; p < N_PHASES; ++p) { a.ph_lo = p; a.ph_hi = p + 1; hipLaunchKernelGGL(fwd, dim3(grid), dim3(NTHREADS), LDS_BYTES, stream, a); }
#endif
}
```

```cpp
#include <hip/hip_runtime.h>
#include <cstdio>
#include <cstdint>
#include <cstdlib>

#ifndef MK_N_LAUNCHES
#define MK_N_LAUNCHES 1
#endif
#define XB_TMO      128
#define XB_XCNT(j)  (256  + 64 * (j))
#define XB_XSUB(j)  (1280 + 64 * (j))
#define XB_XGEN(j)  (2304 + 64 * (j))
#define XB_TOP      3328
#define XB_TOPGEN   3392
#define XCD_BAR_WORDS 3456
#define XB_SPIN_CAP (1u << 18)
#define LAS __attribute__((address_space(3)))

__device__ __forceinline__ unsigned xb_ld(unsigned* p)              { return __hip_atomic_load(p, __ATOMIC_RELAXED, __HIP_MEMORY_SCOPE_AGENT); }
__device__ __forceinline__ unsigned xb_add(unsigned* p, unsigned v) { return __hip_atomic_fetch_add(p, v, __ATOMIC_RELAXED, __HIP_MEMORY_SCOPE_AGENT); }
__device__ __forceinline__ unsigned xb_xcc_id() { return (unsigned)__builtin_amdgcn_s_getreg((3 << 11) | 20) & 0xFu; }
#define XB_SPIN(cond, bar) do { unsigned _sp = 0; while (cond) { __builtin_amdgcn_s_sleep(1); \
    if ((++_sp & 255u) == 0u) { if (xb_ld(&(bar)[XB_TMO])) break; if (_sp > XB_SPIN_CAP) { atomicAdd(&(bar)[XB_TMO], 1u); break; } } } } while (0)

struct XcdBarrier {
    unsigned* bar; unsigned x;
    volatile LAS unsigned* st;
};

__device__ __forceinline__ XcdBarrier xcd_barrier_post(unsigned* bar, volatile LAS unsigned* st) {
    XcdBarrier b; b.bar = bar; b.x = xb_xcc_id(); b.st = st;
    if (threadIdx.x == 0) (void)xb_add(&bar[XB_XCNT(b.x)], 1u);
    return b;
}
__device__ __forceinline__ void xcd_barrier_complete(unsigned* bar, unsigned x, unsigned& nloc, unsigned& nx) {
    const unsigned G = gridDim.x * gridDim.y * gridDim.z;
    unsigned sum, cnt, mine, sp = 0u;
    for (;;) {
        sum = 0u; cnt = 0u; mine = 0u;
#pragma unroll
        for (unsigned j = 0; j < 16; ++j) { const unsigned c = xb_ld(&bar[XB_XCNT(j)]); sum += c; cnt += (c > 0u) ? 1u : 0u; mine = (j == x) ? c : mine; }
        if (sum == G) break;
        __builtin_amdgcn_s_sleep(1);
        if ((++sp & 255u) == 0u) { if (xb_ld(&bar[XB_TMO])) break; if (sp > XB_SPIN_CAP) { atomicAdd(&bar[XB_TMO], 1u); break; } }
    }
    nloc = mine > 0u ? mine : 1u; nx = cnt > 0u ? cnt : 1u;
}

__device__ __forceinline__ void xcd_barrier(const XcdBarrier& b) {
    asm volatile("s_waitcnt vmcnt(0)" ::: "memory");
    __syncthreads();
    if (threadIdx.x == 0) {
        unsigned* bar = b.bar;
        __builtin_amdgcn_s_waitcnt(0);
        unsigned nloc = b.st[0], nx = b.st[1];
        if (nloc == 0u) { xcd_barrier_complete(bar, b.x, nloc, nx); b.st[0] = nloc; b.st[1] = nx; }
        const unsigned old = xb_add(&bar[XB_XSUB(b.x)], 1u);
        const unsigned gen = old / nloc;
        if (old + 1u == (gen + 1u) * nloc) {
            __builtin_amdgcn_fence(__ATOMIC_RELEASE, "agent");
            asm volatile("s_waitcnt vmcnt(0)" ::: "memory");
            const unsigned og = xb_add(&bar[XB_TOP], 1u);
            const unsigned tg = og / nx;
            if (og + 1u == (tg + 1u) * nx) xb_add(&bar[XB_TOPGEN], 1u);
            else XB_SPIN(xb_ld(&bar[XB_TOPGEN]) == tg, bar);
            __builtin_amdgcn_fence(__ATOMIC_ACQUIRE, "agent");
            xb_add(&bar[XB_XGEN(b.x)], 1u);
            asm volatile("s_waitcnt vmcnt(0)" ::: "memory");
        } else {
            XB_SPIN(xb_ld(&bar[XB_XGEN(b.x)]) == gen, bar);
            __builtin_amdgcn_fence(__ATOMIC_ACQUIRE, "agent");
            asm volatile("s_waitcnt vmcnt(0)" ::: "memory");
        }
    }
    __syncthreads();
}

namespace pg8 {
#define PG8_LAS __attribute__((address_space(3)))
typedef unsigned short bf16_t;
typedef short bf16x8 __attribute__((ext_vector_type(8)));
typedef float f32x4 __attribute__((ext_vector_type(4)));
typedef unsigned u32x4 __attribute__((ext_vector_type(4)));
constexpr int BM = 256, BK = 64, HALF = 128, HTB = HALF * BK * 2  , STAGE_BYTES = 8 * HTB, NXCD = 8, WGM = 8;

__host__ __device__ __forceinline__ int lds_byte(int r, int c) { const int st = (r >> 4) * 2 + (c >> 5), rr = r & 15, cc = c & 31, ob = rr * 64 + cc * 2; return st * 1024 + (ob ^ (((ob >> 9) & 1) << 5)); }
__host__ __device__ __forceinline__ void stage_rc(int b, int& R, int& C) { const int st = b / 1024, sb = b % 1024, swz = sb ^ (((sb >> 9) & 1) << 5); R = (st >> 1) * 16 + swz / 64; C = (st & 1) * 32 + (swz % 64) / 2; }
__host__ __device__ __forceinline__ int perm32(int rho) { const int n = rho >> 4, i = rho & 15; return 8 * (i >> 2) + 4 * n + (i & 3); }

struct Unit { int pm, pn; };
struct Gemm { const bf16_t* A; const bf16_t* Bt; int M, N, K; };

struct StaticOrder {
    int nM, nN, nwg, G, c;
    __host__ __device__ void init(int M, int N, int G_, int c_) { nM = M / BM; nN = N / BM; nwg = nM * nN; G = G_; c = c_; }
    __host__ __device__ bool next(int i, Unit& u) const {
        const long L = (long)i * G + c; if (L >= nwg) return false;
        int wgid = (int)L; { const int q = nwg / NXCD, r = nwg % NXCD, xcd = wgid % NXCD, off = wgid / NXCD; wgid = (xcd < r ? xcd * (q + 1) : r * (q + 1) + (xcd - r) * q) + off; }
        const int nig = WGM * nN, gid = wgid / nig, fm = gid * WGM, gsz = (nM - fm) < WGM ? (nM - fm) : WGM;
        u.pm = fm + ((wgid % nig) % gsz); u.pn = (wgid % nig) / gsz; return true;
    }
    __device__ __forceinline__ void a_ready(const Unit&) const {}
    __device__ __forceinline__ void done(const Unit&) const {}
};
struct CountedOrder : StaticOrder {
    const unsigned* ready; unsigned need; unsigned* tmo;
    __device__ __forceinline__ void a_ready(const Unit& u) const {
        if (threadIdx.x < 64) {
            const unsigned long long t0 = __builtin_amdgcn_s_memrealtime(); unsigned polls = 0;
            while ((unsigned)__builtin_amdgcn_readfirstlane(__hip_atomic_load(ready + 64 * u.pm, __ATOMIC_RELAXED, __HIP_MEMORY_SCOPE_AGENT)) < need) {
                if ((++polls & 255u) == 0u && __builtin_amdgcn_readfirstlane(__hip_atomic_load(tmo, __ATOMIC_RELAXED, __HIP_MEMORY_SCOPE_AGENT)) != 0u) break;
                if (__builtin_amdgcn_s_memrealtime() - t0 > 2000000ull) {
                    if (threadIdx.x == 0) { unsigned expect = 0u; __hip_atomic_compare_exchange_strong(tmo + 1, &expect, 0x600u | (unsigned)(u.pm & 0xff), __ATOMIC_RELAXED, __ATOMIC_RELAXED, __HIP_MEMORY_SCOPE_AGENT); __hip_atomic_store(tmo, 1u, __ATOMIC_RELAXED, __HIP_MEMORY_SCOPE_AGENT); }
                    break; }
                __builtin_amdgcn_s_sleep(2); }
            __builtin_amdgcn_fence(__ATOMIC_ACQUIRE, "agent");
            asm volatile("s_waitcnt vmcnt(0)" ::: "memory");
        }
#if !defined(BROKEN_HOOK_NO_BARRIER)
        asm volatile("" ::: "memory"); __builtin_amdgcn_s_barrier(); asm volatile("" ::: "memory");
#endif
    }
};

__device__ __forceinline__ unsigned cvt_pk_bf16(float lo, float hi) { unsigned r; asm volatile("v_cvt_pk_bf16_f32 %0, %1, %2" : "=v"(r) : "v"(lo), "v"(hi)); return r; }
typedef float f32x2 __attribute__((ext_vector_type(2)));
__device__ __forceinline__ f32x2 gelu_pk(f32x2 v) {
    const f32x2 av = __builtin_elementwise_abs(v), d = av * 0.2316418882f + 1.0f;
    f32x2 t; t.x = __builtin_amdgcn_rcpf(d.x); t.y = __builtin_amdgcn_rcpf(d.y);
    f32x2 q = t * 0.5307027145f + (-0.7265760135f); q = q * t + 0.7107068705f; q = q * t + (-0.142248368f); q = q * t + 0.127414796f; q = q * t;
    const f32x2 s = (v * v) * (-0.72134752044f);
    f32x2 e; e.x = __builtin_amdgcn_exp2f(s.x); e.y = __builtin_amdgcn_exp2f(s.y);
    const f32x2 m = v * (q * e), r = v - m;
    f32x2 o; o.x = v.x < 0.f ? m.x : r.x; o.y = v.y < 0.f ? m.y : r.y; return o;
}

struct EpiF32 {
    static constexpr bool PERM = false, AFTER_DRAIN = false;
    float* C; int ldc; const float* bias;
    __device__ __forceinline__ void operator()(const f32x4 (&acc)[2][2][4][2], const Unit& u, int wr, int wc, int fr, int fq) const {
        const int row0 = u.pm * BM + wr * 64 + fr, col0 = u.pn * BM + wc * 32 + 4 * fq;
        f32x4 bv[2][2];
#pragma unroll
        for (int bj = 0; bj < 2; ++bj)
#pragma unroll
            for (int n = 0; n < 2; ++n) bv[bj][n] = bias ? *(const f32x4*)(bias + col0 + bj * HALF + n * 16) : (f32x4){0.f, 0.f, 0.f, 0.f};
#pragma unroll
        for (int ai = 0; ai < 2; ++ai)
#pragma unroll
            for (int m = 0; m < 4; ++m) { float* rowp = C + (size_t)(row0 + ai * HALF + m * 16) * ldc + col0;
#pragma unroll
                for (int bj = 0; bj < 2; ++bj)
#pragma unroll
                    for (int n = 0; n < 2; ++n) *(f32x4*)(rowp + bj * HALF + n * 16) = acc[ai][bj][m][n] + bv[bj][n]; }
    }
};
template <int ACT  > struct EpiBf16 {
    static constexpr bool PERM = true, AFTER_DRAIN = false;
    bf16_t* O; int ldc; const float* bias; int split_cols; size_t split_stride;
    __device__ __forceinline__ void operator()(const f32x4 (&acc)[2][2][4][2], const Unit& u, int wr, int wc, int fr, int fq) const {
        const int row0 = u.pm * BM + wr * 64 + fr; int colt = u.pn * BM; bf16_t* base = O;
        if (split_cols) { const int t = colt / split_cols; base += (size_t)t * split_stride; colt -= t * split_cols; }
        const int col0 = colt + wc * 32 + 8 * fq, bcol0 = u.pn * BM + wc * 32 + 8 * fq;
        f32x4 bv[2][2];
#pragma unroll
        for (int bj = 0; bj < 2; ++bj)
#pragma unroll
            for (int n = 0; n < 2; ++n) bv[bj][n] = bias ? *(const f32x4*)(bias + bcol0 + bj * HALF + 4 * n) : (f32x4){0.f, 0.f, 0.f, 0.f};
#pragma unroll
        for (int ai = 0; ai < 2; ++ai)
#pragma unroll
            for (int m = 0; m < 4; ++m) { bf16_t* rowp = base + (size_t)(row0 + ai * HALF + m * 16) * ldc + col0;
#pragma unroll
                for (int bj = 0; bj < 2; ++bj) { f32x4 v0 = acc[ai][bj][m][0] + bv[bj][0], v1 = acc[ai][bj][m][1] + bv[bj][1];
                    if (ACT == 1) { f32x2 a = gelu_pk((f32x2){v0[0], v0[1]}), b = gelu_pk((f32x2){v0[2], v0[3]}), c = gelu_pk((f32x2){v1[0], v1[1]}), d = gelu_pk((f32x2){v1[2], v1[3]});
                        v0 = (f32x4){a.x, a.y, b.x, b.y}; v1 = (f32x4){c.x, c.y, d.x, d.y}; }
                    if (ACT == 2) {
#pragma unroll
                        for (int j = 0; j < 4; ++j) { v0[j] = 0.5f * v0[j] * (1.0f + erff(v0[j] * 0.70710678f)); v1[j] = 0.5f * v1[j] * (1.0f + erff(v1[j] * 0.70710678f)); } }
                    u32x4 w; w.x = cvt_pk_bf16(v0[0], v0[1]); w.y = cvt_pk_bf16(v0[2], v0[3]); w.z = cvt_pk_bf16(v1[0], v1[1]); w.w = cvt_pk_bf16(v1[2], v1[3]);
                    *(u32x4*)(rowp + bj * HALF) = w; } }
    }
};

struct PanelStats {
    unsigned* xbuf;
    unsigned* cnt;
    unsigned* tmo;
    int ntn; float eps;
    unsigned code;
    __device__ __forceinline__ bool run(const f32x4 (&v)[2][2][4][2], const Unit& u, int wr, int wc, int fr, int fq, PG8_LAS unsigned char* lds, int wid, int lane) const {
        typedef float f32x2v __attribute__((ext_vector_type(2)));
        PG8_LAS f32x2v* P = (PG8_LAS f32x2v*)lds;
        PG8_LAS f32x2v* S = (PG8_LAS f32x2v*)(lds + 8192);
        PG8_LAS unsigned* flag = (PG8_LAS unsigned*)(lds + 8192 + 2048);
#pragma unroll
        for (int ai = 0; ai < 2; ++ai)
#pragma unroll
            for (int m = 0; m < 4; ++m) {
                float s = 0.f;
#pragma unroll
                for (int bj = 0; bj < 2; ++bj)
#pragma unroll
                    for (int n = 0; n < 2; ++n) { const f32x4 x = v[ai][bj][m][n]; s += (x[0] + x[1]) + (x[2] + x[3]); }
                s += __shfl_xor(s, 16); s += __shfl_xor(s, 32);
                const float mw = s * (1.0f / 64.0f); float q = 0.f;
#pragma unroll
                for (int bj = 0; bj < 2; ++bj)
#pragma unroll
                    for (int n = 0; n < 2; ++n) { const f32x4 d = v[ai][bj][m][n] - mw; q += (d[0] * d[0] + d[1] * d[1]) + (d[2] * d[2] + d[3] * d[3]); }
                q += __shfl_xor(q, 16); q += __shfl_xor(q, 32);
                if (fq == 0) P[(ai * HALF + wr * 64 + m * 16 + fr) * 4 + wc] = (f32x2v){mw, q};
            }
        asm volatile("s_waitcnt lgkmcnt(0)" ::: "memory"); __builtin_amdgcn_s_barrier(); asm volatile("" ::: "memory");
#if defined(BROKEN_NO_WAIT)
        if (blockIdx.x >= 64) { const long long t0 = clock64(); while (clock64() - t0 < 60000) __builtin_amdgcn_s_sleep(8); }
#endif
        const int row = wid * 32 + (lane & 31);
        if (lane < 32) {
            const f32x2v a = P[row * 4 + 0], b = P[row * 4 + 1], c = P[row * 4 + 2], d = P[row * 4 + 3];
            const float mt = (a.x + b.x + c.x + d.x) * 0.25f;
            const float da = a.x - mt, db = b.x - mt, dc = c.x - mt, dd = d.x - mt;
            const float m2 = (a.y + b.y) + (c.y + d.y) + 64.0f * ((da * da + db * db) + (dc * dc + dd * dd));
            unsigned long long* slot = (unsigned long long*)xbuf + ((size_t)(u.pm * BM + row) * 4 + u.pn);
            __hip_atomic_store(slot, ((unsigned long long)__float_as_uint(m2) << 32) | __float_as_uint(mt), __ATOMIC_RELAXED, __HIP_MEMORY_SCOPE_AGENT);
        }
        asm volatile("s_waitcnt vmcnt(0)" ::: "memory");
        if (lane == 0) __hip_atomic_fetch_add(cnt + 64 * u.pm, 1u, __ATOMIC_RELAXED, __HIP_MEMORY_SCOPE_AGENT);
        if (wid == 0) {
            bool dead = false; const unsigned long long t0 = __builtin_amdgcn_s_memrealtime(); const unsigned want = 8u * (unsigned)ntn;
            for (;;) {
#if defined(BROKEN_NO_WAIT)
                break;
#endif
                if ((unsigned)__builtin_amdgcn_readfirstlane(__hip_atomic_load(cnt + 64 * u.pm, __ATOMIC_RELAXED, __HIP_MEMORY_SCOPE_AGENT)) >= want) break;
                if (__builtin_amdgcn_s_memrealtime() - t0 > 2000000ull) {
                    if (lane == 0) { unsigned expect = 0u; __hip_atomic_compare_exchange_strong(tmo + 1, &expect, code | (unsigned)(u.pm & 0xff), __ATOMIC_RELAXED, __ATOMIC_RELAXED, __HIP_MEMORY_SCOPE_AGENT);
                                     __hip_atomic_store(tmo, 1u, __ATOMIC_RELAXED, __HIP_MEMORY_SCOPE_AGENT); }
                    dead = true; break; }
                __builtin_amdgcn_s_sleep(2);
            }
            __builtin_amdgcn_fence(__ATOMIC_ACQUIRE, "agent");
            if (lane == 0) flag[0] = dead ? 1u : 0u;
        }
        asm volatile("s_waitcnt vmcnt(0) lgkmcnt(0)" ::: "memory"); __builtin_amdgcn_s_barrier(); asm volatile("" ::: "memory");
        const bool bad = flag[0] != 0u;
        if (lane < 32) {
            const unsigned long long* slot = (const unsigned long long*)xbuf + (size_t)(u.pm * BM + row) * 4; float mt[4], m2[4]; float ms = 0.f;
#pragma unroll
            for (int t = 0; t < 4; ++t) { if (t < ntn) { const unsigned long long w = __hip_atomic_load(slot + t, __ATOMIC_RELAXED, __HIP_MEMORY_SCOPE_AGENT); mt[t] = __uint_as_float((unsigned)w); m2[t] = __uint_as_float((unsigned)(w >> 32)); } else { mt[t] = 0.f; m2[t] = 0.f; } ms += mt[t]; }
            const float mean = ms / (float)ntn; float q = 0.f;
#pragma unroll
            for (int t = 0; t < 4; ++t) if (t < ntn) { const float dm = mt[t] - mean; q += m2[t] + 256.0f * dm * dm; }
            S[row] = (f32x2v){mean, 1.0f / sqrtf(q / (256.0f * (float)ntn) + eps)};
        }
        asm volatile("s_waitcnt lgkmcnt(0)" ::: "memory"); __builtin_amdgcn_s_barrier(); asm volatile("" ::: "memory");
        return bad;
    }
};
struct EpiLnRes {
    static constexpr bool PERM = false, AFTER_DRAIN = true;
    const float* base; float* out; int ldc; const float* bias; PanelStats st; unsigned poison;
    __device__ __forceinline__ void refuse(size_t i0, size_t stride, int M, int N) const { const float q = __builtin_nanf(""); for (size_t i = i0; i < (size_t)M * N; i += stride) out[(i / N) * ldc + i % N] = q;
        if (i0 == 0) { unsigned expect = 0u; __hip_atomic_compare_exchange_strong(st.tmo + 1, &expect, 0x7f0u, __ATOMIC_RELAXED, __ATOMIC_RELAXED, __HIP_MEMORY_SCOPE_AGENT); __hip_atomic_store(st.tmo, 1u, __ATOMIC_RELAXED, __HIP_MEMORY_SCOPE_AGENT); } }
    __device__ __forceinline__ void fused(f32x4 (&acc)[2][2][4][2], const Unit& u, int wr, int wc, int fr, int fq, PG8_LAS unsigned char* lds, int wid, int lane) const {
        typedef float f32x2v __attribute__((ext_vector_type(2)));
        const PG8_LAS f32x2v* S = (const PG8_LAS f32x2v*)(lds + 8192);
        const int col0 = u.pn * BM + wc * 32 + 4 * fq;
#pragma unroll
        for (int bj = 0; bj < 2; ++bj)
#pragma unroll
            for (int n = 0; n < 2; ++n) { const f32x4 bv = bias ? *(const f32x4*)(bias + col0 + bj * HALF + n * 16) : (f32x4){0.f, 0.f, 0.f, 0.f};
#pragma unroll
                for (int ai = 0; ai < 2; ++ai)
#pragma unroll
                    for (int m = 0; m < 4; ++m) acc[ai][bj][m][n] += bv; }
        const bool bad = st.run(acc, u, wr, wc, fr, fq, lds, wid, lane) || poison != 0u;
        const float qnan = __builtin_nanf("");
#pragma unroll
        for (int ai = 0; ai < 2; ++ai)
#pragma unroll
            for (int m = 0; m < 4; ++m) { const int r = ai * HALF + wr * 64 + m * 16 + fr; const f32x2v sr = S[r]; const size_t off = (size_t)(u.pm * BM + r) * ldc + col0;
#pragma unroll
                for (int bj = 0; bj < 2; ++bj)
#pragma unroll
                    for (int n = 0; n < 2; ++n) { const f32x4 bs = *(const f32x4*)(base + off + bj * HALF + n * 16); f32x4 o = bs + (acc[ai][bj][m][n] - sr.x) * sr.y;
                        if (bad) o = (f32x4){qnan, qnan, qnan, qnan}; *(f32x4*)(out + off + bj * HALF + n * 16) = o; }
                asm volatile("" ::: "memory"); }
    }
};
struct EpiLnResLn {
    static constexpr bool PERM = false, AFTER_DRAIN = true;
    const float* base; float* out; bf16_t* xn; int ldc; const float* bias; PanelStats st1, st2; unsigned poison;
    __device__ __forceinline__ void refuse(size_t i0, size_t stride, int M, int N) const { const float q = __builtin_nanf(""); for (size_t i = i0; i < (size_t)M * N; i += stride) { const size_t o = (i / N) * ldc + i % N; out[o] = q; xn[o] = (bf16_t)0x7fc0u; }
        if (i0 == 0) { unsigned expect = 0u; __hip_atomic_compare_exchange_strong(st1.tmo + 1, &expect, 0x7f0u, __ATOMIC_RELAXED, __ATOMIC_RELAXED, __HIP_MEMORY_SCOPE_AGENT); __hip_atomic_store(st1.tmo, 1u, __ATOMIC_RELAXED, __HIP_MEMORY_SCOPE_AGENT); } }
    __device__ __forceinline__ void fused(f32x4 (&acc)[2][2][4][2], const Unit& u, int wr, int wc, int fr, int fq, PG8_LAS unsigned char* lds, int wid, int lane) const {
        typedef float f32x2v __attribute__((ext_vector_type(2))); typedef unsigned u32x2v __attribute__((ext_vector_type(2)));
        const PG8_LAS f32x2v* S = (const PG8_LAS f32x2v*)(lds + 8192);
        const int col0 = u.pn * BM + wc * 32 + 4 * fq;
#pragma unroll
        for (int bj = 0; bj < 2; ++bj)
#pragma unroll
            for (int n = 0; n < 2; ++n) { const f32x4 bv = bias ? *(const f32x4*)(bias + col0 + bj * HALF + n * 16) : (f32x4){0.f, 0.f, 0.f, 0.f};
#pragma unroll
                for (int ai = 0; ai < 2; ++ai)
#pragma unroll
                    for (int m = 0; m < 4; ++m) acc[ai][bj][m][n] += bv; }
        bool bad = st1.run(acc, u, wr, wc, fr, fq, lds, wid, lane) || poison != 0u;
        const float qnan = __builtin_nanf("");
#pragma unroll
        for (int ai = 0; ai < 2; ++ai)
#pragma unroll
            for (int m = 0; m < 4; ++m) { const int r = ai * HALF + wr * 64 + m * 16 + fr; const f32x2v sr = S[r]; const size_t off = (size_t)(u.pm * BM + r) * ldc + col0;
#pragma unroll
                for (int bj = 0; bj < 2; ++bj)
#pragma unroll
                    for (int n = 0; n < 2; ++n) { const f32x4 bs = *(const f32x4*)(base + off + bj * HALF + n * 16); acc[ai][bj][m][n] = bs + (acc[ai][bj][m][n] - sr.x) * sr.y; }
                asm volatile("" : "+v"(acc[ai][0][m][0]), "+v"(acc[ai][0][m][1]), "+v"(acc[ai][1][m][0]), "+v"(acc[ai][1][m][1]));
                if (m & 1) asm volatile("" ::: "memory"); }
        const bool bad1 = bad;
        bad = st2.run(acc, u, wr, wc, fr, fq, lds, wid, lane) || bad;
#pragma unroll
        for (int ai = 0; ai < 2; ++ai)
#pragma unroll
            for (int m = 0; m < 4; ++m) { const int r = ai * HALF + wr * 64 + m * 16 + fr; const f32x2v sr = S[r]; const size_t off = (size_t)(u.pm * BM + r) * ldc + col0;
#pragma unroll
                for (int bj = 0; bj < 2; ++bj)
#pragma unroll
                    for (int n = 0; n < 2; ++n) { const f32x4 x1 = acc[ai][bj][m][n]; *(f32x4*)(out + off + bj * HALF + n * 16) = bad1 ? (f32x4){qnan, qnan, qnan, qnan} : x1;
                        const f32x4 o = (x1 - sr.x) * sr.y; u32x2v w; w.x = cvt_pk_bf16(o[0], o[1]); w.y = cvt_pk_bf16(o[2], o[3]);
                        if (bad) { w.x = 0x7fc07fc0u; w.y = 0x7fc07fc0u; } *(u32x2v*)(xn + off + bj * HALF + n * 16) = w; }
                asm volatile("" ::: "memory"); }
    }
};

template <class Epi, class Sched, bool STAMP = false>
__device__ __forceinline__ void gemm_phase(PG8_LAS unsigned char* lds, const Gemm g, const Sched& S, const Epi& E, unsigned long long* stamps) {
    const int tid = threadIdx.x, wid = __builtin_amdgcn_readfirstlane(tid >> 6), lane = tid & 63, wr = wid >> 2, wc = wid & 3, fr = lane & 15, fq = lane >> 4;
    const int K = g.K, nt = K / BK;
    int ts_lo = 0, ts_hi = 0, nts = 0; const unsigned long long rt_entry = STAMP ? (unsigned long long)wall_clock64() : 0ull;
#define PG8_STAMP() do { if (STAMP && wid == 0 && nts < 64) { const unsigned long long _c = (unsigned long long)clock64(); \
        ts_lo = (lane == nts) ? (int)(unsigned)_c : ts_lo; ts_hi = (lane == nts) ? (int)(unsigned)(_c >> 32) : ts_hi; ++nts; } } while (0)
    PG8_STAMP();
    unsigned voffA[2], voffB[2];
#pragma unroll
    for (int i = 0; i < 2; ++i) { int R, C; stage_rc(tid * 16 + i * 8192, R, C); const int Rb = Epi::PERM ? ((R & ~31) + perm32(R & 31)) : R;
        voffA[i] = (unsigned)(R * K + C) * 2u; voffB[i] = (unsigned)(Rb * K + C) * 2u; }
    const size_t kstep = (size_t)(BK * 2);
    const size_t hstep = (size_t)HALF * K * 2;
    const size_t tstep = 2 * hstep;
    const unsigned ldsw = (unsigned)wid * 1024u;
    const int aoff = lds_byte(wr * 64 + fr, fq * 8), boff = lds_byte(wc * 32 + fr, fq * 8);
#define PG8_SA(b, h) (((b) * 2 + (h)) * HTB)
#define PG8_SB(b, h) ((4 + (b) * 2 + (h)) * HTB)
#define PG8_STAGE(bufoff, gbase, voff) do { _Pragma("unroll") for (int _i = 0; _i < 2; ++_i) \
        __builtin_amdgcn_global_load_lds((const unsigned*)((const char*)(gbase) + (voff)[_i]), (PG8_LAS unsigned*)(lds + (bufoff) + ldsw + _i * 8192), 16, 0, 0); } while (0)
#define PG8_LDA(dst, b, h) do { _Pragma("unroll") for (int m = 0; m < 4; ++m) _Pragma("unroll") for (int k = 0; k < 2; ++k) dst[m][k] = *(const PG8_LAS bf16x8*)(lds + PG8_SA(b, h) + aoff + m * 2048 + k * 1024); } while (0)
#define PG8_LDB(dst, b, h) do { _Pragma("unroll") for (int n = 0; n < 2; ++n) _Pragma("unroll") for (int k = 0; k < 2; ++k) dst[n][k] = *(const PG8_LAS bf16x8*)(lds + PG8_SB(b, h) + boff + n * 2048 + k * 1024); } while (0)
#define PG8_MMA(ai, bj, At, Bt) do { __builtin_amdgcn_s_setprio(1); _Pragma("unroll") for (int m = 0; m < 4; ++m) _Pragma("unroll") for (int n = 0; n < 2; ++n) _Pragma("unroll") for (int k = 0; k < 2; ++k) \
        acc[ai][bj][m][n] = __builtin_amdgcn_mfma_f32_16x16x32_bf16(Bt[n][k], At[m][k], acc[ai][bj][m][n], 0, 0, 0); __builtin_amdgcn_s_setprio(0); } while (0)
#define PG8_WAIT_V(n) asm volatile("s_waitcnt vmcnt(" #n ")" ::: "memory")
#define PG8_WAIT_L(n) asm volatile("s_waitcnt lgkmcnt(" #n ")" ::: "memory")
#define PG8_BAR __builtin_amdgcn_s_barrier()
#define PG8_SCHED __builtin_amdgcn_sched_barrier(0)
    Unit cur, nxt; int ui = 0;
    if (!S.next(0, cur)) return;
    f32x4 acc[2][2][4][2];
#pragma unroll
    for (int a = 0; a < 2; ++a)
#pragma unroll
        for (int b = 0; b < 2; ++b)
#pragma unroll
            for (int m = 0; m < 4; ++m)
#pragma unroll
                for (int n = 0; n < 2; ++n) acc[a][b][m][n] = (f32x4){0.f, 0.f, 0.f, 0.f};
    bf16x8 At[4][2], B0[2][2], B1[2][2];
    const char* cA = (const char*)g.A + (size_t)cur.pm * tstep; const char* cB = (const char*)g.Bt + (size_t)cur.pn * tstep;
    S.a_ready(cur);
    PG8_STAGE(PG8_SB(0, 0), cB, voffB); PG8_STAGE(PG8_SA(0, 0), cA, voffA); PG8_STAGE(PG8_SB(0, 1), cB + hstep, voffB); PG8_STAGE(PG8_SA(0, 1), cA + hstep, voffA);
    if (wr == 1) PG8_BAR;
    PG8_WAIT_V(4); PG8_BAR;
    PG8_STAGE(PG8_SB(1, 0), cB + kstep, voffB); PG8_STAGE(PG8_SA(1, 0), cA + kstep, voffA); PG8_STAGE(PG8_SB(1, 1), cB + hstep + kstep, voffB);
    PG8_WAIT_V(6); PG8_BAR;
    PG8_STAMP();
    for (;;) {
        const bool has_next = S.next(ui + 1, nxt);
        const char* nA = has_next ? (const char*)g.A + (size_t)nxt.pm * tstep : cA; const char* nB = has_next ? (const char*)g.Bt + (size_t)nxt.pn * tstep : cB;
        for (int t = 0; t < nt; t += 2) {
            const bool last = (t == nt - 2);
            const char* a1 = cA + (size_t)(t + 1) * kstep;
            const char* a2 = last ? nA : cA + (size_t)(t + 2) * kstep; const char* b2 = last ? nB : cB + (size_t)(t + 2) * kstep;
            const char* a3 = a2 + kstep; const char* b3 = b2 + kstep;
            if (last && has_next) S.a_ready(nxt);
            PG8_LDB(B0, 0, 0); PG8_SCHED; PG8_LDA(At, 0, 0); PG8_STAGE(PG8_SA(1, 1), a1 + hstep, voffA);
            PG8_WAIT_L(8); PG8_BAR; PG8_WAIT_L(0); PG8_MMA(0, 0, At, B0); PG8_BAR; PG8_SCHED;
            PG8_LDB(B1, 0, 1); PG8_STAGE(PG8_SB(0, 0), b2, voffB);
            PG8_BAR; PG8_WAIT_L(0); PG8_MMA(0, 1, At, B1); PG8_BAR;
            PG8_LDA(At, 0, 1); PG8_STAGE(PG8_SA(0, 0), a2, voffA);
            PG8_BAR; PG8_WAIT_L(0); PG8_MMA(1, 0, At, B0); PG8_BAR; PG8_SCHED;
            PG8_STAGE(PG8_SB(0, 1), b2 + hstep, voffB);
            PG8_WAIT_V(6); PG8_BAR; PG8_MMA(1, 1, At, B1); PG8_BAR;
            PG8_LDB(B0, 1, 0); PG8_SCHED; PG8_LDA(At, 1, 0); PG8_STAGE(PG8_SA(0, 1), a2 + hstep, voffA);
            PG8_WAIT_L(8); PG8_BAR; PG8_WAIT_L(0); PG8_MMA(0, 0, At, B0); PG8_BAR; PG8_SCHED;
            PG8_LDB(B1, 1, 1); PG8_STAGE(PG8_SB(1, 0), b3, voffB);
            PG8_BAR; PG8_WAIT_L(0); PG8_MMA(0, 1, At, B1); PG8_BAR;
            PG8_LDA(At, 1, 1); PG8_STAGE(PG8_SA(1, 0), a3, voffA);
            PG8_BAR; PG8_WAIT_L(0); PG8_MMA(1, 0, At, B0); PG8_BAR; PG8_SCHED;
            PG8_STAGE(PG8_SB(1, 1), b3 + hstep, voffB);
            PG8_WAIT_V(6); PG8_BAR; PG8_MMA(1, 1, At, B1); PG8_BAR;
        }
        PG8_STAMP();
        if constexpr (!Epi::AFTER_DRAIN) { E(acc, cur, wr, wc, fr, fq); S.done(cur); }
        PG8_STAMP();
        if (!has_next) break;
#pragma unroll
        for (int a = 0; a < 2; ++a)
#pragma unroll
            for (int b = 0; b < 2; ++b)
#pragma unroll
                for (int m = 0; m < 4; ++m)
#pragma unroll
                    for (int n = 0; n < 2; ++n) acc[a][b][m][n] = (f32x4){0.f, 0.f, 0.f, 0.f};
        cur = nxt; cA = nA; cB = nB; ++ui;
    }
    PG8_WAIT_V(0);
    if (wr == 0) PG8_BAR;
    PG8_BAR;
    if constexpr (Epi::AFTER_DRAIN) { E.fused(acc, cur, wr, wc, fr, fq, lds, wid, lane); S.done(cur); }
    PG8_STAMP();
    if (STAMP && wid == 0) { stamps[lane] = lane < nts ? (((unsigned long long)(unsigned)ts_hi << 32) | (unsigned)ts_lo) : 0ull;
        if (lane == 62) stamps[62] = rt_entry; if (lane == 63) stamps[63] = (unsigned long long)wall_clock64(); }
#undef PG8_STAMP
#undef PG8_SA
#undef PG8_SB
#undef PG8_STAGE
#undef PG8_LDA
#undef PG8_LDB
#undef PG8_MMA
#undef PG8_WAIT_V
#undef PG8_WAIT_L
#undef PG8_BAR
#undef PG8_SCHED
}
}

constexpr int D = 1024, NB = 16, S = 2048, T = NB * S;
constexpr int NCOL = 2840, NPAD = 3072;
constexpr int C_Q = 0, C_KC = 512, C_VC = 640, C_KS = 768, C_VS = 896, C_KW = 1024, C_VW = 1152, C_GT = 1280, C_CB = 1304, C_CC = 1816, C_CH = 2328;
constexpr int NCMP = 127;
constexpr int NEXP = 16384;
constexpr float EPS = 1e-6f;
constexpr int NTHREADS = 512, NWAVES = 8;

constexpr size_t al256(size_t x) { return (x + 255) & ~(size_t)255; }
constexpr size_t WS_CTL   = 0;                                   constexpr size_t CTL_BYTES = 65536;
constexpr size_t WS_MOD   = WS_CTL + CTL_BYTES;
constexpr size_t WS_WIN   = al256(WS_MOD + (size_t)16 * 6144 * 4);
constexpr size_t WS_WOUT  = al256(WS_WIN + (size_t)NPAD * D * 2);
constexpr size_t WS_WQ    = al256(WS_WOUT + (size_t)D * D * 2);
constexpr size_t WS_KEYS  = al256(WS_WQ + (size_t)D * D * 2);
constexpr size_t WS_UB    = al256(WS_KEYS + (size_t)16 * 128 * 64 * 2);
constexpr size_t WS_VB    = al256(WS_UB + (size_t)NEXP * D * 2);
constexpr size_t WS_KC    = al256(WS_VB + (size_t)NEXP * D * 2);
constexpr size_t WS_VC    = al256(WS_KC + (size_t)16 * 2 * 128 * 64 * 2);
constexpr size_t WS_H     = al256(WS_VC + (size_t)16 * 2 * 128 * 64 * 2);
constexpr size_t WS_OATT  = al256(WS_H + (size_t)T * D * 2);
constexpr size_t WS_PROJ  = al256(WS_OATT + (size_t)T * 512 * 2);
constexpr size_t WS_QP    = WS_PROJ;
constexpr size_t WS_EIDX  = al256(WS_QP + (size_t)T * D * 2);
constexpr size_t WS_EW    = al256(WS_EIDX + (size_t)T * 128 * 4);
constexpr size_t WS_END   = al256(WS_PROJ + (size_t)T * NPAD * 2);
static_assert(WS_EW + (size_t)T * 128 * 4 <= WS_END, "alias region");

constexpr int LDS_STAGE = 147456;
constexpr int LDS_MISC_OFF = LDS_STAGE;
constexpr int LDS_BYTES = LDS_STAGE + 256;

typedef unsigned short bf16_t;
__device__ __forceinline__ float bf2f(bf16_t b) { return __uint_as_float(((unsigned)b) << 16); }
__device__ __forceinline__ bf16_t f2bf(float f) { unsigned u = __float_as_uint(f); u += 0x7FFFu + ((u >> 16) & 1u); return (bf16_t)(u >> 16); }
__device__ __forceinline__ float bflo(unsigned w) { return __uint_as_float(w << 16); }
__device__ __forceinline__ float bfhi(unsigned w) { return __uint_as_float(w & 0xFFFF0000u); }
__device__ __forceinline__ unsigned pack2(float lo, float hi) { return (unsigned)f2bf(lo) | ((unsigned)f2bf(hi) << 16); }
__device__ __forceinline__ float gelu_tanh(float x) { const float u = 0.7978845608028654f * (x + 0.044715f * x * x * x); return 0.5f * x * (1.0f + tanhf(u)); }
__device__ __forceinline__ float sigmoidf_(float x) { return 1.0f / (1.0f + __expf(-x)); }
__device__ __forceinline__ float wave_sum(float v) {
#pragma unroll
    for (int o = 32; o >= 1; o >>= 1) v += __shfl_xor(v, o);
    return v; }
__device__ __forceinline__ float wave_max(float v) {
#pragma unroll
    for (int o = 32; o >= 1; o >>= 1) v = fmaxf(v, __shfl_xor(v, o));
    return v; }
__device__ __forceinline__ void lds_wave_sync() { asm volatile("s_waitcnt lgkmcnt(0)" ::: "memory"); }
__device__ __forceinline__ int rel_bucket(int dist) {
    const int n = dist > 0 ? dist : 0;
    if (n < 16) return n;
    const float lr = logf((float)n / 16.0f) / 2.0794415416798357f;
    const int large = 16 + (int)(lr * 16.0f);
    return large < 31 ? large : 31;
}

struct Frame {
    const float* in[23]; float* out; unsigned char* ws;
    LAS unsigned char* lds; int tid, lane, wave, G;
};

__device__ __forceinline__ void transpose_tile(const Frame& F, const float* src, int srcK, int srcN, bf16_t* dst, int dstK, int kt, int nt) {
    LAS float* tile = (LAS float*)F.lds;
    const int k0 = kt * 64, n0 = nt * 64;
    for (int i = F.tid; i < 4096; i += NTHREADS) { const int r = i >> 6, c = i & 63; const int k = k0 + r, n = n0 + c;
        tile[r * 65 + c] = (k < srcK && n < srcN) ? src[(size_t)k * srcN + n] : 0.0f; }
    __syncthreads();
    for (int i = F.tid; i < 4096; i += NTHREADS) { const int r = i >> 6, c = i & 63;
        dst[(size_t)(n0 + r) * dstK + k0 + c] = f2bf(tile[c * 65 + r]); }
    __syncthreads();
}
__device__ __forceinline__ void p0_prologue(const Frame& F) {
    const float* c = F.in[1]; const float* w_mod = F.in[4]; const float* b_mod = F.in[5];
    float* MOD = (float*)(F.ws + WS_MOD);
    constexpr int I_MOD = 192, I_WIN = 16 * 48, I_WOUT = 256, I_WQ = 256, I_U = 256, I_V = 256, I_KEYS = 2;
    constexpr int O_WIN = I_MOD, O_WOUT = O_WIN + I_WIN, O_WQ = O_WOUT + I_WOUT, O_U = O_WQ + I_WQ, O_V = O_U + I_U, O_KEYS = O_V + I_V, N_ITEMS = O_KEYS + I_KEYS;
    for (int it = blockIdx.x; it < N_ITEMS; it += F.G) {
        if (it < O_WIN) {
            const int idx = it * NTHREADS + F.tid; const int b = idx / 6144, j = idx % 6144;
            float acc = 0.f;
            for (int k = 0; k < D; ++k) { const float cv = c[b * D + k]; const float sv = cv / (1.0f + __expf(-cv)); acc += sv * w_mod[(size_t)k * 6144 + j]; }
            MOD[b * 6144 + j] = acc + b_mod[j];
        } else if (it < O_WOUT) { const int i = it - O_WIN; transpose_tile(F, F.in[6], D, NCOL, (bf16_t*)(F.ws + WS_WIN), D, i % 16, i / 16); }
        else if (it < O_WQ) { const int i = it - O_WOUT; transpose_tile(F, F.in[16], D, D, (bf16_t*)(F.ws + WS_WOUT), D, i % 16, i / 16); }
        else if (it < O_U) { const int i = it - O_WQ; transpose_tile(F, F.in[17], D, D, (bf16_t*)(F.ws + WS_WQ), D, i % 16, i / 16); }
        else if (it < O_KEYS) {
            const bool isv = it >= O_V; const int i = isv ? it - O_V : it - O_U;
            const float4* src = (const float4*)(isv ? F.in[20] : F.in[19]) + (size_t)i * 16384;
            uint2* dst = (uint2*)(F.ws + (isv ? WS_VB : WS_UB)) + (size_t)i * 16384;
            for (int q = F.tid; q < 16384; q += NTHREADS) { const float4 v = src[q]; dst[q] = make_uint2(pack2(v.x, v.y), pack2(v.z, v.w)); }
        } else {
            const int i = it - O_KEYS; const float4* src = (const float4*)F.in[18] + (size_t)i * 16384; uint2* dst = (uint2*)(F.ws + WS_KEYS) + (size_t)i * 16384;
            for (int q = F.tid; q < 16384; q += NTHREADS) { const float4 v = src[q]; dst[q] = make_uint2(pack2(v.x, v.y), pack2(v.z, v.w)); }
        }
    }
}

__device__ __forceinline__ void norm_mod_rows(const Frame& F, const float* x, const float* g, int sh_off, int sc_off, bf16_t* dst) {
    const float* MOD = (const float*)(F.ws + WS_MOD);
    const int gw = blockIdx.x * NWAVES + F.wave, nw = F.G * NWAVES;
    for (int t = gw; t < T; t += nw) {
        const int b = t / S; const float4* xr = (const float4*)(x + (size_t)t * D);
        float4 v[4]; float ss = 0.f;
#pragma unroll
        for (int i = 0; i < 4; ++i) { v[i] = xr[F.lane + 64 * i]; ss += v[i].x * v[i].x + v[i].y * v[i].y + v[i].z * v[i].z + v[i].w * v[i].w; }
        ss = wave_sum(ss); const float rstd = rsqrtf(ss * (1.0f / D) + EPS);
#pragma unroll
        for (int i = 0; i < 4; ++i) { const int col = (F.lane + 64 * i) * 4;
            const float4 gg = *(const float4*)(g + col), sc = *(const float4*)(MOD + b * 6144 + sc_off + col), sh = *(const float4*)(MOD + b * 6144 + sh_off + col);
            const float o0 = v[i].x * rstd * gg.x * (1.f + sc.x) + sh.x, o1 = v[i].y * rstd * gg.y * (1.f + sc.y) + sh.y, o2 = v[i].z * rstd * gg.z * (1.f + sc.z) + sh.z, o3 = v[i].w * rstd * gg.w * (1.f + sc.w) + sh.w;
            *(uint2*)(dst + (size_t)t * D + col) = make_uint2(pack2(o0, o1), pack2(o2, o3)); }
    }
}

__device__ __forceinline__ void p3_compress_naive(const Frame& F) {
    const bf16_t* PROJ = (const bf16_t*)(F.ws + WS_PROJ);
    LAS float* hid = (LAS float*)F.lds + F.wave * 64;
    const int gw = blockIdx.x * NWAVES + F.wave, nw = F.G * NWAVES;
    if (gw < 64) { bf16_t* dz = (bf16_t*)(F.ws + ((gw & 1) ? WS_VC : WS_KC)); dz[((size_t)(gw >> 1) * 128 + 127) * 64 + F.lane] = 0; }
    for (int u = gw; u < NB * NCMP * 2 * 2; u += nw) {
        const int kv = u & 1, g = (u >> 1) & 1, n = (u >> 2) % NCMP, b = (u >> 2) / NCMP;
        const float* pe = kv ? F.in[8] : F.in[7]; const float* w1 = kv ? F.in[11] : F.in[9]; const float* w2 = kv ? F.in[12] : F.in[10];
        const int cbase = (kv ? C_VC : C_KC) + g * 64;
        float acc = 0.f;
        for (int l = 0; l < 32; ++l) {
            const bf16_t* row = PROJ + (size_t)(b * S + 16 * n + l) * NPAD + cbase;
            for (int d = 0; d < 64; ++d) { const float a = bf2f(row[d]) + pe[l * 64 + d]; acc += a * w1[(size_t)(l * 64 + d) * 64 + F.lane]; }
        }
        hid[F.lane] = gelu_tanh(acc); lds_wave_sync();
        float o = 0.f;
        for (int j = 0; j < 64; ++j) o += hid[j] * w2[j * 64 + F.lane];
        bf16_t* dst = (bf16_t*)(F.ws + (kv ? WS_VC : WS_KC)); dst[((size_t)(b * 2 + g) * 128 + n) * 64 + F.lane] = f2bf(o);
        lds_wave_sync();
    }
}

__device__ __forceinline__ void dot4_row(const bf16_t* krow, const LAS float* qs, float (&acc)[4]) {
    const uint4* kr = (const uint4*)krow;
#pragma unroll 1
    for (int c = 0; c < 8; ++c) { asm volatile("" ::: "memory"); const uint4 w = kr[c]; const unsigned ww[4] = {w.x, w.y, w.z, w.w};
#pragma unroll
        for (int e = 0; e < 4; ++e) { const float k0 = bflo(ww[e]), k1 = bfhi(ww[e]); const int d = c * 8 + e * 2;
#pragma unroll
            for (int r = 0; r < 4; ++r) acc[r] += qs[r * 64 + d] * k0 + qs[r * 64 + d + 1] * k1; } }
}
__device__ __forceinline__ void p4_attn_naive(const Frame& F) {
    const bf16_t* PROJ = (const bf16_t*)(F.ws + WS_PROJ); const bf16_t* KC = (const bf16_t*)(F.ws + WS_KC); const bf16_t* VC = (const bf16_t*)(F.ws + WS_VC);
    bf16_t* OATT = (bf16_t*)(F.ws + WS_OATT); const float* rel = F.in[21];
    LAS float* wl = (LAS float*)F.lds + F.wave * (256 + 512 + 2048 + 16);
    LAS float* qs = wl; LAS float* pc = wl + 256; LAS float* ps = wl + 768; LAS int* pbase = (LAS int*)(wl + 768 + 2048);
    const int gw = blockIdx.x * NWAVES + F.wave, nw = F.G * NWAVES, lane = F.lane;
    for (int u = gw; u < T * 2; u += nw) {
        const int g = u & 1, tok = u >> 1, b = tok / S, t = tok % S;
        const bf16_t* prow = PROJ + (size_t)tok * NPAD;
#pragma unroll
        for (int r = 0; r < 4; ++r) qs[r * 64 + lane] = bf2f(prow[C_Q + (g * 4 + r) * 64 + lane]) * 0.125f;
        lds_wave_sync();
        const int nv = t >= 31 ? ((t - 31) >> 4) + 1 : 0;
        float sc[2][4]; bool va[2];
#pragma unroll
        for (int i = 0; i < 2; ++i) { const int n = lane + 64 * i; va[i] = n < nv; float a[4] = {0.f, 0.f, 0.f, 0.f};
            if (va[i]) { dot4_row(KC + ((size_t)(b * 2 + g) * 128 + n) * 64, qs, a); const int bk = rel_bucket(t - (16 * n + 31));
#pragma unroll
                for (int r = 0; r < 4; ++r) a[r] += rel[bk * 8 + g * 4 + r]; }
#pragma unroll
            for (int r = 0; r < 4; ++r) sc[i][r] = va[i] ? a[r] : -1e30f; }
        float ocmp[4];
#pragma unroll
        for (int r = 0; r < 4; ++r) { const float m = wave_max(fmaxf(sc[0][r], sc[1][r]));
            const float e0 = va[0] ? __expf(sc[0][r] - m) : 0.f, e1 = va[1] ? __expf(sc[1][r] - m) : 0.f; const float sum = wave_sum(e0 + e1);
            const float inv = nv > 0 ? 1.0f / sum : 0.f; pc[r * 128 + lane] = e0 * inv; pc[r * 128 + 64 + lane] = e1 * inv; }
        lds_wave_sync();
        { float o[4] = {0.f, 0.f, 0.f, 0.f}; const bf16_t* vb = VC + ((size_t)(b * 2 + g) * 128) * 64 + lane;
            for (int n = 0; n < nv; ++n) { const float v = bf2f(vb[n * 64]);
#pragma unroll
                for (int r = 0; r < 4; ++r) o[r] += pc[r * 128 + n] * v; }
#pragma unroll
            for (int r = 0; r < 4; ++r) ocmp[r] = o[r]; }
        const int cur = t >> 6; float val;
        { const int j = lane & 31; float imp = 0.f;
#pragma unroll
            for (int r = 0; r < 4; ++r) for (int n = 4 * j - 1; n <= 4 * j + 3; ++n) if (n >= 0 && n < NCMP) imp += pc[r * 128 + n];
            const bool forced = (j == 0) || (j == cur) || (j == cur - 1); const bool allowed = j <= cur;
            val = forced ? 1e4f : (allowed ? imp : -INFINITY); }
        int rank = 0;
        for (int jp = 0; jp < 32; ++jp) { const float vp = __shfl(val, jp); rank += ((vp > val) || (vp == val && jp < (lane & 31))) ? 1 : 0; }
        unsigned selmask = (unsigned)(__ballot(lane < 32 && rank < 8) & 0xFFFFFFFFull);
        float oslc[4], owin[4];
#pragma unroll
        for (int br = 0; br < 2; ++br) {
            const int ck = br == 0 ? C_KS : C_KW, cv = br == 0 ? C_VS : C_VW;
            unsigned mk = selmask;
#pragma unroll 1
            for (int c = 0; c < 8; ++c) {
                int kpos, bs;
                if (br == 0) { const int j = __builtin_ctz(mk | 0x80000000u); mk &= mk - 1; bs = 64 * j; } else { bs = t - 511 + 64 * c; }
                kpos = bs + lane; if (lane == 0) pbase[c] = bs;
                const int dist = t - kpos; const bool vv = (dist >= 0) && (kpos >= 0) && (kpos < S);
                float a[4] = {0.f, 0.f, 0.f, 0.f};
                if (vv) { dot4_row(PROJ + (size_t)(b * S + kpos) * NPAD + ck + g * 64, qs, a); const int bk = rel_bucket(dist);
#pragma unroll
                    for (int r = 0; r < 4; ++r) a[r] += rel[bk * 8 + g * 4 + r]; }
#pragma unroll
                for (int r = 0; r < 4; ++r) ps[r * 512 + c * 64 + lane] = vv ? a[r] : -1e30f;
            }
            lds_wave_sync();
#pragma unroll 1
            for (int r = 0; r < 4; ++r) { float m = -1e30f;
#pragma unroll
                for (int c = 0; c < 8; ++c) m = fmaxf(m, ps[r * 512 + c * 64 + lane]);
                m = wave_max(m); float e[8], sum = 0.f;
#pragma unroll
                for (int c = 0; c < 8; ++c) { const float sv = ps[r * 512 + c * 64 + lane]; e[c] = sv > -1e29f ? __expf(sv - m) : 0.f; sum += e[c]; }
                sum = wave_sum(sum); const float inv = sum > 0.f ? 1.0f / sum : 0.f;
#pragma unroll
                for (int c = 0; c < 8; ++c) ps[r * 512 + c * 64 + lane] = e[c] * inv; }
            lds_wave_sync();
            float o[4] = {0.f, 0.f, 0.f, 0.f};
#pragma unroll 1
            for (int c = 0; c < 8; ++c) {
                const int bsc = pbase[c];
                for (int kk = 0; kk < 64; ++kk) { const int kpos = bsc + kk; if (kpos < 0 || kpos > t) continue;
                    const float v = bf2f(PROJ[(size_t)(b * S + kpos) * NPAD + cv + g * 64 + lane]);
#pragma unroll
                    for (int r = 0; r < 4; ++r) o[r] += ps[r * 512 + c * 64 + kk] * v; } }
            lds_wave_sync();
#pragma unroll
            for (int r = 0; r < 4; ++r) { if (br == 0) oslc[r] = o[r]; else owin[r] = o[r]; }
        }
#pragma unroll
        for (int r = 0; r < 4; ++r) { const int h = g * 4 + r;
            const float g0 = sigmoidf_(bf2f(prow[C_GT + h * 3 + 0])), g1 = sigmoidf_(bf2f(prow[C_GT + h * 3 + 1])), g2 = sigmoidf_(bf2f(prow[C_GT + h * 3 + 2]));
            OATT[(size_t)tok * 512 + h * 64 + lane] = f2bf(g0 * ocmp[r] + g1 * oslc[r] + g2 * owin[r]); }
    }
}


typedef short bf16x8 __attribute__((ext_vector_type(8)));
typedef short s16x4 __attribute__((ext_vector_type(4)));
typedef float f32x4 __attribute__((ext_vector_type(4)));
typedef unsigned u32x4v __attribute__((ext_vector_type(4)));
constexpr float LOG2E = 1.4426950408889634f;
constexpr int AT_KC = 0, AT_VC = 16384, AT_KV = 32768  , AT_BTAB = 65536, AT_IMP = 69888, AT_SEL = 78336, AT_OUT = 78592  , AT_END = 78592 + 65536;
constexpr int BT_STRIDE = 132;
__device__ __forceinline__ int tile_off(int row, int chunk) { return row * 128 + ((chunk ^ (row & 7)) << 4); }
__device__ __forceinline__ bf16x8 mk_frag(unsigned a, unsigned b, unsigned c, unsigned d) { u32x4v v = {a, b, c, d}; return __builtin_bit_cast(bf16x8, v); }
struct LaneOffs { int koff[2]; int voff[4]; int soff; };
__device__ __forceinline__ LaneOffs lane_offs(int lane, int tid) {
    LaneOffs L; const int grp = lane >> 4, rowi = lane & 15, q4 = rowi >> 2, p = lane & 3;
#pragma unroll
    for (int ks = 0; ks < 2; ++ks) L.koff[ks] = tile_off(rowi, ks * 4 + grp);
#pragma unroll
    for (int dt = 0; dt < 4; ++dt) L.voff[dt] = tile_off(4 * grp + q4, 2 * dt + (p >> 1)) + 8 * (p & 1);
    L.soff = tile_off(tid >> 3, tid & 7); return L;
}
__device__ __forceinline__ bf16x8 vfrag_read(const LAS unsigned char* vt, int voff_dt, int row0) {
    const s16x4 a = __builtin_amdgcn_ds_read_tr16_b64_v4i16((LAS s16x4*)(vt + voff_dt + row0 * 128));
    const s16x4 b = __builtin_amdgcn_ds_read_tr16_b64_v4i16((LAS s16x4*)(vt + voff_dt + row0 * 128 + 2048));
    bf16x8 f = {a[0], a[1], a[2], a[3], b[0], b[1], b[2], b[3]}; return f;
}

struct AttnState {
    f32x4 o[4][2]; float m[2], l[2];
};

template <int BR>
__device__ __forceinline__ void attn_tile(const LAS unsigned char* kt_lds, const LAS unsigned char* vt_lds, const LAS float* btab_h, const bf16x8 (&qf)[2][2], const int (&tq)[2], const unsigned (&sel)[2],
                                          int j, bool near, AttnState& st, int lane, const LaneOffs& L) {
    const int grp = lane >> 4, kbase = 64 * j;
    f32x4 sacc[4][2];
#pragma unroll
    for (int kt = 0; kt < 4; ++kt) { sacc[kt][0] = (f32x4){0.f, 0.f, 0.f, 0.f}; sacc[kt][1] = (f32x4){0.f, 0.f, 0.f, 0.f}; }
#pragma unroll
    for (int kt = 0; kt < 4; ++kt)
#pragma unroll
        for (int ks = 0; ks < 2; ++ks) { const bf16x8 kf = *(const LAS bf16x8*)(kt_lds + L.koff[ks] + kt * 2048);
            sacc[kt][0] = __builtin_amdgcn_mfma_f32_16x16x32_bf16(kf, qf[0][ks], sacc[kt][0], 0, 0, 0);
            sacc[kt][1] = __builtin_amdgcn_mfma_f32_16x16x32_bf16(kf, qf[1][ks], sacc[kt][1], 0, 0, 0); }
    __builtin_amdgcn_sched_barrier(0);
    const float SC = 0.125f * LOG2E; const float bfar = btab_h[128];
    bf16x8 pf[2][2];
#pragma unroll
    for (int qt = 0; qt < 2; ++qt) {
        const int t = tq[qt]; const bool selq = BR == 0 ? ((sel[qt] >> j) & 1u) != 0u : true;
        float sv[4][4]; float tmax = -1e30f;
        int d0 = t - 4 * grp - kbase; asm volatile("" : "+v"(d0));
        if (near) {
#pragma unroll
            for (int kt = 0; kt < 4; ++kt)
#pragma unroll
                for (int rg = 0; rg < 4; ++rg) { const int dist = d0 - (kt * 16 + rg); const int dd = dist < 0 ? 0 : (dist > 128 ? 128 : dist); sv[kt][rg] = btab_h[dd]; }
        } else {
#pragma unroll
            for (int kt = 0; kt < 4; ++kt)
#pragma unroll
                for (int rg = 0; rg < 4; ++rg) sv[kt][rg] = bfar;
        }
#pragma unroll
        for (int kt = 0; kt < 4; ++kt)
#pragma unroll
            for (int rg = 0; rg < 4; ++rg) { const int c = kt * 16 + rg;
                const bool valid = BR == 0 ? (selq && d0 >= c) : (d0 >= c && d0 < 512 + c);
                const float sx = sacc[kt][qt][rg] * SC + sv[kt][rg]; const float s = valid ? sx : -1e30f; sv[kt][rg] = s; tmax = fmaxf(tmax, s); }
        tmax = fmaxf(tmax, __shfl_xor(tmax, 16)); tmax = fmaxf(tmax, __shfl_xor(tmax, 32));
        const float mnew = fmaxf(st.m[qt], tmax); const float alpha = __builtin_amdgcn_exp2f(st.m[qt] - mnew); st.m[qt] = mnew;
        const float muse = mnew < -1e29f ? 0.f : mnew;
        float ls = 0.f; unsigned pk[4][2];
#pragma unroll
        for (int kt = 0; kt < 4; ++kt) { float e[4];
#pragma unroll
            for (int rg = 0; rg < 4; ++rg) { e[rg] = __builtin_amdgcn_exp2f(sv[kt][rg] - muse); ls += e[rg]; }
            pk[kt][0] = pg8::cvt_pk_bf16(e[0], e[1]); pk[kt][1] = pg8::cvt_pk_bf16(e[2], e[3]); }
        st.l[qt] = st.l[qt] * alpha + ls;
#pragma unroll
        for (int dt = 0; dt < 4; ++dt) st.o[dt][qt] *= alpha;
        pf[qt][0] = mk_frag(pk[0][0], pk[0][1], pk[1][0], pk[1][1]); pf[qt][1] = mk_frag(pk[2][0], pk[2][1], pk[3][0], pk[3][1]);
        __builtin_amdgcn_sched_barrier(0);
    }
#pragma unroll
    for (int ks = 0; ks < 2; ++ks)
#pragma unroll
        for (int dt = 0; dt < 4; ++dt) { const bf16x8 vf = vfrag_read(vt_lds, L.voff[dt], 32 * ks);
            st.o[dt][0] = __builtin_amdgcn_mfma_f32_16x16x32_bf16(vf, pf[0][ks], st.o[dt][0], 0, 0, 0);
            st.o[dt][1] = __builtin_amdgcn_mfma_f32_16x16x32_bf16(vf, pf[1][ks], st.o[dt][1], 0, 0, 0); }
}

template <int BR>
__device__ __forceinline__ void attn_branch(const Frame& F, const bf16_t* PROJ, int b, int g, int t0, unsigned tiles  , const LAS float* btab_h,
                                            const bf16x8 (&qf)[2][2], const int (&tq)[2], const unsigned (&sel)[2], const float (&gate)[2], const LaneOffs& L) {
    const int lane = F.lane, tid = F.tid;
    const int ck = (BR == 0 ? C_KS : C_KW) + g * 64, cv = (BR == 0 ? C_VS : C_VW) + g * 64;
    const int srow = tid >> 3, sch = tid & 7;
    AttnState st;
#pragma unroll
    for (int dt = 0; dt < 4; ++dt) { st.o[dt][0] = (f32x4){0.f, 0.f, 0.f, 0.f}; st.o[dt][1] = (f32x4){0.f, 0.f, 0.f, 0.f}; }
    st.m[0] = st.m[1] = -1e30f; st.l[0] = st.l[1] = 0.f;
    unsigned rem = tiles; int cur = 0;
    u32x4v rk, rv;
    { const int j = __builtin_ctz(rem); const bf16_t* rowp = PROJ + (size_t)(b * S + 64 * j + srow) * NPAD + sch * 8;
        rk = *(const u32x4v*)(rowp + ck); rv = *(const u32x4v*)(rowp + cv);
        *(LAS u32x4v*)(F.lds + AT_KV + L.soff) = rk; *(LAS u32x4v*)(F.lds + AT_KV + 8192 + L.soff) = rv; }
    __syncthreads();
    while (rem) {
        const int j = __builtin_ctz(rem); rem &= rem - 1;
        const bool has_next = rem != 0u;
        if (has_next) { const int jn = __builtin_ctz(rem); const bf16_t* rowp = PROJ + (size_t)(b * S + 64 * jn + srow) * NPAD + sch * 8; rk = *(const u32x4v*)(rowp + ck); rv = *(const u32x4v*)(rowp + cv); }
        const bool near = (t0 + 8 * F.wave) - (64 * j + 63) < 128;
        attn_tile<BR>(F.lds + AT_KV + cur * 16384, F.lds + AT_KV + cur * 16384 + 8192, btab_h, qf, tq, sel, j, near, st, lane, L);
        if (has_next) { *(LAS u32x4v*)(F.lds + AT_KV + (cur ^ 1) * 16384 + L.soff) = rk; *(LAS u32x4v*)(F.lds + AT_KV + (cur ^ 1) * 16384 + 8192 + L.soff) = rv; }
        __syncthreads();
        cur ^= 1;
    }
    int pob = AT_OUT + tid * 4; asm volatile("" : "+v"(pob));
    LAS float* po = (LAS float*)(F.lds + pob);
#pragma unroll
    for (int qt = 0; qt < 2; ++qt) { float l = st.l[qt]; l += __shfl_xor(l, 16); l += __shfl_xor(l, 32); const float sc = l > 0.f ? gate[qt] / l : 0.f;
#pragma unroll
        for (int dt = 0; dt < 4; ++dt)
#pragma unroll
            for (int e = 0; e < 4; ++e) po[((qt * 4 + dt) * 4 + e) * 512] += st.o[dt][qt][e] * sc; }
}

__device__ __forceinline__ void p4_attn_mfma(const Frame& F) {
    const bf16_t* PROJ = (const bf16_t*)(F.ws + WS_PROJ); const bf16_t* KC = (const bf16_t*)(F.ws + WS_KC); const bf16_t* VC = (const bf16_t*)(F.ws + WS_VC);
    bf16_t* OATT = (bf16_t*)(F.ws + WS_OATT); const float* rel = F.in[21];
    const int lane = F.lane, tid = F.tid, wave = F.wave, grp = lane >> 4, col = lane & 15, qi = col >> 2, r = col & 3;
    LAS float* btab = (LAS float*)(F.lds + AT_BTAB); LAS float* impq = (LAS float*)(F.lds + AT_IMP); LAS unsigned* selm = (LAS unsigned*)(F.lds + AT_SEL);
    const LaneOffs L = lane_offs(lane, tid);
    for (int i = tid; i < 8 * 129; i += NTHREADS) { const int hh = i / 129, dd = i % 129; btab[hh * BT_STRIDE + dd] = rel[rel_bucket(dd) * 8 + hh] * LOG2E; }
    __syncthreads();
    for (int uu = blockIdx.x; uu < 1024; uu += F.G) {
        int sidx = uu;
        if (F.G == 256) { const int round = uu >> 8, k = uu & 255; sidx = (round == 0) ? k : (round == 1) ? 511 - k : (round == 2) ? 512 + k : 1023 - k; }
        const int qb = 31 - (sidx >> 5), bg = sidx & 31, b = bg >> 1, g = bg & 1, t0 = qb * 64, h = g * 4 + r;
        const LAS float* btab_h = btab + h * BT_STRIDE;
        int tq[2]; bf16x8 qf[2][2]; float gate[3][2];
#pragma unroll
        for (int qt = 0; qt < 2; ++qt) { tq[qt] = t0 + 8 * wave + 4 * qt + qi; const bf16_t* prow = PROJ + (size_t)(b * S + tq[qt]) * NPAD;
#pragma unroll
            for (int ks = 0; ks < 2; ++ks) qf[qt][ks] = *(const bf16x8*)(prow + C_Q + h * 64 + ks * 32 + 8 * grp);
#pragma unroll
            for (int jg = 0; jg < 3; ++jg) gate[jg][qt] = sigmoidf_(bf2f(prow[C_GT + h * 3 + jg])); }
#pragma unroll
        for (int i = 0; i < 2; ++i) { const int c2 = tid + 512 * i, row = c2 >> 3, ch = c2 & 7; const size_t src = ((size_t)(b * 2 + g) * 128 + row) * 64 + ch * 8;
            *(LAS u32x4v*)(F.lds + AT_KC + L.soff + 8192 * i) = *(const u32x4v*)(KC + src); *(LAS u32x4v*)(F.lds + AT_VC + L.soff + 8192 * i) = *(const u32x4v*)(VC + src); }
        __syncthreads();
#ifndef AT_SKIP_CMP
        {
            const int nvmax = t0 + 63 >= 31 ? ((t0 + 63 - 31) >> 4) + 1 : 0;
            const float SC = 0.125f * LOG2E; const int srcl = (lane + 48) & 63;
            int pob = AT_OUT + tid * 4; asm volatile("" : "+v"(pob));
            LAS float* po = (LAS float*)(F.lds + pob);
#pragma unroll
            for (int qt = 0; qt < 2; ++qt) {
                f32x4 sa[8];
#pragma unroll
                for (int kt = 0; kt < 8; ++kt) sa[kt] = (f32x4){0.f, 0.f, 0.f, 0.f};
#pragma unroll
                for (int kt = 0; kt < 8; ++kt) if (kt * 16 < nvmax) {
#pragma unroll
                    for (int ks = 0; ks < 2; ++ks) { const bf16x8 kf = *(const LAS bf16x8*)(F.lds + AT_KC + L.koff[ks] + kt * 2048);
                        sa[kt] = __builtin_amdgcn_mfma_f32_16x16x32_bf16(kf, qf[qt][ks], sa[kt], 0, 0, 0); } }
                __builtin_amdgcn_sched_barrier(0);
                int d0 = tq[qt] - 31 - 64 * grp; asm volatile("" : "+v"(d0));
                float mx = -1e30f;
#pragma unroll
                for (int kt = 0; kt < 8; ++kt)
#pragma unroll
                    for (int rg = 0; rg < 4; ++rg) { const int c = 256 * kt + 16 * rg; const int dist = d0 - c; const int dd = dist < 0 ? 0 : (dist > 128 ? 128 : dist);
                        const float sx = sa[kt][rg] * SC + btab_h[dd]; const float s = d0 >= c ? sx : -1e30f; sa[kt][rg] = s; mx = fmaxf(mx, s); }
                mx = fmaxf(mx, __shfl_xor(mx, 16)); mx = fmaxf(mx, __shfl_xor(mx, 32));
                float sum = 0.f;
#pragma unroll
                for (int kt = 0; kt < 8; ++kt)
#pragma unroll
                    for (int rg = 0; rg < 4; ++rg) { const int c = 256 * kt + 16 * rg; const float ex = __builtin_amdgcn_exp2f(sa[kt][rg] - mx); const float e = d0 >= c ? ex : 0.f; sa[kt][rg] = e; sum += e; }
                __builtin_amdgcn_sched_barrier(0);
                sum += __shfl_xor(sum, 16); sum += __shfl_xor(sum, 32);
                const float inv = sum > 0.f ? 1.0f / sum : 0.f;
                float prev3 = 0.f;
#pragma unroll
                for (int kt = 0; kt < 8; ++kt) { const float p3 = sa[kt][3] * inv; const float part = (sa[kt][0] * inv + sa[kt][1] * inv) + (sa[kt][2] * inv + p3);
                    const float xa = __shfl(p3, srcl), xb = __shfl(prev3, srcl); float tot = part + (grp >= 1 ? xa : xb);
                    tot += __shfl_xor(tot, 1); tot += __shfl_xor(tot, 2);
                    if (r == 0) impq[(8 * wave + 4 * qt + qi) * 33 + 4 * kt + grp] = tot;
                    prev3 = p3; }
                __builtin_amdgcn_sched_barrier(0);
                f32x4 oc[4];
#pragma unroll
                for (int dt = 0; dt < 4; ++dt) oc[dt] = (f32x4){0.f, 0.f, 0.f, 0.f};
#pragma unroll
                for (int ks = 0; ks < 4; ++ks) if (ks * 32 < nvmax) {
                    const bf16x8 pfr = mk_frag(pg8::cvt_pk_bf16(sa[2 * ks][0], sa[2 * ks][1]), pg8::cvt_pk_bf16(sa[2 * ks][2], sa[2 * ks][3]),
                                               pg8::cvt_pk_bf16(sa[2 * ks + 1][0], sa[2 * ks + 1][1]), pg8::cvt_pk_bf16(sa[2 * ks + 1][2], sa[2 * ks + 1][3]));
#pragma unroll
                    for (int dt = 0; dt < 4; ++dt) { const bf16x8 vf = vfrag_read(F.lds + AT_VC, L.voff[dt], 32 * ks); oc[dt] = __builtin_amdgcn_mfma_f32_16x16x32_bf16(vf, pfr, oc[dt], 0, 0, 0); } }
                const float scq = inv * gate[0][qt];
#pragma unroll
                for (int dt = 0; dt < 4; ++dt)
#pragma unroll
                    for (int e = 0; e < 4; ++e) po[((qt * 4 + dt) * 4 + e) * 512] = oc[dt][e] * scq;
                __builtin_amdgcn_sched_barrier(0);
            }
        }
#endif
        __syncthreads();
#ifndef AT_SKIP_SEL
        {
            const int q = tid >> 3, jj = tid & 7, cur = qb; unsigned bits = 0u;
            float vj[4];
#pragma unroll
            for (int e = 0; e < 4; ++e) { const int j = jj * 4 + e; const bool forced = (j == 0) || (j == cur) || (j == cur - 1); vj[e] = forced ? 1e4f : (j <= cur ? impq[q * 33 + j] : -INFINITY); }
            int rk[4] = {0, 0, 0, 0};
            for (int jp = 0; jp < 32; ++jp) { const bool forced = (jp == 0) || (jp == cur) || (jp == cur - 1); const float vp = forced ? 1e4f : (jp <= cur ? impq[q * 33 + jp] : -INFINITY);
#pragma unroll
                for (int e = 0; e < 4; ++e) rk[e] += ((vp > vj[e]) || (vp == vj[e] && jp < jj * 4 + e)) ? 1 : 0; }
#pragma unroll
            for (int e = 0; e < 4; ++e) bits |= (rk[e] < 8 ? 1u : 0u) << (jj * 4 + e);
            bits |= __shfl_xor(bits, 1); bits |= __shfl_xor(bits, 2); bits |= __shfl_xor(bits, 4);
            if (jj == 0) selm[q] = bits;
        }
#endif
        __syncthreads();
        unsigned sel[2] = {selm[8 * wave + qi], selm[8 * wave + 4 + qi]};
        unsigned un = selm[lane];
#pragma unroll
        for (int o = 32; o >= 1; o >>= 1) un |= __shfl_xor(un, o);
        un = __builtin_amdgcn_readfirstlane(un);
        const unsigned causal = qb == 31 ? 0xFFFFFFFFu : ((2u << qb) - 1u);
#ifndef AT_SKIP_BR0
        { const float gt1[2] = {gate[1][0], gate[1][1]}; attn_branch<0>(F, PROJ, b, g, t0, un & causal, btab_h, qf, tq, sel, gt1, L); }
#endif
#ifndef AT_SKIP_BR1
        { const int jlo = qb >= 8 ? qb - 8 : 0; const unsigned wmask = causal & ~((1u << jlo) - 1u); const float gt2[2] = {gate[2][0], gate[2][1]};
            attn_branch<1>(F, PROJ, b, g, t0, wmask, btab_h, qf, tq, sel, gt2, L); }
#endif
        int pob2 = AT_OUT + tid * 4; asm volatile("" : "+v"(pob2));
#pragma unroll
        for (int qt = 0; qt < 2; ++qt) { bf16_t* orow = OATT + (size_t)(b * S + tq[qt]) * 512 + h * 64 + 4 * grp;
#pragma unroll
            for (int dt = 0; dt < 4; ++dt) { const LAS float* po = (const LAS float*)(F.lds + pob2) + (qt * 4 + dt) * 4 * 512;
                *(uint2*)(orow + dt * 16) = make_uint2(pg8::cvt_pk_bf16(po[0], po[512]), pg8::cvt_pk_bf16(po[1024], po[1536])); } }
    }
}
__device__ __forceinline__ void p5_mixed(const Frame& F) {
    const bf16_t* PROJ = (const bf16_t*)(F.ws + WS_PROJ); const bf16_t* OATT = (const bf16_t*)(F.ws + WS_OATT); bf16_t* MIX = (bf16_t*)(F.ws + WS_H);
    const float* cw = F.in[13]; const float* ga = F.in[14]; const float* gc = F.in[15];
    const int gw = blockIdx.x * NWAVES + F.wave, nw = F.G * NWAVES, lane = F.lane;
    for (int tok = gw; tok < T; tok += nw) {
        const int s = tok % S; const int c0 = lane * 8;
        float a[8], y[8];
        { const uint4 w = *(const uint4*)(OATT + (size_t)tok * 512 + c0); const unsigned ww[4] = {w.x, w.y, w.z, w.w};
#pragma unroll
            for (int e = 0; e < 4; ++e) { a[2 * e] = bflo(ww[e]); a[2 * e + 1] = bfhi(ww[e]); } }
#pragma unroll
        for (int e = 0; e < 8; ++e) y[e] = 0.f;
#pragma unroll
        for (int dt = 0; dt < 3; ++dt) { if (s - 2 + dt >= 0) { const bf16_t* row = PROJ + (size_t)(tok - 2 + dt) * NPAD;
                const uint4 wc = *(const uint4*)(row + C_CC + c0), wh = *(const uint4*)(row + C_CH + c0); const unsigned c4[4] = {wc.x, wc.y, wc.z, wc.w}, h4[4] = {wh.x, wh.y, wh.z, wh.w};
#pragma unroll
                for (int e = 0; e < 4; ++e) { y[2 * e] += cw[dt * 512 + c0 + 2 * e] * (bflo(c4[e]) * bflo(h4[e])); y[2 * e + 1] += cw[dt * 512 + c0 + 2 * e + 1] * (bfhi(c4[e]) * bfhi(h4[e])); } } }
        { const uint4 wb = *(const uint4*)(PROJ + (size_t)tok * NPAD + C_CB + c0); const unsigned b4[4] = {wb.x, wb.y, wb.z, wb.w};
#pragma unroll
            for (int e = 0; e < 4; ++e) { y[2 * e] *= bflo(b4[e]); y[2 * e + 1] *= bfhi(b4[e]); } }
        float sa = 0.f, sy = 0.f;
#pragma unroll
        for (int e = 0; e < 8; ++e) { sa += a[e] * a[e]; sy += y[e] * y[e]; }
        sa = wave_sum(sa); sy = wave_sum(sy);
        const float ra = rsqrtf(sa * (1.0f / 512) + EPS), ry = rsqrtf(sy * (1.0f / 512) + EPS);
        unsigned oa[4], oy[4];
#pragma unroll
        for (int e = 0; e < 4; ++e) { oa[e] = pack2(a[2 * e] * ra * ga[c0 + 2 * e], a[2 * e + 1] * ra * ga[c0 + 2 * e + 1]); oy[e] = pack2(y[2 * e] * ry * gc[c0 + 2 * e], y[2 * e + 1] * ry * gc[c0 + 2 * e + 1]); }
        *(uint4*)(MIX + (size_t)tok * D + c0) = make_uint4(oa[0], oa[1], oa[2], oa[3]);
        *(uint4*)(MIX + (size_t)tok * D + 512 + c0) = make_uint4(oy[0], oy[1], oy[2], oy[3]);
    }
}

struct EpiResGate {
    static constexpr bool PERM = false, AFTER_DRAIN = false;
    float* C; const float* X; const float* MOD; int gate_off;
    __device__ __forceinline__ void operator()(const pg8::f32x4 (&acc)[2][2][4][2], const pg8::Unit& u, int wr, int wc, int fr, int fq) const {
        using pg8::f32x4; using pg8::HALF; using pg8::BM;
        const int row0 = u.pm * BM + wr * 64 + fr, col0 = u.pn * BM + wc * 32 + 4 * fq;
        const int b = (u.pm * BM) / S;
        f32x4 gv[2][2];
#pragma unroll
        for (int bj = 0; bj < 2; ++bj)
#pragma unroll
            for (int n = 0; n < 2; ++n) gv[bj][n] = *(const f32x4*)(MOD + b * 6144 + gate_off + col0 + bj * HALF + n * 16);
#pragma unroll
        for (int ai = 0; ai < 2; ++ai)
#pragma unroll
            for (int m = 0; m < 4; ++m) { const size_t ro = (size_t)(row0 + ai * HALF + m * 16) * D + col0;
#pragma unroll
                for (int bj = 0; bj < 2; ++bj)
#pragma unroll
                    for (int n = 0; n < 2; ++n) { const f32x4 xv = *(const f32x4*)(X + ro + bj * HALF + n * 16); *(f32x4*)(C + ro + bj * HALF + n * 16) = xv + gv[bj][n] * acc[ai][bj][m][n]; } }
    }
};

__device__ __forceinline__ void argmax_bfly(float& v, int& i) {
#pragma unroll
    for (int o = 32; o >= 1; o >>= 1) { const float ov = __shfl_xor(v, o); const int oi = __shfl_xor(i, o); if (ov > v || (ov == v && oi < i)) { v = ov; i = oi; } }
}
__device__ __forceinline__ void p9_route_naive(const Frame& F) {
    const bf16_t* QP = (const bf16_t*)(F.ws + WS_QP); const bf16_t* KEYS = (const bf16_t*)(F.ws + WS_KEYS);
    int* EIDX = (int*)(F.ws + WS_EIDX); float* EW = (float*)(F.ws + WS_EW);
    LAS float* ql = (LAS float*)F.lds + F.wave * 128;
    const int gw = blockIdx.x * NWAVES + F.wave, nw = F.G * NWAVES, lane = F.lane;
    for (int u = gw; u < T * 8; u += nw) {
        const int h = u & 7, tok = u >> 3;
        ql[lane] = bf2f(QP[(size_t)tok * D + h * 128 + lane]); ql[64 + lane] = bf2f(QP[(size_t)tok * D + h * 128 + 64 + lane]);
        lds_wave_sync();
        float tv[2]; int ti[2];
#pragma unroll
        for (int p = 0; p < 2; ++p) {
            float s[2];
#pragma unroll
            for (int kk = 0; kk < 2; ++kk) { const uint4* kr = (const uint4*)(KEYS + ((size_t)(h * 2 + p) * 128 + lane + 64 * kk) * 64); float a = 0.f;
#pragma unroll
                for (int c = 0; c < 8; ++c) { const uint4 w = kr[c]; const unsigned ww[4] = {w.x, w.y, w.z, w.w};
#pragma unroll
                    for (int e = 0; e < 4; ++e) a += ql[p * 64 + c * 8 + 2 * e] * bflo(ww[e]) + ql[p * 64 + c * 8 + 2 * e + 1] * bfhi(ww[e]); }
                s[kk] = a; }
            tv[p] = 0.f; ti[p] = 0;
            for (int i = 0; i < 16; ++i) {
                float v = s[0]; int ix = lane; if (s[1] > v) { v = s[1]; ix = lane + 64; }
                argmax_bfly(v, ix);
                if (lane == i) { tv[p] = v; ti[p] = ix; }
                if (ix == lane) s[0] = -INFINITY; if (ix == lane + 64) s[1] = -INFINITY;
            }
        }
        float cd[4];
        { const float va = __shfl(tv[0], lane >> 2);
#pragma unroll
            for (int i = 0; i < 4; ++i) cd[i] = va + __shfl(tv[1], (lane & 3) * 4 + i); }
        float cs = 0.f; int cc = 0;
        for (int it = 0; it < 16; ++it) {
            float v = cd[0]; int ix = lane * 4;
#pragma unroll
            for (int i = 1; i < 4; ++i) if (cd[i] > v) { v = cd[i]; ix = lane * 4 + i; }
            argmax_bfly(v, ix);
            if (lane == it) { cs = v; cc = ix; }
#pragma unroll
            for (int i = 0; i < 4; ++i) if (ix == lane * 4 + i) cd[i] = -INFINITY;
        }
        const int i1 = __shfl(ti[0], cc >> 4), i2 = __shfl(ti[1], cc & 15);
        const float m = __shfl(cs, 0); float ex = lane < 16 ? __expf(cs - m) : 0.f; const float sum = wave_sum(ex);
        if (lane < 16) { EIDX[(size_t)tok * 128 + h * 16 + lane] = i1 * 128 + i2; EW[(size_t)tok * 128 + h * 16 + lane] = ex / sum; }
        lds_wave_sync();
    }
}


__device__ __forceinline__ int ord_i(float f) { const int u = __float_as_int(f); return u >= 0 ? u : (u ^ 0x7FFFFFFF); }
__device__ __forceinline__ float unord_f(int i) { const int u = i >= 0 ? i : (i ^ 0x7FFFFFFF); return __int_as_float(u); }
#define INT_MIN_ (-2147483647 - 1)
struct CandTab { int a[50], b[50]; };
constexpr CandTab make_cand() { CandTab t{}; int n = 0; for (int a = 0; a < 16; ++a) for (int b = 0; b < 16; ++b) if ((a + 1) * (b + 1) <= 16) { t.a[n] = a; t.b[n] = b; ++n; } return t; }
constexpr CandTab CAND = make_cand();
constexpr int RT_LDS_PER_WAVE = 16 * 32 * 4;
__device__ __forceinline__ void p9_route_mfma(const Frame& F) {
    const bf16_t* QP = (const bf16_t*)(F.ws + WS_QP); const bf16_t* KEYS = (const bf16_t*)(F.ws + WS_KEYS);
    int* EIDX = (int*)(F.ws + WS_EIDX); float* EW = (float*)(F.ws + WS_EW);
    const int lane = F.lane, grp = lane >> 4, col = lane & 15;
    LAS int* itab = (LAS int*)(F.lds + F.wave * RT_LDS_PER_WAVE) + col * 32;
    const int gw = blockIdx.x * NWAVES + F.wave, nw = F.G * NWAVES;
    for (int task = gw; task < (T / 16) * 8; task += nw) {
        const int h = task & 7, tile = task >> 3, tok = tile * 16 + col;
        int lst[2][16];
#pragma unroll
        for (int p = 0; p < 2; ++p) {
            bf16x8 qf[2];
#pragma unroll
            for (int ks = 0; ks < 2; ++ks) qf[ks] = *(const bf16x8*)(QP + (size_t)tok * D + h * 128 + p * 64 + ks * 32 + 8 * grp);
            f32x4 sc[8];
#pragma unroll
            for (int kt = 0; kt < 8; ++kt) { sc[kt] = (f32x4){0.f, 0.f, 0.f, 0.f};
#pragma unroll
                for (int ks = 0; ks < 2; ++ks) { const bf16x8 kf = *(const bf16x8*)(KEYS + ((size_t)(h * 2 + p) * 128 + kt * 16 + col) * 64 + ks * 32 + 8 * grp);
                    sc[kt] = __builtin_amdgcn_mfma_f32_16x16x32_bf16(kf, qf[ks], sc[kt], 0, 0, 0); } }
            int r[32];
#pragma unroll
            for (int kt = 0; kt < 8; ++kt)
#pragma unroll
                for (int rg = 0; rg < 4; ++rg) r[kt * 4 + rg] = (ord_i(sc[kt][rg]) & ~0x7F) | (127 - (kt * 16 + 4 * grp + rg));
#pragma unroll
            for (int it = 0; it < 16; ++it) {
                int m = r[0];
#pragma unroll
                for (int i = 1; i < 32; ++i) m = max(m, r[i]);
                m = max(m, __shfl_xor(m, 16)); m = max(m, __shfl_xor(m, 32));
                lst[p][it] = m;
#pragma unroll
                for (int i = 0; i < 32; ++i) r[i] = (r[i] == m) ? INT_MIN_ : r[i];
            }
            if (grp == 0) {
#pragma unroll
                for (int it = 0; it < 16; ++it) itab[p * 16 + it] = 127 - (lst[p][it] & 0x7F);
            }
        }
        float v0[16], v1[16];
#pragma unroll
        for (int i = 0; i < 16; ++i) { v0[i] = unord_f(lst[0][i] & ~0x7F); v1[i] = unord_f(lst[1][i] & ~0x7F); }
        int ck[50];
#pragma unroll
        for (int i = 0; i < 50; ++i) ck[i] = (ord_i(v0[CAND.a[i]] + v1[CAND.b[i]]) & ~0xFF) | (255 - (CAND.a[i] * 16 + CAND.b[i]));
        int top[16];
#pragma unroll
        for (int it = 0; it < 16; ++it) {
            int m = ck[0];
#pragma unroll
            for (int i = 1; i < 50; ++i) m = max(m, ck[i]);
            top[it] = m;
#pragma unroll
            for (int i = 0; i < 50; ++i) ck[i] = (ck[i] == m) ? INT_MIN_ : ck[i];
        }
        lds_wave_sync();
        const float smax = unord_f(top[0] & ~0xFF);
        float ex[16], sum = 0.f;
#pragma unroll
        for (int it = 0; it < 16; ++it) { ex[it] = __expf(unord_f(top[it] & ~0xFF) - smax); sum += ex[it]; }
        const float inv = 1.0f / sum;
        if (grp == 0) {
#pragma unroll
            for (int it = 0; it < 16; ++it) { const int flat = 255 - (top[it] & 0xFF); const int i1 = itab[flat >> 4], i2 = itab[16 + (flat & 15)];
                EIDX[(size_t)tok * 128 + h * 16 + it] = i1 * 128 + i2; EW[(size_t)tok * 128 + h * 16 + it] = ex[it] * inv; }
        }
        lds_wave_sync();
    }
}

__device__ __forceinline__ void p10_peer_naive(const Frame& F) {
    const bf16_t* H2 = (const bf16_t*)(F.ws + WS_H); const bf16_t* UB = (const bf16_t*)(F.ws + WS_UB); const bf16_t* VB = (const bf16_t*)(F.ws + WS_VB);
    const int* EIDX = (const int*)(F.ws + WS_EIDX); const float* EW = (const float*)(F.ws + WS_EW); const float* MOD = (const float*)(F.ws + WS_MOD);
    const float* gfin = F.in[22]; float* out = F.out;
    const int gw = blockIdx.x * NWAVES + F.wave, nw = F.G * NWAVES, lane = F.lane;
    for (int tok = gw; tok < T; tok += nw) {
        const int b = tok / S;
        float xr[16], acc[16];
#pragma unroll
        for (int hlf = 0; hlf < 2; ++hlf) { const uint4 w = *(const uint4*)(H2 + (size_t)tok * D + hlf * 512 + lane * 8); const unsigned ww[4] = {w.x, w.y, w.z, w.w};
#pragma unroll
            for (int e = 0; e < 4; ++e) { xr[hlf * 8 + 2 * e] = bflo(ww[e]); xr[hlf * 8 + 2 * e + 1] = bfhi(ww[e]); } }
#pragma unroll
        for (int e = 0; e < 16; ++e) acc[e] = 0.f;
        for (int i0 = 0; i0 < 128; i0 += 4) {
            int ei[4]; float wi[4], dt[4];
#pragma unroll
            for (int i = 0; i < 4; ++i) { ei[i] = __builtin_amdgcn_readfirstlane(EIDX[(size_t)tok * 128 + i0 + i]); wi[i] = EW[(size_t)tok * 128 + i0 + i]; }
#pragma unroll
            for (int i = 0; i < 4; ++i) { float d = 0.f;
#pragma unroll
                for (int hlf = 0; hlf < 2; ++hlf) { const uint4 w = *(const uint4*)(UB + (size_t)ei[i] * D + hlf * 512 + lane * 8); const unsigned ww[4] = {w.x, w.y, w.z, w.w};
#pragma unroll
                    for (int e = 0; e < 4; ++e) d += xr[hlf * 8 + 2 * e] * bflo(ww[e]) + xr[hlf * 8 + 2 * e + 1] * bfhi(ww[e]); }
                dt[i] = d; }
#pragma unroll
            for (int i = 0; i < 4; ++i) { const float dot = wave_sum(dt[i]); const float cf = wi[i] * gelu_tanh(dot);
#pragma unroll
                for (int hlf = 0; hlf < 2; ++hlf) { const uint4 w = *(const uint4*)(VB + (size_t)ei[i] * D + hlf * 512 + lane * 8); const unsigned ww[4] = {w.x, w.y, w.z, w.w};
#pragma unroll
                    for (int e = 0; e < 4; ++e) { acc[hlf * 8 + 2 * e] += cf * bflo(ww[e]); acc[hlf * 8 + 2 * e + 1] += cf * bfhi(ww[e]); } } }
        }
        float x2[16], ss = 0.f;
#pragma unroll
        for (int hlf = 0; hlf < 2; ++hlf)
#pragma unroll
            for (int q = 0; q < 2; ++q) { const int col = hlf * 512 + lane * 8 + q * 4; const float4 x1 = *(const float4*)(out + (size_t)tok * D + col); const float4 gt = *(const float4*)(MOD + b * 6144 + 5120 + col);
                const int e = hlf * 8 + q * 4;
                x2[e] = x1.x + gt.x * acc[e]; x2[e + 1] = x1.y + gt.y * acc[e + 1]; x2[e + 2] = x1.z + gt.z * acc[e + 2]; x2[e + 3] = x1.w + gt.w * acc[e + 3];
                ss += x2[e] * x2[e] + x2[e + 1] * x2[e + 1] + x2[e + 2] * x2[e + 2] + x2[e + 3] * x2[e + 3]; }
        ss = wave_sum(ss); const float rstd = rsqrtf(ss * (1.0f / D) + EPS);
#pragma unroll
        for (int hlf = 0; hlf < 2; ++hlf)
#pragma unroll
            for (int q = 0; q < 2; ++q) { const int col = hlf * 512 + lane * 8 + q * 4; const float4 gg = *(const float4*)(gfin + col); const int e = hlf * 8 + q * 4;
                *(float4*)(out + (size_t)tok * D + col) = make_float4(x2[e] * rstd * gg.x, x2[e + 1] * rstd * gg.y, x2[e + 2] * rstd * gg.z, x2[e + 3] * rstd * gg.w); }
    }
}

constexpr int N_PHASES = 11;
struct Args { const float* in[23]; float* out; unsigned char* ws; int ph_lo, ph_hi; };
__global__ void __launch_bounds__(NTHREADS, 2) fwd(Args args) {
    extern __shared__ __attribute__((aligned(16))) unsigned char lds_raw[];
    Frame F;
#pragma unroll
    for (int i = 0; i < 23; ++i) F.in[i] = args.in[i];
    F.out = args.out; F.ws = args.ws; F.lds = (LAS unsigned char*)lds_raw;
    F.tid = threadIdx.x; F.lane = F.tid & 63; F.wave = __builtin_amdgcn_readfirstlane(F.tid >> 6); F.G = gridDim.x;
    volatile LAS unsigned* misc = (volatile LAS unsigned*)(F.lds + LDS_MISC_OFF);
    if (F.tid < 64) misc[F.tid] = 0u;
    __syncthreads();
    XcdBarrier bar; bar.bar = (unsigned*)(F.ws + WS_CTL); bar.x = 0; bar.st = misc;
    const int lo = args.ph_lo, hi = args.ph_hi;
    if (hi - lo > 1) bar = xcd_barrier_post((unsigned*)(F.ws + WS_CTL), misc);
#ifndef PH_MASK
#define PH_MASK 0xFFFF
#endif
#define IN(k) (((PH_MASK >> (k)) & 1) && lo <= (k) && (k) < hi)
#define SEAM(k) do { if (IN(k) && IN((k) + 1)) xcd_barrier(bar); } while (0)
    const float* MOD = (const float*)(F.ws + WS_MOD);
    if (IN(0)) { p0_prologue(F); } SEAM(0);
    if (IN(1)) { norm_mod_rows(F, F.in[0], F.in[2], 0, 1024, (bf16_t*)(F.ws + WS_H)); } SEAM(1);
    if (IN(2)) { pg8::Gemm g{(const pg8::bf16_t*)(F.ws + WS_H), (const pg8::bf16_t*)(F.ws + WS_WIN), T, NPAD, D}; pg8::StaticOrder So; So.init(T, NPAD, F.G, (int)blockIdx.x);
        pg8::EpiBf16<0> E{(pg8::bf16_t*)(F.ws + WS_PROJ), NPAD, nullptr, 0, 0};
        pg8::gemm_phase<pg8::EpiBf16<0>, pg8::StaticOrder>(F.lds, g, So, E, nullptr); } SEAM(2);
    if (IN(3)) { p3_compress_naive(F); } SEAM(3);
    #ifdef ATTN_NAIVE
    if (IN(4)) { p4_attn_naive(F); } SEAM(4);
#else
    if (IN(4)) { p4_attn_mfma(F); } SEAM(4);
#endif
    if (IN(5)) { p5_mixed(F); } SEAM(5);
    if (IN(6)) { pg8::Gemm g{(const pg8::bf16_t*)(F.ws + WS_H), (const pg8::bf16_t*)(F.ws + WS_WOUT), T, D, D}; pg8::StaticOrder So; So.init(T, D, F.G, (int)blockIdx.x);
        EpiResGate E{F.out, F.in[0], MOD, 2048};
        pg8::gemm_phase<EpiResGate, pg8::StaticOrder>(F.lds, g, So, E, nullptr); } SEAM(6);
    if (IN(7)) { norm_mod_rows(F, F.out, F.in[3], 3072, 4096, (bf16_t*)(F.ws + WS_H)); } SEAM(7);
    if (IN(8)) { pg8::Gemm g{(const pg8::bf16_t*)(F.ws + WS_H), (const pg8::bf16_t*)(F.ws + WS_WQ), T, D, D}; pg8::StaticOrder So; So.init(T, D, F.G, (int)blockIdx.x);
        pg8::EpiBf16<0> E{(pg8::bf16_t*)(F.ws + WS_QP), D, nullptr, 0, 0};
        pg8::gemm_phase<pg8::EpiBf16<0>, pg8::StaticOrder>(F.lds, g, So, E, nullptr); } SEAM(8);
    #ifdef ROUTE_NAIVE
    if (IN(9)) { p9_route_naive(F); } SEAM(9);
#else
    if (IN(9)) { p9_route_mfma(F); } SEAM(9);
#endif
    if (IN(10)) { p10_peer_naive(F); }
#undef IN
#undef SEAM
}

extern "C" void kernel_launch(void* const* d_in, const int* in_sizes, int n_in, void* d_out, int out_size, void* d_ws, size_t ws_size, hipStream_t stream) {
    static int grid = 0;
    if (grid == 0) {
        if (n_in != 23 || out_size != T * D || ws_size < WS_END) { fprintf(stderr, "kernel_launch: unexpected shapes: n_in %d out %d ws %zu (need %zu)\n", n_in, out_size, ws_size, (size_t)WS_END); grid = -1; return; }
        int dev = 0, cus = 0, per_cu = 0;
        if (hipGetDevice(&dev) != hipSuccess || hipDeviceGetAttribute(&cus, hipDeviceAttributeMultiprocessorCount, dev) != hipSuccess) { grid = -1; return; }
        if (hipFuncSetAttribute((const void*)fwd, hipFuncAttributeMaxDynamicSharedMemorySize, LDS_BYTES) != hipSuccess) { fprintf(stderr, "kernel_launch: hipFuncSetAttribute failed\n"); grid = -1; return; }
        if (hipOccupancyMaxActiveBlocksPerMultiprocessor(&per_cu, (const void*)fwd, NTHREADS, LDS_BYTES) != hipSuccess || per_cu < 1) { fprintf(stderr, "kernel_launch: occupancy query says %d\n", per_cu); (void)hipGetLastError(); per_cu = 1; }
        grid = cus;
    }
    if (grid < 0) return;
    (void)hipMemsetAsync((char*)d_ws + WS_CTL, 0, CTL_BYTES, stream);
    Args a{};
    for (int i = 0; i < 23; ++i) a.in[i] = (const float*)d_in[i];
    a.out = (float*)d_out; a.ws = (unsigned char*)d_ws;
#if MK_N_LAUNCHES == 1
    a.ph_lo = 0; a.ph_hi = N_PHASES;
    hipLaunchKernelGGL(fwd, dim3(grid), dim3(NTHREADS), LDS_BYTES, stream, a);
#else
#ifdef PROBE_LIST
    { const int plist[] = PROBE_LIST; for (int p : plist) { a.ph_lo = p; a.ph_hi = p + 1; hipLaunchKernelGGL(fwd, dim3(grid), dim3(NTHREADS), LDS_BYTES, stream, a); } }
#else
    for (int p = 0; p < N_PHASES; ++p) { a.ph_lo = p; a.ph_hi = p + 1; hipLaunchKernelGGL(fwd, dim3(grid), dim3(NTHREADS), LDS_BYTES, stream, a); }
#endif
#endif
}
```

```cpp
#include <hip/hip_runtime.h>
#include <cstdio>
#include <cstdint>
#include <cstdlib>

#ifndef MK_N_LAUNCHES
#define MK_N_LAUNCHES 1
#endif
#define XB_TMO      128
#define XB_XCNT(j)  (256  + 64 * (j))
#define XB_XSUB(j)  (1280 + 64 * (j))
#define XB_XGEN(j)  (2304 + 64 * (j))
#define XB_TOP      3328
#define XB_TOPGEN   3392
#define XCD_BAR_WORDS 3456
#define XB_SPIN_CAP (1u << 18)
#define LAS __attribute__((address_space(3)))

__device__ __forceinline__ unsigned xb_ld(unsigned* p)              { return __hip_atomic_load(p, __ATOMIC_RELAXED, __HIP_MEMORY_SCOPE_AGENT); }
__device__ __forceinline__ unsigned xb_add(unsigned* p, unsigned v) { return __hip_atomic_fetch_add(p, v, __ATOMIC_RELAXED, __HIP_MEMORY_SCOPE_AGENT); }
__device__ __forceinline__ unsigned xb_xcc_id() { return (unsigned)__builtin_amdgcn_s_getreg((3 << 11) | 20) & 0xFu; }
#define XB_SPIN(cond, bar) do { unsigned _sp = 0; while (cond) { __builtin_amdgcn_s_sleep(1); \
    if ((++_sp & 255u) == 0u) { if (xb_ld(&(bar)[XB_TMO])) break; if (_sp > XB_SPIN_CAP) { atomicAdd(&(bar)[XB_TMO], 1u); break; } } } } while (0)

struct XcdBarrier {
    unsigned* bar; unsigned x;
    volatile LAS unsigned* st;
};

__device__ __forceinline__ XcdBarrier xcd_barrier_post(unsigned* bar, volatile LAS unsigned* st) {
    XcdBarrier b; b.bar = bar; b.x = xb_xcc_id(); b.st = st;
    if (threadIdx.x == 0) (void)xb_add(&bar[XB_XCNT(b.x)], 1u);
    return b;
}
__device__ __forceinline__ void xcd_barrier_complete(unsigned* bar, unsigned x, unsigned& nloc, unsigned& nx) {
    const unsigned G = gridDim.x * gridDim.y * gridDim.z;
    unsigned sum, cnt, mine, sp = 0u;
    for (;;) {
        sum = 0u; cnt = 0u; mine = 0u;
#pragma unroll
        for (unsigned j = 0; j < 16; ++j) { const unsigned c = xb_ld(&bar[XB_XCNT(j)]); sum += c; cnt += (c > 0u) ? 1u : 0u; mine = (j == x) ? c : mine; }
        if (sum == G) break;
        __builtin_amdgcn_s_sleep(1);
        if ((++sp & 255u) == 0u) { if (xb_ld(&bar[XB_TMO])) break; if (sp > XB_SPIN_CAP) { atomicAdd(&bar[XB_TMO], 1u); break; } }
    }
    nloc = mine > 0u ? mine : 1u; nx = cnt > 0u ? cnt : 1u;
}

__device__ __forceinline__ void xcd_barrier(const XcdBarrier& b) {
    asm volatile("s_waitcnt vmcnt(0)" ::: "memory");
    __syncthreads();
    if (threadIdx.x == 0) {
        unsigned* bar = b.bar;
        __builtin_amdgcn_s_waitcnt(0);
        unsigned nloc = b.st[0], nx = b.st[1];
        if (nloc == 0u) { xcd_barrier_complete(bar, b.x, nloc, nx); b.st[0] = nloc; b.st[1] = nx; }
        const unsigned old = xb_add(&bar[XB_XSUB(b.x)], 1u);
        const unsigned gen = old / nloc;
        if (old + 1u == (gen + 1u) * nloc) {
            __builtin_amdgcn_fence(__ATOMIC_RELEASE, "agent");
            asm volatile("s_waitcnt vmcnt(0)" ::: "memory");
            const unsigned og = xb_add(&bar[XB_TOP], 1u);
            const unsigned tg = og / nx;
            if (og + 1u == (tg + 1u) * nx) xb_add(&bar[XB_TOPGEN], 1u);
            else XB_SPIN(xb_ld(&bar[XB_TOPGEN]) == tg, bar);
            __builtin_amdgcn_fence(__ATOMIC_ACQUIRE, "agent");
            xb_add(&bar[XB_XGEN(b.x)], 1u);
            asm volatile("s_waitcnt vmcnt(0)" ::: "memory");
        } else {
            XB_SPIN(xb_ld(&bar[XB_XGEN(b.x)]) == gen, bar);
            __builtin_amdgcn_fence(__ATOMIC_ACQUIRE, "agent");
            asm volatile("s_waitcnt vmcnt(0)" ::: "memory");
        }
    }
    __syncthreads();
}

namespace pg8 {
#define PG8_LAS __attribute__((address_space(3)))
typedef unsigned short bf16_t;
typedef short bf16x8 __attribute__((ext_vector_type(8)));
typedef float f32x4 __attribute__((ext_vector_type(4)));
typedef unsigned u32x4 __attribute__((ext_vector_type(4)));
constexpr int BM = 256, BK = 64, HALF = 128, HTB = HALF * BK * 2  , STAGE_BYTES = 8 * HTB, NXCD = 8, WGM = 8;

__host__ __device__ __forceinline__ int lds_byte(int r, int c) { const int st = (r >> 4) * 2 + (c >> 5), rr = r & 15, cc = c & 31, ob = rr * 64 + cc * 2; return st * 1024 + (ob ^ (((ob >> 9) & 1) << 5)); }
__host__ __device__ __forceinline__ void stage_rc(int b, int& R, int& C) { const int st = b / 1024, sb = b % 1024, swz = sb ^ (((sb >> 9) & 1) << 5); R = (st >> 1) * 16 + swz / 64; C = (st & 1) * 32 + (swz % 64) / 2; }
__host__ __device__ __forceinline__ int perm32(int rho) { const int n = rho >> 4, i = rho & 15; return 8 * (i >> 2) + 4 * n + (i & 3); }

struct Unit { int pm, pn; };
struct Gemm { const bf16_t* A; const bf16_t* Bt; int M, N, K; };

struct StaticOrder {
    int nM, nN, nwg, G, c;
    __host__ __device__ void init(int M, int N, int G_, int c_) { nM = M / BM; nN = N / BM; nwg = nM * nN; G = G_; c = c_; }
    __host__ __device__ bool next(int i, Unit& u) const {
        const long L = (long)i * G + c; if (L >= nwg) return false;
        int wgid = (int)L; { const int q = nwg / NXCD, r = nwg % NXCD, xcd = wgid % NXCD, off = wgid / NXCD; wgid = (xcd < r ? xcd * (q + 1) : r * (q + 1) + (xcd - r) * q) + off; }
        const int nig = WGM * nN, gid = wgid / nig, fm = gid * WGM, gsz = (nM - fm) < WGM ? (nM - fm) : WGM;
        u.pm = fm + ((wgid % nig) % gsz); u.pn = (wgid % nig) / gsz; return true;
    }
    __device__ __forceinline__ void a_ready(const Unit&) const {}
    __device__ __forceinline__ void done(const Unit&) const {}
};
struct CountedOrder : StaticOrder {
    const unsigned* ready; unsigned need; unsigned* tmo;
    __device__ __forceinline__ void a_ready(const Unit& u) const {
        if (threadIdx.x < 64) {
            const unsigned long long t0 = __builtin_amdgcn_s_memrealtime(); unsigned polls = 0;
            while ((unsigned)__builtin_amdgcn_readfirstlane(__hip_atomic_load(ready + 64 * u.pm, __ATOMIC_RELAXED, __HIP_MEMORY_SCOPE_AGENT)) < need) {
                if ((++polls & 255u) == 0u && __builtin_amdgcn_readfirstlane(__hip_atomic_load(tmo, __ATOMIC_RELAXED, __HIP_MEMORY_SCOPE_AGENT)) != 0u) break;
                if (__builtin_amdgcn_s_memrealtime() - t0 > 2000000ull) {
                    if (threadIdx.x == 0) { unsigned expect = 0u; __hip_atomic_compare_exchange_strong(tmo + 1, &expect, 0x600u | (unsigned)(u.pm & 0xff), __ATOMIC_RELAXED, __ATOMIC_RELAXED, __HIP_MEMORY_SCOPE_AGENT); __hip_atomic_store(tmo, 1u, __ATOMIC_RELAXED, __HIP_MEMORY_SCOPE_AGENT); }
                    break; }
                __builtin_amdgcn_s_sleep(2); }
            __builtin_amdgcn_fence(__ATOMIC_ACQUIRE, "agent");
            asm volatile("s_waitcnt vmcnt(0)" ::: "memory");
        }
#if !defined(BROKEN_HOOK_NO_BARRIER)
        asm volatile("" ::: "memory"); __builtin_amdgcn_s_barrier(); asm volatile("" ::: "memory");
#endif
    }
};

__device__ __forceinline__ unsigned cvt_pk_bf16(float lo, float hi) { unsigned r; asm volatile("v_cvt_pk_bf16_f32 %0, %1, %2" : "=v"(r) : "v"(lo), "v"(hi)); return r; }
typedef float f32x2 __attribute__((ext_vector_type(2)));
__device__ __forceinline__ f32x2 gelu_pk(f32x2 v) {
    const f32x2 av = __builtin_elementwise_abs(v), d = av * 0.2316418882f + 1.0f;
    f32x2 t; t.x = __builtin_amdgcn_rcpf(d.x); t.y = __builtin_amdgcn_rcpf(d.y);
    f32x2 q = t * 0.5307027145f + (-0.7265760135f); q = q * t + 0.7107068705f; q = q * t + (-0.142248368f); q = q * t + 0.127414796f; q = q * t;
    const f32x2 s = (v * v) * (-0.72134752044f);
    f32x2 e; e.x = __builtin_amdgcn_exp2f(s.x); e.y = __builtin_amdgcn_exp2f(s.y);
    const f32x2 m = v * (q * e), r = v - m;
    f32x2 o; o.x = v.x < 0.f ? m.x : r.x; o.y = v.y < 0.f ? m.y : r.y; return o;
}

struct EpiF32 {
    static constexpr bool PERM = false, AFTER_DRAIN = false;
    float* C; int ldc; const float* bias;
    __device__ __forceinline__ void operator()(const f32x4 (&acc)[2][2][4][2], const Unit& u, int wr, int wc, int fr, int fq) const {
        const int row0 = u.pm * BM + wr * 64 + fr, col0 = u.pn * BM + wc * 32 + 4 * fq;
        f32x4 bv[2][2];
#pragma unroll
        for (int bj = 0; bj < 2; ++bj)
#pragma unroll
            for (int n = 0; n < 2; ++n) bv[bj][n] = bias ? *(const f32x4*)(bias + col0 + bj * HALF + n * 16) : (f32x4){0.f, 0.f, 0.f, 0.f};
#pragma unroll
        for (int ai = 0; ai < 2; ++ai)
#pragma unroll
            for (int m = 0; m < 4; ++m) { float* rowp = C + (size_t)(row0 + ai * HALF + m * 16) * ldc + col0;
#pragma unroll
                for (int bj = 0; bj < 2; ++bj)
#pragma unroll
                    for (int n = 0; n < 2; ++n) *(f32x4*)(rowp + bj * HALF + n * 16) = acc[ai][bj][m][n] + bv[bj][n]; }
    }
};
template <int ACT  > struct EpiBf16 {
    static constexpr bool PERM = true, AFTER_DRAIN = false;
    bf16_t* O; int ldc; const float* bias; int split_cols; size_t split_stride;
    __device__ __forceinline__ void operator()(const f32x4 (&acc)[2][2][4][2], const Unit& u, int wr, int wc, int fr, int fq) const {
        const int row0 = u.pm * BM + wr * 64 + fr; int colt = u.pn * BM; bf16_t* base = O;
        if (split_cols) { const int t = colt / split_cols; base += (size_t)t * split_stride; colt -= t * split_cols; }
        const int col0 = colt + wc * 32 + 8 * fq, bcol0 = u.pn * BM + wc * 32 + 8 * fq;
        f32x4 bv[2][2];
#pragma unroll
        for (int bj = 0; bj < 2; ++bj)
#pragma unroll
            for (int n = 0; n < 2; ++n) bv[bj][n] = bias ? *(const f32x4*)(bias + bcol0 + bj * HALF + 4 * n) : (f32x4){0.f, 0.f, 0.f, 0.f};
#pragma unroll
        for (int ai = 0; ai < 2; ++ai)
#pragma unroll
            for (int m = 0; m < 4; ++m) { bf16_t* rowp = base + (size_t)(row0 + ai * HALF + m * 16) * ldc + col0;
#pragma unroll
                for (int bj = 0; bj < 2; ++bj) { f32x4 v0 = acc[ai][bj][m][0] + bv[bj][0], v1 = acc[ai][bj][m][1] + bv[bj][1];
                    if (ACT == 1) { f32x2 a = gelu_pk((f32x2){v0[0], v0[1]}), b = gelu_pk((f32x2){v0[2], v0[3]}), c = gelu_pk((f32x2){v1[0], v1[1]}), d = gelu_pk((f32x2){v1[2], v1[3]});
                        v0 = (f32x4){a.x, a.y, b.x, b.y}; v1 = (f32x4){c.x, c.y, d.x, d.y}; }
                    if (ACT == 2) {
#pragma unroll
                        for (int j = 0; j < 4; ++j) { v0[j] = 0.5f * v0[j] * (1.0f + erff(v0[j] * 0.70710678f)); v1[j] = 0.5f * v1[j] * (1.0f + erff(v1[j] * 0.70710678f)); } }
                    u32x4 w; w.x = cvt_pk_bf16(v0[0], v0[1]); w.y = cvt_pk_bf16(v0[2], v0[3]); w.z = cvt_pk_bf16(v1[0], v1[1]); w.w = cvt_pk_bf16(v1[2], v1[3]);
                    *(u32x4*)(rowp + bj * HALF) = w; } }
    }
};

struct PanelStats {
    unsigned* xbuf;
    unsigned* cnt;
    unsigned* tmo;
    int ntn; float eps;
    unsigned code;
    __device__ __forceinline__ bool run(const f32x4 (&v)[2][2][4][2], const Unit& u, int wr, int wc, int fr, int fq, PG8_LAS unsigned char* lds, int wid, int lane) const {
        typedef float f32x2v __attribute__((ext_vector_type(2)));
        PG8_LAS f32x2v* P = (PG8_LAS f32x2v*)lds;
        PG8_LAS f32x2v* S = (PG8_LAS f32x2v*)(lds + 8192);
        PG8_LAS unsigned* flag = (PG8_LAS unsigned*)(lds + 8192 + 2048);
#pragma unroll
        for (int ai = 0; ai < 2; ++ai)
#pragma unroll
            for (int m = 0; m < 4; ++m) {
                float s = 0.f;
#pragma unroll
                for (int bj = 0; bj < 2; ++bj)
#pragma unroll
                    for (int n = 0; n < 2; ++n) { const f32x4 x = v[ai][bj][m][n]; s += (x[0] + x[1]) + (x[2] + x[3]); }
                s += __shfl_xor(s, 16); s += __shfl_xor(s, 32);
                const float mw = s * (1.0f / 64.0f); float q = 0.f;
#pragma unroll
                for (int bj = 0; bj < 2; ++bj)
#pragma unroll
                    for (int n = 0; n < 2; ++n) { const f32x4 d = v[ai][bj][m][n] - mw; q += (d[0] * d[0] + d[1] * d[1]) + (d[2] * d[2] + d[3] * d[3]); }
                q += __shfl_xor(q, 16); q += __shfl_xor(q, 32);
                if (fq == 0) P[(ai * HALF + wr * 64 + m * 16 + fr) * 4 + wc] = (f32x2v){mw, q};
            }
        asm volatile("s_waitcnt lgkmcnt(0)" ::: "memory"); __builtin_amdgcn_s_barrier(); asm volatile("" ::: "memory");
#if defined(BROKEN_NO_WAIT)
        if (blockIdx.x >= 64) { const long long t0 = clock64(); while (clock64() - t0 < 60000) __builtin_amdgcn_s_sleep(8); }
#endif
        const int row = wid * 32 + (lane & 31);
        if (lane < 32) {
            const f32x2v a = P[row * 4 + 0], b = P[row * 4 + 1], c = P[row * 4 + 2], d = P[row * 4 + 3];
            const float mt = (a.x + b.x + c.x + d.x) * 0.25f;
            const float da = a.x - mt, db = b.x - mt, dc = c.x - mt, dd = d.x - mt;
            const float m2 = (a.y + b.y) + (c.y + d.y) + 64.0f * ((da * da + db * db) + (dc * dc + dd * dd));
            unsigned long long* slot = (unsigned long long*)xbuf + ((size_t)(u.pm * BM + row) * 4 + u.pn);
            __hip_atomic_store(slot, ((unsigned long long)__float_as_uint(m2) << 32) | __float_as_uint(mt), __ATOMIC_RELAXED, __HIP_MEMORY_SCOPE_AGENT);
        }
        asm volatile("s_waitcnt vmcnt(0)" ::: "memory");
        if (lane == 0) __hip_atomic_fetch_add(cnt + 64 * u.pm, 1u, __ATOMIC_RELAXED, __HIP_MEMORY_SCOPE_AGENT);
        if (wid == 0) {
            bool dead = false; const unsigned long long t0 = __builtin_amdgcn_s_memrealtime(); const unsigned want = 8u * (unsigned)ntn;
            for (;;) {
#if defined(BROKEN_NO_WAIT)
                break;
#endif
                if ((unsigned)__builtin_amdgcn_readfirstlane(__hip_atomic_load(cnt + 64 * u.pm, __ATOMIC_RELAXED, __HIP_MEMORY_SCOPE_AGENT)) >= want) break;
                if (__builtin_amdgcn_s_memrealtime() - t0 > 2000000ull) {
                    if (lane == 0) { unsigned expect = 0u; __hip_atomic_compare_exchange_strong(tmo + 1, &expect, code | (unsigned)(u.pm & 0xff), __ATOMIC_RELAXED, __ATOMIC_RELAXED, __HIP_MEMORY_SCOPE_AGENT);
                                     __hip_atomic_store(tmo, 1u, __ATOMIC_RELAXED, __HIP_MEMORY_SCOPE_AGENT); }
                    dead = true; break; }
                __builtin_amdgcn_s_sleep(2);
            }
            __builtin_amdgcn_fence(__ATOMIC_ACQUIRE, "agent");
            if (lane == 0) flag[0] = dead ? 1u : 0u;
        }
        asm volatile("s_waitcnt vmcnt(0) lgkmcnt(0)" ::: "memory"); __builtin_amdgcn_s_barrier(); asm volatile("" ::: "memory");
        const bool bad = flag[0] != 0u;
        if (lane < 32) {
            const unsigned long long* slot = (const unsigned long long*)xbuf + (size_t)(u.pm * BM + row) * 4; float mt[4], m2[4]; float ms = 0.f;
#pragma unroll
            for (int t = 0; t < 4; ++t) { if (t < ntn) { const unsigned long long w = __hip_atomic_load(slot + t, __ATOMIC_RELAXED, __HIP_MEMORY_SCOPE_AGENT); mt[t] = __uint_as_float((unsigned)w); m2[t] = __uint_as_float((unsigned)(w >> 32)); } else { mt[t] = 0.f; m2[t] = 0.f; } ms += mt[t]; }
            const float mean = ms / (float)ntn; float q = 0.f;
#pragma unroll
            for (int t = 0; t < 4; ++t) if (t < ntn) { const float dm = mt[t] - mean; q += m2[t] + 256.0f * dm * dm; }
            S[row] = (f32x2v){mean, 1.0f / sqrtf(q / (256.0f * (float)ntn) + eps)};
        }
        asm volatile("s_waitcnt lgkmcnt(0)" ::: "memory"); __builtin_amdgcn_s_barrier(); asm volatile("" ::: "memory");
        return bad;
    }
};
struct EpiLnRes {
    static constexpr bool PERM = false, AFTER_DRAIN = true;
    const float* base; float* out; int ldc; const float* bias; PanelStats st; unsigned poison;
    __device__ __forceinline__ void refuse(size_t i0, size_t stride, int M, int N) const { const float q = __builtin_nanf(""); for (size_t i = i0; i < (size_t)M * N; i += stride) out[(i / N) * ldc + i % N] = q;
        if (i0 == 0) { unsigned expect = 0u; __hip_atomic_compare_exchange_strong(st.tmo + 1, &expect, 0x7f0u, __ATOMIC_RELAXED, __ATOMIC_RELAXED, __HIP_MEMORY_SCOPE_AGENT); __hip_atomic_store(st.tmo, 1u, __ATOMIC_RELAXED, __HIP_MEMORY_SCOPE_AGENT); } }
    __device__ __forceinline__ void fused(f32x4 (&acc)[2][2][4][2], const Unit& u, int wr, int wc, int fr, int fq, PG8_LAS unsigned char* lds, int wid, int lane) const {
        typedef float f32x2v __attribute__((ext_vector_type(2)));
        const PG8_LAS f32x2v* S = (const PG8_LAS f32x2v*)(lds + 8192);
        const int col0 = u.pn * BM + wc * 32 + 4 * fq;
#pragma unroll
        for (int bj = 0; bj < 2; ++bj)
#pragma unroll
            for (int n = 0; n < 2; ++n) { const f32x4 bv = bias ? *(const f32x4*)(bias + col0 + bj * HALF + n * 16) : (f32x4){0.f, 0.f, 0.f, 0.f};
#pragma unroll
                for (int ai = 0; ai < 2; ++ai)
#pragma unroll
                    for (int m = 0; m < 4; ++m) acc[ai][bj][m][n] += bv; }
        const bool bad = st.run(acc, u, wr, wc, fr, fq, lds, wid, lane) || poison != 0u;
        const float qnan = __builtin_nanf("");
#pragma unroll
        for (int ai = 0; ai < 2; ++ai)
#pragma unroll
            for (int m = 0; m < 4; ++m) { const int r = ai * HALF + wr * 64 + m * 16 + fr; const f32x2v sr = S[r]; const size_t off = (size_t)(u.pm * BM + r) * ldc + col0;
#pragma unroll
                for (int bj = 0; bj < 2; ++bj)
#pragma unroll
                    for (int n = 0; n < 2; ++n) { const f32x4 bs = *(const f32x4*)(base + off + bj * HALF + n * 16); f32x4 o = bs + (acc[ai][bj][m][n] - sr.x) * sr.y;
                        if (bad) o = (f32x4){qnan, qnan, qnan, qnan}; *(f32x4*)(out + off + bj * HALF + n * 16) = o; }
                asm volatile("" ::: "memory"); }
    }
};
struct EpiLnResLn {
    static constexpr bool PERM = false, AFTER_DRAIN = true;
    const float* base; float* out; bf16_t* xn; int ldc; const float* bias; PanelStats st1, st2; unsigned poison;
    __device__ __forceinline__ void refuse(size_t i0, size_t stride, int M, int N) const { const float q = __builtin_nanf(""); for (size_t i = i0; i < (size_t)M * N; i += stride) { const size_t o = (i / N) * ldc + i % N; out[o] = q; xn[o] = (bf16_t)0x7fc0u; }
        if (i0 == 0) { unsigned expect = 0u; __hip_atomic_compare_exchange_strong(st1.tmo + 1, &expect, 0x7f0u, __ATOMIC_RELAXED, __ATOMIC_RELAXED, __HIP_MEMORY_SCOPE_AGENT); __hip_atomic_store(st1.tmo, 1u, __ATOMIC_RELAXED, __HIP_MEMORY_SCOPE_AGENT); } }
    __device__ __forceinline__ void fused(f32x4 (&acc)[2][2][4][2], const Unit& u, int wr, int wc, int fr, int fq, PG8_LAS unsigned char* lds, int wid, int lane) const {
        typedef float f32x2v __attribute__((ext_vector_type(2))); typedef unsigned u32x2v __attribute__((ext_vector_type(2)));
        const PG8_LAS f32x2v* S = (const PG8_LAS f32x2v*)(lds + 8192);
        const int col0 = u.pn * BM + wc * 32 + 4 * fq;
#pragma unroll
        for (int bj = 0; bj < 2; ++bj)
#pragma unroll
            for (int n = 0; n < 2; ++n) { const f32x4 bv = bias ? *(const f32x4*)(bias + col0 + bj * HALF + n * 16) : (f32x4){0.f, 0.f, 0.f, 0.f};
#pragma unroll
                for (int ai = 0; ai < 2; ++ai)
#pragma unroll
                    for (int m = 0; m < 4; ++m) acc[ai][bj][m][n] += bv; }
        bool bad = st1.run(acc, u, wr, wc, fr, fq, lds, wid, lane) || poison != 0u;
        const float qnan = __builtin_nanf("");
#pragma unroll
        for (int ai = 0; ai < 2; ++ai)
#pragma unroll
            for (int m = 0; m < 4; ++m) { const int r = ai * HALF + wr * 64 + m * 16 + fr; const f32x2v sr = S[r]; const size_t off = (size_t)(u.pm * BM + r) * ldc + col0;
#pragma unroll
                for (int bj = 0; bj < 2; ++bj)
#pragma unroll
                    for (int n = 0; n < 2; ++n) { const f32x4 bs = *(const f32x4*)(base + off + bj * HALF + n * 16); acc[ai][bj][m][n] = bs + (acc[ai][bj][m][n] - sr.x) * sr.y; }
                asm volatile("" : "+v"(acc[ai][0][m][0]), "+v"(acc[ai][0][m][1]), "+v"(acc[ai][1][m][0]), "+v"(acc[ai][1][m][1]));
                if (m & 1) asm volatile("" ::: "memory"); }
        const bool bad1 = bad;
        bad = st2.run(acc, u, wr, wc, fr, fq, lds, wid, lane) || bad;
#pragma unroll
        for (int ai = 0; ai < 2; ++ai)
#pragma unroll
            for (int m = 0; m < 4; ++m) { const int r = ai * HALF + wr * 64 + m * 16 + fr; const f32x2v sr = S[r]; const size_t off = (size_t)(u.pm * BM + r) * ldc + col0;
#pragma unroll
                for (int bj = 0; bj < 2; ++bj)
#pragma unroll
                    for (int n = 0; n < 2; ++n) { const f32x4 x1 = acc[ai][bj][m][n]; *(f32x4*)(out + off + bj * HALF + n * 16) = bad1 ? (f32x4){qnan, qnan, qnan, qnan} : x1;
                        const f32x4 o = (x1 - sr.x) * sr.y; u32x2v w; w.x = cvt_pk_bf16(o[0], o[1]); w.y = cvt_pk_bf16(o[2], o[3]);
                        if (bad) { w.x = 0x7fc07fc0u; w.y = 0x7fc07fc0u; } *(u32x2v*)(xn + off + bj * HALF + n * 16) = w; }
                asm volatile("" ::: "memory"); }
    }
};

template <class Epi, class Sched, bool STAMP = false>
__device__ __forceinline__ void gemm_phase(PG8_LAS unsigned char* lds, const Gemm g, const Sched& S, const Epi& E, unsigned long long* stamps) {
    const int tid = threadIdx.x, wid = __builtin_amdgcn_readfirstlane(tid >> 6), lane = tid & 63, wr = wid >> 2, wc = wid & 3, fr = lane & 15, fq = lane >> 4;
    const int K = g.K, nt = K / BK;
    int ts_lo = 0, ts_hi = 0, nts = 0; const unsigned long long rt_entry = STAMP ? (unsigned long long)wall_clock64() : 0ull;
#define PG8_STAMP() do { if (STAMP && wid == 0 && nts < 64) { const unsigned long long _c = (unsigned long long)clock64(); \
        ts_lo = (lane == nts) ? (int)(unsigned)_c : ts_lo; ts_hi = (lane == nts) ? (int)(unsigned)(_c >> 32) : ts_hi; ++nts; } } while (0)
    PG8_STAMP();
    unsigned voffA[2], voffB[2];
#pragma unroll
    for (int i = 0; i < 2; ++i) { int R, C; stage_rc(tid * 16 + i * 8192, R, C); const int Rb = Epi::PERM ? ((R & ~31) + perm32(R & 31)) : R;
        voffA[i] = (unsigned)(R * K + C) * 2u; voffB[i] = (unsigned)(Rb * K + C) * 2u; }
    const size_t kstep = (size_t)(BK * 2);
    const size_t hstep = (size_t)HALF * K * 2;
    const size_t tstep = 2 * hstep;
    const unsigned ldsw = (unsigned)wid * 1024u;
    const int aoff = lds_byte(wr * 64 + fr, fq * 8), boff = lds_byte(wc * 32 + fr, fq * 8);
#define PG8_SA(b, h) (((b) * 2 + (h)) * HTB)
#define PG8_SB(b, h) ((4 + (b) * 2 + (h)) * HTB)
#define PG8_STAGE(bufoff, gbase, voff) do { _Pragma("unroll") for (int _i = 0; _i < 2; ++_i) \
        __builtin_amdgcn_global_load_lds((const unsigned*)((const char*)(gbase) + (voff)[_i]), (PG8_LAS unsigned*)(lds + (bufoff) + ldsw + _i * 8192), 16, 0, 0); } while (0)
#define PG8_LDA(dst, b, h) do { _Pragma("unroll") for (int m = 0; m < 4; ++m) _Pragma("unroll") for (int k = 0; k < 2; ++k) dst[m][k] = *(const PG8_LAS bf16x8*)(lds + PG8_SA(b, h) + aoff + m * 2048 + k * 1024); } while (0)
#define PG8_LDB(dst, b, h) do { _Pragma("unroll") for (int n = 0; n < 2; ++n) _Pragma("unroll") for (int k = 0; k < 2; ++k) dst[n][k] = *(const PG8_LAS bf16x8*)(lds + PG8_SB(b, h) + boff + n * 2048 + k * 1024); } while (0)
#define PG8_MMA(ai, bj, At, Bt) do { __builtin_amdgcn_s_setprio(1); _Pragma("unroll") for (int m = 0; m < 4; ++m) _Pragma("unroll") for (int n = 0; n < 2; ++n) _Pragma("unroll") for (int k = 0; k < 2; ++k) \
        acc[ai][bj][m][n] = __builtin_amdgcn_mfma_f32_16x16x32_bf16(Bt[n][k], At[m][k], acc[ai][bj][m][n], 0, 0, 0); __builtin_amdgcn_s_setprio(0); } while (0)
#define PG8_WAIT_V(n) asm volatile("s_waitcnt vmcnt(" #n ")" ::: "memory")
#define PG8_WAIT_L(n) asm volatile("s_waitcnt lgkmcnt(" #n ")" ::: "memory")
#define PG8_BAR __builtin_amdgcn_s_barrier()
#define PG8_SCHED __builtin_amdgcn_sched_barrier(0)
    Unit cur, nxt; int ui = 0;
    if (!S.next(0, cur)) return;
    f32x4 acc[2][2][4][2];
#pragma unroll
    for (int a = 0; a < 2; ++a)
#pragma unroll
        for (int b = 0; b < 2; ++b)
#pragma unroll
            for (int m = 0; m < 4; ++m)
#pragma unroll
                for (int n = 0; n < 2; ++n) acc[a][b][m][n] = (f32x4){0.f, 0.f, 0.f, 0.f};
    bf16x8 At[4][2], B0[2][2], B1[2][2];
    const char* cA = (const char*)g.A + (size_t)cur.pm * tstep; const char* cB = (const char*)g.Bt + (size_t)cur.pn * tstep;
    S.a_ready(cur);
    PG8_STAGE(PG8_SB(0, 0), cB, voffB); PG8_STAGE(PG8_SA(0, 0), cA, voffA); PG8_STAGE(PG8_SB(0, 1), cB + hstep, voffB); PG8_STAGE(PG8_SA(0, 1), cA + hstep, voffA);
    if (wr == 1) PG8_BAR;
    PG8_WAIT_V(4); PG8_BAR;
    PG8_STAGE(PG8_SB(1, 0), cB + kstep, voffB); PG8_STAGE(PG8_SA(1, 0), cA + kstep, voffA); PG8_STAGE(PG8_SB(1, 1), cB + hstep + kstep, voffB);
    PG8_WAIT_V(6); PG8_BAR;
    PG8_STAMP();
    for (;;) {
        const bool has_next = S.next(ui + 1, nxt);
        const char* nA = has_next ? (const char*)g.A + (size_t)nxt.pm * tstep : cA; const char* nB = has_next ? (const char*)g.Bt + (size_t)nxt.pn * tstep : cB;
        for (int t = 0; t < nt; t += 2) {
            const bool last = (t == nt - 2);
            const char* a1 = cA + (size_t)(t + 1) * kstep;
            const char* a2 = last ? nA : cA + (size_t)(t + 2) * kstep; const char* b2 = last ? nB : cB + (size_t)(t + 2) * kstep;
            const char* a3 = a2 + kstep; const char* b3 = b2 + kstep;
            if (last && has_next) S.a_ready(nxt);
            PG8_LDB(B0, 0, 0); PG8_SCHED; PG8_LDA(At, 0, 0); PG8_STAGE(PG8_SA(1, 1), a1 + hstep, voffA);
            PG8_WAIT_L(8); PG8_BAR; PG8_WAIT_L(0); PG8_MMA(0, 0, At, B0); PG8_BAR; PG8_SCHED;
            PG8_LDB(B1, 0, 1); PG8_STAGE(PG8_SB(0, 0), b2, voffB);
            PG8_BAR; PG8_WAIT_L(0); PG8_MMA(0, 1, At, B1); PG8_BAR;
            PG8_LDA(At, 0, 1); PG8_STAGE(PG8_SA(0, 0), a2, voffA);
            PG8_BAR; PG8_WAIT_L(0); PG8_MMA(1, 0, At, B0); PG8_BAR; PG8_SCHED;
            PG8_STAGE(PG8_SB(0, 1), b2 + hstep, voffB);
            PG8_WAIT_V(6); PG8_BAR; PG8_MMA(1, 1, At, B1); PG8_BAR;
            PG8_LDB(B0, 1, 0); PG8_SCHED; PG8_LDA(At, 1, 0); PG8_STAGE(PG8_SA(0, 1), a2 + hstep, voffA);
            PG8_WAIT_L(8); PG8_BAR; PG8_WAIT_L(0); PG8_MMA(0, 0, At, B0); PG8_BAR; PG8_SCHED;
            PG8_LDB(B1, 1, 1); PG8_STAGE(PG8_SB(1, 0), b3, voffB);
            PG8_BAR; PG8_WAIT_L(0); PG8_MMA(0, 1, At, B1); PG8_BAR;
            PG8_LDA(At, 1, 1); PG8_STAGE(PG8_SA(1, 0), a3, voffA);
            PG8_BAR; PG8_WAIT_L(0); PG8_MMA(1, 0, At, B0); PG8_BAR; PG8_SCHED;
            PG8_STAGE(PG8_SB(1, 1), b3 + hstep, voffB);
            PG8_WAIT_V(6); PG8_BAR; PG8_MMA(1, 1, At, B1); PG8_BAR;
        }
        PG8_STAMP();
        if constexpr (!Epi::AFTER_DRAIN) { E(acc, cur, wr, wc, fr, fq); S.done(cur); }
        PG8_STAMP();
        if (!has_next) break;
#pragma unroll
        for (int a = 0; a < 2; ++a)
#pragma unroll
            for (int b = 0; b < 2; ++b)
#pragma unroll
                for (int m = 0; m < 4; ++m)
#pragma unroll
                    for (int n = 0; n < 2; ++n) acc[a][b][m][n] = (f32x4){0.f, 0.f, 0.f, 0.f};
        cur = nxt; cA = nA; cB = nB; ++ui;
    }
    PG8_WAIT_V(0);
    if (wr == 0) PG8_BAR;
    PG8_BAR;
    if constexpr (Epi::AFTER_DRAIN) { E.fused(acc, cur, wr, wc, fr, fq, lds, wid, lane); S.done(cur); }
    PG8_STAMP();
    if (STAMP && wid == 0) { stamps[lane] = lane < nts ? (((unsigned long long)(unsigned)ts_hi << 32) | (unsigned)ts_lo) : 0ull;
        if (lane == 62) stamps[62] = rt_entry; if (lane == 63) stamps[63] = (unsigned long long)wall_clock64(); }
#undef PG8_STAMP
#undef PG8_SA
#undef PG8_SB
#undef PG8_STAGE
#undef PG8_LDA
#undef PG8_LDB
#undef PG8_MMA
#undef PG8_WAIT_V
#undef PG8_WAIT_L
#undef PG8_BAR
#undef PG8_SCHED
}
}

constexpr int D = 1024, NB = 16, S = 2048, T = NB * S;
constexpr int NCOL = 2840, NPAD = 3072;
constexpr int C_Q = 0, C_KC = 512, C_VC = 640, C_KS = 768, C_VS = 896, C_KW = 1024, C_VW = 1152, C_GT = 1280, C_CB = 1304, C_CC = 1816, C_CH = 2328;
constexpr int NCMP = 127;
constexpr int NEXP = 16384;
constexpr float EPS = 1e-6f;
constexpr int NTHREADS = 512, NWAVES = 8;

constexpr size_t al256(size_t x) { return (x + 255) & ~(size_t)255; }
constexpr size_t WS_CTL   = 0;                                   constexpr size_t CTL_BYTES = 65536;
constexpr size_t WS_MOD   = WS_CTL + CTL_BYTES;
constexpr size_t WS_WIN   = al256(WS_MOD + (size_t)16 * 6144 * 4);
constexpr size_t WS_WOUT  = al256(WS_WIN + (size_t)NPAD * D * 2);
constexpr size_t WS_WQ    = al256(WS_WOUT + (size_t)D * D * 2);
constexpr size_t WS_KEYS  = al256(WS_WQ + (size_t)D * D * 2);
constexpr size_t WS_U8S   = al256(WS_KEYS + (size_t)16 * 128 * 64 * 2);
constexpr size_t WS_V8S   = al256(WS_U8S + (size_t)NEXP * D);
constexpr size_t WS_X8S   = al256(WS_V8S + (size_t)NEXP * D);
constexpr size_t WS_SU    = al256(WS_X8S + (size_t)T * D);
constexpr size_t WS_SV    = al256(WS_SU + (size_t)NEXP * 4);
constexpr size_t WS_SX    = al256(WS_SV + (size_t)NEXP * 4);
constexpr size_t WS_KC    = al256(WS_SX + (size_t)T * 4);
constexpr size_t WS_VC    = al256(WS_KC + (size_t)16 * 2 * 128 * 64 * 2);
constexpr size_t WS_H     = al256(WS_VC + (size_t)16 * 2 * 128 * 64 * 2);
constexpr size_t WS_CS    = WS_H;
constexpr size_t WS_CSUM  = WS_H + (size_t)32 * 1024 * 1024;
constexpr size_t WS_SSQP  = WS_H + (size_t)33 * 1024 * 1024;
constexpr size_t WS_OATT  = al256(WS_H + (size_t)T * D * 2);
constexpr size_t WS_PROJ  = al256(WS_OATT + (size_t)T * 512 * 2);
constexpr size_t WS_QP    = WS_PROJ;
constexpr size_t WS_PART  = WS_PROJ;
constexpr size_t WS_EIDX  = WS_PROJ + (size_t)160 * 1024 * 1024;
constexpr size_t WS_EW    = WS_EIDX + (size_t)T * 128 * 4;
constexpr size_t WS_END   = al256(WS_PROJ + (size_t)T * NPAD * 2);
static_assert(WS_EW + (size_t)T * 128 * 4 <= WS_END, "alias region");
static_assert((size_t)8 * T * 128 * 4 <= (size_t)160 * 1024 * 1024, "PART fits under EIDX");
constexpr int CTL_CTR_A = 16384, CTL_CTR_B = 16384 + 8 * 256;

constexpr int LDS_STAGE = 147456;
constexpr int LDS_MISC_OFF = LDS_STAGE;
constexpr int LDS_BYTES = LDS_STAGE + 256;

typedef unsigned short bf16_t;
typedef short bf16x8 __attribute__((ext_vector_type(8)));
typedef short s16x4 __attribute__((ext_vector_type(4)));
typedef float f32x4 __attribute__((ext_vector_type(4)));
typedef unsigned u32x4v __attribute__((ext_vector_type(4)));
__device__ __forceinline__ float bf2f(bf16_t b) { return __uint_as_float(((unsigned)b) << 16); }
__device__ __forceinline__ bf16_t f2bf(float f) { unsigned u = __float_as_uint(f); u += 0x7FFFu + ((u >> 16) & 1u); return (bf16_t)(u >> 16); }
__device__ __forceinline__ float bflo(unsigned w) { return __uint_as_float(w << 16); }
__device__ __forceinline__ float bfhi(unsigned w) { return __uint_as_float(w & 0xFFFF0000u); }
__device__ __forceinline__ unsigned pack2(float lo, float hi) { return (unsigned)f2bf(lo) | ((unsigned)f2bf(hi) << 16); }
__device__ __forceinline__ float gelu_tanh(float x) { const float u = 0.7978845608028654f * (x + 0.044715f * x * x * x); return 0.5f * x * (1.0f + tanhf(u)); }
__device__ __forceinline__ float sigmoidf_(float x) { return 1.0f / (1.0f + __expf(-x)); }
__device__ __forceinline__ float wave_sum(float v) {
#pragma unroll
    for (int o = 32; o >= 1; o >>= 1) v += __shfl_xor(v, o);
    return v; }
__device__ __forceinline__ float wave_max(float v) {
#pragma unroll
    for (int o = 32; o >= 1; o >>= 1) v = fmaxf(v, __shfl_xor(v, o));
    return v; }
__device__ __forceinline__ void lds_wave_sync() { asm volatile("s_waitcnt lgkmcnt(0)" ::: "memory"); }
__device__ __forceinline__ int rel_bucket(int dist) {
    const int n = dist > 0 ? dist : 0;
    if (n < 16) return n;
    const float lr = logf((float)n / 16.0f) / 2.0794415416798357f;
    const int large = 16 + (int)(lr * 16.0f);
    return large < 31 ? large : 31;
}

struct Frame {
    const float* in[23]; float* out; unsigned char* ws;
    LAS unsigned char* lds; int tid, lane, wave, G;
};


typedef int i32x4v __attribute__((ext_vector_type(4)));
constexpr int PEER_CHUNK_TOK = 128, PEER_NCHUNK = T / PEER_CHUNK_TOK;

__device__ __forceinline__ void quant_row_sliced(const float* row, unsigned char* dst8  , size_t nrows, size_t r, float* scale_out, int bias, int lane) {
    float4 v[4]; float am = 0.f;
#pragma unroll
    for (int i = 0; i < 4; ++i) { v[i] = *(const float4*)(row + (lane + 64 * i) * 4); am = fmaxf(am, fmaxf(fmaxf(fabsf(v[i].x), fabsf(v[i].y)), fmaxf(fabsf(v[i].z), fabsf(v[i].w)))); }
    am = wave_max(am); const float inv = am > 0.f ? 127.0f / am : 0.f;
    if (lane == 0) *scale_out = am > 0.f ? am / 127.0f : 0.f;
#pragma unroll
    for (int i = 0; i < 4; ++i) { const int col = (lane + 64 * i) * 4; const int sl = col >> 7, off = col & 127;
        const int q0 = (int)rintf(v[i].x * inv) + bias, q1 = (int)rintf(v[i].y * inv) + bias, q2 = (int)rintf(v[i].z * inv) + bias, q3 = (int)rintf(v[i].w * inv) + bias;
        *(unsigned*)(dst8 + ((size_t)sl * nrows + r) * 128 + off) = (unsigned)(q0 & 0xFF) | ((unsigned)(q1 & 0xFF) << 8) | ((unsigned)(q2 & 0xFF) << 16) | ((unsigned)(q3 & 0xFF) << 24); }
}

__device__ __forceinline__ int grab_chunk(const Frame& F, unsigned* ctr, int slice) {
    LAS int* bc = (LAS int*)(F.lds + LDS_MISC_OFF + 64);
    __syncthreads();
    if (F.tid == 0) *bc = (int)__hip_atomic_fetch_add(ctr + slice * 64, 1u, __ATOMIC_RELAXED, __HIP_MEMORY_SCOPE_AGENT);
    __syncthreads();
    return *bc;
}

__device__ __forceinline__ void p10a_udots(const Frame& F) {
    const unsigned char* U8S = F.ws + WS_U8S; const unsigned char* X8S = F.ws + WS_X8S; const int* EIDX = (const int*)(F.ws + WS_EIDX); int* PART = (int*)(F.ws + WS_PART);
    unsigned* ctr = (unsigned*)(F.ws + WS_CTL + CTL_CTR_A);
    const int lane = F.lane, j = lane >> 3, c = lane & 7; const int xcc = (int)(xb_xcc_id() & 7u);
    for (int so = 0; so < 8; ++so) { const int x = (xcc + so) & 7;
        for (;;) { const int chunk = grab_chunk(F, ctr, x); if (chunk >= PEER_NCHUNK) break;
            const unsigned char* ub = U8S + (size_t)x * NEXP * 128 + c * 16;
#pragma unroll 1
            for (int tt = 0; tt < 16; ++tt) { const int t = chunk * PEER_CHUNK_TOK + F.wave * 16 + tt;
                const i32x4v xq = *(const i32x4v*)(X8S + ((size_t)x * T + t) * 128 + c * 16);
                i32x4v ev[4];
#pragma unroll
                for (int q = 0; q < 4; ++q) ev[q] = *(const i32x4v*)(EIDX + (size_t)t * 128 + 16 * j + 4 * q);
                i32x4v uv[16];
#pragma unroll
                for (int ld = 0; ld < 16; ++ld) uv[ld] = *(const i32x4v*)(ub + (size_t)ev[ld >> 2][ld & 3] * 128);
                i32x4v res[4];
#pragma unroll
                for (int ld = 0; ld < 16; ++ld) { int p = __builtin_amdgcn_sdot4(uv[ld][0], xq[0], 0, false); p = __builtin_amdgcn_sdot4(uv[ld][1], xq[1], p, false);
                    p = __builtin_amdgcn_sdot4(uv[ld][2], xq[2], p, false); p = __builtin_amdgcn_sdot4(uv[ld][3], xq[3], p, false);
                    p += __shfl_xor(p, 1); p += __shfl_xor(p, 2); p += __shfl_xor(p, 4); res[ld >> 2][ld & 3] = p; }
                if (c == 0) {
#pragma unroll
                    for (int q = 0; q < 4; ++q) *(i32x4v*)(PART + ((size_t)x * T + t) * 128 + 16 * j + 4 * q) = res[q]; }
            }
        }
    }
}

__device__ __forceinline__ void p10b_coef(const Frame& F) {
    const int* EIDX = (const int*)(F.ws + WS_EIDX); const float* EW = (const float*)(F.ws + WS_EW); const int* PART = (const int*)(F.ws + WS_PART);
    const float* SU = (const float*)(F.ws + WS_SU); const float* SV = (const float*)(F.ws + WS_SV); const float* SX = (const float*)(F.ws + WS_SX);
    float* CS = (float*)(F.ws + WS_CS); float* CSUM = (float*)(F.ws + WS_CSUM);
    const int gw = blockIdx.x * NWAVES + F.wave, nw = F.G * NWAVES, lane = F.lane;
    for (int t = gw; t < T; t += nw) { const float sx = SX[t]; float tot = 0.f;
#pragma unroll
        for (int hh = 0; hh < 2; ++hh) { const int i = lane + 64 * hh; int s = 0;
#pragma unroll
            for (int x = 0; x < 8; ++x) s += PART[((size_t)x * T + t) * 128 + i];
            const int e = EIDX[(size_t)t * 128 + i]; const float dot = (float)s * sx * SU[e];
            const float cs = EW[(size_t)t * 128 + i] * gelu_tanh(dot) * SV[e]; CS[(size_t)t * 128 + i] = cs; tot += cs; }
        tot = wave_sum(tot); if (lane == 0) CSUM[t] = tot; }
}

__device__ __forceinline__ void p10c_vsum(const Frame& F) {
    const unsigned char* V8S = F.ws + WS_V8S; const int* EIDX = (const int*)(F.ws + WS_EIDX); const float* CS = (const float*)(F.ws + WS_CS); const float* CSUM = (const float*)(F.ws + WS_CSUM);
    const float* MOD = (const float*)(F.ws + WS_MOD); float* SSQP = (float*)(F.ws + WS_SSQP); float* out = F.out;
    unsigned* ctr = (unsigned*)(F.ws + WS_CTL + CTL_CTR_B);
    const int lane = F.lane, j = lane >> 3, c = lane & 7; const int xcc = (int)(xb_xcc_id() & 7u);
    const int ocol = 16 * c + 8 * ((lane >> 5) & 1) + 4 * ((lane >> 4) & 1) + 2 * ((lane >> 3) & 1);
    for (int so = 0; so < 8; ++so) { const int x = (xcc + so) & 7;
        for (;;) { const int chunk = grab_chunk(F, ctr, x); if (chunk >= PEER_NCHUNK) break;
            const unsigned char* vb = V8S + (size_t)x * NEXP * 128 + c * 16;
#pragma unroll 1
            for (int tt = 0; tt < 16; ++tt) { const int t = chunk * PEER_CHUNK_TOK + F.wave * 16 + tt; const int b = t / S;
                i32x4v ev[4]; f32x4 cv[4];
#pragma unroll
                for (int q = 0; q < 4; ++q) { ev[q] = *(const i32x4v*)(EIDX + (size_t)t * 128 + 16 * j + 4 * q); cv[q] = *(const f32x4*)(CS + (size_t)t * 128 + 16 * j + 4 * q); }
                u32x4v vv[16];
#pragma unroll
                for (int ld = 0; ld < 16; ++ld) vv[ld] = *(const u32x4v*)(vb + (size_t)ev[ld >> 2][ld & 3] * 128);
                float acc[16];
#pragma unroll
                for (int k = 0; k < 16; ++k) acc[k] = 0.f;
#pragma unroll
                for (int ld = 0; ld < 16; ++ld) { const float cf = cv[ld >> 2][ld & 3];
#pragma unroll
                    for (int w = 0; w < 4; ++w) { const unsigned u = vv[ld][w];
                        acc[4 * w + 0] += cf * (float)(u & 0xFFu); acc[4 * w + 1] += cf * (float)((u >> 8) & 0xFFu); acc[4 * w + 2] += cf * (float)((u >> 16) & 0xFFu); acc[4 * w + 3] += cf * (float)(u >> 24); } }
                float a8[8], a4[4], a2[2];
                { const bool hi = (lane & 32) != 0;
#pragma unroll
                    for (int k = 0; k < 8; ++k) { const float snd = hi ? acc[k] : acc[k + 8]; const float rcv = __shfl_xor(snd, 32); a8[k] = (hi ? acc[k + 8] : acc[k]) + rcv; } }
                { const bool hi = (lane & 16) != 0;
#pragma unroll
                    for (int k = 0; k < 4; ++k) { const float snd = hi ? a8[k] : a8[k + 4]; const float rcv = __shfl_xor(snd, 16); a4[k] = (hi ? a8[k + 4] : a8[k]) + rcv; } }
                { const bool hi = (lane & 8) != 0;
#pragma unroll
                    for (int k = 0; k < 2; ++k) { const float snd = hi ? a4[k] : a4[k + 2]; const float rcv = __shfl_xor(snd, 8); a2[k] = (hi ? a4[k + 2] : a4[k]) + rcv; } }
                const float off = 128.0f * CSUM[t];
                const int col = x * 128 + ocol; float* xp = out + (size_t)t * D + col;
                const float2 x1 = *(const float2*)xp; const float2 gt = *(const float2*)(MOD + b * 6144 + 5120 + col);
                const float y0 = x1.x + gt.x * (a2[0] - off), y1 = x1.y + gt.y * (a2[1] - off);
                *(float2*)xp = make_float2(y0, y1);
                const float ss = wave_sum(y0 * y0 + y1 * y1); if (lane == 0) SSQP[(size_t)t * 8 + x] = ss;
            }
        }
    }
}

__device__ __forceinline__ void p10d_final(const Frame& F) {
    const float* SSQP = (const float*)(F.ws + WS_SSQP); const float* gfin = F.in[22]; float* out = F.out;
    const int gw = blockIdx.x * NWAVES + F.wave, nw = F.G * NWAVES, lane = F.lane;
    for (int t = gw; t < T; t += nw) {
        float ss = 0.f;
#pragma unroll
        for (int x = 0; x < 8; ++x) ss += SSQP[(size_t)t * 8 + x];
        const float rstd = rsqrtf(ss * (1.0f / D) + EPS);
#pragma unroll
        for (int i = 0; i < 4; ++i) { const int col = (lane + 64 * i) * 4; const float4 v = *(const float4*)(out + (size_t)t * D + col), gg = *(const float4*)(gfin + col);
            *(float4*)(out + (size_t)t * D + col) = make_float4(v.x * rstd * gg.x, v.y * rstd * gg.y, v.z * rstd * gg.z, v.w * rstd * gg.w); }
    }
}

__device__ __forceinline__ void transpose_tile(const Frame& F, const float* src, int srcK, int srcN, bf16_t* dst, int dstK, int kt, int nt) {
    LAS float* tile = (LAS float*)F.lds;
    const int k0 = kt * 64, n0 = nt * 64;
    for (int i = F.tid; i < 4096; i += NTHREADS) { const int r = i >> 6, c = i & 63; const int k = k0 + r, n = n0 + c;
        tile[r * 65 + c] = (k < srcK && n < srcN) ? src[(size_t)k * srcN + n] : 0.0f; }
    __syncthreads();
    for (int i = F.tid; i < 4096; i += NTHREADS) { const int r = i >> 6, c = i & 63;
        dst[(size_t)(n0 + r) * dstK + k0 + c] = f2bf(tile[c * 65 + r]); }
    __syncthreads();
}
__device__ __forceinline__ void p0_prologue(const Frame& F) {
    const float* c = F.in[1]; const float* w_mod = F.in[4]; const float* b_mod = F.in[5];
    float* MOD = (float*)(F.ws + WS_MOD);
    constexpr int I_MOD = 192, I_WIN = 16 * 48, I_WOUT = 256, I_WQ = 256, I_U = 256, I_V = 256, I_KEYS = 2;
    constexpr int O_WIN = I_MOD, O_WOUT = O_WIN + I_WIN, O_WQ = O_WOUT + I_WOUT, O_U = O_WQ + I_WQ, O_V = O_U + I_U, O_KEYS = O_V + I_V, N_ITEMS = O_KEYS + I_KEYS;
    for (int it = blockIdx.x; it < N_ITEMS; it += F.G) {
        if (it < O_WIN) {
            const int idx = it * NTHREADS + F.tid; const int b = idx / 6144, j = idx % 6144;
            float acc = 0.f;
            for (int k = 0; k < D; ++k) { const float cv = c[b * D + k]; const float sv = cv / (1.0f + __expf(-cv)); acc += sv * w_mod[(size_t)k * 6144 + j]; }
            MOD[b * 6144 + j] = acc + b_mod[j];
        } else if (it < O_WOUT) { const int i = it - O_WIN; transpose_tile(F, F.in[6], D, NCOL, (bf16_t*)(F.ws + WS_WIN), D, i % 16, i / 16); }
        else if (it < O_WQ) { const int i = it - O_WOUT; transpose_tile(F, F.in[16], D, D, (bf16_t*)(F.ws + WS_WOUT), D, i % 16, i / 16); }
        else if (it < O_U) { const int i = it - O_WQ; transpose_tile(F, F.in[17], D, D, (bf16_t*)(F.ws + WS_WQ), D, i % 16, i / 16); }
        else if (it < O_KEYS) {
            const bool isv = it >= O_V; const int i = isv ? it - O_V : it - O_U;
            for (int rr = 0; rr < 8; ++rr) { const size_t r = (size_t)i * 64 + rr * 8 + F.wave;
                quant_row_sliced((isv ? F.in[20] : F.in[19]) + r * D, F.ws + (isv ? WS_V8S : WS_U8S), NEXP, r, (float*)(F.ws + (isv ? WS_SV : WS_SU)) + r, isv ? 128 : 0, F.lane); }
        } else {
            const int i = it - O_KEYS; const float4* src = (const float4*)F.in[18] + (size_t)i * 16384; uint2* dst = (uint2*)(F.ws + WS_KEYS) + (size_t)i * 16384;
            for (int q = F.tid; q < 16384; q += NTHREADS) { const float4 v = src[q]; dst[q] = make_uint2(pack2(v.x, v.y), pack2(v.z, v.w)); }
        }
    }
}

__device__ __forceinline__ void norm_mod_rows(const Frame& F, const float* x, const float* g, int sh_off, int sc_off, bf16_t* dst) {
    const float* MOD = (const float*)(F.ws + WS_MOD);
    const int gw = blockIdx.x * NWAVES + F.wave, nw = F.G * NWAVES;
    for (int t = gw; t < T; t += nw) {
        const int b = t / S; const float4* xr = (const float4*)(x + (size_t)t * D);
        float4 v[4]; float ss = 0.f;
#pragma unroll
        for (int i = 0; i < 4; ++i) { v[i] = xr[F.lane + 64 * i]; ss += v[i].x * v[i].x + v[i].y * v[i].y + v[i].z * v[i].z + v[i].w * v[i].w; }
        ss = wave_sum(ss); const float rstd = rsqrtf(ss * (1.0f / D) + EPS);
#pragma unroll
        for (int i = 0; i < 4; ++i) { const int col = (F.lane + 64 * i) * 4;
            const float4 gg = *(const float4*)(g + col), sc = *(const float4*)(MOD + b * 6144 + sc_off + col), sh = *(const float4*)(MOD + b * 6144 + sh_off + col);
            const float o0 = v[i].x * rstd * gg.x * (1.f + sc.x) + sh.x, o1 = v[i].y * rstd * gg.y * (1.f + sc.y) + sh.y, o2 = v[i].z * rstd * gg.z * (1.f + sc.z) + sh.z, o3 = v[i].w * rstd * gg.w * (1.f + sc.w) + sh.w;
            *(uint2*)(dst + (size_t)t * D + col) = make_uint2(pack2(o0, o1), pack2(o2, o3)); }
    }
}

__device__ __forceinline__ void norm_mod_rows_q(const Frame& F, const float* x, const float* g, int sh_off, int sc_off, bf16_t* dst) {
    const float* MOD = (const float*)(F.ws + WS_MOD);
    const int gw = blockIdx.x * NWAVES + F.wave, nw = F.G * NWAVES;
    for (int t = gw; t < T; t += nw) {
        const int b = t / S; const float4* xr = (const float4*)(x + (size_t)t * D);
        float4 v[4]; float ss = 0.f;
#pragma unroll
        for (int i = 0; i < 4; ++i) { v[i] = xr[F.lane + 64 * i]; ss += v[i].x * v[i].x + v[i].y * v[i].y + v[i].z * v[i].z + v[i].w * v[i].w; }
        ss = wave_sum(ss); const float rstd = rsqrtf(ss * (1.0f / D) + EPS);
        float am = 0.f;
#pragma unroll
        for (int i = 0; i < 4; ++i) { const int col = (F.lane + 64 * i) * 4;
            const float4 gg = *(const float4*)(g + col), sc = *(const float4*)(MOD + b * 6144 + sc_off + col), sh = *(const float4*)(MOD + b * 6144 + sh_off + col);
            v[i].x = v[i].x * rstd * gg.x * (1.f + sc.x) + sh.x; v[i].y = v[i].y * rstd * gg.y * (1.f + sc.y) + sh.y; v[i].z = v[i].z * rstd * gg.z * (1.f + sc.z) + sh.z; v[i].w = v[i].w * rstd * gg.w * (1.f + sc.w) + sh.w;
            *(uint2*)(dst + (size_t)t * D + col) = make_uint2(pack2(v[i].x, v[i].y), pack2(v[i].z, v[i].w));
            am = fmaxf(am, fmaxf(fmaxf(fabsf(v[i].x), fabsf(v[i].y)), fmaxf(fabsf(v[i].z), fabsf(v[i].w)))); }
        am = wave_max(am); const float inv = am > 0.f ? 127.0f / am : 0.f;
        if (F.lane == 0) ((float*)(F.ws + WS_SX))[t] = am > 0.f ? am / 127.0f : 0.f;
#pragma unroll
        for (int i = 0; i < 4; ++i) { const int col = (F.lane + 64 * i) * 4; const int sl = col >> 7, off = col & 127;
            const int q0 = (int)rintf(v[i].x * inv), q1 = (int)rintf(v[i].y * inv), q2 = (int)rintf(v[i].z * inv), q3 = (int)rintf(v[i].w * inv);
            *(unsigned*)(F.ws + WS_X8S + ((size_t)sl * T + t) * 128 + off) = (unsigned)(q0 & 0xFF) | ((unsigned)(q1 & 0xFF) << 8) | ((unsigned)(q2 & 0xFF) << 16) | ((unsigned)(q3 & 0xFF) << 24); }
    }
}

__device__ __forceinline__ void p3_compress_naive(const Frame& F) {
    const bf16_t* PROJ = (const bf16_t*)(F.ws + WS_PROJ);
    LAS float* hid = (LAS float*)F.lds + F.wave * 64;
    const int gw = blockIdx.x * NWAVES + F.wave, nw = F.G * NWAVES;
    if (gw < 64) { bf16_t* dz = (bf16_t*)(F.ws + ((gw & 1) ? WS_VC : WS_KC)); dz[((size_t)(gw >> 1) * 128 + 127) * 64 + F.lane] = 0; }
    for (int u = gw; u < NB * NCMP * 2 * 2; u += nw) {
        const int kv = u & 1, g = (u >> 1) & 1, n = (u >> 2) % NCMP, b = (u >> 2) / NCMP;
        const float* pe = kv ? F.in[8] : F.in[7]; const float* w1 = kv ? F.in[11] : F.in[9]; const float* w2 = kv ? F.in[12] : F.in[10];
        const int cbase = (kv ? C_VC : C_KC) + g * 64;
        float acc = 0.f;
        for (int l = 0; l < 32; ++l) {
            const bf16_t* row = PROJ + (size_t)(b * S + 16 * n + l) * NPAD + cbase;
            for (int d = 0; d < 64; ++d) { const float a = bf2f(row[d]) + pe[l * 64 + d]; acc += a * w1[(size_t)(l * 64 + d) * 64 + F.lane]; }
        }
        hid[F.lane] = gelu_tanh(acc); lds_wave_sync();
        float o = 0.f;
        for (int j = 0; j < 64; ++j) o += hid[j] * w2[j * 64 + F.lane];
        bf16_t* dst = (bf16_t*)(F.ws + (kv ? WS_VC : WS_KC)); dst[((size_t)(b * 2 + g) * 128 + n) * 64 + F.lane] = f2bf(o);
        lds_wave_sync();
    }
}

__device__ __forceinline__ void dot4_row(const bf16_t* krow, const LAS float* qs, float (&acc)[4]) {
    const uint4* kr = (const uint4*)krow;
#pragma unroll 1
    for (int c = 0; c < 8; ++c) { asm volatile("" ::: "memory"); const uint4 w = kr[c]; const unsigned ww[4] = {w.x, w.y, w.z, w.w};
#pragma unroll
        for (int e = 0; e < 4; ++e) { const float k0 = bflo(ww[e]), k1 = bfhi(ww[e]); const int d = c * 8 + e * 2;
#pragma unroll
            for (int r = 0; r < 4; ++r) acc[r] += qs[r * 64 + d] * k0 + qs[r * 64 + d + 1] * k1; } }
}
__device__ __forceinline__ void p4_attn_naive(const Frame& F) {
    const bf16_t* PROJ = (const bf16_t*)(F.ws + WS_PROJ); const bf16_t* KC = (const bf16_t*)(F.ws + WS_KC); const bf16_t* VC = (const bf16_t*)(F.ws + WS_VC);
    bf16_t* OATT = (bf16_t*)(F.ws + WS_OATT); const float* rel = F.in[21];
    LAS float* wl = (LAS float*)F.lds + F.wave * (256 + 512 + 2048 + 16);
    LAS float* qs = wl; LAS float* pc = wl + 256; LAS float* ps = wl + 768; LAS int* pbase = (LAS int*)(wl + 768 + 2048);
    const int gw = blockIdx.x * NWAVES + F.wave, nw = F.G * NWAVES, lane = F.lane;
    for (int u = gw; u < T * 2; u += nw) {
        const int g = u & 1, tok = u >> 1, b = tok / S, t = tok % S;
        const bf16_t* prow = PROJ + (size_t)tok * NPAD;
#pragma unroll
        for (int r = 0; r < 4; ++r) qs[r * 64 + lane] = bf2f(prow[C_Q + (g * 4 + r) * 64 + lane]) * 0.125f;
        lds_wave_sync();
        const int nv = t >= 31 ? ((t - 31) >> 4) + 1 : 0;
        float sc[2][4]; bool va[2];
#pragma unroll
        for (int i = 0; i < 2; ++i) { const int n = lane + 64 * i; va[i] = n < nv; float a[4] = {0.f, 0.f, 0.f, 0.f};
            if (va[i]) { dot4_row(KC + ((size_t)(b * 2 + g) * 128 + n) * 64, qs, a); const int bk = rel_bucket(t - (16 * n + 31));
#pragma unroll
                for (int r = 0; r < 4; ++r) a[r] += rel[bk * 8 + g * 4 + r]; }
#pragma unroll
            for (int r = 0; r < 4; ++r) sc[i][r] = va[i] ? a[r] : -1e30f; }
        float ocmp[4];
#pragma unroll
        for (int r = 0; r < 4; ++r) { const float m = wave_max(fmaxf(sc[0][r], sc[1][r]));
            const float e0 = va[0] ? __expf(sc[0][r] - m) : 0.f, e1 = va[1] ? __expf(sc[1][r] - m) : 0.f; const float sum = wave_sum(e0 + e1);
            const float inv = nv > 0 ? 1.0f / sum : 0.f; pc[r * 128 + lane] = e0 * inv; pc[r * 128 + 64 + lane] = e1 * inv; }
        lds_wave_sync();
        { float o[4] = {0.f, 0.f, 0.f, 0.f}; const bf16_t* vb = VC + ((size_t)(b * 2 + g) * 128) * 64 + lane;
            for (int n = 0; n < nv; ++n) { const float v = bf2f(vb[n * 64]);
#pragma unroll
                for (int r = 0; r < 4; ++r) o[r] += pc[r * 128 + n] * v; }
#pragma unroll
            for (int r = 0; r < 4; ++r) ocmp[r] = o[r]; }
        const int cur = t >> 6; float val;
        { const int j = lane & 31; float imp = 0.f;
#pragma unroll
            for (int r = 0; r < 4; ++r) for (int n = 4 * j - 1; n <= 4 * j + 3; ++n) if (n >= 0 && n < NCMP) imp += pc[r * 128 + n];
            const bool forced = (j == 0) || (j == cur) || (j == cur - 1); const bool allowed = j <= cur;
            val = forced ? 1e4f : (allowed ? imp : -INFINITY); }
        int rank = 0;
        for (int jp = 0; jp < 32; ++jp) { const float vp = __shfl(val, jp); rank += ((vp > val) || (vp == val && jp < (lane & 31))) ? 1 : 0; }
        unsigned selmask = (unsigned)(__ballot(lane < 32 && rank < 8) & 0xFFFFFFFFull);
        float oslc[4], owin[4];
#pragma unroll
        for (int br = 0; br < 2; ++br) {
            const int ck = br == 0 ? C_KS : C_KW, cv = br == 0 ? C_VS : C_VW;
            unsigned mk = selmask;
#pragma unroll 1
            for (int c = 0; c < 8; ++c) {
                int kpos, bs;
                if (br == 0) { const int j = __builtin_ctz(mk | 0x80000000u); mk &= mk - 1; bs = 64 * j; } else { bs = t - 511 + 64 * c; }
                kpos = bs + lane; if (lane == 0) pbase[c] = bs;
                const int dist = t - kpos; const bool vv = (dist >= 0) && (kpos >= 0) && (kpos < S);
                float a[4] = {0.f, 0.f, 0.f, 0.f};
                if (vv) { dot4_row(PROJ + (size_t)(b * S + kpos) * NPAD + ck + g * 64, qs, a); const int bk = rel_bucket(dist);
#pragma unroll
                    for (int r = 0; r < 4; ++r) a[r] += rel[bk * 8 + g * 4 + r]; }
#pragma unroll
                for (int r = 0; r < 4; ++r) ps[r * 512 + c * 64 + lane] = vv ? a[r] : -1e30f;
            }
            lds_wave_sync();
#pragma unroll 1
            for (int r = 0; r < 4; ++r) { float m = -1e30f;
#pragma unroll
                for (int c = 0; c < 8; ++c) m = fmaxf(m, ps[r * 512 + c * 64 + lane]);
                m = wave_max(m); float e[8], sum = 0.f;
#pragma unroll
                for (int c = 0; c < 8; ++c) { const float sv = ps[r * 512 + c * 64 + lane]; e[c] = sv > -1e29f ? __expf(sv - m) : 0.f; sum += e[c]; }
                sum = wave_sum(sum); const float inv = sum > 0.f ? 1.0f / sum : 0.f;
#pragma unroll
                for (int c = 0; c < 8; ++c) ps[r * 512 + c * 64 + lane] = e[c] * inv; }
            lds_wave_sync();
            float o[4] = {0.f, 0.f, 0.f, 0.f};
#pragma unroll 1
            for (int c = 0; c < 8; ++c) {
                const int bsc = pbase[c];
                for (int kk = 0; kk < 64; ++kk) { const int kpos = bsc + kk; if (kpos < 0 || kpos > t) continue;
                    const float v = bf2f(PROJ[(size_t)(b * S + kpos) * NPAD + cv + g * 64 + lane]);
#pragma unroll
                    for (int r = 0; r < 4; ++r) o[r] += ps[r * 512 + c * 64 + kk] * v; } }
            lds_wave_sync();
#pragma unroll
            for (int r = 0; r < 4; ++r) { if (br == 0) oslc[r] = o[r]; else owin[r] = o[r]; }
        }
#pragma unroll
        for (int r = 0; r < 4; ++r) { const int h = g * 4 + r;
            const float g0 = sigmoidf_(bf2f(prow[C_GT + h * 3 + 0])), g1 = sigmoidf_(bf2f(prow[C_GT + h * 3 + 1])), g2 = sigmoidf_(bf2f(prow[C_GT + h * 3 + 2]));
            OATT[(size_t)tok * 512 + h * 64 + lane] = f2bf(g0 * ocmp[r] + g1 * oslc[r] + g2 * owin[r]); }
    }
}


constexpr float LOG2E = 1.4426950408889634f;
constexpr int AT_KC = 0, AT_VC = 16384, AT_KV = 32768  , AT_BTAB = 65536, AT_IMP = 69888, AT_SEL = 78336, AT_OUT = 78592  , AT_END = 78592 + 65536;
constexpr int BT_STRIDE = 132;
__device__ __forceinline__ int tile_off(int row, int chunk) { return row * 128 + ((chunk ^ (row & 7)) << 4); }
__device__ __forceinline__ bf16x8 mk_frag(unsigned a, unsigned b, unsigned c, unsigned d) { u32x4v v = {a, b, c, d}; return __builtin_bit_cast(bf16x8, v); }
struct LaneOffs { int koff[2]; int voff[4]; int soff; };
__device__ __forceinline__ LaneOffs lane_offs(int lane, int tid) {
    LaneOffs L; const int grp = lane >> 4, rowi = lane & 15, q4 = rowi >> 2, p = lane & 3;
#pragma unroll
    for (int ks = 0; ks < 2; ++ks) L.koff[ks] = tile_off(rowi, ks * 4 + grp);
#pragma unroll
    for (int dt = 0; dt < 4; ++dt) L.voff[dt] = tile_off(4 * grp + q4, 2 * dt + (p >> 1)) + 8 * (p & 1);
    L.soff = tile_off(tid >> 3, tid & 7); return L;
}
__device__ __forceinline__ bf16x8 vfrag_read(const LAS unsigned char* vt, int voff_dt, int row0) {
    const s16x4 a = __builtin_amdgcn_ds_read_tr16_b64_v4i16((LAS s16x4*)(vt + voff_dt + row0 * 128));
    const s16x4 b = __builtin_amdgcn_ds_read_tr16_b64_v4i16((LAS s16x4*)(vt + voff_dt + row0 * 128 + 2048));
    bf16x8 f = {a[0], a[1], a[2], a[3], b[0], b[1], b[2], b[3]}; return f;
}

struct AttnState {
    f32x4 o[4][2]; float m[2], l[2];
};

template <int BR>
__device__ __forceinline__ void attn_tile(const LAS unsigned char* kt_lds, const LAS unsigned char* vt_lds, const LAS float* btab_h, const bf16x8 (&qf)[2][2], const int (&tq)[2], const unsigned (&sel)[2],
                                          int j, bool near, AttnState& st, int lane, const LaneOffs& L) {
    const int grp = lane >> 4, kbase = 64 * j;
    f32x4 sacc[4][2];
#pragma unroll
    for (int kt = 0; kt < 4; ++kt) { sacc[kt][0] = (f32x4){0.f, 0.f, 0.f, 0.f}; sacc[kt][1] = (f32x4){0.f, 0.f, 0.f, 0.f}; }
#pragma unroll
    for (int kt = 0; kt < 4; ++kt)
#pragma unroll
        for (int ks = 0; ks < 2; ++ks) { const bf16x8 kf = *(const LAS bf16x8*)(kt_lds + L.koff[ks] + kt * 2048);
            sacc[kt][0] = __builtin_amdgcn_mfma_f32_16x16x32_bf16(kf, qf[0][ks], sacc[kt][0], 0, 0, 0);
            sacc[kt][1] = __builtin_amdgcn_mfma_f32_16x16x32_bf16(kf, qf[1][ks], sacc[kt][1], 0, 0, 0); }
    __builtin_amdgcn_sched_barrier(0);
    const float SC = 0.125f * LOG2E; const float bfar = btab_h[128];
    bf16x8 pf[2][2];
#pragma unroll
    for (int qt = 0; qt < 2; ++qt) {
        const int t = tq[qt]; const bool selq = BR == 0 ? ((sel[qt] >> j) & 1u) != 0u : true;
        float sv[4][4]; float tmax = -1e30f;
        int d0 = t - 4 * grp - kbase; asm volatile("" : "+v"(d0));
        if (near) {
#pragma unroll
            for (int kt = 0; kt < 4; ++kt)
#pragma unroll
                for (int rg = 0; rg < 4; ++rg) { const int dist = d0 - (kt * 16 + rg); const int dd = dist < 0 ? 0 : (dist > 128 ? 128 : dist); sv[kt][rg] = btab_h[dd]; }
        } else {
#pragma unroll
            for (int kt = 0; kt < 4; ++kt)
#pragma unroll
                for (int rg = 0; rg < 4; ++rg) sv[kt][rg] = bfar;
        }
#pragma unroll
        for (int kt = 0; kt < 4; ++kt)
#pragma unroll
            for (int rg = 0; rg < 4; ++rg) { const int c = kt * 16 + rg;
                const bool valid = BR == 0 ? (selq && d0 >= c) : (d0 >= c && d0 < 512 + c);
                const float sx = sacc[kt][qt][rg] * SC + sv[kt][rg]; const float s = valid ? sx : -1e30f; sv[kt][rg] = s; tmax = fmaxf(tmax, s); }
        tmax = fmaxf(tmax, __shfl_xor(tmax, 16)); tmax = fmaxf(tmax, __shfl_xor(tmax, 32));
        const float mnew = fmaxf(st.m[qt], tmax); const float alpha = __builtin_amdgcn_exp2f(st.m[qt] - mnew); st.m[qt] = mnew;
        const float muse = mnew < -1e29f ? 0.f : mnew;
        float ls = 0.f; unsigned pk[4][2];
#pragma unroll
        for (int kt = 0; kt < 4; ++kt) { float e[4];
#pragma unroll
            for (int rg = 0; rg < 4; ++rg) { e[rg] = __builtin_amdgcn_exp2f(sv[kt][rg] - muse); ls += e[rg]; }
            pk[kt][0] = pg8::cvt_pk_bf16(e[0], e[1]); pk[kt][1] = pg8::cvt_pk_bf16(e[2], e[3]); }
        st.l[qt] = st.l[qt] * alpha + ls;
#pragma unroll
        for (int dt = 0; dt < 4; ++dt) st.o[dt][qt] *= alpha;
        pf[qt][0] = mk_frag(pk[0][0], pk[0][1], pk[1][0], pk[1][1]); pf[qt][1] = mk_frag(pk[2][0], pk[2][1], pk[3][0], pk[3][1]);
        __builtin_amdgcn_sched_barrier(0);
    }
#pragma unroll
    for (int ks = 0; ks < 2; ++ks)
#pragma unroll
        for (int dt = 0; dt < 4; ++dt) { const bf16x8 vf = vfrag_read(vt_lds, L.voff[dt], 32 * ks);
            st.o[dt][0] = __builtin_amdgcn_mfma_f32_16x16x32_bf16(vf, pf[0][ks], st.o[dt][0], 0, 0, 0);
            st.o[dt][1] = __builtin_amdgcn_mfma_f32_16x16x32_bf16(vf, pf[1][ks], st.o[dt][1], 0, 0, 0); }
}

template <int BR>
__device__ __forceinline__ void attn_branch(const Frame& F, const bf16_t* PROJ, int b, int g, int t0, unsigned tiles  , const LAS float* btab_h,
                                            const bf16x8 (&qf)[2][2], const int (&tq)[2], const unsigned (&sel)[2], const float (&gate)[2], const LaneOffs& L) {
    const int lane = F.lane, tid = F.tid;
    const int ck = (BR == 0 ? C_KS : C_KW) + g * 64, cv = (BR == 0 ? C_VS : C_VW) + g * 64;
    const int srow = tid >> 3, sch = tid & 7;
    AttnState st;
#pragma unroll
    for (int dt = 0; dt < 4; ++dt) { st.o[dt][0] = (f32x4){0.f, 0.f, 0.f, 0.f}; st.o[dt][1] = (f32x4){0.f, 0.f, 0.f, 0.f}; }
    st.m[0] = st.m[1] = -1e30f; st.l[0] = st.l[1] = 0.f;
    unsigned rem = tiles; int cur = 0;
    u32x4v rk, rv;
    { const int j = __builtin_ctz(rem); const bf16_t* rowp = PROJ + (size_t)(b * S + 64 * j + srow) * NPAD + sch * 8;
        rk = *(const u32x4v*)(rowp + ck); rv = *(const u32x4v*)(rowp + cv);
        *(LAS u32x4v*)(F.lds + AT_KV + L.soff) = rk; *(LAS u32x4v*)(F.lds + AT_KV + 8192 + L.soff) = rv; }
    __syncthreads();
    while (rem) {
        const int j = __builtin_ctz(rem); rem &= rem - 1;
        const bool has_next = rem != 0u;
        if (has_next) { const int jn = __builtin_ctz(rem); const bf16_t* rowp = PROJ + (size_t)(b * S + 64 * jn + srow) * NPAD + sch * 8; rk = *(const u32x4v*)(rowp + ck); rv = *(const u32x4v*)(rowp + cv); }
        const bool near = (t0 + 8 * F.wave) - (64 * j + 63) < 128;
        attn_tile<BR>(F.lds + AT_KV + cur * 16384, F.lds + AT_KV + cur * 16384 + 8192, btab_h, qf, tq, sel, j, near, st, lane, L);
        if (has_next) { *(LAS u32x4v*)(F.lds + AT_KV + (cur ^ 1) * 16384 + L.soff) = rk; *(LAS u32x4v*)(F.lds + AT_KV + (cur ^ 1) * 16384 + 8192 + L.soff) = rv; }
        __syncthreads();
        cur ^= 1;
    }
    int pob = AT_OUT + tid * 4; asm volatile("" : "+v"(pob));
    LAS float* po = (LAS float*)(F.lds + pob);
#pragma unroll
    for (int qt = 0; qt < 2; ++qt) { float l = st.l[qt]; l += __shfl_xor(l, 16); l += __shfl_xor(l, 32); const float sc = l > 0.f ? gate[qt] / l : 0.f;
#pragma unroll
        for (int dt = 0; dt < 4; ++dt)
#pragma unroll
            for (int e = 0; e < 4; ++e) po[((qt * 4 + dt) * 4 + e) * 512] += st.o[dt][qt][e] * sc; }
}

__device__ __forceinline__ void p4_attn_mfma(const Frame& F) {
    const bf16_t* PROJ = (const bf16_t*)(F.ws + WS_PROJ); const bf16_t* KC = (const bf16_t*)(F.ws + WS_KC); const bf16_t* VC = (const bf16_t*)(F.ws + WS_VC);
    bf16_t* OATT = (bf16_t*)(F.ws + WS_OATT); const float* rel = F.in[21];
    const int lane = F.lane, tid = F.tid, wave = F.wave, grp = lane >> 4, col = lane & 15, qi = col >> 2, r = col & 3;
    LAS float* btab = (LAS float*)(F.lds + AT_BTAB); LAS float* impq = (LAS float*)(F.lds + AT_IMP); LAS unsigned* selm = (LAS unsigned*)(F.lds + AT_SEL);
    const LaneOffs L = lane_offs(lane, tid);
    for (int i = tid; i < 8 * 129; i += NTHREADS) { const int hh = i / 129, dd = i % 129; btab[hh * BT_STRIDE + dd] = rel[rel_bucket(dd) * 8 + hh] * LOG2E; }
    __syncthreads();
    for (int uu = blockIdx.x; uu < 1024; uu += F.G) {
        int sidx = uu;
        if (F.G == 256) { const int round = uu >> 8, k = uu & 255; sidx = (round == 0) ? k : (round == 1) ? 511 - k : (round == 2) ? 512 + k : 1023 - k; }
        const int qb = 31 - (sidx >> 5), bg = sidx & 31, b = bg >> 1, g = bg & 1, t0 = qb * 64, h = g * 4 + r;
        const LAS float* btab_h = btab + h * BT_STRIDE;
        int tq[2]; bf16x8 qf[2][2]; float gate[3][2];
#pragma unroll
        for (int qt = 0; qt < 2; ++qt) { tq[qt] = t0 + 8 * wave + 4 * qt + qi; const bf16_t* prow = PROJ + (size_t)(b * S + tq[qt]) * NPAD;
#pragma unroll
            for (int ks = 0; ks < 2; ++ks) qf[qt][ks] = *(const bf16x8*)(prow + C_Q + h * 64 + ks * 32 + 8 * grp);
#pragma unroll
            for (int jg = 0; jg < 3; ++jg) gate[jg][qt] = sigmoidf_(bf2f(prow[C_GT + h * 3 + jg])); }
#pragma unroll
        for (int i = 0; i < 2; ++i) { const int c2 = tid + 512 * i, row = c2 >> 3, ch = c2 & 7; const size_t src = ((size_t)(b * 2 + g) * 128 + row) * 64 + ch * 8;
            *(LAS u32x4v*)(F.lds + AT_KC + L.soff + 8192 * i) = *(const u32x4v*)(KC + src); *(LAS u32x4v*)(F.lds + AT_VC + L.soff + 8192 * i) = *(const u32x4v*)(VC + src); }
        __syncthreads();
#ifndef AT_SKIP_CMP
        {
            const int nvmax = t0 + 63 >= 31 ? ((t0 + 63 - 31) >> 4) + 1 : 0;
            const float SC = 0.125f * LOG2E; const int srcl = (lane + 48) & 63;
            int pob = AT_OUT + tid * 4; asm volatile("" : "+v"(pob));
            LAS float* po = (LAS float*)(F.lds + pob);
#pragma unroll
            for (int qt = 0; qt < 2; ++qt) {
                f32x4 sa[8];
#pragma unroll
                for (int kt = 0; kt < 8; ++kt) sa[kt] = (f32x4){0.f, 0.f, 0.f, 0.f};
#pragma unroll
                for (int kt = 0; kt < 8; ++kt) if (kt * 16 < nvmax) {
#pragma unroll
                    for (int ks = 0; ks < 2; ++ks) { const bf16x8 kf = *(const LAS bf16x8*)(F.lds + AT_KC + L.koff[ks] + kt * 2048);
                        sa[kt] = __builtin_amdgcn_mfma_f32_16x16x32_bf16(kf, qf[qt][ks], sa[kt], 0, 0, 0); } }
                __builtin_amdgcn_sched_barrier(0);
                int d0 = tq[qt] - 31 - 64 * grp; asm volatile("" : "+v"(d0));
                float mx = -1e30f;
#pragma unroll
                for (int kt = 0; kt < 8; ++kt)
#pragma unroll
                    for (int rg = 0; rg < 4; ++rg) { const int c = 256 * kt + 16 * rg; const int dist = d0 - c; const int dd = dist < 0 ? 0 : (dist > 128 ? 128 : dist);
                        const float sx = sa[kt][rg] * SC + btab_h[dd]; const float s = d0 >= c ? sx : -1e30f; sa[kt][rg] = s; mx = fmaxf(mx, s); }
                mx = fmaxf(mx, __shfl_xor(mx, 16)); mx = fmaxf(mx, __shfl_xor(mx, 32));
                float sum = 0.f;
#pragma unroll
                for (int kt = 0; kt < 8; ++kt)
#pragma unroll
                    for (int rg = 0; rg < 4; ++rg) { const int c = 256 * kt + 16 * rg; const float ex = __builtin_amdgcn_exp2f(sa[kt][rg] - mx); const float e = d0 >= c ? ex : 0.f; sa[kt][rg] = e; sum += e; }
                __builtin_amdgcn_sched_barrier(0);
                sum += __shfl_xor(sum, 16); sum += __shfl_xor(sum, 32);
                const float inv = sum > 0.f ? 1.0f / sum : 0.f;
                float prev3 = 0.f;
#pragma unroll
                for (int kt = 0; kt < 8; ++kt) { const float p3 = sa[kt][3] * inv; const float part = (sa[kt][0] * inv + sa[kt][1] * inv) + (sa[kt][2] * inv + p3);
                    const float xa = __shfl(p3, srcl), xb = __shfl(prev3, srcl); float tot = part + (grp >= 1 ? xa : xb);
                    tot += __shfl_xor(tot, 1); tot += __shfl_xor(tot, 2);
                    if (r == 0) impq[(8 * wave + 4 * qt + qi) * 33 + 4 * kt + grp] = tot;
                    prev3 = p3; }
                __builtin_amdgcn_sched_barrier(0);
                f32x4 oc[4];
#pragma unroll
                for (int dt = 0; dt < 4; ++dt) oc[dt] = (f32x4){0.f, 0.f, 0.f, 0.f};
#pragma unroll
                for (int ks = 0; ks < 4; ++ks) if (ks * 32 < nvmax) {
                    const bf16x8 pfr = mk_frag(pg8::cvt_pk_bf16(sa[2 * ks][0], sa[2 * ks][1]), pg8::cvt_pk_bf16(sa[2 * ks][2], sa[2 * ks][3]),
                                               pg8::cvt_pk_bf16(sa[2 * ks + 1][0], sa[2 * ks + 1][1]), pg8::cvt_pk_bf16(sa[2 * ks + 1][2], sa[2 * ks + 1][3]));
#pragma unroll
                    for (int dt = 0; dt < 4; ++dt) { const bf16x8 vf = vfrag_read(F.lds + AT_VC, L.voff[dt], 32 * ks); oc[dt] = __builtin_amdgcn_mfma_f32_16x16x32_bf16(vf, pfr, oc[dt], 0, 0, 0); } }
                const float scq = inv * gate[0][qt];
#pragma unroll
                for (int dt = 0; dt < 4; ++dt)
#pragma unroll
                    for (int e = 0; e < 4; ++e) po[((qt * 4 + dt) * 4 + e) * 512] = oc[dt][e] * scq;
                __builtin_amdgcn_sched_barrier(0);
            }
        }
#endif
        __syncthreads();
#ifndef AT_SKIP_SEL
        {
            const int q = tid >> 3, jj = tid & 7, cur = qb; unsigned bits = 0u;
            float vj[4];
#pragma unroll
            for (int e = 0; e < 4; ++e) { const int j = jj * 4 + e; const bool forced = (j == 0) || (j == cur) || (j == cur - 1); vj[e] = forced ? 1e4f : (j <= cur ? impq[q * 33 + j] : -INFINITY); }
            int rk[4] = {0, 0, 0, 0};
            for (int jp = 0; jp < 32; ++jp) { const bool forced = (jp == 0) || (jp == cur) || (jp == cur - 1); const float vp = forced ? 1e4f : (jp <= cur ? impq[q * 33 + jp] : -INFINITY);
#pragma unroll
                for (int e = 0; e < 4; ++e) rk[e] += ((vp > vj[e]) || (vp == vj[e] && jp < jj * 4 + e)) ? 1 : 0; }
#pragma unroll
            for (int e = 0; e < 4; ++e) bits |= (rk[e] < 8 ? 1u : 0u) << (jj * 4 + e);
            bits |= __shfl_xor(bits, 1); bits |= __shfl_xor(bits, 2); bits |= __shfl_xor(bits, 4);
            if (jj == 0) selm[q] = bits;
        }
#endif
        __syncthreads();
        unsigned sel[2] = {selm[8 * wave + qi], selm[8 * wave + 4 + qi]};
        unsigned un = selm[lane];
#pragma unroll
        for (int o = 32; o >= 1; o >>= 1) un |= __shfl_xor(un, o);
        un = __builtin_amdgcn_readfirstlane(un);
        const unsigned causal = qb == 31 ? 0xFFFFFFFFu : ((2u << qb) - 1u);
#ifndef AT_SKIP_BR0
        { const float gt1[2] = {gate[1][0], gate[1][1]}; attn_branch<0>(F, PROJ, b, g, t0, un & causal, btab_h, qf, tq, sel, gt1, L); }
#endif
#ifndef AT_SKIP_BR1
        { const int jlo = qb >= 8 ? qb - 8 : 0; const unsigned wmask = causal & ~((1u << jlo) - 1u); const float gt2[2] = {gate[2][0], gate[2][1]};
            attn_branch<1>(F, PROJ, b, g, t0, wmask, btab_h, qf, tq, sel, gt2, L); }
#endif
        int pob2 = AT_OUT + tid * 4; asm volatile("" : "+v"(pob2));
#pragma unroll
        for (int qt = 0; qt < 2; ++qt) { bf16_t* orow = OATT + (size_t)(b * S + tq[qt]) * 512 + h * 64 + 4 * grp;
#pragma unroll
            for (int dt = 0; dt < 4; ++dt) { const LAS float* po = (const LAS float*)(F.lds + pob2) + (qt * 4 + dt) * 4 * 512;
                *(uint2*)(orow + dt * 16) = make_uint2(pg8::cvt_pk_bf16(po[0], po[512]), pg8::cvt_pk_bf16(po[1024], po[1536])); } }
    }
}
__device__ __forceinline__ void p5_mixed(const Frame& F) {
    const bf16_t* PROJ = (const bf16_t*)(F.ws + WS_PROJ); const bf16_t* OATT = (const bf16_t*)(F.ws + WS_OATT); bf16_t* MIX = (bf16_t*)(F.ws + WS_H);
    const float* cw = F.in[13]; const float* ga = F.in[14]; const float* gc = F.in[15];
    const int gw = blockIdx.x * NWAVES + F.wave, nw = F.G * NWAVES, lane = F.lane;
    for (int tok = gw; tok < T; tok += nw) {
        const int s = tok % S; const int c0 = lane * 8;
        float a[8], y[8];
        { const uint4 w = *(const uint4*)(OATT + (size_t)tok * 512 + c0); const unsigned ww[4] = {w.x, w.y, w.z, w.w};
#pragma unroll
            for (int e = 0; e < 4; ++e) { a[2 * e] = bflo(ww[e]); a[2 * e + 1] = bfhi(ww[e]); } }
#pragma unroll
        for (int e = 0; e < 8; ++e) y[e] = 0.f;
#pragma unroll
        for (int dt = 0; dt < 3; ++dt) { if (s - 2 + dt >= 0) { const bf16_t* row = PROJ + (size_t)(tok - 2 + dt) * NPAD;
                const uint4 wc = *(const uint4*)(row + C_CC + c0), wh = *(const uint4*)(row + C_CH + c0); const unsigned c4[4] = {wc.x, wc.y, wc.z, wc.w}, h4[4] = {wh.x, wh.y, wh.z, wh.w};
#pragma unroll
                for (int e = 0; e < 4; ++e) { y[2 * e] += cw[dt * 512 + c0 + 2 * e] * (bflo(c4[e]) * bflo(h4[e])); y[2 * e + 1] += cw[dt * 512 + c0 + 2 * e + 1] * (bfhi(c4[e]) * bfhi(h4[e])); } } }
        { const uint4 wb = *(const uint4*)(PROJ + (size_t)tok * NPAD + C_CB + c0); const unsigned b4[4] = {wb.x, wb.y, wb.z, wb.w};
#pragma unroll
            for (int e = 0; e < 4; ++e) { y[2 * e] *= bflo(b4[e]); y[2 * e + 1] *= bfhi(b4[e]); } }
        float sa = 0.f, sy = 0.f;
#pragma unroll
        for (int e = 0; e < 8; ++e) { sa += a[e] * a[e]; sy += y[e] * y[e]; }
        sa = wave_sum(sa); sy = wave_sum(sy);
        const float ra = rsqrtf(sa * (1.0f / 512) + EPS), ry = rsqrtf(sy * (1.0f / 512) + EPS);
        unsigned oa[4], oy[4];
#pragma unroll
        for (int e = 0; e < 4; ++e) { oa[e] = pack2(a[2 * e] * ra * ga[c0 + 2 * e], a[2 * e + 1] * ra * ga[c0 + 2 * e + 1]); oy[e] = pack2(y[2 * e] * ry * gc[c0 + 2 * e], y[2 * e + 1] * ry * gc[c0 + 2 * e + 1]); }
        *(uint4*)(MIX + (size_t)tok * D + c0) = make_uint4(oa[0], oa[1], oa[2], oa[3]);
        *(uint4*)(MIX + (size_t)tok * D + 512 + c0) = make_uint4(oy[0], oy[1], oy[2], oy[3]);
    }
}

struct EpiResGate {
    static constexpr bool PERM = false, AFTER_DRAIN = false;
    float* C; const float* X; const float* MOD; int gate_off;
    __device__ __forceinline__ void operator()(const pg8::f32x4 (&acc)[2][2][4][2], const pg8::Unit& u, int wr, int wc, int fr, int fq) const {
        using pg8::f32x4; using pg8::HALF; using pg8::BM;
        const int row0 = u.pm * BM + wr * 64 + fr, col0 = u.pn * BM + wc * 32 + 4 * fq;
        const int b = (u.pm * BM) / S;
        f32x4 gv[2][2];
#pragma unroll
        for (int bj = 0; bj < 2; ++bj)
#pragma unroll
            for (int n = 0; n < 2; ++n) gv[bj][n] = *(const f32x4*)(MOD + b * 6144 + gate_off + col0 + bj * HALF + n * 16);
#pragma unroll
        for (int ai = 0; ai < 2; ++ai)
#pragma unroll
            for (int m = 0; m < 4; ++m) { const size_t ro = (size_t)(row0 + ai * HALF + m * 16) * D + col0;
#pragma unroll
                for (int bj = 0; bj < 2; ++bj)
#pragma unroll
                    for (int n = 0; n < 2; ++n) { const f32x4 xv = *(const f32x4*)(X + ro + bj * HALF + n * 16); *(f32x4*)(C + ro + bj * HALF + n * 16) = xv + gv[bj][n] * acc[ai][bj][m][n]; } }
    }
};

__device__ __forceinline__ void argmax_bfly(float& v, int& i) {
#pragma unroll
    for (int o = 32; o >= 1; o >>= 1) { const float ov = __shfl_xor(v, o); const int oi = __shfl_xor(i, o); if (ov > v || (ov == v && oi < i)) { v = ov; i = oi; } }
}
__device__ __forceinline__ void p9_route_naive(const Frame& F) {
    const bf16_t* QP = (const bf16_t*)(F.ws + WS_QP); const bf16_t* KEYS = (const bf16_t*)(F.ws + WS_KEYS);
    int* EIDX = (int*)(F.ws + WS_EIDX); float* EW = (float*)(F.ws + WS_EW);
    LAS float* ql = (LAS float*)F.lds + F.wave * 128;
    const int gw = blockIdx.x * NWAVES + F.wave, nw = F.G * NWAVES, lane = F.lane;
    for (int u = gw; u < T * 8; u += nw) {
        const int h = u & 7, tok = u >> 3;
        ql[lane] = bf2f(QP[(size_t)tok * D + h * 128 + lane]); ql[64 + lane] = bf2f(QP[(size_t)tok * D + h * 128 + 64 + lane]);
        lds_wave_sync();
        float tv[2]; int ti[2];
#pragma unroll
        for (int p = 0; p < 2; ++p) {
            float s[2];
#pragma unroll
            for (int kk = 0; kk < 2; ++kk) { const uint4* kr = (const uint4*)(KEYS + ((size_t)(h * 2 + p) * 128 + lane + 64 * kk) * 64); float a = 0.f;
#pragma unroll
                for (int c = 0; c < 8; ++c) { const uint4 w = kr[c]; const unsigned ww[4] = {w.x, w.y, w.z, w.w};
#pragma unroll
                    for (int e = 0; e < 4; ++e) a += ql[p * 64 + c * 8 + 2 * e] * bflo(ww[e]) + ql[p * 64 + c * 8 + 2 * e + 1] * bfhi(ww[e]); }
                s[kk] = a; }
            tv[p] = 0.f; ti[p] = 0;
            for (int i = 0; i < 16; ++i) {
                float v = s[0]; int ix = lane; if (s[1] > v) { v = s[1]; ix = lane + 64; }
                argmax_bfly(v, ix);
                if (lane == i) { tv[p] = v; ti[p] = ix; }
                if (ix == lane) s[0] = -INFINITY; if (ix == lane + 64) s[1] = -INFINITY;
            }
        }
        float cd[4];
        { const float va = __shfl(tv[0], lane >> 2);
#pragma unroll
            for (int i = 0; i < 4; ++i) cd[i] = va + __shfl(tv[1], (lane & 3) * 4 + i); }
        float cs = 0.f; int cc = 0;
        for (int it = 0; it < 16; ++it) {
            float v = cd[0]; int ix = lane * 4;
#pragma unroll
            for (int i = 1; i < 4; ++i) if (cd[i] > v) { v = cd[i]; ix = lane * 4 + i; }
            argmax_bfly(v, ix);
            if (lane == it) { cs = v; cc = ix; }
#pragma unroll
            for (int i = 0; i < 4; ++i) if (ix == lane * 4 + i) cd[i] = -INFINITY;
        }
        const int i1 = __shfl(ti[0], cc >> 4), i2 = __shfl(ti[1], cc & 15);
        const float m = __shfl(cs, 0); float ex = lane < 16 ? __expf(cs - m) : 0.f; const float sum = wave_sum(ex);
        if (lane < 16) { EIDX[(size_t)tok * 128 + h * 16 + lane] = i1 * 128 + i2; EW[(size_t)tok * 128 + h * 16 + lane] = ex / sum; }
        lds_wave_sync();
    }
}


__device__ __forceinline__ int ord_i(float f) { const int u = __float_as_int(f); return u >= 0 ? u : (u ^ 0x7FFFFFFF); }
__device__ __forceinline__ float unord_f(int i) { const int u = i >= 0 ? i : (i ^ 0x7FFFFFFF); return __int_as_float(u); }
#define INT_MIN_ (-2147483647 - 1)
struct CandTab { int a[50], b[50]; };
constexpr CandTab make_cand() { CandTab t{}; int n = 0; for (int a = 0; a < 16; ++a) for (int b = 0; b < 16; ++b) if ((a + 1) * (b + 1) <= 16) { t.a[n] = a; t.b[n] = b; ++n; } return t; }
constexpr CandTab CAND = make_cand();
constexpr int RT_LDS_PER_WAVE = 16 * 32 * 4;
__device__ __forceinline__ void p9_route_mfma(const Frame& F) {
    const bf16_t* QP = (const bf16_t*)(F.ws + WS_QP); const bf16_t* KEYS = (const bf16_t*)(F.ws + WS_KEYS);
    int* EIDX = (int*)(F.ws + WS_EIDX); float* EW = (float*)(F.ws + WS_EW);
    const int lane = F.lane, grp = lane >> 4, col = lane & 15;
    LAS int* itab = (LAS int*)(F.lds + F.wave * RT_LDS_PER_WAVE) + col * 32;
    const int gw = blockIdx.x * NWAVES + F.wave, nw = F.G * NWAVES;
    for (int task = gw; task < (T / 16) * 8; task += nw) {
        const int h = task & 7, tile = task >> 3, tok = tile * 16 + col;
        int lst[2][16];
#pragma unroll
        for (int p = 0; p < 2; ++p) {
            bf16x8 qf[2];
#pragma unroll
            for (int ks = 0; ks < 2; ++ks) qf[ks] = *(const bf16x8*)(QP + (size_t)tok * D + h * 128 + p * 64 + ks * 32 + 8 * grp);
            f32x4 sc[8];
#pragma unroll
            for (int kt = 0; kt < 8; ++kt) { sc[kt] = (f32x4){0.f, 0.f, 0.f, 0.f};
#pragma unroll
                for (int ks = 0; ks < 2; ++ks) { const bf16x8 kf = *(const bf16x8*)(KEYS + ((size_t)(h * 2 + p) * 128 + kt * 16 + col) * 64 + ks * 32 + 8 * grp);
                    sc[kt] = __builtin_amdgcn_mfma_f32_16x16x32_bf16(kf, qf[ks], sc[kt], 0, 0, 0); } }
            int r[32];
#pragma unroll
            for (int kt = 0; kt < 8; ++kt)
#pragma unroll
                for (int rg = 0; rg < 4; ++rg) r[kt * 4 + rg] = (ord_i(sc[kt][rg]) & ~0x7F) | (127 - (kt * 16 + 4 * grp + rg));
#pragma unroll
            for (int it = 0; it < 16; ++it) {
                int m = r[0];
#pragma unroll
                for (int i = 1; i < 32; ++i) m = max(m, r[i]);
                m = max(m, __shfl_xor(m, 16)); m = max(m, __shfl_xor(m, 32));
                lst[p][it] = m;
#pragma unroll
                for (int i = 0; i < 32; ++i) r[i] = (r[i] == m) ? INT_MIN_ : r[i];
            }
            if (grp == 0) {
#pragma unroll
                for (int it = 0; it < 16; ++it) itab[p * 16 + it] = 127 - (lst[p][it] & 0x7F);
            }
        }
        float v0[16], v1[16];
#pragma unroll
        for (int i = 0; i < 16; ++i) { v0[i] = unord_f(lst[0][i] & ~0x7F); v1[i] = unord_f(lst[1][i] & ~0x7F); }
        int ck[50];
#pragma unroll
        for (int i = 0; i < 50; ++i) ck[i] = (ord_i(v0[CAND.a[i]] + v1[CAND.b[i]]) & ~0xFF) | (255 - (CAND.a[i] * 16 + CAND.b[i]));
        int top[16];
#pragma unroll
        for (int it = 0; it < 16; ++it) {
            int m = ck[0];
#pragma unroll
            for (int i = 1; i < 50; ++i) m = max(m, ck[i]);
            top[it] = m;
#pragma unroll
            for (int i = 0; i < 50; ++i) ck[i] = (ck[i] == m) ? INT_MIN_ : ck[i];
        }
        lds_wave_sync();
        const float smax = unord_f(top[0] & ~0xFF);
        float ex[16], sum = 0.f;
#pragma unroll
        for (int it = 0; it < 16; ++it) { ex[it] = __expf(unord_f(top[it] & ~0xFF) - smax); sum += ex[it]; }
        const float inv = 1.0f / sum;
        if (grp == 0) {
#pragma unroll
            for (int it = 0; it < 16; ++it) { const int flat = 255 - (top[it] & 0xFF); const int i1 = itab[flat >> 4], i2 = itab[16 + (flat & 15)];
                EIDX[(size_t)tok * 128 + h * 16 + it] = i1 * 128 + i2; EW[(size_t)tok * 128 + h * 16 + it] = ex[it] * inv; }
        }
        lds_wave_sync();
    }
}

constexpr int N_PHASES = 14;
struct Args { const float* in[23]; float* out; unsigned char* ws; int ph_lo, ph_hi; };
__global__ void __launch_bounds__(NTHREADS, 2) fwd(Args args) {
    extern __shared__ __attribute__((aligned(16))) unsigned char lds_raw[];
    Frame F;
#pragma unroll
    for (int i = 0; i < 23; ++i) F.in[i] = args.in[i];
    F.out = args.out; F.ws = args.ws; F.lds = (LAS unsigned char*)lds_raw;
    F.tid = threadIdx.x; F.lane = F.tid & 63; F.wave = __builtin_amdgcn_readfirstlane(F.tid >> 6); F.G = gridDim.x;
    volatile LAS unsigned* misc = (volatile LAS unsigned*)(F.lds + LDS_MISC_OFF);
    if (F.tid < 64) misc[F.tid] = 0u;
    __syncthreads();
    XcdBarrier bar; bar.bar = (unsigned*)(F.ws + WS_CTL); bar.x = 0; bar.st = misc;
    const int lo = args.ph_lo, hi = args.ph_hi;
    if (hi - lo > 1) bar = xcd_barrier_post((unsigned*)(F.ws + WS_CTL), misc);
#ifndef PH_MASK
#define PH_MASK 0xFFFF
#endif
#define IN(k) (((PH_MASK >> (k)) & 1) && lo <= (k) && (k) < hi)
#define SEAM(k) do { if (IN(k) && IN((k) + 1)) xcd_barrier(bar); } while (0)
    const float* MOD = (const float*)(F.ws + WS_MOD);
    if (IN(0)) { p0_prologue(F); } SEAM(0);
    if (IN(1)) { norm_mod_rows(F, F.in[0], F.in[2], 0, 1024, (bf16_t*)(F.ws + WS_H)); } SEAM(1);
    if (IN(2)) { pg8::Gemm g{(const pg8::bf16_t*)(F.ws + WS_H), (const pg8::bf16_t*)(F.ws + WS_WIN), T, NPAD, D}; pg8::StaticOrder So; So.init(T, NPAD, F.G, (int)blockIdx.x);
        pg8::EpiBf16<0> E{(pg8::bf16_t*)(F.ws + WS_PROJ), NPAD, nullptr, 0, 0};
        pg8::gemm_phase<pg8::EpiBf16<0>, pg8::StaticOrder>(F.lds, g, So, E, nullptr); } SEAM(2);
    if (IN(3)) { p3_compress_naive(F); } SEAM(3);
    #ifdef ATTN_NAIVE
    if (IN(4)) { p4_attn_naive(F); } SEAM(4);
#else
    if (IN(4)) { p4_attn_mfma(F); } SEAM(4);
#endif
    if (IN(5)) { p5_mixed(F); } SEAM(5);
    if (IN(6)) { pg8::Gemm g{(const pg8::bf16_t*)(F.ws + WS_H), (const pg8::bf16_t*)(F.ws + WS_WOUT), T, D, D}; pg8::StaticOrder So; So.init(T, D, F.G, (int)blockIdx.x);
        EpiResGate E{F.out, F.in[0], MOD, 2048};
        pg8::gemm_phase<EpiResGate, pg8::StaticOrder>(F.lds, g, So, E, nullptr); } SEAM(6);
    if (IN(7)) { norm_mod_rows_q(F, F.out, F.in[3], 3072, 4096, (bf16_t*)(F.ws + WS_H)); } SEAM(7);
    if (IN(8)) { pg8::Gemm g{(const pg8::bf16_t*)(F.ws + WS_H), (const pg8::bf16_t*)(F.ws + WS_WQ), T, D, D}; pg8::StaticOrder So; So.init(T, D, F.G, (int)blockIdx.x);
        pg8::EpiBf16<0> E{(pg8::bf16_t*)(F.ws + WS_QP), D, nullptr, 0, 0};
        pg8::gemm_phase<pg8::EpiBf16<0>, pg8::StaticOrder>(F.lds, g, So, E, nullptr); } SEAM(8);
    #ifdef ROUTE_NAIVE
    if (IN(9)) { p9_route_naive(F); } SEAM(9);
#else
    if (IN(9)) { p9_route_mfma(F); } SEAM(9);
#endif
    if (IN(10)) { p10a_udots(F); } SEAM(10);
    if (IN(11)) { p10b_coef(F); } SEAM(11);
    if (IN(12)) { p10c_vsum(F); } SEAM(12);
    if (IN(13)) { p10d_final(F); }
#undef IN
#undef SEAM
}

extern "C" void kernel_launch(void* const* d_in, const int* in_sizes, int n_in, void* d_out, int out_size, void* d_ws, size_t ws_size, hipStream_t stream) {
    static int grid = 0;
    if (grid == 0) {
        if (n_in != 23 || out_size != T * D || ws_size < WS_END) { fprintf(stderr, "kernel_launch: unexpected shapes: n_in %d out %d ws %zu (need %zu)\n", n_in, out_size, ws_size, (size_t)WS_END); grid = -1; return; }
        int dev = 0, cus = 0, per_cu = 0;
        if (hipGetDevice(&dev) != hipSuccess || hipDeviceGetAttribute(&cus, hipDeviceAttributeMultiprocessorCount, dev) != hipSuccess) { grid = -1; return; }
        if (hipFuncSetAttribute((const void*)fwd, hipFuncAttributeMaxDynamicSharedMemorySize, LDS_BYTES) != hipSuccess) { fprintf(stderr, "kernel_launch: hipFuncSetAttribute failed\n"); grid = -1; return; }
        if (hipOccupancyMaxActiveBlocksPerMultiprocessor(&per_cu, (const void*)fwd, NTHREADS, LDS_BYTES) != hipSuccess || per_cu < 1) { fprintf(stderr, "kernel_launch: occupancy query says %d\n", per_cu); (void)hipGetLastError(); per_cu = 1; }
        grid = cus;
    }
    if (grid < 0) return;
    (void)hipMemsetAsync((char*)d_ws + WS_CTL, 0, CTL_BYTES, stream);
    Args a{};
    for (int i = 0; i < 23; ++i) a.in[i] = (const float*)d_in[i];
    a.out = (float*)d_out; a.ws = (unsigned char*)d_ws;
#if MK_N_LAUNCHES == 1
    a.ph_lo = 0; a.ph_hi = N_PHASES;
    hipLaunchKernelGGL(fwd, dim3(grid), dim3(NTHREADS), LDS_BYTES, stream, a);
#else
#ifdef PROBE_LIST
    { const int plist[] = PROBE_LIST; for (int p : plist) { a.ph_lo = p; a.ph_hi = p + 1; hipLaunchKernelGGL(fwd, dim3(grid), dim3(NTHREADS), LDS_BYTES, stream, a); } }
#else
    for (int p = 0; p < N_PHASES; ++p) { a.ph_lo = p; a.ph_hi = p + 1; hipLaunchKernelGGL(fwd, dim3(grid), dim3(NTHREADS), LDS_BYTES, stream, a); }
#endif
#endif
}
```

```cpp
#include <hip/hip_runtime.h>
#include <cstdio>
#include <cstdint>
#include <cstdlib>

#ifndef MK_N_LAUNCHES
#define MK_N_LAUNCHES 1
#endif
#define XB_TMO      128
#define XB_XCNT(j)  (256  + 64 * (j))
#define XB_XSUB(j)  (1280 + 64 * (j))
#define XB_XGEN(j)  (2304 + 64 * (j))
#define XB_TOP      3328
#define XB_TOPGEN   3392
#define XCD_BAR_WORDS 3456
#define XB_SPIN_CAP (1u << 18)
#define LAS __attribute__((address_space(3)))

__device__ __forceinline__ unsigned xb_ld(unsigned* p)              { return __hip_atomic_load(p, __ATOMIC_RELAXED, __HIP_MEMORY_SCOPE_AGENT); }
__device__ __forceinline__ unsigned xb_add(unsigned* p, unsigned v) { return __hip_atomic_fetch_add(p, v, __ATOMIC_RELAXED, __HIP_MEMORY_SCOPE_AGENT); }
__device__ __forceinline__ unsigned xb_xcc_id() { return (unsigned)__builtin_amdgcn_s_getreg((3 << 11) | 20) & 0xFu; }
#define XB_SPIN(cond, bar) do { unsigned _sp = 0; while (cond) { __builtin_amdgcn_s_sleep(1); \
    if ((++_sp & 255u) == 0u) { if (xb_ld(&(bar)[XB_TMO])) break; if (_sp > XB_SPIN_CAP) { atomicAdd(&(bar)[XB_TMO], 1u); break; } } } } while (0)

struct XcdBarrier {
    unsigned* bar; unsigned x;
    volatile LAS unsigned* st;
};

__device__ __forceinline__ XcdBarrier xcd_barrier_post(unsigned* bar, volatile LAS unsigned* st) {
    XcdBarrier b; b.bar = bar; b.x = xb_xcc_id(); b.st = st;
    if (threadIdx.x == 0) (void)xb_add(&bar[XB_XCNT(b.x)], 1u);
    return b;
}
__device__ __forceinline__ void xcd_barrier_complete(unsigned* bar, unsigned x, unsigned& nloc, unsigned& nx) {
    const unsigned G = gridDim.x * gridDim.y * gridDim.z;
    unsigned sum, cnt, mine, sp = 0u;
    for (;;) {
        sum = 0u; cnt = 0u; mine = 0u;
#pragma unroll
        for (unsigned j = 0; j < 16; ++j) { const unsigned c = xb_ld(&bar[XB_XCNT(j)]); sum += c; cnt += (c > 0u) ? 1u : 0u; mine = (j == x) ? c : mine; }
        if (sum == G) break;
        __builtin_amdgcn_s_sleep(1);
        if ((++sp & 255u) == 0u) { if (xb_ld(&bar[XB_TMO])) break; if (sp > XB_SPIN_CAP) { atomicAdd(&bar[XB_TMO], 1u); break; } }
    }
    nloc = mine > 0u ? mine : 1u; nx = cnt > 0u ? cnt : 1u;
}

__device__ __forceinline__ void xcd_barrier(const XcdBarrier& b) {
    asm volatile("s_waitcnt vmcnt(0)" ::: "memory");
    __syncthreads();
    if (threadIdx.x == 0) {
        unsigned* bar = b.bar;
        __builtin_amdgcn_s_waitcnt(0);
        unsigned nloc = b.st[0], nx = b.st[1];
        if (nloc == 0u) { xcd_barrier_complete(bar, b.x, nloc, nx); b.st[0] = nloc; b.st[1] = nx; }
        const unsigned old = xb_add(&bar[XB_XSUB(b.x)], 1u);
        const unsigned gen = old / nloc;
        if (old + 1u == (gen + 1u) * nloc) {
            __builtin_amdgcn_fence(__ATOMIC_RELEASE, "agent");
            asm volatile("s_waitcnt vmcnt(0)" ::: "memory");
            const unsigned og = xb_add(&bar[XB_TOP], 1u);
            const unsigned tg = og / nx;
            if (og + 1u == (tg + 1u) * nx) xb_add(&bar[XB_TOPGEN], 1u);
            else XB_SPIN(xb_ld(&bar[XB_TOPGEN]) == tg, bar);
            __builtin_amdgcn_fence(__ATOMIC_ACQUIRE, "agent");
            xb_add(&bar[XB_XGEN(b.x)], 1u);
            asm volatile("s_waitcnt vmcnt(0)" ::: "memory");
        } else {
            XB_SPIN(xb_ld(&bar[XB_XGEN(b.x)]) == gen, bar);
            __builtin_amdgcn_fence(__ATOMIC_ACQUIRE, "agent");
            asm volatile("s_waitcnt vmcnt(0)" ::: "memory");
        }
    }
    __syncthreads();
}

namespace pg8 {
#define PG8_LAS __attribute__((address_space(3)))
typedef unsigned short bf16_t;
typedef short bf16x8 __attribute__((ext_vector_type(8)));
typedef float f32x4 __attribute__((ext_vector_type(4)));
typedef unsigned u32x4 __attribute__((ext_vector_type(4)));
constexpr int BM = 256, BK = 64, HALF = 128, HTB = HALF * BK * 2  , STAGE_BYTES = 8 * HTB, NXCD = 8, WGM = 8;

__host__ __device__ __forceinline__ int lds_byte(int r, int c) { const int st = (r >> 4) * 2 + (c >> 5), rr = r & 15, cc = c & 31, ob = rr * 64 + cc * 2; return st * 1024 + (ob ^ (((ob >> 9) & 1) << 5)); }
__host__ __device__ __forceinline__ void stage_rc(int b, int& R, int& C) { const int st = b / 1024, sb = b % 1024, swz = sb ^ (((sb >> 9) & 1) << 5); R = (st >> 1) * 16 + swz / 64; C = (st & 1) * 32 + (swz % 64) / 2; }
__host__ __device__ __forceinline__ int perm32(int rho) { const int n = rho >> 4, i = rho & 15; return 8 * (i >> 2) + 4 * n + (i & 3); }

struct Unit { int pm, pn; };
struct Gemm { const bf16_t* A; const bf16_t* Bt; int M, N, K; };

struct StaticOrder {
    int nM, nN, nwg, G, c;
    __host__ __device__ void init(int M, int N, int G_, int c_) { nM = M / BM; nN = N / BM; nwg = nM * nN; G = G_; c = c_; }
    __host__ __device__ bool next(int i, Unit& u) const {
        const long L = (long)i * G + c; if (L >= nwg) return false;
        int wgid = (int)L; { const int q = nwg / NXCD, r = nwg % NXCD, xcd = wgid % NXCD, off = wgid / NXCD; wgid = (xcd < r ? xcd * (q + 1) : r * (q + 1) + (xcd - r) * q) + off; }
        const int nig = WGM * nN, gid = wgid / nig, fm = gid * WGM, gsz = (nM - fm) < WGM ? (nM - fm) : WGM;
        u.pm = fm + ((wgid % nig) % gsz); u.pn = (wgid % nig) / gsz; return true;
    }
    __device__ __forceinline__ void a_ready(const Unit&) const {}
    __device__ __forceinline__ void done(const Unit&) const {}
};
struct CountedOrder : StaticOrder {
    const unsigned* ready; unsigned need; unsigned* tmo;
    __device__ __forceinline__ void a_ready(const Unit& u) const {
        if (threadIdx.x < 64) {
            const unsigned long long t0 = __builtin_amdgcn_s_memrealtime(); unsigned polls = 0;
            while ((unsigned)__builtin_amdgcn_readfirstlane(__hip_atomic_load(ready + 64 * u.pm, __ATOMIC_RELAXED, __HIP_MEMORY_SCOPE_AGENT)) < need) {
                if ((++polls & 255u) == 0u && __builtin_amdgcn_readfirstlane(__hip_atomic_load(tmo, __ATOMIC_RELAXED, __HIP_MEMORY_SCOPE_AGENT)) != 0u) break;
                if (__builtin_amdgcn_s_memrealtime() - t0 > 2000000ull) {
                    if (threadIdx.x == 0) { unsigned expect = 0u; __hip_atomic_compare_exchange_strong(tmo + 1, &expect, 0x600u | (unsigned)(u.pm & 0xff), __ATOMIC_RELAXED, __ATOMIC_RELAXED, __HIP_MEMORY_SCOPE_AGENT); __hip_atomic_store(tmo, 1u, __ATOMIC_RELAXED, __HIP_MEMORY_SCOPE_AGENT); }
                    break; }
                __builtin_amdgcn_s_sleep(2); }
            __builtin_amdgcn_fence(__ATOMIC_ACQUIRE, "agent");
            asm volatile("s_waitcnt vmcnt(0)" ::: "memory");
        }
#if !defined(BROKEN_HOOK_NO_BARRIER)
        asm volatile("" ::: "memory"); __builtin_amdgcn_s_barrier(); asm volatile("" ::: "memory");
#endif
    }
};

__device__ __forceinline__ unsigned cvt_pk_bf16(float lo, float hi) { unsigned r; asm volatile("v_cvt_pk_bf16_f32 %0, %1, %2" : "=v"(r) : "v"(lo), "v"(hi)); return r; }
typedef float f32x2 __attribute__((ext_vector_type(2)));
__device__ __forceinline__ f32x2 gelu_pk(f32x2 v) {
    const f32x2 av = __builtin_elementwise_abs(v), d = av * 0.2316418882f + 1.0f;
    f32x2 t; t.x = __builtin_amdgcn_rcpf(d.x); t.y = __builtin_amdgcn_rcpf(d.y);
    f32x2 q = t * 0.5307027145f + (-0.7265760135f); q = q * t + 0.7107068705f; q = q * t + (-0.142248368f); q = q * t + 0.127414796f; q = q * t;
    const f32x2 s = (v * v) * (-0.72134752044f);
    f32x2 e; e.x = __builtin_amdgcn_exp2f(s.x); e.y = __builtin_amdgcn_exp2f(s.y);
    const f32x2 m = v * (q * e), r = v - m;
    f32x2 o; o.x = v.x < 0.f ? m.x : r.x; o.y = v.y < 0.f ? m.y : r.y; return o;
}

struct EpiF32 {
    static constexpr bool PERM = false, AFTER_DRAIN = false;
    float* C; int ldc; const float* bias;
    __device__ __forceinline__ void operator()(const f32x4 (&acc)[2][2][4][2], const Unit& u, int wr, int wc, int fr, int fq) const {
        const int row0 = u.pm * BM + wr * 64 + fr, col0 = u.pn * BM + wc * 32 + 4 * fq;
        f32x4 bv[2][2];
#pragma unroll
        for (int bj = 0; bj < 2; ++bj)
#pragma unroll
            for (int n = 0; n < 2; ++n) bv[bj][n] = bias ? *(const f32x4*)(bias + col0 + bj * HALF + n * 16) : (f32x4){0.f, 0.f, 0.f, 0.f};
#pragma unroll
        for (int ai = 0; ai < 2; ++ai)
#pragma unroll
            for (int m = 0; m < 4; ++m) { float* rowp = C + (size_t)(row0 + ai * HALF + m * 16) * ldc + col0;
#pragma unroll
                for (int bj = 0; bj < 2; ++bj)
#pragma unroll
                    for (int n = 0; n < 2; ++n) *(f32x4*)(rowp + bj * HALF + n * 16) = acc[ai][bj][m][n] + bv[bj][n]; }
    }
};
template <int ACT  > struct EpiBf16 {
    static constexpr bool PERM = true, AFTER_DRAIN = false;
    bf16_t* O; int ldc; const float* bias; int split_cols; size_t split_stride;
    __device__ __forceinline__ void operator()(const f32x4 (&acc)[2][2][4][2], const Unit& u, int wr, int wc, int fr, int fq) const {
        const int row0 = u.pm * BM + wr * 64 + fr; int colt = u.pn * BM; bf16_t* base = O;
        if (split_cols) { const int t = colt / split_cols; base += (size_t)t * split_stride; colt -= t * split_cols; }
        const int col0 = colt + wc * 32 + 8 * fq, bcol0 = u.pn * BM + wc * 32 + 8 * fq;
        f32x4 bv[2][2];
#pragma unroll
        for (int bj = 0; bj < 2; ++bj)
#pragma unroll
            for (int n = 0; n < 2; ++n) bv[bj][n] = bias ? *(const f32x4*)(bias + bcol0 + bj * HALF + 4 * n) : (f32x4){0.f, 0.f, 0.f, 0.f};
#pragma unroll
        for (int ai = 0; ai < 2; ++ai)
#pragma unroll
            for (int m = 0; m < 4; ++m) { bf16_t* rowp = base + (size_t)(row0 + ai * HALF + m * 16) * ldc + col0;
#pragma unroll
                for (int bj = 0; bj < 2; ++bj) { f32x4 v0 = acc[ai][bj][m][0] + bv[bj][0], v1 = acc[ai][bj][m][1] + bv[bj][1];
                    if (ACT == 1) { f32x2 a = gelu_pk((f32x2){v0[0], v0[1]}), b = gelu_pk((f32x2){v0[2], v0[3]}), c = gelu_pk((f32x2){v1[0], v1[1]}), d = gelu_pk((f32x2){v1[2], v1[3]});
                        v0 = (f32x4){a.x, a.y, b.x, b.y}; v1 = (f32x4){c.x, c.y, d.x, d.y}; }
                    if (ACT == 2) {
#pragma unroll
                        for (int j = 0; j < 4; ++j) { v0[j] = 0.5f * v0[j] * (1.0f + erff(v0[j] * 0.70710678f)); v1[j] = 0.5f * v1[j] * (1.0f + erff(v1[j] * 0.70710678f)); } }
                    u32x4 w; w.x = cvt_pk_bf16(v0[0], v0[1]); w.y = cvt_pk_bf16(v0[2], v0[3]); w.z = cvt_pk_bf16(v1[0], v1[1]); w.w = cvt_pk_bf16(v1[2], v1[3]);
                    *(u32x4*)(rowp + bj * HALF) = w; } }
    }
};

struct PanelStats {
    unsigned* xbuf;
    unsigned* cnt;
    unsigned* tmo;
    int ntn; float eps;
    unsigned code;
    __device__ __forceinline__ bool run(const f32x4 (&v)[2][2][4][2], const Unit& u, int wr, int wc, int fr, int fq, PG8_LAS unsigned char* lds, int wid, int lane) const {
        typedef float f32x2v __attribute__((ext_vector_type(2)));
        PG8_LAS f32x2v* P = (PG8_LAS f32x2v*)lds;
        PG8_LAS f32x2v* S = (PG8_LAS f32x2v*)(lds + 8192);
        PG8_LAS unsigned* flag = (PG8_LAS unsigned*)(lds + 8192 + 2048);
#pragma unroll
        for (int ai = 0; ai < 2; ++ai)
#pragma unroll
            for (int m = 0; m < 4; ++m) {
                float s = 0.f;
#pragma unroll
                for (int bj = 0; bj < 2; ++bj)
#pragma unroll
                    for (int n = 0; n < 2; ++n) { const f32x4 x = v[ai][bj][m][n]; s += (x[0] + x[1]) + (x[2] + x[3]); }
                s += __shfl_xor(s, 16); s += __shfl_xor(s, 32);
                const float mw = s * (1.0f / 64.0f); float q = 0.f;
#pragma unroll
                for (int bj = 0; bj < 2; ++bj)
#pragma unroll
                    for (int n = 0; n < 2; ++n) { const f32x4 d = v[ai][bj][m][n] - mw; q += (d[0] * d[0] + d[1] * d[1]) + (d[2] * d[2] + d[3] * d[3]); }
                q += __shfl_xor(q, 16); q += __shfl_xor(q, 32);
                if (fq == 0) P[(ai * HALF + wr * 64 + m * 16 + fr) * 4 + wc] = (f32x2v){mw, q};
            }
        asm volatile("s_waitcnt lgkmcnt(0)" ::: "memory"); __builtin_amdgcn_s_barrier(); asm volatile("" ::: "memory");
#if defined(BROKEN_NO_WAIT)
        if (blockIdx.x >= 64) { const long long t0 = clock64(); while (clock64() - t0 < 60000) __builtin_amdgcn_s_sleep(8); }
#endif
        const int row = wid * 32 + (lane & 31);
        if (lane < 32) {
            const f32x2v a = P[row * 4 + 0], b = P[row * 4 + 1], c = P[row * 4 + 2], d = P[row * 4 + 3];
            const float mt = (a.x + b.x + c.x + d.x) * 0.25f;
            const float da = a.x - mt, db = b.x - mt, dc = c.x - mt, dd = d.x - mt;
            const float m2 = (a.y + b.y) + (c.y + d.y) + 64.0f * ((da * da + db * db) + (dc * dc + dd * dd));
            unsigned long long* slot = (unsigned long long*)xbuf + ((size_t)(u.pm * BM + row) * 4 + u.pn);
            __hip_atomic_store(slot, ((unsigned long long)__float_as_uint(m2) << 32) | __float_as_uint(mt), __ATOMIC_RELAXED, __HIP_MEMORY_SCOPE_AGENT);
        }
        asm volatile("s_waitcnt vmcnt(0)" ::: "memory");
        if (lane == 0) __hip_atomic_fetch_add(cnt + 64 * u.pm, 1u, __ATOMIC_RELAXED, __HIP_MEMORY_SCOPE_AGENT);
        if (wid == 0) {
            bool dead = false; const unsigned long long t0 = __builtin_amdgcn_s_memrealtime(); const unsigned want = 8u * (unsigned)ntn;
            for (;;) {
#if defined(BROKEN_NO_WAIT)
                break;
#endif
                if ((unsigned)__builtin_amdgcn_readfirstlane(__hip_atomic_load(cnt + 64 * u.pm, __ATOMIC_RELAXED, __HIP_MEMORY_SCOPE_AGENT)) >= want) break;
                if (__builtin_amdgcn_s_memrealtime() - t0 > 2000000ull) {
                    if (lane == 0) { unsigned expect = 0u; __hip_atomic_compare_exchange_strong(tmo + 1, &expect, code | (unsigned)(u.pm & 0xff), __ATOMIC_RELAXED, __ATOMIC_RELAXED, __HIP_MEMORY_SCOPE_AGENT);
                                     __hip_atomic_store(tmo, 1u, __ATOMIC_RELAXED, __HIP_MEMORY_SCOPE_AGENT); }
                    dead = true; break; }
                __builtin_amdgcn_s_sleep(2);
            }
            __builtin_amdgcn_fence(__ATOMIC_ACQUIRE, "agent");
            if (lane == 0) flag[0] = dead ? 1u : 0u;
        }
        asm volatile("s_waitcnt vmcnt(0) lgkmcnt(0)" ::: "memory"); __builtin_amdgcn_s_barrier(); asm volatile("" ::: "memory");
        const bool bad = flag[0] != 0u;
        if (lane < 32) {
            const unsigned long long* slot = (const unsigned long long*)xbuf + (size_t)(u.pm * BM + row) * 4; float mt[4], m2[4]; float ms = 0.f;
#pragma unroll
            for (int t = 0; t < 4; ++t) { if (t < ntn) { const unsigned long long w = __hip_atomic_load(slot + t, __ATOMIC_RELAXED, __HIP_MEMORY_SCOPE_AGENT); mt[t] = __uint_as_float((unsigned)w); m2[t] = __uint_as_float((unsigned)(w >> 32)); } else { mt[t] = 0.f; m2[t] = 0.f; } ms += mt[t]; }
            const float mean = ms / (float)ntn; float q = 0.f;
#pragma unroll
            for (int t = 0; t < 4; ++t) if (t < ntn) { const float dm = mt[t] - mean; q += m2[t] + 256.0f * dm * dm; }
            S[row] = (f32x2v){mean, 1.0f / sqrtf(q / (256.0f * (float)ntn) + eps)};
        }
        asm volatile("s_waitcnt lgkmcnt(0)" ::: "memory"); __builtin_amdgcn_s_barrier(); asm volatile("" ::: "memory");
        return bad;
    }
};
struct EpiLnRes {
    static constexpr bool PERM = false, AFTER_DRAIN = true;
    const float* base; float* out; int ldc; const float* bias; PanelStats st; unsigned poison;
    __device__ __forceinline__ void refuse(size_t i0, size_t stride, int M, int N) const { const float q = __builtin_nanf(""); for (size_t i = i0; i < (size_t)M * N; i += stride) out[(i / N) * ldc + i % N] = q;
        if (i0 == 0) { unsigned expect = 0u; __hip_atomic_compare_exchange_strong(st.tmo + 1, &expect, 0x7f0u, __ATOMIC_RELAXED, __ATOMIC_RELAXED, __HIP_MEMORY_SCOPE_AGENT); __hip_atomic_store(st.tmo, 1u, __ATOMIC_RELAXED, __HIP_MEMORY_SCOPE_AGENT); } }
    __device__ __forceinline__ void fused(f32x4 (&acc)[2][2][4][2], const Unit& u, int wr, int wc, int fr, int fq, PG8_LAS unsigned char* lds, int wid, int lane) const {
        typedef float f32x2v __attribute__((ext_vector_type(2)));
        const PG8_LAS f32x2v* S = (const PG8_LAS f32x2v*)(lds + 8192);
        const int col0 = u.pn * BM + wc * 32 + 4 * fq;
#pragma unroll
        for (int bj = 0; bj < 2; ++bj)
#pragma unroll
            for (int n = 0; n < 2; ++n) { const f32x4 bv = bias ? *(const f32x4*)(bias + col0 + bj * HALF + n * 16) : (f32x4){0.f, 0.f, 0.f, 0.f};
#pragma unroll
                for (int ai = 0; ai < 2; ++ai)
#pragma unroll
                    for (int m = 0; m < 4; ++m) acc[ai][bj][m][n] += bv; }
        const bool bad = st.run(acc, u, wr, wc, fr, fq, lds, wid, lane) || poison != 0u;
        const float qnan = __builtin_nanf("");
#pragma unroll
        for (int ai = 0; ai < 2; ++ai)
#pragma unroll
            for (int m = 0; m < 4; ++m) { const int r = ai * HALF + wr * 64 + m * 16 + fr; const f32x2v sr = S[r]; const size_t off = (size_t)(u.pm * BM + r) * ldc + col0;
#pragma unroll
                for (int bj = 0; bj < 2; ++bj)
#pragma unroll
                    for (int n = 0; n < 2; ++n) { const f32x4 bs = *(const f32x4*)(base + off + bj * HALF + n * 16); f32x4 o = bs + (acc[ai][bj][m][n] - sr.x) * sr.y;
                        if (bad) o = (f32x4){qnan, qnan, qnan, qnan}; *(f32x4*)(out + off + bj * HALF + n * 16) = o; }
                asm volatile("" ::: "memory"); }
    }
};
struct EpiLnResLn {
    static constexpr bool PERM = false, AFTER_DRAIN = true;
    const float* base; float* out; bf16_t* xn; int ldc; const float* bias; PanelStats st1, st2; unsigned poison;
    __device__ __forceinline__ void refuse(size_t i0, size_t stride, int M, int N) const { const float q = __builtin_nanf(""); for (size_t i = i0; i < (size_t)M * N; i += stride) { const size_t o = (i / N) * ldc + i % N; out[o] = q; xn[o] = (bf16_t)0x7fc0u; }
        if (i0 == 0) { unsigned expect = 0u; __hip_atomic_compare_exchange_strong(st1.tmo + 1, &expect, 0x7f0u, __ATOMIC_RELAXED, __ATOMIC_RELAXED, __HIP_MEMORY_SCOPE_AGENT); __hip_atomic_store(st1.tmo, 1u, __ATOMIC_RELAXED, __HIP_MEMORY_SCOPE_AGENT); } }
    __device__ __forceinline__ void fused(f32x4 (&acc)[2][2][4][2], const Unit& u, int wr, int wc, int fr, int fq, PG8_LAS unsigned char* lds, int wid, int lane) const {
        typedef float f32x2v __attribute__((ext_vector_type(2))); typedef unsigned u32x2v __attribute__((ext_vector_type(2)));
        const PG8_LAS f32x2v* S = (const PG8_LAS f32x2v*)(lds + 8192);
        const int col0 = u.pn * BM + wc * 32 + 4 * fq;
#pragma unroll
        for (int bj = 0; bj < 2; ++bj)
#pragma unroll
            for (int n = 0; n < 2; ++n) { const f32x4 bv = bias ? *(const f32x4*)(bias + col0 + bj * HALF + n * 16) : (f32x4){0.f, 0.f, 0.f, 0.f};
#pragma unroll
                for (int ai = 0; ai < 2; ++ai)
#pragma unroll
                    for (int m = 0; m < 4; ++m) acc[ai][bj][m][n] += bv; }
        bool bad = st1.run(acc, u, wr, wc, fr, fq, lds, wid, lane) || poison != 0u;
        const float qnan = __builtin_nanf("");
#pragma unroll
        for (int ai = 0; ai < 2; ++ai)
#pragma unroll
            for (int m = 0; m < 4; ++m) { const int r = ai * HALF + wr * 64 + m * 16 + fr; const f32x2v sr = S[r]; const size_t off = (size_t)(u.pm * BM + r) * ldc + col0;
#pragma unroll
                for (int bj = 0; bj < 2; ++bj)
#pragma unroll
                    for (int n = 0; n < 2; ++n) { const f32x4 bs = *(const f32x4*)(base + off + bj * HALF + n * 16); acc[ai][bj][m][n] = bs + (acc[ai][bj][m][n] - sr.x) * sr.y; }
                asm volatile("" : "+v"(acc[ai][0][m][0]), "+v"(acc[ai][0][m][1]), "+v"(acc[ai][1][m][0]), "+v"(acc[ai][1][m][1]));
                if (m & 1) asm volatile("" ::: "memory"); }
        const bool bad1 = bad;
        bad = st2.run(acc, u, wr, wc, fr, fq, lds, wid, lane) || bad;
#pragma unroll
        for (int ai = 0; ai < 2; ++ai)
#pragma unroll
            for (int m = 0; m < 4; ++m) { const int r = ai * HALF + wr * 64 + m * 16 + fr; const f32x2v sr = S[r]; const size_t off = (size_t)(u.pm * BM + r) * ldc + col0;
#pragma unroll
                for (int bj = 0; bj < 2; ++bj)
#pragma unroll
                    for (int n = 0; n < 2; ++n) { const f32x4 x1 = acc[ai][bj][m][n]; *(f32x4*)(out + off + bj * HALF + n * 16) = bad1 ? (f32x4){qnan, qnan, qnan, qnan} : x1;
                        const f32x4 o = (x1 - sr.x) * sr.y; u32x2v w; w.x = cvt_pk_bf16(o[0], o[1]); w.y = cvt_pk_bf16(o[2], o[3]);
                        if (bad) { w.x = 0x7fc07fc0u; w.y = 0x7fc07fc0u; } *(u32x2v*)(xn + off + bj * HALF + n * 16) = w; }
                asm volatile("" ::: "memory"); }
    }
};

template <class Epi, class Sched, bool STAMP = false>
__device__ __forceinline__ void gemm_phase(PG8_LAS unsigned char* lds, const Gemm g, const Sched& S, const Epi& E, unsigned long long* stamps) {
    const int tid = threadIdx.x, wid = __builtin_amdgcn_readfirstlane(tid >> 6), lane = tid & 63, wr = wid >> 2, wc = wid & 3, fr = lane & 15, fq = lane >> 4;
    const int K = g.K, nt = K / BK;
    int ts_lo = 0, ts_hi = 0, nts = 0; const unsigned long long rt_entry = STAMP ? (unsigned long long)wall_clock64() : 0ull;
#define PG8_STAMP() do { if (STAMP && wid == 0 && nts < 64) { const unsigned long long _c = (unsigned long long)clock64(); \
        ts_lo = (lane == nts) ? (int)(unsigned)_c : ts_lo; ts_hi = (lane == nts) ? (int)(unsigned)(_c >> 32) : ts_hi; ++nts; } } while (0)
    PG8_STAMP();
    unsigned voffA[2], voffB[2];
#pragma unroll
    for (int i = 0; i < 2; ++i) { int R, C; stage_rc(tid * 16 + i * 8192, R, C); const int Rb = Epi::PERM ? ((R & ~31) + perm32(R & 31)) : R;
        voffA[i] = (unsigned)(R * K + C) * 2u; voffB[i] = (unsigned)(Rb * K + C) * 2u; }
    const size_t kstep = (size_t)(BK * 2);
    const size_t hstep = (size_t)HALF * K * 2;
    const size_t tstep = 2 * hstep;
    const unsigned ldsw = (unsigned)wid * 1024u;
    const int aoff = lds_byte(wr * 64 + fr, fq * 8), boff = lds_byte(wc * 32 + fr, fq * 8);
#define PG8_SA(b, h) (((b) * 2 + (h)) * HTB)
#define PG8_SB(b, h) ((4 + (b) * 2 + (h)) * HTB)
#define PG8_STAGE(bufoff, gbase, voff) do { _Pragma("unroll") for (int _i = 0; _i < 2; ++_i) \
        __builtin_amdgcn_global_load_lds((const unsigned*)((const char*)(gbase) + (voff)[_i]), (PG8_LAS unsigned*)(lds + (bufoff) + ldsw + _i * 8192), 16, 0, 0); } while (0)
#define PG8_LDA(dst, b, h) do { _Pragma("unroll") for (int m = 0; m < 4; ++m) _Pragma("unroll") for (int k = 0; k < 2; ++k) dst[m][k] = *(const PG8_LAS bf16x8*)(lds + PG8_SA(b, h) + aoff + m * 2048 + k * 1024); } while (0)
#define PG8_LDB(dst, b, h) do { _Pragma("unroll") for (int n = 0; n < 2; ++n) _Pragma("unroll") for (int k = 0; k < 2; ++k) dst[n][k] = *(const PG8_LAS bf16x8*)(lds + PG8_SB(b, h) + boff + n * 2048 + k * 1024); } while (0)
#define PG8_MMA(ai, bj, At, Bt) do { __builtin_amdgcn_s_setprio(1); _Pragma("unroll") for (int m = 0; m < 4; ++m) _Pragma("unroll") for (int n = 0; n < 2; ++n) _Pragma("unroll") for (int k = 0; k < 2; ++k) \
        acc[ai][bj][m][n] = __builtin_amdgcn_mfma_f32_16x16x32_bf16(Bt[n][k], At[m][k], acc[ai][bj][m][n], 0, 0, 0); __builtin_amdgcn_s_setprio(0); } while (0)
#define PG8_WAIT_V(n) asm volatile("s_waitcnt vmcnt(" #n ")" ::: "memory")
#define PG8_WAIT_L(n) asm volatile("s_waitcnt lgkmcnt(" #n ")" ::: "memory")
#define PG8_BAR __builtin_amdgcn_s_barrier()
#define PG8_SCHED __builtin_amdgcn_sched_barrier(0)
    Unit cur, nxt; int ui = 0;
    if (!S.next(0, cur)) return;
    f32x4 acc[2][2][4][2];
#pragma unroll
    for (int a = 0; a < 2; ++a)
#pragma unroll
        for (int b = 0; b < 2; ++b)
#pragma unroll
            for (int m = 0; m < 4; ++m)
#pragma unroll
                for (int n = 0; n < 2; ++n) acc[a][b][m][n] = (f32x4){0.f, 0.f, 0.f, 0.f};
    bf16x8 At[4][2], B0[2][2], B1[2][2];
    const char* cA = (const char*)g.A + (size_t)cur.pm * tstep; const char* cB = (const char*)g.Bt + (size_t)cur.pn * tstep;
    S.a_ready(cur);
    PG8_STAGE(PG8_SB(0, 0), cB, voffB); PG8_STAGE(PG8_SA(0, 0), cA, voffA); PG8_STAGE(PG8_SB(0, 1), cB + hstep, voffB); PG8_STAGE(PG8_SA(0, 1), cA + hstep, voffA);
    if (wr == 1) PG8_BAR;
    PG8_WAIT_V(4); PG8_BAR;
    PG8_STAGE(PG8_SB(1, 0), cB + kstep, voffB); PG8_STAGE(PG8_SA(1, 0), cA + kstep, voffA); PG8_STAGE(PG8_SB(1, 1), cB + hstep + kstep, voffB);
    PG8_WAIT_V(6); PG8_BAR;
    PG8_STAMP();
    for (;;) {
        const bool has_next = S.next(ui + 1, nxt);
        const char* nA = has_next ? (const char*)g.A + (size_t)nxt.pm * tstep : cA; const char* nB = has_next ? (const char*)g.Bt + (size_t)nxt.pn * tstep : cB;
        for (int t = 0; t < nt; t += 2) {
            const bool last = (t == nt - 2);
            const char* a1 = cA + (size_t)(t + 1) * kstep;
            const char* a2 = last ? nA : cA + (size_t)(t + 2) * kstep; const char* b2 = last ? nB : cB + (size_t)(t + 2) * kstep;
            const char* a3 = a2 + kstep; const char* b3 = b2 + kstep;
            if (last && has_next) S.a_ready(nxt);
            PG8_LDB(B0, 0, 0); PG8_SCHED; PG8_LDA(At, 0, 0); PG8_STAGE(PG8_SA(1, 1), a1 + hstep, voffA);
            PG8_WAIT_L(8); PG8_BAR; PG8_WAIT_L(0); PG8_MMA(0, 0, At, B0); PG8_BAR; PG8_SCHED;
            PG8_LDB(B1, 0, 1); PG8_STAGE(PG8_SB(0, 0), b2, voffB);
            PG8_BAR; PG8_WAIT_L(0); PG8_MMA(0, 1, At, B1); PG8_BAR;
            PG8_LDA(At, 0, 1); PG8_STAGE(PG8_SA(0, 0), a2, voffA);
            PG8_BAR; PG8_WAIT_L(0); PG8_MMA(1, 0, At, B0); PG8_BAR; PG8_SCHED;
            PG8_STAGE(PG8_SB(0, 1), b2 + hstep, voffB);
            PG8_WAIT_V(6); PG8_BAR; PG8_MMA(1, 1, At, B1); PG8_BAR;
            PG8_LDB(B0, 1, 0); PG8_SCHED; PG8_LDA(At, 1, 0); PG8_STAGE(PG8_SA(0, 1), a2 + hstep, voffA);
            PG8_WAIT_L(8); PG8_BAR; PG8_WAIT_L(0); PG8_MMA(0, 0, At, B0); PG8_BAR; PG8_SCHED;
            PG8_LDB(B1, 1, 1); PG8_STAGE(PG8_SB(1, 0), b3, voffB);
            PG8_BAR; PG8_WAIT_L(0); PG8_MMA(0, 1, At, B1); PG8_BAR;
            PG8_LDA(At, 1, 1); PG8_STAGE(PG8_SA(1, 0), a3, voffA);
            PG8_BAR; PG8_WAIT_L(0); PG8_MMA(1, 0, At, B0); PG8_BAR; PG8_SCHED;
            PG8_STAGE(PG8_SB(1, 1), b3 + hstep, voffB);
            PG8_WAIT_V(6); PG8_BAR; PG8_MMA(1, 1, At, B1); PG8_BAR;
        }
        PG8_STAMP();
        if constexpr (!Epi::AFTER_DRAIN) { E(acc, cur, wr, wc, fr, fq); S.done(cur); }
        PG8_STAMP();
        if (!has_next) break;
#pragma unroll
        for (int a = 0; a < 2; ++a)
#pragma unroll
            for (int b = 0; b < 2; ++b)
#pragma unroll
                for (int m = 0; m < 4; ++m)
#pragma unroll
                    for (int n = 0; n < 2; ++n) acc[a][b][m][n] = (f32x4){0.f, 0.f, 0.f, 0.f};
        cur = nxt; cA = nA; cB = nB; ++ui;
    }
    PG8_WAIT_V(0);
    if (wr == 0) PG8_BAR;
    PG8_BAR;
    if constexpr (Epi::AFTER_DRAIN) { E.fused(acc, cur, wr, wc, fr, fq, lds, wid, lane); S.done(cur); }
    PG8_STAMP();
    if (STAMP && wid == 0) { stamps[lane] = lane < nts ? (((unsigned long long)(unsigned)ts_hi << 32) | (unsigned)ts_lo) : 0ull;
        if (lane == 62) stamps[62] = rt_entry; if (lane == 63) stamps[63] = (unsigned long long)wall_clock64(); }
#undef PG8_STAMP
#undef PG8_SA
#undef PG8_SB
#undef PG8_STAGE
#undef PG8_LDA
#undef PG8_LDB
#undef PG8_MMA
#undef PG8_WAIT_V
#undef PG8_WAIT_L
#undef PG8_BAR
#undef PG8_SCHED
}
}

constexpr int D = 1024, NB = 16, S = 2048, T = NB * S;
constexpr int NCOL = 2840, NPAD = 3072;
constexpr int C_Q = 0, C_KC = 512, C_VC = 640, C_KS = 768, C_VS = 896, C_KW = 1024, C_VW = 1152, C_GT = 1280, C_CB = 1304, C_CC = 1816, C_CH = 2328;
constexpr int NCMP = 127;
constexpr int NEXP = 16384;
constexpr float EPS = 1e-6f;
constexpr int NTHREADS = 512, NWAVES = 8;

constexpr size_t al256(size_t x) { return (x + 255) & ~(size_t)255; }
constexpr size_t WS_CTL   = 0;                                   constexpr size_t CTL_BYTES = 65536;
constexpr size_t WS_MOD   = WS_CTL + CTL_BYTES;
constexpr size_t WS_WIN   = al256(WS_MOD + (size_t)16 * 6144 * 4);
constexpr size_t WS_WOUT  = al256(WS_WIN + (size_t)NPAD * D * 2);
constexpr size_t WS_WQ    = al256(WS_WOUT + (size_t)D * D * 2);
constexpr size_t WS_KEYS  = al256(WS_WQ + (size_t)D * D * 2);
constexpr size_t WS_U8S   = al256(WS_KEYS + (size_t)16 * 128 * 64 * 2);
constexpr size_t WS_V8S   = al256(WS_U8S + (size_t)NEXP * D);
constexpr size_t WS_X8S   = al256(WS_V8S + (size_t)NEXP * D);
constexpr size_t WS_SU    = al256(WS_X8S + (size_t)T * D);
constexpr size_t WS_SV    = al256(WS_SU + (size_t)NEXP * 4);
constexpr size_t WS_SX    = al256(WS_SV + (size_t)NEXP * 4);
constexpr size_t WS_W1T   = al256(WS_SX + (size_t)T * 4);
constexpr size_t WS_W2T   = al256(WS_W1T + (size_t)2 * 64 * 2048 * 2);
constexpr size_t WS_PEC   = al256(WS_W2T + (size_t)2 * 64 * 64 * 2);
constexpr size_t WS_KC    = al256(WS_PEC + (size_t)2 * 64 * 4);
constexpr size_t WS_VC    = al256(WS_KC + (size_t)16 * 2 * 128 * 64 * 2);
constexpr size_t WS_H     = al256(WS_VC + (size_t)16 * 2 * 128 * 64 * 2);
constexpr size_t WS_CS    = WS_H;
constexpr size_t WS_CSUM  = WS_H + (size_t)32 * 1024 * 1024;
constexpr size_t WS_SSQP  = WS_H + (size_t)33 * 1024 * 1024;
constexpr size_t WS_OATT  = al256(WS_H + (size_t)T * D * 2);
constexpr size_t WS_PROJ  = al256(WS_OATT + (size_t)T * 512 * 2);
constexpr size_t WS_QP    = WS_PROJ;
constexpr size_t WS_PART  = WS_PROJ;
constexpr size_t WS_EIDX  = WS_PROJ + (size_t)160 * 1024 * 1024;
constexpr size_t WS_EW    = WS_EIDX + (size_t)T * 128 * 4;
constexpr size_t WS_END   = al256(WS_PROJ + (size_t)T * NPAD * 2);
static_assert(WS_EW + (size_t)T * 128 * 4 <= WS_END, "alias region");
static_assert((size_t)8 * T * 128 * 4 <= (size_t)160 * 1024 * 1024, "PART fits under EIDX");
constexpr int CTL_CTR_A = 16384, CTL_CTR_B = 16384 + 8 * 256;

constexpr int LDS_STAGE = 147456;
constexpr int LDS_MISC_OFF = LDS_STAGE;
constexpr int LDS_BYTES = LDS_STAGE + 256;

typedef unsigned short bf16_t;
typedef short bf16x8 __attribute__((ext_vector_type(8)));
typedef short s16x4 __attribute__((ext_vector_type(4)));
typedef float f32x4 __attribute__((ext_vector_type(4)));
typedef unsigned u32x4v __attribute__((ext_vector_type(4)));
__device__ __forceinline__ float bf2f(bf16_t b) { return __uint_as_float(((unsigned)b) << 16); }
__device__ __forceinline__ bf16_t f2bf(float f) { unsigned u = __float_as_uint(f); u += 0x7FFFu + ((u >> 16) & 1u); return (bf16_t)(u >> 16); }
__device__ __forceinline__ float bflo(unsigned w) { return __uint_as_float(w << 16); }
__device__ __forceinline__ float bfhi(unsigned w) { return __uint_as_float(w & 0xFFFF0000u); }
__device__ __forceinline__ unsigned pack2(float lo, float hi) { return (unsigned)f2bf(lo) | ((unsigned)f2bf(hi) << 16); }
__device__ __forceinline__ float gelu_tanh(float x) { const float u = 0.7978845608028654f * (x + 0.044715f * x * x * x); return 0.5f * x * (1.0f + tanhf(u)); }
__device__ __forceinline__ float sigmoidf_(float x) { return 1.0f / (1.0f + __expf(-x)); }
__device__ __forceinline__ float wave_sum(float v) {
#pragma unroll
    for (int o = 32; o >= 1; o >>= 1) v += __shfl_xor(v, o);
    return v; }
__device__ __forceinline__ float wave_max(float v) {
#pragma unroll
    for (int o = 32; o >= 1; o >>= 1) v = fmaxf(v, __shfl_xor(v, o));
    return v; }
__device__ __forceinline__ void lds_wave_sync() { asm volatile("s_waitcnt lgkmcnt(0)" ::: "memory"); }
__device__ __forceinline__ int rel_bucket(int dist) {
    const int n = dist > 0 ? dist : 0;
    if (n < 16) return n;
    const float lr = logf((float)n / 16.0f) / 2.0794415416798357f;
    const int large = 16 + (int)(lr * 16.0f);
    return large < 31 ? large : 31;
}

struct Frame {
    const float* in[23]; float* out; unsigned char* ws;
    LAS unsigned char* lds; int tid, lane, wave, G;
};


typedef int i32x4v __attribute__((ext_vector_type(4)));
constexpr int PEER_CHUNK_TOK = 128, PEER_NCHUNK = T / PEER_CHUNK_TOK;

__device__ __forceinline__ void quant_row_sliced(const float* row, unsigned char* dst8  , size_t nrows, size_t r, float* scale_out, int bias, int lane) {
    float4 v[4]; float am = 0.f;
#pragma unroll
    for (int i = 0; i < 4; ++i) { v[i] = *(const float4*)(row + (lane + 64 * i) * 4); am = fmaxf(am, fmaxf(fmaxf(fabsf(v[i].x), fabsf(v[i].y)), fmaxf(fabsf(v[i].z), fabsf(v[i].w)))); }
    am = wave_max(am); const float inv = am > 0.f ? 127.0f / am : 0.f;
    if (lane == 0) *scale_out = am > 0.f ? am / 127.0f : 0.f;
#pragma unroll
    for (int i = 0; i < 4; ++i) { const int col = (lane + 64 * i) * 4; const int sl = col >> 7, off = col & 127;
        const int q0 = (int)rintf(v[i].x * inv) + bias, q1 = (int)rintf(v[i].y * inv) + bias, q2 = (int)rintf(v[i].z * inv) + bias, q3 = (int)rintf(v[i].w * inv) + bias;
        *(unsigned*)(dst8 + ((size_t)sl * nrows + r) * 128 + off) = (unsigned)(q0 & 0xFF) | ((unsigned)(q1 & 0xFF) << 8) | ((unsigned)(q2 & 0xFF) << 16) | ((unsigned)(q3 & 0xFF) << 24); }
}

__device__ __forceinline__ int grab_chunk(const Frame& F, unsigned* ctr, int slice) {
    LAS int* bc = (LAS int*)(F.lds + LDS_MISC_OFF + 64);
    __syncthreads();
    if (F.tid == 0) *bc = (int)__hip_atomic_fetch_add(ctr + slice * 64, 1u, __ATOMIC_RELAXED, __HIP_MEMORY_SCOPE_AGENT);
    __syncthreads();
    return *bc;
}

__device__ __forceinline__ void p10a_udots(const Frame& F) {
    const unsigned char* U8S = F.ws + WS_U8S; const unsigned char* X8S = F.ws + WS_X8S; const int* EIDX = (const int*)(F.ws + WS_EIDX); int* PART = (int*)(F.ws + WS_PART);
    unsigned* ctr = (unsigned*)(F.ws + WS_CTL + CTL_CTR_A);
    const int lane = F.lane, j = lane >> 3, c = lane & 7; const int xcc = (int)(xb_xcc_id() & 7u);
    for (int so = 0; so < 8; ++so) { const int x = (xcc + so) & 7;
        for (;;) { const int chunk = grab_chunk(F, ctr, x); if (chunk >= PEER_NCHUNK) break;
            const unsigned char* ub = U8S + (size_t)x * NEXP * 128 + c * 16;
#pragma unroll 1
            for (int tt = 0; tt < 16; ++tt) { const int t = chunk * PEER_CHUNK_TOK + F.wave * 16 + tt;
                const i32x4v xq = *(const i32x4v*)(X8S + ((size_t)x * T + t) * 128 + c * 16);
                i32x4v ev[4];
#pragma unroll
                for (int q = 0; q < 4; ++q) ev[q] = *(const i32x4v*)(EIDX + (size_t)t * 128 + 16 * j + 4 * q);
                i32x4v uv[16];
#pragma unroll
                for (int ld = 0; ld < 16; ++ld) uv[ld] = *(const i32x4v*)(ub + (size_t)ev[ld >> 2][ld & 3] * 128);
                i32x4v res[4];
#pragma unroll
                for (int ld = 0; ld < 16; ++ld) { int p = __builtin_amdgcn_sdot4(uv[ld][0], xq[0], 0, false); p = __builtin_amdgcn_sdot4(uv[ld][1], xq[1], p, false);
                    p = __builtin_amdgcn_sdot4(uv[ld][2], xq[2], p, false); p = __builtin_amdgcn_sdot4(uv[ld][3], xq[3], p, false);
                    p += __shfl_xor(p, 1); p += __shfl_xor(p, 2); p += __shfl_xor(p, 4); res[ld >> 2][ld & 3] = p; }
                if (c == 0) {
#pragma unroll
                    for (int q = 0; q < 4; ++q) *(i32x4v*)(PART + ((size_t)x * T + t) * 128 + 16 * j + 4 * q) = res[q]; }
            }
        }
    }
}

__device__ __forceinline__ void p10b_coef(const Frame& F) {
    const int* EIDX = (const int*)(F.ws + WS_EIDX); const float* EW = (const float*)(F.ws + WS_EW); const int* PART = (const int*)(F.ws + WS_PART);
    const float* SU = (const float*)(F.ws + WS_SU); const float* SV = (const float*)(F.ws + WS_SV); const float* SX = (const float*)(F.ws + WS_SX);
    float* CS = (float*)(F.ws + WS_CS); float* CSUM = (float*)(F.ws + WS_CSUM);
    const int gw = blockIdx.x * NWAVES + F.wave, nw = F.G * NWAVES, lane = F.lane;
    for (int t = gw; t < T; t += nw) { const float sx = SX[t]; float tot = 0.f;
#pragma unroll
        for (int hh = 0; hh < 2; ++hh) { const int i = lane + 64 * hh; int s = 0;
#pragma unroll
            for (int x = 0; x < 8; ++x) s += PART[((size_t)x * T + t) * 128 + i];
            const int e = EIDX[(size_t)t * 128 + i]; const float dot = (float)s * sx * SU[e];
            const float cs = EW[(size_t)t * 128 + i] * gelu_tanh(dot) * SV[e]; CS[(size_t)t * 128 + i] = cs; tot += cs; }
        tot = wave_sum(tot); if (lane == 0) CSUM[t] = tot; }
}

__device__ __forceinline__ void p10c_vsum(const Frame& F) {
    const unsigned char* V8S = F.ws + WS_V8S; const int* EIDX = (const int*)(F.ws + WS_EIDX); const float* CS = (const float*)(F.ws + WS_CS); const float* CSUM = (const float*)(F.ws + WS_CSUM);
    const float* MOD = (const float*)(F.ws + WS_MOD); float* SSQP = (float*)(F.ws + WS_SSQP); float* out = F.out;
    unsigned* ctr = (unsigned*)(F.ws + WS_CTL + CTL_CTR_B);
    const int lane = F.lane, j = lane >> 3, c = lane & 7; const int xcc = (int)(xb_xcc_id() & 7u);
    const int ocol = 16 * c + 8 * ((lane >> 5) & 1) + 4 * ((lane >> 4) & 1) + 2 * ((lane >> 3) & 1);
    for (int so = 0; so < 8; ++so) { const int x = (xcc + so) & 7;
        for (;;) { const int chunk = grab_chunk(F, ctr, x); if (chunk >= PEER_NCHUNK) break;
            const unsigned char* vb = V8S + (size_t)x * NEXP * 128 + c * 16;
#pragma unroll 1
            for (int tt = 0; tt < 16; ++tt) { const int t = chunk * PEER_CHUNK_TOK + F.wave * 16 + tt; const int b = t / S;
                i32x4v ev[4]; f32x4 cv[4];
#pragma unroll
                for (int q = 0; q < 4; ++q) { ev[q] = *(const i32x4v*)(EIDX + (size_t)t * 128 + 16 * j + 4 * q); cv[q] = *(const f32x4*)(CS + (size_t)t * 128 + 16 * j + 4 * q); }
                u32x4v vv[16];
#pragma unroll
                for (int ld = 0; ld < 16; ++ld) vv[ld] = *(const u32x4v*)(vb + (size_t)ev[ld >> 2][ld & 3] * 128);
                float acc[16];
#pragma unroll
                for (int k = 0; k < 16; ++k) acc[k] = 0.f;
#pragma unroll
                for (int ld = 0; ld < 16; ++ld) { const float cf = cv[ld >> 2][ld & 3];
#pragma unroll
                    for (int w = 0; w < 4; ++w) { const unsigned u = vv[ld][w];
                        acc[4 * w + 0] += cf * (float)(u & 0xFFu); acc[4 * w + 1] += cf * (float)((u >> 8) & 0xFFu); acc[4 * w + 2] += cf * (float)((u >> 16) & 0xFFu); acc[4 * w + 3] += cf * (float)(u >> 24); } }
                float a8[8], a4[4], a2[2];
                { const bool hi = (lane & 32) != 0;
#pragma unroll
                    for (int k = 0; k < 8; ++k) { const float snd = hi ? acc[k] : acc[k + 8]; const float rcv = __shfl_xor(snd, 32); a8[k] = (hi ? acc[k + 8] : acc[k]) + rcv; } }
                { const bool hi = (lane & 16) != 0;
#pragma unroll
                    for (int k = 0; k < 4; ++k) { const float snd = hi ? a8[k] : a8[k + 4]; const float rcv = __shfl_xor(snd, 16); a4[k] = (hi ? a8[k + 4] : a8[k]) + rcv; } }
                { const bool hi = (lane & 8) != 0;
#pragma unroll
                    for (int k = 0; k < 2; ++k) { const float snd = hi ? a4[k] : a4[k + 2]; const float rcv = __shfl_xor(snd, 8); a2[k] = (hi ? a4[k + 2] : a4[k]) + rcv; } }
                const float off = 128.0f * CSUM[t];
                const int col = x * 128 + ocol; float* xp = out + (size_t)t * D + col;
                const float2 x1 = *(const float2*)xp; const float2 gt = *(const float2*)(MOD + b * 6144 + 5120 + col);
                const float y0 = x1.x + gt.x * (a2[0] - off), y1 = x1.y + gt.y * (a2[1] - off);
                *(float2*)xp = make_float2(y0, y1);
                const float ss = wave_sum(y0 * y0 + y1 * y1); if (lane == 0) SSQP[(size_t)t * 8 + x] = ss;
            }
        }
    }
}

__device__ __forceinline__ void p10d_final(const Frame& F) {
    const float* SSQP = (const float*)(F.ws + WS_SSQP); const float* gfin = F.in[22]; float* out = F.out;
    const int gw = blockIdx.x * NWAVES + F.wave, nw = F.G * NWAVES, lane = F.lane;
    for (int t = gw; t < T; t += nw) {
        float ss = 0.f;
#pragma unroll
        for (int x = 0; x < 8; ++x) ss += SSQP[(size_t)t * 8 + x];
        const float rstd = rsqrtf(ss * (1.0f / D) + EPS);
#pragma unroll
        for (int i = 0; i < 4; ++i) { const int col = (lane + 64 * i) * 4; const float4 v = *(const float4*)(out + (size_t)t * D + col), gg = *(const float4*)(gfin + col);
            *(float4*)(out + (size_t)t * D + col) = make_float4(v.x * rstd * gg.x, v.y * rstd * gg.y, v.z * rstd * gg.z, v.w * rstd * gg.w); }
    }
}

__device__ __forceinline__ void transpose_tile(const Frame& F, const float* src, int srcK, int srcN, bf16_t* dst, int dstK, int kt, int nt) {
    LAS float* tile = (LAS float*)F.lds;
    const int k0 = kt * 64, n0 = nt * 64;
    for (int i = F.tid; i < 4096; i += NTHREADS) { const int r = i >> 6, c = i & 63; const int k = k0 + r, n = n0 + c;
        tile[r * 65 + c] = (k < srcK && n < srcN) ? src[(size_t)k * srcN + n] : 0.0f; }
    __syncthreads();
    for (int i = F.tid; i < 4096; i += NTHREADS) { const int r = i >> 6, c = i & 63;
        dst[(size_t)(n0 + r) * dstK + k0 + c] = f2bf(tile[c * 65 + r]); }
    __syncthreads();
}
__device__ __forceinline__ void p0_prologue(const Frame& F) {
    const float* c = F.in[1]; const float* w_mod = F.in[4]; const float* b_mod = F.in[5];
    float* MOD = (float*)(F.ws + WS_MOD);
    constexpr int I_MOD = 192, I_WIN = 16 * 48, I_WOUT = 256, I_WQ = 256, I_U = 256, I_V = 256, I_KEYS = 2, I_CMP = 32 + 32 + 1 + 1 + 2;
    constexpr int O_WIN = I_MOD, O_WOUT = O_WIN + I_WIN, O_WQ = O_WOUT + I_WOUT, O_U = O_WQ + I_WQ, O_V = O_U + I_U, O_KEYS = O_V + I_V, O_CMP = O_KEYS + I_KEYS, N_ITEMS = O_CMP + I_CMP;
    for (int it = blockIdx.x; it < N_ITEMS; it += F.G) {
        if (it < O_WIN) {
            const int idx = it * NTHREADS + F.tid; const int b = idx / 6144, j = idx % 6144;
            float acc = 0.f;
            for (int k = 0; k < D; ++k) { const float cv = c[b * D + k]; const float sv = cv / (1.0f + __expf(-cv)); acc += sv * w_mod[(size_t)k * 6144 + j]; }
            MOD[b * 6144 + j] = acc + b_mod[j];
        } else if (it < O_WOUT) { const int i = it - O_WIN; transpose_tile(F, F.in[6], D, NCOL, (bf16_t*)(F.ws + WS_WIN), D, i % 16, i / 16); }
        else if (it < O_WQ) { const int i = it - O_WOUT; transpose_tile(F, F.in[16], D, D, (bf16_t*)(F.ws + WS_WOUT), D, i % 16, i / 16); }
        else if (it < O_U) { const int i = it - O_WQ; transpose_tile(F, F.in[17], D, D, (bf16_t*)(F.ws + WS_WQ), D, i % 16, i / 16); }
        else if (it < O_KEYS) {
            const bool isv = it >= O_V; const int i = isv ? it - O_V : it - O_U;
            for (int rr = 0; rr < 8; ++rr) { const size_t r = (size_t)i * 64 + rr * 8 + F.wave;
                quant_row_sliced((isv ? F.in[20] : F.in[19]) + r * D, F.ws + (isv ? WS_V8S : WS_U8S), NEXP, r, (float*)(F.ws + (isv ? WS_SV : WS_SU)) + r, isv ? 128 : 0, F.lane); }
        } else if (it >= O_CMP) {
            const int i = it - O_CMP;
            if (i < 64) { const int kv = i >> 5; transpose_tile(F, kv ? F.in[11] : F.in[9], 2048, 64, (bf16_t*)(F.ws + WS_W1T) + (size_t)kv * 64 * 2048, 2048, i & 31, 0); }
            else if (i < 66) { const int kv = i - 64; transpose_tile(F, kv ? F.in[12] : F.in[10], 64, 64, (bf16_t*)(F.ws + WS_W2T) + (size_t)kv * 64 * 64, 64, 0, 0); }
            else { const int kv = i - 66; const float* pe = kv ? F.in[8] : F.in[7]; const float* w1 = kv ? F.in[11] : F.in[9];
                if (F.tid < 64) { float a = 0.f; for (int k = 0; k < 2048; ++k) a += pe[k] * w1[(size_t)k * 64 + F.tid]; ((float*)(F.ws + WS_PEC))[kv * 64 + F.tid] = a; } }
        } else {
            const int i = it - O_KEYS; const float4* src = (const float4*)F.in[18] + (size_t)i * 16384; uint2* dst = (uint2*)(F.ws + WS_KEYS) + (size_t)i * 16384;
            for (int q = F.tid; q < 16384; q += NTHREADS) { const float4 v = src[q]; dst[q] = make_uint2(pack2(v.x, v.y), pack2(v.z, v.w)); }
        }
    }
}

__device__ __forceinline__ void norm_mod_rows(const Frame& F, const float* x, const float* g, int sh_off, int sc_off, bf16_t* dst) {
    const float* MOD = (const float*)(F.ws + WS_MOD);
    const int gw = blockIdx.x * NWAVES + F.wave, nw = F.G * NWAVES;
    for (int t = gw; t < T; t += nw) {
        const int b = t / S; const float4* xr = (const float4*)(x + (size_t)t * D);
        float4 v[4]; float ss = 0.f;
#pragma unroll
        for (int i = 0; i < 4; ++i) { v[i] = xr[F.lane + 64 * i]; ss += v[i].x * v[i].x + v[i].y * v[i].y + v[i].z * v[i].z + v[i].w * v[i].w; }
        ss = wave_sum(ss); const float rstd = rsqrtf(ss * (1.0f / D) + EPS);
#pragma unroll
        for (int i = 0; i < 4; ++i) { const int col = (F.lane + 64 * i) * 4;
            const float4 gg = *(const float4*)(g + col), sc = *(const float4*)(MOD + b * 6144 + sc_off + col), sh = *(const float4*)(MOD + b * 6144 + sh_off + col);
            const float o0 = v[i].x * rstd * gg.x * (1.f + sc.x) + sh.x, o1 = v[i].y * rstd * gg.y * (1.f + sc.y) + sh.y, o2 = v[i].z * rstd * gg.z * (1.f + sc.z) + sh.z, o3 = v[i].w * rstd * gg.w * (1.f + sc.w) + sh.w;
            *(uint2*)(dst + (size_t)t * D + col) = make_uint2(pack2(o0, o1), pack2(o2, o3)); }
    }
}

__device__ __forceinline__ void norm_mod_rows_q(const Frame& F, const float* x, const float* g, int sh_off, int sc_off, bf16_t* dst) {
    const float* MOD = (const float*)(F.ws + WS_MOD);
    const int gw = blockIdx.x * NWAVES + F.wave, nw = F.G * NWAVES;
    for (int t = gw; t < T; t += nw) {
        const int b = t / S; const float4* xr = (const float4*)(x + (size_t)t * D);
        float4 v[4]; float ss = 0.f;
#pragma unroll
        for (int i = 0; i < 4; ++i) { v[i] = xr[F.lane + 64 * i]; ss += v[i].x * v[i].x + v[i].y * v[i].y + v[i].z * v[i].z + v[i].w * v[i].w; }
        ss = wave_sum(ss); const float rstd = rsqrtf(ss * (1.0f / D) + EPS);
        float am = 0.f;
#pragma unroll
        for (int i = 0; i < 4; ++i) { const int col = (F.lane + 64 * i) * 4;
            const float4 gg = *(const float4*)(g + col), sc = *(const float4*)(MOD + b * 6144 + sc_off + col), sh = *(const float4*)(MOD + b * 6144 + sh_off + col);
            v[i].x = v[i].x * rstd * gg.x * (1.f + sc.x) + sh.x; v[i].y = v[i].y * rstd * gg.y * (1.f + sc.y) + sh.y; v[i].z = v[i].z * rstd * gg.z * (1.f + sc.z) + sh.z; v[i].w = v[i].w * rstd * gg.w * (1.f + sc.w) + sh.w;
            *(uint2*)(dst + (size_t)t * D + col) = make_uint2(pack2(v[i].x, v[i].y), pack2(v[i].z, v[i].w));
            am = fmaxf(am, fmaxf(fmaxf(fabsf(v[i].x), fabsf(v[i].y)), fmaxf(fabsf(v[i].z), fabsf(v[i].w)))); }
        am = wave_max(am); const float inv = am > 0.f ? 127.0f / am : 0.f;
        if (F.lane == 0) ((float*)(F.ws + WS_SX))[t] = am > 0.f ? am / 127.0f : 0.f;
#pragma unroll
        for (int i = 0; i < 4; ++i) { const int col = (F.lane + 64 * i) * 4; const int sl = col >> 7, off = col & 127;
            const int q0 = (int)rintf(v[i].x * inv), q1 = (int)rintf(v[i].y * inv), q2 = (int)rintf(v[i].z * inv), q3 = (int)rintf(v[i].w * inv);
            *(unsigned*)(F.ws + WS_X8S + ((size_t)sl * T + t) * 128 + off) = (unsigned)(q0 & 0xFF) | ((unsigned)(q1 & 0xFF) << 8) | ((unsigned)(q2 & 0xFF) << 16) | ((unsigned)(q3 & 0xFF) << 24); }
    }
}

__device__ __forceinline__ void p3_compress_naive(const Frame& F) {
    const bf16_t* PROJ = (const bf16_t*)(F.ws + WS_PROJ);
    LAS float* hid = (LAS float*)F.lds + F.wave * 64;
    const int gw = blockIdx.x * NWAVES + F.wave, nw = F.G * NWAVES;
    if (gw < 64) { bf16_t* dz = (bf16_t*)(F.ws + ((gw & 1) ? WS_VC : WS_KC)); dz[((size_t)(gw >> 1) * 128 + 127) * 64 + F.lane] = 0; }
    for (int u = gw; u < NB * NCMP * 2 * 2; u += nw) {
        const int kv = u & 1, g = (u >> 1) & 1, n = (u >> 2) % NCMP, b = (u >> 2) / NCMP;
        const float* pe = kv ? F.in[8] : F.in[7]; const float* w1 = kv ? F.in[11] : F.in[9]; const float* w2 = kv ? F.in[12] : F.in[10];
        const int cbase = (kv ? C_VC : C_KC) + g * 64;
        float acc = 0.f;
        for (int l = 0; l < 32; ++l) {
            const bf16_t* row = PROJ + (size_t)(b * S + 16 * n + l) * NPAD + cbase;
            for (int d = 0; d < 64; ++d) { const float a = bf2f(row[d]) + pe[l * 64 + d]; acc += a * w1[(size_t)(l * 64 + d) * 64 + F.lane]; }
        }
        hid[F.lane] = gelu_tanh(acc); lds_wave_sync();
        float o = 0.f;
        for (int j = 0; j < 64; ++j) o += hid[j] * w2[j * 64 + F.lane];
        bf16_t* dst = (bf16_t*)(F.ws + (kv ? WS_VC : WS_KC)); dst[((size_t)(b * 2 + g) * 128 + n) * 64 + F.lane] = f2bf(o);
        lds_wave_sync();
    }
}


__device__ __forceinline__ void p3_compress_mfma(const Frame& F) {
    const bf16_t* PROJ = (const bf16_t*)(F.ws + WS_PROJ);
    const int lane = F.lane, tid = F.tid, wave = F.wave, grp = lane >> 4, col = lane & 15;
    LAS float* red = (LAS float*)F.lds;
    LAS bf16_t* hid = (LAS bf16_t*)(F.lds + 32768);
    if (blockIdx.x * NWAVES + wave < 64) { const int gw = blockIdx.x * NWAVES + wave; bf16_t* dz = (bf16_t*)(F.ws + ((gw & 1) ? WS_VC : WS_KC)); dz[((size_t)(gw >> 1) * 128 + 127) * 64 + lane] = 0; }
    for (int u = blockIdx.x; u < NB * 2 * 2 * 8; u += F.G) {
        const int nt8 = u & 7, kv = (u >> 3) & 1, g = (u >> 4) & 1, b = u >> 5; const int n0 = nt8 * 16;
        const bf16_t* W1T = (const bf16_t*)(F.ws + WS_W1T) + (size_t)kv * 64 * 2048; const bf16_t* W2T = (const bf16_t*)(F.ws + WS_W2T) + (size_t)kv * 64 * 64;
        const float* pec = (const float*)(F.ws + WS_PEC) + kv * 64;
        const int cbase = (kv ? C_VC : C_KC) + g * 64;
        const int nrow = (n0 + col) < NCMP ? (n0 + col) : (NCMP - 1);
        f32x4 acc[4];
#pragma unroll
        for (int nt = 0; nt < 4; ++nt) acc[nt] = (f32x4){0.f, 0.f, 0.f, 0.f};
#pragma unroll
        for (int ks = 0; ks < 8; ++ks) { const int l = 4 * wave + (ks >> 1), d0 = (ks & 1) * 32 + 8 * grp;
            const bf16x8 af = *(const bf16x8*)(PROJ + (size_t)(b * S + 16 * nrow + l) * NPAD + cbase + d0);
#pragma unroll
            for (int nt = 0; nt < 4; ++nt) { const bf16x8 bfr = *(const bf16x8*)(W1T + (size_t)(nt * 16 + col) * 2048 + l * 64 + d0);
                acc[nt] = __builtin_amdgcn_mfma_f32_16x16x32_bf16(af, bfr, acc[nt], 0, 0, 0); } }
#pragma unroll
        for (int nt = 0; nt < 4; ++nt)
#pragma unroll
            for (int rg = 0; rg < 4; ++rg) red[(wave * 16 + 4 * grp + rg) * 64 + nt * 16 + col] = acc[nt][rg];
        __syncthreads();
#pragma unroll
        for (int q = 0; q < 2; ++q) { const int idx = tid + 512 * q; float s = pec[idx & 63];
#pragma unroll
            for (int w = 0; w < 8; ++w) s += red[w * 1024 + idx];
            hid[idx] = f2bf(gelu_tanh(s)); }
        __syncthreads();
        if (wave < 4) { f32x4 o = (f32x4){0.f, 0.f, 0.f, 0.f};
#pragma unroll
            for (int ks = 0; ks < 2; ++ks) { const bf16x8 af = *(const LAS bf16x8*)(hid + col * 64 + ks * 32 + 8 * grp); const bf16x8 bfr = *(const bf16x8*)(W2T + (size_t)(wave * 16 + col) * 64 + ks * 32 + 8 * grp);
                o = __builtin_amdgcn_mfma_f32_16x16x32_bf16(af, bfr, o, 0, 0, 0); }
            bf16_t* dst = (bf16_t*)(F.ws + (kv ? WS_VC : WS_KC));
#pragma unroll
            for (int rg = 0; rg < 4; ++rg) { const int n = n0 + 4 * grp + rg; if (n < NCMP) dst[((size_t)(b * 2 + g) * 128 + n) * 64 + wave * 16 + col] = f2bf(o[rg]); } }
        __syncthreads();
    }
}

__device__ __forceinline__ void dot4_row(const bf16_t* krow, const LAS float* qs, float (&acc)[4]) {
    const uint4* kr = (const uint4*)krow;
#pragma unroll 1
    for (int c = 0; c < 8; ++c) { asm volatile("" ::: "memory"); const uint4 w = kr[c]; const unsigned ww[4] = {w.x, w.y, w.z, w.w};
#pragma unroll
        for (int e = 0; e < 4; ++e) { const float k0 = bflo(ww[e]), k1 = bfhi(ww[e]); const int d = c * 8 + e * 2;
#pragma unroll
            for (int r = 0; r < 4; ++r) acc[r] += qs[r * 64 + d] * k0 + qs[r * 64 + d + 1] * k1; } }
}
__device__ __forceinline__ void p4_attn_naive(const Frame& F) {
    const bf16_t* PROJ = (const bf16_t*)(F.ws + WS_PROJ); const bf16_t* KC = (const bf16_t*)(F.ws + WS_KC); const bf16_t* VC = (const bf16_t*)(F.ws + WS_VC);
    bf16_t* OATT = (bf16_t*)(F.ws + WS_OATT); const float* rel = F.in[21];
    LAS float* wl = (LAS float*)F.lds + F.wave * (256 + 512 + 2048 + 16);
    LAS float* qs = wl; LAS float* pc = wl + 256; LAS float* ps = wl + 768; LAS int* pbase = (LAS int*)(wl + 768 + 2048);
    const int gw = blockIdx.x * NWAVES + F.wave, nw = F.G * NWAVES, lane = F.lane;
    for (int u = gw; u < T * 2; u += nw) {
        const int g = u & 1, tok = u >> 1, b = tok / S, t = tok % S;
        const bf16_t* prow = PROJ + (size_t)tok * NPAD;
#pragma unroll
        for (int r = 0; r < 4; ++r) qs[r * 64 + lane] = bf2f(prow[C_Q + (g * 4 + r) * 64 + lane]) * 0.125f;
        lds_wave_sync();
        const int nv = t >= 31 ? ((t - 31) >> 4) + 1 : 0;
        float sc[2][4]; bool va[2];
#pragma unroll
        for (int i = 0; i < 2; ++i) { const int n = lane + 64 * i; va[i] = n < nv; float a[4] = {0.f, 0.f, 0.f, 0.f};
            if (va[i]) { dot4_row(KC + ((size_t)(b * 2 + g) * 128 + n) * 64, qs, a); const int bk = rel_bucket(t - (16 * n + 31));
#pragma unroll
                for (int r = 0; r < 4; ++r) a[r] += rel[bk * 8 + g * 4 + r]; }
#pragma unroll
            for (int r = 0; r < 4; ++r) sc[i][r] = va[i] ? a[r] : -1e30f; }
        float ocmp[4];
#pragma unroll
        for (int r = 0; r < 4; ++r) { const float m = wave_max(fmaxf(sc[0][r], sc[1][r]));
            const float e0 = va[0] ? __expf(sc[0][r] - m) : 0.f, e1 = va[1] ? __expf(sc[1][r] - m) : 0.f; const float sum = wave_sum(e0 + e1);
            const float inv = nv > 0 ? 1.0f / sum : 0.f; pc[r * 128 + lane] = e0 * inv; pc[r * 128 + 64 + lane] = e1 * inv; }
        lds_wave_sync();
        { float o[4] = {0.f, 0.f, 0.f, 0.f}; const bf16_t* vb = VC + ((size_t)(b * 2 + g) * 128) * 64 + lane;
            for (int n = 0; n < nv; ++n) { const float v = bf2f(vb[n * 64]);
#pragma unroll
                for (int r = 0; r < 4; ++r) o[r] += pc[r * 128 + n] * v; }
#pragma unroll
            for (int r = 0; r < 4; ++r) ocmp[r] = o[r]; }
        const int cur = t >> 6; float val;
        { const int j = lane & 31; float imp = 0.f;
#pragma unroll
            for (int r = 0; r < 4; ++r) for (int n = 4 * j - 1; n <= 4 * j + 3; ++n) if (n >= 0 && n < NCMP) imp += pc[r * 128 + n];
            const bool forced = (j == 0) || (j == cur) || (j == cur - 1); const bool allowed = j <= cur;
            val = forced ? 1e4f : (allowed ? imp : -INFINITY); }
        int rank = 0;
        for (int jp = 0; jp < 32; ++jp) { const float vp = __shfl(val, jp); rank += ((vp > val) || (vp == val && jp < (lane & 31))) ? 1 : 0; }
        unsigned selmask = (unsigned)(__ballot(lane < 32 && rank < 8) & 0xFFFFFFFFull);
        float oslc[4], owin[4];
#pragma unroll
        for (int br = 0; br < 2; ++br) {
            const int ck = br == 0 ? C_KS : C_KW, cv = br == 0 ? C_VS : C_VW;
            unsigned mk = selmask;
#pragma unroll 1
            for (int c = 0; c < 8; ++c) {
                int kpos, bs;
                if (br == 0) { const int j = __builtin_ctz(mk | 0x80000000u); mk &= mk - 1; bs = 64 * j; } else { bs = t - 511 + 64 * c; }
                kpos = bs + lane; if (lane == 0) pbase[c] = bs;
                const int dist = t - kpos; const bool vv = (dist >= 0) && (kpos >= 0) && (kpos < S);
                float a[4] = {0.f, 0.f, 0.f, 0.f};
                if (vv) { dot4_row(PROJ + (size_t)(b * S + kpos) * NPAD + ck + g * 64, qs, a); const int bk = rel_bucket(dist);
#pragma unroll
                    for (int r = 0; r < 4; ++r) a[r] += rel[bk * 8 + g * 4 + r]; }
#pragma unroll
                for (int r = 0; r < 4; ++r) ps[r * 512 + c * 64 + lane] = vv ? a[r] : -1e30f;
            }
            lds_wave_sync();
#pragma unroll 1
            for (int r = 0; r < 4; ++r) { float m = -1e30f;
#pragma unroll
                for (int c = 0; c < 8; ++c) m = fmaxf(m, ps[r * 512 + c * 64 + lane]);
                m = wave_max(m); float e[8], sum = 0.f;
#pragma unroll
                for (int c = 0; c < 8; ++c) { const float sv = ps[r * 512 + c * 64 + lane]; e[c] = sv > -1e29f ? __expf(sv - m) : 0.f; sum += e[c]; }
                sum = wave_sum(sum); const float inv = sum > 0.f ? 1.0f / sum : 0.f;
#pragma unroll
                for (int c = 0; c < 8; ++c) ps[r * 512 + c * 64 + lane] = e[c] * inv; }
            lds_wave_sync();
            float o[4] = {0.f, 0.f, 0.f, 0.f};
#pragma unroll 1
            for (int c = 0; c < 8; ++c) {
                const int bsc = pbase[c];
                for (int kk = 0; kk < 64; ++kk) { const int kpos = bsc + kk; if (kpos < 0 || kpos > t) continue;
                    const float v = bf2f(PROJ[(size_t)(b * S + kpos) * NPAD + cv + g * 64 + lane]);
#pragma unroll
                    for (int r = 0; r < 4; ++r) o[r] += ps[r * 512 + c * 64 + kk] * v; } }
            lds_wave_sync();
#pragma unroll
            for (int r = 0; r < 4; ++r) { if (br == 0) oslc[r] = o[r]; else owin[r] = o[r]; }
        }
#pragma unroll
        for (int r = 0; r < 4; ++r) { const int h = g * 4 + r;
            const float g0 = sigmoidf_(bf2f(prow[C_GT + h * 3 + 0])), g1 = sigmoidf_(bf2f(prow[C_GT + h * 3 + 1])), g2 = sigmoidf_(bf2f(prow[C_GT + h * 3 + 2]));
            OATT[(size_t)tok * 512 + h * 64 + lane] = f2bf(g0 * ocmp[r] + g1 * oslc[r] + g2 * owin[r]); }
    }
}


constexpr float LOG2E = 1.4426950408889634f;
constexpr int AT_KC = 0, AT_VC = 16384, AT_KV = 32768  , AT_BTAB = 65536, AT_IMP = 69888, AT_SEL = 78336, AT_OUT = 78592  , AT_END = 78592 + 65536;
constexpr int BT_STRIDE = 132;
__device__ __forceinline__ int tile_off(int row, int chunk) { return row * 128 + ((chunk ^ (row & 7)) << 4); }
__device__ __forceinline__ bf16x8 mk_frag(unsigned a, unsigned b, unsigned c, unsigned d) { u32x4v v = {a, b, c, d}; return __builtin_bit_cast(bf16x8, v); }
struct LaneOffs { int koff[2]; int voff[4]; int soff; };
__device__ __forceinline__ LaneOffs lane_offs(int lane, int tid) {
    LaneOffs L; const int grp = lane >> 4, rowi = lane & 15, q4 = rowi >> 2, p = lane & 3;
#pragma unroll
    for (int ks = 0; ks < 2; ++ks) L.koff[ks] = tile_off(rowi, ks * 4 + grp);
#pragma unroll
    for (int dt = 0; dt < 4; ++dt) L.voff[dt] = tile_off(4 * grp + q4, 2 * dt + (p >> 1)) + 8 * (p & 1);
    L.soff = tile_off(tid >> 3, tid & 7); return L;
}
__device__ __forceinline__ bf16x8 vfrag_read(const LAS unsigned char* vt, int voff_dt, int row0) {
    const s16x4 a = __builtin_amdgcn_ds_read_tr16_b64_v4i16((LAS s16x4*)(vt + voff_dt + row0 * 128));
    const s16x4 b = __builtin_amdgcn_ds_read_tr16_b64_v4i16((LAS s16x4*)(vt + voff_dt + row0 * 128 + 2048));
    bf16x8 f = {a[0], a[1], a[2], a[3], b[0], b[1], b[2], b[3]}; return f;
}

struct AttnState {
    f32x4 o[4][2]; float m[2], l[2];
};

template <int BR>
__device__ __forceinline__ void attn_tile(const LAS unsigned char* kt_lds, const LAS unsigned char* vt_lds, const LAS float* btab_h, const bf16x8 (&qf)[2][2], const int (&tq)[2], const unsigned (&sel)[2],
                                          int j, bool near, AttnState& st, int lane, const LaneOffs& L) {
    const int grp = lane >> 4, kbase = 64 * j;
    f32x4 sacc[4][2];
#pragma unroll
    for (int kt = 0; kt < 4; ++kt) { sacc[kt][0] = (f32x4){0.f, 0.f, 0.f, 0.f}; sacc[kt][1] = (f32x4){0.f, 0.f, 0.f, 0.f}; }
#pragma unroll
    for (int kt = 0; kt < 4; ++kt)
#pragma unroll
        for (int ks = 0; ks < 2; ++ks) { const bf16x8 kf = *(const LAS bf16x8*)(kt_lds + L.koff[ks] + kt * 2048);
            sacc[kt][0] = __builtin_amdgcn_mfma_f32_16x16x32_bf16(kf, qf[0][ks], sacc[kt][0], 0, 0, 0);
            sacc[kt][1] = __builtin_amdgcn_mfma_f32_16x16x32_bf16(kf, qf[1][ks], sacc[kt][1], 0, 0, 0); }
    __builtin_amdgcn_sched_barrier(0);
    const float SC = 0.125f * LOG2E; const float bfar = btab_h[128];
    bf16x8 pf[2][2];
#pragma unroll
    for (int qt = 0; qt < 2; ++qt) {
        const int t = tq[qt]; const bool selq = BR == 0 ? ((sel[qt] >> j) & 1u) != 0u : true;
        float sv[4][4]; float tmax = -1e30f;
        int d0 = t - 4 * grp - kbase; asm volatile("" : "+v"(d0));
        if (near) {
#pragma unroll
            for (int kt = 0; kt < 4; ++kt)
#pragma unroll
                for (int rg = 0; rg < 4; ++rg) { const int dist = d0 - (kt * 16 + rg); const int dd = dist < 0 ? 0 : (dist > 128 ? 128 : dist); sv[kt][rg] = btab_h[dd]; }
        } else {
#pragma unroll
            for (int kt = 0; kt < 4; ++kt)
#pragma unroll
                for (int rg = 0; rg < 4; ++rg) sv[kt][rg] = bfar;
        }
#pragma unroll
        for (int kt = 0; kt < 4; ++kt)
#pragma unroll
            for (int rg = 0; rg < 4; ++rg) { const int c = kt * 16 + rg;
                const bool valid = BR == 0 ? (selq && d0 >= c) : (d0 >= c && d0 < 512 + c);
                const float sx = sacc[kt][qt][rg] * SC + sv[kt][rg]; const float s = valid ? sx : -1e30f; sv[kt][rg] = s; tmax = fmaxf(tmax, s); }
        tmax = fmaxf(tmax, __shfl_xor(tmax, 16)); tmax = fmaxf(tmax, __shfl_xor(tmax, 32));
        const float mnew = fmaxf(st.m[qt], tmax); const float alpha = __builtin_amdgcn_exp2f(st.m[qt] - mnew); st.m[qt] = mnew;
        const float muse = mnew < -1e29f ? 0.f : mnew;
        float ls = 0.f; unsigned pk[4][2];
#pragma unroll
        for (int kt = 0; kt < 4; ++kt) { float e[4];
#pragma unroll
            for (int rg = 0; rg < 4; ++rg) { e[rg] = __builtin_amdgcn_exp2f(sv[kt][rg] - muse); ls += e[rg]; }
            pk[kt][0] = pg8::cvt_pk_bf16(e[0], e[1]); pk[kt][1] = pg8::cvt_pk_bf16(e[2], e[3]); }
        st.l[qt] = st.l[qt] * alpha + ls;
#pragma unroll
        for (int dt = 0; dt < 4; ++dt) st.o[dt][qt] *= alpha;
        pf[qt][0] = mk_frag(pk[0][0], pk[0][1], pk[1][0], pk[1][1]); pf[qt][1] = mk_frag(pk[2][0], pk[2][1], pk[3][0], pk[3][1]);
        __builtin_amdgcn_sched_barrier(0);
    }
#pragma unroll
    for (int ks = 0; ks < 2; ++ks)
#pragma unroll
        for (int dt = 0; dt < 4; ++dt) { const bf16x8 vf = vfrag_read(vt_lds, L.voff[dt], 32 * ks);
            st.o[dt][0] = __builtin_amdgcn_mfma_f32_16x16x32_bf16(vf, pf[0][ks], st.o[dt][0], 0, 0, 0);
            st.o[dt][1] = __builtin_amdgcn_mfma_f32_16x16x32_bf16(vf, pf[1][ks], st.o[dt][1], 0, 0, 0); }
}

template <int BR>
__device__ __forceinline__ void attn_branch(const Frame& F, const bf16_t* PROJ, int b, int g, int t0, unsigned tiles  , const LAS float* btab_h,
                                            const bf16x8 (&qf)[2][2], const int (&tq)[2], const unsigned (&sel)[2], const float (&gate)[2], const LaneOffs& L) {
    const int lane = F.lane, tid = F.tid;
    const int ck = (BR == 0 ? C_KS : C_KW) + g * 64, cv = (BR == 0 ? C_VS : C_VW) + g * 64;
    const int srow = tid >> 3, sch = tid & 7;
    AttnState st;
#pragma unroll
    for (int dt = 0; dt < 4; ++dt) { st.o[dt][0] = (f32x4){0.f, 0.f, 0.f, 0.f}; st.o[dt][1] = (f32x4){0.f, 0.f, 0.f, 0.f}; }
    st.m[0] = st.m[1] = -1e30f; st.l[0] = st.l[1] = 0.f;
    unsigned rem = tiles; int cur = 0;
    u32x4v rk, rv;
    { const int j = __builtin_ctz(rem); const bf16_t* rowp = PROJ + (size_t)(b * S + 64 * j + srow) * NPAD + sch * 8;
        rk = *(const u32x4v*)(rowp + ck); rv = *(const u32x4v*)(rowp + cv);
        *(LAS u32x4v*)(F.lds + AT_KV + L.soff) = rk; *(LAS u32x4v*)(F.lds + AT_KV + 8192 + L.soff) = rv; }
    __syncthreads();
    while (rem) {
        const int j = __builtin_ctz(rem); rem &= rem - 1;
        const bool has_next = rem != 0u;
        if (has_next) { const int jn = __builtin_ctz(rem); const bf16_t* rowp = PROJ + (size_t)(b * S + 64 * jn + srow) * NPAD + sch * 8; rk = *(const u32x4v*)(rowp + ck); rv = *(const u32x4v*)(rowp + cv); }
        const bool near = (t0 + 8 * F.wave) - (64 * j + 63) < 128;
        attn_tile<BR>(F.lds + AT_KV + cur * 16384, F.lds + AT_KV + cur * 16384 + 8192, btab_h, qf, tq, sel, j, near, st, lane, L);
        if (has_next) { *(LAS u32x4v*)(F.lds + AT_KV + (cur ^ 1) * 16384 + L.soff) = rk; *(LAS u32x4v*)(F.lds + AT_KV + (cur ^ 1) * 16384 + 8192 + L.soff) = rv; }
        __syncthreads();
        cur ^= 1;
    }
    int pob = AT_OUT + tid * 4; asm volatile("" : "+v"(pob));
    LAS float* po = (LAS float*)(F.lds + pob);
#pragma unroll
    for (int qt = 0; qt < 2; ++qt) { float l = st.l[qt]; l += __shfl_xor(l, 16); l += __shfl_xor(l, 32); const float sc = l > 0.f ? gate[qt] / l : 0.f;
#pragma unroll
        for (int dt = 0; dt < 4; ++dt)
#pragma unroll
            for (int e = 0; e < 4; ++e) po[((qt * 4 + dt) * 4 + e) * 512] += st.o[dt][qt][e] * sc; }
}

__device__ __forceinline__ void p4_attn_mfma(const Frame& F) {
    const bf16_t* PROJ = (const bf16_t*)(F.ws + WS_PROJ); const bf16_t* KC = (const bf16_t*)(F.ws + WS_KC); const bf16_t* VC = (const bf16_t*)(F.ws + WS_VC);
    bf16_t* OATT = (bf16_t*)(F.ws + WS_OATT); const float* rel = F.in[21];
    const int lane = F.lane, tid = F.tid, wave = F.wave, grp = lane >> 4, col = lane & 15, qi = col >> 2, r = col & 3;
    LAS float* btab = (LAS float*)(F.lds + AT_BTAB); LAS float* impq = (LAS float*)(F.lds + AT_IMP); LAS unsigned* selm = (LAS unsigned*)(F.lds + AT_SEL);
    const LaneOffs L = lane_offs(lane, tid);
    for (int i = tid; i < 8 * 129; i += NTHREADS) { const int hh = i / 129, dd = i % 129; btab[hh * BT_STRIDE + dd] = rel[rel_bucket(dd) * 8 + hh] * LOG2E; }
    __syncthreads();
    for (int uu = blockIdx.x; uu < 1024; uu += F.G) {
        int sidx = uu;
        if (F.G == 256) { const int round = uu >> 8, k = uu & 255; sidx = (round == 0) ? k : (round == 1) ? 511 - k : (round == 2) ? 512 + k : 1023 - k; }
        const int qb = 31 - (sidx >> 5), bg = sidx & 31, b = bg >> 1, g = bg & 1, t0 = qb * 64, h = g * 4 + r;
        const LAS float* btab_h = btab + h * BT_STRIDE;
        int tq[2]; bf16x8 qf[2][2]; float gate[3][2];
#pragma unroll
        for (int qt = 0; qt < 2; ++qt) { tq[qt] = t0 + 8 * wave + 4 * qt + qi; const bf16_t* prow = PROJ + (size_t)(b * S + tq[qt]) * NPAD;
#pragma unroll
            for (int ks = 0; ks < 2; ++ks) qf[qt][ks] = *(const bf16x8*)(prow + C_Q + h * 64 + ks * 32 + 8 * grp);
#pragma unroll
            for (int jg = 0; jg < 3; ++jg) gate[jg][qt] = sigmoidf_(bf2f(prow[C_GT + h * 3 + jg])); }
#pragma unroll
        for (int i = 0; i < 2; ++i) { const int c2 = tid + 512 * i, row = c2 >> 3, ch = c2 & 7; const size_t src = ((size_t)(b * 2 + g) * 128 + row) * 64 + ch * 8;
            *(LAS u32x4v*)(F.lds + AT_KC + L.soff + 8192 * i) = *(const u32x4v*)(KC + src); *(LAS u32x4v*)(F.lds + AT_VC + L.soff + 8192 * i) = *(const u32x4v*)(VC + src); }
        __syncthreads();
#ifndef AT_SKIP_CMP
        {
            const int nvmax = t0 + 63 >= 31 ? ((t0 + 63 - 31) >> 4) + 1 : 0;
            const float SC = 0.125f * LOG2E; const int srcl = (lane + 48) & 63;
            int pob = AT_OUT + tid * 4; asm volatile("" : "+v"(pob));
            LAS float* po = (LAS float*)(F.lds + pob);
#pragma unroll
            for (int qt = 0; qt < 2; ++qt) {
                f32x4 sa[8];
#pragma unroll
                for (int kt = 0; kt < 8; ++kt) sa[kt] = (f32x4){0.f, 0.f, 0.f, 0.f};
#pragma unroll
                for (int kt = 0; kt < 8; ++kt) if (kt * 16 < nvmax) {
#pragma unroll
                    for (int ks = 0; ks < 2; ++ks) { const bf16x8 kf = *(const LAS bf16x8*)(F.lds + AT_KC + L.koff[ks] + kt * 2048);
                        sa[kt] = __builtin_amdgcn_mfma_f32_16x16x32_bf16(kf, qf[qt][ks], sa[kt], 0, 0, 0); } }
                __builtin_amdgcn_sched_barrier(0);
                int d0 = tq[qt] - 31 - 64 * grp; asm volatile("" : "+v"(d0));
                float mx = -1e30f;
#pragma unroll
                for (int kt = 0; kt < 8; ++kt)
#pragma unroll
                    for (int rg = 0; rg < 4; ++rg) { const int c = 256 * kt + 16 * rg; const int dist = d0 - c; const int dd = dist < 0 ? 0 : (dist > 128 ? 128 : dist);
                        const float sx = sa[kt][rg] * SC + btab_h[dd]; const float s = d0 >= c ? sx : -1e30f; sa[kt][rg] = s; mx = fmaxf(mx, s); }
                mx = fmaxf(mx, __shfl_xor(mx, 16)); mx = fmaxf(mx, __shfl_xor(mx, 32));
                float sum = 0.f;
#pragma unroll
                for (int kt = 0; kt < 8; ++kt)
#pragma unroll
                    for (int rg = 0; rg < 4; ++rg) { const int c = 256 * kt + 16 * rg; const float ex = __builtin_amdgcn_exp2f(sa[kt][rg] - mx); const float e = d0 >= c ? ex : 0.f; sa[kt][rg] = e; sum += e; }
                __builtin_amdgcn_sched_barrier(0);
                sum += __shfl_xor(sum, 16); sum += __shfl_xor(sum, 32);
                const float inv = sum > 0.f ? 1.0f / sum : 0.f;
                float prev3 = 0.f;
#pragma unroll
                for (int kt = 0; kt < 8; ++kt) { const float p3 = sa[kt][3] * inv; const float part = (sa[kt][0] * inv + sa[kt][1] * inv) + (sa[kt][2] * inv + p3);
                    const float xa = __shfl(p3, srcl), xb = __shfl(prev3, srcl); float tot = part + (grp >= 1 ? xa : xb);
                    tot += __shfl_xor(tot, 1); tot += __shfl_xor(tot, 2);
                    if (r == 0) impq[(8 * wave + 4 * qt + qi) * 33 + 4 * kt + grp] = tot;
                    prev3 = p3; }
                __builtin_amdgcn_sched_barrier(0);
                f32x4 oc[4];
#pragma unroll
                for (int dt = 0; dt < 4; ++dt) oc[dt] = (f32x4){0.f, 0.f, 0.f, 0.f};
#pragma unroll
                for (int ks = 0; ks < 4; ++ks) if (ks * 32 < nvmax) {
                    const bf16x8 pfr = mk_frag(pg8::cvt_pk_bf16(sa[2 * ks][0], sa[2 * ks][1]), pg8::cvt_pk_bf16(sa[2 * ks][2], sa[2 * ks][3]),
                                               pg8::cvt_pk_bf16(sa[2 * ks + 1][0], sa[2 * ks + 1][1]), pg8::cvt_pk_bf16(sa[2 * ks + 1][2], sa[2 * ks + 1][3]));
#pragma unroll
                    for (int dt = 0; dt < 4; ++dt) { const bf16x8 vf = vfrag_read(F.lds + AT_VC, L.voff[dt], 32 * ks); oc[dt] = __builtin_amdgcn_mfma_f32_16x16x32_bf16(vf, pfr, oc[dt], 0, 0, 0); } }
                const float scq = inv * gate[0][qt];
#pragma unroll
                for (int dt = 0; dt < 4; ++dt)
#pragma unroll
                    for (int e = 0; e < 4; ++e) po[((qt * 4 + dt) * 4 + e) * 512] = oc[dt][e] * scq;
                __builtin_amdgcn_sched_barrier(0);
            }
        }
#endif
        __syncthreads();
#ifndef AT_SKIP_SEL
        {
            const int q = tid >> 3, jj = tid & 7, cur = qb; unsigned bits = 0u;
            float vj[4];
#pragma unroll
            for (int e = 0; e < 4; ++e) { const int j = jj * 4 + e; const bool forced = (j == 0) || (j == cur) || (j == cur - 1); vj[e] = forced ? 1e4f : (j <= cur ? impq[q * 33 + j] : -INFINITY); }
            int rk[4] = {0, 0, 0, 0};
            for (int jp = 0; jp < 32; ++jp) { const bool forced = (jp == 0) || (jp == cur) || (jp == cur - 1); const float vp = forced ? 1e4f : (jp <= cur ? impq[q * 33 + jp] : -INFINITY);
#pragma unroll
                for (int e = 0; e < 4; ++e) rk[e] += ((vp > vj[e]) || (vp == vj[e] && jp < jj * 4 + e)) ? 1 : 0; }
#pragma unroll
            for (int e = 0; e < 4; ++e) bits |= (rk[e] < 8 ? 1u : 0u) << (jj * 4 + e);
            bits |= __shfl_xor(bits, 1); bits |= __shfl_xor(bits, 2); bits |= __shfl_xor(bits, 4);
            if (jj == 0) selm[q] = bits;
        }
#endif
        __syncthreads();
        unsigned sel[2] = {selm[8 * wave + qi], selm[8 * wave + 4 + qi]};
        unsigned un = selm[lane];
#pragma unroll
        for (int o = 32; o >= 1; o >>= 1) un |= __shfl_xor(un, o);
        un = __builtin_amdgcn_readfirstlane(un);
        const unsigned causal = qb == 31 ? 0xFFFFFFFFu : ((2u << qb) - 1u);
#ifndef AT_SKIP_BR0
        { const float gt1[2] = {gate[1][0], gate[1][1]}; attn_branch<0>(F, PROJ, b, g, t0, un & causal, btab_h, qf, tq, sel, gt1, L); }
#endif
#ifndef AT_SKIP_BR1
        { const int jlo = qb >= 8 ? qb - 8 : 0; const unsigned wmask = causal & ~((1u << jlo) - 1u); const float gt2[2] = {gate[2][0], gate[2][1]};
            attn_branch<1>(F, PROJ, b, g, t0, wmask, btab_h, qf, tq, sel, gt2, L); }
#endif
        int pob2 = AT_OUT + tid * 4; asm volatile("" : "+v"(pob2));
#pragma unroll
        for (int qt = 0; qt < 2; ++qt) { bf16_t* orow = OATT + (size_t)(b * S + tq[qt]) * 512 + h * 64 + 4 * grp;
#pragma unroll
            for (int dt = 0; dt < 4; ++dt) { const LAS float* po = (const LAS float*)(F.lds + pob2) + (qt * 4 + dt) * 4 * 512;
                *(uint2*)(orow + dt * 16) = make_uint2(pg8::cvt_pk_bf16(po[0], po[512]), pg8::cvt_pk_bf16(po[1024], po[1536])); } }
    }
}
__device__ __forceinline__ void p5_mixed(const Frame& F) {
    const bf16_t* PROJ = (const bf16_t*)(F.ws + WS_PROJ); const bf16_t* OATT = (const bf16_t*)(F.ws + WS_OATT); bf16_t* MIX = (bf16_t*)(F.ws + WS_H);
    const float* cw = F.in[13]; const float* ga = F.in[14]; const float* gc = F.in[15];
    const int gw = blockIdx.x * NWAVES + F.wave, nw = F.G * NWAVES, lane = F.lane;
    for (int tok = gw; tok < T; tok += nw) {
        const int s = tok % S; const int c0 = lane * 8;
        float a[8], y[8];
        { const uint4 w = *(const uint4*)(OATT + (size_t)tok * 512 + c0); const unsigned ww[4] = {w.x, w.y, w.z, w.w};
#pragma unroll
            for (int e = 0; e < 4; ++e) { a[2 * e] = bflo(ww[e]); a[2 * e + 1] = bfhi(ww[e]); } }
#pragma unroll
        for (int e = 0; e < 8; ++e) y[e] = 0.f;
#pragma unroll
        for (int dt = 0; dt < 3; ++dt) { if (s - 2 + dt >= 0) { const bf16_t* row = PROJ + (size_t)(tok - 2 + dt) * NPAD;
                const uint4 wc = *(const uint4*)(row + C_CC + c0), wh = *(const uint4*)(row + C_CH + c0); const unsigned c4[4] = {wc.x, wc.y, wc.z, wc.w}, h4[4] = {wh.x, wh.y, wh.z, wh.w};
#pragma unroll
                for (int e = 0; e < 4; ++e) { y[2 * e] += cw[dt * 512 + c0 + 2 * e] * (bflo(c4[e]) * bflo(h4[e])); y[2 * e + 1] += cw[dt * 512 + c0 + 2 * e + 1] * (bfhi(c4[e]) * bfhi(h4[e])); } } }
        { const uint4 wb = *(const uint4*)(PROJ + (size_t)tok * NPAD + C_CB + c0); const unsigned b4[4] = {wb.x, wb.y, wb.z, wb.w};
#pragma unroll
            for (int e = 0; e < 4; ++e) { y[2 * e] *= bflo(b4[e]); y[2 * e + 1] *= bfhi(b4[e]); } }
        float sa = 0.f, sy = 0.f;
#pragma unroll
        for (int e = 0; e < 8; ++e) { sa += a[e] * a[e]; sy += y[e] * y[e]; }
        sa = wave_sum(sa); sy = wave_sum(sy);
        const float ra = rsqrtf(sa * (1.0f / 512) + EPS), ry = rsqrtf(sy * (1.0f / 512) + EPS);
        unsigned oa[4], oy[4];
#pragma unroll
        for (int e = 0; e < 4; ++e) { oa[e] = pack2(a[2 * e] * ra * ga[c0 + 2 * e], a[2 * e + 1] * ra * ga[c0 + 2 * e + 1]); oy[e] = pack2(y[2 * e] * ry * gc[c0 + 2 * e], y[2 * e + 1] * ry * gc[c0 + 2 * e + 1]); }
        *(uint4*)(MIX + (size_t)tok * D + c0) = make_uint4(oa[0], oa[1], oa[2], oa[3]);
        *(uint4*)(MIX + (size_t)tok * D + 512 + c0) = make_uint4(oy[0], oy[1], oy[2], oy[3]);
    }
}

struct EpiResGate {
    static constexpr bool PERM = false, AFTER_DRAIN = false;
    float* C; const float* X; const float* MOD; int gate_off;
    __device__ __forceinline__ void operator()(const pg8::f32x4 (&acc)[2][2][4][2], const pg8::Unit& u, int wr, int wc, int fr, int fq) const {
        using pg8::f32x4; using pg8::HALF; using pg8::BM;
        const int row0 = u.pm * BM + wr * 64 + fr, col0 = u.pn * BM + wc * 32 + 4 * fq;
        const int b = (u.pm * BM) / S;
        f32x4 gv[2][2];
#pragma unroll
        for (int bj = 0; bj < 2; ++bj)
#pragma unroll
            for (int n = 0; n < 2; ++n) gv[bj][n] = *(const f32x4*)(MOD + b * 6144 + gate_off + col0 + bj * HALF + n * 16);
#pragma unroll
        for (int ai = 0; ai < 2; ++ai)
#pragma unroll
            for (int m = 0; m < 4; ++m) { const size_t ro = (size_t)(row0 + ai * HALF + m * 16) * D + col0;
#pragma unroll
                for (int bj = 0; bj < 2; ++bj)
#pragma unroll
                    for (int n = 0; n < 2; ++n) { const f32x4 xv = *(const f32x4*)(X + ro + bj * HALF + n * 16); *(f32x4*)(C + ro + bj * HALF + n * 16) = xv + gv[bj][n] * acc[ai][bj][m][n]; } }
    }
};

__device__ __forceinline__ void argmax_bfly(float& v, int& i) {
#pragma unroll
    for (int o = 32; o >= 1; o >>= 1) { const float ov = __shfl_xor(v, o); const int oi = __shfl_xor(i, o); if (ov > v || (ov == v && oi < i)) { v = ov; i = oi; } }
}
__device__ __forceinline__ void p9_route_naive(const Frame& F) {
    const bf16_t* QP = (const bf16_t*)(F.ws + WS_QP); const bf16_t* KEYS = (const bf16_t*)(F.ws + WS_KEYS);
    int* EIDX = (int*)(F.ws + WS_EIDX); float* EW = (float*)(F.ws + WS_EW);
    LAS float* ql = (LAS float*)F.lds + F.wave * 128;
    const int gw = blockIdx.x * NWAVES + F.wave, nw = F.G * NWAVES, lane = F.lane;
    for (int u = gw; u < T * 8; u += nw) {
        const int h = u & 7, tok = u >> 3;
        ql[lane] = bf2f(QP[(size_t)tok * D + h * 128 + lane]); ql[64 + lane] = bf2f(QP[(size_t)tok * D + h * 128 + 64 + lane]);
        lds_wave_sync();
        float tv[2]; int ti[2];
#pragma unroll
        for (int p = 0; p < 2; ++p) {
            float s[2];
#pragma unroll
            for (int kk = 0; kk < 2; ++kk) { const uint4* kr = (const uint4*)(KEYS + ((size_t)(h * 2 + p) * 128 + lane + 64 * kk) * 64); float a = 0.f;
#pragma unroll
                for (int c = 0; c < 8; ++c) { const uint4 w = kr[c]; const unsigned ww[4] = {w.x, w.y, w.z, w.w};
#pragma unroll
                    for (int e = 0; e < 4; ++e) a += ql[p * 64 + c * 8 + 2 * e] * bflo(ww[e]) + ql[p * 64 + c * 8 + 2 * e + 1] * bfhi(ww[e]); }
                s[kk] = a; }
            tv[p] = 0.f; ti[p] = 0;
            for (int i = 0; i < 16; ++i) {
                float v = s[0]; int ix = lane; if (s[1] > v) { v = s[1]; ix = lane + 64; }
                argmax_bfly(v, ix);
                if (lane == i) { tv[p] = v; ti[p] = ix; }
                if (ix == lane) s[0] = -INFINITY; if (ix == lane + 64) s[1] = -INFINITY;
            }
        }
        float cd[4];
        { const float va = __shfl(tv[0], lane >> 2);
#pragma unroll
            for (int i = 0; i < 4; ++i) cd[i] = va + __shfl(tv[1], (lane & 3) * 4 + i); }
        float cs = 0.f; int cc = 0;
        for (int it = 0; it < 16; ++it) {
            float v = cd[0]; int ix = lane * 4;
#pragma unroll
            for (int i = 1; i < 4; ++i) if (cd[i] > v) { v = cd[i]; ix = lane * 4 + i; }
            argmax_bfly(v, ix);
            if (lane == it) { cs = v; cc = ix; }
#pragma unroll
            for (int i = 0; i < 4; ++i) if (ix == lane * 4 + i) cd[i] = -INFINITY;
        }
        const int i1 = __shfl(ti[0], cc >> 4), i2 = __shfl(ti[1], cc & 15);
        const float m = __shfl(cs, 0); float ex = lane < 16 ? __expf(cs - m) : 0.f; const float sum = wave_sum(ex);
        if (lane < 16) { EIDX[(size_t)tok * 128 + h * 16 + lane] = i1 * 128 + i2; EW[(size_t)tok * 128 + h * 16 + lane] = ex / sum; }
        lds_wave_sync();
    }
}


__device__ __forceinline__ int ord_i(float f) { const int u = __float_as_int(f); return u >= 0 ? u : (u ^ 0x7FFFFFFF); }
__device__ __forceinline__ float unord_f(int i) { const int u = i >= 0 ? i : (i ^ 0x7FFFFFFF); return __int_as_float(u); }
#define INT_MIN_ (-2147483647 - 1)
struct CandTab { int a[50], b[50]; };
constexpr CandTab make_cand() { CandTab t{}; int n = 0; for (int a = 0; a < 16; ++a) for (int b = 0; b < 16; ++b) if ((a + 1) * (b + 1) <= 16) { t.a[n] = a; t.b[n] = b; ++n; } return t; }
constexpr CandTab CAND = make_cand();
constexpr int RT_LDS_PER_WAVE = 16 * 32 * 4;
__device__ __forceinline__ void p9_route_mfma(const Frame& F) {
    const bf16_t* QP = (const bf16_t*)(F.ws + WS_QP); const bf16_t* KEYS = (const bf16_t*)(F.ws + WS_KEYS);
    int* EIDX = (int*)(F.ws + WS_EIDX); float* EW = (float*)(F.ws + WS_EW);
    const int lane = F.lane, grp = lane >> 4, col = lane & 15;
    LAS int* itab = (LAS int*)(F.lds + F.wave * RT_LDS_PER_WAVE) + col * 32;
    const int gw = blockIdx.x * NWAVES + F.wave, nw = F.G * NWAVES;
    for (int task = gw; task < (T / 16) * 8; task += nw) {
        const int h = task & 7, tile = task >> 3, tok = tile * 16 + col;
        int lst[2][16];
#pragma unroll
        for (int p = 0; p < 2; ++p) {
            bf16x8 qf[2];
#pragma unroll
            for (int ks = 0; ks < 2; ++ks) qf[ks] = *(const bf16x8*)(QP + (size_t)tok * D + h * 128 + p * 64 + ks * 32 + 8 * grp);
            f32x4 sc[8];
#pragma unroll
            for (int kt = 0; kt < 8; ++kt) { sc[kt] = (f32x4){0.f, 0.f, 0.f, 0.f};
#pragma unroll
                for (int ks = 0; ks < 2; ++ks) { const bf16x8 kf = *(const bf16x8*)(KEYS + ((size_t)(h * 2 + p) * 128 + kt * 16 + col) * 64 + ks * 32 + 8 * grp);
                    sc[kt] = __builtin_amdgcn_mfma_f32_16x16x32_bf16(kf, qf[ks], sc[kt], 0, 0, 0); } }
            int r[32];
#pragma unroll
            for (int kt = 0; kt < 8; ++kt)
#pragma unroll
                for (int rg = 0; rg < 4; ++rg) r[kt * 4 + rg] = (ord_i(sc[kt][rg]) & ~0x7F) | (127 - (kt * 16 + 4 * grp + rg));
#pragma unroll
            for (int it = 0; it < 16; ++it) {
                int m = r[0];
#pragma unroll
                for (int i = 1; i < 32; ++i) m = max(m, r[i]);
                m = max(m, __shfl_xor(m, 16)); m = max(m, __shfl_xor(m, 32));
                lst[p][it] = m;
#pragma unroll
                for (int i = 0; i < 32; ++i) r[i] = (r[i] == m) ? INT_MIN_ : r[i];
            }
            if (grp == 0) {
#pragma unroll
                for (int it = 0; it < 16; ++it) itab[p * 16 + it] = 127 - (lst[p][it] & 0x7F);
            }
        }
        float v0[16], v1[16];
#pragma unroll
        for (int i = 0; i < 16; ++i) { v0[i] = unord_f(lst[0][i] & ~0x7F); v1[i] = unord_f(lst[1][i] & ~0x7F); }
        int ck[50];
#pragma unroll
        for (int i = 0; i < 50; ++i) ck[i] = (ord_i(v0[CAND.a[i]] + v1[CAND.b[i]]) & ~0xFF) | (255 - (CAND.a[i] * 16 + CAND.b[i]));
        int top[16];
#pragma unroll
        for (int it = 0; it < 16; ++it) {
            int m = ck[0];
#pragma unroll
            for (int i = 1; i < 50; ++i) m = max(m, ck[i]);
            top[it] = m;
#pragma unroll
            for (int i = 0; i < 50; ++i) ck[i] = (ck[i] == m) ? INT_MIN_ : ck[i];
        }
        lds_wave_sync();
        const float smax = unord_f(top[0] & ~0xFF);
        float ex[16], sum = 0.f;
#pragma unroll
        for (int it = 0; it < 16; ++it) { ex[it] = __expf(unord_f(top[it] & ~0xFF) - smax); sum += ex[it]; }
        const float inv = 1.0f / sum;
        if (grp == 0) {
#pragma unroll
            for (int it = 0; it < 16; ++it) { const int flat = 255 - (top[it] & 0xFF); const int i1 = itab[flat >> 4], i2 = itab[16 + (flat & 15)];
                EIDX[(size_t)tok * 128 + h * 16 + it] = i1 * 128 + i2; EW[(size_t)tok * 128 + h * 16 + it] = ex[it] * inv; }
        }
        lds_wave_sync();
    }
}

constexpr int N_PHASES = 14;
struct Args { const float* in[23]; float* out; unsigned char* ws; int ph_lo, ph_hi; };
__global__ void __launch_bounds__(NTHREADS, 2) fwd(Args args) {
    extern __shared__ __attribute__((aligned(16))) unsigned char lds_raw[];
    Frame F;
#pragma unroll
    for (int i = 0; i < 23; ++i) F.in[i] = args.in[i];
    F.out = args.out; F.ws = args.ws; F.lds = (LAS unsigned char*)lds_raw;
    F.tid = threadIdx.x; F.lane = F.tid & 63; F.wave = __builtin_amdgcn_readfirstlane(F.tid >> 6); F.G = gridDim.x;
    volatile LAS unsigned* misc = (volatile LAS unsigned*)(F.lds + LDS_MISC_OFF);
    if (F.tid < 64) misc[F.tid] = 0u;
    __syncthreads();
    XcdBarrier bar; bar.bar = (unsigned*)(F.ws + WS_CTL); bar.x = 0; bar.st = misc;
    const int lo = args.ph_lo, hi = args.ph_hi;
    if (hi - lo > 1) bar = xcd_barrier_post((unsigned*)(F.ws + WS_CTL), misc);
#ifndef PH_MASK
#define PH_MASK 0xFFFF
#endif
#define IN(k) (((PH_MASK >> (k)) & 1) && lo <= (k) && (k) < hi)
#define SEAM(k) do { if (IN(k) && IN((k) + 1)) xcd_barrier(bar); } while (0)
    const float* MOD = (const float*)(F.ws + WS_MOD);
    if (IN(0)) { p0_prologue(F); } SEAM(0);
    if (IN(1)) { norm_mod_rows(F, F.in[0], F.in[2], 0, 1024, (bf16_t*)(F.ws + WS_H)); } SEAM(1);
    if (IN(2)) { pg8::Gemm g{(const pg8::bf16_t*)(F.ws + WS_H), (const pg8::bf16_t*)(F.ws + WS_WIN), T, NPAD, D}; pg8::StaticOrder So; So.init(T, NPAD, F.G, (int)blockIdx.x);
        pg8::EpiBf16<0> E{(pg8::bf16_t*)(F.ws + WS_PROJ), NPAD, nullptr, 0, 0};
        pg8::gemm_phase<pg8::EpiBf16<0>, pg8::StaticOrder>(F.lds, g, So, E, nullptr); } SEAM(2);
#ifdef COMPRESS_NAIVE
    if (IN(3)) { p3_compress_naive(F); } SEAM(3);
#else
    if (IN(3)) { p3_compress_mfma(F); } SEAM(3);
#endif
    #ifdef ATTN_NAIVE
    if (IN(4)) { p4_attn_naive(F); } SEAM(4);
#else
    if (IN(4)) { p4_attn_mfma(F); } SEAM(4);
#endif
    if (IN(5)) { p5_mixed(F); } SEAM(5);
    if (IN(6)) { pg8::Gemm g{(const pg8::bf16_t*)(F.ws + WS_H), (const pg8::bf16_t*)(F.ws + WS_WOUT), T, D, D}; pg8::StaticOrder So; So.init(T, D, F.G, (int)blockIdx.x);
        EpiResGate E{F.out, F.in[0], MOD, 2048};
        pg8::gemm_phase<EpiResGate, pg8::StaticOrder>(F.lds, g, So, E, nullptr); } SEAM(6);
    if (IN(7)) { norm_mod_rows_q(F, F.out, F.in[3], 3072, 4096, (bf16_t*)(F.ws + WS_H)); } SEAM(7);
    if (IN(8)) { pg8::Gemm g{(const pg8::bf16_t*)(F.ws + WS_H), (const pg8::bf16_t*)(F.ws + WS_WQ), T, D, D}; pg8::StaticOrder So; So.init(T, D, F.G, (int)blockIdx.x);
        pg8::EpiBf16<0> E{(pg8::bf16_t*)(F.ws + WS_QP), D, nullptr, 0, 0};
        pg8::gemm_phase<pg8::EpiBf16<0>, pg8::StaticOrder>(F.lds, g, So, E, nullptr); } SEAM(8);
    #ifdef ROUTE_NAIVE
    if (IN(9)) { p9_route_naive(F); } SEAM(9);
#else
    if (IN(9)) { p9_route_mfma(F); } SEAM(9);
#endif
    if (IN(10)) { p10a_udots(F); } SEAM(10);
    if (IN(11)) { p10b_coef(F); } SEAM(11);
    if (IN(12)) { p10c_vsum(F); } SEAM(12);
    if (IN(13)) { p10d_final(F); }
#undef IN
#undef SEAM
}

extern "C" void kernel_launch(void* const* d_in, const int* in_sizes, int n_in, void* d_out, int out_size, void* d_ws, size_t ws_size, hipStream_t stream) {
    static int grid = 0;
    if (grid == 0) {
        if (n_in != 23 || out_size != T * D || ws_size < WS_END) { fprintf(stderr, "kernel_launch: unexpected shapes: n_in %d out %d ws %zu (need %zu)\n", n_in, out_size, ws_size, (size_t)WS_END); grid = -1; return; }
        int dev = 0, cus = 0, per_cu = 0;
        if (hipGetDevice(&dev) != hipSuccess || hipDeviceGetAttribute(&cus, hipDeviceAttributeMultiprocessorCount, dev) != hipSuccess) { grid = -1; return; }
        if (hipFuncSetAttribute((const void*)fwd, hipFuncAttributeMaxDynamicSharedMemorySize, LDS_BYTES) != hipSuccess) { fprintf(stderr, "kernel_launch: hipFuncSetAttribute failed\n"); grid = -1; return; }
        if (hipOccupancyMaxActiveBlocksPerMultiprocessor(&per_cu, (const void*)fwd, NTHREADS, LDS_BYTES) != hipSuccess || per_cu < 1) { fprintf(stderr, "kernel_launch: occupancy query says %d\n", per_cu); (void)hipGetLastError(); per_cu = 1; }
        grid = cus;
    }
    if (grid < 0) return;
    (void)hipMemsetAsync((char*)d_ws + WS_CTL, 0, CTL_BYTES, stream);
    Args a{};
    for (int i = 0; i < 23; ++i) a.in[i] = (const float*)d_in[i];
    a.out = (float*)d_out; a.ws = (unsigned char*)d_ws;
#if MK_N_LAUNCHES == 1
    a.ph_lo = 0; a.ph_hi = N_PHASES;
    hipLaunchKernelGGL(fwd, dim3(grid), dim3(NTHREADS), LDS_BYTES, stream, a);
#else
#ifdef PROBE_LIST
    { const int plist[] = PROBE_LIST; for (int p : plist) { if (p < 0) { (void)hipMemsetAsync((char*)d_ws + WS_CTL, 0, CTL_BYTES, stream); continue; } a.ph_lo = p; a.ph_hi = p + 1; hipLaunchKernelGGL(fwd, dim3(grid), dim3(NTHREADS), LDS_BYTES, stream, a); } }
#else
    for (int p = 0; p < N_PHASES; ++p) { a.ph_lo = p; a.ph_hi = p + 1; hipLaunchKernelGGL(fwd, dim3(grid), dim3(NTHREADS), LDS_BYTES, stream, a); }
#endif
#endif
}
```

```cpp
#include <hip/hip_runtime.h>
#include <cstdio>
#include <cstdint>
#include <cstdlib>

#ifndef MK_N_LAUNCHES
#define MK_N_LAUNCHES 1
#endif
#define XB_TMO      128
#define XB_XCNT(j)  (256  + 64 * (j))
#define XB_XSUB(j)  (1280 + 64 * (j))
#define XB_XGEN(j)  (2304 + 64 * (j))
#define XB_TOP      3328
#define XB_TOPGEN   3392
#define XCD_BAR_WORDS 3456
#define XB_SPIN_CAP (1u << 18)
#define LAS __attribute__((address_space(3)))

__device__ __forceinline__ unsigned xb_ld(unsigned* p)              { return __hip_atomic_load(p, __ATOMIC_RELAXED, __HIP_MEMORY_SCOPE_AGENT); }
__device__ __forceinline__ unsigned xb_add(unsigned* p, unsigned v) { return __hip_atomic_fetch_add(p, v, __ATOMIC_RELAXED, __HIP_MEMORY_SCOPE_AGENT); }
__device__ __forceinline__ unsigned xb_xcc_id() { return (unsigned)__builtin_amdgcn_s_getreg((3 << 11) | 20) & 0xFu; }
#define XB_SPIN(cond, bar) do { unsigned _sp = 0; while (cond) { __builtin_amdgcn_s_sleep(1); \
    if ((++_sp & 255u) == 0u) { if (xb_ld(&(bar)[XB_TMO])) break; if (_sp > XB_SPIN_CAP) { atomicAdd(&(bar)[XB_TMO], 1u); break; } } } } while (0)

struct XcdBarrier {
    unsigned* bar; unsigned x;
    volatile LAS unsigned* st;
};

__device__ __forceinline__ XcdBarrier xcd_barrier_post(unsigned* bar, volatile LAS unsigned* st) {
    XcdBarrier b; b.bar = bar; b.x = xb_xcc_id(); b.st = st;
    if (threadIdx.x == 0) (void)xb_add(&bar[XB_XCNT(b.x)], 1u);
    return b;
}
__device__ __forceinline__ void xcd_barrier_complete(unsigned* bar, unsigned x, unsigned& nloc, unsigned& nx) {
    const unsigned G = gridDim.x * gridDim.y * gridDim.z;
    unsigned sum, cnt, mine, sp = 0u;
    for (;;) {
        sum = 0u; cnt = 0u; mine = 0u;
#pragma unroll
        for (unsigned j = 0; j < 16; ++j) { const unsigned c = xb_ld(&bar[XB_XCNT(j)]); sum += c; cnt += (c > 0u) ? 1u : 0u; mine = (j == x) ? c : mine; }
        if (sum == G) break;
        __builtin_amdgcn_s_sleep(1);
        if ((++sp & 255u) == 0u) { if (xb_ld(&bar[XB_TMO])) break; if (sp > XB_SPIN_CAP) { atomicAdd(&bar[XB_TMO], 1u); break; } }
    }
    nloc = mine > 0u ? mine : 1u; nx = cnt > 0u ? cnt : 1u;
}

__device__ __forceinline__ void xcd_barrier(const XcdBarrier& b) {
    asm volatile("s_waitcnt vmcnt(0)" ::: "memory");
    __syncthreads();
    if (threadIdx.x == 0) {
        unsigned* bar = b.bar;
        __builtin_amdgcn_s_waitcnt(0);
        unsigned nloc = b.st[0], nx = b.st[1];
        if (nloc == 0u) { xcd_barrier_complete(bar, b.x, nloc, nx); b.st[0] = nloc; b.st[1] = nx; }
        const unsigned old = xb_add(&bar[XB_XSUB(b.x)], 1u);
        const unsigned gen = old / nloc;
        if (old + 1u == (gen + 1u) * nloc) {
            __builtin_amdgcn_fence(__ATOMIC_RELEASE, "agent");
            asm volatile("s_waitcnt vmcnt(0)" ::: "memory");
            const unsigned og = xb_add(&bar[XB_TOP], 1u);
            const unsigned tg = og / nx;
            if (og + 1u == (tg + 1u) * nx) xb_add(&bar[XB_TOPGEN], 1u);
            else XB_SPIN(xb_ld(&bar[XB_TOPGEN]) == tg, bar);
            __builtin_amdgcn_fence(__ATOMIC_ACQUIRE, "agent");
            xb_add(&bar[XB_XGEN(b.x)], 1u);
            asm volatile("s_waitcnt vmcnt(0)" ::: "memory");
        } else {
            XB_SPIN(xb_ld(&bar[XB_XGEN(b.x)]) == gen, bar);
            __builtin_amdgcn_fence(__ATOMIC_ACQUIRE, "agent");
            asm volatile("s_waitcnt vmcnt(0)" ::: "memory");
        }
    }
    __syncthreads();
}

namespace pg8 {
#define PG8_LAS __attribute__((address_space(3)))
typedef unsigned short bf16_t;
typedef short bf16x8 __attribute__((ext_vector_type(8)));
typedef float f32x4 __attribute__((ext_vector_type(4)));
typedef unsigned u32x4 __attribute__((ext_vector_type(4)));
constexpr int BM = 256, BK = 64, HALF = 128, HTB = HALF * BK * 2  , STAGE_BYTES = 8 * HTB, NXCD = 8, WGM = 8;

__host__ __device__ __forceinline__ int lds_byte(int r, int c) { const int st = (r >> 4) * 2 + (c >> 5), rr = r & 15, cc = c & 31, ob = rr * 64 + cc * 2; return st * 1024 + (ob ^ (((ob >> 9) & 1) << 5)); }
__host__ __device__ __forceinline__ void stage_rc(int b, int& R, int& C) { const int st = b / 1024, sb = b % 1024, swz = sb ^ (((sb >> 9) & 1) << 5); R = (st >> 1) * 16 + swz / 64; C = (st & 1) * 32 + (swz % 64) / 2; }
__host__ __device__ __forceinline__ int perm32(int rho) { const int n = rho >> 4, i = rho & 15; return 8 * (i >> 2) + 4 * n + (i & 3); }

struct Unit { int pm, pn; };
struct Gemm { const bf16_t* A; const bf16_t* Bt; int M, N, K; };

struct StaticOrder {
    int nM, nN, nwg, G, c;
    __host__ __device__ void init(int M, int N, int G_, int c_) { nM = M / BM; nN = N / BM; nwg = nM * nN; G = G_; c = c_; }
    __host__ __device__ bool next(int i, Unit& u) const {
        const long L = (long)i * G + c; if (L >= nwg) return false;
        int wgid = (int)L; { const int q = nwg / NXCD, r = nwg % NXCD, xcd = wgid % NXCD, off = wgid / NXCD; wgid = (xcd < r ? xcd * (q + 1) : r * (q + 1) + (xcd - r) * q) + off; }
        const int nig = WGM * nN, gid = wgid / nig, fm = gid * WGM, gsz = (nM - fm) < WGM ? (nM - fm) : WGM;
        u.pm = fm + ((wgid % nig) % gsz); u.pn = (wgid % nig) / gsz; return true;
    }
    __device__ __forceinline__ void a_ready(const Unit&) const {}
    __device__ __forceinline__ void done(const Unit&) const {}
};
struct CountedOrder : StaticOrder {
    const unsigned* ready; unsigned need; unsigned* tmo;
    __device__ __forceinline__ void a_ready(const Unit& u) const {
        if (threadIdx.x < 64) {
            const unsigned long long t0 = __builtin_amdgcn_s_memrealtime(); unsigned polls = 0;
            while ((unsigned)__builtin_amdgcn_readfirstlane(__hip_atomic_load(ready + 64 * u.pm, __ATOMIC_RELAXED, __HIP_MEMORY_SCOPE_AGENT)) < need) {
                if ((++polls & 255u) == 0u && __builtin_amdgcn_readfirstlane(__hip_atomic_load(tmo, __ATOMIC_RELAXED, __HIP_MEMORY_SCOPE_AGENT)) != 0u) break;
                if (__builtin_amdgcn_s_memrealtime() - t0 > 2000000ull) {
                    if (threadIdx.x == 0) { unsigned expect = 0u; __hip_atomic_compare_exchange_strong(tmo + 1, &expect, 0x600u | (unsigned)(u.pm & 0xff), __ATOMIC_RELAXED, __ATOMIC_RELAXED, __HIP_MEMORY_SCOPE_AGENT); __hip_atomic_store(tmo, 1u, __ATOMIC_RELAXED, __HIP_MEMORY_SCOPE_AGENT); }
                    break; }
                __builtin_amdgcn_s_sleep(2); }
            __builtin_amdgcn_fence(__ATOMIC_ACQUIRE, "agent");
            asm volatile("s_waitcnt vmcnt(0)" ::: "memory");
        }
#if !defined(BROKEN_HOOK_NO_BARRIER)
        asm volatile("" ::: "memory"); __builtin_amdgcn_s_barrier(); asm volatile("" ::: "memory");
#endif
    }
};

__device__ __forceinline__ unsigned cvt_pk_bf16(float lo, float hi) { unsigned r; asm volatile("v_cvt_pk_bf16_f32 %0, %1, %2" : "=v"(r) : "v"(lo), "v"(hi)); return r; }
typedef float f32x2 __attribute__((ext_vector_type(2)));
__device__ __forceinline__ f32x2 gelu_pk(f32x2 v) {
    const f32x2 av = __builtin_elementwise_abs(v), d = av * 0.2316418882f + 1.0f;
    f32x2 t; t.x = __builtin_amdgcn_rcpf(d.x); t.y = __builtin_amdgcn_rcpf(d.y);
    f32x2 q = t * 0.5307027145f + (-0.7265760135f); q = q * t + 0.7107068705f; q = q * t + (-0.142248368f); q = q * t + 0.127414796f; q = q * t;
    const f32x2 s = (v * v) * (-0.72134752044f);
    f32x2 e; e.x = __builtin_amdgcn_exp2f(s.x); e.y = __builtin_amdgcn_exp2f(s.y);
    const f32x2 m = v * (q * e), r = v - m;
    f32x2 o; o.x = v.x < 0.f ? m.x : r.x; o.y = v.y < 0.f ? m.y : r.y; return o;
}

struct EpiF32 {
    static constexpr bool PERM = false, AFTER_DRAIN = false;
    float* C; int ldc; const float* bias;
    __device__ __forceinline__ void operator()(const f32x4 (&acc)[2][2][4][2], const Unit& u, int wr, int wc, int fr, int fq) const {
        const int row0 = u.pm * BM + wr * 64 + fr, col0 = u.pn * BM + wc * 32 + 4 * fq;
        f32x4 bv[2][2];
#pragma unroll
        for (int bj = 0; bj < 2; ++bj)
#pragma unroll
            for (int n = 0; n < 2; ++n) bv[bj][n] = bias ? *(const f32x4*)(bias + col0 + bj * HALF + n * 16) : (f32x4){0.f, 0.f, 0.f, 0.f};
#pragma unroll
        for (int ai = 0; ai < 2; ++ai)
#pragma unroll
            for (int m = 0; m < 4; ++m) { float* rowp = C + (size_t)(row0 + ai * HALF + m * 16) * ldc + col0;
#pragma unroll
                for (int bj = 0; bj < 2; ++bj)
#pragma unroll
                    for (int n = 0; n < 2; ++n) *(f32x4*)(rowp + bj * HALF + n * 16) = acc[ai][bj][m][n] + bv[bj][n]; }
    }
};
template <int ACT  > struct EpiBf16 {
    static constexpr bool PERM = true, AFTER_DRAIN = false;
    bf16_t* O; int ldc; const float* bias; int split_cols; size_t split_stride;
    __device__ __forceinline__ void operator()(const f32x4 (&acc)[2][2][4][2], const Unit& u, int wr, int wc, int fr, int fq) const {
        const int row0 = u.pm * BM + wr * 64 + fr; int colt = u.pn * BM; bf16_t* base = O;
        if (split_cols) { const int t = colt / split_cols; base += (size_t)t * split_stride; colt -= t * split_cols; }
        const int col0 = colt + wc * 32 + 8 * fq, bcol0 = u.pn * BM + wc * 32 + 8 * fq;
        f32x4 bv[2][2];
#pragma unroll
        for (int bj = 0; bj < 2; ++bj)
#pragma unroll
            for (int n = 0; n < 2; ++n) bv[bj][n] = bias ? *(const f32x4*)(bias + bcol0 + bj * HALF + 4 * n) : (f32x4){0.f, 0.f, 0.f, 0.f};
#pragma unroll
        for (int ai = 0; ai < 2; ++ai)
#pragma unroll
            for (int m = 0; m < 4; ++m) { bf16_t* rowp = base + (size_t)(row0 + ai * HALF + m * 16) * ldc + col0;
#pragma unroll
                for (int bj = 0; bj < 2; ++bj) { f32x4 v0 = acc[ai][bj][m][0] + bv[bj][0], v1 = acc[ai][bj][m][1] + bv[bj][1];
                    if (ACT == 1) { f32x2 a = gelu_pk((f32x2){v0[0], v0[1]}), b = gelu_pk((f32x2){v0[2], v0[3]}), c = gelu_pk((f32x2){v1[0], v1[1]}), d = gelu_pk((f32x2){v1[2], v1[3]});
                        v0 = (f32x4){a.x, a.y, b.x, b.y}; v1 = (f32x4){c.x, c.y, d.x, d.y}; }
                    if (ACT == 2) {
#pragma unroll
                        for (int j = 0; j < 4; ++j) { v0[j] = 0.5f * v0[j] * (1.0f + erff(v0[j] * 0.70710678f)); v1[j] = 0.5f * v1[j] * (1.0f + erff(v1[j] * 0.70710678f)); } }
                    u32x4 w; w.x = cvt_pk_bf16(v0[0], v0[1]); w.y = cvt_pk_bf16(v0[2], v0[3]); w.z = cvt_pk_bf16(v1[0], v1[1]); w.w = cvt_pk_bf16(v1[2], v1[3]);
                    *(u32x4*)(rowp + bj * HALF) = w; } }
    }
};

struct PanelStats {
    unsigned* xbuf;
    unsigned* cnt;
    unsigned* tmo;
    int ntn; float eps;
    unsigned code;
    __device__ __forceinline__ bool run(const f32x4 (&v)[2][2][4][2], const Unit& u, int wr, int wc, int fr, int fq, PG8_LAS unsigned char* lds, int wid, int lane) const {
        typedef float f32x2v __attribute__((ext_vector_type(2)));
        PG8_LAS f32x2v* P = (PG8_LAS f32x2v*)lds;
        PG8_LAS f32x2v* S = (PG8_LAS f32x2v*)(lds + 8192);
        PG8_LAS unsigned* flag = (PG8_LAS unsigned*)(lds + 8192 + 2048);
#pragma unroll
        for (int ai = 0; ai < 2; ++ai)
#pragma unroll
            for (int m = 0; m < 4; ++m) {
                float s = 0.f;
#pragma unroll
                for (int bj = 0; bj < 2; ++bj)
#pragma unroll
                    for (int n = 0; n < 2; ++n) { const f32x4 x = v[ai][bj][m][n]; s += (x[0] + x[1]) + (x[2] + x[3]); }
                s += __shfl_xor(s, 16); s += __shfl_xor(s, 32);
                const float mw = s * (1.0f / 64.0f); float q = 0.f;
#pragma unroll
                for (int bj = 0; bj < 2; ++bj)
#pragma unroll
                    for (int n = 0; n < 2; ++n) { const f32x4 d = v[ai][bj][m][n] - mw; q += (d[0] * d[0] + d[1] * d[1]) + (d[2] * d[2] + d[3] * d[3]); }
                q += __shfl_xor(q, 16); q += __shfl_xor(q, 32);
                if (fq == 0) P[(ai * HALF + wr * 64 + m * 16 + fr) * 4 + wc] = (f32x2v){mw, q};
            }
        asm volatile("s_waitcnt lgkmcnt(0)" ::: "memory"); __builtin_amdgcn_s_barrier(); asm volatile("" ::: "memory");
#if defined(BROKEN_NO_WAIT)
        if (blockIdx.x >= 64) { const long long t0 = clock64(); while (clock64() - t0 < 60000) __builtin_amdgcn_s_sleep(8); }
#endif
        const int row = wid * 32 + (lane & 31);
        if (lane < 32) {
            const f32x2v a = P[row * 4 + 0], b = P[row * 4 + 1], c = P[row * 4 + 2], d = P[row * 4 + 3];
            const float mt = (a.x + b.x + c.x + d.x) * 0.25f;
            const float da = a.x - mt, db = b.x - mt, dc = c.x - mt, dd = d.x - mt;
            const float m2 = (a.y + b.y) + (c.y + d.y) + 64.0f * ((da * da + db * db) + (dc * dc + dd * dd));
            unsigned long long* slot = (unsigned long long*)xbuf + ((size_t)(u.pm * BM + row) * 4 + u.pn);
            __hip_atomic_store(slot, ((unsigned long long)__float_as_uint(m2) << 32) | __float_as_uint(mt), __ATOMIC_RELAXED, __HIP_MEMORY_SCOPE_AGENT);
        }
        asm volatile("s_waitcnt vmcnt(0)" ::: "memory");
        if (lane == 0) __hip_atomic_fetch_add(cnt + 64 * u.pm, 1u, __ATOMIC_RELAXED, __HIP_MEMORY_SCOPE_AGENT);
        if (wid == 0) {
            bool dead = false; const unsigned long long t0 = __builtin_amdgcn_s_memrealtime(); const unsigned want = 8u * (unsigned)ntn;
            for (;;) {
#if defined(BROKEN_NO_WAIT)
                break;
#endif
                if ((unsigned)__builtin_amdgcn_readfirstlane(__hip_atomic_load(cnt + 64 * u.pm, __ATOMIC_RELAXED, __HIP_MEMORY_SCOPE_AGENT)) >= want) break;
                if (__builtin_amdgcn_s_memrealtime() - t0 > 2000000ull) {
                    if (lane == 0) { unsigned expect = 0u; __hip_atomic_compare_exchange_strong(tmo + 1, &expect, code | (unsigned)(u.pm & 0xff), __ATOMIC_RELAXED, __ATOMIC_RELAXED, __HIP_MEMORY_SCOPE_AGENT);
                                     __hip_atomic_store(tmo, 1u, __ATOMIC_RELAXED, __HIP_MEMORY_SCOPE_AGENT); }
                    dead = true; break; }
                __builtin_amdgcn_s_sleep(2);
            }
            __builtin_amdgcn_fence(__ATOMIC_ACQUIRE, "agent");
            if (lane == 0) flag[0] = dead ? 1u : 0u;
        }
        asm volatile("s_waitcnt vmcnt(0) lgkmcnt(0)" ::: "memory"); __builtin_amdgcn_s_barrier(); asm volatile("" ::: "memory");
        const bool bad = flag[0] != 0u;
        if (lane < 32) {
            const unsigned long long* slot = (const unsigned long long*)xbuf + (size_t)(u.pm * BM + row) * 4; float mt[4], m2[4]; float ms = 0.f;
#pragma unroll
            for (int t = 0; t < 4; ++t) { if (t < ntn) { const unsigned long long w = __hip_atomic_load(slot + t, __ATOMIC_RELAXED, __HIP_MEMORY_SCOPE_AGENT); mt[t] = __uint_as_float((unsigned)w); m2[t] = __uint_as_float((unsigned)(w >> 32)); } else { mt[t] = 0.f; m2[t] = 0.f; } ms += mt[t]; }
            const float mean = ms / (float)ntn; float q = 0.f;
#pragma unroll
            for (int t = 0; t < 4; ++t) if (t < ntn) { const float dm = mt[t] - mean; q += m2[t] + 256.0f * dm * dm; }
            S[row] = (f32x2v){mean, 1.0f / sqrtf(q / (256.0f * (float)ntn) + eps)};
        }
        asm volatile("s_waitcnt lgkmcnt(0)" ::: "memory"); __builtin_amdgcn_s_barrier(); asm volatile("" ::: "memory");
        return bad;
    }
};
struct EpiLnRes {
    static constexpr bool PERM = false, AFTER_DRAIN = true;
    const float* base; float* out; int ldc; const float* bias; PanelStats st; unsigned poison;
    __device__ __forceinline__ void refuse(size_t i0, size_t stride, int M, int N) const { const float q = __builtin_nanf(""); for (size_t i = i0; i < (size_t)M * N; i += stride) out[(i / N) * ldc + i % N] = q;
        if (i0 == 0) { unsigned expect = 0u; __hip_atomic_compare_exchange_strong(st.tmo + 1, &expect, 0x7f0u, __ATOMIC_RELAXED, __ATOMIC_RELAXED, __HIP_MEMORY_SCOPE_AGENT); __hip_atomic_store(st.tmo, 1u, __ATOMIC_RELAXED, __HIP_MEMORY_SCOPE_AGENT); } }
    __device__ __forceinline__ void fused(f32x4 (&acc)[2][2][4][2], const Unit& u, int wr, int wc, int fr, int fq, PG8_LAS unsigned char* lds, int wid, int lane) const {
        typedef float f32x2v __attribute__((ext_vector_type(2)));
        const PG8_LAS f32x2v* S = (const PG8_LAS f32x2v*)(lds + 8192);
        const int col0 = u.pn * BM + wc * 32 + 4 * fq;
#pragma unroll
        for (int bj = 0; bj < 2; ++bj)
#pragma unroll
            for (int n = 0; n < 2; ++n) { const f32x4 bv = bias ? *(const f32x4*)(bias + col0 + bj * HALF + n * 16) : (f32x4){0.f, 0.f, 0.f, 0.f};
#pragma unroll
                for (int ai = 0; ai < 2; ++ai)
#pragma unroll
                    for (int m = 0; m < 4; ++m) acc[ai][bj][m][n] += bv; }
        const bool bad = st.run(acc, u, wr, wc, fr, fq, lds, wid, lane) || poison != 0u;
        const float qnan = __builtin_nanf("");
#pragma unroll
        for (int ai = 0; ai < 2; ++ai)
#pragma unroll
            for (int m = 0; m < 4; ++m) { const int r = ai * HALF + wr * 64 + m * 16 + fr; const f32x2v sr = S[r]; const size_t off = (size_t)(u.pm * BM + r) * ldc + col0;
#pragma unroll
                for (int bj = 0; bj < 2; ++bj)
#pragma unroll
                    for (int n = 0; n < 2; ++n) { const f32x4 bs = *(const f32x4*)(base + off + bj * HALF + n * 16); f32x4 o = bs + (acc[ai][bj][m][n] - sr.x) * sr.y;
                        if (bad) o = (f32x4){qnan, qnan, qnan, qnan}; *(f32x4*)(out + off + bj * HALF + n * 16) = o; }
                asm volatile("" ::: "memory"); }
    }
};
struct EpiLnResLn {
    static constexpr bool PERM = false, AFTER_DRAIN = true;
    const float* base; float* out; bf16_t* xn; int ldc; const float* bias; PanelStats st1, st2; unsigned poison;
    __device__ __forceinline__ void refuse(size_t i0, size_t stride, int M, int N) const { const float q = __builtin_nanf(""); for (size_t i = i0; i < (size_t)M * N; i += stride) { const size_t o = (i / N) * ldc + i % N; out[o] = q; xn[o] = (bf16_t)0x7fc0u; }
        if (i0 == 0) { unsigned expect = 0u; __hip_atomic_compare_exchange_strong(st1.tmo + 1, &expect, 0x7f0u, __ATOMIC_RELAXED, __ATOMIC_RELAXED, __HIP_MEMORY_SCOPE_AGENT); __hip_atomic_store(st1.tmo, 1u, __ATOMIC_RELAXED, __HIP_MEMORY_SCOPE_AGENT); } }
    __device__ __forceinline__ void fused(f32x4 (&acc)[2][2][4][2], const Unit& u, int wr, int wc, int fr, int fq, PG8_LAS unsigned char* lds, int wid, int lane) const {
        typedef float f32x2v __attribute__((ext_vector_type(2))); typedef unsigned u32x2v __attribute__((ext_vector_type(2)));
        const PG8_LAS f32x2v* S = (const PG8_LAS f32x2v*)(lds + 8192);
        const int col0 = u.pn * BM + wc * 32 + 4 * fq;
#pragma unroll
        for (int bj = 0; bj < 2; ++bj)
#pragma unroll
            for (int n = 0; n < 2; ++n) { const f32x4 bv = bias ? *(const f32x4*)(bias + col0 + bj * HALF + n * 16) : (f32x4){0.f, 0.f, 0.f, 0.f};
#pragma unroll
                for (int ai = 0; ai < 2; ++ai)
#pragma unroll
                    for (int m = 0; m < 4; ++m) acc[ai][bj][m][n] += bv; }
        bool bad = st1.run(acc, u, wr, wc, fr, fq, lds, wid, lane) || poison != 0u;
        const float qnan = __builtin_nanf("");
#pragma unroll
        for (int ai = 0; ai < 2; ++ai)
#pragma unroll
            for (int m = 0; m < 4; ++m) { const int r = ai * HALF + wr * 64 + m * 16 + fr; const f32x2v sr = S[r]; const size_t off = (size_t)(u.pm * BM + r) * ldc + col0;
#pragma unroll
                for (int bj = 0; bj < 2; ++bj)
#pragma unroll
                    for (int n = 0; n < 2; ++n) { const f32x4 bs = *(const f32x4*)(base + off + bj * HALF + n * 16); acc[ai][bj][m][n] = bs + (acc[ai][bj][m][n] - sr.x) * sr.y; }
                asm volatile("" : "+v"(acc[ai][0][m][0]), "+v"(acc[ai][0][m][1]), "+v"(acc[ai][1][m][0]), "+v"(acc[ai][1][m][1]));
                if (m & 1) asm volatile("" ::: "memory"); }
        const bool bad1 = bad;
        bad = st2.run(acc, u, wr, wc, fr, fq, lds, wid, lane) || bad;
#pragma unroll
        for (int ai = 0; ai < 2; ++ai)
#pragma unroll
            for (int m = 0; m < 4; ++m) { const int r = ai * HALF + wr * 64 + m * 16 + fr; const f32x2v sr = S[r]; const size_t off = (size_t)(u.pm * BM + r) * ldc + col0;
#pragma unroll
                for (int bj = 0; bj < 2; ++bj)
#pragma unroll
                    for (int n = 0; n < 2; ++n) { const f32x4 x1 = acc[ai][bj][m][n]; *(f32x4*)(out + off + bj * HALF + n * 16) = bad1 ? (f32x4){qnan, qnan, qnan, qnan} : x1;
                        const f32x4 o = (x1 - sr.x) * sr.y; u32x2v w; w.x = cvt_pk_bf16(o[0], o[1]); w.y = cvt_pk_bf16(o[2], o[3]);
                        if (bad) { w.x = 0x7fc07fc0u; w.y = 0x7fc07fc0u; } *(u32x2v*)(xn + off + bj * HALF + n * 16) = w; }
                asm volatile("" ::: "memory"); }
    }
};

template <class Epi, class Sched, bool STAMP = false>
__device__ __forceinline__ void gemm_phase(PG8_LAS unsigned char* lds, const Gemm g, const Sched& S, const Epi& E, unsigned long long* stamps) {
    const int tid = threadIdx.x, wid = __builtin_amdgcn_readfirstlane(tid >> 6), lane = tid & 63, wr = wid >> 2, wc = wid & 3, fr = lane & 15, fq = lane >> 4;
    const int K = g.K, nt = K / BK;
    int ts_lo = 0, ts_hi = 0, nts = 0; const unsigned long long rt_entry = STAMP ? (unsigned long long)wall_clock64() : 0ull;
#define PG8_STAMP() do { if (STAMP && wid == 0 && nts < 64) { const unsigned long long _c = (unsigned long long)clock64(); \
        ts_lo = (lane == nts) ? (int)(unsigned)_c : ts_lo; ts_hi = (lane == nts) ? (int)(unsigned)(_c >> 32) : ts_hi; ++nts; } } while (0)
    PG8_STAMP();
    unsigned voffA[2], voffB[2];
#pragma unroll
    for (int i = 0; i < 2; ++i) { int R, C; stage_rc(tid * 16 + i * 8192, R, C); const int Rb = Epi::PERM ? ((R & ~31) + perm32(R & 31)) : R;
        voffA[i] = (unsigned)(R * K + C) * 2u; voffB[i] = (unsigned)(Rb * K + C) * 2u; }
    const size_t kstep = (size_t)(BK * 2);
    const size_t hstep = (size_t)HALF * K * 2;
    const size_t tstep = 2 * hstep;
    const unsigned ldsw = (unsigned)wid * 1024u;
    const int aoff = lds_byte(wr * 64 + fr, fq * 8), boff = lds_byte(wc * 32 + fr, fq * 8);
#define PG8_SA(b, h) (((b) * 2 + (h)) * HTB)
#define PG8_SB(b, h) ((4 + (b) * 2 + (h)) * HTB)
#define PG8_STAGE(bufoff, gbase, voff) do { _Pragma("unroll") for (int _i = 0; _i < 2; ++_i) \
        __builtin_amdgcn_global_load_lds((const unsigned*)((const char*)(gbase) + (voff)[_i]), (PG8_LAS unsigned*)(lds + (bufoff) + ldsw + _i * 8192), 16, 0, 0); } while (0)
#define PG8_LDA(dst, b, h) do { _Pragma("unroll") for (int m = 0; m < 4; ++m) _Pragma("unroll") for (int k = 0; k < 2; ++k) dst[m][k] = *(const PG8_LAS bf16x8*)(lds + PG8_SA(b, h) + aoff + m * 2048 + k * 1024); } while (0)
#define PG8_LDB(dst, b, h) do { _Pragma("unroll") for (int n = 0; n < 2; ++n) _Pragma("unroll") for (int k = 0; k < 2; ++k) dst[n][k] = *(const PG8_LAS bf16x8*)(lds + PG8_SB(b, h) + boff + n * 2048 + k * 1024); } while (0)
#define PG8_MMA(ai, bj, At, Bt) do { __builtin_amdgcn_s_setprio(1); _Pragma("unroll") for (int m = 0; m < 4; ++m) _Pragma("unroll") for (int n = 0; n < 2; ++n) _Pragma("unroll") for (int k = 0; k < 2; ++k) \
        acc[ai][bj][m][n] = __builtin_amdgcn_mfma_f32_16x16x32_bf16(Bt[n][k], At[m][k], acc[ai][bj][m][n], 0, 0, 0); __builtin_amdgcn_s_setprio(0); } while (0)
#define PG8_WAIT_V(n) asm volatile("s_waitcnt vmcnt(" #n ")" ::: "memory")
#define PG8_WAIT_L(n) asm volatile("s_waitcnt lgkmcnt(" #n ")" ::: "memory")
#define PG8_BAR __builtin_amdgcn_s_barrier()
#define PG8_SCHED __builtin_amdgcn_sched_barrier(0)
    Unit cur, nxt; int ui = 0;
    if (!S.next(0, cur)) return;
    f32x4 acc[2][2][4][2];
#pragma unroll
    for (int a = 0; a < 2; ++a)
#pragma unroll
        for (int b = 0; b < 2; ++b)
#pragma unroll
            for (int m = 0; m < 4; ++m)
#pragma unroll
                for (int n = 0; n < 2; ++n) acc[a][b][m][n] = (f32x4){0.f, 0.f, 0.f, 0.f};
    bf16x8 At[4][2], B0[2][2], B1[2][2];
    const char* cA = (const char*)g.A + (size_t)cur.pm * tstep; const char* cB = (const char*)g.Bt + (size_t)cur.pn * tstep;
    S.a_ready(cur);
    PG8_STAGE(PG8_SB(0, 0), cB, voffB); PG8_STAGE(PG8_SA(0, 0), cA, voffA); PG8_STAGE(PG8_SB(0, 1), cB + hstep, voffB); PG8_STAGE(PG8_SA(0, 1), cA + hstep, voffA);
    if (wr == 1) PG8_BAR;
    PG8_WAIT_V(4); PG8_BAR;
    PG8_STAGE(PG8_SB(1, 0), cB + kstep, voffB); PG8_STAGE(PG8_SA(1, 0), cA + kstep, voffA); PG8_STAGE(PG8_SB(1, 1), cB + hstep + kstep, voffB);
    PG8_WAIT_V(6); PG8_BAR;
    PG8_STAMP();
    for (;;) {
        const bool has_next = S.next(ui + 1, nxt);
        const char* nA = has_next ? (const char*)g.A + (size_t)nxt.pm * tstep : cA; const char* nB = has_next ? (const char*)g.Bt + (size_t)nxt.pn * tstep : cB;
        for (int t = 0; t < nt; t += 2) {
            const bool last = (t == nt - 2);
            const char* a1 = cA + (size_t)(t + 1) * kstep;
            const char* a2 = last ? nA : cA + (size_t)(t + 2) * kstep; const char* b2 = last ? nB : cB + (size_t)(t + 2) * kstep;
            const char* a3 = a2 + kstep; const char* b3 = b2 + kstep;
            if (last && has_next) S.a_ready(nxt);
            PG8_LDB(B0, 0, 0); PG8_SCHED; PG8_LDA(At, 0, 0); PG8_STAGE(PG8_SA(1, 1), a1 + hstep, voffA);
            PG8_WAIT_L(8); PG8_BAR; PG8_WAIT_L(0); PG8_MMA(0, 0, At, B0); PG8_BAR; PG8_SCHED;
            PG8_LDB(B1, 0, 1); PG8_STAGE(PG8_SB(0, 0), b2, voffB);
            PG8_BAR; PG8_WAIT_L(0); PG8_MMA(0, 1, At, B1); PG8_BAR;
            PG8_LDA(At, 0, 1); PG8_STAGE(PG8_SA(0, 0), a2, voffA);
            PG8_BAR; PG8_WAIT_L(0); PG8_MMA(1, 0, At, B0); PG8_BAR; PG8_SCHED;
            PG8_STAGE(PG8_SB(0, 1), b2 + hstep, voffB);
            PG8_WAIT_V(6); PG8_BAR; PG8_MMA(1, 1, At, B1); PG8_BAR;
            PG8_LDB(B0, 1, 0); PG8_SCHED; PG8_LDA(At, 1, 0); PG8_STAGE(PG8_SA(0, 1), a2 + hstep, voffA);
            PG8_WAIT_L(8); PG8_BAR; PG8_WAIT_L(0); PG8_MMA(0, 0, At, B0); PG8_BAR; PG8_SCHED;
            PG8_LDB(B1, 1, 1); PG8_STAGE(PG8_SB(1, 0), b3, voffB);
            PG8_BAR; PG8_WAIT_L(0); PG8_MMA(0, 1, At, B1); PG8_BAR;
            PG8_LDA(At, 1, 1); PG8_STAGE(PG8_SA(1, 0), a3, voffA);
            PG8_BAR; PG8_WAIT_L(0); PG8_MMA(1, 0, At, B0); PG8_BAR; PG8_SCHED;
            PG8_STAGE(PG8_SB(1, 1), b3 + hstep, voffB);
            PG8_WAIT_V(6); PG8_BAR; PG8_MMA(1, 1, At, B1); PG8_BAR;
        }
        PG8_STAMP();
        if constexpr (!Epi::AFTER_DRAIN) { E(acc, cur, wr, wc, fr, fq); S.done(cur); }
        PG8_STAMP();
        if (!has_next) break;
#pragma unroll
        for (int a = 0; a < 2; ++a)
#pragma unroll
            for (int b = 0; b < 2; ++b)
#pragma unroll
                for (int m = 0; m < 4; ++m)
#pragma unroll
                    for (int n = 0; n < 2; ++n) acc[a][b][m][n] = (f32x4){0.f, 0.f, 0.f, 0.f};
        cur = nxt; cA = nA; cB = nB; ++ui;
    }
    PG8_WAIT_V(0);
    if (wr == 0) PG8_BAR;
    PG8_BAR;
    if constexpr (Epi::AFTER_DRAIN) { E.fused(acc, cur, wr, wc, fr, fq, lds, wid, lane); S.done(cur); }
    PG8_STAMP();
    if (STAMP && wid == 0) { stamps[lane] = lane < nts ? (((unsigned long long)(unsigned)ts_hi << 32) | (unsigned)ts_lo) : 0ull;
        if (lane == 62) stamps[62] = rt_entry; if (lane == 63) stamps[63] = (unsigned long long)wall_clock64(); }
#undef PG8_STAMP
#undef PG8_SA
#undef PG8_SB
#undef PG8_STAGE
#undef PG8_LDA
#undef PG8_LDB
#undef PG8_MMA
#undef PG8_WAIT_V
#undef PG8_WAIT_L
#undef PG8_BAR
#undef PG8_SCHED
}
}

constexpr int D = 1024, NB = 16, S = 2048, T = NB * S;
constexpr int NCOL = 2840, NPAD = 3072;
constexpr int C_Q = 0, C_KC = 512, C_VC = 640, C_KS = 768, C_VS = 896, C_KW = 1024, C_VW = 1152, C_GT = 1280, C_CB = 1304, C_CC = 1816, C_CH = 2328;
constexpr int NCMP = 127;
constexpr int NEXP = 16384;
constexpr float EPS = 1e-6f;
constexpr int NTHREADS = 512, NWAVES = 8;

constexpr size_t al256(size_t x) { return (x + 255) & ~(size_t)255; }
constexpr size_t WS_CTL   = 0;                                   constexpr size_t CTL_BYTES = 65536;
constexpr size_t WS_MOD   = WS_CTL + CTL_BYTES;
constexpr size_t WS_WIN   = al256(WS_MOD + (size_t)16 * 6144 * 4);
constexpr size_t WS_WOUT  = al256(WS_WIN + (size_t)NPAD * D * 2);
constexpr size_t WS_WQ    = al256(WS_WOUT + (size_t)D * D * 2);
constexpr size_t WS_KEYS  = al256(WS_WQ + (size_t)D * D * 2);
constexpr size_t WS_U8S   = al256(WS_KEYS + (size_t)16 * 128 * 64 * 2);
constexpr size_t WS_V8S   = al256(WS_U8S + (size_t)NEXP * D);
constexpr size_t WS_X8S   = al256(WS_V8S + (size_t)NEXP * D);
constexpr size_t WS_SU    = al256(WS_X8S + (size_t)T * D);
constexpr size_t WS_SV    = al256(WS_SU + (size_t)NEXP * 4);
constexpr size_t WS_SX    = al256(WS_SV + (size_t)NEXP * 4);
constexpr size_t WS_W1T   = al256(WS_SX + (size_t)T * 4);
constexpr size_t WS_W2T   = al256(WS_W1T + (size_t)2 * 64 * 2048 * 2);
constexpr size_t WS_PEC   = al256(WS_W2T + (size_t)2 * 64 * 64 * 2);
constexpr size_t WS_KC    = al256(WS_PEC + (size_t)2 * 64 * 4);
constexpr size_t WS_VC    = al256(WS_KC + (size_t)16 * 2 * 128 * 64 * 2);
constexpr size_t WS_H     = al256(WS_VC + (size_t)16 * 2 * 128 * 64 * 2);
constexpr size_t WS_CS    = WS_H;
constexpr size_t WS_CSUM  = WS_H + (size_t)32 * 1024 * 1024;
constexpr size_t WS_SSQP  = WS_H + (size_t)33 * 1024 * 1024;
constexpr size_t WS_OATT  = al256(WS_H + (size_t)T * D * 2);
constexpr size_t WS_PROJ  = al256(WS_OATT + (size_t)T * 512 * 2);
constexpr size_t WS_QP    = WS_PROJ;
constexpr size_t WS_PART  = WS_PROJ;
constexpr size_t WS_X2    = WS_PROJ;
constexpr size_t WS_EIDX  = WS_PROJ + (size_t)160 * 1024 * 1024;
constexpr size_t WS_EW    = WS_EIDX + (size_t)T * 128 * 4;
constexpr size_t WS_END   = al256(WS_PROJ + (size_t)T * NPAD * 2);
static_assert(WS_EW + (size_t)T * 128 * 4 <= WS_END, "alias region");
static_assert((size_t)8 * T * 128 * 4 <= (size_t)160 * 1024 * 1024, "PART fits under EIDX");
constexpr int CTL_CTR_A = 16384, CTL_CTR_B = 16384 + 8 * 256;

constexpr int LDS_STAGE = 147456;
constexpr int LDS_MISC_OFF = LDS_STAGE;
constexpr int LDS_BYTES = LDS_STAGE + 256;

typedef unsigned short bf16_t;
typedef short bf16x8 __attribute__((ext_vector_type(8)));
typedef short s16x4 __attribute__((ext_vector_type(4)));
typedef float f32x4 __attribute__((ext_vector_type(4)));
typedef unsigned u32x4v __attribute__((ext_vector_type(4)));
__device__ __forceinline__ float bf2f(bf16_t b) { return __uint_as_float(((unsigned)b) << 16); }
__device__ __forceinline__ bf16_t f2bf(float f) { unsigned u = __float_as_uint(f); u += 0x7FFFu + ((u >> 16) & 1u); return (bf16_t)(u >> 16); }
__device__ __forceinline__ float bflo(unsigned w) { return __uint_as_float(w << 16); }
__device__ __forceinline__ float bfhi(unsigned w) { return __uint_as_float(w & 0xFFFF0000u); }
__device__ __forceinline__ unsigned pack2(float lo, float hi) { return (unsigned)f2bf(lo) | ((unsigned)f2bf(hi) << 16); }
__device__ __forceinline__ float gelu_tanh(float x) { const float u = 0.7978845608028654f * (x + 0.044715f * x * x * x); return 0.5f * x * (1.0f + tanhf(u)); }
__device__ __forceinline__ float sigmoidf_(float x) { return 1.0f / (1.0f + __expf(-x)); }
__device__ __forceinline__ float wave_sum(float v) {
#pragma unroll
    for (int o = 32; o >= 1; o >>= 1) v += __shfl_xor(v, o);
    return v; }
__device__ __forceinline__ float wave_max(float v) {
#pragma unroll
    for (int o = 32; o >= 1; o >>= 1) v = fmaxf(v, __shfl_xor(v, o));
    return v; }
__device__ __forceinline__ void lds_wave_sync() { asm volatile("s_waitcnt lgkmcnt(0)" ::: "memory"); }
__device__ __forceinline__ int rel_bucket(int dist) {
    const int n = dist > 0 ? dist : 0;
    if (n < 16) return n;
    const float lr = logf((float)n / 16.0f) / 2.0794415416798357f;
    const int large = 16 + (int)(lr * 16.0f);
    return large < 31 ? large : 31;
}

struct Frame {
    const float* in[23]; float* out; unsigned char* ws;
    LAS unsigned char* lds; int tid, lane, wave, G;
};


typedef int i32x4v __attribute__((ext_vector_type(4)));
constexpr int PEER_CHUNK_TOK = 128, PEER_NCHUNK = T / PEER_CHUNK_TOK;

__device__ __forceinline__ void quant_row_sliced(const float* row, unsigned char* dst8  , size_t nrows, size_t r, float* scale_out, int bias, int lane) {
    float4 v[4]; float am = 0.f;
#pragma unroll
    for (int i = 0; i < 4; ++i) { v[i] = *(const float4*)(row + (lane + 64 * i) * 4); am = fmaxf(am, fmaxf(fmaxf(fabsf(v[i].x), fabsf(v[i].y)), fmaxf(fabsf(v[i].z), fabsf(v[i].w)))); }
    am = wave_max(am); const float inv = am > 0.f ? 127.0f / am : 0.f;
    if (lane == 0) *scale_out = am > 0.f ? am / 127.0f : 0.f;
#pragma unroll
    for (int i = 0; i < 4; ++i) { const int col = (lane + 64 * i) * 4; const int sl = col >> 7, off = col & 127;
        const int q0 = (int)rintf(v[i].x * inv) + bias, q1 = (int)rintf(v[i].y * inv) + bias, q2 = (int)rintf(v[i].z * inv) + bias, q3 = (int)rintf(v[i].w * inv) + bias;
        *(unsigned*)(dst8 + ((size_t)sl * nrows + r) * 128 + off) = (unsigned)(q0 & 0xFF) | ((unsigned)(q1 & 0xFF) << 8) | ((unsigned)(q2 & 0xFF) << 16) | ((unsigned)(q3 & 0xFF) << 24); }
}

__device__ __forceinline__ int grab_chunk(const Frame& F, unsigned* ctr, int slice) {
    LAS int* bc = (LAS int*)(F.lds + LDS_MISC_OFF + 64);
    __syncthreads();
    if (F.tid == 0) *bc = (int)__hip_atomic_fetch_add(ctr + slice * 64, 1u, __ATOMIC_RELAXED, __HIP_MEMORY_SCOPE_AGENT);
    __syncthreads();
    return *bc;
}

__device__ __forceinline__ void stage_chunk_lists(const Frame& F, const int* eidx_chunk, const float* cs_chunk) {
#pragma unroll
    for (int i = 0; i < 8; ++i) { const int q = F.tid + 512 * i; *(LAS i32x4v*)(F.lds + q * 16) = *(const i32x4v*)(eidx_chunk + q * 4);
        if (cs_chunk) *(LAS f32x4*)(F.lds + 65536 + q * 16) = *(const f32x4*)(cs_chunk + q * 4); }
    __syncthreads();
}
__device__ __forceinline__ void gather_rows16(u32x4v (&vv)[16], const unsigned char* base, const LAS int* le) {
    i32x4v ev[4];
#pragma unroll
    for (int q = 0; q < 4; ++q) ev[q] = *(const LAS i32x4v*)(le + 4 * q);
#pragma unroll
    for (int ld = 0; ld < 16; ++ld) vv[ld] = *(const u32x4v*)(base + (size_t)ev[ld >> 2][ld & 3] * 128);
}
__device__ __forceinline__ void udot_item(const u32x4v (&uv)[16], const i32x4v xq, int* part_row  , int c) {
    i32x4v res[4];
#pragma unroll
    for (int ld = 0; ld < 16; ++ld) { int p = __builtin_amdgcn_sdot4((int)uv[ld][0], xq[0], 0, false); p = __builtin_amdgcn_sdot4((int)uv[ld][1], xq[1], p, false);
        p = __builtin_amdgcn_sdot4((int)uv[ld][2], xq[2], p, false); p = __builtin_amdgcn_sdot4((int)uv[ld][3], xq[3], p, false);
        p += __shfl_xor(p, 1); p += __shfl_xor(p, 2); p += __shfl_xor(p, 4); res[ld >> 2][ld & 3] = p; }
    if (c == 0) {
#pragma unroll
        for (int q = 0; q < 4; ++q) *(i32x4v*)(part_row + 4 * q) = res[q]; }
}
__device__ __forceinline__ void p10a_udots(const Frame& F) {
    const unsigned char* U8S = F.ws + WS_U8S; const unsigned char* X8S = F.ws + WS_X8S; const int* EIDX = (const int*)(F.ws + WS_EIDX); int* PART = (int*)(F.ws + WS_PART);
    unsigned* ctr = (unsigned*)(F.ws + WS_CTL + CTL_CTR_A);
    const int lane = F.lane, j = lane >> 3, c = lane & 7; const int xcc = (int)(xb_xcc_id() & 7u);
    for (int so = 0; so < 8; ++so) { const int x = (xcc + so) & 7;
        for (;;) { const int chunk = grab_chunk(F, ctr, x); if (chunk >= PEER_NCHUNK) break;
            stage_chunk_lists(F, EIDX + (size_t)chunk * PEER_CHUNK_TOK * 128, nullptr);
            const unsigned char* ub = U8S + (size_t)x * NEXP * 128 + c * 16;
            const int tl0 = F.wave * 16; const int t0 = chunk * PEER_CHUNK_TOK + tl0;
            const LAS int* le = (const LAS int*)F.lds + tl0 * 128 + 16 * j;
            const unsigned char* xb = X8S + ((size_t)x * T + t0) * 128 + c * 16; int* pr = PART + ((size_t)x * T + t0) * 128 + 16 * j;
            u32x4v va[16], vb[16];
            gather_rows16(va, ub, le);
#pragma unroll 1
            for (int tt = 0; tt < 16; tt += 2) {
                const i32x4v xqa = *(const i32x4v*)(xb + (size_t)tt * 128), xqb = *(const i32x4v*)(xb + (size_t)(tt + 1) * 128);
                gather_rows16(vb, ub, le + (tt + 1) * 128);
                udot_item(va, xqa, pr + (size_t)tt * 128, c);
                if (tt + 2 < 16) gather_rows16(va, ub, le + (tt + 2) * 128);
                udot_item(vb, xqb, pr + (size_t)(tt + 1) * 128, c);
            }
        }
    }
}

__device__ __forceinline__ void p10b_coef(const Frame& F) {
    const int* EIDX = (const int*)(F.ws + WS_EIDX); const float* EW = (const float*)(F.ws + WS_EW); const int* PART = (const int*)(F.ws + WS_PART);
    const float* SU = (const float*)(F.ws + WS_SU); const float* SV = (const float*)(F.ws + WS_SV); const float* SX = (const float*)(F.ws + WS_SX);
    float* CS = (float*)(F.ws + WS_CS); float* CSUM = (float*)(F.ws + WS_CSUM);
    const int gw = blockIdx.x * NWAVES + F.wave, nw = F.G * NWAVES, lane = F.lane;
    for (int t = gw; t < T; t += nw) { const float sx = SX[t]; float tot = 0.f;
#pragma unroll
        for (int hh = 0; hh < 2; ++hh) { const int i = lane + 64 * hh; int s = 0;
#pragma unroll
            for (int x = 0; x < 8; ++x) s += PART[((size_t)x * T + t) * 128 + i];
            const int e = EIDX[(size_t)t * 128 + i]; const float dot = (float)s * sx * SU[e];
            const float cs = EW[(size_t)t * 128 + i] * gelu_tanh(dot) * SV[e]; CS[(size_t)t * 128 + i] = cs; tot += cs; }
        tot = wave_sum(tot); if (lane == 0) CSUM[t] = tot; }
}

struct VsumPre { float2 x1, gt; float off; };
__device__ __forceinline__ void vsum_item(const u32x4v (&vv)[16], const LAS float* lc  , const VsumPre& pre, float* x2p, float* ssqp, int lane) {
    f32x4 cv[4];
#pragma unroll
    for (int q = 0; q < 4; ++q) cv[q] = *(const LAS f32x4*)(lc + 4 * q);
    float acc[16];
#pragma unroll
    for (int k = 0; k < 16; ++k) acc[k] = 0.f;
#pragma unroll
    for (int ld = 0; ld < 16; ++ld) { const float cf = cv[ld >> 2][ld & 3];
#pragma unroll
        for (int w = 0; w < 4; ++w) { const unsigned u = vv[ld][w];
            acc[4 * w + 0] += cf * (float)(u & 0xFFu); acc[4 * w + 1] += cf * (float)((u >> 8) & 0xFFu); acc[4 * w + 2] += cf * (float)((u >> 16) & 0xFFu); acc[4 * w + 3] += cf * (float)(u >> 24); } }
    float a8[8], a4[4], a2[2];
    { const bool hi = (lane & 32) != 0;
#pragma unroll
        for (int k = 0; k < 8; ++k) { const float snd = hi ? acc[k] : acc[k + 8]; const float rcv = __shfl_xor(snd, 32); a8[k] = (hi ? acc[k + 8] : acc[k]) + rcv; } }
    { const bool hi = (lane & 16) != 0;
#pragma unroll
        for (int k = 0; k < 4; ++k) { const float snd = hi ? a8[k] : a8[k + 4]; const float rcv = __shfl_xor(snd, 16); a4[k] = (hi ? a8[k + 4] : a8[k]) + rcv; } }
    { const bool hi = (lane & 8) != 0;
#pragma unroll
        for (int k = 0; k < 2; ++k) { const float snd = hi ? a4[k] : a4[k + 2]; const float rcv = __shfl_xor(snd, 8); a2[k] = (hi ? a4[k + 2] : a4[k]) + rcv; } }
    const float y0 = pre.x1.x + pre.gt.x * (a2[0] - pre.off), y1 = pre.x1.y + pre.gt.y * (a2[1] - pre.off);
    *(float2*)x2p = make_float2(y0, y1);
    const float ss = wave_sum(y0 * y0 + y1 * y1); if (lane == 0) *ssqp = ss;
}
__device__ __forceinline__ void p10c_vsum(const Frame& F) {
    const unsigned char* V8S = F.ws + WS_V8S; const int* EIDX = (const int*)(F.ws + WS_EIDX); const float* CS = (const float*)(F.ws + WS_CS); const float* CSUM = (const float*)(F.ws + WS_CSUM);
    const float* MOD = (const float*)(F.ws + WS_MOD); float* SSQP = (float*)(F.ws + WS_SSQP); const float* x1 = F.out; float* X2 = (float*)(F.ws + WS_X2);
    unsigned* ctr = (unsigned*)(F.ws + WS_CTL + CTL_CTR_B);
    const int lane = F.lane, j = lane >> 3, c = lane & 7; const int xcc = (int)(xb_xcc_id() & 7u);
    const int ocol = 16 * c + 8 * ((lane >> 5) & 1) + 4 * ((lane >> 4) & 1) + 2 * ((lane >> 3) & 1);
    for (int so = 0; so < 8; ++so) { const int x = (xcc + so) & 7;
        for (;;) { const int chunk = grab_chunk(F, ctr, x); if (chunk >= PEER_NCHUNK) break;
            stage_chunk_lists(F, EIDX + (size_t)chunk * PEER_CHUNK_TOK * 128, CS + (size_t)chunk * PEER_CHUNK_TOK * 128);
            const unsigned char* vb = V8S + (size_t)x * NEXP * 128 + c * 16;
            const int tl0 = F.wave * 16; const int t0 = chunk * PEER_CHUNK_TOK + tl0; const int b = t0 / S;
            const LAS int* le = (const LAS int*)F.lds + tl0 * 128 + 16 * j; const LAS float* lc = (const LAS float*)(F.lds + 65536) + tl0 * 128 + 16 * j;
            const int col = x * 128 + ocol; const float2 gt = *(const float2*)(MOD + b * 6144 + 5120 + col);
            u32x4v va[16], vbb[16];
            gather_rows16(va, vb, le);
#pragma unroll 1
            for (int tt = 0; tt < 16; tt += 2) {
                { VsumPre pa; pa.gt = gt; pa.x1 = *(const float2*)(x1 + (size_t)(t0 + tt) * D + col); pa.off = 128.0f * CSUM[t0 + tt];
                  gather_rows16(vbb, vb, le + (tt + 1) * 128);
                  vsum_item(va, lc + tt * 128, pa, X2 + (size_t)(t0 + tt) * D + col, SSQP + (size_t)(t0 + tt) * 8 + x, lane); }
                { VsumPre pb; pb.gt = gt; pb.x1 = *(const float2*)(x1 + (size_t)(t0 + tt + 1) * D + col); pb.off = 128.0f * CSUM[t0 + tt + 1];
                  if (tt + 2 < 16) gather_rows16(va, vb, le + (tt + 2) * 128);
                  vsum_item(vbb, lc + (tt + 1) * 128, pb, X2 + (size_t)(t0 + tt + 1) * D + col, SSQP + (size_t)(t0 + tt + 1) * 8 + x, lane); }
            }
        }
    }
}

__device__ __forceinline__ void p10d_final(const Frame& F) {
    const float* SSQP = (const float*)(F.ws + WS_SSQP); const float* gfin = F.in[22]; float* out = F.out; const float* X2 = (const float*)(F.ws + WS_X2);
    const int gw = blockIdx.x * NWAVES + F.wave, nw = F.G * NWAVES, lane = F.lane;
    for (int t = gw; t < T; t += nw) {
        float ss = 0.f;
#pragma unroll
        for (int x = 0; x < 8; ++x) ss += SSQP[(size_t)t * 8 + x];
        const float rstd = rsqrtf(ss * (1.0f / D) + EPS);
#pragma unroll
        for (int i = 0; i < 4; ++i) { const int col = (lane + 64 * i) * 4; const float4 v = *(const float4*)(X2 + (size_t)t * D + col), gg = *(const float4*)(gfin + col);
            *(float4*)(out + (size_t)t * D + col) = make_float4(v.x * rstd * gg.x, v.y * rstd * gg.y, v.z * rstd * gg.z, v.w * rstd * gg.w); }
    }
}

__device__ __forceinline__ void transpose_tile(const Frame& F, const float* src, int srcK, int srcN, bf16_t* dst, int dstK, int kt, int nt) {
    LAS float* tile = (LAS float*)F.lds;
    const int k0 = kt * 64, n0 = nt * 64;
    for (int i = F.tid; i < 4096; i += NTHREADS) { const int r = i >> 6, c = i & 63; const int k = k0 + r, n = n0 + c;
        tile[r * 65 + c] = (k < srcK && n < srcN) ? src[(size_t)k * srcN + n] : 0.0f; }
    __syncthreads();
    for (int i = F.tid; i < 4096; i += NTHREADS) { const int r = i >> 6, c = i & 63;
        dst[(size_t)(n0 + r) * dstK + k0 + c] = f2bf(tile[c * 65 + r]); }
    __syncthreads();
}
__device__ __forceinline__ void p0_prologue(const Frame& F) {
    const float* c = F.in[1]; const float* w_mod = F.in[4]; const float* b_mod = F.in[5];
    float* MOD = (float*)(F.ws + WS_MOD);
    constexpr int I_MOD = 192, I_WIN = 16 * 48, I_WOUT = 256, I_WQ = 256, I_U = 256, I_V = 256, I_KEYS = 2, I_CMP = 32 + 32 + 1 + 1 + 2;
    constexpr int O_WIN = I_MOD, O_WOUT = O_WIN + I_WIN, O_WQ = O_WOUT + I_WOUT, O_U = O_WQ + I_WQ, O_V = O_U + I_U, O_KEYS = O_V + I_V, O_CMP = O_KEYS + I_KEYS, N_ITEMS = O_CMP + I_CMP;
    for (int it = blockIdx.x; it < N_ITEMS; it += F.G) {
        if (it < O_WIN) {
            const int idx = it * NTHREADS + F.tid; const int b = idx / 6144, j = idx % 6144;
            float acc = 0.f;
            for (int k = 0; k < D; ++k) { const float cv = c[b * D + k]; const float sv = cv / (1.0f + __expf(-cv)); acc += sv * w_mod[(size_t)k * 6144 + j]; }
            MOD[b * 6144 + j] = acc + b_mod[j];
        } else if (it < O_WOUT) { const int i = it - O_WIN; transpose_tile(F, F.in[6], D, NCOL, (bf16_t*)(F.ws + WS_WIN), D, i % 16, i / 16); }
        else if (it < O_WQ) { const int i = it - O_WOUT; transpose_tile(F, F.in[16], D, D, (bf16_t*)(F.ws + WS_WOUT), D, i % 16, i / 16); }
        else if (it < O_U) { const int i = it - O_WQ; transpose_tile(F, F.in[17], D, D, (bf16_t*)(F.ws + WS_WQ), D, i % 16, i / 16); }
        else if (it < O_KEYS) {
            const bool isv = it >= O_V; const int i = isv ? it - O_V : it - O_U;
            for (int rr = 0; rr < 8; ++rr) { const size_t r = (size_t)i * 64 + rr * 8 + F.wave;
                quant_row_sliced((isv ? F.in[20] : F.in[19]) + r * D, F.ws + (isv ? WS_V8S : WS_U8S), NEXP, r, (float*)(F.ws + (isv ? WS_SV : WS_SU)) + r, isv ? 128 : 0, F.lane); }
        } else if (it >= O_CMP) {
            const int i = it - O_CMP;
            if (i < 64) { const int kv = i >> 5; transpose_tile(F, kv ? F.in[11] : F.in[9], 2048, 64, (bf16_t*)(F.ws + WS_W1T) + (size_t)kv * 64 * 2048, 2048, i & 31, 0); }
            else if (i < 66) { const int kv = i - 64; transpose_tile(F, kv ? F.in[12] : F.in[10], 64, 64, (bf16_t*)(F.ws + WS_W2T) + (size_t)kv * 64 * 64, 64, 0, 0); }
            else { const int kv = i - 66; const float* pe = kv ? F.in[8] : F.in[7]; const float* w1 = kv ? F.in[11] : F.in[9];
                if (F.tid < 64) { float a = 0.f; for (int k = 0; k < 2048; ++k) a += pe[k] * w1[(size_t)k * 64 + F.tid]; ((float*)(F.ws + WS_PEC))[kv * 64 + F.tid] = a; } }
        } else {
            const int i = it - O_KEYS; const float4* src = (const float4*)F.in[18] + (size_t)i * 16384; uint2* dst = (uint2*)(F.ws + WS_KEYS) + (size_t)i * 16384;
            for (int q = F.tid; q < 16384; q += NTHREADS) { const float4 v = src[q]; dst[q] = make_uint2(pack2(v.x, v.y), pack2(v.z, v.w)); }
        }
    }
}

__device__ __forceinline__ void norm_mod_rows(const Frame& F, const float* x, const float* g, int sh_off, int sc_off, bf16_t* dst) {
    const float* MOD = (const float*)(F.ws + WS_MOD);
    const int gw = blockIdx.x * NWAVES + F.wave, nw = F.G * NWAVES;
    for (int t = gw; t < T; t += nw) {
        const int b = t / S; const float4* xr = (const float4*)(x + (size_t)t * D);
        float4 v[4]; float ss = 0.f;
#pragma unroll
        for (int i = 0; i < 4; ++i) { v[i] = xr[F.lane + 64 * i]; ss += v[i].x * v[i].x + v[i].y * v[i].y + v[i].z * v[i].z + v[i].w * v[i].w; }
        ss = wave_sum(ss); const float rstd = rsqrtf(ss * (1.0f / D) + EPS);
#pragma unroll
        for (int i = 0; i < 4; ++i) { const int col = (F.lane + 64 * i) * 4;
            const float4 gg = *(const float4*)(g + col), sc = *(const float4*)(MOD + b * 6144 + sc_off + col), sh = *(const float4*)(MOD + b * 6144 + sh_off + col);
            const float o0 = v[i].x * rstd * gg.x * (1.f + sc.x) + sh.x, o1 = v[i].y * rstd * gg.y * (1.f + sc.y) + sh.y, o2 = v[i].z * rstd * gg.z * (1.f + sc.z) + sh.z, o3 = v[i].w * rstd * gg.w * (1.f + sc.w) + sh.w;
            *(uint2*)(dst + (size_t)t * D + col) = make_uint2(pack2(o0, o1), pack2(o2, o3)); }
    }
}

__device__ __forceinline__ void norm_mod_rows_q(const Frame& F, const float* x, const float* g, int sh_off, int sc_off, bf16_t* dst) {
    const float* MOD = (const float*)(F.ws + WS_MOD);
    const int gw = blockIdx.x * NWAVES + F.wave, nw = F.G * NWAVES;
    for (int t = gw; t < T; t += nw) {
        const int b = t / S; const float4* xr = (const float4*)(x + (size_t)t * D);
        float4 v[4]; float ss = 0.f;
#pragma unroll
        for (int i = 0; i < 4; ++i) { v[i] = xr[F.lane + 64 * i]; ss += v[i].x * v[i].x + v[i].y * v[i].y + v[i].z * v[i].z + v[i].w * v[i].w; }
        ss = wave_sum(ss); const float rstd = rsqrtf(ss * (1.0f / D) + EPS);
        float am = 0.f;
#pragma unroll
        for (int i = 0; i < 4; ++i) { const int col = (F.lane + 64 * i) * 4;
            const float4 gg = *(const float4*)(g + col), sc = *(const float4*)(MOD + b * 6144 + sc_off + col), sh = *(const float4*)(MOD + b * 6144 + sh_off + col);
            v[i].x = v[i].x * rstd * gg.x * (1.f + sc.x) + sh.x; v[i].y = v[i].y * rstd * gg.y * (1.f + sc.y) + sh.y; v[i].z = v[i].z * rstd * gg.z * (1.f + sc.z) + sh.z; v[i].w = v[i].w * rstd * gg.w * (1.f + sc.w) + sh.w;
            *(uint2*)(dst + (size_t)t * D + col) = make_uint2(pack2(v[i].x, v[i].y), pack2(v[i].z, v[i].w));
            am = fmaxf(am, fmaxf(fmaxf(fabsf(v[i].x), fabsf(v[i].y)), fmaxf(fabsf(v[i].z), fabsf(v[i].w)))); }
        am = wave_max(am); const float inv = am > 0.f ? 127.0f / am : 0.f;
        if (F.lane == 0) ((float*)(F.ws + WS_SX))[t] = am > 0.f ? am / 127.0f : 0.f;
#pragma unroll
        for (int i = 0; i < 4; ++i) { const int col = (F.lane + 64 * i) * 4; const int sl = col >> 7, off = col & 127;
            const int q0 = (int)rintf(v[i].x * inv), q1 = (int)rintf(v[i].y * inv), q2 = (int)rintf(v[i].z * inv), q3 = (int)rintf(v[i].w * inv);
            *(unsigned*)(F.ws + WS_X8S + ((size_t)sl * T + t) * 128 + off) = (unsigned)(q0 & 0xFF) | ((unsigned)(q1 & 0xFF) << 8) | ((unsigned)(q2 & 0xFF) << 16) | ((unsigned)(q3 & 0xFF) << 24); }
    }
}

__device__ __forceinline__ void p3_compress_naive(const Frame& F) {
    const bf16_t* PROJ = (const bf16_t*)(F.ws + WS_PROJ);
    LAS float* hid = (LAS float*)F.lds + F.wave * 64;
    const int gw = blockIdx.x * NWAVES + F.wave, nw = F.G * NWAVES;
    if (gw < 64) { bf16_t* dz = (bf16_t*)(F.ws + ((gw & 1) ? WS_VC : WS_KC)); dz[((size_t)(gw >> 1) * 128 + 127) * 64 + F.lane] = 0; }
    for (int u = gw; u < NB * NCMP * 2 * 2; u += nw) {
        const int kv = u & 1, g = (u >> 1) & 1, n = (u >> 2) % NCMP, b = (u >> 2) / NCMP;
        const float* pe = kv ? F.in[8] : F.in[7]; const float* w1 = kv ? F.in[11] : F.in[9]; const float* w2 = kv ? F.in[12] : F.in[10];
        const int cbase = (kv ? C_VC : C_KC) + g * 64;
        float acc = 0.f;
        for (int l = 0; l < 32; ++l) {
            const bf16_t* row = PROJ + (size_t)(b * S + 16 * n + l) * NPAD + cbase;
            for (int d = 0; d < 64; ++d) { const float a = bf2f(row[d]) + pe[l * 64 + d]; acc += a * w1[(size_t)(l * 64 + d) * 64 + F.lane]; }
        }
        hid[F.lane] = gelu_tanh(acc); lds_wave_sync();
        float o = 0.f;
        for (int j = 0; j < 64; ++j) o += hid[j] * w2[j * 64 + F.lane];
        bf16_t* dst = (bf16_t*)(F.ws + (kv ? WS_VC : WS_KC)); dst[((size_t)(b * 2 + g) * 128 + n) * 64 + F.lane] = f2bf(o);
        lds_wave_sync();
    }
}


__device__ __forceinline__ void p3_compress_mfma(const Frame& F) {
    const bf16_t* PROJ = (const bf16_t*)(F.ws + WS_PROJ);
    const int lane = F.lane, tid = F.tid, wave = F.wave, grp = lane >> 4, col = lane & 15;
    LAS float* red = (LAS float*)F.lds;
    LAS bf16_t* hid = (LAS bf16_t*)(F.lds + 32768);
    if (blockIdx.x * NWAVES + wave < 64) { const int gw = blockIdx.x * NWAVES + wave; bf16_t* dz = (bf16_t*)(F.ws + ((gw & 1) ? WS_VC : WS_KC)); dz[((size_t)(gw >> 1) * 128 + 127) * 64 + lane] = 0; }
    for (int u = blockIdx.x; u < NB * 2 * 2 * 8; u += F.G) {
        const int nt8 = u & 7, kv = (u >> 3) & 1, g = (u >> 4) & 1, b = u >> 5; const int n0 = nt8 * 16;
        const bf16_t* W1T = (const bf16_t*)(F.ws + WS_W1T) + (size_t)kv * 64 * 2048; const bf16_t* W2T = (const bf16_t*)(F.ws + WS_W2T) + (size_t)kv * 64 * 64;
        const float* pec = (const float*)(F.ws + WS_PEC) + kv * 64;
        const int cbase = (kv ? C_VC : C_KC) + g * 64;
        const int nrow = (n0 + col) < NCMP ? (n0 + col) : (NCMP - 1);
        f32x4 acc[4];
#pragma unroll
        for (int nt = 0; nt < 4; ++nt) acc[nt] = (f32x4){0.f, 0.f, 0.f, 0.f};
#pragma unroll
        for (int ks = 0; ks < 8; ++ks) { const int l = 4 * wave + (ks >> 1), d0 = (ks & 1) * 32 + 8 * grp;
            const bf16x8 af = *(const bf16x8*)(PROJ + (size_t)(b * S + 16 * nrow + l) * NPAD + cbase + d0);
#pragma unroll
            for (int nt = 0; nt < 4; ++nt) { const bf16x8 bfr = *(const bf16x8*)(W1T + (size_t)(nt * 16 + col) * 2048 + l * 64 + d0);
                acc[nt] = __builtin_amdgcn_mfma_f32_16x16x32_bf16(af, bfr, acc[nt], 0, 0, 0); } }
#pragma unroll
        for (int nt = 0; nt < 4; ++nt)
#pragma unroll
            for (int rg = 0; rg < 4; ++rg) red[(wave * 16 + 4 * grp + rg) * 64 + nt * 16 + col] = acc[nt][rg];
        __syncthreads();
#pragma unroll
        for (int q = 0; q < 2; ++q) { const int idx = tid + 512 * q; float s = pec[idx & 63];
#pragma unroll
            for (int w = 0; w < 8; ++w) s += red[w * 1024 + idx];
            hid[idx] = f2bf(gelu_tanh(s)); }
        __syncthreads();
        if (wave < 4) { f32x4 o = (f32x4){0.f, 0.f, 0.f, 0.f};
#pragma unroll
            for (int ks = 0; ks < 2; ++ks) { const bf16x8 af = *(const LAS bf16x8*)(hid + col * 64 + ks * 32 + 8 * grp); const bf16x8 bfr = *(const bf16x8*)(W2T + (size_t)(wave * 16 + col) * 64 + ks * 32 + 8 * grp);
                o = __builtin_amdgcn_mfma_f32_16x16x32_bf16(af, bfr, o, 0, 0, 0); }
            bf16_t* dst = (bf16_t*)(F.ws + (kv ? WS_VC : WS_KC));
#pragma unroll
            for (int rg = 0; rg < 4; ++rg) { const int n = n0 + 4 * grp + rg; if (n < NCMP) dst[((size_t)(b * 2 + g) * 128 + n) * 64 + wave * 16 + col] = f2bf(o[rg]); } }
        __syncthreads();
    }
}

__device__ __forceinline__ void dot4_row(const bf16_t* krow, const LAS float* qs, float (&acc)[4]) {
    const uint4* kr = (const uint4*)krow;
#pragma unroll 1
    for (int c = 0; c < 8; ++c) { asm volatile("" ::: "memory"); const uint4 w = kr[c]; const unsigned ww[4] = {w.x, w.y, w.z, w.w};
#pragma unroll
        for (int e = 0; e < 4; ++e) { const float k0 = bflo(ww[e]), k1 = bfhi(ww[e]); const int d = c * 8 + e * 2;
#pragma unroll
            for (int r = 0; r < 4; ++r) acc[r] += qs[r * 64 + d] * k0 + qs[r * 64 + d + 1] * k1; } }
}
__device__ __forceinline__ void p4_attn_naive(const Frame& F) {
    const bf16_t* PROJ = (const bf16_t*)(F.ws + WS_PROJ); const bf16_t* KC = (const bf16_t*)(F.ws + WS_KC); const bf16_t* VC = (const bf16_t*)(F.ws + WS_VC);
    bf16_t* OATT = (bf16_t*)(F.ws + WS_OATT); const float* rel = F.in[21];
    LAS float* wl = (LAS float*)F.lds + F.wave * (256 + 512 + 2048 + 16);
    LAS float* qs = wl; LAS float* pc = wl + 256; LAS float* ps = wl + 768; LAS int* pbase = (LAS int*)(wl + 768 + 2048);
    const int gw = blockIdx.x * NWAVES + F.wave, nw = F.G * NWAVES, lane = F.lane;
    for (int u = gw; u < T * 2; u += nw) {
        const int g = u & 1, tok = u >> 1, b = tok / S, t = tok % S;
        const bf16_t* prow = PROJ + (size_t)tok * NPAD;
#pragma unroll
        for (int r = 0; r < 4; ++r) qs[r * 64 + lane] = bf2f(prow[C_Q + (g * 4 + r) * 64 + lane]) * 0.125f;
        lds_wave_sync();
        const int nv = t >= 31 ? ((t - 31) >> 4) + 1 : 0;
        float sc[2][4]; bool va[2];
#pragma unroll
        for (int i = 0; i < 2; ++i) { const int n = lane + 64 * i; va[i] = n < nv; float a[4] = {0.f, 0.f, 0.f, 0.f};
            if (va[i]) { dot4_row(KC + ((size_t)(b * 2 + g) * 128 + n) * 64, qs, a); const int bk = rel_bucket(t - (16 * n + 31));
#pragma unroll
                for (int r = 0; r < 4; ++r) a[r] += rel[bk * 8 + g * 4 + r]; }
#pragma unroll
            for (int r = 0; r < 4; ++r) sc[i][r] = va[i] ? a[r] : -1e30f; }
        float ocmp[4];
#pragma unroll
        for (int r = 0; r < 4; ++r) { const float m = wave_max(fmaxf(sc[0][r], sc[1][r]));
            const float e0 = va[0] ? __expf(sc[0][r] - m) : 0.f, e1 = va[1] ? __expf(sc[1][r] - m) : 0.f; const float sum = wave_sum(e0 + e1);
            const float inv = nv > 0 ? 1.0f / sum : 0.f; pc[r * 128 + lane] = e0 * inv; pc[r * 128 + 64 + lane] = e1 * inv; }
        lds_wave_sync();
        { float o[4] = {0.f, 0.f, 0.f, 0.f}; const bf16_t* vb = VC + ((size_t)(b * 2 + g) * 128) * 64 + lane;
            for (int n = 0; n < nv; ++n) { const float v = bf2f(vb[n * 64]);
#pragma unroll
                for (int r = 0; r < 4; ++r) o[r] += pc[r * 128 + n] * v; }
#pragma unroll
            for (int r = 0; r < 4; ++r) ocmp[r] = o[r]; }
        const int cur = t >> 6; float val;
        { const int j = lane & 31; float imp = 0.f;
#pragma unroll
            for (int r = 0; r < 4; ++r) for (int n = 4 * j - 1; n <= 4 * j + 3; ++n) if (n >= 0 && n < NCMP) imp += pc[r * 128 + n];
            const bool forced = (j == 0) || (j == cur) || (j == cur - 1); const bool allowed = j <= cur;
            val = forced ? 1e4f : (allowed ? imp : -INFINITY); }
        int rank = 0;
        for (int jp = 0; jp < 32; ++jp) { const float vp = __shfl(val, jp); rank += ((vp > val) || (vp == val && jp < (lane & 31))) ? 1 : 0; }
        unsigned selmask = (unsigned)(__ballot(lane < 32 && rank < 8) & 0xFFFFFFFFull);
        float oslc[4], owin[4];
#pragma unroll
        for (int br = 0; br < 2; ++br) {
            const int ck = br == 0 ? C_KS : C_KW, cv = br == 0 ? C_VS : C_VW;
            unsigned mk = selmask;
#pragma unroll 1
            for (int c = 0; c < 8; ++c) {
                int kpos, bs;
                if (br == 0) { const int j = __builtin_ctz(mk | 0x80000000u); mk &= mk - 1; bs = 64 * j; } else { bs = t - 511 + 64 * c; }
                kpos = bs + lane; if (lane == 0) pbase[c] = bs;
                const int dist = t - kpos; const bool vv = (dist >= 0) && (kpos >= 0) && (kpos < S);
                float a[4] = {0.f, 0.f, 0.f, 0.f};
                if (vv) { dot4_row(PROJ + (size_t)(b * S + kpos) * NPAD + ck + g * 64, qs, a); const int bk = rel_bucket(dist);
#pragma unroll
                    for (int r = 0; r < 4; ++r) a[r] += rel[bk * 8 + g * 4 + r]; }
#pragma unroll
                for (int r = 0; r < 4; ++r) ps[r * 512 + c * 64 + lane] = vv ? a[r] : -1e30f;
            }
            lds_wave_sync();
#pragma unroll 1
            for (int r = 0; r < 4; ++r) { float m = -1e30f;
#pragma unroll
                for (int c = 0; c < 8; ++c) m = fmaxf(m, ps[r * 512 + c * 64 + lane]);
                m = wave_max(m); float e[8], sum = 0.f;
#pragma unroll
                for (int c = 0; c < 8; ++c) { const float sv = ps[r * 512 + c * 64 + lane]; e[c] = sv > -1e29f ? __expf(sv - m) : 0.f; sum += e[c]; }
                sum = wave_sum(sum); const float inv = sum > 0.f ? 1.0f / sum : 0.f;
#pragma unroll
                for (int c = 0; c < 8; ++c) ps[r * 512 + c * 64 + lane] = e[c] * inv; }
            lds_wave_sync();
            float o[4] = {0.f, 0.f, 0.f, 0.f};
#pragma unroll 1
            for (int c = 0; c < 8; ++c) {
                const int bsc = pbase[c];
                for (int kk = 0; kk < 64; ++kk) { const int kpos = bsc + kk; if (kpos < 0 || kpos > t) continue;
                    const float v = bf2f(PROJ[(size_t)(b * S + kpos) * NPAD + cv + g * 64 + lane]);
#pragma unroll
                    for (int r = 0; r < 4; ++r) o[r] += ps[r * 512 + c * 64 + kk] * v; } }
            lds_wave_sync();
#pragma unroll
            for (int r = 0; r < 4; ++r) { if (br == 0) oslc[r] = o[r]; else owin[r] = o[r]; }
        }
#pragma unroll
        for (int r = 0; r < 4; ++r) { const int h = g * 4 + r;
            const float g0 = sigmoidf_(bf2f(prow[C_GT + h * 3 + 0])), g1 = sigmoidf_(bf2f(prow[C_GT + h * 3 + 1])), g2 = sigmoidf_(bf2f(prow[C_GT + h * 3 + 2]));
            OATT[(size_t)tok * 512 + h * 64 + lane] = f2bf(g0 * ocmp[r] + g1 * oslc[r] + g2 * owin[r]); }
    }
}


constexpr float LOG2E = 1.4426950408889634f;
constexpr int AT_KC = 0, AT_VC = 16384, AT_KV = 32768  , AT_BTAB = 65536, AT_IMP = 69888, AT_SEL = 78336, AT_OUT = 78592  , AT_END = 78592 + 65536;
constexpr int BT_STRIDE = 132;
__device__ __forceinline__ int tile_off(int row, int chunk) { return row * 128 + ((chunk ^ (row & 7)) << 4); }
__device__ __forceinline__ bf16x8 mk_frag(unsigned a, unsigned b, unsigned c, unsigned d) { u32x4v v = {a, b, c, d}; return __builtin_bit_cast(bf16x8, v); }
struct LaneOffs { int koff[2]; int voff[4]; int soff; };
__device__ __forceinline__ LaneOffs lane_offs(int lane, int tid) {
    LaneOffs L; const int grp = lane >> 4, rowi = lane & 15, q4 = rowi >> 2, p = lane & 3;
#pragma unroll
    for (int ks = 0; ks < 2; ++ks) L.koff[ks] = tile_off(rowi, ks * 4 + grp);
#pragma unroll
    for (int dt = 0; dt < 4; ++dt) L.voff[dt] = tile_off(4 * grp + q4, 2 * dt + (p >> 1)) + 8 * (p & 1);
    L.soff = tile_off(tid >> 3, tid & 7); return L;
}
__device__ __forceinline__ bf16x8 vfrag_read(const LAS unsigned char* vt, int voff_dt, int row0) {
    const s16x4 a = __builtin_amdgcn_ds_read_tr16_b64_v4i16((LAS s16x4*)(vt + voff_dt + row0 * 128));
    const s16x4 b = __builtin_amdgcn_ds_read_tr16_b64_v4i16((LAS s16x4*)(vt + voff_dt + row0 * 128 + 2048));
    bf16x8 f = {a[0], a[1], a[2], a[3], b[0], b[1], b[2], b[3]}; return f;
}

struct AttnState {
    f32x4 o[4][2]; float m[2], l[2];
};

template <int BR>
__device__ __forceinline__ void attn_tile(const LAS unsigned char* kt_lds, const LAS unsigned char* vt_lds, const LAS float* btab_h, const bf16x8 (&qf)[2][2], const int (&tq)[2], const unsigned (&sel)[2],
                                          int j, bool near, AttnState& st, int lane, const LaneOffs& L) {
    const int grp = lane >> 4, kbase = 64 * j;
    f32x4 sacc[4][2];
#pragma unroll
    for (int kt = 0; kt < 4; ++kt) { sacc[kt][0] = (f32x4){0.f, 0.f, 0.f, 0.f}; sacc[kt][1] = (f32x4){0.f, 0.f, 0.f, 0.f}; }
#pragma unroll
    for (int kt = 0; kt < 4; ++kt)
#pragma unroll
        for (int ks = 0; ks < 2; ++ks) { const bf16x8 kf = *(const LAS bf16x8*)(kt_lds + L.koff[ks] + kt * 2048);
            sacc[kt][0] = __builtin_amdgcn_mfma_f32_16x16x32_bf16(kf, qf[0][ks], sacc[kt][0], 0, 0, 0);
            sacc[kt][1] = __builtin_amdgcn_mfma_f32_16x16x32_bf16(kf, qf[1][ks], sacc[kt][1], 0, 0, 0); }
    __builtin_amdgcn_sched_barrier(0);
    const float SC = 0.125f * LOG2E; const float bfar = btab_h[128];
    bf16x8 pf[2][2];
#pragma unroll
    for (int qt = 0; qt < 2; ++qt) {
        const int t = tq[qt]; const bool selq = BR == 0 ? ((sel[qt] >> j) & 1u) != 0u : true;
        float sv[4][4]; float tmax = -1e30f;
        int d0 = t - 4 * grp - kbase; asm volatile("" : "+v"(d0));
        if (near) {
#pragma unroll
            for (int kt = 0; kt < 4; ++kt)
#pragma unroll
                for (int rg = 0; rg < 4; ++rg) { const int dist = d0 - (kt * 16 + rg); const int dd = dist < 0 ? 0 : (dist > 128 ? 128 : dist); sv[kt][rg] = btab_h[dd]; }
        } else {
#pragma unroll
            for (int kt = 0; kt < 4; ++kt)
#pragma unroll
                for (int rg = 0; rg < 4; ++rg) sv[kt][rg] = bfar;
        }
#pragma unroll
        for (int kt = 0; kt < 4; ++kt)
#pragma unroll
            for (int rg = 0; rg < 4; ++rg) { const int c = kt * 16 + rg;
                const bool valid = BR == 0 ? (selq && d0 >= c) : (d0 >= c && d0 < 512 + c);
                const float sx = sacc[kt][qt][rg] * SC + sv[kt][rg]; const float s = valid ? sx : -1e30f; sv[kt][rg] = s; tmax = fmaxf(tmax, s); }
        tmax = fmaxf(tmax, __shfl_xor(tmax, 16)); tmax = fmaxf(tmax, __shfl_xor(tmax, 32));
        const float mnew = fmaxf(st.m[qt], tmax); const float alpha = __builtin_amdgcn_exp2f(st.m[qt] - mnew); st.m[qt] = mnew;
        const float muse = mnew < -1e29f ? 0.f : mnew;
        float ls = 0.f; unsigned pk[4][2];
#pragma unroll
        for (int kt = 0; kt < 4; ++kt) { float e[4];
#pragma unroll
            for (int rg = 0; rg < 4; ++rg) { e[rg] = __builtin_amdgcn_exp2f(sv[kt][rg] - muse); ls += e[rg]; }
            pk[kt][0] = pg8::cvt_pk_bf16(e[0], e[1]); pk[kt][1] = pg8::cvt_pk_bf16(e[2], e[3]); }
        st.l[qt] = st.l[qt] * alpha + ls;
#pragma unroll
        for (int dt = 0; dt < 4; ++dt) st.o[dt][qt] *= alpha;
        pf[qt][0] = mk_frag(pk[0][0], pk[0][1], pk[1][0], pk[1][1]); pf[qt][1] = mk_frag(pk[2][0], pk[2][1], pk[3][0], pk[3][1]);
        __builtin_amdgcn_sched_barrier(0);
    }
#pragma unroll
    for (int ks = 0; ks < 2; ++ks)
#pragma unroll
        for (int dt = 0; dt < 4; ++dt) { const bf16x8 vf = vfrag_read(vt_lds, L.voff[dt], 32 * ks);
            st.o[dt][0] = __builtin_amdgcn_mfma_f32_16x16x32_bf16(vf, pf[0][ks], st.o[dt][0], 0, 0, 0);
            st.o[dt][1] = __builtin_amdgcn_mfma_f32_16x16x32_bf16(vf, pf[1][ks], st.o[dt][1], 0, 0, 0); }
}

template <int BR>
__device__ __forceinline__ void attn_branch(const Frame& F, const bf16_t* PROJ, int b, int g, int t0, unsigned tiles  , const LAS float* btab_h,
                                            const bf16x8 (&qf)[2][2], const int (&tq)[2], const unsigned (&sel)[2], const float (&gate)[2], const LaneOffs& L) {
    const int lane = F.lane, tid = F.tid;
    const int ck = (BR == 0 ? C_KS : C_KW) + g * 64, cv = (BR == 0 ? C_VS : C_VW) + g * 64;
    const int srow = tid >> 3, sch = tid & 7;
    AttnState st;
#pragma unroll
    for (int dt = 0; dt < 4; ++dt) { st.o[dt][0] = (f32x4){0.f, 0.f, 0.f, 0.f}; st.o[dt][1] = (f32x4){0.f, 0.f, 0.f, 0.f}; }
    st.m[0] = st.m[1] = -1e30f; st.l[0] = st.l[1] = 0.f;
    unsigned rem = tiles; int cur = 0;
    u32x4v rk, rv;
    { const int j = __builtin_ctz(rem); const bf16_t* rowp = PROJ + (size_t)(b * S + 64 * j + srow) * NPAD + sch * 8;
        rk = *(const u32x4v*)(rowp + ck); rv = *(const u32x4v*)(rowp + cv);
        *(LAS u32x4v*)(F.lds + AT_KV + L.soff) = rk; *(LAS u32x4v*)(F.lds + AT_KV + 8192 + L.soff) = rv; }
    __syncthreads();
    while (rem) {
        const int j = __builtin_ctz(rem); rem &= rem - 1;
        const bool has_next = rem != 0u;
        if (has_next) { const int jn = __builtin_ctz(rem); const bf16_t* rowp = PROJ + (size_t)(b * S + 64 * jn + srow) * NPAD + sch * 8; rk = *(const u32x4v*)(rowp + ck); rv = *(const u32x4v*)(rowp + cv); }
        const bool near = (t0 + 8 * F.wave) - (64 * j + 63) < 128;
        attn_tile<BR>(F.lds + AT_KV + cur * 16384, F.lds + AT_KV + cur * 16384 + 8192, btab_h, qf, tq, sel, j, near, st, lane, L);
        if (has_next) { *(LAS u32x4v*)(F.lds + AT_KV + (cur ^ 1) * 16384 + L.soff) = rk; *(LAS u32x4v*)(F.lds + AT_KV + (cur ^ 1) * 16384 + 8192 + L.soff) = rv; }
        __syncthreads();
        cur ^= 1;
    }
    int pob = AT_OUT + tid * 4; asm volatile("" : "+v"(pob));
    LAS float* po = (LAS float*)(F.lds + pob);
#pragma unroll
    for (int qt = 0; qt < 2; ++qt) { float l = st.l[qt]; l += __shfl_xor(l, 16); l += __shfl_xor(l, 32); const float sc = l > 0.f ? gate[qt] / l : 0.f;
#pragma unroll
        for (int dt = 0; dt < 4; ++dt)
#pragma unroll
            for (int e = 0; e < 4; ++e) po[((qt * 4 + dt) * 4 + e) * 512] += st.o[dt][qt][e] * sc; }
}

__device__ __forceinline__ void p4_attn_mfma(const Frame& F) {
    const bf16_t* PROJ = (const bf16_t*)(F.ws + WS_PROJ); const bf16_t* KC = (const bf16_t*)(F.ws + WS_KC); const bf16_t* VC = (const bf16_t*)(F.ws + WS_VC);
    bf16_t* OATT = (bf16_t*)(F.ws + WS_OATT); const float* rel = F.in[21];
    const int lane = F.lane, tid = F.tid, wave = F.wave, grp = lane >> 4, col = lane & 15, qi = col >> 2, r = col & 3;
    LAS float* btab = (LAS float*)(F.lds + AT_BTAB); LAS float* impq = (LAS float*)(F.lds + AT_IMP); LAS unsigned* selm = (LAS unsigned*)(F.lds + AT_SEL);
    const LaneOffs L = lane_offs(lane, tid);
    for (int i = tid; i < 8 * 129; i += NTHREADS) { const int hh = i / 129, dd = i % 129; btab[hh * BT_STRIDE + dd] = rel[rel_bucket(dd) * 8 + hh] * LOG2E; }
    __syncthreads();
    for (int uu = blockIdx.x; uu < 1024; uu += F.G) {
        int sidx = uu;
        if (F.G == 256) { const int round = uu >> 8, k = uu & 255; sidx = (round == 0) ? k : (round == 1) ? 511 - k : (round == 2) ? 512 + k : 1023 - k; }
        const int qb = 31 - (sidx >> 5), bg = sidx & 31, b = bg >> 1, g = bg & 1, t0 = qb * 64, h = g * 4 + r;
        const LAS float* btab_h = btab + h * BT_STRIDE;
        int tq[2]; bf16x8 qf[2][2]; float gate[3][2];
#pragma unroll
        for (int qt = 0; qt < 2; ++qt) { tq[qt] = t0 + 8 * wave + 4 * qt + qi; const bf16_t* prow = PROJ + (size_t)(b * S + tq[qt]) * NPAD;
#pragma unroll
            for (int ks = 0; ks < 2; ++ks) qf[qt][ks] = *(const bf16x8*)(prow + C_Q + h * 64 + ks * 32 + 8 * grp);
#pragma unroll
            for (int jg = 0; jg < 3; ++jg) gate[jg][qt] = sigmoidf_(bf2f(prow[C_GT + h * 3 + jg])); }
#pragma unroll
        for (int i = 0; i < 2; ++i) { const int c2 = tid + 512 * i, row = c2 >> 3, ch = c2 & 7; const size_t src = ((size_t)(b * 2 + g) * 128 + row) * 64 + ch * 8;
            *(LAS u32x4v*)(F.lds + AT_KC + L.soff + 8192 * i) = *(const u32x4v*)(KC + src); *(LAS u32x4v*)(F.lds + AT_VC + L.soff + 8192 * i) = *(const u32x4v*)(VC + src); }
        __syncthreads();
#ifndef AT_SKIP_CMP
        {
            const int nvmax = t0 + 63 >= 31 ? ((t0 + 63 - 31) >> 4) + 1 : 0;
            const float SC = 0.125f * LOG2E; const int srcl = (lane + 48) & 63;
            int pob = AT_OUT + tid * 4; asm volatile("" : "+v"(pob));
            LAS float* po = (LAS float*)(F.lds + pob);
#pragma unroll
            for (int qt = 0; qt < 2; ++qt) {
                f32x4 sa[8];
#pragma unroll
                for (int kt = 0; kt < 8; ++kt) sa[kt] = (f32x4){0.f, 0.f, 0.f, 0.f};
#pragma unroll
                for (int kt = 0; kt < 8; ++kt) if (kt * 16 < nvmax) {
#pragma unroll
                    for (int ks = 0; ks < 2; ++ks) { const bf16x8 kf = *(const LAS bf16x8*)(F.lds + AT_KC + L.koff[ks] + kt * 2048);
                        sa[kt] = __builtin_amdgcn_mfma_f32_16x16x32_bf16(kf, qf[qt][ks], sa[kt], 0, 0, 0); } }
                __builtin_amdgcn_sched_barrier(0);
                int d0 = tq[qt] - 31 - 64 * grp; asm volatile("" : "+v"(d0));
                float mx = -1e30f;
#pragma unroll
                for (int kt = 0; kt < 8; ++kt)
#pragma unroll
                    for (int rg = 0; rg < 4; ++rg) { const int c = 256 * kt + 16 * rg; const int dist = d0 - c; const int dd = dist < 0 ? 0 : (dist > 128 ? 128 : dist);
                        const float sx = sa[kt][rg] * SC + btab_h[dd]; const float s = d0 >= c ? sx : -1e30f; sa[kt][rg] = s; mx = fmaxf(mx, s); }
                mx = fmaxf(mx, __shfl_xor(mx, 16)); mx = fmaxf(mx, __shfl_xor(mx, 32));
                float sum = 0.f;
#pragma unroll
                for (int kt = 0; kt < 8; ++kt)
#pragma unroll
                    for (int rg = 0; rg < 4; ++rg) { const int c = 256 * kt + 16 * rg; const float ex = __builtin_amdgcn_exp2f(sa[kt][rg] - mx); const float e = d0 >= c ? ex : 0.f; sa[kt][rg] = e; sum += e; }
                __builtin_amdgcn_sched_barrier(0);
                sum += __shfl_xor(sum, 16); sum += __shfl_xor(sum, 32);
                const float inv = sum > 0.f ? 1.0f / sum : 0.f;
                float prev3 = 0.f;
#pragma unroll
                for (int kt = 0; kt < 8; ++kt) { const float p3 = sa[kt][3] * inv; const float part = (sa[kt][0] * inv + sa[kt][1] * inv) + (sa[kt][2] * inv + p3);
                    const float xa = __shfl(p3, srcl), xb = __shfl(prev3, srcl); float tot = part + (grp >= 1 ? xa : xb);
                    tot += __shfl_xor(tot, 1); tot += __shfl_xor(tot, 2);
                    if (r == 0) impq[(8 * wave + 4 * qt + qi) * 33 + 4 * kt + grp] = tot;
                    prev3 = p3; }
                __builtin_amdgcn_sched_barrier(0);
                f32x4 oc[4];
#pragma unroll
                for (int dt = 0; dt < 4; ++dt) oc[dt] = (f32x4){0.f, 0.f, 0.f, 0.f};
#pragma unroll
                for (int ks = 0; ks < 4; ++ks) if (ks * 32 < nvmax) {
                    const bf16x8 pfr = mk_frag(pg8::cvt_pk_bf16(sa[2 * ks][0], sa[2 * ks][1]), pg8::cvt_pk_bf16(sa[2 * ks][2], sa[2 * ks][3]),
                                               pg8::cvt_pk_bf16(sa[2 * ks + 1][0], sa[2 * ks + 1][1]), pg8::cvt_pk_bf16(sa[2 * ks + 1][2], sa[2 * ks + 1][3]));
#pragma unroll
                    for (int dt = 0; dt < 4; ++dt) { const bf16x8 vf = vfrag_read(F.lds + AT_VC, L.voff[dt], 32 * ks); oc[dt] = __builtin_amdgcn_mfma_f32_16x16x32_bf16(vf, pfr, oc[dt], 0, 0, 0); } }
                const float scq = inv * gate[0][qt];
#pragma unroll
                for (int dt = 0; dt < 4; ++dt)
#pragma unroll
                    for (int e = 0; e < 4; ++e) po[((qt * 4 + dt) * 4 + e) * 512] = oc[dt][e] * scq;
                __builtin_amdgcn_sched_barrier(0);
            }
        }
#endif
        __syncthreads();
#ifndef AT_SKIP_SEL
        {
            const int q = tid >> 3, jj = tid & 7, cur = qb; unsigned bits = 0u;
            float vj[4];
#pragma unroll
            for (int e = 0; e < 4; ++e) { const int j = jj * 4 + e; const bool forced = (j == 0) || (j == cur) || (j == cur - 1); vj[e] = forced ? 1e4f : (j <= cur ? impq[q * 33 + j] : -INFINITY); }
            int rk[4] = {0, 0, 0, 0};
            for (int jp = 0; jp < 32; ++jp) { const bool forced = (jp == 0) || (jp == cur) || (jp == cur - 1); const float vp = forced ? 1e4f : (jp <= cur ? impq[q * 33 + jp] : -INFINITY);
#pragma unroll
                for (int e = 0; e < 4; ++e) rk[e] += ((vp > vj[e]) || (vp == vj[e] && jp < jj * 4 + e)) ? 1 : 0; }
#pragma unroll
            for (int e = 0; e < 4; ++e) bits |= (rk[e] < 8 ? 1u : 0u) << (jj * 4 + e);
            bits |= __shfl_xor(bits, 1); bits |= __shfl_xor(bits, 2); bits |= __shfl_xor(bits, 4);
            if (jj == 0) selm[q] = bits;
        }
#endif
        __syncthreads();
        unsigned sel[2] = {selm[8 * wave + qi], selm[8 * wave + 4 + qi]};
        unsigned un = selm[lane];
#pragma unroll
        for (int o = 32; o >= 1; o >>= 1) un |= __shfl_xor(un, o);
        un = __builtin_amdgcn_readfirstlane(un);
        const unsigned causal = qb == 31 ? 0xFFFFFFFFu : ((2u << qb) - 1u);
#ifndef AT_SKIP_BR0
        { const float gt1[2] = {gate[1][0], gate[1][1]}; attn_branch<0>(F, PROJ, b, g, t0, un & causal, btab_h, qf, tq, sel, gt1, L); }
#endif
#ifndef AT_SKIP_BR1
        { const int jlo = qb >= 8 ? qb - 8 : 0; const unsigned wmask = causal & ~((1u << jlo) - 1u); const float gt2[2] = {gate[2][0], gate[2][1]};
            attn_branch<1>(F, PROJ, b, g, t0, wmask, btab_h, qf, tq, sel, gt2, L); }
#endif
        int pob2 = AT_OUT + tid * 4; asm volatile("" : "+v"(pob2));
#pragma unroll
        for (int qt = 0; qt < 2; ++qt) { bf16_t* orow = OATT + (size_t)(b * S + tq[qt]) * 512 + h * 64 + 4 * grp;
#pragma unroll
            for (int dt = 0; dt < 4; ++dt) { const LAS float* po = (const LAS float*)(F.lds + pob2) + (qt * 4 + dt) * 4 * 512;
                *(uint2*)(orow + dt * 16) = make_uint2(pg8::cvt_pk_bf16(po[0], po[512]), pg8::cvt_pk_bf16(po[1024], po[1536])); } }
    }
}
__device__ __forceinline__ void p5_mixed(const Frame& F) {
    const bf16_t* PROJ = (const bf16_t*)(F.ws + WS_PROJ); const bf16_t* OATT = (const bf16_t*)(F.ws + WS_OATT); bf16_t* MIX = (bf16_t*)(F.ws + WS_H);
    const float* cw = F.in[13]; const float* ga = F.in[14]; const float* gc = F.in[15];
    const int gw = blockIdx.x * NWAVES + F.wave, nw = F.G * NWAVES, lane = F.lane;
    for (int tok = gw; tok < T; tok += nw) {
        const int s = tok % S; const int c0 = lane * 8;
        float a[8], y[8];
        { const uint4 w = *(const uint4*)(OATT + (size_t)tok * 512 + c0); const unsigned ww[4] = {w.x, w.y, w.z, w.w};
#pragma unroll
            for (int e = 0; e < 4; ++e) { a[2 * e] = bflo(ww[e]); a[2 * e + 1] = bfhi(ww[e]); } }
#pragma unroll
        for (int e = 0; e < 8; ++e) y[e] = 0.f;
#pragma unroll
        for (int dt = 0; dt < 3; ++dt) { if (s - 2 + dt >= 0) { const bf16_t* row = PROJ + (size_t)(tok - 2 + dt) * NPAD;
                const uint4 wc = *(const uint4*)(row + C_CC + c0), wh = *(const uint4*)(row + C_CH + c0); const unsigned c4[4] = {wc.x, wc.y, wc.z, wc.w}, h4[4] = {wh.x, wh.y, wh.z, wh.w};
#pragma unroll
                for (int e = 0; e < 4; ++e) { y[2 * e] += cw[dt * 512 + c0 + 2 * e] * (bflo(c4[e]) * bflo(h4[e])); y[2 * e + 1] += cw[dt * 512 + c0 + 2 * e + 1] * (bfhi(c4[e]) * bfhi(h4[e])); } } }
        { const uint4 wb = *(const uint4*)(PROJ + (size_t)tok * NPAD + C_CB + c0); const unsigned b4[4] = {wb.x, wb.y, wb.z, wb.w};
#pragma unroll
            for (int e = 0; e < 4; ++e) { y[2 * e] *= bflo(b4[e]); y[2 * e + 1] *= bfhi(b4[e]); } }
        float sa = 0.f, sy = 0.f;
#pragma unroll
        for (int e = 0; e < 8; ++e) { sa += a[e] * a[e]; sy += y[e] * y[e]; }
        sa = wave_sum(sa); sy = wave_sum(sy);
        const float ra = rsqrtf(sa * (1.0f / 512) + EPS), ry = rsqrtf(sy * (1.0f / 512) + EPS);
        unsigned oa[4], oy[4];
#pragma unroll
        for (int e = 0; e < 4; ++e) { oa[e] = pack2(a[2 * e] * ra * ga[c0 + 2 * e], a[2 * e + 1] * ra * ga[c0 + 2 * e + 1]); oy[e] = pack2(y[2 * e] * ry * gc[c0 + 2 * e], y[2 * e + 1] * ry * gc[c0 + 2 * e + 1]); }
        *(uint4*)(MIX + (size_t)tok * D + c0) = make_uint4(oa[0], oa[1], oa[2], oa[3]);
        *(uint4*)(MIX + (size_t)tok * D + 512 + c0) = make_uint4(oy[0], oy[1], oy[2], oy[3]);
    }
}

struct EpiResGate {
    static constexpr bool PERM = false, AFTER_DRAIN = false;
    float* C; const float* X; const float* MOD; int gate_off;
    __device__ __forceinline__ void operator()(const pg8::f32x4 (&acc)[2][2][4][2], const pg8::Unit& u, int wr, int wc, int fr, int fq) const {
        using pg8::f32x4; using pg8::HALF; using pg8::BM;
        const int row0 = u.pm * BM + wr * 64 + fr, col0 = u.pn * BM + wc * 32 + 4 * fq;
        const int b = (u.pm * BM) / S;
        f32x4 gv[2][2];
#pragma unroll
        for (int bj = 0; bj < 2; ++bj)
#pragma unroll
            for (int n = 0; n < 2; ++n) gv[bj][n] = *(const f32x4*)(MOD + b * 6144 + gate_off + col0 + bj * HALF + n * 16);
#pragma unroll
        for (int ai = 0; ai < 2; ++ai)
#pragma unroll
            for (int m = 0; m < 4; ++m) { const size_t ro = (size_t)(row0 + ai * HALF + m * 16) * D + col0;
#pragma unroll
                for (int bj = 0; bj < 2; ++bj)
#pragma unroll
                    for (int n = 0; n < 2; ++n) { const f32x4 xv = *(const f32x4*)(X + ro + bj * HALF + n * 16); *(f32x4*)(C + ro + bj * HALF + n * 16) = xv + gv[bj][n] * acc[ai][bj][m][n]; } }
    }
};

__device__ __forceinline__ void argmax_bfly(float& v, int& i) {
#pragma unroll
    for (int o = 32; o >= 1; o >>= 1) { const float ov = __shfl_xor(v, o); const int oi = __shfl_xor(i, o); if (ov > v || (ov == v && oi < i)) { v = ov; i = oi; } }
}
__device__ __forceinline__ void p9_route_naive(const Frame& F) {
    const bf16_t* QP = (const bf16_t*)(F.ws + WS_QP); const bf16_t* KEYS = (const bf16_t*)(F.ws + WS_KEYS);
    int* EIDX = (int*)(F.ws + WS_EIDX); float* EW = (float*)(F.ws + WS_EW);
    LAS float* ql = (LAS float*)F.lds + F.wave * 128;
    const int gw = blockIdx.x * NWAVES + F.wave, nw = F.G * NWAVES, lane = F.lane;
    for (int u = gw; u < T * 8; u += nw) {
        const int h = u & 7, tok = u >> 3;
        ql[lane] = bf2f(QP[(size_t)tok * D + h * 128 + lane]); ql[64 + lane] = bf2f(QP[(size_t)tok * D + h * 128 + 64 + lane]);
        lds_wave_sync();
        float tv[2]; int ti[2];
#pragma unroll
        for (int p = 0; p < 2; ++p) {
            float s[2];
#pragma unroll
            for (int kk = 0; kk < 2; ++kk) { const uint4* kr = (const uint4*)(KEYS + ((size_t)(h * 2 + p) * 128 + lane + 64 * kk) * 64); float a = 0.f;
#pragma unroll
                for (int c = 0; c < 8; ++c) { const uint4 w = kr[c]; const unsigned ww[4] = {w.x, w.y, w.z, w.w};
#pragma unroll
                    for (int e = 0; e < 4; ++e) a += ql[p * 64 + c * 8 + 2 * e] * bflo(ww[e]) + ql[p * 64 + c * 8 + 2 * e + 1] * bfhi(ww[e]); }
                s[kk] = a; }
            tv[p] = 0.f; ti[p] = 0;
            for (int i = 0; i < 16; ++i) {
                float v = s[0]; int ix = lane; if (s[1] > v) { v = s[1]; ix = lane + 64; }
                argmax_bfly(v, ix);
                if (lane == i) { tv[p] = v; ti[p] = ix; }
                if (ix == lane) s[0] = -INFINITY; if (ix == lane + 64) s[1] = -INFINITY;
            }
        }
        float cd[4];
        { const float va = __shfl(tv[0], lane >> 2);
#pragma unroll
            for (int i = 0; i < 4; ++i) cd[i] = va + __shfl(tv[1], (lane & 3) * 4 + i); }
        float cs = 0.f; int cc = 0;
        for (int it = 0; it < 16; ++it) {
            float v = cd[0]; int ix = lane * 4;
#pragma unroll
            for (int i = 1; i < 4; ++i) if (cd[i] > v) { v = cd[i]; ix = lane * 4 + i; }
            argmax_bfly(v, ix);
            if (lane == it) { cs = v; cc = ix; }
#pragma unroll
            for (int i = 0; i < 4; ++i) if (ix == lane * 4 + i) cd[i] = -INFINITY;
        }
        const int i1 = __shfl(ti[0], cc >> 4), i2 = __shfl(ti[1], cc & 15);
        const float m = __shfl(cs, 0); float ex = lane < 16 ? __expf(cs - m) : 0.f; const float sum = wave_sum(ex);
        if (lane < 16) { EIDX[(size_t)tok * 128 + h * 16 + lane] = i1 * 128 + i2; EW[(size_t)tok * 128 + h * 16 + lane] = ex / sum; }
        lds_wave_sync();
    }
}


__device__ __forceinline__ int ord_i(float f) { const int u = __float_as_int(f); return u >= 0 ? u : (u ^ 0x7FFFFFFF); }
__device__ __forceinline__ float unord_f(int i) { const int u = i >= 0 ? i : (i ^ 0x7FFFFFFF); return __int_as_float(u); }
#define INT_MIN_ (-2147483647 - 1)
struct CandTab { int a[50], b[50]; };
constexpr CandTab make_cand() { CandTab t{}; int n = 0; for (int a = 0; a < 16; ++a) for (int b = 0; b < 16; ++b) if ((a + 1) * (b + 1) <= 16) { t.a[n] = a; t.b[n] = b; ++n; } return t; }
constexpr CandTab CAND = make_cand();
constexpr int RT_LDS_PER_WAVE = 16 * 32 * 4;
__device__ __forceinline__ void p9_route_mfma(const Frame& F) {
    const bf16_t* QP = (const bf16_t*)(F.ws + WS_QP); const bf16_t* KEYS = (const bf16_t*)(F.ws + WS_KEYS);
    int* EIDX = (int*)(F.ws + WS_EIDX); float* EW = (float*)(F.ws + WS_EW);
    const int lane = F.lane, grp = lane >> 4, col = lane & 15;
    LAS int* itab = (LAS int*)(F.lds + F.wave * RT_LDS_PER_WAVE) + col * 32;
    const int gw = blockIdx.x * NWAVES + F.wave, nw = F.G * NWAVES;
    for (int task = gw; task < (T / 16) * 8; task += nw) {
        const int h = task & 7, tile = task >> 3, tok = tile * 16 + col;
        int lst[2][16];
#pragma unroll
        for (int p = 0; p < 2; ++p) {
            bf16x8 qf[2];
#pragma unroll
            for (int ks = 0; ks < 2; ++ks) qf[ks] = *(const bf16x8*)(QP + (size_t)tok * D + h * 128 + p * 64 + ks * 32 + 8 * grp);
            f32x4 sc[8];
#pragma unroll
            for (int kt = 0; kt < 8; ++kt) { sc[kt] = (f32x4){0.f, 0.f, 0.f, 0.f};
#pragma unroll
                for (int ks = 0; ks < 2; ++ks) { const bf16x8 kf = *(const bf16x8*)(KEYS + ((size_t)(h * 2 + p) * 128 + kt * 16 + col) * 64 + ks * 32 + 8 * grp);
                    sc[kt] = __builtin_amdgcn_mfma_f32_16x16x32_bf16(kf, qf[ks], sc[kt], 0, 0, 0); } }
            int r[32];
#pragma unroll
            for (int kt = 0; kt < 8; ++kt)
#pragma unroll
                for (int rg = 0; rg < 4; ++rg) r[kt * 4 + rg] = (ord_i(sc[kt][rg]) & ~0x7F) | (127 - (kt * 16 + 4 * grp + rg));
#pragma unroll
            for (int it = 0; it < 16; ++it) {
                int m = r[0];
#pragma unroll
                for (int i = 1; i < 32; ++i) m = max(m, r[i]);
                m = max(m, __shfl_xor(m, 16)); m = max(m, __shfl_xor(m, 32));
                lst[p][it] = m;
#pragma unroll
                for (int i = 0; i < 32; ++i) r[i] = (r[i] == m) ? INT_MIN_ : r[i];
            }
            if (grp == 0) {
#pragma unroll
                for (int it = 0; it < 16; ++it) itab[p * 16 + it] = 127 - (lst[p][it] & 0x7F);
            }
        }
        float v0[16], v1[16];
#pragma unroll
        for (int i = 0; i < 16; ++i) { v0[i] = unord_f(lst[0][i] & ~0x7F); v1[i] = unord_f(lst[1][i] & ~0x7F); }
        int ck[50];
#pragma unroll
        for (int i = 0; i < 50; ++i) ck[i] = (ord_i(v0[CAND.a[i]] + v1[CAND.b[i]]) & ~0xFF) | (255 - (CAND.a[i] * 16 + CAND.b[i]));
        int top[16];
#pragma unroll
        for (int it = 0; it < 16; ++it) {
            int m = ck[0];
#pragma unroll
            for (int i = 1; i < 50; ++i) m = max(m, ck[i]);
            top[it] = m;
#pragma unroll
            for (int i = 0; i < 50; ++i) ck[i] = (ck[i] == m) ? INT_MIN_ : ck[i];
        }
        lds_wave_sync();
        const float smax = unord_f(top[0] & ~0xFF);
        float ex[16], sum = 0.f;
#pragma unroll
        for (int it = 0; it < 16; ++it) { ex[it] = __expf(unord_f(top[it] & ~0xFF) - smax); sum += ex[it]; }
        const float inv = 1.0f / sum;
        if (grp == 0) {
#pragma unroll
            for (int it = 0; it < 16; ++it) { const int flat = 255 - (top[it] & 0xFF); const int i1 = itab[flat >> 4], i2 = itab[16 + (flat & 15)];
                EIDX[(size_t)tok * 128 + h * 16 + it] = i1 * 128 + i2; EW[(size_t)tok * 128 + h * 16 + it] = ex[it] * inv; }
        }
        lds_wave_sync();
    }
}

constexpr int N_PHASES = 14;
struct Args { const float* in[23]; float* out; unsigned char* ws; int ph_lo, ph_hi; };
__global__ void __launch_bounds__(NTHREADS, 2) fwd(Args args) {
    extern __shared__ __attribute__((aligned(16))) unsigned char lds_raw[];
    Frame F;
#pragma unroll
    for (int i = 0; i < 23; ++i) F.in[i] = args.in[i];
    F.out = args.out; F.ws = args.ws; F.lds = (LAS unsigned char*)lds_raw;
    F.tid = threadIdx.x; F.lane = F.tid & 63; F.wave = __builtin_amdgcn_readfirstlane(F.tid >> 6); F.G = gridDim.x;
    volatile LAS unsigned* misc = (volatile LAS unsigned*)(F.lds + LDS_MISC_OFF);
    if (F.tid < 64) misc[F.tid] = 0u;
    __syncthreads();
    XcdBarrier bar; bar.bar = (unsigned*)(F.ws + WS_CTL); bar.x = 0; bar.st = misc;
    const int lo = args.ph_lo, hi = args.ph_hi;
    if (hi - lo > 1) bar = xcd_barrier_post((unsigned*)(F.ws + WS_CTL), misc);
#ifndef PH_MASK
#define PH_MASK 0xFFFF
#endif
#define IN(k) (((PH_MASK >> (k)) & 1) && lo <= (k) && (k) < hi)
#define SEAM(k) do { if (IN(k) && IN((k) + 1)) xcd_barrier(bar); } while (0)
    const float* MOD = (const float*)(F.ws + WS_MOD);
    if (IN(0)) { p0_prologue(F); } SEAM(0);
    if (IN(1)) { norm_mod_rows(F, F.in[0], F.in[2], 0, 1024, (bf16_t*)(F.ws + WS_H)); } SEAM(1);
    if (IN(2)) { pg8::Gemm g{(const pg8::bf16_t*)(F.ws + WS_H), (const pg8::bf16_t*)(F.ws + WS_WIN), T, NPAD, D}; pg8::StaticOrder So; So.init(T, NPAD, F.G, (int)blockIdx.x);
        pg8::EpiBf16<0> E{(pg8::bf16_t*)(F.ws + WS_PROJ), NPAD, nullptr, 0, 0};
        pg8::gemm_phase<pg8::EpiBf16<0>, pg8::StaticOrder>(F.lds, g, So, E, nullptr); } SEAM(2);
#ifdef COMPRESS_NAIVE
    if (IN(3)) { p3_compress_naive(F); } SEAM(3);
#else
    if (IN(3)) { p3_compress_mfma(F); } SEAM(3);
#endif
    #ifdef ATTN_NAIVE
    if (IN(4)) { p4_attn_naive(F); } SEAM(4);
#else
    if (IN(4)) { p4_attn_mfma(F); } SEAM(4);
#endif
    if (IN(5)) { p5_mixed(F); } SEAM(5);
    if (IN(6)) { pg8::Gemm g{(const pg8::bf16_t*)(F.ws + WS_H), (const pg8::bf16_t*)(F.ws + WS_WOUT), T, D, D}; pg8::StaticOrder So; So.init(T, D, F.G, (int)blockIdx.x);
        EpiResGate E{F.out, F.in[0], MOD, 2048};
        pg8::gemm_phase<EpiResGate, pg8::StaticOrder>(F.lds, g, So, E, nullptr); } SEAM(6);
    if (IN(7)) { norm_mod_rows_q(F, F.out, F.in[3], 3072, 4096, (bf16_t*)(F.ws + WS_H)); } SEAM(7);
    if (IN(8)) { pg8::Gemm g{(const pg8::bf16_t*)(F.ws + WS_H), (const pg8::bf16_t*)(F.ws + WS_WQ), T, D, D}; pg8::StaticOrder So; So.init(T, D, F.G, (int)blockIdx.x);
        pg8::EpiBf16<0> E{(pg8::bf16_t*)(F.ws + WS_QP), D, nullptr, 0, 0};
        pg8::gemm_phase<pg8::EpiBf16<0>, pg8::StaticOrder>(F.lds, g, So, E, nullptr); } SEAM(8);
    #ifdef ROUTE_NAIVE
    if (IN(9)) { p9_route_naive(F); } SEAM(9);
#else
    if (IN(9)) { p9_route_mfma(F); } SEAM(9);
#endif
    if (IN(10)) { p10a_udots(F); } SEAM(10);
    if (IN(11)) { p10b_coef(F); } SEAM(11);
    if (IN(12)) { p10c_vsum(F); } SEAM(12);
    if (IN(13)) { p10d_final(F); }
#undef IN
#undef SEAM
}

extern "C" void kernel_launch(void* const* d_in, const int* in_sizes, int n_in, void* d_out, int out_size, void* d_ws, size_t ws_size, hipStream_t stream) {
    static int grid = 0;
    if (grid == 0) {
        if (n_in != 23 || out_size != T * D || ws_size < WS_END) { fprintf(stderr, "kernel_launch: unexpected shapes: n_in %d out %d ws %zu (need %zu)\n", n_in, out_size, ws_size, (size_t)WS_END); grid = -1; return; }
        int dev = 0, cus = 0, per_cu = 0;
        if (hipGetDevice(&dev) != hipSuccess || hipDeviceGetAttribute(&cus, hipDeviceAttributeMultiprocessorCount, dev) != hipSuccess) { grid = -1; return; }
        if (hipFuncSetAttribute((const void*)fwd, hipFuncAttributeMaxDynamicSharedMemorySize, LDS_BYTES) != hipSuccess) { fprintf(stderr, "kernel_launch: hipFuncSetAttribute failed\n"); grid = -1; return; }
        if (hipOccupancyMaxActiveBlocksPerMultiprocessor(&per_cu, (const void*)fwd, NTHREADS, LDS_BYTES) != hipSuccess || per_cu < 1) { fprintf(stderr, "kernel_launch: occupancy query says %d\n", per_cu); (void)hipGetLastError(); per_cu = 1; }
        grid = cus;
    }
    if (grid < 0) return;
    (void)hipMemsetAsync((char*)d_ws + WS_CTL, 0, CTL_BYTES, stream);
    Args a{};
    for (int i = 0; i < 23; ++i) a.in[i] = (const float*)d_in[i];
    a.out = (float*)d_out; a.ws = (unsigned char*)d_ws;
#if MK_N_LAUNCHES == 1
    a.ph_lo = 0; a.ph_hi = N_PHASES;
    hipLaunchKernelGGL(fwd, dim3(grid), dim3(NTHREADS), LDS_BYTES, stream, a);
#else
#ifdef PROBE_LIST
    { const int plist[] = PROBE_LIST; for (int p : plist) { if (p < 0) { (void)hipMemsetAsync((char*)d_ws + WS_CTL, 0, CTL_BYTES, stream); continue; } a.ph_lo = p; a.ph_hi = p + 1; hipLaunchKernelGGL(fwd, dim3(grid), dim3(NTHREADS), LDS_BYTES, stream, a); } }
#else
    for (int p = 0; p < N_PHASES; ++p) { a.ph_lo = p; a.ph_hi = p + 1; hipLaunchKernelGGL(fwd, dim3(grid), dim3(NTHREADS), LDS_BYTES, stream, a); }
#endif
#endif
}
```

```cpp
#include <hip/hip_runtime.h>
#include <cstdio>
#include <cstdint>
#include <cstdlib>

#ifndef MK_N_LAUNCHES
#define MK_N_LAUNCHES 1
#endif
#define XB_TMO      128
#define XB_XCNT(j)  (256  + 64 * (j))
#define XB_XSUB(j)  (1280 + 64 * (j))
#define XB_XGEN(j)  (2304 + 64 * (j))
#define XB_TOP      3328
#define XB_TOPGEN   3392
#define XCD_BAR_WORDS 3456
#define XB_SPIN_CAP (1u << 18)
#define LAS __attribute__((address_space(3)))

__device__ __forceinline__ unsigned xb_ld(unsigned* p)              { return __hip_atomic_load(p, __ATOMIC_RELAXED, __HIP_MEMORY_SCOPE_AGENT); }
__device__ __forceinline__ unsigned xb_add(unsigned* p, unsigned v) { return __hip_atomic_fetch_add(p, v, __ATOMIC_RELAXED, __HIP_MEMORY_SCOPE_AGENT); }
__device__ __forceinline__ unsigned xb_xcc_id() { return (unsigned)__builtin_amdgcn_s_getreg((3 << 11) | 20) & 0xFu; }
#define XB_SPIN(cond, bar) do { unsigned _sp = 0; while (cond) { __builtin_amdgcn_s_sleep(1); \
    if ((++_sp & 255u) == 0u) { if (xb_ld(&(bar)[XB_TMO])) break; if (_sp > XB_SPIN_CAP) { atomicAdd(&(bar)[XB_TMO], 1u); break; } } } } while (0)

struct XcdBarrier {
    unsigned* bar; unsigned x;
    volatile LAS unsigned* st;
};

__device__ __forceinline__ XcdBarrier xcd_barrier_post(unsigned* bar, volatile LAS unsigned* st) {
    XcdBarrier b; b.bar = bar; b.x = xb_xcc_id(); b.st = st;
    if (threadIdx.x == 0) (void)xb_add(&bar[XB_XCNT(b.x)], 1u);
    return b;
}
__device__ __forceinline__ void xcd_barrier_complete(unsigned* bar, unsigned x, unsigned& nloc, unsigned& nx) {
    const unsigned G = gridDim.x * gridDim.y * gridDim.z;
    unsigned sum, cnt, mine, sp = 0u;
    for (;;) {
        sum = 0u; cnt = 0u; mine = 0u;
#pragma unroll
        for (unsigned j = 0; j < 16; ++j) { const unsigned c = xb_ld(&bar[XB_XCNT(j)]); sum += c; cnt += (c > 0u) ? 1u : 0u; mine = (j == x) ? c : mine; }
        if (sum == G) break;
        __builtin_amdgcn_s_sleep(1);
        if ((++sp & 255u) == 0u) { if (xb_ld(&bar[XB_TMO])) break; if (sp > XB_SPIN_CAP) { atomicAdd(&bar[XB_TMO], 1u); break; } }
    }
    nloc = mine > 0u ? mine : 1u; nx = cnt > 0u ? cnt : 1u;
}

__device__ __forceinline__ void xcd_barrier(const XcdBarrier& b) {
    asm volatile("s_waitcnt vmcnt(0)" ::: "memory");
    __syncthreads();
    if (threadIdx.x == 0) {
        unsigned* bar = b.bar;
        __builtin_amdgcn_s_waitcnt(0);
        unsigned nloc = b.st[0], nx = b.st[1];
        if (nloc == 0u) { xcd_barrier_complete(bar, b.x, nloc, nx); b.st[0] = nloc; b.st[1] = nx; }
        const unsigned old = xb_add(&bar[XB_XSUB(b.x)], 1u);
        const unsigned gen = old / nloc;
        if (old + 1u == (gen + 1u) * nloc) {
            __builtin_amdgcn_fence(__ATOMIC_RELEASE, "agent");
            asm volatile("s_waitcnt vmcnt(0)" ::: "memory");
            const unsigned og = xb_add(&bar[XB_TOP], 1u);
            const unsigned tg = og / nx;
            if (og + 1u == (tg + 1u) * nx) xb_add(&bar[XB_TOPGEN], 1u);
            else XB_SPIN(xb_ld(&bar[XB_TOPGEN]) == tg, bar);
            __builtin_amdgcn_fence(__ATOMIC_ACQUIRE, "agent");
            xb_add(&bar[XB_XGEN(b.x)], 1u);
            asm volatile("s_waitcnt vmcnt(0)" ::: "memory");
        } else {
            XB_SPIN(xb_ld(&bar[XB_XGEN(b.x)]) == gen, bar);
            __builtin_amdgcn_fence(__ATOMIC_ACQUIRE, "agent");
            asm volatile("s_waitcnt vmcnt(0)" ::: "memory");
        }
    }
    __syncthreads();
}

namespace pg8 {
#define PG8_LAS __attribute__((address_space(3)))
typedef unsigned short bf16_t;
typedef short bf16x8 __attribute__((ext_vector_type(8)));
typedef float f32x4 __attribute__((ext_vector_type(4)));
typedef unsigned u32x4 __attribute__((ext_vector_type(4)));
constexpr int BM = 256, BK = 64, HALF = 128, HTB = HALF * BK * 2  , STAGE_BYTES = 8 * HTB, NXCD = 8, WGM = 8;

__host__ __device__ __forceinline__ int lds_byte(int r, int c) { const int st = (r >> 4) * 2 + (c >> 5), rr = r & 15, cc = c & 31, ob = rr * 64 + cc * 2; return st * 1024 + (ob ^ (((ob >> 9) & 1) << 5)); }
__host__ __device__ __forceinline__ void stage_rc(int b, int& R, int& C) { const int st = b / 1024, sb = b % 1024, swz = sb ^ (((sb >> 9) & 1) << 5); R = (st >> 1) * 16 + swz / 64; C = (st & 1) * 32 + (swz % 64) / 2; }
__host__ __device__ __forceinline__ int perm32(int rho) { const int n = rho >> 4, i = rho & 15; return 8 * (i >> 2) + 4 * n + (i & 3); }

struct Unit { int pm, pn; };
struct Gemm { const bf16_t* A; const bf16_t* Bt; int M, N, K; };

struct StaticOrder {
    int nM, nN, nwg, G, c;
    __host__ __device__ void init(int M, int N, int G_, int c_) { nM = M / BM; nN = N / BM; nwg = nM * nN; G = G_; c = c_; }
    __host__ __device__ bool next(int i, Unit& u) const {
        const long L = (long)i * G + c; if (L >= nwg) return false;
        int wgid = (int)L; { const int q = nwg / NXCD, r = nwg % NXCD, xcd = wgid % NXCD, off = wgid / NXCD; wgid = (xcd < r ? xcd * (q + 1) : r * (q + 1) + (xcd - r) * q) + off; }
        const int nig = WGM * nN, gid = wgid / nig, fm = gid * WGM, gsz = (nM - fm) < WGM ? (nM - fm) : WGM;
        u.pm = fm + ((wgid % nig) % gsz); u.pn = (wgid % nig) / gsz; return true;
    }
    __device__ __forceinline__ void a_ready(const Unit&) const {}
    __device__ __forceinline__ void done(const Unit&) const {}
};
struct CountedOrder : StaticOrder {
    const unsigned* ready; unsigned need; unsigned* tmo;
    __device__ __forceinline__ void a_ready(const Unit& u) const {
        if (threadIdx.x < 64) {
            const unsigned long long t0 = __builtin_amdgcn_s_memrealtime(); unsigned polls = 0;
            while ((unsigned)__builtin_amdgcn_readfirstlane(__hip_atomic_load(ready + 64 * u.pm, __ATOMIC_RELAXED, __HIP_MEMORY_SCOPE_AGENT)) < need) {
                if ((++polls & 255u) == 0u && __builtin_amdgcn_readfirstlane(__hip_atomic_load(tmo, __ATOMIC_RELAXED, __HIP_MEMORY_SCOPE_AGENT)) != 0u) break;
                if (__builtin_amdgcn_s_memrealtime() - t0 > 2000000ull) {
                    if (threadIdx.x == 0) { unsigned expect = 0u; __hip_atomic_compare_exchange_strong(tmo + 1, &expect, 0x600u | (unsigned)(u.pm & 0xff), __ATOMIC_RELAXED, __ATOMIC_RELAXED, __HIP_MEMORY_SCOPE_AGENT); __hip_atomic_store(tmo, 1u, __ATOMIC_RELAXED, __HIP_MEMORY_SCOPE_AGENT); }
                    break; }
                __builtin_amdgcn_s_sleep(2); }
            __builtin_amdgcn_fence(__ATOMIC_ACQUIRE, "agent");
            asm volatile("s_waitcnt vmcnt(0)" ::: "memory");
        }
#if !defined(BROKEN_HOOK_NO_BARRIER)
        asm volatile("" ::: "memory"); __builtin_amdgcn_s_barrier(); asm volatile("" ::: "memory");
#endif
    }
};

__device__ __forceinline__ unsigned cvt_pk_bf16(float lo, float hi) { unsigned r; asm volatile("v_cvt_pk_bf16_f32 %0, %1, %2" : "=v"(r) : "v"(lo), "v"(hi)); return r; }
typedef float f32x2 __attribute__((ext_vector_type(2)));
__device__ __forceinline__ f32x2 gelu_pk(f32x2 v) {
    const f32x2 av = __builtin_elementwise_abs(v), d = av * 0.2316418882f + 1.0f;
    f32x2 t; t.x = __builtin_amdgcn_rcpf(d.x); t.y = __builtin_amdgcn_rcpf(d.y);
    f32x2 q = t * 0.5307027145f + (-0.7265760135f); q = q * t + 0.7107068705f; q = q * t + (-0.142248368f); q = q * t + 0.127414796f; q = q * t;
    const f32x2 s = (v * v) * (-0.72134752044f);
    f32x2 e; e.x = __builtin_amdgcn_exp2f(s.x); e.y = __builtin_amdgcn_exp2f(s.y);
    const f32x2 m = v * (q * e), r = v - m;
    f32x2 o; o.x = v.x < 0.f ? m.x : r.x; o.y = v.y < 0.f ? m.y : r.y; return o;
}

struct EpiF32 {
    static constexpr bool PERM = false, AFTER_DRAIN = false;
    float* C; int ldc; const float* bias;
    __device__ __forceinline__ void operator()(const f32x4 (&acc)[2][2][4][2], const Unit& u, int wr, int wc, int fr, int fq) const {
        const int row0 = u.pm * BM + wr * 64 + fr, col0 = u.pn * BM + wc * 32 + 4 * fq;
        f32x4 bv[2][2];
#pragma unroll
        for (int bj = 0; bj < 2; ++bj)
#pragma unroll
            for (int n = 0; n < 2; ++n) bv[bj][n] = bias ? *(const f32x4*)(bias + col0 + bj * HALF + n * 16) : (f32x4){0.f, 0.f, 0.f, 0.f};
#pragma unroll
        for (int ai = 0; ai < 2; ++ai)
#pragma unroll
            for (int m = 0; m < 4; ++m) { float* rowp = C + (size_t)(row0 + ai * HALF + m * 16) * ldc + col0;
#pragma unroll
                for (int bj = 0; bj < 2; ++bj)
#pragma unroll
                    for (int n = 0; n < 2; ++n) *(f32x4*)(rowp + bj * HALF + n * 16) = acc[ai][bj][m][n] + bv[bj][n]; }
    }
};
template <int ACT  > struct EpiBf16 {
    static constexpr bool PERM = true, AFTER_DRAIN = false;
    bf16_t* O; int ldc; const float* bias; int split_cols; size_t split_stride;
    __device__ __forceinline__ void operator()(const f32x4 (&acc)[2][2][4][2], const Unit& u, int wr, int wc, int fr, int fq) const {
        const int row0 = u.pm * BM + wr * 64 + fr; int colt = u.pn * BM; bf16_t* base = O;
        if (split_cols) { const int t = colt / split_cols; base += (size_t)t * split_stride; colt -= t * split_cols; }
        const int col0 = colt + wc * 32 + 8 * fq, bcol0 = u.pn * BM + wc * 32 + 8 * fq;
        f32x4 bv[2][2];
#pragma unroll
        for (int bj = 0; bj < 2; ++bj)
#pragma unroll
            for (int n = 0; n < 2; ++n) bv[bj][n] = bias ? *(const f32x4*)(bias + bcol0 + bj * HALF + 4 * n) : (f32x4){0.f, 0.f, 0.f, 0.f};
#pragma unroll
        for (int ai = 0; ai < 2; ++ai)
#pragma unroll
            for (int m = 0; m < 4; ++m) { bf16_t* rowp = base + (size_t)(row0 + ai * HALF + m * 16) * ldc + col0;
#pragma unroll
                for (int bj = 0; bj < 2; ++bj) { f32x4 v0 = acc[ai][bj][m][0] + bv[bj][0], v1 = acc[ai][bj][m][1] + bv[bj][1];
                    if (ACT == 1) { f32x2 a = gelu_pk((f32x2){v0[0], v0[1]}), b = gelu_pk((f32x2){v0[2], v0[3]}), c = gelu_pk((f32x2){v1[0], v1[1]}), d = gelu_pk((f32x2){v1[2], v1[3]});
                        v0 = (f32x4){a.x, a.y, b.x, b.y}; v1 = (f32x4){c.x, c.y, d.x, d.y}; }
                    if (ACT == 2) {
#pragma unroll
                        for (int j = 0; j < 4; ++j) { v0[j] = 0.5f * v0[j] * (1.0f + erff(v0[j] * 0.70710678f)); v1[j] = 0.5f * v1[j] * (1.0f + erff(v1[j] * 0.70710678f)); } }
                    u32x4 w; w.x = cvt_pk_bf16(v0[0], v0[1]); w.y = cvt_pk_bf16(v0[2], v0[3]); w.z = cvt_pk_bf16(v1[0], v1[1]); w.w = cvt_pk_bf16(v1[2], v1[3]);
                    *(u32x4*)(rowp + bj * HALF) = w; } }
    }
};

struct PanelStats {
    unsigned* xbuf;
    unsigned* cnt;
    unsigned* tmo;
    int ntn; float eps;
    unsigned code;
    __device__ __forceinline__ bool run(const f32x4 (&v)[2][2][4][2], const Unit& u, int wr, int wc, int fr, int fq, PG8_LAS unsigned char* lds, int wid, int lane) const {
        typedef float f32x2v __attribute__((ext_vector_type(2)));
        PG8_LAS f32x2v* P = (PG8_LAS f32x2v*)lds;
        PG8_LAS f32x2v* S = (PG8_LAS f32x2v*)(lds + 8192);
        PG8_LAS unsigned* flag = (PG8_LAS unsigned*)(lds + 8192 + 2048);
#pragma unroll
        for (int ai = 0; ai < 2; ++ai)
#pragma unroll
            for (int m = 0; m < 4; ++m) {
                float s = 0.f;
#pragma unroll
                for (int bj = 0; bj < 2; ++bj)
#pragma unroll
                    for (int n = 0; n < 2; ++n) { const f32x4 x = v[ai][bj][m][n]; s += (x[0] + x[1]) + (x[2] + x[3]); }
                s += __shfl_xor(s, 16); s += __shfl_xor(s, 32);
                const float mw = s * (1.0f / 64.0f); float q = 0.f;
#pragma unroll
                for (int bj = 0; bj < 2; ++bj)
#pragma unroll
                    for (int n = 0; n < 2; ++n) { const f32x4 d = v[ai][bj][m][n] - mw; q += (d[0] * d[0] + d[1] * d[1]) + (d[2] * d[2] + d[3] * d[3]); }
                q += __shfl_xor(q, 16); q += __shfl_xor(q, 32);
                if (fq == 0) P[(ai * HALF + wr * 64 + m * 16 + fr) * 4 + wc] = (f32x2v){mw, q};
            }
        asm volatile("s_waitcnt lgkmcnt(0)" ::: "memory"); __builtin_amdgcn_s_barrier(); asm volatile("" ::: "memory");
#if defined(BROKEN_NO_WAIT)
        if (blockIdx.x >= 64) { const long long t0 = clock64(); while (clock64() - t0 < 60000) __builtin_amdgcn_s_sleep(8); }
#endif
        const int row = wid * 32 + (lane & 31);
        if (lane < 32) {
            const f32x2v a = P[row * 4 + 0], b = P[row * 4 + 1], c = P[row * 4 + 2], d = P[row * 4 + 3];
            const float mt = (a.x + b.x + c.x + d.x) * 0.25f;
            const float da = a.x - mt, db = b.x - mt, dc = c.x - mt, dd = d.x - mt;
            const float m2 = (a.y + b.y) + (c.y + d.y) + 64.0f * ((da * da + db * db) + (dc * dc + dd * dd));
            unsigned long long* slot = (unsigned long long*)xbuf + ((size_t)(u.pm * BM + row) * 4 + u.pn);
            __hip_atomic_store(slot, ((unsigned long long)__float_as_uint(m2) << 32) | __float_as_uint(mt), __ATOMIC_RELAXED, __HIP_MEMORY_SCOPE_AGENT);
        }
        asm volatile("s_waitcnt vmcnt(0)" ::: "memory");
        if (lane == 0) __hip_atomic_fetch_add(cnt + 64 * u.pm, 1u, __ATOMIC_RELAXED, __HIP_MEMORY_SCOPE_AGENT);
        if (wid == 0) {
            bool dead = false; const unsigned long long t0 = __builtin_amdgcn_s_memrealtime(); const unsigned want = 8u * (unsigned)ntn;
            for (;;) {
#if defined(BROKEN_NO_WAIT)
                break;
#endif
                if ((unsigned)__builtin_amdgcn_readfirstlane(__hip_atomic_load(cnt + 64 * u.pm, __ATOMIC_RELAXED, __HIP_MEMORY_SCOPE_AGENT)) >= want) break;
                if (__builtin_amdgcn_s_memrealtime() - t0 > 2000000ull) {
                    if (lane == 0) { unsigned expect = 0u; __hip_atomic_compare_exchange_strong(tmo + 1, &expect, code | (unsigned)(u.pm & 0xff), __ATOMIC_RELAXED, __ATOMIC_RELAXED, __HIP_MEMORY_SCOPE_AGENT);
                                     __hip_atomic_store(tmo, 1u, __ATOMIC_RELAXED, __HIP_MEMORY_SCOPE_AGENT); }
                    dead = true; break; }
                __builtin_amdgcn_s_sleep(2);
            }
            __builtin_amdgcn_fence(__ATOMIC_ACQUIRE, "agent");
            if (lane == 0) flag[0] = dead ? 1u : 0u;
        }
        asm volatile("s_waitcnt vmcnt(0) lgkmcnt(0)" ::: "memory"); __builtin_amdgcn_s_barrier(); asm volatile("" ::: "memory");
        const bool bad = flag[0] != 0u;
        if (lane < 32) {
            const unsigned long long* slot = (const unsigned long long*)xbuf + (size_t)(u.pm * BM + row) * 4; float mt[4], m2[4]; float ms = 0.f;
#pragma unroll
            for (int t = 0; t < 4; ++t) { if (t < ntn) { const unsigned long long w = __hip_atomic_load(slot + t, __ATOMIC_RELAXED, __HIP_MEMORY_SCOPE_AGENT); mt[t] = __uint_as_float((unsigned)w); m2[t] = __uint_as_float((unsigned)(w >> 32)); } else { mt[t] = 0.f; m2[t] = 0.f; } ms += mt[t]; }
            const float mean = ms / (float)ntn; float q = 0.f;
#pragma unroll
            for (int t = 0; t < 4; ++t) if (t < ntn) { const float dm = mt[t] - mean; q += m2[t] + 256.0f * dm * dm; }
            S[row] = (f32x2v){mean, 1.0f / sqrtf(q / (256.0f * (float)ntn) + eps)};
        }
        asm volatile("s_waitcnt lgkmcnt(0)" ::: "memory"); __builtin_amdgcn_s_barrier(); asm volatile("" ::: "memory");
        return bad;
    }
};
struct EpiLnRes {
    static constexpr bool PERM = false, AFTER_DRAIN = true;
    const float* base; float* out; int ldc; const float* bias; PanelStats st; unsigned poison;
    __device__ __forceinline__ void refuse(size_t i0, size_t stride, int M, int N) const { const float q = __builtin_nanf(""); for (size_t i = i0; i < (size_t)M * N; i += stride) out[(i / N) * ldc + i % N] = q;
        if (i0 == 0) { unsigned expect = 0u; __hip_atomic_compare_exchange_strong(st.tmo + 1, &expect, 0x7f0u, __ATOMIC_RELAXED, __ATOMIC_RELAXED, __HIP_MEMORY_SCOPE_AGENT); __hip_atomic_store(st.tmo, 1u, __ATOMIC_RELAXED, __HIP_MEMORY_SCOPE_AGENT); } }
    __device__ __forceinline__ void fused(f32x4 (&acc)[2][2][4][2], const Unit& u, int wr, int wc, int fr, int fq, PG8_LAS unsigned char* lds, int wid, int lane) const {
        typedef float f32x2v __attribute__((ext_vector_type(2)));
        const PG8_LAS f32x2v* S = (const PG8_LAS f32x2v*)(lds + 8192);
        const int col0 = u.pn * BM + wc * 32 + 4 * fq;
#pragma unroll
        for (int bj = 0; bj < 2; ++bj)
#pragma unroll
            for (int n = 0; n < 2; ++n) { const f32x4 bv = bias ? *(const f32x4*)(bias + col0 + bj * HALF + n * 16) : (f32x4){0.f, 0.f, 0.f, 0.f};
#pragma unroll
                for (int ai = 0; ai < 2; ++ai)
#pragma unroll
                    for (int m = 0; m < 4; ++m) acc[ai][bj][m][n] += bv; }
        const bool bad = st.run(acc, u, wr, wc, fr, fq, lds, wid, lane) || poison != 0u;
        const float qnan = __builtin_nanf("");
#pragma unroll
        for (int ai = 0; ai < 2; ++ai)
#pragma unroll
            for (int m = 0; m < 4; ++m) { const int r = ai * HALF + wr * 64 + m * 16 + fr; const f32x2v sr = S[r]; const size_t off = (size_t)(u.pm * BM + r) * ldc + col0;
#pragma unroll
                for (int bj = 0; bj < 2; ++bj)
#pragma unroll
                    for (int n = 0; n < 2; ++n) { const f32x4 bs = *(const f32x4*)(base + off + bj * HALF + n * 16); f32x4 o = bs + (acc[ai][bj][m][n] - sr.x) * sr.y;
                        if (bad) o = (f32x4){qnan, qnan, qnan, qnan}; *(f32x4*)(out + off + bj * HALF + n * 16) = o; }
                asm volatile("" ::: "memory"); }
    }
};
struct EpiLnResLn {
    static constexpr bool PERM = false, AFTER_DRAIN = true;
    const float* base; float* out; bf16_t* xn; int ldc; const float* bias; PanelStats st1, st2; unsigned poison;
    __device__ __forceinline__ void refuse(size_t i0, size_t stride, int M, int N) const { const float q = __builtin_nanf(""); for (size_t i = i0; i < (size_t)M * N; i += stride) { const size_t o = (i / N) * ldc + i % N; out[o] = q; xn[o] = (bf16_t)0x7fc0u; }
        if (i0 == 0) { unsigned expect = 0u; __hip_atomic_compare_exchange_strong(st1.tmo + 1, &expect, 0x7f0u, __ATOMIC_RELAXED, __ATOMIC_RELAXED, __HIP_MEMORY_SCOPE_AGENT); __hip_atomic_store(st1.tmo, 1u, __ATOMIC_RELAXED, __HIP_MEMORY_SCOPE_AGENT); } }
    __device__ __forceinline__ void fused(f32x4 (&acc)[2][2][4][2], const Unit& u, int wr, int wc, int fr, int fq, PG8_LAS unsigned char* lds, int wid, int lane) const {
        typedef float f32x2v __attribute__((ext_vector_type(2))); typedef unsigned u32x2v __attribute__((ext_vector_type(2)));
        const PG8_LAS f32x2v* S = (const PG8_LAS f32x2v*)(lds + 8192);
        const int col0 = u.pn * BM + wc * 32 + 4 * fq;
#pragma unroll
        for (int bj = 0; bj < 2; ++bj)
#pragma unroll
            for (int n = 0; n < 2; ++n) { const f32x4 bv = bias ? *(const f32x4*)(bias + col0 + bj * HALF + n * 16) : (f32x4){0.f, 0.f, 0.f, 0.f};
#pragma unroll
                for (int ai = 0; ai < 2; ++ai)
#pragma unroll
                    for (int m = 0; m < 4; ++m) acc[ai][bj][m][n] += bv; }
        bool bad = st1.run(acc, u, wr, wc, fr, fq, lds, wid, lane) || poison != 0u;
        const float qnan = __builtin_nanf("");
#pragma unroll
        for (int ai = 0; ai < 2; ++ai)
#pragma unroll
            for (int m = 0; m < 4; ++m) { const int r = ai * HALF + wr * 64 + m * 16 + fr; const f32x2v sr = S[r]; const size_t off = (size_t)(u.pm * BM + r) * ldc + col0;
#pragma unroll
                for (int bj = 0; bj < 2; ++bj)
#pragma unroll
                    for (int n = 0; n < 2; ++n) { const f32x4 bs = *(const f32x4*)(base + off + bj * HALF + n * 16); acc[ai][bj][m][n] = bs + (acc[ai][bj][m][n] - sr.x) * sr.y; }
                asm volatile("" : "+v"(acc[ai][0][m][0]), "+v"(acc[ai][0][m][1]), "+v"(acc[ai][1][m][0]), "+v"(acc[ai][1][m][1]));
                if (m & 1) asm volatile("" ::: "memory"); }
        const bool bad1 = bad;
        bad = st2.run(acc, u, wr, wc, fr, fq, lds, wid, lane) || bad;
#pragma unroll
        for (int ai = 0; ai < 2; ++ai)
#pragma unroll
            for (int m = 0; m < 4; ++m) { const int r = ai * HALF + wr * 64 + m * 16 + fr; const f32x2v sr = S[r]; const size_t off = (size_t)(u.pm * BM + r) * ldc + col0;
#pragma unroll
                for (int bj = 0; bj < 2; ++bj)
#pragma unroll
                    for (int n = 0; n < 2; ++n) { const f32x4 x1 = acc[ai][bj][m][n]; *(f32x4*)(out + off + bj * HALF + n * 16) = bad1 ? (f32x4){qnan, qnan, qnan, qnan} : x1;
                        const f32x4 o = (x1 - sr.x) * sr.y; u32x2v w; w.x = cvt_pk_bf16(o[0], o[1]); w.y = cvt_pk_bf16(o[2], o[3]);
                        if (bad) { w.x = 0x7fc07fc0u; w.y = 0x7fc07fc0u; } *(u32x2v*)(xn + off + bj * HALF + n * 16) = w; }
                asm volatile("" ::: "memory"); }
    }
};

template <class Epi, class Sched, bool STAMP = false>
__device__ __forceinline__ void gemm_phase(PG8_LAS unsigned char* lds, const Gemm g, const Sched& S, const Epi& E, unsigned long long* stamps) {
    const int tid = threadIdx.x, wid = __builtin_amdgcn_readfirstlane(tid >> 6), lane = tid & 63, wr = wid >> 2, wc = wid & 3, fr = lane & 15, fq = lane >> 4;
    const int K = g.K, nt = K / BK;
    int ts_lo = 0, ts_hi = 0, nts = 0; const unsigned long long rt_entry = STAMP ? (unsigned long long)wall_clock64() : 0ull;
#define PG8_STAMP() do { if (STAMP && wid == 0 && nts < 64) { const unsigned long long _c = (unsigned long long)clock64(); \
        ts_lo = (lane == nts) ? (int)(unsigned)_c : ts_lo; ts_hi = (lane == nts) ? (int)(unsigned)(_c >> 32) : ts_hi; ++nts; } } while (0)
    PG8_STAMP();
    unsigned voffA[2], voffB[2];
#pragma unroll
    for (int i = 0; i < 2; ++i) { int R, C; stage_rc(tid * 16 + i * 8192, R, C); const int Rb = Epi::PERM ? ((R & ~31) + perm32(R & 31)) : R;
        voffA[i] = (unsigned)(R * K + C) * 2u; voffB[i] = (unsigned)(Rb * K + C) * 2u; }
    const size_t kstep = (size_t)(BK * 2);
    const size_t hstep = (size_t)HALF * K * 2;
    const size_t tstep = 2 * hstep;
    const unsigned ldsw = (unsigned)wid * 1024u;
    const int aoff = lds_byte(wr * 64 + fr, fq * 8), boff = lds_byte(wc * 32 + fr, fq * 8);
#define PG8_SA(b, h) (((b) * 2 + (h)) * HTB)
#define PG8_SB(b, h) ((4 + (b) * 2 + (h)) * HTB)
#define PG8_STAGE(bufoff, gbase, voff) do { _Pragma("unroll") for (int _i = 0; _i < 2; ++_i) \
        __builtin_amdgcn_global_load_lds((const unsigned*)((const char*)(gbase) + (voff)[_i]), (PG8_LAS unsigned*)(lds + (bufoff) + ldsw + _i * 8192), 16, 0, 0); } while (0)
#define PG8_LDA(dst, b, h) do { _Pragma("unroll") for (int m = 0; m < 4; ++m) _Pragma("unroll") for (int k = 0; k < 2; ++k) dst[m][k] = *(const PG8_LAS bf16x8*)(lds + PG8_SA(b, h) + aoff + m * 2048 + k * 1024); } while (0)
#define PG8_LDB(dst, b, h) do { _Pragma("unroll") for (int n = 0; n < 2; ++n) _Pragma("unroll") for (int k = 0; k < 2; ++k) dst[n][k] = *(const PG8_LAS bf16x8*)(lds + PG8_SB(b, h) + boff + n * 2048 + k * 1024); } while (0)
#define PG8_MMA(ai, bj, At, Bt) do { __builtin_amdgcn_s_setprio(1); _Pragma("unroll") for (int m = 0; m < 4; ++m) _Pragma("unroll") for (int n = 0; n < 2; ++n) _Pragma("unroll") for (int k = 0; k < 2; ++k) \
        acc[ai][bj][m][n] = __builtin_amdgcn_mfma_f32_16x16x32_bf16(Bt[n][k], At[m][k], acc[ai][bj][m][n], 0, 0, 0); __builtin_amdgcn_s_setprio(0); } while (0)
#define PG8_WAIT_V(n) asm volatile("s_waitcnt vmcnt(" #n ")" ::: "memory")
#define PG8_WAIT_L(n) asm volatile("s_waitcnt lgkmcnt(" #n ")" ::: "memory")
#define PG8_BAR __builtin_amdgcn_s_barrier()
#define PG8_SCHED __builtin_amdgcn_sched_barrier(0)
    Unit cur, nxt; int ui = 0;
    if (!S.next(0, cur)) return;
    f32x4 acc[2][2][4][2];
#pragma unroll
    for (int a = 0; a < 2; ++a)
#pragma unroll
        for (int b = 0; b < 2; ++b)
#pragma unroll
            for (int m = 0; m < 4; ++m)
#pragma unroll
                for (int n = 0; n < 2; ++n) acc[a][b][m][n] = (f32x4){0.f, 0.f, 0.f, 0.f};
    bf16x8 At[4][2], B0[2][2], B1[2][2];
    const char* cA = (const char*)g.A + (size_t)cur.pm * tstep; const char* cB = (const char*)g.Bt + (size_t)cur.pn * tstep;
    S.a_ready(cur);
    PG8_STAGE(PG8_SB(0, 0), cB, voffB); PG8_STAGE(PG8_SA(0, 0), cA, voffA); PG8_STAGE(PG8_SB(0, 1), cB + hstep, voffB); PG8_STAGE(PG8_SA(0, 1), cA + hstep, voffA);
    if (wr == 1) PG8_BAR;
    PG8_WAIT_V(4); PG8_BAR;
    PG8_STAGE(PG8_SB(1, 0), cB + kstep, voffB); PG8_STAGE(PG8_SA(1, 0), cA + kstep, voffA); PG8_STAGE(PG8_SB(1, 1), cB + hstep + kstep, voffB);
    PG8_WAIT_V(6); PG8_BAR;
    PG8_STAMP();
    for (;;) {
        const bool has_next = S.next(ui + 1, nxt);
        const char* nA = has_next ? (const char*)g.A + (size_t)nxt.pm * tstep : cA; const char* nB = has_next ? (const char*)g.Bt + (size_t)nxt.pn * tstep : cB;
        for (int t = 0; t < nt; t += 2) {
            const bool last = (t == nt - 2);
            const char* a1 = cA + (size_t)(t + 1) * kstep;
            const char* a2 = last ? nA : cA + (size_t)(t + 2) * kstep; const char* b2 = last ? nB : cB + (size_t)(t + 2) * kstep;
            const char* a3 = a2 + kstep; const char* b3 = b2 + kstep;
            if (last && has_next) S.a_ready(nxt);
            PG8_LDB(B0, 0, 0); PG8_SCHED; PG8_LDA(At, 0, 0); PG8_STAGE(PG8_SA(1, 1), a1 + hstep, voffA);
            PG8_WAIT_L(8); PG8_BAR; PG8_WAIT_L(0); PG8_MMA(0, 0, At, B0); PG8_BAR; PG8_SCHED;
            PG8_LDB(B1, 0, 1); PG8_STAGE(PG8_SB(0, 0), b2, voffB);
            PG8_BAR; PG8_WAIT_L(0); PG8_MMA(0, 1, At, B1); PG8_BAR;
            PG8_LDA(At, 0, 1); PG8_STAGE(PG8_SA(0, 0), a2, voffA);
            PG8_BAR; PG8_WAIT_L(0); PG8_MMA(1, 0, At, B0); PG8_BAR; PG8_SCHED;
            PG8_STAGE(PG8_SB(0, 1), b2 + hstep, voffB);
            PG8_WAIT_V(6); PG8_BAR; PG8_MMA(1, 1, At, B1); PG8_BAR;
            PG8_LDB(B0, 1, 0); PG8_SCHED; PG8_LDA(At, 1, 0); PG8_STAGE(PG8_SA(0, 1), a2 + hstep, voffA);
            PG8_WAIT_L(8); PG8_BAR; PG8_WAIT_L(0); PG8_MMA(0, 0, At, B0); PG8_BAR; PG8_SCHED;
            PG8_LDB(B1, 1, 1); PG8_STAGE(PG8_SB(1, 0), b3, voffB);
            PG8_BAR; PG8_WAIT_L(0); PG8_MMA(0, 1, At, B1); PG8_BAR;
            PG8_LDA(At, 1, 1); PG8_STAGE(PG8_SA(1, 0), a3, voffA);
            PG8_BAR; PG8_WAIT_L(0); PG8_MMA(1, 0, At, B0); PG8_BAR; PG8_SCHED;
            PG8_STAGE(PG8_SB(1, 1), b3 + hstep, voffB);
            PG8_WAIT_V(6); PG8_BAR; PG8_MMA(1, 1, At, B1); PG8_BAR;
        }
        PG8_STAMP();
        if constexpr (!Epi::AFTER_DRAIN) { E(acc, cur, wr, wc, fr, fq); S.done(cur); }
        PG8_STAMP();
        if (!has_next) break;
#pragma unroll
        for (int a = 0; a < 2; ++a)
#pragma unroll
            for (int b = 0; b < 2; ++b)
#pragma unroll
                for (int m = 0; m < 4; ++m)
#pragma unroll
                    for (int n = 0; n < 2; ++n) acc[a][b][m][n] = (f32x4){0.f, 0.f, 0.f, 0.f};
        cur = nxt; cA = nA; cB = nB; ++ui;
    }
    PG8_WAIT_V(0);
    if (wr == 0) PG8_BAR;
    PG8_BAR;
    if constexpr (Epi::AFTER_DRAIN) { E.fused(acc, cur, wr, wc, fr, fq, lds, wid, lane); S.done(cur); }
    PG8_STAMP();
    if (STAMP && wid == 0) { stamps[lane] = lane < nts ? (((unsigned long long)(unsigned)ts_hi << 32) | (unsigned)ts_lo) : 0ull;
        if (lane == 62) stamps[62] = rt_entry; if (lane == 63) stamps[63] = (unsigned long long)wall_clock64(); }
#undef PG8_STAMP
#undef PG8_SA
#undef PG8_SB
#undef PG8_STAGE
#undef PG8_LDA
#undef PG8_LDB
#undef PG8_MMA
#undef PG8_WAIT_V
#undef PG8_WAIT_L
#undef PG8_BAR
#undef PG8_SCHED
}
}

constexpr int D = 1024, NB = 16, S = 2048, T = NB * S;
constexpr int NCOL = 2840, NPAD = 3072;
constexpr int C_Q = 0, C_KC = 512, C_VC = 640, C_KS = 768, C_VS = 896, C_KW = 1024, C_VW = 1152, C_GT = 1280, C_CB = 1304, C_CC = 1816, C_CH = 2328;
constexpr int NCMP = 127;
constexpr int NEXP = 16384;
constexpr float EPS = 1e-6f;
constexpr int NTHREADS = 512, NWAVES = 8;

constexpr size_t al256(size_t x) { return (x + 255) & ~(size_t)255; }
constexpr size_t WS_CTL   = 0;                                   constexpr size_t CTL_BYTES = 65536;
constexpr size_t WS_MOD   = WS_CTL + CTL_BYTES;
constexpr size_t WS_WIN   = al256(WS_MOD + (size_t)16 * 6144 * 4);
constexpr size_t WS_WOUT  = al256(WS_WIN + (size_t)NPAD * D * 2);
constexpr size_t WS_WQ    = al256(WS_WOUT + (size_t)D * D * 2);
constexpr size_t WS_KEYS  = al256(WS_WQ + (size_t)D * D * 2);
constexpr size_t WS_U8S   = al256(WS_KEYS + (size_t)16 * 128 * 64 * 2);
constexpr size_t WS_V8S   = al256(WS_U8S + (size_t)NEXP * D);
constexpr size_t WS_X8S   = al256(WS_V8S + (size_t)NEXP * D);
constexpr size_t WS_SU    = al256(WS_X8S + (size_t)T * D);
constexpr size_t WS_SV    = al256(WS_SU + (size_t)NEXP * 4);
constexpr size_t WS_SX    = al256(WS_SV + (size_t)NEXP * 4);
constexpr size_t WS_W1T   = al256(WS_SX + (size_t)T * 4);
constexpr size_t WS_W2T   = al256(WS_W1T + (size_t)2 * 64 * 2048 * 2);
constexpr size_t WS_PEC   = al256(WS_W2T + (size_t)2 * 64 * 64 * 2);
constexpr size_t WS_KC    = al256(WS_PEC + (size_t)2 * 64 * 4);
constexpr size_t WS_VC    = al256(WS_KC + (size_t)16 * 2 * 128 * 64 * 2);
constexpr size_t WS_H     = al256(WS_VC + (size_t)16 * 2 * 128 * 64 * 2);
constexpr size_t WS_CS    = WS_H;
constexpr size_t WS_CSUM  = WS_H + (size_t)32 * 1024 * 1024;
constexpr size_t WS_SSQP  = WS_H + (size_t)33 * 1024 * 1024;
constexpr size_t WS_OATT  = al256(WS_H + (size_t)T * D * 2);
constexpr size_t WS_PROJ  = al256(WS_OATT + (size_t)T * 512 * 2);
constexpr size_t WS_QP    = WS_PROJ;
constexpr size_t WS_PART  = WS_PROJ;
constexpr size_t WS_X2    = WS_PROJ;
constexpr size_t WS_EIDX  = WS_PROJ + (size_t)160 * 1024 * 1024;
constexpr size_t WS_EW    = WS_EIDX + (size_t)T * 128 * 4;
constexpr size_t WS_END   = al256(WS_PROJ + (size_t)T * NPAD * 2);
static_assert(WS_EW + (size_t)T * 128 * 4 <= WS_END, "alias region");
static_assert((size_t)8 * T * 128 * 4 <= (size_t)160 * 1024 * 1024, "PART fits under EIDX");
constexpr int CTL_CTR_A = 16384, CTL_CTR_B = 16384 + 8 * 256;

constexpr int LDS_STAGE = 147456;
constexpr int LDS_MISC_OFF = LDS_STAGE;
constexpr int LDS_BYTES = LDS_STAGE + 256;

typedef unsigned short bf16_t;
typedef short bf16x8 __attribute__((ext_vector_type(8)));
typedef short s16x4 __attribute__((ext_vector_type(4)));
typedef float f32x4 __attribute__((ext_vector_type(4)));
typedef unsigned u32x4v __attribute__((ext_vector_type(4)));
__device__ __forceinline__ float bf2f(bf16_t b) { return __uint_as_float(((unsigned)b) << 16); }
__device__ __forceinline__ bf16_t f2bf(float f) { unsigned u = __float_as_uint(f); u += 0x7FFFu + ((u >> 16) & 1u); return (bf16_t)(u >> 16); }
__device__ __forceinline__ float bflo(unsigned w) { return __uint_as_float(w << 16); }
__device__ __forceinline__ float bfhi(unsigned w) { return __uint_as_float(w & 0xFFFF0000u); }
__device__ __forceinline__ unsigned pack2(float lo, float hi) { return (unsigned)f2bf(lo) | ((unsigned)f2bf(hi) << 16); }
__device__ __forceinline__ float gelu_tanh(float x) { const float u = 0.7978845608028654f * (x + 0.044715f * x * x * x); return 0.5f * x * (1.0f + tanhf(u)); }
__device__ __forceinline__ float sigmoidf_(float x) { return 1.0f / (1.0f + __expf(-x)); }
__device__ __forceinline__ float wave_sum(float v) {
#pragma unroll
    for (int o = 32; o >= 1; o >>= 1) v += __shfl_xor(v, o);
    return v; }
__device__ __forceinline__ float wave_max(float v) {
#pragma unroll
    for (int o = 32; o >= 1; o >>= 1) v = fmaxf(v, __shfl_xor(v, o));
    return v; }
__device__ __forceinline__ void lds_wave_sync() { asm volatile("s_waitcnt lgkmcnt(0)" ::: "memory"); }
__device__ __forceinline__ int rel_bucket(int dist) {
    const int n = dist > 0 ? dist : 0;
    if (n < 16) return n;
    const float lr = logf((float)n / 16.0f) / 2.0794415416798357f;
    const int large = 16 + (int)(lr * 16.0f);
    return large < 31 ? large : 31;
}

struct Frame {
    const float* in[23]; float* out; unsigned char* ws;
    LAS unsigned char* lds; int tid, lane, wave, G;
};


typedef int i32x4v __attribute__((ext_vector_type(4)));
constexpr int PEER_CHUNK_TOK = 128, PEER_NCHUNK = T / PEER_CHUNK_TOK;

__device__ __forceinline__ void quant_row_sliced(const float* row, unsigned char* dst8  , size_t nrows, size_t r, float* scale_out, int bias, int lane) {
    float4 v[4]; float am = 0.f;
#pragma unroll
    for (int i = 0; i < 4; ++i) { v[i] = *(const float4*)(row + (lane + 64 * i) * 4); am = fmaxf(am, fmaxf(fmaxf(fabsf(v[i].x), fabsf(v[i].y)), fmaxf(fabsf(v[i].z), fabsf(v[i].w)))); }
    am = wave_max(am); const float inv = am > 0.f ? 127.0f / am : 0.f;
    if (lane == 0) *scale_out = am > 0.f ? am / 127.0f : 0.f;
#pragma unroll
    for (int i = 0; i < 4; ++i) { const int col = (lane + 64 * i) * 4; const int sl = col >> 7, off = col & 127;
        const int q0 = (int)rintf(v[i].x * inv) + bias, q1 = (int)rintf(v[i].y * inv) + bias, q2 = (int)rintf(v[i].z * inv) + bias, q3 = (int)rintf(v[i].w * inv) + bias;
        *(unsigned*)(dst8 + ((size_t)sl * nrows + r) * 128 + off) = (unsigned)(q0 & 0xFF) | ((unsigned)(q1 & 0xFF) << 8) | ((unsigned)(q2 & 0xFF) << 16) | ((unsigned)(q3 & 0xFF) << 24); }
}

__device__ __forceinline__ int grab_chunk(const Frame& F, unsigned* ctr, int slice) {
    LAS int* bc = (LAS int*)(F.lds + LDS_MISC_OFF + 64);
    __syncthreads();
    if (F.tid == 0) *bc = (int)__hip_atomic_fetch_add(ctr + slice * 64, 1u, __ATOMIC_RELAXED, __HIP_MEMORY_SCOPE_AGENT);
    __syncthreads();
    return *bc;
}

__device__ __forceinline__ void stage_chunk_lists(const Frame& F, const int* eidx_chunk, const float* cs_chunk) {
#pragma unroll
    for (int i = 0; i < 8; ++i) { const int q = F.tid + 512 * i; *(LAS i32x4v*)(F.lds + q * 16) = *(const i32x4v*)(eidx_chunk + q * 4);
        if (cs_chunk) *(LAS f32x4*)(F.lds + 65536 + q * 16) = *(const f32x4*)(cs_chunk + q * 4); }
    __syncthreads();
}
__device__ __forceinline__ void gather_rows16(u32x4v (&vv)[16], const unsigned char* base, const LAS int* le) {
    i32x4v ev[4];
#pragma unroll
    for (int q = 0; q < 4; ++q) ev[q] = *(const LAS i32x4v*)(le + 4 * q);
#pragma unroll
    for (int ld = 0; ld < 16; ++ld) vv[ld] = *(const u32x4v*)(base + (size_t)ev[ld >> 2][ld & 3] * 128);
}
__device__ __forceinline__ void udot_item(const u32x4v (&uv)[16], const i32x4v xq, int* part_row  , int c) {
    i32x4v res[4];
#pragma unroll
    for (int ld = 0; ld < 16; ++ld) { int p = __builtin_amdgcn_sdot4((int)uv[ld][0], xq[0], 0, false); p = __builtin_amdgcn_sdot4((int)uv[ld][1], xq[1], p, false);
        p = __builtin_amdgcn_sdot4((int)uv[ld][2], xq[2], p, false); p = __builtin_amdgcn_sdot4((int)uv[ld][3], xq[3], p, false);
        p += __shfl_xor(p, 1); p += __shfl_xor(p, 2); p += __shfl_xor(p, 4); res[ld >> 2][ld & 3] = p; }
    if (c == 0) {
#pragma unroll
        for (int q = 0; q < 4; ++q) *(i32x4v*)(part_row + 4 * q) = res[q]; }
}
__device__ __forceinline__ void p10a_udots(const Frame& F) {
    const unsigned char* U8S = F.ws + WS_U8S; const unsigned char* X8S = F.ws + WS_X8S; const int* EIDX = (const int*)(F.ws + WS_EIDX); int* PART = (int*)(F.ws + WS_PART);
    unsigned* ctr = (unsigned*)(F.ws + WS_CTL + CTL_CTR_A);
    const int lane = F.lane, j = lane >> 3, c = lane & 7; const int xcc = (int)(xb_xcc_id() & 7u);
    for (int so = 0; so < 8; ++so) { const int x = (xcc + so) & 7;
        for (;;) { const int chunk = grab_chunk(F, ctr, x); if (chunk >= PEER_NCHUNK) break;
            stage_chunk_lists(F, EIDX + (size_t)chunk * PEER_CHUNK_TOK * 128, nullptr);
            const unsigned char* ub = U8S + (size_t)x * NEXP * 128 + c * 16;
            const int tl0 = F.wave * 16; const int t0 = chunk * PEER_CHUNK_TOK + tl0;
            const LAS int* le = (const LAS int*)F.lds + tl0 * 128 + 16 * j;
            const unsigned char* xb = X8S + ((size_t)x * T + t0) * 128 + c * 16; int* pr = PART + ((size_t)x * T + t0) * 128 + 16 * j;
            u32x4v va[16], vb[16];
            gather_rows16(va, ub, le);
#pragma unroll 1
            for (int tt = 0; tt < 16; tt += 2) {
                const i32x4v xqa = *(const i32x4v*)(xb + (size_t)tt * 128), xqb = *(const i32x4v*)(xb + (size_t)(tt + 1) * 128);
                gather_rows16(vb, ub, le + (tt + 1) * 128);
                udot_item(va, xqa, pr + (size_t)tt * 128, c);
                if (tt + 2 < 16) gather_rows16(va, ub, le + (tt + 2) * 128);
                udot_item(vb, xqb, pr + (size_t)(tt + 1) * 128, c);
            }
        }
    }
}

__device__ __forceinline__ void p10b_coef(const Frame& F) {
    const int* EIDX = (const int*)(F.ws + WS_EIDX); const float* EW = (const float*)(F.ws + WS_EW); const int* PART = (const int*)(F.ws + WS_PART);
    const float* SU = (const float*)(F.ws + WS_SU); const float* SV = (const float*)(F.ws + WS_SV); const float* SX = (const float*)(F.ws + WS_SX);
    float* CS = (float*)(F.ws + WS_CS); float* CSUM = (float*)(F.ws + WS_CSUM);
    const int gw = blockIdx.x * NWAVES + F.wave, nw = F.G * NWAVES, lane = F.lane;
    for (int t = gw; t < T; t += nw) { const float sx = SX[t]; float tot = 0.f;
#pragma unroll
        for (int hh = 0; hh < 2; ++hh) { const int i = lane + 64 * hh; int s = 0;
#pragma unroll
            for (int x = 0; x < 8; ++x) s += PART[((size_t)x * T + t) * 128 + i];
            const int e = EIDX[(size_t)t * 128 + i]; const float dot = (float)s * sx * SU[e];
            const float cs = EW[(size_t)t * 128 + i] * gelu_tanh(dot) * SV[e]; CS[(size_t)t * 128 + i] = cs; tot += cs; }
        tot = wave_sum(tot); if (lane == 0) CSUM[t] = tot; }
}

struct VsumPre { float2 x1, gt; float off; };
__device__ __forceinline__ void vsum_item(const u32x4v (&vv)[16], const LAS float* lc  , const VsumPre& pre, float* x2p, float* ssqp, int lane) {
    f32x4 cv[4];
#pragma unroll
    for (int q = 0; q < 4; ++q) cv[q] = *(const LAS f32x4*)(lc + 4 * q);
    float acc[16];
#pragma unroll
    for (int k = 0; k < 16; ++k) acc[k] = 0.f;
#pragma unroll
    for (int ld = 0; ld < 16; ++ld) { const float cf = cv[ld >> 2][ld & 3];
#pragma unroll
        for (int w = 0; w < 4; ++w) { const unsigned u = vv[ld][w];
            acc[4 * w + 0] += cf * (float)(u & 0xFFu); acc[4 * w + 1] += cf * (float)((u >> 8) & 0xFFu); acc[4 * w + 2] += cf * (float)((u >> 16) & 0xFFu); acc[4 * w + 3] += cf * (float)(u >> 24); } }
    float a8[8], a4[4], a2[2];
    { const bool hi = (lane & 32) != 0;
#pragma unroll
        for (int k = 0; k < 8; ++k) { const float snd = hi ? acc[k] : acc[k + 8]; const float rcv = __shfl_xor(snd, 32); a8[k] = (hi ? acc[k + 8] : acc[k]) + rcv; } }
    { const bool hi = (lane & 16) != 0;
#pragma unroll
        for (int k = 0; k < 4; ++k) { const float snd = hi ? a8[k] : a8[k + 4]; const float rcv = __shfl_xor(snd, 16); a4[k] = (hi ? a8[k + 4] : a8[k]) + rcv; } }
    { const bool hi = (lane & 8) != 0;
#pragma unroll
        for (int k = 0; k < 2; ++k) { const float snd = hi ? a4[k] : a4[k + 2]; const float rcv = __shfl_xor(snd, 8); a2[k] = (hi ? a4[k + 2] : a4[k]) + rcv; } }
    const float y0 = pre.x1.x + pre.gt.x * (a2[0] - pre.off), y1 = pre.x1.y + pre.gt.y * (a2[1] - pre.off);
    *(float2*)x2p = make_float2(y0, y1);
    const float ss = wave_sum(y0 * y0 + y1 * y1); if (lane == 0) *ssqp = ss;
}
__device__ __forceinline__ void p10c_vsum(const Frame& F) {
    const unsigned char* V8S = F.ws + WS_V8S; const int* EIDX = (const int*)(F.ws + WS_EIDX); const float* CS = (const float*)(F.ws + WS_CS); const float* CSUM = (const float*)(F.ws + WS_CSUM);
    const float* MOD = (const float*)(F.ws + WS_MOD); float* SSQP = (float*)(F.ws + WS_SSQP); const float* x1 = F.out; float* X2 = (float*)(F.ws + WS_X2);
    unsigned* ctr = (unsigned*)(F.ws + WS_CTL + CTL_CTR_B);
    const int lane = F.lane, j = lane >> 3, c = lane & 7; const int xcc = (int)(xb_xcc_id() & 7u);
    const int ocol = 16 * c + 8 * ((lane >> 5) & 1) + 4 * ((lane >> 4) & 1) + 2 * ((lane >> 3) & 1);
    for (int so = 0; so < 8; ++so) { const int x = (xcc + so) & 7;
        for (;;) { const int chunk = grab_chunk(F, ctr, x); if (chunk >= PEER_NCHUNK) break;
            stage_chunk_lists(F, EIDX + (size_t)chunk * PEER_CHUNK_TOK * 128, CS + (size_t)chunk * PEER_CHUNK_TOK * 128);
            const unsigned char* vb = V8S + (size_t)x * NEXP * 128 + c * 16;
            const int tl0 = F.wave * 16; const int t0 = chunk * PEER_CHUNK_TOK + tl0; const int b = t0 / S;
            const LAS int* le = (const LAS int*)F.lds + tl0 * 128 + 16 * j; const LAS float* lc = (const LAS float*)(F.lds + 65536) + tl0 * 128 + 16 * j;
            const int col = x * 128 + ocol; const float2 gt = *(const float2*)(MOD + b * 6144 + 5120 + col);
            u32x4v va[16], vbb[16];
            gather_rows16(va, vb, le);
#pragma unroll 1
            for (int tt = 0; tt < 16; tt += 2) {
                { VsumPre pa; pa.gt = gt; pa.x1 = *(const float2*)(x1 + (size_t)(t0 + tt) * D + col); pa.off = 128.0f * CSUM[t0 + tt];
                  gather_rows16(vbb, vb, le + (tt + 1) * 128);
                  vsum_item(va, lc + tt * 128, pa, X2 + (size_t)(t0 + tt) * D + col, SSQP + (size_t)(t0 + tt) * 8 + x, lane); }
                { VsumPre pb; pb.gt = gt; pb.x1 = *(const float2*)(x1 + (size_t)(t0 + tt + 1) * D + col); pb.off = 128.0f * CSUM[t0 + tt + 1];
                  if (tt + 2 < 16) gather_rows16(va, vb, le + (tt + 2) * 128);
                  vsum_item(vbb, lc + (tt + 1) * 128, pb, X2 + (size_t)(t0 + tt + 1) * D + col, SSQP + (size_t)(t0 + tt + 1) * 8 + x, lane); }
            }
        }
    }
}

__device__ __forceinline__ void p10d_final(const Frame& F) {
    const float* SSQP = (const float*)(F.ws + WS_SSQP); const float* gfin = F.in[22]; float* out = F.out; const float* X2 = (const float*)(F.ws + WS_X2);
    const int gw = blockIdx.x * NWAVES + F.wave, nw = F.G * NWAVES, lane = F.lane;
    for (int t = gw; t < T; t += nw) {
        float ss = 0.f;
#pragma unroll
        for (int x = 0; x < 8; ++x) ss += SSQP[(size_t)t * 8 + x];
        const float rstd = rsqrtf(ss * (1.0f / D) + EPS);
#pragma unroll
        for (int i = 0; i < 4; ++i) { const int col = (lane + 64 * i) * 4; const float4 v = *(const float4*)(X2 + (size_t)t * D + col), gg = *(const float4*)(gfin + col);
            *(float4*)(out + (size_t)t * D + col) = make_float4(v.x * rstd * gg.x, v.y * rstd * gg.y, v.z * rstd * gg.z, v.w * rstd * gg.w); }
    }
}

__device__ __forceinline__ void transpose_tile(const Frame& F, const float* src, int srcK, int srcN, bf16_t* dst, int dstK, int kt, int nt) {
    LAS float* tile = (LAS float*)F.lds;
    const int k0 = kt * 64, n0 = nt * 64;
    for (int i = F.tid; i < 4096; i += NTHREADS) { const int r = i >> 6, c = i & 63; const int k = k0 + r, n = n0 + c;
        tile[r * 65 + c] = (k < srcK && n < srcN) ? src[(size_t)k * srcN + n] : 0.0f; }
    __syncthreads();
    for (int i = F.tid; i < 4096; i += NTHREADS) { const int r = i >> 6, c = i & 63;
        dst[(size_t)(n0 + r) * dstK + k0 + c] = f2bf(tile[c * 65 + r]); }
    __syncthreads();
}
__device__ __forceinline__ void p0_prologue(const Frame& F) {
    const float* c = F.in[1]; const float* w_mod = F.in[4]; const float* b_mod = F.in[5];
    float* MOD = (float*)(F.ws + WS_MOD);
    constexpr int I_MOD = 96, I_WIN = 16 * 48, I_WOUT = 256, I_WQ = 256, I_U = 256, I_V = 256, I_KEYS = 2, I_CMP = 32 + 32 + 1 + 1 + 2;
    constexpr int O_WIN = I_MOD, O_WOUT = O_WIN + I_WIN, O_WQ = O_WOUT + I_WOUT, O_U = O_WQ + I_WQ, O_V = O_U + I_U, O_KEYS = O_V + I_V, O_CMP = O_KEYS + I_KEYS, N_ITEMS = O_CMP + I_CMP;
    for (int it = blockIdx.x; it < N_ITEMS; it += F.G) {
        if (it < O_WIN) {
            LAS float* sl = (LAS float*)F.lds; LAS float* red = (LAS float*)(F.lds + 65536);
            for (int q = F.tid; q < 16 * D; q += NTHREADS) { const float cv = c[q]; sl[q] = cv / (1.0f + __expf(-cv)); }
            __syncthreads();
            const int kg = F.tid >> 6, cl = F.tid & 63, j0 = it * 64;
            float acc[16];
#pragma unroll
            for (int bb = 0; bb < 16; ++bb) acc[bb] = 0.f;
            const float* wp = w_mod + (size_t)(kg * 128) * 6144 + j0 + cl;
#pragma unroll 4
            for (int kk = 0; kk < 128; ++kk) { const float w = wp[(size_t)kk * 6144]; const int k = kg * 128 + kk;
#pragma unroll
                for (int bb = 0; bb < 16; ++bb) acc[bb] += sl[bb * D + k] * w; }
#pragma unroll
            for (int bb = 0; bb < 16; ++bb) red[(kg * 16 + bb) * 64 + cl] = acc[bb];
            __syncthreads();
#pragma unroll
            for (int q = 0; q < 2; ++q) { const int o = F.tid + 512 * q; const int bb = o >> 6, cc = o & 63; float s = b_mod[j0 + cc];
#pragma unroll
                for (int g8 = 0; g8 < 8; ++g8) s += red[(g8 * 16 + bb) * 64 + cc];
                MOD[bb * 6144 + j0 + cc] = s; }
            __syncthreads();
        } else if (it < O_WOUT) { const int i = it - O_WIN; transpose_tile(F, F.in[6], D, NCOL, (bf16_t*)(F.ws + WS_WIN), D, i % 16, i / 16); }
        else if (it < O_WQ) { const int i = it - O_WOUT; transpose_tile(F, F.in[16], D, D, (bf16_t*)(F.ws + WS_WOUT), D, i % 16, i / 16); }
        else if (it < O_U) { const int i = it - O_WQ; transpose_tile(F, F.in[17], D, D, (bf16_t*)(F.ws + WS_WQ), D, i % 16, i / 16); }
        else if (it < O_KEYS) {
            const bool isv = it >= O_V; const int i = isv ? it - O_V : it - O_U;
            for (int rr = 0; rr < 8; ++rr) { const size_t r = (size_t)i * 64 + rr * 8 + F.wave;
                quant_row_sliced((isv ? F.in[20] : F.in[19]) + r * D, F.ws + (isv ? WS_V8S : WS_U8S), NEXP, r, (float*)(F.ws + (isv ? WS_SV : WS_SU)) + r, isv ? 128 : 0, F.lane); }
        } else if (it >= O_CMP) {
            const int i = it - O_CMP;
            if (i < 64) { const int kv = i >> 5; transpose_tile(F, kv ? F.in[11] : F.in[9], 2048, 64, (bf16_t*)(F.ws + WS_W1T) + (size_t)kv * 64 * 2048, 2048, i & 31, 0); }
            else if (i < 66) { const int kv = i - 64; transpose_tile(F, kv ? F.in[12] : F.in[10], 64, 64, (bf16_t*)(F.ws + WS_W2T) + (size_t)kv * 64 * 64, 64, 0, 0); }
            else { const int kv = i - 66; const float* pe = kv ? F.in[8] : F.in[7]; const float* w1 = kv ? F.in[11] : F.in[9];
                if (F.tid < 64) { float a = 0.f; for (int k = 0; k < 2048; ++k) a += pe[k] * w1[(size_t)k * 64 + F.tid]; ((float*)(F.ws + WS_PEC))[kv * 64 + F.tid] = a; } }
        } else {
            const int i = it - O_KEYS; const float4* src = (const float4*)F.in[18] + (size_t)i * 16384; uint2* dst = (uint2*)(F.ws + WS_KEYS) + (size_t)i * 16384;
            for (int q = F.tid; q < 16384; q += NTHREADS) { const float4 v = src[q]; dst[q] = make_uint2(pack2(v.x, v.y), pack2(v.z, v.w)); }
        }
    }
}

__device__ __forceinline__ void norm_mod_rows(const Frame& F, const float* x, const float* g, int sh_off, int sc_off, bf16_t* dst) {
    const float* MOD = (const float*)(F.ws + WS_MOD);
    const int gw = blockIdx.x * NWAVES + F.wave, nw = F.G * NWAVES;
    for (int t = gw; t < T; t += nw) {
        const int b = t / S; const float4* xr = (const float4*)(x + (size_t)t * D);
        float4 v[4]; float ss = 0.f;
#pragma unroll
        for (int i = 0; i < 4; ++i) { v[i] = xr[F.lane + 64 * i]; ss += v[i].x * v[i].x + v[i].y * v[i].y + v[i].z * v[i].z + v[i].w * v[i].w; }
        ss = wave_sum(ss); const float rstd = rsqrtf(ss * (1.0f / D) + EPS);
#pragma unroll
        for (int i = 0; i < 4; ++i) { const int col = (F.lane + 64 * i) * 4;
            const float4 gg = *(const float4*)(g + col), sc = *(const float4*)(MOD + b * 6144 + sc_off + col), sh = *(const float4*)(MOD + b * 6144 + sh_off + col);
            const float o0 = v[i].x * rstd * gg.x * (1.f + sc.x) + sh.x, o1 = v[i].y * rstd * gg.y * (1.f + sc.y) + sh.y, o2 = v[i].z * rstd * gg.z * (1.f + sc.z) + sh.z, o3 = v[i].w * rstd * gg.w * (1.f + sc.w) + sh.w;
            *(uint2*)(dst + (size_t)t * D + col) = make_uint2(pack2(o0, o1), pack2(o2, o3)); }
    }
}

__device__ __forceinline__ void norm_mod_rows_q(const Frame& F, const float* x, const float* g, int sh_off, int sc_off, bf16_t* dst) {
    const float* MOD = (const float*)(F.ws + WS_MOD);
    const int gw = blockIdx.x * NWAVES + F.wave, nw = F.G * NWAVES;
    for (int t = gw; t < T; t += nw) {
        const int b = t / S; const float4* xr = (const float4*)(x + (size_t)t * D);
        float4 v[4]; float ss = 0.f;
#pragma unroll
        for (int i = 0; i < 4; ++i) { v[i] = xr[F.lane + 64 * i]; ss += v[i].x * v[i].x + v[i].y * v[i].y + v[i].z * v[i].z + v[i].w * v[i].w; }
        ss = wave_sum(ss); const float rstd = rsqrtf(ss * (1.0f / D) + EPS);
        float am = 0.f;
#pragma unroll
        for (int i = 0; i < 4; ++i) { const int col = (F.lane + 64 * i) * 4;
            const float4 gg = *(const float4*)(g + col), sc = *(const float4*)(MOD + b * 6144 + sc_off + col), sh = *(const float4*)(MOD + b * 6144 + sh_off + col);
            v[i].x = v[i].x * rstd * gg.x * (1.f + sc.x) + sh.x; v[i].y = v[i].y * rstd * gg.y * (1.f + sc.y) + sh.y; v[i].z = v[i].z * rstd * gg.z * (1.f + sc.z) + sh.z; v[i].w = v[i].w * rstd * gg.w * (1.f + sc.w) + sh.w;
            *(uint2*)(dst + (size_t)t * D + col) = make_uint2(pack2(v[i].x, v[i].y), pack2(v[i].z, v[i].w));
            am = fmaxf(am, fmaxf(fmaxf(fabsf(v[i].x), fabsf(v[i].y)), fmaxf(fabsf(v[i].z), fabsf(v[i].w)))); }
        am = wave_max(am); const float inv = am > 0.f ? 127.0f / am : 0.f;
        if (F.lane == 0) ((float*)(F.ws + WS_SX))[t] = am > 0.f ? am / 127.0f : 0.f;
#pragma unroll
        for (int i = 0; i < 4; ++i) { const int col = (F.lane + 64 * i) * 4; const int sl = col >> 7, off = col & 127;
            const int q0 = (int)rintf(v[i].x * inv), q1 = (int)rintf(v[i].y * inv), q2 = (int)rintf(v[i].z * inv), q3 = (int)rintf(v[i].w * inv);
            *(unsigned*)(F.ws + WS_X8S + ((size_t)sl * T + t) * 128 + off) = (unsigned)(q0 & 0xFF) | ((unsigned)(q1 & 0xFF) << 8) | ((unsigned)(q2 & 0xFF) << 16) | ((unsigned)(q3 & 0xFF) << 24); }
    }
}

__device__ __forceinline__ void p3_compress_naive(const Frame& F) {
    const bf16_t* PROJ = (const bf16_t*)(F.ws + WS_PROJ);
    LAS float* hid = (LAS float*)F.lds + F.wave * 64;
    const int gw = blockIdx.x * NWAVES + F.wave, nw = F.G * NWAVES;
    if (gw < 64) { bf16_t* dz = (bf16_t*)(F.ws + ((gw & 1) ? WS_VC : WS_KC)); dz[((size_t)(gw >> 1) * 128 + 127) * 64 + F.lane] = 0; }
    for (int u = gw; u < NB * NCMP * 2 * 2; u += nw) {
        const int kv = u & 1, g = (u >> 1) & 1, n = (u >> 2) % NCMP, b = (u >> 2) / NCMP;
        const float* pe = kv ? F.in[8] : F.in[7]; const float* w1 = kv ? F.in[11] : F.in[9]; const float* w2 = kv ? F.in[12] : F.in[10];
        const int cbase = (kv ? C_VC : C_KC) + g * 64;
        float acc = 0.f;
        for (int l = 0; l < 32; ++l) {
            const bf16_t* row = PROJ + (size_t)(b * S + 16 * n + l) * NPAD + cbase;
            for (int d = 0; d < 64; ++d) { const float a = bf2f(row[d]) + pe[l * 64 + d]; acc += a * w1[(size_t)(l * 64 + d) * 64 + F.lane]; }
        }
        hid[F.lane] = gelu_tanh(acc); lds_wave_sync();
        float o = 0.f;
        for (int j = 0; j < 64; ++j) o += hid[j] * w2[j * 64 + F.lane];
        bf16_t* dst = (bf16_t*)(F.ws + (kv ? WS_VC : WS_KC)); dst[((size_t)(b * 2 + g) * 128 + n) * 64 + F.lane] = f2bf(o);
        lds_wave_sync();
    }
}


__device__ __forceinline__ void p3_compress_mfma(const Frame& F) {
    const bf16_t* PROJ = (const bf16_t*)(F.ws + WS_PROJ);
    const int lane = F.lane, tid = F.tid, wave = F.wave, grp = lane >> 4, col = lane & 15;
    LAS float* red = (LAS float*)F.lds;
    LAS bf16_t* hid = (LAS bf16_t*)(F.lds + 32768);
    if (blockIdx.x * NWAVES + wave < 64) { const int gw = blockIdx.x * NWAVES + wave; bf16_t* dz = (bf16_t*)(F.ws + ((gw & 1) ? WS_VC : WS_KC)); dz[((size_t)(gw >> 1) * 128 + 127) * 64 + lane] = 0; }
    for (int u = blockIdx.x; u < NB * 2 * 2 * 8; u += F.G) {
        const int nt8 = u & 7, kv = (u >> 3) & 1, g = (u >> 4) & 1, b = u >> 5; const int n0 = nt8 * 16;
        const bf16_t* W1T = (const bf16_t*)(F.ws + WS_W1T) + (size_t)kv * 64 * 2048; const bf16_t* W2T = (const bf16_t*)(F.ws + WS_W2T) + (size_t)kv * 64 * 64;
        const float* pec = (const float*)(F.ws + WS_PEC) + kv * 64;
        const int cbase = (kv ? C_VC : C_KC) + g * 64;
        const int nrow = (n0 + col) < NCMP ? (n0 + col) : (NCMP - 1);
        f32x4 acc[4];
#pragma unroll
        for (int nt = 0; nt < 4; ++nt) acc[nt] = (f32x4){0.f, 0.f, 0.f, 0.f};
#pragma unroll
        for (int ks = 0; ks < 8; ++ks) { const int l = 4 * wave + (ks >> 1), d0 = (ks & 1) * 32 + 8 * grp;
            const bf16x8 af = *(const bf16x8*)(PROJ + (size_t)(b * S + 16 * nrow + l) * NPAD + cbase + d0);
#pragma unroll
            for (int nt = 0; nt < 4; ++nt) { const bf16x8 bfr = *(const bf16x8*)(W1T + (size_t)(nt * 16 + col) * 2048 + l * 64 + d0);
                acc[nt] = __builtin_amdgcn_mfma_f32_16x16x32_bf16(af, bfr, acc[nt], 0, 0, 0); } }
#pragma unroll
        for (int nt = 0; nt < 4; ++nt)
#pragma unroll
            for (int rg = 0; rg < 4; ++rg) red[(wave * 16 + 4 * grp + rg) * 64 + nt * 16 + col] = acc[nt][rg];
        __syncthreads();
#pragma unroll
        for (int q = 0; q < 2; ++q) { const int idx = tid + 512 * q; float s = pec[idx & 63];
#pragma unroll
            for (int w = 0; w < 8; ++w) s += red[w * 1024 + idx];
            hid[idx] = f2bf(gelu_tanh(s)); }
        __syncthreads();
        if (wave < 4) { f32x4 o = (f32x4){0.f, 0.f, 0.f, 0.f};
#pragma unroll
            for (int ks = 0; ks < 2; ++ks) { const bf16x8 af = *(const LAS bf16x8*)(hid + col * 64 + ks * 32 + 8 * grp); const bf16x8 bfr = *(const bf16x8*)(W2T + (size_t)(wave * 16 + col) * 64 + ks * 32 + 8 * grp);
                o = __builtin_amdgcn_mfma_f32_16x16x32_bf16(af, bfr, o, 0, 0, 0); }
            bf16_t* dst = (bf16_t*)(F.ws + (kv ? WS_VC : WS_KC));
#pragma unroll
            for (int rg = 0; rg < 4; ++rg) { const int n = n0 + 4 * grp + rg; if (n < NCMP) dst[((size_t)(b * 2 + g) * 128 + n) * 64 + wave * 16 + col] = f2bf(o[rg]); } }
        __syncthreads();
    }
}

__device__ __forceinline__ void dot4_row(const bf16_t* krow, const LAS float* qs, float (&acc)[4]) {
    const uint4* kr = (const uint4*)krow;
#pragma unroll 1
    for (int c = 0; c < 8; ++c) { asm volatile("" ::: "memory"); const uint4 w = kr[c]; const unsigned ww[4] = {w.x, w.y, w.z, w.w};
#pragma unroll
        for (int e = 0; e < 4; ++e) { const float k0 = bflo(ww[e]), k1 = bfhi(ww[e]); const int d = c * 8 + e * 2;
#pragma unroll
            for (int r = 0; r < 4; ++r) acc[r] += qs[r * 64 + d] * k0 + qs[r * 64 + d + 1] * k1; } }
}
__device__ __forceinline__ void p4_attn_naive(const Frame& F) {
    const bf16_t* PROJ = (const bf16_t*)(F.ws + WS_PROJ); const bf16_t* KC = (const bf16_t*)(F.ws + WS_KC); const bf16_t* VC = (const bf16_t*)(F.ws + WS_VC);
    bf16_t* OATT = (bf16_t*)(F.ws + WS_OATT); const float* rel = F.in[21];
    LAS float* wl = (LAS float*)F.lds + F.wave * (256 + 512 + 2048 + 16);
    LAS float* qs = wl; LAS float* pc = wl + 256; LAS float* ps = wl + 768; LAS int* pbase = (LAS int*)(wl + 768 + 2048);
    const int gw = blockIdx.x * NWAVES + F.wave, nw = F.G * NWAVES, lane = F.lane;
    for (int u = gw; u < T * 2; u += nw) {
        const int g = u & 1, tok = u >> 1, b = tok / S, t = tok % S;
        const bf16_t* prow = PROJ + (size_t)tok * NPAD;
#pragma unroll
        for (int r = 0; r < 4; ++r) qs[r * 64 + lane] = bf2f(prow[C_Q + (g * 4 + r) * 64 + lane]) * 0.125f;
        lds_wave_sync();
        const int nv = t >= 31 ? ((t - 31) >> 4) + 1 : 0;
        float sc[2][4]; bool va[2];
#pragma unroll
        for (int i = 0; i < 2; ++i) { const int n = lane + 64 * i; va[i] = n < nv; float a[4] = {0.f, 0.f, 0.f, 0.f};
            if (va[i]) { dot4_row(KC + ((size_t)(b * 2 + g) * 128 + n) * 64, qs, a); const int bk = rel_bucket(t - (16 * n + 31));
#pragma unroll
                for (int r = 0; r < 4; ++r) a[r] += rel[bk * 8 + g * 4 + r]; }
#pragma unroll
            for (int r = 0; r < 4; ++r) sc[i][r] = va[i] ? a[r] : -1e30f; }
        float ocmp[4];
#pragma unroll
        for (int r = 0; r < 4; ++r) { const float m = wave_max(fmaxf(sc[0][r], sc[1][r]));
            const float e0 = va[0] ? __expf(sc[0][r] - m) : 0.f, e1 = va[1] ? __expf(sc[1][r] - m) : 0.f; const float sum = wave_sum(e0 + e1);
            const float inv = nv > 0 ? 1.0f / sum : 0.f; pc[r * 128 + lane] = e0 * inv; pc[r * 128 + 64 + lane] = e1 * inv; }
        lds_wave_sync();
        { float o[4] = {0.f, 0.f, 0.f, 0.f}; const bf16_t* vb = VC + ((size_t)(b * 2 + g) * 128) * 64 + lane;
            for (int n = 0; n < nv; ++n) { const float v = bf2f(vb[n * 64]);
#pragma unroll
                for (int r = 0; r < 4; ++r) o[r] += pc[r * 128 + n] * v; }
#pragma unroll
            for (int r = 0; r < 4; ++r) ocmp[r] = o[r]; }
        const int cur = t >> 6; float val;
        { const int j = lane & 31; float imp = 0.f;
#pragma unroll
            for (int r = 0; r < 4; ++r) for (int n = 4 * j - 1; n <= 4 * j + 3; ++n) if (n >= 0 && n < NCMP) imp += pc[r * 128 + n];
            const bool forced = (j == 0) || (j == cur) || (j == cur - 1); const bool allowed = j <= cur;
            val = forced ? 1e4f : (allowed ? imp : -INFINITY); }
        int rank = 0;
        for (int jp = 0; jp < 32; ++jp) { const float vp = __shfl(val, jp); rank += ((vp > val) || (vp == val && jp < (lane & 31))) ? 1 : 0; }
        unsigned selmask = (unsigned)(__ballot(lane < 32 && rank < 8) & 0xFFFFFFFFull);
        float oslc[4], owin[4];
#pragma unroll
        for (int br = 0; br < 2; ++br) {
            const int ck = br == 0 ? C_KS : C_KW, cv = br == 0 ? C_VS : C_VW;
            unsigned mk = selmask;
#pragma unroll 1
            for (int c = 0; c < 8; ++c) {
                int kpos, bs;
                if (br == 0) { const int j = __builtin_ctz(mk | 0x80000000u); mk &= mk - 1; bs = 64 * j; } else { bs = t - 511 + 64 * c; }
                kpos = bs + lane; if (lane == 0) pbase[c] = bs;
                const int dist = t - kpos; const bool vv = (dist >= 0) && (kpos >= 0) && (kpos < S);
                float a[4] = {0.f, 0.f, 0.f, 0.f};
                if (vv) { dot4_row(PROJ + (size_t)(b * S + kpos) * NPAD + ck + g * 64, qs, a); const int bk = rel_bucket(dist);
#pragma unroll
                    for (int r = 0; r < 4; ++r) a[r] += rel[bk * 8 + g * 4 + r]; }
#pragma unroll
                for (int r = 0; r < 4; ++r) ps[r * 512 + c * 64 + lane] = vv ? a[r] : -1e30f;
            }
            lds_wave_sync();
#pragma unroll 1
            for (int r = 0; r < 4; ++r) { float m = -1e30f;
#pragma unroll
                for (int c = 0; c < 8; ++c) m = fmaxf(m, ps[r * 512 + c * 64 + lane]);
                m = wave_max(m); float e[8], sum = 0.f;
#pragma unroll
                for (int c = 0; c < 8; ++c) { const float sv = ps[r * 512 + c * 64 + lane]; e[c] = sv > -1e29f ? __expf(sv - m) : 0.f; sum += e[c]; }
                sum = wave_sum(sum); const float inv = sum > 0.f ? 1.0f / sum : 0.f;
#pragma unroll
                for (int c = 0; c < 8; ++c) ps[r * 512 + c * 64 + lane] = e[c] * inv; }
            lds_wave_sync();
            float o[4] = {0.f, 0.f, 0.f, 0.f};
#pragma unroll 1
            for (int c = 0; c < 8; ++c) {
                const int bsc = pbase[c];
                for (int kk = 0; kk < 64; ++kk) { const int kpos = bsc + kk; if (kpos < 0 || kpos > t) continue;
                    const float v = bf2f(PROJ[(size_t)(b * S + kpos) * NPAD + cv + g * 64 + lane]);
#pragma unroll
                    for (int r = 0; r < 4; ++r) o[r] += ps[r * 512 + c * 64 + kk] * v; } }
            lds_wave_sync();
#pragma unroll
            for (int r = 0; r < 4; ++r) { if (br == 0) oslc[r] = o[r]; else owin[r] = o[r]; }
        }
#pragma unroll
        for (int r = 0; r < 4; ++r) { const int h = g * 4 + r;
            const float g0 = sigmoidf_(bf2f(prow[C_GT + h * 3 + 0])), g1 = sigmoidf_(bf2f(prow[C_GT + h * 3 + 1])), g2 = sigmoidf_(bf2f(prow[C_GT + h * 3 + 2]));
            OATT[(size_t)tok * 512 + h * 64 + lane] = f2bf(g0 * ocmp[r] + g1 * oslc[r] + g2 * owin[r]); }
    }
}


constexpr float LOG2E = 1.4426950408889634f;
constexpr int AT_KC = 0, AT_VC = 16384, AT_KV = 32768  , AT_BTAB = 65536, AT_IMP = 69888, AT_SEL = 78336, AT_OUT = 78592  , AT_END = 78592 + 65536;
constexpr int BT_STRIDE = 132;
__device__ __forceinline__ int tile_off(int row, int chunk) { return row * 128 + ((chunk ^ (row & 7)) << 4); }
__device__ __forceinline__ bf16x8 mk_frag(unsigned a, unsigned b, unsigned c, unsigned d) { u32x4v v = {a, b, c, d}; return __builtin_bit_cast(bf16x8, v); }
struct LaneOffs { int koff[2]; int voff[4]; int soff; };
__device__ __forceinline__ LaneOffs lane_offs(int lane, int tid) {
    LaneOffs L; const int grp = lane >> 4, rowi = lane & 15, q4 = rowi >> 2, p = lane & 3;
#pragma unroll
    for (int ks = 0; ks < 2; ++ks) L.koff[ks] = tile_off(rowi, ks * 4 + grp);
#pragma unroll
    for (int dt = 0; dt < 4; ++dt) L.voff[dt] = tile_off(4 * grp + q4, 2 * dt + (p >> 1)) + 8 * (p & 1);
    L.soff = tile_off(tid >> 3, tid & 7); return L;
}
__device__ __forceinline__ bf16x8 vfrag_read(const LAS unsigned char* vt, int voff_dt, int row0) {
    const s16x4 a = __builtin_amdgcn_ds_read_tr16_b64_v4i16((LAS s16x4*)(vt + voff_dt + row0 * 128));
    const s16x4 b = __builtin_amdgcn_ds_read_tr16_b64_v4i16((LAS s16x4*)(vt + voff_dt + row0 * 128 + 2048));
    bf16x8 f = {a[0], a[1], a[2], a[3], b[0], b[1], b[2], b[3]}; return f;
}

struct AttnState {
    f32x4 o[4][2]; float m[2], l[2];
};

template <int BR>
__device__ __forceinline__ void attn_tile(const LAS unsigned char* kt_lds, const LAS unsigned char* vt_lds, const LAS float* btab_h, const bf16x8 (&qf)[2][2], const int (&tq)[2], const unsigned (&sel)[2],
                                          int j, bool near, AttnState& st, int lane, const LaneOffs& L) {
    const int grp = lane >> 4, kbase = 64 * j;
    f32x4 sacc[4][2];
#pragma unroll
    for (int kt = 0; kt < 4; ++kt) { sacc[kt][0] = (f32x4){0.f, 0.f, 0.f, 0.f}; sacc[kt][1] = (f32x4){0.f, 0.f, 0.f, 0.f}; }
#pragma unroll
    for (int kt = 0; kt < 4; ++kt)
#pragma unroll
        for (int ks = 0; ks < 2; ++ks) { const bf16x8 kf = *(const LAS bf16x8*)(kt_lds + L.koff[ks] + kt * 2048);
            sacc[kt][0] = __builtin_amdgcn_mfma_f32_16x16x32_bf16(kf, qf[0][ks], sacc[kt][0], 0, 0, 0);
            sacc[kt][1] = __builtin_amdgcn_mfma_f32_16x16x32_bf16(kf, qf[1][ks], sacc[kt][1], 0, 0, 0); }
    __builtin_amdgcn_sched_barrier(0);
    const float SC = 0.125f * LOG2E; const float bfar = btab_h[128];
    bf16x8 pf[2][2];
#pragma unroll
    for (int qt = 0; qt < 2; ++qt) {
        const int t = tq[qt]; const bool selq = BR == 0 ? ((sel[qt] >> j) & 1u) != 0u : true;
        float sv[4][4]; float tmax = -1e30f;
        int d0 = t - 4 * grp - kbase; asm volatile("" : "+v"(d0));
        if (near) {
#pragma unroll
            for (int kt = 0; kt < 4; ++kt)
#pragma unroll
                for (int rg = 0; rg < 4; ++rg) { const int dist = d0 - (kt * 16 + rg); const int dd = dist < 0 ? 0 : (dist > 128 ? 128 : dist); sv[kt][rg] = btab_h[dd]; }
        } else {
#pragma unroll
            for (int kt = 0; kt < 4; ++kt)
#pragma unroll
                for (int rg = 0; rg < 4; ++rg) sv[kt][rg] = bfar;
        }
#pragma unroll
        for (int kt = 0; kt < 4; ++kt)
#pragma unroll
            for (int rg = 0; rg < 4; ++rg) { const int c = kt * 16 + rg;
                const bool valid = BR == 0 ? (selq && d0 >= c) : (d0 >= c && d0 < 512 + c);
                const float sx = sacc[kt][qt][rg] * SC + sv[kt][rg]; const float s = valid ? sx : -1e30f; sv[kt][rg] = s; tmax = fmaxf(tmax, s); }
        tmax = fmaxf(tmax, __shfl_xor(tmax, 16)); tmax = fmaxf(tmax, __shfl_xor(tmax, 32));
        const float mnew = fmaxf(st.m[qt], tmax); const float alpha = __builtin_amdgcn_exp2f(st.m[qt] - mnew); st.m[qt] = mnew;
        const float muse = mnew < -1e29f ? 0.f : mnew;
        float ls = 0.f; unsigned pk[4][2];
#pragma unroll
        for (int kt = 0; kt < 4; ++kt) { float e[4];
#pragma unroll
            for (int rg = 0; rg < 4; ++rg) { e[rg] = __builtin_amdgcn_exp2f(sv[kt][rg] - muse); ls += e[rg]; }
            pk[kt][0] = pg8::cvt_pk_bf16(e[0], e[1]); pk[kt][1] = pg8::cvt_pk_bf16(e[2], e[3]); }
        st.l[qt] = st.l[qt] * alpha + ls;
#pragma unroll
        for (int dt = 0; dt < 4; ++dt) st.o[dt][qt] *= alpha;
        pf[qt][0] = mk_frag(pk[0][0], pk[0][1], pk[1][0], pk[1][1]); pf[qt][1] = mk_frag(pk[2][0], pk[2][1], pk[3][0], pk[3][1]);
        __builtin_amdgcn_sched_barrier(0);
    }
#pragma unroll
    for (int ks = 0; ks < 2; ++ks)
#pragma unroll
        for (int dt = 0; dt < 4; ++dt) { const bf16x8 vf = vfrag_read(vt_lds, L.voff[dt], 32 * ks);
            st.o[dt][0] = __builtin_amdgcn_mfma_f32_16x16x32_bf16(vf, pf[0][ks], st.o[dt][0], 0, 0, 0);
            st.o[dt][1] = __builtin_amdgcn_mfma_f32_16x16x32_bf16(vf, pf[1][ks], st.o[dt][1], 0, 0, 0); }
}

template <int BR>
__device__ __forceinline__ void attn_branch(const Frame& F, const bf16_t* PROJ, int b, int g, int t0, unsigned tiles  , const LAS float* btab_h,
                                            const bf16x8 (&qf)[2][2], const int (&tq)[2], const unsigned (&sel)[2], const float (&gate)[2], const LaneOffs& L) {
    const int lane = F.lane, tid = F.tid;
    const int ck = (BR == 0 ? C_KS : C_KW) + g * 64, cv = (BR == 0 ? C_VS : C_VW) + g * 64;
    const int srow = tid >> 3, sch = tid & 7;
    AttnState st;
#pragma unroll
    for (int dt = 0; dt < 4; ++dt) { st.o[dt][0] = (f32x4){0.f, 0.f, 0.f, 0.f}; st.o[dt][1] = (f32x4){0.f, 0.f, 0.f, 0.f}; }
    st.m[0] = st.m[1] = -1e30f; st.l[0] = st.l[1] = 0.f;
    unsigned rem = tiles; int cur = 0;
    u32x4v rk0, rv0, rk1, rv1;
    const bf16_t* srcb = PROJ + (size_t)(b * S + srow) * NPAD + sch * 8;
#define AT_LOAD(RK, RV, jj) do { const bf16_t* rowp = srcb + (size_t)(64 * (jj)) * NPAD; RK = *(const u32x4v*)(rowp + ck); RV = *(const u32x4v*)(rowp + cv); } while (0)
#define AT_WRITE(RK, RV, bufi) do { *(LAS u32x4v*)(F.lds + AT_KV + (bufi) * 16384 + L.soff) = RK; *(LAS u32x4v*)(F.lds + AT_KV + (bufi) * 16384 + 8192 + L.soff) = RV; } while (0)
#define AT_COMPUTE(jj) do { const bool near = (t0 + 8 * F.wave) - (64 * (jj) + 63) < 128; \
        attn_tile<BR>(F.lds + AT_KV + cur * 16384, F.lds + AT_KV + cur * 16384 + 8192, btab_h, qf, tq, sel, (jj), near, st, lane, L); } while (0)
    int j = __builtin_ctz(rem); rem &= rem - 1;
    AT_LOAD(rk0, rv0, j); AT_WRITE(rk0, rv0, 0);
    int j1 = -1; if (rem) { j1 = __builtin_ctz(rem); rem &= rem - 1; AT_LOAD(rk0, rv0, j1); }
    __syncthreads();
    for (;;) {
        int j2 = -1; if (rem) { j2 = __builtin_ctz(rem); rem &= rem - 1; AT_LOAD(rk1, rv1, j2); }
        AT_COMPUTE(j);
        if (j1 >= 0) AT_WRITE(rk0, rv0, cur ^ 1);
        __syncthreads(); cur ^= 1;
        if (j1 < 0) break;
        int j3 = -1; if (rem) { j3 = __builtin_ctz(rem); rem &= rem - 1; AT_LOAD(rk0, rv0, j3); }
        AT_COMPUTE(j1);
        if (j2 >= 0) AT_WRITE(rk1, rv1, cur ^ 1);
        __syncthreads(); cur ^= 1;
        if (j2 < 0) break;
        j = j2; j1 = j3;
    }
#undef AT_LOAD
#undef AT_WRITE
#undef AT_COMPUTE
    int pob = AT_OUT + tid * 4; asm volatile("" : "+v"(pob));
    LAS float* po = (LAS float*)(F.lds + pob);
#pragma unroll
    for (int qt = 0; qt < 2; ++qt) { float l = st.l[qt]; l += __shfl_xor(l, 16); l += __shfl_xor(l, 32); const float sc = l > 0.f ? gate[qt] / l : 0.f;
#pragma unroll
        for (int dt = 0; dt < 4; ++dt)
#pragma unroll
            for (int e = 0; e < 4; ++e) po[((qt * 4 + dt) * 4 + e) * 512] += st.o[dt][qt][e] * sc; }
}

__device__ __forceinline__ void p4_attn_mfma(const Frame& F) {
    const bf16_t* PROJ = (const bf16_t*)(F.ws + WS_PROJ); const bf16_t* KC = (const bf16_t*)(F.ws + WS_KC); const bf16_t* VC = (const bf16_t*)(F.ws + WS_VC);
    bf16_t* OATT = (bf16_t*)(F.ws + WS_OATT); const float* rel = F.in[21];
    const int lane = F.lane, tid = F.tid, wave = F.wave, grp = lane >> 4, col = lane & 15, qi = col >> 2, r = col & 3;
    LAS float* btab = (LAS float*)(F.lds + AT_BTAB); LAS float* impq = (LAS float*)(F.lds + AT_IMP); LAS unsigned* selm = (LAS unsigned*)(F.lds + AT_SEL);
    const LaneOffs L = lane_offs(lane, tid);
    for (int i = tid; i < 8 * 129; i += NTHREADS) { const int hh = i / 129, dd = i % 129; btab[hh * BT_STRIDE + dd] = rel[rel_bucket(dd) * 8 + hh] * LOG2E; }
    __syncthreads();
    for (int uu = blockIdx.x; uu < 1024; uu += F.G) {
        int sidx = uu;
        if (F.G == 256) { const int round = uu >> 8, k = uu & 255; sidx = (round == 0) ? k : (round == 1) ? 511 - k : (round == 2) ? 512 + k : 1023 - k; }
        const int qb = 31 - (sidx >> 5), bg = sidx & 31, b = bg >> 1, g = bg & 1, t0 = qb * 64, h = g * 4 + r;
        const LAS float* btab_h = btab + h * BT_STRIDE;
        int tq[2]; bf16x8 qf[2][2]; float gate[3][2];
#pragma unroll
        for (int qt = 0; qt < 2; ++qt) { tq[qt] = t0 + 8 * wave + 4 * qt + qi; const bf16_t* prow = PROJ + (size_t)(b * S + tq[qt]) * NPAD;
#pragma unroll
            for (int ks = 0; ks < 2; ++ks) qf[qt][ks] = *(const bf16x8*)(prow + C_Q + h * 64 + ks * 32 + 8 * grp);
#pragma unroll
            for (int jg = 0; jg < 3; ++jg) gate[jg][qt] = sigmoidf_(bf2f(prow[C_GT + h * 3 + jg])); }
#pragma unroll
        for (int i = 0; i < 2; ++i) { const int c2 = tid + 512 * i, row = c2 >> 3, ch = c2 & 7; const size_t src = ((size_t)(b * 2 + g) * 128 + row) * 64 + ch * 8;
            *(LAS u32x4v*)(F.lds + AT_KC + L.soff + 8192 * i) = *(const u32x4v*)(KC + src); *(LAS u32x4v*)(F.lds + AT_VC + L.soff + 8192 * i) = *(const u32x4v*)(VC + src); }
        __syncthreads();
#ifndef AT_SKIP_CMP
        {
            const int nvmax = t0 + 63 >= 31 ? ((t0 + 63 - 31) >> 4) + 1 : 0;
            const float SC = 0.125f * LOG2E; const int srcl = (lane + 48) & 63;
            int pob = AT_OUT + tid * 4; asm volatile("" : "+v"(pob));
            LAS float* po = (LAS float*)(F.lds + pob);
#pragma unroll
            for (int qt = 0; qt < 2; ++qt) {
                f32x4 sa[8];
#pragma unroll
                for (int kt = 0; kt < 8; ++kt) sa[kt] = (f32x4){0.f, 0.f, 0.f, 0.f};
#pragma unroll
                for (int kt = 0; kt < 8; ++kt) if (kt * 16 < nvmax) {
#pragma unroll
                    for (int ks = 0; ks < 2; ++ks) { const bf16x8 kf = *(const LAS bf16x8*)(F.lds + AT_KC + L.koff[ks] + kt * 2048);
                        sa[kt] = __builtin_amdgcn_mfma_f32_16x16x32_bf16(kf, qf[qt][ks], sa[kt], 0, 0, 0); } }
                __builtin_amdgcn_sched_barrier(0);
                int d0 = tq[qt] - 31 - 64 * grp; asm volatile("" : "+v"(d0));
                float mx = -1e30f;
#pragma unroll
                for (int kt = 0; kt < 8; ++kt)
#pragma unroll
                    for (int rg = 0; rg < 4; ++rg) { const int c = 256 * kt + 16 * rg; const int dist = d0 - c; const int dd = dist < 0 ? 0 : (dist > 128 ? 128 : dist);
                        const float sx = sa[kt][rg] * SC + btab_h[dd]; const float s = d0 >= c ? sx : -1e30f; sa[kt][rg] = s; mx = fmaxf(mx, s); }
                mx = fmaxf(mx, __shfl_xor(mx, 16)); mx = fmaxf(mx, __shfl_xor(mx, 32));
                float sum = 0.f;
#pragma unroll
                for (int kt = 0; kt < 8; ++kt)
#pragma unroll
                    for (int rg = 0; rg < 4; ++rg) { const int c = 256 * kt + 16 * rg; const float ex = __builtin_amdgcn_exp2f(sa[kt][rg] - mx); const float e = d0 >= c ? ex : 0.f; sa[kt][rg] = e; sum += e; }
                __builtin_amdgcn_sched_barrier(0);
                sum += __shfl_xor(sum, 16); sum += __shfl_xor(sum, 32);
                const float inv = sum > 0.f ? 1.0f / sum : 0.f;
                float prev3 = 0.f;
#pragma unroll
                for (int kt = 0; kt < 8; ++kt) { const float p3 = sa[kt][3] * inv; const float part = (sa[kt][0] * inv + sa[kt][1] * inv) + (sa[kt][2] * inv + p3);
                    const float xa = __shfl(p3, srcl), xb = __shfl(prev3, srcl); float tot = part + (grp >= 1 ? xa : xb);
                    tot += __shfl_xor(tot, 1); tot += __shfl_xor(tot, 2);
                    if (r == 0) impq[(8 * wave + 4 * qt + qi) * 33 + 4 * kt + grp] = tot;
                    prev3 = p3; }
                __builtin_amdgcn_sched_barrier(0);
                f32x4 oc[4];
#pragma unroll
                for (int dt = 0; dt < 4; ++dt) oc[dt] = (f32x4){0.f, 0.f, 0.f, 0.f};
#pragma unroll
                for (int ks = 0; ks < 4; ++ks) if (ks * 32 < nvmax) {
                    const bf16x8 pfr = mk_frag(pg8::cvt_pk_bf16(sa[2 * ks][0], sa[2 * ks][1]), pg8::cvt_pk_bf16(sa[2 * ks][2], sa[2 * ks][3]),
                                               pg8::cvt_pk_bf16(sa[2 * ks + 1][0], sa[2 * ks + 1][1]), pg8::cvt_pk_bf16(sa[2 * ks + 1][2], sa[2 * ks + 1][3]));
#pragma unroll
                    for (int dt = 0; dt < 4; ++dt) { const bf16x8 vf = vfrag_read(F.lds + AT_VC, L.voff[dt], 32 * ks); oc[dt] = __builtin_amdgcn_mfma_f32_16x16x32_bf16(vf, pfr, oc[dt], 0, 0, 0); } }
                const float scq = inv * gate[0][qt];
#pragma unroll
                for (int dt = 0; dt < 4; ++dt)
#pragma unroll
                    for (int e = 0; e < 4; ++e) po[((qt * 4 + dt) * 4 + e) * 512] = oc[dt][e] * scq;
                __builtin_amdgcn_sched_barrier(0);
            }
        }
#endif
        __syncthreads();
#ifndef AT_SKIP_SEL
        {
            const int q = tid >> 3, jj = tid & 7, cur = qb; unsigned bits = 0u;
            float vj[4];
#pragma unroll
            for (int e = 0; e < 4; ++e) { const int j = jj * 4 + e; const bool forced = (j == 0) || (j == cur) || (j == cur - 1); vj[e] = forced ? 1e4f : (j <= cur ? impq[q * 33 + j] : -INFINITY); }
            int rk[4] = {0, 0, 0, 0};
            for (int jp = 0; jp < 32; ++jp) { const bool forced = (jp == 0) || (jp == cur) || (jp == cur - 1); const float vp = forced ? 1e4f : (jp <= cur ? impq[q * 33 + jp] : -INFINITY);
#pragma unroll
                for (int e = 0; e < 4; ++e) rk[e] += ((vp > vj[e]) || (vp == vj[e] && jp < jj * 4 + e)) ? 1 : 0; }
#pragma unroll
            for (int e = 0; e < 4; ++e) bits |= (rk[e] < 8 ? 1u : 0u) << (jj * 4 + e);
            bits |= __shfl_xor(bits, 1); bits |= __shfl_xor(bits, 2); bits |= __shfl_xor(bits, 4);
            if (jj == 0) selm[q] = bits;
        }
#endif
        __syncthreads();
        unsigned sel[2] = {selm[8 * wave + qi], selm[8 * wave + 4 + qi]};
        unsigned un = selm[lane];
#pragma unroll
        for (int o = 32; o >= 1; o >>= 1) un |= __shfl_xor(un, o);
        un = __builtin_amdgcn_readfirstlane(un);
        const unsigned causal = qb == 31 ? 0xFFFFFFFFu : ((2u << qb) - 1u);
#ifndef AT_SKIP_BR0
        { const float gt1[2] = {gate[1][0], gate[1][1]}; attn_branch<0>(F, PROJ, b, g, t0, un & causal, btab_h, qf, tq, sel, gt1, L); }
#endif
#ifndef AT_SKIP_BR1
        { const int jlo = qb >= 8 ? qb - 8 : 0; const unsigned wmask = causal & ~((1u << jlo) - 1u); const float gt2[2] = {gate[2][0], gate[2][1]};
            attn_branch<1>(F, PROJ, b, g, t0, wmask, btab_h, qf, tq, sel, gt2, L); }
#endif
        int pob2 = AT_OUT + tid * 4; asm volatile("" : "+v"(pob2));
#pragma unroll
        for (int qt = 0; qt < 2; ++qt) { bf16_t* orow = OATT + (size_t)(b * S + tq[qt]) * 512 + h * 64 + 4 * grp;
#pragma unroll
            for (int dt = 0; dt < 4; ++dt) { const LAS float* po = (const LAS float*)(F.lds + pob2) + (qt * 4 + dt) * 4 * 512;
                *(uint2*)(orow + dt * 16) = make_uint2(pg8::cvt_pk_bf16(po[0], po[512]), pg8::cvt_pk_bf16(po[1024], po[1536])); } }
    }
}
__device__ __forceinline__ void p5_mixed(const Frame& F) {
    const bf16_t* PROJ = (const bf16_t*)(F.ws + WS_PROJ); const bf16_t* OATT = (const bf16_t*)(F.ws + WS_OATT); bf16_t* MIX = (bf16_t*)(F.ws + WS_H);
    const float* cw = F.in[13]; const float* ga = F.in[14]; const float* gc = F.in[15];
    const int gw = blockIdx.x * NWAVES + F.wave, nw = F.G * NWAVES, lane = F.lane;
    for (int tok = gw; tok < T; tok += nw) {
        const int s = tok % S; const int c0 = lane * 8;
        float a[8], y[8];
        { const uint4 w = *(const uint4*)(OATT + (size_t)tok * 512 + c0); const unsigned ww[4] = {w.x, w.y, w.z, w.w};
#pragma unroll
            for (int e = 0; e < 4; ++e) { a[2 * e] = bflo(ww[e]); a[2 * e + 1] = bfhi(ww[e]); } }
#pragma unroll
        for (int e = 0; e < 8; ++e) y[e] = 0.f;
#pragma unroll
        for (int dt = 0; dt < 3; ++dt) { if (s - 2 + dt >= 0) { const bf16_t* row = PROJ + (size_t)(tok - 2 + dt) * NPAD;
                const uint4 wc = *(const uint4*)(row + C_CC + c0), wh = *(const uint4*)(row + C_CH + c0); const unsigned c4[4] = {wc.x, wc.y, wc.z, wc.w}, h4[4] = {wh.x, wh.y, wh.z, wh.w};
#pragma unroll
                for (int e = 0; e < 4; ++e) { y[2 * e] += cw[dt * 512 + c0 + 2 * e] * (bflo(c4[e]) * bflo(h4[e])); y[2 * e + 1] += cw[dt * 512 + c0 + 2 * e + 1] * (bfhi(c4[e]) * bfhi(h4[e])); } } }
        { const uint4 wb = *(const uint4*)(PROJ + (size_t)tok * NPAD + C_CB + c0); const unsigned b4[4] = {wb.x, wb.y, wb.z, wb.w};
#pragma unroll
            for (int e = 0; e < 4; ++e) { y[2 * e] *= bflo(b4[e]); y[2 * e + 1] *= bfhi(b4[e]); } }
        float sa = 0.f, sy = 0.f;
#pragma unroll
        for (int e = 0; e < 8; ++e) { sa += a[e] * a[e]; sy += y[e] * y[e]; }
        sa = wave_sum(sa); sy = wave_sum(sy);
        const float ra = rsqrtf(sa * (1.0f / 512) + EPS), ry = rsqrtf(sy * (1.0f / 512) + EPS);
        unsigned oa[4], oy[4];
#pragma unroll
        for (int e = 0; e < 4; ++e) { oa[e] = pack2(a[2 * e] * ra * ga[c0 + 2 * e], a[2 * e + 1] * ra * ga[c0 + 2 * e + 1]); oy[e] = pack2(y[2 * e] * ry * gc[c0 + 2 * e], y[2 * e + 1] * ry * gc[c0 + 2 * e + 1]); }
        *(uint4*)(MIX + (size_t)tok * D + c0) = make_uint4(oa[0], oa[1], oa[2], oa[3]);
        *(uint4*)(MIX + (size_t)tok * D + 512 + c0) = make_uint4(oy[0], oy[1], oy[2], oy[3]);
    }
}

struct EpiResGate {
    static constexpr bool PERM = false, AFTER_DRAIN = false;
    float* C; const float* X; const float* MOD; int gate_off;
    __device__ __forceinline__ void operator()(const pg8::f32x4 (&acc)[2][2][4][2], const pg8::Unit& u, int wr, int wc, int fr, int fq) const {
        using pg8::f32x4; using pg8::HALF; using pg8::BM;
        const int row0 = u.pm * BM + wr * 64 + fr, col0 = u.pn * BM + wc * 32 + 4 * fq;
        const int b = (u.pm * BM) / S;
        f32x4 gv[2][2];
#pragma unroll
        for (int bj = 0; bj < 2; ++bj)
#pragma unroll
            for (int n = 0; n < 2; ++n) gv[bj][n] = *(const f32x4*)(MOD + b * 6144 + gate_off + col0 + bj * HALF + n * 16);
#pragma unroll
        for (int ai = 0; ai < 2; ++ai)
#pragma unroll
            for (int m = 0; m < 4; ++m) { const size_t ro = (size_t)(row0 + ai * HALF + m * 16) * D + col0;
#pragma unroll
                for (int bj = 0; bj < 2; ++bj)
#pragma unroll
                    for (int n = 0; n < 2; ++n) { const f32x4 xv = *(const f32x4*)(X + ro + bj * HALF + n * 16); *(f32x4*)(C + ro + bj * HALF + n * 16) = xv + gv[bj][n] * acc[ai][bj][m][n]; } }
    }
};

__device__ __forceinline__ void argmax_bfly(float& v, int& i) {
#pragma unroll
    for (int o = 32; o >= 1; o >>= 1) { const float ov = __shfl_xor(v, o); const int oi = __shfl_xor(i, o); if (ov > v || (ov == v && oi < i)) { v = ov; i = oi; } }
}
__device__ __forceinline__ void p9_route_naive(const Frame& F) {
    const bf16_t* QP = (const bf16_t*)(F.ws + WS_QP); const bf16_t* KEYS = (const bf16_t*)(F.ws + WS_KEYS);
    int* EIDX = (int*)(F.ws + WS_EIDX); float* EW = (float*)(F.ws + WS_EW);
    LAS float* ql = (LAS float*)F.lds + F.wave * 128;
    const int gw = blockIdx.x * NWAVES + F.wave, nw = F.G * NWAVES, lane = F.lane;
    for (int u = gw; u < T * 8; u += nw) {
        const int h = u & 7, tok = u >> 3;
        ql[lane] = bf2f(QP[(size_t)tok * D + h * 128 + lane]); ql[64 + lane] = bf2f(QP[(size_t)tok * D + h * 128 + 64 + lane]);
        lds_wave_sync();
        float tv[2]; int ti[2];
#pragma unroll
        for (int p = 0; p < 2; ++p) {
            float s[2];
#pragma unroll
            for (int kk = 0; kk < 2; ++kk) { const uint4* kr = (const uint4*)(KEYS + ((size_t)(h * 2 + p) * 128 + lane + 64 * kk) * 64); float a = 0.f;
#pragma unroll
                for (int c = 0; c < 8; ++c) { const uint4 w = kr[c]; const unsigned ww[4] = {w.x, w.y, w.z, w.w};
#pragma unroll
                    for (int e = 0; e < 4; ++e) a += ql[p * 64 + c * 8 + 2 * e] * bflo(ww[e]) + ql[p * 64 + c * 8 + 2 * e + 1] * bfhi(ww[e]); }
                s[kk] = a; }
            tv[p] = 0.f; ti[p] = 0;
            for (int i = 0; i < 16; ++i) {
                float v = s[0]; int ix = lane; if (s[1] > v) { v = s[1]; ix = lane + 64; }
                argmax_bfly(v, ix);
                if (lane == i) { tv[p] = v; ti[p] = ix; }
                if (ix == lane) s[0] = -INFINITY; if (ix == lane + 64) s[1] = -INFINITY;
            }
        }
        float cd[4];
        { const float va = __shfl(tv[0], lane >> 2);
#pragma unroll
            for (int i = 0; i < 4; ++i) cd[i] = va + __shfl(tv[1], (lane & 3) * 4 + i); }
        float cs = 0.f; int cc = 0;
        for (int it = 0; it < 16; ++it) {
            float v = cd[0]; int ix = lane * 4;
#pragma unroll
            for (int i = 1; i < 4; ++i) if (cd[i] > v) { v = cd[i]; ix = lane * 4 + i; }
            argmax_bfly(v, ix);
            if (lane == it) { cs = v; cc = ix; }
#pragma unroll
            for (int i = 0; i < 4; ++i) if (ix == lane * 4 + i) cd[i] = -INFINITY;
        }
        const int i1 = __shfl(ti[0], cc >> 4), i2 = __shfl(ti[1], cc & 15);
        const float m = __shfl(cs, 0); float ex = lane < 16 ? __expf(cs - m) : 0.f; const float sum = wave_sum(ex);
        if (lane < 16) { EIDX[(size_t)tok * 128 + h * 16 + lane] = i1 * 128 + i2; EW[(size_t)tok * 128 + h * 16 + lane] = ex / sum; }
        lds_wave_sync();
    }
}


__device__ __forceinline__ int ord_i(float f) { const int u = __float_as_int(f); return u >= 0 ? u : (u ^ 0x7FFFFFFF); }
__device__ __forceinline__ float unord_f(int i) { const int u = i >= 0 ? i : (i ^ 0x7FFFFFFF); return __int_as_float(u); }
#define INT_MIN_ (-2147483647 - 1)
struct CandTab { int a[50], b[50]; };
constexpr CandTab make_cand() { CandTab t{}; int n = 0; for (int a = 0; a < 16; ++a) for (int b = 0; b < 16; ++b) if ((a + 1) * (b + 1) <= 16) { t.a[n] = a; t.b[n] = b; ++n; } return t; }
constexpr CandTab CAND = make_cand();
constexpr int RT_LDS_PER_WAVE = 16 * 32 * 4;
__device__ __forceinline__ void p9_route_mfma(const Frame& F) {
    const bf16_t* QP = (const bf16_t*)(F.ws + WS_QP); const bf16_t* KEYS = (const bf16_t*)(F.ws + WS_KEYS);
    int* EIDX = (int*)(F.ws + WS_EIDX); float* EW = (float*)(F.ws + WS_EW);
    const int lane = F.lane, grp = lane >> 4, col = lane & 15;
    LAS int* itab = (LAS int*)(F.lds + F.wave * RT_LDS_PER_WAVE) + col * 32;
    const int gw = blockIdx.x * NWAVES + F.wave, nw = F.G * NWAVES;
    for (int task = gw; task < (T / 16) * 8; task += nw) {
        const int h = task & 7, tile = task >> 3, tok = tile * 16 + col;
        int lst[2][16];
#pragma unroll
        for (int p = 0; p < 2; ++p) {
            bf16x8 qf[2];
#pragma unroll
            for (int ks = 0; ks < 2; ++ks) qf[ks] = *(const bf16x8*)(QP + (size_t)tok * D + h * 128 + p * 64 + ks * 32 + 8 * grp);
            f32x4 sc[8];
#pragma unroll
            for (int kt = 0; kt < 8; ++kt) { sc[kt] = (f32x4){0.f, 0.f, 0.f, 0.f};
#pragma unroll
                for (int ks = 0; ks < 2; ++ks) { const bf16x8 kf = *(const bf16x8*)(KEYS + ((size_t)(h * 2 + p) * 128 + kt * 16 + col) * 64 + ks * 32 + 8 * grp);
                    sc[kt] = __builtin_amdgcn_mfma_f32_16x16x32_bf16(kf, qf[ks], sc[kt], 0, 0, 0); } }
            int r[32];
#pragma unroll
            for (int kt = 0; kt < 8; ++kt)
#pragma unroll
                for (int rg = 0; rg < 4; ++rg) r[kt * 4 + rg] = (ord_i(sc[kt][rg]) & ~0x7F) | (127 - (kt * 16 + 4 * grp + rg));
#pragma unroll
            for (int it = 0; it < 16; ++it) {
                int m = r[0];
#pragma unroll
                for (int i = 1; i < 32; ++i) m = max(m, r[i]);
                m = max(m, __shfl_xor(m, 16)); m = max(m, __shfl_xor(m, 32));
                lst[p][it] = m;
#pragma unroll
                for (int i = 0; i < 32; ++i) r[i] = (r[i] == m) ? INT_MIN_ : r[i];
            }
            if (grp == 0) {
#pragma unroll
                for (int it = 0; it < 16; ++it) itab[p * 16 + it] = 127 - (lst[p][it] & 0x7F);
            }
        }
        float v0[16], v1[16];
#pragma unroll
        for (int i = 0; i < 16; ++i) { v0[i] = unord_f(lst[0][i] & ~0x7F); v1[i] = unord_f(lst[1][i] & ~0x7F); }
        int ck[50];
#pragma unroll
        for (int i = 0; i < 50; ++i) ck[i] = (ord_i(v0[CAND.a[i]] + v1[CAND.b[i]]) & ~0xFF) | (255 - (CAND.a[i] * 16 + CAND.b[i]));
        int top[16];
#pragma unroll
        for (int it = 0; it < 16; ++it) {
            int m = ck[0];
#pragma unroll
            for (int i = 1; i < 50; ++i) m = max(m, ck[i]);
            top[it] = m;
#pragma unroll
            for (int i = 0; i < 50; ++i) ck[i] = (ck[i] == m) ? INT_MIN_ : ck[i];
        }
        lds_wave_sync();
        const float smax = unord_f(top[0] & ~0xFF);
        float ex[16], sum = 0.f;
#pragma unroll
        for (int it = 0; it < 16; ++it) { ex[it] = __expf(unord_f(top[it] & ~0xFF) - smax); sum += ex[it]; }
        const float inv = 1.0f / sum;
        if (grp == 0) {
#pragma unroll
            for (int it = 0; it < 16; ++it) { const int flat = 255 - (top[it] & 0xFF); const int i1 = itab[flat >> 4], i2 = itab[16 + (flat & 15)];
                EIDX[(size_t)tok * 128 + h * 16 + it] = i1 * 128 + i2; EW[(size_t)tok * 128 + h * 16 + it] = ex[it] * inv; }
        }
        lds_wave_sync();
    }
}

constexpr int N_PHASES = 14;
struct Args { const float* in[23]; float* out; unsigned char* ws; int ph_lo, ph_hi; };
__global__ void __launch_bounds__(NTHREADS, 2) fwd(Args args) {
    extern __shared__ __attribute__((aligned(16))) unsigned char lds_raw[];
    Frame F;
#pragma unroll
    for (int i = 0; i < 23; ++i) F.in[i] = args.in[i];
    F.out = args.out; F.ws = args.ws; F.lds = (LAS unsigned char*)lds_raw;
    F.tid = threadIdx.x; F.lane = F.tid & 63; F.wave = __builtin_amdgcn_readfirstlane(F.tid >> 6); F.G = gridDim.x;
    volatile LAS unsigned* misc = (volatile LAS unsigned*)(F.lds + LDS_MISC_OFF);
    if (F.tid < 64) misc[F.tid] = 0u;
    __syncthreads();
    XcdBarrier bar; bar.bar = (unsigned*)(F.ws + WS_CTL); bar.x = 0; bar.st = misc;
    const int lo = args.ph_lo, hi = args.ph_hi;
    if (hi - lo > 1) bar = xcd_barrier_post((unsigned*)(F.ws + WS_CTL), misc);
#ifndef PH_MASK
#define PH_MASK 0xFFFF
#endif
#define IN(k) (((PH_MASK >> (k)) & 1) && lo <= (k) && (k) < hi)
#define SEAM(k) do { if (IN(k) && IN((k) + 1)) xcd_barrier(bar); } while (0)
    const float* MOD = (const float*)(F.ws + WS_MOD);
    if (IN(0)) { p0_prologue(F); } SEAM(0);
    if (IN(1)) { norm_mod_rows(F, F.in[0], F.in[2], 0, 1024, (bf16_t*)(F.ws + WS_H)); } SEAM(1);
    if (IN(2)) { pg8::Gemm g{(const pg8::bf16_t*)(F.ws + WS_H), (const pg8::bf16_t*)(F.ws + WS_WIN), T, NPAD, D}; pg8::StaticOrder So; So.init(T, NPAD, F.G, (int)blockIdx.x);
        pg8::EpiBf16<0> E{(pg8::bf16_t*)(F.ws + WS_PROJ), NPAD, nullptr, 0, 0};
        pg8::gemm_phase<pg8::EpiBf16<0>, pg8::StaticOrder>(F.lds, g, So, E, nullptr); } SEAM(2);
#ifdef COMPRESS_NAIVE
    if (IN(3)) { p3_compress_naive(F); } SEAM(3);
#else
    if (IN(3)) { p3_compress_mfma(F); } SEAM(3);
#endif
    #ifdef ATTN_NAIVE
    if (IN(4)) { p4_attn_naive(F); } SEAM(4);
#else
    if (IN(4)) { p4_attn_mfma(F); } SEAM(4);
#endif
    if (IN(5)) { p5_mixed(F); } SEAM(5);
    if (IN(6)) { pg8::Gemm g{(const pg8::bf16_t*)(F.ws + WS_H), (const pg8::bf16_t*)(F.ws + WS_WOUT), T, D, D}; pg8::StaticOrder So; So.init(T, D, F.G, (int)blockIdx.x);
        EpiResGate E{F.out, F.in[0], MOD, 2048};
        pg8::gemm_phase<EpiResGate, pg8::StaticOrder>(F.lds, g, So, E, nullptr); } SEAM(6);
    if (IN(7)) { norm_mod_rows_q(F, F.out, F.in[3], 3072, 4096, (bf16_t*)(F.ws + WS_H)); } SEAM(7);
    if (IN(8)) { pg8::Gemm g{(const pg8::bf16_t*)(F.ws + WS_H), (const pg8::bf16_t*)(F.ws + WS_WQ), T, D, D}; pg8::StaticOrder So; So.init(T, D, F.G, (int)blockIdx.x);
        pg8::EpiBf16<0> E{(pg8::bf16_t*)(F.ws + WS_QP), D, nullptr, 0, 0};
        pg8::gemm_phase<pg8::EpiBf16<0>, pg8::StaticOrder>(F.lds, g, So, E, nullptr); } SEAM(8);
    #ifdef ROUTE_NAIVE
    if (IN(9)) { p9_route_naive(F); } SEAM(9);
#else
    if (IN(9)) { p9_route_mfma(F); } SEAM(9);
#endif
    if (IN(10)) { p10a_udots(F); } SEAM(10);
    if (IN(11)) { p10b_coef(F); } SEAM(11);
    if (IN(12)) { p10c_vsum(F); } SEAM(12);
    if (IN(13)) { p10d_final(F); }
#undef IN
#undef SEAM
}

extern "C" void kernel_launch(void* const* d_in, const int* in_sizes, int n_in, void* d_out, int out_size, void* d_ws, size_t ws_size, hipStream_t stream) {
    static int grid = 0;
    if (grid == 0) {
        if (n_in != 23 || out_size != T * D || ws_size < WS_END) { fprintf(stderr, "kernel_launch: unexpected shapes: n_in %d out %d ws %zu (need %zu)\n", n_in, out_size, ws_size, (size_t)WS_END); grid = -1; return; }
        int dev = 0, cus = 0, per_cu = 0;
        if (hipGetDevice(&dev) != hipSuccess || hipDeviceGetAttribute(&cus, hipDeviceAttributeMultiprocessorCount, dev) != hipSuccess) { grid = -1; return; }
        if (hipFuncSetAttribute((const void*)fwd, hipFuncAttributeMaxDynamicSharedMemorySize, LDS_BYTES) != hipSuccess) { fprintf(stderr, "kernel_launch: hipFuncSetAttribute failed\n"); grid = -1; return; }
        if (hipOccupancyMaxActiveBlocksPerMultiprocessor(&per_cu, (const void*)fwd, NTHREADS, LDS_BYTES) != hipSuccess || per_cu < 1) { fprintf(stderr, "kernel_launch: occupancy query says %d\n", per_cu); (void)hipGetLastError(); per_cu = 1; }
        grid = cus;
    }
    if (grid < 0) return;
    (void)hipMemsetAsync((char*)d_ws + WS_CTL, 0, CTL_BYTES, stream);
    Args a{};
    for (int i = 0; i < 23; ++i) a.in[i] = (const float*)d_in[i];
    a.out = (float*)d_out; a.ws = (unsigned char*)d_ws;
#if MK_N_LAUNCHES == 1
    a.ph_lo = 0; a.ph_hi = N_PHASES;
    hipLaunchKernelGGL(fwd, dim3(grid), dim3(NTHREADS), LDS_BYTES, stream, a);
#else
#ifdef PROBE_LIST
    { const int plist[] = PROBE_LIST; for (int p : plist) { if (p < 0) { (void)hipMemsetAsync((char*)d_ws + WS_CTL, 0, CTL_BYTES, stream); continue; } a.ph_lo = p; a.ph_hi = p + 1; hipLaunchKernelGGL(fwd, dim3(grid), dim3(NTHREADS), LDS_BYTES, stream, a); } }
#else
    for (int p = 0; p < N_PHASES; ++p) { a.ph_lo = p; a.ph_hi = p + 1; hipLaunchKernelGGL(fwd, dim3(grid), dim3(NTHREADS), LDS_BYTES, stream, a); }
#endif
#endif
}
```

```cpp
#include <hip/hip_runtime.h>
#include <cstdio>
#include <cstdint>
#include <cstdlib>

#ifndef MK_N_LAUNCHES
#define MK_N_LAUNCHES 1
#endif
#define XB_TMO      128
#define XB_XCNT(j)  (256  + 64 * (j))
#define XB_XSUB(j)  (1280 + 64 * (j))
#define XB_XGEN(j)  (2304 + 64 * (j))
#define XB_TOP      3328
#define XB_TOPGEN   3392
#define XCD_BAR_WORDS 3456
#define XB_SPIN_CAP (1u << 18)
#define LAS __attribute__((address_space(3)))

__device__ __forceinline__ unsigned xb_ld(unsigned* p)              { return __hip_atomic_load(p, __ATOMIC_RELAXED, __HIP_MEMORY_SCOPE_AGENT); }
__device__ __forceinline__ unsigned xb_add(unsigned* p, unsigned v) { return __hip_atomic_fetch_add(p, v, __ATOMIC_RELAXED, __HIP_MEMORY_SCOPE_AGENT); }
__device__ __forceinline__ unsigned xb_xcc_id() { return (unsigned)__builtin_amdgcn_s_getreg((3 << 11) | 20) & 0xFu; }
#define XB_SPIN(cond, bar) do { unsigned _sp = 0; while (cond) { __builtin_amdgcn_s_sleep(1); \
    if ((++_sp & 255u) == 0u) { if (xb_ld(&(bar)[XB_TMO])) break; if (_sp > XB_SPIN_CAP) { atomicAdd(&(bar)[XB_TMO], 1u); break; } } } } while (0)

struct XcdBarrier {
    unsigned* bar; unsigned x;
    volatile LAS unsigned* st;
};

__device__ __forceinline__ XcdBarrier xcd_barrier_post(unsigned* bar, volatile LAS unsigned* st) {
    XcdBarrier b; b.bar = bar; b.x = xb_xcc_id(); b.st = st;
    if (threadIdx.x == 0) (void)xb_add(&bar[XB_XCNT(b.x)], 1u);
    return b;
}
__device__ __forceinline__ void xcd_barrier_complete(unsigned* bar, unsigned x, unsigned& nloc, unsigned& nx) {
    const unsigned G = gridDim.x * gridDim.y * gridDim.z;
    unsigned sum, cnt, mine, sp = 0u;
    for (;;) {
        sum = 0u; cnt = 0u; mine = 0u;
#pragma unroll
        for (unsigned j = 0; j < 16; ++j) { const unsigned c = xb_ld(&bar[XB_XCNT(j)]); sum += c; cnt += (c > 0u) ? 1u : 0u; mine = (j == x) ? c : mine; }
        if (sum == G) break;
        __builtin_amdgcn_s_sleep(1);
        if ((++sp & 255u) == 0u) { if (xb_ld(&bar[XB_TMO])) break; if (sp > XB_SPIN_CAP) { atomicAdd(&bar[XB_TMO], 1u); break; } }
    }
    nloc = mine > 0u ? mine : 1u; nx = cnt > 0u ? cnt : 1u;
}

__device__ __forceinline__ void xcd_barrier(const XcdBarrier& b) {
    asm volatile("s_waitcnt vmcnt(0)" ::: "memory");
    __syncthreads();
    if (threadIdx.x == 0) {
        unsigned* bar = b.bar;
        __builtin_amdgcn_s_waitcnt(0);
        unsigned nloc = b.st[0], nx = b.st[1];
        if (nloc == 0u) { xcd_barrier_complete(bar, b.x, nloc, nx); b.st[0] = nloc; b.st[1] = nx; }
        const unsigned old = xb_add(&bar[XB_XSUB(b.x)], 1u);
        const unsigned gen = old / nloc;
        if (old + 1u == (gen + 1u) * nloc) {
            __builtin_amdgcn_fence(__ATOMIC_RELEASE, "agent");
            asm volatile("s_waitcnt vmcnt(0)" ::: "memory");
            const unsigned og = xb_add(&bar[XB_TOP], 1u);
            const unsigned tg = og / nx;
            if (og + 1u == (tg + 1u) * nx) xb_add(&bar[XB_TOPGEN], 1u);
            else XB_SPIN(xb_ld(&bar[XB_TOPGEN]) == tg, bar);
            __builtin_amdgcn_fence(__ATOMIC_ACQUIRE, "agent");
            xb_add(&bar[XB_XGEN(b.x)], 1u);
            asm volatile("s_waitcnt vmcnt(0)" ::: "memory");
        } else {
            XB_SPIN(xb_ld(&bar[XB_XGEN(b.x)]) == gen, bar);
            __builtin_amdgcn_fence(__ATOMIC_ACQUIRE, "agent");
            asm volatile("s_waitcnt vmcnt(0)" ::: "memory");
        }
    }
    __syncthreads();
}

namespace pg8 {
#define PG8_LAS __attribute__((address_space(3)))
typedef unsigned short bf16_t;
typedef short bf16x8 __attribute__((ext_vector_type(8)));
typedef float f32x4 __attribute__((ext_vector_type(4)));
typedef unsigned u32x4 __attribute__((ext_vector_type(4)));
constexpr int BM = 256, BK = 64, HALF = 128, HTB = HALF * BK * 2  , STAGE_BYTES = 8 * HTB, NXCD = 8, WGM = 8;

__host__ __device__ __forceinline__ int lds_byte(int r, int c) { const int st = (r >> 4) * 2 + (c >> 5), rr = r & 15, cc = c & 31, ob = rr * 64 + cc * 2; return st * 1024 + (ob ^ (((ob >> 9) & 1) << 5)); }
__host__ __device__ __forceinline__ void stage_rc(int b, int& R, int& C) { const int st = b / 1024, sb = b % 1024, swz = sb ^ (((sb >> 9) & 1) << 5); R = (st >> 1) * 16 + swz / 64; C = (st & 1) * 32 + (swz % 64) / 2; }
__host__ __device__ __forceinline__ int perm32(int rho) { const int n = rho >> 4, i = rho & 15; return 8 * (i >> 2) + 4 * n + (i & 3); }

struct Unit { int pm, pn; };
struct Gemm { const bf16_t* A; const bf16_t* Bt; int M, N, K; };

struct StaticOrder {
    int nM, nN, nwg, G, c;
    __host__ __device__ void init(int M, int N, int G_, int c_) { nM = M / BM; nN = N / BM; nwg = nM * nN; G = G_; c = c_; }
    __host__ __device__ bool next(int i, Unit& u) const {
        const long L = (long)i * G + c; if (L >= nwg) return false;
        int wgid = (int)L; { const int q = nwg / NXCD, r = nwg % NXCD, xcd = wgid % NXCD, off = wgid / NXCD; wgid = (xcd < r ? xcd * (q + 1) : r * (q + 1) + (xcd - r) * q) + off; }
        const int nig = WGM * nN, gid = wgid / nig, fm = gid * WGM, gsz = (nM - fm) < WGM ? (nM - fm) : WGM;
        u.pm = fm + ((wgid % nig) % gsz); u.pn = (wgid % nig) / gsz; return true;
    }
    __device__ __forceinline__ void a_ready(const Unit&) const {}
    __device__ __forceinline__ void done(const Unit&) const {}
};
struct CountedOrder : StaticOrder {
    const unsigned* ready; unsigned need; unsigned* tmo;
    __device__ __forceinline__ void a_ready(const Unit& u) const {
        if (threadIdx.x < 64) {
            const unsigned long long t0 = __builtin_amdgcn_s_memrealtime(); unsigned polls = 0;
            while ((unsigned)__builtin_amdgcn_readfirstlane(__hip_atomic_load(ready + 64 * u.pm, __ATOMIC_RELAXED, __HIP_MEMORY_SCOPE_AGENT)) < need) {
                if ((++polls & 255u) == 0u && __builtin_amdgcn_readfirstlane(__hip_atomic_load(tmo, __ATOMIC_RELAXED, __HIP_MEMORY_SCOPE_AGENT)) != 0u) break;
                if (__builtin_amdgcn_s_memrealtime() - t0 > 2000000ull) {
                    if (threadIdx.x == 0) { unsigned expect = 0u; __hip_atomic_compare_exchange_strong(tmo + 1, &expect, 0x600u | (unsigned)(u.pm & 0xff), __ATOMIC_RELAXED, __ATOMIC_RELAXED, __HIP_MEMORY_SCOPE_AGENT); __hip_atomic_store(tmo, 1u, __ATOMIC_RELAXED, __HIP_MEMORY_SCOPE_AGENT); }
                    break; }
                __builtin_amdgcn_s_sleep(2); }
            __builtin_amdgcn_fence(__ATOMIC_ACQUIRE, "agent");
            asm volatile("s_waitcnt vmcnt(0)" ::: "memory");
        }
#if !defined(BROKEN_HOOK_NO_BARRIER)
        asm volatile("" ::: "memory"); __builtin_amdgcn_s_barrier(); asm volatile("" ::: "memory");
#endif
    }
};

__device__ __forceinline__ unsigned cvt_pk_bf16(float lo, float hi) { unsigned r; asm volatile("v_cvt_pk_bf16_f32 %0, %1, %2" : "=v"(r) : "v"(lo), "v"(hi)); return r; }
typedef float f32x2 __attribute__((ext_vector_type(2)));
__device__ __forceinline__ f32x2 gelu_pk(f32x2 v) {
    const f32x2 av = __builtin_elementwise_abs(v), d = av * 0.2316418882f + 1.0f;
    f32x2 t; t.x = __builtin_amdgcn_rcpf(d.x); t.y = __builtin_amdgcn_rcpf(d.y);
    f32x2 q = t * 0.5307027145f + (-0.7265760135f); q = q * t + 0.7107068705f; q = q * t + (-0.142248368f); q = q * t + 0.127414796f; q = q * t;
    const f32x2 s = (v * v) * (-0.72134752044f);
    f32x2 e; e.x = __builtin_amdgcn_exp2f(s.x); e.y = __builtin_amdgcn_exp2f(s.y);
    const f32x2 m = v * (q * e), r = v - m;
    f32x2 o; o.x = v.x < 0.f ? m.x : r.x; o.y = v.y < 0.f ? m.y : r.y; return o;
}

struct EpiF32 {
    static constexpr bool PERM = false, AFTER_DRAIN = false;
    float* C; int ldc; const float* bias;
    __device__ __forceinline__ void operator()(const f32x4 (&acc)[2][2][4][2], const Unit& u, int wr, int wc, int fr, int fq) const {
        const int row0 = u.pm * BM + wr * 64 + fr, col0 = u.pn * BM + wc * 32 + 4 * fq;
        f32x4 bv[2][2];
#pragma unroll
        for (int bj = 0; bj < 2; ++bj)
#pragma unroll
            for (int n = 0; n < 2; ++n) bv[bj][n] = bias ? *(const f32x4*)(bias + col0 + bj * HALF + n * 16) : (f32x4){0.f, 0.f, 0.f, 0.f};
#pragma unroll
        for (int ai = 0; ai < 2; ++ai)
#pragma unroll
            for (int m = 0; m < 4; ++m) { float* rowp = C + (size_t)(row0 + ai * HALF + m * 16) * ldc + col0;
#pragma unroll
                for (int bj = 0; bj < 2; ++bj)
#pragma unroll
                    for (int n = 0; n < 2; ++n) *(f32x4*)(rowp + bj * HALF + n * 16) = acc[ai][bj][m][n] + bv[bj][n]; }
    }
};
template <int ACT  > struct EpiBf16 {
    static constexpr bool PERM = true, AFTER_DRAIN = false;
    bf16_t* O; int ldc; const float* bias; int split_cols; size_t split_stride;
    __device__ __forceinline__ void operator()(const f32x4 (&acc)[2][2][4][2], const Unit& u, int wr, int wc, int fr, int fq) const {
        const int row0 = u.pm * BM + wr * 64 + fr; int colt = u.pn * BM; bf16_t* base = O;
        if (split_cols) { const int t = colt / split_cols; base += (size_t)t * split_stride; colt -= t * split_cols; }
        const int col0 = colt + wc * 32 + 8 * fq, bcol0 = u.pn * BM + wc * 32 + 8 * fq;
        f32x4 bv[2][2];
#pragma unroll
        for (int bj = 0; bj < 2; ++bj)
#pragma unroll
            for (int n = 0; n < 2; ++n) bv[bj][n] = bias ? *(const f32x4*)(bias + bcol0 + bj * HALF + 4 * n) : (f32x4){0.f, 0.f, 0.f, 0.f};
#pragma unroll
        for (int ai = 0; ai < 2; ++ai)
#pragma unroll
            for (int m = 0; m < 4; ++m) { bf16_t* rowp = base + (size_t)(row0 + ai * HALF + m * 16) * ldc + col0;
#pragma unroll
                for (int bj = 0; bj < 2; ++bj) { f32x4 v0 = acc[ai][bj][m][0] + bv[bj][0], v1 = acc[ai][bj][m][1] + bv[bj][1];
                    if (ACT == 1) { f32x2 a = gelu_pk((f32x2){v0[0], v0[1]}), b = gelu_pk((f32x2){v0[2], v0[3]}), c = gelu_pk((f32x2){v1[0], v1[1]}), d = gelu_pk((f32x2){v1[2], v1[3]});
                        v0 = (f32x4){a.x, a.y, b.x, b.y}; v1 = (f32x4){c.x, c.y, d.x, d.y}; }
                    if (ACT == 2) {
#pragma unroll
                        for (int j = 0; j < 4; ++j) { v0[j] = 0.5f * v0[j] * (1.0f + erff(v0[j] * 0.70710678f)); v1[j] = 0.5f * v1[j] * (1.0f + erff(v1[j] * 0.70710678f)); } }
                    u32x4 w; w.x = cvt_pk_bf16(v0[0], v0[1]); w.y = cvt_pk_bf16(v0[2], v0[3]); w.z = cvt_pk_bf16(v1[0], v1[1]); w.w = cvt_pk_bf16(v1[2], v1[3]);
                    *(u32x4*)(rowp + bj * HALF) = w; } }
    }
};

struct PanelStats {
    unsigned* xbuf;
    unsigned* cnt;
    unsigned* tmo;
    int ntn; float eps;
    unsigned code;
    __device__ __forceinline__ bool run(const f32x4 (&v)[2][2][4][2], const Unit& u, int wr, int wc, int fr, int fq, PG8_LAS unsigned char* lds, int wid, int lane) const {
        typedef float f32x2v __attribute__((ext_vector_type(2)));
        PG8_LAS f32x2v* P = (PG8_LAS f32x2v*)lds;
        PG8_LAS f32x2v* S = (PG8_LAS f32x2v*)(lds + 8192);
        PG8_LAS unsigned* flag = (PG8_LAS unsigned*)(lds + 8192 + 2048);
#pragma unroll
        for (int ai = 0; ai < 2; ++ai)
#pragma unroll
            for (int m = 0; m < 4; ++m) {
                float s = 0.f;
#pragma unroll
                for (int bj = 0; bj < 2; ++bj)
#pragma unroll
                    for (int n = 0; n < 2; ++n) { const f32x4 x = v[ai][bj][m][n]; s += (x[0] + x[1]) + (x[2] + x[3]); }
                s += __shfl_xor(s, 16); s += __shfl_xor(s, 32);
                const float mw = s * (1.0f / 64.0f); float q = 0.f;
#pragma unroll
                for (int bj = 0; bj < 2; ++bj)
#pragma unroll
                    for (int n = 0; n < 2; ++n) { const f32x4 d = v[ai][bj][m][n] - mw; q += (d[0] * d[0] + d[1] * d[1]) + (d[2] * d[2] + d[3] * d[3]); }
                q += __shfl_xor(q, 16); q += __shfl_xor(q, 32);
                if (fq == 0) P[(ai * HALF + wr * 64 + m * 16 + fr) * 4 + wc] = (f32x2v){mw, q};
            }
        asm volatile("s_waitcnt lgkmcnt(0)" ::: "memory"); __builtin_amdgcn_s_barrier(); asm volatile("" ::: "memory");
#if defined(BROKEN_NO_WAIT)
        if (blockIdx.x >= 64) { const long long t0 = clock64(); while (clock64() - t0 < 60000) __builtin_amdgcn_s_sleep(8); }
#endif
        const int row = wid * 32 + (lane & 31);
        if (lane < 32) {
            const f32x2v a = P[row * 4 + 0], b = P[row * 4 + 1], c = P[row * 4 + 2], d = P[row * 4 + 3];
            const float mt = (a.x + b.x + c.x + d.x) * 0.25f;
            const float da = a.x - mt, db = b.x - mt, dc = c.x - mt, dd = d.x - mt;
            const float m2 = (a.y + b.y) + (c.y + d.y) + 64.0f * ((da * da + db * db) + (dc * dc + dd * dd));
            unsigned long long* slot = (unsigned long long*)xbuf + ((size_t)(u.pm * BM + row) * 4 + u.pn);
            __hip_atomic_store(slot, ((unsigned long long)__float_as_uint(m2) << 32) | __float_as_uint(mt), __ATOMIC_RELAXED, __HIP_MEMORY_SCOPE_AGENT);
        }
        asm volatile("s_waitcnt vmcnt(0)" ::: "memory");
        if (lane == 0) __hip_atomic_fetch_add(cnt + 64 * u.pm, 1u, __ATOMIC_RELAXED, __HIP_MEMORY_SCOPE_AGENT);
        if (wid == 0) {
            bool dead = false; const unsigned long long t0 = __builtin_amdgcn_s_memrealtime(); const unsigned want = 8u * (unsigned)ntn;
            for (;;) {
#if defined(BROKEN_NO_WAIT)
                break;
#endif
                if ((unsigned)__builtin_amdgcn_readfirstlane(__hip_atomic_load(cnt + 64 * u.pm, __ATOMIC_RELAXED, __HIP_MEMORY_SCOPE_AGENT)) >= want) break;
                if (__builtin_amdgcn_s_memrealtime() - t0 > 2000000ull) {
                    if (lane == 0) { unsigned expect = 0u; __hip_atomic_compare_exchange_strong(tmo + 1, &expect, code | (unsigned)(u.pm & 0xff), __ATOMIC_RELAXED, __ATOMIC_RELAXED, __HIP_MEMORY_SCOPE_AGENT);
                                     __hip_atomic_store(tmo, 1u, __ATOMIC_RELAXED, __HIP_MEMORY_SCOPE_AGENT); }
                    dead = true; break; }
                __builtin_amdgcn_s_sleep(2);
            }
            __builtin_amdgcn_fence(__ATOMIC_ACQUIRE, "agent");
            if (lane == 0) flag[0] = dead ? 1u : 0u;
        }
        asm volatile("s_waitcnt vmcnt(0) lgkmcnt(0)" ::: "memory"); __builtin_amdgcn_s_barrier(); asm volatile("" ::: "memory");
        const bool bad = flag[0] != 0u;
        if (lane < 32) {
            const unsigned long long* slot = (const unsigned long long*)xbuf + (size_t)(u.pm * BM + row) * 4; float mt[4], m2[4]; float ms = 0.f;
#pragma unroll
            for (int t = 0; t < 4; ++t) { if (t < ntn) { const unsigned long long w = __hip_atomic_load(slot + t, __ATOMIC_RELAXED, __HIP_MEMORY_SCOPE_AGENT); mt[t] = __uint_as_float((unsigned)w); m2[t] = __uint_as_float((unsigned)(w >> 32)); } else { mt[t] = 0.f; m2[t] = 0.f; } ms += mt[t]; }
            const float mean = ms / (float)ntn; float q = 0.f;
#pragma unroll
            for (int t = 0; t < 4; ++t) if (t < ntn) { const float dm = mt[t] - mean; q += m2[t] + 256.0f * dm * dm; }
            S[row] = (f32x2v){mean, 1.0f / sqrtf(q / (256.0f * (float)ntn) + eps)};
        }
        asm volatile("s_waitcnt lgkmcnt(0)" ::: "memory"); __builtin_amdgcn_s_barrier(); asm volatile("" ::: "memory");
        return bad;
    }
};
struct EpiLnRes {
    static constexpr bool PERM = false, AFTER_DRAIN = true;
    const float* base; float* out; int ldc; const float* bias; PanelStats st; unsigned poison;
    __device__ __forceinline__ void refuse(size_t i0, size_t stride, int M, int N) const { const float q = __builtin_nanf(""); for (size_t i = i0; i < (size_t)M * N; i += stride) out[(i / N) * ldc + i % N] = q;
        if (i0 == 0) { unsigned expect = 0u; __hip_atomic_compare_exchange_strong(st.tmo + 1, &expect, 0x7f0u, __ATOMIC_RELAXED, __ATOMIC_RELAXED, __HIP_MEMORY_SCOPE_AGENT); __hip_atomic_store(st.tmo, 1u, __ATOMIC_RELAXED, __HIP_MEMORY_SCOPE_AGENT); } }
    __device__ __forceinline__ void fused(f32x4 (&acc)[2][2][4][2], const Unit& u, int wr, int wc, int fr, int fq, PG8_LAS unsigned char* lds, int wid, int lane) const {
        typedef float f32x2v __attribute__((ext_vector_type(2)));
        const PG8_LAS f32x2v* S = (const PG8_LAS f32x2v*)(lds + 8192);
        const int col0 = u.pn * BM + wc * 32 + 4 * fq;
#pragma unroll
        for (int bj = 0; bj < 2; ++bj)
#pragma unroll
            for (int n = 0; n < 2; ++n) { const f32x4 bv = bias ? *(const f32x4*)(bias + col0 + bj * HALF + n * 16) : (f32x4){0.f, 0.f, 0.f, 0.f};
#pragma unroll
                for (int ai = 0; ai < 2; ++ai)
#pragma unroll
                    for (int m = 0; m < 4; ++m) acc[ai][bj][m][n] += bv; }
        const bool bad = st.run(acc, u, wr, wc, fr, fq, lds, wid, lane) || poison != 0u;
        const float qnan = __builtin_nanf("");
#pragma unroll
        for (int ai = 0; ai < 2; ++ai)
#pragma unroll
            for (int m = 0; m < 4; ++m) { const int r = ai * HALF + wr * 64 + m * 16 + fr; const f32x2v sr = S[r]; const size_t off = (size_t)(u.pm * BM + r) * ldc + col0;
#pragma unroll
                for (int bj = 0; bj < 2; ++bj)
#pragma unroll
                    for (int n = 0; n < 2; ++n) { const f32x4 bs = *(const f32x4*)(base + off + bj * HALF + n * 16); f32x4 o = bs + (acc[ai][bj][m][n] - sr.x) * sr.y;
                        if (bad) o = (f32x4){qnan, qnan, qnan, qnan}; *(f32x4*)(out + off + bj * HALF + n * 16) = o; }
                asm volatile("" ::: "memory"); }
    }
};
struct EpiLnResLn {
    static constexpr bool PERM = false, AFTER_DRAIN = true;
    const float* base; float* out; bf16_t* xn; int ldc; const float* bias; PanelStats st1, st2; unsigned poison;
    __device__ __forceinline__ void refuse(size_t i0, size_t stride, int M, int N) const { const float q = __builtin_nanf(""); for (size_t i = i0; i < (size_t)M * N; i += stride) { const size_t o = (i / N) * ldc + i % N; out[o] = q; xn[o] = (bf16_t)0x7fc0u; }
        if (i0 == 0) { unsigned expect = 0u; __hip_atomic_compare_exchange_strong(st1.tmo + 1, &expect, 0x7f0u, __ATOMIC_RELAXED, __ATOMIC_RELAXED, __HIP_MEMORY_SCOPE_AGENT); __hip_atomic_store(st1.tmo, 1u, __ATOMIC_RELAXED, __HIP_MEMORY_SCOPE_AGENT); } }
    __device__ __forceinline__ void fused(f32x4 (&acc)[2][2][4][2], const Unit& u, int wr, int wc, int fr, int fq, PG8_LAS unsigned char* lds, int wid, int lane) const {
        typedef float f32x2v __attribute__((ext_vector_type(2))); typedef unsigned u32x2v __attribute__((ext_vector_type(2)));
        const PG8_LAS f32x2v* S = (const PG8_LAS f32x2v*)(lds + 8192);
        const int col0 = u.pn * BM + wc * 32 + 4 * fq;
#pragma unroll
        for (int bj = 0; bj < 2; ++bj)
#pragma unroll
            for (int n = 0; n < 2; ++n) { const f32x4 bv = bias ? *(const f32x4*)(bias + col0 + bj * HALF + n * 16) : (f32x4){0.f, 0.f, 0.f, 0.f};
#pragma unroll
                for (int ai = 0; ai < 2; ++ai)
#pragma unroll
                    for (int m = 0; m < 4; ++m) acc[ai][bj][m][n] += bv; }
        bool bad = st1.run(acc, u, wr, wc, fr, fq, lds, wid, lane) || poison != 0u;
        const float qnan = __builtin_nanf("");
#pragma unroll
        for (int ai = 0; ai < 2; ++ai)
#pragma unroll
            for (int m = 0; m < 4; ++m) { const int r = ai * HALF + wr * 64 + m * 16 + fr; const f32x2v sr = S[r]; const size_t off = (size_t)(u.pm * BM + r) * ldc + col0;
#pragma unroll
                for (int bj = 0; bj < 2; ++bj)
#pragma unroll
                    for (int n = 0; n < 2; ++n) { const f32x4 bs = *(const f32x4*)(base + off + bj * HALF + n * 16); acc[ai][bj][m][n] = bs + (acc[ai][bj][m][n] - sr.x) * sr.y; }
                asm volatile("" : "+v"(acc[ai][0][m][0]), "+v"(acc[ai][0][m][1]), "+v"(acc[ai][1][m][0]), "+v"(acc[ai][1][m][1]));
                if (m & 1) asm volatile("" ::: "memory"); }
        const bool bad1 = bad;
        bad = st2.run(acc, u, wr, wc, fr, fq, lds, wid, lane) || bad;
#pragma unroll
        for (int ai = 0; ai < 2; ++ai)
#pragma unroll
            for (int m = 0; m < 4; ++m) { const int r = ai * HALF + wr * 64 + m * 16 + fr; const f32x2v sr = S[r]; const size_t off = (size_t)(u.pm * BM + r) * ldc + col0;
#pragma unroll
                for (int bj = 0; bj < 2; ++bj)
#pragma unroll
                    for (int n = 0; n < 2; ++n) { const f32x4 x1 = acc[ai][bj][m][n]; *(f32x4*)(out + off + bj * HALF + n * 16) = bad1 ? (f32x4){qnan, qnan, qnan, qnan} : x1;
                        const f32x4 o = (x1 - sr.x) * sr.y; u32x2v w; w.x = cvt_pk_bf16(o[0], o[1]); w.y = cvt_pk_bf16(o[2], o[3]);
                        if (bad) { w.x = 0x7fc07fc0u; w.y = 0x7fc07fc0u; } *(u32x2v*)(xn + off + bj * HALF + n * 16) = w; }
                asm volatile("" ::: "memory"); }
    }
};

template <class Epi, class Sched, bool STAMP = false>
__device__ __forceinline__ void gemm_phase(PG8_LAS unsigned char* lds, const Gemm g, const Sched& S, const Epi& E, unsigned long long* stamps) {
    const int tid = threadIdx.x, wid = __builtin_amdgcn_readfirstlane(tid >> 6), lane = tid & 63, wr = wid >> 2, wc = wid & 3, fr = lane & 15, fq = lane >> 4;
    const int K = g.K, nt = K / BK;
    int ts_lo = 0, ts_hi = 0, nts = 0; const unsigned long long rt_entry = STAMP ? (unsigned long long)wall_clock64() : 0ull;
#define PG8_STAMP() do { if (STAMP && wid == 0 && nts < 64) { const unsigned long long _c = (unsigned long long)clock64(); \
        ts_lo = (lane == nts) ? (int)(unsigned)_c : ts_lo; ts_hi = (lane == nts) ? (int)(unsigned)(_c >> 32) : ts_hi; ++nts; } } while (0)
    PG8_STAMP();
    unsigned voffA[2], voffB[2];
#pragma unroll
    for (int i = 0; i < 2; ++i) { int R, C; stage_rc(tid * 16 + i * 8192, R, C); const int Rb = Epi::PERM ? ((R & ~31) + perm32(R & 31)) : R;
        voffA[i] = (unsigned)(R * K + C) * 2u; voffB[i] = (unsigned)(Rb * K + C) * 2u; }
    const size_t kstep = (size_t)(BK * 2);
    const size_t hstep = (size_t)HALF * K * 2;
    const size_t tstep = 2 * hstep;
    const unsigned ldsw = (unsigned)wid * 1024u;
    const int aoff = lds_byte(wr * 64 + fr, fq * 8), boff = lds_byte(wc * 32 + fr, fq * 8);
#define PG8_SA(b, h) (((b) * 2 + (h)) * HTB)
#define PG8_SB(b, h) ((4 + (b) * 2 + (h)) * HTB)
#define PG8_STAGE(bufoff, gbase, voff) do { _Pragma("unroll") for (int _i = 0; _i < 2; ++_i) \
        __builtin_amdgcn_global_load_lds((const unsigned*)((const char*)(gbase) + (voff)[_i]), (PG8_LAS unsigned*)(lds + (bufoff) + ldsw + _i * 8192), 16, 0, 0); } while (0)
#define PG8_LDA(dst, b, h) do { _Pragma("unroll") for (int m = 0; m < 4; ++m) _Pragma("unroll") for (int k = 0; k < 2; ++k) dst[m][k] = *(const PG8_LAS bf16x8*)(lds + PG8_SA(b, h) + aoff + m * 2048 + k * 1024); } while (0)
#define PG8_LDB(dst, b, h) do { _Pragma("unroll") for (int n = 0; n < 2; ++n) _Pragma("unroll") for (int k = 0; k < 2; ++k) dst[n][k] = *(const PG8_LAS bf16x8*)(lds + PG8_SB(b, h) + boff + n * 2048 + k * 1024); } while (0)
#define PG8_MMA(ai, bj, At, Bt) do { __builtin_amdgcn_s_setprio(1); _Pragma("unroll") for (int m = 0; m < 4; ++m) _Pragma("unroll") for (int n = 0; n < 2; ++n) _Pragma("unroll") for (int k = 0; k < 2; ++k) \
        acc[ai][bj][m][n] = __builtin_amdgcn_mfma_f32_16x16x32_bf16(Bt[n][k], At[m][k], acc[ai][bj][m][n], 0, 0, 0); __builtin_amdgcn_s_setprio(0); } while (0)
#define PG8_WAIT_V(n) asm volatile("s_waitcnt vmcnt(" #n ")" ::: "memory")
#define PG8_WAIT_L(n) asm volatile("s_waitcnt lgkmcnt(" #n ")" ::: "memory")
#define PG8_BAR __builtin_amdgcn_s_barrier()
#define PG8_SCHED __builtin_amdgcn_sched_barrier(0)
    Unit cur, nxt; int ui = 0;
    if (!S.next(0, cur)) return;
    f32x4 acc[2][2][4][2];
#pragma unroll
    for (int a = 0; a < 2; ++a)
#pragma unroll
        for (int b = 0; b < 2; ++b)
#pragma unroll
            for (int m = 0; m < 4; ++m)
#pragma unroll
                for (int n = 0; n < 2; ++n) acc[a][b][m][n] = (f32x4){0.f, 0.f, 0.f, 0.f};
    bf16x8 At[4][2], B0[2][2], B1[2][2];
    const char* cA = (const char*)g.A + (size_t)cur.pm * tstep; const char* cB = (const char*)g.Bt + (size_t)cur.pn * tstep;
    S.a_ready(cur);
    PG8_STAGE(PG8_SB(0, 0), cB, voffB); PG8_STAGE(PG8_SA(0, 0), cA, voffA); PG8_STAGE(PG8_SB(0, 1), cB + hstep, voffB); PG8_STAGE(PG8_SA(0, 1), cA + hstep, voffA);
    if (wr == 1) PG8_BAR;
    PG8_WAIT_V(4); PG8_BAR;
    PG8_STAGE(PG8_SB(1, 0), cB + kstep, voffB); PG8_STAGE(PG8_SA(1, 0), cA + kstep, voffA); PG8_STAGE(PG8_SB(1, 1), cB + hstep + kstep, voffB);
    PG8_WAIT_V(6); PG8_BAR;
    PG8_STAMP();
    for (;;) {
        const bool has_next = S.next(ui + 1, nxt);
        const char* nA = has_next ? (const char*)g.A + (size_t)nxt.pm * tstep : cA; const char* nB = has_next ? (const char*)g.Bt + (size_t)nxt.pn * tstep : cB;
        for (int t = 0; t < nt; t += 2) {
            const bool last = (t == nt - 2);
            const char* a1 = cA + (size_t)(t + 1) * kstep;
            const char* a2 = last ? nA : cA + (size_t)(t + 2) * kstep; const char* b2 = last ? nB : cB + (size_t)(t + 2) * kstep;
            const char* a3 = a2 + kstep; const char* b3 = b2 + kstep;
            if (last && has_next) S.a_ready(nxt);
            PG8_LDB(B0, 0, 0); PG8_SCHED; PG8_LDA(At, 0, 0); PG8_STAGE(PG8_SA(1, 1), a1 + hstep, voffA);
            PG8_WAIT_L(8); PG8_BAR; PG8_WAIT_L(0); PG8_MMA(0, 0, At, B0); PG8_BAR; PG8_SCHED;
            PG8_LDB(B1, 0, 1); PG8_STAGE(PG8_SB(0, 0), b2, voffB);
            PG8_BAR; PG8_WAIT_L(0); PG8_MMA(0, 1, At, B1); PG8_BAR;
            PG8_LDA(At, 0, 1); PG8_STAGE(PG8_SA(0, 0), a2, voffA);
            PG8_BAR; PG8_WAIT_L(0); PG8_MMA(1, 0, At, B0); PG8_BAR; PG8_SCHED;
            PG8_STAGE(PG8_SB(0, 1), b2 + hstep, voffB);
            PG8_WAIT_V(6); PG8_BAR; PG8_MMA(1, 1, At, B1); PG8_BAR;
            PG8_LDB(B0, 1, 0); PG8_SCHED; PG8_LDA(At, 1, 0); PG8_STAGE(PG8_SA(0, 1), a2 + hstep, voffA);
            PG8_WAIT_L(8); PG8_BAR; PG8_WAIT_L(0); PG8_MMA(0, 0, At, B0); PG8_BAR; PG8_SCHED;
            PG8_LDB(B1, 1, 1); PG8_STAGE(PG8_SB(1, 0), b3, voffB);
            PG8_BAR; PG8_WAIT_L(0); PG8_MMA(0, 1, At, B1); PG8_BAR;
            PG8_LDA(At, 1, 1); PG8_STAGE(PG8_SA(1, 0), a3, voffA);
            PG8_BAR; PG8_WAIT_L(0); PG8_MMA(1, 0, At, B0); PG8_BAR; PG8_SCHED;
            PG8_STAGE(PG8_SB(1, 1), b3 + hstep, voffB);
            PG8_WAIT_V(6); PG8_BAR; PG8_MMA(1, 1, At, B1); PG8_BAR;
        }
        PG8_STAMP();
        if constexpr (!Epi::AFTER_DRAIN) { E(acc, cur, wr, wc, fr, fq); S.done(cur); }
        PG8_STAMP();
        if (!has_next) break;
#pragma unroll
        for (int a = 0; a < 2; ++a)
#pragma unroll
            for (int b = 0; b < 2; ++b)
#pragma unroll
                for (int m = 0; m < 4; ++m)
#pragma unroll
                    for (int n = 0; n < 2; ++n) acc[a][b][m][n] = (f32x4){0.f, 0.f, 0.f, 0.f};
        cur = nxt; cA = nA; cB = nB; ++ui;
    }
    PG8_WAIT_V(0);
    if (wr == 0) PG8_BAR;
    PG8_BAR;
    if constexpr (Epi::AFTER_DRAIN) { E.fused(acc, cur, wr, wc, fr, fq, lds, wid, lane); S.done(cur); }
    PG8_STAMP();
    if (STAMP && wid == 0) { stamps[lane] = lane < nts ? (((unsigned long long)(unsigned)ts_hi << 32) | (unsigned)ts_lo) : 0ull;
        if (lane == 62) stamps[62] = rt_entry; if (lane == 63) stamps[63] = (unsigned long long)wall_clock64(); }
#undef PG8_STAMP
#undef PG8_SA
#undef PG8_SB
#undef PG8_STAGE
#undef PG8_LDA
#undef PG8_LDB
#undef PG8_MMA
#undef PG8_WAIT_V
#undef PG8_WAIT_L
#undef PG8_BAR
#undef PG8_SCHED
}
}

constexpr int D = 1024, NB = 16, S = 2048, T = NB * S;
constexpr int NCOL = 2840, NPAD = 3072;
constexpr int C_Q = 0, C_KC = 512, C_VC = 640, C_KS = 768, C_VS = 896, C_KW = 1024, C_VW = 1152, C_GT = 1280, C_CB = 1304, C_CC = 1816, C_CH = 2328;
constexpr int NCMP = 127;
constexpr int NEXP = 16384;
constexpr float EPS = 1e-6f;
constexpr int NTHREADS = 512, NWAVES = 8;

constexpr size_t al256(size_t x) { return (x + 255) & ~(size_t)255; }
constexpr size_t WS_CTL   = 0;                                   constexpr size_t CTL_BYTES = 65536;
constexpr size_t WS_MOD   = WS_CTL + CTL_BYTES;
constexpr size_t WS_WIN   = al256(WS_MOD + (size_t)16 * 6144 * 4);
constexpr size_t WS_WOUT  = al256(WS_WIN + (size_t)NPAD * D * 2);
constexpr size_t WS_WQ    = al256(WS_WOUT + (size_t)D * D * 2);
constexpr size_t WS_KEYS  = al256(WS_WQ + (size_t)D * D * 2);
constexpr size_t WS_U8S   = al256(WS_KEYS + (size_t)16 * 128 * 64 * 2);
constexpr size_t WS_V8S   = al256(WS_U8S + (size_t)NEXP * D);
constexpr size_t WS_X8S   = al256(WS_V8S + (size_t)NEXP * D);
constexpr size_t WS_SU    = al256(WS_X8S + (size_t)T * D);
constexpr size_t WS_SV    = al256(WS_SU + (size_t)NEXP * 4);
constexpr size_t WS_SX    = al256(WS_SV + (size_t)NEXP * 4);
constexpr size_t WS_W1T   = al256(WS_SX + (size_t)T * 4);
constexpr size_t WS_W2T   = al256(WS_W1T + (size_t)2 * 64 * 2048 * 2);
constexpr size_t WS_PEC   = al256(WS_W2T + (size_t)2 * 64 * 64 * 2);
constexpr size_t WS_KC    = al256(WS_PEC + (size_t)2 * 64 * 4);
constexpr size_t WS_VC    = al256(WS_KC + (size_t)16 * 2 * 128 * 64 * 2);
constexpr size_t WS_H     = al256(WS_VC + (size_t)16 * 2 * 128 * 64 * 2);
constexpr size_t WS_CS    = WS_H;
constexpr size_t WS_CSUM  = WS_H + (size_t)32 * 1024 * 1024;
constexpr size_t WS_SSQP  = WS_H + (size_t)33 * 1024 * 1024;
constexpr size_t WS_OATT  = al256(WS_H + (size_t)T * D * 2);
constexpr size_t WS_PROJ  = al256(WS_OATT + (size_t)T * 512 * 2);
constexpr size_t WS_QP    = WS_PROJ;
constexpr size_t WS_PART  = WS_PROJ;
constexpr size_t WS_X2    = WS_PROJ;
constexpr size_t WS_EIDX  = WS_PROJ + (size_t)160 * 1024 * 1024;
constexpr size_t WS_EW    = WS_EIDX + (size_t)T * 128 * 4;
constexpr size_t WS_END   = al256(WS_PROJ + (size_t)T * NPAD * 2);
static_assert(WS_EW + (size_t)T * 128 * 4 <= WS_END, "alias region");
static_assert((size_t)8 * T * 128 * 4 <= (size_t)160 * 1024 * 1024, "PART fits under EIDX");
constexpr int CTL_CTR_A = 16384, CTL_CTR_B = 16384 + 8 * 256;

constexpr int LDS_STAGE = 147456;
constexpr int LDS_MISC_OFF = LDS_STAGE;
constexpr int LDS_BYTES = LDS_STAGE + 256;

typedef unsigned short bf16_t;
typedef short bf16x8 __attribute__((ext_vector_type(8)));
typedef short s16x4 __attribute__((ext_vector_type(4)));
typedef float f32x4 __attribute__((ext_vector_type(4)));
typedef unsigned u32x4v __attribute__((ext_vector_type(4)));
__device__ __forceinline__ float bf2f(bf16_t b) { return __uint_as_float(((unsigned)b) << 16); }
__device__ __forceinline__ bf16_t f2bf(float f) { unsigned u = __float_as_uint(f); u += 0x7FFFu + ((u >> 16) & 1u); return (bf16_t)(u >> 16); }
__device__ __forceinline__ float bflo(unsigned w) { return __uint_as_float(w << 16); }
__device__ __forceinline__ float bfhi(unsigned w) { return __uint_as_float(w & 0xFFFF0000u); }
__device__ __forceinline__ unsigned pack2(float lo, float hi) { return (unsigned)f2bf(lo) | ((unsigned)f2bf(hi) << 16); }
__device__ __forceinline__ float gelu_tanh(float x) { const float u = 0.7978845608028654f * (x + 0.044715f * x * x * x); return 0.5f * x * (1.0f + tanhf(u)); }
__device__ __forceinline__ float sigmoidf_(float x) { return 1.0f / (1.0f + __expf(-x)); }
__device__ __forceinline__ float wave_sum(float v) {
#pragma unroll
    for (int o = 32; o >= 1; o >>= 1) v += __shfl_xor(v, o);
    return v; }
__device__ __forceinline__ float wave_max(float v) {
#pragma unroll
    for (int o = 32; o >= 1; o >>= 1) v = fmaxf(v, __shfl_xor(v, o));
    return v; }
__device__ __forceinline__ void lds_wave_sync() { asm volatile("s_waitcnt lgkmcnt(0)" ::: "memory"); }
__device__ __forceinline__ int rel_bucket(int dist) {
    const int n = dist > 0 ? dist : 0;
    if (n < 16) return n;
    const float lr = logf((float)n / 16.0f) / 2.0794415416798357f;
    const int large = 16 + (int)(lr * 16.0f);
    return large < 31 ? large : 31;
}

struct Frame {
    const float* in[23]; float* out; unsigned char* ws;
    LAS unsigned char* lds; int tid, lane, wave, G;
};


typedef int i32x4v __attribute__((ext_vector_type(4)));
constexpr int PEER_CHUNK_TOK = 128, PEER_NCHUNK = T / PEER_CHUNK_TOK;

__device__ __forceinline__ void quant_row_sliced(const float* row, unsigned char* dst8  , size_t nrows, size_t r, float* scale_out, int bias, int lane) {
    float4 v[4]; float am = 0.f;
#pragma unroll
    for (int i = 0; i < 4; ++i) { v[i] = *(const float4*)(row + (lane + 64 * i) * 4); am = fmaxf(am, fmaxf(fmaxf(fabsf(v[i].x), fabsf(v[i].y)), fmaxf(fabsf(v[i].z), fabsf(v[i].w)))); }
    am = wave_max(am); const float inv = am > 0.f ? 127.0f / am : 0.f;
    if (lane == 0) *scale_out = am > 0.f ? am / 127.0f : 0.f;
#pragma unroll
    for (int i = 0; i < 4; ++i) { const int col = (lane + 64 * i) * 4; const int sl = col >> 7, off = col & 127;
        const int q0 = (int)rintf(v[i].x * inv) + bias, q1 = (int)rintf(v[i].y * inv) + bias, q2 = (int)rintf(v[i].z * inv) + bias, q3 = (int)rintf(v[i].w * inv) + bias;
        *(unsigned*)(dst8 + ((size_t)sl * nrows + r) * 128 + off) = (unsigned)(q0 & 0xFF) | ((unsigned)(q1 & 0xFF) << 8) | ((unsigned)(q2 & 0xFF) << 16) | ((unsigned)(q3 & 0xFF) << 24); }
}

__device__ __forceinline__ int grab_chunk(const Frame& F, unsigned* ctr, int slice) {
    LAS int* bc = (LAS int*)(F.lds + LDS_MISC_OFF + 64);
    __syncthreads();
    if (F.tid == 0) *bc = (int)__hip_atomic_fetch_add(ctr + slice * 64, 1u, __ATOMIC_RELAXED, __HIP_MEMORY_SCOPE_AGENT);
    __syncthreads();
    return *bc;
}

__device__ __forceinline__ void stage_chunk_lists(const Frame& F, const int* eidx_chunk, const float* cs_chunk) {
#pragma unroll
    for (int i = 0; i < 8; ++i) { const int q = F.tid + 512 * i; *(LAS i32x4v*)(F.lds + q * 16) = *(const i32x4v*)(eidx_chunk + q * 4);
        if (cs_chunk) *(LAS f32x4*)(F.lds + 65536 + q * 16) = *(const f32x4*)(cs_chunk + q * 4); }
    __syncthreads();
}
__device__ __forceinline__ void gather_rows16(u32x4v (&vv)[16], const unsigned char* base, const LAS int* le) {
    i32x4v ev[4];
#pragma unroll
    for (int q = 0; q < 4; ++q) ev[q] = *(const LAS i32x4v*)(le + 4 * q);
#pragma unroll
    for (int ld = 0; ld < 16; ++ld) vv[ld] = *(const u32x4v*)(base + (size_t)ev[ld >> 2][ld & 3] * 128);
}
__device__ __forceinline__ void udot_item(const u32x4v (&uv)[16], const i32x4v xq, int* part_row  , int c) {
    i32x4v res[4];
#pragma unroll
    for (int ld = 0; ld < 16; ++ld) { int p = __builtin_amdgcn_sdot4((int)uv[ld][0], xq[0], 0, false); p = __builtin_amdgcn_sdot4((int)uv[ld][1], xq[1], p, false);
        p = __builtin_amdgcn_sdot4((int)uv[ld][2], xq[2], p, false); p = __builtin_amdgcn_sdot4((int)uv[ld][3], xq[3], p, false);
        p += __shfl_xor(p, 1); p += __shfl_xor(p, 2); p += __shfl_xor(p, 4); res[ld >> 2][ld & 3] = p; }
    if (c == 0) {
#pragma unroll
        for (int q = 0; q < 4; ++q) *(i32x4v*)(part_row + 4 * q) = res[q]; }
}
__device__ __forceinline__ void p10a_udots(const Frame& F) {
    const unsigned char* U8S = F.ws + WS_U8S; const unsigned char* X8S = F.ws + WS_X8S; const int* EIDX = (const int*)(F.ws + WS_EIDX); int* PART = (int*)(F.ws + WS_PART);
    unsigned* ctr = (unsigned*)(F.ws + WS_CTL + CTL_CTR_A);
    const int lane = F.lane, j = lane >> 3, c = lane & 7; const int xcc = (int)(xb_xcc_id() & 7u);
    for (int so = 0; so < 8; ++so) { const int x = (xcc + so) & 7;
        for (;;) { const int chunk = grab_chunk(F, ctr, x); if (chunk >= PEER_NCHUNK) break;
            stage_chunk_lists(F, EIDX + (size_t)chunk * PEER_CHUNK_TOK * 128, nullptr);
            const unsigned char* ub = U8S + (size_t)x * NEXP * 128 + c * 16;
            const int tl0 = F.wave * 16; const int t0 = chunk * PEER_CHUNK_TOK + tl0;
            const LAS int* le = (const LAS int*)F.lds + tl0 * 128 + 16 * j;
            const unsigned char* xb = X8S + ((size_t)x * T + t0) * 128 + c * 16; int* pr = PART + ((size_t)x * T + t0) * 128 + 16 * j;
            u32x4v va[16], vb[16];
            gather_rows16(va, ub, le);
#pragma unroll 1
            for (int tt = 0; tt < 16; tt += 2) {
                const i32x4v xqa = *(const i32x4v*)(xb + (size_t)tt * 128), xqb = *(const i32x4v*)(xb + (size_t)(tt + 1) * 128);
                gather_rows16(vb, ub, le + (tt + 1) * 128);
                udot_item(va, xqa, pr + (size_t)tt * 128, c);
                if (tt + 2 < 16) gather_rows16(va, ub, le + (tt + 2) * 128);
                udot_item(vb, xqb, pr + (size_t)(tt + 1) * 128, c);
            }
        }
    }
}

__device__ __forceinline__ void p10b_coef(const Frame& F) {
    const int* EIDX = (const int*)(F.ws + WS_EIDX); const float* EW = (const float*)(F.ws + WS_EW); const int* PART = (const int*)(F.ws + WS_PART);
    const float* SU = (const float*)(F.ws + WS_SU); const float* SV = (const float*)(F.ws + WS_SV); const float* SX = (const float*)(F.ws + WS_SX);
    float* CS = (float*)(F.ws + WS_CS); float* CSUM = (float*)(F.ws + WS_CSUM);
    const int gw = blockIdx.x * NWAVES + F.wave, nw = F.G * NWAVES, lane = F.lane;
    for (int t = gw; t < T; t += nw) { const float sx = SX[t]; float tot = 0.f;
#pragma unroll
        for (int hh = 0; hh < 2; ++hh) { const int i = lane + 64 * hh; int s = 0;
#pragma unroll
            for (int x = 0; x < 8; ++x) s += PART[((size_t)x * T + t) * 128 + i];
            const int e = EIDX[(size_t)t * 128 + i]; const float dot = (float)s * sx * SU[e];
            const float cs = EW[(size_t)t * 128 + i] * gelu_tanh(dot) * SV[e]; CS[(size_t)t * 128 + i] = cs; tot += cs; }
        tot = wave_sum(tot); if (lane == 0) CSUM[t] = tot; }
}

struct VsumPre { float2 x1, gt; float off; };
__device__ __forceinline__ void vsum_item(const u32x4v (&vv)[16], const LAS float* lc  , const VsumPre& pre, float* x2p, float* ssqp, int lane) {
    f32x4 cv[4];
#pragma unroll
    for (int q = 0; q < 4; ++q) cv[q] = *(const LAS f32x4*)(lc + 4 * q);
    float acc[16];
#pragma unroll
    for (int k = 0; k < 16; ++k) acc[k] = 0.f;
#pragma unroll
    for (int ld = 0; ld < 16; ++ld) { const float cf = cv[ld >> 2][ld & 3];
#pragma unroll
        for (int w = 0; w < 4; ++w) { const unsigned u = vv[ld][w];
            acc[4 * w + 0] += cf * (float)(u & 0xFFu); acc[4 * w + 1] += cf * (float)((u >> 8) & 0xFFu); acc[4 * w + 2] += cf * (float)((u >> 16) & 0xFFu); acc[4 * w + 3] += cf * (float)(u >> 24); } }
    float a8[8], a4[4], a2[2];
    { const bool hi = (lane & 32) != 0;
#pragma unroll
        for (int k = 0; k < 8; ++k) { const float snd = hi ? acc[k] : acc[k + 8]; const float rcv = __shfl_xor(snd, 32); a8[k] = (hi ? acc[k + 8] : acc[k]) + rcv; } }
    { const bool hi = (lane & 16) != 0;
#pragma unroll
        for (int k = 0; k < 4; ++k) { const float snd = hi ? a8[k] : a8[k + 4]; const float rcv = __shfl_xor(snd, 16); a4[k] = (hi ? a8[k + 4] : a8[k]) + rcv; } }
    { const bool hi = (lane & 8) != 0;
#pragma unroll
        for (int k = 0; k < 2; ++k) { const float snd = hi ? a4[k] : a4[k + 2]; const float rcv = __shfl_xor(snd, 8); a2[k] = (hi ? a4[k + 2] : a4[k]) + rcv; } }
    const float y0 = pre.x1.x + pre.gt.x * (a2[0] - pre.off), y1 = pre.x1.y + pre.gt.y * (a2[1] - pre.off);
    *(float2*)x2p = make_float2(y0, y1);
    const float ss = wave_sum(y0 * y0 + y1 * y1); if (lane == 0) *ssqp = ss;
}
__device__ __forceinline__ void p10c_vsum(const Frame& F) {
    const unsigned char* V8S = F.ws + WS_V8S; const int* EIDX = (const int*)(F.ws + WS_EIDX); const float* CS = (const float*)(F.ws + WS_CS); const float* CSUM = (const float*)(F.ws + WS_CSUM);
    const float* MOD = (const float*)(F.ws + WS_MOD); float* SSQP = (float*)(F.ws + WS_SSQP); const float* x1 = F.out; float* X2 = (float*)(F.ws + WS_X2);
    unsigned* ctr = (unsigned*)(F.ws + WS_CTL + CTL_CTR_B);
    const int lane = F.lane, j = lane >> 3, c = lane & 7; const int xcc = (int)(xb_xcc_id() & 7u);
    const int ocol = 16 * c + 8 * ((lane >> 5) & 1) + 4 * ((lane >> 4) & 1) + 2 * ((lane >> 3) & 1);
    for (int so = 0; so < 8; ++so) { const int x = (xcc + so) & 7;
        for (;;) { const int chunk = grab_chunk(F, ctr, x); if (chunk >= PEER_NCHUNK) break;
            stage_chunk_lists(F, EIDX + (size_t)chunk * PEER_CHUNK_TOK * 128, CS + (size_t)chunk * PEER_CHUNK_TOK * 128);
            const unsigned char* vb = V8S + (size_t)x * NEXP * 128 + c * 16;
            const int tl0 = F.wave * 16; const int t0 = chunk * PEER_CHUNK_TOK + tl0; const int b = t0 / S;
            const LAS int* le = (const LAS int*)F.lds + tl0 * 128 + 16 * j; const LAS float* lc = (const LAS float*)(F.lds + 65536) + tl0 * 128 + 16 * j;
            const int col = x * 128 + ocol; const float2 gt = *(const float2*)(MOD + b * 6144 + 5120 + col);
            u32x4v va[16], vbb[16];
            gather_rows16(va, vb, le);
#pragma unroll 1
            for (int tt = 0; tt < 16; tt += 2) {
                { VsumPre pa; pa.gt = gt; pa.x1 = *(const float2*)(x1 + (size_t)(t0 + tt) * D + col); pa.off = 128.0f * CSUM[t0 + tt];
                  gather_rows16(vbb, vb, le + (tt + 1) * 128);
                  vsum_item(va, lc + tt * 128, pa, X2 + (size_t)(t0 + tt) * D + col, SSQP + (size_t)(t0 + tt) * 8 + x, lane); }
                { VsumPre pb; pb.gt = gt; pb.x1 = *(const float2*)(x1 + (size_t)(t0 + tt + 1) * D + col); pb.off = 128.0f * CSUM[t0 + tt + 1];
                  if (tt + 2 < 16) gather_rows16(va, vb, le + (tt + 2) * 128);
                  vsum_item(vbb, lc + (tt + 1) * 128, pb, X2 + (size_t)(t0 + tt + 1) * D + col, SSQP + (size_t)(t0 + tt + 1) * 8 + x, lane); }
            }
        }
    }
}

__device__ __forceinline__ void p10d_final(const Frame& F) {
    const float* SSQP = (const float*)(F.ws + WS_SSQP); const float* gfin = F.in[22]; float* out = F.out; const float* X2 = (const float*)(F.ws + WS_X2);
    const int gw = blockIdx.x * NWAVES + F.wave, nw = F.G * NWAVES, lane = F.lane;
    for (int t = gw; t < T; t += nw) {
        float ss = 0.f;
#pragma unroll
        for (int x = 0; x < 8; ++x) ss += SSQP[(size_t)t * 8 + x];
        const float rstd = rsqrtf(ss * (1.0f / D) + EPS);
#pragma unroll
        for (int i = 0; i < 4; ++i) { const int col = (lane + 64 * i) * 4; const float4 v = *(const float4*)(X2 + (size_t)t * D + col), gg = *(const float4*)(gfin + col);
            *(float4*)(out + (size_t)t * D + col) = make_float4(v.x * rstd * gg.x, v.y * rstd * gg.y, v.z * rstd * gg.z, v.w * rstd * gg.w); }
    }
}

__device__ __forceinline__ void transpose_tile(const Frame& F, const float* src, int srcK, int srcN, bf16_t* dst, int dstK, int kt, int nt) {
    LAS float* tile = (LAS float*)F.lds;
    const int k0 = kt * 64, n0 = nt * 64;
    for (int i = F.tid; i < 4096; i += NTHREADS) { const int r = i >> 6, c = i & 63; const int k = k0 + r, n = n0 + c;
        tile[r * 65 + c] = (k < srcK && n < srcN) ? src[(size_t)k * srcN + n] : 0.0f; }
    __syncthreads();
    for (int i = F.tid; i < 4096; i += NTHREADS) { const int r = i >> 6, c = i & 63;
        dst[(size_t)(n0 + r) * dstK + k0 + c] = f2bf(tile[c * 65 + r]); }
    __syncthreads();
}
__device__ __forceinline__ void p0_prologue(const Frame& F) {
    const float* c = F.in[1]; const float* w_mod = F.in[4]; const float* b_mod = F.in[5];
    float* MOD = (float*)(F.ws + WS_MOD);
    constexpr int I_MOD = 96, I_WIN = 16 * 48, I_WOUT = 256, I_WQ = 256, I_U = 256, I_V = 256, I_KEYS = 2, I_CMP = 32 + 32 + 1 + 1 + 2;
    constexpr int O_WIN = I_MOD, O_WOUT = O_WIN + I_WIN, O_WQ = O_WOUT + I_WOUT, O_U = O_WQ + I_WQ, O_V = O_U + I_U, O_KEYS = O_V + I_V, O_CMP = O_KEYS + I_KEYS, N_ITEMS = O_CMP + I_CMP;
    for (int it = blockIdx.x; it < N_ITEMS; it += F.G) {
        if (it < O_WIN) {
            LAS float* sl = (LAS float*)F.lds; LAS float* red = (LAS float*)(F.lds + 65536);
            for (int q = F.tid; q < 16 * D; q += NTHREADS) { const float cv = c[q]; sl[q] = cv / (1.0f + __expf(-cv)); }
            __syncthreads();
            const int kg = F.tid >> 6, cl = F.tid & 63, j0 = it * 64;
            float acc[16];
#pragma unroll
            for (int bb = 0; bb < 16; ++bb) acc[bb] = 0.f;
            const float* wp = w_mod + (size_t)(kg * 128) * 6144 + j0 + cl;
#pragma unroll 4
            for (int kk = 0; kk < 128; ++kk) { const float w = wp[(size_t)kk * 6144]; const int k = kg * 128 + kk;
#pragma unroll
                for (int bb = 0; bb < 16; ++bb) acc[bb] += sl[bb * D + k] * w; }
#pragma unroll
            for (int bb = 0; bb < 16; ++bb) red[(kg * 16 + bb) * 64 + cl] = acc[bb];
            __syncthreads();
#pragma unroll
            for (int q = 0; q < 2; ++q) { const int o = F.tid + 512 * q; const int bb = o >> 6, cc = o & 63; float s = b_mod[j0 + cc];
#pragma unroll
                for (int g8 = 0; g8 < 8; ++g8) s += red[(g8 * 16 + bb) * 64 + cc];
                MOD[bb * 6144 + j0 + cc] = s; }
            __syncthreads();
        } else if (it < O_WOUT) { const int i = it - O_WIN; transpose_tile(F, F.in[6], D, NCOL, (bf16_t*)(F.ws + WS_WIN), D, i % 16, i / 16); }
        else if (it < O_WQ) { const int i = it - O_WOUT; transpose_tile(F, F.in[16], D, D, (bf16_t*)(F.ws + WS_WOUT), D, i % 16, i / 16); }
        else if (it < O_U) { const int i = it - O_WQ; transpose_tile(F, F.in[17], D, D, (bf16_t*)(F.ws + WS_WQ), D, i % 16, i / 16); }
        else if (it < O_KEYS) {
            const bool isv = it >= O_V; const int i = isv ? it - O_V : it - O_U;
            for (int rr = 0; rr < 8; ++rr) { const size_t r = (size_t)i * 64 + rr * 8 + F.wave;
                quant_row_sliced((isv ? F.in[20] : F.in[19]) + r * D, F.ws + (isv ? WS_V8S : WS_U8S), NEXP, r, (float*)(F.ws + (isv ? WS_SV : WS_SU)) + r, isv ? 128 : 0, F.lane); }
        } else if (it >= O_CMP) {
            const int i = it - O_CMP;
            if (i < 64) { const int kv = i >> 5; transpose_tile(F, kv ? F.in[11] : F.in[9], 2048, 64, (bf16_t*)(F.ws + WS_W1T) + (size_t)kv * 64 * 2048, 2048, i & 31, 0); }
            else if (i < 66) { const int kv = i - 64; transpose_tile(F, kv ? F.in[12] : F.in[10], 64, 64, (bf16_t*)(F.ws + WS_W2T) + (size_t)kv * 64 * 64, 64, 0, 0); }
            else { const int kv = i - 66; const float* pe = kv ? F.in[8] : F.in[7]; const float* w1 = kv ? F.in[11] : F.in[9];
                if (F.tid < 64) { float a = 0.f; for (int k = 0; k < 2048; ++k) a += pe[k] * w1[(size_t)k * 64 + F.tid]; ((float*)(F.ws + WS_PEC))[kv * 64 + F.tid] = a; } }
        } else {
            const int i = it - O_KEYS; const float4* src = (const float4*)F.in[18] + (size_t)i * 16384; uint2* dst = (uint2*)(F.ws + WS_KEYS) + (size_t)i * 16384;
            for (int q = F.tid; q < 16384; q += NTHREADS) { const float4 v = src[q]; dst[q] = make_uint2(pack2(v.x, v.y), pack2(v.z, v.w)); }
        }
    }
}

__device__ __forceinline__ void norm_mod_rows(const Frame& F, const float* x, const float* g, int sh_off, int sc_off, bf16_t* dst) {
    const float* MOD = (const float*)(F.ws + WS_MOD);
    const int gw = blockIdx.x * NWAVES + F.wave, nw = F.G * NWAVES;
    for (int t = gw; t < T; t += nw) {
        const int b = t / S; const float4* xr = (const float4*)(x + (size_t)t * D);
        float4 v[4]; float ss = 0.f;
#pragma unroll
        for (int i = 0; i < 4; ++i) { v[i] = xr[F.lane + 64 * i]; ss += v[i].x * v[i].x + v[i].y * v[i].y + v[i].z * v[i].z + v[i].w * v[i].w; }
        ss = wave_sum(ss); const float rstd = rsqrtf(ss * (1.0f / D) + EPS);
#pragma unroll
        for (int i = 0; i < 4; ++i) { const int col = (F.lane + 64 * i) * 4;
            const float4 gg = *(const float4*)(g + col), sc = *(const float4*)(MOD + b * 6144 + sc_off + col), sh = *(const float4*)(MOD + b * 6144 + sh_off + col);
            const float o0 = v[i].x * rstd * gg.x * (1.f + sc.x) + sh.x, o1 = v[i].y * rstd * gg.y * (1.f + sc.y) + sh.y, o2 = v[i].z * rstd * gg.z * (1.f + sc.z) + sh.z, o3 = v[i].w * rstd * gg.w * (1.f + sc.w) + sh.w;
            *(uint2*)(dst + (size_t)t * D + col) = make_uint2(pack2(o0, o1), pack2(o2, o3)); }
    }
}

__device__ __forceinline__ void norm_mod_rows_q(const Frame& F, const float* x, const float* g, int sh_off, int sc_off, bf16_t* dst) {
    const float* MOD = (const float*)(F.ws + WS_MOD);
    const int gw = blockIdx.x * NWAVES + F.wave, nw = F.G * NWAVES;
    for (int t = gw; t < T; t += nw) {
        const int b = t / S; const float4* xr = (const float4*)(x + (size_t)t * D);
        float4 v[4]; float ss = 0.f;
#pragma unroll
        for (int i = 0; i < 4; ++i) { v[i] = xr[F.lane + 64 * i]; ss += v[i].x * v[i].x + v[i].y * v[i].y + v[i].z * v[i].z + v[i].w * v[i].w; }
        ss = wave_sum(ss); const float rstd = rsqrtf(ss * (1.0f / D) + EPS);
        float am = 0.f;
#pragma unroll
        for (int i = 0; i < 4; ++i) { const int col = (F.lane + 64 * i) * 4;
            const float4 gg = *(const float4*)(g + col), sc = *(const float4*)(MOD + b * 6144 + sc_off + col), sh = *(const float4*)(MOD + b * 6144 + sh_off + col);
            v[i].x = v[i].x * rstd * gg.x * (1.f + sc.x) + sh.x; v[i].y = v[i].y * rstd * gg.y * (1.f + sc.y) + sh.y; v[i].z = v[i].z * rstd * gg.z * (1.f + sc.z) + sh.z; v[i].w = v[i].w * rstd * gg.w * (1.f + sc.w) + sh.w;
            *(uint2*)(dst + (size_t)t * D + col) = make_uint2(pack2(v[i].x, v[i].y), pack2(v[i].z, v[i].w));
            am = fmaxf(am, fmaxf(fmaxf(fabsf(v[i].x), fabsf(v[i].y)), fmaxf(fabsf(v[i].z), fabsf(v[i].w)))); }
        am = wave_max(am); const float inv = am > 0.f ? 127.0f / am : 0.f;
        if (F.lane == 0) ((float*)(F.ws + WS_SX))[t] = am > 0.f ? am / 127.0f : 0.f;
#pragma unroll
        for (int i = 0; i < 4; ++i) { const int col = (F.lane + 64 * i) * 4; const int sl = col >> 7, off = col & 127;
            const int q0 = (int)rintf(v[i].x * inv), q1 = (int)rintf(v[i].y * inv), q2 = (int)rintf(v[i].z * inv), q3 = (int)rintf(v[i].w * inv);
            *(unsigned*)(F.ws + WS_X8S + ((size_t)sl * T + t) * 128 + off) = (unsigned)(q0 & 0xFF) | ((unsigned)(q1 & 0xFF) << 8) | ((unsigned)(q2 & 0xFF) << 16) | ((unsigned)(q3 & 0xFF) << 24); }
    }
}

__device__ __forceinline__ void p3_compress_naive(const Frame& F) {
    const bf16_t* PROJ = (const bf16_t*)(F.ws + WS_PROJ);
    LAS float* hid = (LAS float*)F.lds + F.wave * 64;
    const int gw = blockIdx.x * NWAVES + F.wave, nw = F.G * NWAVES;
    if (gw < 64) { bf16_t* dz = (bf16_t*)(F.ws + ((gw & 1) ? WS_VC : WS_KC)); dz[((size_t)(gw >> 1) * 128 + 127) * 64 + F.lane] = 0; }
    for (int u = gw; u < NB * NCMP * 2 * 2; u += nw) {
        const int kv = u & 1, g = (u >> 1) & 1, n = (u >> 2) % NCMP, b = (u >> 2) / NCMP;
        const float* pe = kv ? F.in[8] : F.in[7]; const float* w1 = kv ? F.in[11] : F.in[9]; const float* w2 = kv ? F.in[12] : F.in[10];
        const int cbase = (kv ? C_VC : C_KC) + g * 64;
        float acc = 0.f;
        for (int l = 0; l < 32; ++l) {
            const bf16_t* row = PROJ + (size_t)(b * S + 16 * n + l) * NPAD + cbase;
            for (int d = 0; d < 64; ++d) { const float a = bf2f(row[d]) + pe[l * 64 + d]; acc += a * w1[(size_t)(l * 64 + d) * 64 + F.lane]; }
        }
        hid[F.lane] = gelu_tanh(acc); lds_wave_sync();
        float o = 0.f;
        for (int j = 0; j < 64; ++j) o += hid[j] * w2[j * 64 + F.lane];
        bf16_t* dst = (bf16_t*)(F.ws + (kv ? WS_VC : WS_KC)); dst[((size_t)(b * 2 + g) * 128 + n) * 64 + F.lane] = f2bf(o);
        lds_wave_sync();
    }
}


__device__ __forceinline__ void p3_compress_mfma(const Frame& F) {
    const bf16_t* PROJ = (const bf16_t*)(F.ws + WS_PROJ);
    const int lane = F.lane, tid = F.tid, wave = F.wave, grp = lane >> 4, col = lane & 15;
    LAS float* red = (LAS float*)F.lds;
    LAS bf16_t* hid = (LAS bf16_t*)(F.lds + 32768);
    if (blockIdx.x * NWAVES + wave < 64) { const int gw = blockIdx.x * NWAVES + wave; bf16_t* dz = (bf16_t*)(F.ws + ((gw & 1) ? WS_VC : WS_KC)); dz[((size_t)(gw >> 1) * 128 + 127) * 64 + lane] = 0; }
    for (int u = blockIdx.x; u < NB * 2 * 2 * 8; u += F.G) {
        const int nt8 = u & 7, kv = (u >> 3) & 1, g = (u >> 4) & 1, b = u >> 5; const int n0 = nt8 * 16;
        const bf16_t* W1T = (const bf16_t*)(F.ws + WS_W1T) + (size_t)kv * 64 * 2048; const bf16_t* W2T = (const bf16_t*)(F.ws + WS_W2T) + (size_t)kv * 64 * 64;
        const float* pec = (const float*)(F.ws + WS_PEC) + kv * 64;
        const int cbase = (kv ? C_VC : C_KC) + g * 64;
        const int nrow = (n0 + col) < NCMP ? (n0 + col) : (NCMP - 1);
        f32x4 acc[4];
#pragma unroll
        for (int nt = 0; nt < 4; ++nt) acc[nt] = (f32x4){0.f, 0.f, 0.f, 0.f};
#pragma unroll
        for (int ks = 0; ks < 8; ++ks) { const int l = 4 * wave + (ks >> 1), d0 = (ks & 1) * 32 + 8 * grp;
            const bf16x8 af = *(const bf16x8*)(PROJ + (size_t)(b * S + 16 * nrow + l) * NPAD + cbase + d0);
#pragma unroll
            for (int nt = 0; nt < 4; ++nt) { const bf16x8 bfr = *(const bf16x8*)(W1T + (size_t)(nt * 16 + col) * 2048 + l * 64 + d0);
                acc[nt] = __builtin_amdgcn_mfma_f32_16x16x32_bf16(af, bfr, acc[nt], 0, 0, 0); } }
#pragma unroll
        for (int nt = 0; nt < 4; ++nt)
#pragma unroll
            for (int rg = 0; rg < 4; ++rg) red[(wave * 16 + 4 * grp + rg) * 64 + nt * 16 + col] = acc[nt][rg];
        __syncthreads();
#pragma unroll
        for (int q = 0; q < 2; ++q) { const int idx = tid + 512 * q; float s = pec[idx & 63];
#pragma unroll
            for (int w = 0; w < 8; ++w) s += red[w * 1024 + idx];
            hid[idx] = f2bf(gelu_tanh(s)); }
        __syncthreads();
        if (wave < 4) { f32x4 o = (f32x4){0.f, 0.f, 0.f, 0.f};
#pragma unroll
            for (int ks = 0; ks < 2; ++ks) { const bf16x8 af = *(const LAS bf16x8*)(hid + col * 64 + ks * 32 + 8 * grp); const bf16x8 bfr = *(const bf16x8*)(W2T + (size_t)(wave * 16 + col) * 64 + ks * 32 + 8 * grp);
                o = __builtin_amdgcn_mfma_f32_16x16x32_bf16(af, bfr, o, 0, 0, 0); }
            bf16_t* dst = (bf16_t*)(F.ws + (kv ? WS_VC : WS_KC));
#pragma unroll
            for (int rg = 0; rg < 4; ++rg) { const int n = n0 + 4 * grp + rg; if (n < NCMP) dst[((size_t)(b * 2 + g) * 128 + n) * 64 + wave * 16 + col] = f2bf(o[rg]); } }
        __syncthreads();
    }
}

__device__ __forceinline__ void dot4_row(const bf16_t* krow, const LAS float* qs, float (&acc)[4]) {
    const uint4* kr = (const uint4*)krow;
#pragma unroll 1
    for (int c = 0; c < 8; ++c) { asm volatile("" ::: "memory"); const uint4 w = kr[c]; const unsigned ww[4] = {w.x, w.y, w.z, w.w};
#pragma unroll
        for (int e = 0; e < 4; ++e) { const float k0 = bflo(ww[e]), k1 = bfhi(ww[e]); const int d = c * 8 + e * 2;
#pragma unroll
            for (int r = 0; r < 4; ++r) acc[r] += qs[r * 64 + d] * k0 + qs[r * 64 + d + 1] * k1; } }
}
__device__ __forceinline__ void p4_attn_naive(const Frame& F) {
    const bf16_t* PROJ = (const bf16_t*)(F.ws + WS_PROJ); const bf16_t* KC = (const bf16_t*)(F.ws + WS_KC); const bf16_t* VC = (const bf16_t*)(F.ws + WS_VC);
    bf16_t* OATT = (bf16_t*)(F.ws + WS_OATT); const float* rel = F.in[21];
    LAS float* wl = (LAS float*)F.lds + F.wave * (256 + 512 + 2048 + 16);
    LAS float* qs = wl; LAS float* pc = wl + 256; LAS float* ps = wl + 768; LAS int* pbase = (LAS int*)(wl + 768 + 2048);
    const int gw = blockIdx.x * NWAVES + F.wave, nw = F.G * NWAVES, lane = F.lane;
    for (int u = gw; u < T * 2; u += nw) {
        const int g = u & 1, tok = u >> 1, b = tok / S, t = tok % S;
        const bf16_t* prow = PROJ + (size_t)tok * NPAD;
#pragma unroll
        for (int r = 0; r < 4; ++r) qs[r * 64 + lane] = bf2f(prow[C_Q + (g * 4 + r) * 64 + lane]) * 0.125f;
        lds_wave_sync();
        const int nv = t >= 31 ? ((t - 31) >> 4) + 1 : 0;
        float sc[2][4]; bool va[2];
#pragma unroll
        for (int i = 0; i < 2; ++i) { const int n = lane + 64 * i; va[i] = n < nv; float a[4] = {0.f, 0.f, 0.f, 0.f};
            if (va[i]) { dot4_row(KC + ((size_t)(b * 2 + g) * 128 + n) * 64, qs, a); const int bk = rel_bucket(t - (16 * n + 31));
#pragma unroll
                for (int r = 0; r < 4; ++r) a[r] += rel[bk * 8 + g * 4 + r]; }
#pragma unroll
            for (int r = 0; r < 4; ++r) sc[i][r] = va[i] ? a[r] : -1e30f; }
        float ocmp[4];
#pragma unroll
        for (int r = 0; r < 4; ++r) { const float m = wave_max(fmaxf(sc[0][r], sc[1][r]));
            const float e0 = va[0] ? __expf(sc[0][r] - m) : 0.f, e1 = va[1] ? __expf(sc[1][r] - m) : 0.f; const float sum = wave_sum(e0 + e1);
            const float inv = nv > 0 ? 1.0f / sum : 0.f; pc[r * 128 + lane] = e0 * inv; pc[r * 128 + 64 + lane] = e1 * inv; }
        lds_wave_sync();
        { float o[4] = {0.f, 0.f, 0.f, 0.f}; const bf16_t* vb = VC + ((size_t)(b * 2 + g) * 128) * 64 + lane;
            for (int n = 0; n < nv; ++n) { const float v = bf2f(vb[n * 64]);
#pragma unroll
                for (int r = 0; r < 4; ++r) o[r] += pc[r * 128 + n] * v; }
#pragma unroll
            for (int r = 0; r < 4; ++r) ocmp[r] = o[r]; }
        const int cur = t >> 6; float val;
        { const int j = lane & 31; float imp = 0.f;
#pragma unroll
            for (int r = 0; r < 4; ++r) for (int n = 4 * j - 1; n <= 4 * j + 3; ++n) if (n >= 0 && n < NCMP) imp += pc[r * 128 + n];
            const bool forced = (j == 0) || (j == cur) || (j == cur - 1); const bool allowed = j <= cur;
            val = forced ? 1e4f : (allowed ? imp : -INFINITY); }
        int rank = 0;
        for (int jp = 0; jp < 32; ++jp) { const float vp = __shfl(val, jp); rank += ((vp > val) || (vp == val && jp < (lane & 31))) ? 1 : 0; }
        unsigned selmask = (unsigned)(__ballot(lane < 32 && rank < 8) & 0xFFFFFFFFull);
        float oslc[4], owin[4];
#pragma unroll
        for (int br = 0; br < 2; ++br) {
            const int ck = br == 0 ? C_KS : C_KW, cv = br == 0 ? C_VS : C_VW;
            unsigned mk = selmask;
#pragma unroll 1
            for (int c = 0; c < 8; ++c) {
                int kpos, bs;
                if (br == 0) { const int j = __builtin_ctz(mk | 0x80000000u); mk &= mk - 1; bs = 64 * j; } else { bs = t - 511 + 64 * c; }
                kpos = bs + lane; if (lane == 0) pbase[c] = bs;
                const int dist = t - kpos; const bool vv = (dist >= 0) && (kpos >= 0) && (kpos < S);
                float a[4] = {0.f, 0.f, 0.f, 0.f};
                if (vv) { dot4_row(PROJ + (size_t)(b * S + kpos) * NPAD + ck + g * 64, qs, a); const int bk = rel_bucket(dist);
#pragma unroll
                    for (int r = 0; r < 4; ++r) a[r] += rel[bk * 8 + g * 4 + r]; }
#pragma unroll
                for (int r = 0; r < 4; ++r) ps[r * 512 + c * 64 + lane] = vv ? a[r] : -1e30f;
            }
            lds_wave_sync();
#pragma unroll 1
            for (int r = 0; r < 4; ++r) { float m = -1e30f;
#pragma unroll
                for (int c = 0; c < 8; ++c) m = fmaxf(m, ps[r * 512 + c * 64 + lane]);
                m = wave_max(m); float e[8], sum = 0.f;
#pragma unroll
                for (int c = 0; c < 8; ++c) { const float sv = ps[r * 512 + c * 64 + lane]; e[c] = sv > -1e29f ? __expf(sv - m) : 0.f; sum += e[c]; }
                sum = wave_sum(sum); const float inv = sum > 0.f ? 1.0f / sum : 0.f;
#pragma unroll
                for (int c = 0; c < 8; ++c) ps[r * 512 + c * 64 + lane] = e[c] * inv; }
            lds_wave_sync();
            float o[4] = {0.f, 0.f, 0.f, 0.f};
#pragma unroll 1
            for (int c = 0; c < 8; ++c) {
                const int bsc = pbase[c];
                for (int kk = 0; kk < 64; ++kk) { const int kpos = bsc + kk; if (kpos < 0 || kpos > t) continue;
                    const float v = bf2f(PROJ[(size_t)(b * S + kpos) * NPAD + cv + g * 64 + lane]);
#pragma unroll
                    for (int r = 0; r < 4; ++r) o[r] += ps[r * 512 + c * 64 + kk] * v; } }
            lds_wave_sync();
#pragma unroll
            for (int r = 0; r < 4; ++r) { if (br == 0) oslc[r] = o[r]; else owin[r] = o[r]; }
        }
#pragma unroll
        for (int r = 0; r < 4; ++r) { const int h = g * 4 + r;
            const float g0 = sigmoidf_(bf2f(prow[C_GT + h * 3 + 0])), g1 = sigmoidf_(bf2f(prow[C_GT + h * 3 + 1])), g2 = sigmoidf_(bf2f(prow[C_GT + h * 3 + 2]));
            OATT[(size_t)tok * 512 + h * 64 + lane] = f2bf(g0 * ocmp[r] + g1 * oslc[r] + g2 * owin[r]); }
    }
}


constexpr float LOG2E = 1.4426950408889634f;
constexpr int AT_KC = 0, AT_VC = 16384, AT_KV = 32768  , AT_BTAB = 65536, AT_IMP = 69888, AT_SEL = 78336, AT_OUT = 78592  , AT_END = 78592 + 65536;
constexpr int BT_STRIDE = 132;
__device__ __forceinline__ int tile_off(int row, int chunk) { return row * 128 + ((chunk ^ (row & 7)) << 4); }
__device__ __forceinline__ bf16x8 mk_frag(unsigned a, unsigned b, unsigned c, unsigned d) { u32x4v v = {a, b, c, d}; return __builtin_bit_cast(bf16x8, v); }
struct LaneOffs { int koff[2]; int voff[4]; int soff; };
__device__ __forceinline__ LaneOffs lane_offs(int lane, int tid) {
    LaneOffs L; const int grp = lane >> 4, rowi = lane & 15, q4 = rowi >> 2, p = lane & 3;
#pragma unroll
    for (int ks = 0; ks < 2; ++ks) L.koff[ks] = tile_off(rowi, ks * 4 + grp);
#pragma unroll
    for (int dt = 0; dt < 4; ++dt) L.voff[dt] = tile_off(4 * grp + q4, 2 * dt + (p >> 1)) + 8 * (p & 1);
    L.soff = tile_off(tid >> 3, tid & 7); return L;
}
__device__ __forceinline__ bf16x8 vfrag_read(const LAS unsigned char* vt, int voff_dt, int row0) {
    const s16x4 a = __builtin_amdgcn_ds_read_tr16_b64_v4i16((LAS s16x4*)(vt + voff_dt + row0 * 128));
    const s16x4 b = __builtin_amdgcn_ds_read_tr16_b64_v4i16((LAS s16x4*)(vt + voff_dt + row0 * 128 + 2048));
    bf16x8 f = {a[0], a[1], a[2], a[3], b[0], b[1], b[2], b[3]}; return f;
}

struct AttnState {
    f32x4 o[4][2]; float m[2], l[2];
};

template <int BR>
__device__ __forceinline__ void attn_tile(const LAS unsigned char* kt_lds, const LAS unsigned char* vt_lds, const LAS float* btab_h, const bf16x8 (&qf)[2][2], const int (&tq)[2], const unsigned (&sel)[2],
                                          int j, bool near, AttnState& st, int lane, const LaneOffs& L) {
    const int grp = lane >> 4, kbase = 64 * j;
    f32x4 sacc[4][2];
#pragma unroll
    for (int kt = 0; kt < 4; ++kt) { sacc[kt][0] = (f32x4){0.f, 0.f, 0.f, 0.f}; sacc[kt][1] = (f32x4){0.f, 0.f, 0.f, 0.f}; }
#pragma unroll
    for (int kt = 0; kt < 4; ++kt)
#pragma unroll
        for (int ks = 0; ks < 2; ++ks) { const bf16x8 kf = *(const LAS bf16x8*)(kt_lds + L.koff[ks] + kt * 2048);
            sacc[kt][0] = __builtin_amdgcn_mfma_f32_16x16x32_bf16(kf, qf[0][ks], sacc[kt][0], 0, 0, 0);
            sacc[kt][1] = __builtin_amdgcn_mfma_f32_16x16x32_bf16(kf, qf[1][ks], sacc[kt][1], 0, 0, 0); }
    __builtin_amdgcn_sched_barrier(0);
    const float SC = 0.125f * LOG2E; const float bfar = btab_h[128];
    bf16x8 pf[2][2];
#pragma unroll
    for (int qt = 0; qt < 2; ++qt) {
        const int t = tq[qt]; const bool selq = BR == 0 ? ((sel[qt] >> j) & 1u) != 0u : true;
        float sv[4][4]; float tmax = -1e30f;
        int d0 = t - 4 * grp - kbase; asm volatile("" : "+v"(d0));
        if (near) {
#pragma unroll
            for (int kt = 0; kt < 4; ++kt)
#pragma unroll
                for (int rg = 0; rg < 4; ++rg) { const int dist = d0 - (kt * 16 + rg); const int dd = dist < 0 ? 0 : (dist > 128 ? 128 : dist); sv[kt][rg] = btab_h[dd]; }
        } else {
#pragma unroll
            for (int kt = 0; kt < 4; ++kt)
#pragma unroll
                for (int rg = 0; rg < 4; ++rg) sv[kt][rg] = bfar;
        }
#pragma unroll
        for (int kt = 0; kt < 4; ++kt)
#pragma unroll
            for (int rg = 0; rg < 4; ++rg) { const int c = kt * 16 + rg;
                const bool valid = BR == 0 ? (selq && d0 >= c) : (d0 >= c && d0 < 512 + c);
                const float sx = sacc[kt][qt][rg] * SC + sv[kt][rg]; const float s = valid ? sx : -1e30f; sv[kt][rg] = s; tmax = fmaxf(tmax, s); }
        tmax = fmaxf(tmax, __shfl_xor(tmax, 16)); tmax = fmaxf(tmax, __shfl_xor(tmax, 32));
        const float mnew = fmaxf(st.m[qt], tmax); const float alpha = __builtin_amdgcn_exp2f(st.m[qt] - mnew); st.m[qt] = mnew;
        const float muse = mnew < -1e29f ? 0.f : mnew;
        float ls = 0.f; unsigned pk[4][2];
#pragma unroll
        for (int kt = 0; kt < 4; ++kt) { float e[4];
#pragma unroll
            for (int rg = 0; rg < 4; ++rg) { e[rg] = __builtin_amdgcn_exp2f(sv[kt][rg] - muse); ls += e[rg]; }
            pk[kt][0] = pg8::cvt_pk_bf16(e[0], e[1]); pk[kt][1] = pg8::cvt_pk_bf16(e[2], e[3]); }
        st.l[qt] = st.l[qt] * alpha + ls;
#pragma unroll
        for (int dt = 0; dt < 4; ++dt) st.o[dt][qt] *= alpha;
        pf[qt][0] = mk_frag(pk[0][0], pk[0][1], pk[1][0], pk[1][1]); pf[qt][1] = mk_frag(pk[2][0], pk[2][1], pk[3][0], pk[3][1]);
        __builtin_amdgcn_sched_barrier(0);
    }
#pragma unroll
    for (int ks = 0; ks < 2; ++ks)
#pragma unroll
        for (int dt = 0; dt < 4; ++dt) { const bf16x8 vf = vfrag_read(vt_lds, L.voff[dt], 32 * ks);
            st.o[dt][0] = __builtin_amdgcn_mfma_f32_16x16x32_bf16(vf, pf[0][ks], st.o[dt][0], 0, 0, 0);
            st.o[dt][1] = __builtin_amdgcn_mfma_f32_16x16x32_bf16(vf, pf[1][ks], st.o[dt][1], 0, 0, 0); }
}

template <int BR>
__device__ __forceinline__ void attn_branch(const Frame& F, const bf16_t* PROJ, int b, int g, int t0, unsigned tiles  , const LAS float* btab_h,
                                            const bf16x8 (&qf)[2][2], const int (&tq)[2], const unsigned (&sel)[2], const float (&gate)[2], const LaneOffs& L) {
    const int lane = F.lane, tid = F.tid;
    const int ck = (BR == 0 ? C_KS : C_KW) + g * 64, cv = (BR == 0 ? C_VS : C_VW) + g * 64;
    const int srow = tid >> 3, sch = tid & 7;
    AttnState st;
#pragma unroll
    for (int dt = 0; dt < 4; ++dt) { st.o[dt][0] = (f32x4){0.f, 0.f, 0.f, 0.f}; st.o[dt][1] = (f32x4){0.f, 0.f, 0.f, 0.f}; }
    st.m[0] = st.m[1] = -1e30f; st.l[0] = st.l[1] = 0.f;
    unsigned rem = tiles; int cur = 0;
    u32x4v rk0, rv0, rk1, rv1;
    const bf16_t* srcb = PROJ + (size_t)(b * S + srow) * NPAD + sch * 8;
#define AT_LOAD(RK, RV, jj) do { const bf16_t* rowp = srcb + (size_t)(64 * (jj)) * NPAD; RK = *(const u32x4v*)(rowp + ck); RV = *(const u32x4v*)(rowp + cv); } while (0)
#define AT_WRITE(RK, RV, bufi) do { *(LAS u32x4v*)(F.lds + AT_KV + (bufi) * 16384 + L.soff) = RK; *(LAS u32x4v*)(F.lds + AT_KV + (bufi) * 16384 + 8192 + L.soff) = RV; } while (0)
#define AT_COMPUTE(jj) do { const bool near = (t0 + 8 * F.wave) - (64 * (jj) + 63) < 128; \
        attn_tile<BR>(F.lds + AT_KV + cur * 16384, F.lds + AT_KV + cur * 16384 + 8192, btab_h, qf, tq, sel, (jj), near, st, lane, L); } while (0)
    int j = __builtin_ctz(rem); rem &= rem - 1;
    AT_LOAD(rk0, rv0, j); AT_WRITE(rk0, rv0, 0);
    int j1 = -1; if (rem) { j1 = __builtin_ctz(rem); rem &= rem - 1; AT_LOAD(rk0, rv0, j1); }
    __syncthreads();
    for (;;) {
        int j2 = -1; if (rem) { j2 = __builtin_ctz(rem); rem &= rem - 1; AT_LOAD(rk1, rv1, j2); }
        AT_COMPUTE(j);
        if (j1 >= 0) AT_WRITE(rk0, rv0, cur ^ 1);
        __syncthreads(); cur ^= 1;
        if (j1 < 0) break;
        int j3 = -1; if (rem) { j3 = __builtin_ctz(rem); rem &= rem - 1; AT_LOAD(rk0, rv0, j3); }
        AT_COMPUTE(j1);
        if (j2 >= 0) AT_WRITE(rk1, rv1, cur ^ 1);
        __syncthreads(); cur ^= 1;
        if (j2 < 0) break;
        j = j2; j1 = j3;
    }
#undef AT_LOAD
#undef AT_WRITE
#undef AT_COMPUTE
    int pob = AT_OUT + tid * 4; asm volatile("" : "+v"(pob));
    LAS float* po = (LAS float*)(F.lds + pob);
#pragma unroll
    for (int qt = 0; qt < 2; ++qt) { float l = st.l[qt]; l += __shfl_xor(l, 16); l += __shfl_xor(l, 32); const float sc = l > 0.f ? gate[qt] / l : 0.f;
#pragma unroll
        for (int dt = 0; dt < 4; ++dt)
#pragma unroll
            for (int e = 0; e < 4; ++e) po[((qt * 4 + dt) * 4 + e) * 512] += st.o[dt][qt][e] * sc; }
}

__device__ __forceinline__ void p4_attn_mfma(const Frame& F) {
    const bf16_t* PROJ = (const bf16_t*)(F.ws + WS_PROJ); const bf16_t* KC = (const bf16_t*)(F.ws + WS_KC); const bf16_t* VC = (const bf16_t*)(F.ws + WS_VC);
    bf16_t* OATT = (bf16_t*)(F.ws + WS_OATT); const float* rel = F.in[21];
    const int lane = F.lane, tid = F.tid, wave = F.wave, grp = lane >> 4, col = lane & 15, qi = col >> 2, r = col & 3;
    LAS float* btab = (LAS float*)(F.lds + AT_BTAB); LAS float* impq = (LAS float*)(F.lds + AT_IMP); LAS unsigned* selm = (LAS unsigned*)(F.lds + AT_SEL);
    const LaneOffs L = lane_offs(lane, tid);
    for (int i = tid; i < 8 * 129; i += NTHREADS) { const int hh = i / 129, dd = i % 129; btab[hh * BT_STRIDE + dd] = rel[rel_bucket(dd) * 8 + hh] * LOG2E; }
    __syncthreads();
    for (int uu = blockIdx.x; uu < 1024; uu += F.G) {
        int sidx = uu;
        if (F.G == 256) { const int round = uu >> 8, k = uu & 255; sidx = (round == 0) ? k : (round == 1) ? 511 - k : (round == 2) ? 512 + k : 1023 - k; }
        const int qb = 31 - (sidx >> 5), bg = sidx & 31, b = bg >> 1, g = bg & 1, t0 = qb * 64, h = g * 4 + r;
        const LAS float* btab_h = btab + h * BT_STRIDE;
        int tq[2]; bf16x8 qf[2][2]; float gate[3][2];
#pragma unroll
        for (int qt = 0; qt < 2; ++qt) { tq[qt] = t0 + 8 * wave + 4 * qt + qi; const bf16_t* prow = PROJ + (size_t)(b * S + tq[qt]) * NPAD;
#pragma unroll
            for (int ks = 0; ks < 2; ++ks) qf[qt][ks] = *(const bf16x8*)(prow + C_Q + h * 64 + ks * 32 + 8 * grp);
#pragma unroll
            for (int jg = 0; jg < 3; ++jg) gate[jg][qt] = sigmoidf_(bf2f(prow[C_GT + h * 3 + jg])); }
#pragma unroll
        for (int i = 0; i < 2; ++i) { const int c2 = tid + 512 * i, row = c2 >> 3, ch = c2 & 7; const size_t src = ((size_t)(b * 2 + g) * 128 + row) * 64 + ch * 8;
            *(LAS u32x4v*)(F.lds + AT_KC + L.soff + 8192 * i) = *(const u32x4v*)(KC + src); *(LAS u32x4v*)(F.lds + AT_VC + L.soff + 8192 * i) = *(const u32x4v*)(VC + src); }
        __syncthreads();
#ifndef AT_SKIP_CMP
        {
            const int nvmax = t0 + 63 >= 31 ? ((t0 + 63 - 31) >> 4) + 1 : 0;
            const float SC = 0.125f * LOG2E; const int srcl = (lane + 48) & 63;
            int pob = AT_OUT + tid * 4; asm volatile("" : "+v"(pob));
            LAS float* po = (LAS float*)(F.lds + pob);
#pragma unroll
            for (int qt = 0; qt < 2; ++qt) {
                f32x4 sa[8];
#pragma unroll
                for (int kt = 0; kt < 8; ++kt) sa[kt] = (f32x4){0.f, 0.f, 0.f, 0.f};
#pragma unroll
                for (int kt = 0; kt < 8; ++kt) if (kt * 16 < nvmax) {
#pragma unroll
                    for (int ks = 0; ks < 2; ++ks) { const bf16x8 kf = *(const LAS bf16x8*)(F.lds + AT_KC + L.koff[ks] + kt * 2048);
                        sa[kt] = __builtin_amdgcn_mfma_f32_16x16x32_bf16(kf, qf[qt][ks], sa[kt], 0, 0, 0); } }
                __builtin_amdgcn_sched_barrier(0);
                int d0 = tq[qt] - 31 - 64 * grp; asm volatile("" : "+v"(d0));
                float mx = -1e30f;
#pragma unroll
                for (int kt = 0; kt < 8; ++kt)
#pragma unroll
                    for (int rg = 0; rg < 4; ++rg) { const int c = 256 * kt + 16 * rg; const int dist = d0 - c; const int dd = dist < 0 ? 0 : (dist > 128 ? 128 : dist);
                        const float sx = sa[kt][rg] * SC + btab_h[dd]; const float s = d0 >= c ? sx : -1e30f; sa[kt][rg] = s; mx = fmaxf(mx, s); }
                mx = fmaxf(mx, __shfl_xor(mx, 16)); mx = fmaxf(mx, __shfl_xor(mx, 32));
                float sum = 0.f;
#pragma unroll
                for (int kt = 0; kt < 8; ++kt)
#pragma unroll
                    for (int rg = 0; rg < 4; ++rg) { const int c = 256 * kt + 16 * rg; const float ex = __builtin_amdgcn_exp2f(sa[kt][rg] - mx); const float e = d0 >= c ? ex : 0.f; sa[kt][rg] = e; sum += e; }
                __builtin_amdgcn_sched_barrier(0);
                sum += __shfl_xor(sum, 16); sum += __shfl_xor(sum, 32);
                const float inv = sum > 0.f ? 1.0f / sum : 0.f;
                float prev3 = 0.f;
#pragma unroll
                for (int kt = 0; kt < 8; ++kt) { const float p3 = sa[kt][3] * inv; const float part = (sa[kt][0] * inv + sa[kt][1] * inv) + (sa[kt][2] * inv + p3);
                    const float xa = __shfl(p3, srcl), xb = __shfl(prev3, srcl); float tot = part + (grp >= 1 ? xa : xb);
                    tot += __shfl_xor(tot, 1); tot += __shfl_xor(tot, 2);
                    if (r == 0) impq[(8 * wave + 4 * qt + qi) * 33 + 4 * kt + grp] = tot;
                    prev3 = p3; }
                __builtin_amdgcn_sched_barrier(0);
                f32x4 oc[4];
#pragma unroll
                for (int dt = 0; dt < 4; ++dt) oc[dt] = (f32x4){0.f, 0.f, 0.f, 0.f};
#pragma unroll
                for (int ks = 0; ks < 4; ++ks) if (ks * 32 < nvmax) {
                    const bf16x8 pfr = mk_frag(pg8::cvt_pk_bf16(sa[2 * ks][0], sa[2 * ks][1]), pg8::cvt_pk_bf16(sa[2 * ks][2], sa[2 * ks][3]),
                                               pg8::cvt_pk_bf16(sa[2 * ks + 1][0], sa[2 * ks + 1][1]), pg8::cvt_pk_bf16(sa[2 * ks + 1][2], sa[2 * ks + 1][3]));
#pragma unroll
                    for (int dt = 0; dt < 4; ++dt) { const bf16x8 vf = vfrag_read(F.lds + AT_VC, L.voff[dt], 32 * ks); oc[dt] = __builtin_amdgcn_mfma_f32_16x16x32_bf16(vf, pfr, oc[dt], 0, 0, 0); } }
                const float scq = inv * gate[0][qt];
#pragma unroll
                for (int dt = 0; dt < 4; ++dt)
#pragma unroll
                    for (int e = 0; e < 4; ++e) po[((qt * 4 + dt) * 4 + e) * 512] = oc[dt][e] * scq;
                __builtin_amdgcn_sched_barrier(0);
            }
        }
#endif
        __syncthreads();
#ifndef AT_SKIP_SEL
        {
            const int q = tid >> 3, jj = tid & 7, cur = qb; unsigned bits = 0u;
            float vj[4];
#pragma unroll
            for (int e = 0; e < 4; ++e) { const int j = jj * 4 + e; const bool forced = (j == 0) || (j == cur) || (j == cur - 1); vj[e] = forced ? 1e4f : (j <= cur ? impq[q * 33 + j] : -INFINITY); }
            int rk[4] = {0, 0, 0, 0};
            for (int jp = 0; jp < 32; ++jp) { const bool forced = (jp == 0) || (jp == cur) || (jp == cur - 1); const float vp = forced ? 1e4f : (jp <= cur ? impq[q * 33 + jp] : -INFINITY);
#pragma unroll
                for (int e = 0; e < 4; ++e) rk[e] += ((vp > vj[e]) || (vp == vj[e] && jp < jj * 4 + e)) ? 1 : 0; }
#pragma unroll
            for (int e = 0; e < 4; ++e) bits |= (rk[e] < 8 ? 1u : 0u) << (jj * 4 + e);
            bits |= __shfl_xor(bits, 1); bits |= __shfl_xor(bits, 2); bits |= __shfl_xor(bits, 4);
            if (jj == 0) selm[q] = bits;
        }
#endif
        __syncthreads();
        unsigned sel[2] = {selm[8 * wave + qi], selm[8 * wave + 4 + qi]};
        unsigned un = selm[lane];
#pragma unroll
        for (int o = 32; o >= 1; o >>= 1) un |= __shfl_xor(un, o);
        un = __builtin_amdgcn_readfirstlane(un);
        const unsigned causal = qb == 31 ? 0xFFFFFFFFu : ((2u << qb) - 1u);
#ifndef AT_SKIP_BR0
        { const float gt1[2] = {gate[1][0], gate[1][1]}; attn_branch<0>(F, PROJ, b, g, t0, un & causal, btab_h, qf, tq, sel, gt1, L); }
#endif
#ifndef AT_SKIP_BR1
        { const int jlo = qb >= 8 ? qb - 8 : 0; const unsigned wmask = causal & ~((1u << jlo) - 1u); const float gt2[2] = {gate[2][0], gate[2][1]};
            attn_branch<1>(F, PROJ, b, g, t0, wmask, btab_h, qf, tq, sel, gt2, L); }
#endif
        int pob2 = AT_OUT + tid * 4; asm volatile("" : "+v"(pob2));
#pragma unroll
        for (int qt = 0; qt < 2; ++qt) { bf16_t* orow = OATT + (size_t)(b * S + tq[qt]) * 512 + h * 64 + 4 * grp;
#pragma unroll
            for (int dt = 0; dt < 4; ++dt) { const LAS float* po = (const LAS float*)(F.lds + pob2) + (qt * 4 + dt) * 4 * 512;
                *(uint2*)(orow + dt * 16) = make_uint2(pg8::cvt_pk_bf16(po[0], po[512]), pg8::cvt_pk_bf16(po[1024], po[1536])); } }
    }
}
__device__ __forceinline__ void p5_mixed(const Frame& F) {
    const bf16_t* PROJ = (const bf16_t*)(F.ws + WS_PROJ); const bf16_t* OATT = (const bf16_t*)(F.ws + WS_OATT); bf16_t* MIX = (bf16_t*)(F.ws + WS_H);
    const float* cw = F.in[13]; const float* ga = F.in[14]; const float* gc = F.in[15];
    const int gw = blockIdx.x * NWAVES + F.wave, nw = F.G * NWAVES, lane = F.lane;
    for (int tok = gw; tok < T; tok += nw) {
        const int s = tok % S; const int c0 = lane * 8;
        float a[8], y[8];
        { const uint4 w = *(const uint4*)(OATT + (size_t)tok * 512 + c0); const unsigned ww[4] = {w.x, w.y, w.z, w.w};
#pragma unroll
            for (int e = 0; e < 4; ++e) { a[2 * e] = bflo(ww[e]); a[2 * e + 1] = bfhi(ww[e]); } }
#pragma unroll
        for (int e = 0; e < 8; ++e) y[e] = 0.f;
#pragma unroll
        for (int dt = 0; dt < 3; ++dt) { if (s - 2 + dt >= 0) { const bf16_t* row = PROJ + (size_t)(tok - 2 + dt) * NPAD;
                const uint4 wc = *(const uint4*)(row + C_CC + c0), wh = *(const uint4*)(row + C_CH + c0); const unsigned c4[4] = {wc.x, wc.y, wc.z, wc.w}, h4[4] = {wh.x, wh.y, wh.z, wh.w};
#pragma unroll
                for (int e = 0; e < 4; ++e) { y[2 * e] += cw[dt * 512 + c0 + 2 * e] * (bflo(c4[e]) * bflo(h4[e])); y[2 * e + 1] += cw[dt * 512 + c0 + 2 * e + 1] * (bfhi(c4[e]) * bfhi(h4[e])); } } }
        { const uint4 wb = *(const uint4*)(PROJ + (size_t)tok * NPAD + C_CB + c0); const unsigned b4[4] = {wb.x, wb.y, wb.z, wb.w};
#pragma unroll
            for (int e = 0; e < 4; ++e) { y[2 * e] *= bflo(b4[e]); y[2 * e + 1] *= bfhi(b4[e]); } }
        float sa = 0.f, sy = 0.f;
#pragma unroll
        for (int e = 0; e < 8; ++e) { sa += a[e] * a[e]; sy += y[e] * y[e]; }
        sa = wave_sum(sa); sy = wave_sum(sy);
        const float ra = rsqrtf(sa * (1.0f / 512) + EPS), ry = rsqrtf(sy * (1.0f / 512) + EPS);
        unsigned oa[4], oy[4];
#pragma unroll
        for (int e = 0; e < 4; ++e) { oa[e] = pack2(a[2 * e] * ra * ga[c0 + 2 * e], a[2 * e + 1] * ra * ga[c0 + 2 * e + 1]); oy[e] = pack2(y[2 * e] * ry * gc[c0 + 2 * e], y[2 * e + 1] * ry * gc[c0 + 2 * e + 1]); }
        *(uint4*)(MIX + (size_t)tok * D + c0) = make_uint4(oa[0], oa[1], oa[2], oa[3]);
        *(uint4*)(MIX + (size_t)tok * D + 512 + c0) = make_uint4(oy[0], oy[1], oy[2], oy[3]);
    }
}

struct EpiResGate {
    static constexpr bool PERM = false, AFTER_DRAIN = false;
    float* C; const float* X; const float* MOD; int gate_off;
    __device__ __forceinline__ void operator()(const pg8::f32x4 (&acc)[2][2][4][2], const pg8::Unit& u, int wr, int wc, int fr, int fq) const {
        using pg8::f32x4; using pg8::HALF; using pg8::BM;
        const int row0 = u.pm * BM + wr * 64 + fr, col0 = u.pn * BM + wc * 32 + 4 * fq;
        const int b = (u.pm * BM) / S;
        f32x4 gv[2][2];
#pragma unroll
        for (int bj = 0; bj < 2; ++bj)
#pragma unroll
            for (int n = 0; n < 2; ++n) gv[bj][n] = *(const f32x4*)(MOD + b * 6144 + gate_off + col0 + bj * HALF + n * 16);
#pragma unroll
        for (int ai = 0; ai < 2; ++ai)
#pragma unroll
            for (int m = 0; m < 4; ++m) { const size_t ro = (size_t)(row0 + ai * HALF + m * 16) * D + col0;
#pragma unroll
                for (int bj = 0; bj < 2; ++bj)
#pragma unroll
                    for (int n = 0; n < 2; ++n) { const f32x4 xv = *(const f32x4*)(X + ro + bj * HALF + n * 16); *(f32x4*)(C + ro + bj * HALF + n * 16) = xv + gv[bj][n] * acc[ai][bj][m][n]; } }
    }
};

__device__ __forceinline__ void argmax_bfly(float& v, int& i) {
#pragma unroll
    for (int o = 32; o >= 1; o >>= 1) { const float ov = __shfl_xor(v, o); const int oi = __shfl_xor(i, o); if (ov > v || (ov == v && oi < i)) { v = ov; i = oi; } }
}
__device__ __forceinline__ void p9_route_naive(const Frame& F) {
    const bf16_t* QP = (const bf16_t*)(F.ws + WS_QP); const bf16_t* KEYS = (const bf16_t*)(F.ws + WS_KEYS);
    int* EIDX = (int*)(F.ws + WS_EIDX); float* EW = (float*)(F.ws + WS_EW);
    LAS float* ql = (LAS float*)F.lds + F.wave * 128;
    const int gw = blockIdx.x * NWAVES + F.wave, nw = F.G * NWAVES, lane = F.lane;
    for (int u = gw; u < T * 8; u += nw) {
        const int h = u & 7, tok = u >> 3;
        ql[lane] = bf2f(QP[(size_t)tok * D + h * 128 + lane]); ql[64 + lane] = bf2f(QP[(size_t)tok * D + h * 128 + 64 + lane]);
        lds_wave_sync();
        float tv[2]; int ti[2];
#pragma unroll
        for (int p = 0; p < 2; ++p) {
            float s[2];
#pragma unroll
            for (int kk = 0; kk < 2; ++kk) { const uint4* kr = (const uint4*)(KEYS + ((size_t)(h * 2 + p) * 128 + lane + 64 * kk) * 64); float a = 0.f;
#pragma unroll
                for (int c = 0; c < 8; ++c) { const uint4 w = kr[c]; const unsigned ww[4] = {w.x, w.y, w.z, w.w};
#pragma unroll
                    for (int e = 0; e < 4; ++e) a += ql[p * 64 + c * 8 + 2 * e] * bflo(ww[e]) + ql[p * 64 + c * 8 + 2 * e + 1] * bfhi(ww[e]); }
                s[kk] = a; }
            tv[p] = 0.f; ti[p] = 0;
            for (int i = 0; i < 16; ++i) {
                float v = s[0]; int ix = lane; if (s[1] > v) { v = s[1]; ix = lane + 64; }
                argmax_bfly(v, ix);
                if (lane == i) { tv[p] = v; ti[p] = ix; }
                if (ix == lane) s[0] = -INFINITY; if (ix == lane + 64) s[1] = -INFINITY;
            }
        }
        float cd[4];
        { const float va = __shfl(tv[0], lane >> 2);
#pragma unroll
            for (int i = 0; i < 4; ++i) cd[i] = va + __shfl(tv[1], (lane & 3) * 4 + i); }
        float cs = 0.f; int cc = 0;
        for (int it = 0; it < 16; ++it) {
            float v = cd[0]; int ix = lane * 4;
#pragma unroll
            for (int i = 1; i < 4; ++i) if (cd[i] > v) { v = cd[i]; ix = lane * 4 + i; }
            argmax_bfly(v, ix);
            if (lane == it) { cs = v; cc = ix; }
#pragma unroll
            for (int i = 0; i < 4; ++i) if (ix == lane * 4 + i) cd[i] = -INFINITY;
        }
        const int i1 = __shfl(ti[0], cc >> 4), i2 = __shfl(ti[1], cc & 15);
        const float m = __shfl(cs, 0); float ex = lane < 16 ? __expf(cs - m) : 0.f; const float sum = wave_sum(ex);
        if (lane < 16) { EIDX[(size_t)tok * 128 + h * 16 + lane] = i1 * 128 + i2; EW[(size_t)tok * 128 + h * 16 + lane] = ex / sum; }
        lds_wave_sync();
    }
}


__device__ __forceinline__ int ord_i(float f) { const int u = __float_as_int(f); return u >= 0 ? u : (u ^ 0x7FFFFFFF); }
__device__ __forceinline__ float unord_f(int i) { const int u = i >= 0 ? i : (i ^ 0x7FFFFFFF); return __int_as_float(u); }
#define INT_MIN_ (-2147483647 - 1)
struct CandTab { int a[50], b[50]; };
constexpr CandTab make_cand() { CandTab t{}; int n = 0; for (int a = 0; a < 16; ++a) for (int b = 0; b < 16; ++b) if ((a + 1) * (b + 1) <= 16) { t.a[n] = a; t.b[n] = b; ++n; } return t; }
constexpr CandTab CAND = make_cand();
constexpr int RT_LDS_PER_WAVE = 16 * 32 * 4;
__device__ __forceinline__ void p9_route_mfma(const Frame& F) {
    const bf16_t* QP = (const bf16_t*)(F.ws + WS_QP); const bf16_t* KEYS = (const bf16_t*)(F.ws + WS_KEYS);
    int* EIDX = (int*)(F.ws + WS_EIDX); float* EW = (float*)(F.ws + WS_EW);
    const int lane = F.lane, grp = lane >> 4, col = lane & 15;
    LAS int* itab = (LAS int*)(F.lds + F.wave * RT_LDS_PER_WAVE) + col * 32;
    const int gw = blockIdx.x * NWAVES + F.wave, nw = F.G * NWAVES;
    for (int task = gw; task < (T / 16) * 8; task += nw) {
        const int h = task & 7, tile = task >> 3, tok = tile * 16 + col;
        int lst[2][16];
#pragma unroll
        for (int p = 0; p < 2; ++p) {
            bf16x8 qf[2];
#pragma unroll
            for (int ks = 0; ks < 2; ++ks) qf[ks] = *(const bf16x8*)(QP + (size_t)tok * D + h * 128 + p * 64 + ks * 32 + 8 * grp);
            f32x4 sc[8];
#pragma unroll
            for (int kt = 0; kt < 8; ++kt) { sc[kt] = (f32x4){0.f, 0.f, 0.f, 0.f};
#pragma unroll
                for (int ks = 0; ks < 2; ++ks) { const bf16x8 kf = *(const bf16x8*)(KEYS + ((size_t)(h * 2 + p) * 128 + kt * 16 + col) * 64 + ks * 32 + 8 * grp);
                    sc[kt] = __builtin_amdgcn_mfma_f32_16x16x32_bf16(kf, qf[ks], sc[kt], 0, 0, 0); } }
            int r[32];
#pragma unroll
            for (int kt = 0; kt < 8; ++kt)
#pragma unroll
                for (int rg = 0; rg < 4; ++rg) r[kt * 4 + rg] = (ord_i(sc[kt][rg]) & ~0x7F) | (127 - (kt * 16 + 4 * grp + rg));
#pragma unroll
            for (int it = 0; it < 16; ++it) {
                int m = r[0];
#pragma unroll
                for (int i = 1; i < 32; ++i) m = max(m, r[i]);
                m = max(m, __shfl_xor(m, 16)); m = max(m, __shfl_xor(m, 32));
                lst[p][it] = m;
#pragma unroll
                for (int i = 0; i < 32; ++i) r[i] = (r[i] == m) ? INT_MIN_ : r[i];
            }
            if (grp == 0) {
#pragma unroll
                for (int it = 0; it < 16; ++it) itab[p * 16 + it] = 127 - (lst[p][it] & 0x7F);
            }
        }
        float v0[16], v1[16];
#pragma unroll
        for (int i = 0; i < 16; ++i) { v0[i] = unord_f(lst[0][i] & ~0x7F); v1[i] = unord_f(lst[1][i] & ~0x7F); }
        int ck[50];
#pragma unroll
        for (int i = 0; i < 50; ++i) ck[i] = (ord_i(v0[CAND.a[i]] + v1[CAND.b[i]]) & ~0xFF) | (255 - (CAND.a[i] * 16 + CAND.b[i]));
        int top[16];
#pragma unroll
        for (int it = 0; it < 16; ++it) {
            int m = ck[0];
#pragma unroll
            for (int i = 1; i < 50; ++i) m = max(m, ck[i]);
            top[it] = m;
#pragma unroll
            for (int i = 0; i < 50; ++i) ck[i] = (ck[i] == m) ? INT_MIN_ : ck[i];
        }
        lds_wave_sync();
        const float smax = unord_f(top[0] & ~0xFF);
        float ex[16], sum = 0.f;
#pragma unroll
        for (int it = 0; it < 16; ++it) { ex[it] = __expf(unord_f(top[it] & ~0xFF) - smax); sum += ex[it]; }
        const float inv = 1.0f / sum;
        if (grp == 0) {
#pragma unroll
            for (int it = 0; it < 16; ++it) { const int flat = 255 - (top[it] & 0xFF); const int i1 = itab[flat >> 4], i2 = itab[16 + (flat & 15)];
                EIDX[(size_t)tok * 128 + h * 16 + it] = i1 * 128 + i2; EW[(size_t)tok * 128 + h * 16 + it] = ex[it] * inv; }
        }
        lds_wave_sync();
    }
}


template <int N, bool DESC> __device__ __forceinline__ void bitonic_sort_i(int (&v)[N]) {
#pragma unroll
    for (int k = 2; k <= N; k <<= 1)
#pragma unroll
        for (int j = k >> 1; j > 0; j >>= 1)
#pragma unroll
            for (int i = 0; i < N; ++i) { const int l = i ^ j; if (l > i) { const bool up = ((i & k) == 0) != DESC; const int lo = min(v[i], v[l]), hi = max(v[i], v[l]); v[i] = up ? lo : hi; v[l] = up ? hi : lo; } }
}
template <int N, bool DESC> __device__ __forceinline__ void bitonic_merge_i(int (&v)[N]) {
#pragma unroll
    for (int j = N >> 1; j > 0; j >>= 1)
#pragma unroll
        for (int i = 0; i < N; ++i) { const int l = i ^ j; if (l > i) { const int lo = min(v[i], v[l]), hi = max(v[i], v[l]); v[i] = DESC ? hi : lo; v[l] = DESC ? lo : hi; } }
}
__device__ __forceinline__ void merge_top16_across(int (&t)[16]) {
#pragma unroll
    for (int m = 16; m <= 32; m <<= 1) { int y[16];
#pragma unroll
        for (int i = 0; i < 16; ++i) y[i] = max(t[i], __shfl_xor(t[15 - i], m));
        bitonic_merge_i<16, true>(y);
#pragma unroll
        for (int i = 0; i < 16; ++i) t[i] = y[i]; }
}
constexpr int RT2_KEYS = 0  , RT2_ITAB = 65536  ;
__device__ __forceinline__ void p9_route_sort(const Frame& F) {
    const bf16_t* QP = (const bf16_t*)(F.ws + WS_QP); const bf16_t* KEYS = (const bf16_t*)(F.ws + WS_KEYS);
    int* EIDX = (int*)(F.ws + WS_EIDX); float* EW = (float*)(F.ws + WS_EW);
    const int lane = F.lane, tid = F.tid, grp = lane >> 4, col = lane & 15;
    const LaneOffs L = lane_offs(lane, tid);
    LAS int* itab = (LAS int*)(F.lds + RT2_ITAB + F.wave * 2048) + col * 32;
    const bool g1 = grp == 1, g2 = grp == 2, g3 = grp == 3;
    for (int tile = blockIdx.x * NWAVES + F.wave; tile < T / 16; tile += F.G * NWAVES) {
        const int tok = tile * 16 + col;
        {
#pragma unroll
            for (int i = 0; i < 4; ++i) { const int q = tid + 512 * i; *(LAS u32x4v*)(F.lds + RT2_KEYS + tile_off(q >> 3, q & 7)) = *(const u32x4v*)(KEYS + (size_t)q * 8); } }
        bf16x8 qf[2][2];
#pragma unroll
        for (int p = 0; p < 2; ++p)
#pragma unroll
            for (int ks = 0; ks < 2; ++ks) qf[p][ks] = *(const bf16x8*)(QP + (size_t)tok * D + p * 64 + ks * 32 + 8 * grp);
        __syncthreads();
#pragma unroll 1
        for (int h = 0; h < 8; ++h) {
            const int kb = RT2_KEYS + (h & 1) * 32768;
            u32x4v stg[4]; bf16x8 qn[2][2];
            if (h < 7) {
#pragma unroll
                for (int i = 0; i < 4; ++i) { const int q = tid + 512 * i; stg[i] = *(const u32x4v*)(KEYS + (size_t)(h + 1) * 16384 + (size_t)q * 8); }
#pragma unroll
                for (int p = 0; p < 2; ++p)
#pragma unroll
                    for (int ks = 0; ks < 2; ++ks) qn[p][ks] = *(const bf16x8*)(QP + (size_t)tok * D + (h + 1) * 128 + p * 64 + ks * 32 + 8 * grp);
            }
            int lst[2][16];
#pragma unroll
            for (int p = 0; p < 2; ++p) {
                f32x4 sc[8];
#pragma unroll
                for (int kt = 0; kt < 8; ++kt) { sc[kt] = (f32x4){0.f, 0.f, 0.f, 0.f};
#pragma unroll
                    for (int ks = 0; ks < 2; ++ks) { const bf16x8 kf = *(const LAS bf16x8*)(F.lds + kb + p * 16384 + L.koff[ks] + kt * 2048);
                        sc[kt] = __builtin_amdgcn_mfma_f32_16x16x32_bf16(kf, qf[p][ks], sc[kt], 0, 0, 0); } }
                int ra[16], rb[16];
#pragma unroll
                for (int kt = 0; kt < 4; ++kt)
#pragma unroll
                    for (int rg = 0; rg < 4; ++rg) { ra[kt * 4 + rg] = (ord_i(sc[kt][rg]) & ~0x7F) | (127 - (kt * 16 + 4 * grp + rg)); rb[kt * 4 + rg] = (ord_i(sc[kt + 4][rg]) & ~0x7F) | (127 - ((kt + 4) * 16 + 4 * grp + rg)); }
                bitonic_sort_i<16, true>(ra); bitonic_sort_i<16, false>(rb);
#pragma unroll
                for (int i = 0; i < 16; ++i) ra[i] = max(ra[i], rb[i]);
                bitonic_merge_i<16, true>(ra);
                merge_top16_across(ra);
#pragma unroll
                for (int i = 0; i < 16; ++i) lst[p][i] = ra[i];
                if (grp == 0) {
#pragma unroll
                    for (int it = 0; it < 16; ++it) itab[p * 16 + it] = 127 - (ra[it] & 0x7F);
                }
            }
            float v0[16], v1[16];
#pragma unroll
            for (int i = 0; i < 16; ++i) { v0[i] = unord_f(lst[0][i] & ~0x7F); v1[i] = unord_f(lst[1][i] & ~0x7F); }
            int ck[16];
#pragma unroll
            for (int i = 0; i < 13; ++i) {
                constexpr int NC = 50;
                const int k0 = 4 * i, k1 = 4 * i + 1 < NC ? 4 * i + 1 : NC - 1, k2 = 4 * i + 2 < NC ? 4 * i + 2 : NC - 1, k3 = 4 * i + 3 < NC ? 4 * i + 3 : NC - 1;
                float va = v0[CAND.a[k0]], vb = v1[CAND.b[k0]]; int fl = 255 - (CAND.a[k0] * 16 + CAND.b[k0]);
                va = g1 ? v0[CAND.a[k1]] : va; vb = g1 ? v1[CAND.b[k1]] : vb; fl = g1 ? 255 - (CAND.a[k1] * 16 + CAND.b[k1]) : fl;
                va = g2 ? v0[CAND.a[k2]] : va; vb = g2 ? v1[CAND.b[k2]] : vb; fl = g2 ? 255 - (CAND.a[k2] * 16 + CAND.b[k2]) : fl;
                va = g3 ? v0[CAND.a[k3]] : va; vb = g3 ? v1[CAND.b[k3]] : vb; fl = g3 ? 255 - (CAND.a[k3] * 16 + CAND.b[k3]) : fl;
                int key = (ord_i(va + vb) & ~0xFF) | fl;
                if (4 * i + 1 >= NC) key = g1 ? INT_MIN_ : key;
                if (4 * i + 2 >= NC) key = g2 ? INT_MIN_ : key;
                if (4 * i + 3 >= NC) key = g3 ? INT_MIN_ : key;
                ck[i] = key; }
            ck[13] = INT_MIN_; ck[14] = INT_MIN_; ck[15] = INT_MIN_;
            bitonic_sort_i<16, true>(ck);
            merge_top16_across(ck);
            lds_wave_sync();
            const float smax = unord_f(ck[0] & ~0xFF);
            float ex[16], sum = 0.f;
#pragma unroll
            for (int it = 0; it < 16; ++it) { ex[it] = __expf(unord_f(ck[it] & ~0xFF) - smax); sum += ex[it]; }
            const float inv = 1.0f / sum;
            if (grp == 0) {
#pragma unroll
                for (int it = 0; it < 16; ++it) { const int flat = 255 - (ck[it] & 0xFF); const int i1 = itab[flat >> 4], i2 = itab[16 + (flat & 15)];
                    EIDX[(size_t)tok * 128 + h * 16 + it] = i1 * 128 + i2; EW[(size_t)tok * 128 + h * 16 + it] = ex[it] * inv; }
            }
            lds_wave_sync();
            if (h < 7) {
                const int kn = RT2_KEYS + ((h + 1) & 1) * 32768;
#pragma unroll
                for (int i = 0; i < 4; ++i) { const int q = tid + 512 * i; *(LAS u32x4v*)(F.lds + kn + tile_off(q >> 3, q & 7)) = stg[i]; }
#pragma unroll
                for (int p = 0; p < 2; ++p)
#pragma unroll
                    for (int ks = 0; ks < 2; ++ks) qf[p][ks] = qn[p][ks];
            }
            __syncthreads();
        }
    }
}

constexpr int N_PHASES = 14;
struct Args { const float* in[23]; float* out; unsigned char* ws; int ph_lo, ph_hi; };
__global__ void __launch_bounds__(NTHREADS, 2) fwd(Args args) {
    extern __shared__ __attribute__((aligned(16))) unsigned char lds_raw[];
    Frame F;
#pragma unroll
    for (int i = 0; i < 23; ++i) F.in[i] = args.in[i];
    F.out = args.out; F.ws = args.ws; F.lds = (LAS unsigned char*)lds_raw;
    F.tid = threadIdx.x; F.lane = F.tid & 63; F.wave = __builtin_amdgcn_readfirstlane(F.tid >> 6); F.G = gridDim.x;
    volatile LAS unsigned* misc = (volatile LAS unsigned*)(F.lds + LDS_MISC_OFF);
    if (F.tid < 64) misc[F.tid] = 0u;
    __syncthreads();
    XcdBarrier bar; bar.bar = (unsigned*)(F.ws + WS_CTL); bar.x = 0; bar.st = misc;
    const int lo = args.ph_lo, hi = args.ph_hi;
    if (hi - lo > 1) bar = xcd_barrier_post((unsigned*)(F.ws + WS_CTL), misc);
#ifndef PH_MASK
#define PH_MASK 0xFFFF
#endif
#define IN(k) (((PH_MASK >> (k)) & 1) && lo <= (k) && (k) < hi)
#define SEAM(k) do { if (IN(k) && IN((k) + 1)) xcd_barrier(bar); } while (0)
    const float* MOD = (const float*)(F.ws + WS_MOD);
    if (IN(0)) { p0_prologue(F); } SEAM(0);
    if (IN(1)) { norm_mod_rows(F, F.in[0], F.in[2], 0, 1024, (bf16_t*)(F.ws + WS_H)); } SEAM(1);
    if (IN(2)) { pg8::Gemm g{(const pg8::bf16_t*)(F.ws + WS_H), (const pg8::bf16_t*)(F.ws + WS_WIN), T, NPAD, D}; pg8::StaticOrder So; So.init(T, NPAD, F.G, (int)blockIdx.x);
        pg8::EpiBf16<0> E{(pg8::bf16_t*)(F.ws + WS_PROJ), NPAD, nullptr, 0, 0};
        pg8::gemm_phase<pg8::EpiBf16<0>, pg8::StaticOrder>(F.lds, g, So, E, nullptr); } SEAM(2);
#ifdef COMPRESS_NAIVE
    if (IN(3)) { p3_compress_naive(F); } SEAM(3);
#else
    if (IN(3)) { p3_compress_mfma(F); } SEAM(3);
#endif
    #ifdef ATTN_NAIVE
    if (IN(4)) { p4_attn_naive(F); } SEAM(4);
#else
    if (IN(4)) { p4_attn_mfma(F); } SEAM(4);
#endif
    if (IN(5)) { p5_mixed(F); } SEAM(5);
    if (IN(6)) { pg8::Gemm g{(const pg8::bf16_t*)(F.ws + WS_H), (const pg8::bf16_t*)(F.ws + WS_WOUT), T, D, D}; pg8::StaticOrder So; So.init(T, D, F.G, (int)blockIdx.x);
        EpiResGate E{F.out, F.in[0], MOD, 2048};
        pg8::gemm_phase<EpiResGate, pg8::StaticOrder>(F.lds, g, So, E, nullptr); } SEAM(6);
    if (IN(7)) { norm_mod_rows_q(F, F.out, F.in[3], 3072, 4096, (bf16_t*)(F.ws + WS_H)); } SEAM(7);
    if (IN(8)) { pg8::Gemm g{(const pg8::bf16_t*)(F.ws + WS_H), (const pg8::bf16_t*)(F.ws + WS_WQ), T, D, D}; pg8::StaticOrder So; So.init(T, D, F.G, (int)blockIdx.x);
        pg8::EpiBf16<0> E{(pg8::bf16_t*)(F.ws + WS_QP), D, nullptr, 0, 0};
        pg8::gemm_phase<pg8::EpiBf16<0>, pg8::StaticOrder>(F.lds, g, So, E, nullptr); } SEAM(8);
    #ifdef ROUTE_NAIVE
    if (IN(9)) { p9_route_naive(F); } SEAM(9);
#elif defined(ROUTE_V1)
    if (IN(9)) { p9_route_mfma(F); } SEAM(9);
#else
    if (IN(9)) { p9_route_sort(F); } SEAM(9);
#endif
    if (IN(10)) { p10a_udots(F); } SEAM(10);
    if (IN(11)) { p10b_coef(F); } SEAM(11);
    if (IN(12)) { p10c_vsum(F); } SEAM(12);
    if (IN(13)) { p10d_final(F); }
#undef IN
#undef SEAM
}

extern "C" void kernel_launch(void* const* d_in, const int* in_sizes, int n_in, void* d_out, int out_size, void* d_ws, size_t ws_size, hipStream_t stream) {
    static int grid = 0;
    if (grid == 0) {
        if (n_in != 23 || out_size != T * D || ws_size < WS_END) { fprintf(stderr, "kernel_launch: unexpected shapes: n_in %d out %d ws %zu (need %zu)\n", n_in, out_size, ws_size, (size_t)WS_END); grid = -1; return; }
        int dev = 0, cus = 0, per_cu = 0;
        if (hipGetDevice(&dev) != hipSuccess || hipDeviceGetAttribute(&cus, hipDeviceAttributeMultiprocessorCount, dev) != hipSuccess) { grid = -1; return; }
        if (hipFuncSetAttribute((const void*)fwd, hipFuncAttributeMaxDynamicSharedMemorySize, LDS_BYTES) != hipSuccess) { fprintf(stderr, "kernel_launch: hipFuncSetAttribute failed\n"); grid = -1; return; }
        if (hipOccupancyMaxActiveBlocksPerMultiprocessor(&per_cu, (const void*)fwd, NTHREADS, LDS_BYTES) != hipSuccess || per_cu < 1) { fprintf(stderr, "kernel_launch: occupancy query says %d\n", per_cu); (void)hipGetLastError(); per_cu = 1; }
        grid = cus;
    }
    if (grid < 0) return;
    (void)hipMemsetAsync((char*)d_ws + WS_CTL, 0, CTL_BYTES, stream);
    Args a{};
    for (int i = 0; i < 23; ++i) a.in[i] = (const float*)d_in[i];
    a.out = (float*)d_out; a.ws = (unsigned char*)d_ws;
#if MK_N_LAUNCHES == 1
    a.ph_lo = 0; a.ph_hi = N_PHASES;
    hipLaunchKernelGGL(fwd, dim3(grid), dim3(NTHREADS), LDS_BYTES, stream, a);
#else
#ifdef PROBE_LIST
    { const int plist[] = PROBE_LIST; for (int p : plist) { if (p < 0) { (void)hipMemsetAsync((char*)d_ws + WS_CTL, 0, CTL_BYTES, stream); continue; } a.ph_lo = p; a.ph_hi = p + 1; hipLaunchKernelGGL(fwd, dim3(grid), dim3(NTHREADS), LDS_BYTES, stream, a); } }
#else
    for (int p = 0; p < N_PHASES; ++p) { a.ph_lo = p; a.ph_hi = p + 1; hipLaunchKernelGGL(fwd, dim3(grid), dim3(NTHREADS), LDS_BYTES, stream, a); }
#endif
#endif
}
```

```cpp
#include <hip/hip_runtime.h>
#include <cstdio>
#include <cstdint>
#include <cstdlib>

#ifndef MK_N_LAUNCHES
#define MK_N_LAUNCHES 1
#endif
#define XB_TMO      128
#define XB_XCNT(j)  (256  + 64 * (j))
#define XB_XSUB(j)  (1280 + 64 * (j))
#define XB_XGEN(j)  (2304 + 64 * (j))
#define XB_TOP      3328
#define XB_TOPGEN   3392
#define XCD_BAR_WORDS 3456
#define XB_SPIN_CAP (1u << 18)
#define LAS __attribute__((address_space(3)))

__device__ __forceinline__ unsigned xb_ld(unsigned* p)              { return __hip_atomic_load(p, __ATOMIC_RELAXED, __HIP_MEMORY_SCOPE_AGENT); }
__device__ __forceinline__ unsigned xb_add(unsigned* p, unsigned v) { return __hip_atomic_fetch_add(p, v, __ATOMIC_RELAXED, __HIP_MEMORY_SCOPE_AGENT); }
__device__ __forceinline__ unsigned xb_xcc_id() { return (unsigned)__builtin_amdgcn_s_getreg((3 << 11) | 20) & 0xFu; }
#define XB_SPIN(cond, bar) do { unsigned _sp = 0; while (cond) { __builtin_amdgcn_s_sleep(1); \
    if ((++_sp & 255u) == 0u) { if (xb_ld(&(bar)[XB_TMO])) break; if (_sp > XB_SPIN_CAP) { atomicAdd(&(bar)[XB_TMO], 1u); break; } } } } while (0)

struct XcdBarrier {
    unsigned* bar; unsigned x;
    volatile LAS unsigned* st;
};

__device__ __forceinline__ XcdBarrier xcd_barrier_post(unsigned* bar, volatile LAS unsigned* st) {
    XcdBarrier b; b.bar = bar; b.x = xb_xcc_id(); b.st = st;
    if (threadIdx.x == 0) (void)xb_add(&bar[XB_XCNT(b.x)], 1u);
    return b;
}
__device__ __forceinline__ void xcd_barrier_complete(unsigned* bar, unsigned x, unsigned& nloc, unsigned& nx) {
    const unsigned G = gridDim.x * gridDim.y * gridDim.z;
    unsigned sum, cnt, mine, sp = 0u;
    for (;;) {
        sum = 0u; cnt = 0u; mine = 0u;
#pragma unroll
        for (unsigned j = 0; j < 16; ++j) { const unsigned c = xb_ld(&bar[XB_XCNT(j)]); sum += c; cnt += (c > 0u) ? 1u : 0u; mine = (j == x) ? c : mine; }
        if (sum == G) break;
        __builtin_amdgcn_s_sleep(1);
        if ((++sp & 255u) == 0u) { if (xb_ld(&bar[XB_TMO])) break; if (sp > XB_SPIN_CAP) { atomicAdd(&bar[XB_TMO], 1u); break; } }
    }
    nloc = mine > 0u ? mine : 1u; nx = cnt > 0u ? cnt : 1u;
}

__device__ __forceinline__ void xcd_barrier(const XcdBarrier& b) {
    asm volatile("s_waitcnt vmcnt(0)" ::: "memory");
    __syncthreads();
    if (threadIdx.x == 0) {
        unsigned* bar = b.bar;
        __builtin_amdgcn_s_waitcnt(0);
        unsigned nloc = b.st[0], nx = b.st[1];
        if (nloc == 0u) { xcd_barrier_complete(bar, b.x, nloc, nx); b.st[0] = nloc; b.st[1] = nx; }
        const unsigned old = xb_add(&bar[XB_XSUB(b.x)], 1u);
        const unsigned gen = old / nloc;
        if (old + 1u == (gen + 1u) * nloc) {
            __builtin_amdgcn_fence(__ATOMIC_RELEASE, "agent");
            asm volatile("s_waitcnt vmcnt(0)" ::: "memory");
            const unsigned og = xb_add(&bar[XB_TOP], 1u);
            const unsigned tg = og / nx;
            if (og + 1u == (tg + 1u) * nx) xb_add(&bar[XB_TOPGEN], 1u);
            else XB_SPIN(xb_ld(&bar[XB_TOPGEN]) == tg, bar);
            __builtin_amdgcn_fence(__ATOMIC_ACQUIRE, "agent");
            xb_add(&bar[XB_XGEN(b.x)], 1u);
            asm volatile("s_waitcnt vmcnt(0)" ::: "memory");
        } else {
            XB_SPIN(xb_ld(&bar[XB_XGEN(b.x)]) == gen, bar);
            __builtin_amdgcn_fence(__ATOMIC_ACQUIRE, "agent");
            asm volatile("s_waitcnt vmcnt(0)" ::: "memory");
        }
    }
    __syncthreads();
}

namespace pg8 {
#define PG8_LAS __attribute__((address_space(3)))
typedef unsigned short bf16_t;
typedef short bf16x8 __attribute__((ext_vector_type(8)));
typedef float f32x4 __attribute__((ext_vector_type(4)));
typedef unsigned u32x4 __attribute__((ext_vector_type(4)));
constexpr int BM = 256, BK = 64, HALF = 128, HTB = HALF * BK * 2  , STAGE_BYTES = 8 * HTB, NXCD = 8, WGM = 8;

__host__ __device__ __forceinline__ int lds_byte(int r, int c) { const int st = (r >> 4) * 2 + (c >> 5), rr = r & 15, cc = c & 31, ob = rr * 64 + cc * 2; return st * 1024 + (ob ^ (((ob >> 9) & 1) << 5)); }
__host__ __device__ __forceinline__ void stage_rc(int b, int& R, int& C) { const int st = b / 1024, sb = b % 1024, swz = sb ^ (((sb >> 9) & 1) << 5); R = (st >> 1) * 16 + swz / 64; C = (st & 1) * 32 + (swz % 64) / 2; }
__host__ __device__ __forceinline__ int perm32(int rho) { const int n = rho >> 4, i = rho & 15; return 8 * (i >> 2) + 4 * n + (i & 3); }

struct Unit { int pm, pn; };
struct Gemm { const bf16_t* A; const bf16_t* Bt; int M, N, K; };

struct StaticOrder {
    int nM, nN, nwg, G, c;
    __host__ __device__ void init(int M, int N, int G_, int c_) { nM = M / BM; nN = N / BM; nwg = nM * nN; G = G_; c = c_; }
    __host__ __device__ bool next(int i, Unit& u) const {
        const long L = (long)i * G + c; if (L >= nwg) return false;
        int wgid = (int)L; { const int q = nwg / NXCD, r = nwg % NXCD, xcd = wgid % NXCD, off = wgid / NXCD; wgid = (xcd < r ? xcd * (q + 1) : r * (q + 1) + (xcd - r) * q) + off; }
        const int nig = WGM * nN, gid = wgid / nig, fm = gid * WGM, gsz = (nM - fm) < WGM ? (nM - fm) : WGM;
        u.pm = fm + ((wgid % nig) % gsz); u.pn = (wgid % nig) / gsz; return true;
    }
    __device__ __forceinline__ void a_ready(const Unit&) const {}
    __device__ __forceinline__ void done(const Unit&) const {}
};
struct CountedOrder : StaticOrder {
    const unsigned* ready; unsigned need; unsigned* tmo;
    __device__ __forceinline__ void a_ready(const Unit& u) const {
        if (threadIdx.x < 64) {
            const unsigned long long t0 = __builtin_amdgcn_s_memrealtime(); unsigned polls = 0;
            while ((unsigned)__builtin_amdgcn_readfirstlane(__hip_atomic_load(ready + 64 * u.pm, __ATOMIC_RELAXED, __HIP_MEMORY_SCOPE_AGENT)) < need) {
                if ((++polls & 255u) == 0u && __builtin_amdgcn_readfirstlane(__hip_atomic_load(tmo, __ATOMIC_RELAXED, __HIP_MEMORY_SCOPE_AGENT)) != 0u) break;
                if (__builtin_amdgcn_s_memrealtime() - t0 > 2000000ull) {
                    if (threadIdx.x == 0) { unsigned expect = 0u; __hip_atomic_compare_exchange_strong(tmo + 1, &expect, 0x600u | (unsigned)(u.pm & 0xff), __ATOMIC_RELAXED, __ATOMIC_RELAXED, __HIP_MEMORY_SCOPE_AGENT); __hip_atomic_store(tmo, 1u, __ATOMIC_RELAXED, __HIP_MEMORY_SCOPE_AGENT); }
                    break; }
                __builtin_amdgcn_s_sleep(2); }
            __builtin_amdgcn_fence(__ATOMIC_ACQUIRE, "agent");
            asm volatile("s_waitcnt vmcnt(0)" ::: "memory");
        }
#if !defined(BROKEN_HOOK_NO_BARRIER)
        asm volatile("" ::: "memory"); __builtin_amdgcn_s_barrier(); asm volatile("" ::: "memory");
#endif
    }
};

__device__ __forceinline__ unsigned cvt_pk_bf16(float lo, float hi) { unsigned r; asm volatile("v_cvt_pk_bf16_f32 %0, %1, %2" : "=v"(r) : "v"(lo), "v"(hi)); return r; }
typedef float f32x2 __attribute__((ext_vector_type(2)));
__device__ __forceinline__ f32x2 gelu_pk(f32x2 v) {
    const f32x2 av = __builtin_elementwise_abs(v), d = av * 0.2316418882f + 1.0f;
    f32x2 t; t.x = __builtin_amdgcn_rcpf(d.x); t.y = __builtin_amdgcn_rcpf(d.y);
    f32x2 q = t * 0.5307027145f + (-0.7265760135f); q = q * t + 0.7107068705f; q = q * t + (-0.142248368f); q = q * t + 0.127414796f; q = q * t;
    const f32x2 s = (v * v) * (-0.72134752044f);
    f32x2 e; e.x = __builtin_amdgcn_exp2f(s.x); e.y = __builtin_amdgcn_exp2f(s.y);
    const f32x2 m = v * (q * e), r = v - m;
    f32x2 o; o.x = v.x < 0.f ? m.x : r.x; o.y = v.y < 0.f ? m.y : r.y; return o;
}

struct EpiF32 {
    static constexpr bool PERM = false, AFTER_DRAIN = false;
    float* C; int ldc; const float* bias;
    __device__ __forceinline__ void operator()(const f32x4 (&acc)[2][2][4][2], const Unit& u, int wr, int wc, int fr, int fq) const {
        const int row0 = u.pm * BM + wr * 64 + fr, col0 = u.pn * BM + wc * 32 + 4 * fq;
        f32x4 bv[2][2];
#pragma unroll
        for (int bj = 0; bj < 2; ++bj)
#pragma unroll
            for (int n = 0; n < 2; ++n) bv[bj][n] = bias ? *(const f32x4*)(bias + col0 + bj * HALF + n * 16) : (f32x4){0.f, 0.f, 0.f, 0.f};
#pragma unroll
        for (int ai = 0; ai < 2; ++ai)
#pragma unroll
            for (int m = 0; m < 4; ++m) { float* rowp = C + (size_t)(row0 + ai * HALF + m * 16) * ldc + col0;
#pragma unroll
                for (int bj = 0; bj < 2; ++bj)
#pragma unroll
                    for (int n = 0; n < 2; ++n) *(f32x4*)(rowp + bj * HALF + n * 16) = acc[ai][bj][m][n] + bv[bj][n]; }
    }
};
template <int ACT  > struct EpiBf16 {
    static constexpr bool PERM = true, AFTER_DRAIN = false;
    bf16_t* O; int ldc; const float* bias; int split_cols; size_t split_stride;
    __device__ __forceinline__ void operator()(const f32x4 (&acc)[2][2][4][2], const Unit& u, int wr, int wc, int fr, int fq) const {
        const int row0 = u.pm * BM + wr * 64 + fr; int colt = u.pn * BM; bf16_t* base = O;
        if (split_cols) { const int t = colt / split_cols; base += (size_t)t * split_stride; colt -= t * split_cols; }
        const int col0 = colt + wc * 32 + 8 * fq, bcol0 = u.pn * BM + wc * 32 + 8 * fq;
        f32x4 bv[2][2];
#pragma unroll
        for (int bj = 0; bj < 2; ++bj)
#pragma unroll
            for (int n = 0; n < 2; ++n) bv[bj][n] = bias ? *(const f32x4*)(bias + bcol0 + bj * HALF + 4 * n) : (f32x4){0.f, 0.f, 0.f, 0.f};
#pragma unroll
        for (int ai = 0; ai < 2; ++ai)
#pragma unroll
            for (int m = 0; m < 4; ++m) { bf16_t* rowp = base + (size_t)(row0 + ai * HALF + m * 16) * ldc + col0;
#pragma unroll
                for (int bj = 0; bj < 2; ++bj) { f32x4 v0 = acc[ai][bj][m][0] + bv[bj][0], v1 = acc[ai][bj][m][1] + bv[bj][1];
                    if (ACT == 1) { f32x2 a = gelu_pk((f32x2){v0[0], v0[1]}), b = gelu_pk((f32x2){v0[2], v0[3]}), c = gelu_pk((f32x2){v1[0], v1[1]}), d = gelu_pk((f32x2){v1[2], v1[3]});
                        v0 = (f32x4){a.x, a.y, b.x, b.y}; v1 = (f32x4){c.x, c.y, d.x, d.y}; }
                    if (ACT == 2) {
#pragma unroll
                        for (int j = 0; j < 4; ++j) { v0[j] = 0.5f * v0[j] * (1.0f + erff(v0[j] * 0.70710678f)); v1[j] = 0.5f * v1[j] * (1.0f + erff(v1[j] * 0.70710678f)); } }
                    u32x4 w; w.x = cvt_pk_bf16(v0[0], v0[1]); w.y = cvt_pk_bf16(v0[2], v0[3]); w.z = cvt_pk_bf16(v1[0], v1[1]); w.w = cvt_pk_bf16(v1[2], v1[3]);
                    *(u32x4*)(rowp + bj * HALF) = w; } }
    }
};

struct PanelStats {
    unsigned* xbuf;
    unsigned* cnt;
    unsigned* tmo;
    int ntn; float eps;
    unsigned code;
    __device__ __forceinline__ bool run(const f32x4 (&v)[2][2][4][2], const Unit& u, int wr, int wc, int fr, int fq, PG8_LAS unsigned char* lds, int wid, int lane) const {
        typedef float f32x2v __attribute__((ext_vector_type(2)));
        PG8_LAS f32x2v* P = (PG8_LAS f32x2v*)lds;
        PG8_LAS f32x2v* S = (PG8_LAS f32x2v*)(lds + 8192);
        PG8_LAS unsigned* flag = (PG8_LAS unsigned*)(lds + 8192 + 2048);
#pragma unroll
        for (int ai = 0; ai < 2; ++ai)
#pragma unroll
            for (int m = 0; m < 4; ++m) {
                float s = 0.f;
#pragma unroll
                for (int bj = 0; bj < 2; ++bj)
#pragma unroll
                    for (int n = 0; n < 2; ++n) { const f32x4 x = v[ai][bj][m][n]; s += (x[0] + x[1]) + (x[2] + x[3]); }
                s += __shfl_xor(s, 16); s += __shfl_xor(s, 32);
                const float mw = s * (1.0f / 64.0f); float q = 0.f;
#pragma unroll
                for (int bj = 0; bj < 2; ++bj)
#pragma unroll
                    for (int n = 0; n < 2; ++n) { const f32x4 d = v[ai][bj][m][n] - mw; q += (d[0] * d[0] + d[1] * d[1]) + (d[2] * d[2] + d[3] * d[3]); }
                q += __shfl_xor(q, 16); q += __shfl_xor(q, 32);
                if (fq == 0) P[(ai * HALF + wr * 64 + m * 16 + fr) * 4 + wc] = (f32x2v){mw, q};
            }
        asm volatile("s_waitcnt lgkmcnt(0)" ::: "memory"); __builtin_amdgcn_s_barrier(); asm volatile("" ::: "memory");
#if defined(BROKEN_NO_WAIT)
        if (blockIdx.x >= 64) { const long long t0 = clock64(); while (clock64() - t0 < 60000) __builtin_amdgcn_s_sleep(8); }
#endif
        const int row = wid * 32 + (lane & 31);
        if (lane < 32) {
            const f32x2v a = P[row * 4 + 0], b = P[row * 4 + 1], c = P[row * 4 + 2], d = P[row * 4 + 3];
            const float mt = (a.x + b.x + c.x + d.x) * 0.25f;
            const float da = a.x - mt, db = b.x - mt, dc = c.x - mt, dd = d.x - mt;
            const float m2 = (a.y + b.y) + (c.y + d.y) + 64.0f * ((da * da + db * db) + (dc * dc + dd * dd));
            unsigned long long* slot = (unsigned long long*)xbuf + ((size_t)(u.pm * BM + row) * 4 + u.pn);
            __hip_atomic_store(slot, ((unsigned long long)__float_as_uint(m2) << 32) | __float_as_uint(mt), __ATOMIC_RELAXED, __HIP_MEMORY_SCOPE_AGENT);
        }
        asm volatile("s_waitcnt vmcnt(0)" ::: "memory");
        if (lane == 0) __hip_atomic_fetch_add(cnt + 64 * u.pm, 1u, __ATOMIC_RELAXED, __HIP_MEMORY_SCOPE_AGENT);
        if (wid == 0) {
            bool dead = false; const unsigned long long t0 = __builtin_amdgcn_s_memrealtime(); const unsigned want = 8u * (unsigned)ntn;
            for (;;) {
#if defined(BROKEN_NO_WAIT)
                break;
#endif
                if ((unsigned)__builtin_amdgcn_readfirstlane(__hip_atomic_load(cnt + 64 * u.pm, __ATOMIC_RELAXED, __HIP_MEMORY_SCOPE_AGENT)) >= want) break;
                if (__builtin_amdgcn_s_memrealtime() - t0 > 2000000ull) {
                    if (lane == 0) { unsigned expect = 0u; __hip_atomic_compare_exchange_strong(tmo + 1, &expect, code | (unsigned)(u.pm & 0xff), __ATOMIC_RELAXED, __ATOMIC_RELAXED, __HIP_MEMORY_SCOPE_AGENT);
                                     __hip_atomic_store(tmo, 1u, __ATOMIC_RELAXED, __HIP_MEMORY_SCOPE_AGENT); }
                    dead = true; break; }
                __builtin_amdgcn_s_sleep(2);
            }
            __builtin_amdgcn_fence(__ATOMIC_ACQUIRE, "agent");
            if (lane == 0) flag[0] = dead ? 1u : 0u;
        }
        asm volatile("s_waitcnt vmcnt(0) lgkmcnt(0)" ::: "memory"); __builtin_amdgcn_s_barrier(); asm volatile("" ::: "memory");
        const bool bad = flag[0] != 0u;
        if (lane < 32) {
            const unsigned long long* slot = (const unsigned long long*)xbuf + (size_t)(u.pm * BM + row) * 4; float mt[4], m2[4]; float ms = 0.f;
#pragma unroll
            for (int t = 0; t < 4; ++t) { if (t < ntn) { const unsigned long long w = __hip_atomic_load(slot + t, __ATOMIC_RELAXED, __HIP_MEMORY_SCOPE_AGENT); mt[t] = __uint_as_float((unsigned)w); m2[t] = __uint_as_float((unsigned)(w >> 32)); } else { mt[t] = 0.f; m2[t] = 0.f; } ms += mt[t]; }
            const float mean = ms / (float)ntn; float q = 0.f;
#pragma unroll
            for (int t = 0; t < 4; ++t) if (t < ntn) { const float dm = mt[t] - mean; q += m2[t] + 256.0f * dm * dm; }
            S[row] = (f32x2v){mean, 1.0f / sqrtf(q / (256.0f * (float)ntn) + eps)};
        }
        asm volatile("s_waitcnt lgkmcnt(0)" ::: "memory"); __builtin_amdgcn_s_barrier(); asm volatile("" ::: "memory");
        return bad;
    }
};
struct EpiLnRes {
    static constexpr bool PERM = false, AFTER_DRAIN = true;
    const float* base; float* out; int ldc; const float* bias; PanelStats st; unsigned poison;
    __device__ __forceinline__ void refuse(size_t i0, size_t stride, int M, int N) const { const float q = __builtin_nanf(""); for (size_t i = i0; i < (size_t)M * N; i += stride) out[(i / N) * ldc + i % N] = q;
        if (i0 == 0) { unsigned expect = 0u; __hip_atomic_compare_exchange_strong(st.tmo + 1, &expect, 0x7f0u, __ATOMIC_RELAXED, __ATOMIC_RELAXED, __HIP_MEMORY_SCOPE_AGENT); __hip_atomic_store(st.tmo, 1u, __ATOMIC_RELAXED, __HIP_MEMORY_SCOPE_AGENT); } }
    __device__ __forceinline__ void fused(f32x4 (&acc)[2][2][4][2], const Unit& u, int wr, int wc, int fr, int fq, PG8_LAS unsigned char* lds, int wid, int lane) const {
        typedef float f32x2v __attribute__((ext_vector_type(2)));
        const PG8_LAS f32x2v* S = (const PG8_LAS f32x2v*)(lds + 8192);
        const int col0 = u.pn * BM + wc * 32 + 4 * fq;
#pragma unroll
        for (int bj = 0; bj < 2; ++bj)
#pragma unroll
            for (int n = 0; n < 2; ++n) { const f32x4 bv = bias ? *(const f32x4*)(bias + col0 + bj * HALF + n * 16) : (f32x4){0.f, 0.f, 0.f, 0.f};
#pragma unroll
                for (int ai = 0; ai < 2; ++ai)
#pragma unroll
                    for (int m = 0; m < 4; ++m) acc[ai][bj][m][n] += bv; }
        const bool bad = st.run(acc, u, wr, wc, fr, fq, lds, wid, lane) || poison != 0u;
        const float qnan = __builtin_nanf("");
#pragma unroll
        for (int ai = 0; ai < 2; ++ai)
#pragma unroll
            for (int m = 0; m < 4; ++m) { const int r = ai * HALF + wr * 64 + m * 16 + fr; const f32x2v sr = S[r]; const size_t off = (size_t)(u.pm * BM + r) * ldc + col0;
#pragma unroll
                for (int bj = 0; bj < 2; ++bj)
#pragma unroll
                    for (int n = 0; n < 2; ++n) { const f32x4 bs = *(const f32x4*)(base + off + bj * HALF + n * 16); f32x4 o = bs + (acc[ai][bj][m][n] - sr.x) * sr.y;
                        if (bad) o = (f32x4){qnan, qnan, qnan, qnan}; *(f32x4*)(out + off + bj * HALF + n * 16) = o; }
                asm volatile("" ::: "memory"); }
    }
};
struct EpiLnResLn {
    static constexpr bool PERM = false, AFTER_DRAIN = true;
    const float* base; float* out; bf16_t* xn; int ldc; const float* bias; PanelStats st1, st2; unsigned poison;
    __device__ __forceinline__ void refuse(size_t i0, size_t stride, int M, int N) const { const float q = __builtin_nanf(""); for (size_t i = i0; i < (size_t)M * N; i += stride) { const size_t o = (i / N) * ldc + i % N; out[o] = q; xn[o] = (bf16_t)0x7fc0u; }
        if (i0 == 0) { unsigned expect = 0u; __hip_atomic_compare_exchange_strong(st1.tmo + 1, &expect, 0x7f0u, __ATOMIC_RELAXED, __ATOMIC_RELAXED, __HIP_MEMORY_SCOPE_AGENT); __hip_atomic_store(st1.tmo, 1u, __ATOMIC_RELAXED, __HIP_MEMORY_SCOPE_AGENT); } }
    __device__ __forceinline__ void fused(f32x4 (&acc)[2][2][4][2], const Unit& u, int wr, int wc, int fr, int fq, PG8_LAS unsigned char* lds, int wid, int lane) const {
        typedef float f32x2v __attribute__((ext_vector_type(2))); typedef unsigned u32x2v __attribute__((ext_vector_type(2)));
        const PG8_LAS f32x2v* S = (const PG8_LAS f32x2v*)(lds + 8192);
        const int col0 = u.pn * BM + wc * 32 + 4 * fq;
#pragma unroll
        for (int bj = 0; bj < 2; ++bj)
#pragma unroll
            for (int n = 0; n < 2; ++n) { const f32x4 bv = bias ? *(const f32x4*)(bias + col0 + bj * HALF + n * 16) : (f32x4){0.f, 0.f, 0.f, 0.f};
#pragma unroll
                for (int ai = 0; ai < 2; ++ai)
#pragma unroll
                    for (int m = 0; m < 4; ++m) acc[ai][bj][m][n] += bv; }
        bool bad = st1.run(acc, u, wr, wc, fr, fq, lds, wid, lane) || poison != 0u;
        const float qnan = __builtin_nanf("");
#pragma unroll
        for (int ai = 0; ai < 2; ++ai)
#pragma unroll
            for (int m = 0; m < 4; ++m) { const int r = ai * HALF + wr * 64 + m * 16 + fr; const f32x2v sr = S[r]; const size_t off = (size_t)(u.pm * BM + r) * ldc + col0;
#pragma unroll
                for (int bj = 0; bj < 2; ++bj)
#pragma unroll
                    for (int n = 0; n < 2; ++n) { const f32x4 bs = *(const f32x4*)(base + off + bj * HALF + n * 16); acc[ai][bj][m][n] = bs + (acc[ai][bj][m][n] - sr.x) * sr.y; }
                asm volatile("" : "+v"(acc[ai][0][m][0]), "+v"(acc[ai][0][m][1]), "+v"(acc[ai][1][m][0]), "+v"(acc[ai][1][m][1]));
                if (m & 1) asm volatile("" ::: "memory"); }
        const bool bad1 = bad;
        bad = st2.run(acc, u, wr, wc, fr, fq, lds, wid, lane) || bad;
#pragma unroll
        for (int ai = 0; ai < 2; ++ai)
#pragma unroll
            for (int m = 0; m < 4; ++m) { const int r = ai * HALF + wr * 64 + m * 16 + fr; const f32x2v sr = S[r]; const size_t off = (size_t)(u.pm * BM + r) * ldc + col0;
#pragma unroll
                for (int bj = 0; bj < 2; ++bj)
#pragma unroll
                    for (int n = 0; n < 2; ++n) { const f32x4 x1 = acc[ai][bj][m][n]; *(f32x4*)(out + off + bj * HALF + n * 16) = bad1 ? (f32x4){qnan, qnan, qnan, qnan} : x1;
                        const f32x4 o = (x1 - sr.x) * sr.y; u32x2v w; w.x = cvt_pk_bf16(o[0], o[1]); w.y = cvt_pk_bf16(o[2], o[3]);
                        if (bad) { w.x = 0x7fc07fc0u; w.y = 0x7fc07fc0u; } *(u32x2v*)(xn + off + bj * HALF + n * 16) = w; }
                asm volatile("" ::: "memory"); }
    }
};

template <class Epi, class Sched, bool STAMP = false>
__device__ __forceinline__ void gemm_phase(PG8_LAS unsigned char* lds, const Gemm g, const Sched& S, const Epi& E, unsigned long long* stamps) {
    const int tid = threadIdx.x, wid = __builtin_amdgcn_readfirstlane(tid >> 6), lane = tid & 63, wr = wid >> 2, wc = wid & 3, fr = lane & 15, fq = lane >> 4;
    const int K = g.K, nt = K / BK;
    int ts_lo = 0, ts_hi = 0, nts = 0; const unsigned long long rt_entry = STAMP ? (unsigned long long)wall_clock64() : 0ull;
#define PG8_STAMP() do { if (STAMP && wid == 0 && nts < 64) { const unsigned long long _c = (unsigned long long)clock64(); \
        ts_lo = (lane == nts) ? (int)(unsigned)_c : ts_lo; ts_hi = (lane == nts) ? (int)(unsigned)(_c >> 32) : ts_hi; ++nts; } } while (0)
    PG8_STAMP();
    unsigned voffA[2], voffB[2];
#pragma unroll
    for (int i = 0; i < 2; ++i) { int R, C; stage_rc(tid * 16 + i * 8192, R, C); const int Rb = Epi::PERM ? ((R & ~31) + perm32(R & 31)) : R;
        voffA[i] = (unsigned)(R * K + C) * 2u; voffB[i] = (unsigned)(Rb * K + C) * 2u; }
    const size_t kstep = (size_t)(BK * 2);
    const size_t hstep = (size_t)HALF * K * 2;
    const size_t tstep = 2 * hstep;
    const unsigned ldsw = (unsigned)wid * 1024u;
    const int aoff = lds_byte(wr * 64 + fr, fq * 8), boff = lds_byte(wc * 32 + fr, fq * 8);
#define PG8_SA(b, h) (((b) * 2 + (h)) * HTB)
#define PG8_SB(b, h) ((4 + (b) * 2 + (h)) * HTB)
#define PG8_STAGE(bufoff, gbase, voff) do { _Pragma("unroll") for (int _i = 0; _i < 2; ++_i) \
        __builtin_amdgcn_global_load_lds((const unsigned*)((const char*)(gbase) + (voff)[_i]), (PG8_LAS unsigned*)(lds + (bufoff) + ldsw + _i * 8192), 16, 0, 0); } while (0)
#define PG8_LDA(dst, b, h) do { _Pragma("unroll") for (int m = 0; m < 4; ++m) _Pragma("unroll") for (int k = 0; k < 2; ++k) dst[m][k] = *(const PG8_LAS bf16x8*)(lds + PG8_SA(b, h) + aoff + m * 2048 + k * 1024); } while (0)
#define PG8_LDB(dst, b, h) do { _Pragma("unroll") for (int n = 0; n < 2; ++n) _Pragma("unroll") for (int k = 0; k < 2; ++k) dst[n][k] = *(const PG8_LAS bf16x8*)(lds + PG8_SB(b, h) + boff + n * 2048 + k * 1024); } while (0)
#define PG8_MMA(ai, bj, At, Bt) do { __builtin_amdgcn_s_setprio(1); _Pragma("unroll") for (int m = 0; m < 4; ++m) _Pragma("unroll") for (int n = 0; n < 2; ++n) _Pragma("unroll") for (int k = 0; k < 2; ++k) \
        acc[ai][bj][m][n] = __builtin_amdgcn_mfma_f32_16x16x32_bf16(Bt[n][k], At[m][k], acc[ai][bj][m][n], 0, 0, 0); __builtin_amdgcn_s_setprio(0); } while (0)
#define PG8_WAIT_V(n) asm volatile("s_waitcnt vmcnt(" #n ")" ::: "memory")
#define PG8_WAIT_L(n) asm volatile("s_waitcnt lgkmcnt(" #n ")" ::: "memory")
#define PG8_BAR __builtin_amdgcn_s_barrier()
#define PG8_SCHED __builtin_amdgcn_sched_barrier(0)
    Unit cur, nxt; int ui = 0;
    if (!S.next(0, cur)) return;
    f32x4 acc[2][2][4][2];
#pragma unroll
    for (int a = 0; a < 2; ++a)
#pragma unroll
        for (int b = 0; b < 2; ++b)
#pragma unroll
            for (int m = 0; m < 4; ++m)
#pragma unroll
                for (int n = 0; n < 2; ++n) acc[a][b][m][n] = (f32x4){0.f, 0.f, 0.f, 0.f};
    bf16x8 At[4][2], B0[2][2], B1[2][2];
    const char* cA = (const char*)g.A + (size_t)cur.pm * tstep; const char* cB = (const char*)g.Bt + (size_t)cur.pn * tstep;
    S.a_ready(cur);
    PG8_STAGE(PG8_SB(0, 0), cB, voffB); PG8_STAGE(PG8_SA(0, 0), cA, voffA); PG8_STAGE(PG8_SB(0, 1), cB + hstep, voffB); PG8_STAGE(PG8_SA(0, 1), cA + hstep, voffA);
    if (wr == 1) PG8_BAR;
    PG8_WAIT_V(4); PG8_BAR;
    PG8_STAGE(PG8_SB(1, 0), cB + kstep, voffB); PG8_STAGE(PG8_SA(1, 0), cA + kstep, voffA); PG8_STAGE(PG8_SB(1, 1), cB + hstep + kstep, voffB);
    PG8_WAIT_V(6); PG8_BAR;
    PG8_STAMP();
    for (;;) {
        const bool has_next = S.next(ui + 1, nxt);
        const char* nA = has_next ? (const char*)g.A + (size_t)nxt.pm * tstep : cA; const char* nB = has_next ? (const char*)g.Bt + (size_t)nxt.pn * tstep : cB;
        for (int t = 0; t < nt; t += 2) {
            const bool last = (t == nt - 2);
            const char* a1 = cA + (size_t)(t + 1) * kstep;
            const char* a2 = last ? nA : cA + (size_t)(t + 2) * kstep; const char* b2 = last ? nB : cB + (size_t)(t + 2) * kstep;
            const char* a3 = a2 + kstep; const char* b3 = b2 + kstep;
            if (last && has_next) S.a_ready(nxt);
            PG8_LDB(B0, 0, 0); PG8_SCHED; PG8_LDA(At, 0, 0); PG8_STAGE(PG8_SA(1, 1), a1 + hstep, voffA);
            PG8_WAIT_L(8); PG8_BAR; PG8_WAIT_L(0); PG8_MMA(0, 0, At, B0); PG8_BAR; PG8_SCHED;
            PG8_LDB(B1, 0, 1); PG8_STAGE(PG8_SB(0, 0), b2, voffB);
            PG8_BAR; PG8_WAIT_L(0); PG8_MMA(0, 1, At, B1); PG8_BAR;
            PG8_LDA(At, 0, 1); PG8_STAGE(PG8_SA(0, 0), a2, voffA);
            PG8_BAR; PG8_WAIT_L(0); PG8_MMA(1, 0, At, B0); PG8_BAR; PG8_SCHED;
            PG8_STAGE(PG8_SB(0, 1), b2 + hstep, voffB);
            PG8_WAIT_V(6); PG8_BAR; PG8_MMA(1, 1, At, B1); PG8_BAR;
            PG8_LDB(B0, 1, 0); PG8_SCHED; PG8_LDA(At, 1, 0); PG8_STAGE(PG8_SA(0, 1), a2 + hstep, voffA);
            PG8_WAIT_L(8); PG8_BAR; PG8_WAIT_L(0); PG8_MMA(0, 0, At, B0); PG8_BAR; PG8_SCHED;
            PG8_LDB(B1, 1, 1); PG8_STAGE(PG8_SB(1, 0), b3, voffB);
            PG8_BAR; PG8_WAIT_L(0); PG8_MMA(0, 1, At, B1); PG8_BAR;
            PG8_LDA(At, 1, 1); PG8_STAGE(PG8_SA(1, 0), a3, voffA);
            PG8_BAR; PG8_WAIT_L(0); PG8_MMA(1, 0, At, B0); PG8_BAR; PG8_SCHED;
            PG8_STAGE(PG8_SB(1, 1), b3 + hstep, voffB);
            PG8_WAIT_V(6); PG8_BAR; PG8_MMA(1, 1, At, B1); PG8_BAR;
        }
        PG8_STAMP();
        if constexpr (!Epi::AFTER_DRAIN) { E(acc, cur, wr, wc, fr, fq); S.done(cur); }
        PG8_STAMP();
        if (!has_next) break;
#pragma unroll
        for (int a = 0; a < 2; ++a)
#pragma unroll
            for (int b = 0; b < 2; ++b)
#pragma unroll
                for (int m = 0; m < 4; ++m)
#pragma unroll
                    for (int n = 0; n < 2; ++n) acc[a][b][m][n] = (f32x4){0.f, 0.f, 0.f, 0.f};
        cur = nxt; cA = nA; cB = nB; ++ui;
    }
    PG8_WAIT_V(0);
    if (wr == 0) PG8_BAR;
    PG8_BAR;
    if constexpr (Epi::AFTER_DRAIN) { E.fused(acc, cur, wr, wc, fr, fq, lds, wid, lane); S.done(cur); }
    PG8_STAMP();
    if (STAMP && wid == 0) { stamps[lane] = lane < nts ? (((unsigned long long)(unsigned)ts_hi << 32) | (unsigned)ts_lo) : 0ull;
        if (lane == 62) stamps[62] = rt_entry; if (lane == 63) stamps[63] = (unsigned long long)wall_clock64(); }
#undef PG8_STAMP
#undef PG8_SA
#undef PG8_SB
#undef PG8_STAGE
#undef PG8_LDA
#undef PG8_LDB
#undef PG8_MMA
#undef PG8_WAIT_V
#undef PG8_WAIT_L
#undef PG8_BAR
#undef PG8_SCHED
}
}

constexpr int D = 1024, NB = 16, S = 2048, T = NB * S;
constexpr int NCOL = 2840, NPAD = 3072;
constexpr int C_Q = 0, C_KC = 512, C_VC = 640, C_KS = 768, C_VS = 896, C_KW = 1024, C_VW = 1152, C_GT = 1280, C_CB = 1304, C_CC = 1816, C_CH = 2328;
constexpr int NCMP = 127;
constexpr int NEXP = 16384;
constexpr float EPS = 1e-6f;
constexpr int NTHREADS = 512, NWAVES = 8;

constexpr size_t al256(size_t x) { return (x + 255) & ~(size_t)255; }
constexpr size_t WS_CTL   = 0;                                   constexpr size_t CTL_BYTES = 65536;
constexpr size_t WS_MOD   = WS_CTL + CTL_BYTES;
constexpr size_t WS_WIN   = al256(WS_MOD + (size_t)16 * 6144 * 4);
constexpr size_t WS_WOUT  = al256(WS_WIN + (size_t)NPAD * D * 2);
constexpr size_t WS_WQ    = al256(WS_WOUT + (size_t)D * D * 2);
constexpr size_t WS_KEYS  = al256(WS_WQ + (size_t)D * D * 2);
constexpr size_t WS_U8S   = al256(WS_KEYS + (size_t)16 * 128 * 64 * 2);
constexpr size_t WS_V8S   = al256(WS_U8S + (size_t)NEXP * D);
constexpr size_t WS_X8S   = al256(WS_V8S + (size_t)NEXP * D);
constexpr size_t WS_SU    = al256(WS_X8S + (size_t)T * D);
constexpr size_t WS_SV    = al256(WS_SU + (size_t)NEXP * 4);
constexpr size_t WS_SX    = al256(WS_SV + (size_t)NEXP * 4);
constexpr size_t WS_W1T   = al256(WS_SX + (size_t)T * 4);
constexpr size_t WS_W2T   = al256(WS_W1T + (size_t)2 * 64 * 2048 * 2);
constexpr size_t WS_PEC   = al256(WS_W2T + (size_t)2 * 64 * 64 * 2);
constexpr size_t WS_KC    = al256(WS_PEC + (size_t)2 * 64 * 4);
constexpr size_t WS_VC    = al256(WS_KC + (size_t)16 * 2 * 128 * 64 * 2);
constexpr size_t WS_H     = al256(WS_VC + (size_t)16 * 2 * 128 * 64 * 2);
constexpr size_t WS_CQ8   = WS_H;
constexpr size_t WS_CMAX  = WS_H + (size_t)32 * 1024 * 1024;
constexpr size_t WS_SSQP  = WS_H + (size_t)33 * 1024 * 1024;
constexpr size_t WS_OATT  = al256(WS_H + (size_t)T * D * 2);
constexpr size_t WS_PROJ  = al256(WS_OATT + (size_t)T * 512 * 2);
constexpr size_t WS_QP    = WS_PROJ;
constexpr size_t WS_PART  = WS_PROJ;
constexpr size_t WS_X2    = WS_PROJ;
constexpr size_t WS_E16   = WS_PROJ + (size_t)160 * 1024 * 1024;
constexpr size_t WS_EW    = WS_E16 + (size_t)T * 128 * 4;
constexpr size_t WS_END   = al256(WS_PROJ + (size_t)T * NPAD * 2);
static_assert(WS_EW + (size_t)T * 128 * 4 <= WS_END, "alias region");
static_assert((size_t)8 * T * 128 * 4 <= (size_t)160 * 1024 * 1024, "PART fits under EIDX");
constexpr int CTL_CTR_A = 16384, CTL_CTR_B = 16384 + 8 * 256;

constexpr int LDS_STAGE = 147456;
constexpr int LDS_MISC_OFF = LDS_STAGE;
constexpr int LDS_BYTES = LDS_STAGE + 256;

typedef unsigned short bf16_t;
typedef short bf16x8 __attribute__((ext_vector_type(8)));
typedef short s16x4 __attribute__((ext_vector_type(4)));
typedef float f32x4 __attribute__((ext_vector_type(4)));
typedef unsigned u32x4v __attribute__((ext_vector_type(4)));
__device__ __forceinline__ float bf2f(bf16_t b) { return __uint_as_float(((unsigned)b) << 16); }
__device__ __forceinline__ bf16_t f2bf(float f) { unsigned u = __float_as_uint(f); u += 0x7FFFu + ((u >> 16) & 1u); return (bf16_t)(u >> 16); }
__device__ __forceinline__ float bflo(unsigned w) { return __uint_as_float(w << 16); }
__device__ __forceinline__ float bfhi(unsigned w) { return __uint_as_float(w & 0xFFFF0000u); }
__device__ __forceinline__ unsigned pack2(float lo, float hi) { return (unsigned)f2bf(lo) | ((unsigned)f2bf(hi) << 16); }
__device__ __forceinline__ float gelu_tanh(float x) { const float u = 0.7978845608028654f * (x + 0.044715f * x * x * x); return 0.5f * x * (1.0f + tanhf(u)); }
__device__ __forceinline__ float sigmoidf_(float x) { return 1.0f / (1.0f + __expf(-x)); }
__device__ __forceinline__ float wave_sum(float v) {
#pragma unroll
    for (int o = 32; o >= 1; o >>= 1) v += __shfl_xor(v, o);
    return v; }
__device__ __forceinline__ float wave_max(float v) {
#pragma unroll
    for (int o = 32; o >= 1; o >>= 1) v = fmaxf(v, __shfl_xor(v, o));
    return v; }
__device__ __forceinline__ void lds_wave_sync() { asm volatile("s_waitcnt lgkmcnt(0)" ::: "memory"); }
#ifdef PROBE_STAMP
#define STAMP_DECL unsigned long long tprev_ = 0ull; const bool dbg_ = (PROBE_PHASE == 12 || blockIdx.x == PROBE_BLOCK) && (threadIdx.x == 0);
#define STAMP_START() do { if (dbg_) tprev_ = __builtin_amdgcn_s_memtime(); } while (0)
#define STAMP(k) do { if (dbg_) { const unsigned long long tn_ = __builtin_amdgcn_s_memtime(); volatile LAS unsigned* c_ = (volatile LAS unsigned*)(F_lds_ + LDS_MISC_OFF + 128); c_[k] += (unsigned)(tn_ - tprev_); tprev_ = tn_; } } while (0)
#define STAMP_COUNT(k) do { if (dbg_) { volatile LAS unsigned* c_ = (volatile LAS unsigned*)(F_lds_ + LDS_MISC_OFF + 128); c_[k] += 1u; } } while (0)
#else
#define STAMP_DECL
#define STAMP_START() do {} while (0)
#define STAMP(k) do {} while (0)
#define STAMP_COUNT(k) do {} while (0)
#endif
#ifndef PROBE_BLOCK
#define PROBE_BLOCK 0
#endif
#ifndef PROBE_PHASE
#define PROBE_PHASE 4
#endif

__device__ __forceinline__ int rel_bucket(int dist) {
    const int n = dist > 0 ? dist : 0;
    if (n < 16) return n;
    const float lr = logf((float)n / 16.0f) / 2.0794415416798357f;
    const int large = 16 + (int)(lr * 16.0f);
    return large < 31 ? large : 31;
}

struct Frame {
    const float* in[23]; float* out; unsigned char* ws;
    LAS unsigned char* lds; int tid, lane, wave, G;
};


typedef int i32x4v __attribute__((ext_vector_type(4)));
constexpr int PEER_CHUNK_TOK = 128, PEER_NCHUNK = T / PEER_CHUNK_TOK;

__device__ __forceinline__ void quant_row_sliced(const float* row, unsigned char* dst8  , size_t nrows, size_t r, float* scale_out, int bias, int lane) {
    float4 v[4]; float am = 0.f;
#pragma unroll
    for (int i = 0; i < 4; ++i) { v[i] = *(const float4*)(row + (lane + 64 * i) * 4); am = fmaxf(am, fmaxf(fmaxf(fabsf(v[i].x), fabsf(v[i].y)), fmaxf(fabsf(v[i].z), fabsf(v[i].w)))); }
    am = wave_max(am); const float inv = am > 0.f ? 127.0f / am : 0.f;
    if (lane == 0) *scale_out = am > 0.f ? am / 127.0f : 0.f;
#pragma unroll
    for (int i = 0; i < 4; ++i) { const int col = (lane + 64 * i) * 4; const int sl = col >> 7, off = col & 127;
        const int q0 = (int)rintf(v[i].x * inv) + bias, q1 = (int)rintf(v[i].y * inv) + bias, q2 = (int)rintf(v[i].z * inv) + bias, q3 = (int)rintf(v[i].w * inv) + bias;
        *(unsigned*)(dst8 + ((size_t)sl * nrows + r) * 128 + off) = (unsigned)(q0 & 0xFF) | ((unsigned)(q1 & 0xFF) << 8) | ((unsigned)(q2 & 0xFF) << 16) | ((unsigned)(q3 & 0xFF) << 24); }
}

constexpr int PEER_NGRP = T / 16;
__device__ __forceinline__ int grab_item(unsigned* ctr, int slice, int lane) {
    unsigned v = 0u; if (lane == 0) v = __hip_atomic_fetch_add(ctr + slice * 64, 1u, __ATOMIC_RELAXED, __HIP_MEMORY_SCOPE_AGENT);
    return (int)__builtin_amdgcn_readfirstlane(v);
}
__device__ __forceinline__ void gather_rows16(u32x4v (&vv)[16], const unsigned char* base, const LAS unsigned* le) {
    const u32x4v e0 = *(const LAS u32x4v*)le, e1 = *(const LAS u32x4v*)(le + 4);
#pragma unroll
    for (int ld = 0; ld < 16; ++ld) { const unsigned w = ld < 8 ? e0[ld >> 1] : e1[(ld - 8) >> 1]; const unsigned e = (ld & 1) ? (w >> 16) : (w & 0xFFFFu);
        vv[ld] = *(const u32x4v*)(base + (size_t)e * 128); }
}
__device__ __forceinline__ void udot_item(const u32x4v (&uv)[16], const i32x4v xq, int* part_row  , int c) {
    i32x4v res[4];
#pragma unroll
    for (int ld = 0; ld < 16; ++ld) { int p = __builtin_amdgcn_sdot4((int)uv[ld][0], xq[0], 0, false); p = __builtin_amdgcn_sdot4((int)uv[ld][1], xq[1], p, false);
        p = __builtin_amdgcn_sdot4((int)uv[ld][2], xq[2], p, false); p = __builtin_amdgcn_sdot4((int)uv[ld][3], xq[3], p, false);
        p += __shfl_xor(p, 1); p += __shfl_xor(p, 2); p += __shfl_xor(p, 4); res[ld >> 2][ld & 3] = p; }
    if (c == 0) {
#pragma unroll
        for (int q = 0; q < 4; ++q) *(i32x4v*)(part_row + 4 * q) = res[q]; }
}
__device__ __forceinline__ void p10a_udots(const Frame& F) {
    const unsigned char* U8S = F.ws + WS_U8S; const unsigned char* X8S = F.ws + WS_X8S; const unsigned short* E16 = (const unsigned short*)(F.ws + WS_E16); int* PART = (int*)(F.ws + WS_PART);
    unsigned* ctr = (unsigned*)(F.ws + WS_CTL + CTL_CTR_A);
    const int lane = F.lane, j = lane >> 3, c = lane & 7; const int xcc = (int)(xb_xcc_id() & 7u);
    LAS unsigned char* wl = F.lds + F.wave * 8192;
    const LAS unsigned* le = (const LAS unsigned*)wl + 8 * j;
    for (int so = 0; so < 8; ++so) { const int x = (xcc + so) & 7;
        const unsigned char* ub = U8S + (size_t)x * NEXP * 128 + c * 16;
        int nxt = grab_item(ctr, x, lane);
        for (;;) { const int cur = nxt; if (cur >= PEER_NGRP) break;
            nxt = grab_item(ctr, x, lane);
            const int t0 = cur * 16;
            { const u32x4v* src = (const u32x4v*)(E16 + (size_t)t0 * 128);
#pragma unroll
                for (int i = 0; i < 4; ++i) *(LAS u32x4v*)(wl + (lane + 64 * i) * 16) = src[lane + 64 * i]; }
            lds_wave_sync();
            const unsigned char* xb = X8S + ((size_t)x * T + t0) * 128 + c * 16; int* pr = PART + ((size_t)x * T + t0) * 128 + 16 * j;
            u32x4v va[16], vb[16];
            gather_rows16(va, ub, le);
#pragma unroll 1
            for (int tt = 0; tt < 16; tt += 2) {
                const i32x4v xqa = *(const i32x4v*)(xb + (size_t)tt * 128), xqb = *(const i32x4v*)(xb + (size_t)(tt + 1) * 128);
                gather_rows16(vb, ub, le + (tt + 1) * 64);
                udot_item(va, xqa, pr + (size_t)tt * 128, c);
                if (tt + 2 < 16) gather_rows16(va, ub, le + (tt + 2) * 64);
                udot_item(vb, xqb, pr + (size_t)(tt + 1) * 128, c);
            }
            lds_wave_sync();
        }
    }
}

__device__ __forceinline__ void p10b_coef(const Frame& F) {
    const unsigned short* E16 = (const unsigned short*)(F.ws + WS_E16); const float* EW = (const float*)(F.ws + WS_EW); const int* PART = (const int*)(F.ws + WS_PART);
    const float* SU = (const float*)(F.ws + WS_SU); const float* SV = (const float*)(F.ws + WS_SV); const float* SX = (const float*)(F.ws + WS_SX);
    signed char* CQ8 = (signed char*)(F.ws + WS_CQ8); float* CMAX = (float*)(F.ws + WS_CMAX);
    const int gw = blockIdx.x * NWAVES + F.wave, nw = F.G * NWAVES, lane = F.lane;
    for (int t = gw; t < T; t += nw) { const float sx = SX[t]; float cs[2]; float am = 0.f;
#pragma unroll
        for (int hh = 0; hh < 2; ++hh) { const int i = lane + 64 * hh; int s = 0;
#pragma unroll
            for (int x = 0; x < 8; ++x) s += PART[((size_t)x * T + t) * 128 + i];
            const int e = E16[(size_t)t * 128 + i]; const float dot = (float)s * sx * SU[e];
            cs[hh] = EW[(size_t)t * 128 + i] * gelu_tanh(dot) * SV[e]; am = fmaxf(am, fabsf(cs[hh])); }
        am = wave_max(am); const float inv = am > 0.f ? 127.0f / am : 0.f;
#pragma unroll
        for (int hh = 0; hh < 2; ++hh) CQ8[(size_t)t * 128 + lane + 64 * hh] = (signed char)(int)rintf(cs[hh] * inv);
        if (lane == 0) CMAX[t] = am > 0.f ? am / 127.0f : 0.f; }
}

struct VsumPre { float2 x1, gt; float sc; };
__device__ __forceinline__ void vsum_item(const u32x4v (&vv)[16], const LAS unsigned* lq  , const VsumPre& pre, float* x2p, float* ssqp, int lane) {
    const u32x4v cq = *(const LAS u32x4v*)lq;
    int acc[16];
#pragma unroll
    for (int k = 0; k < 16; ++k) acc[k] = 0;
#pragma unroll
    for (int g = 0; g < 4; ++g) { const int cw = (int)cq[g];
#pragma unroll
        for (int w = 0; w < 4; ++w) { const unsigned r0 = vv[4 * g][w], r1 = vv[4 * g + 1][w], r2 = vv[4 * g + 2][w], r3 = vv[4 * g + 3][w];
            const unsigned t0 = __builtin_amdgcn_perm(r1, r0, 0x05010400u), t1 = __builtin_amdgcn_perm(r1, r0, 0x07030602u), t2 = __builtin_amdgcn_perm(r3, r2, 0x05010400u), t3 = __builtin_amdgcn_perm(r3, r2, 0x07030602u);
            const unsigned c0 = __builtin_amdgcn_perm(t2, t0, 0x05040100u), c1 = __builtin_amdgcn_perm(t2, t0, 0x07060302u), c2 = __builtin_amdgcn_perm(t3, t1, 0x05040100u), c3 = __builtin_amdgcn_perm(t3, t1, 0x07060302u);
            acc[4 * w + 0] = __builtin_amdgcn_sdot4((int)c0, cw, acc[4 * w + 0], false); acc[4 * w + 1] = __builtin_amdgcn_sdot4((int)c1, cw, acc[4 * w + 1], false);
            acc[4 * w + 2] = __builtin_amdgcn_sdot4((int)c2, cw, acc[4 * w + 2], false); acc[4 * w + 3] = __builtin_amdgcn_sdot4((int)c3, cw, acc[4 * w + 3], false); } }
    int a8[8], a4[4], a2[2];
    { const bool hi = (lane & 32) != 0;
#pragma unroll
        for (int k = 0; k < 8; ++k) { const int snd = hi ? acc[k] : acc[k + 8]; const int rcv = __shfl_xor(snd, 32); a8[k] = (hi ? acc[k + 8] : acc[k]) + rcv; } }
    { const bool hi = (lane & 16) != 0;
#pragma unroll
        for (int k = 0; k < 4; ++k) { const int snd = hi ? a8[k] : a8[k + 4]; const int rcv = __shfl_xor(snd, 16); a4[k] = (hi ? a8[k + 4] : a8[k]) + rcv; } }
    { const bool hi = (lane & 8) != 0;
#pragma unroll
        for (int k = 0; k < 2; ++k) { const int snd = hi ? a4[k] : a4[k + 2]; const int rcv = __shfl_xor(snd, 8); a2[k] = (hi ? a4[k + 2] : a4[k]) + rcv; } }
    const float y0 = pre.x1.x + pre.gt.x * ((float)a2[0] * pre.sc), y1 = pre.x1.y + pre.gt.y * ((float)a2[1] * pre.sc);
    *(float2*)x2p = make_float2(y0, y1);
    const float ss = wave_sum(y0 * y0 + y1 * y1); if (lane == 0) *ssqp = ss;
}
__device__ __forceinline__ void p10c_vsum(const Frame& F) {
    const unsigned char* V8S = F.ws + WS_V8S; const unsigned short* E16 = (const unsigned short*)(F.ws + WS_E16); const signed char* CQ8 = (const signed char*)(F.ws + WS_CQ8); const float* CMAX = (const float*)(F.ws + WS_CMAX);
    const float* MOD = (const float*)(F.ws + WS_MOD); float* SSQP = (float*)(F.ws + WS_SSQP); const float* x1 = F.out; float* X2 = (float*)(F.ws + WS_X2);
    unsigned* ctr = (unsigned*)(F.ws + WS_CTL + CTL_CTR_B);
    const int lane = F.lane, j = lane >> 3, c = lane & 7; const int xcc = (int)(xb_xcc_id() & 7u);
    const int ocol = 16 * c + 8 * ((lane >> 5) & 1) + 4 * ((lane >> 4) & 1) + 2 * ((lane >> 3) & 1);
    LAS unsigned char* wl = F.lds + F.wave * 8192;
    const LAS unsigned* le = (const LAS unsigned*)wl + 8 * j; const LAS unsigned* lq = (const LAS unsigned*)(wl + 4096) + 4 * j;
    for (int so = 0; so < 8; ++so) { const int x = (xcc + so) & 7;
        const unsigned char* vb = V8S + (size_t)x * NEXP * 128 + c * 16;
        const int col = x * 128 + ocol;
        int nxt = grab_item(ctr, x, lane);
        for (;;) { const int cur = nxt; if (cur >= PEER_NGRP) break;
            nxt = grab_item(ctr, x, lane);
            const int t0 = cur * 16; const int b = t0 / S;
            { const u32x4v* src = (const u32x4v*)(E16 + (size_t)t0 * 128); const u32x4v* srq = (const u32x4v*)(CQ8 + (size_t)t0 * 128);
#pragma unroll
                for (int i = 0; i < 4; ++i) *(LAS u32x4v*)(wl + (lane + 64 * i) * 16) = src[lane + 64 * i];
#pragma unroll
                for (int i = 0; i < 2; ++i) *(LAS u32x4v*)(wl + 4096 + (lane + 64 * i) * 16) = srq[lane + 64 * i]; }
            lds_wave_sync();
            const float2 gt = *(const float2*)(MOD + b * 6144 + 5120 + col);
            u32x4v va[16], vbb[16];
            gather_rows16(va, vb, le);
#pragma unroll 1
            for (int tt = 0; tt < 16; tt += 2) {
                { VsumPre pa; pa.gt = gt; pa.x1 = *(const float2*)(x1 + (size_t)(t0 + tt) * D + col); pa.sc = CMAX[t0 + tt];
                  gather_rows16(vbb, vb, le + (tt + 1) * 64);
                  vsum_item(va, lq + tt * 32, pa, X2 + (size_t)(t0 + tt) * D + col, SSQP + (size_t)(t0 + tt) * 8 + x, lane); }
                { VsumPre pb; pb.gt = gt; pb.x1 = *(const float2*)(x1 + (size_t)(t0 + tt + 1) * D + col); pb.sc = CMAX[t0 + tt + 1];
                  if (tt + 2 < 16) gather_rows16(va, vb, le + (tt + 2) * 64);
                  vsum_item(vbb, lq + (tt + 1) * 32, pb, X2 + (size_t)(t0 + tt + 1) * D + col, SSQP + (size_t)(t0 + tt + 1) * 8 + x, lane); }
            }
            lds_wave_sync();
        }
    }
}

__device__ __forceinline__ void p10d_final(const Frame& F) {
    const float* SSQP = (const float*)(F.ws + WS_SSQP); const float* gfin = F.in[22]; float* out = F.out; const float* X2 = (const float*)(F.ws + WS_X2);
    const int gw = blockIdx.x * NWAVES + F.wave, nw = F.G * NWAVES, lane = F.lane;
    for (int t = gw; t < T; t += nw) {
        float ss = 0.f;
#pragma unroll
        for (int x = 0; x < 8; ++x) ss += SSQP[(size_t)t * 8 + x];
#ifdef PROBE_STAMP
        const unsigned* dg = (const unsigned*)(F.ws + WS_CTL + 32768); const float pnum = (float)dg[PROBE_STAMP]; const float pden = PROBE_DEN >= 0 ? (float)dg[PROBE_DEN >= 0 ? PROBE_DEN : 0] : (float)PROBE_ABS;
        const float rstd = rsqrtf(ss * (1.0f / D) + EPS) * (1.0f + 0.5f * pnum / pden);
#else
        const float rstd = rsqrtf(ss * (1.0f / D) + EPS);
#endif
#pragma unroll
        for (int i = 0; i < 4; ++i) { const int col = (lane + 64 * i) * 4; const float4 v = *(const float4*)(X2 + (size_t)t * D + col), gg = *(const float4*)(gfin + col);
            *(float4*)(out + (size_t)t * D + col) = make_float4(v.x * rstd * gg.x, v.y * rstd * gg.y, v.z * rstd * gg.z, v.w * rstd * gg.w); }
    }
}

__device__ __forceinline__ void transpose_tile(const Frame& F, const float* src, int srcK, int srcN, bf16_t* dst, int dstK, int kt, int nt) {
    LAS float* tile = (LAS float*)F.lds;
    const int k0 = kt * 64, n0 = nt * 64;
    for (int i = F.tid; i < 4096; i += NTHREADS) { const int r = i >> 6, c = i & 63; const int k = k0 + r, n = n0 + c;
        tile[r * 65 + c] = (k < srcK && n < srcN) ? src[(size_t)k * srcN + n] : 0.0f; }
    __syncthreads();
    for (int i = F.tid; i < 4096; i += NTHREADS) { const int r = i >> 6, c = i & 63;
        dst[(size_t)(n0 + r) * dstK + k0 + c] = f2bf(tile[c * 65 + r]); }
    __syncthreads();
}
__device__ __forceinline__ void p0_prologue(const Frame& F, int item_lo = 0, int item_hi = 1 << 30) {
    const float* c = F.in[1]; const float* w_mod = F.in[4]; const float* b_mod = F.in[5];
    float* MOD = (float*)(F.ws + WS_MOD);
    constexpr int I_MOD = 96, I_WIN = 16 * 48, I_WOUT = 256, I_WQ = 256, I_U = 256, I_V = 256, I_KEYS = 2, I_CMP = 32 + 32 + 1 + 1 + 2;
    constexpr int O_WIN = I_MOD, O_WOUT = O_WIN + I_WIN, O_WQ = O_WOUT + I_WOUT, O_U = O_WQ + I_WQ, O_V = O_U + I_U, O_KEYS = O_V + I_V, O_CMP = O_KEYS + I_KEYS, N_ITEMS = O_CMP + I_CMP;
    for (int it = item_lo + blockIdx.x; it < N_ITEMS && it < item_hi; it += F.G) {
        if (it < O_WIN) {
            LAS float* sl = (LAS float*)F.lds; LAS float* red = (LAS float*)(F.lds + 65536);
            for (int q = F.tid; q < 16 * D; q += NTHREADS) { const float cv = c[q]; sl[q] = cv / (1.0f + __expf(-cv)); }
            __syncthreads();
            const int kg = F.tid >> 6, cl = F.tid & 63, j0 = it * 64;
            float acc[16];
#pragma unroll
            for (int bb = 0; bb < 16; ++bb) acc[bb] = 0.f;
            const float* wp = w_mod + (size_t)(kg * 128) * 6144 + j0 + cl;
#pragma unroll 4
            for (int kk = 0; kk < 128; ++kk) { const float w = wp[(size_t)kk * 6144]; const int k = kg * 128 + kk;
#pragma unroll
                for (int bb = 0; bb < 16; ++bb) acc[bb] += sl[bb * D + k] * w; }
#pragma unroll
            for (int bb = 0; bb < 16; ++bb) red[(kg * 16 + bb) * 64 + cl] = acc[bb];
            __syncthreads();
#pragma unroll
            for (int q = 0; q < 2; ++q) { const int o = F.tid + 512 * q; const int bb = o >> 6, cc = o & 63; float s = b_mod[j0 + cc];
#pragma unroll
                for (int g8 = 0; g8 < 8; ++g8) s += red[(g8 * 16 + bb) * 64 + cc];
                MOD[bb * 6144 + j0 + cc] = s; }
            __syncthreads();
        } else if (it < O_WOUT) { const int i = it - O_WIN; transpose_tile(F, F.in[6], D, NCOL, (bf16_t*)(F.ws + WS_WIN), D, i % 16, i / 16); }
        else if (it < O_WQ) { const int i = it - O_WOUT; transpose_tile(F, F.in[16], D, D, (bf16_t*)(F.ws + WS_WOUT), D, i % 16, i / 16); }
        else if (it < O_U) { const int i = it - O_WQ; transpose_tile(F, F.in[17], D, D, (bf16_t*)(F.ws + WS_WQ), D, i % 16, i / 16); }
        else if (it < O_KEYS) {
            const bool isv = it >= O_V; const int i = isv ? it - O_V : it - O_U;
            for (int rr = 0; rr < 8; ++rr) { const size_t r = (size_t)i * 64 + rr * 8 + F.wave;
                quant_row_sliced((isv ? F.in[20] : F.in[19]) + r * D, F.ws + (isv ? WS_V8S : WS_U8S), NEXP, r, (float*)(F.ws + (isv ? WS_SV : WS_SU)) + r, 0, F.lane); }
        } else if (it >= O_CMP) {
            const int i = it - O_CMP;
            if (i < 64) { const int kv = i >> 5; transpose_tile(F, kv ? F.in[11] : F.in[9], 2048, 64, (bf16_t*)(F.ws + WS_W1T) + (size_t)kv * 64 * 2048, 2048, i & 31, 0); }
            else if (i < 66) { const int kv = i - 64; transpose_tile(F, kv ? F.in[12] : F.in[10], 64, 64, (bf16_t*)(F.ws + WS_W2T) + (size_t)kv * 64 * 64, 64, 0, 0); }
            else { const int kv = i - 66; const float* pe = kv ? F.in[8] : F.in[7]; const float* w1 = kv ? F.in[11] : F.in[9];
                LAS float* red = (LAS float*)F.lds; const int jj = F.tid & 63, kg = F.tid >> 6; float a = 0.f;
#pragma unroll 8
                for (int kk = 0; kk < 256; ++kk) { const int k = kg * 256 + kk; a += pe[k] * w1[(size_t)k * 64 + jj]; }
                red[kg * 64 + jj] = a; __syncthreads();
                if (F.tid < 64) { float s = 0.f;
#pragma unroll
                    for (int g8 = 0; g8 < 8; ++g8) s += red[g8 * 64 + F.tid];
                    ((float*)(F.ws + WS_PEC))[kv * 64 + F.tid] = s; }
                __syncthreads(); }
        } else {
            const int i = it - O_KEYS; const float4* src = (const float4*)F.in[18] + (size_t)i * 16384; uint2* dst = (uint2*)(F.ws + WS_KEYS) + (size_t)i * 16384;
            for (int q = F.tid; q < 16384; q += NTHREADS) { const float4 v = src[q]; dst[q] = make_uint2(pack2(v.x, v.y), pack2(v.z, v.w)); }
        }
    }
}

__device__ __forceinline__ void norm_mod_rows(const Frame& F, const float* x, const float* g, int sh_off, int sc_off, bf16_t* dst) {
    const float* MOD = (const float*)(F.ws + WS_MOD);
    const int gw = blockIdx.x * NWAVES + F.wave, nw = F.G * NWAVES;
    for (int t = gw; t < T; t += nw) {
        const int b = t / S; const float4* xr = (const float4*)(x + (size_t)t * D);
        float4 v[4]; float ss = 0.f;
#pragma unroll
        for (int i = 0; i < 4; ++i) { v[i] = xr[F.lane + 64 * i]; ss += v[i].x * v[i].x + v[i].y * v[i].y + v[i].z * v[i].z + v[i].w * v[i].w; }
        ss = wave_sum(ss); const float rstd = rsqrtf(ss * (1.0f / D) + EPS);
#pragma unroll
        for (int i = 0; i < 4; ++i) { const int col = (F.lane + 64 * i) * 4;
            const float4 gg = *(const float4*)(g + col), sc = *(const float4*)(MOD + b * 6144 + sc_off + col), sh = *(const float4*)(MOD + b * 6144 + sh_off + col);
            const float o0 = v[i].x * rstd * gg.x * (1.f + sc.x) + sh.x, o1 = v[i].y * rstd * gg.y * (1.f + sc.y) + sh.y, o2 = v[i].z * rstd * gg.z * (1.f + sc.z) + sh.z, o3 = v[i].w * rstd * gg.w * (1.f + sc.w) + sh.w;
            *(uint2*)(dst + (size_t)t * D + col) = make_uint2(pack2(o0, o1), pack2(o2, o3)); }
    }
}

__device__ __forceinline__ void norm_mod_rows_q(const Frame& F, const float* x, const float* g, int sh_off, int sc_off, bf16_t* dst) {
    const float* MOD = (const float*)(F.ws + WS_MOD);
    const int gw = blockIdx.x * NWAVES + F.wave, nw = F.G * NWAVES;
    for (int t = gw; t < T; t += nw) {
        const int b = t / S; const float4* xr = (const float4*)(x + (size_t)t * D);
        float4 v[4]; float ss = 0.f;
#pragma unroll
        for (int i = 0; i < 4; ++i) { v[i] = xr[F.lane + 64 * i]; ss += v[i].x * v[i].x + v[i].y * v[i].y + v[i].z * v[i].z + v[i].w * v[i].w; }
        ss = wave_sum(ss); const float rstd = rsqrtf(ss * (1.0f / D) + EPS);
        float am = 0.f;
#pragma unroll
        for (int i = 0; i < 4; ++i) { const int col = (F.lane + 64 * i) * 4;
            const float4 gg = *(const float4*)(g + col), sc = *(const float4*)(MOD + b * 6144 + sc_off + col), sh = *(const float4*)(MOD + b * 6144 + sh_off + col);
            v[i].x = v[i].x * rstd * gg.x * (1.f + sc.x) + sh.x; v[i].y = v[i].y * rstd * gg.y * (1.f + sc.y) + sh.y; v[i].z = v[i].z * rstd * gg.z * (1.f + sc.z) + sh.z; v[i].w = v[i].w * rstd * gg.w * (1.f + sc.w) + sh.w;
            *(uint2*)(dst + (size_t)t * D + col) = make_uint2(pack2(v[i].x, v[i].y), pack2(v[i].z, v[i].w));
            am = fmaxf(am, fmaxf(fmaxf(fabsf(v[i].x), fabsf(v[i].y)), fmaxf(fabsf(v[i].z), fabsf(v[i].w)))); }
        am = wave_max(am); const float inv = am > 0.f ? 127.0f / am : 0.f;
        if (F.lane == 0) ((float*)(F.ws + WS_SX))[t] = am > 0.f ? am / 127.0f : 0.f;
#pragma unroll
        for (int i = 0; i < 4; ++i) { const int col = (F.lane + 64 * i) * 4; const int sl = col >> 7, off = col & 127;
            const int q0 = (int)rintf(v[i].x * inv), q1 = (int)rintf(v[i].y * inv), q2 = (int)rintf(v[i].z * inv), q3 = (int)rintf(v[i].w * inv);
            *(unsigned*)(F.ws + WS_X8S + ((size_t)sl * T + t) * 128 + off) = (unsigned)(q0 & 0xFF) | ((unsigned)(q1 & 0xFF) << 8) | ((unsigned)(q2 & 0xFF) << 16) | ((unsigned)(q3 & 0xFF) << 24); }
    }
}

__device__ __forceinline__ void p3_compress_naive(const Frame& F) {
    const bf16_t* PROJ = (const bf16_t*)(F.ws + WS_PROJ);
    LAS float* hid = (LAS float*)F.lds + F.wave * 64;
    const int gw = blockIdx.x * NWAVES + F.wave, nw = F.G * NWAVES;
    if (gw < 64) { bf16_t* dz = (bf16_t*)(F.ws + ((gw & 1) ? WS_VC : WS_KC)); dz[((size_t)(gw >> 1) * 128 + 127) * 64 + F.lane] = 0; }
    for (int u = gw; u < NB * NCMP * 2 * 2; u += nw) {
        const int kv = u & 1, g = (u >> 1) & 1, n = (u >> 2) % NCMP, b = (u >> 2) / NCMP;
        const float* pe = kv ? F.in[8] : F.in[7]; const float* w1 = kv ? F.in[11] : F.in[9]; const float* w2 = kv ? F.in[12] : F.in[10];
        const int cbase = (kv ? C_VC : C_KC) + g * 64;
        float acc = 0.f;
        for (int l = 0; l < 32; ++l) {
            const bf16_t* row = PROJ + (size_t)(b * S + 16 * n + l) * NPAD + cbase;
            for (int d = 0; d < 64; ++d) { const float a = bf2f(row[d]) + pe[l * 64 + d]; acc += a * w1[(size_t)(l * 64 + d) * 64 + F.lane]; }
        }
        hid[F.lane] = gelu_tanh(acc); lds_wave_sync();
        float o = 0.f;
        for (int j = 0; j < 64; ++j) o += hid[j] * w2[j * 64 + F.lane];
        bf16_t* dst = (bf16_t*)(F.ws + (kv ? WS_VC : WS_KC)); dst[((size_t)(b * 2 + g) * 128 + n) * 64 + F.lane] = f2bf(o);
        lds_wave_sync();
    }
}


__device__ __forceinline__ void p3_compress_mfma(const Frame& F) {
    const bf16_t* PROJ = (const bf16_t*)(F.ws + WS_PROJ);
    const int lane = F.lane, tid = F.tid, wave = F.wave, grp = lane >> 4, col = lane & 15;
    LAS float* red = (LAS float*)F.lds;
    LAS bf16_t* hid = (LAS bf16_t*)(F.lds + 32768);
    if (blockIdx.x * NWAVES + wave < 64) { const int gw = blockIdx.x * NWAVES + wave; bf16_t* dz = (bf16_t*)(F.ws + ((gw & 1) ? WS_VC : WS_KC)); dz[((size_t)(gw >> 1) * 128 + 127) * 64 + lane] = 0; }
    for (int u = blockIdx.x; u < NB * 2 * 2 * 8; u += F.G) {
        const int nt8 = u & 7, kv = (u >> 3) & 1, g = (u >> 4) & 1, b = u >> 5; const int n0 = nt8 * 16;
        const bf16_t* W1T = (const bf16_t*)(F.ws + WS_W1T) + (size_t)kv * 64 * 2048; const bf16_t* W2T = (const bf16_t*)(F.ws + WS_W2T) + (size_t)kv * 64 * 64;
        const float* pec = (const float*)(F.ws + WS_PEC) + kv * 64;
        const int cbase = (kv ? C_VC : C_KC) + g * 64;
        const int nrow = (n0 + col) < NCMP ? (n0 + col) : (NCMP - 1);
        f32x4 acc[4];
#pragma unroll
        for (int nt = 0; nt < 4; ++nt) acc[nt] = (f32x4){0.f, 0.f, 0.f, 0.f};
#pragma unroll
        for (int ks = 0; ks < 8; ++ks) { const int l = 4 * wave + (ks >> 1), d0 = (ks & 1) * 32 + 8 * grp;
            const bf16x8 af = *(const bf16x8*)(PROJ + (size_t)(b * S + 16 * nrow + l) * NPAD + cbase + d0);
#pragma unroll
            for (int nt = 0; nt < 4; ++nt) { const bf16x8 bfr = *(const bf16x8*)(W1T + (size_t)(nt * 16 + col) * 2048 + l * 64 + d0);
                acc[nt] = __builtin_amdgcn_mfma_f32_16x16x32_bf16(af, bfr, acc[nt], 0, 0, 0); } }
#pragma unroll
        for (int nt = 0; nt < 4; ++nt)
#pragma unroll
            for (int rg = 0; rg < 4; ++rg) red[(wave * 16 + 4 * grp + rg) * 64 + nt * 16 + col] = acc[nt][rg];
        __syncthreads();
#pragma unroll
        for (int q = 0; q < 2; ++q) { const int idx = tid + 512 * q; float s = pec[idx & 63];
#pragma unroll
            for (int w = 0; w < 8; ++w) s += red[w * 1024 + idx];
            hid[idx] = f2bf(gelu_tanh(s)); }
        __syncthreads();
        if (wave < 4) { f32x4 o = (f32x4){0.f, 0.f, 0.f, 0.f};
#pragma unroll
            for (int ks = 0; ks < 2; ++ks) { const bf16x8 af = *(const LAS bf16x8*)(hid + col * 64 + ks * 32 + 8 * grp); const bf16x8 bfr = *(const bf16x8*)(W2T + (size_t)(wave * 16 + col) * 64 + ks * 32 + 8 * grp);
                o = __builtin_amdgcn_mfma_f32_16x16x32_bf16(af, bfr, o, 0, 0, 0); }
            bf16_t* dst = (bf16_t*)(F.ws + (kv ? WS_VC : WS_KC));
#pragma unroll
            for (int rg = 0; rg < 4; ++rg) { const int n = n0 + 4 * grp + rg; if (n < NCMP) dst[((size_t)(b * 2 + g) * 128 + n) * 64 + wave * 16 + col] = f2bf(o[rg]); } }
        __syncthreads();
    }
}

__device__ __forceinline__ void dot4_row(const bf16_t* krow, const LAS float* qs, float (&acc)[4]) {
    const uint4* kr = (const uint4*)krow;
#pragma unroll 1
    for (int c = 0; c < 8; ++c) { asm volatile("" ::: "memory"); const uint4 w = kr[c]; const unsigned ww[4] = {w.x, w.y, w.z, w.w};
#pragma unroll
        for (int e = 0; e < 4; ++e) { const float k0 = bflo(ww[e]), k1 = bfhi(ww[e]); const int d = c * 8 + e * 2;
#pragma unroll
            for (int r = 0; r < 4; ++r) acc[r] += qs[r * 64 + d] * k0 + qs[r * 64 + d + 1] * k1; } }
}
__device__ __forceinline__ void p4_attn_naive(const Frame& F) {
    const bf16_t* PROJ = (const bf16_t*)(F.ws + WS_PROJ); const bf16_t* KC = (const bf16_t*)(F.ws + WS_KC); const bf16_t* VC = (const bf16_t*)(F.ws + WS_VC);
    bf16_t* OATT = (bf16_t*)(F.ws + WS_OATT); const float* rel = F.in[21];
    LAS float* wl = (LAS float*)F.lds + F.wave * (256 + 512 + 2048 + 16);
    LAS float* qs = wl; LAS float* pc = wl + 256; LAS float* ps = wl + 768; LAS int* pbase = (LAS int*)(wl + 768 + 2048);
    const int gw = blockIdx.x * NWAVES + F.wave, nw = F.G * NWAVES, lane = F.lane;
    for (int u = gw; u < T * 2; u += nw) {
        const int g = u & 1, tok = u >> 1, b = tok / S, t = tok % S;
        const bf16_t* prow = PROJ + (size_t)tok * NPAD;
#pragma unroll
        for (int r = 0; r < 4; ++r) qs[r * 64 + lane] = bf2f(prow[C_Q + (g * 4 + r) * 64 + lane]) * 0.125f;
        lds_wave_sync();
        const int nv = t >= 31 ? ((t - 31) >> 4) + 1 : 0;
        float sc[2][4]; bool va[2];
#pragma unroll
        for (int i = 0; i < 2; ++i) { const int n = lane + 64 * i; va[i] = n < nv; float a[4] = {0.f, 0.f, 0.f, 0.f};
            if (va[i]) { dot4_row(KC + ((size_t)(b * 2 + g) * 128 + n) * 64, qs, a); const int bk = rel_bucket(t - (16 * n + 31));
#pragma unroll
                for (int r = 0; r < 4; ++r) a[r] += rel[bk * 8 + g * 4 + r]; }
#pragma unroll
            for (int r = 0; r < 4; ++r) sc[i][r] = va[i] ? a[r] : -1e30f; }
        float ocmp[4];
#pragma unroll
        for (int r = 0; r < 4; ++r) { const float m = wave_max(fmaxf(sc[0][r], sc[1][r]));
            const float e0 = va[0] ? __expf(sc[0][r] - m) : 0.f, e1 = va[1] ? __expf(sc[1][r] - m) : 0.f; const float sum = wave_sum(e0 + e1);
            const float inv = nv > 0 ? 1.0f / sum : 0.f; pc[r * 128 + lane] = e0 * inv; pc[r * 128 + 64 + lane] = e1 * inv; }
        lds_wave_sync();
        { float o[4] = {0.f, 0.f, 0.f, 0.f}; const bf16_t* vb = VC + ((size_t)(b * 2 + g) * 128) * 64 + lane;
            for (int n = 0; n < nv; ++n) { const float v = bf2f(vb[n * 64]);
#pragma unroll
                for (int r = 0; r < 4; ++r) o[r] += pc[r * 128 + n] * v; }
#pragma unroll
            for (int r = 0; r < 4; ++r) ocmp[r] = o[r]; }
        const int cur = t >> 6; float val;
        { const int j = lane & 31; float imp = 0.f;
#pragma unroll
            for (int r = 0; r < 4; ++r) for (int n = 4 * j - 1; n <= 4 * j + 3; ++n) if (n >= 0 && n < NCMP) imp += pc[r * 128 + n];
            const bool forced = (j == 0) || (j == cur) || (j == cur - 1); const bool allowed = j <= cur;
            val = forced ? 1e4f : (allowed ? imp : -INFINITY); }
        int rank = 0;
        for (int jp = 0; jp < 32; ++jp) { const float vp = __shfl(val, jp); rank += ((vp > val) || (vp == val && jp < (lane & 31))) ? 1 : 0; }
        unsigned selmask = (unsigned)(__ballot(lane < 32 && rank < 8) & 0xFFFFFFFFull);
        float oslc[4], owin[4];
#pragma unroll
        for (int br = 0; br < 2; ++br) {
            const int ck = br == 0 ? C_KS : C_KW, cv = br == 0 ? C_VS : C_VW;
            unsigned mk = selmask;
#pragma unroll 1
            for (int c = 0; c < 8; ++c) {
                int kpos, bs;
                if (br == 0) { const int j = __builtin_ctz(mk | 0x80000000u); mk &= mk - 1; bs = 64 * j; } else { bs = t - 511 + 64 * c; }
                kpos = bs + lane; if (lane == 0) pbase[c] = bs;
                const int dist = t - kpos; const bool vv = (dist >= 0) && (kpos >= 0) && (kpos < S);
                float a[4] = {0.f, 0.f, 0.f, 0.f};
                if (vv) { dot4_row(PROJ + (size_t)(b * S + kpos) * NPAD + ck + g * 64, qs, a); const int bk = rel_bucket(dist);
#pragma unroll
                    for (int r = 0; r < 4; ++r) a[r] += rel[bk * 8 + g * 4 + r]; }
#pragma unroll
                for (int r = 0; r < 4; ++r) ps[r * 512 + c * 64 + lane] = vv ? a[r] : -1e30f;
            }
            lds_wave_sync();
#pragma unroll 1
            for (int r = 0; r < 4; ++r) { float m = -1e30f;
#pragma unroll
                for (int c = 0; c < 8; ++c) m = fmaxf(m, ps[r * 512 + c * 64 + lane]);
                m = wave_max(m); float e[8], sum = 0.f;
#pragma unroll
                for (int c = 0; c < 8; ++c) { const float sv = ps[r * 512 + c * 64 + lane]; e[c] = sv > -1e29f ? __expf(sv - m) : 0.f; sum += e[c]; }
                sum = wave_sum(sum); const float inv = sum > 0.f ? 1.0f / sum : 0.f;
#pragma unroll
                for (int c = 0; c < 8; ++c) ps[r * 512 + c * 64 + lane] = e[c] * inv; }
            lds_wave_sync();
            float o[4] = {0.f, 0.f, 0.f, 0.f};
#pragma unroll 1
            for (int c = 0; c < 8; ++c) {
                const int bsc = pbase[c];
                for (int kk = 0; kk < 64; ++kk) { const int kpos = bsc + kk; if (kpos < 0 || kpos > t) continue;
                    const float v = bf2f(PROJ[(size_t)(b * S + kpos) * NPAD + cv + g * 64 + lane]);
#pragma unroll
                    for (int r = 0; r < 4; ++r) o[r] += ps[r * 512 + c * 64 + kk] * v; } }
            lds_wave_sync();
#pragma unroll
            for (int r = 0; r < 4; ++r) { if (br == 0) oslc[r] = o[r]; else owin[r] = o[r]; }
        }
#pragma unroll
        for (int r = 0; r < 4; ++r) { const int h = g * 4 + r;
            const float g0 = sigmoidf_(bf2f(prow[C_GT + h * 3 + 0])), g1 = sigmoidf_(bf2f(prow[C_GT + h * 3 + 1])), g2 = sigmoidf_(bf2f(prow[C_GT + h * 3 + 2]));
            OATT[(size_t)tok * 512 + h * 64 + lane] = f2bf(g0 * ocmp[r] + g1 * oslc[r] + g2 * owin[r]); }
    }
}


constexpr float LOG2E = 1.4426950408889634f;
constexpr int AT_KC = 0, AT_VC = 16384, AT_KV = 32768  , AT_BTAB = 65536, AT_IMP = 69888, AT_SEL = 78336, AT_OUT = 78592  , AT_END = 78592 + 65536;
constexpr int BT_STRIDE = 132;
__device__ __forceinline__ int tile_off(int row, int chunk) { return row * 128 + ((chunk ^ (row & 7)) << 4); }
__device__ __forceinline__ bf16x8 mk_frag(unsigned a, unsigned b, unsigned c, unsigned d) { u32x4v v = {a, b, c, d}; return __builtin_bit_cast(bf16x8, v); }
struct LaneOffs { int koff[2]; int voff[4]; int soff; };
__device__ __forceinline__ LaneOffs lane_offs(int lane, int tid) {
    LaneOffs L; const int grp = lane >> 4, rowi = lane & 15, q4 = rowi >> 2, p = lane & 3;
#pragma unroll
    for (int ks = 0; ks < 2; ++ks) L.koff[ks] = tile_off(rowi, ks * 4 + grp);
#pragma unroll
    for (int dt = 0; dt < 4; ++dt) L.voff[dt] = tile_off(4 * grp + q4, 2 * dt + (p >> 1)) + 8 * (p & 1);
    L.soff = tile_off(tid >> 3, tid & 7); return L;
}
__device__ __forceinline__ bf16x8 vfrag_read(const LAS unsigned char* vt, int voff_dt, int row0) {
    const s16x4 a = __builtin_amdgcn_ds_read_tr16_b64_v4i16((LAS s16x4*)(vt + voff_dt + row0 * 128));
    const s16x4 b = __builtin_amdgcn_ds_read_tr16_b64_v4i16((LAS s16x4*)(vt + voff_dt + row0 * 128 + 2048));
    bf16x8 f = {a[0], a[1], a[2], a[3], b[0], b[1], b[2], b[3]}; return f;
}


struct AttnState {
    f32x4 o[4][2]; float m[2], l[2];
};

template <int BR>
__device__ __forceinline__ void attn_tile(const LAS unsigned char* kt_lds, const LAS unsigned char* vt_lds, const LAS float* btab_h, const bf16x8 (&qf)[2][2], const int (&tq)[2], const unsigned (&sel)[2],
                                          int j, bool near, AttnState& st, int lane, const LaneOffs& L, LAS unsigned char* F_lds_) {
    const int grp = lane >> 4, kbase = 64 * j;
#if defined(PROBE_STAMP) && PROBE_LEVEL >= 2
    STAMP_DECL; STAMP_START();
#define TSTAMP(k) STAMP(k)
#else
#define TSTAMP(k) do {} while (0)
#endif
    f32x4 sacc[4][2];
#pragma unroll
    for (int kt = 0; kt < 4; ++kt) { sacc[kt][0] = (f32x4){0.f, 0.f, 0.f, 0.f}; sacc[kt][1] = (f32x4){0.f, 0.f, 0.f, 0.f}; }
#pragma unroll
    for (int kt = 0; kt < 4; ++kt)
#pragma unroll
        for (int ks = 0; ks < 2; ++ks) { const bf16x8 kf = *(const LAS bf16x8*)(kt_lds + L.koff[ks] + kt * 2048);
            sacc[kt][0] = __builtin_amdgcn_mfma_f32_16x16x32_bf16(kf, qf[0][ks], sacc[kt][0], 0, 0, 0);
            sacc[kt][1] = __builtin_amdgcn_mfma_f32_16x16x32_bf16(kf, qf[1][ks], sacc[kt][1], 0, 0, 0); }
    __builtin_amdgcn_sched_barrier(0);
    TSTAMP(0);
    const float SC = 0.125f * LOG2E; const float bfar = btab_h[128];
    bf16x8 pf[2][2];
    const int cur_blk = tq[0] >> 6;
    const bool full = BR == 0 ? (j == cur_blk) : (j == cur_blk || j + 8 == cur_blk);
    const bool fast = !near && !full;
#pragma unroll
    for (int qt = 0; qt < 2; ++qt) {
        const int t = tq[qt]; const bool selq = BR == 0 ? ((sel[qt] >> j) & 1u) != 0u : true;
        float sv[4][4]; float tmax;
        if (fast) {
            float r0 = fmaxf(fmaxf(sacc[0][qt][0], sacc[0][qt][1]), fmaxf(sacc[0][qt][2], sacc[0][qt][3]));
#pragma unroll
            for (int kt = 1; kt < 4; ++kt) r0 = fmaxf(r0, fmaxf(fmaxf(sacc[kt][qt][0], sacc[kt][qt][1]), fmaxf(sacc[kt][qt][2], sacc[kt][qt][3])));
            tmax = selq ? r0 * SC + bfar : -1e30f;
        } else {
            tmax = -1e30f;
            int d0 = t - 4 * grp - kbase; asm volatile("" : "+v"(d0));
            if (near) {
#pragma unroll
                for (int kt = 0; kt < 4; ++kt)
#pragma unroll
                    for (int rg = 0; rg < 4; ++rg) { const int dist = d0 - (kt * 16 + rg); const int dd = dist < 0 ? 0 : (dist > 128 ? 128 : dist); sv[kt][rg] = btab_h[dd]; }
            } else {
#pragma unroll
                for (int kt = 0; kt < 4; ++kt)
#pragma unroll
                    for (int rg = 0; rg < 4; ++rg) sv[kt][rg] = bfar;
            }
#pragma unroll
            for (int kt = 0; kt < 4; ++kt)
#pragma unroll
                for (int rg = 0; rg < 4; ++rg) { const int c = kt * 16 + rg;
                    const bool valid = BR == 0 ? (selq && d0 >= c) : (d0 >= c && d0 < 512 + c);
                    const float sx = sacc[kt][qt][rg] * SC + sv[kt][rg]; const float s = valid ? sx : -1e30f; sv[kt][rg] = s; tmax = fmaxf(tmax, s); }
        }
        tmax = fmaxf(tmax, __shfl_xor(tmax, 16)); tmax = fmaxf(tmax, __shfl_xor(tmax, 32));
        const float mnew = fmaxf(st.m[qt], tmax); const float alpha = __builtin_amdgcn_exp2f(st.m[qt] - mnew); st.m[qt] = mnew;
        const float muse = mnew < -1e29f ? 0.f : mnew;
        float ev[4][4];
        if (fast) { const float c0 = selq ? bfar - muse : -1e30f;
#pragma unroll
            for (int kt = 0; kt < 4; ++kt)
#pragma unroll
                for (int rg = 0; rg < 4; ++rg) ev[kt][rg] = __builtin_amdgcn_exp2f(sacc[kt][qt][rg] * SC + c0);
        } else {
#pragma unroll
            for (int kt = 0; kt < 4; ++kt)
#pragma unroll
                for (int rg = 0; rg < 4; ++rg) ev[kt][rg] = __builtin_amdgcn_exp2f(sv[kt][rg] - muse);
        }
        float ls = 0.f; unsigned pk[4][2];
#pragma unroll
        for (int kt = 0; kt < 4; ++kt) { ls += (ev[kt][0] + ev[kt][1]) + (ev[kt][2] + ev[kt][3]);
            pk[kt][0] = pg8::cvt_pk_bf16(ev[kt][0], ev[kt][1]); pk[kt][1] = pg8::cvt_pk_bf16(ev[kt][2], ev[kt][3]); }
        st.l[qt] = st.l[qt] * alpha + ls;
        if (!__all(alpha == 1.0f)) {
#pragma unroll
            for (int dt = 0; dt < 4; ++dt) st.o[dt][qt] *= alpha; }
        pf[qt][0] = mk_frag(pk[0][0], pk[0][1], pk[1][0], pk[1][1]); pf[qt][1] = mk_frag(pk[2][0], pk[2][1], pk[3][0], pk[3][1]);
        __builtin_amdgcn_sched_barrier(0);
    }
    TSTAMP(1);
#pragma unroll
    for (int ks = 0; ks < 2; ++ks)
#pragma unroll
        for (int dt = 0; dt < 4; ++dt) { const bf16x8 vf = vfrag_read(vt_lds, L.voff[dt], 32 * ks);
            st.o[dt][0] = __builtin_amdgcn_mfma_f32_16x16x32_bf16(vf, pf[0][ks], st.o[dt][0], 0, 0, 0);
            st.o[dt][1] = __builtin_amdgcn_mfma_f32_16x16x32_bf16(vf, pf[1][ks], st.o[dt][1], 0, 0, 0); }
    TSTAMP(2);
#undef TSTAMP
}

template <int BR>
__device__ __forceinline__ void attn_branch(const Frame& F, const bf16_t* PROJ, int b, int g, int t0, unsigned tiles  , const LAS float* btab_h,
                                            const bf16x8 (&qf)[2][2], const int (&tq)[2], const unsigned (&sel)[2], const float (&gate)[2], const LaneOffs& L) {
    const int lane = F.lane, tid = F.tid;
    const int ck = (BR == 0 ? C_KS : C_KW) + g * 64, cv = (BR == 0 ? C_VS : C_VW) + g * 64;
    const int srow = tid >> 3, sch = tid & 7;
    LAS unsigned char* F_lds_ = F.lds; STAMP_DECL; STAMP_START();
    AttnState st;
#pragma unroll
    for (int dt = 0; dt < 4; ++dt) { st.o[dt][0] = (f32x4){0.f, 0.f, 0.f, 0.f}; st.o[dt][1] = (f32x4){0.f, 0.f, 0.f, 0.f}; }
    st.m[0] = st.m[1] = -1e30f; st.l[0] = st.l[1] = 0.f;
    unsigned rem = tiles; int cur = 0;
#ifdef PROBE_SHALLOW
    u32x4v rk0, rv0;
#else
    u32x4v rk0, rv0, rk1, rv1;
#endif
    const bf16_t* srcb = PROJ + (size_t)(b * S + srow) * NPAD + sch * 8;
#define AT_LOAD(RK, RV, jj) do { const bf16_t* rowp = srcb + (size_t)(64 * (jj)) * NPAD; RK = *(const u32x4v*)(rowp + ck); RV = *(const u32x4v*)(rowp + cv); } while (0)
#define AT_WRITE(RK, RV, bufi) do { *(LAS u32x4v*)(F.lds + AT_KV + (bufi) * 16384 + L.soff) = RK; *(LAS u32x4v*)(F.lds + AT_KV + (bufi) * 16384 + 8192 + L.soff) = RV; } while (0)
#define AT_COMPUTE(jj) do { STAMP_COUNT(4); const bool near = (t0 + 8 * F.wave) - (64 * (jj) + 63) < 128; \
        attn_tile<BR>(F.lds + AT_KV + cur * 16384, F.lds + AT_KV + cur * 16384 + 8192, btab_h, qf, tq, sel, (jj), near, st, lane, L, F.lds); } while (0)
#ifdef PROBE_SHALLOW
    { int j = __builtin_ctz(rem); rem &= rem - 1;
      AT_LOAD(rk0, rv0, j); AT_WRITE(rk0, rv0, 0);
      __syncthreads();
      for (;;) {
          int jn = j; const bool hn = rem != 0u; if (hn) { jn = __builtin_ctz(rem); rem &= rem - 1; }
          AT_LOAD(rk0, rv0, jn);
          AT_COMPUTE(j);
          AT_WRITE(rk0, rv0, cur ^ 1);
          __syncthreads(); cur ^= 1;
          if (!hn) break;
          j = jn; } }
#else
    int j = __builtin_ctz(rem); rem &= rem - 1;
    AT_LOAD(rk0, rv0, j); AT_WRITE(rk0, rv0, 0);
    int j1 = j; bool h1 = rem != 0u; if (h1) { j1 = __builtin_ctz(rem); rem &= rem - 1; }
    AT_LOAD(rk0, rv0, j1);
    __syncthreads();
    for (;;) {
        int j2 = j1; bool h2 = rem != 0u; if (h2) { j2 = __builtin_ctz(rem); rem &= rem - 1; }
        AT_LOAD(rk1, rv1, j2);
        AT_COMPUTE(j);
        AT_WRITE(rk0, rv0, cur ^ 1);
        __syncthreads(); cur ^= 1;
        if (!h1) break;
        int j3 = j2; bool h3 = rem != 0u; if (h3) { j3 = __builtin_ctz(rem); rem &= rem - 1; }
        AT_LOAD(rk0, rv0, j3);
        AT_COMPUTE(j1);
        AT_WRITE(rk1, rv1, cur ^ 1);
        __syncthreads(); cur ^= 1;
        if (!h2) break;
        j = j2; j1 = j3; h1 = h3;
    }
#endif
    STAMP(5 + BR);
#undef AT_LOAD
#undef AT_WRITE
#undef AT_COMPUTE
    int pob = AT_OUT + tid * 4; asm volatile("" : "+v"(pob));
    LAS float* po = (LAS float*)(F.lds + pob);
#pragma unroll
    for (int qt = 0; qt < 2; ++qt) { float l = st.l[qt]; l += __shfl_xor(l, 16); l += __shfl_xor(l, 32); const float sc = l > 0.f ? gate[qt] / l : 0.f;
#pragma unroll
        for (int dt = 0; dt < 4; ++dt)
#pragma unroll
            for (int e = 0; e < 4; ++e) po[((qt * 4 + dt) * 4 + e) * 512] += st.o[dt][qt][e] * sc; }
}

template <int MODE>
__device__ __forceinline__ void p4_attn_mfma_t(const Frame& F) {
    const bf16_t* PROJ = (const bf16_t*)(F.ws + WS_PROJ); const bf16_t* KC = (const bf16_t*)(F.ws + WS_KC); const bf16_t* VC = (const bf16_t*)(F.ws + WS_VC);
    bf16_t* OATT = (bf16_t*)(F.ws + (MODE == 0 ? WS_OATT : WS_H)); const float* rel = F.in[21];
    const int lane = F.lane, tid = F.tid, wave = F.wave, grp = lane >> 4, col = lane & 15, qi = col >> 2, r = col & 3;
    LAS float* btab = (LAS float*)(F.lds + AT_BTAB); LAS float* impq = (LAS float*)(F.lds + AT_IMP); LAS unsigned* selm = (LAS unsigned*)(F.lds + AT_SEL);
    const LaneOffs L = lane_offs(lane, tid);
    for (int i = tid; i < 8 * 129; i += NTHREADS) { const int hh = i / 129, dd = i % 129; btab[hh * BT_STRIDE + dd] = rel[rel_bucket(dd) * 8 + hh] * LOG2E; }
    __syncthreads();
    LAS unsigned char* F_lds_ = F.lds; STAMP_DECL;
#ifdef PROBE_STAMP
    if (tid < 16) ((volatile LAS unsigned*)(F.lds + LDS_MISC_OFF + 128))[tid] = 0u;
    __syncthreads();
#endif
    STAMP_START();
    for (int uu = blockIdx.x; uu < 1024; uu += F.G) {
        int sidx = uu;
        if (F.G == 256) { const int round = uu >> 8, k = uu & 255; sidx = (round == 0) ? k : (round == 1) ? 511 - k : (round == 2) ? 512 + k : 1023 - k; }
        const int qb = 31 - (sidx >> 5), bg = sidx & 31, b = bg >> 1, g = bg & 1, t0 = qb * 64, h = g * 4 + r;
        const LAS float* btab_h = btab + h * BT_STRIDE;
        int tq[2]; bf16x8 qf[2][2]; float gate[3][2];
#pragma unroll
        for (int qt = 0; qt < 2; ++qt) { tq[qt] = t0 + 8 * wave + 4 * qt + qi; const bf16_t* prow = PROJ + (size_t)(b * S + tq[qt]) * NPAD;
#pragma unroll
            for (int ks = 0; ks < 2; ++ks) qf[qt][ks] = *(const bf16x8*)(prow + C_Q + h * 64 + ks * 32 + 8 * grp);
#pragma unroll
            for (int jg = 0; jg < 3; ++jg) gate[jg][qt] = sigmoidf_(bf2f(prow[C_GT + h * 3 + jg])); }
#pragma unroll
        for (int i = 0; i < 2; ++i) { const int c2 = tid + 512 * i, row = c2 >> 3, ch = c2 & 7; const size_t src = ((size_t)(b * 2 + g) * 128 + row) * 64 + ch * 8;
            *(LAS u32x4v*)(F.lds + AT_KC + L.soff + 8192 * i) = *(const u32x4v*)(KC + src); *(LAS u32x4v*)(F.lds + AT_VC + L.soff + 8192 * i) = *(const u32x4v*)(VC + src); }
        __syncthreads();
#ifndef AT_SKIP_CMP
        {
            const int nvmax = t0 + 63 >= 31 ? ((t0 + 63 - 31) >> 4) + 1 : 0;
            const float SC = 0.125f * LOG2E; const int srcl = (lane + 48) & 63;
            int pob = AT_OUT + tid * 4; asm volatile("" : "+v"(pob));
            LAS float* po = (LAS float*)(F.lds + pob);
#pragma unroll
            for (int qt = 0; qt < 2; ++qt) {
                f32x4 sa[8];
#pragma unroll
                for (int kt = 0; kt < 8; ++kt) sa[kt] = (f32x4){0.f, 0.f, 0.f, 0.f};
#pragma unroll
                for (int kt = 0; kt < 8; ++kt) if (kt * 16 < nvmax) {
#pragma unroll
                    for (int ks = 0; ks < 2; ++ks) { const bf16x8 kf = *(const LAS bf16x8*)(F.lds + AT_KC + L.koff[ks] + kt * 2048);
                        sa[kt] = __builtin_amdgcn_mfma_f32_16x16x32_bf16(kf, qf[qt][ks], sa[kt], 0, 0, 0); } }
                __builtin_amdgcn_sched_barrier(0);
                int d0 = tq[qt] - 31 - 64 * grp; asm volatile("" : "+v"(d0));
                float mx = -1e30f;
#pragma unroll
                for (int kt = 0; kt < 8; ++kt)
#pragma unroll
                    for (int rg = 0; rg < 4; ++rg) { const int c = 256 * kt + 16 * rg; const int dist = d0 - c; const int dd = dist < 0 ? 0 : (dist > 128 ? 128 : dist);
                        const float sx = sa[kt][rg] * SC + btab_h[dd]; const float s = d0 >= c ? sx : -1e30f; sa[kt][rg] = s; mx = fmaxf(mx, s); }
                mx = fmaxf(mx, __shfl_xor(mx, 16)); mx = fmaxf(mx, __shfl_xor(mx, 32));
                float sum = 0.f;
#pragma unroll
                for (int kt = 0; kt < 8; ++kt)
#pragma unroll
                    for (int rg = 0; rg < 4; ++rg) { const int c = 256 * kt + 16 * rg; const float ex = __builtin_amdgcn_exp2f(sa[kt][rg] - mx); const float e = d0 >= c ? ex : 0.f; sa[kt][rg] = e; sum += e; }
                __builtin_amdgcn_sched_barrier(0);
                sum += __shfl_xor(sum, 16); sum += __shfl_xor(sum, 32);
                const float inv = sum > 0.f ? 1.0f / sum : 0.f;
                float prev3 = 0.f;
#pragma unroll
                for (int kt = 0; kt < 8; ++kt) { const float p3 = sa[kt][3] * inv; const float part = (sa[kt][0] * inv + sa[kt][1] * inv) + (sa[kt][2] * inv + p3);
                    const float xa = __shfl(p3, srcl), xb = __shfl(prev3, srcl); float tot = part + (grp >= 1 ? xa : xb);
                    tot += __shfl_xor(tot, 1); tot += __shfl_xor(tot, 2);
                    if (r == 0) impq[(8 * wave + 4 * qt + qi) * 33 + 4 * kt + grp] = tot;
                    prev3 = p3; }
                __builtin_amdgcn_sched_barrier(0);
                f32x4 oc[4];
#pragma unroll
                for (int dt = 0; dt < 4; ++dt) oc[dt] = (f32x4){0.f, 0.f, 0.f, 0.f};
#pragma unroll
                for (int ks = 0; ks < 4; ++ks) if (ks * 32 < nvmax) {
                    const bf16x8 pfr = mk_frag(pg8::cvt_pk_bf16(sa[2 * ks][0], sa[2 * ks][1]), pg8::cvt_pk_bf16(sa[2 * ks][2], sa[2 * ks][3]),
                                               pg8::cvt_pk_bf16(sa[2 * ks + 1][0], sa[2 * ks + 1][1]), pg8::cvt_pk_bf16(sa[2 * ks + 1][2], sa[2 * ks + 1][3]));
#pragma unroll
                    for (int dt = 0; dt < 4; ++dt) { const bf16x8 vf = vfrag_read(F.lds + AT_VC, L.voff[dt], 32 * ks); oc[dt] = __builtin_amdgcn_mfma_f32_16x16x32_bf16(vf, pfr, oc[dt], 0, 0, 0); } }
                const float scq = inv * gate[0][qt];
#pragma unroll
                for (int dt = 0; dt < 4; ++dt)
#pragma unroll
                    for (int e = 0; e < 4; ++e) po[((qt * 4 + dt) * 4 + e) * 512] = oc[dt][e] * scq;
                __builtin_amdgcn_sched_barrier(0);
            }
        }
#endif
        __syncthreads();
#ifndef AT_SKIP_SEL
        {
            const int q = tid >> 3, jj = tid & 7, cur = qb; unsigned bits = 0u;
            float vj[4];
#pragma unroll
            for (int e = 0; e < 4; ++e) { const int j = jj * 4 + e; const bool forced = (j == 0) || (j == cur) || (j == cur - 1); vj[e] = forced ? 1e4f : (j <= cur ? impq[q * 33 + j] : -INFINITY); }
            int rk[4] = {0, 0, 0, 0};
            for (int jp = 0; jp < 32; ++jp) { const bool forced = (jp == 0) || (jp == cur) || (jp == cur - 1); const float vp = forced ? 1e4f : (jp <= cur ? impq[q * 33 + jp] : -INFINITY);
#pragma unroll
                for (int e = 0; e < 4; ++e) rk[e] += ((vp > vj[e]) || (vp == vj[e] && jp < jj * 4 + e)) ? 1 : 0; }
#pragma unroll
            for (int e = 0; e < 4; ++e) bits |= (rk[e] < 8 ? 1u : 0u) << (jj * 4 + e);
            bits |= __shfl_xor(bits, 1); bits |= __shfl_xor(bits, 2); bits |= __shfl_xor(bits, 4);
            if (jj == 0) selm[q] = bits;
        }
#endif
        __syncthreads();
        unsigned sel[2] = {selm[8 * wave + qi], selm[8 * wave + 4 + qi]};
        unsigned un = selm[lane];
#pragma unroll
        for (int o = 32; o >= 1; o >>= 1) un |= __shfl_xor(un, o);
        un = __builtin_amdgcn_readfirstlane(un);
        const unsigned causal = qb == 31 ? 0xFFFFFFFFu : ((2u << qb) - 1u);
        if (MODE != 1 && MODE != 2) { const float gt1[2] = {gate[1][0], gate[1][1]}; attn_branch<0>(F, PROJ, b, g, t0, un & causal, btab_h, qf, tq, sel, gt1, L); }
        if (MODE != 2) { const int jlo = qb >= 8 ? qb - 8 : 0; const unsigned wmask = causal & ~((1u << jlo) - 1u); const float gt2[2] = {gate[2][0], gate[2][1]};
            attn_branch<1>(F, PROJ, b, g, t0, wmask, btab_h, qf, tq, sel, gt2, L); }
        int pob2 = AT_OUT + tid * 4; asm volatile("" : "+v"(pob2));
#pragma unroll
        for (int qt = 0; qt < 2; ++qt) { bf16_t* orow = OATT + (size_t)(b * S + tq[qt]) * 512 + h * 64 + 4 * grp;
#pragma unroll
            for (int dt = 0; dt < 4; ++dt) { const LAS float* po = (const LAS float*)(F.lds + pob2) + (qt * 4 + dt) * 4 * 512;
                *(uint2*)(orow + dt * 16) = make_uint2(pg8::cvt_pk_bf16(po[0], po[512]), pg8::cvt_pk_bf16(po[1024], po[1536])); } }
    }
    STAMP(7);
#ifdef PROBE_STAMP
    __syncthreads();
    if (PROBE_PHASE == 4 && MODE == 0 && blockIdx.x == PROBE_BLOCK && tid < 16) ((unsigned*)(F.ws + WS_CTL + 32768))[tid] = ((volatile LAS unsigned*)(F.lds + LDS_MISC_OFF + 128))[tid];
#endif
}

__device__ __forceinline__ void p5_mixed(const Frame& F) {
    const bf16_t* PROJ = (const bf16_t*)(F.ws + WS_PROJ); const bf16_t* OATT = (const bf16_t*)(F.ws + WS_OATT); bf16_t* MIX = (bf16_t*)(F.ws + WS_H);
    const float* cw = F.in[13]; const float* ga = F.in[14]; const float* gc = F.in[15];
    const int gw = blockIdx.x * NWAVES + F.wave, nw = F.G * NWAVES, lane = F.lane;
    for (int tok = gw; tok < T; tok += nw) {
        const int s = tok % S; const int c0 = lane * 8;
        float a[8], y[8];
        { const uint4 w = *(const uint4*)(OATT + (size_t)tok * 512 + c0); const unsigned ww[4] = {w.x, w.y, w.z, w.w};
#pragma unroll
            for (int e = 0; e < 4; ++e) { a[2 * e] = bflo(ww[e]); a[2 * e + 1] = bfhi(ww[e]); } }
#pragma unroll
        for (int e = 0; e < 8; ++e) y[e] = 0.f;
#pragma unroll
        for (int dt = 0; dt < 3; ++dt) { if (s - 2 + dt >= 0) { const bf16_t* row = PROJ + (size_t)(tok - 2 + dt) * NPAD;
                const uint4 wc = *(const uint4*)(row + C_CC + c0), wh = *(const uint4*)(row + C_CH + c0); const unsigned c4[4] = {wc.x, wc.y, wc.z, wc.w}, h4[4] = {wh.x, wh.y, wh.z, wh.w};
#pragma unroll
                for (int e = 0; e < 4; ++e) { y[2 * e] += cw[dt * 512 + c0 + 2 * e] * (bflo(c4[e]) * bflo(h4[e])); y[2 * e + 1] += cw[dt * 512 + c0 + 2 * e + 1] * (bfhi(c4[e]) * bfhi(h4[e])); } } }
        { const uint4 wb = *(const uint4*)(PROJ + (size_t)tok * NPAD + C_CB + c0); const unsigned b4[4] = {wb.x, wb.y, wb.z, wb.w};
#pragma unroll
            for (int e = 0; e < 4; ++e) { y[2 * e] *= bflo(b4[e]); y[2 * e + 1] *= bfhi(b4[e]); } }
        float sa = 0.f, sy = 0.f;
#pragma unroll
        for (int e = 0; e < 8; ++e) { sa += a[e] * a[e]; sy += y[e] * y[e]; }
        sa = wave_sum(sa); sy = wave_sum(sy);
        const float ra = rsqrtf(sa * (1.0f / 512) + EPS), ry = rsqrtf(sy * (1.0f / 512) + EPS);
        unsigned oa[4], oy[4];
#pragma unroll
        for (int e = 0; e < 4; ++e) { oa[e] = pack2(a[2 * e] * ra * ga[c0 + 2 * e], a[2 * e + 1] * ra * ga[c0 + 2 * e + 1]); oy[e] = pack2(y[2 * e] * ry * gc[c0 + 2 * e], y[2 * e + 1] * ry * gc[c0 + 2 * e + 1]); }
        *(uint4*)(MIX + (size_t)tok * D + c0) = make_uint4(oa[0], oa[1], oa[2], oa[3]);
        *(uint4*)(MIX + (size_t)tok * D + 512 + c0) = make_uint4(oy[0], oy[1], oy[2], oy[3]);
    }
}

struct EpiResGate {
    static constexpr bool PERM = false, AFTER_DRAIN = false;
    float* C; const float* X; const float* MOD; int gate_off;
    __device__ __forceinline__ void operator()(const pg8::f32x4 (&acc)[2][2][4][2], const pg8::Unit& u, int wr, int wc, int fr, int fq) const {
        using pg8::f32x4; using pg8::HALF; using pg8::BM;
        const int row0 = u.pm * BM + wr * 64 + fr, col0 = u.pn * BM + wc * 32 + 4 * fq;
        const int b = (u.pm * BM) / S;
        f32x4 gv[2][2];
#pragma unroll
        for (int bj = 0; bj < 2; ++bj)
#pragma unroll
            for (int n = 0; n < 2; ++n) gv[bj][n] = *(const f32x4*)(MOD + b * 6144 + gate_off + col0 + bj * HALF + n * 16);
#pragma unroll
        for (int ai = 0; ai < 2; ++ai)
#pragma unroll
            for (int m = 0; m < 4; ++m) { const size_t ro = (size_t)(row0 + ai * HALF + m * 16) * D + col0;
#pragma unroll
                for (int bj = 0; bj < 2; ++bj)
#pragma unroll
                    for (int n = 0; n < 2; ++n) { const f32x4 xv = *(const f32x4*)(X + ro + bj * HALF + n * 16); *(f32x4*)(C + ro + bj * HALF + n * 16) = xv + gv[bj][n] * acc[ai][bj][m][n]; } }
    }
};

__device__ __forceinline__ int ord_i(float f) { const int u = __float_as_int(f); return u >= 0 ? u : (u ^ 0x7FFFFFFF); }
__device__ __forceinline__ float unord_f(int i) { const int u = i >= 0 ? i : (i ^ 0x7FFFFFFF); return __int_as_float(u); }
#define INT_MIN_ (-2147483647 - 1)
struct CandTab { int a[50], b[50]; };
constexpr CandTab make_cand() { CandTab t{}; int n = 0; for (int a = 0; a < 16; ++a) for (int b = 0; b < 16; ++b) if ((a + 1) * (b + 1) <= 16) { t.a[n] = a; t.b[n] = b; ++n; } return t; }
constexpr CandTab CAND = make_cand();

template <int N, bool DESC> __device__ __forceinline__ void bitonic_sort_i(int (&v)[N]) {
#pragma unroll
    for (int k = 2; k <= N; k <<= 1)
#pragma unroll
        for (int j = k >> 1; j > 0; j >>= 1)
#pragma unroll
            for (int i = 0; i < N; ++i) { const int l = i ^ j; if (l > i) { const bool up = ((i & k) == 0) != DESC; const int lo = min(v[i], v[l]), hi = max(v[i], v[l]); v[i] = up ? lo : hi; v[l] = up ? hi : lo; } }
}
template <int N, bool DESC> __device__ __forceinline__ void bitonic_merge_i(int (&v)[N]) {
#pragma unroll
    for (int j = N >> 1; j > 0; j >>= 1)
#pragma unroll
        for (int i = 0; i < N; ++i) { const int l = i ^ j; if (l > i) { const int lo = min(v[i], v[l]), hi = max(v[i], v[l]); v[i] = DESC ? hi : lo; v[l] = DESC ? lo : hi; } }
}
__device__ __forceinline__ void merge_top16_across(int (&t)[16]) {
#pragma unroll
    for (int m = 16; m <= 32; m <<= 1) { int y[16];
#pragma unroll
        for (int i = 0; i < 16; ++i) y[i] = max(t[i], __shfl_xor(t[15 - i], m));
        bitonic_merge_i<16, true>(y);
#pragma unroll
        for (int i = 0; i < 16; ++i) t[i] = y[i]; }
}
constexpr int RT2_KEYS = 0  , RT2_ITAB = 65536  ;
__device__ __forceinline__ void p9_route_sort(const Frame& F) {
    const bf16_t* QP = (const bf16_t*)(F.ws + WS_QP); const bf16_t* KEYS = (const bf16_t*)(F.ws + WS_KEYS);
    unsigned short* E16 = (unsigned short*)(F.ws + WS_E16); float* EW = (float*)(F.ws + WS_EW);
    const int lane = F.lane, tid = F.tid, grp = lane >> 4, col = lane & 15;
    const LaneOffs L = lane_offs(lane, tid);
    LAS int* itab = (LAS int*)(F.lds + RT2_ITAB + F.wave * 2048) + col * 32;
    const bool g1 = grp == 1, g2 = grp == 2, g3 = grp == 3;
    for (int tile = blockIdx.x * NWAVES + F.wave; tile < T / 16; tile += F.G * NWAVES) {
        const int tok = tile * 16 + col;
        {
#pragma unroll
            for (int i = 0; i < 4; ++i) { const int q = tid + 512 * i; *(LAS u32x4v*)(F.lds + RT2_KEYS + tile_off(q >> 3, q & 7)) = *(const u32x4v*)(KEYS + (size_t)q * 8); } }
        bf16x8 qf[2][2];
#pragma unroll
        for (int p = 0; p < 2; ++p)
#pragma unroll
            for (int ks = 0; ks < 2; ++ks) qf[p][ks] = *(const bf16x8*)(QP + (size_t)tok * D + p * 64 + ks * 32 + 8 * grp);
        __syncthreads();
#pragma unroll 1
        for (int h = 0; h < 8; ++h) {
            const int kb = RT2_KEYS + (h & 1) * 32768;
            u32x4v stg[4]; bf16x8 qn[2][2];
            if (h < 7) {
#pragma unroll
                for (int i = 0; i < 4; ++i) { const int q = tid + 512 * i; stg[i] = *(const u32x4v*)(KEYS + (size_t)(h + 1) * 16384 + (size_t)q * 8); }
#pragma unroll
                for (int p = 0; p < 2; ++p)
#pragma unroll
                    for (int ks = 0; ks < 2; ++ks) qn[p][ks] = *(const bf16x8*)(QP + (size_t)tok * D + (h + 1) * 128 + p * 64 + ks * 32 + 8 * grp);
            }
            int lst[2][16];
#pragma unroll
            for (int p = 0; p < 2; ++p) {
                f32x4 sc[8];
#pragma unroll
                for (int kt = 0; kt < 8; ++kt) { sc[kt] = (f32x4){0.f, 0.f, 0.f, 0.f};
#pragma unroll
                    for (int ks = 0; ks < 2; ++ks) { const bf16x8 kf = *(const LAS bf16x8*)(F.lds + kb + p * 16384 + L.koff[ks] + kt * 2048);
                        sc[kt] = __builtin_amdgcn_mfma_f32_16x16x32_bf16(kf, qf[p][ks], sc[kt], 0, 0, 0); } }
                int ra[16], rb[16];
#pragma unroll
                for (int kt = 0; kt < 4; ++kt)
#pragma unroll
                    for (int rg = 0; rg < 4; ++rg) { ra[kt * 4 + rg] = (ord_i(sc[kt][rg]) & ~0x7F) | (127 - (kt * 16 + 4 * grp + rg)); rb[kt * 4 + rg] = (ord_i(sc[kt + 4][rg]) & ~0x7F) | (127 - ((kt + 4) * 16 + 4 * grp + rg)); }
                bitonic_sort_i<16, true>(ra); bitonic_sort_i<16, false>(rb);
#pragma unroll
                for (int i = 0; i < 16; ++i) ra[i] = max(ra[i], rb[i]);
                bitonic_merge_i<16, true>(ra);
                merge_top16_across(ra);
#pragma unroll
                for (int i = 0; i < 16; ++i) lst[p][i] = ra[i];
                if (grp == 0) {
#pragma unroll
                    for (int it = 0; it < 16; ++it) itab[p * 16 + it] = 127 - (ra[it] & 0x7F);
                }
            }
            float v0[16], v1[16];
#pragma unroll
            for (int i = 0; i < 16; ++i) { v0[i] = unord_f(lst[0][i] & ~0x7F); v1[i] = unord_f(lst[1][i] & ~0x7F); }
            int ck[16];
#pragma unroll
            for (int i = 0; i < 13; ++i) {
                constexpr int NC = 50;
                const int k0 = 4 * i, k1 = 4 * i + 1 < NC ? 4 * i + 1 : NC - 1, k2 = 4 * i + 2 < NC ? 4 * i + 2 : NC - 1, k3 = 4 * i + 3 < NC ? 4 * i + 3 : NC - 1;
                float va = v0[CAND.a[k0]], vb = v1[CAND.b[k0]]; int fl = 255 - (CAND.a[k0] * 16 + CAND.b[k0]);
                va = g1 ? v0[CAND.a[k1]] : va; vb = g1 ? v1[CAND.b[k1]] : vb; fl = g1 ? 255 - (CAND.a[k1] * 16 + CAND.b[k1]) : fl;
                va = g2 ? v0[CAND.a[k2]] : va; vb = g2 ? v1[CAND.b[k2]] : vb; fl = g2 ? 255 - (CAND.a[k2] * 16 + CAND.b[k2]) : fl;
                va = g3 ? v0[CAND.a[k3]] : va; vb = g3 ? v1[CAND.b[k3]] : vb; fl = g3 ? 255 - (CAND.a[k3] * 16 + CAND.b[k3]) : fl;
                int key = (ord_i(va + vb) & ~0xFF) | fl;
                if (4 * i + 1 >= NC) key = g1 ? INT_MIN_ : key;
                if (4 * i + 2 >= NC) key = g2 ? INT_MIN_ : key;
                if (4 * i + 3 >= NC) key = g3 ? INT_MIN_ : key;
                ck[i] = key; }
            ck[13] = INT_MIN_; ck[14] = INT_MIN_; ck[15] = INT_MIN_;
            bitonic_sort_i<16, true>(ck);
            merge_top16_across(ck);
            lds_wave_sync();
            const float smax = unord_f(ck[0] & ~0xFF);
            float ex[16], sum = 0.f;
#pragma unroll
            for (int it = 0; it < 16; ++it) { ex[it] = __expf(unord_f(ck[it] & ~0xFF) - smax); sum += ex[it]; }
            const float inv = 1.0f / sum;
            if (grp == 0) {
#pragma unroll
                for (int it = 0; it < 16; ++it) { const int flat = 255 - (ck[it] & 0xFF); const int i1 = itab[flat >> 4], i2 = itab[16 + (flat & 15)];
                    E16[(size_t)tok * 128 + h * 16 + it] = (unsigned short)(i1 * 128 + i2); EW[(size_t)tok * 128 + h * 16 + it] = ex[it] * inv; }
            }
            lds_wave_sync();
            if (h < 7) {
                const int kn = RT2_KEYS + ((h + 1) & 1) * 32768;
#pragma unroll
                for (int i = 0; i < 4; ++i) { const int q = tid + 512 * i; *(LAS u32x4v*)(F.lds + kn + tile_off(q >> 3, q & 7)) = stg[i]; }
#pragma unroll
                for (int p = 0; p < 2; ++p)
#pragma unroll
                    for (int ks = 0; ks < 2; ++ks) qf[p][ks] = qn[p][ks];
            }
            __syncthreads();
        }
    }
}

constexpr int N_PHASES = 14;
struct Args { const float* in[23]; float* out; unsigned char* ws; int ph_lo, ph_hi; };
__global__ void __launch_bounds__(NTHREADS, 2) fwd(Args args) {
    extern __shared__ __attribute__((aligned(16))) unsigned char lds_raw[];
    Frame F;
#pragma unroll
    for (int i = 0; i < 23; ++i) F.in[i] = args.in[i];
    F.out = args.out; F.ws = args.ws; F.lds = (LAS unsigned char*)lds_raw;
    F.tid = threadIdx.x; F.lane = F.tid & 63; F.wave = __builtin_amdgcn_readfirstlane(F.tid >> 6); F.G = gridDim.x;
    volatile LAS unsigned* misc = (volatile LAS unsigned*)(F.lds + LDS_MISC_OFF);
    if (F.tid < 64) misc[F.tid] = 0u;
    __syncthreads();
    XcdBarrier bar; bar.bar = (unsigned*)(F.ws + WS_CTL); bar.x = 0; bar.st = misc;
    const int lo = args.ph_lo, hi = args.ph_hi;
    if (hi - lo > 1) bar = xcd_barrier_post((unsigned*)(F.ws + WS_CTL), misc);
#ifndef PH_MASK
#define PH_MASK 0xFFFF
#endif
#define IN(k) (((PH_MASK >> (k)) & 1) && lo <= (k) && (k) < hi)
#define SEAM(k) do { if (IN(k) && IN((k) + 1)) xcd_barrier(bar); } while (0)
    const float* MOD = (const float*)(F.ws + WS_MOD);
    if (IN(0)) { p0_prologue(F); } SEAM(0);
    if (IN(1)) { norm_mod_rows(F, F.in[0], F.in[2], 0, 1024, (bf16_t*)(F.ws + WS_H)); } SEAM(1);
    if (IN(2)) { pg8::Gemm g{(const pg8::bf16_t*)(F.ws + WS_H), (const pg8::bf16_t*)(F.ws + WS_WIN), T, NPAD, D}; pg8::StaticOrder So; So.init(T, NPAD, F.G, (int)blockIdx.x);
        pg8::EpiBf16<0> E{(pg8::bf16_t*)(F.ws + WS_PROJ), NPAD, nullptr, 0, 0};
        pg8::gemm_phase<pg8::EpiBf16<0>, pg8::StaticOrder>(F.lds, g, So, E, nullptr); } SEAM(2);
#ifdef COMPRESS_NAIVE
    if (IN(3)) { p3_compress_naive(F); } SEAM(3);
#else
    if (IN(3)) { p3_compress_mfma(F); } SEAM(3);
#endif
    #ifdef ATTN_NAIVE
    if (IN(4)) { p4_attn_naive(F); } SEAM(4);
#else
    if (IN(4)) { p4_attn_mfma_t<0>(F); } SEAM(4);
#ifdef PROBE_ATTN_MODE
    if (IN(14)) { p4_attn_mfma_t<PROBE_ATTN_MODE>(F); }
#endif
#ifdef PROBE_P0_LO
    if (IN(14)) { p0_prologue(F, PROBE_P0_LO, PROBE_P0_HI); }
#endif
#endif
    if (IN(5)) { p5_mixed(F); } SEAM(5);
    if (IN(6)) { pg8::Gemm g{(const pg8::bf16_t*)(F.ws + WS_H), (const pg8::bf16_t*)(F.ws + WS_WOUT), T, D, D}; pg8::StaticOrder So; So.init(T, D, F.G, (int)blockIdx.x);
        EpiResGate E{F.out, F.in[0], MOD, 2048};
        pg8::gemm_phase<EpiResGate, pg8::StaticOrder>(F.lds, g, So, E, nullptr); } SEAM(6);
    if (IN(7)) { norm_mod_rows_q(F, F.out, F.in[3], 3072, 4096, (bf16_t*)(F.ws + WS_H)); } SEAM(7);
    if (IN(8)) { pg8::Gemm g{(const pg8::bf16_t*)(F.ws + WS_H), (const pg8::bf16_t*)(F.ws + WS_WQ), T, D, D}; pg8::StaticOrder So; So.init(T, D, F.G, (int)blockIdx.x);
        pg8::EpiBf16<0> E{(pg8::bf16_t*)(F.ws + WS_QP), D, nullptr, 0, 0};
        pg8::gemm_phase<pg8::EpiBf16<0>, pg8::StaticOrder>(F.lds, g, So, E, nullptr); } SEAM(8);
        if (IN(9)) { p9_route_sort(F); } SEAM(9);
    if (IN(10)) { p10a_udots(F); } SEAM(10);
    if (IN(11)) { p10b_coef(F); } SEAM(11);
    if (IN(12)) { p10c_vsum(F); } SEAM(12);
    if (IN(13)) { p10d_final(F); }
#undef IN
#undef SEAM
}

extern "C" void kernel_launch(void* const* d_in, const int* in_sizes, int n_in, void* d_out, int out_size, void* d_ws, size_t ws_size, hipStream_t stream) {
    static int grid = 0;
    if (grid == 0) {
        if (n_in != 23 || out_size != T * D || ws_size < WS_END) { fprintf(stderr, "kernel_launch: unexpected shapes: n_in %d out %d ws %zu (need %zu)\n", n_in, out_size, ws_size, (size_t)WS_END); grid = -1; return; }
        int dev = 0, cus = 0, per_cu = 0;
        if (hipGetDevice(&dev) != hipSuccess || hipDeviceGetAttribute(&cus, hipDeviceAttributeMultiprocessorCount, dev) != hipSuccess) { grid = -1; return; }
        if (hipFuncSetAttribute((const void*)fwd, hipFuncAttributeMaxDynamicSharedMemorySize, LDS_BYTES) != hipSuccess) { fprintf(stderr, "kernel_launch: hipFuncSetAttribute failed\n"); grid = -1; return; }
        if (hipOccupancyMaxActiveBlocksPerMultiprocessor(&per_cu, (const void*)fwd, NTHREADS, LDS_BYTES) != hipSuccess || per_cu < 1) { fprintf(stderr, "kernel_launch: occupancy query says %d\n", per_cu); (void)hipGetLastError(); per_cu = 1; }
        grid = cus;
    }
    if (grid < 0) return;
    (void)hipMemsetAsync((char*)d_ws + WS_CTL, 0, CTL_BYTES, stream);
    Args a{};
    for (int i = 0; i < 23; ++i) a.in[i] = (const float*)d_in[i];
    a.out = (float*)d_out; a.ws = (unsigned char*)d_ws;
#if MK_N_LAUNCHES == 1
    a.ph_lo = 0; a.ph_hi = N_PHASES;
    hipLaunchKernelGGL(fwd, dim3(grid), dim3(NTHREADS), LDS_BYTES, stream, a);
#else
#ifdef PROBE_LIST
    { const int plist[] = PROBE_LIST; for (int p : plist) { if (p < 0) { (void)hipMemsetAsync((char*)d_ws + WS_CTL, 0, CTL_BYTES, stream); continue; } a.ph_lo = p; a.ph_hi = p + 1; hipLaunchKernelGGL(fwd, dim3(grid), dim3(NTHREADS), LDS_BYTES, stream, a); } }
#else
    for (int p = 0; p < N_PHASES; ++p) { a.ph_lo = p; a.ph_hi = p + 1; hipLaunchKernelGGL(fwd, dim3(grid), dim3(NTHREADS), LDS_BYTES, stream, a); }
#endif
#endif
}
```

```cpp
#include <hip/hip_runtime.h>
#include <cstdio>
#include <cstdint>
#include <cstdlib>

#ifndef MK_N_LAUNCHES
#define MK_N_LAUNCHES 1
#endif
#define XB_TMO      128
#define XB_XCNT(j)  (256  + 64 * (j))
#define XB_XSUB(j)  (1280 + 64 * (j))
#define XB_XGEN(j)  (2304 + 64 * (j))
#define XB_TOP      3328
#define XB_TOPGEN   3392
#define XCD_BAR_WORDS 3456
#define XB_SPIN_CAP (1u << 18)
#define LAS __attribute__((address_space(3)))

__device__ __forceinline__ unsigned xb_ld(unsigned* p)              { return __hip_atomic_load(p, __ATOMIC_RELAXED, __HIP_MEMORY_SCOPE_AGENT); }
__device__ __forceinline__ unsigned xb_add(unsigned* p, unsigned v) { return __hip_atomic_fetch_add(p, v, __ATOMIC_RELAXED, __HIP_MEMORY_SCOPE_AGENT); }
__device__ __forceinline__ unsigned xb_xcc_id() { return (unsigned)__builtin_amdgcn_s_getreg((3 << 11) | 20) & 0xFu; }
#define XB_SPIN(cond, bar) do { unsigned _sp = 0; while (cond) { __builtin_amdgcn_s_sleep(1); \
    if ((++_sp & 255u) == 0u) { if (xb_ld(&(bar)[XB_TMO])) break; if (_sp > XB_SPIN_CAP) { atomicAdd(&(bar)[XB_TMO], 1u); break; } } } } while (0)

struct XcdBarrier {
    unsigned* bar; unsigned x;
    volatile LAS unsigned* st;
};

__device__ __forceinline__ XcdBarrier xcd_barrier_post(unsigned* bar, volatile LAS unsigned* st) {
    XcdBarrier b; b.bar = bar; b.x = xb_xcc_id(); b.st = st;
    if (threadIdx.x == 0) (void)xb_add(&bar[XB_XCNT(b.x)], 1u);
    return b;
}
__device__ __forceinline__ void xcd_barrier_complete(unsigned* bar, unsigned x, unsigned& nloc, unsigned& nx) {
    const unsigned G = gridDim.x * gridDim.y * gridDim.z;
    unsigned sum, cnt, mine, sp = 0u;
    for (;;) {
        sum = 0u; cnt = 0u; mine = 0u;
#pragma unroll
        for (unsigned j = 0; j < 16; ++j) { const unsigned c = xb_ld(&bar[XB_XCNT(j)]); sum += c; cnt += (c > 0u) ? 1u : 0u; mine = (j == x) ? c : mine; }
        if (sum == G) break;
        __builtin_amdgcn_s_sleep(1);
        if ((++sp & 255u) == 0u) { if (xb_ld(&bar[XB_TMO])) break; if (sp > XB_SPIN_CAP) { atomicAdd(&bar[XB_TMO], 1u); break; } }
    }
    nloc = mine > 0u ? mine : 1u; nx = cnt > 0u ? cnt : 1u;
}

__device__ __forceinline__ void xcd_barrier(const XcdBarrier& b) {
    asm volatile("s_waitcnt vmcnt(0)" ::: "memory");
    __syncthreads();
    if (threadIdx.x == 0) {
        unsigned* bar = b.bar;
        __builtin_amdgcn_s_waitcnt(0);
        unsigned nloc = b.st[0], nx = b.st[1];
        if (nloc == 0u) { xcd_barrier_complete(bar, b.x, nloc, nx); b.st[0] = nloc; b.st[1] = nx; }
        const unsigned old = xb_add(&bar[XB_XSUB(b.x)], 1u);
        const unsigned gen = old / nloc;
        if (old + 1u == (gen + 1u) * nloc) {
            __builtin_amdgcn_fence(__ATOMIC_RELEASE, "agent");
            asm volatile("s_waitcnt vmcnt(0)" ::: "memory");
            const unsigned og = xb_add(&bar[XB_TOP], 1u);
            const unsigned tg = og / nx;
            if (og + 1u == (tg + 1u) * nx) xb_add(&bar[XB_TOPGEN], 1u);
            else XB_SPIN(xb_ld(&bar[XB_TOPGEN]) == tg, bar);
            __builtin_amdgcn_fence(__ATOMIC_ACQUIRE, "agent");
            xb_add(&bar[XB_XGEN(b.x)], 1u);
            asm volatile("s_waitcnt vmcnt(0)" ::: "memory");
        } else {
            XB_SPIN(xb_ld(&bar[XB_XGEN(b.x)]) == gen, bar);
            __builtin_amdgcn_fence(__ATOMIC_ACQUIRE, "agent");
            asm volatile("s_waitcnt vmcnt(0)" ::: "memory");
        }
    }
    __syncthreads();
}

namespace pg8 {
#define PG8_LAS __attribute__((address_space(3)))
typedef unsigned short bf16_t;
typedef short bf16x8 __attribute__((ext_vector_type(8)));
typedef float f32x4 __attribute__((ext_vector_type(4)));
typedef unsigned u32x4 __attribute__((ext_vector_type(4)));
constexpr int BM = 256, BK = 64, HALF = 128, HTB = HALF * BK * 2  , STAGE_BYTES = 8 * HTB, NXCD = 8, WGM = 8;

__host__ __device__ __forceinline__ int lds_byte(int r, int c) { const int st = (r >> 4) * 2 + (c >> 5), rr = r & 15, cc = c & 31, ob = rr * 64 + cc * 2; return st * 1024 + (ob ^ (((ob >> 9) & 1) << 5)); }
__host__ __device__ __forceinline__ void stage_rc(int b, int& R, int& C) { const int st = b / 1024, sb = b % 1024, swz = sb ^ (((sb >> 9) & 1) << 5); R = (st >> 1) * 16 + swz / 64; C = (st & 1) * 32 + (swz % 64) / 2; }
__host__ __device__ __forceinline__ int perm32(int rho) { const int n = rho >> 4, i = rho & 15; return 8 * (i >> 2) + 4 * n + (i & 3); }

struct Unit { int pm, pn; };
struct Gemm { const bf16_t* A; const bf16_t* Bt; int M, N, K; };

struct StaticOrder {
    int nM, nN, nwg, G, c;
    __host__ __device__ void init(int M, int N, int G_, int c_) { nM = M / BM; nN = N / BM; nwg = nM * nN; G = G_; c = c_; }
    __host__ __device__ bool next(int i, Unit& u) const {
        const long L = (long)i * G + c; if (L >= nwg) return false;
        int wgid = (int)L; { const int q = nwg / NXCD, r = nwg % NXCD, xcd = wgid % NXCD, off = wgid / NXCD; wgid = (xcd < r ? xcd * (q + 1) : r * (q + 1) + (xcd - r) * q) + off; }
        const int nig = WGM * nN, gid = wgid / nig, fm = gid * WGM, gsz = (nM - fm) < WGM ? (nM - fm) : WGM;
        u.pm = fm + ((wgid % nig) % gsz); u.pn = (wgid % nig) / gsz; return true;
    }
    __device__ __forceinline__ void a_ready(const Unit&) const {}
    __device__ __forceinline__ void done(const Unit&) const {}
};
struct CountedOrder : StaticOrder {
    const unsigned* ready; unsigned need; unsigned* tmo;
    __device__ __forceinline__ void a_ready(const Unit& u) const {
        if (threadIdx.x < 64) {
            const unsigned long long t0 = __builtin_amdgcn_s_memrealtime(); unsigned polls = 0;
            while ((unsigned)__builtin_amdgcn_readfirstlane(__hip_atomic_load(ready + 64 * u.pm, __ATOMIC_RELAXED, __HIP_MEMORY_SCOPE_AGENT)) < need) {
                if ((++polls & 255u) == 0u && __builtin_amdgcn_readfirstlane(__hip_atomic_load(tmo, __ATOMIC_RELAXED, __HIP_MEMORY_SCOPE_AGENT)) != 0u) break;
                if (__builtin_amdgcn_s_memrealtime() - t0 > 2000000ull) {
                    if (threadIdx.x == 0) { unsigned expect = 0u; __hip_atomic_compare_exchange_strong(tmo + 1, &expect, 0x600u | (unsigned)(u.pm & 0xff), __ATOMIC_RELAXED, __ATOMIC_RELAXED, __HIP_MEMORY_SCOPE_AGENT); __hip_atomic_store(tmo, 1u, __ATOMIC_RELAXED, __HIP_MEMORY_SCOPE_AGENT); }
                    break; }
                __builtin_amdgcn_s_sleep(2); }
            __builtin_amdgcn_fence(__ATOMIC_ACQUIRE, "agent");
            asm volatile("s_waitcnt vmcnt(0)" ::: "memory");
        }
#if !defined(BROKEN_HOOK_NO_BARRIER)
        asm volatile("" ::: "memory"); __builtin_amdgcn_s_barrier(); asm volatile("" ::: "memory");
#endif
    }
};

__device__ __forceinline__ unsigned cvt_pk_bf16(float lo, float hi) { unsigned r; asm volatile("v_cvt_pk_bf16_f32 %0, %1, %2" : "=v"(r) : "v"(lo), "v"(hi)); return r; }
typedef float f32x2 __attribute__((ext_vector_type(2)));
__device__ __forceinline__ f32x2 gelu_pk(f32x2 v) {
    const f32x2 av = __builtin_elementwise_abs(v), d = av * 0.2316418882f + 1.0f;
    f32x2 t; t.x = __builtin_amdgcn_rcpf(d.x); t.y = __builtin_amdgcn_rcpf(d.y);
    f32x2 q = t * 0.5307027145f + (-0.7265760135f); q = q * t + 0.7107068705f; q = q * t + (-0.142248368f); q = q * t + 0.127414796f; q = q * t;
    const f32x2 s = (v * v) * (-0.72134752044f);
    f32x2 e; e.x = __builtin_amdgcn_exp2f(s.x); e.y = __builtin_amdgcn_exp2f(s.y);
    const f32x2 m = v * (q * e), r = v - m;
    f32x2 o; o.x = v.x < 0.f ? m.x : r.x; o.y = v.y < 0.f ? m.y : r.y; return o;
}

struct EpiF32 {
    static constexpr bool PERM = false, AFTER_DRAIN = false;
    float* C; int ldc; const float* bias;
    __device__ __forceinline__ void operator()(const f32x4 (&acc)[2][2][4][2], const Unit& u, int wr, int wc, int fr, int fq) const {
        const int row0 = u.pm * BM + wr * 64 + fr, col0 = u.pn * BM + wc * 32 + 4 * fq;
        f32x4 bv[2][2];
#pragma unroll
        for (int bj = 0; bj < 2; ++bj)
#pragma unroll
            for (int n = 0; n < 2; ++n) bv[bj][n] = bias ? *(const f32x4*)(bias + col0 + bj * HALF + n * 16) : (f32x4){0.f, 0.f, 0.f, 0.f};
#pragma unroll
        for (int ai = 0; ai < 2; ++ai)
#pragma unroll
            for (int m = 0; m < 4; ++m) { float* rowp = C + (size_t)(row0 + ai * HALF + m * 16) * ldc + col0;
#pragma unroll
                for (int bj = 0; bj < 2; ++bj)
#pragma unroll
                    for (int n = 0; n < 2; ++n) *(f32x4*)(rowp + bj * HALF + n * 16) = acc[ai][bj][m][n] + bv[bj][n]; }
    }
};
template <int ACT  > struct EpiBf16 {
    static constexpr bool PERM = true, AFTER_DRAIN = false;
    bf16_t* O; int ldc; const float* bias; int split_cols; size_t split_stride;
    __device__ __forceinline__ void operator()(const f32x4 (&acc)[2][2][4][2], const Unit& u, int wr, int wc, int fr, int fq) const {
        const int row0 = u.pm * BM + wr * 64 + fr; int colt = u.pn * BM; bf16_t* base = O;
        if (split_cols) { const int t = colt / split_cols; base += (size_t)t * split_stride; colt -= t * split_cols; }
        const int col0 = colt + wc * 32 + 8 * fq, bcol0 = u.pn * BM + wc * 32 + 8 * fq;
        f32x4 bv[2][2];
#pragma unroll
        for (int bj = 0; bj < 2; ++bj)
#pragma unroll
            for (int n = 0; n < 2; ++n) bv[bj][n] = bias ? *(const f32x4*)(bias + bcol0 + bj * HALF + 4 * n) : (f32x4){0.f, 0.f, 0.f, 0.f};
#pragma unroll
        for (int ai = 0; ai < 2; ++ai)
#pragma unroll
            for (int m = 0; m < 4; ++m) { bf16_t* rowp = base + (size_t)(row0 + ai * HALF + m * 16) * ldc + col0;
#pragma unroll
                for (int bj = 0; bj < 2; ++bj) { f32x4 v0 = acc[ai][bj][m][0] + bv[bj][0], v1 = acc[ai][bj][m][1] + bv[bj][1];
                    if (ACT == 1) { f32x2 a = gelu_pk((f32x2){v0[0], v0[1]}), b = gelu_pk((f32x2){v0[2], v0[3]}), c = gelu_pk((f32x2){v1[0], v1[1]}), d = gelu_pk((f32x2){v1[2], v1[3]});
                        v0 = (f32x4){a.x, a.y, b.x, b.y}; v1 = (f32x4){c.x, c.y, d.x, d.y}; }
                    if (ACT == 2) {
#pragma unroll
                        for (int j = 0; j < 4; ++j) { v0[j] = 0.5f * v0[j] * (1.0f + erff(v0[j] * 0.70710678f)); v1[j] = 0.5f * v1[j] * (1.0f + erff(v1[j] * 0.70710678f)); } }
                    u32x4 w; w.x = cvt_pk_bf16(v0[0], v0[1]); w.y = cvt_pk_bf16(v0[2], v0[3]); w.z = cvt_pk_bf16(v1[0], v1[1]); w.w = cvt_pk_bf16(v1[2], v1[3]);
                    *(u32x4*)(rowp + bj * HALF) = w; } }
    }
};

struct PanelStats {
    unsigned* xbuf;
    unsigned* cnt;
    unsigned* tmo;
    int ntn; float eps;
    unsigned code;
    __device__ __forceinline__ bool run(const f32x4 (&v)[2][2][4][2], const Unit& u, int wr, int wc, int fr, int fq, PG8_LAS unsigned char* lds, int wid, int lane) const {
        typedef float f32x2v __attribute__((ext_vector_type(2)));
        PG8_LAS f32x2v* P = (PG8_LAS f32x2v*)lds;
        PG8_LAS f32x2v* S = (PG8_LAS f32x2v*)(lds + 8192);
        PG8_LAS unsigned* flag = (PG8_LAS unsigned*)(lds + 8192 + 2048);
#pragma unroll
        for (int ai = 0; ai < 2; ++ai)
#pragma unroll
            for (int m = 0; m < 4; ++m) {
                float s = 0.f;
#pragma unroll
                for (int bj = 0; bj < 2; ++bj)
#pragma unroll
                    for (int n = 0; n < 2; ++n) { const f32x4 x = v[ai][bj][m][n]; s += (x[0] + x[1]) + (x[2] + x[3]); }
                s += __shfl_xor(s, 16); s += __shfl_xor(s, 32);
                const float mw = s * (1.0f / 64.0f); float q = 0.f;
#pragma unroll
                for (int bj = 0; bj < 2; ++bj)
#pragma unroll
                    for (int n = 0; n < 2; ++n) { const f32x4 d = v[ai][bj][m][n] - mw; q += (d[0] * d[0] + d[1] * d[1]) + (d[2] * d[2] + d[3] * d[3]); }
                q += __shfl_xor(q, 16); q += __shfl_xor(q, 32);
                if (fq == 0) P[(ai * HALF + wr * 64 + m * 16 + fr) * 4 + wc] = (f32x2v){mw, q};
            }
        asm volatile("s_waitcnt lgkmcnt(0)" ::: "memory"); __builtin_amdgcn_s_barrier(); asm volatile("" ::: "memory");
#if defined(BROKEN_NO_WAIT)
        if (blockIdx.x >= 64) { const long long t0 = clock64(); while (clock64() - t0 < 60000) __builtin_amdgcn_s_sleep(8); }
#endif
        const int row = wid * 32 + (lane & 31);
        if (lane < 32) {
            const f32x2v a = P[row * 4 + 0], b = P[row * 4 + 1], c = P[row * 4 + 2], d = P[row * 4 + 3];
            const float mt = (a.x + b.x + c.x + d.x) * 0.25f;
            const float da = a.x - mt, db = b.x - mt, dc = c.x - mt, dd = d.x - mt;
            const float m2 = (a.y + b.y) + (c.y + d.y) + 64.0f * ((da * da + db * db) + (dc * dc + dd * dd));
            unsigned long long* slot = (unsigned long long*)xbuf + ((size_t)(u.pm * BM + row) * 4 + u.pn);
            __hip_atomic_store(slot, ((unsigned long long)__float_as_uint(m2) << 32) | __float_as_uint(mt), __ATOMIC_RELAXED, __HIP_MEMORY_SCOPE_AGENT);
        }
        asm volatile("s_waitcnt vmcnt(0)" ::: "memory");
        if (lane == 0) __hip_atomic_fetch_add(cnt + 64 * u.pm, 1u, __ATOMIC_RELAXED, __HIP_MEMORY_SCOPE_AGENT);
        if (wid == 0) {
            bool dead = false; const unsigned long long t0 = __builtin_amdgcn_s_memrealtime(); const unsigned want = 8u * (unsigned)ntn;
            for (;;) {
#if defined(BROKEN_NO_WAIT)
                break;
#endif
                if ((unsigned)__builtin_amdgcn_readfirstlane(__hip_atomic_load(cnt + 64 * u.pm, __ATOMIC_RELAXED, __HIP_MEMORY_SCOPE_AGENT)) >= want) break;
                if (__builtin_amdgcn_s_memrealtime() - t0 > 2000000ull) {
                    if (lane == 0) { unsigned expect = 0u; __hip_atomic_compare_exchange_strong(tmo + 1, &expect, code | (unsigned)(u.pm & 0xff), __ATOMIC_RELAXED, __ATOMIC_RELAXED, __HIP_MEMORY_SCOPE_AGENT);
                                     __hip_atomic_store(tmo, 1u, __ATOMIC_RELAXED, __HIP_MEMORY_SCOPE_AGENT); }
                    dead = true; break; }
                __builtin_amdgcn_s_sleep(2);
            }
            __builtin_amdgcn_fence(__ATOMIC_ACQUIRE, "agent");
            if (lane == 0) flag[0] = dead ? 1u : 0u;
        }
        asm volatile("s_waitcnt vmcnt(0) lgkmcnt(0)" ::: "memory"); __builtin_amdgcn_s_barrier(); asm volatile("" ::: "memory");
        const bool bad = flag[0] != 0u;
        if (lane < 32) {
            const unsigned long long* slot = (const unsigned long long*)xbuf + (size_t)(u.pm * BM + row) * 4; float mt[4], m2[4]; float ms = 0.f;
#pragma unroll
            for (int t = 0; t < 4; ++t) { if (t < ntn) { const unsigned long long w = __hip_atomic_load(slot + t, __ATOMIC_RELAXED, __HIP_MEMORY_SCOPE_AGENT); mt[t] = __uint_as_float((unsigned)w); m2[t] = __uint_as_float((unsigned)(w >> 32)); } else { mt[t] = 0.f; m2[t] = 0.f; } ms += mt[t]; }
            const float mean = ms / (float)ntn; float q = 0.f;
#pragma unroll
            for (int t = 0; t < 4; ++t) if (t < ntn) { const float dm = mt[t] - mean; q += m2[t] + 256.0f * dm * dm; }
            S[row] = (f32x2v){mean, 1.0f / sqrtf(q / (256.0f * (float)ntn) + eps)};
        }
        asm volatile("s_waitcnt lgkmcnt(0)" ::: "memory"); __builtin_amdgcn_s_barrier(); asm volatile("" ::: "memory");
        return bad;
    }
};
struct EpiLnRes {
    static constexpr bool PERM = false, AFTER_DRAIN = true;
    const float* base; float* out; int ldc; const float* bias; PanelStats st; unsigned poison;
    __device__ __forceinline__ void refuse(size_t i0, size_t stride, int M, int N) const { const float q = __builtin_nanf(""); for (size_t i = i0; i < (size_t)M * N; i += stride) out[(i / N) * ldc + i % N] = q;
        if (i0 == 0) { unsigned expect = 0u; __hip_atomic_compare_exchange_strong(st.tmo + 1, &expect, 0x7f0u, __ATOMIC_RELAXED, __ATOMIC_RELAXED, __HIP_MEMORY_SCOPE_AGENT); __hip_atomic_store(st.tmo, 1u, __ATOMIC_RELAXED, __HIP_MEMORY_SCOPE_AGENT); } }
    __device__ __forceinline__ void fused(f32x4 (&acc)[2][2][4][2], const Unit& u, int wr, int wc, int fr, int fq, PG8_LAS unsigned char* lds, int wid, int lane) const {
        typedef float f32x2v __attribute__((ext_vector_type(2)));
        const PG8_LAS f32x2v* S = (const PG8_LAS f32x2v*)(lds + 8192);
        const int col0 = u.pn * BM + wc * 32 + 4 * fq;
#pragma unroll
        for (int bj = 0; bj < 2; ++bj)
#pragma unroll
            for (int n = 0; n < 2; ++n) { const f32x4 bv = bias ? *(const f32x4*)(bias + col0 + bj * HALF + n * 16) : (f32x4){0.f, 0.f, 0.f, 0.f};
#pragma unroll
                for (int ai = 0; ai < 2; ++ai)
#pragma unroll
                    for (int m = 0; m < 4; ++m) acc[ai][bj][m][n] += bv; }
        const bool bad = st.run(acc, u, wr, wc, fr, fq, lds, wid, lane) || poison != 0u;
        const float qnan = __builtin_nanf("");
#pragma unroll
        for (int ai = 0; ai < 2; ++ai)
#pragma unroll
            for (int m = 0; m < 4; ++m) { const int r = ai * HALF + wr * 64 + m * 16 + fr; const f32x2v sr = S[r]; const size_t off = (size_t)(u.pm * BM + r) * ldc + col0;
#pragma unroll
                for (int bj = 0; bj < 2; ++bj)
#pragma unroll
                    for (int n = 0; n < 2; ++n) { const f32x4 bs = *(const f32x4*)(base + off + bj * HALF + n * 16); f32x4 o = bs + (acc[ai][bj][m][n] - sr.x) * sr.y;
                        if (bad) o = (f32x4){qnan, qnan, qnan, qnan}; *(f32x4*)(out + off + bj * HALF + n * 16) = o; }
                asm volatile("" ::: "memory"); }
    }
};
struct EpiLnResLn {
    static constexpr bool PERM = false, AFTER_DRAIN = true;
    const float* base; float* out; bf16_t* xn; int ldc; const float* bias; PanelStats st1, st2; unsigned poison;
    __device__ __forceinline__ void refuse(size_t i0, size_t stride, int M, int N) const { const float q = __builtin_nanf(""); for (size_t i = i0; i < (size_t)M * N; i += stride) { const size_t o = (i / N) * ldc + i % N; out[o] = q; xn[o] = (bf16_t)0x7fc0u; }
        if (i0 == 0) { unsigned expect = 0u; __hip_atomic_compare_exchange_strong(st1.tmo + 1, &expect, 0x7f0u, __ATOMIC_RELAXED, __ATOMIC_RELAXED, __HIP_MEMORY_SCOPE_AGENT); __hip_atomic_store(st1.tmo, 1u, __ATOMIC_RELAXED, __HIP_MEMORY_SCOPE_AGENT); } }
    __device__ __forceinline__ void fused(f32x4 (&acc)[2][2][4][2], const Unit& u, int wr, int wc, int fr, int fq, PG8_LAS unsigned char* lds, int wid, int lane) const {
        typedef float f32x2v __attribute__((ext_vector_type(2))); typedef unsigned u32x2v __attribute__((ext_vector_type(2)));
        const PG8_LAS f32x2v* S = (const PG8_LAS f32x2v*)(lds + 8192);
        const int col0 = u.pn * BM + wc * 32 + 4 * fq;
#pragma unroll
        for (int bj = 0; bj < 2; ++bj)
#pragma unroll
            for (int n = 0; n < 2; ++n) { const f32x4 bv = bias ? *(const f32x4*)(bias + col0 + bj * HALF + n * 16) : (f32x4){0.f, 0.f, 0.f, 0.f};
#pragma unroll
                for (int ai = 0; ai < 2; ++ai)
#pragma unroll
                    for (int m = 0; m < 4; ++m) acc[ai][bj][m][n] += bv; }
        bool bad = st1.run(acc, u, wr, wc, fr, fq, lds, wid, lane) || poison != 0u;
        const float qnan = __builtin_nanf("");
#pragma unroll
        for (int ai = 0; ai < 2; ++ai)
#pragma unroll
            for (int m = 0; m < 4; ++m) { const int r = ai * HALF + wr * 64 + m * 16 + fr; const f32x2v sr = S[r]; const size_t off = (size_t)(u.pm * BM + r) * ldc + col0;
#pragma unroll
                for (int bj = 0; bj < 2; ++bj)
#pragma unroll
                    for (int n = 0; n < 2; ++n) { const f32x4 bs = *(const f32x4*)(base + off + bj * HALF + n * 16); acc[ai][bj][m][n] = bs + (acc[ai][bj][m][n] - sr.x) * sr.y; }
                asm volatile("" : "+v"(acc[ai][0][m][0]), "+v"(acc[ai][0][m][1]), "+v"(acc[ai][1][m][0]), "+v"(acc[ai][1][m][1]));
                if (m & 1) asm volatile("" ::: "memory"); }
        const bool bad1 = bad;
        bad = st2.run(acc, u, wr, wc, fr, fq, lds, wid, lane) || bad;
#pragma unroll
        for (int ai = 0; ai < 2; ++ai)
#pragma unroll
            for (int m = 0; m < 4; ++m) { const int r = ai * HALF + wr * 64 + m * 16 + fr; const f32x2v sr = S[r]; const size_t off = (size_t)(u.pm * BM + r) * ldc + col0;
#pragma unroll
                for (int bj = 0; bj < 2; ++bj)
#pragma unroll
                    for (int n = 0; n < 2; ++n) { const f32x4 x1 = acc[ai][bj][m][n]; *(f32x4*)(out + off + bj * HALF + n * 16) = bad1 ? (f32x4){qnan, qnan, qnan, qnan} : x1;
                        const f32x4 o = (x1 - sr.x) * sr.y; u32x2v w; w.x = cvt_pk_bf16(o[0], o[1]); w.y = cvt_pk_bf16(o[2], o[3]);
                        if (bad) { w.x = 0x7fc07fc0u; w.y = 0x7fc07fc0u; } *(u32x2v*)(xn + off + bj * HALF + n * 16) = w; }
                asm volatile("" ::: "memory"); }
    }
};

template <class Epi, class Sched, bool STAMP = false>
__device__ __forceinline__ void gemm_phase(PG8_LAS unsigned char* lds, const Gemm g, const Sched& S, const Epi& E, unsigned long long* stamps) {
    const int tid = threadIdx.x, wid = __builtin_amdgcn_readfirstlane(tid >> 6), lane = tid & 63, wr = wid >> 2, wc = wid & 3, fr = lane & 15, fq = lane >> 4;
    const int K = g.K, nt = K / BK;
    int ts_lo = 0, ts_hi = 0, nts = 0; const unsigned long long rt_entry = STAMP ? (unsigned long long)wall_clock64() : 0ull;
#define PG8_STAMP() do { if (STAMP && wid == 0 && nts < 64) { const unsigned long long _c = (unsigned long long)clock64(); \
        ts_lo = (lane == nts) ? (int)(unsigned)_c : ts_lo; ts_hi = (lane == nts) ? (int)(unsigned)(_c >> 32) : ts_hi; ++nts; } } while (0)
    PG8_STAMP();
    unsigned voffA[2], voffB[2];
#pragma unroll
    for (int i = 0; i < 2; ++i) { int R, C; stage_rc(tid * 16 + i * 8192, R, C); const int Rb = Epi::PERM ? ((R & ~31) + perm32(R & 31)) : R;
        voffA[i] = (unsigned)(R * K + C) * 2u; voffB[i] = (unsigned)(Rb * K + C) * 2u; }
    const size_t kstep = (size_t)(BK * 2);
    const size_t hstep = (size_t)HALF * K * 2;
    const size_t tstep = 2 * hstep;
    const unsigned ldsw = (unsigned)wid * 1024u;
    const int aoff = lds_byte(wr * 64 + fr, fq * 8), boff = lds_byte(wc * 32 + fr, fq * 8);
#define PG8_SA(b, h) (((b) * 2 + (h)) * HTB)
#define PG8_SB(b, h) ((4 + (b) * 2 + (h)) * HTB)
#define PG8_STAGE(bufoff, gbase, voff) do { _Pragma("unroll") for (int _i = 0; _i < 2; ++_i) \
        __builtin_amdgcn_global_load_lds((const unsigned*)((const char*)(gbase) + (voff)[_i]), (PG8_LAS unsigned*)(lds + (bufoff) + ldsw + _i * 8192), 16, 0, 0); } while (0)
#define PG8_LDA(dst, b, h) do { _Pragma("unroll") for (int m = 0; m < 4; ++m) _Pragma("unroll") for (int k = 0; k < 2; ++k) dst[m][k] = *(const PG8_LAS bf16x8*)(lds + PG8_SA(b, h) + aoff + m * 2048 + k * 1024); } while (0)
#define PG8_LDB(dst, b, h) do { _Pragma("unroll") for (int n = 0; n < 2; ++n) _Pragma("unroll") for (int k = 0; k < 2; ++k) dst[n][k] = *(const PG8_LAS bf16x8*)(lds + PG8_SB(b, h) + boff + n * 2048 + k * 1024); } while (0)
#define PG8_MMA(ai, bj, At, Bt) do { __builtin_amdgcn_s_setprio(1); _Pragma("unroll") for (int m = 0; m < 4; ++m) _Pragma("unroll") for (int n = 0; n < 2; ++n) _Pragma("unroll") for (int k = 0; k < 2; ++k) \
        acc[ai][bj][m][n] = __builtin_amdgcn_mfma_f32_16x16x32_bf16(Bt[n][k], At[m][k], acc[ai][bj][m][n], 0, 0, 0); __builtin_amdgcn_s_setprio(0); } while (0)
#define PG8_WAIT_V(n) asm volatile("s_waitcnt vmcnt(" #n ")" ::: "memory")
#define PG8_WAIT_L(n) asm volatile("s_waitcnt lgkmcnt(" #n ")" ::: "memory")
#define PG8_BAR __builtin_amdgcn_s_barrier()
#define PG8_SCHED __builtin_amdgcn_sched_barrier(0)
    Unit cur, nxt; int ui = 0;
    if (!S.next(0, cur)) return;
    f32x4 acc[2][2][4][2];
#pragma unroll
    for (int a = 0; a < 2; ++a)
#pragma unroll
        for (int b = 0; b < 2; ++b)
#pragma unroll
            for (int m = 0; m < 4; ++m)
#pragma unroll
                for (int n = 0; n < 2; ++n) acc[a][b][m][n] = (f32x4){0.f, 0.f, 0.f, 0.f};
    bf16x8 At[4][2], B0[2][2], B1[2][2];
    const char* cA = (const char*)g.A + (size_t)cur.pm * tstep; const char* cB = (const char*)g.Bt + (size_t)cur.pn * tstep;
    S.a_ready(cur);
    PG8_STAGE(PG8_SB(0, 0), cB, voffB); PG8_STAGE(PG8_SA(0, 0), cA, voffA); PG8_STAGE(PG8_SB(0, 1), cB + hstep, voffB); PG8_STAGE(PG8_SA(0, 1), cA + hstep, voffA);
    if (wr == 1) PG8_BAR;
    PG8_WAIT_V(4); PG8_BAR;
    PG8_STAGE(PG8_SB(1, 0), cB + kstep, voffB); PG8_STAGE(PG8_SA(1, 0), cA + kstep, voffA); PG8_STAGE(PG8_SB(1, 1), cB + hstep + kstep, voffB);
    PG8_WAIT_V(6); PG8_BAR;
    PG8_STAMP();
    for (;;) {
        const bool has_next = S.next(ui + 1, nxt);
        const char* nA = has_next ? (const char*)g.A + (size_t)nxt.pm * tstep : cA; const char* nB = has_next ? (const char*)g.Bt + (size_t)nxt.pn * tstep : cB;
        for (int t = 0; t < nt; t += 2) {
            const bool last = (t == nt - 2);
            const char* a1 = cA + (size_t)(t + 1) * kstep;
            const char* a2 = last ? nA : cA + (size_t)(t + 2) * kstep; const char* b2 = last ? nB : cB + (size_t)(t + 2) * kstep;
            const char* a3 = a2 + kstep; const char* b3 = b2 + kstep;
            if (last && has_next) S.a_ready(nxt);
            PG8_LDB(B0, 0, 0); PG8_SCHED; PG8_LDA(At, 0, 0); PG8_STAGE(PG8_SA(1, 1), a1 + hstep, voffA);
            PG8_WAIT_L(8); PG8_BAR; PG8_WAIT_L(0); PG8_MMA(0, 0, At, B0); PG8_BAR; PG8_SCHED;
            PG8_LDB(B1, 0, 1); PG8_STAGE(PG8_SB(0, 0), b2, voffB);
            PG8_BAR; PG8_WAIT_L(0); PG8_MMA(0, 1, At, B1); PG8_BAR;
            PG8_LDA(At, 0, 1); PG8_STAGE(PG8_SA(0, 0), a2, voffA);
            PG8_BAR; PG8_WAIT_L(0); PG8_MMA(1, 0, At, B0); PG8_BAR; PG8_SCHED;
            PG8_STAGE(PG8_SB(0, 1), b2 + hstep, voffB);
            PG8_WAIT_V(6); PG8_BAR; PG8_MMA(1, 1, At, B1); PG8_BAR;
            PG8_LDB(B0, 1, 0); PG8_SCHED; PG8_LDA(At, 1, 0); PG8_STAGE(PG8_SA(0, 1), a2 + hstep, voffA);
            PG8_WAIT_L(8); PG8_BAR; PG8_WAIT_L(0); PG8_MMA(0, 0, At, B0); PG8_BAR; PG8_SCHED;
            PG8_LDB(B1, 1, 1); PG8_STAGE(PG8_SB(1, 0), b3, voffB);
            PG8_BAR; PG8_WAIT_L(0); PG8_MMA(0, 1, At, B1); PG8_BAR;
            PG8_LDA(At, 1, 1); PG8_STAGE(PG8_SA(1, 0), a3, voffA);
            PG8_BAR; PG8_WAIT_L(0); PG8_MMA(1, 0, At, B0); PG8_BAR; PG8_SCHED;
            PG8_STAGE(PG8_SB(1, 1), b3 + hstep, voffB);
            PG8_WAIT_V(6); PG8_BAR; PG8_MMA(1, 1, At, B1); PG8_BAR;
        }
        PG8_STAMP();
        if constexpr (!Epi::AFTER_DRAIN) { E(acc, cur, wr, wc, fr, fq); S.done(cur); }
        PG8_STAMP();
        if (!has_next) break;
#pragma unroll
        for (int a = 0; a < 2; ++a)
#pragma unroll
            for (int b = 0; b < 2; ++b)
#pragma unroll
                for (int m = 0; m < 4; ++m)
#pragma unroll
                    for (int n = 0; n < 2; ++n) acc[a][b][m][n] = (f32x4){0.f, 0.f, 0.f, 0.f};
        cur = nxt; cA = nA; cB = nB; ++ui;
    }
    PG8_WAIT_V(0);
    if (wr == 0) PG8_BAR;
    PG8_BAR;
    if constexpr (Epi::AFTER_DRAIN) { E.fused(acc, cur, wr, wc, fr, fq, lds, wid, lane); S.done(cur); }
    PG8_STAMP();
    if (STAMP && wid == 0) { stamps[lane] = lane < nts ? (((unsigned long long)(unsigned)ts_hi << 32) | (unsigned)ts_lo) : 0ull;
        if (lane == 62) stamps[62] = rt_entry; if (lane == 63) stamps[63] = (unsigned long long)wall_clock64(); }
#undef PG8_STAMP
#undef PG8_SA
#undef PG8_SB
#undef PG8_STAGE
#undef PG8_LDA
#undef PG8_LDB
#undef PG8_MMA
#undef PG8_WAIT_V
#undef PG8_WAIT_L
#undef PG8_BAR
#undef PG8_SCHED
}
}

constexpr int D = 1024, NB = 16, S = 2048, T = NB * S;
constexpr int NCOL = 2840, NPAD = 3072;
constexpr int C_Q = 0, C_KC = 512, C_VC = 640, C_KS = 768, C_VS = 896, C_KW = 1024, C_VW = 1152, C_GT = 1280, C_CB = 1304, C_CC = 1816, C_CH = 2328;
constexpr int NCMP = 127;
constexpr int NEXP = 16384;
constexpr float EPS = 1e-6f;
constexpr int NTHREADS = 512, NWAVES = 8;

constexpr size_t al256(size_t x) { return (x + 255) & ~(size_t)255; }
constexpr size_t WS_CTL   = 0;                                   constexpr size_t CTL_BYTES = 65536;
constexpr size_t WS_MOD   = WS_CTL + CTL_BYTES;
constexpr size_t WS_WIN   = al256(WS_MOD + (size_t)16 * 6144 * 4);
constexpr size_t WS_WOUT  = al256(WS_WIN + (size_t)NPAD * D * 2);
constexpr size_t WS_WQ    = al256(WS_WOUT + (size_t)D * D * 2);
constexpr size_t WS_KEYS  = al256(WS_WQ + (size_t)D * D * 2);
constexpr size_t WS_U8S   = al256(WS_KEYS + (size_t)16 * 128 * 64 * 2);
constexpr size_t WS_V8S   = al256(WS_U8S + (size_t)NEXP * D);
constexpr size_t WS_X8S   = al256(WS_V8S + (size_t)NEXP * D);
constexpr size_t WS_SU    = al256(WS_X8S + (size_t)T * D);
constexpr size_t WS_SV    = al256(WS_SU + (size_t)NEXP * 4);
constexpr size_t WS_SX    = al256(WS_SV + (size_t)NEXP * 4);
constexpr size_t WS_W1T   = al256(WS_SX + (size_t)T * 4);
constexpr size_t WS_W2T   = al256(WS_W1T + (size_t)2 * 64 * 2048 * 2);
constexpr size_t WS_PEC   = al256(WS_W2T + (size_t)2 * 64 * 64 * 2);
constexpr size_t WS_KC    = al256(WS_PEC + (size_t)2 * 64 * 4);
constexpr size_t WS_VC    = al256(WS_KC + (size_t)16 * 2 * 128 * 64 * 2);
constexpr size_t WS_H     = al256(WS_VC + (size_t)16 * 2 * 128 * 64 * 2);
constexpr size_t WS_CQ8   = WS_H;
constexpr size_t WS_CMAX  = WS_H + (size_t)32 * 1024 * 1024;
constexpr size_t WS_SSQP  = WS_H + (size_t)33 * 1024 * 1024;
constexpr size_t WS_OATT  = al256(WS_H + (size_t)T * D * 2);
constexpr size_t WS_PROJ  = al256(WS_OATT + (size_t)T * 512 * 2);
constexpr size_t WS_QP    = WS_PROJ;
constexpr size_t WS_PART  = WS_PROJ;
constexpr size_t WS_PO    = WS_PROJ;
constexpr size_t WS_E16   = WS_PROJ + (size_t)160 * 1024 * 1024;
constexpr size_t WS_EW    = WS_E16 + (size_t)T * 128 * 4;
constexpr size_t WS_END   = al256(WS_PROJ + (size_t)T * NPAD * 2);
static_assert(WS_EW + (size_t)T * 128 * 4 <= WS_END, "alias region");
static_assert((size_t)8 * T * 128 * 4 <= (size_t)160 * 1024 * 1024, "PART fits under EIDX");
constexpr int CTL_CTR_A = 16384, CTL_CTR_B = 16384 + 8 * 256;

constexpr int LDS_STAGE = 147456;
constexpr int LDS_MISC_OFF = LDS_STAGE;
constexpr int LDS_BYTES = LDS_STAGE + 256;

typedef unsigned short bf16_t;
typedef short bf16x8 __attribute__((ext_vector_type(8)));
typedef short s16x4 __attribute__((ext_vector_type(4)));
typedef float f32x4 __attribute__((ext_vector_type(4)));
typedef unsigned u32x4v __attribute__((ext_vector_type(4)));
__device__ __forceinline__ float bf2f(bf16_t b) { return __uint_as_float(((unsigned)b) << 16); }
__device__ __forceinline__ bf16_t f2bf(float f) { unsigned u = __float_as_uint(f); u += 0x7FFFu + ((u >> 16) & 1u); return (bf16_t)(u >> 16); }
__device__ __forceinline__ float bflo(unsigned w) { return __uint_as_float(w << 16); }
__device__ __forceinline__ float bfhi(unsigned w) { return __uint_as_float(w & 0xFFFF0000u); }
__device__ __forceinline__ unsigned pack2(float lo, float hi) { return (unsigned)f2bf(lo) | ((unsigned)f2bf(hi) << 16); }
__device__ __forceinline__ float gelu_tanh(float x) { const float u = 0.7978845608028654f * (x + 0.044715f * x * x * x); return 0.5f * x * (1.0f + tanhf(u)); }
__device__ __forceinline__ float sigmoidf_(float x) { return 1.0f / (1.0f + __expf(-x)); }
__device__ __forceinline__ float wave_sum(float v) {
#pragma unroll
    for (int o = 32; o >= 1; o >>= 1) v += __shfl_xor(v, o);
    return v; }
__device__ __forceinline__ float wave_max(float v) {
#pragma unroll
    for (int o = 32; o >= 1; o >>= 1) v = fmaxf(v, __shfl_xor(v, o));
    return v; }
__device__ __forceinline__ void lds_wave_sync() { asm volatile("s_waitcnt lgkmcnt(0)" ::: "memory"); }
#ifdef PROBE_STAMP
#define STAMP_DECL unsigned long long tprev_ = 0ull; const bool dbg_ = (PROBE_PHASE == 12 || blockIdx.x == PROBE_BLOCK) && (threadIdx.x == 0);
#define STAMP_START() do { if (dbg_) tprev_ = __builtin_amdgcn_s_memtime(); } while (0)
#define STAMP(k) do { if (dbg_) { const unsigned long long tn_ = __builtin_amdgcn_s_memtime(); volatile LAS unsigned* c_ = (volatile LAS unsigned*)(F_lds_ + LDS_MISC_OFF + 128); c_[k] += (unsigned)(tn_ - tprev_); tprev_ = tn_; } } while (0)
#define STAMP_COUNT(k) do { if (dbg_) { volatile LAS unsigned* c_ = (volatile LAS unsigned*)(F_lds_ + LDS_MISC_OFF + 128); c_[k] += 1u; } } while (0)
#else
#define STAMP_DECL
#define STAMP_START() do {} while (0)
#define STAMP(k) do {} while (0)
#define STAMP_COUNT(k) do {} while (0)
#endif
#ifndef PROBE_BLOCK
#define PROBE_BLOCK 0
#endif
#ifndef PROBE_PHASE
#define PROBE_PHASE 4
#endif

__device__ __forceinline__ int rel_bucket(int dist) {
    const int n = dist > 0 ? dist : 0;
    if (n < 16) return n;
    const float lr = logf((float)n / 16.0f) / 2.0794415416798357f;
    const int large = 16 + (int)(lr * 16.0f);
    return large < 31 ? large : 31;
}

struct Frame {
    const float* in[23]; float* out; unsigned char* ws;
    LAS unsigned char* lds; int tid, lane, wave, G;
};


typedef int i32x4v __attribute__((ext_vector_type(4)));
constexpr int PEER_CHUNK_TOK = 128, PEER_NCHUNK = T / PEER_CHUNK_TOK;

__device__ __forceinline__ void quant_row_sliced(const float* row, unsigned char* dst8  , size_t nrows, size_t r, float* scale_out, int bias, int lane) {
    float4 v[4]; float am = 0.f;
#pragma unroll
    for (int i = 0; i < 4; ++i) { v[i] = *(const float4*)(row + (lane + 64 * i) * 4); am = fmaxf(am, fmaxf(fmaxf(fabsf(v[i].x), fabsf(v[i].y)), fmaxf(fabsf(v[i].z), fabsf(v[i].w)))); }
    am = wave_max(am); const float inv = am > 0.f ? 127.0f / am : 0.f;
    if (lane == 0) *scale_out = am > 0.f ? am / 127.0f : 0.f;
#pragma unroll
    for (int i = 0; i < 4; ++i) { const int col = (lane + 64 * i) * 4; const int sl = col >> 7, off = col & 127;
        const int q0 = (int)rintf(v[i].x * inv) + bias, q1 = (int)rintf(v[i].y * inv) + bias, q2 = (int)rintf(v[i].z * inv) + bias, q3 = (int)rintf(v[i].w * inv) + bias;
        *(unsigned*)(dst8 + ((size_t)sl * nrows + r) * 128 + off) = (unsigned)(q0 & 0xFF) | ((unsigned)(q1 & 0xFF) << 8) | ((unsigned)(q2 & 0xFF) << 16) | ((unsigned)(q3 & 0xFF) << 24); }
}

constexpr int PEER_NGRP = T / 16;
__device__ __forceinline__ int grab_item(unsigned* ctr, int slice, int lane) {
    unsigned v = 0u; if (lane == 0) v = __hip_atomic_fetch_add(ctr + slice * 64, 1u, __ATOMIC_RELAXED, __HIP_MEMORY_SCOPE_AGENT);
    return (int)__builtin_amdgcn_readfirstlane(v);
}
__device__ __forceinline__ void gather_rows16(u32x4v (&vv)[16], const unsigned char* base, const LAS unsigned* le) {
    const u32x4v e0 = *(const LAS u32x4v*)le, e1 = *(const LAS u32x4v*)(le + 4);
#pragma unroll
    for (int ld = 0; ld < 16; ++ld) { const unsigned w = ld < 8 ? e0[ld >> 1] : e1[(ld - 8) >> 1]; const unsigned e = (ld & 1) ? (w >> 16) : (w & 0xFFFFu);
        vv[ld] = *(const u32x4v*)(base + (size_t)e * 128); }
}
__device__ __forceinline__ void udot_item(const u32x4v (&uv)[16], const i32x4v xq, int* part_row  , int c) {
    i32x4v res[4];
#pragma unroll
    for (int ld = 0; ld < 16; ++ld) { int p = __builtin_amdgcn_sdot4((int)uv[ld][0], xq[0], 0, false); p = __builtin_amdgcn_sdot4((int)uv[ld][1], xq[1], p, false);
        p = __builtin_amdgcn_sdot4((int)uv[ld][2], xq[2], p, false); p = __builtin_amdgcn_sdot4((int)uv[ld][3], xq[3], p, false);
        p += __shfl_xor(p, 1); p += __shfl_xor(p, 2); p += __shfl_xor(p, 4); res[ld >> 2][ld & 3] = p; }
    if (c == 0) {
#pragma unroll
        for (int q = 0; q < 4; ++q) *(i32x4v*)(part_row + 4 * q) = res[q]; }
}
__device__ __forceinline__ void p10a_udots(const Frame& F) {
    const unsigned char* U8S = F.ws + WS_U8S; const unsigned char* X8S = F.ws + WS_X8S; const unsigned short* E16 = (const unsigned short*)(F.ws + WS_E16); int* PART = (int*)(F.ws + WS_PART);
    unsigned* ctr = (unsigned*)(F.ws + WS_CTL + CTL_CTR_A);
    const int lane = F.lane, j = lane >> 3, c = lane & 7; const int xcc = (int)(xb_xcc_id() & 7u);
    LAS unsigned char* wl = F.lds + F.wave * 8192;
    const LAS unsigned* le = (const LAS unsigned*)wl + 8 * j;
    for (int so = 0; so < 8; ++so) { const int x = (xcc + so) & 7;
        const unsigned char* ub = U8S + (size_t)x * NEXP * 128 + c * 16;
        int nxt = grab_item(ctr, x, lane);
        for (;;) { const int cur = nxt; if (cur >= PEER_NGRP) break;
            nxt = grab_item(ctr, x, lane);
            const int t0 = cur * 16;
            { const u32x4v* src = (const u32x4v*)(E16 + (size_t)t0 * 128);
#pragma unroll
                for (int i = 0; i < 4; ++i) *(LAS u32x4v*)(wl + (lane + 64 * i) * 16) = src[lane + 64 * i]; }
            lds_wave_sync();
            const unsigned char* xb = X8S + ((size_t)x * T + t0) * 128 + c * 16; int* pr = PART + ((size_t)x * T + t0) * 128 + 16 * j;
            u32x4v va[16], vb[16];
            gather_rows16(va, ub, le);
#pragma unroll 1
            for (int tt = 0; tt < 16; tt += 2) {
                const i32x4v xqa = *(const i32x4v*)(xb + (size_t)tt * 128), xqb = *(const i32x4v*)(xb + (size_t)(tt + 1) * 128);
                gather_rows16(vb, ub, le + (tt + 1) * 64);
                udot_item(va, xqa, pr + (size_t)tt * 128, c);
                if (tt + 2 < 16) gather_rows16(va, ub, le + (tt + 2) * 64);
                udot_item(vb, xqb, pr + (size_t)(tt + 1) * 128, c);
            }
            lds_wave_sync();
        }
    }
}

__device__ __forceinline__ void p10b_coef(const Frame& F) {
    const unsigned short* E16 = (const unsigned short*)(F.ws + WS_E16); const float* EW = (const float*)(F.ws + WS_EW); const int* PART = (const int*)(F.ws + WS_PART);
    const float* SU = (const float*)(F.ws + WS_SU); const float* SV = (const float*)(F.ws + WS_SV); const float* SX = (const float*)(F.ws + WS_SX);
    signed char* CQ8 = (signed char*)(F.ws + WS_CQ8); float* CMAX = (float*)(F.ws + WS_CMAX);
    const int gw = blockIdx.x * NWAVES + F.wave, nw = F.G * NWAVES, lane = F.lane;
    for (int t = gw; t < T; t += nw) { const float sx = SX[t]; float cs[2]; float am = 0.f;
#pragma unroll
        for (int hh = 0; hh < 2; ++hh) { const int i = lane + 64 * hh; int s = 0;
#pragma unroll
            for (int x = 0; x < 8; ++x) s += PART[((size_t)x * T + t) * 128 + i];
            const int e = E16[(size_t)t * 128 + i]; const float dot = (float)s * sx * SU[e];
            cs[hh] = EW[(size_t)t * 128 + i] * gelu_tanh(dot) * SV[e]; am = fmaxf(am, fabsf(cs[hh])); }
        am = wave_max(am); const float inv = am > 0.f ? 127.0f / am : 0.f;
#pragma unroll
        for (int hh = 0; hh < 2; ++hh) CQ8[(size_t)t * 128 + lane + 64 * hh] = (signed char)(int)rintf(cs[hh] * inv);
        if (lane == 0) CMAX[t] = am > 0.f ? am / 127.0f : 0.f; }
}

struct VsumPre { float sc; };
__device__ __forceinline__ void vsum_item(const u32x4v (&vv)[16], const LAS unsigned* lq  , const VsumPre& pre, unsigned* pop, int lane) {
    const u32x4v cq = *(const LAS u32x4v*)lq;
    int acc[16];
#pragma unroll
    for (int k = 0; k < 16; ++k) acc[k] = 0;
#pragma unroll
    for (int g = 0; g < 4; ++g) { const int cw = (int)cq[g];
#pragma unroll
        for (int w = 0; w < 4; ++w) { const unsigned r0 = vv[4 * g][w], r1 = vv[4 * g + 1][w], r2 = vv[4 * g + 2][w], r3 = vv[4 * g + 3][w];
            const unsigned t0 = __builtin_amdgcn_perm(r1, r0, 0x05010400u), t1 = __builtin_amdgcn_perm(r1, r0, 0x07030602u), t2 = __builtin_amdgcn_perm(r3, r2, 0x05010400u), t3 = __builtin_amdgcn_perm(r3, r2, 0x07030602u);
            const unsigned c0 = __builtin_amdgcn_perm(t2, t0, 0x05040100u), c1 = __builtin_amdgcn_perm(t2, t0, 0x07060302u), c2 = __builtin_amdgcn_perm(t3, t1, 0x05040100u), c3 = __builtin_amdgcn_perm(t3, t1, 0x07060302u);
            acc[4 * w + 0] = __builtin_amdgcn_sdot4((int)c0, cw, acc[4 * w + 0], false); acc[4 * w + 1] = __builtin_amdgcn_sdot4((int)c1, cw, acc[4 * w + 1], false);
            acc[4 * w + 2] = __builtin_amdgcn_sdot4((int)c2, cw, acc[4 * w + 2], false); acc[4 * w + 3] = __builtin_amdgcn_sdot4((int)c3, cw, acc[4 * w + 3], false); } }
    int a8[8], a4[4], a2[2];
    { const bool hi = (lane & 32) != 0;
#pragma unroll
        for (int k = 0; k < 8; ++k) { const int snd = hi ? acc[k] : acc[k + 8]; const int rcv = __shfl_xor(snd, 32); a8[k] = (hi ? acc[k + 8] : acc[k]) + rcv; } }
    { const bool hi = (lane & 16) != 0;
#pragma unroll
        for (int k = 0; k < 4; ++k) { const int snd = hi ? a8[k] : a8[k + 4]; const int rcv = __shfl_xor(snd, 16); a4[k] = (hi ? a8[k + 4] : a8[k]) + rcv; } }
    { const bool hi = (lane & 8) != 0;
#pragma unroll
        for (int k = 0; k < 2; ++k) { const int snd = hi ? a4[k] : a4[k + 2]; const int rcv = __shfl_xor(snd, 8); a2[k] = (hi ? a4[k + 2] : a4[k]) + rcv; } }
    *pop = pg8::cvt_pk_bf16((float)a2[0] * pre.sc, (float)a2[1] * pre.sc);
}
__device__ __forceinline__ void p10c_vsum(const Frame& F) {
    const unsigned char* V8S = F.ws + WS_V8S; const unsigned short* E16 = (const unsigned short*)(F.ws + WS_E16); const signed char* CQ8 = (const signed char*)(F.ws + WS_CQ8); const float* CMAX = (const float*)(F.ws + WS_CMAX);
    bf16_t* PO = (bf16_t*)(F.ws + WS_PO);
    unsigned* ctr = (unsigned*)(F.ws + WS_CTL + CTL_CTR_B);
    const int lane = F.lane, j = lane >> 3, c = lane & 7; const int xcc = (int)(xb_xcc_id() & 7u);
    const int ocol = 16 * c + 8 * ((lane >> 5) & 1) + 4 * ((lane >> 4) & 1) + 2 * ((lane >> 3) & 1);
    LAS unsigned char* wl = F.lds + F.wave * 8192;
    const LAS unsigned* le = (const LAS unsigned*)wl + 8 * j; const LAS unsigned* lq = (const LAS unsigned*)(wl + 4096) + 4 * j;
    for (int so = 0; so < 8; ++so) { const int x = (xcc + so) & 7;
        const unsigned char* vb = V8S + (size_t)x * NEXP * 128 + c * 16;
        const int col = x * 128 + ocol;
        int nxt = grab_item(ctr, x, lane);
        for (;;) { const int cur = nxt; if (cur >= PEER_NGRP) break;
            nxt = grab_item(ctr, x, lane);
            const int t0 = cur * 16;
            { const u32x4v* src = (const u32x4v*)(E16 + (size_t)t0 * 128); const u32x4v* srq = (const u32x4v*)(CQ8 + (size_t)t0 * 128);
#pragma unroll
                for (int i = 0; i < 4; ++i) *(LAS u32x4v*)(wl + (lane + 64 * i) * 16) = src[lane + 64 * i];
#pragma unroll
                for (int i = 0; i < 2; ++i) *(LAS u32x4v*)(wl + 4096 + (lane + 64 * i) * 16) = srq[lane + 64 * i]; }
            lds_wave_sync();
            u32x4v va[16], vbb[16];
            gather_rows16(va, vb, le);
#pragma unroll 1
            for (int tt = 0; tt < 16; tt += 2) {
                { VsumPre pa; pa.sc = CMAX[t0 + tt];
                  gather_rows16(vbb, vb, le + (tt + 1) * 64);
                  vsum_item(va, lq + tt * 32, pa, (unsigned*)(PO + (size_t)(t0 + tt) * D + col), lane); }
                { VsumPre pb; pb.sc = CMAX[t0 + tt + 1];
                  if (tt + 2 < 16) gather_rows16(va, vb, le + (tt + 2) * 64);
                  vsum_item(vbb, lq + (tt + 1) * 32, pb, (unsigned*)(PO + (size_t)(t0 + tt + 1) * D + col), lane); }
            }
            lds_wave_sync();
        }
    }
}

__device__ __forceinline__ void p10d_final(const Frame& F) {
    const bf16_t* PO = (const bf16_t*)(F.ws + WS_PO); const float* MOD = (const float*)(F.ws + WS_MOD); const float* gfin = F.in[22]; float* out = F.out;
    const int gw = blockIdx.x * NWAVES + F.wave, nw = F.G * NWAVES, lane = F.lane;
    for (int t = gw; t < T; t += nw) { const int b = t / S;
        float4 v[4]; float ss = 0.f;
#pragma unroll
        for (int i = 0; i < 4; ++i) { const int col = (lane + 64 * i) * 4; const float4 x1 = *(const float4*)(out + (size_t)t * D + col), gt = *(const float4*)(MOD + b * 6144 + 5120 + col);
            const uint2 pw = *(const uint2*)(PO + (size_t)t * D + col);
            v[i].x = x1.x + gt.x * bflo(pw.x); v[i].y = x1.y + gt.y * bfhi(pw.x); v[i].z = x1.z + gt.z * bflo(pw.y); v[i].w = x1.w + gt.w * bfhi(pw.y);
            ss += v[i].x * v[i].x + v[i].y * v[i].y + v[i].z * v[i].z + v[i].w * v[i].w; }
        ss = wave_sum(ss);
#ifdef PROBE_STAMP
        const unsigned* dg = (const unsigned*)(F.ws + WS_CTL + 32768); const float pnum = (float)dg[PROBE_STAMP]; const float pden = PROBE_DEN >= 0 ? (float)dg[PROBE_DEN >= 0 ? PROBE_DEN : 0] : (float)PROBE_ABS;
        const float rstd = rsqrtf(ss * (1.0f / D) + EPS) * (1.0f + 0.5f * pnum / pden);
#else
        const float rstd = rsqrtf(ss * (1.0f / D) + EPS);
#endif
#pragma unroll
        for (int i = 0; i < 4; ++i) { const int col = (lane + 64 * i) * 4; const float4 gg = *(const float4*)(gfin + col);
            *(float4*)(out + (size_t)t * D + col) = make_float4(v[i].x * rstd * gg.x, v[i].y * rstd * gg.y, v[i].z * rstd * gg.z, v[i].w * rstd * gg.w); }
    }
}

__device__ __forceinline__ void transpose_tile(const Frame& F, const float* src, int srcK, int srcN, bf16_t* dst, int dstK, int kt, int nt) {
    LAS float* tile = (LAS float*)F.lds;
    const int k0 = kt * 64, n0 = nt * 64;
    for (int i = F.tid; i < 4096; i += NTHREADS) { const int r = i >> 6, c = i & 63; const int k = k0 + r, n = n0 + c;
        tile[r * 65 + c] = (k < srcK && n < srcN) ? src[(size_t)k * srcN + n] : 0.0f; }
    __syncthreads();
    for (int i = F.tid; i < 4096; i += NTHREADS) { const int r = i >> 6, c = i & 63;
        dst[(size_t)(n0 + r) * dstK + k0 + c] = f2bf(tile[c * 65 + r]); }
    __syncthreads();
}
__device__ __forceinline__ void p0_prologue(const Frame& F, int item_lo = 0, int item_hi = 1 << 30) {
    const float* c = F.in[1]; const float* w_mod = F.in[4]; const float* b_mod = F.in[5];
    float* MOD = (float*)(F.ws + WS_MOD);
    constexpr int I_MOD = 96, I_WIN = 16 * 48, I_WOUT = 256, I_WQ = 256, I_U = 256, I_V = 256, I_KEYS = 2, I_CMP = 32 + 32 + 1 + 1 + 2;
    constexpr int O_WIN = I_MOD, O_WOUT = O_WIN + I_WIN, O_WQ = O_WOUT + I_WOUT, O_U = O_WQ + I_WQ, O_V = O_U + I_U, O_KEYS = O_V + I_V, O_CMP = O_KEYS + I_KEYS, N_ITEMS = O_CMP + I_CMP;
    for (int it = item_lo + blockIdx.x; it < N_ITEMS && it < item_hi; it += F.G) {
        if (it < O_WIN) {
            LAS float* sl = (LAS float*)F.lds; LAS float* red = (LAS float*)(F.lds + 65536);
            for (int q = F.tid; q < 16 * D; q += NTHREADS) { const float cv = c[q]; sl[q] = cv / (1.0f + __expf(-cv)); }
            __syncthreads();
            const int kg = F.tid >> 6, cl = F.tid & 63, j0 = it * 64;
            float acc[16];
#pragma unroll
            for (int bb = 0; bb < 16; ++bb) acc[bb] = 0.f;
            const float* wp = w_mod + (size_t)(kg * 128) * 6144 + j0 + cl;
#pragma unroll 4
            for (int kk = 0; kk < 128; ++kk) { const float w = wp[(size_t)kk * 6144]; const int k = kg * 128 + kk;
#pragma unroll
                for (int bb = 0; bb < 16; ++bb) acc[bb] += sl[bb * D + k] * w; }
#pragma unroll
            for (int bb = 0; bb < 16; ++bb) red[(kg * 16 + bb) * 64 + cl] = acc[bb];
            __syncthreads();
#pragma unroll
            for (int q = 0; q < 2; ++q) { const int o = F.tid + 512 * q; const int bb = o >> 6, cc = o & 63; float s = b_mod[j0 + cc];
#pragma unroll
                for (int g8 = 0; g8 < 8; ++g8) s += red[(g8 * 16 + bb) * 64 + cc];
                MOD[bb * 6144 + j0 + cc] = s; }
            __syncthreads();
        } else if (it < O_WOUT) { const int i = it - O_WIN; transpose_tile(F, F.in[6], D, NCOL, (bf16_t*)(F.ws + WS_WIN), D, i % 16, i / 16); }
        else if (it < O_WQ) { const int i = it - O_WOUT; transpose_tile(F, F.in[16], D, D, (bf16_t*)(F.ws + WS_WOUT), D, i % 16, i / 16); }
        else if (it < O_U) { const int i = it - O_WQ; transpose_tile(F, F.in[17], D, D, (bf16_t*)(F.ws + WS_WQ), D, i % 16, i / 16); }
        else if (it < O_KEYS) {
            const bool isv = it >= O_V; const int i = isv ? it - O_V : it - O_U;
            for (int rr = 0; rr < 8; ++rr) { const size_t r = (size_t)i * 64 + rr * 8 + F.wave;
                quant_row_sliced((isv ? F.in[20] : F.in[19]) + r * D, F.ws + (isv ? WS_V8S : WS_U8S), NEXP, r, (float*)(F.ws + (isv ? WS_SV : WS_SU)) + r, 0, F.lane); }
        } else if (it >= O_CMP) {
            const int i = it - O_CMP;
            if (i < 64) { const int kv = i >> 5; transpose_tile(F, kv ? F.in[11] : F.in[9], 2048, 64, (bf16_t*)(F.ws + WS_W1T) + (size_t)kv * 64 * 2048, 2048, i & 31, 0); }
            else if (i < 66) { const int kv = i - 64; transpose_tile(F, kv ? F.in[12] : F.in[10], 64, 64, (bf16_t*)(F.ws + WS_W2T) + (size_t)kv * 64 * 64, 64, 0, 0); }
            else { const int kv = i - 66; const float* pe = kv ? F.in[8] : F.in[7]; const float* w1 = kv ? F.in[11] : F.in[9];
                LAS float* red = (LAS float*)F.lds; const int jj = F.tid & 63, kg = F.tid >> 6; float a = 0.f;
#pragma unroll 8
                for (int kk = 0; kk < 256; ++kk) { const int k = kg * 256 + kk; a += pe[k] * w1[(size_t)k * 64 + jj]; }
                red[kg * 64 + jj] = a; __syncthreads();
                if (F.tid < 64) { float s = 0.f;
#pragma unroll
                    for (int g8 = 0; g8 < 8; ++g8) s += red[g8 * 64 + F.tid];
                    ((float*)(F.ws + WS_PEC))[kv * 64 + F.tid] = s; }
                __syncthreads(); }
        } else {
            const int i = it - O_KEYS; const float4* src = (const float4*)F.in[18] + (size_t)i * 16384; uint2* dst = (uint2*)(F.ws + WS_KEYS) + (size_t)i * 16384;
            for (int q = F.tid; q < 16384; q += NTHREADS) { const float4 v = src[q]; dst[q] = make_uint2(pack2(v.x, v.y), pack2(v.z, v.w)); }
        }
    }
}

__device__ __forceinline__ void norm_mod_rows(const Frame& F, const float* x, const float* g, int sh_off, int sc_off, bf16_t* dst) {
    const float* MOD = (const float*)(F.ws + WS_MOD);
    const int gw = blockIdx.x * NWAVES + F.wave, nw = F.G * NWAVES;
    for (int t = gw; t < T; t += nw) {
        const int b = t / S; const float4* xr = (const float4*)(x + (size_t)t * D);
        float4 v[4]; float ss = 0.f;
#pragma unroll
        for (int i = 0; i < 4; ++i) { v[i] = xr[F.lane + 64 * i]; ss += v[i].x * v[i].x + v[i].y * v[i].y + v[i].z * v[i].z + v[i].w * v[i].w; }
        ss = wave_sum(ss); const float rstd = rsqrtf(ss * (1.0f / D) + EPS);
#pragma unroll
        for (int i = 0; i < 4; ++i) { const int col = (F.lane + 64 * i) * 4;
            const float4 gg = *(const float4*)(g + col), sc = *(const float4*)(MOD + b * 6144 + sc_off + col), sh = *(const float4*)(MOD + b * 6144 + sh_off + col);
            const float o0 = v[i].x * rstd * gg.x * (1.f + sc.x) + sh.x, o1 = v[i].y * rstd * gg.y * (1.f + sc.y) + sh.y, o2 = v[i].z * rstd * gg.z * (1.f + sc.z) + sh.z, o3 = v[i].w * rstd * gg.w * (1.f + sc.w) + sh.w;
            *(uint2*)(dst + (size_t)t * D + col) = make_uint2(pack2(o0, o1), pack2(o2, o3)); }
    }
}

__device__ __forceinline__ void norm_mod_rows_q(const Frame& F, const float* x, const float* g, int sh_off, int sc_off, bf16_t* dst) {
    const float* MOD = (const float*)(F.ws + WS_MOD);
    const int gw = blockIdx.x * NWAVES + F.wave, nw = F.G * NWAVES;
    for (int t = gw; t < T; t += nw) {
        const int b = t / S; const float4* xr = (const float4*)(x + (size_t)t * D);
        float4 v[4]; float ss = 0.f;
#pragma unroll
        for (int i = 0; i < 4; ++i) { v[i] = xr[F.lane + 64 * i]; ss += v[i].x * v[i].x + v[i].y * v[i].y + v[i].z * v[i].z + v[i].w * v[i].w; }
        ss = wave_sum(ss); const float rstd = rsqrtf(ss * (1.0f / D) + EPS);
        float am = 0.f;
#pragma unroll
        for (int i = 0; i < 4; ++i) { const int col = (F.lane + 64 * i) * 4;
            const float4 gg = *(const float4*)(g + col), sc = *(const float4*)(MOD + b * 6144 + sc_off + col), sh = *(const float4*)(MOD + b * 6144 + sh_off + col);
            v[i].x = v[i].x * rstd * gg.x * (1.f + sc.x) + sh.x; v[i].y = v[i].y * rstd * gg.y * (1.f + sc.y) + sh.y; v[i].z = v[i].z * rstd * gg.z * (1.f + sc.z) + sh.z; v[i].w = v[i].w * rstd * gg.w * (1.f + sc.w) + sh.w;
            *(uint2*)(dst + (size_t)t * D + col) = make_uint2(pack2(v[i].x, v[i].y), pack2(v[i].z, v[i].w));
            am = fmaxf(am, fmaxf(fmaxf(fabsf(v[i].x), fabsf(v[i].y)), fmaxf(fabsf(v[i].z), fabsf(v[i].w)))); }
        am = wave_max(am); const float inv = am > 0.f ? 127.0f / am : 0.f;
        if (F.lane == 0) ((float*)(F.ws + WS_SX))[t] = am > 0.f ? am / 127.0f : 0.f;
#pragma unroll
        for (int i = 0; i < 4; ++i) { const int col = (F.lane + 64 * i) * 4; const int sl = col >> 7, off = col & 127;
            const int q0 = (int)rintf(v[i].x * inv), q1 = (int)rintf(v[i].y * inv), q2 = (int)rintf(v[i].z * inv), q3 = (int)rintf(v[i].w * inv);
            *(unsigned*)(F.ws + WS_X8S + ((size_t)sl * T + t) * 128 + off) = (unsigned)(q0 & 0xFF) | ((unsigned)(q1 & 0xFF) << 8) | ((unsigned)(q2 & 0xFF) << 16) | ((unsigned)(q3 & 0xFF) << 24); }
    }
}

__device__ __forceinline__ void p3_compress_naive(const Frame& F) {
    const bf16_t* PROJ = (const bf16_t*)(F.ws + WS_PROJ);
    LAS float* hid = (LAS float*)F.lds + F.wave * 64;
    const int gw = blockIdx.x * NWAVES + F.wave, nw = F.G * NWAVES;
    if (gw < 64) { bf16_t* dz = (bf16_t*)(F.ws + ((gw & 1) ? WS_VC : WS_KC)); dz[((size_t)(gw >> 1) * 128 + 127) * 64 + F.lane] = 0; }
    for (int u = gw; u < NB * NCMP * 2 * 2; u += nw) {
        const int kv = u & 1, g = (u >> 1) & 1, n = (u >> 2) % NCMP, b = (u >> 2) / NCMP;
        const float* pe = kv ? F.in[8] : F.in[7]; const float* w1 = kv ? F.in[11] : F.in[9]; const float* w2 = kv ? F.in[12] : F.in[10];
        const int cbase = (kv ? C_VC : C_KC) + g * 64;
        float acc = 0.f;
        for (int l = 0; l < 32; ++l) {
            const bf16_t* row = PROJ + (size_t)(b * S + 16 * n + l) * NPAD + cbase;
            for (int d = 0; d < 64; ++d) { const float a = bf2f(row[d]) + pe[l * 64 + d]; acc += a * w1[(size_t)(l * 64 + d) * 64 + F.lane]; }
        }
        hid[F.lane] = gelu_tanh(acc); lds_wave_sync();
        float o = 0.f;
        for (int j = 0; j < 64; ++j) o += hid[j] * w2[j * 64 + F.lane];
        bf16_t* dst = (bf16_t*)(F.ws + (kv ? WS_VC : WS_KC)); dst[((size_t)(b * 2 + g) * 128 + n) * 64 + F.lane] = f2bf(o);
        lds_wave_sync();
    }
}


__device__ __forceinline__ void p3_compress_mfma(const Frame& F) {
    const bf16_t* PROJ = (const bf16_t*)(F.ws + WS_PROJ);
    const int lane = F.lane, tid = F.tid, wave = F.wave, grp = lane >> 4, col = lane & 15;
    LAS float* red = (LAS float*)F.lds;
    LAS bf16_t* hid = (LAS bf16_t*)(F.lds + 32768);
    if (blockIdx.x * NWAVES + wave < 64) { const int gw = blockIdx.x * NWAVES + wave; bf16_t* dz = (bf16_t*)(F.ws + ((gw & 1) ? WS_VC : WS_KC)); dz[((size_t)(gw >> 1) * 128 + 127) * 64 + lane] = 0; }
    for (int u = blockIdx.x; u < NB * 2 * 2 * 8; u += F.G) {
        const int nt8 = u & 7, kv = (u >> 3) & 1, g = (u >> 4) & 1, b = u >> 5; const int n0 = nt8 * 16;
        const bf16_t* W1T = (const bf16_t*)(F.ws + WS_W1T) + (size_t)kv * 64 * 2048; const bf16_t* W2T = (const bf16_t*)(F.ws + WS_W2T) + (size_t)kv * 64 * 64;
        const float* pec = (const float*)(F.ws + WS_PEC) + kv * 64;
        const int cbase = (kv ? C_VC : C_KC) + g * 64;
        const int nrow = (n0 + col) < NCMP ? (n0 + col) : (NCMP - 1);
        f32x4 acc[4];
#pragma unroll
        for (int nt = 0; nt < 4; ++nt) acc[nt] = (f32x4){0.f, 0.f, 0.f, 0.f};
#pragma unroll
        for (int ks = 0; ks < 8; ++ks) { const int l = 4 * wave + (ks >> 1), d0 = (ks & 1) * 32 + 8 * grp;
            const bf16x8 af = *(const bf16x8*)(PROJ + (size_t)(b * S + 16 * nrow + l) * NPAD + cbase + d0);
#pragma unroll
            for (int nt = 0; nt < 4; ++nt) { const bf16x8 bfr = *(const bf16x8*)(W1T + (size_t)(nt * 16 + col) * 2048 + l * 64 + d0);
                acc[nt] = __builtin_amdgcn_mfma_f32_16x16x32_bf16(af, bfr, acc[nt], 0, 0, 0); } }
#pragma unroll
        for (int nt = 0; nt < 4; ++nt)
#pragma unroll
            for (int rg = 0; rg < 4; ++rg) red[(wave * 16 + 4 * grp + rg) * 64 + nt * 16 + col] = acc[nt][rg];
        __syncthreads();
#pragma unroll
        for (int q = 0; q < 2; ++q) { const int idx = tid + 512 * q; float s = pec[idx & 63];
#pragma unroll
            for (int w = 0; w < 8; ++w) s += red[w * 1024 + idx];
            hid[idx] = f2bf(gelu_tanh(s)); }
        __syncthreads();
        if (wave < 4) { f32x4 o = (f32x4){0.f, 0.f, 0.f, 0.f};
#pragma unroll
            for (int ks = 0; ks < 2; ++ks) { const bf16x8 af = *(const LAS bf16x8*)(hid + col * 64 + ks * 32 + 8 * grp); const bf16x8 bfr = *(const bf16x8*)(W2T + (size_t)(wave * 16 + col) * 64 + ks * 32 + 8 * grp);
                o = __builtin_amdgcn_mfma_f32_16x16x32_bf16(af, bfr, o, 0, 0, 0); }
            bf16_t* dst = (bf16_t*)(F.ws + (kv ? WS_VC : WS_KC));
#pragma unroll
            for (int rg = 0; rg < 4; ++rg) { const int n = n0 + 4 * grp + rg; if (n < NCMP) dst[((size_t)(b * 2 + g) * 128 + n) * 64 + wave * 16 + col] = f2bf(o[rg]); } }
        __syncthreads();
    }
}

__device__ __forceinline__ void dot4_row(const bf16_t* krow, const LAS float* qs, float (&acc)[4]) {
    const uint4* kr = (const uint4*)krow;
#pragma unroll 1
    for (int c = 0; c < 8; ++c) { asm volatile("" ::: "memory"); const uint4 w = kr[c]; const unsigned ww[4] = {w.x, w.y, w.z, w.w};
#pragma unroll
        for (int e = 0; e < 4; ++e) { const float k0 = bflo(ww[e]), k1 = bfhi(ww[e]); const int d = c * 8 + e * 2;
#pragma unroll
            for (int r = 0; r < 4; ++r) acc[r] += qs[r * 64 + d] * k0 + qs[r * 64 + d + 1] * k1; } }
}
__device__ __forceinline__ void p4_attn_naive(const Frame& F) {
    const bf16_t* PROJ = (const bf16_t*)(F.ws + WS_PROJ); const bf16_t* KC = (const bf16_t*)(F.ws + WS_KC); const bf16_t* VC = (const bf16_t*)(F.ws + WS_VC);
    bf16_t* OATT = (bf16_t*)(F.ws + WS_OATT); const float* rel = F.in[21];
    LAS float* wl = (LAS float*)F.lds + F.wave * (256 + 512 + 2048 + 16);
    LAS float* qs = wl; LAS float* pc = wl + 256; LAS float* ps = wl + 768; LAS int* pbase = (LAS int*)(wl + 768 + 2048);
    const int gw = blockIdx.x * NWAVES + F.wave, nw = F.G * NWAVES, lane = F.lane;
    for (int u = gw; u < T * 2; u += nw) {
        const int g = u & 1, tok = u >> 1, b = tok / S, t = tok % S;
        const bf16_t* prow = PROJ + (size_t)tok * NPAD;
#pragma unroll
        for (int r = 0; r < 4; ++r) qs[r * 64 + lane] = bf2f(prow[C_Q + (g * 4 + r) * 64 + lane]) * 0.125f;
        lds_wave_sync();
        const int nv = t >= 31 ? ((t - 31) >> 4) + 1 : 0;
        float sc[2][4]; bool va[2];
#pragma unroll
        for (int i = 0; i < 2; ++i) { const int n = lane + 64 * i; va[i] = n < nv; float a[4] = {0.f, 0.f, 0.f, 0.f};
            if (va[i]) { dot4_row(KC + ((size_t)(b * 2 + g) * 128 + n) * 64, qs, a); const int bk = rel_bucket(t - (16 * n + 31));
#pragma unroll
                for (int r = 0; r < 4; ++r) a[r] += rel[bk * 8 + g * 4 + r]; }
#pragma unroll
            for (int r = 0; r < 4; ++r) sc[i][r] = va[i] ? a[r] : -1e30f; }
        float ocmp[4];
#pragma unroll
        for (int r = 0; r < 4; ++r) { const float m = wave_max(fmaxf(sc[0][r], sc[1][r]));
            const float e0 = va[0] ? __expf(sc[0][r] - m) : 0.f, e1 = va[1] ? __expf(sc[1][r] - m) : 0.f; const float sum = wave_sum(e0 + e1);
            const float inv = nv > 0 ? 1.0f / sum : 0.f; pc[r * 128 + lane] = e0 * inv; pc[r * 128 + 64 + lane] = e1 * inv; }
        lds_wave_sync();
        { float o[4] = {0.f, 0.f, 0.f, 0.f}; const bf16_t* vb = VC + ((size_t)(b * 2 + g) * 128) * 64 + lane;
            for (int n = 0; n < nv; ++n) { const float v = bf2f(vb[n * 64]);
#pragma unroll
                for (int r = 0; r < 4; ++r) o[r] += pc[r * 128 + n] * v; }
#pragma unroll
            for (int r = 0; r < 4; ++r) ocmp[r] = o[r]; }
        const int cur = t >> 6; float val;
        { const int j = lane & 31; float imp = 0.f;
#pragma unroll
            for (int r = 0; r < 4; ++r) for (int n = 4 * j - 1; n <= 4 * j + 3; ++n) if (n >= 0 && n < NCMP) imp += pc[r * 128 + n];
            const bool forced = (j == 0) || (j == cur) || (j == cur - 1); const bool allowed = j <= cur;
            val = forced ? 1e4f : (allowed ? imp : -INFINITY); }
        int rank = 0;
        for (int jp = 0; jp < 32; ++jp) { const float vp = __shfl(val, jp); rank += ((vp > val) || (vp == val && jp < (lane & 31))) ? 1 : 0; }
        unsigned selmask = (unsigned)(__ballot(lane < 32 && rank < 8) & 0xFFFFFFFFull);
        float oslc[4], owin[4];
#pragma unroll
        for (int br = 0; br < 2; ++br) {
            const int ck = br == 0 ? C_KS : C_KW, cv = br == 0 ? C_VS : C_VW;
            unsigned mk = selmask;
#pragma unroll 1
            for (int c = 0; c < 8; ++c) {
                int kpos, bs;
                if (br == 0) { const int j = __builtin_ctz(mk | 0x80000000u); mk &= mk - 1; bs = 64 * j; } else { bs = t - 511 + 64 * c; }
                kpos = bs + lane; if (lane == 0) pbase[c] = bs;
                const int dist = t - kpos; const bool vv = (dist >= 0) && (kpos >= 0) && (kpos < S);
                float a[4] = {0.f, 0.f, 0.f, 0.f};
                if (vv) { dot4_row(PROJ + (size_t)(b * S + kpos) * NPAD + ck + g * 64, qs, a); const int bk = rel_bucket(dist);
#pragma unroll
                    for (int r = 0; r < 4; ++r) a[r] += rel[bk * 8 + g * 4 + r]; }
#pragma unroll
                for (int r = 0; r < 4; ++r) ps[r * 512 + c * 64 + lane] = vv ? a[r] : -1e30f;
            }
            lds_wave_sync();
#pragma unroll 1
            for (int r = 0; r < 4; ++r) { float m = -1e30f;
#pragma unroll
                for (int c = 0; c < 8; ++c) m = fmaxf(m, ps[r * 512 + c * 64 + lane]);
                m = wave_max(m); float e[8], sum = 0.f;
#pragma unroll
                for (int c = 0; c < 8; ++c) { const float sv = ps[r * 512 + c * 64 + lane]; e[c] = sv > -1e29f ? __expf(sv - m) : 0.f; sum += e[c]; }
                sum = wave_sum(sum); const float inv = sum > 0.f ? 1.0f / sum : 0.f;
#pragma unroll
                for (int c = 0; c < 8; ++c) ps[r * 512 + c * 64 + lane] = e[c] * inv; }
            lds_wave_sync();
            float o[4] = {0.f, 0.f, 0.f, 0.f};
#pragma unroll 1
            for (int c = 0; c < 8; ++c) {
                const int bsc = pbase[c];
                for (int kk = 0; kk < 64; ++kk) { const int kpos = bsc + kk; if (kpos < 0 || kpos > t) continue;
                    const float v = bf2f(PROJ[(size_t)(b * S + kpos) * NPAD + cv + g * 64 + lane]);
#pragma unroll
                    for (int r = 0; r < 4; ++r) o[r] += ps[r * 512 + c * 64 + kk] * v; } }
            lds_wave_sync();
#pragma unroll
            for (int r = 0; r < 4; ++r) { if (br == 0) oslc[r] = o[r]; else owin[r] = o[r]; }
        }
#pragma unroll
        for (int r = 0; r < 4; ++r) { const int h = g * 4 + r;
            const float g0 = sigmoidf_(bf2f(prow[C_GT + h * 3 + 0])), g1 = sigmoidf_(bf2f(prow[C_GT + h * 3 + 1])), g2 = sigmoidf_(bf2f(prow[C_GT + h * 3 + 2]));
            OATT[(size_t)tok * 512 + h * 64 + lane] = f2bf(g0 * ocmp[r] + g1 * oslc[r] + g2 * owin[r]); }
    }
}


constexpr float LOG2E = 1.4426950408889634f;
constexpr int AT_KC = 0, AT_VC = 16384, AT_KV = 32768  , AT_BTAB = 65536, AT_IMP = 69888, AT_SEL = 78336, AT_OUT = 78592  , AT_END = 78592 + 65536;
constexpr int BT_STRIDE = 132;
__device__ __forceinline__ int tile_off(int row, int chunk) { return row * 128 + ((chunk ^ (row & 7)) << 4); }
__device__ __forceinline__ bf16x8 mk_frag(unsigned a, unsigned b, unsigned c, unsigned d) { u32x4v v = {a, b, c, d}; return __builtin_bit_cast(bf16x8, v); }
struct LaneOffs { int koff[2]; int voff[4]; int soff; };
__device__ __forceinline__ LaneOffs lane_offs(int lane, int tid) {
    LaneOffs L; const int grp = lane >> 4, rowi = lane & 15, q4 = rowi >> 2, p = lane & 3;
#pragma unroll
    for (int ks = 0; ks < 2; ++ks) L.koff[ks] = tile_off(rowi, ks * 4 + grp);
#pragma unroll
    for (int dt = 0; dt < 4; ++dt) L.voff[dt] = tile_off(4 * grp + q4, 2 * dt + (p >> 1)) + 8 * (p & 1);
    L.soff = tile_off(tid >> 3, tid & 7); return L;
}
__device__ __forceinline__ bf16x8 vfrag_read(const LAS unsigned char* vt, int voff_dt, int row0) {
    const s16x4 a = __builtin_amdgcn_ds_read_tr16_b64_v4i16((LAS s16x4*)(vt + voff_dt + row0 * 128));
    const s16x4 b = __builtin_amdgcn_ds_read_tr16_b64_v4i16((LAS s16x4*)(vt + voff_dt + row0 * 128 + 2048));
    bf16x8 f = {a[0], a[1], a[2], a[3], b[0], b[1], b[2], b[3]}; return f;
}


struct AttnState {
    f32x4 o[4][2]; float m[2], l[2];
};

template <int BR>
__device__ __forceinline__ void attn_tile(const LAS unsigned char* kt_lds, const LAS unsigned char* vt_lds, const LAS float* btab_h, const bf16x8 (&qf)[2][2], const int (&tq)[2], const unsigned (&sel)[2],
                                          int j, bool near, AttnState& st, int lane, const LaneOffs& L, LAS unsigned char* F_lds_) {
    const int grp = lane >> 4, kbase = 64 * j;
#if defined(PROBE_STAMP) && PROBE_LEVEL >= 2
    STAMP_DECL; STAMP_START();
#define TSTAMP(k) STAMP(k)
#else
#define TSTAMP(k) do {} while (0)
#endif
    f32x4 sacc[4][2];
#pragma unroll
    for (int kt = 0; kt < 4; ++kt) { sacc[kt][0] = (f32x4){0.f, 0.f, 0.f, 0.f}; sacc[kt][1] = (f32x4){0.f, 0.f, 0.f, 0.f}; }
#pragma unroll
    for (int kt = 0; kt < 4; ++kt)
#pragma unroll
        for (int ks = 0; ks < 2; ++ks) { const bf16x8 kf = *(const LAS bf16x8*)(kt_lds + L.koff[ks] + kt * 2048);
            sacc[kt][0] = __builtin_amdgcn_mfma_f32_16x16x32_bf16(kf, qf[0][ks], sacc[kt][0], 0, 0, 0);
            sacc[kt][1] = __builtin_amdgcn_mfma_f32_16x16x32_bf16(kf, qf[1][ks], sacc[kt][1], 0, 0, 0); }
    __builtin_amdgcn_sched_barrier(0);
    TSTAMP(0);
    const float SC = 0.125f * LOG2E; const float bfar = btab_h[128];
    bf16x8 pf[2][2];
    const int cur_blk = tq[0] >> 6;
    const bool full = BR == 0 ? (j == cur_blk) : (j == cur_blk || j + 8 == cur_blk);
    const bool fast = !near && !full;
#pragma unroll
    for (int qt = 0; qt < 2; ++qt) {
        const int t = tq[qt]; const bool selq = BR == 0 ? ((sel[qt] >> j) & 1u) != 0u : true;
        float sv[4][4]; float tmax;
        if (fast) {
            float r0 = fmaxf(fmaxf(sacc[0][qt][0], sacc[0][qt][1]), fmaxf(sacc[0][qt][2], sacc[0][qt][3]));
#pragma unroll
            for (int kt = 1; kt < 4; ++kt) r0 = fmaxf(r0, fmaxf(fmaxf(sacc[kt][qt][0], sacc[kt][qt][1]), fmaxf(sacc[kt][qt][2], sacc[kt][qt][3])));
            tmax = selq ? r0 * SC + bfar : -1e30f;
        } else {
            tmax = -1e30f;
            int d0 = t - 4 * grp - kbase; asm volatile("" : "+v"(d0));
            if (near) {
#pragma unroll
                for (int kt = 0; kt < 4; ++kt)
#pragma unroll
                    for (int rg = 0; rg < 4; ++rg) { const int dist = d0 - (kt * 16 + rg); const int dd = dist < 0 ? 0 : (dist > 128 ? 128 : dist); sv[kt][rg] = btab_h[dd]; }
            } else {
#pragma unroll
                for (int kt = 0; kt < 4; ++kt)
#pragma unroll
                    for (int rg = 0; rg < 4; ++rg) sv[kt][rg] = bfar;
            }
#pragma unroll
            for (int kt = 0; kt < 4; ++kt)
#pragma unroll
                for (int rg = 0; rg < 4; ++rg) { const int c = kt * 16 + rg;
                    const bool valid = BR == 0 ? (selq && d0 >= c) : (d0 >= c && d0 < 512 + c);
                    const float sx = sacc[kt][qt][rg] * SC + sv[kt][rg]; const float s = valid ? sx : -1e30f; sv[kt][rg] = s; tmax = fmaxf(tmax, s); }
        }
        tmax = fmaxf(tmax, __shfl_xor(tmax, 16)); tmax = fmaxf(tmax, __shfl_xor(tmax, 32));
        const float mnew = fmaxf(st.m[qt], tmax); const float alpha = __builtin_amdgcn_exp2f(st.m[qt] - mnew); st.m[qt] = mnew;
        const float muse = mnew < -1e29f ? 0.f : mnew;
        float ev[4][4];
        if (fast) { const float c0 = selq ? bfar - muse : -1e30f;
#pragma unroll
            for (int kt = 0; kt < 4; ++kt)
#pragma unroll
                for (int rg = 0; rg < 4; ++rg) ev[kt][rg] = __builtin_amdgcn_exp2f(sacc[kt][qt][rg] * SC + c0);
        } else {
#pragma unroll
            for (int kt = 0; kt < 4; ++kt)
#pragma unroll
                for (int rg = 0; rg < 4; ++rg) ev[kt][rg] = __builtin_amdgcn_exp2f(sv[kt][rg] - muse);
        }
        float ls = 0.f; unsigned pk[4][2];
#pragma unroll
        for (int kt = 0; kt < 4; ++kt) { ls += (ev[kt][0] + ev[kt][1]) + (ev[kt][2] + ev[kt][3]);
            pk[kt][0] = pg8::cvt_pk_bf16(ev[kt][0], ev[kt][1]); pk[kt][1] = pg8::cvt_pk_bf16(ev[kt][2], ev[kt][3]); }
        st.l[qt] = st.l[qt] * alpha + ls;
        if (!__all(alpha == 1.0f)) {
#pragma unroll
            for (int dt = 0; dt < 4; ++dt) st.o[dt][qt] *= alpha; }
        pf[qt][0] = mk_frag(pk[0][0], pk[0][1], pk[1][0], pk[1][1]); pf[qt][1] = mk_frag(pk[2][0], pk[2][1], pk[3][0], pk[3][1]);
        __builtin_amdgcn_sched_barrier(0);
    }
    TSTAMP(1);
#pragma unroll
    for (int ks = 0; ks < 2; ++ks)
#pragma unroll
        for (int dt = 0; dt < 4; ++dt) { const bf16x8 vf = vfrag_read(vt_lds, L.voff[dt], 32 * ks);
            st.o[dt][0] = __builtin_amdgcn_mfma_f32_16x16x32_bf16(vf, pf[0][ks], st.o[dt][0], 0, 0, 0);
            st.o[dt][1] = __builtin_amdgcn_mfma_f32_16x16x32_bf16(vf, pf[1][ks], st.o[dt][1], 0, 0, 0); }
    TSTAMP(2);
#undef TSTAMP
}

template <int BR>
__device__ __forceinline__ void attn_branch(const Frame& F, const bf16_t* PROJ, int b, int g, int t0, unsigned tiles  , const LAS float* btab_h,
                                            const bf16x8 (&qf)[2][2], const int (&tq)[2], const unsigned (&sel)[2], const float (&gate)[2], const LaneOffs& L) {
    const int lane = F.lane, tid = F.tid;
    const int ck = (BR == 0 ? C_KS : C_KW) + g * 64, cv = (BR == 0 ? C_VS : C_VW) + g * 64;
    const int srow = tid >> 3, sch = tid & 7;
    LAS unsigned char* F_lds_ = F.lds; STAMP_DECL; STAMP_START();
    AttnState st;
#pragma unroll
    for (int dt = 0; dt < 4; ++dt) { st.o[dt][0] = (f32x4){0.f, 0.f, 0.f, 0.f}; st.o[dt][1] = (f32x4){0.f, 0.f, 0.f, 0.f}; }
    st.m[0] = st.m[1] = -1e30f; st.l[0] = st.l[1] = 0.f;
    unsigned rem = tiles; int cur = 0;
#ifdef PROBE_SHALLOW
    u32x4v rk0, rv0;
#else
    u32x4v rk0, rv0, rk1, rv1;
#endif
    const bf16_t* srcb = PROJ + (size_t)(b * S + srow) * NPAD + sch * 8;
#define AT_LOAD(RK, RV, jj) do { const bf16_t* rowp = srcb + (size_t)(64 * (jj)) * NPAD; RK = *(const u32x4v*)(rowp + ck); RV = *(const u32x4v*)(rowp + cv); } while (0)
#define AT_WRITE(RK, RV, bufi) do { *(LAS u32x4v*)(F.lds + AT_KV + (bufi) * 16384 + L.soff) = RK; *(LAS u32x4v*)(F.lds + AT_KV + (bufi) * 16384 + 8192 + L.soff) = RV; } while (0)
#define AT_COMPUTE(jj) do { STAMP_COUNT(4); const bool near = (t0 + 8 * F.wave) - (64 * (jj) + 63) < 128; \
        attn_tile<BR>(F.lds + AT_KV + cur * 16384, F.lds + AT_KV + cur * 16384 + 8192, btab_h, qf, tq, sel, (jj), near, st, lane, L, F.lds); } while (0)
#ifdef PROBE_SHALLOW
    { int j = __builtin_ctz(rem); rem &= rem - 1;
      AT_LOAD(rk0, rv0, j); AT_WRITE(rk0, rv0, 0);
      __syncthreads();
      for (;;) {
          int jn = j; const bool hn = rem != 0u; if (hn) { jn = __builtin_ctz(rem); rem &= rem - 1; }
          AT_LOAD(rk0, rv0, jn);
          AT_COMPUTE(j);
          AT_WRITE(rk0, rv0, cur ^ 1);
          __syncthreads(); cur ^= 1;
          if (!hn) break;
          j = jn; } }
#else
    int j = __builtin_ctz(rem); rem &= rem - 1;
    AT_LOAD(rk0, rv0, j); AT_WRITE(rk0, rv0, 0);
    int j1 = j; bool h1 = rem != 0u; if (h1) { j1 = __builtin_ctz(rem); rem &= rem - 1; }
    AT_LOAD(rk0, rv0, j1);
    __syncthreads();
    for (;;) {
        int j2 = j1; bool h2 = rem != 0u; if (h2) { j2 = __builtin_ctz(rem); rem &= rem - 1; }
        AT_LOAD(rk1, rv1, j2);
        AT_COMPUTE(j);
        AT_WRITE(rk0, rv0, cur ^ 1);
        __syncthreads(); cur ^= 1;
        if (!h1) break;
        int j3 = j2; bool h3 = rem != 0u; if (h3) { j3 = __builtin_ctz(rem); rem &= rem - 1; }
        AT_LOAD(rk0, rv0, j3);
        AT_COMPUTE(j1);
        AT_WRITE(rk1, rv1, cur ^ 1);
        __syncthreads(); cur ^= 1;
        if (!h2) break;
        j = j2; j1 = j3; h1 = h3;
    }
#endif
    STAMP(5 + BR);
#undef AT_LOAD
#undef AT_WRITE
#undef AT_COMPUTE
    int pob = AT_OUT + tid * 4; asm volatile("" : "+v"(pob));
    LAS float* po = (LAS float*)(F.lds + pob);
#pragma unroll
    for (int qt = 0; qt < 2; ++qt) { float l = st.l[qt]; l += __shfl_xor(l, 16); l += __shfl_xor(l, 32); const float sc = l > 0.f ? gate[qt] / l : 0.f;
#pragma unroll
        for (int dt = 0; dt < 4; ++dt)
#pragma unroll
            for (int e = 0; e < 4; ++e) po[((qt * 4 + dt) * 4 + e) * 512] += st.o[dt][qt][e] * sc; }
}

template <int MODE>
__device__ __forceinline__ void p4_attn_mfma_t(const Frame& F) {
    const bf16_t* PROJ = (const bf16_t*)(F.ws + WS_PROJ); const bf16_t* KC = (const bf16_t*)(F.ws + WS_KC); const bf16_t* VC = (const bf16_t*)(F.ws + WS_VC);
    bf16_t* OATT = (bf16_t*)(F.ws + (MODE == 0 ? WS_OATT : WS_H)); const float* rel = F.in[21];
    const int lane = F.lane, tid = F.tid, wave = F.wave, grp = lane >> 4, col = lane & 15, qi = col >> 2, r = col & 3;
    LAS float* btab = (LAS float*)(F.lds + AT_BTAB); LAS float* impq = (LAS float*)(F.lds + AT_IMP); LAS unsigned* selm = (LAS unsigned*)(F.lds + AT_SEL);
    const LaneOffs L = lane_offs(lane, tid);
    for (int i = tid; i < 8 * 129; i += NTHREADS) { const int hh = i / 129, dd = i % 129; btab[hh * BT_STRIDE + dd] = rel[rel_bucket(dd) * 8 + hh] * LOG2E; }
    __syncthreads();
    LAS unsigned char* F_lds_ = F.lds; STAMP_DECL;
#ifdef PROBE_STAMP
    if (tid < 16) ((volatile LAS unsigned*)(F.lds + LDS_MISC_OFF + 128))[tid] = 0u;
    __syncthreads();
#endif
    STAMP_START();
    for (int uu = blockIdx.x; uu < 1024; uu += F.G) {
        int sidx = uu;
        if (F.G == 256) { const int round = uu >> 8, k = uu & 255; sidx = (round == 0) ? k : (round == 1) ? 511 - k : (round == 2) ? 512 + k : 1023 - k; }
        const int qb = 31 - (sidx >> 5), bg = sidx & 31, b = bg >> 1, g = bg & 1, t0 = qb * 64, h = g * 4 + r;
        const LAS float* btab_h = btab + h * BT_STRIDE;
        int tq[2]; bf16x8 qf[2][2]; float gate[3][2];
#pragma unroll
        for (int qt = 0; qt < 2; ++qt) { tq[qt] = t0 + 8 * wave + 4 * qt + qi; const bf16_t* prow = PROJ + (size_t)(b * S + tq[qt]) * NPAD;
#pragma unroll
            for (int ks = 0; ks < 2; ++ks) qf[qt][ks] = *(const bf16x8*)(prow + C_Q + h * 64 + ks * 32 + 8 * grp);
#pragma unroll
            for (int jg = 0; jg < 3; ++jg) gate[jg][qt] = sigmoidf_(bf2f(prow[C_GT + h * 3 + jg])); }
#pragma unroll
        for (int i = 0; i < 2; ++i) { const int c2 = tid + 512 * i, row = c2 >> 3, ch = c2 & 7; const size_t src = ((size_t)(b * 2 + g) * 128 + row) * 64 + ch * 8;
            *(LAS u32x4v*)(F.lds + AT_KC + L.soff + 8192 * i) = *(const u32x4v*)(KC + src); *(LAS u32x4v*)(F.lds + AT_VC + L.soff + 8192 * i) = *(const u32x4v*)(VC + src); }
        __syncthreads();
#ifndef AT_SKIP_CMP
        {
            const int nvmax = t0 + 63 >= 31 ? ((t0 + 63 - 31) >> 4) + 1 : 0;
            const float SC = 0.125f * LOG2E; const int srcl = (lane + 48) & 63;
            int pob = AT_OUT + tid * 4; asm volatile("" : "+v"(pob));
            LAS float* po = (LAS float*)(F.lds + pob);
#pragma unroll
            for (int qt = 0; qt < 2; ++qt) {
                f32x4 sa[8];
#pragma unroll
                for (int kt = 0; kt < 8; ++kt) sa[kt] = (f32x4){0.f, 0.f, 0.f, 0.f};
#pragma unroll
                for (int kt = 0; kt < 8; ++kt) if (kt * 16 < nvmax) {
#pragma unroll
                    for (int ks = 0; ks < 2; ++ks) { const bf16x8 kf = *(const LAS bf16x8*)(F.lds + AT_KC + L.koff[ks] + kt * 2048);
                        sa[kt] = __builtin_amdgcn_mfma_f32_16x16x32_bf16(kf, qf[qt][ks], sa[kt], 0, 0, 0); } }
                __builtin_amdgcn_sched_barrier(0);
                int d0 = tq[qt] - 31 - 64 * grp; asm volatile("" : "+v"(d0));
                float mx = -1e30f;
#pragma unroll
                for (int kt = 0; kt < 8; ++kt)
#pragma unroll
                    for (int rg = 0; rg < 4; ++rg) { const int c = 256 * kt + 16 * rg; const int dist = d0 - c; const int dd = dist < 0 ? 0 : (dist > 128 ? 128 : dist);
                        const float sx = sa[kt][rg] * SC + btab_h[dd]; const float s = d0 >= c ? sx : -1e30f; sa[kt][rg] = s; mx = fmaxf(mx, s); }
                mx = fmaxf(mx, __shfl_xor(mx, 16)); mx = fmaxf(mx, __shfl_xor(mx, 32));
                float sum = 0.f;
#pragma unroll
                for (int kt = 0; kt < 8; ++kt)
#pragma unroll
                    for (int rg = 0; rg < 4; ++rg) { const int c = 256 * kt + 16 * rg; const float ex = __builtin_amdgcn_exp2f(sa[kt][rg] - mx); const float e = d0 >= c ? ex : 0.f; sa[kt][rg] = e; sum += e; }
                __builtin_amdgcn_sched_barrier(0);
                sum += __shfl_xor(sum, 16); sum += __shfl_xor(sum, 32);
                const float inv = sum > 0.f ? 1.0f / sum : 0.f;
                float prev3 = 0.f;
#pragma unroll
                for (int kt = 0; kt < 8; ++kt) { const float p3 = sa[kt][3] * inv; const float part = (sa[kt][0] * inv + sa[kt][1] * inv) + (sa[kt][2] * inv + p3);
                    const float xa = __shfl(p3, srcl), xb = __shfl(prev3, srcl); float tot = part + (grp >= 1 ? xa : xb);
                    tot += __shfl_xor(tot, 1); tot += __shfl_xor(tot, 2);
                    if (r == 0) impq[(8 * wave + 4 * qt + qi) * 33 + 4 * kt + grp] = tot;
                    prev3 = p3; }
                __builtin_amdgcn_sched_barrier(0);
                f32x4 oc[4];
#pragma unroll
                for (int dt = 0; dt < 4; ++dt) oc[dt] = (f32x4){0.f, 0.f, 0.f, 0.f};
#pragma unroll
                for (int ks = 0; ks < 4; ++ks) if (ks * 32 < nvmax) {
                    const bf16x8 pfr = mk_frag(pg8::cvt_pk_bf16(sa[2 * ks][0], sa[2 * ks][1]), pg8::cvt_pk_bf16(sa[2 * ks][2], sa[2 * ks][3]),
                                               pg8::cvt_pk_bf16(sa[2 * ks + 1][0], sa[2 * ks + 1][1]), pg8::cvt_pk_bf16(sa[2 * ks + 1][2], sa[2 * ks + 1][3]));
#pragma unroll
                    for (int dt = 0; dt < 4; ++dt) { const bf16x8 vf = vfrag_read(F.lds + AT_VC, L.voff[dt], 32 * ks); oc[dt] = __builtin_amdgcn_mfma_f32_16x16x32_bf16(vf, pfr, oc[dt], 0, 0, 0); } }
                const float scq = inv * gate[0][qt];
#pragma unroll
                for (int dt = 0; dt < 4; ++dt)
#pragma unroll
                    for (int e = 0; e < 4; ++e) po[((qt * 4 + dt) * 4 + e) * 512] = oc[dt][e] * scq;
                __builtin_amdgcn_sched_barrier(0);
            }
        }
#endif
        __syncthreads();
#ifndef AT_SKIP_SEL
        {
            const int q = tid >> 3, jj = tid & 7, cur = qb; unsigned bits = 0u;
            float vj[4];
#pragma unroll
            for (int e = 0; e < 4; ++e) { const int j = jj * 4 + e; const bool forced = (j == 0) || (j == cur) || (j == cur - 1); vj[e] = forced ? 1e4f : (j <= cur ? impq[q * 33 + j] : -INFINITY); }
            int rk[4] = {0, 0, 0, 0};
            for (int jp = 0; jp < 32; ++jp) { const bool forced = (jp == 0) || (jp == cur) || (jp == cur - 1); const float vp = forced ? 1e4f : (jp <= cur ? impq[q * 33 + jp] : -INFINITY);
#pragma unroll
                for (int e = 0; e < 4; ++e) rk[e] += ((vp > vj[e]) || (vp == vj[e] && jp < jj * 4 + e)) ? 1 : 0; }
#pragma unroll
            for (int e = 0; e < 4; ++e) bits |= (rk[e] < 8 ? 1u : 0u) << (jj * 4 + e);
            bits |= __shfl_xor(bits, 1); bits |= __shfl_xor(bits, 2); bits |= __shfl_xor(bits, 4);
            if (jj == 0) selm[q] = bits;
        }
#endif
        __syncthreads();
        unsigned sel[2] = {selm[8 * wave + qi], selm[8 * wave + 4 + qi]};
        unsigned un = selm[lane];
#pragma unroll
        for (int o = 32; o >= 1; o >>= 1) un |= __shfl_xor(un, o);
        un = __builtin_amdgcn_readfirstlane(un);
        const unsigned causal = qb == 31 ? 0xFFFFFFFFu : ((2u << qb) - 1u);
        if (MODE != 1 && MODE != 2) { const float gt1[2] = {gate[1][0], gate[1][1]}; attn_branch<0>(F, PROJ, b, g, t0, un & causal, btab_h, qf, tq, sel, gt1, L); }
        if (MODE != 2) { const int jlo = qb >= 8 ? qb - 8 : 0; const unsigned wmask = causal & ~((1u << jlo) - 1u); const float gt2[2] = {gate[2][0], gate[2][1]};
            attn_branch<1>(F, PROJ, b, g, t0, wmask, btab_h, qf, tq, sel, gt2, L); }
        int pob2 = AT_OUT + tid * 4; asm volatile("" : "+v"(pob2));
#pragma unroll
        for (int qt = 0; qt < 2; ++qt) { bf16_t* orow = OATT + (size_t)(b * S + tq[qt]) * 512 + h * 64 + 4 * grp;
#pragma unroll
            for (int dt = 0; dt < 4; ++dt) { const LAS float* po = (const LAS float*)(F.lds + pob2) + (qt * 4 + dt) * 4 * 512;
                *(uint2*)(orow + dt * 16) = make_uint2(pg8::cvt_pk_bf16(po[0], po[512]), pg8::cvt_pk_bf16(po[1024], po[1536])); } }
    }
    STAMP(7);
#ifdef PROBE_STAMP
    __syncthreads();
    if (PROBE_PHASE == 4 && MODE == 0 && blockIdx.x == PROBE_BLOCK && tid < 16) ((unsigned*)(F.ws + WS_CTL + 32768))[tid] = ((volatile LAS unsigned*)(F.lds + LDS_MISC_OFF + 128))[tid];
#endif
}

__device__ __forceinline__ void p5_mixed(const Frame& F) {
    const bf16_t* PROJ = (const bf16_t*)(F.ws + WS_PROJ); const bf16_t* OATT = (const bf16_t*)(F.ws + WS_OATT); bf16_t* MIX = (bf16_t*)(F.ws + WS_H);
    const float* cw = F.in[13]; const float* ga = F.in[14]; const float* gc = F.in[15];
    const int gw = blockIdx.x * NWAVES + F.wave, nw = F.G * NWAVES, lane = F.lane;
    for (int tok = gw; tok < T; tok += nw) {
        const int s = tok % S; const int c0 = lane * 8;
        float a[8], y[8];
        { const uint4 w = *(const uint4*)(OATT + (size_t)tok * 512 + c0); const unsigned ww[4] = {w.x, w.y, w.z, w.w};
#pragma unroll
            for (int e = 0; e < 4; ++e) { a[2 * e] = bflo(ww[e]); a[2 * e + 1] = bfhi(ww[e]); } }
#pragma unroll
        for (int e = 0; e < 8; ++e) y[e] = 0.f;
#pragma unroll
        for (int dt = 0; dt < 3; ++dt) { if (s - 2 + dt >= 0) { const bf16_t* row = PROJ + (size_t)(tok - 2 + dt) * NPAD;
                const uint4 wc = *(const uint4*)(row + C_CC + c0), wh = *(const uint4*)(row + C_CH + c0); const unsigned c4[4] = {wc.x, wc.y, wc.z, wc.w}, h4[4] = {wh.x, wh.y, wh.z, wh.w};
#pragma unroll
                for (int e = 0; e < 4; ++e) { y[2 * e] += cw[dt * 512 + c0 + 2 * e] * (bflo(c4[e]) * bflo(h4[e])); y[2 * e + 1] += cw[dt * 512 + c0 + 2 * e + 1] * (bfhi(c4[e]) * bfhi(h4[e])); } } }
        { const uint4 wb = *(const uint4*)(PROJ + (size_t)tok * NPAD + C_CB + c0); const unsigned b4[4] = {wb.x, wb.y, wb.z, wb.w};
#pragma unroll
            for (int e = 0; e < 4; ++e) { y[2 * e] *= bflo(b4[e]); y[2 * e + 1] *= bfhi(b4[e]); } }
        float sa = 0.f, sy = 0.f;
#pragma unroll
        for (int e = 0; e < 8; ++e) { sa += a[e] * a[e]; sy += y[e] * y[e]; }
        sa = wave_sum(sa); sy = wave_sum(sy);
        const float ra = rsqrtf(sa * (1.0f / 512) + EPS), ry = rsqrtf(sy * (1.0f / 512) + EPS);
        unsigned oa[4], oy[4];
#pragma unroll
        for (int e = 0; e < 4; ++e) { oa[e] = pack2(a[2 * e] * ra * ga[c0 + 2 * e], a[2 * e + 1] * ra * ga[c0 + 2 * e + 1]); oy[e] = pack2(y[2 * e] * ry * gc[c0 + 2 * e], y[2 * e + 1] * ry * gc[c0 + 2 * e + 1]); }
        *(uint4*)(MIX + (size_t)tok * D + c0) = make_uint4(oa[0], oa[1], oa[2], oa[3]);
        *(uint4*)(MIX + (size_t)tok * D + 512 + c0) = make_uint4(oy[0], oy[1], oy[2], oy[3]);
    }
}

struct EpiResGate {
    static constexpr bool PERM = false, AFTER_DRAIN = false;
    float* C; const float* X; const float* MOD; int gate_off;
    __device__ __forceinline__ void operator()(const pg8::f32x4 (&acc)[2][2][4][2], const pg8::Unit& u, int wr, int wc, int fr, int fq) const {
        using pg8::f32x4; using pg8::HALF; using pg8::BM;
        const int row0 = u.pm * BM + wr * 64 + fr, col0 = u.pn * BM + wc * 32 + 4 * fq;
        const int b = (u.pm * BM) / S;
        f32x4 gv[2][2];
#pragma unroll
        for (int bj = 0; bj < 2; ++bj)
#pragma unroll
            for (int n = 0; n < 2; ++n) gv[bj][n] = *(const f32x4*)(MOD + b * 6144 + gate_off + col0 + bj * HALF + n * 16);
#pragma unroll
        for (int ai = 0; ai < 2; ++ai)
#pragma unroll
            for (int m = 0; m < 4; ++m) { const size_t ro = (size_t)(row0 + ai * HALF + m * 16) * D + col0;
#pragma unroll
                for (int bj = 0; bj < 2; ++bj)
#pragma unroll
                    for (int n = 0; n < 2; ++n) { const f32x4 xv = *(const f32x4*)(X + ro + bj * HALF + n * 16); *(f32x4*)(C + ro + bj * HALF + n * 16) = xv + gv[bj][n] * acc[ai][bj][m][n]; } }
    }
};

__device__ __forceinline__ int ord_i(float f) { const int u = __float_as_int(f); return u >= 0 ? u : (u ^ 0x7FFFFFFF); }
__device__ __forceinline__ float unord_f(int i) { const int u = i >= 0 ? i : (i ^ 0x7FFFFFFF); return __int_as_float(u); }
#define INT_MIN_ (-2147483647 - 1)
struct CandTab { int a[50], b[50]; };
constexpr CandTab make_cand() { CandTab t{}; int n = 0; for (int a = 0; a < 16; ++a) for (int b = 0; b < 16; ++b) if ((a + 1) * (b + 1) <= 16) { t.a[n] = a; t.b[n] = b; ++n; } return t; }
constexpr CandTab CAND = make_cand();

template <int N, bool DESC> __device__ __forceinline__ void bitonic_sort_i(int (&v)[N]) {
#pragma unroll
    for (int k = 2; k <= N; k <<= 1)
#pragma unroll
        for (int j = k >> 1; j > 0; j >>= 1)
#pragma unroll
            for (int i = 0; i < N; ++i) { const int l = i ^ j; if (l > i) { const bool up = ((i & k) == 0) != DESC; const int lo = min(v[i], v[l]), hi = max(v[i], v[l]); v[i] = up ? lo : hi; v[l] = up ? hi : lo; } }
}
template <int N, bool DESC> __device__ __forceinline__ void bitonic_merge_i(int (&v)[N]) {
#pragma unroll
    for (int j = N >> 1; j > 0; j >>= 1)
#pragma unroll
        for (int i = 0; i < N; ++i) { const int l = i ^ j; if (l > i) { const int lo = min(v[i], v[l]), hi = max(v[i], v[l]); v[i] = DESC ? hi : lo; v[l] = DESC ? lo : hi; } }
}
__device__ __forceinline__ void merge_top16_across(int (&t)[16]) {
#pragma unroll
    for (int m = 16; m <= 32; m <<= 1) { int y[16];
#pragma unroll
        for (int i = 0; i < 16; ++i) y[i] = max(t[i], __shfl_xor(t[15 - i], m));
        bitonic_merge_i<16, true>(y);
#pragma unroll
        for (int i = 0; i < 16; ++i) t[i] = y[i]; }
}
constexpr int RT2_KEYS = 0  , RT2_ITAB = 65536  ;
__device__ __forceinline__ void p9_route_sort(const Frame& F) {
    const bf16_t* QP = (const bf16_t*)(F.ws + WS_QP); const bf16_t* KEYS = (const bf16_t*)(F.ws + WS_KEYS);
    unsigned short* E16 = (unsigned short*)(F.ws + WS_E16); float* EW = (float*)(F.ws + WS_EW);
    const int lane = F.lane, tid = F.tid, grp = lane >> 4, col = lane & 15;
    const LaneOffs L = lane_offs(lane, tid);
    LAS int* itab = (LAS int*)(F.lds + RT2_ITAB + F.wave * 2048) + col * 32;
    const bool g1 = grp == 1, g2 = grp == 2, g3 = grp == 3;
    for (int tile = blockIdx.x * NWAVES + F.wave; tile < T / 16; tile += F.G * NWAVES) {
        const int tok = tile * 16 + col;
        {
#pragma unroll
            for (int i = 0; i < 4; ++i) { const int q = tid + 512 * i; *(LAS u32x4v*)(F.lds + RT2_KEYS + tile_off(q >> 3, q & 7)) = *(const u32x4v*)(KEYS + (size_t)q * 8); } }
        bf16x8 qf[2][2];
#pragma unroll
        for (int p = 0; p < 2; ++p)
#pragma unroll
            for (int ks = 0; ks < 2; ++ks) qf[p][ks] = *(const bf16x8*)(QP + (size_t)tok * D + p * 64 + ks * 32 + 8 * grp);
        __syncthreads();
#pragma unroll 1
        for (int h = 0; h < 8; ++h) {
            const int kb = RT2_KEYS + (h & 1) * 32768;
            u32x4v stg[4]; bf16x8 qn[2][2];
            if (h < 7) {
#pragma unroll
                for (int i = 0; i < 4; ++i) { const int q = tid + 512 * i; stg[i] = *(const u32x4v*)(KEYS + (size_t)(h + 1) * 16384 + (size_t)q * 8); }
#pragma unroll
                for (int p = 0; p < 2; ++p)
#pragma unroll
                    for (int ks = 0; ks < 2; ++ks) qn[p][ks] = *(const bf16x8*)(QP + (size_t)tok * D + (h + 1) * 128 + p * 64 + ks * 32 + 8 * grp);
            }
            int lst[2][16];
#pragma unroll
            for (int p = 0; p < 2; ++p) {
                f32x4 sc[8];
#pragma unroll
                for (int kt = 0; kt < 8; ++kt) { sc[kt] = (f32x4){0.f, 0.f, 0.f, 0.f};
#pragma unroll
                    for (int ks = 0; ks < 2; ++ks) { const bf16x8 kf = *(const LAS bf16x8*)(F.lds + kb + p * 16384 + L.koff[ks] + kt * 2048);
                        sc[kt] = __builtin_amdgcn_mfma_f32_16x16x32_bf16(kf, qf[p][ks], sc[kt], 0, 0, 0); } }
                int ra[16], rb[16];
#pragma unroll
                for (int kt = 0; kt < 4; ++kt)
#pragma unroll
                    for (int rg = 0; rg < 4; ++rg) { ra[kt * 4 + rg] = (ord_i(sc[kt][rg]) & ~0x7F) | (127 - (kt * 16 + 4 * grp + rg)); rb[kt * 4 + rg] = (ord_i(sc[kt + 4][rg]) & ~0x7F) | (127 - ((kt + 4) * 16 + 4 * grp + rg)); }
                bitonic_sort_i<16, true>(ra); bitonic_sort_i<16, false>(rb);
#pragma unroll
                for (int i = 0; i < 16; ++i) ra[i] = max(ra[i], rb[i]);
                bitonic_merge_i<16, true>(ra);
                merge_top16_across(ra);
#pragma unroll
                for (int i = 0; i < 16; ++i) lst[p][i] = ra[i];
                if (grp == 0) {
#pragma unroll
                    for (int it = 0; it < 16; ++it) itab[p * 16 + it] = 127 - (ra[it] & 0x7F);
                }
            }
            float v0[16], v1[16];
#pragma unroll
            for (int i = 0; i < 16; ++i) { v0[i] = unord_f(lst[0][i] & ~0x7F); v1[i] = unord_f(lst[1][i] & ~0x7F); }
            int ck[16];
#pragma unroll
            for (int i = 0; i < 13; ++i) {
                constexpr int NC = 50;
                const int k0 = 4 * i, k1 = 4 * i + 1 < NC ? 4 * i + 1 : NC - 1, k2 = 4 * i + 2 < NC ? 4 * i + 2 : NC - 1, k3 = 4 * i + 3 < NC ? 4 * i + 3 : NC - 1;
                float va = v0[CAND.a[k0]], vb = v1[CAND.b[k0]]; int fl = 255 - (CAND.a[k0] * 16 + CAND.b[k0]);
                va = g1 ? v0[CAND.a[k1]] : va; vb = g1 ? v1[CAND.b[k1]] : vb; fl = g1 ? 255 - (CAND.a[k1] * 16 + CAND.b[k1]) : fl;
                va = g2 ? v0[CAND.a[k2]] : va; vb = g2 ? v1[CAND.b[k2]] : vb; fl = g2 ? 255 - (CAND.a[k2] * 16 + CAND.b[k2]) : fl;
                va = g3 ? v0[CAND.a[k3]] : va; vb = g3 ? v1[CAND.b[k3]] : vb; fl = g3 ? 255 - (CAND.a[k3] * 16 + CAND.b[k3]) : fl;
                int key = (ord_i(va + vb) & ~0xFF) | fl;
                if (4 * i + 1 >= NC) key = g1 ? INT_MIN_ : key;
                if (4 * i + 2 >= NC) key = g2 ? INT_MIN_ : key;
                if (4 * i + 3 >= NC) key = g3 ? INT_MIN_ : key;
                ck[i] = key; }
            ck[13] = INT_MIN_; ck[14] = INT_MIN_; ck[15] = INT_MIN_;
            bitonic_sort_i<16, true>(ck);
            merge_top16_across(ck);
            lds_wave_sync();
            const float smax = unord_f(ck[0] & ~0xFF);
            float ex[16], sum = 0.f;
#pragma unroll
            for (int it = 0; it < 16; ++it) { ex[it] = __expf(unord_f(ck[it] & ~0xFF) - smax); sum += ex[it]; }
            const float inv = 1.0f / sum;
            if (grp == 0) {
#pragma unroll
                for (int it = 0; it < 16; ++it) { const int flat = 255 - (ck[it] & 0xFF); const int i1 = itab[flat >> 4], i2 = itab[16 + (flat & 15)];
                    E16[(size_t)tok * 128 + h * 16 + it] = (unsigned short)(i1 * 128 + i2); EW[(size_t)tok * 128 + h * 16 + it] = ex[it] * inv; }
            }
            lds_wave_sync();
            if (h < 7) {
                const int kn = RT2_KEYS + ((h + 1) & 1) * 32768;
#pragma unroll
                for (int i = 0; i < 4; ++i) { const int q = tid + 512 * i; *(LAS u32x4v*)(F.lds + kn + tile_off(q >> 3, q & 7)) = stg[i]; }
#pragma unroll
                for (int p = 0; p < 2; ++p)
#pragma unroll
                    for (int ks = 0; ks < 2; ++ks) qf[p][ks] = qn[p][ks];
            }
            __syncthreads();
        }
    }
}

constexpr int N_PHASES = 14;
struct Args { const float* in[23]; float* out; unsigned char* ws; int ph_lo, ph_hi; };
__global__ void __launch_bounds__(NTHREADS, 2) fwd(Args args) {
    extern __shared__ __attribute__((aligned(16))) unsigned char lds_raw[];
    Frame F;
#pragma unroll
    for (int i = 0; i < 23; ++i) F.in[i] = args.in[i];
    F.out = args.out; F.ws = args.ws; F.lds = (LAS unsigned char*)lds_raw;
    F.tid = threadIdx.x; F.lane = F.tid & 63; F.wave = __builtin_amdgcn_readfirstlane(F.tid >> 6); F.G = gridDim.x;
    volatile LAS unsigned* misc = (volatile LAS unsigned*)(F.lds + LDS_MISC_OFF);
    if (F.tid < 64) misc[F.tid] = 0u;
    __syncthreads();
    XcdBarrier bar; bar.bar = (unsigned*)(F.ws + WS_CTL); bar.x = 0; bar.st = misc;
    const int lo = args.ph_lo, hi = args.ph_hi;
    if (hi - lo > 1) bar = xcd_barrier_post((unsigned*)(F.ws + WS_CTL), misc);
#ifndef PH_MASK
#define PH_MASK 0xFFFF
#endif
#define IN(k) (((PH_MASK >> (k)) & 1) && lo <= (k) && (k) < hi)
#define SEAM(k) do { if (IN(k) && IN((k) + 1)) xcd_barrier(bar); } while (0)
    const float* MOD = (const float*)(F.ws + WS_MOD);
    if (IN(0)) { p0_prologue(F, 0, 96); } SEAM(0);
    if (IN(1)) { p0_prologue(F, 96, 1 << 30); norm_mod_rows(F, F.in[0], F.in[2], 0, 1024, (bf16_t*)(F.ws + WS_H)); } SEAM(1);
    if (IN(2)) { pg8::Gemm g{(const pg8::bf16_t*)(F.ws + WS_H), (const pg8::bf16_t*)(F.ws + WS_WIN), T, NPAD, D}; pg8::StaticOrder So; So.init(T, NPAD, F.G, (int)blockIdx.x);
        pg8::EpiBf16<0> E{(pg8::bf16_t*)(F.ws + WS_PROJ), NPAD, nullptr, 0, 0};
        pg8::gemm_phase<pg8::EpiBf16<0>, pg8::StaticOrder>(F.lds, g, So, E, nullptr); } SEAM(2);
#ifdef COMPRESS_NAIVE
    if (IN(3)) { p3_compress_naive(F); } SEAM(3);
#else
    if (IN(3)) { p3_compress_mfma(F); } SEAM(3);
#endif
    #ifdef ATTN_NAIVE
    if (IN(4)) { p4_attn_naive(F); } SEAM(4);
#else
    if (IN(4)) { p4_attn_mfma_t<0>(F); } SEAM(4);
#ifdef PROBE_ATTN_MODE
    if (IN(14)) { p4_attn_mfma_t<PROBE_ATTN_MODE>(F); }
#endif
#ifdef PROBE_P0_LO
    if (IN(14)) { p0_prologue(F, PROBE_P0_LO, PROBE_P0_HI); }
#endif
#endif
    if (IN(5)) { p5_mixed(F); } SEAM(5);
    if (IN(6)) { pg8::Gemm g{(const pg8::bf16_t*)(F.ws + WS_H), (const pg8::bf16_t*)(F.ws + WS_WOUT), T, D, D}; pg8::StaticOrder So; So.init(T, D, F.G, (int)blockIdx.x);
        EpiResGate E{F.out, F.in[0], MOD, 2048};
        pg8::gemm_phase<EpiResGate, pg8::StaticOrder>(F.lds, g, So, E, nullptr); } SEAM(6);
    if (IN(7)) { norm_mod_rows_q(F, F.out, F.in[3], 3072, 4096, (bf16_t*)(F.ws + WS_H)); } SEAM(7);
    if (IN(8)) { pg8::Gemm g{(const pg8::bf16_t*)(F.ws + WS_H), (const pg8::bf16_t*)(F.ws + WS_WQ), T, D, D}; pg8::StaticOrder So; So.init(T, D, F.G, (int)blockIdx.x);
        pg8::EpiBf16<0> E{(pg8::bf16_t*)(F.ws + WS_QP), D, nullptr, 0, 0};
        pg8::gemm_phase<pg8::EpiBf16<0>, pg8::StaticOrder>(F.lds, g, So, E, nullptr); } SEAM(8);
        if (IN(9)) { p9_route_sort(F); } SEAM(9);
    if (IN(10)) { p10a_udots(F); } SEAM(10);
    if (IN(11)) { p10b_coef(F); } SEAM(11);
    if (IN(12)) { p10c_vsum(F); } SEAM(12);
    if (IN(13)) { p10d_final(F); }
#undef IN
#undef SEAM
}

extern "C" void kernel_launch(void* const* d_in, const int* in_sizes, int n_in, void* d_out, int out_size, void* d_ws, size_t ws_size, hipStream_t stream) {
    static int grid = 0;
    if (grid == 0) {
        if (n_in != 23 || out_size != T * D || ws_size < WS_END) { fprintf(stderr, "kernel_launch: unexpected shapes: n_in %d out %d ws %zu (need %zu)\n", n_in, out_size, ws_size, (size_t)WS_END); grid = -1; return; }
        int dev = 0, cus = 0, per_cu = 0;
        if (hipGetDevice(&dev) != hipSuccess || hipDeviceGetAttribute(&cus, hipDeviceAttributeMultiprocessorCount, dev) != hipSuccess) { grid = -1; return; }
        if (hipFuncSetAttribute((const void*)fwd, hipFuncAttributeMaxDynamicSharedMemorySize, LDS_BYTES) != hipSuccess) { fprintf(stderr, "kernel_launch: hipFuncSetAttribute failed\n"); grid = -1; return; }
        if (hipOccupancyMaxActiveBlocksPerMultiprocessor(&per_cu, (const void*)fwd, NTHREADS, LDS_BYTES) != hipSuccess || per_cu < 1) { fprintf(stderr, "kernel_launch: occupancy query says %d\n", per_cu); (void)hipGetLastError(); per_cu = 1; }
        grid = cus;
    }
    if (grid < 0) return;
    (void)hipMemsetAsync((char*)d_ws + WS_CTL, 0, CTL_BYTES, stream);
    Args a{};
    for (int i = 0; i < 23; ++i) a.in[i] = (const float*)d_in[i];
    a.out = (float*)d_out; a.ws = (unsigned char*)d_ws;
#if MK_N_LAUNCHES == 1
    a.ph_lo = 0; a.ph_hi = N_PHASES;
    hipLaunchKernelGGL(fwd, dim3(grid), dim3(NTHREADS), LDS_BYTES, stream, a);
#else
#ifdef PROBE_LIST
    { const int plist[] = PROBE_LIST; for (int p : plist) { if (p < 0) { (void)hipMemsetAsync((char*)d_ws + WS_CTL, 0, CTL_BYTES, stream); continue; } a.ph_lo = p; a.ph_hi = p + 1; hipLaunchKernelGGL(fwd, dim3(grid), dim3(NTHREADS), LDS_BYTES, stream, a); } }
#else
    for (int p = 0; p < N_PHASES; ++p) { a.ph_lo = p; a.ph_hi = p + 1; hipLaunchKernelGGL(fwd, dim3(grid), dim3(NTHREADS), LDS_BYTES, stream, a); }
#endif
#endif
}
```

```cpp
#include <hip/hip_runtime.h>
#include <cstdio>
#include <cstdint>
#include <cstdlib>

#ifndef MK_N_LAUNCHES
#define MK_N_LAUNCHES 1
#endif
#define XB_TMO      128
#define XB_XCNT(j)  (256  + 64 * (j))
#define XB_XSUB(j)  (1280 + 64 * (j))
#define XB_XGEN(j)  (2304 + 64 * (j))
#define XB_TOP      3328
#define XB_TOPGEN   3392
#define XCD_BAR_WORDS 3456
#define XB_SPIN_CAP (1u << 18)
#define LAS __attribute__((address_space(3)))

__device__ __forceinline__ unsigned xb_ld(unsigned* p)              { return __hip_atomic_load(p, __ATOMIC_RELAXED, __HIP_MEMORY_SCOPE_AGENT); }
__device__ __forceinline__ unsigned xb_add(unsigned* p, unsigned v) { return __hip_atomic_fetch_add(p, v, __ATOMIC_RELAXED, __HIP_MEMORY_SCOPE_AGENT); }
__device__ __forceinline__ unsigned xb_xcc_id() { return (unsigned)__builtin_amdgcn_s_getreg((3 << 11) | 20) & 0xFu; }
#define XB_SPIN(cond, bar) do { unsigned _sp = 0; while (cond) { __builtin_amdgcn_s_sleep(1); \
    if ((++_sp & 255u) == 0u) { if (xb_ld(&(bar)[XB_TMO])) break; if (_sp > XB_SPIN_CAP) { atomicAdd(&(bar)[XB_TMO], 1u); break; } } } } while (0)

struct XcdBarrier {
    unsigned* bar; unsigned x;
    volatile LAS unsigned* st;
};

__device__ __forceinline__ XcdBarrier xcd_barrier_post(unsigned* bar, volatile LAS unsigned* st) {
    XcdBarrier b; b.bar = bar; b.x = xb_xcc_id(); b.st = st;
    if (threadIdx.x == 0) (void)xb_add(&bar[XB_XCNT(b.x)], 1u);
    return b;
}
__device__ __forceinline__ void xcd_barrier_complete(unsigned* bar, unsigned x, unsigned& nloc, unsigned& nx) {
    const unsigned G = gridDim.x * gridDim.y * gridDim.z;
    unsigned sum, cnt, mine, sp = 0u;
    for (;;) {
        sum = 0u; cnt = 0u; mine = 0u;
#pragma unroll
        for (unsigned j = 0; j < 16; ++j) { const unsigned c = xb_ld(&bar[XB_XCNT(j)]); sum += c; cnt += (c > 0u) ? 1u : 0u; mine = (j == x) ? c : mine; }
        if (sum == G) break;
        __builtin_amdgcn_s_sleep(1);
        if ((++sp & 255u) == 0u) { if (xb_ld(&bar[XB_TMO])) break; if (sp > XB_SPIN_CAP) { atomicAdd(&bar[XB_TMO], 1u); break; } }
    }
    nloc = mine > 0u ? mine : 1u; nx = cnt > 0u ? cnt : 1u;
}

__device__ __forceinline__ void xcd_barrier(const XcdBarrier& b) {
    asm volatile("s_waitcnt vmcnt(0)" ::: "memory");
    __syncthreads();
    if (threadIdx.x == 0) {
        unsigned* bar = b.bar;
        __builtin_amdgcn_s_waitcnt(0);
        unsigned nloc = b.st[0], nx = b.st[1];
        if (nloc == 0u) { xcd_barrier_complete(bar, b.x, nloc, nx); b.st[0] = nloc; b.st[1] = nx; }
        const unsigned old = xb_add(&bar[XB_XSUB(b.x)], 1u);
        const unsigned gen = old / nloc;
        if (old + 1u == (gen + 1u) * nloc) {
            __builtin_amdgcn_fence(__ATOMIC_RELEASE, "agent");
            asm volatile("s_waitcnt vmcnt(0)" ::: "memory");
            const unsigned og = xb_add(&bar[XB_TOP], 1u);
            const unsigned tg = og / nx;
            if (og + 1u == (tg + 1u) * nx) xb_add(&bar[XB_TOPGEN], 1u);
            else XB_SPIN(xb_ld(&bar[XB_TOPGEN]) == tg, bar);
            __builtin_amdgcn_fence(__ATOMIC_ACQUIRE, "agent");
            xb_add(&bar[XB_XGEN(b.x)], 1u);
            asm volatile("s_waitcnt vmcnt(0)" ::: "memory");
        } else {
            XB_SPIN(xb_ld(&bar[XB_XGEN(b.x)]) == gen, bar);
            __builtin_amdgcn_fence(__ATOMIC_ACQUIRE, "agent");
            asm volatile("s_waitcnt vmcnt(0)" ::: "memory");
        }
    }
    __syncthreads();
}

namespace pg8 {
#define PG8_LAS __attribute__((address_space(3)))
typedef unsigned short bf16_t;
typedef short bf16x8 __attribute__((ext_vector_type(8)));
typedef float f32x4 __attribute__((ext_vector_type(4)));
typedef unsigned u32x4 __attribute__((ext_vector_type(4)));
constexpr int BM = 256, BK = 64, HALF = 128, HTB = HALF * BK * 2  , STAGE_BYTES = 8 * HTB, NXCD = 8, WGM = 8;

__host__ __device__ __forceinline__ int lds_byte(int r, int c) { const int st = (r >> 4) * 2 + (c >> 5), rr = r & 15, cc = c & 31, ob = rr * 64 + cc * 2; return st * 1024 + (ob ^ (((ob >> 9) & 1) << 5)); }
__host__ __device__ __forceinline__ void stage_rc(int b, int& R, int& C) { const int st = b / 1024, sb = b % 1024, swz = sb ^ (((sb >> 9) & 1) << 5); R = (st >> 1) * 16 + swz / 64; C = (st & 1) * 32 + (swz % 64) / 2; }
__host__ __device__ __forceinline__ int perm32(int rho) { const int n = rho >> 4, i = rho & 15; return 8 * (i >> 2) + 4 * n + (i & 3); }

struct Unit { int pm, pn; };
struct Gemm { const bf16_t* A; const bf16_t* Bt; int M, N, K; };

struct StaticOrder {
    int nM, nN, nwg, G, c;
    __host__ __device__ void init(int M, int N, int G_, int c_) { nM = M / BM; nN = N / BM; nwg = nM * nN; G = G_; c = c_; }
    __host__ __device__ bool next(int i, Unit& u) const {
        const long L = (long)i * G + c; if (L >= nwg) return false;
        int wgid = (int)L; { const int q = nwg / NXCD, r = nwg % NXCD, xcd = wgid % NXCD, off = wgid / NXCD; wgid = (xcd < r ? xcd * (q + 1) : r * (q + 1) + (xcd - r) * q) + off; }
        const int nig = WGM * nN, gid = wgid / nig, fm = gid * WGM, gsz = (nM - fm) < WGM ? (nM - fm) : WGM;
        u.pm = fm + ((wgid % nig) % gsz); u.pn = (wgid % nig) / gsz; return true;
    }
    __device__ __forceinline__ void a_ready(const Unit&) const {}
    __device__ __forceinline__ void done(const Unit&) const {}
};
struct CountedOrder : StaticOrder {
    const unsigned* ready; unsigned need; unsigned* tmo;
    __device__ __forceinline__ void a_ready(const Unit& u) const {
        if (threadIdx.x < 64) {
            const unsigned long long t0 = __builtin_amdgcn_s_memrealtime(); unsigned polls = 0;
            while ((unsigned)__builtin_amdgcn_readfirstlane(__hip_atomic_load(ready + 64 * u.pm, __ATOMIC_RELAXED, __HIP_MEMORY_SCOPE_AGENT)) < need) {
                if ((++polls & 255u) == 0u && __builtin_amdgcn_readfirstlane(__hip_atomic_load(tmo, __ATOMIC_RELAXED, __HIP_MEMORY_SCOPE_AGENT)) != 0u) break;
                if (__builtin_amdgcn_s_memrealtime() - t0 > 2000000ull) {
                    if (threadIdx.x == 0) { unsigned expect = 0u; __hip_atomic_compare_exchange_strong(tmo + 1, &expect, 0x600u | (unsigned)(u.pm & 0xff), __ATOMIC_RELAXED, __ATOMIC_RELAXED, __HIP_MEMORY_SCOPE_AGENT); __hip_atomic_store(tmo, 1u, __ATOMIC_RELAXED, __HIP_MEMORY_SCOPE_AGENT); }
                    break; }
                __builtin_amdgcn_s_sleep(2); }
            __builtin_amdgcn_fence(__ATOMIC_ACQUIRE, "agent");
            asm volatile("s_waitcnt vmcnt(0)" ::: "memory");
        }
#if !defined(BROKEN_HOOK_NO_BARRIER)
        asm volatile("" ::: "memory"); __builtin_amdgcn_s_barrier(); asm volatile("" ::: "memory");
#endif
    }
};

__device__ __forceinline__ unsigned cvt_pk_bf16(float lo, float hi) { unsigned r; asm volatile("v_cvt_pk_bf16_f32 %0, %1, %2" : "=v"(r) : "v"(lo), "v"(hi)); return r; }
typedef float f32x2 __attribute__((ext_vector_type(2)));
__device__ __forceinline__ f32x2 gelu_pk(f32x2 v) {
    const f32x2 av = __builtin_elementwise_abs(v), d = av * 0.2316418882f + 1.0f;
    f32x2 t; t.x = __builtin_amdgcn_rcpf(d.x); t.y = __builtin_amdgcn_rcpf(d.y);
    f32x2 q = t * 0.5307027145f + (-0.7265760135f); q = q * t + 0.7107068705f; q = q * t + (-0.142248368f); q = q * t + 0.127414796f; q = q * t;
    const f32x2 s = (v * v) * (-0.72134752044f);
    f32x2 e; e.x = __builtin_amdgcn_exp2f(s.x); e.y = __builtin_amdgcn_exp2f(s.y);
    const f32x2 m = v * (q * e), r = v - m;
    f32x2 o; o.x = v.x < 0.f ? m.x : r.x; o.y = v.y < 0.f ? m.y : r.y; return o;
}

struct EpiF32 {
    static constexpr bool PERM = false, AFTER_DRAIN = false;
    float* C; int ldc; const float* bias;
    __device__ __forceinline__ void operator()(const f32x4 (&acc)[2][2][4][2], const Unit& u, int wr, int wc, int fr, int fq) const {
        const int row0 = u.pm * BM + wr * 64 + fr, col0 = u.pn * BM + wc * 32 + 4 * fq;
        f32x4 bv[2][2];
#pragma unroll
        for (int bj = 0; bj < 2; ++bj)
#pragma unroll
            for (int n = 0; n < 2; ++n) bv[bj][n] = bias ? *(const f32x4*)(bias + col0 + bj * HALF + n * 16) : (f32x4){0.f, 0.f, 0.f, 0.f};
#pragma unroll
        for (int ai = 0; ai < 2; ++ai)
#pragma unroll
            for (int m = 0; m < 4; ++m) { float* rowp = C + (size_t)(row0 + ai * HALF + m * 16) * ldc + col0;
#pragma unroll
                for (int bj = 0; bj < 2; ++bj)
#pragma unroll
                    for (int n = 0; n < 2; ++n) *(f32x4*)(rowp + bj * HALF + n * 16) = acc[ai][bj][m][n] + bv[bj][n]; }
    }
};
template <int ACT  > struct EpiBf16 {
    static constexpr bool PERM = true, AFTER_DRAIN = false;
    bf16_t* O; int ldc; const float* bias; int split_cols; size_t split_stride;
    __device__ __forceinline__ void operator()(const f32x4 (&acc)[2][2][4][2], const Unit& u, int wr, int wc, int fr, int fq) const {
        const int row0 = u.pm * BM + wr * 64 + fr; int colt = u.pn * BM; bf16_t* base = O;
        if (split_cols) { const int t = colt / split_cols; base += (size_t)t * split_stride; colt -= t * split_cols; }
        const int col0 = colt + wc * 32 + 8 * fq, bcol0 = u.pn * BM + wc * 32 + 8 * fq;
        f32x4 bv[2][2];
#pragma unroll
        for (int bj = 0; bj < 2; ++bj)
#pragma unroll
            for (int n = 0; n < 2; ++n) bv[bj][n] = bias ? *(const f32x4*)(bias + bcol0 + bj * HALF + 4 * n) : (f32x4){0.f, 0.f, 0.f, 0.f};
#pragma unroll
        for (int ai = 0; ai < 2; ++ai)
#pragma unroll
            for (int m = 0; m < 4; ++m) { bf16_t* rowp = base + (size_t)(row0 + ai * HALF + m * 16) * ldc + col0;
#pragma unroll
                for (int bj = 0; bj < 2; ++bj) { f32x4 v0 = acc[ai][bj][m][0] + bv[bj][0], v1 = acc[ai][bj][m][1] + bv[bj][1];
                    if (ACT == 1) { f32x2 a = gelu_pk((f32x2){v0[0], v0[1]}), b = gelu_pk((f32x2){v0[2], v0[3]}), c = gelu_pk((f32x2){v1[0], v1[1]}), d = gelu_pk((f32x2){v1[2], v1[3]});
                        v0 = (f32x4){a.x, a.y, b.x, b.y}; v1 = (f32x4){c.x, c.y, d.x, d.y}; }
                    if (ACT == 2) {
#pragma unroll
                        for (int j = 0; j < 4; ++j) { v0[j] = 0.5f * v0[j] * (1.0f + erff(v0[j] * 0.70710678f)); v1[j] = 0.5f * v1[j] * (1.0f + erff(v1[j] * 0.70710678f)); } }
                    u32x4 w; w.x = cvt_pk_bf16(v0[0], v0[1]); w.y = cvt_pk_bf16(v0[2], v0[3]); w.z = cvt_pk_bf16(v1[0], v1[1]); w.w = cvt_pk_bf16(v1[2], v1[3]);
                    *(u32x4*)(rowp + bj * HALF) = w; } }
    }
};

struct PanelStats {
    unsigned* xbuf;
    unsigned* cnt;
    unsigned* tmo;
    int ntn; float eps;
    unsigned code;
    __device__ __forceinline__ bool run(const f32x4 (&v)[2][2][4][2], const Unit& u, int wr, int wc, int fr, int fq, PG8_LAS unsigned char* lds, int wid, int lane) const {
        typedef float f32x2v __attribute__((ext_vector_type(2)));
        PG8_LAS f32x2v* P = (PG8_LAS f32x2v*)lds;
        PG8_LAS f32x2v* S = (PG8_LAS f32x2v*)(lds + 8192);
        PG8_LAS unsigned* flag = (PG8_LAS unsigned*)(lds + 8192 + 2048);
#pragma unroll
        for (int ai = 0; ai < 2; ++ai)
#pragma unroll
            for (int m = 0; m < 4; ++m) {
                float s = 0.f;
#pragma unroll
                for (int bj = 0; bj < 2; ++bj)
#pragma unroll
                    for (int n = 0; n < 2; ++n) { const f32x4 x = v[ai][bj][m][n]; s += (x[0] + x[1]) + (x[2] + x[3]); }
                s += __shfl_xor(s, 16); s += __shfl_xor(s, 32);
                const float mw = s * (1.0f / 64.0f); float q = 0.f;
#pragma unroll
                for (int bj = 0; bj < 2; ++bj)
#pragma unroll
                    for (int n = 0; n < 2; ++n) { const f32x4 d = v[ai][bj][m][n] - mw; q += (d[0] * d[0] + d[1] * d[1]) + (d[2] * d[2] + d[3] * d[3]); }
                q += __shfl_xor(q, 16); q += __shfl_xor(q, 32);
                if (fq == 0) P[(ai * HALF + wr * 64 + m * 16 + fr) * 4 + wc] = (f32x2v){mw, q};
            }
        asm volatile("s_waitcnt lgkmcnt(0)" ::: "memory"); __builtin_amdgcn_s_barrier(); asm volatile("" ::: "memory");
#if defined(BROKEN_NO_WAIT)
        if (blockIdx.x >= 64) { const long long t0 = clock64(); while (clock64() - t0 < 60000) __builtin_amdgcn_s_sleep(8); }
#endif
        const int row = wid * 32 + (lane & 31);
        if (lane < 32) {
            const f32x2v a = P[row * 4 + 0], b = P[row * 4 + 1], c = P[row * 4 + 2], d = P[row * 4 + 3];
            const float mt = (a.x + b.x + c.x + d.x) * 0.25f;
            const float da = a.x - mt, db = b.x - mt, dc = c.x - mt, dd = d.x - mt;
            const float m2 = (a.y + b.y) + (c.y + d.y) + 64.0f * ((da * da + db * db) + (dc * dc + dd * dd));
            unsigned long long* slot = (unsigned long long*)xbuf + ((size_t)(u.pm * BM + row) * 4 + u.pn);
            __hip_atomic_store(slot, ((unsigned long long)__float_as_uint(m2) << 32) | __float_as_uint(mt), __ATOMIC_RELAXED, __HIP_MEMORY_SCOPE_AGENT);
        }
        asm volatile("s_waitcnt vmcnt(0)" ::: "memory");
        if (lane == 0) __hip_atomic_fetch_add(cnt + 64 * u.pm, 1u, __ATOMIC_RELAXED, __HIP_MEMORY_SCOPE_AGENT);
        if (wid == 0) {
            bool dead = false; const unsigned long long t0 = __builtin_amdgcn_s_memrealtime(); const unsigned want = 8u * (unsigned)ntn;
            for (;;) {
#if defined(BROKEN_NO_WAIT)
                break;
#endif
                if ((unsigned)__builtin_amdgcn_readfirstlane(__hip_atomic_load(cnt + 64 * u.pm, __ATOMIC_RELAXED, __HIP_MEMORY_SCOPE_AGENT)) >= want) break;
                if (__builtin_amdgcn_s_memrealtime() - t0 > 2000000ull) {
                    if (lane == 0) { unsigned expect = 0u; __hip_atomic_compare_exchange_strong(tmo + 1, &expect, code | (unsigned)(u.pm & 0xff), __ATOMIC_RELAXED, __ATOMIC_RELAXED, __HIP_MEMORY_SCOPE_AGENT);
                                     __hip_atomic_store(tmo, 1u, __ATOMIC_RELAXED, __HIP_MEMORY_SCOPE_AGENT); }
                    dead = true; break; }
                __builtin_amdgcn_s_sleep(2);
            }
            __builtin_amdgcn_fence(__ATOMIC_ACQUIRE, "agent");
            if (lane == 0) flag[0] = dead ? 1u : 0u;
        }
        asm volatile("s_waitcnt vmcnt(0) lgkmcnt(0)" ::: "memory"); __builtin_amdgcn_s_barrier(); asm volatile("" ::: "memory");
        const bool bad = flag[0] != 0u;
        if (lane < 32) {
            const unsigned long long* slot = (const unsigned long long*)xbuf + (size_t)(u.pm * BM + row) * 4; float mt[4], m2[4]; float ms = 0.f;
#pragma unroll
            for (int t = 0; t < 4; ++t) { if (t < ntn) { const unsigned long long w = __hip_atomic_load(slot + t, __ATOMIC_RELAXED, __HIP_MEMORY_SCOPE_AGENT); mt[t] = __uint_as_float((unsigned)w); m2[t] = __uint_as_float((unsigned)(w >> 32)); } else { mt[t] = 0.f; m2[t] = 0.f; } ms += mt[t]; }
            const float mean = ms / (float)ntn; float q = 0.f;
#pragma unroll
            for (int t = 0; t < 4; ++t) if (t < ntn) { const float dm = mt[t] - mean; q += m2[t] + 256.0f * dm * dm; }
            S[row] = (f32x2v){mean, 1.0f / sqrtf(q / (256.0f * (float)ntn) + eps)};
        }
        asm volatile("s_waitcnt lgkmcnt(0)" ::: "memory"); __builtin_amdgcn_s_barrier(); asm volatile("" ::: "memory");
        return bad;
    }
};
struct EpiLnRes {
    static constexpr bool PERM = false, AFTER_DRAIN = true;
    const float* base; float* out; int ldc; const float* bias; PanelStats st; unsigned poison;
    __device__ __forceinline__ void refuse(size_t i0, size_t stride, int M, int N) const { const float q = __builtin_nanf(""); for (size_t i = i0; i < (size_t)M * N; i += stride) out[(i / N) * ldc + i % N] = q;
        if (i0 == 0) { unsigned expect = 0u; __hip_atomic_compare_exchange_strong(st.tmo + 1, &expect, 0x7f0u, __ATOMIC_RELAXED, __ATOMIC_RELAXED, __HIP_MEMORY_SCOPE_AGENT); __hip_atomic_store(st.tmo, 1u, __ATOMIC_RELAXED, __HIP_MEMORY_SCOPE_AGENT); } }
    __device__ __forceinline__ void fused(f32x4 (&acc)[2][2][4][2], const Unit& u, int wr, int wc, int fr, int fq, PG8_LAS unsigned char* lds, int wid, int lane) const {
        typedef float f32x2v __attribute__((ext_vector_type(2)));
        const PG8_LAS f32x2v* S = (const PG8_LAS f32x2v*)(lds + 8192);
        const int col0 = u.pn * BM + wc * 32 + 4 * fq;
#pragma unroll
        for (int bj = 0; bj < 2; ++bj)
#pragma unroll
            for (int n = 0; n < 2; ++n) { const f32x4 bv = bias ? *(const f32x4*)(bias + col0 + bj * HALF + n * 16) : (f32x4){0.f, 0.f, 0.f, 0.f};
#pragma unroll
                for (int ai = 0; ai < 2; ++ai)
#pragma unroll
                    for (int m = 0; m < 4; ++m) acc[ai][bj][m][n] += bv; }
        const bool bad = st.run(acc, u, wr, wc, fr, fq, lds, wid, lane) || poison != 0u;
        const float qnan = __builtin_nanf("");
#pragma unroll
        for (int ai = 0; ai < 2; ++ai)
#pragma unroll
            for (int m = 0; m < 4; ++m) { const int r = ai * HALF + wr * 64 + m * 16 + fr; const f32x2v sr = S[r]; const size_t off = (size_t)(u.pm * BM + r) * ldc + col0;
#pragma unroll
                for (int bj = 0; bj < 2; ++bj)
#pragma unroll
                    for (int n = 0; n < 2; ++n) { const f32x4 bs = *(const f32x4*)(base + off + bj * HALF + n * 16); f32x4 o = bs + (acc[ai][bj][m][n] - sr.x) * sr.y;
                        if (bad) o = (f32x4){qnan, qnan, qnan, qnan}; *(f32x4*)(out + off + bj * HALF + n * 16) = o; }
                asm volatile("" ::: "memory"); }
    }
};
struct EpiLnResLn {
    static constexpr bool PERM = false, AFTER_DRAIN = true;
    const float* base; float* out; bf16_t* xn; int ldc; const float* bias; PanelStats st1, st2; unsigned poison;
    __device__ __forceinline__ void refuse(size_t i0, size_t stride, int M, int N) const { const float q = __builtin_nanf(""); for (size_t i = i0; i < (size_t)M * N; i += stride) { const size_t o = (i / N) * ldc + i % N; out[o] = q; xn[o] = (bf16_t)0x7fc0u; }
        if (i0 == 0) { unsigned expect = 0u; __hip_atomic_compare_exchange_strong(st1.tmo + 1, &expect, 0x7f0u, __ATOMIC_RELAXED, __ATOMIC_RELAXED, __HIP_MEMORY_SCOPE_AGENT); __hip_atomic_store(st1.tmo, 1u, __ATOMIC_RELAXED, __HIP_MEMORY_SCOPE_AGENT); } }
    __device__ __forceinline__ void fused(f32x4 (&acc)[2][2][4][2], const Unit& u, int wr, int wc, int fr, int fq, PG8_LAS unsigned char* lds, int wid, int lane) const {
        typedef float f32x2v __attribute__((ext_vector_type(2))); typedef unsigned u32x2v __attribute__((ext_vector_type(2)));
        const PG8_LAS f32x2v* S = (const PG8_LAS f32x2v*)(lds + 8192);
        const int col0 = u.pn * BM + wc * 32 + 4 * fq;
#pragma unroll
        for (int bj = 0; bj < 2; ++bj)
#pragma unroll
            for (int n = 0; n < 2; ++n) { const f32x4 bv = bias ? *(const f32x4*)(bias + col0 + bj * HALF + n * 16) : (f32x4){0.f, 0.f, 0.f, 0.f};
#pragma unroll
                for (int ai = 0; ai < 2; ++ai)
#pragma unroll
                    for (int m = 0; m < 4; ++m) acc[ai][bj][m][n] += bv; }
        bool bad = st1.run(acc, u, wr, wc, fr, fq, lds, wid, lane) || poison != 0u;
        const float qnan = __builtin_nanf("");
#pragma unroll
        for (int ai = 0; ai < 2; ++ai)
#pragma unroll
            for (int m = 0; m < 4; ++m) { const int r = ai * HALF + wr * 64 + m * 16 + fr; const f32x2v sr = S[r]; const size_t off = (size_t)(u.pm * BM + r) * ldc + col0;
#pragma unroll
                for (int bj = 0; bj < 2; ++bj)
#pragma unroll
                    for (int n = 0; n < 2; ++n) { const f32x4 bs = *(const f32x4*)(base + off + bj * HALF + n * 16); acc[ai][bj][m][n] = bs + (acc[ai][bj][m][n] - sr.x) * sr.y; }
                asm volatile("" : "+v"(acc[ai][0][m][0]), "+v"(acc[ai][0][m][1]), "+v"(acc[ai][1][m][0]), "+v"(acc[ai][1][m][1]));
                if (m & 1) asm volatile("" ::: "memory"); }
        const bool bad1 = bad;
        bad = st2.run(acc, u, wr, wc, fr, fq, lds, wid, lane) || bad;
#pragma unroll
        for (int ai = 0; ai < 2; ++ai)
#pragma unroll
            for (int m = 0; m < 4; ++m) { const int r = ai * HALF + wr * 64 + m * 16 + fr; const f32x2v sr = S[r]; const size_t off = (size_t)(u.pm * BM + r) * ldc + col0;
#pragma unroll
                for (int bj = 0; bj < 2; ++bj)
#pragma unroll
                    for (int n = 0; n < 2; ++n) { const f32x4 x1 = acc[ai][bj][m][n]; *(f32x4*)(out + off + bj * HALF + n * 16) = bad1 ? (f32x4){qnan, qnan, qnan, qnan} : x1;
                        const f32x4 o = (x1 - sr.x) * sr.y; u32x2v w; w.x = cvt_pk_bf16(o[0], o[1]); w.y = cvt_pk_bf16(o[2], o[3]);
                        if (bad) { w.x = 0x7fc07fc0u; w.y = 0x7fc07fc0u; } *(u32x2v*)(xn + off + bj * HALF + n * 16) = w; }
                asm volatile("" ::: "memory"); }
    }
};

template <class Epi, class Sched, bool STAMP = false>
__device__ __forceinline__ void gemm_phase(PG8_LAS unsigned char* lds, const Gemm g, const Sched& S, const Epi& E, unsigned long long* stamps) {
    const int tid = threadIdx.x, wid = __builtin_amdgcn_readfirstlane(tid >> 6), lane = tid & 63, wr = wid >> 2, wc = wid & 3, fr = lane & 15, fq = lane >> 4;
    const int K = g.K, nt = K / BK;
    int ts_lo = 0, ts_hi = 0, nts = 0; const unsigned long long rt_entry = STAMP ? (unsigned long long)wall_clock64() : 0ull;
#define PG8_STAMP() do { if (STAMP && wid == 0 && nts < 64) { const unsigned long long _c = (unsigned long long)clock64(); \
        ts_lo = (lane == nts) ? (int)(unsigned)_c : ts_lo; ts_hi = (lane == nts) ? (int)(unsigned)(_c >> 32) : ts_hi; ++nts; } } while (0)
    PG8_STAMP();
    unsigned voffA[2], voffB[2];
#pragma unroll
    for (int i = 0; i < 2; ++i) { int R, C; stage_rc(tid * 16 + i * 8192, R, C); const int Rb = Epi::PERM ? ((R & ~31) + perm32(R & 31)) : R;
        voffA[i] = (unsigned)(R * K + C) * 2u; voffB[i] = (unsigned)(Rb * K + C) * 2u; }
    const size_t kstep = (size_t)(BK * 2);
    const size_t hstep = (size_t)HALF * K * 2;
    const size_t tstep = 2 * hstep;
    const unsigned ldsw = (unsigned)wid * 1024u;
    const int aoff = lds_byte(wr * 64 + fr, fq * 8), boff = lds_byte(wc * 32 + fr, fq * 8);
#define PG8_SA(b, h) (((b) * 2 + (h)) * HTB)
#define PG8_SB(b, h) ((4 + (b) * 2 + (h)) * HTB)
#define PG8_STAGE(bufoff, gbase, voff) do { _Pragma("unroll") for (int _i = 0; _i < 2; ++_i) \
        __builtin_amdgcn_global_load_lds((const unsigned*)((const char*)(gbase) + (voff)[_i]), (PG8_LAS unsigned*)(lds + (bufoff) + ldsw + _i * 8192), 16, 0, 0); } while (0)
#define PG8_LDA(dst, b, h) do { _Pragma("unroll") for (int m = 0; m < 4; ++m) _Pragma("unroll") for (int k = 0; k < 2; ++k) dst[m][k] = *(const PG8_LAS bf16x8*)(lds + PG8_SA(b, h) + aoff + m * 2048 + k * 1024); } while (0)
#define PG8_LDB(dst, b, h) do { _Pragma("unroll") for (int n = 0; n < 2; ++n) _Pragma("unroll") for (int k = 0; k < 2; ++k) dst[n][k] = *(const PG8_LAS bf16x8*)(lds + PG8_SB(b, h) + boff + n * 2048 + k * 1024); } while (0)
#define PG8_MMA(ai, bj, At, Bt) do { __builtin_amdgcn_s_setprio(1); _Pragma("unroll") for (int m = 0; m < 4; ++m) _Pragma("unroll") for (int n = 0; n < 2; ++n) _Pragma("unroll") for (int k = 0; k < 2; ++k) \
        acc[ai][bj][m][n] = __builtin_amdgcn_mfma_f32_16x16x32_bf16(Bt[n][k], At[m][k], acc[ai][bj][m][n], 0, 0, 0); __builtin_amdgcn_s_setprio(0); } while (0)
#define PG8_WAIT_V(n) asm volatile("s_waitcnt vmcnt(" #n ")" ::: "memory")
#define PG8_WAIT_L(n) asm volatile("s_waitcnt lgkmcnt(" #n ")" ::: "memory")
#define PG8_BAR __builtin_amdgcn_s_barrier()
#define PG8_SCHED __builtin_amdgcn_sched_barrier(0)
    Unit cur, nxt; int ui = 0;
    if (!S.next(0, cur)) return;
    f32x4 acc[2][2][4][2];
#pragma unroll
    for (int a = 0; a < 2; ++a)
#pragma unroll
        for (int b = 0; b < 2; ++b)
#pragma unroll
            for (int m = 0; m < 4; ++m)
#pragma unroll
                for (int n = 0; n < 2; ++n) acc[a][b][m][n] = (f32x4){0.f, 0.f, 0.f, 0.f};
    bf16x8 At[4][2], B0[2][2], B1[2][2];
    const char* cA = (const char*)g.A + (size_t)cur.pm * tstep; const char* cB = (const char*)g.Bt + (size_t)cur.pn * tstep;
    S.a_ready(cur);
    PG8_STAGE(PG8_SB(0, 0), cB, voffB); PG8_STAGE(PG8_SA(0, 0), cA, voffA); PG8_STAGE(PG8_SB(0, 1), cB + hstep, voffB); PG8_STAGE(PG8_SA(0, 1), cA + hstep, voffA);
    if (wr == 1) PG8_BAR;
    PG8_WAIT_V(4); PG8_BAR;
    PG8_STAGE(PG8_SB(1, 0), cB + kstep, voffB); PG8_STAGE(PG8_SA(1, 0), cA + kstep, voffA); PG8_STAGE(PG8_SB(1, 1), cB + hstep + kstep, voffB);
    PG8_WAIT_V(6); PG8_BAR;
    PG8_STAMP();
    for (;;) {
        const bool has_next = S.next(ui + 1, nxt);
        const char* nA = has_next ? (const char*)g.A + (size_t)nxt.pm * tstep : cA; const char* nB = has_next ? (const char*)g.Bt + (size_t)nxt.pn * tstep : cB;
        for (int t = 0; t < nt; t += 2) {
            const bool last = (t == nt - 2);
            const char* a1 = cA + (size_t)(t + 1) * kstep;
            const char* a2 = last ? nA : cA + (size_t)(t + 2) * kstep; const char* b2 = last ? nB : cB + (size_t)(t + 2) * kstep;
            const char* a3 = a2 + kstep; const char* b3 = b2 + kstep;
            if (last && has_next) S.a_ready(nxt);
            PG8_LDB(B0, 0, 0); PG8_SCHED; PG8_LDA(At, 0, 0); PG8_STAGE(PG8_SA(1, 1), a1 + hstep, voffA);
            PG8_WAIT_L(8); PG8_BAR; PG8_WAIT_L(0); PG8_MMA(0, 0, At, B0); PG8_BAR; PG8_SCHED;
            PG8_LDB(B1, 0, 1); PG8_STAGE(PG8_SB(0, 0), b2, voffB);
            PG8_BAR; PG8_WAIT_L(0); PG8_MMA(0, 1, At, B1); PG8_BAR;
            PG8_LDA(At, 0, 1); PG8_STAGE(PG8_SA(0, 0), a2, voffA);
            PG8_BAR; PG8_WAIT_L(0); PG8_MMA(1, 0, At, B0); PG8_BAR; PG8_SCHED;
            PG8_STAGE(PG8_SB(0, 1), b2 + hstep, voffB);
            PG8_WAIT_V(6); PG8_BAR; PG8_MMA(1, 1, At, B1); PG8_BAR;
            PG8_LDB(B0, 1, 0); PG8_SCHED; PG8_LDA(At, 1, 0); PG8_STAGE(PG8_SA(0, 1), a2 + hstep, voffA);
            PG8_WAIT_L(8); PG8_BAR; PG8_WAIT_L(0); PG8_MMA(0, 0, At, B0); PG8_BAR; PG8_SCHED;
            PG8_LDB(B1, 1, 1); PG8_STAGE(PG8_SB(1, 0), b3, voffB);
            PG8_BAR; PG8_WAIT_L(0); PG8_MMA(0, 1, At, B1); PG8_BAR;
            PG8_LDA(At, 1, 1); PG8_STAGE(PG8_SA(1, 0), a3, voffA);
            PG8_BAR; PG8_WAIT_L(0); PG8_MMA(1, 0, At, B0); PG8_BAR; PG8_SCHED;
            PG8_STAGE(PG8_SB(1, 1), b3 + hstep, voffB);
            PG8_WAIT_V(6); PG8_BAR; PG8_MMA(1, 1, At, B1); PG8_BAR;
        }
        PG8_STAMP();
        if constexpr (!Epi::AFTER_DRAIN) { E(acc, cur, wr, wc, fr, fq); S.done(cur); }
        PG8_STAMP();
        if (!has_next) break;
#pragma unroll
        for (int a = 0; a < 2; ++a)
#pragma unroll
            for (int b = 0; b < 2; ++b)
#pragma unroll
                for (int m = 0; m < 4; ++m)
#pragma unroll
                    for (int n = 0; n < 2; ++n) acc[a][b][m][n] = (f32x4){0.f, 0.f, 0.f, 0.f};
        cur = nxt; cA = nA; cB = nB; ++ui;
    }
    PG8_WAIT_V(0);
    if (wr == 0) PG8_BAR;
    PG8_BAR;
    if constexpr (Epi::AFTER_DRAIN) { E.fused(acc, cur, wr, wc, fr, fq, lds, wid, lane); S.done(cur); }
    PG8_STAMP();
    if (STAMP && wid == 0) { stamps[lane] = lane < nts ? (((unsigned long long)(unsigned)ts_hi << 32) | (unsigned)ts_lo) : 0ull;
        if (lane == 62) stamps[62] = rt_entry; if (lane == 63) stamps[63] = (unsigned long long)wall_clock64(); }
#undef PG8_STAMP
#undef PG8_SA
#undef PG8_SB
#undef PG8_STAGE
#undef PG8_LDA
#undef PG8_LDB
#undef PG8_MMA
#undef PG8_WAIT_V
#undef PG8_WAIT_L
#undef PG8_BAR
#undef PG8_SCHED
}
}

constexpr int D = 1024, NB = 16, S = 2048, T = NB * S;
constexpr int NCOL = 2840, NPAD = 3072;
constexpr int C_Q = 0, C_KC = 512, C_VC = 640, C_KS = 768, C_VS = 896, C_KW = 1024, C_VW = 1152, C_GT = 1280, C_CB = 1304, C_CC = 1816, C_CH = 2328;
constexpr int NCMP = 127;
constexpr int NEXP = 16384;
constexpr float EPS = 1e-6f;
constexpr int NTHREADS = 512, NWAVES = 8;

constexpr size_t al256(size_t x) { return (x + 255) & ~(size_t)255; }
constexpr size_t WS_CTL   = 0;                                   constexpr size_t CTL_BYTES = 65536;
constexpr size_t WS_MOD   = WS_CTL + CTL_BYTES;
constexpr size_t WS_WIN   = al256(WS_MOD + (size_t)16 * 6144 * 4);
constexpr size_t WS_WOUT  = al256(WS_WIN + (size_t)NPAD * D * 2);
constexpr size_t WS_WQ    = al256(WS_WOUT + (size_t)D * D * 2);
constexpr size_t WS_KEYS  = al256(WS_WQ + (size_t)D * D * 2);
constexpr size_t WS_U8S   = al256(WS_KEYS + (size_t)16 * 128 * 64 * 2);
constexpr size_t WS_V8S   = al256(WS_U8S + (size_t)NEXP * D);
constexpr size_t WS_X8S   = al256(WS_V8S + (size_t)NEXP * D);
constexpr size_t WS_SU    = al256(WS_X8S + (size_t)T * D);
constexpr size_t WS_SV    = al256(WS_SU + (size_t)NEXP * 4);
constexpr size_t WS_SX    = al256(WS_SV + (size_t)NEXP * 4);
constexpr size_t WS_W1T   = al256(WS_SX + (size_t)T * 4);
constexpr size_t WS_W2T   = al256(WS_W1T + (size_t)2 * 64 * 2048 * 2);
constexpr size_t WS_PEC   = al256(WS_W2T + (size_t)2 * 64 * 64 * 2);
constexpr size_t WS_KC    = al256(WS_PEC + (size_t)2 * 64 * 4);
constexpr size_t WS_VC    = al256(WS_KC + (size_t)16 * 2 * 128 * 64 * 2);
constexpr size_t WS_H     = al256(WS_VC + (size_t)16 * 2 * 128 * 64 * 2);
constexpr size_t WS_CQ8   = WS_H;
constexpr size_t WS_CMAX  = WS_H + (size_t)32 * 1024 * 1024;
constexpr size_t WS_SSQP  = WS_H + (size_t)33 * 1024 * 1024;
constexpr size_t WS_OATT  = al256(WS_H + (size_t)T * D * 2);
constexpr size_t WS_PROJ  = al256(WS_OATT + (size_t)T * 512 * 2);
constexpr size_t WS_QP    = WS_PROJ;
constexpr size_t WS_PART  = WS_PROJ;
constexpr size_t WS_PO    = WS_PROJ;
constexpr size_t WS_E16   = WS_PROJ + (size_t)160 * 1024 * 1024;
constexpr size_t WS_EW    = WS_E16 + (size_t)T * 128 * 4;
constexpr size_t WS_END   = al256(WS_PROJ + (size_t)T * NPAD * 2);
static_assert(WS_EW + (size_t)T * 128 * 4 <= WS_END, "alias region");
static_assert((size_t)8 * T * 128 * 4 <= (size_t)160 * 1024 * 1024, "PART fits under EIDX");
constexpr int CTL_CTR_A = 16384, CTL_CTR_B = 16384 + 8 * 256;

constexpr int LDS_STAGE = 147456;
constexpr int LDS_MISC_OFF = LDS_STAGE;
constexpr int LDS_BYTES = LDS_STAGE + 256;

typedef unsigned short bf16_t;
typedef short bf16x8 __attribute__((ext_vector_type(8)));
typedef short s16x4 __attribute__((ext_vector_type(4)));
typedef float f32x4 __attribute__((ext_vector_type(4)));
typedef unsigned u32x4v __attribute__((ext_vector_type(4)));
__device__ __forceinline__ float bf2f(bf16_t b) { return __uint_as_float(((unsigned)b) << 16); }
__device__ __forceinline__ bf16_t f2bf(float f) { unsigned u = __float_as_uint(f); u += 0x7FFFu + ((u >> 16) & 1u); return (bf16_t)(u >> 16); }
__device__ __forceinline__ float bflo(unsigned w) { return __uint_as_float(w << 16); }
__device__ __forceinline__ float bfhi(unsigned w) { return __uint_as_float(w & 0xFFFF0000u); }
__device__ __forceinline__ unsigned pack2(float lo, float hi) { return (unsigned)f2bf(lo) | ((unsigned)f2bf(hi) << 16); }
__device__ __forceinline__ float gelu_tanh(float x) { const float u = 0.7978845608028654f * (x + 0.044715f * x * x * x); return 0.5f * x * (1.0f + tanhf(u)); }
__device__ __forceinline__ float sigmoidf_(float x) { return 1.0f / (1.0f + __expf(-x)); }
__device__ __forceinline__ float wave_sum(float v) {
#pragma unroll
    for (int o = 32; o >= 1; o >>= 1) v += __shfl_xor(v, o);
    return v; }
__device__ __forceinline__ float wave_max(float v) {
#pragma unroll
    for (int o = 32; o >= 1; o >>= 1) v = fmaxf(v, __shfl_xor(v, o));
    return v; }
__device__ __forceinline__ void lds_wave_sync() { asm volatile("s_waitcnt lgkmcnt(0)" ::: "memory"); }
#ifdef PROBE_STAMP
#define STAMP_DECL unsigned long long tprev_ = 0ull; const bool dbg_ = (PROBE_PHASE == 12 || blockIdx.x == PROBE_BLOCK) && (threadIdx.x == 0);
#define STAMP_START() do { if (dbg_) tprev_ = __builtin_amdgcn_s_memtime(); } while (0)
#define STAMP(k) do { if (dbg_) { const unsigned long long tn_ = __builtin_amdgcn_s_memtime(); volatile LAS unsigned* c_ = (volatile LAS unsigned*)(F_lds_ + LDS_MISC_OFF + 128); c_[k] += (unsigned)(tn_ - tprev_); tprev_ = tn_; } } while (0)
#define STAMP_COUNT(k) do { if (dbg_) { volatile LAS unsigned* c_ = (volatile LAS unsigned*)(F_lds_ + LDS_MISC_OFF + 128); c_[k] += 1u; } } while (0)
#else
#define STAMP_DECL
#define STAMP_START() do {} while (0)
#define STAMP(k) do {} while (0)
#define STAMP_COUNT(k) do {} while (0)
#endif
#ifndef PROBE_BLOCK
#define PROBE_BLOCK 0
#endif
#ifndef PROBE_PHASE
#define PROBE_PHASE 4
#endif

__device__ __forceinline__ int rel_bucket(int dist) {
    const int n = dist > 0 ? dist : 0;
    if (n < 16) return n;
    const float lr = logf((float)n / 16.0f) / 2.0794415416798357f;
    const int large = 16 + (int)(lr * 16.0f);
    return large < 31 ? large : 31;
}

struct Frame {
    const float* in[23]; float* out; unsigned char* ws;
    LAS unsigned char* lds; int tid, lane, wave, G;
};


typedef int i32x4v __attribute__((ext_vector_type(4)));
constexpr int PEER_CHUNK_TOK = 128, PEER_NCHUNK = T / PEER_CHUNK_TOK;

__device__ __forceinline__ void quant_row_sliced(const float* row, unsigned char* dst8  , size_t nrows, size_t r, float* scale_out, int bias, int lane) {
    float4 v[4]; float am = 0.f;
#pragma unroll
    for (int i = 0; i < 4; ++i) { v[i] = *(const float4*)(row + (lane + 64 * i) * 4); am = fmaxf(am, fmaxf(fmaxf(fabsf(v[i].x), fabsf(v[i].y)), fmaxf(fabsf(v[i].z), fabsf(v[i].w)))); }
    am = wave_max(am); const float inv = am > 0.f ? 127.0f / am : 0.f;
    if (lane == 0) *scale_out = am > 0.f ? am / 127.0f : 0.f;
#pragma unroll
    for (int i = 0; i < 4; ++i) { const int col = (lane + 64 * i) * 4; const int sl = col >> 7, off = col & 127;
        const int q0 = (int)rintf(v[i].x * inv) + bias, q1 = (int)rintf(v[i].y * inv) + bias, q2 = (int)rintf(v[i].z * inv) + bias, q3 = (int)rintf(v[i].w * inv) + bias;
        *(unsigned*)(dst8 + ((size_t)sl * nrows + r) * 128 + off) = (unsigned)(q0 & 0xFF) | ((unsigned)(q1 & 0xFF) << 8) | ((unsigned)(q2 & 0xFF) << 16) | ((unsigned)(q3 & 0xFF) << 24); }
}

constexpr int PEER_NGRP = T / 16;
__device__ __forceinline__ int grab_item(unsigned* ctr, int slice, int lane) {
    unsigned v = 0u; if (lane == 0) v = __hip_atomic_fetch_add(ctr + slice * 64, 1u, __ATOMIC_RELAXED, __HIP_MEMORY_SCOPE_AGENT);
    return (int)__builtin_amdgcn_readfirstlane(v);
}
__device__ __forceinline__ void gather_rows16(u32x4v (&vv)[16], const unsigned char* base, const LAS unsigned* le) {
    const u32x4v e0 = *(const LAS u32x4v*)le, e1 = *(const LAS u32x4v*)(le + 4);
#pragma unroll
    for (int ld = 0; ld < 16; ++ld) { const unsigned w = ld < 8 ? e0[ld >> 1] : e1[(ld - 8) >> 1]; const unsigned e = (ld & 1) ? (w >> 16) : (w & 0xFFFFu);
        vv[ld] = *(const u32x4v*)(base + (size_t)e * 128); }
}
__device__ __forceinline__ void udot_item(const u32x4v (&uv)[16], const i32x4v xq, int* part_row  , int c) {
    i32x4v res[4];
#pragma unroll
    for (int ld = 0; ld < 16; ++ld) { int p = __builtin_amdgcn_sdot4((int)uv[ld][0], xq[0], 0, false); p = __builtin_amdgcn_sdot4((int)uv[ld][1], xq[1], p, false);
        p = __builtin_amdgcn_sdot4((int)uv[ld][2], xq[2], p, false); p = __builtin_amdgcn_sdot4((int)uv[ld][3], xq[3], p, false);
        p += __shfl_xor(p, 1); p += __shfl_xor(p, 2); p += __shfl_xor(p, 4); res[ld >> 2][ld & 3] = p; }
    if (c == 0) {
#pragma unroll
        for (int q = 0; q < 4; ++q) *(i32x4v*)(part_row + 4 * q) = res[q]; }
}
__device__ __forceinline__ void p10a_udots(const Frame& F) {
    const unsigned char* U8S = F.ws + WS_U8S; const unsigned char* X8S = F.ws + WS_X8S; const unsigned short* E16 = (const unsigned short*)(F.ws + WS_E16); int* PART = (int*)(F.ws + WS_PART);
    unsigned* ctr = (unsigned*)(F.ws + WS_CTL + CTL_CTR_A);
    const int lane = F.lane, j = lane >> 3, c = lane & 7; const int xcc = (int)(xb_xcc_id() & 7u);
    LAS unsigned char* wl = F.lds + F.wave * 8192;
    const LAS unsigned* le = (const LAS unsigned*)wl + 8 * j;
    for (int so = 0; so < 8; ++so) { const int x = (xcc + so) & 7;
        const unsigned char* ub = U8S + (size_t)x * NEXP * 128 + c * 16;
        int nxt = grab_item(ctr, x, lane);
        for (;;) { const int cur = nxt; if (cur >= PEER_NGRP) break;
            nxt = grab_item(ctr, x, lane);
            const int t0 = cur * 16;
            { const u32x4v* src = (const u32x4v*)(E16 + (size_t)t0 * 128);
#pragma unroll
                for (int i = 0; i < 4; ++i) *(LAS u32x4v*)(wl + (lane + 64 * i) * 16) = src[lane + 64 * i]; }
            lds_wave_sync();
            const unsigned char* xb = X8S + ((size_t)x * T + t0) * 128 + c * 16; int* pr = PART + ((size_t)x * T + t0) * 128 + 16 * j;
            u32x4v va[16], vb[16];
            gather_rows16(va, ub, le);
#pragma unroll 1
            for (int tt = 0; tt < 16; tt += 2) {
                const i32x4v xqa = *(const i32x4v*)(xb + (size_t)tt * 128), xqb = *(const i32x4v*)(xb + (size_t)(tt + 1) * 128);
                gather_rows16(vb, ub, le + (tt + 1) * 64);
                udot_item(va, xqa, pr + (size_t)tt * 128, c);
                if (tt + 2 < 16) gather_rows16(va, ub, le + (tt + 2) * 64);
                udot_item(vb, xqb, pr + (size_t)(tt + 1) * 128, c);
            }
            lds_wave_sync();
        }
    }
}

__device__ __forceinline__ void p10b_coef(const Frame& F) {
    const unsigned short* E16 = (const unsigned short*)(F.ws + WS_E16); const float* EW = (const float*)(F.ws + WS_EW); const int* PART = (const int*)(F.ws + WS_PART);
    const float* SU = (const float*)(F.ws + WS_SU); const float* SV = (const float*)(F.ws + WS_SV); const float* SX = (const float*)(F.ws + WS_SX);
    signed char* CQ8 = (signed char*)(F.ws + WS_CQ8); float* CMAX = (float*)(F.ws + WS_CMAX);
    const int gw = blockIdx.x * NWAVES + F.wave, nw = F.G * NWAVES, lane = F.lane;
    for (int t = gw; t < T; t += nw) { const float sx = SX[t]; float cs[2]; float am = 0.f;
#pragma unroll
        for (int hh = 0; hh < 2; ++hh) { const int i = lane + 64 * hh; int s = 0;
#pragma unroll
            for (int x = 0; x < 8; ++x) s += PART[((size_t)x * T + t) * 128 + i];
            const int e = E16[(size_t)t * 128 + i]; const float dot = (float)s * sx * SU[e];
            cs[hh] = EW[(size_t)t * 128 + i] * gelu_tanh(dot) * SV[e]; am = fmaxf(am, fabsf(cs[hh])); }
        am = wave_max(am); const float inv = am > 0.f ? 127.0f / am : 0.f;
#pragma unroll
        for (int hh = 0; hh < 2; ++hh) CQ8[(size_t)t * 128 + lane + 64 * hh] = (signed char)(int)rintf(cs[hh] * inv);
        if (lane == 0) CMAX[t] = am > 0.f ? am / 127.0f : 0.f; }
}

struct VsumPre { float sc; };
__device__ __forceinline__ void vsum_item(const u32x4v (&vv)[16], const LAS unsigned* lq  , const VsumPre& pre, unsigned* pop, int lane) {
    const u32x4v cq = *(const LAS u32x4v*)lq;
    int acc[16];
#pragma unroll
    for (int k = 0; k < 16; ++k) acc[k] = 0;
#pragma unroll
    for (int g = 0; g < 4; ++g) { const int cw = (int)cq[g];
#pragma unroll
        for (int w = 0; w < 4; ++w) { const unsigned r0 = vv[4 * g][w], r1 = vv[4 * g + 1][w], r2 = vv[4 * g + 2][w], r3 = vv[4 * g + 3][w];
            const unsigned t0 = __builtin_amdgcn_perm(r1, r0, 0x05010400u), t1 = __builtin_amdgcn_perm(r1, r0, 0x07030602u), t2 = __builtin_amdgcn_perm(r3, r2, 0x05010400u), t3 = __builtin_amdgcn_perm(r3, r2, 0x07030602u);
            const unsigned c0 = __builtin_amdgcn_perm(t2, t0, 0x05040100u), c1 = __builtin_amdgcn_perm(t2, t0, 0x07060302u), c2 = __builtin_amdgcn_perm(t3, t1, 0x05040100u), c3 = __builtin_amdgcn_perm(t3, t1, 0x07060302u);
            acc[4 * w + 0] = __builtin_amdgcn_sdot4((int)c0, cw, acc[4 * w + 0], false); acc[4 * w + 1] = __builtin_amdgcn_sdot4((int)c1, cw, acc[4 * w + 1], false);
            acc[4 * w + 2] = __builtin_amdgcn_sdot4((int)c2, cw, acc[4 * w + 2], false); acc[4 * w + 3] = __builtin_amdgcn_sdot4((int)c3, cw, acc[4 * w + 3], false); } }
    int a8[8], a4[4], a2[2];
    { const bool hi = (lane & 32) != 0;
#pragma unroll
        for (int k = 0; k < 8; ++k) { const int snd = hi ? acc[k] : acc[k + 8]; const int rcv = __shfl_xor(snd, 32); a8[k] = (hi ? acc[k + 8] : acc[k]) + rcv; } }
    { const bool hi = (lane & 16) != 0;
#pragma unroll
        for (int k = 0; k < 4; ++k) { const int snd = hi ? a8[k] : a8[k + 4]; const int rcv = __shfl_xor(snd, 16); a4[k] = (hi ? a8[k + 4] : a8[k]) + rcv; } }
    { const bool hi = (lane & 8) != 0;
#pragma unroll
        for (int k = 0; k < 2; ++k) { const int snd = hi ? a4[k] : a4[k + 2]; const int rcv = __shfl_xor(snd, 8); a2[k] = (hi ? a4[k + 2] : a4[k]) + rcv; } }
    *pop = pg8::cvt_pk_bf16((float)a2[0] * pre.sc, (float)a2[1] * pre.sc);
}
__device__ __forceinline__ void p10c_vsum(const Frame& F) {
    const unsigned char* V8S = F.ws + WS_V8S; const unsigned short* E16 = (const unsigned short*)(F.ws + WS_E16); const signed char* CQ8 = (const signed char*)(F.ws + WS_CQ8); const float* CMAX = (const float*)(F.ws + WS_CMAX);
    bf16_t* PO = (bf16_t*)(F.ws + WS_PO);
    unsigned* ctr = (unsigned*)(F.ws + WS_CTL + CTL_CTR_B);
    const int lane = F.lane, j = lane >> 3, c = lane & 7; const int xcc = (int)(xb_xcc_id() & 7u);
    const int ocol = 16 * c + 8 * ((lane >> 5) & 1) + 4 * ((lane >> 4) & 1) + 2 * ((lane >> 3) & 1);
    LAS unsigned char* wl = F.lds + F.wave * 8192;
    const LAS unsigned* le = (const LAS unsigned*)wl + 8 * j; const LAS unsigned* lq = (const LAS unsigned*)(wl + 4096) + 4 * j;
    for (int so = 0; so < 8; ++so) { const int x = (xcc + so) & 7;
        const unsigned char* vb = V8S + (size_t)x * NEXP * 128 + c * 16;
        const int col = x * 128 + ocol;
        int nxt = grab_item(ctr, x, lane);
        for (;;) { const int cur = nxt; if (cur >= PEER_NGRP) break;
            nxt = grab_item(ctr, x, lane);
            const int t0 = cur * 16;
            { const u32x4v* src = (const u32x4v*)(E16 + (size_t)t0 * 128); const u32x4v* srq = (const u32x4v*)(CQ8 + (size_t)t0 * 128);
#pragma unroll
                for (int i = 0; i < 4; ++i) *(LAS u32x4v*)(wl + (lane + 64 * i) * 16) = src[lane + 64 * i];
#pragma unroll
                for (int i = 0; i < 2; ++i) *(LAS u32x4v*)(wl + 4096 + (lane + 64 * i) * 16) = srq[lane + 64 * i]; }
            lds_wave_sync();
            u32x4v va[16], vbb[16];
            gather_rows16(va, vb, le);
#pragma unroll 1
            for (int tt = 0; tt < 16; tt += 2) {
                { VsumPre pa; pa.sc = CMAX[t0 + tt];
                  gather_rows16(vbb, vb, le + (tt + 1) * 64);
                  vsum_item(va, lq + tt * 32, pa, (unsigned*)(PO + (size_t)(t0 + tt) * D + col), lane); }
                { VsumPre pb; pb.sc = CMAX[t0 + tt + 1];
                  if (tt + 2 < 16) gather_rows16(va, vb, le + (tt + 2) * 64);
                  vsum_item(vbb, lq + (tt + 1) * 32, pb, (unsigned*)(PO + (size_t)(t0 + tt + 1) * D + col), lane); }
            }
            lds_wave_sync();
        }
    }
}

__device__ __forceinline__ void p10d_final(const Frame& F) {
    const bf16_t* PO = (const bf16_t*)(F.ws + WS_PO); const float* MOD = (const float*)(F.ws + WS_MOD); const float* gfin = F.in[22]; float* out = F.out;
    const int gw = blockIdx.x * NWAVES + F.wave, nw = F.G * NWAVES, lane = F.lane;
    float4 xn[4]; uint2 pn[4];
    if (gw < T) {
#pragma unroll
        for (int i = 0; i < 4; ++i) { const int col = (lane + 64 * i) * 4; xn[i] = *(const float4*)(out + (size_t)gw * D + col); pn[i] = *(const uint2*)(PO + (size_t)gw * D + col); } }
    for (int t = gw; t < T; t += nw) { const int b = t / S;
        float4 v[4], xc[4]; uint2 pc[4]; float ss = 0.f;
#pragma unroll
        for (int i = 0; i < 4; ++i) { xc[i] = xn[i]; pc[i] = pn[i]; }
        { const int tn = t + nw < T ? t + nw : t;
#pragma unroll
            for (int i = 0; i < 4; ++i) { const int col = (lane + 64 * i) * 4; xn[i] = *(const float4*)(out + (size_t)tn * D + col); pn[i] = *(const uint2*)(PO + (size_t)tn * D + col); } }
#pragma unroll
        for (int i = 0; i < 4; ++i) { const int col = (lane + 64 * i) * 4; const float4 x1 = xc[i], gt = *(const float4*)(MOD + b * 6144 + 5120 + col);
            const uint2 pw = pc[i];
            v[i].x = x1.x + gt.x * bflo(pw.x); v[i].y = x1.y + gt.y * bfhi(pw.x); v[i].z = x1.z + gt.z * bflo(pw.y); v[i].w = x1.w + gt.w * bfhi(pw.y);
            ss += v[i].x * v[i].x + v[i].y * v[i].y + v[i].z * v[i].z + v[i].w * v[i].w; }
        ss = wave_sum(ss);
#ifdef PROBE_STAMP
        const unsigned* dg = (const unsigned*)(F.ws + WS_CTL + 32768); const float pnum = (float)dg[PROBE_STAMP]; const float pden = PROBE_DEN >= 0 ? (float)dg[PROBE_DEN >= 0 ? PROBE_DEN : 0] : (float)PROBE_ABS;
        const float rstd = rsqrtf(ss * (1.0f / D) + EPS) * (1.0f + 0.5f * pnum / pden);
#else
        const float rstd = rsqrtf(ss * (1.0f / D) + EPS);
#endif
#pragma unroll
        for (int i = 0; i < 4; ++i) { const int col = (lane + 64 * i) * 4; const float4 gg = *(const float4*)(gfin + col);
            *(float4*)(out + (size_t)t * D + col) = make_float4(v[i].x * rstd * gg.x, v[i].y * rstd * gg.y, v[i].z * rstd * gg.z, v[i].w * rstd * gg.w); }
    }
}

__device__ __forceinline__ void transpose_tile(const Frame& F, const float* src, int srcK, int srcN, bf16_t* dst, int dstK, int kt, int nt) {
    LAS float* tile = (LAS float*)F.lds;
    const int k0 = kt * 64, n0 = nt * 64;
    for (int i = F.tid; i < 4096; i += NTHREADS) { const int r = i >> 6, c = i & 63; const int k = k0 + r, n = n0 + c;
        tile[r * 65 + c] = (k < srcK && n < srcN) ? src[(size_t)k * srcN + n] : 0.0f; }
    __syncthreads();
    for (int i = F.tid; i < 4096; i += NTHREADS) { const int r = i >> 6, c = i & 63;
        dst[(size_t)(n0 + r) * dstK + k0 + c] = f2bf(tile[c * 65 + r]); }
    __syncthreads();
}
__device__ __forceinline__ void p0_prologue(const Frame& F, int item_lo = 0, int item_hi = 1 << 30) {
    const float* c = F.in[1]; const float* w_mod = F.in[4]; const float* b_mod = F.in[5];
    float* MOD = (float*)(F.ws + WS_MOD);
    constexpr int I_MOD = 96, I_WIN = 16 * 48, I_WOUT = 256, I_WQ = 256, I_U = 256, I_V = 256, I_KEYS = 2, I_CMP = 32 + 32 + 1 + 1 + 2;
    constexpr int O_WIN = I_MOD, O_WOUT = O_WIN + I_WIN, O_WQ = O_WOUT + I_WOUT, O_U = O_WQ + I_WQ, O_V = O_U + I_U, O_KEYS = O_V + I_V, O_CMP = O_KEYS + I_KEYS, N_ITEMS = O_CMP + I_CMP;
    for (int it = item_lo + blockIdx.x; it < N_ITEMS && it < item_hi; it += F.G) {
        if (it < O_WIN) {
            LAS float* sl = (LAS float*)F.lds; LAS float* red = (LAS float*)(F.lds + 65536);
            for (int q = F.tid; q < 16 * D; q += NTHREADS) { const float cv = c[q]; sl[q] = cv / (1.0f + __expf(-cv)); }
            __syncthreads();
            const int kg = F.tid >> 6, cl = F.tid & 63, j0 = it * 64;
            float acc[16];
#pragma unroll
            for (int bb = 0; bb < 16; ++bb) acc[bb] = 0.f;
            const float* wp = w_mod + (size_t)(kg * 128) * 6144 + j0 + cl;
#pragma unroll 4
            for (int kk = 0; kk < 128; ++kk) { const float w = wp[(size_t)kk * 6144]; const int k = kg * 128 + kk;
#pragma unroll
                for (int bb = 0; bb < 16; ++bb) acc[bb] += sl[bb * D + k] * w; }
#pragma unroll
            for (int bb = 0; bb < 16; ++bb) red[(kg * 16 + bb) * 64 + cl] = acc[bb];
            __syncthreads();
#pragma unroll
            for (int q = 0; q < 2; ++q) { const int o = F.tid + 512 * q; const int bb = o >> 6, cc = o & 63; float s = b_mod[j0 + cc];
#pragma unroll
                for (int g8 = 0; g8 < 8; ++g8) s += red[(g8 * 16 + bb) * 64 + cc];
                MOD[bb * 6144 + j0 + cc] = s; }
            __syncthreads();
        } else if (it < O_WOUT) { const int i = it - O_WIN; transpose_tile(F, F.in[6], D, NCOL, (bf16_t*)(F.ws + WS_WIN), D, i % 16, i / 16); }
        else if (it < O_WQ) { const int i = it - O_WOUT; transpose_tile(F, F.in[16], D, D, (bf16_t*)(F.ws + WS_WOUT), D, i % 16, i / 16); }
        else if (it < O_U) { const int i = it - O_WQ; transpose_tile(F, F.in[17], D, D, (bf16_t*)(F.ws + WS_WQ), D, i % 16, i / 16); }
        else if (it < O_KEYS) {
            const bool isv = it >= O_V; const int i = isv ? it - O_V : it - O_U;
            for (int rr = 0; rr < 8; ++rr) { const size_t r = (size_t)i * 64 + rr * 8 + F.wave;
                quant_row_sliced((isv ? F.in[20] : F.in[19]) + r * D, F.ws + (isv ? WS_V8S : WS_U8S), NEXP, r, (float*)(F.ws + (isv ? WS_SV : WS_SU)) + r, 0, F.lane); }
        } else if (it >= O_CMP) {
            const int i = it - O_CMP;
            if (i < 64) { const int kv = i >> 5; transpose_tile(F, kv ? F.in[11] : F.in[9], 2048, 64, (bf16_t*)(F.ws + WS_W1T) + (size_t)kv * 64 * 2048, 2048, i & 31, 0); }
            else if (i < 66) { const int kv = i - 64; transpose_tile(F, kv ? F.in[12] : F.in[10], 64, 64, (bf16_t*)(F.ws + WS_W2T) + (size_t)kv * 64 * 64, 64, 0, 0); }
            else { const int kv = i - 66; const float* pe = kv ? F.in[8] : F.in[7]; const float* w1 = kv ? F.in[11] : F.in[9];
                LAS float* red = (LAS float*)F.lds; const int jj = F.tid & 63, kg = F.tid >> 6; float a = 0.f;
#pragma unroll 8
                for (int kk = 0; kk < 256; ++kk) { const int k = kg * 256 + kk; a += pe[k] * w1[(size_t)k * 64 + jj]; }
                red[kg * 64 + jj] = a; __syncthreads();
                if (F.tid < 64) { float s = 0.f;
#pragma unroll
                    for (int g8 = 0; g8 < 8; ++g8) s += red[g8 * 64 + F.tid];
                    ((float*)(F.ws + WS_PEC))[kv * 64 + F.tid] = s; }
                __syncthreads(); }
        } else {
            const int i = it - O_KEYS; const float4* src = (const float4*)F.in[18] + (size_t)i * 16384; uint2* dst = (uint2*)(F.ws + WS_KEYS) + (size_t)i * 16384;
            for (int q = F.tid; q < 16384; q += NTHREADS) { const float4 v = src[q]; dst[q] = make_uint2(pack2(v.x, v.y), pack2(v.z, v.w)); }
        }
    }
}

__device__ __forceinline__ void norm_mod_rows(const Frame& F, const float* x, const float* g, int sh_off, int sc_off, bf16_t* dst) {
    const float* MOD = (const float*)(F.ws + WS_MOD);
    const int gw = blockIdx.x * NWAVES + F.wave, nw = F.G * NWAVES;
    float4 vn[4];
    if (gw < T) {
#pragma unroll
        for (int i = 0; i < 4; ++i) vn[i] = ((const float4*)(x + (size_t)gw * D))[F.lane + 64 * i]; }
    for (int t = gw; t < T; t += nw) {
        const int b = t / S;
        float4 v[4]; float ss = 0.f;
#pragma unroll
        for (int i = 0; i < 4; ++i) { v[i] = vn[i]; ss += v[i].x * v[i].x + v[i].y * v[i].y + v[i].z * v[i].z + v[i].w * v[i].w; }
        { const int tn = t + nw < T ? t + nw : t;
#pragma unroll
            for (int i = 0; i < 4; ++i) vn[i] = ((const float4*)(x + (size_t)tn * D))[F.lane + 64 * i]; }
        ss = wave_sum(ss); const float rstd = rsqrtf(ss * (1.0f / D) + EPS);
#pragma unroll
        for (int i = 0; i < 4; ++i) { const int col = (F.lane + 64 * i) * 4;
            const float4 gg = *(const float4*)(g + col), sc = *(const float4*)(MOD + b * 6144 + sc_off + col), sh = *(const float4*)(MOD + b * 6144 + sh_off + col);
            const float o0 = v[i].x * rstd * gg.x * (1.f + sc.x) + sh.x, o1 = v[i].y * rstd * gg.y * (1.f + sc.y) + sh.y, o2 = v[i].z * rstd * gg.z * (1.f + sc.z) + sh.z, o3 = v[i].w * rstd * gg.w * (1.f + sc.w) + sh.w;
            *(uint2*)(dst + (size_t)t * D + col) = make_uint2(pack2(o0, o1), pack2(o2, o3)); }
    }
}

__device__ __forceinline__ void norm_mod_rows_q(const Frame& F, const float* x, const float* g, int sh_off, int sc_off, bf16_t* dst) {
    const float* MOD = (const float*)(F.ws + WS_MOD);
    const int gw = blockIdx.x * NWAVES + F.wave, nw = F.G * NWAVES;
    float4 vn[4];
    if (gw < T) {
#pragma unroll
        for (int i = 0; i < 4; ++i) vn[i] = ((const float4*)(x + (size_t)gw * D))[F.lane + 64 * i]; }
    for (int t = gw; t < T; t += nw) {
        const int b = t / S;
        float4 v[4]; float ss = 0.f;
#pragma unroll
        for (int i = 0; i < 4; ++i) { v[i] = vn[i]; ss += v[i].x * v[i].x + v[i].y * v[i].y + v[i].z * v[i].z + v[i].w * v[i].w; }
        { const int tn = t + nw < T ? t + nw : t;
#pragma unroll
            for (int i = 0; i < 4; ++i) vn[i] = ((const float4*)(x + (size_t)tn * D))[F.lane + 64 * i]; }
        ss = wave_sum(ss); const float rstd = rsqrtf(ss * (1.0f / D) + EPS);
        float am = 0.f;
#pragma unroll
        for (int i = 0; i < 4; ++i) { const int col = (F.lane + 64 * i) * 4;
            const float4 gg = *(const float4*)(g + col), sc = *(const float4*)(MOD + b * 6144 + sc_off + col), sh = *(const float4*)(MOD + b * 6144 + sh_off + col);
            v[i].x = v[i].x * rstd * gg.x * (1.f + sc.x) + sh.x; v[i].y = v[i].y * rstd * gg.y * (1.f + sc.y) + sh.y; v[i].z = v[i].z * rstd * gg.z * (1.f + sc.z) + sh.z; v[i].w = v[i].w * rstd * gg.w * (1.f + sc.w) + sh.w;
            *(uint2*)(dst + (size_t)t * D + col) = make_uint2(pack2(v[i].x, v[i].y), pack2(v[i].z, v[i].w));
            am = fmaxf(am, fmaxf(fmaxf(fabsf(v[i].x), fabsf(v[i].y)), fmaxf(fabsf(v[i].z), fabsf(v[i].w)))); }
        am = wave_max(am); const float inv = am > 0.f ? 127.0f / am : 0.f;
        if (F.lane == 0) ((float*)(F.ws + WS_SX))[t] = am > 0.f ? am / 127.0f : 0.f;
#pragma unroll
        for (int i = 0; i < 4; ++i) { const int col = (F.lane + 64 * i) * 4; const int sl = col >> 7, off = col & 127;
            const int q0 = (int)rintf(v[i].x * inv), q1 = (int)rintf(v[i].y * inv), q2 = (int)rintf(v[i].z * inv), q3 = (int)rintf(v[i].w * inv);
            *(unsigned*)(F.ws + WS_X8S + ((size_t)sl * T + t) * 128 + off) = (unsigned)(q0 & 0xFF) | ((unsigned)(q1 & 0xFF) << 8) | ((unsigned)(q2 & 0xFF) << 16) | ((unsigned)(q3 & 0xFF) << 24); }
    }
}

__device__ __forceinline__ void p3_compress_naive(const Frame& F) {
    const bf16_t* PROJ = (const bf16_t*)(F.ws + WS_PROJ);
    LAS float* hid = (LAS float*)F.lds + F.wave * 64;
    const int gw = blockIdx.x * NWAVES + F.wave, nw = F.G * NWAVES;
    if (gw < 64) { bf16_t* dz = (bf16_t*)(F.ws + ((gw & 1) ? WS_VC : WS_KC)); dz[((size_t)(gw >> 1) * 128 + 127) * 64 + F.lane] = 0; }
    for (int u = gw; u < NB * NCMP * 2 * 2; u += nw) {
        const int kv = u & 1, g = (u >> 1) & 1, n = (u >> 2) % NCMP, b = (u >> 2) / NCMP;
        const float* pe = kv ? F.in[8] : F.in[7]; const float* w1 = kv ? F.in[11] : F.in[9]; const float* w2 = kv ? F.in[12] : F.in[10];
        const int cbase = (kv ? C_VC : C_KC) + g * 64;
        float acc = 0.f;
        for (int l = 0; l < 32; ++l) {
            const bf16_t* row = PROJ + (size_t)(b * S + 16 * n + l) * NPAD + cbase;
            for (int d = 0; d < 64; ++d) { const float a = bf2f(row[d]) + pe[l * 64 + d]; acc += a * w1[(size_t)(l * 64 + d) * 64 + F.lane]; }
        }
        hid[F.lane] = gelu_tanh(acc); lds_wave_sync();
        float o = 0.f;
        for (int j = 0; j < 64; ++j) o += hid[j] * w2[j * 64 + F.lane];
        bf16_t* dst = (bf16_t*)(F.ws + (kv ? WS_VC : WS_KC)); dst[((size_t)(b * 2 + g) * 128 + n) * 64 + F.lane] = f2bf(o);
        lds_wave_sync();
    }
}


__device__ __forceinline__ void p3_compress_mfma(const Frame& F) {
    const bf16_t* PROJ = (const bf16_t*)(F.ws + WS_PROJ);
    const int lane = F.lane, tid = F.tid, wave = F.wave, grp = lane >> 4, col = lane & 15;
    LAS float* red = (LAS float*)F.lds;
    LAS bf16_t* hid = (LAS bf16_t*)(F.lds + 32768);
    if (blockIdx.x * NWAVES + wave < 64) { const int gw = blockIdx.x * NWAVES + wave; bf16_t* dz = (bf16_t*)(F.ws + ((gw & 1) ? WS_VC : WS_KC)); dz[((size_t)(gw >> 1) * 128 + 127) * 64 + lane] = 0; }
    for (int u = blockIdx.x; u < NB * 2 * 2 * 8; u += F.G) {
        const int nt8 = u & 7, kv = (u >> 3) & 1, g = (u >> 4) & 1, b = u >> 5; const int n0 = nt8 * 16;
        const bf16_t* W1T = (const bf16_t*)(F.ws + WS_W1T) + (size_t)kv * 64 * 2048; const bf16_t* W2T = (const bf16_t*)(F.ws + WS_W2T) + (size_t)kv * 64 * 64;
        const float* pec = (const float*)(F.ws + WS_PEC) + kv * 64;
        const int cbase = (kv ? C_VC : C_KC) + g * 64;
        const int nrow = (n0 + col) < NCMP ? (n0 + col) : (NCMP - 1);
        f32x4 acc[4];
#pragma unroll
        for (int nt = 0; nt < 4; ++nt) acc[nt] = (f32x4){0.f, 0.f, 0.f, 0.f};
#pragma unroll
        for (int ks = 0; ks < 8; ++ks) { const int l = 4 * wave + (ks >> 1), d0 = (ks & 1) * 32 + 8 * grp;
            const bf16x8 af = *(const bf16x8*)(PROJ + (size_t)(b * S + 16 * nrow + l) * NPAD + cbase + d0);
#pragma unroll
            for (int nt = 0; nt < 4; ++nt) { const bf16x8 bfr = *(const bf16x8*)(W1T + (size_t)(nt * 16 + col) * 2048 + l * 64 + d0);
                acc[nt] = __builtin_amdgcn_mfma_f32_16x16x32_bf16(af, bfr, acc[nt], 0, 0, 0); } }
#pragma unroll
        for (int nt = 0; nt < 4; ++nt)
#pragma unroll
            for (int rg = 0; rg < 4; ++rg) red[(wave * 16 + 4 * grp + rg) * 64 + nt * 16 + col] = acc[nt][rg];
        __syncthreads();
#pragma unroll
        for (int q = 0; q < 2; ++q) { const int idx = tid + 512 * q; float s = pec[idx & 63];
#pragma unroll
            for (int w = 0; w < 8; ++w) s += red[w * 1024 + idx];
            hid[idx] = f2bf(gelu_tanh(s)); }
        __syncthreads();
        if (wave < 4) { f32x4 o = (f32x4){0.f, 0.f, 0.f, 0.f};
#pragma unroll
            for (int ks = 0; ks < 2; ++ks) { const bf16x8 af = *(const LAS bf16x8*)(hid + col * 64 + ks * 32 + 8 * grp); const bf16x8 bfr = *(const bf16x8*)(W2T + (size_t)(wave * 16 + col) * 64 + ks * 32 + 8 * grp);
                o = __builtin_amdgcn_mfma_f32_16x16x32_bf16(af, bfr, o, 0, 0, 0); }
            bf16_t* dst = (bf16_t*)(F.ws + (kv ? WS_VC : WS_KC));
#pragma unroll
            for (int rg = 0; rg < 4; ++rg) { const int n = n0 + 4 * grp + rg; if (n < NCMP) dst[((size_t)(b * 2 + g) * 128 + n) * 64 + wave * 16 + col] = f2bf(o[rg]); } }
        __syncthreads();
    }
}

__device__ __forceinline__ void dot4_row(const bf16_t* krow, const LAS float* qs, float (&acc)[4]) {
    const uint4* kr = (const uint4*)krow;
#pragma unroll 1
    for (int c = 0; c < 8; ++c) { asm volatile("" ::: "memory"); const uint4 w = kr[c]; const unsigned ww[4] = {w.x, w.y, w.z, w.w};
#pragma unroll
        for (int e = 0; e < 4; ++e) { const float k0 = bflo(ww[e]), k1 = bfhi(ww[e]); const int d = c * 8 + e * 2;
#pragma unroll
            for (int r = 0; r < 4; ++r) acc[r] += qs[r * 64 + d] * k0 + qs[r * 64 + d + 1] * k1; } }
}
__device__ __forceinline__ void p4_attn_naive(const Frame& F) {
    const bf16_t* PROJ = (const bf16_t*)(F.ws + WS_PROJ); const bf16_t* KC = (const bf16_t*)(F.ws + WS_KC); const bf16_t* VC = (const bf16_t*)(F.ws + WS_VC);
    bf16_t* OATT = (bf16_t*)(F.ws + WS_OATT); const float* rel = F.in[21];
    LAS float* wl = (LAS float*)F.lds + F.wave * (256 + 512 + 2048 + 16);
    LAS float* qs = wl; LAS float* pc = wl + 256; LAS float* ps = wl + 768; LAS int* pbase = (LAS int*)(wl + 768 + 2048);
    const int gw = blockIdx.x * NWAVES + F.wave, nw = F.G * NWAVES, lane = F.lane;
    for (int u = gw; u < T * 2; u += nw) {
        const int g = u & 1, tok = u >> 1, b = tok / S, t = tok % S;
        const bf16_t* prow = PROJ + (size_t)tok * NPAD;
#pragma unroll
        for (int r = 0; r < 4; ++r) qs[r * 64 + lane] = bf2f(prow[C_Q + (g * 4 + r) * 64 + lane]) * 0.125f;
        lds_wave_sync();
        const int nv = t >= 31 ? ((t - 31) >> 4) + 1 : 0;
        float sc[2][4]; bool va[2];
#pragma unroll
        for (int i = 0; i < 2; ++i) { const int n = lane + 64 * i; va[i] = n < nv; float a[4] = {0.f, 0.f, 0.f, 0.f};
            if (va[i]) { dot4_row(KC + ((size_t)(b * 2 + g) * 128 + n) * 64, qs, a); const int bk = rel_bucket(t - (16 * n + 31));
#pragma unroll
                for (int r = 0; r < 4; ++r) a[r] += rel[bk * 8 + g * 4 + r]; }
#pragma unroll
            for (int r = 0; r < 4; ++r) sc[i][r] = va[i] ? a[r] : -1e30f; }
        float ocmp[4];
#pragma unroll
        for (int r = 0; r < 4; ++r) { const float m = wave_max(fmaxf(sc[0][r], sc[1][r]));
            const float e0 = va[0] ? __expf(sc[0][r] - m) : 0.f, e1 = va[1] ? __expf(sc[1][r] - m) : 0.f; const float sum = wave_sum(e0 + e1);
            const float inv = nv > 0 ? 1.0f / sum : 0.f; pc[r * 128 + lane] = e0 * inv; pc[r * 128 + 64 + lane] = e1 * inv; }
        lds_wave_sync();
        { float o[4] = {0.f, 0.f, 0.f, 0.f}; const bf16_t* vb = VC + ((size_t)(b * 2 + g) * 128) * 64 + lane;
            for (int n = 0; n < nv; ++n) { const float v = bf2f(vb[n * 64]);
#pragma unroll
                for (int r = 0; r < 4; ++r) o[r] += pc[r * 128 + n] * v; }
#pragma unroll
            for (int r = 0; r < 4; ++r) ocmp[r] = o[r]; }
        const int cur = t >> 6; float val;
        { const int j = lane & 31; float imp = 0.f;
#pragma unroll
            for (int r = 0; r < 4; ++r) for (int n = 4 * j - 1; n <= 4 * j + 3; ++n) if (n >= 0 && n < NCMP) imp += pc[r * 128 + n];
            const bool forced = (j == 0) || (j == cur) || (j == cur - 1); const bool allowed = j <= cur;
            val = forced ? 1e4f : (allowed ? imp : -INFINITY); }
        int rank = 0;
        for (int jp = 0; jp < 32; ++jp) { const float vp = __shfl(val, jp); rank += ((vp > val) || (vp == val && jp < (lane & 31))) ? 1 : 0; }
        unsigned selmask = (unsigned)(__ballot(lane < 32 && rank < 8) & 0xFFFFFFFFull);
        float oslc[4], owin[4];
#pragma unroll
        for (int br = 0; br < 2; ++br) {
            const int ck = br == 0 ? C_KS : C_KW, cv = br == 0 ? C_VS : C_VW;
            unsigned mk = selmask;
#pragma unroll 1
            for (int c = 0; c < 8; ++c) {
                int kpos, bs;
                if (br == 0) { const int j = __builtin_ctz(mk | 0x80000000u); mk &= mk - 1; bs = 64 * j; } else { bs = t - 511 + 64 * c; }
                kpos = bs + lane; if (lane == 0) pbase[c] = bs;
                const int dist = t - kpos; const bool vv = (dist >= 0) && (kpos >= 0) && (kpos < S);
                float a[4] = {0.f, 0.f, 0.f, 0.f};
                if (vv) { dot4_row(PROJ + (size_t)(b * S + kpos) * NPAD + ck + g * 64, qs, a); const int bk = rel_bucket(dist);
#pragma unroll
                    for (int r = 0; r < 4; ++r) a[r] += rel[bk * 8 + g * 4 + r]; }
#pragma unroll
                for (int r = 0; r < 4; ++r) ps[r * 512 + c * 64 + lane] = vv ? a[r] : -1e30f;
            }
            lds_wave_sync();
#pragma unroll 1
            for (int r = 0; r < 4; ++r) { float m = -1e30f;
#pragma unroll
                for (int c = 0; c < 8; ++c) m = fmaxf(m, ps[r * 512 + c * 64 + lane]);
                m = wave_max(m); float e[8], sum = 0.f;
#pragma unroll
                for (int c = 0; c < 8; ++c) { const float sv = ps[r * 512 + c * 64 + lane]; e[c] = sv > -1e29f ? __expf(sv - m) : 0.f; sum += e[c]; }
                sum = wave_sum(sum); const float inv = sum > 0.f ? 1.0f / sum : 0.f;
#pragma unroll
                for (int c = 0; c < 8; ++c) ps[r * 512 + c * 64 + lane] = e[c] * inv; }
            lds_wave_sync();
            float o[4] = {0.f, 0.f, 0.f, 0.f};
#pragma unroll 1
            for (int c = 0; c < 8; ++c) {
                const int bsc = pbase[c];
                for (int kk = 0; kk < 64; ++kk) { const int kpos = bsc + kk; if (kpos < 0 || kpos > t) continue;
                    const float v = bf2f(PROJ[(size_t)(b * S + kpos) * NPAD + cv + g * 64 + lane]);
#pragma unroll
                    for (int r = 0; r < 4; ++r) o[r] += ps[r * 512 + c * 64 + kk] * v; } }
            lds_wave_sync();
#pragma unroll
            for (int r = 0; r < 4; ++r) { if (br == 0) oslc[r] = o[r]; else owin[r] = o[r]; }
        }
#pragma unroll
        for (int r = 0; r < 4; ++r) { const int h = g * 4 + r;
            const float g0 = sigmoidf_(bf2f(prow[C_GT + h * 3 + 0])), g1 = sigmoidf_(bf2f(prow[C_GT + h * 3 + 1])), g2 = sigmoidf_(bf2f(prow[C_GT + h * 3 + 2]));
            OATT[(size_t)tok * 512 + h * 64 + lane] = f2bf(g0 * ocmp[r] + g1 * oslc[r] + g2 * owin[r]); }
    }
}


constexpr float LOG2E = 1.4426950408889634f;
constexpr int AT_KC = 0, AT_VC = 16384, AT_KV = 32768  , AT_BTAB = 65536, AT_IMP = 69888, AT_SEL = 78336, AT_OUT = 78592  , AT_END = 78592 + 65536;
constexpr int BT_STRIDE = 132;
__device__ __forceinline__ int tile_off(int row, int chunk) { return row * 128 + ((chunk ^ (row & 7)) << 4); }
__device__ __forceinline__ bf16x8 mk_frag(unsigned a, unsigned b, unsigned c, unsigned d) { u32x4v v = {a, b, c, d}; return __builtin_bit_cast(bf16x8, v); }
struct LaneOffs { int koff[2]; int voff[4]; int soff; };
__device__ __forceinline__ LaneOffs lane_offs(int lane, int tid) {
    LaneOffs L; const int grp = lane >> 4, rowi = lane & 15, q4 = rowi >> 2, p = lane & 3;
#pragma unroll
    for (int ks = 0; ks < 2; ++ks) L.koff[ks] = tile_off(rowi, ks * 4 + grp);
#pragma unroll
    for (int dt = 0; dt < 4; ++dt) L.voff[dt] = tile_off(4 * grp + q4, 2 * dt + (p >> 1)) + 8 * (p & 1);
    L.soff = tile_off(tid >> 3, tid & 7); return L;
}
__device__ __forceinline__ bf16x8 vfrag_read(const LAS unsigned char* vt, int voff_dt, int row0) {
    const s16x4 a = __builtin_amdgcn_ds_read_tr16_b64_v4i16((LAS s16x4*)(vt + voff_dt + row0 * 128));
    const s16x4 b = __builtin_amdgcn_ds_read_tr16_b64_v4i16((LAS s16x4*)(vt + voff_dt + row0 * 128 + 2048));
    bf16x8 f = {a[0], a[1], a[2], a[3], b[0], b[1], b[2], b[3]}; return f;
}


struct AttnState {
    f32x4 o[4][2]; float m[2], l[2];
};

template <int BR>
__device__ __forceinline__ void attn_tile(const LAS unsigned char* kt_lds, const LAS unsigned char* vt_lds, const LAS float* btab_h, const bf16x8 (&qf)[2][2], const int (&tq)[2], const unsigned (&sel)[2],
                                          int j, bool near, AttnState& st, int lane, const LaneOffs& L, LAS unsigned char* F_lds_) {
    const int grp = lane >> 4, kbase = 64 * j;
#if defined(PROBE_STAMP) && PROBE_LEVEL >= 2
    STAMP_DECL; STAMP_START();
#define TSTAMP(k) STAMP(k)
#else
#define TSTAMP(k) do {} while (0)
#endif
    f32x4 sacc[4][2];
#pragma unroll
    for (int kt = 0; kt < 4; ++kt) { sacc[kt][0] = (f32x4){0.f, 0.f, 0.f, 0.f}; sacc[kt][1] = (f32x4){0.f, 0.f, 0.f, 0.f}; }
#pragma unroll
    for (int kt = 0; kt < 4; ++kt)
#pragma unroll
        for (int ks = 0; ks < 2; ++ks) { const bf16x8 kf = *(const LAS bf16x8*)(kt_lds + L.koff[ks] + kt * 2048);
            sacc[kt][0] = __builtin_amdgcn_mfma_f32_16x16x32_bf16(kf, qf[0][ks], sacc[kt][0], 0, 0, 0);
            sacc[kt][1] = __builtin_amdgcn_mfma_f32_16x16x32_bf16(kf, qf[1][ks], sacc[kt][1], 0, 0, 0); }
    __builtin_amdgcn_sched_barrier(0);
    TSTAMP(0);
    const float SC = 0.125f * LOG2E; const float bfar = btab_h[128];
    bf16x8 pf[2][2];
    const int cur_blk = tq[0] >> 6;
    const bool full = BR == 0 ? (j == cur_blk) : (j == cur_blk || j + 8 == cur_blk);
    const bool fast = !near && !full;
#pragma unroll
    for (int qt = 0; qt < 2; ++qt) {
        const int t = tq[qt]; const bool selq = BR == 0 ? ((sel[qt] >> j) & 1u) != 0u : true;
        float sv[4][4]; float tmax;
        if (fast) {
            float r0 = fmaxf(fmaxf(sacc[0][qt][0], sacc[0][qt][1]), fmaxf(sacc[0][qt][2], sacc[0][qt][3]));
#pragma unroll
            for (int kt = 1; kt < 4; ++kt) r0 = fmaxf(r0, fmaxf(fmaxf(sacc[kt][qt][0], sacc[kt][qt][1]), fmaxf(sacc[kt][qt][2], sacc[kt][qt][3])));
            tmax = selq ? r0 * SC + bfar : -1e30f;
        } else {
            tmax = -1e30f;
            int d0 = t - 4 * grp - kbase; asm volatile("" : "+v"(d0));
            if (near) {
#pragma unroll
                for (int kt = 0; kt < 4; ++kt)
#pragma unroll
                    for (int rg = 0; rg < 4; ++rg) { const int dist = d0 - (kt * 16 + rg); const int dd = dist < 0 ? 0 : (dist > 128 ? 128 : dist); sv[kt][rg] = btab_h[dd]; }
            } else {
#pragma unroll
                for (int kt = 0; kt < 4; ++kt)
#pragma unroll
                    for (int rg = 0; rg < 4; ++rg) sv[kt][rg] = bfar;
            }
#pragma unroll
            for (int kt = 0; kt < 4; ++kt)
#pragma unroll
                for (int rg = 0; rg < 4; ++rg) { const int c = kt * 16 + rg;
                    const bool valid = BR == 0 ? (selq && d0 >= c) : (d0 >= c && d0 < 512 + c);
                    const float sx = sacc[kt][qt][rg] * SC + sv[kt][rg]; const float s = valid ? sx : -1e30f; sv[kt][rg] = s; tmax = fmaxf(tmax, s); }
        }
        tmax = fmaxf(tmax, __shfl_xor(tmax, 16)); tmax = fmaxf(tmax, __shfl_xor(tmax, 32));
        const float mnew = fmaxf(st.m[qt], tmax); const float alpha = __builtin_amdgcn_exp2f(st.m[qt] - mnew); st.m[qt] = mnew;
        const float muse = mnew < -1e29f ? 0.f : mnew;
        float ev[4][4];
        if (fast) { const float c0 = selq ? bfar - muse : -1e30f;
#pragma unroll
            for (int kt = 0; kt < 4; ++kt)
#pragma unroll
                for (int rg = 0; rg < 4; ++rg) ev[kt][rg] = __builtin_amdgcn_exp2f(sacc[kt][qt][rg] * SC + c0);
        } else {
#pragma unroll
            for (int kt = 0; kt < 4; ++kt)
#pragma unroll
                for (int rg = 0; rg < 4; ++rg) ev[kt][rg] = __builtin_amdgcn_exp2f(sv[kt][rg] - muse);
        }
        float ls = 0.f; unsigned pk[4][2];
#pragma unroll
        for (int kt = 0; kt < 4; ++kt) { ls += (ev[kt][0] + ev[kt][1]) + (ev[kt][2] + ev[kt][3]);
            pk[kt][0] = pg8::cvt_pk_bf16(ev[kt][0], ev[kt][1]); pk[kt][1] = pg8::cvt_pk_bf16(ev[kt][2], ev[kt][3]); }
        st.l[qt] = st.l[qt] * alpha + ls;
        if (!__all(alpha == 1.0f)) {
#pragma unroll
            for (int dt = 0; dt < 4; ++dt) st.o[dt][qt] *= alpha; }
        pf[qt][0] = mk_frag(pk[0][0], pk[0][1], pk[1][0], pk[1][1]); pf[qt][1] = mk_frag(pk[2][0], pk[2][1], pk[3][0], pk[3][1]);
        __builtin_amdgcn_sched_barrier(0);
    }
    TSTAMP(1);
#pragma unroll
    for (int ks = 0; ks < 2; ++ks)
#pragma unroll
        for (int dt = 0; dt < 4; ++dt) { const bf16x8 vf = vfrag_read(vt_lds, L.voff[dt], 32 * ks);
            st.o[dt][0] = __builtin_amdgcn_mfma_f32_16x16x32_bf16(vf, pf[0][ks], st.o[dt][0], 0, 0, 0);
            st.o[dt][1] = __builtin_amdgcn_mfma_f32_16x16x32_bf16(vf, pf[1][ks], st.o[dt][1], 0, 0, 0); }
    TSTAMP(2);
#undef TSTAMP
}

template <int BR>
__device__ __forceinline__ void attn_branch(const Frame& F, const bf16_t* PROJ, int b, int g, int t0, unsigned tiles  , const LAS float* btab_h,
                                            const bf16x8 (&qf)[2][2], const int (&tq)[2], const unsigned (&sel)[2], const float (&gate)[2], const LaneOffs& L) {
    const int lane = F.lane, tid = F.tid;
    const int ck = (BR == 0 ? C_KS : C_KW) + g * 64, cv = (BR == 0 ? C_VS : C_VW) + g * 64;
    const int srow = tid >> 3, sch = tid & 7;
    LAS unsigned char* F_lds_ = F.lds; STAMP_DECL; STAMP_START();
    AttnState st;
#pragma unroll
    for (int dt = 0; dt < 4; ++dt) { st.o[dt][0] = (f32x4){0.f, 0.f, 0.f, 0.f}; st.o[dt][1] = (f32x4){0.f, 0.f, 0.f, 0.f}; }
    st.m[0] = st.m[1] = -1e30f; st.l[0] = st.l[1] = 0.f;
    unsigned rem = tiles; int cur = 0;
#ifdef PROBE_SHALLOW
    u32x4v rk0, rv0;
#else
    u32x4v rk0, rv0, rk1, rv1;
#endif
    const bf16_t* srcb = PROJ + (size_t)(b * S + srow) * NPAD + sch * 8;
#define AT_LOAD(RK, RV, jj) do { const bf16_t* rowp = srcb + (size_t)(64 * (jj)) * NPAD; RK = *(const u32x4v*)(rowp + ck); RV = *(const u32x4v*)(rowp + cv); } while (0)
#define AT_WRITE(RK, RV, bufi) do { *(LAS u32x4v*)(F.lds + AT_KV + (bufi) * 16384 + L.soff) = RK; *(LAS u32x4v*)(F.lds + AT_KV + (bufi) * 16384 + 8192 + L.soff) = RV; } while (0)
#define AT_COMPUTE(jj) do { STAMP_COUNT(4); const bool near = (t0 + 8 * F.wave) - (64 * (jj) + 63) < 128; \
        attn_tile<BR>(F.lds + AT_KV + cur * 16384, F.lds + AT_KV + cur * 16384 + 8192, btab_h, qf, tq, sel, (jj), near, st, lane, L, F.lds); } while (0)
#ifdef PROBE_SHALLOW
    { int j = __builtin_ctz(rem); rem &= rem - 1;
      AT_LOAD(rk0, rv0, j); AT_WRITE(rk0, rv0, 0);
      __syncthreads();
      for (;;) {
          int jn = j; const bool hn = rem != 0u; if (hn) { jn = __builtin_ctz(rem); rem &= rem - 1; }
          AT_LOAD(rk0, rv0, jn);
          AT_COMPUTE(j);
          AT_WRITE(rk0, rv0, cur ^ 1);
          __syncthreads(); cur ^= 1;
          if (!hn) break;
          j = jn; } }
#else
    int j = __builtin_ctz(rem); rem &= rem - 1;
    AT_LOAD(rk0, rv0, j); AT_WRITE(rk0, rv0, 0);
    int j1 = j; bool h1 = rem != 0u; if (h1) { j1 = __builtin_ctz(rem); rem &= rem - 1; }
    AT_LOAD(rk0, rv0, j1);
    __syncthreads();
    for (;;) {
        int j2 = j1; bool h2 = rem != 0u; if (h2) { j2 = __builtin_ctz(rem); rem &= rem - 1; }
        AT_LOAD(rk1, rv1, j2);
        AT_COMPUTE(j);
        AT_WRITE(rk0, rv0, cur ^ 1);
        __syncthreads(); cur ^= 1;
        if (!h1) break;
        int j3 = j2; bool h3 = rem != 0u; if (h3) { j3 = __builtin_ctz(rem); rem &= rem - 1; }
        AT_LOAD(rk0, rv0, j3);
        AT_COMPUTE(j1);
        AT_WRITE(rk1, rv1, cur ^ 1);
        __syncthreads(); cur ^= 1;
        if (!h2) break;
        j = j2; j1 = j3; h1 = h3;
    }
#endif
    STAMP(5 + BR);
#undef AT_LOAD
#undef AT_WRITE
#undef AT_COMPUTE
    int pob = AT_OUT + tid * 4; asm volatile("" : "+v"(pob));
    LAS float* po = (LAS float*)(F.lds + pob);
#pragma unroll
    for (int qt = 0; qt < 2; ++qt) { float l = st.l[qt]; l += __shfl_xor(l, 16); l += __shfl_xor(l, 32); const float sc = l > 0.f ? gate[qt] / l : 0.f;
#pragma unroll
        for (int dt = 0; dt < 4; ++dt)
#pragma unroll
            for (int e = 0; e < 4; ++e) po[((qt * 4 + dt) * 4 + e) * 512] += st.o[dt][qt][e] * sc; }
}

template <int MODE>
__device__ __forceinline__ void p4_attn_mfma_t(const Frame& F) {
    const bf16_t* PROJ = (const bf16_t*)(F.ws + WS_PROJ); const bf16_t* KC = (const bf16_t*)(F.ws + WS_KC); const bf16_t* VC = (const bf16_t*)(F.ws + WS_VC);
    bf16_t* OATT = (bf16_t*)(F.ws + (MODE == 0 ? WS_OATT : WS_H)); const float* rel = F.in[21];
    const int lane = F.lane, tid = F.tid, wave = F.wave, grp = lane >> 4, col = lane & 15, qi = col >> 2, r = col & 3;
    LAS float* btab = (LAS float*)(F.lds + AT_BTAB); LAS float* impq = (LAS float*)(F.lds + AT_IMP); LAS unsigned* selm = (LAS unsigned*)(F.lds + AT_SEL);
    const LaneOffs L = lane_offs(lane, tid);
    for (int i = tid; i < 8 * 129; i += NTHREADS) { const int hh = i / 129, dd = i % 129; btab[hh * BT_STRIDE + dd] = rel[rel_bucket(dd) * 8 + hh] * LOG2E; }
    __syncthreads();
    LAS unsigned char* F_lds_ = F.lds; STAMP_DECL;
#ifdef PROBE_STAMP
    if (tid < 16) ((volatile LAS unsigned*)(F.lds + LDS_MISC_OFF + 128))[tid] = 0u;
    __syncthreads();
#endif
    STAMP_START();
    for (int uu = blockIdx.x; uu < 1024; uu += F.G) {
        int sidx = uu;
        if (F.G == 256) { const int round = uu >> 8, k = uu & 255; sidx = (round == 0) ? k : (round == 1) ? 511 - k : (round == 2) ? 512 + k : 1023 - k; }
        const int qb = 31 - (sidx >> 5), bg = sidx & 31, b = bg >> 1, g = bg & 1, t0 = qb * 64, h = g * 4 + r;
        const LAS float* btab_h = btab + h * BT_STRIDE;
        int tq[2]; bf16x8 qf[2][2]; float gate[3][2];
#pragma unroll
        for (int qt = 0; qt < 2; ++qt) { tq[qt] = t0 + 8 * wave + 4 * qt + qi; const bf16_t* prow = PROJ + (size_t)(b * S + tq[qt]) * NPAD;
#pragma unroll
            for (int ks = 0; ks < 2; ++ks) qf[qt][ks] = *(const bf16x8*)(prow + C_Q + h * 64 + ks * 32 + 8 * grp);
#pragma unroll
            for (int jg = 0; jg < 3; ++jg) gate[jg][qt] = sigmoidf_(bf2f(prow[C_GT + h * 3 + jg])); }
#pragma unroll
        for (int i = 0; i < 2; ++i) { const int c2 = tid + 512 * i, row = c2 >> 3, ch = c2 & 7; const size_t src = ((size_t)(b * 2 + g) * 128 + row) * 64 + ch * 8;
            *(LAS u32x4v*)(F.lds + AT_KC + L.soff + 8192 * i) = *(const u32x4v*)(KC + src); *(LAS u32x4v*)(F.lds + AT_VC + L.soff + 8192 * i) = *(const u32x4v*)(VC + src); }
        __syncthreads();
#ifndef AT_SKIP_CMP
        {
            const int nvmax = t0 + 63 >= 31 ? ((t0 + 63 - 31) >> 4) + 1 : 0;
            const float SC = 0.125f * LOG2E; const int srcl = (lane + 48) & 63;
            int pob = AT_OUT + tid * 4; asm volatile("" : "+v"(pob));
            LAS float* po = (LAS float*)(F.lds + pob);
#pragma unroll
            for (int qt = 0; qt < 2; ++qt) {
                f32x4 sa[8];
#pragma unroll
                for (int kt = 0; kt < 8; ++kt) sa[kt] = (f32x4){0.f, 0.f, 0.f, 0.f};
#pragma unroll
                for (int kt = 0; kt < 8; ++kt) if (kt * 16 < nvmax) {
#pragma unroll
                    for (int ks = 0; ks < 2; ++ks) { const bf16x8 kf = *(const LAS bf16x8*)(F.lds + AT_KC + L.koff[ks] + kt * 2048);
                        sa[kt] = __builtin_amdgcn_mfma_f32_16x16x32_bf16(kf, qf[qt][ks], sa[kt], 0, 0, 0); } }
                __builtin_amdgcn_sched_barrier(0);
                int d0 = tq[qt] - 31 - 64 * grp; asm volatile("" : "+v"(d0));
                float mx = -1e30f;
#pragma unroll
                for (int kt = 0; kt < 8; ++kt)
#pragma unroll
                    for (int rg = 0; rg < 4; ++rg) { const int c = 256 * kt + 16 * rg; const int dist = d0 - c; const int dd = dist < 0 ? 0 : (dist > 128 ? 128 : dist);
                        const float sx = sa[kt][rg] * SC + btab_h[dd]; const float s = d0 >= c ? sx : -1e30f; sa[kt][rg] = s; mx = fmaxf(mx, s); }
                mx = fmaxf(mx, __shfl_xor(mx, 16)); mx = fmaxf(mx, __shfl_xor(mx, 32));
                float sum = 0.f;
#pragma unroll
                for (int kt = 0; kt < 8; ++kt)
#pragma unroll
                    for (int rg = 0; rg < 4; ++rg) { const int c = 256 * kt + 16 * rg; const float ex = __builtin_amdgcn_exp2f(sa[kt][rg] - mx); const float e = d0 >= c ? ex : 0.f; sa[kt][rg] = e; sum += e; }
                __builtin_amdgcn_sched_barrier(0);
                sum += __shfl_xor(sum, 16); sum += __shfl_xor(sum, 32);
                const float inv = sum > 0.f ? 1.0f / sum : 0.f;
                float prev3 = 0.f;
#pragma unroll
                for (int kt = 0; kt < 8; ++kt) { const float p3 = sa[kt][3] * inv; const float part = (sa[kt][0] * inv + sa[kt][1] * inv) + (sa[kt][2] * inv + p3);
                    const float xa = __shfl(p3, srcl), xb = __shfl(prev3, srcl); float tot = part + (grp >= 1 ? xa : xb);
                    tot += __shfl_xor(tot, 1); tot += __shfl_xor(tot, 2);
                    if (r == 0) impq[(8 * wave + 4 * qt + qi) * 33 + 4 * kt + grp] = tot;
                    prev3 = p3; }
                __builtin_amdgcn_sched_barrier(0);
                f32x4 oc[4];
#pragma unroll
                for (int dt = 0; dt < 4; ++dt) oc[dt] = (f32x4){0.f, 0.f, 0.f, 0.f};
#pragma unroll
                for (int ks = 0; ks < 4; ++ks) if (ks * 32 < nvmax) {
                    const bf16x8 pfr = mk_frag(pg8::cvt_pk_bf16(sa[2 * ks][0], sa[2 * ks][1]), pg8::cvt_pk_bf16(sa[2 * ks][2], sa[2 * ks][3]),
                                               pg8::cvt_pk_bf16(sa[2 * ks + 1][0], sa[2 * ks + 1][1]), pg8::cvt_pk_bf16(sa[2 * ks + 1][2], sa[2 * ks + 1][3]));
#pragma unroll
                    for (int dt = 0; dt < 4; ++dt) { const bf16x8 vf = vfrag_read(F.lds + AT_VC, L.voff[dt], 32 * ks); oc[dt] = __builtin_amdgcn_mfma_f32_16x16x32_bf16(vf, pfr, oc[dt], 0, 0, 0); } }
                const float scq = inv * gate[0][qt];
#pragma unroll
                for (int dt = 0; dt < 4; ++dt)
#pragma unroll
                    for (int e = 0; e < 4; ++e) po[((qt * 4 + dt) * 4 + e) * 512] = oc[dt][e] * scq;
                __builtin_amdgcn_sched_barrier(0);
            }
        }
#endif
        __syncthreads();
#ifndef AT_SKIP_SEL
        {
            const int q = tid >> 3, jj = tid & 7, cur = qb; unsigned bits = 0u;
            float vj[4];
#pragma unroll
            for (int e = 0; e < 4; ++e) { const int j = jj * 4 + e; const bool forced = (j == 0) || (j == cur) || (j == cur - 1); vj[e] = forced ? 1e4f : (j <= cur ? impq[q * 33 + j] : -INFINITY); }
            int rk[4] = {0, 0, 0, 0};
            for (int jp = 0; jp < 32; ++jp) { const bool forced = (jp == 0) || (jp == cur) || (jp == cur - 1); const float vp = forced ? 1e4f : (jp <= cur ? impq[q * 33 + jp] : -INFINITY);
#pragma unroll
                for (int e = 0; e < 4; ++e) rk[e] += ((vp > vj[e]) || (vp == vj[e] && jp < jj * 4 + e)) ? 1 : 0; }
#pragma unroll
            for (int e = 0; e < 4; ++e) bits |= (rk[e] < 8 ? 1u : 0u) << (jj * 4 + e);
            bits |= __shfl_xor(bits, 1); bits |= __shfl_xor(bits, 2); bits |= __shfl_xor(bits, 4);
            if (jj == 0) selm[q] = bits;
        }
#endif
        __syncthreads();
        unsigned sel[2] = {selm[8 * wave + qi], selm[8 * wave + 4 + qi]};
        unsigned un = selm[lane];
#pragma unroll
        for (int o = 32; o >= 1; o >>= 1) un |= __shfl_xor(un, o);
        un = __builtin_amdgcn_readfirstlane(un);
        const unsigned causal = qb == 31 ? 0xFFFFFFFFu : ((2u << qb) - 1u);
        if (MODE != 1 && MODE != 2) { const float gt1[2] = {gate[1][0], gate[1][1]}; attn_branch<0>(F, PROJ, b, g, t0, un & causal, btab_h, qf, tq, sel, gt1, L); }
        if (MODE != 2) { const int jlo = qb >= 8 ? qb - 8 : 0; const unsigned wmask = causal & ~((1u << jlo) - 1u); const float gt2[2] = {gate[2][0], gate[2][1]};
            attn_branch<1>(F, PROJ, b, g, t0, wmask, btab_h, qf, tq, sel, gt2, L); }
        int pob2 = AT_OUT + tid * 4; asm volatile("" : "+v"(pob2));
#pragma unroll
        for (int qt = 0; qt < 2; ++qt) { bf16_t* orow = OATT + (size_t)(b * S + tq[qt]) * 512 + h * 64 + 4 * grp;
#pragma unroll
            for (int dt = 0; dt < 4; ++dt) { const LAS float* po = (const LAS float*)(F.lds + pob2) + (qt * 4 + dt) * 4 * 512;
                *(uint2*)(orow + dt * 16) = make_uint2(pg8::cvt_pk_bf16(po[0], po[512]), pg8::cvt_pk_bf16(po[1024], po[1536])); } }
    }
    STAMP(7);
#ifdef PROBE_STAMP
    __syncthreads();
    if (PROBE_PHASE == 4 && MODE == 0 && blockIdx.x == PROBE_BLOCK && tid < 16) ((unsigned*)(F.ws + WS_CTL + 32768))[tid] = ((volatile LAS unsigned*)(F.lds + LDS_MISC_OFF + 128))[tid];
#endif
}

__device__ __forceinline__ void p5_mixed(const Frame& F) {
    const bf16_t* PROJ = (const bf16_t*)(F.ws + WS_PROJ); const bf16_t* OATT = (const bf16_t*)(F.ws + WS_OATT); bf16_t* MIX = (bf16_t*)(F.ws + WS_H);
    const float* cw = F.in[13]; const float* ga = F.in[14]; const float* gc = F.in[15];
    const int gw = blockIdx.x * NWAVES + F.wave, nw = F.G * NWAVES, lane = F.lane, c0 = lane * 8;
    float w0[8], w1[8], w2[8], gav[8], gcv[8];
#pragma unroll
    for (int e = 0; e < 8; ++e) { w0[e] = cw[c0 + e]; w1[e] = cw[512 + c0 + e]; w2[e] = cw[1024 + c0 + e]; gav[e] = ga[c0 + e]; gcv[e] = gc[c0 + e]; }
    for (int chunk = gw; chunk < T / 16; chunk += nw) {
        const int t0 = chunk * 16, s0 = t0 % S;
        float z1[8], z2[8];
#pragma unroll
        for (int e = 0; e < 8; ++e) { z1[e] = 0.f; z2[e] = 0.f; }
        if (s0 > 0) {
#pragma unroll
            for (int back = 1; back <= 2; ++back) { const bf16_t* row = PROJ + (size_t)(t0 - back) * NPAD;
                const u32x4v wc = *(const u32x4v*)(row + C_CC + c0), wh = *(const u32x4v*)(row + C_CH + c0);
#pragma unroll
                for (int e = 0; e < 4; ++e) { const float a = bflo(wc[e]) * bflo(wh[e]), bq = bfhi(wc[e]) * bfhi(wh[e]); if (back == 1) { z1[2 * e] = a; z1[2 * e + 1] = bq; } else { z2[2 * e] = a; z2[2 * e + 1] = bq; } } } }
        u32x4v na, nc, nh, nb;
        { const bf16_t* row = PROJ + (size_t)t0 * NPAD; na = *(const u32x4v*)(OATT + (size_t)t0 * 512 + c0); nc = *(const u32x4v*)(row + C_CC + c0); nh = *(const u32x4v*)(row + C_CH + c0); nb = *(const u32x4v*)(row + C_CB + c0); }
#pragma unroll 1
        for (int i = 0; i < 16; ++i) { const int tok = t0 + i;
            const u32x4v wa = na, wc = nc, wh = nh, wb = nb;
            { const int tn = i < 15 ? tok + 1 : tok; const bf16_t* row = PROJ + (size_t)tn * NPAD;
                na = *(const u32x4v*)(OATT + (size_t)tn * 512 + c0); nc = *(const u32x4v*)(row + C_CC + c0); nh = *(const u32x4v*)(row + C_CH + c0); nb = *(const u32x4v*)(row + C_CB + c0); }
            float a[8], y[8], z0[8];
#pragma unroll
            for (int e = 0; e < 4; ++e) { a[2 * e] = bflo(wa[e]); a[2 * e + 1] = bfhi(wa[e]); z0[2 * e] = bflo(wc[e]) * bflo(wh[e]); z0[2 * e + 1] = bfhi(wc[e]) * bfhi(wh[e]); }
#pragma unroll
            for (int e = 0; e < 8; ++e) y[e] = w0[e] * z2[e] + w1[e] * z1[e] + w2[e] * z0[e];
#pragma unroll
            for (int e = 0; e < 4; ++e) { y[2 * e] *= bflo(wb[e]); y[2 * e + 1] *= bfhi(wb[e]); }
            float sa = 0.f, sy = 0.f;
#pragma unroll
            for (int e = 0; e < 8; ++e) { sa += a[e] * a[e]; sy += y[e] * y[e]; }
            sa = wave_sum(sa); sy = wave_sum(sy);
            const float ra = rsqrtf(sa * (1.0f / 512) + EPS), ry = rsqrtf(sy * (1.0f / 512) + EPS);
            unsigned oa[4], oy[4];
#pragma unroll
            for (int e = 0; e < 4; ++e) { oa[e] = pack2(a[2 * e] * ra * gav[2 * e], a[2 * e + 1] * ra * gav[2 * e + 1]); oy[e] = pack2(y[2 * e] * ry * gcv[2 * e], y[2 * e + 1] * ry * gcv[2 * e + 1]); }
            *(uint4*)(MIX + (size_t)tok * D + c0) = make_uint4(oa[0], oa[1], oa[2], oa[3]);
            *(uint4*)(MIX + (size_t)tok * D + 512 + c0) = make_uint4(oy[0], oy[1], oy[2], oy[3]);
#pragma unroll
            for (int e = 0; e < 8; ++e) { z2[e] = z1[e]; z1[e] = z0[e]; }
        }
    }
}

struct EpiResGate {
    static constexpr bool PERM = false, AFTER_DRAIN = false;
    float* C; const float* X; const float* MOD; int gate_off;
    __device__ __forceinline__ void operator()(const pg8::f32x4 (&acc)[2][2][4][2], const pg8::Unit& u, int wr, int wc, int fr, int fq) const {
        using pg8::f32x4; using pg8::HALF; using pg8::BM;
        const int row0 = u.pm * BM + wr * 64 + fr, col0 = u.pn * BM + wc * 32 + 4 * fq;
        const int b = (u.pm * BM) / S;
        f32x4 gv[2][2];
#pragma unroll
        for (int bj = 0; bj < 2; ++bj)
#pragma unroll
            for (int n = 0; n < 2; ++n) gv[bj][n] = *(const f32x4*)(MOD + b * 6144 + gate_off + col0 + bj * HALF + n * 16);
#pragma unroll
        for (int ai = 0; ai < 2; ++ai)
#pragma unroll
            for (int m = 0; m < 4; ++m) { const size_t ro = (size_t)(row0 + ai * HALF + m * 16) * D + col0;
#pragma unroll
                for (int bj = 0; bj < 2; ++bj)
#pragma unroll
                    for (int n = 0; n < 2; ++n) { const f32x4 xv = *(const f32x4*)(X + ro + bj * HALF + n * 16); *(f32x4*)(C + ro + bj * HALF + n * 16) = xv + gv[bj][n] * acc[ai][bj][m][n]; } }
    }
};

__device__ __forceinline__ int ord_i(float f) { const int u = __float_as_int(f); return u >= 0 ? u : (u ^ 0x7FFFFFFF); }
__device__ __forceinline__ float unord_f(int i) { const int u = i >= 0 ? i : (i ^ 0x7FFFFFFF); return __int_as_float(u); }
#define INT_MIN_ (-2147483647 - 1)
struct CandTab { int a[50], b[50]; };
constexpr CandTab make_cand() { CandTab t{}; int n = 0; for (int a = 0; a < 16; ++a) for (int b = 0; b < 16; ++b) if ((a + 1) * (b + 1) <= 16) { t.a[n] = a; t.b[n] = b; ++n; } return t; }
constexpr CandTab CAND = make_cand();

template <int N, bool DESC> __device__ __forceinline__ void bitonic_sort_i(int (&v)[N]) {
#pragma unroll
    for (int k = 2; k <= N; k <<= 1)
#pragma unroll
        for (int j = k >> 1; j > 0; j >>= 1)
#pragma unroll
            for (int i = 0; i < N; ++i) { const int l = i ^ j; if (l > i) { const bool up = ((i & k) == 0) != DESC; const int lo = min(v[i], v[l]), hi = max(v[i], v[l]); v[i] = up ? lo : hi; v[l] = up ? hi : lo; } }
}
template <int N, bool DESC> __device__ __forceinline__ void bitonic_merge_i(int (&v)[N]) {
#pragma unroll
    for (int j = N >> 1; j > 0; j >>= 1)
#pragma unroll
        for (int i = 0; i < N; ++i) { const int l = i ^ j; if (l > i) { const int lo = min(v[i], v[l]), hi = max(v[i], v[l]); v[i] = DESC ? hi : lo; v[l] = DESC ? lo : hi; } }
}
__device__ __forceinline__ void merge_top16_across(int (&t)[16]) {
#pragma unroll
    for (int m = 16; m <= 32; m <<= 1) { int y[16];
#pragma unroll
        for (int i = 0; i < 16; ++i) y[i] = max(t[i], __shfl_xor(t[15 - i], m));
        bitonic_merge_i<16, true>(y);
#pragma unroll
        for (int i = 0; i < 16; ++i) t[i] = y[i]; }
}
constexpr int RT2_KEYS = 0  , RT2_ITAB = 65536  ;
__device__ __forceinline__ void p9_route_sort(const Frame& F) {
    const bf16_t* QP = (const bf16_t*)(F.ws + WS_QP); const bf16_t* KEYS = (const bf16_t*)(F.ws + WS_KEYS);
    unsigned short* E16 = (unsigned short*)(F.ws + WS_E16); float* EW = (float*)(F.ws + WS_EW);
    const int lane = F.lane, tid = F.tid, grp = lane >> 4, col = lane & 15;
    const LaneOffs L = lane_offs(lane, tid);
    LAS int* itab = (LAS int*)(F.lds + RT2_ITAB + F.wave * 2048) + col * 32;
    const bool g1 = grp == 1, g2 = grp == 2, g3 = grp == 3;
    for (int tile = blockIdx.x * NWAVES + F.wave; tile < T / 16; tile += F.G * NWAVES) {
        const int tok = tile * 16 + col;
        {
#pragma unroll
            for (int i = 0; i < 4; ++i) { const int q = tid + 512 * i; *(LAS u32x4v*)(F.lds + RT2_KEYS + tile_off(q >> 3, q & 7)) = *(const u32x4v*)(KEYS + (size_t)q * 8); } }
        bf16x8 qf[2][2];
#pragma unroll
        for (int p = 0; p < 2; ++p)
#pragma unroll
            for (int ks = 0; ks < 2; ++ks) qf[p][ks] = *(const bf16x8*)(QP + (size_t)tok * D + p * 64 + ks * 32 + 8 * grp);
        __syncthreads();
#pragma unroll 1
        for (int h = 0; h < 8; ++h) {
            const int kb = RT2_KEYS + (h & 1) * 32768;
            u32x4v stg[4]; bf16x8 qn[2][2];
            if (h < 7) {
#pragma unroll
                for (int i = 0; i < 4; ++i) { const int q = tid + 512 * i; stg[i] = *(const u32x4v*)(KEYS + (size_t)(h + 1) * 16384 + (size_t)q * 8); }
#pragma unroll
                for (int p = 0; p < 2; ++p)
#pragma unroll
                    for (int ks = 0; ks < 2; ++ks) qn[p][ks] = *(const bf16x8*)(QP + (size_t)tok * D + (h + 1) * 128 + p * 64 + ks * 32 + 8 * grp);
            }
            int lst[2][16];
#pragma unroll
            for (int p = 0; p < 2; ++p) {
                f32x4 sc[8];
#pragma unroll
                for (int kt = 0; kt < 8; ++kt) { sc[kt] = (f32x4){0.f, 0.f, 0.f, 0.f};
#pragma unroll
                    for (int ks = 0; ks < 2; ++ks) { const bf16x8 kf = *(const LAS bf16x8*)(F.lds + kb + p * 16384 + L.koff[ks] + kt * 2048);
                        sc[kt] = __builtin_amdgcn_mfma_f32_16x16x32_bf16(kf, qf[p][ks], sc[kt], 0, 0, 0); } }
                int ra[16], rb[16];
#pragma unroll
                for (int kt = 0; kt < 4; ++kt)
#pragma unroll
                    for (int rg = 0; rg < 4; ++rg) { ra[kt * 4 + rg] = (ord_i(sc[kt][rg]) & ~0x7F) | (127 - (kt * 16 + 4 * grp + rg)); rb[kt * 4 + rg] = (ord_i(sc[kt + 4][rg]) & ~0x7F) | (127 - ((kt + 4) * 16 + 4 * grp + rg)); }
                bitonic_sort_i<16, true>(ra); bitonic_sort_i<16, false>(rb);
#pragma unroll
                for (int i = 0; i < 16; ++i) ra[i] = max(ra[i], rb[i]);
                bitonic_merge_i<16, true>(ra);
                merge_top16_across(ra);
#pragma unroll
                for (int i = 0; i < 16; ++i) lst[p][i] = ra[i];
                if (grp == 0) {
#pragma unroll
                    for (int it = 0; it < 16; ++it) itab[p * 16 + it] = 127 - (ra[it] & 0x7F);
                }
            }
            float v0[16], v1[16];
#pragma unroll
            for (int i = 0; i < 16; ++i) { v0[i] = unord_f(lst[0][i] & ~0x7F); v1[i] = unord_f(lst[1][i] & ~0x7F); }
            int ck[16];
#pragma unroll
            for (int i = 0; i < 13; ++i) {
                constexpr int NC = 50;
                const int k0 = 4 * i, k1 = 4 * i + 1 < NC ? 4 * i + 1 : NC - 1, k2 = 4 * i + 2 < NC ? 4 * i + 2 : NC - 1, k3 = 4 * i + 3 < NC ? 4 * i + 3 : NC - 1;
                float va = v0[CAND.a[k0]], vb = v1[CAND.b[k0]]; int fl = 255 - (CAND.a[k0] * 16 + CAND.b[k0]);
                va = g1 ? v0[CAND.a[k1]] : va; vb = g1 ? v1[CAND.b[k1]] : vb; fl = g1 ? 255 - (CAND.a[k1] * 16 + CAND.b[k1]) : fl;
                va = g2 ? v0[CAND.a[k2]] : va; vb = g2 ? v1[CAND.b[k2]] : vb; fl = g2 ? 255 - (CAND.a[k2] * 16 + CAND.b[k2]) : fl;
                va = g3 ? v0[CAND.a[k3]] : va; vb = g3 ? v1[CAND.b[k3]] : vb; fl = g3 ? 255 - (CAND.a[k3] * 16 + CAND.b[k3]) : fl;
                int key = (ord_i(va + vb) & ~0xFF) | fl;
                if (4 * i + 1 >= NC) key = g1 ? INT_MIN_ : key;
                if (4 * i + 2 >= NC) key = g2 ? INT_MIN_ : key;
                if (4 * i + 3 >= NC) key = g3 ? INT_MIN_ : key;
                ck[i] = key; }
            ck[13] = INT_MIN_; ck[14] = INT_MIN_; ck[15] = INT_MIN_;
            bitonic_sort_i<16, true>(ck);
            merge_top16_across(ck);
            lds_wave_sync();
            const float smax = unord_f(ck[0] & ~0xFF);
            float ex[16], sum = 0.f;
#pragma unroll
            for (int it = 0; it < 16; ++it) { ex[it] = __expf(unord_f(ck[it] & ~0xFF) - smax); sum += ex[it]; }
            const float inv = 1.0f / sum;
            if (grp == 0) {
#pragma unroll
                for (int it = 0; it < 16; ++it) { const int flat = 255 - (ck[it] & 0xFF); const int i1 = itab[flat >> 4], i2 = itab[16 + (flat & 15)];
                    E16[(size_t)tok * 128 + h * 16 + it] = (unsigned short)(i1 * 128 + i2); EW[(size_t)tok * 128 + h * 16 + it] = ex[it] * inv; }
            }
            lds_wave_sync();
            if (h < 7) {
                const int kn = RT2_KEYS + ((h + 1) & 1) * 32768;
#pragma unroll
                for (int i = 0; i < 4; ++i) { const int q = tid + 512 * i; *(LAS u32x4v*)(F.lds + kn + tile_off(q >> 3, q & 7)) = stg[i]; }
#pragma unroll
                for (int p = 0; p < 2; ++p)
#pragma unroll
                    for (int ks = 0; ks < 2; ++ks) qf[p][ks] = qn[p][ks];
            }
            __syncthreads();
        }
    }
}

constexpr int N_PHASES = 14;
struct Args { const float* in[23]; float* out; unsigned char* ws; int ph_lo, ph_hi; };
__global__ void __launch_bounds__(NTHREADS, 2) fwd(Args args) {
    extern __shared__ __attribute__((aligned(16))) unsigned char lds_raw[];
    Frame F;
#pragma unroll
    for (int i = 0; i < 23; ++i) F.in[i] = args.in[i];
    F.out = args.out; F.ws = args.ws; F.lds = (LAS unsigned char*)lds_raw;
    F.tid = threadIdx.x; F.lane = F.tid & 63; F.wave = __builtin_amdgcn_readfirstlane(F.tid >> 6); F.G = gridDim.x;
    volatile LAS unsigned* misc = (volatile LAS unsigned*)(F.lds + LDS_MISC_OFF);
    if (F.tid < 64) misc[F.tid] = 0u;
    __syncthreads();
    XcdBarrier bar; bar.bar = (unsigned*)(F.ws + WS_CTL); bar.x = 0; bar.st = misc;
    const int lo = args.ph_lo, hi = args.ph_hi;
    if (hi - lo > 1) bar = xcd_barrier_post((unsigned*)(F.ws + WS_CTL), misc);
#ifndef PH_MASK
#define PH_MASK 0xFFFF
#endif
#define IN(k) (((PH_MASK >> (k)) & 1) && lo <= (k) && (k) < hi)
#define SEAM(k) do { if (IN(k) && IN((k) + 1)) xcd_barrier(bar); } while (0)
    const float* MOD = (const float*)(F.ws + WS_MOD);
    if (IN(0)) { p0_prologue(F, 0, 96); } SEAM(0);
    if (IN(1)) { p0_prologue(F, 96, 1 << 30); norm_mod_rows(F, F.in[0], F.in[2], 0, 1024, (bf16_t*)(F.ws + WS_H)); } SEAM(1);
    if (IN(2)) { pg8::Gemm g{(const pg8::bf16_t*)(F.ws + WS_H), (const pg8::bf16_t*)(F.ws + WS_WIN), T, NPAD, D}; pg8::StaticOrder So; So.init(T, NPAD, F.G, (int)blockIdx.x);
        pg8::EpiBf16<0> E{(pg8::bf16_t*)(F.ws + WS_PROJ), NPAD, nullptr, 0, 0};
        pg8::gemm_phase<pg8::EpiBf16<0>, pg8::StaticOrder>(F.lds, g, So, E, nullptr); } SEAM(2);
#ifdef COMPRESS_NAIVE
    if (IN(3)) { p3_compress_naive(F); } SEAM(3);
#else
    if (IN(3)) { p3_compress_mfma(F); } SEAM(3);
#endif
    #ifdef ATTN_NAIVE
    if (IN(4)) { p4_attn_naive(F); } SEAM(4);
#else
    if (IN(4)) { p4_attn_mfma_t<0>(F); } SEAM(4);
#ifdef PROBE_ATTN_MODE
    if (IN(14)) { p4_attn_mfma_t<PROBE_ATTN_MODE>(F); }
#endif
#ifdef PROBE_P0_LO
    if (IN(14)) { p0_prologue(F, PROBE_P0_LO, PROBE_P0_HI); }
#endif
#endif
    if (IN(5)) { p5_mixed(F); } SEAM(5);
    if (IN(6)) { pg8::Gemm g{(const pg8::bf16_t*)(F.ws + WS_H), (const pg8::bf16_t*)(F.ws + WS_WOUT), T, D, D}; pg8::StaticOrder So; So.init(T, D, F.G, (int)blockIdx.x);
        EpiResGate E{F.out, F.in[0], MOD, 2048};
        pg8::gemm_phase<EpiResGate, pg8::StaticOrder>(F.lds, g, So, E, nullptr); } SEAM(6);
    if (IN(7)) { norm_mod_rows_q(F, F.out, F.in[3], 3072, 4096, (bf16_t*)(F.ws + WS_H)); } SEAM(7);
    if (IN(8)) { pg8::Gemm g{(const pg8::bf16_t*)(F.ws + WS_H), (const pg8::bf16_t*)(F.ws + WS_WQ), T, D, D}; pg8::StaticOrder So; So.init(T, D, F.G, (int)blockIdx.x);
        pg8::EpiBf16<0> E{(pg8::bf16_t*)(F.ws + WS_QP), D, nullptr, 0, 0};
        pg8::gemm_phase<pg8::EpiBf16<0>, pg8::StaticOrder>(F.lds, g, So, E, nullptr); } SEAM(8);
        if (IN(9)) { p9_route_sort(F); } SEAM(9);
    if (IN(10)) { p10a_udots(F); } SEAM(10);
    if (IN(11)) { p10b_coef(F); } SEAM(11);
    if (IN(12)) { p10c_vsum(F); } SEAM(12);
    if (IN(13)) { p10d_final(F); }
#undef IN
#undef SEAM
}

extern "C" void kernel_launch(void* const* d_in, const int* in_sizes, int n_in, void* d_out, int out_size, void* d_ws, size_t ws_size, hipStream_t stream) {
    static int grid = 0;
    if (grid == 0) {
        if (n_in != 23 || out_size != T * D || ws_size < WS_END) { fprintf(stderr, "kernel_launch: unexpected shapes: n_in %d out %d ws %zu (need %zu)\n", n_in, out_size, ws_size, (size_t)WS_END); grid = -1; return; }
        int dev = 0, cus = 0, per_cu = 0;
        if (hipGetDevice(&dev) != hipSuccess || hipDeviceGetAttribute(&cus, hipDeviceAttributeMultiprocessorCount, dev) != hipSuccess) { grid = -1; return; }
        if (hipFuncSetAttribute((const void*)fwd, hipFuncAttributeMaxDynamicSharedMemorySize, LDS_BYTES) != hipSuccess) { fprintf(stderr, "kernel_launch: hipFuncSetAttribute failed\n"); grid = -1; return; }
        if (hipOccupancyMaxActiveBlocksPerMultiprocessor(&per_cu, (const void*)fwd, NTHREADS, LDS_BYTES) != hipSuccess || per_cu < 1) { fprintf(stderr, "kernel_launch: occupancy query says %d\n", per_cu); (void)hipGetLastError(); per_cu = 1; }
        grid = cus;
    }
    if (grid < 0) return;
    (void)hipMemsetAsync((char*)d_ws + WS_CTL, 0, CTL_BYTES, stream);
    Args a{};
    for (int i = 0; i < 23; ++i) a.in[i] = (const float*)d_in[i];
    a.out = (float*)d_out; a.ws = (unsigned char*)d_ws;
#if MK_N_LAUNCHES == 1
    a.ph_lo = 0; a.ph_hi = N_PHASES;
    hipLaunchKernelGGL(fwd, dim3(grid), dim3(NTHREADS), LDS_BYTES, stream, a);
#else
#ifdef PROBE_LIST
    { const int plist[] = PROBE_LIST; for (int p : plist) { if (p < 0) { (void)hipMemsetAsync((char*)d_ws + WS_CTL, 0, CTL_BYTES, stream); continue; } a.ph_lo = p; a.ph_hi = p + 1; hipLaunchKernelGGL(fwd, dim3(grid), dim3(NTHREADS), LDS_BYTES, stream, a); } }
#else
    for (int p = 0; p < N_PHASES; ++p) { a.ph_lo = p; a.ph_hi = p + 1; hipLaunchKernelGGL(fwd, dim3(grid), dim3(NTHREADS), LDS_BYTES, stream, a); }
#endif
#endif
}
```

```cpp
#include <hip/hip_runtime.h>
#include <cstdio>
#include <cstdint>
#include <cstdlib>

#ifndef MK_N_LAUNCHES
#define MK_N_LAUNCHES 1
#endif
#define XB_TMO      128
#define XB_XCNT(j)  (256  + 64 * (j))
#define XB_XSUB(j)  (1280 + 64 * (j))
#define XB_XGEN(j)  (2304 + 64 * (j))
#define XB_TOP      3328
#define XB_TOPGEN   3392
#define XCD_BAR_WORDS 3456
#define XB_SPIN_CAP (1u << 18)
#define LAS __attribute__((address_space(3)))

__device__ __forceinline__ unsigned xb_ld(unsigned* p)              { return __hip_atomic_load(p, __ATOMIC_RELAXED, __HIP_MEMORY_SCOPE_AGENT); }
__device__ __forceinline__ unsigned xb_add(unsigned* p, unsigned v) { return __hip_atomic_fetch_add(p, v, __ATOMIC_RELAXED, __HIP_MEMORY_SCOPE_AGENT); }
__device__ __forceinline__ unsigned xb_xcc_id() { return (unsigned)__builtin_amdgcn_s_getreg((3 << 11) | 20) & 0xFu; }
#define XB_SPIN(cond, bar) do { unsigned _sp = 0; while (cond) { __builtin_amdgcn_s_sleep(1); \
    if ((++_sp & 255u) == 0u) { if (xb_ld(&(bar)[XB_TMO])) break; if (_sp > XB_SPIN_CAP) { atomicAdd(&(bar)[XB_TMO], 1u); break; } } } } while (0)

struct XcdBarrier {
    unsigned* bar; unsigned x;
    volatile LAS unsigned* st;
};

__device__ __forceinline__ XcdBarrier xcd_barrier_post(unsigned* bar, volatile LAS unsigned* st) {
    XcdBarrier b; b.bar = bar; b.x = xb_xcc_id(); b.st = st;
    if (threadIdx.x == 0) (void)xb_add(&bar[XB_XCNT(b.x)], 1u);
    return b;
}
__device__ __forceinline__ void xcd_barrier_complete(unsigned* bar, unsigned x, unsigned& nloc, unsigned& nx) {
    const unsigned G = gridDim.x * gridDim.y * gridDim.z;
    unsigned sum, cnt, mine, sp = 0u;
    for (;;) {
        sum = 0u; cnt = 0u; mine = 0u;
#pragma unroll
        for (unsigned j = 0; j < 16; ++j) { const unsigned c = xb_ld(&bar[XB_XCNT(j)]); sum += c; cnt += (c > 0u) ? 1u : 0u; mine = (j == x) ? c : mine; }
        if (sum == G) break;
        __builtin_amdgcn_s_sleep(1);
        if ((++sp & 255u) == 0u) { if (xb_ld(&bar[XB_TMO])) break; if (sp > XB_SPIN_CAP) { atomicAdd(&bar[XB_TMO], 1u); break; } }
    }
    nloc = mine > 0u ? mine : 1u; nx = cnt > 0u ? cnt : 1u;
}

__device__ __forceinline__ void xcd_barrier(const XcdBarrier& b) {
    asm volatile("s_waitcnt vmcnt(0)" ::: "memory");
    __syncthreads();
    if (threadIdx.x == 0) {
        unsigned* bar = b.bar;
        __builtin_amdgcn_s_waitcnt(0);
        unsigned nloc = b.st[0], nx = b.st[1];
        if (nloc == 0u) { xcd_barrier_complete(bar, b.x, nloc, nx); b.st[0] = nloc; b.st[1] = nx; }
        const unsigned old = xb_add(&bar[XB_XSUB(b.x)], 1u);
        const unsigned gen = old / nloc;
        if (old + 1u == (gen + 1u) * nloc) {
            __builtin_amdgcn_fence(__ATOMIC_RELEASE, "agent");
            asm volatile("s_waitcnt vmcnt(0)" ::: "memory");
            const unsigned og = xb_add(&bar[XB_TOP], 1u);
            const unsigned tg = og / nx;
            if (og + 1u == (tg + 1u) * nx) xb_add(&bar[XB_TOPGEN], 1u);
            else XB_SPIN(xb_ld(&bar[XB_TOPGEN]) == tg, bar);
            __builtin_amdgcn_fence(__ATOMIC_ACQUIRE, "agent");
            xb_add(&bar[XB_XGEN(b.x)], 1u);
            asm volatile("s_waitcnt vmcnt(0)" ::: "memory");
        } else {
            XB_SPIN(xb_ld(&bar[XB_XGEN(b.x)]) == gen, bar);
            __builtin_amdgcn_fence(__ATOMIC_ACQUIRE, "agent");
            asm volatile("s_waitcnt vmcnt(0)" ::: "memory");
        }
    }
    __syncthreads();
}

namespace pg8 {
#define PG8_LAS __attribute__((address_space(3)))
typedef unsigned short bf16_t;
typedef short bf16x8 __attribute__((ext_vector_type(8)));
typedef float f32x4 __attribute__((ext_vector_type(4)));
typedef unsigned u32x4 __attribute__((ext_vector_type(4)));
constexpr int BM = 256, BK = 64, HALF = 128, HTB = HALF * BK * 2  , STAGE_BYTES = 8 * HTB, NXCD = 8, WGM = 8;

__host__ __device__ __forceinline__ int lds_byte(int r, int c) { const int st = (r >> 4) * 2 + (c >> 5), rr = r & 15, cc = c & 31, ob = rr * 64 + cc * 2; return st * 1024 + (ob ^ (((ob >> 9) & 1) << 5)); }
__host__ __device__ __forceinline__ void stage_rc(int b, int& R, int& C) { const int st = b / 1024, sb = b % 1024, swz = sb ^ (((sb >> 9) & 1) << 5); R = (st >> 1) * 16 + swz / 64; C = (st & 1) * 32 + (swz % 64) / 2; }
__host__ __device__ __forceinline__ int perm32(int rho) { const int n = rho >> 4, i = rho & 15; return 8 * (i >> 2) + 4 * n + (i & 3); }

struct Unit { int pm, pn; };
struct Gemm { const bf16_t* A; const bf16_t* Bt; int M, N, K; };

struct StaticOrder {
    int nM, nN, nwg, G, c;
    __host__ __device__ void init(int M, int N, int G_, int c_) { nM = M / BM; nN = N / BM; nwg = nM * nN; G = G_; c = c_; }
    __host__ __device__ bool next(int i, Unit& u) const {
        const long L = (long)i * G + c; if (L >= nwg) return false;
        int wgid = (int)L; { const int q = nwg / NXCD, r = nwg % NXCD, xcd = wgid % NXCD, off = wgid / NXCD; wgid = (xcd < r ? xcd * (q + 1) : r * (q + 1) + (xcd - r) * q) + off; }
        const int nig = WGM * nN, gid = wgid / nig, fm = gid * WGM, gsz = (nM - fm) < WGM ? (nM - fm) : WGM;
        u.pm = fm + ((wgid % nig) % gsz); u.pn = (wgid % nig) / gsz; return true;
    }
    __device__ __forceinline__ void a_ready(const Unit&) const {}
    __device__ __forceinline__ void done(const Unit&) const {}
};
struct CountedOrder : StaticOrder {
    const unsigned* ready; unsigned need; unsigned* tmo;
    __device__ __forceinline__ void a_ready(const Unit& u) const {
        if (threadIdx.x < 64) {
            const unsigned long long t0 = __builtin_amdgcn_s_memrealtime(); unsigned polls = 0;
            while ((unsigned)__builtin_amdgcn_readfirstlane(__hip_atomic_load(ready + 64 * u.pm, __ATOMIC_RELAXED, __HIP_MEMORY_SCOPE_AGENT)) < need) {
                if ((++polls & 255u) == 0u && __builtin_amdgcn_readfirstlane(__hip_atomic_load(tmo, __ATOMIC_RELAXED, __HIP_MEMORY_SCOPE_AGENT)) != 0u) break;
                if (__builtin_amdgcn_s_memrealtime() - t0 > 2000000ull) {
                    if (threadIdx.x == 0) { unsigned expect = 0u; __hip_atomic_compare_exchange_strong(tmo + 1, &expect, 0x600u | (unsigned)(u.pm & 0xff), __ATOMIC_RELAXED, __ATOMIC_RELAXED, __HIP_MEMORY_SCOPE_AGENT); __hip_atomic_store(tmo, 1u, __ATOMIC_RELAXED, __HIP_MEMORY_SCOPE_AGENT); }
                    break; }
                __builtin_amdgcn_s_sleep(2); }
            __builtin_amdgcn_fence(__ATOMIC_ACQUIRE, "agent");
            asm volatile("s_waitcnt vmcnt(0)" ::: "memory");
        }
#if !defined(BROKEN_HOOK_NO_BARRIER)
        asm volatile("" ::: "memory"); __builtin_amdgcn_s_barrier(); asm volatile("" ::: "memory");
#endif
    }
};

__device__ __forceinline__ unsigned cvt_pk_bf16(float lo, float hi) { unsigned r; asm volatile("v_cvt_pk_bf16_f32 %0, %1, %2" : "=v"(r) : "v"(lo), "v"(hi)); return r; }
typedef float f32x2 __attribute__((ext_vector_type(2)));
__device__ __forceinline__ f32x2 gelu_pk(f32x2 v) {
    const f32x2 av = __builtin_elementwise_abs(v), d = av * 0.2316418882f + 1.0f;
    f32x2 t; t.x = __builtin_amdgcn_rcpf(d.x); t.y = __builtin_amdgcn_rcpf(d.y);
    f32x2 q = t * 0.5307027145f + (-0.7265760135f); q = q * t + 0.7107068705f; q = q * t + (-0.142248368f); q = q * t + 0.127414796f; q = q * t;
    const f32x2 s = (v * v) * (-0.72134752044f);
    f32x2 e; e.x = __builtin_amdgcn_exp2f(s.x); e.y = __builtin_amdgcn_exp2f(s.y);
    const f32x2 m = v * (q * e), r = v - m;
    f32x2 o; o.x = v.x < 0.f ? m.x : r.x; o.y = v.y < 0.f ? m.y : r.y; return o;
}

struct EpiF32 {
    static constexpr bool PERM = false, AFTER_DRAIN = false;
    float* C; int ldc; const float* bias;
    __device__ __forceinline__ void operator()(const f32x4 (&acc)[2][2][4][2], const Unit& u, int wr, int wc, int fr, int fq) const {
        const int row0 = u.pm * BM + wr * 64 + fr, col0 = u.pn * BM + wc * 32 + 4 * fq;
        f32x4 bv[2][2];
#pragma unroll
        for (int bj = 0; bj < 2; ++bj)
#pragma unroll
            for (int n = 0; n < 2; ++n) bv[bj][n] = bias ? *(const f32x4*)(bias + col0 + bj * HALF + n * 16) : (f32x4){0.f, 0.f, 0.f, 0.f};
#pragma unroll
        for (int ai = 0; ai < 2; ++ai)
#pragma unroll
            for (int m = 0; m < 4; ++m) { float* rowp = C + (size_t)(row0 + ai * HALF + m * 16) * ldc + col0;
#pragma unroll
                for (int bj = 0; bj < 2; ++bj)
#pragma unroll
                    for (int n = 0; n < 2; ++n) *(f32x4*)(rowp + bj * HALF + n * 16) = acc[ai][bj][m][n] + bv[bj][n]; }
    }
};
template <int ACT  > struct EpiBf16 {
    static constexpr bool PERM = true, AFTER_DRAIN = false;
    bf16_t* O; int ldc; const float* bias; int split_cols; size_t split_stride;
    __device__ __forceinline__ void operator()(const f32x4 (&acc)[2][2][4][2], const Unit& u, int wr, int wc, int fr, int fq) const {
        const int row0 = u.pm * BM + wr * 64 + fr; int colt = u.pn * BM; bf16_t* base = O;
        if (split_cols) { const int t = colt / split_cols; base += (size_t)t * split_stride; colt -= t * split_cols; }
        const int col0 = colt + wc * 32 + 8 * fq, bcol0 = u.pn * BM + wc * 32 + 8 * fq;
        f32x4 bv[2][2];
#pragma unroll
        for (int bj = 0; bj < 2; ++bj)
#pragma unroll
            for (int n = 0; n < 2; ++n) bv[bj][n] = bias ? *(const f32x4*)(bias + bcol0 + bj * HALF + 4 * n) : (f32x4){0.f, 0.f, 0.f, 0.f};
#pragma unroll
        for (int ai = 0; ai < 2; ++ai)
#pragma unroll
            for (int m = 0; m < 4; ++m) { bf16_t* rowp = base + (size_t)(row0 + ai * HALF + m * 16) * ldc + col0;
#pragma unroll
                for (int bj = 0; bj < 2; ++bj) { f32x4 v0 = acc[ai][bj][m][0] + bv[bj][0], v1 = acc[ai][bj][m][1] + bv[bj][1];
                    if (ACT == 1) { f32x2 a = gelu_pk((f32x2){v0[0], v0[1]}), b = gelu_pk((f32x2){v0[2], v0[3]}), c = gelu_pk((f32x2){v1[0], v1[1]}), d = gelu_pk((f32x2){v1[2], v1[3]});
                        v0 = (f32x4){a.x, a.y, b.x, b.y}; v1 = (f32x4){c.x, c.y, d.x, d.y}; }
                    if (ACT == 2) {
#pragma unroll
                        for (int j = 0; j < 4; ++j) { v0[j] = 0.5f * v0[j] * (1.0f + erff(v0[j] * 0.70710678f)); v1[j] = 0.5f * v1[j] * (1.0f + erff(v1[j] * 0.70710678f)); } }
                    u32x4 w; w.x = cvt_pk_bf16(v0[0], v0[1]); w.y = cvt_pk_bf16(v0[2], v0[3]); w.z = cvt_pk_bf16(v1[0], v1[1]); w.w = cvt_pk_bf16(v1[2], v1[3]);
                    *(u32x4*)(rowp + bj * HALF) = w; } }
    }
};

struct PanelStats {
    unsigned* xbuf;
    unsigned* cnt;
    unsigned* tmo;
    int ntn; float eps;
    unsigned code;
    __device__ __forceinline__ bool run(const f32x4 (&v)[2][2][4][2], const Unit& u, int wr, int wc, int fr, int fq, PG8_LAS unsigned char* lds, int wid, int lane) const {
        typedef float f32x2v __attribute__((ext_vector_type(2)));
        PG8_LAS f32x2v* P = (PG8_LAS f32x2v*)lds;
        PG8_LAS f32x2v* S = (PG8_LAS f32x2v*)(lds + 8192);
        PG8_LAS unsigned* flag = (PG8_LAS unsigned*)(lds + 8192 + 2048);
#pragma unroll
        for (int ai = 0; ai < 2; ++ai)
#pragma unroll
            for (int m = 0; m < 4; ++m) {
                float s = 0.f;
#pragma unroll
                for (int bj = 0; bj < 2; ++bj)
#pragma unroll
                    for (int n = 0; n < 2; ++n) { const f32x4 x = v[ai][bj][m][n]; s += (x[0] + x[1]) + (x[2] + x[3]); }
                s += __shfl_xor(s, 16); s += __shfl_xor(s, 32);
                const float mw = s * (1.0f / 64.0f); float q = 0.f;
#pragma unroll
                for (int bj = 0; bj < 2; ++bj)
#pragma unroll
                    for (int n = 0; n < 2; ++n) { const f32x4 d = v[ai][bj][m][n] - mw; q += (d[0] * d[0] + d[1] * d[1]) + (d[2] * d[2] + d[3] * d[3]); }
                q += __shfl_xor(q, 16); q += __shfl_xor(q, 32);
                if (fq == 0) P[(ai * HALF + wr * 64 + m * 16 + fr) * 4 + wc] = (f32x2v){mw, q};
            }
        asm volatile("s_waitcnt lgkmcnt(0)" ::: "memory"); __builtin_amdgcn_s_barrier(); asm volatile("" ::: "memory");
#if defined(BROKEN_NO_WAIT)
        if (blockIdx.x >= 64) { const long long t0 = clock64(); while (clock64() - t0 < 60000) __builtin_amdgcn_s_sleep(8); }
#endif
        const int row = wid * 32 + (lane & 31);
        if (lane < 32) {
            const f32x2v a = P[row * 4 + 0], b = P[row * 4 + 1], c = P[row * 4 + 2], d = P[row * 4 + 3];
            const float mt = (a.x + b.x + c.x + d.x) * 0.25f;
            const float da = a.x - mt, db = b.x - mt, dc = c.x - mt, dd = d.x - mt;
            const float m2 = (a.y + b.y) + (c.y + d.y) + 64.0f * ((da * da + db * db) + (dc * dc + dd * dd));
            unsigned long long* slot = (unsigned long long*)xbuf + ((size_t)(u.pm * BM + row) * 4 + u.pn);
            __hip_atomic_store(slot, ((unsigned long long)__float_as_uint(m2) << 32) | __float_as_uint(mt), __ATOMIC_RELAXED, __HIP_MEMORY_SCOPE_AGENT);
        }
        asm volatile("s_waitcnt vmcnt(0)" ::: "memory");
        if (lane == 0) __hip_atomic_fetch_add(cnt + 64 * u.pm, 1u, __ATOMIC_RELAXED, __HIP_MEMORY_SCOPE_AGENT);
        if (wid == 0) {
            bool dead = false; const unsigned long long t0 = __builtin_amdgcn_s_memrealtime(); const unsigned want = 8u * (unsigned)ntn;
            for (;;) {
#if defined(BROKEN_NO_WAIT)
                break;
#endif
                if ((unsigned)__builtin_amdgcn_readfirstlane(__hip_atomic_load(cnt + 64 * u.pm, __ATOMIC_RELAXED, __HIP_MEMORY_SCOPE_AGENT)) >= want) break;
                if (__builtin_amdgcn_s_memrealtime() - t0 > 2000000ull) {
                    if (lane == 0) { unsigned expect = 0u; __hip_atomic_compare_exchange_strong(tmo + 1, &expect, code | (unsigned)(u.pm & 0xff), __ATOMIC_RELAXED, __ATOMIC_RELAXED, __HIP_MEMORY_SCOPE_AGENT);
                                     __hip_atomic_store(tmo, 1u, __ATOMIC_RELAXED, __HIP_MEMORY_SCOPE_AGENT); }
                    dead = true; break; }
                __builtin_amdgcn_s_sleep(2);
            }
            __builtin_amdgcn_fence(__ATOMIC_ACQUIRE, "agent");
            if (lane == 0) flag[0] = dead ? 1u : 0u;
        }
        asm volatile("s_waitcnt vmcnt(0) lgkmcnt(0)" ::: "memory"); __builtin_amdgcn_s_barrier(); asm volatile("" ::: "memory");
        const bool bad = flag[0] != 0u;
        if (lane < 32) {
            const unsigned long long* slot = (const unsigned long long*)xbuf + (size_t)(u.pm * BM + row) * 4; float mt[4], m2[4]; float ms = 0.f;
#pragma unroll
            for (int t = 0; t < 4; ++t) { if (t < ntn) { const unsigned long long w = __hip_atomic_load(slot + t, __ATOMIC_RELAXED, __HIP_MEMORY_SCOPE_AGENT); mt[t] = __uint_as_float((unsigned)w); m2[t] = __uint_as_float((unsigned)(w >> 32)); } else { mt[t] = 0.f; m2[t] = 0.f; } ms += mt[t]; }
            const float mean = ms / (float)ntn; float q = 0.f;
#pragma unroll
            for (int t = 0; t < 4; ++t) if (t < ntn) { const float dm = mt[t] - mean; q += m2[t] + 256.0f * dm * dm; }
            S[row] = (f32x2v){mean, 1.0f / sqrtf(q / (256.0f * (float)ntn) + eps)};
        }
        asm volatile("s_waitcnt lgkmcnt(0)" ::: "memory"); __builtin_amdgcn_s_barrier(); asm volatile("" ::: "memory");
        return bad;
    }
};
struct EpiLnRes {
    static constexpr bool PERM = false, AFTER_DRAIN = true;
    const float* base; float* out; int ldc; const float* bias; PanelStats st; unsigned poison;
    __device__ __forceinline__ void refuse(size_t i0, size_t stride, int M, int N) const { const float q = __builtin_nanf(""); for (size_t i = i0; i < (size_t)M * N; i += stride) out[(i / N) * ldc + i % N] = q;
        if (i0 == 0) { unsigned expect = 0u; __hip_atomic_compare_exchange_strong(st.tmo + 1, &expect, 0x7f0u, __ATOMIC_RELAXED, __ATOMIC_RELAXED, __HIP_MEMORY_SCOPE_AGENT); __hip_atomic_store(st.tmo, 1u, __ATOMIC_RELAXED, __HIP_MEMORY_SCOPE_AGENT); } }
    __device__ __forceinline__ void fused(f32x4 (&acc)[2][2][4][2], const Unit& u, int wr, int wc, int fr, int fq, PG8_LAS unsigned char* lds, int wid, int lane) const {
        typedef float f32x2v __attribute__((ext_vector_type(2)));
        const PG8_LAS f32x2v* S = (const PG8_LAS f32x2v*)(lds + 8192);
        const int col0 = u.pn * BM + wc * 32 + 4 * fq;
#pragma unroll
        for (int bj = 0; bj < 2; ++bj)
#pragma unroll
            for (int n = 0; n < 2; ++n) { const f32x4 bv = bias ? *(const f32x4*)(bias + col0 + bj * HALF + n * 16) : (f32x4){0.f, 0.f, 0.f, 0.f};
#pragma unroll
                for (int ai = 0; ai < 2; ++ai)
#pragma unroll
                    for (int m = 0; m < 4; ++m) acc[ai][bj][m][n] += bv; }
        const bool bad = st.run(acc, u, wr, wc, fr, fq, lds, wid, lane) || poison != 0u;
        const float qnan = __builtin_nanf("");
#pragma unroll
        for (int ai = 0; ai < 2; ++ai)
#pragma unroll
            for (int m = 0; m < 4; ++m) { const int r = ai * HALF + wr * 64 + m * 16 + fr; const f32x2v sr = S[r]; const size_t off = (size_t)(u.pm * BM + r) * ldc + col0;
#pragma unroll
                for (int bj = 0; bj < 2; ++bj)
#pragma unroll
                    for (int n = 0; n < 2; ++n) { const f32x4 bs = *(const f32x4*)(base + off + bj * HALF + n * 16); f32x4 o = bs + (acc[ai][bj][m][n] - sr.x) * sr.y;
                        if (bad) o = (f32x4){qnan, qnan, qnan, qnan}; *(f32x4*)(out + off + bj * HALF + n * 16) = o; }
                asm volatile("" ::: "memory"); }
    }
};
struct EpiLnResLn {
    static constexpr bool PERM = false, AFTER_DRAIN = true;
    const float* base; float* out; bf16_t* xn; int ldc; const float* bias; PanelStats st1, st2; unsigned poison;
    __device__ __forceinline__ void refuse(size_t i0, size_t stride, int M, int N) const { const float q = __builtin_nanf(""); for (size_t i = i0; i < (size_t)M * N; i += stride) { const size_t o = (i / N) * ldc + i % N; out[o] = q; xn[o] = (bf16_t)0x7fc0u; }
        if (i0 == 0) { unsigned expect = 0u; __hip_atomic_compare_exchange_strong(st1.tmo + 1, &expect, 0x7f0u, __ATOMIC_RELAXED, __ATOMIC_RELAXED, __HIP_MEMORY_SCOPE_AGENT); __hip_atomic_store(st1.tmo, 1u, __ATOMIC_RELAXED, __HIP_MEMORY_SCOPE_AGENT); } }
    __device__ __forceinline__ void fused(f32x4 (&acc)[2][2][4][2], const Unit& u, int wr, int wc, int fr, int fq, PG8_LAS unsigned char* lds, int wid, int lane) const {
        typedef float f32x2v __attribute__((ext_vector_type(2))); typedef unsigned u32x2v __attribute__((ext_vector_type(2)));
        const PG8_LAS f32x2v* S = (const PG8_LAS f32x2v*)(lds + 8192);
        const int col0 = u.pn * BM + wc * 32 + 4 * fq;
#pragma unroll
        for (int bj = 0; bj < 2; ++bj)
#pragma unroll
            for (int n = 0; n < 2; ++n) { const f32x4 bv = bias ? *(const f32x4*)(bias + col0 + bj * HALF + n * 16) : (f32x4){0.f, 0.f, 0.f, 0.f};
#pragma unroll
                for (int ai = 0; ai < 2; ++ai)
#pragma unroll
                    for (int m = 0; m < 4; ++m) acc[ai][bj][m][n] += bv; }
        bool bad = st1.run(acc, u, wr, wc, fr, fq, lds, wid, lane) || poison != 0u;
        const float qnan = __builtin_nanf("");
#pragma unroll
        for (int ai = 0; ai < 2; ++ai)
#pragma unroll
            for (int m = 0; m < 4; ++m) { const int r = ai * HALF + wr * 64 + m * 16 + fr; const f32x2v sr = S[r]; const size_t off = (size_t)(u.pm * BM + r) * ldc + col0;
#pragma unroll
                for (int bj = 0; bj < 2; ++bj)
#pragma unroll
                    for (int n = 0; n < 2; ++n) { const f32x4 bs = *(const f32x4*)(base + off + bj * HALF + n * 16); acc[ai][bj][m][n] = bs + (acc[ai][bj][m][n] - sr.x) * sr.y; }
                asm volatile("" : "+v"(acc[ai][0][m][0]), "+v"(acc[ai][0][m][1]), "+v"(acc[ai][1][m][0]), "+v"(acc[ai][1][m][1]));
                if (m & 1) asm volatile("" ::: "memory"); }
        const bool bad1 = bad;
        bad = st2.run(acc, u, wr, wc, fr, fq, lds, wid, lane) || bad;
#pragma unroll
        for (int ai = 0; ai < 2; ++ai)
#pragma unroll
            for (int m = 0; m < 4; ++m) { const int r = ai * HALF + wr * 64 + m * 16 + fr; const f32x2v sr = S[r]; const size_t off = (size_t)(u.pm * BM + r) * ldc + col0;
#pragma unroll
                for (int bj = 0; bj < 2; ++bj)
#pragma unroll
                    for (int n = 0; n < 2; ++n) { const f32x4 x1 = acc[ai][bj][m][n]; *(f32x4*)(out + off + bj * HALF + n * 16) = bad1 ? (f32x4){qnan, qnan, qnan, qnan} : x1;
                        const f32x4 o = (x1 - sr.x) * sr.y; u32x2v w; w.x = cvt_pk_bf16(o[0], o[1]); w.y = cvt_pk_bf16(o[2], o[3]);
                        if (bad) { w.x = 0x7fc07fc0u; w.y = 0x7fc07fc0u; } *(u32x2v*)(xn + off + bj * HALF + n * 16) = w; }
                asm volatile("" ::: "memory"); }
    }
};

template <class Epi, class Sched, bool STAMP = false>
__device__ __forceinline__ void gemm_phase(PG8_LAS unsigned char* lds, const Gemm g, const Sched& S, const Epi& E, unsigned long long* stamps) {
    const int tid = threadIdx.x, wid = __builtin_amdgcn_readfirstlane(tid >> 6), lane = tid & 63, wr = wid >> 2, wc = wid & 3, fr = lane & 15, fq = lane >> 4;
    const int K = g.K, nt = K / BK;
    int ts_lo = 0, ts_hi = 0, nts = 0; const unsigned long long rt_entry = STAMP ? (unsigned long long)wall_clock64() : 0ull;
#define PG8_STAMP() do { if (STAMP && wid == 0 && nts < 64) { const unsigned long long _c = (unsigned long long)clock64(); \
        ts_lo = (lane == nts) ? (int)(unsigned)_c : ts_lo; ts_hi = (lane == nts) ? (int)(unsigned)(_c >> 32) : ts_hi; ++nts; } } while (0)
    PG8_STAMP();
    unsigned voffA[2], voffB[2];
#pragma unroll
    for (int i = 0; i < 2; ++i) { int R, C; stage_rc(tid * 16 + i * 8192, R, C); const int Rb = Epi::PERM ? ((R & ~31) + perm32(R & 31)) : R;
        voffA[i] = (unsigned)(R * K + C) * 2u; voffB[i] = (unsigned)(Rb * K + C) * 2u; }
    const size_t kstep = (size_t)(BK * 2);
    const size_t hstep = (size_t)HALF * K * 2;
    const size_t tstep = 2 * hstep;
    const unsigned ldsw = (unsigned)wid * 1024u;
    const int aoff = lds_byte(wr * 64 + fr, fq * 8), boff = lds_byte(wc * 32 + fr, fq * 8);
#define PG8_SA(b, h) (((b) * 2 + (h)) * HTB)
#define PG8_SB(b, h) ((4 + (b) * 2 + (h)) * HTB)
#define PG8_STAGE(bufoff, gbase, voff) do { _Pragma("unroll") for (int _i = 0; _i < 2; ++_i) \
        __builtin_amdgcn_global_load_lds((const unsigned*)((const char*)(gbase) + (voff)[_i]), (PG8_LAS unsigned*)(lds + (bufoff) + ldsw + _i * 8192), 16, 0, 0); } while (0)
#define PG8_LDA(dst, b, h) do { _Pragma("unroll") for (int m = 0; m < 4; ++m) _Pragma("unroll") for (int k = 0; k < 2; ++k) dst[m][k] = *(const PG8_LAS bf16x8*)(lds + PG8_SA(b, h) + aoff + m * 2048 + k * 1024); } while (0)
#define PG8_LDB(dst, b, h) do { _Pragma("unroll") for (int n = 0; n < 2; ++n) _Pragma("unroll") for (int k = 0; k < 2; ++k) dst[n][k] = *(const PG8_LAS bf16x8*)(lds + PG8_SB(b, h) + boff + n * 2048 + k * 1024); } while (0)
#define PG8_MMA(ai, bj, At, Bt) do { __builtin_amdgcn_s_setprio(1); _Pragma("unroll") for (int m = 0; m < 4; ++m) _Pragma("unroll") for (int n = 0; n < 2; ++n) _Pragma("unroll") for (int k = 0; k < 2; ++k) \
        acc[ai][bj][m][n] = __builtin_amdgcn_mfma_f32_16x16x32_bf16(Bt[n][k], At[m][k], acc[ai][bj][m][n], 0, 0, 0); __builtin_amdgcn_s_setprio(0); } while (0)
#define PG8_WAIT_V(n) asm volatile("s_waitcnt vmcnt(" #n ")" ::: "memory")
#define PG8_WAIT_L(n) asm volatile("s_waitcnt lgkmcnt(" #n ")" ::: "memory")
#define PG8_BAR __builtin_amdgcn_s_barrier()
#define PG8_SCHED __builtin_amdgcn_sched_barrier(0)
    Unit cur, nxt; int ui = 0;
    if (!S.next(0, cur)) return;
    f32x4 acc[2][2][4][2];
#pragma unroll
    for (int a = 0; a < 2; ++a)
#pragma unroll
        for (int b = 0; b < 2; ++b)
#pragma unroll
            for (int m = 0; m < 4; ++m)
#pragma unroll
                for (int n = 0; n < 2; ++n) acc[a][b][m][n] = (f32x4){0.f, 0.f, 0.f, 0.f};
    bf16x8 At[4][2], B0[2][2], B1[2][2];
    const char* cA = (const char*)g.A + (size_t)cur.pm * tstep; const char* cB = (const char*)g.Bt + (size_t)cur.pn * tstep;
    S.a_ready(cur);
    PG8_STAGE(PG8_SB(0, 0), cB, voffB); PG8_STAGE(PG8_SA(0, 0), cA, voffA); PG8_STAGE(PG8_SB(0, 1), cB + hstep, voffB); PG8_STAGE(PG8_SA(0, 1), cA + hstep, voffA);
    if (wr == 1) PG8_BAR;
    PG8_WAIT_V(4); PG8_BAR;
    PG8_STAGE(PG8_SB(1, 0), cB + kstep, voffB); PG8_STAGE(PG8_SA(1, 0), cA + kstep, voffA); PG8_STAGE(PG8_SB(1, 1), cB + hstep + kstep, voffB);
    PG8_WAIT_V(6); PG8_BAR;
    PG8_STAMP();
    for (;;) {
        const bool has_next = S.next(ui + 1, nxt);
        const char* nA = has_next ? (const char*)g.A + (size_t)nxt.pm * tstep : cA; const char* nB = has_next ? (const char*)g.Bt + (size_t)nxt.pn * tstep : cB;
        for (int t = 0; t < nt; t += 2) {
            const bool last = (t == nt - 2);
            const char* a1 = cA + (size_t)(t + 1) * kstep;
            const char* a2 = last ? nA : cA + (size_t)(t + 2) * kstep; const char* b2 = last ? nB : cB + (size_t)(t + 2) * kstep;
            const char* a3 = a2 + kstep; const char* b3 = b2 + kstep;
            if (last && has_next) S.a_ready(nxt);
            PG8_LDB(B0, 0, 0); PG8_SCHED; PG8_LDA(At, 0, 0); PG8_STAGE(PG8_SA(1, 1), a1 + hstep, voffA);
            PG8_WAIT_L(8); PG8_BAR; PG8_WAIT_L(0); PG8_MMA(0, 0, At, B0); PG8_BAR; PG8_SCHED;
            PG8_LDB(B1, 0, 1); PG8_STAGE(PG8_SB(0, 0), b2, voffB);
            PG8_BAR; PG8_WAIT_L(0); PG8_MMA(0, 1, At, B1); PG8_BAR;
            PG8_LDA(At, 0, 1); PG8_STAGE(PG8_SA(0, 0), a2, voffA);
            PG8_BAR; PG8_WAIT_L(0); PG8_MMA(1, 0, At, B0); PG8_BAR; PG8_SCHED;
            PG8_STAGE(PG8_SB(0, 1), b2 + hstep, voffB);
            PG8_WAIT_V(6); PG8_BAR; PG8_MMA(1, 1, At, B1); PG8_BAR;
            PG8_LDB(B0, 1, 0); PG8_SCHED; PG8_LDA(At, 1, 0); PG8_STAGE(PG8_SA(0, 1), a2 + hstep, voffA);
            PG8_WAIT_L(8); PG8_BAR; PG8_WAIT_L(0); PG8_MMA(0, 0, At, B0); PG8_BAR; PG8_SCHED;
            PG8_LDB(B1, 1, 1); PG8_STAGE(PG8_SB(1, 0), b3, voffB);
            PG8_BAR; PG8_WAIT_L(0); PG8_MMA(0, 1, At, B1); PG8_BAR;
            PG8_LDA(At, 1, 1); PG8_STAGE(PG8_SA(1, 0), a3, voffA);
            PG8_BAR; PG8_WAIT_L(0); PG8_MMA(1, 0, At, B0); PG8_BAR; PG8_SCHED;
            PG8_STAGE(PG8_SB(1, 1), b3 + hstep, voffB);
            PG8_WAIT_V(6); PG8_BAR; PG8_MMA(1, 1, At, B1); PG8_BAR;
        }
        PG8_STAMP();
        if constexpr (!Epi::AFTER_DRAIN) { E(acc, cur, wr, wc, fr, fq); S.done(cur); }
        PG8_STAMP();
        if (!has_next) break;
#pragma unroll
        for (int a = 0; a < 2; ++a)
#pragma unroll
            for (int b = 0; b < 2; ++b)
#pragma unroll
                for (int m = 0; m < 4; ++m)
#pragma unroll
                    for (int n = 0; n < 2; ++n) acc[a][b][m][n] = (f32x4){0.f, 0.f, 0.f, 0.f};
        cur = nxt; cA = nA; cB = nB; ++ui;
    }
    PG8_WAIT_V(0);
    if (wr == 0) PG8_BAR;
    PG8_BAR;
    if constexpr (Epi::AFTER_DRAIN) { E.fused(acc, cur, wr, wc, fr, fq, lds, wid, lane); S.done(cur); }
    PG8_STAMP();
    if (STAMP && wid == 0) { stamps[lane] = lane < nts ? (((unsigned long long)(unsigned)ts_hi << 32) | (unsigned)ts_lo) : 0ull;
        if (lane == 62) stamps[62] = rt_entry; if (lane == 63) stamps[63] = (unsigned long long)wall_clock64(); }
#undef PG8_STAMP
#undef PG8_SA
#undef PG8_SB
#undef PG8_STAGE
#undef PG8_LDA
#undef PG8_LDB
#undef PG8_MMA
#undef PG8_WAIT_V
#undef PG8_WAIT_L
#undef PG8_BAR
#undef PG8_SCHED
}
}

constexpr int D = 1024, NB = 16, S = 2048, T = NB * S;
constexpr int NCOL = 2840, NPAD = 3072;
constexpr int C_Q = 0, C_KC = 512, C_VC = 640, C_KS = 768, C_VS = 896, C_KW = 1024, C_VW = 1152, C_GT = 1280, C_CB = 1304, C_CC = 1816, C_CH = 2328;
constexpr int NCMP = 127;
constexpr int NEXP = 16384;
constexpr float EPS = 1e-6f;
constexpr int NTHREADS = 512, NWAVES = 8;

constexpr size_t al256(size_t x) { return (x + 255) & ~(size_t)255; }
constexpr size_t WS_CTL   = 0;                                   constexpr size_t CTL_BYTES = 65536;
constexpr size_t WS_MOD   = WS_CTL + CTL_BYTES;
constexpr size_t WS_WIN   = al256(WS_MOD + (size_t)16 * 6144 * 4);
constexpr size_t WS_WOUT  = al256(WS_WIN + (size_t)NPAD * D * 2);
constexpr size_t WS_WQ    = al256(WS_WOUT + (size_t)D * D * 2);
constexpr size_t WS_KEYS  = al256(WS_WQ + (size_t)D * D * 2);
constexpr size_t WS_U8S   = al256(WS_KEYS + (size_t)16 * 128 * 64 * 2);
constexpr size_t WS_V8S   = al256(WS_U8S + (size_t)NEXP * D);
constexpr size_t WS_X8S   = al256(WS_V8S + (size_t)NEXP * D);
constexpr size_t WS_SU    = al256(WS_X8S + (size_t)T * D);
constexpr size_t WS_SV    = al256(WS_SU + (size_t)NEXP * 4);
constexpr size_t WS_SX    = al256(WS_SV + (size_t)NEXP * 4);
constexpr size_t WS_W1T   = al256(WS_SX + (size_t)T * 4);
constexpr size_t WS_W2T   = al256(WS_W1T + (size_t)2 * 64 * 2048 * 2);
constexpr size_t WS_PEC   = al256(WS_W2T + (size_t)2 * 64 * 64 * 2);
constexpr size_t WS_KC    = al256(WS_PEC + (size_t)2 * 64 * 4);
constexpr size_t WS_VC    = al256(WS_KC + (size_t)16 * 2 * 128 * 64 * 2);
constexpr size_t WS_H     = al256(WS_VC + (size_t)16 * 2 * 128 * 64 * 2);
constexpr size_t WS_CQ8   = WS_H;
constexpr size_t WS_CMAX  = WS_H + (size_t)32 * 1024 * 1024;
constexpr size_t WS_SSQP  = WS_H + (size_t)33 * 1024 * 1024;
constexpr size_t WS_OATT  = al256(WS_H + (size_t)T * D * 2);
constexpr size_t WS_PROJ  = al256(WS_OATT + (size_t)T * 512 * 2);
constexpr size_t WS_QP    = WS_PROJ;
constexpr size_t WS_PART  = WS_PROJ;
constexpr size_t WS_PO    = WS_PROJ;
constexpr size_t WS_E16   = WS_PROJ + (size_t)160 * 1024 * 1024;
constexpr size_t WS_EW    = WS_E16 + (size_t)T * 128 * 4;
constexpr size_t WS_Y     = al256(WS_PROJ + (size_t)T * NPAD * 2);
constexpr size_t WS_END   = al256(WS_Y + (size_t)T * D * 2);
static_assert(WS_EW + (size_t)T * 128 * 4 <= WS_Y, "alias region");
static_assert((size_t)8 * T * 128 * 4 <= (size_t)160 * 1024 * 1024, "PART fits under EIDX");
constexpr int CTL_CTR_A = 16384, CTL_CTR_B = 16384 + 8 * 256;

constexpr int LDS_STAGE = 147456;
constexpr int LDS_MISC_OFF = LDS_STAGE;
constexpr int LDS_BYTES = LDS_STAGE + 256;

typedef unsigned short bf16_t;
typedef short bf16x8 __attribute__((ext_vector_type(8)));
typedef short s16x4 __attribute__((ext_vector_type(4)));
typedef float f32x4 __attribute__((ext_vector_type(4)));
typedef unsigned u32x4v __attribute__((ext_vector_type(4)));
__device__ __forceinline__ float bf2f(bf16_t b) { return __uint_as_float(((unsigned)b) << 16); }
__device__ __forceinline__ bf16_t f2bf(float f) { unsigned u = __float_as_uint(f); u += 0x7FFFu + ((u >> 16) & 1u); return (bf16_t)(u >> 16); }
__device__ __forceinline__ float bflo(unsigned w) { return __uint_as_float(w << 16); }
__device__ __forceinline__ float bfhi(unsigned w) { return __uint_as_float(w & 0xFFFF0000u); }
__device__ __forceinline__ unsigned pack2(float lo, float hi) { return (unsigned)f2bf(lo) | ((unsigned)f2bf(hi) << 16); }
__device__ __forceinline__ float gelu_tanh(float x) { const float u = 0.7978845608028654f * (x + 0.044715f * x * x * x); return 0.5f * x * (1.0f + tanhf(u)); }
__device__ __forceinline__ float sigmoidf_(float x) { return 1.0f / (1.0f + __expf(-x)); }
__device__ __forceinline__ float wave_sum(float v) {
#pragma unroll
    for (int o = 32; o >= 1; o >>= 1) v += __shfl_xor(v, o);
    return v; }
__device__ __forceinline__ float wave_max(float v) {
#pragma unroll
    for (int o = 32; o >= 1; o >>= 1) v = fmaxf(v, __shfl_xor(v, o));
    return v; }
__device__ __forceinline__ void lds_wave_sync() { asm volatile("s_waitcnt lgkmcnt(0)" ::: "memory"); }
#ifdef PROBE_STAMP
#define STAMP_DECL unsigned long long tprev_ = 0ull; const bool dbg_ = (PROBE_PHASE == 12 || blockIdx.x == PROBE_BLOCK) && (threadIdx.x == 0);
#define STAMP_START() do { if (dbg_) tprev_ = __builtin_amdgcn_s_memtime(); } while (0)
#define STAMP(k) do { if (dbg_) { const unsigned long long tn_ = __builtin_amdgcn_s_memtime(); volatile LAS unsigned* c_ = (volatile LAS unsigned*)(F_lds_ + LDS_MISC_OFF + 128); c_[k] += (unsigned)(tn_ - tprev_); tprev_ = tn_; } } while (0)
#define STAMP_COUNT(k) do { if (dbg_) { volatile LAS unsigned* c_ = (volatile LAS unsigned*)(F_lds_ + LDS_MISC_OFF + 128); c_[k] += 1u; } } while (0)
#else
#define STAMP_DECL
#define STAMP_START() do {} while (0)
#define STAMP(k) do {} while (0)
#define STAMP_COUNT(k) do {} while (0)
#endif
#ifndef PROBE_BLOCK
#define PROBE_BLOCK 0
#endif
#ifndef PROBE_PHASE
#define PROBE_PHASE 4
#endif

__device__ __forceinline__ int rel_bucket(int dist) {
    const int n = dist > 0 ? dist : 0;
    if (n < 16) return n;
    const float lr = logf((float)n / 16.0f) / 2.0794415416798357f;
    const int large = 16 + (int)(lr * 16.0f);
    return large < 31 ? large : 31;
}

struct Frame {
    const float* in[23]; float* out; unsigned char* ws;
    LAS unsigned char* lds; int tid, lane, wave, G;
};


typedef int i32x4v __attribute__((ext_vector_type(4)));
constexpr int PEER_CHUNK_TOK = 128, PEER_NCHUNK = T / PEER_CHUNK_TOK;

__device__ __forceinline__ void quant_row_sliced(const float* row, unsigned char* dst8  , size_t nrows, size_t r, float* scale_out, int bias, int lane) {
    float4 v[4]; float am = 0.f;
#pragma unroll
    for (int i = 0; i < 4; ++i) { v[i] = *(const float4*)(row + (lane + 64 * i) * 4); am = fmaxf(am, fmaxf(fmaxf(fabsf(v[i].x), fabsf(v[i].y)), fmaxf(fabsf(v[i].z), fabsf(v[i].w)))); }
    am = wave_max(am); const float inv = am > 0.f ? 127.0f / am : 0.f;
    if (lane == 0) *scale_out = am > 0.f ? am / 127.0f : 0.f;
#pragma unroll
    for (int i = 0; i < 4; ++i) { const int col = (lane + 64 * i) * 4; const int sl = col >> 7, off = col & 127;
        const int q0 = (int)rintf(v[i].x * inv) + bias, q1 = (int)rintf(v[i].y * inv) + bias, q2 = (int)rintf(v[i].z * inv) + bias, q3 = (int)rintf(v[i].w * inv) + bias;
        *(unsigned*)(dst8 + ((size_t)sl * nrows + r) * 128 + off) = (unsigned)(q0 & 0xFF) | ((unsigned)(q1 & 0xFF) << 8) | ((unsigned)(q2 & 0xFF) << 16) | ((unsigned)(q3 & 0xFF) << 24); }
}

constexpr int PEER_NGRP = T / 16;
__device__ __forceinline__ int grab_item(unsigned* ctr, int slice, int lane) {
    unsigned v = 0u; if (lane == 0) v = __hip_atomic_fetch_add(ctr + slice * 64, 1u, __ATOMIC_RELAXED, __HIP_MEMORY_SCOPE_AGENT);
    return (int)__builtin_amdgcn_readfirstlane(v);
}
__device__ __forceinline__ void gather_rows16(u32x4v (&vv)[16], const unsigned char* base, const LAS unsigned* le) {
    const u32x4v e0 = *(const LAS u32x4v*)le, e1 = *(const LAS u32x4v*)(le + 4);
#pragma unroll
    for (int ld = 0; ld < 16; ++ld) { const unsigned w = ld < 8 ? e0[ld >> 1] : e1[(ld - 8) >> 1]; const unsigned e = (ld & 1) ? (w >> 16) : (w & 0xFFFFu);
        vv[ld] = *(const u32x4v*)(base + (size_t)e * 128); }
}
__device__ __forceinline__ void udot_item(const u32x4v (&uv)[16], const i32x4v xq, int* part_row  , int c) {
    i32x4v res[4];
#pragma unroll
    for (int ld = 0; ld < 16; ++ld) { int p = __builtin_amdgcn_sdot4((int)uv[ld][0], xq[0], 0, false); p = __builtin_amdgcn_sdot4((int)uv[ld][1], xq[1], p, false);
        p = __builtin_amdgcn_sdot4((int)uv[ld][2], xq[2], p, false); p = __builtin_amdgcn_sdot4((int)uv[ld][3], xq[3], p, false);
        p += __shfl_xor(p, 1); p += __shfl_xor(p, 2); p += __shfl_xor(p, 4); res[ld >> 2][ld & 3] = p; }
    if (c == 0) {
#pragma unroll
        for (int q = 0; q < 4; ++q) *(i32x4v*)(part_row + 4 * q) = res[q]; }
}
__device__ __forceinline__ void p10a_udots(const Frame& F) {
    const unsigned char* U8S = F.ws + WS_U8S; const unsigned char* X8S = F.ws + WS_X8S; const unsigned short* E16 = (const unsigned short*)(F.ws + WS_E16); int* PART = (int*)(F.ws + WS_PART);
    unsigned* ctr = (unsigned*)(F.ws + WS_CTL + CTL_CTR_A);
    const int lane = F.lane, j = lane >> 3, c = lane & 7; const int xcc = (int)(xb_xcc_id() & 7u);
    LAS unsigned char* wl = F.lds + F.wave * 8192;
    const LAS unsigned* le = (const LAS unsigned*)wl + 8 * j;
    for (int so = 0; so < 8; ++so) { const int x = (xcc + so) & 7;
        const unsigned char* ub = U8S + (size_t)x * NEXP * 128 + c * 16;
        int nxt = grab_item(ctr, x, lane);
        for (;;) { const int cur = nxt; if (cur >= PEER_NGRP) break;
            nxt = grab_item(ctr, x, lane);
            const int t0 = cur * 16;
            { const u32x4v* src = (const u32x4v*)(E16 + (size_t)t0 * 128);
#pragma unroll
                for (int i = 0; i < 4; ++i) *(LAS u32x4v*)(wl + (lane + 64 * i) * 16) = src[lane + 64 * i]; }
            lds_wave_sync();
            const unsigned char* xb = X8S + ((size_t)x * T + t0) * 128 + c * 16; int* pr = PART + ((size_t)x * T + t0) * 128 + 16 * j;
            u32x4v va[16], vb[16];
            gather_rows16(va, ub, le);
#pragma unroll 1
            for (int tt = 0; tt < 16; tt += 2) {
                const i32x4v xqa = *(const i32x4v*)(xb + (size_t)tt * 128), xqb = *(const i32x4v*)(xb + (size_t)(tt + 1) * 128);
                gather_rows16(vb, ub, le + (tt + 1) * 64);
                udot_item(va, xqa, pr + (size_t)tt * 128, c);
                if (tt + 2 < 16) gather_rows16(va, ub, le + (tt + 2) * 64);
                udot_item(vb, xqb, pr + (size_t)(tt + 1) * 128, c);
            }
            lds_wave_sync();
        }
    }
}

__device__ __forceinline__ void p10b_coef(const Frame& F) {
    const unsigned short* E16 = (const unsigned short*)(F.ws + WS_E16); const float* EW = (const float*)(F.ws + WS_EW); const int* PART = (const int*)(F.ws + WS_PART);
    const float* SU = (const float*)(F.ws + WS_SU); const float* SV = (const float*)(F.ws + WS_SV); const float* SX = (const float*)(F.ws + WS_SX);
    signed char* CQ8 = (signed char*)(F.ws + WS_CQ8); float* CMAX = (float*)(F.ws + WS_CMAX);
    const int gw = blockIdx.x * NWAVES + F.wave, nw = F.G * NWAVES, lane = F.lane;
    for (int t = gw; t < T; t += nw) { const float sx = SX[t]; float cs[2]; float am = 0.f;
#pragma unroll
        for (int hh = 0; hh < 2; ++hh) { const int i = lane + 64 * hh; int s = 0;
#pragma unroll
            for (int x = 0; x < 8; ++x) s += PART[((size_t)x * T + t) * 128 + i];
            const int e = E16[(size_t)t * 128 + i]; const float dot = (float)s * sx * SU[e];
            cs[hh] = EW[(size_t)t * 128 + i] * gelu_tanh(dot) * SV[e]; am = fmaxf(am, fabsf(cs[hh])); }
        am = wave_max(am); const float inv = am > 0.f ? 127.0f / am : 0.f;
#pragma unroll
        for (int hh = 0; hh < 2; ++hh) CQ8[(size_t)t * 128 + lane + 64 * hh] = (signed char)(int)rintf(cs[hh] * inv);
        if (lane == 0) CMAX[t] = am > 0.f ? am / 127.0f : 0.f; }
}

struct VsumPre { float sc; };
__device__ __forceinline__ void vsum_item(const u32x4v (&vv)[16], const LAS unsigned* lq  , const VsumPre& pre, unsigned* pop, int lane) {
    const u32x4v cq = *(const LAS u32x4v*)lq;
    int acc[16];
#pragma unroll
    for (int k = 0; k < 16; ++k) acc[k] = 0;
#pragma unroll
    for (int g = 0; g < 4; ++g) { const int cw = (int)cq[g];
#pragma unroll
        for (int w = 0; w < 4; ++w) { const unsigned r0 = vv[4 * g][w], r1 = vv[4 * g + 1][w], r2 = vv[4 * g + 2][w], r3 = vv[4 * g + 3][w];
            const unsigned t0 = __builtin_amdgcn_perm(r1, r0, 0x05010400u), t1 = __builtin_amdgcn_perm(r1, r0, 0x07030602u), t2 = __builtin_amdgcn_perm(r3, r2, 0x05010400u), t3 = __builtin_amdgcn_perm(r3, r2, 0x07030602u);
            const unsigned c0 = __builtin_amdgcn_perm(t2, t0, 0x05040100u), c1 = __builtin_amdgcn_perm(t2, t0, 0x07060302u), c2 = __builtin_amdgcn_perm(t3, t1, 0x05040100u), c3 = __builtin_amdgcn_perm(t3, t1, 0x07060302u);
            acc[4 * w + 0] = __builtin_amdgcn_sdot4((int)c0, cw, acc[4 * w + 0], false); acc[4 * w + 1] = __builtin_amdgcn_sdot4((int)c1, cw, acc[4 * w + 1], false);
            acc[4 * w + 2] = __builtin_amdgcn_sdot4((int)c2, cw, acc[4 * w + 2], false); acc[4 * w + 3] = __builtin_amdgcn_sdot4((int)c3, cw, acc[4 * w + 3], false); } }
    int a8[8], a4[4], a2[2];
    { const bool hi = (lane & 32) != 0;
#pragma unroll
        for (int k = 0; k < 8; ++k) { const int snd = hi ? acc[k] : acc[k + 8]; const int rcv = __shfl_xor(snd, 32); a8[k] = (hi ? acc[k + 8] : acc[k]) + rcv; } }
    { const bool hi = (lane & 16) != 0;
#pragma unroll
        for (int k = 0; k < 4; ++k) { const int snd = hi ? a8[k] : a8[k + 4]; const int rcv = __shfl_xor(snd, 16); a4[k] = (hi ? a8[k + 4] : a8[k]) + rcv; } }
    { const bool hi = (lane & 8) != 0;
#pragma unroll
        for (int k = 0; k < 2; ++k) { const int snd = hi ? a4[k] : a4[k + 2]; const int rcv = __shfl_xor(snd, 8); a2[k] = (hi ? a4[k + 2] : a4[k]) + rcv; } }
    *pop = pg8::cvt_pk_bf16((float)a2[0] * pre.sc, (float)a2[1] * pre.sc);
}
__device__ __forceinline__ void p10c_vsum(const Frame& F) {
    const unsigned char* V8S = F.ws + WS_V8S; const unsigned short* E16 = (const unsigned short*)(F.ws + WS_E16); const signed char* CQ8 = (const signed char*)(F.ws + WS_CQ8); const float* CMAX = (const float*)(F.ws + WS_CMAX);
    bf16_t* PO = (bf16_t*)(F.ws + WS_PO);
    unsigned* ctr = (unsigned*)(F.ws + WS_CTL + CTL_CTR_B);
    const int lane = F.lane, j = lane >> 3, c = lane & 7; const int xcc = (int)(xb_xcc_id() & 7u);
    const int ocol = 16 * c + 8 * ((lane >> 5) & 1) + 4 * ((lane >> 4) & 1) + 2 * ((lane >> 3) & 1);
    LAS unsigned char* wl = F.lds + F.wave * 8192;
    const LAS unsigned* le = (const LAS unsigned*)wl + 8 * j; const LAS unsigned* lq = (const LAS unsigned*)(wl + 4096) + 4 * j;
    for (int so = 0; so < 8; ++so) { const int x = (xcc + so) & 7;
        const unsigned char* vb = V8S + (size_t)x * NEXP * 128 + c * 16;
        const int col = x * 128 + ocol;
        int nxt = grab_item(ctr, x, lane);
        for (;;) { const int cur = nxt; if (cur >= PEER_NGRP) break;
            nxt = grab_item(ctr, x, lane);
            const int t0 = cur * 16;
            { const u32x4v* src = (const u32x4v*)(E16 + (size_t)t0 * 128); const u32x4v* srq = (const u32x4v*)(CQ8 + (size_t)t0 * 128);
#pragma unroll
                for (int i = 0; i < 4; ++i) *(LAS u32x4v*)(wl + (lane + 64 * i) * 16) = src[lane + 64 * i];
#pragma unroll
                for (int i = 0; i < 2; ++i) *(LAS u32x4v*)(wl + 4096 + (lane + 64 * i) * 16) = srq[lane + 64 * i]; }
            lds_wave_sync();
            u32x4v va[16], vbb[16];
            gather_rows16(va, vb, le);
#pragma unroll 1
            for (int tt = 0; tt < 16; tt += 2) {
                { VsumPre pa; pa.sc = CMAX[t0 + tt];
                  gather_rows16(vbb, vb, le + (tt + 1) * 64);
                  vsum_item(va, lq + tt * 32, pa, (unsigned*)(PO + (size_t)(t0 + tt) * D + col), lane); }
                { VsumPre pb; pb.sc = CMAX[t0 + tt + 1];
                  if (tt + 2 < 16) gather_rows16(va, vb, le + (tt + 2) * 64);
                  vsum_item(vbb, lq + (tt + 1) * 32, pb, (unsigned*)(PO + (size_t)(t0 + tt + 1) * D + col), lane); }
            }
            lds_wave_sync();
        }
    }
}

__device__ __forceinline__ void p10d_final(const Frame& F) {
    const bf16_t* PO = (const bf16_t*)(F.ws + WS_PO); const float* MOD = (const float*)(F.ws + WS_MOD); const float* gfin = F.in[22]; float* out = F.out;
    const int gw = blockIdx.x * NWAVES + F.wave, nw = F.G * NWAVES, lane = F.lane;
    const float* xin = F.in[0]; const bf16_t* Y = (const bf16_t*)(F.ws + WS_Y);
    float4 xn[4]; uint2 pn[4], yn[4];
    if (gw < T) {
#pragma unroll
        for (int i = 0; i < 4; ++i) { const int col = (lane + 64 * i) * 4; xn[i] = *(const float4*)(xin + (size_t)gw * D + col); pn[i] = *(const uint2*)(PO + (size_t)gw * D + col); yn[i] = *(const uint2*)(Y + (size_t)gw * D + col); } }
    for (int t = gw; t < T; t += nw) { const int b = t / S;
        float4 v[4], xc[4]; uint2 pc[4], yc[4]; float ss = 0.f;
#pragma unroll
        for (int i = 0; i < 4; ++i) { xc[i] = xn[i]; pc[i] = pn[i]; yc[i] = yn[i]; }
        { const int tn = t + nw < T ? t + nw : t;
#pragma unroll
            for (int i = 0; i < 4; ++i) { const int col = (lane + 64 * i) * 4; xn[i] = *(const float4*)(xin + (size_t)tn * D + col); pn[i] = *(const uint2*)(PO + (size_t)tn * D + col); yn[i] = *(const uint2*)(Y + (size_t)tn * D + col); } }
#pragma unroll
        for (int i = 0; i < 4; ++i) { const int col = (lane + 64 * i) * 4; const float4 g1 = *(const float4*)(MOD + b * 6144 + 2048 + col), gt = *(const float4*)(MOD + b * 6144 + 5120 + col);
            const uint2 pw = pc[i], yw = yc[i];
            v[i].x = xc[i].x + g1.x * bflo(yw.x) + gt.x * bflo(pw.x); v[i].y = xc[i].y + g1.y * bfhi(yw.x) + gt.y * bfhi(pw.x); v[i].z = xc[i].z + g1.z * bflo(yw.y) + gt.z * bflo(pw.y); v[i].w = xc[i].w + g1.w * bfhi(yw.y) + gt.w * bfhi(pw.y);
            ss += v[i].x * v[i].x + v[i].y * v[i].y + v[i].z * v[i].z + v[i].w * v[i].w; }
        ss = wave_sum(ss);
#ifdef PROBE_STAMP
        const unsigned* dg = (const unsigned*)(F.ws + WS_CTL + 32768); const float pnum = (float)dg[PROBE_STAMP]; const float pden = PROBE_DEN >= 0 ? (float)dg[PROBE_DEN >= 0 ? PROBE_DEN : 0] : (float)PROBE_ABS;
        const float rstd = rsqrtf(ss * (1.0f / D) + EPS) * (1.0f + 0.5f * pnum / pden);
#else
        const float rstd = rsqrtf(ss * (1.0f / D) + EPS);
#endif
#pragma unroll
        for (int i = 0; i < 4; ++i) { const int col = (lane + 64 * i) * 4; const float4 gg = *(const float4*)(gfin + col);
            *(float4*)(out + (size_t)t * D + col) = make_float4(v[i].x * rstd * gg.x, v[i].y * rstd * gg.y, v[i].z * rstd * gg.z, v[i].w * rstd * gg.w); }
    }
}

__device__ __forceinline__ void transpose_tile(const Frame& F, const float* src, int srcK, int srcN, bf16_t* dst, int dstK, int kt, int nt) {
    LAS float* tile = (LAS float*)F.lds;
    const int k0 = kt * 64, n0 = nt * 64;
    for (int i = F.tid; i < 4096; i += NTHREADS) { const int r = i >> 6, c = i & 63; const int k = k0 + r, n = n0 + c;
        tile[r * 65 + c] = (k < srcK && n < srcN) ? src[(size_t)k * srcN + n] : 0.0f; }
    __syncthreads();
    for (int i = F.tid; i < 4096; i += NTHREADS) { const int r = i >> 6, c = i & 63;
        dst[(size_t)(n0 + r) * dstK + k0 + c] = f2bf(tile[c * 65 + r]); }
    __syncthreads();
}
__device__ __forceinline__ void p0_prologue(const Frame& F, int item_lo = 0, int item_hi = 1 << 30) {
    const float* c = F.in[1]; const float* w_mod = F.in[4]; const float* b_mod = F.in[5];
    float* MOD = (float*)(F.ws + WS_MOD);
    constexpr int I_MOD = 96, I_WIN = 16 * 48, I_WOUT = 256, I_WQ = 256, I_U = 256, I_V = 256, I_KEYS = 2, I_CMP = 32 + 32 + 1 + 1 + 2;
    constexpr int O_WIN = I_MOD, O_WOUT = O_WIN + I_WIN, O_WQ = O_WOUT + I_WOUT, O_U = O_WQ + I_WQ, O_V = O_U + I_U, O_KEYS = O_V + I_V, O_CMP = O_KEYS + I_KEYS, N_ITEMS = O_CMP + I_CMP;
    for (int it = item_lo + blockIdx.x; it < N_ITEMS && it < item_hi; it += F.G) {
        if (it < O_WIN) {
            LAS float* sl = (LAS float*)F.lds; LAS float* red = (LAS float*)(F.lds + 65536);
            for (int q = F.tid; q < 16 * D; q += NTHREADS) { const float cv = c[q]; sl[q] = cv / (1.0f + __expf(-cv)); }
            __syncthreads();
            const int kg = F.tid >> 6, cl = F.tid & 63, j0 = it * 64;
            float acc[16];
#pragma unroll
            for (int bb = 0; bb < 16; ++bb) acc[bb] = 0.f;
            const float* wp = w_mod + (size_t)(kg * 128) * 6144 + j0 + cl;
#pragma unroll 4
            for (int kk = 0; kk < 128; ++kk) { const float w = wp[(size_t)kk * 6144]; const int k = kg * 128 + kk;
#pragma unroll
                for (int bb = 0; bb < 16; ++bb) acc[bb] += sl[bb * D + k] * w; }
#pragma unroll
            for (int bb = 0; bb < 16; ++bb) red[(kg * 16 + bb) * 64 + cl] = acc[bb];
            __syncthreads();
#pragma unroll
            for (int q = 0; q < 2; ++q) { const int o = F.tid + 512 * q; const int bb = o >> 6, cc = o & 63; float s = b_mod[j0 + cc];
#pragma unroll
                for (int g8 = 0; g8 < 8; ++g8) s += red[(g8 * 16 + bb) * 64 + cc];
                MOD[bb * 6144 + j0 + cc] = s; }
            __syncthreads();
        } else if (it < O_WOUT) { const int i = it - O_WIN; transpose_tile(F, F.in[6], D, NCOL, (bf16_t*)(F.ws + WS_WIN), D, i % 16, i / 16); }
        else if (it < O_WQ) { const int i = it - O_WOUT; transpose_tile(F, F.in[16], D, D, (bf16_t*)(F.ws + WS_WOUT), D, i % 16, i / 16); }
        else if (it < O_U) { const int i = it - O_WQ; transpose_tile(F, F.in[17], D, D, (bf16_t*)(F.ws + WS_WQ), D, i % 16, i / 16); }
        else if (it < O_KEYS) {
            const bool isv = it >= O_V; const int i = isv ? it - O_V : it - O_U;
            for (int rr = 0; rr < 8; ++rr) { const size_t r = (size_t)i * 64 + rr * 8 + F.wave;
                quant_row_sliced((isv ? F.in[20] : F.in[19]) + r * D, F.ws + (isv ? WS_V8S : WS_U8S), NEXP, r, (float*)(F.ws + (isv ? WS_SV : WS_SU)) + r, 0, F.lane); }
        } else if (it >= O_CMP) {
            const int i = it - O_CMP;
            if (i < 64) { const int kv = i >> 5; transpose_tile(F, kv ? F.in[11] : F.in[9], 2048, 64, (bf16_t*)(F.ws + WS_W1T) + (size_t)kv * 64 * 2048, 2048, i & 31, 0); }
            else if (i < 66) { const int kv = i - 64; transpose_tile(F, kv ? F.in[12] : F.in[10], 64, 64, (bf16_t*)(F.ws + WS_W2T) + (size_t)kv * 64 * 64, 64, 0, 0); }
            else { const int kv = i - 66; const float* pe = kv ? F.in[8] : F.in[7]; const float* w1 = kv ? F.in[11] : F.in[9];
                LAS float* red = (LAS float*)F.lds; const int jj = F.tid & 63, kg = F.tid >> 6; float a = 0.f;
#pragma unroll 8
                for (int kk = 0; kk < 256; ++kk) { const int k = kg * 256 + kk; a += pe[k] * w1[(size_t)k * 64 + jj]; }
                red[kg * 64 + jj] = a; __syncthreads();
                if (F.tid < 64) { float s = 0.f;
#pragma unroll
                    for (int g8 = 0; g8 < 8; ++g8) s += red[g8 * 64 + F.tid];
                    ((float*)(F.ws + WS_PEC))[kv * 64 + F.tid] = s; }
                __syncthreads(); }
        } else {
            const int i = it - O_KEYS; const float4* src = (const float4*)F.in[18] + (size_t)i * 16384; uint2* dst = (uint2*)(F.ws + WS_KEYS) + (size_t)i * 16384;
            for (int q = F.tid; q < 16384; q += NTHREADS) { const float4 v = src[q]; dst[q] = make_uint2(pack2(v.x, v.y), pack2(v.z, v.w)); }
        }
    }
}

__device__ __forceinline__ void norm_mod_rows(const Frame& F, const float* x, const float* g, int sh_off, int sc_off, bf16_t* dst) {
    const float* MOD = (const float*)(F.ws + WS_MOD);
    const int gw = blockIdx.x * NWAVES + F.wave, nw = F.G * NWAVES;
    float4 vn[4];
    if (gw < T) {
#pragma unroll
        for (int i = 0; i < 4; ++i) vn[i] = ((const float4*)(x + (size_t)gw * D))[F.lane + 64 * i]; }
    for (int t = gw; t < T; t += nw) {
        const int b = t / S;
        float4 v[4]; float ss = 0.f;
#pragma unroll
        for (int i = 0; i < 4; ++i) { v[i] = vn[i]; ss += v[i].x * v[i].x + v[i].y * v[i].y + v[i].z * v[i].z + v[i].w * v[i].w; }
        { const int tn = t + nw < T ? t + nw : t;
#pragma unroll
            for (int i = 0; i < 4; ++i) vn[i] = ((const float4*)(x + (size_t)tn * D))[F.lane + 64 * i]; }
        ss = wave_sum(ss); const float rstd = rsqrtf(ss * (1.0f / D) + EPS);
#pragma unroll
        for (int i = 0; i < 4; ++i) { const int col = (F.lane + 64 * i) * 4;
            const float4 gg = *(const float4*)(g + col), sc = *(const float4*)(MOD + b * 6144 + sc_off + col), sh = *(const float4*)(MOD + b * 6144 + sh_off + col);
            const float o0 = v[i].x * rstd * gg.x * (1.f + sc.x) + sh.x, o1 = v[i].y * rstd * gg.y * (1.f + sc.y) + sh.y, o2 = v[i].z * rstd * gg.z * (1.f + sc.z) + sh.z, o3 = v[i].w * rstd * gg.w * (1.f + sc.w) + sh.w;
            *(uint2*)(dst + (size_t)t * D + col) = make_uint2(pack2(o0, o1), pack2(o2, o3)); }
    }
}

__device__ __forceinline__ void norm_mod_rows_q(const Frame& F, const float* x, const float* g, int sh_off, int sc_off, bf16_t* dst) {
    const float* MOD = (const float*)(F.ws + WS_MOD);
    const int gw = blockIdx.x * NWAVES + F.wave, nw = F.G * NWAVES;
    const bf16_t* Y = (const bf16_t*)(F.ws + WS_Y);
    float4 vn[4]; uint2 yn[4];
    if (gw < T) {
#pragma unroll
        for (int i = 0; i < 4; ++i) { vn[i] = ((const float4*)(x + (size_t)gw * D))[F.lane + 64 * i]; yn[i] = ((const uint2*)(Y + (size_t)gw * D))[F.lane + 64 * i]; } }
    for (int t = gw; t < T; t += nw) {
        const int b = t / S;
        float4 v[4]; float ss = 0.f;
#pragma unroll
        for (int i = 0; i < 4; ++i) { const int col = (F.lane + 64 * i) * 4; const float4 gt = *(const float4*)(MOD + b * 6144 + 2048 + col);
            v[i].x = vn[i].x + gt.x * bflo(yn[i].x); v[i].y = vn[i].y + gt.y * bfhi(yn[i].x); v[i].z = vn[i].z + gt.z * bflo(yn[i].y); v[i].w = vn[i].w + gt.w * bfhi(yn[i].y);
            ss += v[i].x * v[i].x + v[i].y * v[i].y + v[i].z * v[i].z + v[i].w * v[i].w; }
        { const int tn = t + nw < T ? t + nw : t;
#pragma unroll
            for (int i = 0; i < 4; ++i) { vn[i] = ((const float4*)(x + (size_t)tn * D))[F.lane + 64 * i]; yn[i] = ((const uint2*)(Y + (size_t)tn * D))[F.lane + 64 * i]; } }
        ss = wave_sum(ss); const float rstd = rsqrtf(ss * (1.0f / D) + EPS);
        float am = 0.f;
#pragma unroll
        for (int i = 0; i < 4; ++i) { const int col = (F.lane + 64 * i) * 4;
            const float4 gg = *(const float4*)(g + col), sc = *(const float4*)(MOD + b * 6144 + sc_off + col), sh = *(const float4*)(MOD + b * 6144 + sh_off + col);
            v[i].x = v[i].x * rstd * gg.x * (1.f + sc.x) + sh.x; v[i].y = v[i].y * rstd * gg.y * (1.f + sc.y) + sh.y; v[i].z = v[i].z * rstd * gg.z * (1.f + sc.z) + sh.z; v[i].w = v[i].w * rstd * gg.w * (1.f + sc.w) + sh.w;
            *(uint2*)(dst + (size_t)t * D + col) = make_uint2(pack2(v[i].x, v[i].y), pack2(v[i].z, v[i].w));
            am = fmaxf(am, fmaxf(fmaxf(fabsf(v[i].x), fabsf(v[i].y)), fmaxf(fabsf(v[i].z), fabsf(v[i].w)))); }
        am = wave_max(am); const float inv = am > 0.f ? 127.0f / am : 0.f;
        if (F.lane == 0) ((float*)(F.ws + WS_SX))[t] = am > 0.f ? am / 127.0f : 0.f;
#pragma unroll
        for (int i = 0; i < 4; ++i) { const int col = (F.lane + 64 * i) * 4; const int sl = col >> 7, off = col & 127;
            const int q0 = (int)rintf(v[i].x * inv), q1 = (int)rintf(v[i].y * inv), q2 = (int)rintf(v[i].z * inv), q3 = (int)rintf(v[i].w * inv);
            *(unsigned*)(F.ws + WS_X8S + ((size_t)sl * T + t) * 128 + off) = (unsigned)(q0 & 0xFF) | ((unsigned)(q1 & 0xFF) << 8) | ((unsigned)(q2 & 0xFF) << 16) | ((unsigned)(q3 & 0xFF) << 24); }
    }
}

__device__ __forceinline__ void p3_compress_naive(const Frame& F) {
    const bf16_t* PROJ = (const bf16_t*)(F.ws + WS_PROJ);
    LAS float* hid = (LAS float*)F.lds + F.wave * 64;
    const int gw = blockIdx.x * NWAVES + F.wave, nw = F.G * NWAVES;
    if (gw < 64) { bf16_t* dz = (bf16_t*)(F.ws + ((gw & 1) ? WS_VC : WS_KC)); dz[((size_t)(gw >> 1) * 128 + 127) * 64 + F.lane] = 0; }
    for (int u = gw; u < NB * NCMP * 2 * 2; u += nw) {
        const int kv = u & 1, g = (u >> 1) & 1, n = (u >> 2) % NCMP, b = (u >> 2) / NCMP;
        const float* pe = kv ? F.in[8] : F.in[7]; const float* w1 = kv ? F.in[11] : F.in[9]; const float* w2 = kv ? F.in[12] : F.in[10];
        const int cbase = (kv ? C_VC : C_KC) + g * 64;
        float acc = 0.f;
        for (int l = 0; l < 32; ++l) {
            const bf16_t* row = PROJ + (size_t)(b * S + 16 * n + l) * NPAD + cbase;
            for (int d = 0; d < 64; ++d) { const float a = bf2f(row[d]) + pe[l * 64 + d]; acc += a * w1[(size_t)(l * 64 + d) * 64 + F.lane]; }
        }
        hid[F.lane] = gelu_tanh(acc); lds_wave_sync();
        float o = 0.f;
        for (int j = 0; j < 64; ++j) o += hid[j] * w2[j * 64 + F.lane];
        bf16_t* dst = (bf16_t*)(F.ws + (kv ? WS_VC : WS_KC)); dst[((size_t)(b * 2 + g) * 128 + n) * 64 + F.lane] = f2bf(o);
        lds_wave_sync();
    }
}


__device__ __forceinline__ void p3_compress_mfma(const Frame& F) {
    const bf16_t* PROJ = (const bf16_t*)(F.ws + WS_PROJ);
    const int lane = F.lane, tid = F.tid, wave = F.wave, grp = lane >> 4, col = lane & 15;
    LAS float* red = (LAS float*)F.lds;
    LAS bf16_t* hid = (LAS bf16_t*)(F.lds + 32768);
    if (blockIdx.x * NWAVES + wave < 64) { const int gw = blockIdx.x * NWAVES + wave; bf16_t* dz = (bf16_t*)(F.ws + ((gw & 1) ? WS_VC : WS_KC)); dz[((size_t)(gw >> 1) * 128 + 127) * 64 + lane] = 0; }
    for (int u = blockIdx.x; u < NB * 2 * 2 * 8; u += F.G) {
        const int nt8 = u & 7, kv = (u >> 3) & 1, g = (u >> 4) & 1, b = u >> 5; const int n0 = nt8 * 16;
        const bf16_t* W1T = (const bf16_t*)(F.ws + WS_W1T) + (size_t)kv * 64 * 2048; const bf16_t* W2T = (const bf16_t*)(F.ws + WS_W2T) + (size_t)kv * 64 * 64;
        const float* pec = (const float*)(F.ws + WS_PEC) + kv * 64;
        const int cbase = (kv ? C_VC : C_KC) + g * 64;
        const int nrow = (n0 + col) < NCMP ? (n0 + col) : (NCMP - 1);
        f32x4 acc[4];
#pragma unroll
        for (int nt = 0; nt < 4; ++nt) acc[nt] = (f32x4){0.f, 0.f, 0.f, 0.f};
#pragma unroll
        for (int ks = 0; ks < 8; ++ks) { const int l = 4 * wave + (ks >> 1), d0 = (ks & 1) * 32 + 8 * grp;
            const bf16x8 af = *(const bf16x8*)(PROJ + (size_t)(b * S + 16 * nrow + l) * NPAD + cbase + d0);
#pragma unroll
            for (int nt = 0; nt < 4; ++nt) { const bf16x8 bfr = *(const bf16x8*)(W1T + (size_t)(nt * 16 + col) * 2048 + l * 64 + d0);
                acc[nt] = __builtin_amdgcn_mfma_f32_16x16x32_bf16(af, bfr, acc[nt], 0, 0, 0); } }
#pragma unroll
        for (int nt = 0; nt < 4; ++nt)
#pragma unroll
            for (int rg = 0; rg < 4; ++rg) red[(wave * 16 + 4 * grp + rg) * 64 + nt * 16 + col] = acc[nt][rg];
        __syncthreads();
#pragma unroll
        for (int q = 0; q < 2; ++q) { const int idx = tid + 512 * q; float s = pec[idx & 63];
#pragma unroll
            for (int w = 0; w < 8; ++w) s += red[w * 1024 + idx];
            hid[idx] = f2bf(gelu_tanh(s)); }
        __syncthreads();
        if (wave < 4) { f32x4 o = (f32x4){0.f, 0.f, 0.f, 0.f};
#pragma unroll
            for (int ks = 0; ks < 2; ++ks) { const bf16x8 af = *(const LAS bf16x8*)(hid + col * 64 + ks * 32 + 8 * grp); const bf16x8 bfr = *(const bf16x8*)(W2T + (size_t)(wave * 16 + col) * 64 + ks * 32 + 8 * grp);
                o = __builtin_amdgcn_mfma_f32_16x16x32_bf16(af, bfr, o, 0, 0, 0); }
            bf16_t* dst = (bf16_t*)(F.ws + (kv ? WS_VC : WS_KC));
#pragma unroll
            for (int rg = 0; rg < 4; ++rg) { const int n = n0 + 4 * grp + rg; if (n < NCMP) dst[((size_t)(b * 2 + g) * 128 + n) * 64 + wave * 16 + col] = f2bf(o[rg]); } }
        __syncthreads();
    }
}

__device__ __forceinline__ void dot4_row(const bf16_t* krow, const LAS float* qs, float (&acc)[4]) {
    const uint4* kr = (const uint4*)krow;
#pragma unroll 1
    for (int c = 0; c < 8; ++c) { asm volatile("" ::: "memory"); const uint4 w = kr[c]; const unsigned ww[4] = {w.x, w.y, w.z, w.w};
#pragma unroll
        for (int e = 0; e < 4; ++e) { const float k0 = bflo(ww[e]), k1 = bfhi(ww[e]); const int d = c * 8 + e * 2;
#pragma unroll
            for (int r = 0; r < 4; ++r) acc[r] += qs[r * 64 + d] * k0 + qs[r * 64 + d + 1] * k1; } }
}
__device__ __forceinline__ void p4_attn_naive(const Frame& F) {
    const bf16_t* PROJ = (const bf16_t*)(F.ws + WS_PROJ); const bf16_t* KC = (const bf16_t*)(F.ws + WS_KC); const bf16_t* VC = (const bf16_t*)(F.ws + WS_VC);
    bf16_t* OATT = (bf16_t*)(F.ws + WS_OATT); const float* rel = F.in[21];
    LAS float* wl = (LAS float*)F.lds + F.wave * (256 + 512 + 2048 + 16);
    LAS float* qs = wl; LAS float* pc = wl + 256; LAS float* ps = wl + 768; LAS int* pbase = (LAS int*)(wl + 768 + 2048);
    const int gw = blockIdx.x * NWAVES + F.wave, nw = F.G * NWAVES, lane = F.lane;
    for (int u = gw; u < T * 2; u += nw) {
        const int g = u & 1, tok = u >> 1, b = tok / S, t = tok % S;
        const bf16_t* prow = PROJ + (size_t)tok * NPAD;
#pragma unroll
        for (int r = 0; r < 4; ++r) qs[r * 64 + lane] = bf2f(prow[C_Q + (g * 4 + r) * 64 + lane]) * 0.125f;
        lds_wave_sync();
        const int nv = t >= 31 ? ((t - 31) >> 4) + 1 : 0;
        float sc[2][4]; bool va[2];
#pragma unroll
        for (int i = 0; i < 2; ++i) { const int n = lane + 64 * i; va[i] = n < nv; float a[4] = {0.f, 0.f, 0.f, 0.f};
            if (va[i]) { dot4_row(KC + ((size_t)(b * 2 + g) * 128 + n) * 64, qs, a); const int bk = rel_bucket(t - (16 * n + 31));
#pragma unroll
                for (int r = 0; r < 4; ++r) a[r] += rel[bk * 8 + g * 4 + r]; }
#pragma unroll
            for (int r = 0; r < 4; ++r) sc[i][r] = va[i] ? a[r] : -1e30f; }
        float ocmp[4];
#pragma unroll
        for (int r = 0; r < 4; ++r) { const float m = wave_max(fmaxf(sc[0][r], sc[1][r]));
            const float e0 = va[0] ? __expf(sc[0][r] - m) : 0.f, e1 = va[1] ? __expf(sc[1][r] - m) : 0.f; const float sum = wave_sum(e0 + e1);
            const float inv = nv > 0 ? 1.0f / sum : 0.f; pc[r * 128 + lane] = e0 * inv; pc[r * 128 + 64 + lane] = e1 * inv; }
        lds_wave_sync();
        { float o[4] = {0.f, 0.f, 0.f, 0.f}; const bf16_t* vb = VC + ((size_t)(b * 2 + g) * 128) * 64 + lane;
            for (int n = 0; n < nv; ++n) { const float v = bf2f(vb[n * 64]);
#pragma unroll
                for (int r = 0; r < 4; ++r) o[r] += pc[r * 128 + n] * v; }
#pragma unroll
            for (int r = 0; r < 4; ++r) ocmp[r] = o[r]; }
        const int cur = t >> 6; float val;
        { const int j = lane & 31; float imp = 0.f;
#pragma unroll
            for (int r = 0; r < 4; ++r) for (int n = 4 * j - 1; n <= 4 * j + 3; ++n) if (n >= 0 && n < NCMP) imp += pc[r * 128 + n];
            const bool forced = (j == 0) || (j == cur) || (j == cur - 1); const bool allowed = j <= cur;
            val = forced ? 1e4f : (allowed ? imp : -INFINITY); }
        int rank = 0;
        for (int jp = 0; jp < 32; ++jp) { const float vp = __shfl(val, jp); rank += ((vp > val) || (vp == val && jp < (lane & 31))) ? 1 : 0; }
        unsigned selmask = (unsigned)(__ballot(lane < 32 && rank < 8) & 0xFFFFFFFFull);
        float oslc[4], owin[4];
#pragma unroll
        for (int br = 0; br < 2; ++br) {
            const int ck = br == 0 ? C_KS : C_KW, cv = br == 0 ? C_VS : C_VW;
            unsigned mk = selmask;
#pragma unroll 1
            for (int c = 0; c < 8; ++c) {
                int kpos, bs;
                if (br == 0) { const int j = __builtin_ctz(mk | 0x80000000u); mk &= mk - 1; bs = 64 * j; } else { bs = t - 511 + 64 * c; }
                kpos = bs + lane; if (lane == 0) pbase[c] = bs;
                const int dist = t - kpos; const bool vv = (dist >= 0) && (kpos >= 0) && (kpos < S);
                float a[4] = {0.f, 0.f, 0.f, 0.f};
                if (vv) { dot4_row(PROJ + (size_t)(b * S + kpos) * NPAD + ck + g * 64, qs, a); const int bk = rel_bucket(dist);
#pragma unroll
                    for (int r = 0; r < 4; ++r) a[r] += rel[bk * 8 + g * 4 + r]; }
#pragma unroll
                for (int r = 0; r < 4; ++r) ps[r * 512 + c * 64 + lane] = vv ? a[r] : -1e30f;
            }
            lds_wave_sync();
#pragma unroll 1
            for (int r = 0; r < 4; ++r) { float m = -1e30f;
#pragma unroll
                for (int c = 0; c < 8; ++c) m = fmaxf(m, ps[r * 512 + c * 64 + lane]);
                m = wave_max(m); float e[8], sum = 0.f;
#pragma unroll
                for (int c = 0; c < 8; ++c) { const float sv = ps[r * 512 + c * 64 + lane]; e[c] = sv > -1e29f ? __expf(sv - m) : 0.f; sum += e[c]; }
                sum = wave_sum(sum); const float inv = sum > 0.f ? 1.0f / sum : 0.f;
#pragma unroll
                for (int c = 0; c < 8; ++c) ps[r * 512 + c * 64 + lane] = e[c] * inv; }
            lds_wave_sync();
            float o[4] = {0.f, 0.f, 0.f, 0.f};
#pragma unroll 1
            for (int c = 0; c < 8; ++c) {
                const int bsc = pbase[c];
                for (int kk = 0; kk < 64; ++kk) { const int kpos = bsc + kk; if (kpos < 0 || kpos > t) continue;
                    const float v = bf2f(PROJ[(size_t)(b * S + kpos) * NPAD + cv + g * 64 + lane]);
#pragma unroll
                    for (int r = 0; r < 4; ++r) o[r] += ps[r * 512 + c * 64 + kk] * v; } }
            lds_wave_sync();
#pragma unroll
            for (int r = 0; r < 4; ++r) { if (br == 0) oslc[r] = o[r]; else owin[r] = o[r]; }
        }
#pragma unroll
        for (int r = 0; r < 4; ++r) { const int h = g * 4 + r;
            const float g0 = sigmoidf_(bf2f(prow[C_GT + h * 3 + 0])), g1 = sigmoidf_(bf2f(prow[C_GT + h * 3 + 1])), g2 = sigmoidf_(bf2f(prow[C_GT + h * 3 + 2]));
            OATT[(size_t)tok * 512 + h * 64 + lane] = f2bf(g0 * ocmp[r] + g1 * oslc[r] + g2 * owin[r]); }
    }
}


constexpr float LOG2E = 1.4426950408889634f;
constexpr int AT_KC = 0, AT_VC = 16384, AT_KV = 32768  , AT_BTAB = 65536, AT_IMP = 69888, AT_SEL = 78336, AT_OUT = 78592  , AT_END = 78592 + 65536;
constexpr int BT_STRIDE = 132;
__device__ __forceinline__ int tile_off(int row, int chunk) { return row * 128 + ((chunk ^ (row & 7)) << 4); }
__device__ __forceinline__ bf16x8 mk_frag(unsigned a, unsigned b, unsigned c, unsigned d) { u32x4v v = {a, b, c, d}; return __builtin_bit_cast(bf16x8, v); }
struct LaneOffs { int koff[2]; int voff[4]; int soff; };
__device__ __forceinline__ LaneOffs lane_offs(int lane, int tid) {
    LaneOffs L; const int grp = lane >> 4, rowi = lane & 15, q4 = rowi >> 2, p = lane & 3;
#pragma unroll
    for (int ks = 0; ks < 2; ++ks) L.koff[ks] = tile_off(rowi, ks * 4 + grp);
#pragma unroll
    for (int dt = 0; dt < 4; ++dt) L.voff[dt] = tile_off(4 * grp + q4, 2 * dt + (p >> 1)) + 8 * (p & 1);
    L.soff = tile_off(tid >> 3, tid & 7); return L;
}
__device__ __forceinline__ bf16x8 vfrag_read(const LAS unsigned char* vt, int voff_dt, int row0) {
    const s16x4 a = __builtin_amdgcn_ds_read_tr16_b64_v4i16((LAS s16x4*)(vt + voff_dt + row0 * 128));
    const s16x4 b = __builtin_amdgcn_ds_read_tr16_b64_v4i16((LAS s16x4*)(vt + voff_dt + row0 * 128 + 2048));
    bf16x8 f = {a[0], a[1], a[2], a[3], b[0], b[1], b[2], b[3]}; return f;
}


struct AttnState {
    f32x4 o[4][2]; float m[2], l[2];
};

template <int BR>
__device__ __forceinline__ void attn_tile(const LAS unsigned char* kt_lds, const LAS unsigned char* vt_lds, const LAS float* btab_h, const bf16x8 (&qf)[2][2], const int (&tq)[2], const unsigned (&sel)[2],
                                          int j, bool near, AttnState& st, int lane, const LaneOffs& L, LAS unsigned char* F_lds_) {
    const int grp = lane >> 4, kbase = 64 * j;
#if defined(PROBE_STAMP) && PROBE_LEVEL >= 2
    STAMP_DECL; STAMP_START();
#define TSTAMP(k) STAMP(k)
#else
#define TSTAMP(k) do {} while (0)
#endif
    f32x4 sacc[4][2];
#pragma unroll
    for (int kt = 0; kt < 4; ++kt) { sacc[kt][0] = (f32x4){0.f, 0.f, 0.f, 0.f}; sacc[kt][1] = (f32x4){0.f, 0.f, 0.f, 0.f}; }
#pragma unroll
    for (int kt = 0; kt < 4; ++kt)
#pragma unroll
        for (int ks = 0; ks < 2; ++ks) { const bf16x8 kf = *(const LAS bf16x8*)(kt_lds + L.koff[ks] + kt * 2048);
            sacc[kt][0] = __builtin_amdgcn_mfma_f32_16x16x32_bf16(kf, qf[0][ks], sacc[kt][0], 0, 0, 0);
            sacc[kt][1] = __builtin_amdgcn_mfma_f32_16x16x32_bf16(kf, qf[1][ks], sacc[kt][1], 0, 0, 0); }
    __builtin_amdgcn_sched_barrier(0);
    TSTAMP(0);
    const float SC = 0.125f * LOG2E; const float bfar = btab_h[128];
    bf16x8 pf[2][2];
    const int cur_blk = tq[0] >> 6;
    const bool full = BR == 0 ? (j == cur_blk) : (j == cur_blk || j + 8 == cur_blk);
    const bool fast = !near && !full;
#pragma unroll
    for (int qt = 0; qt < 2; ++qt) {
        const int t = tq[qt]; const bool selq = BR == 0 ? ((sel[qt] >> j) & 1u) != 0u : true;
        float sv[4][4]; float tmax;
        if (fast) {
            float r0 = fmaxf(fmaxf(sacc[0][qt][0], sacc[0][qt][1]), fmaxf(sacc[0][qt][2], sacc[0][qt][3]));
#pragma unroll
            for (int kt = 1; kt < 4; ++kt) r0 = fmaxf(r0, fmaxf(fmaxf(sacc[kt][qt][0], sacc[kt][qt][1]), fmaxf(sacc[kt][qt][2], sacc[kt][qt][3])));
            tmax = selq ? r0 * SC + bfar : -1e30f;
        } else {
            tmax = -1e30f;
            int d0 = t - 4 * grp - kbase; asm volatile("" : "+v"(d0));
            if (near) {
#pragma unroll
                for (int kt = 0; kt < 4; ++kt)
#pragma unroll
                    for (int rg = 0; rg < 4; ++rg) { const int dist = d0 - (kt * 16 + rg); const int dd = dist < 0 ? 0 : (dist > 128 ? 128 : dist); sv[kt][rg] = btab_h[dd]; }
            } else {
#pragma unroll
                for (int kt = 0; kt < 4; ++kt)
#pragma unroll
                    for (int rg = 0; rg < 4; ++rg) sv[kt][rg] = bfar;
            }
#pragma unroll
            for (int kt = 0; kt < 4; ++kt)
#pragma unroll
                for (int rg = 0; rg < 4; ++rg) { const int c = kt * 16 + rg;
                    const bool valid = BR == 0 ? (selq && d0 >= c) : (d0 >= c && d0 < 512 + c);
                    const float sx = sacc[kt][qt][rg] * SC + sv[kt][rg]; const float s = valid ? sx : -1e30f; sv[kt][rg] = s; tmax = fmaxf(tmax, s); }
        }
        tmax = fmaxf(tmax, __shfl_xor(tmax, 16)); tmax = fmaxf(tmax, __shfl_xor(tmax, 32));
        const float mnew = fmaxf(st.m[qt], tmax); const float alpha = __builtin_amdgcn_exp2f(st.m[qt] - mnew); st.m[qt] = mnew;
        const float muse = mnew < -1e29f ? 0.f : mnew;
        float ev[4][4];
        if (fast) { const float c0 = selq ? bfar - muse : -1e30f;
#pragma unroll
            for (int kt = 0; kt < 4; ++kt)
#pragma unroll
                for (int rg = 0; rg < 4; ++rg) ev[kt][rg] = __builtin_amdgcn_exp2f(sacc[kt][qt][rg] * SC + c0);
        } else {
#pragma unroll
            for (int kt = 0; kt < 4; ++kt)
#pragma unroll
                for (int rg = 0; rg < 4; ++rg) ev[kt][rg] = __builtin_amdgcn_exp2f(sv[kt][rg] - muse);
        }
        float ls = 0.f; unsigned pk[4][2];
#pragma unroll
        for (int kt = 0; kt < 4; ++kt) { ls += (ev[kt][0] + ev[kt][1]) + (ev[kt][2] + ev[kt][3]);
            pk[kt][0] = pg8::cvt_pk_bf16(ev[kt][0], ev[kt][1]); pk[kt][1] = pg8::cvt_pk_bf16(ev[kt][2], ev[kt][3]); }
        st.l[qt] = st.l[qt] * alpha + ls;
        if (!__all(alpha == 1.0f)) {
#pragma unroll
            for (int dt = 0; dt < 4; ++dt) st.o[dt][qt] *= alpha; }
        pf[qt][0] = mk_frag(pk[0][0], pk[0][1], pk[1][0], pk[1][1]); pf[qt][1] = mk_frag(pk[2][0], pk[2][1], pk[3][0], pk[3][1]);
        __builtin_amdgcn_sched_barrier(0);
    }
    TSTAMP(1);
#pragma unroll
    for (int ks = 0; ks < 2; ++ks)
#pragma unroll
        for (int dt = 0; dt < 4; ++dt) { const bf16x8 vf = vfrag_read(vt_lds, L.voff[dt], 32 * ks);
            st.o[dt][0] = __builtin_amdgcn_mfma_f32_16x16x32_bf16(vf, pf[0][ks], st.o[dt][0], 0, 0, 0);
            st.o[dt][1] = __builtin_amdgcn_mfma_f32_16x16x32_bf16(vf, pf[1][ks], st.o[dt][1], 0, 0, 0); }
    TSTAMP(2);
#undef TSTAMP
}

template <int BR>
__device__ __forceinline__ void attn_branch(const Frame& F, const bf16_t* PROJ, int b, int g, int t0, unsigned tiles  , const LAS float* btab_h,
                                            const bf16x8 (&qf)[2][2], const int (&tq)[2], const unsigned (&sel)[2], const float (&gate)[2], const LaneOffs& L) {
    const int lane = F.lane, tid = F.tid;
    const int ck = (BR == 0 ? C_KS : C_KW) + g * 64, cv = (BR == 0 ? C_VS : C_VW) + g * 64;
    const int srow = tid >> 3, sch = tid & 7;
    LAS unsigned char* F_lds_ = F.lds; STAMP_DECL; STAMP_START();
    AttnState st;
#pragma unroll
    for (int dt = 0; dt < 4; ++dt) { st.o[dt][0] = (f32x4){0.f, 0.f, 0.f, 0.f}; st.o[dt][1] = (f32x4){0.f, 0.f, 0.f, 0.f}; }
    st.m[0] = st.m[1] = -1e30f; st.l[0] = st.l[1] = 0.f;
    unsigned rem = tiles; int cur = 0;
#ifdef PROBE_SHALLOW
    u32x4v rk0, rv0;
#else
    u32x4v rk0, rv0, rk1, rv1;
#endif
    const bf16_t* srcb = PROJ + (size_t)(b * S + srow) * NPAD + sch * 8;
#define AT_LOAD(RK, RV, jj) do { const bf16_t* rowp = srcb + (size_t)(64 * (jj)) * NPAD; RK = *(const u32x4v*)(rowp + ck); RV = *(const u32x4v*)(rowp + cv); } while (0)
#define AT_WRITE(RK, RV, bufi) do { *(LAS u32x4v*)(F.lds + AT_KV + (bufi) * 16384 + L.soff) = RK; *(LAS u32x4v*)(F.lds + AT_KV + (bufi) * 16384 + 8192 + L.soff) = RV; } while (0)
#define AT_COMPUTE(jj) do { STAMP_COUNT(4); const bool near = (t0 + 8 * F.wave) - (64 * (jj) + 63) < 128; \
        attn_tile<BR>(F.lds + AT_KV + cur * 16384, F.lds + AT_KV + cur * 16384 + 8192, btab_h, qf, tq, sel, (jj), near, st, lane, L, F.lds); } while (0)
#ifdef PROBE_SHALLOW
    { int j = __builtin_ctz(rem); rem &= rem - 1;
      AT_LOAD(rk0, rv0, j); AT_WRITE(rk0, rv0, 0);
      __syncthreads();
      for (;;) {
          int jn = j; const bool hn = rem != 0u; if (hn) { jn = __builtin_ctz(rem); rem &= rem - 1; }
          AT_LOAD(rk0, rv0, jn);
          AT_COMPUTE(j);
          AT_WRITE(rk0, rv0, cur ^ 1);
          __syncthreads(); cur ^= 1;
          if (!hn) break;
          j = jn; } }
#else
    int j = __builtin_ctz(rem); rem &= rem - 1;
    AT_LOAD(rk0, rv0, j); AT_WRITE(rk0, rv0, 0);
    int j1 = j; bool h1 = rem != 0u; if (h1) { j1 = __builtin_ctz(rem); rem &= rem - 1; }
    AT_LOAD(rk0, rv0, j1);
    __syncthreads();
    for (;;) {
        int j2 = j1; bool h2 = rem != 0u; if (h2) { j2 = __builtin_ctz(rem); rem &= rem - 1; }
        AT_LOAD(rk1, rv1, j2);
        AT_COMPUTE(j);
        AT_WRITE(rk0, rv0, cur ^ 1);
        __syncthreads(); cur ^= 1;
        if (!h1) break;
        int j3 = j2; bool h3 = rem != 0u; if (h3) { j3 = __builtin_ctz(rem); rem &= rem - 1; }
        AT_LOAD(rk0, rv0, j3);
        AT_COMPUTE(j1);
        AT_WRITE(rk1, rv1, cur ^ 1);
        __syncthreads(); cur ^= 1;
        if (!h2) break;
        j = j2; j1 = j3; h1 = h3;
    }
#endif
    STAMP(5 + BR);
#undef AT_LOAD
#undef AT_WRITE
#undef AT_COMPUTE
    int pob = AT_OUT + tid * 4; asm volatile("" : "+v"(pob));
    LAS float* po = (LAS float*)(F.lds + pob);
#pragma unroll
    for (int qt = 0; qt < 2; ++qt) { float l = st.l[qt]; l += __shfl_xor(l, 16); l += __shfl_xor(l, 32); const float sc = l > 0.f ? gate[qt] / l : 0.f;
#pragma unroll
        for (int dt = 0; dt < 4; ++dt)
#pragma unroll
            for (int e = 0; e < 4; ++e) po[((qt * 4 + dt) * 4 + e) * 512] += st.o[dt][qt][e] * sc; }
}

template <int MODE>
__device__ __forceinline__ void p4_attn_mfma_t(const Frame& F) {
    const bf16_t* PROJ = (const bf16_t*)(F.ws + WS_PROJ); const bf16_t* KC = (const bf16_t*)(F.ws + WS_KC); const bf16_t* VC = (const bf16_t*)(F.ws + WS_VC);
    bf16_t* OATT = (bf16_t*)(F.ws + (MODE == 0 ? WS_OATT : WS_H)); const float* rel = F.in[21];
    const int lane = F.lane, tid = F.tid, wave = F.wave, grp = lane >> 4, col = lane & 15, qi = col >> 2, r = col & 3;
    LAS float* btab = (LAS float*)(F.lds + AT_BTAB); LAS float* impq = (LAS float*)(F.lds + AT_IMP); LAS unsigned* selm = (LAS unsigned*)(F.lds + AT_SEL);
    const LaneOffs L = lane_offs(lane, tid);
    for (int i = tid; i < 8 * 129; i += NTHREADS) { const int hh = i / 129, dd = i % 129; btab[hh * BT_STRIDE + dd] = rel[rel_bucket(dd) * 8 + hh] * LOG2E; }
    __syncthreads();
    LAS unsigned char* F_lds_ = F.lds; STAMP_DECL;
#ifdef PROBE_STAMP
    if (tid < 16) ((volatile LAS unsigned*)(F.lds + LDS_MISC_OFF + 128))[tid] = 0u;
    __syncthreads();
#endif
    STAMP_START();
    for (int uu = blockIdx.x; uu < 1024; uu += F.G) {
        int qb, bg;
        if (F.G == 256) { const int round = uu >> 8, k = uu & 255; const int a = k >> 5; bg = k & 31;
            qb = (a == 0) ? (round == 0 ? 25 : round == 1 ? 23 : round == 2 ? 17 : 0) : (a == 1) ? (round == 0 ? 27 : round == 1 ? 19 : round == 2 ? 18 : 1) : (a == 2) ? (round == 0 ? 31 : round == 1 ? 13 : round == 2 ? 12 : 5)
               : (a == 3) ? (round == 0 ? 26 : round == 1 ? 21 : round == 2 ? 15 : 2) : (a == 4) ? (round == 0 ? 30 : round == 1 ? 22 : round == 2 ? 8 : 3) : (a == 5) ? (round == 0 ? 28 : round == 1 ? 20 : round == 2 ? 9 : 4)
               : (a == 6) ? (round == 0 ? 29 : round == 1 ? 14 : round == 2 ? 10 : 6) : (round == 0 ? 24 : round == 1 ? 16 : round == 2 ? 11 : 7); }
        else { qb = 31 - (uu >> 5); bg = uu & 31; }
        const int b = bg >> 1, g = bg & 1, t0 = qb * 64, h = g * 4 + r;
        const LAS float* btab_h = btab + h * BT_STRIDE;
        int tq[2]; bf16x8 qf[2][2]; float gate[3][2];
#pragma unroll
        for (int qt = 0; qt < 2; ++qt) { tq[qt] = t0 + 8 * wave + 4 * qt + qi; const bf16_t* prow = PROJ + (size_t)(b * S + tq[qt]) * NPAD;
#pragma unroll
            for (int ks = 0; ks < 2; ++ks) qf[qt][ks] = *(const bf16x8*)(prow + C_Q + h * 64 + ks * 32 + 8 * grp);
#pragma unroll
            for (int jg = 0; jg < 3; ++jg) gate[jg][qt] = sigmoidf_(bf2f(prow[C_GT + h * 3 + jg])); }
#pragma unroll
        for (int i = 0; i < 2; ++i) { const int c2 = tid + 512 * i, row = c2 >> 3, ch = c2 & 7; const size_t src = ((size_t)(b * 2 + g) * 128 + row) * 64 + ch * 8;
            *(LAS u32x4v*)(F.lds + AT_KC + L.soff + 8192 * i) = *(const u32x4v*)(KC + src); *(LAS u32x4v*)(F.lds + AT_VC + L.soff + 8192 * i) = *(const u32x4v*)(VC + src); }
        __syncthreads();
#ifndef AT_SKIP_CMP
        {
            const int nvmax = t0 + 63 >= 31 ? ((t0 + 63 - 31) >> 4) + 1 : 0;
            const float SC = 0.125f * LOG2E; const int srcl = (lane + 48) & 63;
            int pob = AT_OUT + tid * 4; asm volatile("" : "+v"(pob));
            LAS float* po = (LAS float*)(F.lds + pob);
#pragma unroll
            for (int qt = 0; qt < 2; ++qt) {
                f32x4 sa[8];
#pragma unroll
                for (int kt = 0; kt < 8; ++kt) sa[kt] = (f32x4){0.f, 0.f, 0.f, 0.f};
#pragma unroll
                for (int kt = 0; kt < 8; ++kt) if (kt * 16 < nvmax) {
#pragma unroll
                    for (int ks = 0; ks < 2; ++ks) { const bf16x8 kf = *(const LAS bf16x8*)(F.lds + AT_KC + L.koff[ks] + kt * 2048);
                        sa[kt] = __builtin_amdgcn_mfma_f32_16x16x32_bf16(kf, qf[qt][ks], sa[kt], 0, 0, 0); } }
                __builtin_amdgcn_sched_barrier(0);
                int d0 = tq[qt] - 31 - 64 * grp; asm volatile("" : "+v"(d0));
                float mx = -1e30f;
#pragma unroll
                for (int kt = 0; kt < 8; ++kt)
#pragma unroll
                    for (int rg = 0; rg < 4; ++rg) { const int c = 256 * kt + 16 * rg; const int dist = d0 - c; const int dd = dist < 0 ? 0 : (dist > 128 ? 128 : dist);
                        const float sx = sa[kt][rg] * SC + btab_h[dd]; const float s = d0 >= c ? sx : -1e30f; sa[kt][rg] = s; mx = fmaxf(mx, s); }
                mx = fmaxf(mx, __shfl_xor(mx, 16)); mx = fmaxf(mx, __shfl_xor(mx, 32));
                float sum = 0.f;
#pragma unroll
                for (int kt = 0; kt < 8; ++kt)
#pragma unroll
                    for (int rg = 0; rg < 4; ++rg) { const int c = 256 * kt + 16 * rg; const float ex = __builtin_amdgcn_exp2f(sa[kt][rg] - mx); const float e = d0 >= c ? ex : 0.f; sa[kt][rg] = e; sum += e; }
                __builtin_amdgcn_sched_barrier(0);
                sum += __shfl_xor(sum, 16); sum += __shfl_xor(sum, 32);
                const float inv = sum > 0.f ? 1.0f / sum : 0.f;
                float prev3 = 0.f;
#pragma unroll
                for (int kt = 0; kt < 8; ++kt) { const float p3 = sa[kt][3] * inv; const float part = (sa[kt][0] * inv + sa[kt][1] * inv) + (sa[kt][2] * inv + p3);
                    const float xa = __shfl(p3, srcl), xb = __shfl(prev3, srcl); float tot = part + (grp >= 1 ? xa : xb);
                    tot += __shfl_xor(tot, 1); tot += __shfl_xor(tot, 2);
                    if (r == 0) impq[(8 * wave + 4 * qt + qi) * 33 + 4 * kt + grp] = tot;
                    prev3 = p3; }
                __builtin_amdgcn_sched_barrier(0);
                f32x4 oc[4];
#pragma unroll
                for (int dt = 0; dt < 4; ++dt) oc[dt] = (f32x4){0.f, 0.f, 0.f, 0.f};
#pragma unroll
                for (int ks = 0; ks < 4; ++ks) if (ks * 32 < nvmax) {
                    const bf16x8 pfr = mk_frag(pg8::cvt_pk_bf16(sa[2 * ks][0], sa[2 * ks][1]), pg8::cvt_pk_bf16(sa[2 * ks][2], sa[2 * ks][3]),
                                               pg8::cvt_pk_bf16(sa[2 * ks + 1][0], sa[2 * ks + 1][1]), pg8::cvt_pk_bf16(sa[2 * ks + 1][2], sa[2 * ks + 1][3]));
#pragma unroll
                    for (int dt = 0; dt < 4; ++dt) { const bf16x8 vf = vfrag_read(F.lds + AT_VC, L.voff[dt], 32 * ks); oc[dt] = __builtin_amdgcn_mfma_f32_16x16x32_bf16(vf, pfr, oc[dt], 0, 0, 0); } }
                const float scq = inv * gate[0][qt];
#pragma unroll
                for (int dt = 0; dt < 4; ++dt)
#pragma unroll
                    for (int e = 0; e < 4; ++e) po[((qt * 4 + dt) * 4 + e) * 512] = oc[dt][e] * scq;
                __builtin_amdgcn_sched_barrier(0);
            }
        }
#endif
        __syncthreads();
#ifndef AT_SKIP_SEL
        {
            const int q = tid >> 3, jj = tid & 7, cur = qb; unsigned bits = 0u;
            float vj[4];
#pragma unroll
            for (int e = 0; e < 4; ++e) { const int j = jj * 4 + e; const bool forced = (j == 0) || (j == cur) || (j == cur - 1); vj[e] = forced ? 1e4f : (j <= cur ? impq[q * 33 + j] : -INFINITY); }
            int rk[4] = {0, 0, 0, 0};
            for (int jp = 0; jp < 32; ++jp) { const bool forced = (jp == 0) || (jp == cur) || (jp == cur - 1); const float vp = forced ? 1e4f : (jp <= cur ? impq[q * 33 + jp] : -INFINITY);
#pragma unroll
                for (int e = 0; e < 4; ++e) rk[e] += ((vp > vj[e]) || (vp == vj[e] && jp < jj * 4 + e)) ? 1 : 0; }
#pragma unroll
            for (int e = 0; e < 4; ++e) bits |= (rk[e] < 8 ? 1u : 0u) << (jj * 4 + e);
            bits |= __shfl_xor(bits, 1); bits |= __shfl_xor(bits, 2); bits |= __shfl_xor(bits, 4);
            if (jj == 0) selm[q] = bits;
        }
#endif
        __syncthreads();
        unsigned sel[2] = {selm[8 * wave + qi], selm[8 * wave + 4 + qi]};
        unsigned un = selm[lane];
#pragma unroll
        for (int o = 32; o >= 1; o >>= 1) un |= __shfl_xor(un, o);
        un = __builtin_amdgcn_readfirstlane(un);
        const unsigned causal = qb == 31 ? 0xFFFFFFFFu : ((2u << qb) - 1u);
        if (MODE != 1 && MODE != 2) { const float gt1[2] = {gate[1][0], gate[1][1]}; attn_branch<0>(F, PROJ, b, g, t0, un & causal, btab_h, qf, tq, sel, gt1, L); }
        if (MODE != 2) { const int jlo = qb >= 8 ? qb - 8 : 0; const unsigned wmask = causal & ~((1u << jlo) - 1u); const float gt2[2] = {gate[2][0], gate[2][1]};
            attn_branch<1>(F, PROJ, b, g, t0, wmask, btab_h, qf, tq, sel, gt2, L); }
        int pob2 = AT_OUT + tid * 4; asm volatile("" : "+v"(pob2));
#pragma unroll
        for (int qt = 0; qt < 2; ++qt) { bf16_t* orow = OATT + (size_t)(b * S + tq[qt]) * 512 + h * 64 + 4 * grp;
#pragma unroll
            for (int dt = 0; dt < 4; ++dt) { const LAS float* po = (const LAS float*)(F.lds + pob2) + (qt * 4 + dt) * 4 * 512;
                *(uint2*)(orow + dt * 16) = make_uint2(pg8::cvt_pk_bf16(po[0], po[512]), pg8::cvt_pk_bf16(po[1024], po[1536])); } }
    }
    STAMP(7);
#ifdef PROBE_STAMP
    __syncthreads();
    if (PROBE_PHASE == 4 && MODE == 0 && blockIdx.x == PROBE_BLOCK && tid < 16) ((unsigned*)(F.ws + WS_CTL + 32768))[tid] = ((volatile LAS unsigned*)(F.lds + LDS_MISC_OFF + 128))[tid];
#endif
}

__device__ __forceinline__ void p5_mixed(const Frame& F) {
    const bf16_t* PROJ = (const bf16_t*)(F.ws + WS_PROJ); const bf16_t* OATT = (const bf16_t*)(F.ws + WS_OATT); bf16_t* MIX = (bf16_t*)(F.ws + WS_H);
    const float* cw = F.in[13]; const float* ga = F.in[14]; const float* gc = F.in[15];
    const int gw = blockIdx.x * NWAVES + F.wave, nw = F.G * NWAVES, lane = F.lane, c0 = lane * 8;
    float w0[8], w1[8], w2[8], gav[8], gcv[8];
#pragma unroll
    for (int e = 0; e < 8; ++e) { w0[e] = cw[c0 + e]; w1[e] = cw[512 + c0 + e]; w2[e] = cw[1024 + c0 + e]; gav[e] = ga[c0 + e]; gcv[e] = gc[c0 + e]; }
    for (int chunk = gw; chunk < T / 16; chunk += nw) {
        const int t0 = chunk * 16, s0 = t0 % S;
        float z1[8], z2[8];
#pragma unroll
        for (int e = 0; e < 8; ++e) { z1[e] = 0.f; z2[e] = 0.f; }
        if (s0 > 0) {
#pragma unroll
            for (int back = 1; back <= 2; ++back) { const bf16_t* row = PROJ + (size_t)(t0 - back) * NPAD;
                const u32x4v wc = *(const u32x4v*)(row + C_CC + c0), wh = *(const u32x4v*)(row + C_CH + c0);
#pragma unroll
                for (int e = 0; e < 4; ++e) { const float a = bflo(wc[e]) * bflo(wh[e]), bq = bfhi(wc[e]) * bfhi(wh[e]); if (back == 1) { z1[2 * e] = a; z1[2 * e + 1] = bq; } else { z2[2 * e] = a; z2[2 * e + 1] = bq; } } } }
        u32x4v na, nc, nh, nb;
        { const bf16_t* row = PROJ + (size_t)t0 * NPAD; na = *(const u32x4v*)(OATT + (size_t)t0 * 512 + c0); nc = *(const u32x4v*)(row + C_CC + c0); nh = *(const u32x4v*)(row + C_CH + c0); nb = *(const u32x4v*)(row + C_CB + c0); }
#pragma unroll 1
        for (int i = 0; i < 16; ++i) { const int tok = t0 + i;
            const u32x4v wa = na, wc = nc, wh = nh, wb = nb;
            { const int tn = i < 15 ? tok + 1 : tok; const bf16_t* row = PROJ + (size_t)tn * NPAD;
                na = *(const u32x4v*)(OATT + (size_t)tn * 512 + c0); nc = *(const u32x4v*)(row + C_CC + c0); nh = *(const u32x4v*)(row + C_CH + c0); nb = *(const u32x4v*)(row + C_CB + c0); }
            float a[8], y[8], z0[8];
#pragma unroll
            for (int e = 0; e < 4; ++e) { a[2 * e] = bflo(wa[e]); a[2 * e + 1] = bfhi(wa[e]); z0[2 * e] = bflo(wc[e]) * bflo(wh[e]); z0[2 * e + 1] = bfhi(wc[e]) * bfhi(wh[e]); }
#pragma unroll
            for (int e = 0; e < 8; ++e) y[e] = w0[e] * z2[e] + w1[e] * z1[e] + w2[e] * z0[e];
#pragma unroll
            for (int e = 0; e < 4; ++e) { y[2 * e] *= bflo(wb[e]); y[2 * e + 1] *= bfhi(wb[e]); }
            float sa = 0.f, sy = 0.f;
#pragma unroll
            for (int e = 0; e < 8; ++e) { sa += a[e] * a[e]; sy += y[e] * y[e]; }
            sa = wave_sum(sa); sy = wave_sum(sy);
            const float ra = rsqrtf(sa * (1.0f / 512) + EPS), ry = rsqrtf(sy * (1.0f / 512) + EPS);
            unsigned oa[4], oy[4];
#pragma unroll
            for (int e = 0; e < 4; ++e) { oa[e] = pack2(a[2 * e] * ra * gav[2 * e], a[2 * e + 1] * ra * gav[2 * e + 1]); oy[e] = pack2(y[2 * e] * ry * gcv[2 * e], y[2 * e + 1] * ry * gcv[2 * e + 1]); }
            *(uint4*)(MIX + (size_t)tok * D + c0) = make_uint4(oa[0], oa[1], oa[2], oa[3]);
            *(uint4*)(MIX + (size_t)tok * D + 512 + c0) = make_uint4(oy[0], oy[1], oy[2], oy[3]);
#pragma unroll
            for (int e = 0; e < 8; ++e) { z2[e] = z1[e]; z1[e] = z0[e]; }
        }
    }
}

struct EpiResGate {
    static constexpr bool PERM = false, AFTER_DRAIN = false;
    float* C; const float* X; const float* MOD; int gate_off;
    __device__ __forceinline__ void operator()(const pg8::f32x4 (&acc)[2][2][4][2], const pg8::Unit& u, int wr, int wc, int fr, int fq) const {
        using pg8::f32x4; using pg8::HALF; using pg8::BM;
        const int row0 = u.pm * BM + wr * 64 + fr, col0 = u.pn * BM + wc * 32 + 4 * fq;
        const int b = (u.pm * BM) / S;
        f32x4 gv[2][2];
#pragma unroll
        for (int bj = 0; bj < 2; ++bj)
#pragma unroll
            for (int n = 0; n < 2; ++n) gv[bj][n] = *(const f32x4*)(MOD + b * 6144 + gate_off + col0 + bj * HALF + n * 16);
#pragma unroll
        for (int ai = 0; ai < 2; ++ai)
#pragma unroll
            for (int m = 0; m < 4; ++m) { const size_t ro = (size_t)(row0 + ai * HALF + m * 16) * D + col0;
#pragma unroll
                for (int bj = 0; bj < 2; ++bj)
#pragma unroll
                    for (int n = 0; n < 2; ++n) { const f32x4 xv = *(const f32x4*)(X + ro + bj * HALF + n * 16); *(f32x4*)(C + ro + bj * HALF + n * 16) = xv + gv[bj][n] * acc[ai][bj][m][n]; } }
    }
};

__device__ __forceinline__ int ord_i(float f) { const int u = __float_as_int(f); return u >= 0 ? u : (u ^ 0x7FFFFFFF); }
__device__ __forceinline__ float unord_f(int i) { const int u = i >= 0 ? i : (i ^ 0x7FFFFFFF); return __int_as_float(u); }
#define INT_MIN_ (-2147483647 - 1)
struct CandTab { int a[50], b[50]; };
constexpr CandTab make_cand() { CandTab t{}; int n = 0; for (int a = 0; a < 16; ++a) for (int b = 0; b < 16; ++b) if ((a + 1) * (b + 1) <= 16) { t.a[n] = a; t.b[n] = b; ++n; } return t; }
constexpr CandTab CAND = make_cand();

template <int N, bool DESC> __device__ __forceinline__ void bitonic_sort_i(int (&v)[N]) {
#pragma unroll
    for (int k = 2; k <= N; k <<= 1)
#pragma unroll
        for (int j = k >> 1; j > 0; j >>= 1)
#pragma unroll
            for (int i = 0; i < N; ++i) { const int l = i ^ j; if (l > i) { const bool up = ((i & k) == 0) != DESC; const int lo = min(v[i], v[l]), hi = max(v[i], v[l]); v[i] = up ? lo : hi; v[l] = up ? hi : lo; } }
}
template <int N, bool DESC> __device__ __forceinline__ void bitonic_merge_i(int (&v)[N]) {
#pragma unroll
    for (int j = N >> 1; j > 0; j >>= 1)
#pragma unroll
        for (int i = 0; i < N; ++i) { const int l = i ^ j; if (l > i) { const int lo = min(v[i], v[l]), hi = max(v[i], v[l]); v[i] = DESC ? hi : lo; v[l] = DESC ? lo : hi; } }
}
__device__ __forceinline__ void merge_top16_across(int (&t)[16]) {
#pragma unroll
    for (int m = 16; m <= 32; m <<= 1) { int y[16];
#pragma unroll
        for (int i = 0; i < 16; ++i) y[i] = max(t[i], __shfl_xor(t[15 - i], m));
        bitonic_merge_i<16, true>(y);
#pragma unroll
        for (int i = 0; i < 16; ++i) t[i] = y[i]; }
}
constexpr int RT2_KEYS = 0  , RT2_ITAB = 65536  ;
__device__ __forceinline__ void p9_route_sort(const Frame& F) {
    const bf16_t* QP = (const bf16_t*)(F.ws + WS_QP); const bf16_t* KEYS = (const bf16_t*)(F.ws + WS_KEYS);
    unsigned short* E16 = (unsigned short*)(F.ws + WS_E16); float* EW = (float*)(F.ws + WS_EW);
    const int lane = F.lane, tid = F.tid, grp = lane >> 4, col = lane & 15;
    const LaneOffs L = lane_offs(lane, tid);
    LAS int* itab = (LAS int*)(F.lds + RT2_ITAB + F.wave * 2048) + col * 32;
    const bool g1 = grp == 1, g2 = grp == 2, g3 = grp == 3;
    for (int tile = blockIdx.x * NWAVES + F.wave; tile < T / 16; tile += F.G * NWAVES) {
        const int tok = tile * 16 + col;
        {
#pragma unroll
            for (int i = 0; i < 4; ++i) { const int q = tid + 512 * i; *(LAS u32x4v*)(F.lds + RT2_KEYS + tile_off(q >> 3, q & 7)) = *(const u32x4v*)(KEYS + (size_t)q * 8); } }
        bf16x8 qf[2][2];
#pragma unroll
        for (int p = 0; p < 2; ++p)
#pragma unroll
            for (int ks = 0; ks < 2; ++ks) qf[p][ks] = *(const bf16x8*)(QP + (size_t)tok * D + p * 64 + ks * 32 + 8 * grp);
        __syncthreads();
#pragma unroll 1
        for (int h = 0; h < 8; ++h) {
            const int kb = RT2_KEYS + (h & 1) * 32768;
            u32x4v stg[4]; bf16x8 qn[2][2];
            if (h < 7) {
#pragma unroll
                for (int i = 0; i < 4; ++i) { const int q = tid + 512 * i; stg[i] = *(const u32x4v*)(KEYS + (size_t)(h + 1) * 16384 + (size_t)q * 8); }
#pragma unroll
                for (int p = 0; p < 2; ++p)
#pragma unroll
                    for (int ks = 0; ks < 2; ++ks) qn[p][ks] = *(const bf16x8*)(QP + (size_t)tok * D + (h + 1) * 128 + p * 64 + ks * 32 + 8 * grp);
            }
            int lst[2][16];
#pragma unroll
            for (int p = 0; p < 2; ++p) {
                f32x4 sc[8];
#pragma unroll
                for (int kt = 0; kt < 8; ++kt) { sc[kt] = (f32x4){0.f, 0.f, 0.f, 0.f};
#pragma unroll
                    for (int ks = 0; ks < 2; ++ks) { const bf16x8 kf = *(const LAS bf16x8*)(F.lds + kb + p * 16384 + L.koff[ks] + kt * 2048);
                        sc[kt] = __builtin_amdgcn_mfma_f32_16x16x32_bf16(kf, qf[p][ks], sc[kt], 0, 0, 0); } }
                int ra[16], rb[16];
#pragma unroll
                for (int kt = 0; kt < 4; ++kt)
#pragma unroll
                    for (int rg = 0; rg < 4; ++rg) { ra[kt * 4 + rg] = (ord_i(sc[kt][rg]) & ~0x7F) | (127 - (kt * 16 + 4 * grp + rg)); rb[kt * 4 + rg] = (ord_i(sc[kt + 4][rg]) & ~0x7F) | (127 - ((kt + 4) * 16 + 4 * grp + rg)); }
                bitonic_sort_i<16, true>(ra); bitonic_sort_i<16, false>(rb);
#pragma unroll
                for (int i = 0; i < 16; ++i) ra[i] = max(ra[i], rb[i]);
                bitonic_merge_i<16, true>(ra);
                merge_top16_across(ra);
#pragma unroll
                for (int i = 0; i < 16; ++i) lst[p][i] = ra[i];
                if (grp == 0) {
#pragma unroll
                    for (int it = 0; it < 16; ++it) itab[p * 16 + it] = 127 - (ra[it] & 0x7F);
                }
            }
            float v0[16], v1[16];
#pragma unroll
            for (int i = 0; i < 16; ++i) { v0[i] = unord_f(lst[0][i] & ~0x7F); v1[i] = unord_f(lst[1][i] & ~0x7F); }
            int ck[16];
#pragma unroll
            for (int i = 0; i < 13; ++i) {
                constexpr int NC = 50;
                const int k0 = 4 * i, k1 = 4 * i + 1 < NC ? 4 * i + 1 : NC - 1, k2 = 4 * i + 2 < NC ? 4 * i + 2 : NC - 1, k3 = 4 * i + 3 < NC ? 4 * i + 3 : NC - 1;
                float va = v0[CAND.a[k0]], vb = v1[CAND.b[k0]]; int fl = 255 - (CAND.a[k0] * 16 + CAND.b[k0]);
                va = g1 ? v0[CAND.a[k1]] : va; vb = g1 ? v1[CAND.b[k1]] : vb; fl = g1 ? 255 - (CAND.a[k1] * 16 + CAND.b[k1]) : fl;
                va = g2 ? v0[CAND.a[k2]] : va; vb = g2 ? v1[CAND.b[k2]] : vb; fl = g2 ? 255 - (CAND.a[k2] * 16 + CAND.b[k2]) : fl;
                va = g3 ? v0[CAND.a[k3]] : va; vb = g3 ? v1[CAND.b[k3]] : vb; fl = g3 ? 255 - (CAND.a[k3] * 16 + CAND.b[k3]) : fl;
                int key = (ord_i(va + vb) & ~0xFF) | fl;
                if (4 * i + 1 >= NC) key = g1 ? INT_MIN_ : key;
                if (4 * i + 2 >= NC) key = g2 ? INT_MIN_ : key;
                if (4 * i + 3 >= NC) key = g3 ? INT_MIN_ : key;
                ck[i] = key; }
            ck[13] = INT_MIN_; ck[14] = INT_MIN_; ck[15] = INT_MIN_;
            bitonic_sort_i<16, true>(ck);
            merge_top16_across(ck);
            lds_wave_sync();
            const float smax = unord_f(ck[0] & ~0xFF);
            float ex[16], sum = 0.f;
#pragma unroll
            for (int it = 0; it < 16; ++it) { ex[it] = __expf(unord_f(ck[it] & ~0xFF) - smax); sum += ex[it]; }
            const float inv = 1.0f / sum;
            if (grp == 0) {
#pragma unroll
                for (int it = 0; it < 16; ++it) { const int flat = 255 - (ck[it] & 0xFF); const int i1 = itab[flat >> 4], i2 = itab[16 + (flat & 15)];
                    E16[(size_t)tok * 128 + h * 16 + it] = (unsigned short)(i1 * 128 + i2); EW[(size_t)tok * 128 + h * 16 + it] = ex[it] * inv; }
            }
            lds_wave_sync();
            if (h < 7) {
                const int kn = RT2_KEYS + ((h + 1) & 1) * 32768;
#pragma unroll
                for (int i = 0; i < 4; ++i) { const int q = tid + 512 * i; *(LAS u32x4v*)(F.lds + kn + tile_off(q >> 3, q & 7)) = stg[i]; }
#pragma unroll
                for (int p = 0; p < 2; ++p)
#pragma unroll
                    for (int ks = 0; ks < 2; ++ks) qf[p][ks] = qn[p][ks];
            }
            __syncthreads();
        }
    }
}

constexpr int N_PHASES = 14;
struct Args { const float* in[23]; float* out; unsigned char* ws; int ph_lo, ph_hi; };
__global__ void __launch_bounds__(NTHREADS, 2) fwd(Args args) {
    extern __shared__ __attribute__((aligned(16))) unsigned char lds_raw[];
    Frame F;
#pragma unroll
    for (int i = 0; i < 23; ++i) F.in[i] = args.in[i];
    F.out = args.out; F.ws = args.ws; F.lds = (LAS unsigned char*)lds_raw;
    F.tid = threadIdx.x; F.lane = F.tid & 63; F.wave = __builtin_amdgcn_readfirstlane(F.tid >> 6); F.G = gridDim.x;
    volatile LAS unsigned* misc = (volatile LAS unsigned*)(F.lds + LDS_MISC_OFF);
    if (F.tid < 64) misc[F.tid] = 0u;
    __syncthreads();
    XcdBarrier bar; bar.bar = (unsigned*)(F.ws + WS_CTL); bar.x = 0; bar.st = misc;
    const int lo = args.ph_lo, hi = args.ph_hi;
    if (hi - lo > 1) bar = xcd_barrier_post((unsigned*)(F.ws + WS_CTL), misc);
#ifndef PH_MASK
#define PH_MASK 0xFFFF
#endif
#define IN(k) (((PH_MASK >> (k)) & 1) && lo <= (k) && (k) < hi)
#define SEAM(k) do { if (IN(k) && IN((k) + 1)) xcd_barrier(bar); } while (0)
    const float* MOD = (const float*)(F.ws + WS_MOD);
    if (IN(0)) { p0_prologue(F, 0, 96); } SEAM(0);
    if (IN(1)) { p0_prologue(F, 96, 1 << 30); norm_mod_rows(F, F.in[0], F.in[2], 0, 1024, (bf16_t*)(F.ws + WS_H)); } SEAM(1);
    if (IN(2)) { pg8::Gemm g{(const pg8::bf16_t*)(F.ws + WS_H), (const pg8::bf16_t*)(F.ws + WS_WIN), T, NPAD, D}; pg8::StaticOrder So; So.init(T, NPAD, F.G, (int)blockIdx.x);
        pg8::EpiBf16<0> E{(pg8::bf16_t*)(F.ws + WS_PROJ), NPAD, nullptr, 0, 0};
        pg8::gemm_phase<pg8::EpiBf16<0>, pg8::StaticOrder>(F.lds, g, So, E, nullptr); } SEAM(2);
#ifdef COMPRESS_NAIVE
    if (IN(3)) { p3_compress_naive(F); } SEAM(3);
#else
    if (IN(3)) { p3_compress_mfma(F); } SEAM(3);
#endif
    #ifdef ATTN_NAIVE
    if (IN(4)) { p4_attn_naive(F); } SEAM(4);
#else
    if (IN(4)) { p4_attn_mfma_t<0>(F); } SEAM(4);
#ifdef PROBE_ATTN_MODE
    if (IN(14)) { p4_attn_mfma_t<PROBE_ATTN_MODE>(F); }
#endif
#ifdef PROBE_P0_LO
    if (IN(14)) { p0_prologue(F, PROBE_P0_LO, PROBE_P0_HI); }
#endif
#endif
    if (IN(5)) { p5_mixed(F); } SEAM(5);
    if (IN(6)) { pg8::Gemm g{(const pg8::bf16_t*)(F.ws + WS_H), (const pg8::bf16_t*)(F.ws + WS_WOUT), T, D, D}; pg8::StaticOrder So; So.init(T, D, F.G, (int)blockIdx.x);
        pg8::EpiBf16<0> E{(pg8::bf16_t*)(F.ws + WS_Y), D, nullptr, 0, 0};
        pg8::gemm_phase<pg8::EpiBf16<0>, pg8::StaticOrder>(F.lds, g, So, E, nullptr); } SEAM(6);
    if (IN(7)) { norm_mod_rows_q(F, F.in[0], F.in[3], 3072, 4096, (bf16_t*)(F.ws + WS_H)); } SEAM(7);
    if (IN(8)) { pg8::Gemm g{(const pg8::bf16_t*)(F.ws + WS_H), (const pg8::bf16_t*)(F.ws + WS_WQ), T, D, D}; pg8::StaticOrder So; So.init(T, D, F.G, (int)blockIdx.x);
        pg8::EpiBf16<0> E{(pg8::bf16_t*)(F.ws + WS_QP), D, nullptr, 0, 0};
        pg8::gemm_phase<pg8::EpiBf16<0>, pg8::StaticOrder>(F.lds, g, So, E, nullptr); } SEAM(8);
        if (IN(9)) { p9_route_sort(F); } SEAM(9);
    if (IN(10)) { p10a_udots(F); } SEAM(10);
    if (IN(11)) { p10b_coef(F); } SEAM(11);
    if (IN(12)) { p10c_vsum(F); } SEAM(12);
    if (IN(13)) { p10d_final(F); }
#undef IN
#undef SEAM
}

extern "C" void kernel_launch(void* const* d_in, const int* in_sizes, int n_in, void* d_out, int out_size, void* d_ws, size_t ws_size, hipStream_t stream) {
    static int grid = 0;
    if (grid == 0) {
        if (n_in != 23 || out_size != T * D || ws_size < WS_END) { fprintf(stderr, "kernel_launch: unexpected shapes: n_in %d out %d ws %zu (need %zu)\n", n_in, out_size, ws_size, (size_t)WS_END); grid = -1; return; }
        int dev = 0, cus = 0, per_cu = 0;
        if (hipGetDevice(&dev) != hipSuccess || hipDeviceGetAttribute(&cus, hipDeviceAttributeMultiprocessorCount, dev) != hipSuccess) { grid = -1; return; }
        if (hipFuncSetAttribute((const void*)fwd, hipFuncAttributeMaxDynamicSharedMemorySize, LDS_BYTES) != hipSuccess) { fprintf(stderr, "kernel_launch: hipFuncSetAttribute failed\n"); grid = -1; return; }
        if (hipOccupancyMaxActiveBlocksPerMultiprocessor(&per_cu, (const void*)fwd, NTHREADS, LDS_BYTES) != hipSuccess || per_cu < 1) { fprintf(stderr, "kernel_launch: occupancy query says %d\n", per_cu); (void)hipGetLastError(); per_cu = 1; }
        grid = cus;
    }
    if (grid < 0) return;
    (void)hipMemsetAsync((char*)d_ws + WS_CTL, 0, CTL_BYTES, stream);
    Args a{};
    for (int i = 0; i < 23; ++i) a.in[i] = (const float*)d_in[i];
    a.out = (float*)d_out; a.ws = (unsigned char*)d_ws;
#if MK_N_LAUNCHES == 1
    a.ph_lo = 0; a.ph_hi = N_PHASES;
    hipLaunchKernelGGL(fwd, dim3(grid), dim3(NTHREADS), LDS_BYTES, stream, a);
#else
#ifdef PROBE_LIST
    { const int plist[] = PROBE_LIST; for (int p : plist) { if (p < 0) { (void)hipMemsetAsync((char*)d_ws + WS_CTL, 0, CTL_BYTES, stream); continue; } a.ph_lo = p; a.ph_hi = p + 1; hipLaunchKernelGGL(fwd, dim3(grid), dim3(NTHREADS), LDS_BYTES, stream, a); } }
#else
    for (int p = 0; p < N_PHASES; ++p) { a.ph_lo = p; a.ph_hi = p + 1; hipLaunchKernelGGL(fwd, dim3(grid), dim3(NTHREADS), LDS_BYTES, stream, a); }
#endif
#endif
}
```

```cpp
#include <hip/hip_runtime.h>
#include <cstdio>
#include <cstdint>
#include <cstdlib>

#ifndef MK_N_LAUNCHES
#define MK_N_LAUNCHES 1
#endif
#define XB_TMO      128
#define XB_XCNT(j)  (256  + 64 * (j))
#define XB_XSUB(j)  (1280 + 64 * (j))
#define XB_XGEN(j)  (2304 + 64 * (j))
#define XB_TOP      3328
#define XB_TOPGEN   3392
#define XCD_BAR_WORDS 3456
#define XB_SPIN_CAP (1u << 18)
#define LAS __attribute__((address_space(3)))

__device__ __forceinline__ unsigned xb_ld(unsigned* p)              { return __hip_atomic_load(p, __ATOMIC_RELAXED, __HIP_MEMORY_SCOPE_AGENT); }
__device__ __forceinline__ unsigned xb_add(unsigned* p, unsigned v) { return __hip_atomic_fetch_add(p, v, __ATOMIC_RELAXED, __HIP_MEMORY_SCOPE_AGENT); }
__device__ __forceinline__ unsigned xb_xcc_id() { return (unsigned)__builtin_amdgcn_s_getreg((3 << 11) | 20) & 0xFu; }
#define XB_SPIN(cond, bar) do { unsigned _sp = 0; while (cond) { __builtin_amdgcn_s_sleep(1); \
    if ((++_sp & 255u) == 0u) { if (xb_ld(&(bar)[XB_TMO])) break; if (_sp > XB_SPIN_CAP) { atomicAdd(&(bar)[XB_TMO], 1u); break; } } } } while (0)

struct XcdBarrier {
    unsigned* bar; unsigned x;
    volatile LAS unsigned* st;
};

__device__ __forceinline__ XcdBarrier xcd_barrier_post(unsigned* bar, volatile LAS unsigned* st) {
    XcdBarrier b; b.bar = bar; b.x = xb_xcc_id(); b.st = st;
    if (threadIdx.x == 0) (void)xb_add(&bar[XB_XCNT(b.x)], 1u);
    return b;
}
__device__ __forceinline__ void xcd_barrier_complete(unsigned* bar, unsigned x, unsigned& nloc, unsigned& nx) {
    const unsigned G = gridDim.x * gridDim.y * gridDim.z;
    unsigned sum, cnt, mine, sp = 0u;
    for (;;) {
        sum = 0u; cnt = 0u; mine = 0u;
#pragma unroll
        for (unsigned j = 0; j < 16; ++j) { const unsigned c = xb_ld(&bar[XB_XCNT(j)]); sum += c; cnt += (c > 0u) ? 1u : 0u; mine = (j == x) ? c : mine; }
        if (sum == G) break;
        __builtin_amdgcn_s_sleep(1);
        if ((++sp & 255u) == 0u) { if (xb_ld(&bar[XB_TMO])) break; if (sp > XB_SPIN_CAP) { atomicAdd(&bar[XB_TMO], 1u); break; } }
    }
    nloc = mine > 0u ? mine : 1u; nx = cnt > 0u ? cnt : 1u;
}

__device__ __forceinline__ void xcd_barrier(const XcdBarrier& b) {
    asm volatile("s_waitcnt vmcnt(0)" ::: "memory");
    __syncthreads();
    if (threadIdx.x == 0) {
        unsigned* bar = b.bar;
        __builtin_amdgcn_s_waitcnt(0);
        unsigned nloc = b.st[0], nx = b.st[1];
        if (nloc == 0u) { xcd_barrier_complete(bar, b.x, nloc, nx); b.st[0] = nloc; b.st[1] = nx; }
        const unsigned old = xb_add(&bar[XB_XSUB(b.x)], 1u);
        const unsigned gen = old / nloc;
        if (old + 1u == (gen + 1u) * nloc) {
            __builtin_amdgcn_fence(__ATOMIC_RELEASE, "agent");
            asm volatile("s_waitcnt vmcnt(0)" ::: "memory");
            const unsigned og = xb_add(&bar[XB_TOP], 1u);
            const unsigned tg = og / nx;
            if (og + 1u == (tg + 1u) * nx) xb_add(&bar[XB_TOPGEN], 1u);
            else XB_SPIN(xb_ld(&bar[XB_TOPGEN]) == tg, bar);
            __builtin_amdgcn_fence(__ATOMIC_ACQUIRE, "agent");
            xb_add(&bar[XB_XGEN(b.x)], 1u);
            asm volatile("s_waitcnt vmcnt(0)" ::: "memory");
        } else {
            XB_SPIN(xb_ld(&bar[XB_XGEN(b.x)]) == gen, bar);
            __builtin_amdgcn_fence(__ATOMIC_ACQUIRE, "agent");
            asm volatile("s_waitcnt vmcnt(0)" ::: "memory");
        }
    }
    __syncthreads();
}

namespace pg8 {
#define PG8_LAS __attribute__((address_space(3)))
typedef unsigned short bf16_t;
typedef short bf16x8 __attribute__((ext_vector_type(8)));
typedef float f32x4 __attribute__((ext_vector_type(4)));
typedef unsigned u32x4 __attribute__((ext_vector_type(4)));
constexpr int BM = 256, BK = 64, HALF = 128, HTB = HALF * BK * 2  , STAGE_BYTES = 8 * HTB, NXCD = 8, WGM = 8;

__host__ __device__ __forceinline__ int lds_byte(int r, int c) { const int st = (r >> 4) * 2 + (c >> 5), rr = r & 15, cc = c & 31, ob = rr * 64 + cc * 2; return st * 1024 + (ob ^ (((ob >> 9) & 1) << 5)); }
__host__ __device__ __forceinline__ void stage_rc(int b, int& R, int& C) { const int st = b / 1024, sb = b % 1024, swz = sb ^ (((sb >> 9) & 1) << 5); R = (st >> 1) * 16 + swz / 64; C = (st & 1) * 32 + (swz % 64) / 2; }
__host__ __device__ __forceinline__ int perm32(int rho) { const int n = rho >> 4, i = rho & 15; return 8 * (i >> 2) + 4 * n + (i & 3); }

struct Unit { int pm, pn; };
struct Gemm { const bf16_t* A; const bf16_t* Bt; int M, N, K; };

struct StaticOrder {
    int nM, nN, nwg, G, c;
    __host__ __device__ void init(int M, int N, int G_, int c_) { nM = M / BM; nN = N / BM; nwg = nM * nN; G = G_; c = c_; }
    __host__ __device__ bool next(int i, Unit& u) const {
        const long L = (long)i * G + c; if (L >= nwg) return false;
        int wgid = (int)L; { const int q = nwg / NXCD, r = nwg % NXCD, xcd = wgid % NXCD, off = wgid / NXCD; wgid = (xcd < r ? xcd * (q + 1) : r * (q + 1) + (xcd - r) * q) + off; }
        const int nig = WGM * nN, gid = wgid / nig, fm = gid * WGM, gsz = (nM - fm) < WGM ? (nM - fm) : WGM;
        u.pm = fm + ((wgid % nig) % gsz); u.pn = (wgid % nig) / gsz; return true;
    }
    __device__ __forceinline__ void a_ready(const Unit&) const {}
    __device__ __forceinline__ void done(const Unit&) const {}
};
struct CountedOrder : StaticOrder {
    const unsigned* ready; unsigned need; unsigned* tmo;
    __device__ __forceinline__ void a_ready(const Unit& u) const {
        if (threadIdx.x < 64) {
            const unsigned long long t0 = __builtin_amdgcn_s_memrealtime(); unsigned polls = 0;
            while ((unsigned)__builtin_amdgcn_readfirstlane(__hip_atomic_load(ready + 64 * u.pm, __ATOMIC_RELAXED, __HIP_MEMORY_SCOPE_AGENT)) < need) {
                if ((++polls & 255u) == 0u && __builtin_amdgcn_readfirstlane(__hip_atomic_load(tmo, __ATOMIC_RELAXED, __HIP_MEMORY_SCOPE_AGENT)) != 0u) break;
                if (__builtin_amdgcn_s_memrealtime() - t0 > 2000000ull) {
                    if (threadIdx.x == 0) { unsigned expect = 0u; __hip_atomic_compare_exchange_strong(tmo + 1, &expect, 0x600u | (unsigned)(u.pm & 0xff), __ATOMIC_RELAXED, __ATOMIC_RELAXED, __HIP_MEMORY_SCOPE_AGENT); __hip_atomic_store(tmo, 1u, __ATOMIC_RELAXED, __HIP_MEMORY_SCOPE_AGENT); }
                    break; }
                __builtin_amdgcn_s_sleep(2); }
            __builtin_amdgcn_fence(__ATOMIC_ACQUIRE, "agent");
            asm volatile("s_waitcnt vmcnt(0)" ::: "memory");
        }
#if !defined(BROKEN_HOOK_NO_BARRIER)
        asm volatile("" ::: "memory"); __builtin_amdgcn_s_barrier(); asm volatile("" ::: "memory");
#endif
    }
};

__device__ __forceinline__ unsigned cvt_pk_bf16(float lo, float hi) { unsigned r; asm volatile("v_cvt_pk_bf16_f32 %0, %1, %2" : "=v"(r) : "v"(lo), "v"(hi)); return r; }
typedef float f32x2 __attribute__((ext_vector_type(2)));
__device__ __forceinline__ f32x2 gelu_pk(f32x2 v) {
    const f32x2 av = __builtin_elementwise_abs(v), d = av * 0.2316418882f + 1.0f;
    f32x2 t; t.x = __builtin_amdgcn_rcpf(d.x); t.y = __builtin_amdgcn_rcpf(d.y);
    f32x2 q = t * 0.5307027145f + (-0.7265760135f); q = q * t + 0.7107068705f; q = q * t + (-0.142248368f); q = q * t + 0.127414796f; q = q * t;
    const f32x2 s = (v * v) * (-0.72134752044f);
    f32x2 e; e.x = __builtin_amdgcn_exp2f(s.x); e.y = __builtin_amdgcn_exp2f(s.y);
    const f32x2 m = v * (q * e), r = v - m;
    f32x2 o; o.x = v.x < 0.f ? m.x : r.x; o.y = v.y < 0.f ? m.y : r.y; return o;
}

struct EpiF32 {
    static constexpr bool PERM = false, AFTER_DRAIN = false;
    float* C; int ldc; const float* bias;
    __device__ __forceinline__ void operator()(const f32x4 (&acc)[2][2][4][2], const Unit& u, int wr, int wc, int fr, int fq) const {
        const int row0 = u.pm * BM + wr * 64 + fr, col0 = u.pn * BM + wc * 32 + 4 * fq;
        f32x4 bv[2][2];
#pragma unroll
        for (int bj = 0; bj < 2; ++bj)
#pragma unroll
            for (int n = 0; n < 2; ++n) bv[bj][n] = bias ? *(const f32x4*)(bias + col0 + bj * HALF + n * 16) : (f32x4){0.f, 0.f, 0.f, 0.f};
#pragma unroll
        for (int ai = 0; ai < 2; ++ai)
#pragma unroll
            for (int m = 0; m < 4; ++m) { float* rowp = C + (size_t)(row0 + ai * HALF + m * 16) * ldc + col0;
#pragma unroll
                for (int bj = 0; bj < 2; ++bj)
#pragma unroll
                    for (int n = 0; n < 2; ++n) *(f32x4*)(rowp + bj * HALF + n * 16) = acc[ai][bj][m][n] + bv[bj][n]; }
    }
};
template <int ACT  > struct EpiBf16 {
    static constexpr bool PERM = true, AFTER_DRAIN = false;
    bf16_t* O; int ldc; const float* bias; int split_cols; size_t split_stride;
    __device__ __forceinline__ void operator()(const f32x4 (&acc)[2][2][4][2], const Unit& u, int wr, int wc, int fr, int fq) const {
        const int row0 = u.pm * BM + wr * 64 + fr; int colt = u.pn * BM; bf16_t* base = O;
        if (split_cols) { const int t = colt / split_cols; base += (size_t)t * split_stride; colt -= t * split_cols; }
        const int col0 = colt + wc * 32 + 8 * fq, bcol0 = u.pn * BM + wc * 32 + 8 * fq;
        f32x4 bv[2][2];
#pragma unroll
        for (int bj = 0; bj < 2; ++bj)
#pragma unroll
            for (int n = 0; n < 2; ++n) bv[bj][n] = bias ? *(const f32x4*)(bias + bcol0 + bj * HALF + 4 * n) : (f32x4){0.f, 0.f, 0.f, 0.f};
#pragma unroll
        for (int ai = 0; ai < 2; ++ai)
#pragma unroll
            for (int m = 0; m < 4; ++m) { bf16_t* rowp = base + (size_t)(row0 + ai * HALF + m * 16) * ldc + col0;
#pragma unroll
                for (int bj = 0; bj < 2; ++bj) { f32x4 v0 = acc[ai][bj][m][0] + bv[bj][0], v1 = acc[ai][bj][m][1] + bv[bj][1];
                    if (ACT == 1) { f32x2 a = gelu_pk((f32x2){v0[0], v0[1]}), b = gelu_pk((f32x2){v0[2], v0[3]}), c = gelu_pk((f32x2){v1[0], v1[1]}), d = gelu_pk((f32x2){v1[2], v1[3]});
                        v0 = (f32x4){a.x, a.y, b.x, b.y}; v1 = (f32x4){c.x, c.y, d.x, d.y}; }
                    if (ACT == 2) {
#pragma unroll
                        for (int j = 0; j < 4; ++j) { v0[j] = 0.5f * v0[j] * (1.0f + erff(v0[j] * 0.70710678f)); v1[j] = 0.5f * v1[j] * (1.0f + erff(v1[j] * 0.70710678f)); } }
                    u32x4 w; w.x = cvt_pk_bf16(v0[0], v0[1]); w.y = cvt_pk_bf16(v0[2], v0[3]); w.z = cvt_pk_bf16(v1[0], v1[1]); w.w = cvt_pk_bf16(v1[2], v1[3]);
                    *(u32x4*)(rowp + bj * HALF) = w; } }
    }
};

struct PanelStats {
    unsigned* xbuf;
    unsigned* cnt;
    unsigned* tmo;
    int ntn; float eps;
    unsigned code;
    __device__ __forceinline__ bool run(const f32x4 (&v)[2][2][4][2], const Unit& u, int wr, int wc, int fr, int fq, PG8_LAS unsigned char* lds, int wid, int lane) const {
        typedef float f32x2v __attribute__((ext_vector_type(2)));
        PG8_LAS f32x2v* P = (PG8_LAS f32x2v*)lds;
        PG8_LAS f32x2v* S = (PG8_LAS f32x2v*)(lds + 8192);
        PG8_LAS unsigned* flag = (PG8_LAS unsigned*)(lds + 8192 + 2048);
#pragma unroll
        for (int ai = 0; ai < 2; ++ai)
#pragma unroll
            for (int m = 0; m < 4; ++m) {
                float s = 0.f;
#pragma unroll
                for (int bj = 0; bj < 2; ++bj)
#pragma unroll
                    for (int n = 0; n < 2; ++n) { const f32x4 x = v[ai][bj][m][n]; s += (x[0] + x[1]) + (x[2] + x[3]); }
                s += __shfl_xor(s, 16); s += __shfl_xor(s, 32);
                const float mw = s * (1.0f / 64.0f); float q = 0.f;
#pragma unroll
                for (int bj = 0; bj < 2; ++bj)
#pragma unroll
                    for (int n = 0; n < 2; ++n) { const f32x4 d = v[ai][bj][m][n] - mw; q += (d[0] * d[0] + d[1] * d[1]) + (d[2] * d[2] + d[3] * d[3]); }
                q += __shfl_xor(q, 16); q += __shfl_xor(q, 32);
                if (fq == 0) P[(ai * HALF + wr * 64 + m * 16 + fr) * 4 + wc] = (f32x2v){mw, q};
            }
        asm volatile("s_waitcnt lgkmcnt(0)" ::: "memory"); __builtin_amdgcn_s_barrier(); asm volatile("" ::: "memory");
#if defined(BROKEN_NO_WAIT)
        if (blockIdx.x >= 64) { const long long t0 = clock64(); while (clock64() - t0 < 60000) __builtin_amdgcn_s_sleep(8); }
#endif
        const int row = wid * 32 + (lane & 31);
        if (lane < 32) {
            const f32x2v a = P[row * 4 + 0], b = P[row * 4 + 1], c = P[row * 4 + 2], d = P[row * 4 + 3];
            const float mt = (a.x + b.x + c.x + d.x) * 0.25f;
            const float da = a.x - mt, db = b.x - mt, dc = c.x - mt, dd = d.x - mt;
            const float m2 = (a.y + b.y) + (c.y + d.y) + 64.0f * ((da * da + db * db) + (dc * dc + dd * dd));
            unsigned long long* slot = (unsigned long long*)xbuf + ((size_t)(u.pm * BM + row) * 4 + u.pn);
            __hip_atomic_store(slot, ((unsigned long long)__float_as_uint(m2) << 32) | __float_as_uint(mt), __ATOMIC_RELAXED, __HIP_MEMORY_SCOPE_AGENT);
        }
        asm volatile("s_waitcnt vmcnt(0)" ::: "memory");
        if (lane == 0) __hip_atomic_fetch_add(cnt + 64 * u.pm, 1u, __ATOMIC_RELAXED, __HIP_MEMORY_SCOPE_AGENT);
        if (wid == 0) {
            bool dead = false; const unsigned long long t0 = __builtin_amdgcn_s_memrealtime(); const unsigned want = 8u * (unsigned)ntn;
            for (;;) {
#if defined(BROKEN_NO_WAIT)
                break;
#endif
                if ((unsigned)__builtin_amdgcn_readfirstlane(__hip_atomic_load(cnt + 64 * u.pm, __ATOMIC_RELAXED, __HIP_MEMORY_SCOPE_AGENT)) >= want) break;
                if (__builtin_amdgcn_s_memrealtime() - t0 > 2000000ull) {
                    if (lane == 0) { unsigned expect = 0u; __hip_atomic_compare_exchange_strong(tmo + 1, &expect, code | (unsigned)(u.pm & 0xff), __ATOMIC_RELAXED, __ATOMIC_RELAXED, __HIP_MEMORY_SCOPE_AGENT);
                                     __hip_atomic_store(tmo, 1u, __ATOMIC_RELAXED, __HIP_MEMORY_SCOPE_AGENT); }
                    dead = true; break; }
                __builtin_amdgcn_s_sleep(2);
            }
            __builtin_amdgcn_fence(__ATOMIC_ACQUIRE, "agent");
            if (lane == 0) flag[0] = dead ? 1u : 0u;
        }
        asm volatile("s_waitcnt vmcnt(0) lgkmcnt(0)" ::: "memory"); __builtin_amdgcn_s_barrier(); asm volatile("" ::: "memory");
        const bool bad = flag[0] != 0u;
        if (lane < 32) {
            const unsigned long long* slot = (const unsigned long long*)xbuf + (size_t)(u.pm * BM + row) * 4; float mt[4], m2[4]; float ms = 0.f;
#pragma unroll
            for (int t = 0; t < 4; ++t) { if (t < ntn) { const unsigned long long w = __hip_atomic_load(slot + t, __ATOMIC_RELAXED, __HIP_MEMORY_SCOPE_AGENT); mt[t] = __uint_as_float((unsigned)w); m2[t] = __uint_as_float((unsigned)(w >> 32)); } else { mt[t] = 0.f; m2[t] = 0.f; } ms += mt[t]; }
            const float mean = ms / (float)ntn; float q = 0.f;
#pragma unroll
            for (int t = 0; t < 4; ++t) if (t < ntn) { const float dm = mt[t] - mean; q += m2[t] + 256.0f * dm * dm; }
            S[row] = (f32x2v){mean, 1.0f / sqrtf(q / (256.0f * (float)ntn) + eps)};
        }
        asm volatile("s_waitcnt lgkmcnt(0)" ::: "memory"); __builtin_amdgcn_s_barrier(); asm volatile("" ::: "memory");
        return bad;
    }
};
struct EpiLnRes {
    static constexpr bool PERM = false, AFTER_DRAIN = true;
    const float* base; float* out; int ldc; const float* bias; PanelStats st; unsigned poison;
    __device__ __forceinline__ void refuse(size_t i0, size_t stride, int M, int N) const { const float q = __builtin_nanf(""); for (size_t i = i0; i < (size_t)M * N; i += stride) out[(i / N) * ldc + i % N] = q;
        if (i0 == 0) { unsigned expect = 0u; __hip_atomic_compare_exchange_strong(st.tmo + 1, &expect, 0x7f0u, __ATOMIC_RELAXED, __ATOMIC_RELAXED, __HIP_MEMORY_SCOPE_AGENT); __hip_atomic_store(st.tmo, 1u, __ATOMIC_RELAXED, __HIP_MEMORY_SCOPE_AGENT); } }
    __device__ __forceinline__ void fused(f32x4 (&acc)[2][2][4][2], const Unit& u, int wr, int wc, int fr, int fq, PG8_LAS unsigned char* lds, int wid, int lane) const {
        typedef float f32x2v __attribute__((ext_vector_type(2)));
        const PG8_LAS f32x2v* S = (const PG8_LAS f32x2v*)(lds + 8192);
        const int col0 = u.pn * BM + wc * 32 + 4 * fq;
#pragma unroll
        for (int bj = 0; bj < 2; ++bj)
#pragma unroll
            for (int n = 0; n < 2; ++n) { const f32x4 bv = bias ? *(const f32x4*)(bias + col0 + bj * HALF + n * 16) : (f32x4){0.f, 0.f, 0.f, 0.f};
#pragma unroll
                for (int ai = 0; ai < 2; ++ai)
#pragma unroll
                    for (int m = 0; m < 4; ++m) acc[ai][bj][m][n] += bv; }
        const bool bad = st.run(acc, u, wr, wc, fr, fq, lds, wid, lane) || poison != 0u;
        const float qnan = __builtin_nanf("");
#pragma unroll
        for (int ai = 0; ai < 2; ++ai)
#pragma unroll
            for (int m = 0; m < 4; ++m) { const int r = ai * HALF + wr * 64 + m * 16 + fr; const f32x2v sr = S[r]; const size_t off = (size_t)(u.pm * BM + r) * ldc + col0;
#pragma unroll
                for (int bj = 0; bj < 2; ++bj)
#pragma unroll
                    for (int n = 0; n < 2; ++n) { const f32x4 bs = *(const f32x4*)(base + off + bj * HALF + n * 16); f32x4 o = bs + (acc[ai][bj][m][n] - sr.x) * sr.y;
                        if (bad) o = (f32x4){qnan, qnan, qnan, qnan}; *(f32x4*)(out + off + bj * HALF + n * 16) = o; }
                asm volatile("" ::: "memory"); }
    }
};
struct EpiLnResLn {
    static constexpr bool PERM = false, AFTER_DRAIN = true;
    const float* base; float* out; bf16_t* xn; int ldc; const float* bias; PanelStats st1, st2; unsigned poison;
    __device__ __forceinline__ void refuse(size_t i0, size_t stride, int M, int N) const { const float q = __builtin_nanf(""); for (size_t i = i0; i < (size_t)M * N; i += stride) { const size_t o = (i / N) * ldc + i % N; out[o] = q; xn[o] = (bf16_t)0x7fc0u; }
        if (i0 == 0) { unsigned expect = 0u; __hip_atomic_compare_exchange_strong(st1.tmo + 1, &expect, 0x7f0u, __ATOMIC_RELAXED, __ATOMIC_RELAXED, __HIP_MEMORY_SCOPE_AGENT); __hip_atomic_store(st1.tmo, 1u, __ATOMIC_RELAXED, __HIP_MEMORY_SCOPE_AGENT); } }
    __device__ __forceinline__ void fused(f32x4 (&acc)[2][2][4][2], const Unit& u, int wr, int wc, int fr, int fq, PG8_LAS unsigned char* lds, int wid, int lane) const {
        typedef float f32x2v __attribute__((ext_vector_type(2))); typedef unsigned u32x2v __attribute__((ext_vector_type(2)));
        const PG8_LAS f32x2v* S = (const PG8_LAS f32x2v*)(lds + 8192);
        const int col0 = u.pn * BM + wc * 32 + 4 * fq;
#pragma unroll
        for (int bj = 0; bj < 2; ++bj)
#pragma unroll
            for (int n = 0; n < 2; ++n) { const f32x4 bv = bias ? *(const f32x4*)(bias + col0 + bj * HALF + n * 16) : (f32x4){0.f, 0.f, 0.f, 0.f};
#pragma unroll
                for (int ai = 0; ai < 2; ++ai)
#pragma unroll
                    for (int m = 0; m < 4; ++m) acc[ai][bj][m][n] += bv; }
        bool bad = st1.run(acc, u, wr, wc, fr, fq, lds, wid, lane) || poison != 0u;
        const float qnan = __builtin_nanf("");
#pragma unroll
        for (int ai = 0; ai < 2; ++ai)
#pragma unroll
            for (int m = 0; m < 4; ++m) { const int r = ai * HALF + wr * 64 + m * 16 + fr; const f32x2v sr = S[r]; const size_t off = (size_t)(u.pm * BM + r) * ldc + col0;
#pragma unroll
                for (int bj = 0; bj < 2; ++bj)
#pragma unroll
                    for (int n = 0; n < 2; ++n) { const f32x4 bs = *(const f32x4*)(base + off + bj * HALF + n * 16); acc[ai][bj][m][n] = bs + (acc[ai][bj][m][n] - sr.x) * sr.y; }
                asm volatile("" : "+v"(acc[ai][0][m][0]), "+v"(acc[ai][0][m][1]), "+v"(acc[ai][1][m][0]), "+v"(acc[ai][1][m][1]));
                if (m & 1) asm volatile("" ::: "memory"); }
        const bool bad1 = bad;
        bad = st2.run(acc, u, wr, wc, fr, fq, lds, wid, lane) || bad;
#pragma unroll
        for (int ai = 0; ai < 2; ++ai)
#pragma unroll
            for (int m = 0; m < 4; ++m) { const int r = ai * HALF + wr * 64 + m * 16 + fr; const f32x2v sr = S[r]; const size_t off = (size_t)(u.pm * BM + r) * ldc + col0;
#pragma unroll
                for (int bj = 0; bj < 2; ++bj)
#pragma unroll
                    for (int n = 0; n < 2; ++n) { const f32x4 x1 = acc[ai][bj][m][n]; *(f32x4*)(out + off + bj * HALF + n * 16) = bad1 ? (f32x4){qnan, qnan, qnan, qnan} : x1;
                        const f32x4 o = (x1 - sr.x) * sr.y; u32x2v w; w.x = cvt_pk_bf16(o[0], o[1]); w.y = cvt_pk_bf16(o[2], o[3]);
                        if (bad) { w.x = 0x7fc07fc0u; w.y = 0x7fc07fc0u; } *(u32x2v*)(xn + off + bj * HALF + n * 16) = w; }
                asm volatile("" ::: "memory"); }
    }
};

template <class Epi, class Sched, bool STAMP = false>
__device__ __forceinline__ void gemm_phase(PG8_LAS unsigned char* lds, const Gemm g, const Sched& S, const Epi& E, unsigned long long* stamps) {
    const int tid = threadIdx.x, wid = __builtin_amdgcn_readfirstlane(tid >> 6), lane = tid & 63, wr = wid >> 2, wc = wid & 3, fr = lane & 15, fq = lane >> 4;
    const int K = g.K, nt = K / BK;
    int ts_lo = 0, ts_hi = 0, nts = 0; const unsigned long long rt_entry = STAMP ? (unsigned long long)wall_clock64() : 0ull;
#define PG8_STAMP() do { if (STAMP && wid == 0 && nts < 64) { const unsigned long long _c = (unsigned long long)clock64(); \
        ts_lo = (lane == nts) ? (int)(unsigned)_c : ts_lo; ts_hi = (lane == nts) ? (int)(unsigned)(_c >> 32) : ts_hi; ++nts; } } while (0)
    PG8_STAMP();
    unsigned voffA[2], voffB[2];
#pragma unroll
    for (int i = 0; i < 2; ++i) { int R, C; stage_rc(tid * 16 + i * 8192, R, C); const int Rb = Epi::PERM ? ((R & ~31) + perm32(R & 31)) : R;
        voffA[i] = (unsigned)(R * K + C) * 2u; voffB[i] = (unsigned)(Rb * K + C) * 2u; }
    const size_t kstep = (size_t)(BK * 2);
    const size_t hstep = (size_t)HALF * K * 2;
    const size_t tstep = 2 * hstep;
    const unsigned ldsw = (unsigned)wid * 1024u;
    const int aoff = lds_byte(wr * 64 + fr, fq * 8), boff = lds_byte(wc * 32 + fr, fq * 8);
#define PG8_SA(b, h) (((b) * 2 + (h)) * HTB)
#define PG8_SB(b, h) ((4 + (b) * 2 + (h)) * HTB)
#define PG8_STAGE(bufoff, gbase, voff) do { _Pragma("unroll") for (int _i = 0; _i < 2; ++_i) \
        __builtin_amdgcn_global_load_lds((const unsigned*)((const char*)(gbase) + (voff)[_i]), (PG8_LAS unsigned*)(lds + (bufoff) + ldsw + _i * 8192), 16, 0, 0); } while (0)
#define PG8_LDA(dst, b, h) do { _Pragma("unroll") for (int m = 0; m < 4; ++m) _Pragma("unroll") for (int k = 0; k < 2; ++k) dst[m][k] = *(const PG8_LAS bf16x8*)(lds + PG8_SA(b, h) + aoff + m * 2048 + k * 1024); } while (0)
#define PG8_LDB(dst, b, h) do { _Pragma("unroll") for (int n = 0; n < 2; ++n) _Pragma("unroll") for (int k = 0; k < 2; ++k) dst[n][k] = *(const PG8_LAS bf16x8*)(lds + PG8_SB(b, h) + boff + n * 2048 + k * 1024); } while (0)
#define PG8_MMA(ai, bj, At, Bt) do { __builtin_amdgcn_s_setprio(1); _Pragma("unroll") for (int m = 0; m < 4; ++m) _Pragma("unroll") for (int n = 0; n < 2; ++n) _Pragma("unroll") for (int k = 0; k < 2; ++k) \
        acc[ai][bj][m][n] = __builtin_amdgcn_mfma_f32_16x16x32_bf16(Bt[n][k], At[m][k], acc[ai][bj][m][n], 0, 0, 0); __builtin_amdgcn_s_setprio(0); } while (0)
#define PG8_WAIT_V(n) asm volatile("s_waitcnt vmcnt(" #n ")" ::: "memory")
#define PG8_WAIT_L(n) asm volatile("s_waitcnt lgkmcnt(" #n ")" ::: "memory")
#define PG8_BAR __builtin_amdgcn_s_barrier()
#define PG8_SCHED __builtin_amdgcn_sched_barrier(0)
    Unit cur, nxt; int ui = 0;
    if (!S.next(0, cur)) return;
    f32x4 acc[2][2][4][2];
#pragma unroll
    for (int a = 0; a < 2; ++a)
#pragma unroll
        for (int b = 0; b < 2; ++b)
#pragma unroll
            for (int m = 0; m < 4; ++m)
#pragma unroll
                for (int n = 0; n < 2; ++n) acc[a][b][m][n] = (f32x4){0.f, 0.f, 0.f, 0.f};
    bf16x8 At[4][2], B0[2][2], B1[2][2];
    const char* cA = (const char*)g.A + (size_t)cur.pm * tstep; const char* cB = (const char*)g.Bt + (size_t)cur.pn * tstep;
    S.a_ready(cur);
    PG8_STAGE(PG8_SB(0, 0), cB, voffB); PG8_STAGE(PG8_SA(0, 0), cA, voffA); PG8_STAGE(PG8_SB(0, 1), cB + hstep, voffB); PG8_STAGE(PG8_SA(0, 1), cA + hstep, voffA);
    if (wr == 1) PG8_BAR;
    PG8_WAIT_V(4); PG8_BAR;
    PG8_STAGE(PG8_SB(1, 0), cB + kstep, voffB); PG8_STAGE(PG8_SA(1, 0), cA + kstep, voffA); PG8_STAGE(PG8_SB(1, 1), cB + hstep + kstep, voffB);
    PG8_WAIT_V(6); PG8_BAR;
    PG8_STAMP();
    for (;;) {
        const bool has_next = S.next(ui + 1, nxt);
        const char* nA = has_next ? (const char*)g.A + (size_t)nxt.pm * tstep : cA; const char* nB = has_next ? (const char*)g.Bt + (size_t)nxt.pn * tstep : cB;
        for (int t = 0; t < nt; t += 2) {
            const bool last = (t == nt - 2);
            const char* a1 = cA + (size_t)(t + 1) * kstep;
            const char* a2 = last ? nA : cA + (size_t)(t + 2) * kstep; const char* b2 = last ? nB : cB + (size_t)(t + 2) * kstep;
            const char* a3 = a2 + kstep; const char* b3 = b2 + kstep;
            if (last && has_next) S.a_ready(nxt);
            PG8_LDB(B0, 0, 0); PG8_SCHED; PG8_LDA(At, 0, 0); PG8_STAGE(PG8_SA(1, 1), a1 + hstep, voffA);
            PG8_WAIT_L(8); PG8_BAR; PG8_WAIT_L(0); PG8_MMA(0, 0, At, B0); PG8_BAR; PG8_SCHED;
            PG8_LDB(B1, 0, 1); PG8_STAGE(PG8_SB(0, 0), b2, voffB);
            PG8_BAR; PG8_WAIT_L(0); PG8_MMA(0, 1, At, B1); PG8_BAR;
            PG8_LDA(At, 0, 1); PG8_STAGE(PG8_SA(0, 0), a2, voffA);
            PG8_BAR; PG8_WAIT_L(0); PG8_MMA(1, 0, At, B0); PG8_BAR; PG8_SCHED;
            PG8_STAGE(PG8_SB(0, 1), b2 + hstep, voffB);
            PG8_WAIT_V(6); PG8_BAR; PG8_MMA(1, 1, At, B1); PG8_BAR;
            PG8_LDB(B0, 1, 0); PG8_SCHED; PG8_LDA(At, 1, 0); PG8_STAGE(PG8_SA(0, 1), a2 + hstep, voffA);
            PG8_WAIT_L(8); PG8_BAR; PG8_WAIT_L(0); PG8_MMA(0, 0, At, B0); PG8_BAR; PG8_SCHED;
            PG8_LDB(B1, 1, 1); PG8_STAGE(PG8_SB(1, 0), b3, voffB);
            PG8_BAR; PG8_WAIT_L(0); PG8_MMA(0, 1, At, B1); PG8_BAR;
            PG8_LDA(At, 1, 1); PG8_STAGE(PG8_SA(1, 0), a3, voffA);
            PG8_BAR; PG8_WAIT_L(0); PG8_MMA(1, 0, At, B0); PG8_BAR; PG8_SCHED;
            PG8_STAGE(PG8_SB(1, 1), b3 + hstep, voffB);
            PG8_WAIT_V(6); PG8_BAR; PG8_MMA(1, 1, At, B1); PG8_BAR;
        }
        PG8_STAMP();
        if constexpr (!Epi::AFTER_DRAIN) { E(acc, cur, wr, wc, fr, fq); S.done(cur); }
        PG8_STAMP();
        if (!has_next) break;
#pragma unroll
        for (int a = 0; a < 2; ++a)
#pragma unroll
            for (int b = 0; b < 2; ++b)
#pragma unroll
                for (int m = 0; m < 4; ++m)
#pragma unroll
                    for (int n = 0; n < 2; ++n) acc[a][b][m][n] = (f32x4){0.f, 0.f, 0.f, 0.f};
        cur = nxt; cA = nA; cB = nB; ++ui;
    }
    PG8_WAIT_V(0);
    if (wr == 0) PG8_BAR;
    PG8_BAR;
    if constexpr (Epi::AFTER_DRAIN) { E.fused(acc, cur, wr, wc, fr, fq, lds, wid, lane); S.done(cur); }
    PG8_STAMP();
    if (STAMP && wid == 0) { stamps[lane] = lane < nts ? (((unsigned long long)(unsigned)ts_hi << 32) | (unsigned)ts_lo) : 0ull;
        if (lane == 62) stamps[62] = rt_entry; if (lane == 63) stamps[63] = (unsigned long long)wall_clock64(); }
#undef PG8_STAMP
#undef PG8_SA
#undef PG8_SB
#undef PG8_STAGE
#undef PG8_LDA
#undef PG8_LDB
#undef PG8_MMA
#undef PG8_WAIT_V
#undef PG8_WAIT_L
#undef PG8_BAR
#undef PG8_SCHED
}
}

constexpr int D = 1024, NB = 16, S = 2048, T = NB * S;
constexpr int NCOL = 2840, NPAD = 3072;
constexpr int C_Q = 0, C_KC = 512, C_VC = 640, C_KS = 768, C_VS = 896, C_KW = 1024, C_VW = 1152, C_GT = 1280, C_CB = 1304, C_CC = 1816, C_CH = 2328;
constexpr int NCMP = 127;
constexpr int NEXP = 16384;
constexpr float EPS = 1e-6f;
constexpr int NTHREADS = 512, NWAVES = 8;

constexpr size_t al256(size_t x) { return (x + 255) & ~(size_t)255; }
constexpr size_t WS_CTL   = 0;                                   constexpr size_t CTL_BYTES = 65536;
constexpr size_t WS_MOD   = WS_CTL + CTL_BYTES;
constexpr size_t WS_WIN   = al256(WS_MOD + (size_t)16 * 6144 * 4);
constexpr size_t WS_WOUT  = al256(WS_WIN + (size_t)NPAD * D * 2);
constexpr size_t WS_WQ    = al256(WS_WOUT + (size_t)D * D * 2);
constexpr size_t WS_KEYS  = al256(WS_WQ + (size_t)D * D * 2);
constexpr size_t WS_U8S   = al256(WS_KEYS + (size_t)16 * 128 * 64 * 2);
constexpr size_t WS_V8S   = al256(WS_U8S + (size_t)NEXP * D);
constexpr size_t WS_X8S   = al256(WS_V8S + (size_t)NEXP * D);
constexpr size_t WS_SU    = al256(WS_X8S + (size_t)T * D);
constexpr size_t WS_SV    = al256(WS_SU + (size_t)NEXP * 4);
constexpr size_t WS_SX    = al256(WS_SV + (size_t)NEXP * 4);
constexpr size_t WS_W1T   = al256(WS_SX + (size_t)T * 4);
constexpr size_t WS_W2T   = al256(WS_W1T + (size_t)2 * 64 * 2048 * 2);
constexpr size_t WS_PEC   = al256(WS_W2T + (size_t)2 * 64 * 64 * 2);
constexpr size_t WS_KC    = al256(WS_PEC + (size_t)2 * 64 * 4);
constexpr size_t WS_VC    = al256(WS_KC + (size_t)16 * 2 * 128 * 64 * 2);
constexpr size_t WS_H     = al256(WS_VC + (size_t)16 * 2 * 128 * 64 * 2);
constexpr size_t WS_CQ8   = WS_H;
constexpr size_t WS_CMAX  = WS_H + (size_t)32 * 1024 * 1024;
constexpr size_t WS_SSQP  = WS_H + (size_t)33 * 1024 * 1024;
constexpr size_t WS_OATT  = al256(WS_H + (size_t)T * D * 2);
constexpr size_t WS_PROJ  = al256(WS_OATT + (size_t)T * 512 * 2);
constexpr size_t WS_QP    = WS_PROJ;
constexpr size_t WS_PART  = WS_PROJ;
constexpr size_t WS_PO    = WS_PROJ;
constexpr size_t WS_E16   = WS_PROJ + (size_t)160 * 1024 * 1024;
constexpr size_t WS_EW    = WS_E16 + (size_t)T * 128 * 4;
constexpr size_t WS_Y     = al256(WS_PROJ + (size_t)T * NPAD * 2);
constexpr size_t WS_END   = al256(WS_Y + (size_t)T * D * 2);
static_assert(WS_EW + (size_t)T * 128 * 4 <= WS_Y, "alias region");
static_assert((size_t)8 * T * 128 * 4 <= (size_t)160 * 1024 * 1024, "PART fits under EIDX");
constexpr int CTL_CTR_A = 16384, CTL_CTR_B = 16384 + 8 * 256;

constexpr int LDS_STAGE = 147456;
constexpr int LDS_MISC_OFF = LDS_STAGE;
constexpr int LDS_BYTES = LDS_STAGE + 256;

typedef unsigned short bf16_t;
typedef short bf16x8 __attribute__((ext_vector_type(8)));
typedef short s16x4 __attribute__((ext_vector_type(4)));
typedef float f32x4 __attribute__((ext_vector_type(4)));
typedef unsigned u32x4v __attribute__((ext_vector_type(4)));
__device__ __forceinline__ float bf2f(bf16_t b) { return __uint_as_float(((unsigned)b) << 16); }
__device__ __forceinline__ bf16_t f2bf(float f) { unsigned u = __float_as_uint(f); u += 0x7FFFu + ((u >> 16) & 1u); return (bf16_t)(u >> 16); }
__device__ __forceinline__ float bflo(unsigned w) { return __uint_as_float(w << 16); }
__device__ __forceinline__ float bfhi(unsigned w) { return __uint_as_float(w & 0xFFFF0000u); }
__device__ __forceinline__ unsigned pack2(float lo, float hi) { return (unsigned)f2bf(lo) | ((unsigned)f2bf(hi) << 16); }
__device__ __forceinline__ float gelu_tanh(float x) { const float u = 0.7978845608028654f * (x + 0.044715f * x * x * x); return 0.5f * x * (1.0f + tanhf(u)); }
__device__ __forceinline__ float sigmoidf_(float x) { return 1.0f / (1.0f + __expf(-x)); }
__device__ __forceinline__ float wave_sum(float v) {
#pragma unroll
    for (int o = 32; o >= 1; o >>= 1) v += __shfl_xor(v, o);
    return v; }
__device__ __forceinline__ float wave_max(float v) {
#pragma unroll
    for (int o = 32; o >= 1; o >>= 1) v = fmaxf(v, __shfl_xor(v, o));
    return v; }
__device__ __forceinline__ void lds_wave_sync() { asm volatile("s_waitcnt lgkmcnt(0)" ::: "memory"); }
#ifdef PROBE_STAMP
#define STAMP_DECL unsigned long long tprev_ = 0ull; const bool dbg_ = (PROBE_PHASE == 12 || blockIdx.x == PROBE_BLOCK) && (threadIdx.x == 0);
#define STAMP_START() do { if (dbg_) tprev_ = __builtin_amdgcn_s_memtime(); } while (0)
#define STAMP(k) do { if (dbg_) { const unsigned long long tn_ = __builtin_amdgcn_s_memtime(); volatile LAS unsigned* c_ = (volatile LAS unsigned*)(F_lds_ + LDS_MISC_OFF + 128); c_[k] += (unsigned)(tn_ - tprev_); tprev_ = tn_; } } while (0)
#define STAMP_COUNT(k) do { if (dbg_) { volatile LAS unsigned* c_ = (volatile LAS unsigned*)(F_lds_ + LDS_MISC_OFF + 128); c_[k] += 1u; } } while (0)
#else
#define STAMP_DECL
#define STAMP_START() do {} while (0)
#define STAMP(k) do {} while (0)
#define STAMP_COUNT(k) do {} while (0)
#endif
#ifndef PROBE_BLOCK
#define PROBE_BLOCK 0
#endif
#ifndef PROBE_PHASE
#define PROBE_PHASE 4
#endif

__device__ __forceinline__ int rel_bucket(int dist) {
    const int n = dist > 0 ? dist : 0;
    if (n < 16) return n;
    const float lr = logf((float)n / 16.0f) / 2.0794415416798357f;
    const int large = 16 + (int)(lr * 16.0f);
    return large < 31 ? large : 31;
}

struct Frame {
    const float* in[23]; float* out; unsigned char* ws;
    LAS unsigned char* lds; int tid, lane, wave, G;
};


typedef int i32x4v __attribute__((ext_vector_type(4)));
constexpr int PEER_CHUNK_TOK = 128, PEER_NCHUNK = T / PEER_CHUNK_TOK;

__device__ __forceinline__ void quant_row_sliced(const float* row, unsigned char* dst8  , size_t nrows, size_t r, float* scale_out, int bias, int lane) {
    float4 v[4]; float am = 0.f;
#pragma unroll
    for (int i = 0; i < 4; ++i) { v[i] = *(const float4*)(row + (lane + 64 * i) * 4); am = fmaxf(am, fmaxf(fmaxf(fabsf(v[i].x), fabsf(v[i].y)), fmaxf(fabsf(v[i].z), fabsf(v[i].w)))); }
    am = wave_max(am); const float inv = am > 0.f ? 127.0f / am : 0.f;
    if (lane == 0) *scale_out = am > 0.f ? am / 127.0f : 0.f;
#pragma unroll
    for (int i = 0; i < 4; ++i) { const int col = (lane + 64 * i) * 4; const int sl = col >> 7, off = col & 127;
        const int q0 = (int)rintf(v[i].x * inv) + bias, q1 = (int)rintf(v[i].y * inv) + bias, q2 = (int)rintf(v[i].z * inv) + bias, q3 = (int)rintf(v[i].w * inv) + bias;
        *(unsigned*)(dst8 + ((size_t)sl * nrows + r) * 128 + off) = (unsigned)(q0 & 0xFF) | ((unsigned)(q1 & 0xFF) << 8) | ((unsigned)(q2 & 0xFF) << 16) | ((unsigned)(q3 & 0xFF) << 24); }
}

constexpr int PEER_NGRP = T / 16;
__device__ __forceinline__ int grab_item(unsigned* ctr, int slice, int lane) {
    unsigned v = 0u; if (lane == 0) v = __hip_atomic_fetch_add(ctr + slice * 64, 1u, __ATOMIC_RELAXED, __HIP_MEMORY_SCOPE_AGENT);
    return (int)__builtin_amdgcn_readfirstlane(v);
}
__device__ __forceinline__ void gather_rows16(u32x4v (&vv)[16], const unsigned char* base, const LAS unsigned* le) {
    const u32x4v e0 = *(const LAS u32x4v*)le, e1 = *(const LAS u32x4v*)(le + 4);
#pragma unroll
    for (int ld = 0; ld < 16; ++ld) { const unsigned w = ld < 8 ? e0[ld >> 1] : e1[(ld - 8) >> 1]; const unsigned e = (ld & 1) ? (w >> 16) : (w & 0xFFFFu);
        vv[ld] = *(const u32x4v*)(base + (size_t)e * 128); }
}
__device__ __forceinline__ void udot_item(const u32x4v (&uv)[16], const i32x4v xq, int* part_row  , int c) {
    i32x4v res[4];
#pragma unroll
    for (int ld = 0; ld < 16; ++ld) { int p = __builtin_amdgcn_sdot4((int)uv[ld][0], xq[0], 0, false); p = __builtin_amdgcn_sdot4((int)uv[ld][1], xq[1], p, false);
        p = __builtin_amdgcn_sdot4((int)uv[ld][2], xq[2], p, false); p = __builtin_amdgcn_sdot4((int)uv[ld][3], xq[3], p, false);
        p += __shfl_xor(p, 1); p += __shfl_xor(p, 2); p += __shfl_xor(p, 4); res[ld >> 2][ld & 3] = p; }
    if (c == 0) {
#pragma unroll
        for (int q = 0; q < 4; ++q) *(i32x4v*)(part_row + 4 * q) = res[q]; }
}
__device__ __forceinline__ void p10a_udots(const Frame& F) {
    const unsigned char* U8S = F.ws + WS_U8S; const unsigned char* X8S = F.ws + WS_X8S; const unsigned short* E16 = (const unsigned short*)(F.ws + WS_E16); int* PART = (int*)(F.ws + WS_PART);
    unsigned* ctr = (unsigned*)(F.ws + WS_CTL + CTL_CTR_A);
    const int lane = F.lane, j = lane >> 3, c = lane & 7; const int xcc = (int)(xb_xcc_id() & 7u);
    LAS unsigned char* wl = F.lds + F.wave * 8192;
    const LAS unsigned* le = (const LAS unsigned*)wl + 8 * j;
    for (int so = 0; so < 8; ++so) { const int x = (xcc + so) & 7;
        const unsigned char* ub = U8S + (size_t)x * NEXP * 128 + c * 16;
        int nxt = grab_item(ctr, x, lane);
        for (;;) { const int cur = nxt; if (cur >= PEER_NGRP) break;
            nxt = grab_item(ctr, x, lane);
            const int t0 = cur * 16;
            { const u32x4v* src = (const u32x4v*)(E16 + (size_t)t0 * 128);
#pragma unroll
                for (int i = 0; i < 4; ++i) *(LAS u32x4v*)(wl + (lane + 64 * i) * 16) = src[lane + 64 * i]; }
            lds_wave_sync();
            const unsigned char* xb = X8S + ((size_t)x * T + t0) * 128 + c * 16; int* pr = PART + ((size_t)x * T + t0) * 128 + 16 * j;
            u32x4v va[16], vb[16];
            gather_rows16(va, ub, le);
#pragma unroll 1
            for (int tt = 0; tt < 16; tt += 2) {
                const i32x4v xqa = *(const i32x4v*)(xb + (size_t)tt * 128), xqb = *(const i32x4v*)(xb + (size_t)(tt + 1) * 128);
                gather_rows16(vb, ub, le + (tt + 1) * 64);
                udot_item(va, xqa, pr + (size_t)tt * 128, c);
                if (tt + 2 < 16) gather_rows16(va, ub, le + (tt + 2) * 64);
                udot_item(vb, xqb, pr + (size_t)(tt + 1) * 128, c);
            }
            lds_wave_sync();
        }
    }
}

__device__ __forceinline__ void p10b_coef(const Frame& F) {
    const unsigned short* E16 = (const unsigned short*)(F.ws + WS_E16); const float* EW = (const float*)(F.ws + WS_EW); const int* PART = (const int*)(F.ws + WS_PART);
    const float* SU = (const float*)(F.ws + WS_SU); const float* SV = (const float*)(F.ws + WS_SV); const float* SX = (const float*)(F.ws + WS_SX);
    signed char* CQ8 = (signed char*)(F.ws + WS_CQ8); float* CMAX = (float*)(F.ws + WS_CMAX);
    const int gw = blockIdx.x * NWAVES + F.wave, nw = F.G * NWAVES, lane = F.lane;
    for (int t = gw; t < T; t += nw) { const float sx = SX[t]; float cs[2]; float am = 0.f;
#pragma unroll
        for (int hh = 0; hh < 2; ++hh) { const int i = lane + 64 * hh; int s = 0;
#pragma unroll
            for (int x = 0; x < 8; ++x) s += PART[((size_t)x * T + t) * 128 + i];
            const int e = E16[(size_t)t * 128 + i]; const float dot = (float)s * sx * SU[e];
            cs[hh] = EW[(size_t)t * 128 + i] * gelu_tanh(dot) * SV[e]; am = fmaxf(am, fabsf(cs[hh])); }
        am = wave_max(am); const float inv = am > 0.f ? 127.0f / am : 0.f;
#pragma unroll
        for (int hh = 0; hh < 2; ++hh) CQ8[(size_t)t * 128 + lane + 64 * hh] = (signed char)(int)rintf(cs[hh] * inv);
        if (lane == 0) CMAX[t] = am > 0.f ? am / 127.0f : 0.f; }
}

struct VsumPre { float sc; };
__device__ __forceinline__ void vsum_item(const u32x4v (&vv)[16], const LAS unsigned* lq  , const VsumPre& pre, unsigned* pop, int lane) {
    const u32x4v cq = *(const LAS u32x4v*)lq;
    int acc[16];
#pragma unroll
    for (int k = 0; k < 16; ++k) acc[k] = 0;
#pragma unroll
    for (int g = 0; g < 4; ++g) { const int cw = (int)cq[g];
#pragma unroll
        for (int w = 0; w < 4; ++w) { const unsigned r0 = vv[4 * g][w], r1 = vv[4 * g + 1][w], r2 = vv[4 * g + 2][w], r3 = vv[4 * g + 3][w];
            const unsigned t0 = __builtin_amdgcn_perm(r1, r0, 0x05010400u), t1 = __builtin_amdgcn_perm(r1, r0, 0x07030602u), t2 = __builtin_amdgcn_perm(r3, r2, 0x05010400u), t3 = __builtin_amdgcn_perm(r3, r2, 0x07030602u);
            const unsigned c0 = __builtin_amdgcn_perm(t2, t0, 0x05040100u), c1 = __builtin_amdgcn_perm(t2, t0, 0x07060302u), c2 = __builtin_amdgcn_perm(t3, t1, 0x05040100u), c3 = __builtin_amdgcn_perm(t3, t1, 0x07060302u);
            acc[4 * w + 0] = __builtin_amdgcn_sdot4((int)c0, cw, acc[4 * w + 0], false); acc[4 * w + 1] = __builtin_amdgcn_sdot4((int)c1, cw, acc[4 * w + 1], false);
            acc[4 * w + 2] = __builtin_amdgcn_sdot4((int)c2, cw, acc[4 * w + 2], false); acc[4 * w + 3] = __builtin_amdgcn_sdot4((int)c3, cw, acc[4 * w + 3], false); } }
    int a8[8], a4[4], a2[2];
    { const bool hi = (lane & 32) != 0;
#pragma unroll
        for (int k = 0; k < 8; ++k) { const int snd = hi ? acc[k] : acc[k + 8]; const int rcv = __shfl_xor(snd, 32); a8[k] = (hi ? acc[k + 8] : acc[k]) + rcv; } }
    { const bool hi = (lane & 16) != 0;
#pragma unroll
        for (int k = 0; k < 4; ++k) { const int snd = hi ? a8[k] : a8[k + 4]; const int rcv = __shfl_xor(snd, 16); a4[k] = (hi ? a8[k + 4] : a8[k]) + rcv; } }
    { const bool hi = (lane & 8) != 0;
#pragma unroll
        for (int k = 0; k < 2; ++k) { const int snd = hi ? a4[k] : a4[k + 2]; const int rcv = __shfl_xor(snd, 8); a2[k] = (hi ? a4[k + 2] : a4[k]) + rcv; } }
    *pop = pg8::cvt_pk_bf16((float)a2[0] * pre.sc, (float)a2[1] * pre.sc);
}
__device__ __forceinline__ void p10c_vsum(const Frame& F) {
    const unsigned char* V8S = F.ws + WS_V8S; const unsigned short* E16 = (const unsigned short*)(F.ws + WS_E16); const signed char* CQ8 = (const signed char*)(F.ws + WS_CQ8); const float* CMAX = (const float*)(F.ws + WS_CMAX);
    bf16_t* PO = (bf16_t*)(F.ws + WS_PO);
    unsigned* ctr = (unsigned*)(F.ws + WS_CTL + CTL_CTR_B);
    const int lane = F.lane, j = lane >> 3, c = lane & 7; const int xcc = (int)(xb_xcc_id() & 7u);
    const int ocol = 16 * c + 8 * ((lane >> 5) & 1) + 4 * ((lane >> 4) & 1) + 2 * ((lane >> 3) & 1);
    LAS unsigned char* wl = F.lds + F.wave * 8192;
    const LAS unsigned* le = (const LAS unsigned*)wl + 8 * j; const LAS unsigned* lq = (const LAS unsigned*)(wl + 4096) + 4 * j;
    for (int so = 0; so < 8; ++so) { const int x = (xcc + so) & 7;
        const unsigned char* vb = V8S + (size_t)x * NEXP * 128 + c * 16;
        const int col = x * 128 + ocol;
        int nxt = grab_item(ctr, x, lane);
        for (;;) { const int cur = nxt; if (cur >= PEER_NGRP) break;
            nxt = grab_item(ctr, x, lane);
            const int t0 = cur * 16;
            { const u32x4v* src = (const u32x4v*)(E16 + (size_t)t0 * 128); const u32x4v* srq = (const u32x4v*)(CQ8 + (size_t)t0 * 128);
#pragma unroll
                for (int i = 0; i < 4; ++i) *(LAS u32x4v*)(wl + (lane + 64 * i) * 16) = src[lane + 64 * i];
#pragma unroll
                for (int i = 0; i < 2; ++i) *(LAS u32x4v*)(wl + 4096 + (lane + 64 * i) * 16) = srq[lane + 64 * i]; }
            lds_wave_sync();
            u32x4v va[16], vbb[16];
            gather_rows16(va, vb, le);
#pragma unroll 1
            for (int tt = 0; tt < 16; tt += 2) {
                { VsumPre pa; pa.sc = CMAX[t0 + tt];
                  gather_rows16(vbb, vb, le + (tt + 1) * 64);
                  vsum_item(va, lq + tt * 32, pa, (unsigned*)(PO + (size_t)(t0 + tt) * D + col), lane); }
                { VsumPre pb; pb.sc = CMAX[t0 + tt + 1];
                  if (tt + 2 < 16) gather_rows16(va, vb, le + (tt + 2) * 64);
                  vsum_item(vbb, lq + (tt + 1) * 32, pb, (unsigned*)(PO + (size_t)(t0 + tt + 1) * D + col), lane); }
            }
            lds_wave_sync();
        }
    }
}

__device__ __forceinline__ void p10d_final(const Frame& F) {
    const bf16_t* PO = (const bf16_t*)(F.ws + WS_PO); const float* MOD = (const float*)(F.ws + WS_MOD); const float* gfin = F.in[22]; float* out = F.out;
    const int gw = blockIdx.x * NWAVES + F.wave, nw = F.G * NWAVES, lane = F.lane;
    const float* xin = F.in[0]; const bf16_t* Y = (const bf16_t*)(F.ws + WS_Y);
    float4 xn[4]; uint2 pn[4], yn[4];
    if (gw < T) {
#pragma unroll
        for (int i = 0; i < 4; ++i) { const int col = (lane + 64 * i) * 4; xn[i] = *(const float4*)(xin + (size_t)gw * D + col); pn[i] = *(const uint2*)(PO + (size_t)gw * D + col); yn[i] = *(const uint2*)(Y + (size_t)gw * D + col); } }
    for (int t = gw; t < T; t += nw) { const int b = t / S;
        float4 v[4], xc[4]; uint2 pc[4], yc[4]; float ss = 0.f;
#pragma unroll
        for (int i = 0; i < 4; ++i) { xc[i] = xn[i]; pc[i] = pn[i]; yc[i] = yn[i]; }
        { const int tn = t + nw < T ? t + nw : t;
#pragma unroll
            for (int i = 0; i < 4; ++i) { const int col = (lane + 64 * i) * 4; xn[i] = *(const float4*)(xin + (size_t)tn * D + col); pn[i] = *(const uint2*)(PO + (size_t)tn * D + col); yn[i] = *(const uint2*)(Y + (size_t)tn * D + col); } }
#pragma unroll
        for (int i = 0; i < 4; ++i) { const int col = (lane + 64 * i) * 4; const float4 g1 = *(const float4*)(MOD + b * 6144 + 2048 + col), gt = *(const float4*)(MOD + b * 6144 + 5120 + col);
            const uint2 pw = pc[i], yw = yc[i];
            v[i].x = xc[i].x + g1.x * bflo(yw.x) + gt.x * bflo(pw.x); v[i].y = xc[i].y + g1.y * bfhi(yw.x) + gt.y * bfhi(pw.x); v[i].z = xc[i].z + g1.z * bflo(yw.y) + gt.z * bflo(pw.y); v[i].w = xc[i].w + g1.w * bfhi(yw.y) + gt.w * bfhi(pw.y);
            ss += v[i].x * v[i].x + v[i].y * v[i].y + v[i].z * v[i].z + v[i].w * v[i].w; }
        ss = wave_sum(ss);
#ifdef PROBE_STAMP
        const unsigned* dg = (const unsigned*)(F.ws + WS_CTL + 32768); const float pnum = (float)dg[PROBE_STAMP]; const float pden = PROBE_DEN >= 0 ? (float)dg[PROBE_DEN >= 0 ? PROBE_DEN : 0] : (float)PROBE_ABS;
        const float rstd = rsqrtf(ss * (1.0f / D) + EPS) * (1.0f + 0.5f * pnum / pden);
#else
        const float rstd = rsqrtf(ss * (1.0f / D) + EPS);
#endif
#pragma unroll
        for (int i = 0; i < 4; ++i) { const int col = (lane + 64 * i) * 4; const float4 gg = *(const float4*)(gfin + col);
            *(float4*)(out + (size_t)t * D + col) = make_float4(v[i].x * rstd * gg.x, v[i].y * rstd * gg.y, v[i].z * rstd * gg.z, v[i].w * rstd * gg.w); }
    }
}

__device__ __forceinline__ void transpose_tile(const Frame& F, const float* src, int srcK, int srcN, bf16_t* dst, int dstK, int kt, int nt) {
    LAS float* tile = (LAS float*)F.lds;
    const int k0 = kt * 64, n0 = nt * 64;
    for (int i = F.tid; i < 4096; i += NTHREADS) { const int r = i >> 6, c = i & 63; const int k = k0 + r, n = n0 + c;
        tile[r * 65 + c] = (k < srcK && n < srcN) ? src[(size_t)k * srcN + n] : 0.0f; }
    __syncthreads();
    for (int i = F.tid; i < 4096; i += NTHREADS) { const int r = i >> 6, c = i & 63;
        dst[(size_t)(n0 + r) * dstK + k0 + c] = f2bf(tile[c * 65 + r]); }
    __syncthreads();
}
__device__ __forceinline__ void p0_prologue(const Frame& F, int item_lo = 0, int item_hi = 1 << 30) {
    const float* c = F.in[1]; const float* w_mod = F.in[4]; const float* b_mod = F.in[5];
    float* MOD = (float*)(F.ws + WS_MOD);
    constexpr int I_MOD = 96, I_WIN = 16 * 48, I_WOUT = 256, I_WQ = 256, I_U = 256, I_V = 256, I_KEYS = 2, I_CMP = 32 + 32 + 1 + 1 + 2;
    constexpr int O_WIN = I_MOD, O_WOUT = O_WIN + I_WIN, O_WQ = O_WOUT + I_WOUT, O_U = O_WQ + I_WQ, O_V = O_U + I_U, O_KEYS = O_V + I_V, O_CMP = O_KEYS + I_KEYS, N_ITEMS = O_CMP + I_CMP;
    for (int it = item_lo + blockIdx.x; it < N_ITEMS && it < item_hi; it += F.G) {
        if (it < O_WIN) {
            LAS float* sl = (LAS float*)F.lds; LAS float* red = (LAS float*)(F.lds + 65536);
            for (int q = F.tid; q < 16 * D; q += NTHREADS) { const float cv = c[q]; sl[q] = cv / (1.0f + __expf(-cv)); }
            __syncthreads();
            const int kg = F.tid >> 6, cl = F.tid & 63, j0 = it * 64;
            float acc[16];
#pragma unroll
            for (int bb = 0; bb < 16; ++bb) acc[bb] = 0.f;
            const float* wp = w_mod + (size_t)(kg * 128) * 6144 + j0 + cl;
#pragma unroll 4
            for (int kk = 0; kk < 128; ++kk) { const float w = wp[(size_t)kk * 6144]; const int k = kg * 128 + kk;
#pragma unroll
                for (int bb = 0; bb < 16; ++bb) acc[bb] += sl[bb * D + k] * w; }
#pragma unroll
            for (int bb = 0; bb < 16; ++bb) red[(kg * 16 + bb) * 64 + cl] = acc[bb];
            __syncthreads();
#pragma unroll
            for (int q = 0; q < 2; ++q) { const int o = F.tid + 512 * q; const int bb = o >> 6, cc = o & 63; float s = b_mod[j0 + cc];
#pragma unroll
                for (int g8 = 0; g8 < 8; ++g8) s += red[(g8 * 16 + bb) * 64 + cc];
                MOD[bb * 6144 + j0 + cc] = s; }
            __syncthreads();
        } else if (it < O_WOUT) { const int i = it - O_WIN; transpose_tile(F, F.in[6], D, NCOL, (bf16_t*)(F.ws + WS_WIN), D, i % 16, i / 16); }
        else if (it < O_WQ) { const int i = it - O_WOUT; transpose_tile(F, F.in[16], D, D, (bf16_t*)(F.ws + WS_WOUT), D, i % 16, i / 16); }
        else if (it < O_U) { const int i = it - O_WQ; transpose_tile(F, F.in[17], D, D, (bf16_t*)(F.ws + WS_WQ), D, i % 16, i / 16); }
        else if (it < O_KEYS) {
            const bool isv = it >= O_V; const int i = isv ? it - O_V : it - O_U;
            for (int rr = 0; rr < 8; ++rr) { const size_t r = (size_t)i * 64 + rr * 8 + F.wave;
                quant_row_sliced((isv ? F.in[20] : F.in[19]) + r * D, F.ws + (isv ? WS_V8S : WS_U8S), NEXP, r, (float*)(F.ws + (isv ? WS_SV : WS_SU)) + r, 0, F.lane); }
        } else if (it >= O_CMP) {
            const int i = it - O_CMP;
            if (i < 64) { const int kv = i >> 5; transpose_tile(F, kv ? F.in[11] : F.in[9], 2048, 64, (bf16_t*)(F.ws + WS_W1T) + (size_t)kv * 64 * 2048, 2048, i & 31, 0); }
            else if (i < 66) { const int kv = i - 64; transpose_tile(F, kv ? F.in[12] : F.in[10], 64, 64, (bf16_t*)(F.ws + WS_W2T) + (size_t)kv * 64 * 64, 64, 0, 0); }
            else { const int kv = i - 66; const float* pe = kv ? F.in[8] : F.in[7]; const float* w1 = kv ? F.in[11] : F.in[9];
                LAS float* red = (LAS float*)F.lds; const int jj = F.tid & 63, kg = F.tid >> 6; float a = 0.f;
#pragma unroll 8
                for (int kk = 0; kk < 256; ++kk) { const int k = kg * 256 + kk; a += pe[k] * w1[(size_t)k * 64 + jj]; }
                red[kg * 64 + jj] = a; __syncthreads();
                if (F.tid < 64) { float s = 0.f;
#pragma unroll
                    for (int g8 = 0; g8 < 8; ++g8) s += red[g8 * 64 + F.tid];
                    ((float*)(F.ws + WS_PEC))[kv * 64 + F.tid] = s; }
                __syncthreads(); }
        } else {
            const int i = it - O_KEYS; const float4* src = (const float4*)F.in[18] + (size_t)i * 16384; uint2* dst = (uint2*)(F.ws + WS_KEYS) + (size_t)i * 16384;
            for (int q = F.tid; q < 16384; q += NTHREADS) { const float4 v = src[q]; dst[q] = make_uint2(pack2(v.x, v.y), pack2(v.z, v.w)); }
        }
    }
}

__device__ __forceinline__ void norm_mod_rows(const Frame& F, const float* x, const float* g, int sh_off, int sc_off, bf16_t* dst) {
    const float* MOD = (const float*)(F.ws + WS_MOD);
    const int gw = blockIdx.x * NWAVES + F.wave, nw = F.G * NWAVES;
    float4 vn[4];
    if (gw < T) {
#pragma unroll
        for (int i = 0; i < 4; ++i) vn[i] = ((const float4*)(x + (size_t)gw * D))[F.lane + 64 * i]; }
    for (int t = gw; t < T; t += nw) {
        const int b = t / S;
        float4 v[4]; float ss = 0.f;
#pragma unroll
        for (int i = 0; i < 4; ++i) { v[i] = vn[i]; ss += v[i].x * v[i].x + v[i].y * v[i].y + v[i].z * v[i].z + v[i].w * v[i].w; }
        { const int tn = t + nw < T ? t + nw : t;
#pragma unroll
            for (int i = 0; i < 4; ++i) vn[i] = ((const float4*)(x + (size_t)tn * D))[F.lane + 64 * i]; }
        ss = wave_sum(ss); const float rstd = rsqrtf(ss * (1.0f / D) + EPS);
#pragma unroll
        for (int i = 0; i < 4; ++i) { const int col = (F.lane + 64 * i) * 4;
            const float4 gg = *(const float4*)(g + col), sc = *(const float4*)(MOD + b * 6144 + sc_off + col), sh = *(const float4*)(MOD + b * 6144 + sh_off + col);
            const float o0 = v[i].x * rstd * gg.x * (1.f + sc.x) + sh.x, o1 = v[i].y * rstd * gg.y * (1.f + sc.y) + sh.y, o2 = v[i].z * rstd * gg.z * (1.f + sc.z) + sh.z, o3 = v[i].w * rstd * gg.w * (1.f + sc.w) + sh.w;
            *(uint2*)(dst + (size_t)t * D + col) = make_uint2(pack2(o0, o1), pack2(o2, o3)); }
    }
}

__device__ __forceinline__ void norm_mod_rows_q(const Frame& F, const float* x, const float* g, int sh_off, int sc_off, bf16_t* dst) {
    const float* MOD = (const float*)(F.ws + WS_MOD);
    const int gw = blockIdx.x * NWAVES + F.wave, nw = F.G * NWAVES;
    const bf16_t* Y = (const bf16_t*)(F.ws + WS_Y);
    float4 vn[4]; uint2 yn[4];
    if (gw < T) {
#pragma unroll
        for (int i = 0; i < 4; ++i) { vn[i] = ((const float4*)(x + (size_t)gw * D))[F.lane + 64 * i]; yn[i] = ((const uint2*)(Y + (size_t)gw * D))[F.lane + 64 * i]; } }
    for (int t = gw; t < T; t += nw) {
        const int b = t / S;
        float4 v[4]; float ss = 0.f;
#pragma unroll
        for (int i = 0; i < 4; ++i) { const int col = (F.lane + 64 * i) * 4; const float4 gt = *(const float4*)(MOD + b * 6144 + 2048 + col);
            v[i].x = vn[i].x + gt.x * bflo(yn[i].x); v[i].y = vn[i].y + gt.y * bfhi(yn[i].x); v[i].z = vn[i].z + gt.z * bflo(yn[i].y); v[i].w = vn[i].w + gt.w * bfhi(yn[i].y);
            ss += v[i].x * v[i].x + v[i].y * v[i].y + v[i].z * v[i].z + v[i].w * v[i].w; }
        { const int tn = t + nw < T ? t + nw : t;
#pragma unroll
            for (int i = 0; i < 4; ++i) { vn[i] = ((const float4*)(x + (size_t)tn * D))[F.lane + 64 * i]; yn[i] = ((const uint2*)(Y + (size_t)tn * D))[F.lane + 64 * i]; } }
        ss = wave_sum(ss); const float rstd = rsqrtf(ss * (1.0f / D) + EPS);
        float am = 0.f;
#pragma unroll
        for (int i = 0; i < 4; ++i) { const int col = (F.lane + 64 * i) * 4;
            const float4 gg = *(const float4*)(g + col), sc = *(const float4*)(MOD + b * 6144 + sc_off + col), sh = *(const float4*)(MOD + b * 6144 + sh_off + col);
            v[i].x = v[i].x * rstd * gg.x * (1.f + sc.x) + sh.x; v[i].y = v[i].y * rstd * gg.y * (1.f + sc.y) + sh.y; v[i].z = v[i].z * rstd * gg.z * (1.f + sc.z) + sh.z; v[i].w = v[i].w * rstd * gg.w * (1.f + sc.w) + sh.w;
            *(uint2*)(dst + (size_t)t * D + col) = make_uint2(pack2(v[i].x, v[i].y), pack2(v[i].z, v[i].w));
            am = fmaxf(am, fmaxf(fmaxf(fabsf(v[i].x), fabsf(v[i].y)), fmaxf(fabsf(v[i].z), fabsf(v[i].w)))); }
        am = wave_max(am); const float inv = am > 0.f ? 127.0f / am : 0.f;
        if (F.lane == 0) ((float*)(F.ws + WS_SX))[t] = am > 0.f ? am / 127.0f : 0.f;
#pragma unroll
        for (int i = 0; i < 4; ++i) { const int col = (F.lane + 64 * i) * 4; const int sl = col >> 7, off = col & 127;
            const int q0 = (int)rintf(v[i].x * inv), q1 = (int)rintf(v[i].y * inv), q2 = (int)rintf(v[i].z * inv), q3 = (int)rintf(v[i].w * inv);
            *(unsigned*)(F.ws + WS_X8S + ((size_t)sl * T + t) * 128 + off) = (unsigned)(q0 & 0xFF) | ((unsigned)(q1 & 0xFF) << 8) | ((unsigned)(q2 & 0xFF) << 16) | ((unsigned)(q3 & 0xFF) << 24); }
    }
}

__device__ __forceinline__ void p3_compress_naive(const Frame& F) {
    const bf16_t* PROJ = (const bf16_t*)(F.ws + WS_PROJ);
    LAS float* hid = (LAS float*)F.lds + F.wave * 64;
    const int gw = blockIdx.x * NWAVES + F.wave, nw = F.G * NWAVES;
    if (gw < 64) { bf16_t* dz = (bf16_t*)(F.ws + ((gw & 1) ? WS_VC : WS_KC)); dz[((size_t)(gw >> 1) * 128 + 127) * 64 + F.lane] = 0; }
    for (int u = gw; u < NB * NCMP * 2 * 2; u += nw) {
        const int kv = u & 1, g = (u >> 1) & 1, n = (u >> 2) % NCMP, b = (u >> 2) / NCMP;
        const float* pe = kv ? F.in[8] : F.in[7]; const float* w1 = kv ? F.in[11] : F.in[9]; const float* w2 = kv ? F.in[12] : F.in[10];
        const int cbase = (kv ? C_VC : C_KC) + g * 64;
        float acc = 0.f;
        for (int l = 0; l < 32; ++l) {
            const bf16_t* row = PROJ + (size_t)(b * S + 16 * n + l) * NPAD + cbase;
            for (int d = 0; d < 64; ++d) { const float a = bf2f(row[d]) + pe[l * 64 + d]; acc += a * w1[(size_t)(l * 64 + d) * 64 + F.lane]; }
        }
        hid[F.lane] = gelu_tanh(acc); lds_wave_sync();
        float o = 0.f;
        for (int j = 0; j < 64; ++j) o += hid[j] * w2[j * 64 + F.lane];
        bf16_t* dst = (bf16_t*)(F.ws + (kv ? WS_VC : WS_KC)); dst[((size_t)(b * 2 + g) * 128 + n) * 64 + F.lane] = f2bf(o);
        lds_wave_sync();
    }
}


__device__ __forceinline__ void p3_compress_mfma(const Frame& F) {
    const bf16_t* PROJ = (const bf16_t*)(F.ws + WS_PROJ);
    const int lane = F.lane, tid = F.tid, wave = F.wave, grp = lane >> 4, col = lane & 15;
    LAS float* red = (LAS float*)F.lds;
    LAS bf16_t* hid = (LAS bf16_t*)(F.lds + 32768);
    if (blockIdx.x * NWAVES + wave < 64) { const int gw = blockIdx.x * NWAVES + wave; bf16_t* dz = (bf16_t*)(F.ws + ((gw & 1) ? WS_VC : WS_KC)); dz[((size_t)(gw >> 1) * 128 + 127) * 64 + lane] = 0; }
    for (int u = blockIdx.x; u < NB * 2 * 2 * 8; u += F.G) {
        const int nt8 = u & 7, kv = (u >> 3) & 1, g = (u >> 4) & 1, b = u >> 5; const int n0 = nt8 * 16;
        const bf16_t* W1T = (const bf16_t*)(F.ws + WS_W1T) + (size_t)kv * 64 * 2048; const bf16_t* W2T = (const bf16_t*)(F.ws + WS_W2T) + (size_t)kv * 64 * 64;
        const float* pec = (const float*)(F.ws + WS_PEC) + kv * 64;
        const int cbase = (kv ? C_VC : C_KC) + g * 64;
        const int nrow = (n0 + col) < NCMP ? (n0 + col) : (NCMP - 1);
        f32x4 acc[4];
#pragma unroll
        for (int nt = 0; nt < 4; ++nt) acc[nt] = (f32x4){0.f, 0.f, 0.f, 0.f};
#pragma unroll
        for (int ks = 0; ks < 8; ++ks) { const int l = 4 * wave + (ks >> 1), d0 = (ks & 1) * 32 + 8 * grp;
            const bf16x8 af = *(const bf16x8*)(PROJ + (size_t)(b * S + 16 * nrow + l) * NPAD + cbase + d0);
#pragma unroll
            for (int nt = 0; nt < 4; ++nt) { const bf16x8 bfr = *(const bf16x8*)(W1T + (size_t)(nt * 16 + col) * 2048 + l * 64 + d0);
                acc[nt] = __builtin_amdgcn_mfma_f32_16x16x32_bf16(af, bfr, acc[nt], 0, 0, 0); } }
#pragma unroll
        for (int nt = 0; nt < 4; ++nt)
#pragma unroll
            for (int rg = 0; rg < 4; ++rg) red[(wave * 16 + 4 * grp + rg) * 64 + nt * 16 + col] = acc[nt][rg];
        __syncthreads();
#pragma unroll
        for (int q = 0; q < 2; ++q) { const int idx = tid + 512 * q; float s = pec[idx & 63];
#pragma unroll
            for (int w = 0; w < 8; ++w) s += red[w * 1024 + idx];
            hid[idx] = f2bf(gelu_tanh(s)); }
        __syncthreads();
        if (wave < 4) { f32x4 o = (f32x4){0.f, 0.f, 0.f, 0.f};
#pragma unroll
            for (int ks = 0; ks < 2; ++ks) { const bf16x8 af = *(const LAS bf16x8*)(hid + col * 64 + ks * 32 + 8 * grp); const bf16x8 bfr = *(const bf16x8*)(W2T + (size_t)(wave * 16 + col) * 64 + ks * 32 + 8 * grp);
                o = __builtin_amdgcn_mfma_f32_16x16x32_bf16(af, bfr, o, 0, 0, 0); }
            bf16_t* dst = (bf16_t*)(F.ws + (kv ? WS_VC : WS_KC));
#pragma unroll
            for (int rg = 0; rg < 4; ++rg) { const int n = n0 + 4 * grp + rg; if (n < NCMP) dst[((size_t)(b * 2 + g) * 128 + n) * 64 + wave * 16 + col] = f2bf(o[rg]); } }
        __syncthreads();
    }
}

__device__ __forceinline__ void dot4_row(const bf16_t* krow, const LAS float* qs, float (&acc)[4]) {
    const uint4* kr = (const uint4*)krow;
#pragma unroll 1
    for (int c = 0; c < 8; ++c) { asm volatile("" ::: "memory"); const uint4 w = kr[c]; const unsigned ww[4] = {w.x, w.y, w.z, w.w};
#pragma unroll
        for (int e = 0; e < 4; ++e) { const float k0 = bflo(ww[e]), k1 = bfhi(ww[e]); const int d = c * 8 + e * 2;
#pragma unroll
            for (int r = 0; r < 4; ++r) acc[r] += qs[r * 64 + d] * k0 + qs[r * 64 + d + 1] * k1; } }
}
__device__ __forceinline__ void p4_attn_naive(const Frame& F) {
    const bf16_t* PROJ = (const bf16_t*)(F.ws + WS_PROJ); const bf16_t* KC = (const bf16_t*)(F.ws + WS_KC); const bf16_t* VC = (const bf16_t*)(F.ws + WS_VC);
    bf16_t* OATT = (bf16_t*)(F.ws + WS_OATT); const float* rel = F.in[21];
    LAS float* wl = (LAS float*)F.lds + F.wave * (256 + 512 + 2048 + 16);
    LAS float* qs = wl; LAS float* pc = wl + 256; LAS float* ps = wl + 768; LAS int* pbase = (LAS int*)(wl + 768 + 2048);
    const int gw = blockIdx.x * NWAVES + F.wave, nw = F.G * NWAVES, lane = F.lane;
    for (int u = gw; u < T * 2; u += nw) {
        const int g = u & 1, tok = u >> 1, b = tok / S, t = tok % S;
        const bf16_t* prow = PROJ + (size_t)tok * NPAD;
#pragma unroll
        for (int r = 0; r < 4; ++r) qs[r * 64 + lane] = bf2f(prow[C_Q + (g * 4 + r) * 64 + lane]) * 0.125f;
        lds_wave_sync();
        const int nv = t >= 31 ? ((t - 31) >> 4) + 1 : 0;
        float sc[2][4]; bool va[2];
#pragma unroll
        for (int i = 0; i < 2; ++i) { const int n = lane + 64 * i; va[i] = n < nv; float a[4] = {0.f, 0.f, 0.f, 0.f};
            if (va[i]) { dot4_row(KC + ((size_t)(b * 2 + g) * 128 + n) * 64, qs, a); const int bk = rel_bucket(t - (16 * n + 31));
#pragma unroll
                for (int r = 0; r < 4; ++r) a[r] += rel[bk * 8 + g * 4 + r]; }
#pragma unroll
            for (int r = 0; r < 4; ++r) sc[i][r] = va[i] ? a[r] : -1e30f; }
        float ocmp[4];
#pragma unroll
        for (int r = 0; r < 4; ++r) { const float m = wave_max(fmaxf(sc[0][r], sc[1][r]));
            const float e0 = va[0] ? __expf(sc[0][r] - m) : 0.f, e1 = va[1] ? __expf(sc[1][r] - m) : 0.f; const float sum = wave_sum(e0 + e1);
            const float inv = nv > 0 ? 1.0f / sum : 0.f; pc[r * 128 + lane] = e0 * inv; pc[r * 128 + 64 + lane] = e1 * inv; }
        lds_wave_sync();
        { float o[4] = {0.f, 0.f, 0.f, 0.f}; const bf16_t* vb = VC + ((size_t)(b * 2 + g) * 128) * 64 + lane;
            for (int n = 0; n < nv; ++n) { const float v = bf2f(vb[n * 64]);
#pragma unroll
                for (int r = 0; r < 4; ++r) o[r] += pc[r * 128 + n] * v; }
#pragma unroll
            for (int r = 0; r < 4; ++r) ocmp[r] = o[r]; }
        const int cur = t >> 6; float val;
        { const int j = lane & 31; float imp = 0.f;
#pragma unroll
            for (int r = 0; r < 4; ++r) for (int n = 4 * j - 1; n <= 4 * j + 3; ++n) if (n >= 0 && n < NCMP) imp += pc[r * 128 + n];
            const bool forced = (j == 0) || (j == cur) || (j == cur - 1); const bool allowed = j <= cur;
            val = forced ? 1e4f : (allowed ? imp : -INFINITY); }
        int rank = 0;
        for (int jp = 0; jp < 32; ++jp) { const float vp = __shfl(val, jp); rank += ((vp > val) || (vp == val && jp < (lane & 31))) ? 1 : 0; }
        unsigned selmask = (unsigned)(__ballot(lane < 32 && rank < 8) & 0xFFFFFFFFull);
        float oslc[4], owin[4];
#pragma unroll
        for (int br = 0; br < 2; ++br) {
            const int ck = br == 0 ? C_KS : C_KW, cv = br == 0 ? C_VS : C_VW;
            unsigned mk = selmask;
#pragma unroll 1
            for (int c = 0; c < 8; ++c) {
                int kpos, bs;
                if (br == 0) { const int j = __builtin_ctz(mk | 0x80000000u); mk &= mk - 1; bs = 64 * j; } else { bs = t - 511 + 64 * c; }
                kpos = bs + lane; if (lane == 0) pbase[c] = bs;
                const int dist = t - kpos; const bool vv = (dist >= 0) && (kpos >= 0) && (kpos < S);
                float a[4] = {0.f, 0.f, 0.f, 0.f};
                if (vv) { dot4_row(PROJ + (size_t)(b * S + kpos) * NPAD + ck + g * 64, qs, a); const int bk = rel_bucket(dist);
#pragma unroll
                    for (int r = 0; r < 4; ++r) a[r] += rel[bk * 8 + g * 4 + r]; }
#pragma unroll
                for (int r = 0; r < 4; ++r) ps[r * 512 + c * 64 + lane] = vv ? a[r] : -1e30f;
            }
            lds_wave_sync();
#pragma unroll 1
            for (int r = 0; r < 4; ++r) { float m = -1e30f;
#pragma unroll
                for (int c = 0; c < 8; ++c) m = fmaxf(m, ps[r * 512 + c * 64 + lane]);
                m = wave_max(m); float e[8], sum = 0.f;
#pragma unroll
                for (int c = 0; c < 8; ++c) { const float sv = ps[r * 512 + c * 64 + lane]; e[c] = sv > -1e29f ? __expf(sv - m) : 0.f; sum += e[c]; }
                sum = wave_sum(sum); const float inv = sum > 0.f ? 1.0f / sum : 0.f;
#pragma unroll
                for (int c = 0; c < 8; ++c) ps[r * 512 + c * 64 + lane] = e[c] * inv; }
            lds_wave_sync();
            float o[4] = {0.f, 0.f, 0.f, 0.f};
#pragma unroll 1
            for (int c = 0; c < 8; ++c) {
                const int bsc = pbase[c];
                for (int kk = 0; kk < 64; ++kk) { const int kpos = bsc + kk; if (kpos < 0 || kpos > t) continue;
                    const float v = bf2f(PROJ[(size_t)(b * S + kpos) * NPAD + cv + g * 64 + lane]);
#pragma unroll
                    for (int r = 0; r < 4; ++r) o[r] += ps[r * 512 + c * 64 + kk] * v; } }
            lds_wave_sync();
#pragma unroll
            for (int r = 0; r < 4; ++r) { if (br == 0) oslc[r] = o[r]; else owin[r] = o[r]; }
        }
#pragma unroll
        for (int r = 0; r < 4; ++r) { const int h = g * 4 + r;
            const float g0 = sigmoidf_(bf2f(prow[C_GT + h * 3 + 0])), g1 = sigmoidf_(bf2f(prow[C_GT + h * 3 + 1])), g2 = sigmoidf_(bf2f(prow[C_GT + h * 3 + 2]));
            OATT[(size_t)tok * 512 + h * 64 + lane] = f2bf(g0 * ocmp[r] + g1 * oslc[r] + g2 * owin[r]); }
    }
}


constexpr float LOG2E = 1.4426950408889634f;
constexpr int AT_KC = 0, AT_VC = 16384, AT_KV = 32768  , AT_BTAB = 65536, AT_IMP = 69888, AT_SEL = 78336, AT_OUT = 78592  , AT_END = 78592 + 65536;
constexpr int BT_STRIDE = 132;
__device__ __forceinline__ int tile_off(int row, int chunk) { return row * 128 + ((chunk ^ (row & 7)) << 4); }
__device__ __forceinline__ bf16x8 mk_frag(unsigned a, unsigned b, unsigned c, unsigned d) { u32x4v v = {a, b, c, d}; return __builtin_bit_cast(bf16x8, v); }
struct LaneOffs { int koff[2]; int voff[4]; int soff; };
__device__ __forceinline__ LaneOffs lane_offs(int lane, int tid) {
    LaneOffs L; const int grp = lane >> 4, rowi = lane & 15, q4 = rowi >> 2, p = lane & 3;
#pragma unroll
    for (int ks = 0; ks < 2; ++ks) L.koff[ks] = tile_off(rowi, ks * 4 + grp);
#pragma unroll
    for (int dt = 0; dt < 4; ++dt) L.voff[dt] = tile_off(4 * grp + q4, 2 * dt + (p >> 1)) + 8 * (p & 1);
    L.soff = tile_off(tid >> 3, tid & 7); return L;
}
__device__ __forceinline__ bf16x8 vfrag_read(const LAS unsigned char* vt, int voff_dt, int row0) {
    const s16x4 a = __builtin_amdgcn_ds_read_tr16_b64_v4i16((LAS s16x4*)(vt + voff_dt + row0 * 128));
    const s16x4 b = __builtin_amdgcn_ds_read_tr16_b64_v4i16((LAS s16x4*)(vt + voff_dt + row0 * 128 + 2048));
    bf16x8 f = {a[0], a[1], a[2], a[3], b[0], b[1], b[2], b[3]}; return f;
}


struct AttnState {
    f32x4 o[4][2]; float m[2], l[2];
};

__device__ __forceinline__ void at_qk(f32x4 (&sacc)[4][2], const LAS unsigned char* kt_lds, const bf16x8 (&qf)[2][2], const LaneOffs& Lu) {
    int ln_ = threadIdx.x & 63; asm volatile("" : "+v"(ln_)); const LaneOffs L = lane_offs(ln_, 0); (void)Lu;
#pragma unroll
    for (int kt = 0; kt < 4; ++kt) { sacc[kt][0] = (f32x4){0.f, 0.f, 0.f, 0.f}; sacc[kt][1] = (f32x4){0.f, 0.f, 0.f, 0.f}; }
#pragma unroll
    for (int kt = 0; kt < 4; ++kt)
#pragma unroll
        for (int ks = 0; ks < 2; ++ks) { const bf16x8 kf = *(const LAS bf16x8*)(kt_lds + L.koff[ks] + kt * 2048);
            sacc[kt][0] = __builtin_amdgcn_mfma_f32_16x16x32_bf16(kf, qf[0][ks], sacc[kt][0], 0, 0, 0);
            sacc[kt][1] = __builtin_amdgcn_mfma_f32_16x16x32_bf16(kf, qf[1][ks], sacc[kt][1], 0, 0, 0); }
}
__device__ __forceinline__ void at_pv(AttnState& st, const LAS unsigned char* vt_lds, const bf16x8 (&pf)[2][2], const LaneOffs& Lu) {
    int ln_ = threadIdx.x & 63; asm volatile("" : "+v"(ln_)); const LaneOffs L = lane_offs(ln_, 0); (void)Lu;
#pragma unroll
    for (int ks = 0; ks < 2; ++ks)
#pragma unroll
        for (int dt = 0; dt < 4; ++dt) { const bf16x8 vf = vfrag_read(vt_lds, L.voff[dt], 32 * ks);
            st.o[dt][0] = __builtin_amdgcn_mfma_f32_16x16x32_bf16(vf, pf[0][ks], st.o[dt][0], 0, 0, 0);
            st.o[dt][1] = __builtin_amdgcn_mfma_f32_16x16x32_bf16(vf, pf[1][ks], st.o[dt][1], 0, 0, 0); }
}
template <int BR>
__device__ __forceinline__ void at_softmax(f32x4 (&sacc)[4][2], bf16x8 (&pf)[2][2], const LAS float* btab_h, const int (&tq)[2], const unsigned (&sel)[2], int j, bool near, AttnState& st, int lane) {
    const int grp = lane >> 4, kbase = 64 * j;
    const float SC = 0.125f * LOG2E; const float bfar = btab_h[128];
    const int cur_blk = tq[0] >> 6;
    const bool full = BR == 0 ? (j == cur_blk) : (j == cur_blk || j + 8 == cur_blk);
    const bool fast = !near && !full;
    const bool selq[2] = {BR == 0 ? ((sel[0] >> j) & 1u) != 0u : true, BR == 0 ? ((sel[1] >> j) & 1u) != 0u : true};
    float tmax[2];
    if (fast) {
#pragma unroll
        for (int qt = 0; qt < 2; ++qt) {
            float r0 = fmaxf(fmaxf(sacc[0][qt][0], sacc[0][qt][1]), fmaxf(sacc[0][qt][2], sacc[0][qt][3]));
#pragma unroll
            for (int kt = 1; kt < 4; ++kt) r0 = fmaxf(r0, fmaxf(fmaxf(sacc[kt][qt][0], sacc[kt][qt][1]), fmaxf(sacc[kt][qt][2], sacc[kt][qt][3])));
            tmax[qt] = selq[qt] ? r0 * SC + bfar : -1e30f; }
    } else {
#pragma unroll
        for (int qt = 0; qt < 2; ++qt) {
            float tm = -1e30f;
            int d0 = tq[qt] - 4 * grp - kbase; asm volatile("" : "+v"(d0));
#pragma unroll
            for (int kt = 0; kt < 4; ++kt)
#pragma unroll
                for (int rg = 0; rg < 4; ++rg) { const int c = kt * 16 + rg;
                    float bias = bfar; if (near) { const int dist = d0 - c; const int dd = dist < 0 ? 0 : (dist > 128 ? 128 : dist); bias = btab_h[dd]; }
                    const bool valid = BR == 0 ? (selq[qt] && d0 >= c) : (d0 >= c && d0 < 512 + c);
                    const float sx = sacc[kt][qt][rg] * SC + bias; const float s = valid ? sx : -1e30f; sacc[kt][qt][rg] = s; tm = fmaxf(tm, s); }
            tmax[qt] = tm; }
    }
    { const float a0 = __shfl_xor(tmax[0], 16), a1 = __shfl_xor(tmax[1], 16); tmax[0] = fmaxf(tmax[0], a0); tmax[1] = fmaxf(tmax[1], a1); }
    { const float a0 = __shfl_xor(tmax[0], 32), a1 = __shfl_xor(tmax[1], 32); tmax[0] = fmaxf(tmax[0], a0); tmax[1] = fmaxf(tmax[1], a1); }
    float alpha[2], muse[2];
#pragma unroll
    for (int qt = 0; qt < 2; ++qt) { const float mnew = fmaxf(st.m[qt], tmax[qt]); alpha[qt] = __builtin_amdgcn_exp2f(st.m[qt] - mnew); st.m[qt] = mnew; muse[qt] = mnew < -1e29f ? 0.f : mnew; }
#pragma unroll
    for (int qt = 0; qt < 2; ++qt) { const float mul = fast ? SC : 1.0f; const float add = fast ? (selq[qt] ? bfar - muse[qt] : -1e30f) : -muse[qt];
#pragma unroll
        for (int kt = 0; kt < 4; ++kt)
#pragma unroll
            for (int rg = 0; rg < 4; ++rg) sacc[kt][qt][rg] = __builtin_amdgcn_exp2f(sacc[kt][qt][rg] * mul + add); }
#pragma unroll
    for (int qt = 0; qt < 2; ++qt) {
        float ls = 0.f; unsigned pk[4][2];
#pragma unroll
        for (int kt = 0; kt < 4; ++kt) { ls += (sacc[kt][qt][0] + sacc[kt][qt][1]) + (sacc[kt][qt][2] + sacc[kt][qt][3]);
            pk[kt][0] = pg8::cvt_pk_bf16(sacc[kt][qt][0], sacc[kt][qt][1]); pk[kt][1] = pg8::cvt_pk_bf16(sacc[kt][qt][2], sacc[kt][qt][3]); }
        st.l[qt] = st.l[qt] * alpha[qt] + ls;
        pf[qt][0] = mk_frag(pk[0][0], pk[0][1], pk[1][0], pk[1][1]); pf[qt][1] = mk_frag(pk[2][0], pk[2][1], pk[3][0], pk[3][1]); }
    if (!__all(alpha[0] == 1.0f && alpha[1] == 1.0f)) {
#pragma unroll
        for (int qt = 0; qt < 2; ++qt)
#pragma unroll
            for (int dt = 0; dt < 4; ++dt) st.o[dt][qt] *= alpha[qt]; }
    __builtin_amdgcn_sched_barrier(0);
}
template <int BR>
__device__ __forceinline__ void attn_tile(const LAS unsigned char* kt_lds, const LAS unsigned char* vt_lds, const LAS float* btab_h, const bf16x8 (&qf)[2][2], const int (&tq)[2], const unsigned (&sel)[2],
                                          int j, bool near, AttnState& st, int lane, const LaneOffs& L, LAS unsigned char* F_lds_) {
#if defined(PROBE_STAMP) && PROBE_LEVEL >= 2
    STAMP_DECL; STAMP_START();
#define TSTAMP(k) STAMP(k)
#else
#define TSTAMP(k) do {} while (0)
#endif
    f32x4 sacc[4][2]; bf16x8 pf[2][2];
    at_qk(sacc, kt_lds, qf, L);
    __builtin_amdgcn_sched_barrier(0);
    TSTAMP(0);
#if defined(PROBE_STAMP) && PROBE_LEVEL >= 3
    { float x_ = sacc[3][1][3]; asm volatile("" :: "v"(x_)); }
    TSTAMP(3);
#endif
    at_softmax<BR>(sacc, pf, btab_h, tq, sel, j, near, st, lane);
    TSTAMP(1);
    at_pv(st, vt_lds, pf, L);
    TSTAMP(2);
#undef TSTAMP
}

template <int BR>
__device__ __forceinline__ void attn_branch(const Frame& F, const bf16_t* PROJ, int b, int g, int t0, unsigned tiles  , const LAS float* btab_h,
                                            const bf16x8 (&qf)[2][2], const int (&tq)[2], const unsigned (&sel)[2], const float (&gate)[2], const LaneOffs& L) {
    const int lane = F.lane, tid = F.tid;
    const int ck = (BR == 0 ? C_KS : C_KW) + g * 64, cv = (BR == 0 ? C_VS : C_VW) + g * 64;
    const int srow = tid >> 3, sch = tid & 7;
    LAS unsigned char* F_lds_ = F.lds; STAMP_DECL; STAMP_START();
    AttnState st;
#pragma unroll
    for (int dt = 0; dt < 4; ++dt) { st.o[dt][0] = (f32x4){0.f, 0.f, 0.f, 0.f}; st.o[dt][1] = (f32x4){0.f, 0.f, 0.f, 0.f}; }
    st.m[0] = st.m[1] = -1e30f; st.l[0] = st.l[1] = 0.f;
    unsigned rem = tiles; int cur = 0;
#ifdef PROBE_SHALLOW
    u32x4v rk0, rv0;
#else
    u32x4v rk0, rv0, rk1, rv1;
#endif
    const bf16_t* srcb = PROJ + (size_t)(b * S + srow) * NPAD + sch * 8;
#define AT_LOAD(RK, RV, jj) do { const bf16_t* rowp = srcb + (size_t)(64 * (jj)) * NPAD; RK = *(const u32x4v*)(rowp + ck); RV = *(const u32x4v*)(rowp + cv); } while (0)
#define AT_WRITE(RK, RV, bufi) do { *(LAS u32x4v*)(F.lds + AT_KV + (bufi) * 16384 + L.soff) = RK; *(LAS u32x4v*)(F.lds + AT_KV + (bufi) * 16384 + 8192 + L.soff) = RV; } while (0)
#define AT_COMPUTE(jj) do { STAMP_COUNT(4); const bool near = (t0 + 8 * F.wave) - (64 * (jj) + 63) < 128; \
        attn_tile<BR>(F.lds + AT_KV + cur * 16384, F.lds + AT_KV + cur * 16384 + 8192, btab_h, qf, tq, sel, (jj), near, st, lane, L, F.lds); } while (0)
#ifdef PROBE_SHALLOW
    { int j = __builtin_ctz(rem); rem &= rem - 1;
      AT_LOAD(rk0, rv0, j); AT_WRITE(rk0, rv0, 0);
      __syncthreads();
      for (;;) {
          int jn = j; const bool hn = rem != 0u; if (hn) { jn = __builtin_ctz(rem); rem &= rem - 1; }
          STAMP(12);
          AT_LOAD(rk0, rv0, jn);
          AT_COMPUTE(j);
          STAMP(13);
          AT_WRITE(rk0, rv0, cur ^ 1);
          asm volatile("s_waitcnt lgkmcnt(0)" ::: "memory");
          STAMP(8);
          __syncthreads(); cur ^= 1;
          STAMP(9);
          if (!hn) break;
          j = jn; } }
#else
    int j = __builtin_ctz(rem); rem &= rem - 1;
    AT_LOAD(rk0, rv0, j); AT_WRITE(rk0, rv0, 0);
    int j1 = j; bool h1 = rem != 0u; if (h1) { j1 = __builtin_ctz(rem); rem &= rem - 1; }
    AT_LOAD(rk0, rv0, j1);
    __syncthreads();
    for (;;) {
        int j2 = j1; bool h2 = rem != 0u; if (h2) { j2 = __builtin_ctz(rem); rem &= rem - 1; }
        AT_LOAD(rk1, rv1, j2);
        AT_COMPUTE(j);
        AT_WRITE(rk0, rv0, cur ^ 1);
        __syncthreads(); cur ^= 1;
        if (!h1) break;
        int j3 = j2; bool h3 = rem != 0u; if (h3) { j3 = __builtin_ctz(rem); rem &= rem - 1; }
        AT_LOAD(rk0, rv0, j3);
        AT_COMPUTE(j1);
        AT_WRITE(rk1, rv1, cur ^ 1);
        __syncthreads(); cur ^= 1;
        if (!h2) break;
        j = j2; j1 = j3; h1 = h3;
    }
#endif
    STAMP(5 + BR);
#undef AT_LOAD
#undef AT_WRITE
#undef AT_COMPUTE
    int pob = AT_OUT + tid * 4; asm volatile("" : "+v"(pob));
    LAS float* po = (LAS float*)(F.lds + pob);
#pragma unroll
    for (int qt = 0; qt < 2; ++qt) { float l = st.l[qt]; l += __shfl_xor(l, 16); l += __shfl_xor(l, 32); const float sc = l > 0.f ? gate[qt] / l : 0.f;
#pragma unroll
        for (int dt = 0; dt < 4; ++dt)
#pragma unroll
            for (int e = 0; e < 4; ++e) po[((qt * 4 + dt) * 4 + e) * 512] += st.o[dt][qt][e] * sc; }
}


template <int BR>
__device__ __forceinline__ void attn_branch_stag(const Frame& F, const bf16_t* PROJ, int b, int g, int t0, unsigned tiles, const LAS float* btab_h,
                                                 const bf16x8 (&qf)[2][2], const int (&tq)[2], const unsigned (&sel)[2], int hcol  , const LaneOffs& L) {
    const int lane = F.lane, tid = F.tid;
    const bool isB = F.wave >= 4;
    const int ck = (BR == 0 ? C_KS : C_KW) + g * 64, cv = (BR == 0 ? C_VS : C_VW) + g * 64;
    const int srow = tid >> 3, sch = tid & 7;
    AttnState st;
#pragma unroll
    for (int dt = 0; dt < 4; ++dt) { st.o[dt][0] = (f32x4){0.f, 0.f, 0.f, 0.f}; st.o[dt][1] = (f32x4){0.f, 0.f, 0.f, 0.f}; }
    st.m[0] = st.m[1] = -1e30f; st.l[0] = st.l[1] = 0.f;
    const bf16_t* srcb = PROJ + (size_t)(b * S + srow) * NPAD + sch * 8;
    LAS unsigned char* KB = F.lds + AT_KV;
#define SG_LOADK(R, jj) do { R = *(const u32x4v*)(srcb + (size_t)(64 * (jj)) * NPAD + ck); } while (0)
#define SG_LOADV(R, jj) do { R = *(const u32x4v*)(srcb + (size_t)(64 * (jj)) * NPAD + cv); } while (0)
#define SG_BAR() do { asm volatile("s_waitcnt lgkmcnt(0)" ::: "memory"); __builtin_amdgcn_s_barrier(); asm volatile("" ::: "memory"); } while (0)
    unsigned rem = tiles;
    int j0 = __builtin_ctz(rem); rem &= rem - 1;
    bool h1 = rem != 0u; int j1 = j0; if (h1) { j1 = __builtin_ctz(rem); rem &= rem - 1; }
    bool h2 = rem != 0u; int j2 = j1; if (h2) { j2 = __builtin_ctz(rem); rem &= rem - 1; }
    u32x4v rk, rv;
    { u32x4v a, c2, d2; SG_LOADK(a, j0); SG_LOADV(c2, j0); SG_LOADK(d2, j1);
      *(LAS u32x4v*)(KB + L.soff) = a; *(LAS u32x4v*)(KB + 16384 + L.soff) = c2; *(LAS u32x4v*)(KB + 8192 + L.soff) = d2; }
    SG_LOADK(rk, j2); SG_LOADV(rv, j1);
    SG_BAR();
    f32x4 sacc[4][2]; bf16x8 pf[2][2];
    at_qk(sacc, KB, qf, L);
    if (isB) SG_BAR();
    int i = 0;
    for (;;) {
        { const bool near = (t0 + 8 * F.wave) - (64 * j0 + 63) < 128; at_softmax<BR>(sacc, pf, btab_h, tq, sel, j0, near, st, lane); }
        SG_BAR();
        at_pv(st, KB + 16384 + (i & 1) * 8192, pf, L);
        if (h1) at_qk(sacc, KB + ((i + 1) & 1) * 8192, qf, L);
        *(LAS u32x4v*)(KB + (i & 1) * 8192 + L.soff) = rk; *(LAS u32x4v*)(KB + 16384 + ((i + 1) & 1) * 8192 + L.soff) = rv;
        bool h3 = rem != 0u; int j3 = j2; if (h3) { j3 = __builtin_ctz(rem); rem &= rem - 1; }
        SG_LOADK(rk, j3); SG_LOADV(rv, j2);
        SG_BAR();
        if (!h1) break;
        j0 = j1; j1 = j2; j2 = j3; h1 = h2; h2 = h3; ++i;
    }
    if (!isB) SG_BAR();
#undef SG_LOADK
#undef SG_LOADV
#undef SG_BAR
    int pob = AT_OUT + tid * 4; asm volatile("" : "+v"(pob));
    LAS float* po = (LAS float*)(F.lds + pob);
#pragma unroll
    for (int qt = 0; qt < 2; ++qt) { float l = st.l[qt]; l += __shfl_xor(l, 16); l += __shfl_xor(l, 32);
        const float gq = sigmoidf_(bf2f(PROJ[(size_t)(b * S + tq[qt]) * NPAD + C_GT + hcol * 3 + 1 + BR]));
        const float sc = l > 0.f ? gq / l : 0.f;
#pragma unroll
        for (int dt = 0; dt < 4; ++dt)
#pragma unroll
            for (int e = 0; e < 4; ++e) po[((qt * 4 + dt) * 4 + e) * 512] += st.o[dt][qt][e] * sc; }
}

template <int MODE>
__device__ __forceinline__ void p4_attn_mfma_t(const Frame& F) {
    const bf16_t* PROJ = (const bf16_t*)(F.ws + WS_PROJ); const bf16_t* KC = (const bf16_t*)(F.ws + WS_KC); const bf16_t* VC = (const bf16_t*)(F.ws + WS_VC);
    bf16_t* OATT = (bf16_t*)(F.ws + (MODE == 0 ? WS_OATT : WS_H)); const float* rel = F.in[21];
    const int lane = F.lane, tid = F.tid, wave = F.wave, grp = lane >> 4, col = lane & 15, qi = col >> 2, r = col & 3;
    LAS float* btab = (LAS float*)(F.lds + AT_BTAB); LAS float* impq = (LAS float*)(F.lds + AT_IMP); LAS unsigned* selm = (LAS unsigned*)(F.lds + AT_SEL);
    const LaneOffs L = lane_offs(lane, tid);
    for (int i = tid; i < 8 * 129; i += NTHREADS) { const int hh = i / 129, dd = i % 129; btab[hh * BT_STRIDE + dd] = rel[rel_bucket(dd) * 8 + hh] * LOG2E; }
    __syncthreads();
    LAS unsigned char* F_lds_ = F.lds; STAMP_DECL;
#ifdef PROBE_STAMP
    if (tid < 16) ((volatile LAS unsigned*)(F.lds + LDS_MISC_OFF + 128))[tid] = 0u;
    __syncthreads();
#endif
    STAMP_START();
    for (int uu = blockIdx.x; uu < 1024; uu += F.G) {
        int qb, bg;
        if (F.G == 256) { const int round = uu >> 8, k = uu & 255; const int a = k >> 5; bg = k & 31;
            qb = (a == 0) ? (round == 0 ? 25 : round == 1 ? 23 : round == 2 ? 17 : 0) : (a == 1) ? (round == 0 ? 27 : round == 1 ? 19 : round == 2 ? 18 : 1) : (a == 2) ? (round == 0 ? 31 : round == 1 ? 13 : round == 2 ? 12 : 5)
               : (a == 3) ? (round == 0 ? 26 : round == 1 ? 21 : round == 2 ? 15 : 2) : (a == 4) ? (round == 0 ? 30 : round == 1 ? 22 : round == 2 ? 8 : 3) : (a == 5) ? (round == 0 ? 28 : round == 1 ? 20 : round == 2 ? 9 : 4)
               : (a == 6) ? (round == 0 ? 29 : round == 1 ? 14 : round == 2 ? 10 : 6) : (round == 0 ? 24 : round == 1 ? 16 : round == 2 ? 11 : 7); }
        else { qb = 31 - (uu >> 5); bg = uu & 31; }
        const int b = bg >> 1, g = bg & 1, t0 = qb * 64, h = g * 4 + r;
        const LAS float* btab_h = btab + h * BT_STRIDE;
        int tq[2]; bf16x8 qf[2][2]; float gate[3][2];
#pragma unroll
        for (int qt = 0; qt < 2; ++qt) { tq[qt] = t0 + 8 * wave + 4 * qt + qi; const bf16_t* prow = PROJ + (size_t)(b * S + tq[qt]) * NPAD;
#pragma unroll
            for (int ks = 0; ks < 2; ++ks) qf[qt][ks] = *(const bf16x8*)(prow + C_Q + h * 64 + ks * 32 + 8 * grp);
#pragma unroll
            for (int jg = 0; jg < 3; ++jg) gate[jg][qt] = sigmoidf_(bf2f(prow[C_GT + h * 3 + jg])); }
#pragma unroll
        for (int i = 0; i < 2; ++i) { const int c2 = tid + 512 * i, row = c2 >> 3, ch = c2 & 7; const size_t src = ((size_t)(b * 2 + g) * 128 + row) * 64 + ch * 8;
            *(LAS u32x4v*)(F.lds + AT_KC + L.soff + 8192 * i) = *(const u32x4v*)(KC + src); *(LAS u32x4v*)(F.lds + AT_VC + L.soff + 8192 * i) = *(const u32x4v*)(VC + src); }
        __syncthreads();
#ifndef AT_SKIP_CMP
        {
            const int nvmax = t0 + 63 >= 31 ? ((t0 + 63 - 31) >> 4) + 1 : 0;
            const float SC = 0.125f * LOG2E; const int srcl = (lane + 48) & 63;
            int pob = AT_OUT + tid * 4; asm volatile("" : "+v"(pob));
            LAS float* po = (LAS float*)(F.lds + pob);
#pragma unroll
            for (int qt = 0; qt < 2; ++qt) {
                f32x4 sa[8];
#pragma unroll
                for (int kt = 0; kt < 8; ++kt) sa[kt] = (f32x4){0.f, 0.f, 0.f, 0.f};
#pragma unroll
                for (int kt = 0; kt < 8; ++kt) if (kt * 16 < nvmax) {
#pragma unroll
                    for (int ks = 0; ks < 2; ++ks) { const bf16x8 kf = *(const LAS bf16x8*)(F.lds + AT_KC + L.koff[ks] + kt * 2048);
                        sa[kt] = __builtin_amdgcn_mfma_f32_16x16x32_bf16(kf, qf[qt][ks], sa[kt], 0, 0, 0); } }
                __builtin_amdgcn_sched_barrier(0);
                int d0 = tq[qt] - 31 - 64 * grp; asm volatile("" : "+v"(d0));
                float mx = -1e30f;
#pragma unroll
                for (int kt = 0; kt < 8; ++kt)
#pragma unroll
                    for (int rg = 0; rg < 4; ++rg) { const int c = 256 * kt + 16 * rg; const int dist = d0 - c; const int dd = dist < 0 ? 0 : (dist > 128 ? 128 : dist);
                        const float sx = sa[kt][rg] * SC + btab_h[dd]; const float s = d0 >= c ? sx : -1e30f; sa[kt][rg] = s; mx = fmaxf(mx, s); }
                mx = fmaxf(mx, __shfl_xor(mx, 16)); mx = fmaxf(mx, __shfl_xor(mx, 32));
                float sum = 0.f;
#pragma unroll
                for (int kt = 0; kt < 8; ++kt)
#pragma unroll
                    for (int rg = 0; rg < 4; ++rg) { const int c = 256 * kt + 16 * rg; const float ex = __builtin_amdgcn_exp2f(sa[kt][rg] - mx); const float e = d0 >= c ? ex : 0.f; sa[kt][rg] = e; sum += e; }
                __builtin_amdgcn_sched_barrier(0);
                sum += __shfl_xor(sum, 16); sum += __shfl_xor(sum, 32);
                const float inv = sum > 0.f ? 1.0f / sum : 0.f;
                float prev3 = 0.f;
#pragma unroll
                for (int kt = 0; kt < 8; ++kt) { const float p3 = sa[kt][3] * inv; const float part = (sa[kt][0] * inv + sa[kt][1] * inv) + (sa[kt][2] * inv + p3);
                    const float xa = __shfl(p3, srcl), xb = __shfl(prev3, srcl); float tot = part + (grp >= 1 ? xa : xb);
                    tot += __shfl_xor(tot, 1); tot += __shfl_xor(tot, 2);
                    if (r == 0) impq[(8 * wave + 4 * qt + qi) * 33 + 4 * kt + grp] = tot;
                    prev3 = p3; }
                __builtin_amdgcn_sched_barrier(0);
                f32x4 oc[4];
#pragma unroll
                for (int dt = 0; dt < 4; ++dt) oc[dt] = (f32x4){0.f, 0.f, 0.f, 0.f};
#pragma unroll
                for (int ks = 0; ks < 4; ++ks) if (ks * 32 < nvmax) {
                    const bf16x8 pfr = mk_frag(pg8::cvt_pk_bf16(sa[2 * ks][0], sa[2 * ks][1]), pg8::cvt_pk_bf16(sa[2 * ks][2], sa[2 * ks][3]),
                                               pg8::cvt_pk_bf16(sa[2 * ks + 1][0], sa[2 * ks + 1][1]), pg8::cvt_pk_bf16(sa[2 * ks + 1][2], sa[2 * ks + 1][3]));
#pragma unroll
                    for (int dt = 0; dt < 4; ++dt) { const bf16x8 vf = vfrag_read(F.lds + AT_VC, L.voff[dt], 32 * ks); oc[dt] = __builtin_amdgcn_mfma_f32_16x16x32_bf16(vf, pfr, oc[dt], 0, 0, 0); } }
                const float scq = inv * gate[0][qt];
#pragma unroll
                for (int dt = 0; dt < 4; ++dt)
#pragma unroll
                    for (int e = 0; e < 4; ++e) po[((qt * 4 + dt) * 4 + e) * 512] = oc[dt][e] * scq;
                __builtin_amdgcn_sched_barrier(0);
            }
        }
#endif
        __syncthreads();
#ifndef AT_SKIP_SEL
        {
            const int q = tid >> 3, jj = tid & 7, cur = qb; unsigned bits = 0u;
            float vj[4];
#pragma unroll
            for (int e = 0; e < 4; ++e) { const int j = jj * 4 + e; const bool forced = (j == 0) || (j == cur) || (j == cur - 1); vj[e] = forced ? 1e4f : (j <= cur ? impq[q * 33 + j] : -INFINITY); }
            int rk[4] = {0, 0, 0, 0};
            for (int jp = 0; jp < 32; ++jp) { const bool forced = (jp == 0) || (jp == cur) || (jp == cur - 1); const float vp = forced ? 1e4f : (jp <= cur ? impq[q * 33 + jp] : -INFINITY);
#pragma unroll
                for (int e = 0; e < 4; ++e) rk[e] += ((vp > vj[e]) || (vp == vj[e] && jp < jj * 4 + e)) ? 1 : 0; }
#pragma unroll
            for (int e = 0; e < 4; ++e) bits |= (rk[e] < 8 ? 1u : 0u) << (jj * 4 + e);
            bits |= __shfl_xor(bits, 1); bits |= __shfl_xor(bits, 2); bits |= __shfl_xor(bits, 4);
            if (jj == 0) selm[q] = bits;
        }
#endif
        __syncthreads();
        unsigned sel[2] = {selm[8 * wave + qi], selm[8 * wave + 4 + qi]};
        unsigned un = selm[lane];
#pragma unroll
        for (int o = 32; o >= 1; o >>= 1) un |= __shfl_xor(un, o);
        un = __builtin_amdgcn_readfirstlane(un);
        const unsigned causal = qb == 31 ? 0xFFFFFFFFu : ((2u << qb) - 1u);
        if (MODE != 1 && MODE != 2) { const float gt1[2] = {gate[1][0], gate[1][1]};
#ifndef ATTN_STAGGER
            attn_branch<0>(F, PROJ, b, g, t0, un & causal, btab_h, qf, tq, sel, gt1, L);
#else
            attn_branch_stag<0>(F, PROJ, b, g, t0, un & causal, btab_h, qf, tq, sel, h, L);
#endif
        }
        if (MODE != 2) { const int jlo = qb >= 8 ? qb - 8 : 0; const unsigned wmask = causal & ~((1u << jlo) - 1u); const float gt2[2] = {gate[2][0], gate[2][1]};

#ifndef ATTN_STAGGER
            attn_branch<1>(F, PROJ, b, g, t0, wmask, btab_h, qf, tq, sel, gt2, L);
#else
            attn_branch_stag<1>(F, PROJ, b, g, t0, wmask, btab_h, qf, tq, sel, h, L);
#endif
        }
        int pob2 = AT_OUT + tid * 4; asm volatile("" : "+v"(pob2));
#pragma unroll
        for (int qt = 0; qt < 2; ++qt) { bf16_t* orow = OATT + (size_t)(b * S + tq[qt]) * 512 + h * 64 + 4 * grp;
#pragma unroll
            for (int dt = 0; dt < 4; ++dt) { const LAS float* po = (const LAS float*)(F.lds + pob2) + (qt * 4 + dt) * 4 * 512;
                *(uint2*)(orow + dt * 16) = make_uint2(pg8::cvt_pk_bf16(po[0], po[512]), pg8::cvt_pk_bf16(po[1024], po[1536])); } }
    }
    STAMP(7);
#ifdef PROBE_STAMP
    __syncthreads();
    if (PROBE_PHASE == 4 && MODE == 0 && blockIdx.x == PROBE_BLOCK && tid < 16) ((unsigned*)(F.ws + WS_CTL + 32768))[tid] = ((volatile LAS unsigned*)(F.lds + LDS_MISC_OFF + 128))[tid];
#endif
}

__device__ __forceinline__ void p5_mixed(const Frame& F) {
    const bf16_t* PROJ = (const bf16_t*)(F.ws + WS_PROJ); const bf16_t* OATT = (const bf16_t*)(F.ws + WS_OATT); bf16_t* MIX = (bf16_t*)(F.ws + WS_H);
    const float* cw = F.in[13]; const float* ga = F.in[14]; const float* gc = F.in[15];
    const int gw = blockIdx.x * NWAVES + F.wave, nw = F.G * NWAVES, lane = F.lane, c0 = lane * 8;
    float w0[8], w1[8], w2[8], gav[8], gcv[8];
#pragma unroll
    for (int e = 0; e < 8; ++e) { w0[e] = cw[c0 + e]; w1[e] = cw[512 + c0 + e]; w2[e] = cw[1024 + c0 + e]; gav[e] = ga[c0 + e]; gcv[e] = gc[c0 + e]; }
    for (int chunk = gw; chunk < T / 16; chunk += nw) {
        const int t0 = chunk * 16, s0 = t0 % S;
        float z1[8], z2[8];
#pragma unroll
        for (int e = 0; e < 8; ++e) { z1[e] = 0.f; z2[e] = 0.f; }
        if (s0 > 0) {
#pragma unroll
            for (int back = 1; back <= 2; ++back) { const bf16_t* row = PROJ + (size_t)(t0 - back) * NPAD;
                const u32x4v wc = *(const u32x4v*)(row + C_CC + c0), wh = *(const u32x4v*)(row + C_CH + c0);
#pragma unroll
                for (int e = 0; e < 4; ++e) { const float a = bflo(wc[e]) * bflo(wh[e]), bq = bfhi(wc[e]) * bfhi(wh[e]); if (back == 1) { z1[2 * e] = a; z1[2 * e + 1] = bq; } else { z2[2 * e] = a; z2[2 * e + 1] = bq; } } } }
        u32x4v na, nc, nh, nb;
        { const bf16_t* row = PROJ + (size_t)t0 * NPAD; na = *(const u32x4v*)(OATT + (size_t)t0 * 512 + c0); nc = *(const u32x4v*)(row + C_CC + c0); nh = *(const u32x4v*)(row + C_CH + c0); nb = *(const u32x4v*)(row + C_CB + c0); }
#pragma unroll 1
        for (int i = 0; i < 16; ++i) { const int tok = t0 + i;
            const u32x4v wa = na, wc = nc, wh = nh, wb = nb;
            { const int tn = i < 15 ? tok + 1 : tok; const bf16_t* row = PROJ + (size_t)tn * NPAD;
                na = *(const u32x4v*)(OATT + (size_t)tn * 512 + c0); nc = *(const u32x4v*)(row + C_CC + c0); nh = *(const u32x4v*)(row + C_CH + c0); nb = *(const u32x4v*)(row + C_CB + c0); }
            float a[8], y[8], z0[8];
#pragma unroll
            for (int e = 0; e < 4; ++e) { a[2 * e] = bflo(wa[e]); a[2 * e + 1] = bfhi(wa[e]); z0[2 * e] = bflo(wc[e]) * bflo(wh[e]); z0[2 * e + 1] = bfhi(wc[e]) * bfhi(wh[e]); }
#pragma unroll
            for (int e = 0; e < 8; ++e) y[e] = w0[e] * z2[e] + w1[e] * z1[e] + w2[e] * z0[e];
#pragma unroll
            for (int e = 0; e < 4; ++e) { y[2 * e] *= bflo(wb[e]); y[2 * e + 1] *= bfhi(wb[e]); }
            float sa = 0.f, sy = 0.f;
#pragma unroll
            for (int e = 0; e < 8; ++e) { sa += a[e] * a[e]; sy += y[e] * y[e]; }
            sa = wave_sum(sa); sy = wave_sum(sy);
            const float ra = rsqrtf(sa * (1.0f / 512) + EPS), ry = rsqrtf(sy * (1.0f / 512) + EPS);
            unsigned oa[4], oy[4];
#pragma unroll
            for (int e = 0; e < 4; ++e) { oa[e] = pack2(a[2 * e] * ra * gav[2 * e], a[2 * e + 1] * ra * gav[2 * e + 1]); oy[e] = pack2(y[2 * e] * ry * gcv[2 * e], y[2 * e + 1] * ry * gcv[2 * e + 1]); }
            *(uint4*)(MIX + (size_t)tok * D + c0) = make_uint4(oa[0], oa[1], oa[2], oa[3]);
            *(uint4*)(MIX + (size_t)tok * D + 512 + c0) = make_uint4(oy[0], oy[1], oy[2], oy[3]);
#pragma unroll
            for (int e = 0; e < 8; ++e) { z2[e] = z1[e]; z1[e] = z0[e]; }
        }
    }
}

struct EpiResGate {
    static constexpr bool PERM = false, AFTER_DRAIN = false;
    float* C; const float* X; const float* MOD; int gate_off;
    __device__ __forceinline__ void operator()(const pg8::f32x4 (&acc)[2][2][4][2], const pg8::Unit& u, int wr, int wc, int fr, int fq) const {
        using pg8::f32x4; using pg8::HALF; using pg8::BM;
        const int row0 = u.pm * BM + wr * 64 + fr, col0 = u.pn * BM + wc * 32 + 4 * fq;
        const int b = (u.pm * BM) / S;
        f32x4 gv[2][2];
#pragma unroll
        for (int bj = 0; bj < 2; ++bj)
#pragma unroll
            for (int n = 0; n < 2; ++n) gv[bj][n] = *(const f32x4*)(MOD + b * 6144 + gate_off + col0 + bj * HALF + n * 16);
#pragma unroll
        for (int ai = 0; ai < 2; ++ai)
#pragma unroll
            for (int m = 0; m < 4; ++m) { const size_t ro = (size_t)(row0 + ai * HALF + m * 16) * D + col0;
#pragma unroll
                for (int bj = 0; bj < 2; ++bj)
#pragma unroll
                    for (int n = 0; n < 2; ++n) { const f32x4 xv = *(const f32x4*)(X + ro + bj * HALF + n * 16); *(f32x4*)(C + ro + bj * HALF + n * 16) = xv + gv[bj][n] * acc[ai][bj][m][n]; } }
    }
};

__device__ __forceinline__ int ord_i(float f) { const int u = __float_as_int(f); return u >= 0 ? u : (u ^ 0x7FFFFFFF); }
__device__ __forceinline__ float unord_f(int i) { const int u = i >= 0 ? i : (i ^ 0x7FFFFFFF); return __int_as_float(u); }
#define INT_MIN_ (-2147483647 - 1)
struct CandTab { int a[50], b[50]; };
constexpr CandTab make_cand() { CandTab t{}; int n = 0; for (int a = 0; a < 16; ++a) for (int b = 0; b < 16; ++b) if ((a + 1) * (b + 1) <= 16) { t.a[n] = a; t.b[n] = b; ++n; } return t; }
constexpr CandTab CAND = make_cand();

template <int N, bool DESC> __device__ __forceinline__ void bitonic_sort_i(int (&v)[N]) {
#pragma unroll
    for (int k = 2; k <= N; k <<= 1)
#pragma unroll
        for (int j = k >> 1; j > 0; j >>= 1)
#pragma unroll
            for (int i = 0; i < N; ++i) { const int l = i ^ j; if (l > i) { const bool up = ((i & k) == 0) != DESC; const int lo = min(v[i], v[l]), hi = max(v[i], v[l]); v[i] = up ? lo : hi; v[l] = up ? hi : lo; } }
}
template <int N, bool DESC> __device__ __forceinline__ void bitonic_merge_i(int (&v)[N]) {
#pragma unroll
    for (int j = N >> 1; j > 0; j >>= 1)
#pragma unroll
        for (int i = 0; i < N; ++i) { const int l = i ^ j; if (l > i) { const int lo = min(v[i], v[l]), hi = max(v[i], v[l]); v[i] = DESC ? hi : lo; v[l] = DESC ? lo : hi; } }
}
__device__ __forceinline__ void merge_top16_across(int (&t)[16]) {
#pragma unroll
    for (int m = 16; m <= 32; m <<= 1) { int y[16];
#pragma unroll
        for (int i = 0; i < 16; ++i) y[i] = max(t[i], __shfl_xor(t[15 - i], m));
        bitonic_merge_i<16, true>(y);
#pragma unroll
        for (int i = 0; i < 16; ++i) t[i] = y[i]; }
}
constexpr int RT2_KEYS = 0  , RT2_ITAB = 65536  ;
__device__ __forceinline__ void p9_route_sort(const Frame& F) {
    const bf16_t* QP = (const bf16_t*)(F.ws + WS_QP); const bf16_t* KEYS = (const bf16_t*)(F.ws + WS_KEYS);
    unsigned short* E16 = (unsigned short*)(F.ws + WS_E16); float* EW = (float*)(F.ws + WS_EW);
    const int lane = F.lane, tid = F.tid, grp = lane >> 4, col = lane & 15;
    const LaneOffs L = lane_offs(lane, tid);
    LAS int* itab = (LAS int*)(F.lds + RT2_ITAB + F.wave * 2048) + col * 32;
    const bool g1 = grp == 1, g2 = grp == 2, g3 = grp == 3;
    for (int tile = blockIdx.x * NWAVES + F.wave; tile < T / 16; tile += F.G * NWAVES) {
        const int tok = tile * 16 + col;
        {
#pragma unroll
            for (int i = 0; i < 4; ++i) { const int q = tid + 512 * i; *(LAS u32x4v*)(F.lds + RT2_KEYS + tile_off(q >> 3, q & 7)) = *(const u32x4v*)(KEYS + (size_t)q * 8); } }
        bf16x8 qf[2][2];
#pragma unroll
        for (int p = 0; p < 2; ++p)
#pragma unroll
            for (int ks = 0; ks < 2; ++ks) qf[p][ks] = *(const bf16x8*)(QP + (size_t)tok * D + p * 64 + ks * 32 + 8 * grp);
        __syncthreads();
#pragma unroll 1
        for (int h = 0; h < 8; ++h) {
            const int kb = RT2_KEYS + (h & 1) * 32768;
            u32x4v stg[4]; bf16x8 qn[2][2];
            if (h < 7) {
#pragma unroll
                for (int i = 0; i < 4; ++i) { const int q = tid + 512 * i; stg[i] = *(const u32x4v*)(KEYS + (size_t)(h + 1) * 16384 + (size_t)q * 8); }
#pragma unroll
                for (int p = 0; p < 2; ++p)
#pragma unroll
                    for (int ks = 0; ks < 2; ++ks) qn[p][ks] = *(const bf16x8*)(QP + (size_t)tok * D + (h + 1) * 128 + p * 64 + ks * 32 + 8 * grp);
            }
            int lst[2][16];
#pragma unroll
            for (int p = 0; p < 2; ++p) {
                f32x4 sc[8];
#pragma unroll
                for (int kt = 0; kt < 8; ++kt) { sc[kt] = (f32x4){0.f, 0.f, 0.f, 0.f};
#pragma unroll
                    for (int ks = 0; ks < 2; ++ks) { const bf16x8 kf = *(const LAS bf16x8*)(F.lds + kb + p * 16384 + L.koff[ks] + kt * 2048);
                        sc[kt] = __builtin_amdgcn_mfma_f32_16x16x32_bf16(kf, qf[p][ks], sc[kt], 0, 0, 0); } }
                int ra[16], rb[16];
#pragma unroll
                for (int kt = 0; kt < 4; ++kt)
#pragma unroll
                    for (int rg = 0; rg < 4; ++rg) { ra[kt * 4 + rg] = (ord_i(sc[kt][rg]) & ~0x7F) | (127 - (kt * 16 + 4 * grp + rg)); rb[kt * 4 + rg] = (ord_i(sc[kt + 4][rg]) & ~0x7F) | (127 - ((kt + 4) * 16 + 4 * grp + rg)); }
                bitonic_sort_i<16, true>(ra); bitonic_sort_i<16, false>(rb);
#pragma unroll
                for (int i = 0; i < 16; ++i) ra[i] = max(ra[i], rb[i]);
                bitonic_merge_i<16, true>(ra);
                merge_top16_across(ra);
#pragma unroll
                for (int i = 0; i < 16; ++i) lst[p][i] = ra[i];
                if (grp == 0) {
#pragma unroll
                    for (int it = 0; it < 16; ++it) itab[p * 16 + it] = 127 - (ra[it] & 0x7F);
                }
            }
            float v0[16], v1[16];
#pragma unroll
            for (int i = 0; i < 16; ++i) { v0[i] = unord_f(lst[0][i] & ~0x7F); v1[i] = unord_f(lst[1][i] & ~0x7F); }
            int ck[16];
#pragma unroll
            for (int i = 0; i < 13; ++i) {
                constexpr int NC = 50;
                const int k0 = 4 * i, k1 = 4 * i + 1 < NC ? 4 * i + 1 : NC - 1, k2 = 4 * i + 2 < NC ? 4 * i + 2 : NC - 1, k3 = 4 * i + 3 < NC ? 4 * i + 3 : NC - 1;
                float va = v0[CAND.a[k0]], vb = v1[CAND.b[k0]]; int fl = 255 - (CAND.a[k0] * 16 + CAND.b[k0]);
                va = g1 ? v0[CAND.a[k1]] : va; vb = g1 ? v1[CAND.b[k1]] : vb; fl = g1 ? 255 - (CAND.a[k1] * 16 + CAND.b[k1]) : fl;
                va = g2 ? v0[CAND.a[k2]] : va; vb = g2 ? v1[CAND.b[k2]] : vb; fl = g2 ? 255 - (CAND.a[k2] * 16 + CAND.b[k2]) : fl;
                va = g3 ? v0[CAND.a[k3]] : va; vb = g3 ? v1[CAND.b[k3]] : vb; fl = g3 ? 255 - (CAND.a[k3] * 16 + CAND.b[k3]) : fl;
                int key = (ord_i(va + vb) & ~0xFF) | fl;
                if (4 * i + 1 >= NC) key = g1 ? INT_MIN_ : key;
                if (4 * i + 2 >= NC) key = g2 ? INT_MIN_ : key;
                if (4 * i + 3 >= NC) key = g3 ? INT_MIN_ : key;
                ck[i] = key; }
            ck[13] = INT_MIN_; ck[14] = INT_MIN_; ck[15] = INT_MIN_;
            bitonic_sort_i<16, true>(ck);
            merge_top16_across(ck);
            lds_wave_sync();
            const float smax = unord_f(ck[0] & ~0xFF);
            float ex[16], sum = 0.f;
#pragma unroll
            for (int it = 0; it < 16; ++it) { ex[it] = __expf(unord_f(ck[it] & ~0xFF) - smax); sum += ex[it]; }
            const float inv = 1.0f / sum;
            if (grp == 0) {
#pragma unroll
                for (int it = 0; it < 16; ++it) { const int flat = 255 - (ck[it] & 0xFF); const int i1 = itab[flat >> 4], i2 = itab[16 + (flat & 15)];
                    E16[(size_t)tok * 128 + h * 16 + it] = (unsigned short)(i1 * 128 + i2); EW[(size_t)tok * 128 + h * 16 + it] = ex[it] * inv; }
            }
            lds_wave_sync();
            if (h < 7) {
                const int kn = RT2_KEYS + ((h + 1) & 1) * 32768;
#pragma unroll
                for (int i = 0; i < 4; ++i) { const int q = tid + 512 * i; *(LAS u32x4v*)(F.lds + kn + tile_off(q >> 3, q & 7)) = stg[i]; }
#pragma unroll
                for (int p = 0; p < 2; ++p)
#pragma unroll
                    for (int ks = 0; ks < 2; ++ks) qf[p][ks] = qn[p][ks];
            }
            __syncthreads();
        }
    }
}

constexpr int N_PHASES = 14;
struct Args { const float* in[23]; float* out; unsigned char* ws; int ph_lo, ph_hi; };
__global__ void __launch_bounds__(NTHREADS, 2) fwd(Args args) {
    extern __shared__ __attribute__((aligned(16))) unsigned char lds_raw[];
    Frame F;
#pragma unroll
    for (int i = 0; i < 23; ++i) F.in[i] = args.in[i];
    F.out = args.out; F.ws = args.ws; F.lds = (LAS unsigned char*)lds_raw;
    F.tid = threadIdx.x; F.lane = F.tid & 63; F.wave = __builtin_amdgcn_readfirstlane(F.tid >> 6); F.G = gridDim.x;
    volatile LAS unsigned* misc = (volatile LAS unsigned*)(F.lds + LDS_MISC_OFF);
    if (F.tid < 64) misc[F.tid] = 0u;
    __syncthreads();
    XcdBarrier bar; bar.bar = (unsigned*)(F.ws + WS_CTL); bar.x = 0; bar.st = misc;
    const int lo = args.ph_lo, hi = args.ph_hi;
    if (hi - lo > 1) bar = xcd_barrier_post((unsigned*)(F.ws + WS_CTL), misc);
#ifndef PH_MASK
#define PH_MASK 0xFFFF
#endif
#define IN(k) (((PH_MASK >> (k)) & 1) && lo <= (k) && (k) < hi)
#define SEAM(k) do { if (IN(k) && IN((k) + 1)) xcd_barrier(bar); } while (0)
    const float* MOD = (const float*)(F.ws + WS_MOD);
    if (IN(0)) { p0_prologue(F, 0, 96); } SEAM(0);
    if (IN(1)) { p0_prologue(F, 96, 1 << 30); norm_mod_rows(F, F.in[0], F.in[2], 0, 1024, (bf16_t*)(F.ws + WS_H)); } SEAM(1);
    if (IN(2)) { pg8::Gemm g{(const pg8::bf16_t*)(F.ws + WS_H), (const pg8::bf16_t*)(F.ws + WS_WIN), T, NPAD, D}; pg8::StaticOrder So; So.init(T, NPAD, F.G, (int)blockIdx.x);
        pg8::EpiBf16<0> E{(pg8::bf16_t*)(F.ws + WS_PROJ), NPAD, nullptr, 0, 0};
        pg8::gemm_phase<pg8::EpiBf16<0>, pg8::StaticOrder>(F.lds, g, So, E, nullptr); } SEAM(2);
#ifdef COMPRESS_NAIVE
    if (IN(3)) { p3_compress_naive(F); } SEAM(3);
#else
    if (IN(3)) { p3_compress_mfma(F); } SEAM(3);
#endif
    #ifdef ATTN_NAIVE
    if (IN(4)) { p4_attn_naive(F); } SEAM(4);
#else
    if (IN(4)) { p4_attn_mfma_t<0>(F); } SEAM(4);
#ifdef PROBE_ATTN_MODE
    if (IN(14)) { p4_attn_mfma_t<PROBE_ATTN_MODE>(F); }
#endif
#ifdef PROBE_P0_LO
    if (IN(14)) { p0_prologue(F, PROBE_P0_LO, PROBE_P0_HI); }
#endif
#endif
    if (IN(5)) { p5_mixed(F); } SEAM(5);
    if (IN(6)) { pg8::Gemm g{(const pg8::bf16_t*)(F.ws + WS_H), (const pg8::bf16_t*)(F.ws + WS_WOUT), T, D, D}; pg8::StaticOrder So; So.init(T, D, F.G, (int)blockIdx.x);
        pg8::EpiBf16<0> E{(pg8::bf16_t*)(F.ws + WS_Y), D, nullptr, 0, 0};
        pg8::gemm_phase<pg8::EpiBf16<0>, pg8::StaticOrder>(F.lds, g, So, E, nullptr); } SEAM(6);
    if (IN(7)) { norm_mod_rows_q(F, F.in[0], F.in[3], 3072, 4096, (bf16_t*)(F.ws + WS_H)); } SEAM(7);
    if (IN(8)) { pg8::Gemm g{(const pg8::bf16_t*)(F.ws + WS_H), (const pg8::bf16_t*)(F.ws + WS_WQ), T, D, D}; pg8::StaticOrder So; So.init(T, D, F.G, (int)blockIdx.x);
        pg8::EpiBf16<0> E{(pg8::bf16_t*)(F.ws + WS_QP), D, nullptr, 0, 0};
        pg8::gemm_phase<pg8::EpiBf16<0>, pg8::StaticOrder>(F.lds, g, So, E, nullptr); } SEAM(8);
        if (IN(9)) { p9_route_sort(F); } SEAM(9);
    if (IN(10)) { p10a_udots(F); } SEAM(10);
    if (IN(11)) { p10b_coef(F); } SEAM(11);
    if (IN(12)) { p10c_vsum(F); } SEAM(12);
    if (IN(13)) { p10d_final(F); }
#undef IN
#undef SEAM
}

extern "C" void kernel_launch(void* const* d_in, const int* in_sizes, int n_in, void* d_out, int out_size, void* d_ws, size_t ws_size, hipStream_t stream) {
    static int grid = 0;
    if (grid == 0) {
        if (n_in != 23 || out_size != T * D || ws_size < WS_END) { fprintf(stderr, "kernel_launch: unexpected shapes: n_in %d out %d ws %zu (need %zu)\n", n_in, out_size, ws_size, (size_t)WS_END); grid = -1; return; }
        int dev = 0, cus = 0, per_cu = 0;
        if (hipGetDevice(&dev) != hipSuccess || hipDeviceGetAttribute(&cus, hipDeviceAttributeMultiprocessorCount, dev) != hipSuccess) { grid = -1; return; }
        if (hipFuncSetAttribute((const void*)fwd, hipFuncAttributeMaxDynamicSharedMemorySize, LDS_BYTES) != hipSuccess) { fprintf(stderr, "kernel_launch: hipFuncSetAttribute failed\n"); grid = -1; return; }
        if (hipOccupancyMaxActiveBlocksPerMultiprocessor(&per_cu, (const void*)fwd, NTHREADS, LDS_BYTES) != hipSuccess || per_cu < 1) { fprintf(stderr, "kernel_launch: occupancy query says %d\n", per_cu); (void)hipGetLastError(); per_cu = 1; }
        grid = cus;
    }
    if (grid < 0) return;
    (void)hipMemsetAsync((char*)d_ws + WS_CTL, 0, CTL_BYTES, stream);
    Args a{};
    for (int i = 0; i < 23; ++i) a.in[i] = (const float*)d_in[i];
    a.out = (float*)d_out; a.ws = (unsigned char*)d_ws;
#if MK_N_LAUNCHES == 1
    a.ph_lo = 0; a.ph_hi = N_PHASES;
    hipLaunchKernelGGL(fwd, dim3(grid), dim3(NTHREADS), LDS_BYTES, stream, a);
#else
#ifdef PROBE_LIST
    { const int plist[] = PROBE_LIST; for (int p : plist) { if (p < 0) { (void)hipMemsetAsync((char*)d_ws + WS_CTL, 0, CTL_BYTES, stream); continue; } a.ph_lo = p; a.ph_hi = p + 1; hipLaunchKernelGGL(fwd, dim3(grid), dim3(NTHREADS), LDS_BYTES, stream, a); } }
#else
    for (int p = 0; p < N_PHASES; ++p) { a.ph_lo = p; a.ph_hi = p + 1; hipLaunchKernelGGL(fwd, dim3(grid), dim3(NTHREADS), LDS_BYTES, stream, a); }
#endif
#endif
}
```

```cpp
#include <hip/hip_runtime.h>
#include <cstdio>
#include <cstdint>
#include <cstdlib>

#ifndef MK_N_LAUNCHES
#define MK_N_LAUNCHES 1
#endif
#define XB_TMO      128
#define XB_XCNT(j)  (256  + 64 * (j))
#define XB_XSUB(j)  (1280 + 64 * (j))
#define XB_XGEN(j)  (2304 + 64 * (j))
#define XB_TOP      3328
#define XB_TOPGEN   3392
#define XCD_BAR_WORDS 3456
#define XB_SPIN_CAP (1u << 18)
#define LAS __attribute__((address_space(3)))

__device__ __forceinline__ unsigned xb_ld(unsigned* p)              { return __hip_atomic_load(p, __ATOMIC_RELAXED, __HIP_MEMORY_SCOPE_AGENT); }
__device__ __forceinline__ unsigned xb_add(unsigned* p, unsigned v) { return __hip_atomic_fetch_add(p, v, __ATOMIC_RELAXED, __HIP_MEMORY_SCOPE_AGENT); }
__device__ __forceinline__ unsigned xb_xcc_id() { return (unsigned)__builtin_amdgcn_s_getreg((3 << 11) | 20) & 0xFu; }
#define XB_SPIN(cond, bar) do { unsigned _sp = 0; while (cond) { __builtin_amdgcn_s_sleep(1); \
    if ((++_sp & 255u) == 0u) { if (xb_ld(&(bar)[XB_TMO])) break; if (_sp > XB_SPIN_CAP) { atomicAdd(&(bar)[XB_TMO], 1u); break; } } } } while (0)

struct XcdBarrier {
    unsigned* bar; unsigned x;
    volatile LAS unsigned* st;
};

__device__ __forceinline__ XcdBarrier xcd_barrier_post(unsigned* bar, volatile LAS unsigned* st) {
    XcdBarrier b; b.bar = bar; b.x = xb_xcc_id(); b.st = st;
    if (threadIdx.x == 0) (void)xb_add(&bar[XB_XCNT(b.x)], 1u);
    return b;
}
__device__ __forceinline__ void xcd_barrier_complete(unsigned* bar, unsigned x, unsigned& nloc, unsigned& nx) {
    const unsigned G = gridDim.x * gridDim.y * gridDim.z;
    unsigned sum, cnt, mine, sp = 0u;
    for (;;) {
        sum = 0u; cnt = 0u; mine = 0u;
#pragma unroll
        for (unsigned j = 0; j < 16; ++j) { const unsigned c = xb_ld(&bar[XB_XCNT(j)]); sum += c; cnt += (c > 0u) ? 1u : 0u; mine = (j == x) ? c : mine; }
        if (sum == G) break;
        __builtin_amdgcn_s_sleep(1);
        if ((++sp & 255u) == 0u) { if (xb_ld(&bar[XB_TMO])) break; if (sp > XB_SPIN_CAP) { atomicAdd(&bar[XB_TMO], 1u); break; } }
    }
    nloc = mine > 0u ? mine : 1u; nx = cnt > 0u ? cnt : 1u;
}

__device__ __forceinline__ void xcd_barrier(const XcdBarrier& b) {
    asm volatile("s_waitcnt vmcnt(0)" ::: "memory");
    __syncthreads();
    if (threadIdx.x == 0) {
        unsigned* bar = b.bar;
        __builtin_amdgcn_s_waitcnt(0);
        unsigned nloc = b.st[0], nx = b.st[1];
        if (nloc == 0u) { xcd_barrier_complete(bar, b.x, nloc, nx); b.st[0] = nloc; b.st[1] = nx; }
        const unsigned old = xb_add(&bar[XB_XSUB(b.x)], 1u);
        const unsigned gen = old / nloc;
        if (old + 1u == (gen + 1u) * nloc) {
            __builtin_amdgcn_fence(__ATOMIC_RELEASE, "agent");
            asm volatile("s_waitcnt vmcnt(0)" ::: "memory");
            const unsigned og = xb_add(&bar[XB_TOP], 1u);
            const unsigned tg = og / nx;
            if (og + 1u == (tg + 1u) * nx) xb_add(&bar[XB_TOPGEN], 1u);
            else XB_SPIN(xb_ld(&bar[XB_TOPGEN]) == tg, bar);
            __builtin_amdgcn_fence(__ATOMIC_ACQUIRE, "agent");
            xb_add(&bar[XB_XGEN(b.x)], 1u);
            asm volatile("s_waitcnt vmcnt(0)" ::: "memory");
        } else {
            XB_SPIN(xb_ld(&bar[XB_XGEN(b.x)]) == gen, bar);
            __builtin_amdgcn_fence(__ATOMIC_ACQUIRE, "agent");
            asm volatile("s_waitcnt vmcnt(0)" ::: "memory");
        }
    }
    __syncthreads();
}

namespace pg8 {
#define PG8_LAS __attribute__((address_space(3)))
typedef unsigned short bf16_t;
typedef short bf16x8 __attribute__((ext_vector_type(8)));
typedef float f32x4 __attribute__((ext_vector_type(4)));
typedef unsigned u32x4 __attribute__((ext_vector_type(4)));
constexpr int BM = 256, BK = 64, HALF = 128, HTB = HALF * BK * 2  , STAGE_BYTES = 8 * HTB, NXCD = 8, WGM = 8;

__host__ __device__ __forceinline__ int lds_byte(int r, int c) { const int st = (r >> 4) * 2 + (c >> 5), rr = r & 15, cc = c & 31, ob = rr * 64 + cc * 2; return st * 1024 + (ob ^ (((ob >> 9) & 1) << 5)); }
__host__ __device__ __forceinline__ void stage_rc(int b, int& R, int& C) { const int st = b / 1024, sb = b % 1024, swz = sb ^ (((sb >> 9) & 1) << 5); R = (st >> 1) * 16 + swz / 64; C = (st & 1) * 32 + (swz % 64) / 2; }
__host__ __device__ __forceinline__ int perm32(int rho) { const int n = rho >> 4, i = rho & 15; return 8 * (i >> 2) + 4 * n + (i & 3); }

struct Unit { int pm, pn; };
struct Gemm { const bf16_t* A; const bf16_t* Bt; int M, N, K; };

struct StaticOrder {
    int nM, nN, nwg, G, c;
    __host__ __device__ void init(int M, int N, int G_, int c_) { nM = M / BM; nN = N / BM; nwg = nM * nN; G = G_; c = c_; }
    __host__ __device__ bool next(int i, Unit& u) const {
        const long L = (long)i * G + c; if (L >= nwg) return false;
        int wgid = (int)L; { const int q = nwg / NXCD, r = nwg % NXCD, xcd = wgid % NXCD, off = wgid / NXCD; wgid = (xcd < r ? xcd * (q + 1) : r * (q + 1) + (xcd - r) * q) + off; }
        const int nig = WGM * nN, gid = wgid / nig, fm = gid * WGM, gsz = (nM - fm) < WGM ? (nM - fm) : WGM;
        u.pm = fm + ((wgid % nig) % gsz); u.pn = (wgid % nig) / gsz; return true;
    }
    __device__ __forceinline__ void a_ready(const Unit&) const {}
    __device__ __forceinline__ void done(const Unit&) const {}
};
struct CountedOrder : StaticOrder {
    const unsigned* ready; unsigned need; unsigned* tmo;
    __device__ __forceinline__ void a_ready(const Unit& u) const {
        if (threadIdx.x < 64) {
            const unsigned long long t0 = __builtin_amdgcn_s_memrealtime(); unsigned polls = 0;
            while ((unsigned)__builtin_amdgcn_readfirstlane(__hip_atomic_load(ready + 64 * u.pm, __ATOMIC_RELAXED, __HIP_MEMORY_SCOPE_AGENT)) < need) {
                if ((++polls & 255u) == 0u && __builtin_amdgcn_readfirstlane(__hip_atomic_load(tmo, __ATOMIC_RELAXED, __HIP_MEMORY_SCOPE_AGENT)) != 0u) break;
                if (__builtin_amdgcn_s_memrealtime() - t0 > 2000000ull) {
                    if (threadIdx.x == 0) { unsigned expect = 0u; __hip_atomic_compare_exchange_strong(tmo + 1, &expect, 0x600u | (unsigned)(u.pm & 0xff), __ATOMIC_RELAXED, __ATOMIC_RELAXED, __HIP_MEMORY_SCOPE_AGENT); __hip_atomic_store(tmo, 1u, __ATOMIC_RELAXED, __HIP_MEMORY_SCOPE_AGENT); }
                    break; }
                __builtin_amdgcn_s_sleep(2); }
            __builtin_amdgcn_fence(__ATOMIC_ACQUIRE, "agent");
            asm volatile("s_waitcnt vmcnt(0)" ::: "memory");
        }
#if !defined(BROKEN_HOOK_NO_BARRIER)
        asm volatile("" ::: "memory"); __builtin_amdgcn_s_barrier(); asm volatile("" ::: "memory");
#endif
    }
};

__device__ __forceinline__ unsigned cvt_pk_bf16(float lo, float hi) { unsigned r; asm volatile("v_cvt_pk_bf16_f32 %0, %1, %2" : "=v"(r) : "v"(lo), "v"(hi)); return r; }
typedef float f32x2 __attribute__((ext_vector_type(2)));
__device__ __forceinline__ f32x2 gelu_pk(f32x2 v) {
    const f32x2 av = __builtin_elementwise_abs(v), d = av * 0.2316418882f + 1.0f;
    f32x2 t; t.x = __builtin_amdgcn_rcpf(d.x); t.y = __builtin_amdgcn_rcpf(d.y);
    f32x2 q = t * 0.5307027145f + (-0.7265760135f); q = q * t + 0.7107068705f; q = q * t + (-0.142248368f); q = q * t + 0.127414796f; q = q * t;
    const f32x2 s = (v * v) * (-0.72134752044f);
    f32x2 e; e.x = __builtin_amdgcn_exp2f(s.x); e.y = __builtin_amdgcn_exp2f(s.y);
    const f32x2 m = v * (q * e), r = v - m;
    f32x2 o; o.x = v.x < 0.f ? m.x : r.x; o.y = v.y < 0.f ? m.y : r.y; return o;
}

struct EpiF32 {
    static constexpr bool PERM = false, AFTER_DRAIN = false;
    float* C; int ldc; const float* bias;
    __device__ __forceinline__ void operator()(const f32x4 (&acc)[2][2][4][2], const Unit& u, int wr, int wc, int fr, int fq) const {
        const int row0 = u.pm * BM + wr * 64 + fr, col0 = u.pn * BM + wc * 32 + 4 * fq;
        f32x4 bv[2][2];
#pragma unroll
        for (int bj = 0; bj < 2; ++bj)
#pragma unroll
            for (int n = 0; n < 2; ++n) bv[bj][n] = bias ? *(const f32x4*)(bias + col0 + bj * HALF + n * 16) : (f32x4){0.f, 0.f, 0.f, 0.f};
#pragma unroll
        for (int ai = 0; ai < 2; ++ai)
#pragma unroll
            for (int m = 0; m < 4; ++m) { float* rowp = C + (size_t)(row0 + ai * HALF + m * 16) * ldc + col0;
#pragma unroll
                for (int bj = 0; bj < 2; ++bj)
#pragma unroll
                    for (int n = 0; n < 2; ++n) *(f32x4*)(rowp + bj * HALF + n * 16) = acc[ai][bj][m][n] + bv[bj][n]; }
    }
};
template <int ACT  > struct EpiBf16 {
    static constexpr bool PERM = true, AFTER_DRAIN = false;
    bf16_t* O; int ldc; const float* bias; int split_cols; size_t split_stride;
    __device__ __forceinline__ void operator()(const f32x4 (&acc)[2][2][4][2], const Unit& u, int wr, int wc, int fr, int fq) const {
        const int row0 = u.pm * BM + wr * 64 + fr; int colt = u.pn * BM; bf16_t* base = O;
        if (split_cols) { const int t = colt / split_cols; base += (size_t)t * split_stride; colt -= t * split_cols; }
        const int col0 = colt + wc * 32 + 8 * fq, bcol0 = u.pn * BM + wc * 32 + 8 * fq;
        f32x4 bv[2][2];
#pragma unroll
        for (int bj = 0; bj < 2; ++bj)
#pragma unroll
            for (int n = 0; n < 2; ++n) bv[bj][n] = bias ? *(const f32x4*)(bias + bcol0 + bj * HALF + 4 * n) : (f32x4){0.f, 0.f, 0.f, 0.f};
#pragma unroll
        for (int ai = 0; ai < 2; ++ai)
#pragma unroll
            for (int m = 0; m < 4; ++m) { bf16_t* rowp = base + (size_t)(row0 + ai * HALF + m * 16) * ldc + col0;
#pragma unroll
                for (int bj = 0; bj < 2; ++bj) { f32x4 v0 = acc[ai][bj][m][0] + bv[bj][0], v1 = acc[ai][bj][m][1] + bv[bj][1];
                    if (ACT == 1) { f32x2 a = gelu_pk((f32x2){v0[0], v0[1]}), b = gelu_pk((f32x2){v0[2], v0[3]}), c = gelu_pk((f32x2){v1[0], v1[1]}), d = gelu_pk((f32x2){v1[2], v1[3]});
                        v0 = (f32x4){a.x, a.y, b.x, b.y}; v1 = (f32x4){c.x, c.y, d.x, d.y}; }
                    if (ACT == 2) {
#pragma unroll
                        for (int j = 0; j < 4; ++j) { v0[j] = 0.5f * v0[j] * (1.0f + erff(v0[j] * 0.70710678f)); v1[j] = 0.5f * v1[j] * (1.0f + erff(v1[j] * 0.70710678f)); } }
                    u32x4 w; w.x = cvt_pk_bf16(v0[0], v0[1]); w.y = cvt_pk_bf16(v0[2], v0[3]); w.z = cvt_pk_bf16(v1[0], v1[1]); w.w = cvt_pk_bf16(v1[2], v1[3]);
                    *(u32x4*)(rowp + bj * HALF) = w; } }
    }
};

struct PanelStats {
    unsigned* xbuf;
    unsigned* cnt;
    unsigned* tmo;
    int ntn; float eps;
    unsigned code;
    __device__ __forceinline__ bool run(const f32x4 (&v)[2][2][4][2], const Unit& u, int wr, int wc, int fr, int fq, PG8_LAS unsigned char* lds, int wid, int lane) const {
        typedef float f32x2v __attribute__((ext_vector_type(2)));
        PG8_LAS f32x2v* P = (PG8_LAS f32x2v*)lds;
        PG8_LAS f32x2v* S = (PG8_LAS f32x2v*)(lds + 8192);
        PG8_LAS unsigned* flag = (PG8_LAS unsigned*)(lds + 8192 + 2048);
#pragma unroll
        for (int ai = 0; ai < 2; ++ai)
#pragma unroll
            for (int m = 0; m < 4; ++m) {
                float s = 0.f;
#pragma unroll
                for (int bj = 0; bj < 2; ++bj)
#pragma unroll
                    for (int n = 0; n < 2; ++n) { const f32x4 x = v[ai][bj][m][n]; s += (x[0] + x[1]) + (x[2] + x[3]); }
                s += __shfl_xor(s, 16); s += __shfl_xor(s, 32);
                const float mw = s * (1.0f / 64.0f); float q = 0.f;
#pragma unroll
                for (int bj = 0; bj < 2; ++bj)
#pragma unroll
                    for (int n = 0; n < 2; ++n) { const f32x4 d = v[ai][bj][m][n] - mw; q += (d[0] * d[0] + d[1] * d[1]) + (d[2] * d[2] + d[3] * d[3]); }
                q += __shfl_xor(q, 16); q += __shfl_xor(q, 32);
                if (fq == 0) P[(ai * HALF + wr * 64 + m * 16 + fr) * 4 + wc] = (f32x2v){mw, q};
            }
        asm volatile("s_waitcnt lgkmcnt(0)" ::: "memory"); __builtin_amdgcn_s_barrier(); asm volatile("" ::: "memory");
#if defined(BROKEN_NO_WAIT)
        if (blockIdx.x >= 64) { const long long t0 = clock64(); while (clock64() - t0 < 60000) __builtin_amdgcn_s_sleep(8); }
#endif
        const int row = wid * 32 + (lane & 31);
        if (lane < 32) {
            const f32x2v a = P[row * 4 + 0], b = P[row * 4 + 1], c = P[row * 4 + 2], d = P[row * 4 + 3];
            const float mt = (a.x + b.x + c.x + d.x) * 0.25f;
            const float da = a.x - mt, db = b.x - mt, dc = c.x - mt, dd = d.x - mt;
            const float m2 = (a.y + b.y) + (c.y + d.y) + 64.0f * ((da * da + db * db) + (dc * dc + dd * dd));
            unsigned long long* slot = (unsigned long long*)xbuf + ((size_t)(u.pm * BM + row) * 4 + u.pn);
            __hip_atomic_store(slot, ((unsigned long long)__float_as_uint(m2) << 32) | __float_as_uint(mt), __ATOMIC_RELAXED, __HIP_MEMORY_SCOPE_AGENT);
        }
        asm volatile("s_waitcnt vmcnt(0)" ::: "memory");
        if (lane == 0) __hip_atomic_fetch_add(cnt + 64 * u.pm, 1u, __ATOMIC_RELAXED, __HIP_MEMORY_SCOPE_AGENT);
        if (wid == 0) {
            bool dead = false; const unsigned long long t0 = __builtin_amdgcn_s_memrealtime(); const unsigned want = 8u * (unsigned)ntn;
            for (;;) {
#if defined(BROKEN_NO_WAIT)
                break;
#endif
                if ((unsigned)__builtin_amdgcn_readfirstlane(__hip_atomic_load(cnt + 64 * u.pm, __ATOMIC_RELAXED, __HIP_MEMORY_SCOPE_AGENT)) >= want) break;
                if (__builtin_amdgcn_s_memrealtime() - t0 > 2000000ull) {
                    if (lane == 0) { unsigned expect = 0u; __hip_atomic_compare_exchange_strong(tmo + 1, &expect, code | (unsigned)(u.pm & 0xff), __ATOMIC_RELAXED, __ATOMIC_RELAXED, __HIP_MEMORY_SCOPE_AGENT);
                                     __hip_atomic_store(tmo, 1u, __ATOMIC_RELAXED, __HIP_MEMORY_SCOPE_AGENT); }
                    dead = true; break; }
                __builtin_amdgcn_s_sleep(2);
            }
            __builtin_amdgcn_fence(__ATOMIC_ACQUIRE, "agent");
            if (lane == 0) flag[0] = dead ? 1u : 0u;
        }
        asm volatile("s_waitcnt vmcnt(0) lgkmcnt(0)" ::: "memory"); __builtin_amdgcn_s_barrier(); asm volatile("" ::: "memory");
        const bool bad = flag[0] != 0u;
        if (lane < 32) {
            const unsigned long long* slot = (const unsigned long long*)xbuf + (size_t)(u.pm * BM + row) * 4; float mt[4], m2[4]; float ms = 0.f;
#pragma unroll
            for (int t = 0; t < 4; ++t) { if (t < ntn) { const unsigned long long w = __hip_atomic_load(slot + t, __ATOMIC_RELAXED, __HIP_MEMORY_SCOPE_AGENT); mt[t] = __uint_as_float((unsigned)w); m2[t] = __uint_as_float((unsigned)(w >> 32)); } else { mt[t] = 0.f; m2[t] = 0.f; } ms += mt[t]; }
            const float mean = ms / (float)ntn; float q = 0.f;
#pragma unroll
            for (int t = 0; t < 4; ++t) if (t < ntn) { const float dm = mt[t] - mean; q += m2[t] + 256.0f * dm * dm; }
            S[row] = (f32x2v){mean, 1.0f / sqrtf(q / (256.0f * (float)ntn) + eps)};
        }
        asm volatile("s_waitcnt lgkmcnt(0)" ::: "memory"); __builtin_amdgcn_s_barrier(); asm volatile("" ::: "memory");
        return bad;
    }
};
struct EpiLnRes {
    static constexpr bool PERM = false, AFTER_DRAIN = true;
    const float* base; float* out; int ldc; const float* bias; PanelStats st; unsigned poison;
    __device__ __forceinline__ void refuse(size_t i0, size_t stride, int M, int N) const { const float q = __builtin_nanf(""); for (size_t i = i0; i < (size_t)M * N; i += stride) out[(i / N) * ldc + i % N] = q;
        if (i0 == 0) { unsigned expect = 0u; __hip_atomic_compare_exchange_strong(st.tmo + 1, &expect, 0x7f0u, __ATOMIC_RELAXED, __ATOMIC_RELAXED, __HIP_MEMORY_SCOPE_AGENT); __hip_atomic_store(st.tmo, 1u, __ATOMIC_RELAXED, __HIP_MEMORY_SCOPE_AGENT); } }
    __device__ __forceinline__ void fused(f32x4 (&acc)[2][2][4][2], const Unit& u, int wr, int wc, int fr, int fq, PG8_LAS unsigned char* lds, int wid, int lane) const {
        typedef float f32x2v __attribute__((ext_vector_type(2)));
        const PG8_LAS f32x2v* S = (const PG8_LAS f32x2v*)(lds + 8192);
        const int col0 = u.pn * BM + wc * 32 + 4 * fq;
#pragma unroll
        for (int bj = 0; bj < 2; ++bj)
#pragma unroll
            for (int n = 0; n < 2; ++n) { const f32x4 bv = bias ? *(const f32x4*)(bias + col0 + bj * HALF + n * 16) : (f32x4){0.f, 0.f, 0.f, 0.f};
#pragma unroll
                for (int ai = 0; ai < 2; ++ai)
#pragma unroll
                    for (int m = 0; m < 4; ++m) acc[ai][bj][m][n] += bv; }
        const bool bad = st.run(acc, u, wr, wc, fr, fq, lds, wid, lane) || poison != 0u;
        const float qnan = __builtin_nanf("");
#pragma unroll
        for (int ai = 0; ai < 2; ++ai)
#pragma unroll
            for (int m = 0; m < 4; ++m) { const int r = ai * HALF + wr * 64 + m * 16 + fr; const f32x2v sr = S[r]; const size_t off = (size_t)(u.pm * BM + r) * ldc + col0;
#pragma unroll
                for (int bj = 0; bj < 2; ++bj)
#pragma unroll
                    for (int n = 0; n < 2; ++n) { const f32x4 bs = *(const f32x4*)(base + off + bj * HALF + n * 16); f32x4 o = bs + (acc[ai][bj][m][n] - sr.x) * sr.y;
                        if (bad) o = (f32x4){qnan, qnan, qnan, qnan}; *(f32x4*)(out + off + bj * HALF + n * 16) = o; }
                asm volatile("" ::: "memory"); }
    }
};
struct EpiLnResLn {
    static constexpr bool PERM = false, AFTER_DRAIN = true;
    const float* base; float* out; bf16_t* xn; int ldc; const float* bias; PanelStats st1, st2; unsigned poison;
    __device__ __forceinline__ void refuse(size_t i0, size_t stride, int M, int N) const { const float q = __builtin_nanf(""); for (size_t i = i0; i < (size_t)M * N; i += stride) { const size_t o = (i / N) * ldc + i % N; out[o] = q; xn[o] = (bf16_t)0x7fc0u; }
        if (i0 == 0) { unsigned expect = 0u; __hip_atomic_compare_exchange_strong(st1.tmo + 1, &expect, 0x7f0u, __ATOMIC_RELAXED, __ATOMIC_RELAXED, __HIP_MEMORY_SCOPE_AGENT); __hip_atomic_store(st1.tmo, 1u, __ATOMIC_RELAXED, __HIP_MEMORY_SCOPE_AGENT); } }
    __device__ __forceinline__ void fused(f32x4 (&acc)[2][2][4][2], const Unit& u, int wr, int wc, int fr, int fq, PG8_LAS unsigned char* lds, int wid, int lane) const {
        typedef float f32x2v __attribute__((ext_vector_type(2))); typedef unsigned u32x2v __attribute__((ext_vector_type(2)));
        const PG8_LAS f32x2v* S = (const PG8_LAS f32x2v*)(lds + 8192);
        const int col0 = u.pn * BM + wc * 32 + 4 * fq;
#pragma unroll
        for (int bj = 0; bj < 2; ++bj)
#pragma unroll
            for (int n = 0; n < 2; ++n) { const f32x4 bv = bias ? *(const f32x4*)(bias + col0 + bj * HALF + n * 16) : (f32x4){0.f, 0.f, 0.f, 0.f};
#pragma unroll
                for (int ai = 0; ai < 2; ++ai)
#pragma unroll
                    for (int m = 0; m < 4; ++m) acc[ai][bj][m][n] += bv; }
        bool bad = st1.run(acc, u, wr, wc, fr, fq, lds, wid, lane) || poison != 0u;
        const float qnan = __builtin_nanf("");
#pragma unroll
        for (int ai = 0; ai < 2; ++ai)
#pragma unroll
            for (int m = 0; m < 4; ++m) { const int r = ai * HALF + wr * 64 + m * 16 + fr; const f32x2v sr = S[r]; const size_t off = (size_t)(u.pm * BM + r) * ldc + col0;
#pragma unroll
                for (int bj = 0; bj < 2; ++bj)
#pragma unroll
                    for (int n = 0; n < 2; ++n) { const f32x4 bs = *(const f32x4*)(base + off + bj * HALF + n * 16); acc[ai][bj][m][n] = bs + (acc[ai][bj][m][n] - sr.x) * sr.y; }
                asm volatile("" : "+v"(acc[ai][0][m][0]), "+v"(acc[ai][0][m][1]), "+v"(acc[ai][1][m][0]), "+v"(acc[ai][1][m][1]));
                if (m & 1) asm volatile("" ::: "memory"); }
        const bool bad1 = bad;
        bad = st2.run(acc, u, wr, wc, fr, fq, lds, wid, lane) || bad;
#pragma unroll
        for (int ai = 0; ai < 2; ++ai)
#pragma unroll
            for (int m = 0; m < 4; ++m) { const int r = ai * HALF + wr * 64 + m * 16 + fr; const f32x2v sr = S[r]; const size_t off = (size_t)(u.pm * BM + r) * ldc + col0;
#pragma unroll
                for (int bj = 0; bj < 2; ++bj)
#pragma unroll
                    for (int n = 0; n < 2; ++n) { const f32x4 x1 = acc[ai][bj][m][n]; *(f32x4*)(out + off + bj * HALF + n * 16) = bad1 ? (f32x4){qnan, qnan, qnan, qnan} : x1;
                        const f32x4 o = (x1 - sr.x) * sr.y; u32x2v w; w.x = cvt_pk_bf16(o[0], o[1]); w.y = cvt_pk_bf16(o[2], o[3]);
                        if (bad) { w.x = 0x7fc07fc0u; w.y = 0x7fc07fc0u; } *(u32x2v*)(xn + off + bj * HALF + n * 16) = w; }
                asm volatile("" ::: "memory"); }
    }
};

template <class Epi, class Sched, bool STAMP = false>
__device__ __forceinline__ void gemm_phase(PG8_LAS unsigned char* lds, const Gemm g, const Sched& S, const Epi& E, unsigned long long* stamps) {
    const int tid = threadIdx.x, wid = __builtin_amdgcn_readfirstlane(tid >> 6), lane = tid & 63, wr = wid >> 2, wc = wid & 3, fr = lane & 15, fq = lane >> 4;
    const int K = g.K, nt = K / BK;
    int ts_lo = 0, ts_hi = 0, nts = 0; const unsigned long long rt_entry = STAMP ? (unsigned long long)wall_clock64() : 0ull;
#define PG8_STAMP() do { if (STAMP && wid == 0 && nts < 64) { const unsigned long long _c = (unsigned long long)clock64(); \
        ts_lo = (lane == nts) ? (int)(unsigned)_c : ts_lo; ts_hi = (lane == nts) ? (int)(unsigned)(_c >> 32) : ts_hi; ++nts; } } while (0)
    PG8_STAMP();
    unsigned voffA[2], voffB[2];
#pragma unroll
    for (int i = 0; i < 2; ++i) { int R, C; stage_rc(tid * 16 + i * 8192, R, C); const int Rb = Epi::PERM ? ((R & ~31) + perm32(R & 31)) : R;
        voffA[i] = (unsigned)(R * K + C) * 2u; voffB[i] = (unsigned)(Rb * K + C) * 2u; }
    const size_t kstep = (size_t)(BK * 2);
    const size_t hstep = (size_t)HALF * K * 2;
    const size_t tstep = 2 * hstep;
    const unsigned ldsw = (unsigned)wid * 1024u;
    const int aoff = lds_byte(wr * 64 + fr, fq * 8), boff = lds_byte(wc * 32 + fr, fq * 8);
#define PG8_SA(b, h) (((b) * 2 + (h)) * HTB)
#define PG8_SB(b, h) ((4 + (b) * 2 + (h)) * HTB)
#define PG8_STAGE(bufoff, gbase, voff) do { _Pragma("unroll") for (int _i = 0; _i < 2; ++_i) \
        __builtin_amdgcn_global_load_lds((const unsigned*)((const char*)(gbase) + (voff)[_i]), (PG8_LAS unsigned*)(lds + (bufoff) + ldsw + _i * 8192), 16, 0, 0); } while (0)
#define PG8_LDA(dst, b, h) do { _Pragma("unroll") for (int m = 0; m < 4; ++m) _Pragma("unroll") for (int k = 0; k < 2; ++k) dst[m][k] = *(const PG8_LAS bf16x8*)(lds + PG8_SA(b, h) + aoff + m * 2048 + k * 1024); } while (0)
#define PG8_LDB(dst, b, h) do { _Pragma("unroll") for (int n = 0; n < 2; ++n) _Pragma("unroll") for (int k = 0; k < 2; ++k) dst[n][k] = *(const PG8_LAS bf16x8*)(lds + PG8_SB(b, h) + boff + n * 2048 + k * 1024); } while (0)
#define PG8_MMA(ai, bj, At, Bt) do { __builtin_amdgcn_s_setprio(1); _Pragma("unroll") for (int m = 0; m < 4; ++m) _Pragma("unroll") for (int n = 0; n < 2; ++n) _Pragma("unroll") for (int k = 0; k < 2; ++k) \
        acc[ai][bj][m][n] = __builtin_amdgcn_mfma_f32_16x16x32_bf16(Bt[n][k], At[m][k], acc[ai][bj][m][n], 0, 0, 0); __builtin_amdgcn_s_setprio(0); } while (0)
#define PG8_WAIT_V(n) asm volatile("s_waitcnt vmcnt(" #n ")" ::: "memory")
#define PG8_WAIT_L(n) asm volatile("s_waitcnt lgkmcnt(" #n ")" ::: "memory")
#define PG8_BAR __builtin_amdgcn_s_barrier()
#define PG8_SCHED __builtin_amdgcn_sched_barrier(0)
    Unit cur, nxt; int ui = 0;
    if (!S.next(0, cur)) return;
    f32x4 acc[2][2][4][2];
#pragma unroll
    for (int a = 0; a < 2; ++a)
#pragma unroll
        for (int b = 0; b < 2; ++b)
#pragma unroll
            for (int m = 0; m < 4; ++m)
#pragma unroll
                for (int n = 0; n < 2; ++n) acc[a][b][m][n] = (f32x4){0.f, 0.f, 0.f, 0.f};
    bf16x8 At[4][2], B0[2][2], B1[2][2];
    const char* cA = (const char*)g.A + (size_t)cur.pm * tstep; const char* cB = (const char*)g.Bt + (size_t)cur.pn * tstep;
    S.a_ready(cur);
    PG8_STAGE(PG8_SB(0, 0), cB, voffB); PG8_STAGE(PG8_SA(0, 0), cA, voffA); PG8_STAGE(PG8_SB(0, 1), cB + hstep, voffB); PG8_STAGE(PG8_SA(0, 1), cA + hstep, voffA);
    if (wr == 1) PG8_BAR;
    PG8_WAIT_V(4); PG8_BAR;
    PG8_STAGE(PG8_SB(1, 0), cB + kstep, voffB); PG8_STAGE(PG8_SA(1, 0), cA + kstep, voffA); PG8_STAGE(PG8_SB(1, 1), cB + hstep + kstep, voffB);
    PG8_WAIT_V(6); PG8_BAR;
    PG8_STAMP();
    for (;;) {
        const bool has_next = S.next(ui + 1, nxt);
        const char* nA = has_next ? (const char*)g.A + (size_t)nxt.pm * tstep : cA; const char* nB = has_next ? (const char*)g.Bt + (size_t)nxt.pn * tstep : cB;
        for (int t = 0; t < nt; t += 2) {
            const bool last = (t == nt - 2);
            const char* a1 = cA + (size_t)(t + 1) * kstep;
            const char* a2 = last ? nA : cA + (size_t)(t + 2) * kstep; const char* b2 = last ? nB : cB + (size_t)(t + 2) * kstep;
            const char* a3 = a2 + kstep; const char* b3 = b2 + kstep;
            if (last && has_next) S.a_ready(nxt);
            PG8_LDB(B0, 0, 0); PG8_SCHED; PG8_LDA(At, 0, 0); PG8_STAGE(PG8_SA(1, 1), a1 + hstep, voffA);
            PG8_WAIT_L(8); PG8_BAR; PG8_WAIT_L(0); PG8_MMA(0, 0, At, B0); PG8_BAR; PG8_SCHED;
            PG8_LDB(B1, 0, 1); PG8_STAGE(PG8_SB(0, 0), b2, voffB);
            PG8_BAR; PG8_WAIT_L(0); PG8_MMA(0, 1, At, B1); PG8_BAR;
            PG8_LDA(At, 0, 1); PG8_STAGE(PG8_SA(0, 0), a2, voffA);
            PG8_BAR; PG8_WAIT_L(0); PG8_MMA(1, 0, At, B0); PG8_BAR; PG8_SCHED;
            PG8_STAGE(PG8_SB(0, 1), b2 + hstep, voffB);
            PG8_WAIT_V(6); PG8_BAR; PG8_MMA(1, 1, At, B1); PG8_BAR;
            PG8_LDB(B0, 1, 0); PG8_SCHED; PG8_LDA(At, 1, 0); PG8_STAGE(PG8_SA(0, 1), a2 + hstep, voffA);
            PG8_WAIT_L(8); PG8_BAR; PG8_WAIT_L(0); PG8_MMA(0, 0, At, B0); PG8_BAR; PG8_SCHED;
            PG8_LDB(B1, 1, 1); PG8_STAGE(PG8_SB(1, 0), b3, voffB);
            PG8_BAR; PG8_WAIT_L(0); PG8_MMA(0, 1, At, B1); PG8_BAR;
            PG8_LDA(At, 1, 1); PG8_STAGE(PG8_SA(1, 0), a3, voffA);
            PG8_BAR; PG8_WAIT_L(0); PG8_MMA(1, 0, At, B0); PG8_BAR; PG8_SCHED;
            PG8_STAGE(PG8_SB(1, 1), b3 + hstep, voffB);
            PG8_WAIT_V(6); PG8_BAR; PG8_MMA(1, 1, At, B1); PG8_BAR;
        }
        PG8_STAMP();
        if constexpr (!Epi::AFTER_DRAIN) { E(acc, cur, wr, wc, fr, fq); S.done(cur); }
        PG8_STAMP();
        if (!has_next) break;
#pragma unroll
        for (int a = 0; a < 2; ++a)
#pragma unroll
            for (int b = 0; b < 2; ++b)
#pragma unroll
                for (int m = 0; m < 4; ++m)
#pragma unroll
                    for (int n = 0; n < 2; ++n) acc[a][b][m][n] = (f32x4){0.f, 0.f, 0.f, 0.f};
        cur = nxt; cA = nA; cB = nB; ++ui;
    }
    PG8_WAIT_V(0);
    if (wr == 0) PG8_BAR;
    PG8_BAR;
    if constexpr (Epi::AFTER_DRAIN) { E.fused(acc, cur, wr, wc, fr, fq, lds, wid, lane); S.done(cur); }
    PG8_STAMP();
    if (STAMP && wid == 0) { stamps[lane] = lane < nts ? (((unsigned long long)(unsigned)ts_hi << 32) | (unsigned)ts_lo) : 0ull;
        if (lane == 62) stamps[62] = rt_entry; if (lane == 63) stamps[63] = (unsigned long long)wall_clock64(); }
#undef PG8_STAMP
#undef PG8_SA
#undef PG8_SB
#undef PG8_STAGE
#undef PG8_LDA
#undef PG8_LDB
#undef PG8_MMA
#undef PG8_WAIT_V
#undef PG8_WAIT_L
#undef PG8_BAR
#undef PG8_SCHED
}
}

constexpr int D = 1024, NB = 16, S = 2048, T = NB * S;
constexpr int NCOL = 2840, NPAD = 3072;
constexpr int C_Q = 0, C_KC = 512, C_VC = 640, C_KS = 768, C_VS = 896, C_KW = 1024, C_VW = 1152, C_GT = 1280, C_CB = 1304, C_CC = 1816, C_CH = 2328;
constexpr int NCMP = 127;
constexpr int NEXP = 16384;
constexpr float EPS = 1e-6f;
constexpr int NTHREADS = 512, NWAVES = 8;

constexpr size_t al256(size_t x) { return (x + 255) & ~(size_t)255; }
constexpr size_t WS_CTL   = 0;                                   constexpr size_t CTL_BYTES = 65536;
constexpr size_t WS_MOD   = WS_CTL + CTL_BYTES;
constexpr size_t WS_WIN   = al256(WS_MOD + (size_t)16 * 6144 * 4);
constexpr size_t WS_WOUT  = al256(WS_WIN + (size_t)NPAD * D * 2);
constexpr size_t WS_WQ    = al256(WS_WOUT + (size_t)D * D * 2);
constexpr size_t WS_KEYS  = al256(WS_WQ + (size_t)D * D * 2);
constexpr size_t WS_U8S   = al256(WS_KEYS + (size_t)16 * 128 * 64 * 2);
constexpr size_t WS_V8S   = al256(WS_U8S + (size_t)NEXP * D);
constexpr size_t WS_X8S   = al256(WS_V8S + (size_t)NEXP * D);
constexpr size_t WS_SU    = al256(WS_X8S + (size_t)T * D);
constexpr size_t WS_SV    = al256(WS_SU + (size_t)NEXP * 4);
constexpr size_t WS_SX    = al256(WS_SV + (size_t)NEXP * 4);
constexpr size_t WS_W1T   = al256(WS_SX + (size_t)T * 4);
constexpr size_t WS_W2T   = al256(WS_W1T + (size_t)2 * 64 * 2048 * 2);
constexpr size_t WS_PEC   = al256(WS_W2T + (size_t)2 * 64 * 64 * 2);
constexpr size_t WS_KC    = al256(WS_PEC + (size_t)2 * 64 * 4);
constexpr size_t WS_VC    = al256(WS_KC + (size_t)16 * 2 * 128 * 64 * 2);
constexpr size_t WS_H     = al256(WS_VC + (size_t)16 * 2 * 128 * 64 * 2);
constexpr size_t WS_CQ8   = WS_H;
constexpr size_t WS_CMAX  = WS_H + (size_t)32 * 1024 * 1024;
constexpr size_t WS_SSQP  = WS_H + (size_t)33 * 1024 * 1024;
constexpr size_t WS_OATT  = al256(WS_H + (size_t)T * D * 2);
constexpr size_t WS_PROJ  = al256(WS_OATT + (size_t)T * 512 * 2);
constexpr size_t WS_QP    = WS_PROJ;
constexpr size_t WS_PART  = WS_PROJ;
constexpr size_t WS_PO    = WS_PROJ;
constexpr size_t WS_E16   = WS_PROJ + (size_t)160 * 1024 * 1024;
constexpr size_t WS_EW    = WS_E16 + (size_t)T * 128 * 4;
constexpr size_t WS_Y     = al256(WS_PROJ + (size_t)T * NPAD * 2);
constexpr size_t WS_END   = al256(WS_Y + (size_t)T * D * 2);
static_assert(WS_EW + (size_t)T * 128 * 4 <= WS_Y, "alias region");
static_assert((size_t)8 * T * 128 * 4 <= (size_t)160 * 1024 * 1024, "PART fits under EIDX");
constexpr int CTL_CTR_A = 16384, CTL_CTR_B = 16384 + 8 * 256;

constexpr int LDS_STAGE = 147456;
constexpr int LDS_MISC_OFF = LDS_STAGE;
constexpr int LDS_BYTES = LDS_STAGE + 256;

typedef unsigned short bf16_t;
typedef short bf16x8 __attribute__((ext_vector_type(8)));
typedef short s16x4 __attribute__((ext_vector_type(4)));
typedef float f32x4 __attribute__((ext_vector_type(4)));
typedef unsigned u32x4v __attribute__((ext_vector_type(4)));
__device__ __forceinline__ float bf2f(bf16_t b) { return __uint_as_float(((unsigned)b) << 16); }
__device__ __forceinline__ bf16_t f2bf(float f) { unsigned u = __float_as_uint(f); u += 0x7FFFu + ((u >> 16) & 1u); return (bf16_t)(u >> 16); }
__device__ __forceinline__ float bflo(unsigned w) { return __uint_as_float(w << 16); }
__device__ __forceinline__ float bfhi(unsigned w) { return __uint_as_float(w & 0xFFFF0000u); }
__device__ __forceinline__ unsigned pack2(float lo, float hi) { return (unsigned)f2bf(lo) | ((unsigned)f2bf(hi) << 16); }
__device__ __forceinline__ float gelu_tanh(float x) { const float u = 0.7978845608028654f * (x + 0.044715f * x * x * x); return 0.5f * x * (1.0f + tanhf(u)); }
__device__ __forceinline__ float sigmoidf_(float x) { return 1.0f / (1.0f + __expf(-x)); }
__device__ __forceinline__ float wave_sum(float v) {
#pragma unroll
    for (int o = 32; o >= 1; o >>= 1) v += __shfl_xor(v, o);
    return v; }
__device__ __forceinline__ float wave_max(float v) {
#pragma unroll
    for (int o = 32; o >= 1; o >>= 1) v = fmaxf(v, __shfl_xor(v, o));
    return v; }
__device__ __forceinline__ void lds_wave_sync() { asm volatile("s_waitcnt lgkmcnt(0)" ::: "memory"); }
#ifdef PROBE_STAMP
#define STAMP_DECL unsigned long long tprev_ = 0ull; const bool dbg_ = (PROBE_PHASE == 12 || blockIdx.x == PROBE_BLOCK) && (threadIdx.x == 0);
#define STAMP_START() do { if (dbg_) tprev_ = __builtin_amdgcn_s_memtime(); } while (0)
#define STAMP(k) do { if (dbg_) { const unsigned long long tn_ = __builtin_amdgcn_s_memtime(); volatile LAS unsigned* c_ = (volatile LAS unsigned*)(F_lds_ + LDS_MISC_OFF + 128); c_[k] += (unsigned)(tn_ - tprev_); tprev_ = tn_; } } while (0)
#define STAMP_COUNT(k) do { if (dbg_) { volatile LAS unsigned* c_ = (volatile LAS unsigned*)(F_lds_ + LDS_MISC_OFF + 128); c_[k] += 1u; } } while (0)
#else
#define STAMP_DECL
#define STAMP_START() do {} while (0)
#define STAMP(k) do {} while (0)
#define STAMP_COUNT(k) do {} while (0)
#endif
#ifndef PROBE_BLOCK
#define PROBE_BLOCK 0
#endif
#ifndef PROBE_PHASE
#define PROBE_PHASE 4
#endif

__device__ __forceinline__ int rel_bucket(int dist) {
    const int n = dist > 0 ? dist : 0;
    if (n < 16) return n;
    const float lr = logf((float)n / 16.0f) / 2.0794415416798357f;
    const int large = 16 + (int)(lr * 16.0f);
    return large < 31 ? large : 31;
}

struct Frame {
    const float* in[23]; float* out; unsigned char* ws;
    LAS unsigned char* lds; int tid, lane, wave, G;
};


typedef int i32x4v __attribute__((ext_vector_type(4)));
constexpr int PEER_CHUNK_TOK = 128, PEER_NCHUNK = T / PEER_CHUNK_TOK;

__device__ __forceinline__ void quant_row_sliced(const float* row, unsigned char* dst8  , size_t nrows, size_t r, float* scale_out, int bias, int lane) {
    float4 v[4]; float am = 0.f;
#pragma unroll
    for (int i = 0; i < 4; ++i) { v[i] = *(const float4*)(row + (lane + 64 * i) * 4); am = fmaxf(am, fmaxf(fmaxf(fabsf(v[i].x), fabsf(v[i].y)), fmaxf(fabsf(v[i].z), fabsf(v[i].w)))); }
    am = wave_max(am); const float inv = am > 0.f ? 127.0f / am : 0.f;
    if (lane == 0) *scale_out = am > 0.f ? am / 127.0f : 0.f;
#pragma unroll
    for (int i = 0; i < 4; ++i) { const int col = (lane + 64 * i) * 4; const int sl = col >> 7, off = col & 127;
        const int q0 = (int)rintf(v[i].x * inv) + bias, q1 = (int)rintf(v[i].y * inv) + bias, q2 = (int)rintf(v[i].z * inv) + bias, q3 = (int)rintf(v[i].w * inv) + bias;
        *(unsigned*)(dst8 + ((size_t)sl * nrows + r) * 128 + off) = (unsigned)(q0 & 0xFF) | ((unsigned)(q1 & 0xFF) << 8) | ((unsigned)(q2 & 0xFF) << 16) | ((unsigned)(q3 & 0xFF) << 24); }
}

constexpr int PEER_NGRP = T / 16;
__device__ __forceinline__ int grab_item(unsigned* ctr, int slice, int lane) {
    unsigned v = 0u; if (lane == 0) v = __hip_atomic_fetch_add(ctr + slice * 64, 1u, __ATOMIC_RELAXED, __HIP_MEMORY_SCOPE_AGENT);
    return (int)__builtin_amdgcn_readfirstlane(v);
}
__device__ __forceinline__ void gather_rows16(u32x4v (&vv)[16], const unsigned char* base, const LAS unsigned* le) {
    const u32x4v e0 = *(const LAS u32x4v*)le, e1 = *(const LAS u32x4v*)(le + 4);
#pragma unroll
    for (int ld = 0; ld < 16; ++ld) { const unsigned w = ld < 8 ? e0[ld >> 1] : e1[(ld - 8) >> 1]; const unsigned e = (ld & 1) ? (w >> 16) : (w & 0xFFFFu);
        vv[ld] = *(const u32x4v*)(base + (size_t)e * 128); }
}
__device__ __forceinline__ void udot_item(const u32x4v (&uv)[16], const i32x4v xq, int* part_row  , int c) {
    i32x4v res[4];
#pragma unroll
    for (int ld = 0; ld < 16; ++ld) { int p = __builtin_amdgcn_sdot4((int)uv[ld][0], xq[0], 0, false); p = __builtin_amdgcn_sdot4((int)uv[ld][1], xq[1], p, false);
        p = __builtin_amdgcn_sdot4((int)uv[ld][2], xq[2], p, false); p = __builtin_amdgcn_sdot4((int)uv[ld][3], xq[3], p, false);
        p += __shfl_xor(p, 1); p += __shfl_xor(p, 2); p += __shfl_xor(p, 4); res[ld >> 2][ld & 3] = p; }
    if (c == 0) {
#pragma unroll
        for (int q = 0; q < 4; ++q) *(i32x4v*)(part_row + 4 * q) = res[q]; }
}
__device__ __forceinline__ void p10a_udots(const Frame& F) {
    const unsigned char* U8S = F.ws + WS_U8S; const unsigned char* X8S = F.ws + WS_X8S; const unsigned short* E16 = (const unsigned short*)(F.ws + WS_E16); int* PART = (int*)(F.ws + WS_PART);
    unsigned* ctr = (unsigned*)(F.ws + WS_CTL + CTL_CTR_A);
    const int lane = F.lane, j = lane >> 3, c = lane & 7; const int xcc = (int)(xb_xcc_id() & 7u);
    LAS unsigned char* wl = F.lds + F.wave * 8192;
    const LAS unsigned* le = (const LAS unsigned*)wl + 8 * j;
    for (int so = 0; so < 8; ++so) { const int x = (xcc + so) & 7;
        const unsigned char* ub = U8S + (size_t)x * NEXP * 128 + c * 16;
        int nxt = grab_item(ctr, x, lane);
        for (;;) { const int cur = nxt; if (cur >= PEER_NGRP) break;
            nxt = grab_item(ctr, x, lane);
            const int t0 = cur * 16;
            { const u32x4v* src = (const u32x4v*)(E16 + (size_t)t0 * 128);
#pragma unroll
                for (int i = 0; i < 4; ++i) *(LAS u32x4v*)(wl + (lane + 64 * i) * 16) = src[lane + 64 * i]; }
            lds_wave_sync();
            const unsigned char* xb = X8S + ((size_t)x * T + t0) * 128 + c * 16; int* pr = PART + ((size_t)x * T + t0) * 128 + 16 * j;
            u32x4v va[16], vb[16];
            gather_rows16(va, ub, le);
#pragma unroll 1
            for (int tt = 0; tt < 16; tt += 2) {
                const i32x4v xqa = *(const i32x4v*)(xb + (size_t)tt * 128), xqb = *(const i32x4v*)(xb + (size_t)(tt + 1) * 128);
                gather_rows16(vb, ub, le + (tt + 1) * 64);
                udot_item(va, xqa, pr + (size_t)tt * 128, c);
                if (tt + 2 < 16) gather_rows16(va, ub, le + (tt + 2) * 64);
                udot_item(vb, xqb, pr + (size_t)(tt + 1) * 128, c);
            }
            lds_wave_sync();
        }
    }
}

__device__ __forceinline__ void p10b_coef(const Frame& F) {
    const unsigned short* E16 = (const unsigned short*)(F.ws + WS_E16); const float* EW = (const float*)(F.ws + WS_EW); const int* PART = (const int*)(F.ws + WS_PART);
    const float* SU = (const float*)(F.ws + WS_SU); const float* SV = (const float*)(F.ws + WS_SV); const float* SX = (const float*)(F.ws + WS_SX);
    signed char* CQ8 = (signed char*)(F.ws + WS_CQ8); float* CMAX = (float*)(F.ws + WS_CMAX);
    const int gw = blockIdx.x * NWAVES + F.wave, nw = F.G * NWAVES, lane = F.lane;
    for (int t = gw; t < T; t += nw) { const float sx = SX[t]; float cs[2]; float am = 0.f;
#pragma unroll
        for (int hh = 0; hh < 2; ++hh) { const int i = lane + 64 * hh; int s = 0;
#pragma unroll
            for (int x = 0; x < 8; ++x) s += PART[((size_t)x * T + t) * 128 + i];
            const int e = E16[(size_t)t * 128 + i]; const float dot = (float)s * sx * SU[e];
            cs[hh] = EW[(size_t)t * 128 + i] * gelu_tanh(dot) * SV[e]; am = fmaxf(am, fabsf(cs[hh])); }
        am = wave_max(am); const float inv = am > 0.f ? 127.0f / am : 0.f;
#pragma unroll
        for (int hh = 0; hh < 2; ++hh) CQ8[(size_t)t * 128 + lane + 64 * hh] = (signed char)(int)rintf(cs[hh] * inv);
        if (lane == 0) CMAX[t] = am > 0.f ? am / 127.0f : 0.f; }
}

struct VsumPre { float sc; };
__device__ __forceinline__ void vsum_item(const u32x4v (&vv)[16], const LAS unsigned* lq  , const VsumPre& pre, unsigned* pop, int lane) {
    const u32x4v cq = *(const LAS u32x4v*)lq;
    int acc[16];
#pragma unroll
    for (int k = 0; k < 16; ++k) acc[k] = 0;
#pragma unroll
    for (int g = 0; g < 4; ++g) { const int cw = (int)cq[g];
#pragma unroll
        for (int w = 0; w < 4; ++w) { const unsigned r0 = vv[4 * g][w], r1 = vv[4 * g + 1][w], r2 = vv[4 * g + 2][w], r3 = vv[4 * g + 3][w];
            const unsigned t0 = __builtin_amdgcn_perm(r1, r0, 0x05010400u), t1 = __builtin_amdgcn_perm(r1, r0, 0x07030602u), t2 = __builtin_amdgcn_perm(r3, r2, 0x05010400u), t3 = __builtin_amdgcn_perm(r3, r2, 0x07030602u);
            const unsigned c0 = __builtin_amdgcn_perm(t2, t0, 0x05040100u), c1 = __builtin_amdgcn_perm(t2, t0, 0x07060302u), c2 = __builtin_amdgcn_perm(t3, t1, 0x05040100u), c3 = __builtin_amdgcn_perm(t3, t1, 0x07060302u);
            acc[4 * w + 0] = __builtin_amdgcn_sdot4((int)c0, cw, acc[4 * w + 0], false); acc[4 * w + 1] = __builtin_amdgcn_sdot4((int)c1, cw, acc[4 * w + 1], false);
            acc[4 * w + 2] = __builtin_amdgcn_sdot4((int)c2, cw, acc[4 * w + 2], false); acc[4 * w + 3] = __builtin_amdgcn_sdot4((int)c3, cw, acc[4 * w + 3], false); } }
    int a8[8], a4[4], a2[2];
    { const bool hi = (lane & 32) != 0;
#pragma unroll
        for (int k = 0; k < 8; ++k) { const int snd = hi ? acc[k] : acc[k + 8]; const int rcv = __shfl_xor(snd, 32); a8[k] = (hi ? acc[k + 8] : acc[k]) + rcv; } }
    { const bool hi = (lane & 16) != 0;
#pragma unroll
        for (int k = 0; k < 4; ++k) { const int snd = hi ? a8[k] : a8[k + 4]; const int rcv = __shfl_xor(snd, 16); a4[k] = (hi ? a8[k + 4] : a8[k]) + rcv; } }
    { const bool hi = (lane & 8) != 0;
#pragma unroll
        for (int k = 0; k < 2; ++k) { const int snd = hi ? a4[k] : a4[k + 2]; const int rcv = __shfl_xor(snd, 8); a2[k] = (hi ? a4[k + 2] : a4[k]) + rcv; } }
    *pop = pg8::cvt_pk_bf16((float)a2[0] * pre.sc, (float)a2[1] * pre.sc);
}
__device__ __forceinline__ void p10c_vsum(const Frame& F) {
    const unsigned char* V8S = F.ws + WS_V8S; const unsigned short* E16 = (const unsigned short*)(F.ws + WS_E16); const signed char* CQ8 = (const signed char*)(F.ws + WS_CQ8); const float* CMAX = (const float*)(F.ws + WS_CMAX);
    bf16_t* PO = (bf16_t*)(F.ws + WS_PO);
    unsigned* ctr = (unsigned*)(F.ws + WS_CTL + CTL_CTR_B);
    const int lane = F.lane, j = lane >> 3, c = lane & 7; const int xcc = (int)(xb_xcc_id() & 7u);
    const int ocol = 16 * c + 8 * ((lane >> 5) & 1) + 4 * ((lane >> 4) & 1) + 2 * ((lane >> 3) & 1);
    LAS unsigned char* wl = F.lds + F.wave * 8192;
    const LAS unsigned* le = (const LAS unsigned*)wl + 8 * j; const LAS unsigned* lq = (const LAS unsigned*)(wl + 4096) + 4 * j;
    for (int so = 0; so < 8; ++so) { const int x = (xcc + so) & 7;
        const unsigned char* vb = V8S + (size_t)x * NEXP * 128 + c * 16;
        const int col = x * 128 + ocol;
        int nxt = grab_item(ctr, x, lane);
        for (;;) { const int cur = nxt; if (cur >= PEER_NGRP) break;
            nxt = grab_item(ctr, x, lane);
            const int t0 = cur * 16;
            { const u32x4v* src = (const u32x4v*)(E16 + (size_t)t0 * 128); const u32x4v* srq = (const u32x4v*)(CQ8 + (size_t)t0 * 128);
#pragma unroll
                for (int i = 0; i < 4; ++i) *(LAS u32x4v*)(wl + (lane + 64 * i) * 16) = src[lane + 64 * i];
#pragma unroll
                for (int i = 0; i < 2; ++i) *(LAS u32x4v*)(wl + 4096 + (lane + 64 * i) * 16) = srq[lane + 64 * i]; }
            lds_wave_sync();
            u32x4v va[16], vbb[16];
            gather_rows16(va, vb, le);
#pragma unroll 1
            for (int tt = 0; tt < 16; tt += 2) {
                { VsumPre pa; pa.sc = CMAX[t0 + tt];
                  gather_rows16(vbb, vb, le + (tt + 1) * 64);
                  vsum_item(va, lq + tt * 32, pa, (unsigned*)(PO + (size_t)(t0 + tt) * D + col), lane); }
                { VsumPre pb; pb.sc = CMAX[t0 + tt + 1];
                  if (tt + 2 < 16) gather_rows16(va, vb, le + (tt + 2) * 64);
                  vsum_item(vbb, lq + (tt + 1) * 32, pb, (unsigned*)(PO + (size_t)(t0 + tt + 1) * D + col), lane); }
            }
            lds_wave_sync();
        }
    }
}

__device__ __forceinline__ void p10d_final(const Frame& F) {
    const bf16_t* PO = (const bf16_t*)(F.ws + WS_PO); const float* MOD = (const float*)(F.ws + WS_MOD); const float* gfin = F.in[22]; float* out = F.out;
    const int gw = blockIdx.x * NWAVES + F.wave, nw = F.G * NWAVES, lane = F.lane;
    const float* xin = F.in[0]; const bf16_t* Y = (const bf16_t*)(F.ws + WS_Y);
    float4 xn[4]; uint2 pn[4], yn[4];
    if (gw < T) {
#pragma unroll
        for (int i = 0; i < 4; ++i) { const int col = (lane + 64 * i) * 4; xn[i] = *(const float4*)(xin + (size_t)gw * D + col); pn[i] = *(const uint2*)(PO + (size_t)gw * D + col); yn[i] = *(const uint2*)(Y + (size_t)gw * D + col); } }
    for (int t = gw; t < T; t += nw) { const int b = t / S;
        float4 v[4], xc[4]; uint2 pc[4], yc[4]; float ss = 0.f;
#pragma unroll
        for (int i = 0; i < 4; ++i) { xc[i] = xn[i]; pc[i] = pn[i]; yc[i] = yn[i]; }
        { const int tn = t + nw < T ? t + nw : t;
#pragma unroll
            for (int i = 0; i < 4; ++i) { const int col = (lane + 64 * i) * 4; xn[i] = *(const float4*)(xin + (size_t)tn * D + col); pn[i] = *(const uint2*)(PO + (size_t)tn * D + col); yn[i] = *(const uint2*)(Y + (size_t)tn * D + col); } }
#pragma unroll
        for (int i = 0; i < 4; ++i) { const int col = (lane + 64 * i) * 4; const float4 g1 = *(const float4*)(MOD + b * 6144 + 2048 + col), gt = *(const float4*)(MOD + b * 6144 + 5120 + col);
            const uint2 pw = pc[i], yw = yc[i];
            v[i].x = xc[i].x + g1.x * bflo(yw.x) + gt.x * bflo(pw.x); v[i].y = xc[i].y + g1.y * bfhi(yw.x) + gt.y * bfhi(pw.x); v[i].z = xc[i].z + g1.z * bflo(yw.y) + gt.z * bflo(pw.y); v[i].w = xc[i].w + g1.w * bfhi(yw.y) + gt.w * bfhi(pw.y);
            ss += v[i].x * v[i].x + v[i].y * v[i].y + v[i].z * v[i].z + v[i].w * v[i].w; }
        ss = wave_sum(ss);
#ifdef PROBE_STAMP
        const unsigned* dg = (const unsigned*)(F.ws + WS_CTL + 32768); const float pnum = (float)dg[PROBE_STAMP]; const float pden = PROBE_DEN >= 0 ? (float)dg[PROBE_DEN >= 0 ? PROBE_DEN : 0] : (float)PROBE_ABS;
        const float rstd = rsqrtf(ss * (1.0f / D) + EPS) * (1.0f + 0.5f * pnum / pden);
#else
        const float rstd = rsqrtf(ss * (1.0f / D) + EPS);
#endif
#pragma unroll
        for (int i = 0; i < 4; ++i) { const int col = (lane + 64 * i) * 4; const float4 gg = *(const float4*)(gfin + col);
            *(float4*)(out + (size_t)t * D + col) = make_float4(v[i].x * rstd * gg.x, v[i].y * rstd * gg.y, v[i].z * rstd * gg.z, v[i].w * rstd * gg.w); }
    }
}

__device__ __forceinline__ void transpose_tile(const Frame& F, const float* src, int srcK, int srcN, bf16_t* dst, int dstK, int kt, int nt) {
    LAS float* tile = (LAS float*)F.lds;
    const int k0 = kt * 64, n0 = nt * 64;
    for (int i = F.tid; i < 4096; i += NTHREADS) { const int r = i >> 6, c = i & 63; const int k = k0 + r, n = n0 + c;
        tile[r * 65 + c] = (k < srcK && n < srcN) ? src[(size_t)k * srcN + n] : 0.0f; }
    __syncthreads();
    for (int i = F.tid; i < 4096; i += NTHREADS) { const int r = i >> 6, c = i & 63;
        dst[(size_t)(n0 + r) * dstK + k0 + c] = f2bf(tile[c * 65 + r]); }
    __syncthreads();
}
__device__ __forceinline__ void p0_prologue(const Frame& F, int item_lo = 0, int item_hi = 1 << 30) {
    const float* c = F.in[1]; const float* w_mod = F.in[4]; const float* b_mod = F.in[5];
    float* MOD = (float*)(F.ws + WS_MOD);
    constexpr int I_MOD = 96, I_WIN = 16 * 48, I_WOUT = 256, I_WQ = 256, I_U = 256, I_V = 256, I_KEYS = 32, I_CMP = 32 + 32 + 1 + 1 + 2;
    constexpr int O_WIN = I_MOD, O_WOUT = O_WIN + I_WIN, O_WQ = O_WOUT + I_WOUT, O_U = O_WQ + I_WQ, O_V = O_U + I_U, O_KEYS = O_V + I_V, O_CMP = O_KEYS + I_KEYS, N_ITEMS = O_CMP + I_CMP;
    for (int vit = item_lo + blockIdx.x; vit < N_ITEMS && vit < item_hi; vit += F.G) {
        int it = vit;
        if (vit >= O_WIN) { const int v = vit - O_WIN; constexpr int NQ = I_U + I_V, NT = I_WIN + I_WOUT + I_WQ;
            it = v < NQ ? O_U + v : (v < NQ + NT ? O_WIN + (v - NQ) : O_KEYS + (v - NQ - NT)); }
        if (it < O_WIN) {
            LAS float* sl = (LAS float*)F.lds; LAS float* red = (LAS float*)(F.lds + 65536);
            for (int q = F.tid; q < 16 * D; q += NTHREADS) { const float cv = c[q]; sl[q] = cv / (1.0f + __expf(-cv)); }
            __syncthreads();
            const int kg = F.tid >> 6, cl = F.tid & 63, j0 = it * 64;
            float acc[16];
#pragma unroll
            for (int bb = 0; bb < 16; ++bb) acc[bb] = 0.f;
            const float* wp = w_mod + (size_t)(kg * 128) * 6144 + j0 + cl;
#pragma unroll 4
            for (int kk = 0; kk < 128; ++kk) { const float w = wp[(size_t)kk * 6144]; const int k = kg * 128 + kk;
#pragma unroll
                for (int bb = 0; bb < 16; ++bb) acc[bb] += sl[bb * D + k] * w; }
#pragma unroll
            for (int bb = 0; bb < 16; ++bb) red[(kg * 16 + bb) * 64 + cl] = acc[bb];
            __syncthreads();
#pragma unroll
            for (int q = 0; q < 2; ++q) { const int o = F.tid + 512 * q; const int bb = o >> 6, cc = o & 63; float s = b_mod[j0 + cc];
#pragma unroll
                for (int g8 = 0; g8 < 8; ++g8) s += red[(g8 * 16 + bb) * 64 + cc];
                MOD[bb * 6144 + j0 + cc] = s; }
            __syncthreads();
        } else if (it < O_WOUT) { const int i = it - O_WIN; transpose_tile(F, F.in[6], D, NCOL, (bf16_t*)(F.ws + WS_WIN), D, i % 16, i / 16); }
        else if (it < O_WQ) { const int i = it - O_WOUT; transpose_tile(F, F.in[16], D, D, (bf16_t*)(F.ws + WS_WOUT), D, i % 16, i / 16); }
        else if (it < O_U) { const int i = it - O_WQ; transpose_tile(F, F.in[17], D, D, (bf16_t*)(F.ws + WS_WQ), D, i % 16, i / 16); }
        else if (it < O_KEYS) {
            const bool isv = it >= O_V; const int i = isv ? it - O_V : it - O_U;
            for (int rr = 0; rr < 8; ++rr) { const size_t r = (size_t)i * 64 + rr * 8 + F.wave;
                quant_row_sliced((isv ? F.in[20] : F.in[19]) + r * D, F.ws + (isv ? WS_V8S : WS_U8S), NEXP, r, (float*)(F.ws + (isv ? WS_SV : WS_SU)) + r, 0, F.lane); }
        } else if (it >= O_CMP) {
            const int i = it - O_CMP;
            if (i < 64) { const int kv = i >> 5; transpose_tile(F, kv ? F.in[11] : F.in[9], 2048, 64, (bf16_t*)(F.ws + WS_W1T) + (size_t)kv * 64 * 2048, 2048, i & 31, 0); }
            else if (i < 66) { const int kv = i - 64; transpose_tile(F, kv ? F.in[12] : F.in[10], 64, 64, (bf16_t*)(F.ws + WS_W2T) + (size_t)kv * 64 * 64, 64, 0, 0); }
            else { const int kv = i - 66; const float* pe = kv ? F.in[8] : F.in[7]; const float* w1 = kv ? F.in[11] : F.in[9];
                LAS float* red = (LAS float*)F.lds; const int jj = F.tid & 63, kg = F.tid >> 6; float a = 0.f;
#pragma unroll 32
                for (int kk = 0; kk < 256; ++kk) { const int k = kg * 256 + kk; a += pe[k] * w1[(size_t)k * 64 + jj]; }
                red[kg * 64 + jj] = a; __syncthreads();
                if (F.tid < 64) { float s = 0.f;
#pragma unroll
                    for (int g8 = 0; g8 < 8; ++g8) s += red[g8 * 64 + F.tid];
                    ((float*)(F.ws + WS_PEC))[kv * 64 + F.tid] = s; }
                __syncthreads(); }
        } else {
            const int i = it - O_KEYS; const float4* src = (const float4*)F.in[18] + (size_t)i * 1024; uint2* dst = (uint2*)(F.ws + WS_KEYS) + (size_t)i * 1024;
#pragma unroll
            for (int q = 0; q < 2; ++q) { const float4 v = src[F.tid + 512 * q]; dst[F.tid + 512 * q] = make_uint2(pack2(v.x, v.y), pack2(v.z, v.w)); }
        }
    }
}

__device__ __forceinline__ void norm_mod_rows(const Frame& F, const float* x, const float* g, int sh_off, int sc_off, bf16_t* dst) {
    const float* MOD = (const float*)(F.ws + WS_MOD);
    const int gw = blockIdx.x * NWAVES + F.wave, nw = F.G * NWAVES;
    float4 vn[4];
    if (gw < T) {
#pragma unroll
        for (int i = 0; i < 4; ++i) vn[i] = ((const float4*)(x + (size_t)gw * D))[F.lane + 64 * i]; }
    for (int t = gw; t < T; t += nw) {
        const int b = t / S;
        float4 v[4]; float ss = 0.f;
#pragma unroll
        for (int i = 0; i < 4; ++i) { v[i] = vn[i]; ss += v[i].x * v[i].x + v[i].y * v[i].y + v[i].z * v[i].z + v[i].w * v[i].w; }
        { const int tn = t + nw < T ? t + nw : t;
#pragma unroll
            for (int i = 0; i < 4; ++i) vn[i] = ((const float4*)(x + (size_t)tn * D))[F.lane + 64 * i]; }
        ss = wave_sum(ss); const float rstd = rsqrtf(ss * (1.0f / D) + EPS);
#pragma unroll
        for (int i = 0; i < 4; ++i) { const int col = (F.lane + 64 * i) * 4;
            const float4 gg = *(const float4*)(g + col), sc = *(const float4*)(MOD + b * 6144 + sc_off + col), sh = *(const float4*)(MOD + b * 6144 + sh_off + col);
            const float o0 = v[i].x * rstd * gg.x * (1.f + sc.x) + sh.x, o1 = v[i].y * rstd * gg.y * (1.f + sc.y) + sh.y, o2 = v[i].z * rstd * gg.z * (1.f + sc.z) + sh.z, o3 = v[i].w * rstd * gg.w * (1.f + sc.w) + sh.w;
            *(uint2*)(dst + (size_t)t * D + col) = make_uint2(pack2(o0, o1), pack2(o2, o3)); }
    }
}

__device__ __forceinline__ void norm_mod_rows_q(const Frame& F, const float* x, const float* g, int sh_off, int sc_off, bf16_t* dst) {
    const float* MOD = (const float*)(F.ws + WS_MOD);
    const int gw = blockIdx.x * NWAVES + F.wave, nw = F.G * NWAVES;
    const bf16_t* Y = (const bf16_t*)(F.ws + WS_Y);
    float4 vn[4]; uint2 yn[4];
    if (gw < T) {
#pragma unroll
        for (int i = 0; i < 4; ++i) { vn[i] = ((const float4*)(x + (size_t)gw * D))[F.lane + 64 * i]; yn[i] = ((const uint2*)(Y + (size_t)gw * D))[F.lane + 64 * i]; } }
    for (int t = gw; t < T; t += nw) {
        const int b = t / S;
        float4 v[4]; float ss = 0.f;
#pragma unroll
        for (int i = 0; i < 4; ++i) { const int col = (F.lane + 64 * i) * 4; const float4 gt = *(const float4*)(MOD + b * 6144 + 2048 + col);
            v[i].x = vn[i].x + gt.x * bflo(yn[i].x); v[i].y = vn[i].y + gt.y * bfhi(yn[i].x); v[i].z = vn[i].z + gt.z * bflo(yn[i].y); v[i].w = vn[i].w + gt.w * bfhi(yn[i].y);
            ss += v[i].x * v[i].x + v[i].y * v[i].y + v[i].z * v[i].z + v[i].w * v[i].w; }
        { const int tn = t + nw < T ? t + nw : t;
#pragma unroll
            for (int i = 0; i < 4; ++i) { vn[i] = ((const float4*)(x + (size_t)tn * D))[F.lane + 64 * i]; yn[i] = ((const uint2*)(Y + (size_t)tn * D))[F.lane + 64 * i]; } }
        ss = wave_sum(ss); const float rstd = rsqrtf(ss * (1.0f / D) + EPS);
        float am = 0.f;
#pragma unroll
        for (int i = 0; i < 4; ++i) { const int col = (F.lane + 64 * i) * 4;
            const float4 gg = *(const float4*)(g + col), sc = *(const float4*)(MOD + b * 6144 + sc_off + col), sh = *(const float4*)(MOD + b * 6144 + sh_off + col);
            v[i].x = v[i].x * rstd * gg.x * (1.f + sc.x) + sh.x; v[i].y = v[i].y * rstd * gg.y * (1.f + sc.y) + sh.y; v[i].z = v[i].z * rstd * gg.z * (1.f + sc.z) + sh.z; v[i].w = v[i].w * rstd * gg.w * (1.f + sc.w) + sh.w;
            *(uint2*)(dst + (size_t)t * D + col) = make_uint2(pack2(v[i].x, v[i].y), pack2(v[i].z, v[i].w));
            am = fmaxf(am, fmaxf(fmaxf(fabsf(v[i].x), fabsf(v[i].y)), fmaxf(fabsf(v[i].z), fabsf(v[i].w)))); }
        am = wave_max(am); const float inv = am > 0.f ? 127.0f / am : 0.f;
        if (F.lane == 0) ((float*)(F.ws + WS_SX))[t] = am > 0.f ? am / 127.0f : 0.f;
#pragma unroll
        for (int i = 0; i < 4; ++i) { const int col = (F.lane + 64 * i) * 4; const int sl = col >> 7, off = col & 127;
            const int q0 = (int)rintf(v[i].x * inv), q1 = (int)rintf(v[i].y * inv), q2 = (int)rintf(v[i].z * inv), q3 = (int)rintf(v[i].w * inv);
            *(unsigned*)(F.ws + WS_X8S + ((size_t)sl * T + t) * 128 + off) = (unsigned)(q0 & 0xFF) | ((unsigned)(q1 & 0xFF) << 8) | ((unsigned)(q2 & 0xFF) << 16) | ((unsigned)(q3 & 0xFF) << 24); }
    }
}

__device__ __forceinline__ void p3_compress_naive(const Frame& F) {
    const bf16_t* PROJ = (const bf16_t*)(F.ws + WS_PROJ);
    LAS float* hid = (LAS float*)F.lds + F.wave * 64;
    const int gw = blockIdx.x * NWAVES + F.wave, nw = F.G * NWAVES;
    if (gw < 64) { bf16_t* dz = (bf16_t*)(F.ws + ((gw & 1) ? WS_VC : WS_KC)); dz[((size_t)(gw >> 1) * 128 + 127) * 64 + F.lane] = 0; }
    for (int u = gw; u < NB * NCMP * 2 * 2; u += nw) {
        const int kv = u & 1, g = (u >> 1) & 1, n = (u >> 2) % NCMP, b = (u >> 2) / NCMP;
        const float* pe = kv ? F.in[8] : F.in[7]; const float* w1 = kv ? F.in[11] : F.in[9]; const float* w2 = kv ? F.in[12] : F.in[10];
        const int cbase = (kv ? C_VC : C_KC) + g * 64;
        float acc = 0.f;
        for (int l = 0; l < 32; ++l) {
            const bf16_t* row = PROJ + (size_t)(b * S + 16 * n + l) * NPAD + cbase;
            for (int d = 0; d < 64; ++d) { const float a = bf2f(row[d]) + pe[l * 64 + d]; acc += a * w1[(size_t)(l * 64 + d) * 64 + F.lane]; }
        }
        hid[F.lane] = gelu_tanh(acc); lds_wave_sync();
        float o = 0.f;
        for (int j = 0; j < 64; ++j) o += hid[j] * w2[j * 64 + F.lane];
        bf16_t* dst = (bf16_t*)(F.ws + (kv ? WS_VC : WS_KC)); dst[((size_t)(b * 2 + g) * 128 + n) * 64 + F.lane] = f2bf(o);
        lds_wave_sync();
    }
}


__device__ __forceinline__ void p3_compress_mfma(const Frame& F) {
    const bf16_t* PROJ = (const bf16_t*)(F.ws + WS_PROJ);
    const int lane = F.lane, tid = F.tid, wave = F.wave, grp = lane >> 4, col = lane & 15;
    LAS float* red = (LAS float*)F.lds;
    LAS bf16_t* hid = (LAS bf16_t*)(F.lds + 32768);
    if (blockIdx.x * NWAVES + wave < 64) { const int gw = blockIdx.x * NWAVES + wave; bf16_t* dz = (bf16_t*)(F.ws + ((gw & 1) ? WS_VC : WS_KC)); dz[((size_t)(gw >> 1) * 128 + 127) * 64 + lane] = 0; }
    for (int u = blockIdx.x; u < NB * 2 * 2 * 8; u += F.G) {
        const int nt8 = u & 7, kv = (u >> 3) & 1, g = (u >> 4) & 1, b = u >> 5; const int n0 = nt8 * 16;
        const bf16_t* W1T = (const bf16_t*)(F.ws + WS_W1T) + (size_t)kv * 64 * 2048; const bf16_t* W2T = (const bf16_t*)(F.ws + WS_W2T) + (size_t)kv * 64 * 64;
        const float* pec = (const float*)(F.ws + WS_PEC) + kv * 64;
        const int cbase = (kv ? C_VC : C_KC) + g * 64;
        const int nrow = (n0 + col) < NCMP ? (n0 + col) : (NCMP - 1);
        f32x4 acc[4];
#pragma unroll
        for (int nt = 0; nt < 4; ++nt) acc[nt] = (f32x4){0.f, 0.f, 0.f, 0.f};
#pragma unroll
        for (int ks = 0; ks < 8; ++ks) { const int l = 4 * wave + (ks >> 1), d0 = (ks & 1) * 32 + 8 * grp;
            const bf16x8 af = *(const bf16x8*)(PROJ + (size_t)(b * S + 16 * nrow + l) * NPAD + cbase + d0);
#pragma unroll
            for (int nt = 0; nt < 4; ++nt) { const bf16x8 bfr = *(const bf16x8*)(W1T + (size_t)(nt * 16 + col) * 2048 + l * 64 + d0);
                acc[nt] = __builtin_amdgcn_mfma_f32_16x16x32_bf16(af, bfr, acc[nt], 0, 0, 0); } }
#pragma unroll
        for (int nt = 0; nt < 4; ++nt)
#pragma unroll
            for (int rg = 0; rg < 4; ++rg) red[(wave * 16 + 4 * grp + rg) * 64 + nt * 16 + col] = acc[nt][rg];
        __syncthreads();
#pragma unroll
        for (int q = 0; q < 2; ++q) { const int idx = tid + 512 * q; float s = pec[idx & 63];
#pragma unroll
            for (int w = 0; w < 8; ++w) s += red[w * 1024 + idx];
            hid[idx] = f2bf(gelu_tanh(s)); }
        __syncthreads();
        if (wave < 4) { f32x4 o = (f32x4){0.f, 0.f, 0.f, 0.f};
#pragma unroll
            for (int ks = 0; ks < 2; ++ks) { const bf16x8 af = *(const LAS bf16x8*)(hid + col * 64 + ks * 32 + 8 * grp); const bf16x8 bfr = *(const bf16x8*)(W2T + (size_t)(wave * 16 + col) * 64 + ks * 32 + 8 * grp);
                o = __builtin_amdgcn_mfma_f32_16x16x32_bf16(af, bfr, o, 0, 0, 0); }
            bf16_t* dst = (bf16_t*)(F.ws + (kv ? WS_VC : WS_KC));
#pragma unroll
            for (int rg = 0; rg < 4; ++rg) { const int n = n0 + 4 * grp + rg; if (n < NCMP) dst[((size_t)(b * 2 + g) * 128 + n) * 64 + wave * 16 + col] = f2bf(o[rg]); } }
        __syncthreads();
    }
}

__device__ __forceinline__ void dot4_row(const bf16_t* krow, const LAS float* qs, float (&acc)[4]) {
    const uint4* kr = (const uint4*)krow;
#pragma unroll 1
    for (int c = 0; c < 8; ++c) { asm volatile("" ::: "memory"); const uint4 w = kr[c]; const unsigned ww[4] = {w.x, w.y, w.z, w.w};
#pragma unroll
        for (int e = 0; e < 4; ++e) { const float k0 = bflo(ww[e]), k1 = bfhi(ww[e]); const int d = c * 8 + e * 2;
#pragma unroll
            for (int r = 0; r < 4; ++r) acc[r] += qs[r * 64 + d] * k0 + qs[r * 64 + d + 1] * k1; } }
}
__device__ __forceinline__ void p4_attn_naive(const Frame& F) {
    const bf16_t* PROJ = (const bf16_t*)(F.ws + WS_PROJ); const bf16_t* KC = (const bf16_t*)(F.ws + WS_KC); const bf16_t* VC = (const bf16_t*)(F.ws + WS_VC);
    bf16_t* OATT = (bf16_t*)(F.ws + WS_OATT); const float* rel = F.in[21];
    LAS float* wl = (LAS float*)F.lds + F.wave * (256 + 512 + 2048 + 16);
    LAS float* qs = wl; LAS float* pc = wl + 256; LAS float* ps = wl + 768; LAS int* pbase = (LAS int*)(wl + 768 + 2048);
    const int gw = blockIdx.x * NWAVES + F.wave, nw = F.G * NWAVES, lane = F.lane;
    for (int u = gw; u < T * 2; u += nw) {
        const int g = u & 1, tok = u >> 1, b = tok / S, t = tok % S;
        const bf16_t* prow = PROJ + (size_t)tok * NPAD;
#pragma unroll
        for (int r = 0; r < 4; ++r) qs[r * 64 + lane] = bf2f(prow[C_Q + (g * 4 + r) * 64 + lane]) * 0.125f;
        lds_wave_sync();
        const int nv = t >= 31 ? ((t - 31) >> 4) + 1 : 0;
        float sc[2][4]; bool va[2];
#pragma unroll
        for (int i = 0; i < 2; ++i) { const int n = lane + 64 * i; va[i] = n < nv; float a[4] = {0.f, 0.f, 0.f, 0.f};
            if (va[i]) { dot4_row(KC + ((size_t)(b * 2 + g) * 128 + n) * 64, qs, a); const int bk = rel_bucket(t - (16 * n + 31));
#pragma unroll
                for (int r = 0; r < 4; ++r) a[r] += rel[bk * 8 + g * 4 + r]; }
#pragma unroll
            for (int r = 0; r < 4; ++r) sc[i][r] = va[i] ? a[r] : -1e30f; }
        float ocmp[4];
#pragma unroll
        for (int r = 0; r < 4; ++r) { const float m = wave_max(fmaxf(sc[0][r], sc[1][r]));
            const float e0 = va[0] ? __expf(sc[0][r] - m) : 0.f, e1 = va[1] ? __expf(sc[1][r] - m) : 0.f; const float sum = wave_sum(e0 + e1);
            const float inv = nv > 0 ? 1.0f / sum : 0.f; pc[r * 128 + lane] = e0 * inv; pc[r * 128 + 64 + lane] = e1 * inv; }
        lds_wave_sync();
        { float o[4] = {0.f, 0.f, 0.f, 0.f}; const bf16_t* vb = VC + ((size_t)(b * 2 + g) * 128) * 64 + lane;
            for (int n = 0; n < nv; ++n) { const float v = bf2f(vb[n * 64]);
#pragma unroll
                for (int r = 0; r < 4; ++r) o[r] += pc[r * 128 + n] * v; }
#pragma unroll
            for (int r = 0; r < 4; ++r) ocmp[r] = o[r]; }
        const int cur = t >> 6; float val;
        { const int j = lane & 31; float imp = 0.f;
#pragma unroll
            for (int r = 0; r < 4; ++r) for (int n = 4 * j - 1; n <= 4 * j + 3; ++n) if (n >= 0 && n < NCMP) imp += pc[r * 128 + n];
            const bool forced = (j == 0) || (j == cur) || (j == cur - 1); const bool allowed = j <= cur;
            val = forced ? 1e4f : (allowed ? imp : -INFINITY); }
        int rank = 0;
        for (int jp = 0; jp < 32; ++jp) { const float vp = __shfl(val, jp); rank += ((vp > val) || (vp == val && jp < (lane & 31))) ? 1 : 0; }
        unsigned selmask = (unsigned)(__ballot(lane < 32 && rank < 8) & 0xFFFFFFFFull);
        float oslc[4], owin[4];
#pragma unroll
        for (int br = 0; br < 2; ++br) {
            const int ck = br == 0 ? C_KS : C_KW, cv = br == 0 ? C_VS : C_VW;
            unsigned mk = selmask;
#pragma unroll 1
            for (int c = 0; c < 8; ++c) {
                int kpos, bs;
                if (br == 0) { const int j = __builtin_ctz(mk | 0x80000000u); mk &= mk - 1; bs = 64 * j; } else { bs = t - 511 + 64 * c; }
                kpos = bs + lane; if (lane == 0) pbase[c] = bs;
                const int dist = t - kpos; const bool vv = (dist >= 0) && (kpos >= 0) && (kpos < S);
                float a[4] = {0.f, 0.f, 0.f, 0.f};
                if (vv) { dot4_row(PROJ + (size_t)(b * S + kpos) * NPAD + ck + g * 64, qs, a); const int bk = rel_bucket(dist);
#pragma unroll
                    for (int r = 0; r < 4; ++r) a[r] += rel[bk * 8 + g * 4 + r]; }
#pragma unroll
                for (int r = 0; r < 4; ++r) ps[r * 512 + c * 64 + lane] = vv ? a[r] : -1e30f;
            }
            lds_wave_sync();
#pragma unroll 1
            for (int r = 0; r < 4; ++r) { float m = -1e30f;
#pragma unroll
                for (int c = 0; c < 8; ++c) m = fmaxf(m, ps[r * 512 + c * 64 + lane]);
                m = wave_max(m); float e[8], sum = 0.f;
#pragma unroll
                for (int c = 0; c < 8; ++c) { const float sv = ps[r * 512 + c * 64 + lane]; e[c] = sv > -1e29f ? __expf(sv - m) : 0.f; sum += e[c]; }
                sum = wave_sum(sum); const float inv = sum > 0.f ? 1.0f / sum : 0.f;
#pragma unroll
                for (int c = 0; c < 8; ++c) ps[r * 512 + c * 64 + lane] = e[c] * inv; }
            lds_wave_sync();
            float o[4] = {0.f, 0.f, 0.f, 0.f};
#pragma unroll 1
            for (int c = 0; c < 8; ++c) {
                const int bsc = pbase[c];
                for (int kk = 0; kk < 64; ++kk) { const int kpos = bsc + kk; if (kpos < 0 || kpos > t) continue;
                    const float v = bf2f(PROJ[(size_t)(b * S + kpos) * NPAD + cv + g * 64 + lane]);
#pragma unroll
                    for (int r = 0; r < 4; ++r) o[r] += ps[r * 512 + c * 64 + kk] * v; } }
            lds_wave_sync();
#pragma unroll
            for (int r = 0; r < 4; ++r) { if (br == 0) oslc[r] = o[r]; else owin[r] = o[r]; }
        }
#pragma unroll
        for (int r = 0; r < 4; ++r) { const int h = g * 4 + r;
            const float g0 = sigmoidf_(bf2f(prow[C_GT + h * 3 + 0])), g1 = sigmoidf_(bf2f(prow[C_GT + h * 3 + 1])), g2 = sigmoidf_(bf2f(prow[C_GT + h * 3 + 2]));
            OATT[(size_t)tok * 512 + h * 64 + lane] = f2bf(g0 * ocmp[r] + g1 * oslc[r] + g2 * owin[r]); }
    }
}


constexpr float LOG2E = 1.4426950408889634f;
constexpr int AT_KC = 0, AT_VC = 16384, AT_KV = 32768  , AT_BTAB = 65536, AT_IMP = 69888, AT_SEL = 78336, AT_OUT = 78592  , AT_END = 78592 + 65536;
constexpr int BT_STRIDE = 132;
__device__ __forceinline__ int tile_off(int row, int chunk) { return row * 128 + ((chunk ^ (row & 7)) << 4); }
__device__ __forceinline__ bf16x8 mk_frag(unsigned a, unsigned b, unsigned c, unsigned d) { u32x4v v = {a, b, c, d}; return __builtin_bit_cast(bf16x8, v); }
struct LaneOffs { int koff[2]; int voff[4]; int soff; };
__device__ __forceinline__ LaneOffs lane_offs(int lane, int tid) {
    LaneOffs L; const int grp = lane >> 4, rowi = lane & 15, q4 = rowi >> 2, p = lane & 3;
#pragma unroll
    for (int ks = 0; ks < 2; ++ks) L.koff[ks] = tile_off(rowi, ks * 4 + grp);
#pragma unroll
    for (int dt = 0; dt < 4; ++dt) L.voff[dt] = tile_off(4 * grp + q4, 2 * dt + (p >> 1)) + 8 * (p & 1);
    L.soff = tile_off(tid >> 3, tid & 7); return L;
}
__device__ __forceinline__ bf16x8 vfrag_read(const LAS unsigned char* vt, int voff_dt, int row0) {
    const s16x4 a = __builtin_amdgcn_ds_read_tr16_b64_v4i16((LAS s16x4*)(vt + voff_dt + row0 * 128));
    const s16x4 b = __builtin_amdgcn_ds_read_tr16_b64_v4i16((LAS s16x4*)(vt + voff_dt + row0 * 128 + 2048));
    bf16x8 f = {a[0], a[1], a[2], a[3], b[0], b[1], b[2], b[3]}; return f;
}


struct AttnState {
    f32x4 o[4][2]; float m[2], l[2];
};

__device__ __forceinline__ void at_qk(f32x4 (&sacc)[4][2], const LAS unsigned char* kt_lds, const bf16x8 (&qf)[2][2], const LaneOffs& Lu) {
    int ln_ = threadIdx.x & 63; asm volatile("" : "+v"(ln_)); const LaneOffs L = lane_offs(ln_, 0); (void)Lu;
#pragma unroll
    for (int kt = 0; kt < 4; ++kt) { sacc[kt][0] = (f32x4){0.f, 0.f, 0.f, 0.f}; sacc[kt][1] = (f32x4){0.f, 0.f, 0.f, 0.f}; }
#pragma unroll
    for (int kt = 0; kt < 4; ++kt)
#pragma unroll
        for (int ks = 0; ks < 2; ++ks) { const bf16x8 kf = *(const LAS bf16x8*)(kt_lds + L.koff[ks] + kt * 2048);
            sacc[kt][0] = __builtin_amdgcn_mfma_f32_16x16x32_bf16(kf, qf[0][ks], sacc[kt][0], 0, 0, 0);
            sacc[kt][1] = __builtin_amdgcn_mfma_f32_16x16x32_bf16(kf, qf[1][ks], sacc[kt][1], 0, 0, 0); }
}
__device__ __forceinline__ void at_pv(AttnState& st, const LAS unsigned char* vt_lds, const bf16x8 (&pf)[2][2], const LaneOffs& Lu) {
    int ln_ = threadIdx.x & 63; asm volatile("" : "+v"(ln_)); const LaneOffs L = lane_offs(ln_, 0); (void)Lu;
#pragma unroll
    for (int ks = 0; ks < 2; ++ks)
#pragma unroll
        for (int dt = 0; dt < 4; ++dt) { const bf16x8 vf = vfrag_read(vt_lds, L.voff[dt], 32 * ks);
            st.o[dt][0] = __builtin_amdgcn_mfma_f32_16x16x32_bf16(vf, pf[0][ks], st.o[dt][0], 0, 0, 0);
            st.o[dt][1] = __builtin_amdgcn_mfma_f32_16x16x32_bf16(vf, pf[1][ks], st.o[dt][1], 0, 0, 0); }
}
template <int BR>
__device__ __forceinline__ void at_softmax(f32x4 (&sacc)[4][2], bf16x8 (&pf)[2][2], const LAS float* btab_h, const int (&tq)[2], const unsigned (&sel)[2], int j, bool near, AttnState& st, int lane) {
    const int grp = lane >> 4, kbase = 64 * j;
    const float SC = 0.125f * LOG2E; const float bfar = btab_h[128];
    const int cur_blk = tq[0] >> 6;
    const bool full = BR == 0 ? (j == cur_blk) : (j == cur_blk || j + 8 == cur_blk);
    const bool fast = !near && !full;
    const bool selq[2] = {BR == 0 ? ((sel[0] >> j) & 1u) != 0u : true, BR == 0 ? ((sel[1] >> j) & 1u) != 0u : true};
    float tmax[2];
    if (fast) {
#pragma unroll
        for (int qt = 0; qt < 2; ++qt) {
            float r0 = fmaxf(fmaxf(sacc[0][qt][0], sacc[0][qt][1]), fmaxf(sacc[0][qt][2], sacc[0][qt][3]));
#pragma unroll
            for (int kt = 1; kt < 4; ++kt) r0 = fmaxf(r0, fmaxf(fmaxf(sacc[kt][qt][0], sacc[kt][qt][1]), fmaxf(sacc[kt][qt][2], sacc[kt][qt][3])));
            tmax[qt] = selq[qt] ? r0 * SC + bfar : -1e30f; }
    } else {
#pragma unroll
        for (int qt = 0; qt < 2; ++qt) {
            float tm = -1e30f;
            int d0 = tq[qt] - 4 * grp - kbase; asm volatile("" : "+v"(d0));
#pragma unroll
            for (int kt = 0; kt < 4; ++kt)
#pragma unroll
                for (int rg = 0; rg < 4; ++rg) { const int c = kt * 16 + rg;
                    float bias = bfar; if (near) { const int dist = d0 - c; const int dd = dist < 0 ? 0 : (dist > 128 ? 128 : dist); bias = btab_h[dd]; }
                    const bool valid = BR == 0 ? (selq[qt] && d0 >= c) : (d0 >= c && d0 < 512 + c);
                    const float sx = sacc[kt][qt][rg] * SC + bias; const float s = valid ? sx : -1e30f; sacc[kt][qt][rg] = s; tm = fmaxf(tm, s); }
            tmax[qt] = tm; }
    }
    { const float a0 = __shfl_xor(tmax[0], 16), a1 = __shfl_xor(tmax[1], 16); tmax[0] = fmaxf(tmax[0], a0); tmax[1] = fmaxf(tmax[1], a1); }
    { const float a0 = __shfl_xor(tmax[0], 32), a1 = __shfl_xor(tmax[1], 32); tmax[0] = fmaxf(tmax[0], a0); tmax[1] = fmaxf(tmax[1], a1); }
    float alpha[2], muse[2];
#pragma unroll
    for (int qt = 0; qt < 2; ++qt) { const float mnew = fmaxf(st.m[qt], tmax[qt]); alpha[qt] = __builtin_amdgcn_exp2f(st.m[qt] - mnew); st.m[qt] = mnew; muse[qt] = mnew < -1e29f ? 0.f : mnew; }
#pragma unroll
    for (int qt = 0; qt < 2; ++qt) { const float mul = fast ? SC : 1.0f; const float add = fast ? (selq[qt] ? bfar - muse[qt] : -1e30f) : -muse[qt];
#pragma unroll
        for (int kt = 0; kt < 4; ++kt)
#pragma unroll
            for (int rg = 0; rg < 4; ++rg) sacc[kt][qt][rg] = __builtin_amdgcn_exp2f(sacc[kt][qt][rg] * mul + add); }
#pragma unroll
    for (int qt = 0; qt < 2; ++qt) {
        float ls = 0.f; unsigned pk[4][2];
#pragma unroll
        for (int kt = 0; kt < 4; ++kt) { ls += (sacc[kt][qt][0] + sacc[kt][qt][1]) + (sacc[kt][qt][2] + sacc[kt][qt][3]);
            pk[kt][0] = pg8::cvt_pk_bf16(sacc[kt][qt][0], sacc[kt][qt][1]); pk[kt][1] = pg8::cvt_pk_bf16(sacc[kt][qt][2], sacc[kt][qt][3]); }
        st.l[qt] = st.l[qt] * alpha[qt] + ls;
        pf[qt][0] = mk_frag(pk[0][0], pk[0][1], pk[1][0], pk[1][1]); pf[qt][1] = mk_frag(pk[2][0], pk[2][1], pk[3][0], pk[3][1]); }
    if (!__all(alpha[0] == 1.0f && alpha[1] == 1.0f)) {
#pragma unroll
        for (int qt = 0; qt < 2; ++qt)
#pragma unroll
            for (int dt = 0; dt < 4; ++dt) st.o[dt][qt] *= alpha[qt]; }
    __builtin_amdgcn_sched_barrier(0);
}
template <int BR>
__device__ __forceinline__ void attn_tile(const LAS unsigned char* kt_lds, const LAS unsigned char* vt_lds, const LAS float* btab_h, const bf16x8 (&qf)[2][2], const int (&tq)[2], const unsigned (&sel)[2],
                                          int j, bool near, AttnState& st, int lane, const LaneOffs& L, LAS unsigned char* F_lds_) {
#if defined(PROBE_STAMP) && PROBE_LEVEL >= 2
    STAMP_DECL; STAMP_START();
#define TSTAMP(k) STAMP(k)
#else
#define TSTAMP(k) do {} while (0)
#endif
    f32x4 sacc[4][2]; bf16x8 pf[2][2];
    at_qk(sacc, kt_lds, qf, L);
    __builtin_amdgcn_sched_barrier(0);
    TSTAMP(0);
#if defined(PROBE_STAMP) && PROBE_LEVEL >= 3
    { float x_ = sacc[3][1][3]; asm volatile("" :: "v"(x_)); }
    TSTAMP(3);
#endif
    at_softmax<BR>(sacc, pf, btab_h, tq, sel, j, near, st, lane);
    TSTAMP(1);
    at_pv(st, vt_lds, pf, L);
    TSTAMP(2);
#undef TSTAMP
}

template <int BR>
__device__ __forceinline__ void attn_branch(const Frame& F, const bf16_t* PROJ, int b, int g, int t0, unsigned tiles  , const LAS float* btab_h,
                                            const bf16x8 (&qf)[2][2], const int (&tq)[2], const unsigned (&sel)[2], const float (&gate)[2], const LaneOffs& L) {
    const int lane = F.lane, tid = F.tid;
    const int ck = (BR == 0 ? C_KS : C_KW) + g * 64, cv = (BR == 0 ? C_VS : C_VW) + g * 64;
    const int srow = tid >> 3, sch = tid & 7;
    LAS unsigned char* F_lds_ = F.lds; STAMP_DECL; STAMP_START();
    AttnState st;
#pragma unroll
    for (int dt = 0; dt < 4; ++dt) { st.o[dt][0] = (f32x4){0.f, 0.f, 0.f, 0.f}; st.o[dt][1] = (f32x4){0.f, 0.f, 0.f, 0.f}; }
    st.m[0] = st.m[1] = -1e30f; st.l[0] = st.l[1] = 0.f;
    unsigned rem = tiles; int cur = 0;
#ifdef PROBE_SHALLOW
    u32x4v rk0, rv0;
#else
    u32x4v rk0, rv0, rk1, rv1;
#endif
    const bf16_t* srcb = PROJ + (size_t)(b * S + srow) * NPAD + sch * 8;
#define AT_LOAD(RK, RV, jj) do { const bf16_t* rowp = srcb + (size_t)(64 * (jj)) * NPAD; RK = *(const u32x4v*)(rowp + ck); RV = *(const u32x4v*)(rowp + cv); } while (0)
#define AT_WRITE(RK, RV, bufi) do { *(LAS u32x4v*)(F.lds + AT_KV + (bufi) * 16384 + L.soff) = RK; *(LAS u32x4v*)(F.lds + AT_KV + (bufi) * 16384 + 8192 + L.soff) = RV; } while (0)
#define AT_COMPUTE(jj) do { STAMP_COUNT(4); const bool near = (t0 + 8 * F.wave) - (64 * (jj) + 63) < 128; \
        attn_tile<BR>(F.lds + AT_KV + cur * 16384, F.lds + AT_KV + cur * 16384 + 8192, btab_h, qf, tq, sel, (jj), near, st, lane, L, F.lds); } while (0)
#ifdef PROBE_SHALLOW
    { int j = __builtin_ctz(rem); rem &= rem - 1;
      AT_LOAD(rk0, rv0, j); AT_WRITE(rk0, rv0, 0);
      __syncthreads();
      for (;;) {
          int jn = j; const bool hn = rem != 0u; if (hn) { jn = __builtin_ctz(rem); rem &= rem - 1; }
          STAMP(12);
          AT_LOAD(rk0, rv0, jn);
          AT_COMPUTE(j);
          STAMP(13);
          AT_WRITE(rk0, rv0, cur ^ 1);
          asm volatile("s_waitcnt lgkmcnt(0)" ::: "memory");
          STAMP(8);
          __syncthreads(); cur ^= 1;
          STAMP(9);
          if (!hn) break;
          j = jn; } }
#else
    int j = __builtin_ctz(rem); rem &= rem - 1;
    AT_LOAD(rk0, rv0, j); AT_WRITE(rk0, rv0, 0);
    int j1 = j; bool h1 = rem != 0u; if (h1) { j1 = __builtin_ctz(rem); rem &= rem - 1; }
    AT_LOAD(rk0, rv0, j1);
    __syncthreads();
    for (;;) {
        int j2 = j1; bool h2 = rem != 0u; if (h2) { j2 = __builtin_ctz(rem); rem &= rem - 1; }
        AT_LOAD(rk1, rv1, j2);
        AT_COMPUTE(j);
        AT_WRITE(rk0, rv0, cur ^ 1);
        __syncthreads(); cur ^= 1;
        if (!h1) break;
        int j3 = j2; bool h3 = rem != 0u; if (h3) { j3 = __builtin_ctz(rem); rem &= rem - 1; }
        AT_LOAD(rk0, rv0, j3);
        AT_COMPUTE(j1);
        AT_WRITE(rk1, rv1, cur ^ 1);
        __syncthreads(); cur ^= 1;
        if (!h2) break;
        j = j2; j1 = j3; h1 = h3;
    }
#endif
    STAMP(5 + BR);
#undef AT_LOAD
#undef AT_WRITE
#undef AT_COMPUTE
    int pob = AT_OUT + tid * 4; asm volatile("" : "+v"(pob));
    LAS float* po = (LAS float*)(F.lds + pob);
#pragma unroll
    for (int qt = 0; qt < 2; ++qt) { float l = st.l[qt]; l += __shfl_xor(l, 16); l += __shfl_xor(l, 32); const float sc = l > 0.f ? gate[qt] / l : 0.f;
#pragma unroll
        for (int dt = 0; dt < 4; ++dt)
#pragma unroll
            for (int e = 0; e < 4; ++e) po[((qt * 4 + dt) * 4 + e) * 512] += st.o[dt][qt][e] * sc; }
}


template <int BR>
__device__ __forceinline__ void attn_branch_stag(const Frame& F, const bf16_t* PROJ, int b, int g, int t0, unsigned tiles, const LAS float* btab_h,
                                                 const bf16x8 (&qf)[2][2], const int (&tq)[2], const unsigned (&sel)[2], int hcol  , const LaneOffs& L) {
    const int lane = F.lane, tid = F.tid;
    const bool isB = F.wave >= 4;
    const int ck = (BR == 0 ? C_KS : C_KW) + g * 64, cv = (BR == 0 ? C_VS : C_VW) + g * 64;
    const int srow = tid >> 3, sch = tid & 7;
    AttnState st;
#pragma unroll
    for (int dt = 0; dt < 4; ++dt) { st.o[dt][0] = (f32x4){0.f, 0.f, 0.f, 0.f}; st.o[dt][1] = (f32x4){0.f, 0.f, 0.f, 0.f}; }
    st.m[0] = st.m[1] = -1e30f; st.l[0] = st.l[1] = 0.f;
    const bf16_t* srcb = PROJ + (size_t)(b * S + srow) * NPAD + sch * 8;
    LAS unsigned char* KB = F.lds + AT_KV;
#define SG_LOADK(R, jj) do { R = *(const u32x4v*)(srcb + (size_t)(64 * (jj)) * NPAD + ck); } while (0)
#define SG_LOADV(R, jj) do { R = *(const u32x4v*)(srcb + (size_t)(64 * (jj)) * NPAD + cv); } while (0)
#define SG_BAR() do { asm volatile("s_waitcnt lgkmcnt(0)" ::: "memory"); __builtin_amdgcn_s_barrier(); asm volatile("" ::: "memory"); } while (0)
    unsigned rem = tiles;
    int j0 = __builtin_ctz(rem); rem &= rem - 1;
    bool h1 = rem != 0u; int j1 = j0; if (h1) { j1 = __builtin_ctz(rem); rem &= rem - 1; }
    bool h2 = rem != 0u; int j2 = j1; if (h2) { j2 = __builtin_ctz(rem); rem &= rem - 1; }
    u32x4v rk, rv;
    { u32x4v a, c2, d2; SG_LOADK(a, j0); SG_LOADV(c2, j0); SG_LOADK(d2, j1);
      *(LAS u32x4v*)(KB + L.soff) = a; *(LAS u32x4v*)(KB + 16384 + L.soff) = c2; *(LAS u32x4v*)(KB + 8192 + L.soff) = d2; }
    SG_LOADK(rk, j2); SG_LOADV(rv, j1);
    SG_BAR();
    f32x4 sacc[4][2]; bf16x8 pf[2][2];
    at_qk(sacc, KB, qf, L);
    if (isB) SG_BAR();
    int i = 0;
    for (;;) {
        { const bool near = (t0 + 8 * F.wave) - (64 * j0 + 63) < 128; at_softmax<BR>(sacc, pf, btab_h, tq, sel, j0, near, st, lane); }
        SG_BAR();
        at_pv(st, KB + 16384 + (i & 1) * 8192, pf, L);
        if (h1) at_qk(sacc, KB + ((i + 1) & 1) * 8192, qf, L);
        *(LAS u32x4v*)(KB + (i & 1) * 8192 + L.soff) = rk; *(LAS u32x4v*)(KB + 16384 + ((i + 1) & 1) * 8192 + L.soff) = rv;
        bool h3 = rem != 0u; int j3 = j2; if (h3) { j3 = __builtin_ctz(rem); rem &= rem - 1; }
        SG_LOADK(rk, j3); SG_LOADV(rv, j2);
        SG_BAR();
        if (!h1) break;
        j0 = j1; j1 = j2; j2 = j3; h1 = h2; h2 = h3; ++i;
    }
    if (!isB) SG_BAR();
#undef SG_LOADK
#undef SG_LOADV
#undef SG_BAR
    int pob = AT_OUT + tid * 4; asm volatile("" : "+v"(pob));
    LAS float* po = (LAS float*)(F.lds + pob);
#pragma unroll
    for (int qt = 0; qt < 2; ++qt) { float l = st.l[qt]; l += __shfl_xor(l, 16); l += __shfl_xor(l, 32);
        const float gq = sigmoidf_(bf2f(PROJ[(size_t)(b * S + tq[qt]) * NPAD + C_GT + hcol * 3 + 1 + BR]));
        const float sc = l > 0.f ? gq / l : 0.f;
#pragma unroll
        for (int dt = 0; dt < 4; ++dt)
#pragma unroll
            for (int e = 0; e < 4; ++e) po[((qt * 4 + dt) * 4 + e) * 512] += st.o[dt][qt][e] * sc; }
}

template <int MODE>
__device__ __forceinline__ void p4_attn_mfma_t(const Frame& F) {
    const bf16_t* PROJ = (const bf16_t*)(F.ws + WS_PROJ); const bf16_t* KC = (const bf16_t*)(F.ws + WS_KC); const bf16_t* VC = (const bf16_t*)(F.ws + WS_VC);
    bf16_t* OATT = (bf16_t*)(F.ws + (MODE == 0 ? WS_OATT : WS_H)); const float* rel = F.in[21];
    const int lane = F.lane, tid = F.tid, wave = F.wave, grp = lane >> 4, col = lane & 15, qi = col >> 2, r = col & 3;
    LAS float* btab = (LAS float*)(F.lds + AT_BTAB); LAS float* impq = (LAS float*)(F.lds + AT_IMP); LAS unsigned* selm = (LAS unsigned*)(F.lds + AT_SEL);
    const LaneOffs L = lane_offs(lane, tid);
    for (int i = tid; i < 8 * 129; i += NTHREADS) { const int hh = i / 129, dd = i % 129; btab[hh * BT_STRIDE + dd] = rel[rel_bucket(dd) * 8 + hh] * LOG2E; }
    __syncthreads();
    LAS unsigned char* F_lds_ = F.lds; STAMP_DECL;
#ifdef PROBE_STAMP
    if (tid < 16) ((volatile LAS unsigned*)(F.lds + LDS_MISC_OFF + 128))[tid] = 0u;
    __syncthreads();
#endif
    STAMP_START();
    for (int uu = blockIdx.x; uu < 1024; uu += F.G) {
        int qb, bg;
        if (F.G == 256) { const int round = uu >> 8, k = uu & 255; const int a = k >> 5; bg = k & 31;
            qb = (a == 0) ? (round == 0 ? 25 : round == 1 ? 23 : round == 2 ? 17 : 0) : (a == 1) ? (round == 0 ? 27 : round == 1 ? 19 : round == 2 ? 18 : 1) : (a == 2) ? (round == 0 ? 31 : round == 1 ? 13 : round == 2 ? 12 : 5)
               : (a == 3) ? (round == 0 ? 26 : round == 1 ? 21 : round == 2 ? 15 : 2) : (a == 4) ? (round == 0 ? 30 : round == 1 ? 22 : round == 2 ? 8 : 3) : (a == 5) ? (round == 0 ? 28 : round == 1 ? 20 : round == 2 ? 9 : 4)
               : (a == 6) ? (round == 0 ? 29 : round == 1 ? 14 : round == 2 ? 10 : 6) : (round == 0 ? 24 : round == 1 ? 16 : round == 2 ? 11 : 7); }
        else { qb = 31 - (uu >> 5); bg = uu & 31; }
        const int b = bg >> 1, g = bg & 1, t0 = qb * 64, h = g * 4 + r;
        const LAS float* btab_h = btab + h * BT_STRIDE;
        int tq[2]; bf16x8 qf[2][2]; float gate[3][2];
#pragma unroll
        for (int qt = 0; qt < 2; ++qt) { tq[qt] = t0 + 8 * wave + 4 * qt + qi; const bf16_t* prow = PROJ + (size_t)(b * S + tq[qt]) * NPAD;
#pragma unroll
            for (int ks = 0; ks < 2; ++ks) qf[qt][ks] = *(const bf16x8*)(prow + C_Q + h * 64 + ks * 32 + 8 * grp);
#pragma unroll
            for (int jg = 0; jg < 3; ++jg) gate[jg][qt] = sigmoidf_(bf2f(prow[C_GT + h * 3 + jg])); }
#pragma unroll
        for (int i = 0; i < 2; ++i) { const int c2 = tid + 512 * i, row = c2 >> 3, ch = c2 & 7; const size_t src = ((size_t)(b * 2 + g) * 128 + row) * 64 + ch * 8;
            *(LAS u32x4v*)(F.lds + AT_KC + L.soff + 8192 * i) = *(const u32x4v*)(KC + src); *(LAS u32x4v*)(F.lds + AT_VC + L.soff + 8192 * i) = *(const u32x4v*)(VC + src); }
        __syncthreads();
#ifndef AT_SKIP_CMP
        {
            const int nvmax = t0 + 63 >= 31 ? ((t0 + 63 - 31) >> 4) + 1 : 0;
            const float SC = 0.125f * LOG2E; const int srcl = (lane + 48) & 63;
            int pob = AT_OUT + tid * 4; asm volatile("" : "+v"(pob));
            LAS float* po = (LAS float*)(F.lds + pob);
#pragma unroll
            for (int qt = 0; qt < 2; ++qt) {
                f32x4 sa[8];
#pragma unroll
                for (int kt = 0; kt < 8; ++kt) sa[kt] = (f32x4){0.f, 0.f, 0.f, 0.f};
#pragma unroll
                for (int kt = 0; kt < 8; ++kt) if (kt * 16 < nvmax) {
#pragma unroll
                    for (int ks = 0; ks < 2; ++ks) { const bf16x8 kf = *(const LAS bf16x8*)(F.lds + AT_KC + L.koff[ks] + kt * 2048);
                        sa[kt] = __builtin_amdgcn_mfma_f32_16x16x32_bf16(kf, qf[qt][ks], sa[kt], 0, 0, 0); } }
                __builtin_amdgcn_sched_barrier(0);
                int d0 = tq[qt] - 31 - 64 * grp; asm volatile("" : "+v"(d0));
                float mx = -1e30f;
#pragma unroll
                for (int kt = 0; kt < 8; ++kt)
#pragma unroll
                    for (int rg = 0; rg < 4; ++rg) { const int c = 256 * kt + 16 * rg; const int dist = d0 - c; const int dd = dist < 0 ? 0 : (dist > 128 ? 128 : dist);
                        const float sx = sa[kt][rg] * SC + btab_h[dd]; const float s = d0 >= c ? sx : -1e30f; sa[kt][rg] = s; mx = fmaxf(mx, s); }
                mx = fmaxf(mx, __shfl_xor(mx, 16)); mx = fmaxf(mx, __shfl_xor(mx, 32));
                float sum = 0.f;
#pragma unroll
                for (int kt = 0; kt < 8; ++kt)
#pragma unroll
                    for (int rg = 0; rg < 4; ++rg) { const int c = 256 * kt + 16 * rg; const float ex = __builtin_amdgcn_exp2f(sa[kt][rg] - mx); const float e = d0 >= c ? ex : 0.f; sa[kt][rg] = e; sum += e; }
                __builtin_amdgcn_sched_barrier(0);
                sum += __shfl_xor(sum, 16); sum += __shfl_xor(sum, 32);
                const float inv = sum > 0.f ? 1.0f / sum : 0.f;
                float prev3 = 0.f;
#pragma unroll
                for (int kt = 0; kt < 8; ++kt) { const float p3 = sa[kt][3] * inv; const float part = (sa[kt][0] * inv + sa[kt][1] * inv) + (sa[kt][2] * inv + p3);
                    const float xa = __shfl(p3, srcl), xb = __shfl(prev3, srcl); float tot = part + (grp >= 1 ? xa : xb);
                    tot += __shfl_xor(tot, 1); tot += __shfl_xor(tot, 2);
                    if (r == 0) impq[(8 * wave + 4 * qt + qi) * 33 + 4 * kt + grp] = tot;
                    prev3 = p3; }
                __builtin_amdgcn_sched_barrier(0);
                f32x4 oc[4];
#pragma unroll
                for (int dt = 0; dt < 4; ++dt) oc[dt] = (f32x4){0.f, 0.f, 0.f, 0.f};
#pragma unroll
                for (int ks = 0; ks < 4; ++ks) if (ks * 32 < nvmax) {
                    const bf16x8 pfr = mk_frag(pg8::cvt_pk_bf16(sa[2 * ks][0], sa[2 * ks][1]), pg8::cvt_pk_bf16(sa[2 * ks][2], sa[2 * ks][3]),
                                               pg8::cvt_pk_bf16(sa[2 * ks + 1][0], sa[2 * ks + 1][1]), pg8::cvt_pk_bf16(sa[2 * ks + 1][2], sa[2 * ks + 1][3]));
#pragma unroll
                    for (int dt = 0; dt < 4; ++dt) { const bf16x8 vf = vfrag_read(F.lds + AT_VC, L.voff[dt], 32 * ks); oc[dt] = __builtin_amdgcn_mfma_f32_16x16x32_bf16(vf, pfr, oc[dt], 0, 0, 0); } }
                const float scq = inv * gate[0][qt];
#pragma unroll
                for (int dt = 0; dt < 4; ++dt)
#pragma unroll
                    for (int e = 0; e < 4; ++e) po[((qt * 4 + dt) * 4 + e) * 512] = oc[dt][e] * scq;
                __builtin_amdgcn_sched_barrier(0);
            }
        }
#endif
        __syncthreads();
#ifndef AT_SKIP_SEL
        {
            const int q = tid >> 3, jj = tid & 7, cur = qb; unsigned bits = 0u;
            float vj[4];
#pragma unroll
            for (int e = 0; e < 4; ++e) { const int j = jj * 4 + e; const bool forced = (j == 0) || (j == cur) || (j == cur - 1); vj[e] = forced ? 1e4f : (j <= cur ? impq[q * 33 + j] : -INFINITY); }
            int rk[4] = {0, 0, 0, 0};
            for (int jp = 0; jp < 32; ++jp) { const bool forced = (jp == 0) || (jp == cur) || (jp == cur - 1); const float vp = forced ? 1e4f : (jp <= cur ? impq[q * 33 + jp] : -INFINITY);
#pragma unroll
                for (int e = 0; e < 4; ++e) rk[e] += ((vp > vj[e]) || (vp == vj[e] && jp < jj * 4 + e)) ? 1 : 0; }
#pragma unroll
            for (int e = 0; e < 4; ++e) bits |= (rk[e] < 8 ? 1u : 0u) << (jj * 4 + e);
            bits |= __shfl_xor(bits, 1); bits |= __shfl_xor(bits, 2); bits |= __shfl_xor(bits, 4);
            if (jj == 0) selm[q] = bits;
        }
#endif
        __syncthreads();
        unsigned sel[2] = {selm[8 * wave + qi], selm[8 * wave + 4 + qi]};
        unsigned un = selm[lane];
#pragma unroll
        for (int o = 32; o >= 1; o >>= 1) un |= __shfl_xor(un, o);
        un = __builtin_amdgcn_readfirstlane(un);
        const unsigned causal = qb == 31 ? 0xFFFFFFFFu : ((2u << qb) - 1u);
        if (MODE != 1 && MODE != 2) { const float gt1[2] = {gate[1][0], gate[1][1]};
#ifndef ATTN_STAGGER
            attn_branch<0>(F, PROJ, b, g, t0, un & causal, btab_h, qf, tq, sel, gt1, L);
#else
            attn_branch_stag<0>(F, PROJ, b, g, t0, un & causal, btab_h, qf, tq, sel, h, L);
#endif
        }
        if (MODE != 2) { const int jlo = qb >= 8 ? qb - 8 : 0; const unsigned wmask = causal & ~((1u << jlo) - 1u); const float gt2[2] = {gate[2][0], gate[2][1]};

#ifndef ATTN_STAGGER
            attn_branch<1>(F, PROJ, b, g, t0, wmask, btab_h, qf, tq, sel, gt2, L);
#else
            attn_branch_stag<1>(F, PROJ, b, g, t0, wmask, btab_h, qf, tq, sel, h, L);
#endif
        }
        int pob2 = AT_OUT + tid * 4; asm volatile("" : "+v"(pob2));
#pragma unroll
        for (int qt = 0; qt < 2; ++qt) { bf16_t* orow = OATT + (size_t)(b * S + tq[qt]) * 512 + h * 64 + 4 * grp;
#pragma unroll
            for (int dt = 0; dt < 4; ++dt) { const LAS float* po = (const LAS float*)(F.lds + pob2) + (qt * 4 + dt) * 4 * 512;
                *(uint2*)(orow + dt * 16) = make_uint2(pg8::cvt_pk_bf16(po[0], po[512]), pg8::cvt_pk_bf16(po[1024], po[1536])); } }
    }
    STAMP(7);
#ifdef PROBE_STAMP
    __syncthreads();
    if (PROBE_PHASE == 4 && MODE == 0 && blockIdx.x == PROBE_BLOCK && tid < 16) ((unsigned*)(F.ws + WS_CTL + 32768))[tid] = ((volatile LAS unsigned*)(F.lds + LDS_MISC_OFF + 128))[tid];
#endif
}

__device__ __forceinline__ void p5_mixed(const Frame& F) {
    const bf16_t* PROJ = (const bf16_t*)(F.ws + WS_PROJ); const bf16_t* OATT = (const bf16_t*)(F.ws + WS_OATT); bf16_t* MIX = (bf16_t*)(F.ws + WS_H);
    const float* cw = F.in[13]; const float* ga = F.in[14]; const float* gc = F.in[15];
    const int gw = blockIdx.x * NWAVES + F.wave, nw = F.G * NWAVES, lane = F.lane, c0 = lane * 8;
    float w0[8], w1[8], w2[8], gav[8], gcv[8];
#pragma unroll
    for (int e = 0; e < 8; ++e) { w0[e] = cw[c0 + e]; w1[e] = cw[512 + c0 + e]; w2[e] = cw[1024 + c0 + e]; gav[e] = ga[c0 + e]; gcv[e] = gc[c0 + e]; }
    for (int chunk = gw; chunk < T / 16; chunk += nw) {
        const int t0 = chunk * 16, s0 = t0 % S;
        float z1[8], z2[8];
#pragma unroll
        for (int e = 0; e < 8; ++e) { z1[e] = 0.f; z2[e] = 0.f; }
        if (s0 > 0) {
#pragma unroll
            for (int back = 1; back <= 2; ++back) { const bf16_t* row = PROJ + (size_t)(t0 - back) * NPAD;
                const u32x4v wc = *(const u32x4v*)(row + C_CC + c0), wh = *(const u32x4v*)(row + C_CH + c0);
#pragma unroll
                for (int e = 0; e < 4; ++e) { const float a = bflo(wc[e]) * bflo(wh[e]), bq = bfhi(wc[e]) * bfhi(wh[e]); if (back == 1) { z1[2 * e] = a; z1[2 * e + 1] = bq; } else { z2[2 * e] = a; z2[2 * e + 1] = bq; } } } }
        u32x4v na, nc, nh, nb;
        { const bf16_t* row = PROJ + (size_t)t0 * NPAD; na = *(const u32x4v*)(OATT + (size_t)t0 * 512 + c0); nc = *(const u32x4v*)(row + C_CC + c0); nh = *(const u32x4v*)(row + C_CH + c0); nb = *(const u32x4v*)(row + C_CB + c0); }
#pragma unroll 1
        for (int i = 0; i < 16; ++i) { const int tok = t0 + i;
            const u32x4v wa = na, wc = nc, wh = nh, wb = nb;
            { const int tn = i < 15 ? tok + 1 : tok; const bf16_t* row = PROJ + (size_t)tn * NPAD;
                na = *(const u32x4v*)(OATT + (size_t)tn * 512 + c0); nc = *(const u32x4v*)(row + C_CC + c0); nh = *(const u32x4v*)(row + C_CH + c0); nb = *(const u32x4v*)(row + C_CB + c0); }
            float a[8], y[8], z0[8];
#pragma unroll
            for (int e = 0; e < 4; ++e) { a[2 * e] = bflo(wa[e]); a[2 * e + 1] = bfhi(wa[e]); z0[2 * e] = bflo(wc[e]) * bflo(wh[e]); z0[2 * e + 1] = bfhi(wc[e]) * bfhi(wh[e]); }
#pragma unroll
            for (int e = 0; e < 8; ++e) y[e] = w0[e] * z2[e] + w1[e] * z1[e] + w2[e] * z0[e];
#pragma unroll
            for (int e = 0; e < 4; ++e) { y[2 * e] *= bflo(wb[e]); y[2 * e + 1] *= bfhi(wb[e]); }
            float sa = 0.f, sy = 0.f;
#pragma unroll
            for (int e = 0; e < 8; ++e) { sa += a[e] * a[e]; sy += y[e] * y[e]; }
            sa = wave_sum(sa); sy = wave_sum(sy);
            const float ra = rsqrtf(sa * (1.0f / 512) + EPS), ry = rsqrtf(sy * (1.0f / 512) + EPS);
            unsigned oa[4], oy[4];
#pragma unroll
            for (int e = 0; e < 4; ++e) { oa[e] = pack2(a[2 * e] * ra * gav[2 * e], a[2 * e + 1] * ra * gav[2 * e + 1]); oy[e] = pack2(y[2 * e] * ry * gcv[2 * e], y[2 * e + 1] * ry * gcv[2 * e + 1]); }
            *(uint4*)(MIX + (size_t)tok * D + c0) = make_uint4(oa[0], oa[1], oa[2], oa[3]);
            *(uint4*)(MIX + (size_t)tok * D + 512 + c0) = make_uint4(oy[0], oy[1], oy[2], oy[3]);
#pragma unroll
            for (int e = 0; e < 8; ++e) { z2[e] = z1[e]; z1[e] = z0[e]; }
        }
    }
}

struct EpiResGate {
    static constexpr bool PERM = false, AFTER_DRAIN = false;
    float* C; const float* X; const float* MOD; int gate_off;
    __device__ __forceinline__ void operator()(const pg8::f32x4 (&acc)[2][2][4][2], const pg8::Unit& u, int wr, int wc, int fr, int fq) const {
        using pg8::f32x4; using pg8::HALF; using pg8::BM;
        const int row0 = u.pm * BM + wr * 64 + fr, col0 = u.pn * BM + wc * 32 + 4 * fq;
        const int b = (u.pm * BM) / S;
        f32x4 gv[2][2];
#pragma unroll
        for (int bj = 0; bj < 2; ++bj)
#pragma unroll
            for (int n = 0; n < 2; ++n) gv[bj][n] = *(const f32x4*)(MOD + b * 6144 + gate_off + col0 + bj * HALF + n * 16);
#pragma unroll
        for (int ai = 0; ai < 2; ++ai)
#pragma unroll
            for (int m = 0; m < 4; ++m) { const size_t ro = (size_t)(row0 + ai * HALF + m * 16) * D + col0;
#pragma unroll
                for (int bj = 0; bj < 2; ++bj)
#pragma unroll
                    for (int n = 0; n < 2; ++n) { const f32x4 xv = *(const f32x4*)(X + ro + bj * HALF + n * 16); *(f32x4*)(C + ro + bj * HALF + n * 16) = xv + gv[bj][n] * acc[ai][bj][m][n]; } }
    }
};

__device__ __forceinline__ int ord_i(float f) { const int u = __float_as_int(f); return u >= 0 ? u : (u ^ 0x7FFFFFFF); }
__device__ __forceinline__ float unord_f(int i) { const int u = i >= 0 ? i : (i ^ 0x7FFFFFFF); return __int_as_float(u); }
#define INT_MIN_ (-2147483647 - 1)
struct CandTab { int a[50], b[50]; };
constexpr CandTab make_cand() { CandTab t{}; int n = 0; for (int a = 0; a < 16; ++a) for (int b = 0; b < 16; ++b) if ((a + 1) * (b + 1) <= 16) { t.a[n] = a; t.b[n] = b; ++n; } return t; }
constexpr CandTab CAND = make_cand();

template <int N, bool DESC> __device__ __forceinline__ void bitonic_sort_i(int (&v)[N]) {
#pragma unroll
    for (int k = 2; k <= N; k <<= 1)
#pragma unroll
        for (int j = k >> 1; j > 0; j >>= 1)
#pragma unroll
            for (int i = 0; i < N; ++i) { const int l = i ^ j; if (l > i) { const bool up = ((i & k) == 0) != DESC; const int lo = min(v[i], v[l]), hi = max(v[i], v[l]); v[i] = up ? lo : hi; v[l] = up ? hi : lo; } }
}
struct Net16 { int a[60], b[60]; };
constexpr Net16 NET16 = {{0,1,2,3,4,5,7,9,0,1,2,3,6,8,10,11,0,2,4,6,7,10,12,14,0,1,4,5,6,8,12,13,1,3,4,5,8,9,13,1,2,5,7,9,11,2,3,9,11,3,6,7,10,3,5,7,9,11,6,8}, {13,12,15,14,8,6,11,10,5,7,9,4,13,14,15,12,1,3,5,8,9,11,13,15,2,3,10,11,7,9,14,15,2,12,6,7,10,11,14,4,6,8,10,13,14,4,6,12,13,5,8,9,12,4,6,8,10,12,7,9}};
template <bool DESC> __device__ __forceinline__ void sort16_net(int (&v)[16]) {
#pragma unroll
    for (int c = 0; c < 60; ++c) { const int lo = min(v[NET16.a[c]], v[NET16.b[c]]), hi = max(v[NET16.a[c]], v[NET16.b[c]]); v[NET16.a[c]] = DESC ? hi : lo; v[NET16.b[c]] = DESC ? lo : hi; }
}
template <int N, bool DESC> __device__ __forceinline__ void bitonic_merge_i(int (&v)[N]) {
#pragma unroll
    for (int j = N >> 1; j > 0; j >>= 1)
#pragma unroll
        for (int i = 0; i < N; ++i) { const int l = i ^ j; if (l > i) { const int lo = min(v[i], v[l]), hi = max(v[i], v[l]); v[i] = DESC ? hi : lo; v[l] = DESC ? lo : hi; } }
}
__device__ __forceinline__ void merge_top16_across(int (&t)[16]) {
#pragma unroll
    for (int m = 16; m <= 32; m <<= 1) { int y[16];
#pragma unroll
        for (int i = 0; i < 16; ++i) y[i] = max(t[i], __shfl_xor(t[15 - i], m));
        bitonic_merge_i<16, true>(y);
#pragma unroll
        for (int i = 0; i < 16; ++i) t[i] = y[i]; }
}
constexpr int RT2_KEYS = 0  , RT2_ITAB = 65536  ;
__device__ __forceinline__ void p9_route_sort(const Frame& F) {
    const bf16_t* QP = (const bf16_t*)(F.ws + WS_QP); const bf16_t* KEYS = (const bf16_t*)(F.ws + WS_KEYS);
    unsigned short* E16 = (unsigned short*)(F.ws + WS_E16); float* EW = (float*)(F.ws + WS_EW);
    const int lane = F.lane, tid = F.tid, grp = lane >> 4, col = lane & 15;
    const LaneOffs L = lane_offs(lane, tid);
    LAS int* itab = (LAS int*)(F.lds + RT2_ITAB + F.wave * 2048) + col * 32;
    const bool g1 = grp == 1, g2 = grp == 2, g3 = grp == 3;
    for (int tile = blockIdx.x * NWAVES + F.wave; tile < T / 16; tile += F.G * NWAVES) {
        const int tok = tile * 16 + col;
        {
#pragma unroll
            for (int i = 0; i < 4; ++i) { const int q = tid + 512 * i; *(LAS u32x4v*)(F.lds + RT2_KEYS + tile_off(q >> 3, q & 7)) = *(const u32x4v*)(KEYS + (size_t)q * 8); } }
        bf16x8 qf[2][2];
#pragma unroll
        for (int p = 0; p < 2; ++p)
#pragma unroll
            for (int ks = 0; ks < 2; ++ks) qf[p][ks] = *(const bf16x8*)(QP + (size_t)tok * D + p * 64 + ks * 32 + 8 * grp);
        __syncthreads();
#pragma unroll 1
        for (int h = 0; h < 8; ++h) {
            const int kb = RT2_KEYS + (h & 1) * 32768;
            u32x4v stg[4]; bf16x8 qn[2][2];
            if (h < 7) {
#pragma unroll
                for (int i = 0; i < 4; ++i) { const int q = tid + 512 * i; stg[i] = *(const u32x4v*)(KEYS + (size_t)(h + 1) * 16384 + (size_t)q * 8); }
#pragma unroll
                for (int p = 0; p < 2; ++p)
#pragma unroll
                    for (int ks = 0; ks < 2; ++ks) qn[p][ks] = *(const bf16x8*)(QP + (size_t)tok * D + (h + 1) * 128 + p * 64 + ks * 32 + 8 * grp);
            }
            int lst[2][16];
#pragma unroll
            for (int p = 0; p < 2; ++p) {
                f32x4 sc[8];
#pragma unroll
                for (int kt = 0; kt < 8; ++kt) { sc[kt] = (f32x4){0.f, 0.f, 0.f, 0.f};
#pragma unroll
                    for (int ks = 0; ks < 2; ++ks) { const bf16x8 kf = *(const LAS bf16x8*)(F.lds + kb + p * 16384 + L.koff[ks] + kt * 2048);
                        sc[kt] = __builtin_amdgcn_mfma_f32_16x16x32_bf16(kf, qf[p][ks], sc[kt], 0, 0, 0); } }
                int ra[16], rb[16];
#pragma unroll
                for (int kt = 0; kt < 4; ++kt)
#pragma unroll
                    for (int rg = 0; rg < 4; ++rg) { ra[kt * 4 + rg] = (ord_i(sc[kt][rg]) & ~0x7F) | (127 - (kt * 16 + 4 * grp + rg)); rb[kt * 4 + rg] = (ord_i(sc[kt + 4][rg]) & ~0x7F) | (127 - ((kt + 4) * 16 + 4 * grp + rg)); }
                sort16_net<true>(ra); sort16_net<false>(rb);
#pragma unroll
                for (int i = 0; i < 16; ++i) ra[i] = max(ra[i], rb[i]);
                bitonic_merge_i<16, true>(ra);
                merge_top16_across(ra);
#pragma unroll
                for (int i = 0; i < 16; ++i) lst[p][i] = ra[i];
                if (grp == 0) {
#pragma unroll
                    for (int it = 0; it < 16; ++it) itab[p * 16 + it] = 127 - (ra[it] & 0x7F);
                }
            }
            float v0[16], v1[16];
#pragma unroll
            for (int i = 0; i < 16; ++i) { v0[i] = unord_f(lst[0][i] & ~0x7F); v1[i] = unord_f(lst[1][i] & ~0x7F); }
            int ck[16];
#pragma unroll
            for (int i = 0; i < 13; ++i) {
                constexpr int NC = 50;
                const int k0 = 4 * i, k1 = 4 * i + 1 < NC ? 4 * i + 1 : NC - 1, k2 = 4 * i + 2 < NC ? 4 * i + 2 : NC - 1, k3 = 4 * i + 3 < NC ? 4 * i + 3 : NC - 1;
                float va = v0[CAND.a[k0]], vb = v1[CAND.b[k0]]; int fl = 255 - (CAND.a[k0] * 16 + CAND.b[k0]);
                va = g1 ? v0[CAND.a[k1]] : va; vb = g1 ? v1[CAND.b[k1]] : vb; fl = g1 ? 255 - (CAND.a[k1] * 16 + CAND.b[k1]) : fl;
                va = g2 ? v0[CAND.a[k2]] : va; vb = g2 ? v1[CAND.b[k2]] : vb; fl = g2 ? 255 - (CAND.a[k2] * 16 + CAND.b[k2]) : fl;
                va = g3 ? v0[CAND.a[k3]] : va; vb = g3 ? v1[CAND.b[k3]] : vb; fl = g3 ? 255 - (CAND.a[k3] * 16 + CAND.b[k3]) : fl;
                int key = (ord_i(va + vb) & ~0xFF) | fl;
                if (4 * i + 1 >= NC) key = g1 ? INT_MIN_ : key;
                if (4 * i + 2 >= NC) key = g2 ? INT_MIN_ : key;
                if (4 * i + 3 >= NC) key = g3 ? INT_MIN_ : key;
                ck[i] = key; }
            ck[13] = INT_MIN_; ck[14] = INT_MIN_; ck[15] = INT_MIN_;
            sort16_net<true>(ck);
            merge_top16_across(ck);
            lds_wave_sync();
            const float smax = unord_f(ck[0] & ~0xFF);
            float ex[16], sum = 0.f;
#pragma unroll
            for (int it = 0; it < 16; ++it) { ex[it] = __expf(unord_f(ck[it] & ~0xFF) - smax); sum += ex[it]; }
            const float inv = 1.0f / sum;
            if (grp == 0) {
#pragma unroll
                for (int it = 0; it < 16; ++it) { const int flat = 255 - (ck[it] & 0xFF); const int i1 = itab[flat >> 4], i2 = itab[16 + (flat & 15)];
                    E16[(size_t)tok * 128 + h * 16 + it] = (unsigned short)(i1 * 128 + i2); EW[(size_t)tok * 128 + h * 16 + it] = ex[it] * inv; }
            }
            lds_wave_sync();
            if (h < 7) {
                const int kn = RT2_KEYS + ((h + 1) & 1) * 32768;
#pragma unroll
                for (int i = 0; i < 4; ++i) { const int q = tid + 512 * i; *(LAS u32x4v*)(F.lds + kn + tile_off(q >> 3, q & 7)) = stg[i]; }
#pragma unroll
                for (int p = 0; p < 2; ++p)
#pragma unroll
                    for (int ks = 0; ks < 2; ++ks) qf[p][ks] = qn[p][ks];
            }
            __syncthreads();
        }
    }
}

constexpr int N_PHASES = 14;
struct Args { const float* in[23]; float* out; unsigned char* ws; int ph_lo, ph_hi; };
__global__ void __launch_bounds__(NTHREADS, 2) fwd(Args args) {
    extern __shared__ __attribute__((aligned(16))) unsigned char lds_raw[];
    Frame F;
#pragma unroll
    for (int i = 0; i < 23; ++i) F.in[i] = args.in[i];
    F.out = args.out; F.ws = args.ws; F.lds = (LAS unsigned char*)lds_raw;
    F.tid = threadIdx.x; F.lane = F.tid & 63; F.wave = __builtin_amdgcn_readfirstlane(F.tid >> 6); F.G = gridDim.x;
    volatile LAS unsigned* misc = (volatile LAS unsigned*)(F.lds + LDS_MISC_OFF);
    if (F.tid < 64) misc[F.tid] = 0u;
    __syncthreads();
    XcdBarrier bar; bar.bar = (unsigned*)(F.ws + WS_CTL); bar.x = 0; bar.st = misc;
    const int lo = args.ph_lo, hi = args.ph_hi;
    if (hi - lo > 1) bar = xcd_barrier_post((unsigned*)(F.ws + WS_CTL), misc);
#ifndef PH_MASK
#define PH_MASK 0xFFFF
#endif
#define IN(k) (((PH_MASK >> (k)) & 1) && lo <= (k) && (k) < hi)
#define SEAM(k) do { if (IN(k) && IN((k) + 1)) xcd_barrier(bar); } while (0)
    const float* MOD = (const float*)(F.ws + WS_MOD);
    if (IN(0)) { p0_prologue(F, 0, 96); } SEAM(0);
    if (IN(1)) { p0_prologue(F, 96, 1 << 30); norm_mod_rows(F, F.in[0], F.in[2], 0, 1024, (bf16_t*)(F.ws + WS_H)); } SEAM(1);
    if (IN(2)) { pg8::Gemm g{(const pg8::bf16_t*)(F.ws + WS_H), (const pg8::bf16_t*)(F.ws + WS_WIN), T, NPAD, D}; pg8::StaticOrder So; So.init(T, NPAD, F.G, (int)blockIdx.x);
        pg8::EpiBf16<0> E{(pg8::bf16_t*)(F.ws + WS_PROJ), NPAD, nullptr, 0, 0};
        pg8::gemm_phase<pg8::EpiBf16<0>, pg8::StaticOrder>(F.lds, g, So, E, nullptr); } SEAM(2);
#ifdef COMPRESS_NAIVE
    if (IN(3)) { p3_compress_naive(F); } SEAM(3);
#else
    if (IN(3)) { p3_compress_mfma(F); } SEAM(3);
#endif
    #ifdef ATTN_NAIVE
    if (IN(4)) { p4_attn_naive(F); } SEAM(4);
#else
    if (IN(4)) { p4_attn_mfma_t<0>(F); } SEAM(4);
#ifdef PROBE_ATTN_MODE
    if (IN(14)) { p4_attn_mfma_t<PROBE_ATTN_MODE>(F); }
#endif
#ifdef PROBE_P0_LO
    if (IN(14)) { p0_prologue(F, PROBE_P0_LO, PROBE_P0_HI); }
#endif
#endif
    if (IN(5)) { p5_mixed(F); } SEAM(5);
    if (IN(6)) { pg8::Gemm g{(const pg8::bf16_t*)(F.ws + WS_H), (const pg8::bf16_t*)(F.ws + WS_WOUT), T, D, D}; pg8::StaticOrder So; So.init(T, D, F.G, (int)blockIdx.x);
        pg8::EpiBf16<0> E{(pg8::bf16_t*)(F.ws + WS_Y), D, nullptr, 0, 0};
        pg8::gemm_phase<pg8::EpiBf16<0>, pg8::StaticOrder>(F.lds, g, So, E, nullptr); } SEAM(6);
    if (IN(7)) { norm_mod_rows_q(F, F.in[0], F.in[3], 3072, 4096, (bf16_t*)(F.ws + WS_H)); } SEAM(7);
    if (IN(8)) { pg8::Gemm g{(const pg8::bf16_t*)(F.ws + WS_H), (const pg8::bf16_t*)(F.ws + WS_WQ), T, D, D}; pg8::StaticOrder So; So.init(T, D, F.G, (int)blockIdx.x);
        pg8::EpiBf16<0> E{(pg8::bf16_t*)(F.ws + WS_QP), D, nullptr, 0, 0};
        pg8::gemm_phase<pg8::EpiBf16<0>, pg8::StaticOrder>(F.lds, g, So, E, nullptr); } SEAM(8);
        if (IN(9)) { p9_route_sort(F); } SEAM(9);
    if (IN(10)) { p10a_udots(F); } SEAM(10);
    if (IN(11)) { p10b_coef(F); } SEAM(11);
    if (IN(12)) { p10c_vsum(F); } SEAM(12);
    if (IN(13)) { p10d_final(F); }
#undef IN
#undef SEAM
}

extern "C" void kernel_launch(void* const* d_in, const int* in_sizes, int n_in, void* d_out, int out_size, void* d_ws, size_t ws_size, hipStream_t stream) {
    static int grid = 0;
    if (grid == 0) {
        if (n_in != 23 || out_size != T * D || ws_size < WS_END) { fprintf(stderr, "kernel_launch: unexpected shapes: n_in %d out %d ws %zu (need %zu)\n", n_in, out_size, ws_size, (size_t)WS_END); grid = -1; return; }
        int dev = 0, cus = 0, per_cu = 0;
        if (hipGetDevice(&dev) != hipSuccess || hipDeviceGetAttribute(&cus, hipDeviceAttributeMultiprocessorCount, dev) != hipSuccess) { grid = -1; return; }
        if (hipFuncSetAttribute((const void*)fwd, hipFuncAttributeMaxDynamicSharedMemorySize, LDS_BYTES) != hipSuccess) { fprintf(stderr, "kernel_launch: hipFuncSetAttribute failed\n"); grid = -1; return; }
        if (hipOccupancyMaxActiveBlocksPerMultiprocessor(&per_cu, (const void*)fwd, NTHREADS, LDS_BYTES) != hipSuccess || per_cu < 1) { fprintf(stderr, "kernel_launch: occupancy query says %d\n", per_cu); (void)hipGetLastError(); per_cu = 1; }
        grid = cus;
    }
    if (grid < 0) return;
    (void)hipMemsetAsync((char*)d_ws + WS_CTL, 0, CTL_BYTES, stream);
    Args a{};
    for (int i = 0; i < 23; ++i) a.in[i] = (const float*)d_in[i];
    a.out = (float*)d_out; a.ws = (unsigned char*)d_ws;
#if MK_N_LAUNCHES == 1
    a.ph_lo = 0; a.ph_hi = N_PHASES;
    hipLaunchKernelGGL(fwd, dim3(grid), dim3(NTHREADS), LDS_BYTES, stream, a);
#else
#ifdef PROBE_LIST
    { const int plist[] = PROBE_LIST; for (int p : plist) { if (p < 0) { (void)hipMemsetAsync((char*)d_ws + WS_CTL, 0, CTL_BYTES, stream); continue; } a.ph_lo = p; a.ph_hi = p + 1; hipLaunchKernelGGL(fwd, dim3(grid), dim3(NTHREADS), LDS_BYTES, stream, a); } }
#else
    for (int p = 0; p < N_PHASES; ++p) { a.ph_lo = p; a.ph_hi = p + 1; hipLaunchKernelGGL(fwd, dim3(grid), dim3(NTHREADS), LDS_BYTES, stream, a); }
#endif
#endif
}
```

```cpp
#include <hip/hip_runtime.h>
#include <cstdio>
#include <cstdint>
#include <cstdlib>

#ifndef MK_N_LAUNCHES
#define MK_N_LAUNCHES 1
#endif
#define XB_TMO      128
#define XB_XCNT(j)  (256  + 64 * (j))
#define XB_XSUB(j)  (1280 + 64 * (j))
#define XB_XGEN(j)  (2304 + 64 * (j))
#define XB_TOP      3328
#define XB_TOPGEN   3392
#define XCD_BAR_WORDS 3456
#define XB_SPIN_CAP (1u << 18)
#define LAS __attribute__((address_space(3)))

__device__ __forceinline__ unsigned xb_ld(unsigned* p)              { return __hip_atomic_load(p, __ATOMIC_RELAXED, __HIP_MEMORY_SCOPE_AGENT); }
__device__ __forceinline__ unsigned xb_add(unsigned* p, unsigned v) { return __hip_atomic_fetch_add(p, v, __ATOMIC_RELAXED, __HIP_MEMORY_SCOPE_AGENT); }
__device__ __forceinline__ unsigned xb_xcc_id() { return (unsigned)__builtin_amdgcn_s_getreg((3 << 11) | 20) & 0xFu; }
#define XB_SPIN(cond, bar) do { unsigned _sp = 0; while (cond) { __builtin_amdgcn_s_sleep(1); \
    if ((++_sp & 255u) == 0u) { if (xb_ld(&(bar)[XB_TMO])) break; if (_sp > XB_SPIN_CAP) { atomicAdd(&(bar)[XB_TMO], 1u); break; } } } } while (0)

struct XcdBarrier {
    unsigned* bar; unsigned x;
    volatile LAS unsigned* st;
};

__device__ __forceinline__ XcdBarrier xcd_barrier_post(unsigned* bar, volatile LAS unsigned* st) {
    XcdBarrier b; b.bar = bar; b.x = xb_xcc_id(); b.st = st;
    if (threadIdx.x == 0) (void)xb_add(&bar[XB_XCNT(b.x)], 1u);
    return b;
}
__device__ __forceinline__ void xcd_barrier_complete(unsigned* bar, unsigned x, unsigned& nloc, unsigned& nx) {
    const unsigned G = gridDim.x * gridDim.y * gridDim.z;
    unsigned sum, cnt, mine, sp = 0u;
    for (;;) {
        sum = 0u; cnt = 0u; mine = 0u;
#pragma unroll
        for (unsigned j = 0; j < 16; ++j) { const unsigned c = xb_ld(&bar[XB_XCNT(j)]); sum += c; cnt += (c > 0u) ? 1u : 0u; mine = (j == x) ? c : mine; }
        if (sum == G) break;
        __builtin_amdgcn_s_sleep(1);
        if ((++sp & 255u) == 0u) { if (xb_ld(&bar[XB_TMO])) break; if (sp > XB_SPIN_CAP) { atomicAdd(&bar[XB_TMO], 1u); break; } }
    }
    nloc = mine > 0u ? mine : 1u; nx = cnt > 0u ? cnt : 1u;
}

__device__ __forceinline__ void xcd_barrier(const XcdBarrier& b) {
    asm volatile("s_waitcnt vmcnt(0)" ::: "memory");
    __syncthreads();
    if (threadIdx.x == 0) {
        unsigned* bar = b.bar;
        __builtin_amdgcn_s_waitcnt(0);
        unsigned nloc = b.st[0], nx = b.st[1];
        if (nloc == 0u) { xcd_barrier_complete(bar, b.x, nloc, nx); b.st[0] = nloc; b.st[1] = nx; }
        const unsigned old = xb_add(&bar[XB_XSUB(b.x)], 1u);
        const unsigned gen = old / nloc;
        if (old + 1u == (gen + 1u) * nloc) {
            __builtin_amdgcn_fence(__ATOMIC_RELEASE, "agent");
            asm volatile("s_waitcnt vmcnt(0)" ::: "memory");
            const unsigned og = xb_add(&bar[XB_TOP], 1u);
            const unsigned tg = og / nx;
            if (og + 1u == (tg + 1u) * nx) xb_add(&bar[XB_TOPGEN], 1u);
            else XB_SPIN(xb_ld(&bar[XB_TOPGEN]) == tg, bar);
            __builtin_amdgcn_fence(__ATOMIC_ACQUIRE, "agent");
            xb_add(&bar[XB_XGEN(b.x)], 1u);
            asm volatile("s_waitcnt vmcnt(0)" ::: "memory");
        } else {
            XB_SPIN(xb_ld(&bar[XB_XGEN(b.x)]) == gen, bar);
            __builtin_amdgcn_fence(__ATOMIC_ACQUIRE, "agent");
            asm volatile("s_waitcnt vmcnt(0)" ::: "memory");
        }
    }
    __syncthreads();
}

namespace pg8 {
#define PG8_LAS __attribute__((address_space(3)))
typedef unsigned short bf16_t;
typedef short bf16x8 __attribute__((ext_vector_type(8)));
typedef float f32x4 __attribute__((ext_vector_type(4)));
typedef unsigned u32x4 __attribute__((ext_vector_type(4)));
constexpr int BM = 256, BK = 64, HALF = 128, HTB = HALF * BK * 2  , STAGE_BYTES = 8 * HTB, NXCD = 8, WGM = 8;

__host__ __device__ __forceinline__ int lds_byte(int r, int c) { const int st = (r >> 4) * 2 + (c >> 5), rr = r & 15, cc = c & 31, ob = rr * 64 + cc * 2; return st * 1024 + (ob ^ (((ob >> 9) & 1) << 5)); }
__host__ __device__ __forceinline__ void stage_rc(int b, int& R, int& C) { const int st = b / 1024, sb = b % 1024, swz = sb ^ (((sb >> 9) & 1) << 5); R = (st >> 1) * 16 + swz / 64; C = (st & 1) * 32 + (swz % 64) / 2; }
__host__ __device__ __forceinline__ int perm32(int rho) { const int n = rho >> 4, i = rho & 15; return 8 * (i >> 2) + 4 * n + (i & 3); }

struct Unit { int pm, pn; };
struct Gemm { const bf16_t* A; const bf16_t* Bt; int M, N, K; };

struct StaticOrder {
    int nM, nN, nwg, G, c;
    __host__ __device__ void init(int M, int N, int G_, int c_) { nM = M / BM; nN = N / BM; nwg = nM * nN; G = G_; c = c_; }
    __host__ __device__ bool next(int i, Unit& u) const {
        const long L = (long)i * G + c; if (L >= nwg) return false;
        int wgid = (int)L; { const int q = nwg / NXCD, r = nwg % NXCD, xcd = wgid % NXCD, off = wgid / NXCD; wgid = (xcd < r ? xcd * (q + 1) : r * (q + 1) + (xcd - r) * q) + off; }
        const int nig = WGM * nN, gid = wgid / nig, fm = gid * WGM, gsz = (nM - fm) < WGM ? (nM - fm) : WGM;
        u.pm = fm + ((wgid % nig) % gsz); u.pn = (wgid % nig) / gsz; return true;
    }
    __device__ __forceinline__ void a_ready(const Unit&) const {}
    __device__ __forceinline__ void done(const Unit&) const {}
};
struct CountedOrder : StaticOrder {
    const unsigned* ready; unsigned need; unsigned* tmo;
    __device__ __forceinline__ void a_ready(const Unit& u) const {
        if (threadIdx.x < 64) {
            const unsigned long long t0 = __builtin_amdgcn_s_memrealtime(); unsigned polls = 0;
            while ((unsigned)__builtin_amdgcn_readfirstlane(__hip_atomic_load(ready + 64 * u.pm, __ATOMIC_RELAXED, __HIP_MEMORY_SCOPE_AGENT)) < need) {
                if ((++polls & 255u) == 0u && __builtin_amdgcn_readfirstlane(__hip_atomic_load(tmo, __ATOMIC_RELAXED, __HIP_MEMORY_SCOPE_AGENT)) != 0u) break;
                if (__builtin_amdgcn_s_memrealtime() - t0 > 2000000ull) {
                    if (threadIdx.x == 0) { unsigned expect = 0u; __hip_atomic_compare_exchange_strong(tmo + 1, &expect, 0x600u | (unsigned)(u.pm & 0xff), __ATOMIC_RELAXED, __ATOMIC_RELAXED, __HIP_MEMORY_SCOPE_AGENT); __hip_atomic_store(tmo, 1u, __ATOMIC_RELAXED, __HIP_MEMORY_SCOPE_AGENT); }
                    break; }
                __builtin_amdgcn_s_sleep(2); }
            __builtin_amdgcn_fence(__ATOMIC_ACQUIRE, "agent");
            asm volatile("s_waitcnt vmcnt(0)" ::: "memory");
        }
#if !defined(BROKEN_HOOK_NO_BARRIER)
        asm volatile("" ::: "memory"); __builtin_amdgcn_s_barrier(); asm volatile("" ::: "memory");
#endif
    }
};

__device__ __forceinline__ unsigned cvt_pk_bf16(float lo, float hi) { unsigned r; asm volatile("v_cvt_pk_bf16_f32 %0, %1, %2" : "=v"(r) : "v"(lo), "v"(hi)); return r; }
typedef float f32x2 __attribute__((ext_vector_type(2)));
__device__ __forceinline__ f32x2 gelu_pk(f32x2 v) {
    const f32x2 av = __builtin_elementwise_abs(v), d = av * 0.2316418882f + 1.0f;
    f32x2 t; t.x = __builtin_amdgcn_rcpf(d.x); t.y = __builtin_amdgcn_rcpf(d.y);
    f32x2 q = t * 0.5307027145f + (-0.7265760135f); q = q * t + 0.7107068705f; q = q * t + (-0.142248368f); q = q * t + 0.127414796f; q = q * t;
    const f32x2 s = (v * v) * (-0.72134752044f);
    f32x2 e; e.x = __builtin_amdgcn_exp2f(s.x); e.y = __builtin_amdgcn_exp2f(s.y);
    const f32x2 m = v * (q * e), r = v - m;
    f32x2 o; o.x = v.x < 0.f ? m.x : r.x; o.y = v.y < 0.f ? m.y : r.y; return o;
}

struct EpiF32 {
    static constexpr bool PERM = false, AFTER_DRAIN = false;
    float* C; int ldc; const float* bias;
    __device__ __forceinline__ void operator()(const f32x4 (&acc)[2][2][4][2], const Unit& u, int wr, int wc, int fr, int fq) const {
        const int row0 = u.pm * BM + wr * 64 + fr, col0 = u.pn * BM + wc * 32 + 4 * fq;
        f32x4 bv[2][2];
#pragma unroll
        for (int bj = 0; bj < 2; ++bj)
#pragma unroll
            for (int n = 0; n < 2; ++n) bv[bj][n] = bias ? *(const f32x4*)(bias + col0 + bj * HALF + n * 16) : (f32x4){0.f, 0.f, 0.f, 0.f};
#pragma unroll
        for (int ai = 0; ai < 2; ++ai)
#pragma unroll
            for (int m = 0; m < 4; ++m) { float* rowp = C + (size_t)(row0 + ai * HALF + m * 16) * ldc + col0;
#pragma unroll
                for (int bj = 0; bj < 2; ++bj)
#pragma unroll
                    for (int n = 0; n < 2; ++n) *(f32x4*)(rowp + bj * HALF + n * 16) = acc[ai][bj][m][n] + bv[bj][n]; }
    }
};
template <int ACT  > struct EpiBf16 {
    static constexpr bool PERM = true, AFTER_DRAIN = false;
    bf16_t* O; int ldc; const float* bias; int split_cols; size_t split_stride;
    __device__ __forceinline__ void operator()(const f32x4 (&acc)[2][2][4][2], const Unit& u, int wr, int wc, int fr, int fq) const {
        const int row0 = u.pm * BM + wr * 64 + fr; int colt = u.pn * BM; bf16_t* base = O;
        if (split_cols) { const int t = colt / split_cols; base += (size_t)t * split_stride; colt -= t * split_cols; }
        const int col0 = colt + wc * 32 + 8 * fq, bcol0 = u.pn * BM + wc * 32 + 8 * fq;
        f32x4 bv[2][2];
#pragma unroll
        for (int bj = 0; bj < 2; ++bj)
#pragma unroll
            for (int n = 0; n < 2; ++n) bv[bj][n] = bias ? *(const f32x4*)(bias + bcol0 + bj * HALF + 4 * n) : (f32x4){0.f, 0.f, 0.f, 0.f};
#pragma unroll
        for (int ai = 0; ai < 2; ++ai)
#pragma unroll
            for (int m = 0; m < 4; ++m) { bf16_t* rowp = base + (size_t)(row0 + ai * HALF + m * 16) * ldc + col0;
#pragma unroll
                for (int bj = 0; bj < 2; ++bj) { f32x4 v0 = acc[ai][bj][m][0] + bv[bj][0], v1 = acc[ai][bj][m][1] + bv[bj][1];
                    if (ACT == 1) { f32x2 a = gelu_pk((f32x2){v0[0], v0[1]}), b = gelu_pk((f32x2){v0[2], v0[3]}), c = gelu_pk((f32x2){v1[0], v1[1]}), d = gelu_pk((f32x2){v1[2], v1[3]});
                        v0 = (f32x4){a.x, a.y, b.x, b.y}; v1 = (f32x4){c.x, c.y, d.x, d.y}; }
                    if (ACT == 2) {
#pragma unroll
                        for (int j = 0; j < 4; ++j) { v0[j] = 0.5f * v0[j] * (1.0f + erff(v0[j] * 0.70710678f)); v1[j] = 0.5f * v1[j] * (1.0f + erff(v1[j] * 0.70710678f)); } }
                    u32x4 w; w.x = cvt_pk_bf16(v0[0], v0[1]); w.y = cvt_pk_bf16(v0[2], v0[3]); w.z = cvt_pk_bf16(v1[0], v1[1]); w.w = cvt_pk_bf16(v1[2], v1[3]);
                    *(u32x4*)(rowp + bj * HALF) = w; } }
    }
};

struct PanelStats {
    unsigned* xbuf;
    unsigned* cnt;
    unsigned* tmo;
    int ntn; float eps;
    unsigned code;
    __device__ __forceinline__ bool run(const f32x4 (&v)[2][2][4][2], const Unit& u, int wr, int wc, int fr, int fq, PG8_LAS unsigned char* lds, int wid, int lane) const {
        typedef float f32x2v __attribute__((ext_vector_type(2)));
        PG8_LAS f32x2v* P = (PG8_LAS f32x2v*)lds;
        PG8_LAS f32x2v* S = (PG8_LAS f32x2v*)(lds + 8192);
        PG8_LAS unsigned* flag = (PG8_LAS unsigned*)(lds + 8192 + 2048);
#pragma unroll
        for (int ai = 0; ai < 2; ++ai)
#pragma unroll
            for (int m = 0; m < 4; ++m) {
                float s = 0.f;
#pragma unroll
                for (int bj = 0; bj < 2; ++bj)
#pragma unroll
                    for (int n = 0; n < 2; ++n) { const f32x4 x = v[ai][bj][m][n]; s += (x[0] + x[1]) + (x[2] + x[3]); }
                s += __shfl_xor(s, 16); s += __shfl_xor(s, 32);
                const float mw = s * (1.0f / 64.0f); float q = 0.f;
#pragma unroll
                for (int bj = 0; bj < 2; ++bj)
#pragma unroll
                    for (int n = 0; n < 2; ++n) { const f32x4 d = v[ai][bj][m][n] - mw; q += (d[0] * d[0] + d[1] * d[1]) + (d[2] * d[2] + d[3] * d[3]); }
                q += __shfl_xor(q, 16); q += __shfl_xor(q, 32);
                if (fq == 0) P[(ai * HALF + wr * 64 + m * 16 + fr) * 4 + wc] = (f32x2v){mw, q};
            }
        asm volatile("s_waitcnt lgkmcnt(0)" ::: "memory"); __builtin_amdgcn_s_barrier(); asm volatile("" ::: "memory");
#if defined(BROKEN_NO_WAIT)
        if (blockIdx.x >= 64) { const long long t0 = clock64(); while (clock64() - t0 < 60000) __builtin_amdgcn_s_sleep(8); }
#endif
        const int row = wid * 32 + (lane & 31);
        if (lane < 32) {
            const f32x2v a = P[row * 4 + 0], b = P[row * 4 + 1], c = P[row * 4 + 2], d = P[row * 4 + 3];
            const float mt = (a.x + b.x + c.x + d.x) * 0.25f;
            const float da = a.x - mt, db = b.x - mt, dc = c.x - mt, dd = d.x - mt;
            const float m2 = (a.y + b.y) + (c.y + d.y) + 64.0f * ((da * da + db * db) + (dc * dc + dd * dd));
            unsigned long long* slot = (unsigned long long*)xbuf + ((size_t)(u.pm * BM + row) * 4 + u.pn);
            __hip_atomic_store(slot, ((unsigned long long)__float_as_uint(m2) << 32) | __float_as_uint(mt), __ATOMIC_RELAXED, __HIP_MEMORY_SCOPE_AGENT);
        }
        asm volatile("s_waitcnt vmcnt(0)" ::: "memory");
        if (lane == 0) __hip_atomic_fetch_add(cnt + 64 * u.pm, 1u, __ATOMIC_RELAXED, __HIP_MEMORY_SCOPE_AGENT);
        if (wid == 0) {
            bool dead = false; const unsigned long long t0 = __builtin_amdgcn_s_memrealtime(); const unsigned want = 8u * (unsigned)ntn;
            for (;;) {
#if defined(BROKEN_NO_WAIT)
                break;
#endif
                if ((unsigned)__builtin_amdgcn_readfirstlane(__hip_atomic_load(cnt + 64 * u.pm, __ATOMIC_RELAXED, __HIP_MEMORY_SCOPE_AGENT)) >= want) break;
                if (__builtin_amdgcn_s_memrealtime() - t0 > 2000000ull) {
                    if (lane == 0) { unsigned expect = 0u; __hip_atomic_compare_exchange_strong(tmo + 1, &expect, code | (unsigned)(u.pm & 0xff), __ATOMIC_RELAXED, __ATOMIC_RELAXED, __HIP_MEMORY_SCOPE_AGENT);
                                     __hip_atomic_store(tmo, 1u, __ATOMIC_RELAXED, __HIP_MEMORY_SCOPE_AGENT); }
                    dead = true; break; }
                __builtin_amdgcn_s_sleep(2);
            }
            __builtin_amdgcn_fence(__ATOMIC_ACQUIRE, "agent");
            if (lane == 0) flag[0] = dead ? 1u : 0u;
        }
        asm volatile("s_waitcnt vmcnt(0) lgkmcnt(0)" ::: "memory"); __builtin_amdgcn_s_barrier(); asm volatile("" ::: "memory");
        const bool bad = flag[0] != 0u;
        if (lane < 32) {
            const unsigned long long* slot = (const unsigned long long*)xbuf + (size_t)(u.pm * BM + row) * 4; float mt[4], m2[4]; float ms = 0.f;
#pragma unroll
            for (int t = 0; t < 4; ++t) { if (t < ntn) { const unsigned long long w = __hip_atomic_load(slot + t, __ATOMIC_RELAXED, __HIP_MEMORY_SCOPE_AGENT); mt[t] = __uint_as_float((unsigned)w); m2[t] = __uint_as_float((unsigned)(w >> 32)); } else { mt[t] = 0.f; m2[t] = 0.f; } ms += mt[t]; }
            const float mean = ms / (float)ntn; float q = 0.f;
#pragma unroll
            for (int t = 0; t < 4; ++t) if (t < ntn) { const float dm = mt[t] - mean; q += m2[t] + 256.0f * dm * dm; }
            S[row] = (f32x2v){mean, 1.0f / sqrtf(q / (256.0f * (float)ntn) + eps)};
        }
        asm volatile("s_waitcnt lgkmcnt(0)" ::: "memory"); __builtin_amdgcn_s_barrier(); asm volatile("" ::: "memory");
        return bad;
    }
};
struct EpiLnRes {
    static constexpr bool PERM = false, AFTER_DRAIN = true;
    const float* base; float* out; int ldc; const float* bias; PanelStats st; unsigned poison;
    __device__ __forceinline__ void refuse(size_t i0, size_t stride, int M, int N) const { const float q = __builtin_nanf(""); for (size_t i = i0; i < (size_t)M * N; i += stride) out[(i / N) * ldc + i % N] = q;
        if (i0 == 0) { unsigned expect = 0u; __hip_atomic_compare_exchange_strong(st.tmo + 1, &expect, 0x7f0u, __ATOMIC_RELAXED, __ATOMIC_RELAXED, __HIP_MEMORY_SCOPE_AGENT); __hip_atomic_store(st.tmo, 1u, __ATOMIC_RELAXED, __HIP_MEMORY_SCOPE_AGENT); } }
    __device__ __forceinline__ void fused(f32x4 (&acc)[2][2][4][2], const Unit& u, int wr, int wc, int fr, int fq, PG8_LAS unsigned char* lds, int wid, int lane) const {
        typedef float f32x2v __attribute__((ext_vector_type(2)));
        const PG8_LAS f32x2v* S = (const PG8_LAS f32x2v*)(lds + 8192);
        const int col0 = u.pn * BM + wc * 32 + 4 * fq;
#pragma unroll
        for (int bj = 0; bj < 2; ++bj)
#pragma unroll
            for (int n = 0; n < 2; ++n) { const f32x4 bv = bias ? *(const f32x4*)(bias + col0 + bj * HALF + n * 16) : (f32x4){0.f, 0.f, 0.f, 0.f};
#pragma unroll
                for (int ai = 0; ai < 2; ++ai)
#pragma unroll
                    for (int m = 0; m < 4; ++m) acc[ai][bj][m][n] += bv; }
        const bool bad = st.run(acc, u, wr, wc, fr, fq, lds, wid, lane) || poison != 0u;
        const float qnan = __builtin_nanf("");
#pragma unroll
        for (int ai = 0; ai < 2; ++ai)
#pragma unroll
            for (int m = 0; m < 4; ++m) { const int r = ai * HALF + wr * 64 + m * 16 + fr; const f32x2v sr = S[r]; const size_t off = (size_t)(u.pm * BM + r) * ldc + col0;
#pragma unroll
                for (int bj = 0; bj < 2; ++bj)
#pragma unroll
                    for (int n = 0; n < 2; ++n) { const f32x4 bs = *(const f32x4*)(base + off + bj * HALF + n * 16); f32x4 o = bs + (acc[ai][bj][m][n] - sr.x) * sr.y;
                        if (bad) o = (f32x4){qnan, qnan, qnan, qnan}; *(f32x4*)(out + off + bj * HALF + n * 16) = o; }
                asm volatile("" ::: "memory"); }
    }
};
struct EpiLnResLn {
    static constexpr bool PERM = false, AFTER_DRAIN = true;
    const float* base; float* out; bf16_t* xn; int ldc; const float* bias; PanelStats st1, st2; unsigned poison;
    __device__ __forceinline__ void refuse(size_t i0, size_t stride, int M, int N) const { const float q = __builtin_nanf(""); for (size_t i = i0; i < (size_t)M * N; i += stride) { const size_t o = (i / N) * ldc + i % N; out[o] = q; xn[o] = (bf16_t)0x7fc0u; }
        if (i0 == 0) { unsigned expect = 0u; __hip_atomic_compare_exchange_strong(st1.tmo + 1, &expect, 0x7f0u, __ATOMIC_RELAXED, __ATOMIC_RELAXED, __HIP_MEMORY_SCOPE_AGENT); __hip_atomic_store(st1.tmo, 1u, __ATOMIC_RELAXED, __HIP_MEMORY_SCOPE_AGENT); } }
    __device__ __forceinline__ void fused(f32x4 (&acc)[2][2][4][2], const Unit& u, int wr, int wc, int fr, int fq, PG8_LAS unsigned char* lds, int wid, int lane) const {
        typedef float f32x2v __attribute__((ext_vector_type(2))); typedef unsigned u32x2v __attribute__((ext_vector_type(2)));
        const PG8_LAS f32x2v* S = (const PG8_LAS f32x2v*)(lds + 8192);
        const int col0 = u.pn * BM + wc * 32 + 4 * fq;
#pragma unroll
        for (int bj = 0; bj < 2; ++bj)
#pragma unroll
            for (int n = 0; n < 2; ++n) { const f32x4 bv = bias ? *(const f32x4*)(bias + col0 + bj * HALF + n * 16) : (f32x4){0.f, 0.f, 0.f, 0.f};
#pragma unroll
                for (int ai = 0; ai < 2; ++ai)
#pragma unroll
                    for (int m = 0; m < 4; ++m) acc[ai][bj][m][n] += bv; }
        bool bad = st1.run(acc, u, wr, wc, fr, fq, lds, wid, lane) || poison != 0u;
        const float qnan = __builtin_nanf("");
#pragma unroll
        for (int ai = 0; ai < 2; ++ai)
#pragma unroll
            for (int m = 0; m < 4; ++m) { const int r = ai * HALF + wr * 64 + m * 16 + fr; const f32x2v sr = S[r]; const size_t off = (size_t)(u.pm * BM + r) * ldc + col0;
#pragma unroll
                for (int bj = 0; bj < 2; ++bj)
#pragma unroll
                    for (int n = 0; n < 2; ++n) { const f32x4 bs = *(const f32x4*)(base + off + bj * HALF + n * 16); acc[ai][bj][m][n] = bs + (acc[ai][bj][m][n] - sr.x) * sr.y; }
                asm volatile("" : "+v"(acc[ai][0][m][0]), "+v"(acc[ai][0][m][1]), "+v"(acc[ai][1][m][0]), "+v"(acc[ai][1][m][1]));
                if (m & 1) asm volatile("" ::: "memory"); }
        const bool bad1 = bad;
        bad = st2.run(acc, u, wr, wc, fr, fq, lds, wid, lane) || bad;
#pragma unroll
        for (int ai = 0; ai < 2; ++ai)
#pragma unroll
            for (int m = 0; m < 4; ++m) { const int r = ai * HALF + wr * 64 + m * 16 + fr; const f32x2v sr = S[r]; const size_t off = (size_t)(u.pm * BM + r) * ldc + col0;
#pragma unroll
                for (int bj = 0; bj < 2; ++bj)
#pragma unroll
                    for (int n = 0; n < 2; ++n) { const f32x4 x1 = acc[ai][bj][m][n]; *(f32x4*)(out + off + bj * HALF + n * 16) = bad1 ? (f32x4){qnan, qnan, qnan, qnan} : x1;
                        const f32x4 o = (x1 - sr.x) * sr.y; u32x2v w; w.x = cvt_pk_bf16(o[0], o[1]); w.y = cvt_pk_bf16(o[2], o[3]);
                        if (bad) { w.x = 0x7fc07fc0u; w.y = 0x7fc07fc0u; } *(u32x2v*)(xn + off + bj * HALF + n * 16) = w; }
                asm volatile("" ::: "memory"); }
    }
};

template <class Epi, class Sched, bool STAMP = false>
__device__ __forceinline__ void gemm_phase(PG8_LAS unsigned char* lds, const Gemm g, const Sched& S, const Epi& E, unsigned long long* stamps) {
    const int tid = threadIdx.x, wid = __builtin_amdgcn_readfirstlane(tid >> 6), lane = tid & 63, wr = wid >> 2, wc = wid & 3, fr = lane & 15, fq = lane >> 4;
    const int K = g.K, nt = K / BK;
    int ts_lo = 0, ts_hi = 0, nts = 0; const unsigned long long rt_entry = STAMP ? (unsigned long long)wall_clock64() : 0ull;
#define PG8_STAMP() do { if (STAMP && wid == 0 && nts < 64) { const unsigned long long _c = (unsigned long long)clock64(); \
        ts_lo = (lane == nts) ? (int)(unsigned)_c : ts_lo; ts_hi = (lane == nts) ? (int)(unsigned)(_c >> 32) : ts_hi; ++nts; } } while (0)
    PG8_STAMP();
    unsigned voffA[2], voffB[2];
#pragma unroll
    for (int i = 0; i < 2; ++i) { int R, C; stage_rc(tid * 16 + i * 8192, R, C); const int Rb = Epi::PERM ? ((R & ~31) + perm32(R & 31)) : R;
        voffA[i] = (unsigned)(R * K + C) * 2u; voffB[i] = (unsigned)(Rb * K + C) * 2u; }
    const size_t kstep = (size_t)(BK * 2);
    const size_t hstep = (size_t)HALF * K * 2;
    const size_t tstep = 2 * hstep;
    const unsigned ldsw = (unsigned)wid * 1024u;
    const int aoff = lds_byte(wr * 64 + fr, fq * 8), boff = lds_byte(wc * 32 + fr, fq * 8);
#define PG8_SA(b, h) (((b) * 2 + (h)) * HTB)
#define PG8_SB(b, h) ((4 + (b) * 2 + (h)) * HTB)
#define PG8_STAGE(bufoff, gbase, voff) do { _Pragma("unroll") for (int _i = 0; _i < 2; ++_i) \
        __builtin_amdgcn_global_load_lds((const unsigned*)((const char*)(gbase) + (voff)[_i]), (PG8_LAS unsigned*)(lds + (bufoff) + ldsw + _i * 8192), 16, 0, 0); } while (0)
#define PG8_LDA(dst, b, h) do { _Pragma("unroll") for (int m = 0; m < 4; ++m) _Pragma("unroll") for (int k = 0; k < 2; ++k) dst[m][k] = *(const PG8_LAS bf16x8*)(lds + PG8_SA(b, h) + aoff + m * 2048 + k * 1024); } while (0)
#define PG8_LDB(dst, b, h) do { _Pragma("unroll") for (int n = 0; n < 2; ++n) _Pragma("unroll") for (int k = 0; k < 2; ++k) dst[n][k] = *(const PG8_LAS bf16x8*)(lds + PG8_SB(b, h) + boff + n * 2048 + k * 1024); } while (0)
#define PG8_MMA(ai, bj, At, Bt) do { __builtin_amdgcn_s_setprio(1); _Pragma("unroll") for (int m = 0; m < 4; ++m) _Pragma("unroll") for (int n = 0; n < 2; ++n) _Pragma("unroll") for (int k = 0; k < 2; ++k) \
        acc[ai][bj][m][n] = __builtin_amdgcn_mfma_f32_16x16x32_bf16(Bt[n][k], At[m][k], acc[ai][bj][m][n], 0, 0, 0); __builtin_amdgcn_s_setprio(0); } while (0)
#define PG8_WAIT_V(n) asm volatile("s_waitcnt vmcnt(" #n ")" ::: "memory")
#define PG8_WAIT_L(n) asm volatile("s_waitcnt lgkmcnt(" #n ")" ::: "memory")
#define PG8_BAR __builtin_amdgcn_s_barrier()
#define PG8_SCHED __builtin_amdgcn_sched_barrier(0)
    Unit cur, nxt; int ui = 0;
    if (!S.next(0, cur)) return;
    f32x4 acc[2][2][4][2];
#pragma unroll
    for (int a = 0; a < 2; ++a)
#pragma unroll
        for (int b = 0; b < 2; ++b)
#pragma unroll
            for (int m = 0; m < 4; ++m)
#pragma unroll
                for (int n = 0; n < 2; ++n) acc[a][b][m][n] = (f32x4){0.f, 0.f, 0.f, 0.f};
    bf16x8 At[4][2], B0[2][2], B1[2][2];
    const char* cA = (const char*)g.A + (size_t)cur.pm * tstep; const char* cB = (const char*)g.Bt + (size_t)cur.pn * tstep;
    S.a_ready(cur);
    PG8_STAGE(PG8_SB(0, 0), cB, voffB); PG8_STAGE(PG8_SA(0, 0), cA, voffA); PG8_STAGE(PG8_SB(0, 1), cB + hstep, voffB); PG8_STAGE(PG8_SA(0, 1), cA + hstep, voffA);
    if (wr == 1) PG8_BAR;
    PG8_WAIT_V(4); PG8_BAR;
    PG8_STAGE(PG8_SB(1, 0), cB + kstep, voffB); PG8_STAGE(PG8_SA(1, 0), cA + kstep, voffA); PG8_STAGE(PG8_SB(1, 1), cB + hstep + kstep, voffB);
    PG8_WAIT_V(6); PG8_BAR;
    PG8_STAMP();
    for (;;) {
        const bool has_next = S.next(ui + 1, nxt);
        const char* nA = has_next ? (const char*)g.A + (size_t)nxt.pm * tstep : cA; const char* nB = has_next ? (const char*)g.Bt + (size_t)nxt.pn * tstep : cB;
        for (int t = 0; t < nt; t += 2) {
            const bool last = (t == nt - 2);
            const char* a1 = cA + (size_t)(t + 1) * kstep;
            const char* a2 = last ? nA : cA + (size_t)(t + 2) * kstep; const char* b2 = last ? nB : cB + (size_t)(t + 2) * kstep;
            const char* a3 = a2 + kstep; const char* b3 = b2 + kstep;
            if (last && has_next) S.a_ready(nxt);
            PG8_LDB(B0, 0, 0); PG8_SCHED; PG8_LDA(At, 0, 0); PG8_STAGE(PG8_SA(1, 1), a1 + hstep, voffA);
            PG8_WAIT_L(8); PG8_BAR; PG8_WAIT_L(0); PG8_MMA(0, 0, At, B0); PG8_BAR; PG8_SCHED;
            PG8_LDB(B1, 0, 1); PG8_STAGE(PG8_SB(0, 0), b2, voffB);
            PG8_BAR; PG8_WAIT_L(0); PG8_MMA(0, 1, At, B1); PG8_BAR;
            PG8_LDA(At, 0, 1); PG8_STAGE(PG8_SA(0, 0), a2, voffA);
            PG8_BAR; PG8_WAIT_L(0); PG8_MMA(1, 0, At, B0); PG8_BAR; PG8_SCHED;
            PG8_STAGE(PG8_SB(0, 1), b2 + hstep, voffB);
            PG8_WAIT_V(6); PG8_BAR; PG8_MMA(1, 1, At, B1); PG8_BAR;
            PG8_LDB(B0, 1, 0); PG8_SCHED; PG8_LDA(At, 1, 0); PG8_STAGE(PG8_SA(0, 1), a2 + hstep, voffA);
            PG8_WAIT_L(8); PG8_BAR; PG8_WAIT_L(0); PG8_MMA(0, 0, At, B0); PG8_BAR; PG8_SCHED;
            PG8_LDB(B1, 1, 1); PG8_STAGE(PG8_SB(1, 0), b3, voffB);
            PG8_BAR; PG8_WAIT_L(0); PG8_MMA(0, 1, At, B1); PG8_BAR;
            PG8_LDA(At, 1, 1); PG8_STAGE(PG8_SA(1, 0), a3, voffA);
            PG8_BAR; PG8_WAIT_L(0); PG8_MMA(1, 0, At, B0); PG8_BAR; PG8_SCHED;
            PG8_STAGE(PG8_SB(1, 1), b3 + hstep, voffB);
            PG8_WAIT_V(6); PG8_BAR; PG8_MMA(1, 1, At, B1); PG8_BAR;
        }
        PG8_STAMP();
        if constexpr (!Epi::AFTER_DRAIN) { E(acc, cur, wr, wc, fr, fq); S.done(cur); }
        PG8_STAMP();
        if (!has_next) break;
#pragma unroll
        for (int a = 0; a < 2; ++a)
#pragma unroll
            for (int b = 0; b < 2; ++b)
#pragma unroll
                for (int m = 0; m < 4; ++m)
#pragma unroll
                    for (int n = 0; n < 2; ++n) acc[a][b][m][n] = (f32x4){0.f, 0.f, 0.f, 0.f};
        cur = nxt; cA = nA; cB = nB; ++ui;
    }
    PG8_WAIT_V(0);
    if (wr == 0) PG8_BAR;
    PG8_BAR;
    if constexpr (Epi::AFTER_DRAIN) { E.fused(acc, cur, wr, wc, fr, fq, lds, wid, lane); S.done(cur); }
    PG8_STAMP();
    if (STAMP && wid == 0) { stamps[lane] = lane < nts ? (((unsigned long long)(unsigned)ts_hi << 32) | (unsigned)ts_lo) : 0ull;
        if (lane == 62) stamps[62] = rt_entry; if (lane == 63) stamps[63] = (unsigned long long)wall_clock64(); }
#undef PG8_STAMP
#undef PG8_SA
#undef PG8_SB
#undef PG8_STAGE
#undef PG8_LDA
#undef PG8_LDB
#undef PG8_MMA
#undef PG8_WAIT_V
#undef PG8_WAIT_L
#undef PG8_BAR
#undef PG8_SCHED
}
}

constexpr int D = 1024, NB = 16, S = 2048, T = NB * S;
constexpr int NCOL = 2840, NPAD = 3072;
constexpr int C_Q = 0, C_KC = 512, C_VC = 640, C_KS = 768, C_VS = 896, C_KW = 1024, C_VW = 1152, C_GT = 1280, C_CB = 1304, C_CC = 1816, C_CH = 2328;
constexpr int NCMP = 127;
constexpr int NEXP = 16384;
constexpr float EPS = 1e-6f;
constexpr int NTHREADS = 512, NWAVES = 8;

constexpr size_t al256(size_t x) { return (x + 255) & ~(size_t)255; }
constexpr size_t WS_CTL   = 0;                                   constexpr size_t CTL_BYTES = 65536;
constexpr size_t WS_MOD   = WS_CTL + CTL_BYTES;
constexpr size_t WS_WIN   = al256(WS_MOD + (size_t)16 * 6144 * 4);
constexpr size_t WS_WOUT  = al256(WS_WIN + (size_t)NPAD * D * 2);
constexpr size_t WS_WQ    = al256(WS_WOUT + (size_t)D * D * 2);
constexpr size_t WS_KEYS  = al256(WS_WQ + (size_t)D * D * 2);
constexpr size_t WS_U8S   = al256(WS_KEYS + (size_t)16 * 128 * 64 * 2);
constexpr size_t WS_V8S   = al256(WS_U8S + (size_t)NEXP * D);
constexpr size_t WS_X8S   = al256(WS_V8S + (size_t)NEXP * D);
constexpr size_t WS_SU    = al256(WS_X8S + (size_t)T * D);
constexpr size_t WS_SV    = al256(WS_SU + (size_t)NEXP * 4);
constexpr size_t WS_SX    = al256(WS_SV + (size_t)NEXP * 4);
constexpr size_t WS_W1T   = al256(WS_SX + (size_t)T * 4);
constexpr size_t WS_W2T   = al256(WS_W1T + (size_t)2 * 64 * 2048 * 2);
constexpr size_t WS_PEC   = al256(WS_W2T + (size_t)2 * 64 * 64 * 2);
constexpr size_t WS_KC    = al256(WS_PEC + (size_t)2 * 64 * 4);
constexpr size_t WS_VC    = al256(WS_KC + (size_t)16 * 2 * 128 * 64 * 2);
constexpr size_t WS_H     = al256(WS_VC + (size_t)16 * 2 * 128 * 64 * 2);
constexpr size_t WS_CQ8   = WS_H;
constexpr size_t WS_CMAX  = WS_H + (size_t)32 * 1024 * 1024;
constexpr size_t WS_SSQP  = WS_H + (size_t)33 * 1024 * 1024;
constexpr size_t WS_OATT  = al256(WS_H + (size_t)T * D * 2);
constexpr size_t WS_PROJ  = al256(WS_OATT + (size_t)T * 512 * 2);
constexpr size_t WS_QP    = WS_PROJ;
constexpr size_t WS_PART  = WS_PROJ;
constexpr size_t WS_PO    = WS_PROJ;
constexpr size_t WS_E16   = WS_PROJ + (size_t)160 * 1024 * 1024;
constexpr size_t WS_EW    = WS_E16 + (size_t)T * 128 * 4;
constexpr size_t WS_Y     = al256(WS_PROJ + (size_t)T * NPAD * 2);
constexpr size_t WS_END   = al256(WS_Y + (size_t)T * D * 2);
static_assert(WS_EW + (size_t)T * 128 * 4 <= WS_Y, "alias region");
static_assert((size_t)8 * T * 128 * 4 <= (size_t)160 * 1024 * 1024, "PART fits under EIDX");
constexpr int CTL_CTR_A = 16384, CTL_CTR_B = 16384 + 8 * 256;

constexpr int LDS_STAGE = 147456;
constexpr int LDS_MISC_OFF = LDS_STAGE;
constexpr int LDS_BYTES = LDS_STAGE + 256;

typedef unsigned short bf16_t;
typedef short bf16x8 __attribute__((ext_vector_type(8)));
typedef short s16x4 __attribute__((ext_vector_type(4)));
typedef float f32x4 __attribute__((ext_vector_type(4)));
typedef unsigned u32x4v __attribute__((ext_vector_type(4)));
__device__ __forceinline__ float bf2f(bf16_t b) { return __uint_as_float(((unsigned)b) << 16); }
__device__ __forceinline__ bf16_t f2bf(float f) { unsigned u = __float_as_uint(f); u += 0x7FFFu + ((u >> 16) & 1u); return (bf16_t)(u >> 16); }
__device__ __forceinline__ float bflo(unsigned w) { return __uint_as_float(w << 16); }
__device__ __forceinline__ float bfhi(unsigned w) { return __uint_as_float(w & 0xFFFF0000u); }
__device__ __forceinline__ unsigned pack2(float lo, float hi) { return (unsigned)f2bf(lo) | ((unsigned)f2bf(hi) << 16); }
__device__ __forceinline__ float gelu_tanh(float x) { const float u = 0.7978845608028654f * (x + 0.044715f * x * x * x); return 0.5f * x * (1.0f + tanhf(u)); }
__device__ __forceinline__ float sigmoidf_(float x) { return 1.0f / (1.0f + __expf(-x)); }
__device__ __forceinline__ float wave_sum(float v) {
#pragma unroll
    for (int o = 32; o >= 1; o >>= 1) v += __shfl_xor(v, o);
    return v; }
__device__ __forceinline__ float wave_max(float v) {
#pragma unroll
    for (int o = 32; o >= 1; o >>= 1) v = fmaxf(v, __shfl_xor(v, o));
    return v; }
__device__ __forceinline__ void lds_wave_sync() { asm volatile("s_waitcnt lgkmcnt(0)" ::: "memory"); }
#ifdef PROBE_STAMP
#define STAMP_DECL unsigned long long tprev_ = 0ull; const bool dbg_ = (PROBE_PHASE == 12 || blockIdx.x == PROBE_BLOCK) && (threadIdx.x == 0);
#define STAMP_START() do { if (dbg_) tprev_ = __builtin_amdgcn_s_memtime(); } while (0)
#define STAMP(k) do { if (dbg_) { const unsigned long long tn_ = __builtin_amdgcn_s_memtime(); volatile LAS unsigned* c_ = (volatile LAS unsigned*)(F_lds_ + LDS_MISC_OFF + 128); c_[k] += (unsigned)(tn_ - tprev_); tprev_ = tn_; } } while (0)
#define STAMP_COUNT(k) do { if (dbg_) { volatile LAS unsigned* c_ = (volatile LAS unsigned*)(F_lds_ + LDS_MISC_OFF + 128); c_[k] += 1u; } } while (0)
#else
#define STAMP_DECL
#define STAMP_START() do {} while (0)
#define STAMP(k) do {} while (0)
#define STAMP_COUNT(k) do {} while (0)
#endif
#ifndef PROBE_BLOCK
#define PROBE_BLOCK 0
#endif
#ifndef PROBE_PHASE
#define PROBE_PHASE 4
#endif

__device__ __forceinline__ int rel_bucket(int dist) {
    const int n = dist > 0 ? dist : 0;
    if (n < 16) return n;
    const float lr = logf((float)n / 16.0f) / 2.0794415416798357f;
    const int large = 16 + (int)(lr * 16.0f);
    return large < 31 ? large : 31;
}

struct Frame {
    const float* in[23]; float* out; unsigned char* ws;
    LAS unsigned char* lds; int tid, lane, wave, G;
};


typedef int i32x4v __attribute__((ext_vector_type(4)));
constexpr int PEER_CHUNK_TOK = 128, PEER_NCHUNK = T / PEER_CHUNK_TOK;

__device__ __forceinline__ void quant_row_sliced(const float* row, unsigned char* dst8  , size_t nrows, size_t r, float* scale_out, int bias, int lane) {
    float4 v[4]; float am = 0.f;
#pragma unroll
    for (int i = 0; i < 4; ++i) { v[i] = *(const float4*)(row + (lane + 64 * i) * 4); am = fmaxf(am, fmaxf(fmaxf(fabsf(v[i].x), fabsf(v[i].y)), fmaxf(fabsf(v[i].z), fabsf(v[i].w)))); }
    am = wave_max(am); const float inv = am > 0.f ? 127.0f / am : 0.f;
    if (lane == 0) *scale_out = am > 0.f ? am / 127.0f : 0.f;
#pragma unroll
    for (int i = 0; i < 4; ++i) { const int col = (lane + 64 * i) * 4; const int sl = col >> 7, off = col & 127;
        const int q0 = (int)rintf(v[i].x * inv) + bias, q1 = (int)rintf(v[i].y * inv) + bias, q2 = (int)rintf(v[i].z * inv) + bias, q3 = (int)rintf(v[i].w * inv) + bias;
        *(unsigned*)(dst8 + ((size_t)sl * nrows + r) * 128 + off) = (unsigned)(q0 & 0xFF) | ((unsigned)(q1 & 0xFF) << 8) | ((unsigned)(q2 & 0xFF) << 16) | ((unsigned)(q3 & 0xFF) << 24); }
}

constexpr int PEER_NGRP = T / 16;
__device__ __forceinline__ int grab_item(unsigned* ctr, int slice, int lane) {
    unsigned v = 0u; if (lane == 0) v = __hip_atomic_fetch_add(ctr + slice * 64, 1u, __ATOMIC_RELAXED, __HIP_MEMORY_SCOPE_AGENT);
    return (int)__builtin_amdgcn_readfirstlane(v);
}
__device__ __forceinline__ void gather_rows16(u32x4v (&vv)[16], const unsigned char* base, const LAS unsigned* le) {
    const u32x4v e0 = *(const LAS u32x4v*)le, e1 = *(const LAS u32x4v*)(le + 4);
#pragma unroll
    for (int ld = 0; ld < 16; ++ld) { const unsigned w = ld < 8 ? e0[ld >> 1] : e1[(ld - 8) >> 1]; const unsigned e = (ld & 1) ? (w >> 16) : (w & 0xFFFFu);
        vv[ld] = *(const u32x4v*)(base + (size_t)e * 128); }
}
__device__ __forceinline__ void udot_item(const u32x4v (&uv)[16], const i32x4v xq, int* part_row  , int c) {
    i32x4v res[4];
#pragma unroll
    for (int ld = 0; ld < 16; ++ld) { int p = __builtin_amdgcn_sdot4((int)uv[ld][0], xq[0], 0, false); p = __builtin_amdgcn_sdot4((int)uv[ld][1], xq[1], p, false);
        p = __builtin_amdgcn_sdot4((int)uv[ld][2], xq[2], p, false); p = __builtin_amdgcn_sdot4((int)uv[ld][3], xq[3], p, false);
        p += __shfl_xor(p, 1); p += __shfl_xor(p, 2); p += __shfl_xor(p, 4); res[ld >> 2][ld & 3] = p; }
    if (c == 0) {
#pragma unroll
        for (int q = 0; q < 4; ++q) *(i32x4v*)(part_row + 4 * q) = res[q]; }
}
__device__ __forceinline__ void p10a_udots(const Frame& F) {
    const unsigned char* U8S = F.ws + WS_U8S; const unsigned char* X8S = F.ws + WS_X8S; const unsigned short* E16 = (const unsigned short*)(F.ws + WS_E16); int* PART = (int*)(F.ws + WS_PART);
    unsigned* ctr = (unsigned*)(F.ws + WS_CTL + CTL_CTR_A);
    const int lane = F.lane, j = lane >> 3, c = lane & 7; const int xcc = (int)(xb_xcc_id() & 7u);
    LAS unsigned char* wl = F.lds + F.wave * 8192;
    const LAS unsigned* le = (const LAS unsigned*)wl + 8 * j;
    for (int so = 0; so < 8; ++so) { const int x = (xcc + so) & 7;
        const unsigned char* ub = U8S + (size_t)x * NEXP * 128 + c * 16;
        int nxt = grab_item(ctr, x, lane);
        for (;;) { const int cur = nxt; if (cur >= PEER_NGRP) break;
            nxt = grab_item(ctr, x, lane);
            const int t0 = cur * 16;
            { const u32x4v* src = (const u32x4v*)(E16 + (size_t)t0 * 128);
#pragma unroll
                for (int i = 0; i < 4; ++i) *(LAS u32x4v*)(wl + (lane + 64 * i) * 16) = src[lane + 64 * i]; }
            lds_wave_sync();
            const unsigned char* xb = X8S + ((size_t)x * T + t0) * 128 + c * 16; int* pr = PART + ((size_t)x * T + t0) * 128 + 16 * j;
            u32x4v va[16], vb[16];
            gather_rows16(va, ub, le);
#pragma unroll 1
            for (int tt = 0; tt < 16; tt += 2) {
                const i32x4v xqa = *(const i32x4v*)(xb + (size_t)tt * 128), xqb = *(const i32x4v*)(xb + (size_t)(tt + 1) * 128);
                gather_rows16(vb, ub, le + (tt + 1) * 64);
                udot_item(va, xqa, pr + (size_t)tt * 128, c);
                if (tt + 2 < 16) gather_rows16(va, ub, le + (tt + 2) * 64);
                udot_item(vb, xqb, pr + (size_t)(tt + 1) * 128, c);
            }
            lds_wave_sync();
        }
    }
}

__device__ __forceinline__ void p10b_coef(const Frame& F) {
    const unsigned short* E16 = (const unsigned short*)(F.ws + WS_E16); const float* EW = (const float*)(F.ws + WS_EW); const int* PART = (const int*)(F.ws + WS_PART);
    const float* SU = (const float*)(F.ws + WS_SU); const float* SV = (const float*)(F.ws + WS_SV); const float* SX = (const float*)(F.ws + WS_SX);
    signed char* CQ8 = (signed char*)(F.ws + WS_CQ8); float* CMAX = (float*)(F.ws + WS_CMAX);
    const int gw = blockIdx.x * NWAVES + F.wave, nw = F.G * NWAVES, lane = F.lane;
    for (int t = gw; t < T; t += nw) { const float sx = SX[t]; float cs[2]; float am = 0.f;
#pragma unroll
        for (int hh = 0; hh < 2; ++hh) { const int i = lane + 64 * hh; int s = 0;
#pragma unroll
            for (int x = 0; x < 8; ++x) s += PART[((size_t)x * T + t) * 128 + i];
            const int e = E16[(size_t)t * 128 + i]; const float dot = (float)s * sx * SU[e];
            cs[hh] = EW[(size_t)t * 128 + i] * gelu_tanh(dot) * SV[e]; am = fmaxf(am, fabsf(cs[hh])); }
        am = wave_max(am); const float inv = am > 0.f ? 127.0f / am : 0.f;
#pragma unroll
        for (int hh = 0; hh < 2; ++hh) CQ8[(size_t)t * 128 + lane + 64 * hh] = (signed char)(int)rintf(cs[hh] * inv);
        if (lane == 0) CMAX[t] = am > 0.f ? am / 127.0f : 0.f; }
}

struct VsumPre { float sc; };
__device__ __forceinline__ void vsum_item(const u32x4v (&vv)[16], const LAS unsigned* lq  , const VsumPre& pre, unsigned* pop, int lane) {
    const u32x4v cq = *(const LAS u32x4v*)lq;
    int acc[16];
#pragma unroll
    for (int k = 0; k < 16; ++k) acc[k] = 0;
#pragma unroll
    for (int g = 0; g < 4; ++g) { const int cw = (int)cq[g];
#pragma unroll
        for (int w = 0; w < 4; ++w) { const unsigned r0 = vv[4 * g][w], r1 = vv[4 * g + 1][w], r2 = vv[4 * g + 2][w], r3 = vv[4 * g + 3][w];
            const unsigned t0 = __builtin_amdgcn_perm(r1, r0, 0x05010400u), t1 = __builtin_amdgcn_perm(r1, r0, 0x07030602u), t2 = __builtin_amdgcn_perm(r3, r2, 0x05010400u), t3 = __builtin_amdgcn_perm(r3, r2, 0x07030602u);
            const unsigned c0 = __builtin_amdgcn_perm(t2, t0, 0x05040100u), c1 = __builtin_amdgcn_perm(t2, t0, 0x07060302u), c2 = __builtin_amdgcn_perm(t3, t1, 0x05040100u), c3 = __builtin_amdgcn_perm(t3, t1, 0x07060302u);
            acc[4 * w + 0] = __builtin_amdgcn_sdot4((int)c0, cw, acc[4 * w + 0], false); acc[4 * w + 1] = __builtin_amdgcn_sdot4((int)c1, cw, acc[4 * w + 1], false);
            acc[4 * w + 2] = __builtin_amdgcn_sdot4((int)c2, cw, acc[4 * w + 2], false); acc[4 * w + 3] = __builtin_amdgcn_sdot4((int)c3, cw, acc[4 * w + 3], false); } }
    int a8[8], a4[4], a2[2];
    { const bool hi = (lane & 32) != 0;
#pragma unroll
        for (int k = 0; k < 8; ++k) { const int snd = hi ? acc[k] : acc[k + 8]; const int rcv = __shfl_xor(snd, 32); a8[k] = (hi ? acc[k + 8] : acc[k]) + rcv; } }
    { const bool hi = (lane & 16) != 0;
#pragma unroll
        for (int k = 0; k < 4; ++k) { const int snd = hi ? a8[k] : a8[k + 4]; const int rcv = __shfl_xor(snd, 16); a4[k] = (hi ? a8[k + 4] : a8[k]) + rcv; } }
    { const bool hi = (lane & 8) != 0;
#pragma unroll
        for (int k = 0; k < 2; ++k) { const int snd = hi ? a4[k] : a4[k + 2]; const int rcv = __shfl_xor(snd, 8); a2[k] = (hi ? a4[k + 2] : a4[k]) + rcv; } }
    *pop = pg8::cvt_pk_bf16((float)a2[0] * pre.sc, (float)a2[1] * pre.sc);
}
__device__ __forceinline__ void p10c_vsum(const Frame& F) {
    const unsigned char* V8S = F.ws + WS_V8S; const unsigned short* E16 = (const unsigned short*)(F.ws + WS_E16); const signed char* CQ8 = (const signed char*)(F.ws + WS_CQ8); const float* CMAX = (const float*)(F.ws + WS_CMAX);
    bf16_t* PO = (bf16_t*)(F.ws + WS_PO);
    unsigned* ctr = (unsigned*)(F.ws + WS_CTL + CTL_CTR_B);
    const int lane = F.lane, j = lane >> 3, c = lane & 7; const int xcc = (int)(xb_xcc_id() & 7u);
    const int ocol = 16 * c + 8 * ((lane >> 5) & 1) + 4 * ((lane >> 4) & 1) + 2 * ((lane >> 3) & 1);
    LAS unsigned char* wl = F.lds + F.wave * 8192;
    const LAS unsigned* le = (const LAS unsigned*)wl + 8 * j; const LAS unsigned* lq = (const LAS unsigned*)(wl + 4096) + 4 * j;
    for (int so = 0; so < 8; ++so) { const int x = (xcc + so) & 7;
        const unsigned char* vb = V8S + (size_t)x * NEXP * 128 + c * 16;
        const int col = x * 128 + ocol;
        int nxt = grab_item(ctr, x, lane);
        for (;;) { const int cur = nxt; if (cur >= PEER_NGRP) break;
            nxt = grab_item(ctr, x, lane);
            const int t0 = cur * 16;
            { const u32x4v* src = (const u32x4v*)(E16 + (size_t)t0 * 128); const u32x4v* srq = (const u32x4v*)(CQ8 + (size_t)t0 * 128);
#pragma unroll
                for (int i = 0; i < 4; ++i) *(LAS u32x4v*)(wl + (lane + 64 * i) * 16) = src[lane + 64 * i];
#pragma unroll
                for (int i = 0; i < 2; ++i) *(LAS u32x4v*)(wl + 4096 + (lane + 64 * i) * 16) = srq[lane + 64 * i]; }
            lds_wave_sync();
            u32x4v va[16], vbb[16];
            gather_rows16(va, vb, le);
#pragma unroll 1
            for (int tt = 0; tt < 16; tt += 2) {
                { VsumPre pa; pa.sc = CMAX[t0 + tt];
                  gather_rows16(vbb, vb, le + (tt + 1) * 64);
                  vsum_item(va, lq + tt * 32, pa, (unsigned*)(PO + (size_t)(t0 + tt) * D + col), lane); }
                { VsumPre pb; pb.sc = CMAX[t0 + tt + 1];
                  if (tt + 2 < 16) gather_rows16(va, vb, le + (tt + 2) * 64);
                  vsum_item(vbb, lq + (tt + 1) * 32, pb, (unsigned*)(PO + (size_t)(t0 + tt + 1) * D + col), lane); }
            }
            lds_wave_sync();
        }
    }
}

__device__ __forceinline__ void p10d_final(const Frame& F) {
    const bf16_t* PO = (const bf16_t*)(F.ws + WS_PO); const float* MOD = (const float*)(F.ws + WS_MOD); const float* gfin = F.in[22]; float* out = F.out;
    const int gw = blockIdx.x * NWAVES + F.wave, nw = F.G * NWAVES, lane = F.lane;
    const float* xin = F.in[0]; const bf16_t* Y = (const bf16_t*)(F.ws + WS_Y);
    float4 xn[4]; uint2 pn[4], yn[4];
    if (gw < T) {
#pragma unroll
        for (int i = 0; i < 4; ++i) { const int col = (lane + 64 * i) * 4; xn[i] = *(const float4*)(xin + (size_t)gw * D + col); pn[i] = *(const uint2*)(PO + (size_t)gw * D + col); yn[i] = *(const uint2*)(Y + (size_t)gw * D + col); } }
    for (int t = gw; t < T; t += nw) { const int b = t / S;
        float4 v[4], xc[4]; uint2 pc[4], yc[4]; float ss = 0.f;
#pragma unroll
        for (int i = 0; i < 4; ++i) { xc[i] = xn[i]; pc[i] = pn[i]; yc[i] = yn[i]; }
        { const int tn = t + nw < T ? t + nw : t;
#pragma unroll
            for (int i = 0; i < 4; ++i) { const int col = (lane + 64 * i) * 4; xn[i] = *(const float4*)(xin + (size_t)tn * D + col); pn[i] = *(const uint2*)(PO + (size_t)tn * D + col); yn[i] = *(const uint2*)(Y + (size_t)tn * D + col); } }
#pragma unroll
        for (int i = 0; i < 4; ++i) { const int col = (lane + 64 * i) * 4; const float4 g1 = *(const float4*)(MOD + b * 6144 + 2048 + col), gt = *(const float4*)(MOD + b * 6144 + 5120 + col);
            const uint2 pw = pc[i], yw = yc[i];
            v[i].x = xc[i].x + g1.x * bflo(yw.x) + gt.x * bflo(pw.x); v[i].y = xc[i].y + g1.y * bfhi(yw.x) + gt.y * bfhi(pw.x); v[i].z = xc[i].z + g1.z * bflo(yw.y) + gt.z * bflo(pw.y); v[i].w = xc[i].w + g1.w * bfhi(yw.y) + gt.w * bfhi(pw.y);
            ss += v[i].x * v[i].x + v[i].y * v[i].y + v[i].z * v[i].z + v[i].w * v[i].w; }
        ss = wave_sum(ss);
#ifdef PROBE_STAMP
        const unsigned* dg = (const unsigned*)(F.ws + WS_CTL + 32768); const float pnum = (float)dg[PROBE_STAMP]; const float pden = PROBE_DEN >= 0 ? (float)dg[PROBE_DEN >= 0 ? PROBE_DEN : 0] : (float)PROBE_ABS;
        const float rstd = rsqrtf(ss * (1.0f / D) + EPS) * (1.0f + 0.5f * pnum / pden);
#else
        const float rstd = rsqrtf(ss * (1.0f / D) + EPS);
#endif
#pragma unroll
        for (int i = 0; i < 4; ++i) { const int col = (lane + 64 * i) * 4; const float4 gg = *(const float4*)(gfin + col);
            *(float4*)(out + (size_t)t * D + col) = make_float4(v[i].x * rstd * gg.x, v[i].y * rstd * gg.y, v[i].z * rstd * gg.z, v[i].w * rstd * gg.w); }
    }
}

__device__ __forceinline__ void transpose_tile(const Frame& F, const float* src, int srcK, int srcN, bf16_t* dst, int dstK, int kt, int nt) {
    LAS float* tile = (LAS float*)F.lds;
    const int k0 = kt * 64, n0 = nt * 64;
    for (int i = F.tid; i < 4096; i += NTHREADS) { const int r = i >> 6, c = i & 63; const int k = k0 + r, n = n0 + c;
        tile[r * 65 + c] = (k < srcK && n < srcN) ? src[(size_t)k * srcN + n] : 0.0f; }
    __syncthreads();
    for (int i = F.tid; i < 4096; i += NTHREADS) { const int r = i >> 6, c = i & 63;
        dst[(size_t)(n0 + r) * dstK + k0 + c] = f2bf(tile[c * 65 + r]); }
    __syncthreads();
}
__device__ __forceinline__ void p0_prologue(const Frame& F, int item_lo = 0, int item_hi = 1 << 30) {
    const float* c = F.in[1]; const float* w_mod = F.in[4]; const float* b_mod = F.in[5];
    float* MOD = (float*)(F.ws + WS_MOD);
    constexpr int I_MOD = 96, I_WIN = 16 * 48, I_WOUT = 256, I_WQ = 256, I_U = 256, I_V = 256, I_KEYS = 32, I_CMP = 32 + 32 + 1 + 1 + 2;
    constexpr int O_WIN = I_MOD, O_WOUT = O_WIN + I_WIN, O_WQ = O_WOUT + I_WOUT, O_U = O_WQ + I_WQ, O_V = O_U + I_U, O_KEYS = O_V + I_V, O_CMP = O_KEYS + I_KEYS, N_ITEMS = O_CMP + I_CMP;
    for (int vit = item_lo + blockIdx.x; vit < N_ITEMS && vit < item_hi; vit += F.G) {
        int it = vit;
        if (vit >= O_WIN) { const int v = vit - O_WIN; constexpr int NQ = I_U + I_V, NT = I_WIN + I_WOUT + I_WQ;
            it = v < NQ ? O_U + v : (v < NQ + NT ? O_WIN + (v - NQ) : O_KEYS + (v - NQ - NT)); }
        if (it < O_WIN) {
            LAS float* sl = (LAS float*)F.lds; LAS float* red = (LAS float*)(F.lds + 65536);
            for (int q = F.tid; q < 16 * D; q += NTHREADS) { const float cv = c[q]; sl[q] = cv / (1.0f + __expf(-cv)); }
            __syncthreads();
            const int kg = F.tid >> 6, cl = F.tid & 63, j0 = it * 64;
            float acc[16];
#pragma unroll
            for (int bb = 0; bb < 16; ++bb) acc[bb] = 0.f;
            const float* wp = w_mod + (size_t)(kg * 128) * 6144 + j0 + cl;
#pragma unroll 4
            for (int kk = 0; kk < 128; ++kk) { const float w = wp[(size_t)kk * 6144]; const int k = kg * 128 + kk;
#pragma unroll
                for (int bb = 0; bb < 16; ++bb) acc[bb] += sl[bb * D + k] * w; }
#pragma unroll
            for (int bb = 0; bb < 16; ++bb) red[(kg * 16 + bb) * 64 + cl] = acc[bb];
            __syncthreads();
#pragma unroll
            for (int q = 0; q < 2; ++q) { const int o = F.tid + 512 * q; const int bb = o >> 6, cc = o & 63; float s = b_mod[j0 + cc];
#pragma unroll
                for (int g8 = 0; g8 < 8; ++g8) s += red[(g8 * 16 + bb) * 64 + cc];
                MOD[bb * 6144 + j0 + cc] = s; }
            __syncthreads();
        } else if (it < O_WOUT) { const int i = it - O_WIN; transpose_tile(F, F.in[6], D, NCOL, (bf16_t*)(F.ws + WS_WIN), D, i % 16, i / 16); }
        else if (it < O_WQ) { const int i = it - O_WOUT; transpose_tile(F, F.in[16], D, D, (bf16_t*)(F.ws + WS_WOUT), D, i % 16, i / 16); }
        else if (it < O_U) { const int i = it - O_WQ; transpose_tile(F, F.in[17], D, D, (bf16_t*)(F.ws + WS_WQ), D, i % 16, i / 16); }
        else if (it < O_KEYS) {
            const bool isv = it >= O_V; const int i = isv ? it - O_V : it - O_U;
            for (int rr = 0; rr < 8; ++rr) { const size_t r = (size_t)i * 64 + rr * 8 + F.wave;
                quant_row_sliced((isv ? F.in[20] : F.in[19]) + r * D, F.ws + (isv ? WS_V8S : WS_U8S), NEXP, r, (float*)(F.ws + (isv ? WS_SV : WS_SU)) + r, 0, F.lane); }
        } else if (it >= O_CMP) {
            const int i = it - O_CMP;
            if (i < 64) { const int kv = i >> 5; transpose_tile(F, kv ? F.in[11] : F.in[9], 2048, 64, (bf16_t*)(F.ws + WS_W1T) + (size_t)kv * 64 * 2048, 2048, i & 31, 0); }
            else if (i < 66) { const int kv = i - 64; transpose_tile(F, kv ? F.in[12] : F.in[10], 64, 64, (bf16_t*)(F.ws + WS_W2T) + (size_t)kv * 64 * 64, 64, 0, 0); }
            else { const int kv = i - 66; const float* pe = kv ? F.in[8] : F.in[7]; const float* w1 = kv ? F.in[11] : F.in[9];
                LAS float* red = (LAS float*)F.lds; const int jj = F.tid & 63, kg = F.tid >> 6; float a = 0.f;
#pragma unroll 32
                for (int kk = 0; kk < 256; ++kk) { const int k = kg * 256 + kk; a += pe[k] * w1[(size_t)k * 64 + jj]; }
                red[kg * 64 + jj] = a; __syncthreads();
                if (F.tid < 64) { float s = 0.f;
#pragma unroll
                    for (int g8 = 0; g8 < 8; ++g8) s += red[g8 * 64 + F.tid];
                    ((float*)(F.ws + WS_PEC))[kv * 64 + F.tid] = s; }
                __syncthreads(); }
        } else {
            const int i = it - O_KEYS; const float4* src = (const float4*)F.in[18] + (size_t)i * 1024; uint2* dst = (uint2*)(F.ws + WS_KEYS) + (size_t)i * 1024;
#pragma unroll
            for (int q = 0; q < 2; ++q) { const float4 v = src[F.tid + 512 * q]; dst[F.tid + 512 * q] = make_uint2(pack2(v.x, v.y), pack2(v.z, v.w)); }
        }
    }
}

__device__ __forceinline__ void norm_mod_rows(const Frame& F, const float* x, const float* g, int sh_off, int sc_off, bf16_t* dst) {
    const float* MOD = (const float*)(F.ws + WS_MOD);
    const int gw = blockIdx.x * NWAVES + F.wave, nw = F.G * NWAVES;
    float4 vn[4];
    if (gw < T) {
#pragma unroll
        for (int i = 0; i < 4; ++i) vn[i] = ((const float4*)(x + (size_t)gw * D))[F.lane + 64 * i]; }
    for (int t = gw; t < T; t += nw) {
        const int b = t / S;
        float4 v[4]; float ss = 0.f;
#pragma unroll
        for (int i = 0; i < 4; ++i) { v[i] = vn[i]; ss += v[i].x * v[i].x + v[i].y * v[i].y + v[i].z * v[i].z + v[i].w * v[i].w; }
        { const int tn = t + nw < T ? t + nw : t;
#pragma unroll
            for (int i = 0; i < 4; ++i) vn[i] = ((const float4*)(x + (size_t)tn * D))[F.lane + 64 * i]; }
        ss = wave_sum(ss); const float rstd = rsqrtf(ss * (1.0f / D) + EPS);
#pragma unroll
        for (int i = 0; i < 4; ++i) { const int col = (F.lane + 64 * i) * 4;
            const float4 gg = *(const float4*)(g + col), sc = *(const float4*)(MOD + b * 6144 + sc_off + col), sh = *(const float4*)(MOD + b * 6144 + sh_off + col);
            const float o0 = v[i].x * rstd * gg.x * (1.f + sc.x) + sh.x, o1 = v[i].y * rstd * gg.y * (1.f + sc.y) + sh.y, o2 = v[i].z * rstd * gg.z * (1.f + sc.z) + sh.z, o3 = v[i].w * rstd * gg.w * (1.f + sc.w) + sh.w;
            *(uint2*)(dst + (size_t)t * D + col) = make_uint2(pack2(o0, o1), pack2(o2, o3)); }
    }
}

__device__ __forceinline__ void norm_mod_rows_q(const Frame& F, const float* x, const float* g, int sh_off, int sc_off, bf16_t* dst) {
    const float* MOD = (const float*)(F.ws + WS_MOD);
    const int gw = blockIdx.x * NWAVES + F.wave, nw = F.G * NWAVES;
    const bf16_t* Y = (const bf16_t*)(F.ws + WS_Y);
    float4 vn[4]; uint2 yn[4];
    if (gw < T) {
#pragma unroll
        for (int i = 0; i < 4; ++i) { vn[i] = ((const float4*)(x + (size_t)gw * D))[F.lane + 64 * i]; yn[i] = ((const uint2*)(Y + (size_t)gw * D))[F.lane + 64 * i]; } }
    for (int t = gw; t < T; t += nw) {
        const int b = t / S;
        float4 v[4]; float ss = 0.f;
#pragma unroll
        for (int i = 0; i < 4; ++i) { const int col = (F.lane + 64 * i) * 4; const float4 gt = *(const float4*)(MOD + b * 6144 + 2048 + col);
            v[i].x = vn[i].x + gt.x * bflo(yn[i].x); v[i].y = vn[i].y + gt.y * bfhi(yn[i].x); v[i].z = vn[i].z + gt.z * bflo(yn[i].y); v[i].w = vn[i].w + gt.w * bfhi(yn[i].y);
            ss += v[i].x * v[i].x + v[i].y * v[i].y + v[i].z * v[i].z + v[i].w * v[i].w; }
        { const int tn = t + nw < T ? t + nw : t;
#pragma unroll
            for (int i = 0; i < 4; ++i) { vn[i] = ((const float4*)(x + (size_t)tn * D))[F.lane + 64 * i]; yn[i] = ((const uint2*)(Y + (size_t)tn * D))[F.lane + 64 * i]; } }
        ss = wave_sum(ss); const float rstd = rsqrtf(ss * (1.0f / D) + EPS);
        float am = 0.f;
#pragma unroll
        for (int i = 0; i < 4; ++i) { const int col = (F.lane + 64 * i) * 4;
            const float4 gg = *(const float4*)(g + col), sc = *(const float4*)(MOD + b * 6144 + sc_off + col), sh = *(const float4*)(MOD + b * 6144 + sh_off + col);
            v[i].x = v[i].x * rstd * gg.x * (1.f + sc.x) + sh.x; v[i].y = v[i].y * rstd * gg.y * (1.f + sc.y) + sh.y; v[i].z = v[i].z * rstd * gg.z * (1.f + sc.z) + sh.z; v[i].w = v[i].w * rstd * gg.w * (1.f + sc.w) + sh.w;
            *(uint2*)(dst + (size_t)t * D + col) = make_uint2(pack2(v[i].x, v[i].y), pack2(v[i].z, v[i].w));
            am = fmaxf(am, fmaxf(fmaxf(fabsf(v[i].x), fabsf(v[i].y)), fmaxf(fabsf(v[i].z), fabsf(v[i].w)))); }
        am = wave_max(am); const float inv = am > 0.f ? 127.0f / am : 0.f;
        if (F.lane == 0) ((float*)(F.ws + WS_SX))[t] = am > 0.f ? am / 127.0f : 0.f;
#pragma unroll
        for (int i = 0; i < 4; ++i) { const int col = (F.lane + 64 * i) * 4; const int sl = col >> 7, off = col & 127;
            const int q0 = (int)rintf(v[i].x * inv), q1 = (int)rintf(v[i].y * inv), q2 = (int)rintf(v[i].z * inv), q3 = (int)rintf(v[i].w * inv);
            *(unsigned*)(F.ws + WS_X8S + ((size_t)sl * T + t) * 128 + off) = (unsigned)(q0 & 0xFF) | ((unsigned)(q1 & 0xFF) << 8) | ((unsigned)(q2 & 0xFF) << 16) | ((unsigned)(q3 & 0xFF) << 24); }
    }
}

__device__ __forceinline__ void p3_compress_naive(const Frame& F) {
    const bf16_t* PROJ = (const bf16_t*)(F.ws + WS_PROJ);
    LAS float* hid = (LAS float*)F.lds + F.wave * 64;
    const int gw = blockIdx.x * NWAVES + F.wave, nw = F.G * NWAVES;
    if (gw < 64) { bf16_t* dz = (bf16_t*)(F.ws + ((gw & 1) ? WS_VC : WS_KC)); dz[((size_t)(gw >> 1) * 128 + 127) * 64 + F.lane] = 0; }
    for (int u = gw; u < NB * NCMP * 2 * 2; u += nw) {
        const int kv = u & 1, g = (u >> 1) & 1, n = (u >> 2) % NCMP, b = (u >> 2) / NCMP;
        const float* pe = kv ? F.in[8] : F.in[7]; const float* w1 = kv ? F.in[11] : F.in[9]; const float* w2 = kv ? F.in[12] : F.in[10];
        const int cbase = (kv ? C_VC : C_KC) + g * 64;
        float acc = 0.f;
        for (int l = 0; l < 32; ++l) {
            const bf16_t* row = PROJ + (size_t)(b * S + 16 * n + l) * NPAD + cbase;
            for (int d = 0; d < 64; ++d) { const float a = bf2f(row[d]) + pe[l * 64 + d]; acc += a * w1[(size_t)(l * 64 + d) * 64 + F.lane]; }
        }
        hid[F.lane] = gelu_tanh(acc); lds_wave_sync();
        float o = 0.f;
        for (int j = 0; j < 64; ++j) o += hid[j] * w2[j * 64 + F.lane];
        bf16_t* dst = (bf16_t*)(F.ws + (kv ? WS_VC : WS_KC)); dst[((size_t)(b * 2 + g) * 128 + n) * 64 + F.lane] = f2bf(o);
        lds_wave_sync();
    }
}


__device__ __forceinline__ void p3_compress_mfma(const Frame& F) {
    const bf16_t* PROJ = (const bf16_t*)(F.ws + WS_PROJ);
    const int lane = F.lane, tid = F.tid, wave = F.wave, grp = lane >> 4, col = lane & 15;
    LAS float* red = (LAS float*)F.lds;
    LAS bf16_t* hid = (LAS bf16_t*)(F.lds + 32768);
    if (blockIdx.x * NWAVES + wave < 64) { const int gw = blockIdx.x * NWAVES + wave; bf16_t* dz = (bf16_t*)(F.ws + ((gw & 1) ? WS_VC : WS_KC)); dz[((size_t)(gw >> 1) * 128 + 127) * 64 + lane] = 0; }
    for (int u = blockIdx.x; u < NB * 2 * 2 * 8; u += F.G) {
        const int nt8 = u & 7, kv = (u >> 3) & 1, g = (u >> 4) & 1, b = u >> 5; const int n0 = nt8 * 16;
        const bf16_t* W1T = (const bf16_t*)(F.ws + WS_W1T) + (size_t)kv * 64 * 2048; const bf16_t* W2T = (const bf16_t*)(F.ws + WS_W2T) + (size_t)kv * 64 * 64;
        const float* pec = (const float*)(F.ws + WS_PEC) + kv * 64;
        const int cbase = (kv ? C_VC : C_KC) + g * 64;
        const int nrow = (n0 + col) < NCMP ? (n0 + col) : (NCMP - 1);
        f32x4 acc[4];
#pragma unroll
        for (int nt = 0; nt < 4; ++nt) acc[nt] = (f32x4){0.f, 0.f, 0.f, 0.f};
#pragma unroll
        for (int ks = 0; ks < 8; ++ks) { const int l = 4 * wave + (ks >> 1), d0 = (ks & 1) * 32 + 8 * grp;
            const bf16x8 af = *(const bf16x8*)(PROJ + (size_t)(b * S + 16 * nrow + l) * NPAD + cbase + d0);
#pragma unroll
            for (int nt = 0; nt < 4; ++nt) { const bf16x8 bfr = *(const bf16x8*)(W1T + (size_t)(nt * 16 + col) * 2048 + l * 64 + d0);
                acc[nt] = __builtin_amdgcn_mfma_f32_16x16x32_bf16(af, bfr, acc[nt], 0, 0, 0); } }
#pragma unroll
        for (int nt = 0; nt < 4; ++nt)
#pragma unroll
            for (int rg = 0; rg < 4; ++rg) red[(wave * 16 + 4 * grp + rg) * 64 + nt * 16 + col] = acc[nt][rg];
        __syncthreads();
#pragma unroll
        for (int q = 0; q < 2; ++q) { const int idx = tid + 512 * q; float s = pec[idx & 63];
#pragma unroll
            for (int w = 0; w < 8; ++w) s += red[w * 1024 + idx];
            hid[idx] = f2bf(gelu_tanh(s)); }
        __syncthreads();
        if (wave < 4) { f32x4 o = (f32x4){0.f, 0.f, 0.f, 0.f};
#pragma unroll
            for (int ks = 0; ks < 2; ++ks) { const bf16x8 af = *(const LAS bf16x8*)(hid + col * 64 + ks * 32 + 8 * grp); const bf16x8 bfr = *(const bf16x8*)(W2T + (size_t)(wave * 16 + col) * 64 + ks * 32 + 8 * grp);
                o = __builtin_amdgcn_mfma_f32_16x16x32_bf16(af, bfr, o, 0, 0, 0); }
            bf16_t* dst = (bf16_t*)(F.ws + (kv ? WS_VC : WS_KC));
#pragma unroll
            for (int rg = 0; rg < 4; ++rg) { const int n = n0 + 4 * grp + rg; if (n < NCMP) dst[((size_t)(b * 2 + g) * 128 + n) * 64 + wave * 16 + col] = f2bf(o[rg]); } }
        __syncthreads();
    }
}

__device__ __forceinline__ void dot4_row(const bf16_t* krow, const LAS float* qs, float (&acc)[4]) {
    const uint4* kr = (const uint4*)krow;
#pragma unroll 1
    for (int c = 0; c < 8; ++c) { asm volatile("" ::: "memory"); const uint4 w = kr[c]; const unsigned ww[4] = {w.x, w.y, w.z, w.w};
#pragma unroll
        for (int e = 0; e < 4; ++e) { const float k0 = bflo(ww[e]), k1 = bfhi(ww[e]); const int d = c * 8 + e * 2;
#pragma unroll
            for (int r = 0; r < 4; ++r) acc[r] += qs[r * 64 + d] * k0 + qs[r * 64 + d + 1] * k1; } }
}
__device__ __forceinline__ void p4_attn_naive(const Frame& F) {
    const bf16_t* PROJ = (const bf16_t*)(F.ws + WS_PROJ); const bf16_t* KC = (const bf16_t*)(F.ws + WS_KC); const bf16_t* VC = (const bf16_t*)(F.ws + WS_VC);
    bf16_t* OATT = (bf16_t*)(F.ws + WS_OATT); const float* rel = F.in[21];
    LAS float* wl = (LAS float*)F.lds + F.wave * (256 + 512 + 2048 + 16);
    LAS float* qs = wl; LAS float* pc = wl + 256; LAS float* ps = wl + 768; LAS int* pbase = (LAS int*)(wl + 768 + 2048);
    const int gw = blockIdx.x * NWAVES + F.wave, nw = F.G * NWAVES, lane = F.lane;
    for (int u = gw; u < T * 2; u += nw) {
        const int g = u & 1, tok = u >> 1, b = tok / S, t = tok % S;
        const bf16_t* prow = PROJ + (size_t)tok * NPAD;
#pragma unroll
        for (int r = 0; r < 4; ++r) qs[r * 64 + lane] = bf2f(prow[C_Q + (g * 4 + r) * 64 + lane]) * 0.125f;
        lds_wave_sync();
        const int nv = t >= 31 ? ((t - 31) >> 4) + 1 : 0;
        float sc[2][4]; bool va[2];
#pragma unroll
        for (int i = 0; i < 2; ++i) { const int n = lane + 64 * i; va[i] = n < nv; float a[4] = {0.f, 0.f, 0.f, 0.f};
            if (va[i]) { dot4_row(KC + ((size_t)(b * 2 + g) * 128 + n) * 64, qs, a); const int bk = rel_bucket(t - (16 * n + 31));
#pragma unroll
                for (int r = 0; r < 4; ++r) a[r] += rel[bk * 8 + g * 4 + r]; }
#pragma unroll
            for (int r = 0; r < 4; ++r) sc[i][r] = va[i] ? a[r] : -1e30f; }
        float ocmp[4];
#pragma unroll
        for (int r = 0; r < 4; ++r) { const float m = wave_max(fmaxf(sc[0][r], sc[1][r]));
            const float e0 = va[0] ? __expf(sc[0][r] - m) : 0.f, e1 = va[1] ? __expf(sc[1][r] - m) : 0.f; const float sum = wave_sum(e0 + e1);
            const float inv = nv > 0 ? 1.0f / sum : 0.f; pc[r * 128 + lane] = e0 * inv; pc[r * 128 + 64 + lane] = e1 * inv; }
        lds_wave_sync();
        { float o[4] = {0.f, 0.f, 0.f, 0.f}; const bf16_t* vb = VC + ((size_t)(b * 2 + g) * 128) * 64 + lane;
            for (int n = 0; n < nv; ++n) { const float v = bf2f(vb[n * 64]);
#pragma unroll
                for (int r = 0; r < 4; ++r) o[r] += pc[r * 128 + n] * v; }
#pragma unroll
            for (int r = 0; r < 4; ++r) ocmp[r] = o[r]; }
        const int cur = t >> 6; float val;
        { const int j = lane & 31; float imp = 0.f;
#pragma unroll
            for (int r = 0; r < 4; ++r) for (int n = 4 * j - 1; n <= 4 * j + 3; ++n) if (n >= 0 && n < NCMP) imp += pc[r * 128 + n];
            const bool forced = (j == 0) || (j == cur) || (j == cur - 1); const bool allowed = j <= cur;
            val = forced ? 1e4f : (allowed ? imp : -INFINITY); }
        int rank = 0;
        for (int jp = 0; jp < 32; ++jp) { const float vp = __shfl(val, jp); rank += ((vp > val) || (vp == val && jp < (lane & 31))) ? 1 : 0; }
        unsigned selmask = (unsigned)(__ballot(lane < 32 && rank < 8) & 0xFFFFFFFFull);
        float oslc[4], owin[4];
#pragma unroll
        for (int br = 0; br < 2; ++br) {
            const int ck = br == 0 ? C_KS : C_KW, cv = br == 0 ? C_VS : C_VW;
            unsigned mk = selmask;
#pragma unroll 1
            for (int c = 0; c < 8; ++c) {
                int kpos, bs;
                if (br == 0) { const int j = __builtin_ctz(mk | 0x80000000u); mk &= mk - 1; bs = 64 * j; } else { bs = t - 511 + 64 * c; }
                kpos = bs + lane; if (lane == 0) pbase[c] = bs;
                const int dist = t - kpos; const bool vv = (dist >= 0) && (kpos >= 0) && (kpos < S);
                float a[4] = {0.f, 0.f, 0.f, 0.f};
                if (vv) { dot4_row(PROJ + (size_t)(b * S + kpos) * NPAD + ck + g * 64, qs, a); const int bk = rel_bucket(dist);
#pragma unroll
                    for (int r = 0; r < 4; ++r) a[r] += rel[bk * 8 + g * 4 + r]; }
#pragma unroll
                for (int r = 0; r < 4; ++r) ps[r * 512 + c * 64 + lane] = vv ? a[r] : -1e30f;
            }
            lds_wave_sync();
#pragma unroll 1
            for (int r = 0; r < 4; ++r) { float m = -1e30f;
#pragma unroll
                for (int c = 0; c < 8; ++c) m = fmaxf(m, ps[r * 512 + c * 64 + lane]);
                m = wave_max(m); float e[8], sum = 0.f;
#pragma unroll
                for (int c = 0; c < 8; ++c) { const float sv = ps[r * 512 + c * 64 + lane]; e[c] = sv > -1e29f ? __expf(sv - m) : 0.f; sum += e[c]; }
                sum = wave_sum(sum); const float inv = sum > 0.f ? 1.0f / sum : 0.f;
#pragma unroll
                for (int c = 0; c < 8; ++c) ps[r * 512 + c * 64 + lane] = e[c] * inv; }
            lds_wave_sync();
            float o[4] = {0.f, 0.f, 0.f, 0.f};
#pragma unroll 1
            for (int c = 0; c < 8; ++c) {
                const int bsc = pbase[c];
                for (int kk = 0; kk < 64; ++kk) { const int kpos = bsc + kk; if (kpos < 0 || kpos > t) continue;
                    const float v = bf2f(PROJ[(size_t)(b * S + kpos) * NPAD + cv + g * 64 + lane]);
#pragma unroll
                    for (int r = 0; r < 4; ++r) o[r] += ps[r * 512 + c * 64 + kk] * v; } }
            lds_wave_sync();
#pragma unroll
            for (int r = 0; r < 4; ++r) { if (br == 0) oslc[r] = o[r]; else owin[r] = o[r]; }
        }
#pragma unroll
        for (int r = 0; r < 4; ++r) { const int h = g * 4 + r;
            const float g0 = sigmoidf_(bf2f(prow[C_GT + h * 3 + 0])), g1 = sigmoidf_(bf2f(prow[C_GT + h * 3 + 1])), g2 = sigmoidf_(bf2f(prow[C_GT + h * 3 + 2]));
            OATT[(size_t)tok * 512 + h * 64 + lane] = f2bf(g0 * ocmp[r] + g1 * oslc[r] + g2 * owin[r]); }
    }
}


constexpr float LOG2E = 1.4426950408889634f;
constexpr int AT_KC = 0, AT_VC = 16384, AT_KV = 32768  , AT_BTAB = 65536, AT_IMP = 69888, AT_SEL = 78336, AT_OUT = 78592  , AT_END = 78592 + 65536;
constexpr int BT_STRIDE = 132;
__device__ __forceinline__ int tile_off(int row, int chunk) { return row * 128 + ((chunk ^ (row & 7)) << 4); }
__device__ __forceinline__ bf16x8 mk_frag(unsigned a, unsigned b, unsigned c, unsigned d) { u32x4v v = {a, b, c, d}; return __builtin_bit_cast(bf16x8, v); }
struct LaneOffs { int koff[2]; int voff[4]; int soff; };
__device__ __forceinline__ LaneOffs lane_offs(int lane, int tid) {
    LaneOffs L; const int grp = lane >> 4, rowi = lane & 15, q4 = rowi >> 2, p = lane & 3;
#pragma unroll
    for (int ks = 0; ks < 2; ++ks) L.koff[ks] = tile_off(rowi, ks * 4 + grp);
#pragma unroll
    for (int dt = 0; dt < 4; ++dt) L.voff[dt] = tile_off(4 * grp + q4, 2 * dt + (p >> 1)) + 8 * (p & 1);
    L.soff = tile_off(tid >> 3, tid & 7); return L;
}
__device__ __forceinline__ bf16x8 vfrag_read(const LAS unsigned char* vt, int voff_dt, int row0) {
    const s16x4 a = __builtin_amdgcn_ds_read_tr16_b64_v4i16((LAS s16x4*)(vt + voff_dt + row0 * 128));
    const s16x4 b = __builtin_amdgcn_ds_read_tr16_b64_v4i16((LAS s16x4*)(vt + voff_dt + row0 * 128 + 2048));
    bf16x8 f = {a[0], a[1], a[2], a[3], b[0], b[1], b[2], b[3]}; return f;
}


struct AttnState {
    f32x4 o[4][2]; float m[2], l[2];
};

__device__ __forceinline__ void at_qk(f32x4 (&sacc)[4][2], const LAS unsigned char* kt_lds, const bf16x8 (&qf)[2][2], const LaneOffs& Lu) {
    int ln_ = threadIdx.x & 63; asm volatile("" : "+v"(ln_)); const LaneOffs L = lane_offs(ln_, 0); (void)Lu;
#pragma unroll
    for (int kt = 0; kt < 4; ++kt) { sacc[kt][0] = (f32x4){0.f, 0.f, 0.f, 0.f}; sacc[kt][1] = (f32x4){0.f, 0.f, 0.f, 0.f}; }
#pragma unroll
    for (int kt = 0; kt < 4; ++kt)
#pragma unroll
        for (int ks = 0; ks < 2; ++ks) { const bf16x8 kf = *(const LAS bf16x8*)(kt_lds + L.koff[ks] + kt * 2048);
            sacc[kt][0] = __builtin_amdgcn_mfma_f32_16x16x32_bf16(kf, qf[0][ks], sacc[kt][0], 0, 0, 0);
            sacc[kt][1] = __builtin_amdgcn_mfma_f32_16x16x32_bf16(kf, qf[1][ks], sacc[kt][1], 0, 0, 0); }
}
__device__ __forceinline__ void at_pv(AttnState& st, const LAS unsigned char* vt_lds, const bf16x8 (&pf)[2][2], const LaneOffs& Lu) {
    int ln_ = threadIdx.x & 63; asm volatile("" : "+v"(ln_)); const LaneOffs L = lane_offs(ln_, 0); (void)Lu;
#pragma unroll
    for (int ks = 0; ks < 2; ++ks)
#pragma unroll
        for (int dt = 0; dt < 4; ++dt) { const bf16x8 vf = vfrag_read(vt_lds, L.voff[dt], 32 * ks);
            st.o[dt][0] = __builtin_amdgcn_mfma_f32_16x16x32_bf16(vf, pf[0][ks], st.o[dt][0], 0, 0, 0);
            st.o[dt][1] = __builtin_amdgcn_mfma_f32_16x16x32_bf16(vf, pf[1][ks], st.o[dt][1], 0, 0, 0); }
}
template <int BR>
__device__ __forceinline__ void at_softmax(f32x4 (&sacc)[4][2], bf16x8 (&pf)[2][2], const LAS float* btab_h, const int (&tq)[2], const unsigned (&sel)[2], int j, bool near, AttnState& st, int lane) {
    const int grp = lane >> 4, kbase = 64 * j;
    const float SC = 0.125f * LOG2E; const float bfar = btab_h[128];
    const int cur_blk = tq[0] >> 6;
    const bool full = BR == 0 ? (j == cur_blk) : (j == cur_blk || j + 8 == cur_blk);
    const bool fast = !near && !full;
    const bool selq[2] = {BR == 0 ? ((sel[0] >> j) & 1u) != 0u : true, BR == 0 ? ((sel[1] >> j) & 1u) != 0u : true};
    float tmax[2];
    if (fast) {
#pragma unroll
        for (int qt = 0; qt < 2; ++qt) {
            float r0 = fmaxf(fmaxf(sacc[0][qt][0], sacc[0][qt][1]), fmaxf(sacc[0][qt][2], sacc[0][qt][3]));
#pragma unroll
            for (int kt = 1; kt < 4; ++kt) r0 = fmaxf(r0, fmaxf(fmaxf(sacc[kt][qt][0], sacc[kt][qt][1]), fmaxf(sacc[kt][qt][2], sacc[kt][qt][3])));
            tmax[qt] = selq[qt] ? r0 * SC + bfar : -1e30f; }
    } else {
#pragma unroll
        for (int qt = 0; qt < 2; ++qt) {
            float tm = -1e30f;
            int d0 = tq[qt] - 4 * grp - kbase; asm volatile("" : "+v"(d0));
#pragma unroll
            for (int kt = 0; kt < 4; ++kt)
#pragma unroll
                for (int rg = 0; rg < 4; ++rg) { const int c = kt * 16 + rg;
                    float bias = bfar; if (near) { const int dist = d0 - c; const int dd = dist < 0 ? 0 : (dist > 128 ? 128 : dist); bias = btab_h[dd]; }
                    const bool valid = BR == 0 ? (selq[qt] && d0 >= c) : (d0 >= c && d0 < 512 + c);
                    const float sx = sacc[kt][qt][rg] * SC + bias; const float s = valid ? sx : -1e30f; sacc[kt][qt][rg] = s; tm = fmaxf(tm, s); }
            tmax[qt] = tm; }
    }
    { const float a0 = __shfl_xor(tmax[0], 16), a1 = __shfl_xor(tmax[1], 16); tmax[0] = fmaxf(tmax[0], a0); tmax[1] = fmaxf(tmax[1], a1); }
    { const float a0 = __shfl_xor(tmax[0], 32), a1 = __shfl_xor(tmax[1], 32); tmax[0] = fmaxf(tmax[0], a0); tmax[1] = fmaxf(tmax[1], a1); }
    float alpha[2], muse[2];
#pragma unroll
    for (int qt = 0; qt < 2; ++qt) { const float mnew = fmaxf(st.m[qt], tmax[qt]); alpha[qt] = __builtin_amdgcn_exp2f(st.m[qt] - mnew); st.m[qt] = mnew; muse[qt] = mnew < -1e29f ? 0.f : mnew; }
#pragma unroll
    for (int qt = 0; qt < 2; ++qt) { const float mul = fast ? SC : 1.0f; const float add = fast ? (selq[qt] ? bfar - muse[qt] : -1e30f) : -muse[qt];
#pragma unroll
        for (int kt = 0; kt < 4; ++kt)
#pragma unroll
            for (int rg = 0; rg < 4; ++rg) sacc[kt][qt][rg] = __builtin_amdgcn_exp2f(sacc[kt][qt][rg] * mul + add); }
#pragma unroll
    for (int qt = 0; qt < 2; ++qt) {
        float ls = 0.f; unsigned pk[4][2];
#pragma unroll
        for (int kt = 0; kt < 4; ++kt) { ls += (sacc[kt][qt][0] + sacc[kt][qt][1]) + (sacc[kt][qt][2] + sacc[kt][qt][3]);
            pk[kt][0] = pg8::cvt_pk_bf16(sacc[kt][qt][0], sacc[kt][qt][1]); pk[kt][1] = pg8::cvt_pk_bf16(sacc[kt][qt][2], sacc[kt][qt][3]); }
        st.l[qt] = st.l[qt] * alpha[qt] + ls;
        pf[qt][0] = mk_frag(pk[0][0], pk[0][1], pk[1][0], pk[1][1]); pf[qt][1] = mk_frag(pk[2][0], pk[2][1], pk[3][0], pk[3][1]); }
    if (!__all(alpha[0] == 1.0f && alpha[1] == 1.0f)) {
#pragma unroll
        for (int qt = 0; qt < 2; ++qt)
#pragma unroll
            for (int dt = 0; dt < 4; ++dt) st.o[dt][qt] *= alpha[qt]; }
    __builtin_amdgcn_sched_barrier(0);
}
template <int BR>
__device__ __forceinline__ void attn_tile(const LAS unsigned char* kt_lds, const LAS unsigned char* vt_lds, const LAS float* btab_h, const bf16x8 (&qf)[2][2], const int (&tq)[2], const unsigned (&sel)[2],
                                          int j, bool near, AttnState& st, int lane, const LaneOffs& L, LAS unsigned char* F_lds_, unsigned wsel = 0xFFFFFFFFu) {
#if defined(PROBE_STAMP) && PROBE_LEVEL >= 2
    STAMP_DECL; STAMP_START();
#define TSTAMP(k) STAMP(k)
#else
#define TSTAMP(k) do {} while (0)
#endif
    if (BR == 0 && ((wsel >> j) & 1u) == 0u) return;
    f32x4 sacc[4][2]; bf16x8 pf[2][2];
    at_qk(sacc, kt_lds, qf, L);
    __builtin_amdgcn_sched_barrier(0);
    TSTAMP(0);
#if defined(PROBE_STAMP) && PROBE_LEVEL >= 3
    { float x_ = sacc[3][1][3]; asm volatile("" :: "v"(x_)); }
    TSTAMP(3);
#endif
    at_softmax<BR>(sacc, pf, btab_h, tq, sel, j, near, st, lane);
    TSTAMP(1);
    at_pv(st, vt_lds, pf, L);
    TSTAMP(2);
#undef TSTAMP
}

template <int BR>
__device__ __forceinline__ void attn_branch(const Frame& F, const bf16_t* PROJ, int b, int g, int t0, unsigned tiles  , const LAS float* btab_h,
                                            const bf16x8 (&qf)[2][2], const int (&tq)[2], const unsigned (&sel)[2], const float (&gate)[2], const LaneOffs& L) {
    const int lane = F.lane, tid = F.tid;
    unsigned wsel = sel[0] | sel[1];
#pragma unroll
    for (int o = 32; o >= 1; o >>= 1) wsel |= __shfl_xor(wsel, o);
    wsel = __builtin_amdgcn_readfirstlane(wsel);
    const int ck = (BR == 0 ? C_KS : C_KW) + g * 64, cv = (BR == 0 ? C_VS : C_VW) + g * 64;
    const int srow = tid >> 3, sch = tid & 7;
    LAS unsigned char* F_lds_ = F.lds; STAMP_DECL; STAMP_START();
    AttnState st;
#pragma unroll
    for (int dt = 0; dt < 4; ++dt) { st.o[dt][0] = (f32x4){0.f, 0.f, 0.f, 0.f}; st.o[dt][1] = (f32x4){0.f, 0.f, 0.f, 0.f}; }
    st.m[0] = st.m[1] = -1e30f; st.l[0] = st.l[1] = 0.f;
    unsigned rem = tiles; int cur = 0;
#ifdef PROBE_SHALLOW
    u32x4v rk0, rv0;
#else
    u32x4v rk0, rv0, rk1, rv1;
#endif
    const bf16_t* srcb = PROJ + (size_t)(b * S + srow) * NPAD + sch * 8;
#define AT_LOAD(RK, RV, jj) do { const bf16_t* rowp = srcb + (size_t)(64 * (jj)) * NPAD; RK = *(const u32x4v*)(rowp + ck); RV = *(const u32x4v*)(rowp + cv); } while (0)
#define AT_WRITE(RK, RV, bufi) do { *(LAS u32x4v*)(F.lds + AT_KV + (bufi) * 16384 + L.soff) = RK; *(LAS u32x4v*)(F.lds + AT_KV + (bufi) * 16384 + 8192 + L.soff) = RV; } while (0)
#define AT_COMPUTE(jj) do { STAMP_COUNT(4); const bool near = (t0 + 8 * F.wave) - (64 * (jj) + 63) < 128; \
        attn_tile<BR>(F.lds + AT_KV + cur * 16384, F.lds + AT_KV + cur * 16384 + 8192, btab_h, qf, tq, sel, (jj), near, st, lane, L, F.lds, wsel); } while (0)
#ifdef PROBE_SHALLOW
    { int j = __builtin_ctz(rem); rem &= rem - 1;
      AT_LOAD(rk0, rv0, j); AT_WRITE(rk0, rv0, 0);
      __syncthreads();
      for (;;) {
          int jn = j; const bool hn = rem != 0u; if (hn) { jn = __builtin_ctz(rem); rem &= rem - 1; }
          STAMP(12);
          AT_LOAD(rk0, rv0, jn);
          AT_COMPUTE(j);
          STAMP(13);
          AT_WRITE(rk0, rv0, cur ^ 1);
          asm volatile("s_waitcnt lgkmcnt(0)" ::: "memory");
          STAMP(8);
          __syncthreads(); cur ^= 1;
          STAMP(9);
          if (!hn) break;
          j = jn; } }
#else
    int j = __builtin_ctz(rem); rem &= rem - 1;
    AT_LOAD(rk0, rv0, j); AT_WRITE(rk0, rv0, 0);
    int j1 = j; bool h1 = rem != 0u; if (h1) { j1 = __builtin_ctz(rem); rem &= rem - 1; }
    AT_LOAD(rk0, rv0, j1);
    __syncthreads();
    for (;;) {
        int j2 = j1; bool h2 = rem != 0u; if (h2) { j2 = __builtin_ctz(rem); rem &= rem - 1; }
        AT_LOAD(rk1, rv1, j2);
        AT_COMPUTE(j);
        AT_WRITE(rk0, rv0, cur ^ 1);
        __syncthreads(); cur ^= 1;
        if (!h1) break;
        int j3 = j2; bool h3 = rem != 0u; if (h3) { j3 = __builtin_ctz(rem); rem &= rem - 1; }
        AT_LOAD(rk0, rv0, j3);
        AT_COMPUTE(j1);
        AT_WRITE(rk1, rv1, cur ^ 1);
        __syncthreads(); cur ^= 1;
        if (!h2) break;
        j = j2; j1 = j3; h1 = h3;
    }
#endif
    STAMP(5 + BR);
#undef AT_LOAD
#undef AT_WRITE
#undef AT_COMPUTE
    int pob = AT_OUT + tid * 4; asm volatile("" : "+v"(pob));
    LAS float* po = (LAS float*)(F.lds + pob);
#pragma unroll
    for (int qt = 0; qt < 2; ++qt) { float l = st.l[qt]; l += __shfl_xor(l, 16); l += __shfl_xor(l, 32); const float sc = l > 0.f ? gate[qt] / l : 0.f;
#pragma unroll
        for (int dt = 0; dt < 4; ++dt)
#pragma unroll
            for (int e = 0; e < 4; ++e) po[((qt * 4 + dt) * 4 + e) * 512] += st.o[dt][qt][e] * sc; }
}


template <int BR>
__device__ __forceinline__ void attn_branch_stag(const Frame& F, const bf16_t* PROJ, int b, int g, int t0, unsigned tiles, const LAS float* btab_h,
                                                 const bf16x8 (&qf)[2][2], const int (&tq)[2], const unsigned (&sel)[2], int hcol  , const LaneOffs& L) {
    const int lane = F.lane, tid = F.tid;
    const bool isB = F.wave >= 4;
    const int ck = (BR == 0 ? C_KS : C_KW) + g * 64, cv = (BR == 0 ? C_VS : C_VW) + g * 64;
    const int srow = tid >> 3, sch = tid & 7;
    AttnState st;
#pragma unroll
    for (int dt = 0; dt < 4; ++dt) { st.o[dt][0] = (f32x4){0.f, 0.f, 0.f, 0.f}; st.o[dt][1] = (f32x4){0.f, 0.f, 0.f, 0.f}; }
    st.m[0] = st.m[1] = -1e30f; st.l[0] = st.l[1] = 0.f;
    const bf16_t* srcb = PROJ + (size_t)(b * S + srow) * NPAD + sch * 8;
    LAS unsigned char* KB = F.lds + AT_KV;
#define SG_LOADK(R, jj) do { R = *(const u32x4v*)(srcb + (size_t)(64 * (jj)) * NPAD + ck); } while (0)
#define SG_LOADV(R, jj) do { R = *(const u32x4v*)(srcb + (size_t)(64 * (jj)) * NPAD + cv); } while (0)
#define SG_BAR() do { asm volatile("s_waitcnt lgkmcnt(0)" ::: "memory"); __builtin_amdgcn_s_barrier(); asm volatile("" ::: "memory"); } while (0)
    unsigned rem = tiles;
    int j0 = __builtin_ctz(rem); rem &= rem - 1;
    bool h1 = rem != 0u; int j1 = j0; if (h1) { j1 = __builtin_ctz(rem); rem &= rem - 1; }
    bool h2 = rem != 0u; int j2 = j1; if (h2) { j2 = __builtin_ctz(rem); rem &= rem - 1; }
    u32x4v rk, rv;
    { u32x4v a, c2, d2; SG_LOADK(a, j0); SG_LOADV(c2, j0); SG_LOADK(d2, j1);
      *(LAS u32x4v*)(KB + L.soff) = a; *(LAS u32x4v*)(KB + 16384 + L.soff) = c2; *(LAS u32x4v*)(KB + 8192 + L.soff) = d2; }
    SG_LOADK(rk, j2); SG_LOADV(rv, j1);
    SG_BAR();
    f32x4 sacc[4][2]; bf16x8 pf[2][2];
    at_qk(sacc, KB, qf, L);
    if (isB) SG_BAR();
    int i = 0;
    for (;;) {
        { const bool near = (t0 + 8 * F.wave) - (64 * j0 + 63) < 128; at_softmax<BR>(sacc, pf, btab_h, tq, sel, j0, near, st, lane); }
        SG_BAR();
        at_pv(st, KB + 16384 + (i & 1) * 8192, pf, L);
        if (h1) at_qk(sacc, KB + ((i + 1) & 1) * 8192, qf, L);
        *(LAS u32x4v*)(KB + (i & 1) * 8192 + L.soff) = rk; *(LAS u32x4v*)(KB + 16384 + ((i + 1) & 1) * 8192 + L.soff) = rv;
        bool h3 = rem != 0u; int j3 = j2; if (h3) { j3 = __builtin_ctz(rem); rem &= rem - 1; }
        SG_LOADK(rk, j3); SG_LOADV(rv, j2);
        SG_BAR();
        if (!h1) break;
        j0 = j1; j1 = j2; j2 = j3; h1 = h2; h2 = h3; ++i;
    }
    if (!isB) SG_BAR();
#undef SG_LOADK
#undef SG_LOADV
#undef SG_BAR
    int pob = AT_OUT + tid * 4; asm volatile("" : "+v"(pob));
    LAS float* po = (LAS float*)(F.lds + pob);
#pragma unroll
    for (int qt = 0; qt < 2; ++qt) { float l = st.l[qt]; l += __shfl_xor(l, 16); l += __shfl_xor(l, 32);
        const float gq = sigmoidf_(bf2f(PROJ[(size_t)(b * S + tq[qt]) * NPAD + C_GT + hcol * 3 + 1 + BR]));
        const float sc = l > 0.f ? gq / l : 0.f;
#pragma unroll
        for (int dt = 0; dt < 4; ++dt)
#pragma unroll
            for (int e = 0; e < 4; ++e) po[((qt * 4 + dt) * 4 + e) * 512] += st.o[dt][qt][e] * sc; }
}

template <int MODE>
__device__ __forceinline__ void p4_attn_mfma_t(const Frame& F) {
    const bf16_t* PROJ = (const bf16_t*)(F.ws + WS_PROJ); const bf16_t* KC = (const bf16_t*)(F.ws + WS_KC); const bf16_t* VC = (const bf16_t*)(F.ws + WS_VC);
    bf16_t* OATT = (bf16_t*)(F.ws + (MODE == 0 ? WS_OATT : WS_H)); const float* rel = F.in[21];
    const int lane = F.lane, tid = F.tid, wave = F.wave, grp = lane >> 4, col = lane & 15, qi = col >> 2, r = col & 3;
    LAS float* btab = (LAS float*)(F.lds + AT_BTAB); LAS float* impq = (LAS float*)(F.lds + AT_IMP); LAS unsigned* selm = (LAS unsigned*)(F.lds + AT_SEL);
    const LaneOffs L = lane_offs(lane, tid);
    for (int i = tid; i < 8 * 129; i += NTHREADS) { const int hh = i / 129, dd = i % 129; btab[hh * BT_STRIDE + dd] = rel[rel_bucket(dd) * 8 + hh] * LOG2E; }
    __syncthreads();
    LAS unsigned char* F_lds_ = F.lds; STAMP_DECL;
#ifdef PROBE_STAMP
    if (tid < 16) ((volatile LAS unsigned*)(F.lds + LDS_MISC_OFF + 128))[tid] = 0u;
    __syncthreads();
#endif
    STAMP_START();
    for (int uu = blockIdx.x; uu < 1024; uu += F.G) {
        int qb, bg;
        if (F.G == 256) { const int round = uu >> 8, k = uu & 255; const int a = k >> 5; bg = k & 31;
            qb = (a == 0) ? (round == 0 ? 25 : round == 1 ? 23 : round == 2 ? 17 : 0) : (a == 1) ? (round == 0 ? 27 : round == 1 ? 19 : round == 2 ? 18 : 1) : (a == 2) ? (round == 0 ? 31 : round == 1 ? 13 : round == 2 ? 12 : 5)
               : (a == 3) ? (round == 0 ? 26 : round == 1 ? 21 : round == 2 ? 15 : 2) : (a == 4) ? (round == 0 ? 30 : round == 1 ? 22 : round == 2 ? 8 : 3) : (a == 5) ? (round == 0 ? 28 : round == 1 ? 20 : round == 2 ? 9 : 4)
               : (a == 6) ? (round == 0 ? 29 : round == 1 ? 14 : round == 2 ? 10 : 6) : (round == 0 ? 24 : round == 1 ? 16 : round == 2 ? 11 : 7); }
        else { qb = 31 - (uu >> 5); bg = uu & 31; }
        const int b = bg >> 1, g = bg & 1, t0 = qb * 64, h = g * 4 + r;
        const LAS float* btab_h = btab + h * BT_STRIDE;
        int tq[2]; bf16x8 qf[2][2]; float gate[3][2];
#pragma unroll
        for (int qt = 0; qt < 2; ++qt) { tq[qt] = t0 + 8 * wave + 4 * qt + qi; const bf16_t* prow = PROJ + (size_t)(b * S + tq[qt]) * NPAD;
#pragma unroll
            for (int ks = 0; ks < 2; ++ks) qf[qt][ks] = *(const bf16x8*)(prow + C_Q + h * 64 + ks * 32 + 8 * grp);
#pragma unroll
            for (int jg = 0; jg < 3; ++jg) gate[jg][qt] = sigmoidf_(bf2f(prow[C_GT + h * 3 + jg])); }
#pragma unroll
        for (int i = 0; i < 2; ++i) { const int c2 = tid + 512 * i, row = c2 >> 3, ch = c2 & 7; const size_t src = ((size_t)(b * 2 + g) * 128 + row) * 64 + ch * 8;
            *(LAS u32x4v*)(F.lds + AT_KC + L.soff + 8192 * i) = *(const u32x4v*)(KC + src); *(LAS u32x4v*)(F.lds + AT_VC + L.soff + 8192 * i) = *(const u32x4v*)(VC + src); }
        __syncthreads();
#ifndef AT_SKIP_CMP
        {
            const int nvmax = t0 + 63 >= 31 ? ((t0 + 63 - 31) >> 4) + 1 : 0;
            const float SC = 0.125f * LOG2E; const int srcl = (lane + 48) & 63;
            int pob = AT_OUT + tid * 4; asm volatile("" : "+v"(pob));
            LAS float* po = (LAS float*)(F.lds + pob);
#pragma unroll
            for (int qt = 0; qt < 2; ++qt) {
                f32x4 sa[8];
#pragma unroll
                for (int kt = 0; kt < 8; ++kt) sa[kt] = (f32x4){0.f, 0.f, 0.f, 0.f};
#pragma unroll
                for (int kt = 0; kt < 8; ++kt) if (kt * 16 < nvmax) {
#pragma unroll
                    for (int ks = 0; ks < 2; ++ks) { const bf16x8 kf = *(const LAS bf16x8*)(F.lds + AT_KC + L.koff[ks] + kt * 2048);
                        sa[kt] = __builtin_amdgcn_mfma_f32_16x16x32_bf16(kf, qf[qt][ks], sa[kt], 0, 0, 0); } }
                __builtin_amdgcn_sched_barrier(0);
                int d0 = tq[qt] - 31 - 64 * grp; asm volatile("" : "+v"(d0));
                float mx = -1e30f;
#pragma unroll
                for (int kt = 0; kt < 8; ++kt)
#pragma unroll
                    for (int rg = 0; rg < 4; ++rg) { const int c = 256 * kt + 16 * rg; const int dist = d0 - c; const int dd = dist < 0 ? 0 : (dist > 128 ? 128 : dist);
                        const float sx = sa[kt][rg] * SC + btab_h[dd]; const float s = d0 >= c ? sx : -1e30f; sa[kt][rg] = s; mx = fmaxf(mx, s); }
                mx = fmaxf(mx, __shfl_xor(mx, 16)); mx = fmaxf(mx, __shfl_xor(mx, 32));
                float sum = 0.f;
#pragma unroll
                for (int kt = 0; kt < 8; ++kt)
#pragma unroll
                    for (int rg = 0; rg < 4; ++rg) { const int c = 256 * kt + 16 * rg; const float ex = __builtin_amdgcn_exp2f(sa[kt][rg] - mx); const float e = d0 >= c ? ex : 0.f; sa[kt][rg] = e; sum += e; }
                __builtin_amdgcn_sched_barrier(0);
                sum += __shfl_xor(sum, 16); sum += __shfl_xor(sum, 32);
                const float inv = sum > 0.f ? 1.0f / sum : 0.f;
                float prev3 = 0.f;
#pragma unroll
                for (int kt = 0; kt < 8; ++kt) { const float p3 = sa[kt][3] * inv; const float part = (sa[kt][0] * inv + sa[kt][1] * inv) + (sa[kt][2] * inv + p3);
                    const float xa = __shfl(p3, srcl), xb = __shfl(prev3, srcl); float tot = part + (grp >= 1 ? xa : xb);
                    tot += __shfl_xor(tot, 1); tot += __shfl_xor(tot, 2);
                    if (r == 0) impq[(8 * wave + 4 * qt + qi) * 33 + 4 * kt + grp] = tot;
                    prev3 = p3; }
                __builtin_amdgcn_sched_barrier(0);
                f32x4 oc[4];
#pragma unroll
                for (int dt = 0; dt < 4; ++dt) oc[dt] = (f32x4){0.f, 0.f, 0.f, 0.f};
#pragma unroll
                for (int ks = 0; ks < 4; ++ks) if (ks * 32 < nvmax) {
                    const bf16x8 pfr = mk_frag(pg8::cvt_pk_bf16(sa[2 * ks][0], sa[2 * ks][1]), pg8::cvt_pk_bf16(sa[2 * ks][2], sa[2 * ks][3]),
                                               pg8::cvt_pk_bf16(sa[2 * ks + 1][0], sa[2 * ks + 1][1]), pg8::cvt_pk_bf16(sa[2 * ks + 1][2], sa[2 * ks + 1][3]));
#pragma unroll
                    for (int dt = 0; dt < 4; ++dt) { const bf16x8 vf = vfrag_read(F.lds + AT_VC, L.voff[dt], 32 * ks); oc[dt] = __builtin_amdgcn_mfma_f32_16x16x32_bf16(vf, pfr, oc[dt], 0, 0, 0); } }
                const float scq = inv * gate[0][qt];
#pragma unroll
                for (int dt = 0; dt < 4; ++dt)
#pragma unroll
                    for (int e = 0; e < 4; ++e) po[((qt * 4 + dt) * 4 + e) * 512] = oc[dt][e] * scq;
                __builtin_amdgcn_sched_barrier(0);
            }
        }
#endif
        __syncthreads();
#ifndef AT_SKIP_SEL
        {
            const int q = tid >> 3, jj = tid & 7, cur = qb; unsigned bits = 0u;
            float vj[4];
#pragma unroll
            for (int e = 0; e < 4; ++e) { const int j = jj * 4 + e; const bool forced = (j == 0) || (j == cur) || (j == cur - 1); vj[e] = forced ? 1e4f : (j <= cur ? impq[q * 33 + j] : -INFINITY); }
            int rk[4] = {0, 0, 0, 0};
            for (int jp = 0; jp < 32; ++jp) { const bool forced = (jp == 0) || (jp == cur) || (jp == cur - 1); const float vp = forced ? 1e4f : (jp <= cur ? impq[q * 33 + jp] : -INFINITY);
#pragma unroll
                for (int e = 0; e < 4; ++e) rk[e] += ((vp > vj[e]) || (vp == vj[e] && jp < jj * 4 + e)) ? 1 : 0; }
#pragma unroll
            for (int e = 0; e < 4; ++e) bits |= (rk[e] < 8 ? 1u : 0u) << (jj * 4 + e);
            bits |= __shfl_xor(bits, 1); bits |= __shfl_xor(bits, 2); bits |= __shfl_xor(bits, 4);
            if (jj == 0) selm[q] = bits;
        }
#endif
        __syncthreads();
        unsigned sel[2] = {selm[8 * wave + qi], selm[8 * wave + 4 + qi]};
        unsigned un = selm[lane];
#pragma unroll
        for (int o = 32; o >= 1; o >>= 1) un |= __shfl_xor(un, o);
        un = __builtin_amdgcn_readfirstlane(un);
        const unsigned causal = qb == 31 ? 0xFFFFFFFFu : ((2u << qb) - 1u);
        if (MODE != 1 && MODE != 2) { const float gt1[2] = {gate[1][0], gate[1][1]};
#ifndef ATTN_STAGGER
            attn_branch<0>(F, PROJ, b, g, t0, un & causal, btab_h, qf, tq, sel, gt1, L);
#else
            attn_branch_stag<0>(F, PROJ, b, g, t0, un & causal, btab_h, qf, tq, sel, h, L);
#endif
        }
        if (MODE != 2) { const int jlo = qb >= 8 ? qb - 8 : 0; const unsigned wmask = causal & ~((1u << jlo) - 1u); const float gt2[2] = {gate[2][0], gate[2][1]};

#ifndef ATTN_STAGGER
            attn_branch<1>(F, PROJ, b, g, t0, wmask, btab_h, qf, tq, sel, gt2, L);
#else
            attn_branch_stag<1>(F, PROJ, b, g, t0, wmask, btab_h, qf, tq, sel, h, L);
#endif
        }
        int pob2 = AT_OUT + tid * 4; asm volatile("" : "+v"(pob2));
#pragma unroll
        for (int qt = 0; qt < 2; ++qt) { bf16_t* orow = OATT + (size_t)(b * S + tq[qt]) * 512 + h * 64 + 4 * grp;
#pragma unroll
            for (int dt = 0; dt < 4; ++dt) { const LAS float* po = (const LAS float*)(F.lds + pob2) + (qt * 4 + dt) * 4 * 512;
                *(uint2*)(orow + dt * 16) = make_uint2(pg8::cvt_pk_bf16(po[0], po[512]), pg8::cvt_pk_bf16(po[1024], po[1536])); } }
    }
    STAMP(7);
#ifdef PROBE_STAMP
    __syncthreads();
    if (PROBE_PHASE == 4 && MODE == 0 && blockIdx.x == PROBE_BLOCK && tid < 16) ((unsigned*)(F.ws + WS_CTL + 32768))[tid] = ((volatile LAS unsigned*)(F.lds + LDS_MISC_OFF + 128))[tid];
#endif
}

__device__ __forceinline__ void p5_mixed(const Frame& F) {
    const bf16_t* PROJ = (const bf16_t*)(F.ws + WS_PROJ); const bf16_t* OATT = (const bf16_t*)(F.ws + WS_OATT); bf16_t* MIX = (bf16_t*)(F.ws + WS_H);
    const float* cw = F.in[13]; const float* ga = F.in[14]; const float* gc = F.in[15];
    const int gw = blockIdx.x * NWAVES + F.wave, nw = F.G * NWAVES, lane = F.lane, c0 = lane * 8;
    float w0[8], w1[8], w2[8], gav[8], gcv[8];
#pragma unroll
    for (int e = 0; e < 8; ++e) { w0[e] = cw[c0 + e]; w1[e] = cw[512 + c0 + e]; w2[e] = cw[1024 + c0 + e]; gav[e] = ga[c0 + e]; gcv[e] = gc[c0 + e]; }
    for (int chunk = gw; chunk < T / 16; chunk += nw) {
        const int t0 = chunk * 16, s0 = t0 % S;
        float z1[8], z2[8];
#pragma unroll
        for (int e = 0; e < 8; ++e) { z1[e] = 0.f; z2[e] = 0.f; }
        if (s0 > 0) {
#pragma unroll
            for (int back = 1; back <= 2; ++back) { const bf16_t* row = PROJ + (size_t)(t0 - back) * NPAD;
                const u32x4v wc = *(const u32x4v*)(row + C_CC + c0), wh = *(const u32x4v*)(row + C_CH + c0);
#pragma unroll
                for (int e = 0; e < 4; ++e) { const float a = bflo(wc[e]) * bflo(wh[e]), bq = bfhi(wc[e]) * bfhi(wh[e]); if (back == 1) { z1[2 * e] = a; z1[2 * e + 1] = bq; } else { z2[2 * e] = a; z2[2 * e + 1] = bq; } } } }
        u32x4v na, nc, nh, nb;
        { const bf16_t* row = PROJ + (size_t)t0 * NPAD; na = *(const u32x4v*)(OATT + (size_t)t0 * 512 + c0); nc = *(const u32x4v*)(row + C_CC + c0); nh = *(const u32x4v*)(row + C_CH + c0); nb = *(const u32x4v*)(row + C_CB + c0); }
#pragma unroll 1
        for (int i = 0; i < 16; ++i) { const int tok = t0 + i;
            const u32x4v wa = na, wc = nc, wh = nh, wb = nb;
            { const int tn = i < 15 ? tok + 1 : tok; const bf16_t* row = PROJ + (size_t)tn * NPAD;
                na = *(const u32x4v*)(OATT + (size_t)tn * 512 + c0); nc = *(const u32x4v*)(row + C_CC + c0); nh = *(const u32x4v*)(row + C_CH + c0); nb = *(const u32x4v*)(row + C_CB + c0); }
            float a[8], y[8], z0[8];
#pragma unroll
            for (int e = 0; e < 4; ++e) { a[2 * e] = bflo(wa[e]); a[2 * e + 1] = bfhi(wa[e]); z0[2 * e] = bflo(wc[e]) * bflo(wh[e]); z0[2 * e + 1] = bfhi(wc[e]) * bfhi(wh[e]); }
#pragma unroll
            for (int e = 0; e < 8; ++e) y[e] = w0[e] * z2[e] + w1[e] * z1[e] + w2[e] * z0[e];
#pragma unroll
            for (int e = 0; e < 4; ++e) { y[2 * e] *= bflo(wb[e]); y[2 * e + 1] *= bfhi(wb[e]); }
            float sa = 0.f, sy = 0.f;
#pragma unroll
            for (int e = 0; e < 8; ++e) { sa += a[e] * a[e]; sy += y[e] * y[e]; }
            sa = wave_sum(sa); sy = wave_sum(sy);
            const float ra = rsqrtf(sa * (1.0f / 512) + EPS), ry = rsqrtf(sy * (1.0f / 512) + EPS);
            unsigned oa[4], oy[4];
#pragma unroll
            for (int e = 0; e < 4; ++e) { oa[e] = pack2(a[2 * e] * ra * gav[2 * e], a[2 * e + 1] * ra * gav[2 * e + 1]); oy[e] = pack2(y[2 * e] * ry * gcv[2 * e], y[2 * e + 1] * ry * gcv[2 * e + 1]); }
            *(uint4*)(MIX + (size_t)tok * D + c0) = make_uint4(oa[0], oa[1], oa[2], oa[3]);
            *(uint4*)(MIX + (size_t)tok * D + 512 + c0) = make_uint4(oy[0], oy[1], oy[2], oy[3]);
#pragma unroll
            for (int e = 0; e < 8; ++e) { z2[e] = z1[e]; z1[e] = z0[e]; }
        }
    }
}

struct EpiResGate {
    static constexpr bool PERM = false, AFTER_DRAIN = false;
    float* C; const float* X; const float* MOD; int gate_off;
    __device__ __forceinline__ void operator()(const pg8::f32x4 (&acc)[2][2][4][2], const pg8::Unit& u, int wr, int wc, int fr, int fq) const {
        using pg8::f32x4; using pg8::HALF; using pg8::BM;
        const int row0 = u.pm * BM + wr * 64 + fr, col0 = u.pn * BM + wc * 32 + 4 * fq;
        const int b = (u.pm * BM) / S;
        f32x4 gv[2][2];
#pragma unroll
        for (int bj = 0; bj < 2; ++bj)
#pragma unroll
            for (int n = 0; n < 2; ++n) gv[bj][n] = *(const f32x4*)(MOD + b * 6144 + gate_off + col0 + bj * HALF + n * 16);
#pragma unroll
        for (int ai = 0; ai < 2; ++ai)
#pragma unroll
            for (int m = 0; m < 4; ++m) { const size_t ro = (size_t)(row0 + ai * HALF + m * 16) * D + col0;
#pragma unroll
                for (int bj = 0; bj < 2; ++bj)
#pragma unroll
                    for (int n = 0; n < 2; ++n) { const f32x4 xv = *(const f32x4*)(X + ro + bj * HALF + n * 16); *(f32x4*)(C + ro + bj * HALF + n * 16) = xv + gv[bj][n] * acc[ai][bj][m][n]; } }
    }
};

__device__ __forceinline__ int ord_i(float f) { const int u = __float_as_int(f); return u >= 0 ? u : (u ^ 0x7FFFFFFF); }
__device__ __forceinline__ float unord_f(int i) { const int u = i >= 0 ? i : (i ^ 0x7FFFFFFF); return __int_as_float(u); }
#define INT_MIN_ (-2147483647 - 1)
struct CandTab { int a[50], b[50]; };
constexpr CandTab make_cand() { CandTab t{}; int n = 0; for (int a = 0; a < 16; ++a) for (int b = 0; b < 16; ++b) if ((a + 1) * (b + 1) <= 16) { t.a[n] = a; t.b[n] = b; ++n; } return t; }
constexpr CandTab CAND = make_cand();

template <int N, bool DESC> __device__ __forceinline__ void bitonic_sort_i(int (&v)[N]) {
#pragma unroll
    for (int k = 2; k <= N; k <<= 1)
#pragma unroll
        for (int j = k >> 1; j > 0; j >>= 1)
#pragma unroll
            for (int i = 0; i < N; ++i) { const int l = i ^ j; if (l > i) { const bool up = ((i & k) == 0) != DESC; const int lo = min(v[i], v[l]), hi = max(v[i], v[l]); v[i] = up ? lo : hi; v[l] = up ? hi : lo; } }
}
struct Net16 { int a[60], b[60]; };
constexpr Net16 NET16 = {{0,1,2,3,4,5,7,9,0,1,2,3,6,8,10,11,0,2,4,6,7,10,12,14,0,1,4,5,6,8,12,13,1,3,4,5,8,9,13,1,2,5,7,9,11,2,3,9,11,3,6,7,10,3,5,7,9,11,6,8}, {13,12,15,14,8,6,11,10,5,7,9,4,13,14,15,12,1,3,5,8,9,11,13,15,2,3,10,11,7,9,14,15,2,12,6,7,10,11,14,4,6,8,10,13,14,4,6,12,13,5,8,9,12,4,6,8,10,12,7,9}};
template <bool DESC> __device__ __forceinline__ void sort16_net(int (&v)[16]) {
#pragma unroll
    for (int c = 0; c < 60; ++c) { const int lo = min(v[NET16.a[c]], v[NET16.b[c]]), hi = max(v[NET16.a[c]], v[NET16.b[c]]); v[NET16.a[c]] = DESC ? hi : lo; v[NET16.b[c]] = DESC ? lo : hi; }
}
template <int N, bool DESC> __device__ __forceinline__ void bitonic_merge_i(int (&v)[N]) {
#pragma unroll
    for (int j = N >> 1; j > 0; j >>= 1)
#pragma unroll
        for (int i = 0; i < N; ++i) { const int l = i ^ j; if (l > i) { const int lo = min(v[i], v[l]), hi = max(v[i], v[l]); v[i] = DESC ? hi : lo; v[l] = DESC ? lo : hi; } }
}
__device__ __forceinline__ void merge_top16_across(int (&t)[16]) {
#pragma unroll
    for (int m = 16; m <= 32; m <<= 1) { int y[16];
#pragma unroll
        for (int i = 0; i < 16; ++i) y[i] = max(t[i], __shfl_xor(t[15 - i], m));
        bitonic_merge_i<16, true>(y);
#pragma unroll
        for (int i = 0; i < 16; ++i) t[i] = y[i]; }
}
constexpr int RT2_KEYS = 0  , RT2_ITAB = 65536  ;
__device__ __forceinline__ void p9_route_sort(const Frame& F) {
    const bf16_t* QP = (const bf16_t*)(F.ws + WS_QP); const bf16_t* KEYS = (const bf16_t*)(F.ws + WS_KEYS);
    unsigned short* E16 = (unsigned short*)(F.ws + WS_E16); float* EW = (float*)(F.ws + WS_EW);
    const int lane = F.lane, tid = F.tid, grp = lane >> 4, col = lane & 15;
    const LaneOffs L = lane_offs(lane, tid);
    LAS int* itab = (LAS int*)(F.lds + RT2_ITAB + F.wave * 2048) + col * 32;
    const bool g1 = grp == 1, g2 = grp == 2, g3 = grp == 3;
    for (int tile = blockIdx.x * NWAVES + F.wave; tile < T / 16; tile += F.G * NWAVES) {
        const int tok = tile * 16 + col;
        {
#pragma unroll
            for (int i = 0; i < 4; ++i) { const int q = tid + 512 * i; *(LAS u32x4v*)(F.lds + RT2_KEYS + tile_off(q >> 3, q & 7)) = *(const u32x4v*)(KEYS + (size_t)q * 8); } }
        bf16x8 qf[2][2];
#pragma unroll
        for (int p = 0; p < 2; ++p)
#pragma unroll
            for (int ks = 0; ks < 2; ++ks) qf[p][ks] = *(const bf16x8*)(QP + (size_t)tok * D + p * 64 + ks * 32 + 8 * grp);
        __syncthreads();
#pragma unroll 1
        for (int h = 0; h < 8; ++h) {
            const int kb = RT2_KEYS + (h & 1) * 32768;
            u32x4v stg[4]; bf16x8 qn[2][2];
            if (h < 7) {
#pragma unroll
                for (int i = 0; i < 4; ++i) { const int q = tid + 512 * i; stg[i] = *(const u32x4v*)(KEYS + (size_t)(h + 1) * 16384 + (size_t)q * 8); }
#pragma unroll
                for (int p = 0; p < 2; ++p)
#pragma unroll
                    for (int ks = 0; ks < 2; ++ks) qn[p][ks] = *(const bf16x8*)(QP + (size_t)tok * D + (h + 1) * 128 + p * 64 + ks * 32 + 8 * grp);
            }
            int lst[2][16];
#pragma unroll
            for (int p = 0; p < 2; ++p) {
                f32x4 sc[8];
#pragma unroll
                for (int kt = 0; kt < 8; ++kt) { sc[kt] = (f32x4){0.f, 0.f, 0.f, 0.f};
#pragma unroll
                    for (int ks = 0; ks < 2; ++ks) { const bf16x8 kf = *(const LAS bf16x8*)(F.lds + kb + p * 16384 + L.koff[ks] + kt * 2048);
                        sc[kt] = __builtin_amdgcn_mfma_f32_16x16x32_bf16(kf, qf[p][ks], sc[kt], 0, 0, 0); } }
                int ra[16], rb[16];
#pragma unroll
                for (int kt = 0; kt < 4; ++kt)
#pragma unroll
                    for (int rg = 0; rg < 4; ++rg) { ra[kt * 4 + rg] = (ord_i(sc[kt][rg]) & ~0x7F) | (127 - (kt * 16 + 4 * grp + rg)); rb[kt * 4 + rg] = (ord_i(sc[kt + 4][rg]) & ~0x7F) | (127 - ((kt + 4) * 16 + 4 * grp + rg)); }
                sort16_net<true>(ra); sort16_net<false>(rb);
#pragma unroll
                for (int i = 0; i < 16; ++i) ra[i] = max(ra[i], rb[i]);
                bitonic_merge_i<16, true>(ra);
                merge_top16_across(ra);
#pragma unroll
                for (int i = 0; i < 16; ++i) lst[p][i] = ra[i];
                if (grp == 0) {
#pragma unroll
                    for (int it = 0; it < 16; ++it) itab[p * 16 + it] = 127 - (ra[it] & 0x7F);
                }
            }
            float v0[16], v1[16];
#pragma unroll
            for (int i = 0; i < 16; ++i) { v0[i] = unord_f(lst[0][i] & ~0x7F); v1[i] = unord_f(lst[1][i] & ~0x7F); }
            int ck[16];
#pragma unroll
            for (int i = 0; i < 13; ++i) {
                constexpr int NC = 50;
                const int k0 = 4 * i, k1 = 4 * i + 1 < NC ? 4 * i + 1 : NC - 1, k2 = 4 * i + 2 < NC ? 4 * i + 2 : NC - 1, k3 = 4 * i + 3 < NC ? 4 * i + 3 : NC - 1;
                float va = v0[CAND.a[k0]], vb = v1[CAND.b[k0]]; int fl = 255 - (CAND.a[k0] * 16 + CAND.b[k0]);
                va = g1 ? v0[CAND.a[k1]] : va; vb = g1 ? v1[CAND.b[k1]] : vb; fl = g1 ? 255 - (CAND.a[k1] * 16 + CAND.b[k1]) : fl;
                va = g2 ? v0[CAND.a[k2]] : va; vb = g2 ? v1[CAND.b[k2]] : vb; fl = g2 ? 255 - (CAND.a[k2] * 16 + CAND.b[k2]) : fl;
                va = g3 ? v0[CAND.a[k3]] : va; vb = g3 ? v1[CAND.b[k3]] : vb; fl = g3 ? 255 - (CAND.a[k3] * 16 + CAND.b[k3]) : fl;
                int key = (ord_i(va + vb) & ~0xFF) | fl;
                if (4 * i + 1 >= NC) key = g1 ? INT_MIN_ : key;
                if (4 * i + 2 >= NC) key = g2 ? INT_MIN_ : key;
                if (4 * i + 3 >= NC) key = g3 ? INT_MIN_ : key;
                ck[i] = key; }
            ck[13] = INT_MIN_; ck[14] = INT_MIN_; ck[15] = INT_MIN_;
            sort16_net<true>(ck);
            merge_top16_across(ck);
            lds_wave_sync();
            const float smax = unord_f(ck[0] & ~0xFF);
            float ex[16], sum = 0.f;
#pragma unroll
            for (int it = 0; it < 16; ++it) { ex[it] = __expf(unord_f(ck[it] & ~0xFF) - smax); sum += ex[it]; }
            const float inv = 1.0f / sum;
            if (grp == 0) {
#pragma unroll
                for (int it = 0; it < 16; ++it) { const int flat = 255 - (ck[it] & 0xFF); const int i1 = itab[flat >> 4], i2 = itab[16 + (flat & 15)];
                    E16[(size_t)tok * 128 + h * 16 + it] = (unsigned short)(i1 * 128 + i2); EW[(size_t)tok * 128 + h * 16 + it] = ex[it] * inv; }
            }
            lds_wave_sync();
            if (h < 7) {
                const int kn = RT2_KEYS + ((h + 1) & 1) * 32768;
#pragma unroll
                for (int i = 0; i < 4; ++i) { const int q = tid + 512 * i; *(LAS u32x4v*)(F.lds + kn + tile_off(q >> 3, q & 7)) = stg[i]; }
#pragma unroll
                for (int p = 0; p < 2; ++p)
#pragma unroll
                    for (int ks = 0; ks < 2; ++ks) qf[p][ks] = qn[p][ks];
            }
            __syncthreads();
        }
    }
}

constexpr int N_PHASES = 14;
struct Args { const float* in[23]; float* out; unsigned char* ws; int ph_lo, ph_hi; };
__global__ void __launch_bounds__(NTHREADS, 2) fwd(Args args) {
    extern __shared__ __attribute__((aligned(16))) unsigned char lds_raw[];
    Frame F;
#pragma unroll
    for (int i = 0; i < 23; ++i) F.in[i] = args.in[i];
    F.out = args.out; F.ws = args.ws; F.lds = (LAS unsigned char*)lds_raw;
    F.tid = threadIdx.x; F.lane = F.tid & 63; F.wave = __builtin_amdgcn_readfirstlane(F.tid >> 6); F.G = gridDim.x;
    volatile LAS unsigned* misc = (volatile LAS unsigned*)(F.lds + LDS_MISC_OFF);
    if (F.tid < 64) misc[F.tid] = 0u;
    __syncthreads();
    XcdBarrier bar; bar.bar = (unsigned*)(F.ws + WS_CTL); bar.x = 0; bar.st = misc;
    const int lo = args.ph_lo, hi = args.ph_hi;
    if (hi - lo > 1) bar = xcd_barrier_post((unsigned*)(F.ws + WS_CTL), misc);
#ifndef PH_MASK
#define PH_MASK 0xFFFF
#endif
#define IN(k) (((PH_MASK >> (k)) & 1) && lo <= (k) && (k) < hi)
#define SEAM(k) do { if (IN(k) && IN((k) + 1)) xcd_barrier(bar); } while (0)
    const float* MOD = (const float*)(F.ws + WS_MOD);
    if (IN(0)) { p0_prologue(F, 0, 96); } SEAM(0);
    if (IN(1)) { p0_prologue(F, 96, 1 << 30); norm_mod_rows(F, F.in[0], F.in[2], 0, 1024, (bf16_t*)(F.ws + WS_H)); } SEAM(1);
    if (IN(2)) { pg8::Gemm g{(const pg8::bf16_t*)(F.ws + WS_H), (const pg8::bf16_t*)(F.ws + WS_WIN), T, NPAD, D}; pg8::StaticOrder So; So.init(T, NPAD, F.G, (int)blockIdx.x);
        pg8::EpiBf16<0> E{(pg8::bf16_t*)(F.ws + WS_PROJ), NPAD, nullptr, 0, 0};
        pg8::gemm_phase<pg8::EpiBf16<0>, pg8::StaticOrder>(F.lds, g, So, E, nullptr); } SEAM(2);
#ifdef COMPRESS_NAIVE
    if (IN(3)) { p3_compress_naive(F); } SEAM(3);
#else
    if (IN(3)) { p3_compress_mfma(F); } SEAM(3);
#endif
    #ifdef ATTN_NAIVE
    if (IN(4)) { p4_attn_naive(F); } SEAM(4);
#else
    if (IN(4)) { p4_attn_mfma_t<0>(F); } SEAM(4);
#ifdef PROBE_ATTN_MODE
    if (IN(14)) { p4_attn_mfma_t<PROBE_ATTN_MODE>(F); }
#endif
#ifdef PROBE_P0_LO
    if (IN(14)) { p0_prologue(F, PROBE_P0_LO, PROBE_P0_HI); }
#endif
#endif
    if (IN(5)) { p5_mixed(F); } SEAM(5);
    if (IN(6)) { pg8::Gemm g{(const pg8::bf16_t*)(F.ws + WS_H), (const pg8::bf16_t*)(F.ws + WS_WOUT), T, D, D}; pg8::StaticOrder So; So.init(T, D, F.G, (int)blockIdx.x);
        pg8::EpiBf16<0> E{(pg8::bf16_t*)(F.ws + WS_Y), D, nullptr, 0, 0};
        pg8::gemm_phase<pg8::EpiBf16<0>, pg8::StaticOrder>(F.lds, g, So, E, nullptr); } SEAM(6);
    if (IN(7)) { norm_mod_rows_q(F, F.in[0], F.in[3], 3072, 4096, (bf16_t*)(F.ws + WS_H)); } SEAM(7);
    if (IN(8)) { pg8::Gemm g{(const pg8::bf16_t*)(F.ws + WS_H), (const pg8::bf16_t*)(F.ws + WS_WQ), T, D, D}; pg8::StaticOrder So; So.init(T, D, F.G, (int)blockIdx.x);
        pg8::EpiBf16<0> E{(pg8::bf16_t*)(F.ws + WS_QP), D, nullptr, 0, 0};
        pg8::gemm_phase<pg8::EpiBf16<0>, pg8::StaticOrder>(F.lds, g, So, E, nullptr); } SEAM(8);
        if (IN(9)) { p9_route_sort(F); } SEAM(9);
    if (IN(10)) { p10a_udots(F); } SEAM(10);
    if (IN(11)) { p10b_coef(F); } SEAM(11);
    if (IN(12)) { p10c_vsum(F); } SEAM(12);
    if (IN(13)) { p10d_final(F); }
#undef IN
#undef SEAM
}

extern "C" void kernel_launch(void* const* d_in, const int* in_sizes, int n_in, void* d_out, int out_size, void* d_ws, size_t ws_size, hipStream_t stream) {
    static int grid = 0;
    if (grid == 0) {
        if (n_in != 23 || out_size != T * D || ws_size < WS_END) { fprintf(stderr, "kernel_launch: unexpected shapes: n_in %d out %d ws %zu (need %zu)\n", n_in, out_size, ws_size, (size_t)WS_END); grid = -1; return; }
        int dev = 0, cus = 0, per_cu = 0;
        if (hipGetDevice(&dev) != hipSuccess || hipDeviceGetAttribute(&cus, hipDeviceAttributeMultiprocessorCount, dev) != hipSuccess) { grid = -1; return; }
        if (hipFuncSetAttribute((const void*)fwd, hipFuncAttributeMaxDynamicSharedMemorySize, LDS_BYTES) != hipSuccess) { fprintf(stderr, "kernel_launch: hipFuncSetAttribute failed\n"); grid = -1; return; }
        if (hipOccupancyMaxActiveBlocksPerMultiprocessor(&per_cu, (const void*)fwd, NTHREADS, LDS_BYTES) != hipSuccess || per_cu < 1) { fprintf(stderr, "kernel_launch: occupancy query says %d\n", per_cu); (void)hipGetLastError(); per_cu = 1; }
        grid = cus;
    }
    if (grid < 0) return;
    (void)hipMemsetAsync((char*)d_ws + WS_CTL, 0, CTL_BYTES, stream);
    Args a{};
    for (int i = 0; i < 23; ++i) a.in[i] = (const float*)d_in[i];
    a.out = (float*)d_out; a.ws = (unsigned char*)d_ws;
#if MK_N_LAUNCHES == 1
    a.ph_lo = 0; a.ph_hi = N_PHASES;
    hipLaunchKernelGGL(fwd, dim3(grid), dim3(NTHREADS), LDS_BYTES, stream, a);
#else
#ifdef PROBE_LIST
    { const int plist[] = PROBE_LIST; for (int p : plist) { if (p < 0) { (void)hipMemsetAsync((char*)d_ws + WS_CTL, 0, CTL_BYTES, stream); continue; } a.ph_lo = p; a.ph_hi = p + 1; hipLaunchKernelGGL(fwd, dim3(grid), dim3(NTHREADS), LDS_BYTES, stream, a); } }
#else
    for (int p = 0; p < N_PHASES; ++p) { a.ph_lo = p; a.ph_hi = p + 1; hipLaunchKernelGGL(fwd, dim3(grid), dim3(NTHREADS), LDS_BYTES, stream, a); }
#endif
#endif
}
```

```cpp
#include <hip/hip_runtime.h>
#include <cstdio>
#include <cstdint>
#include <cstdlib>

#ifndef MK_N_LAUNCHES
#define MK_N_LAUNCHES 1
#endif
#define XB_TMO      128
#define XB_XCNT(j)  (256  + 64 * (j))
#define XB_XSUB(j)  (1280 + 64 * (j))
#define XB_XGEN(j)  (2304 + 64 * (j))
#define XB_TOP      3328
#define XB_TOPGEN   3392
#define XCD_BAR_WORDS 3456
#define XB_SPIN_CAP (1u << 18)
#define LAS __attribute__((address_space(3)))

__device__ __forceinline__ unsigned xb_ld(unsigned* p)              { return __hip_atomic_load(p, __ATOMIC_RELAXED, __HIP_MEMORY_SCOPE_AGENT); }
__device__ __forceinline__ unsigned xb_add(unsigned* p, unsigned v) { return __hip_atomic_fetch_add(p, v, __ATOMIC_RELAXED, __HIP_MEMORY_SCOPE_AGENT); }
__device__ __forceinline__ unsigned xb_xcc_id() { return (unsigned)__builtin_amdgcn_s_getreg((3 << 11) | 20) & 0xFu; }
#define XB_SPIN(cond, bar) do { unsigned _sp = 0; while (cond) { __builtin_amdgcn_s_sleep(1); \
    if ((++_sp & 255u) == 0u) { if (xb_ld(&(bar)[XB_TMO])) break; if (_sp > XB_SPIN_CAP) { atomicAdd(&(bar)[XB_TMO], 1u); break; } } } } while (0)

struct XcdBarrier {
    unsigned* bar; unsigned x;
    volatile LAS unsigned* st;
};

__device__ __forceinline__ XcdBarrier xcd_barrier_post(unsigned* bar, volatile LAS unsigned* st) {
    XcdBarrier b; b.bar = bar; b.x = xb_xcc_id(); b.st = st;
    if (threadIdx.x == 0) (void)xb_add(&bar[XB_XCNT(b.x)], 1u);
    return b;
}
__device__ __forceinline__ void xcd_barrier_complete(unsigned* bar, unsigned x, unsigned& nloc, unsigned& nx) {
    const unsigned G = gridDim.x * gridDim.y * gridDim.z;
    unsigned sum, cnt, mine, sp = 0u;
    for (;;) {
        sum = 0u; cnt = 0u; mine = 0u;
#pragma unroll
        for (unsigned j = 0; j < 16; ++j) { const unsigned c = xb_ld(&bar[XB_XCNT(j)]); sum += c; cnt += (c > 0u) ? 1u : 0u; mine = (j == x) ? c : mine; }
        if (sum == G) break;
        __builtin_amdgcn_s_sleep(1);
        if ((++sp & 255u) == 0u) { if (xb_ld(&bar[XB_TMO])) break; if (sp > XB_SPIN_CAP) { atomicAdd(&bar[XB_TMO], 1u); break; } }
    }
    nloc = mine > 0u ? mine : 1u; nx = cnt > 0u ? cnt : 1u;
}

__device__ __forceinline__ void xcd_barrier(const XcdBarrier& b) {
    asm volatile("s_waitcnt vmcnt(0)" ::: "memory");
    __syncthreads();
    if (threadIdx.x == 0) {
        unsigned* bar = b.bar;
        __builtin_amdgcn_s_waitcnt(0);
        unsigned nloc = b.st[0], nx = b.st[1];
        if (nloc == 0u) { xcd_barrier_complete(bar, b.x, nloc, nx); b.st[0] = nloc; b.st[1] = nx; }
        const unsigned old = xb_add(&bar[XB_XSUB(b.x)], 1u);
        const unsigned gen = old / nloc;
        if (old + 1u == (gen + 1u) * nloc) {
            __builtin_amdgcn_fence(__ATOMIC_RELEASE, "agent");
            asm volatile("s_waitcnt vmcnt(0)" ::: "memory");
            const unsigned og = xb_add(&bar[XB_TOP], 1u);
            const unsigned tg = og / nx;
            if (og + 1u == (tg + 1u) * nx) xb_add(&bar[XB_TOPGEN], 1u);
            else XB_SPIN(xb_ld(&bar[XB_TOPGEN]) == tg, bar);
            __builtin_amdgcn_fence(__ATOMIC_ACQUIRE, "agent");
            xb_add(&bar[XB_XGEN(b.x)], 1u);
            asm volatile("s_waitcnt vmcnt(0)" ::: "memory");
        } else {
            XB_SPIN(xb_ld(&bar[XB_XGEN(b.x)]) == gen, bar);
            __builtin_amdgcn_fence(__ATOMIC_ACQUIRE, "agent");
            asm volatile("s_waitcnt vmcnt(0)" ::: "memory");
        }
    }
    __syncthreads();
}

namespace pg8 {
#define PG8_LAS __attribute__((address_space(3)))
typedef unsigned short bf16_t;
typedef short bf16x8 __attribute__((ext_vector_type(8)));
typedef float f32x4 __attribute__((ext_vector_type(4)));
typedef unsigned u32x4 __attribute__((ext_vector_type(4)));
constexpr int BM = 256, BK = 64, HALF = 128, HTB = HALF * BK * 2  , STAGE_BYTES = 8 * HTB, NXCD = 8, WGM = 8;

__host__ __device__ __forceinline__ int lds_byte(int r, int c) { const int st = (r >> 4) * 2 + (c >> 5), rr = r & 15, cc = c & 31, ob = rr * 64 + cc * 2; return st * 1024 + (ob ^ (((ob >> 9) & 1) << 5)); }
__host__ __device__ __forceinline__ void stage_rc(int b, int& R, int& C) { const int st = b / 1024, sb = b % 1024, swz = sb ^ (((sb >> 9) & 1) << 5); R = (st >> 1) * 16 + swz / 64; C = (st & 1) * 32 + (swz % 64) / 2; }
__host__ __device__ __forceinline__ int perm32(int rho) { const int n = rho >> 4, i = rho & 15; return 8 * (i >> 2) + 4 * n + (i & 3); }

struct Unit { int pm, pn; };
struct Gemm { const bf16_t* A; const bf16_t* Bt; int M, N, K; };

struct StaticOrder {
    int nM, nN, nwg, G, c;
    __host__ __device__ void init(int M, int N, int G_, int c_) { nM = M / BM; nN = N / BM; nwg = nM * nN; G = G_; c = c_; }
    __host__ __device__ bool next(int i, Unit& u) const {
        const long L = (long)i * G + c; if (L >= nwg) return false;
        int wgid = (int)L; { const int q = nwg / NXCD, r = nwg % NXCD, xcd = wgid % NXCD, off = wgid / NXCD; wgid = (xcd < r ? xcd * (q + 1) : r * (q + 1) + (xcd - r) * q) + off; }
        const int nig = WGM * nN, gid = wgid / nig, fm = gid * WGM, gsz = (nM - fm) < WGM ? (nM - fm) : WGM;
        u.pm = fm + ((wgid % nig) % gsz); u.pn = (wgid % nig) / gsz; return true;
    }
    __device__ __forceinline__ void a_ready(const Unit&) const {}
    __device__ __forceinline__ void done(const Unit&) const {}
};
struct CountedOrder : StaticOrder {
    const unsigned* ready; unsigned need; unsigned* tmo;
    __device__ __forceinline__ void a_ready(const Unit& u) const {
        if (threadIdx.x < 64) {
            const unsigned long long t0 = __builtin_amdgcn_s_memrealtime(); unsigned polls = 0;
            while ((unsigned)__builtin_amdgcn_readfirstlane(__hip_atomic_load(ready + 64 * u.pm, __ATOMIC_RELAXED, __HIP_MEMORY_SCOPE_AGENT)) < need) {
                if ((++polls & 255u) == 0u && __builtin_amdgcn_readfirstlane(__hip_atomic_load(tmo, __ATOMIC_RELAXED, __HIP_MEMORY_SCOPE_AGENT)) != 0u) break;
                if (__builtin_amdgcn_s_memrealtime() - t0 > 2000000ull) {
                    if (threadIdx.x == 0) { unsigned expect = 0u; __hip_atomic_compare_exchange_strong(tmo + 1, &expect, 0x600u | (unsigned)(u.pm & 0xff), __ATOMIC_RELAXED, __ATOMIC_RELAXED, __HIP_MEMORY_SCOPE_AGENT); __hip_atomic_store(tmo, 1u, __ATOMIC_RELAXED, __HIP_MEMORY_SCOPE_AGENT); }
                    break; }
                __builtin_amdgcn_s_sleep(2); }
            __builtin_amdgcn_fence(__ATOMIC_ACQUIRE, "agent");
            asm volatile("s_waitcnt vmcnt(0)" ::: "memory");
        }
#if !defined(BROKEN_HOOK_NO_BARRIER)
        asm volatile("" ::: "memory"); __builtin_amdgcn_s_barrier(); asm volatile("" ::: "memory");
#endif
    }
};

__device__ __forceinline__ unsigned cvt_pk_bf16(float lo, float hi) { unsigned r; asm volatile("v_cvt_pk_bf16_f32 %0, %1, %2" : "=v"(r) : "v"(lo), "v"(hi)); return r; }
typedef float f32x2 __attribute__((ext_vector_type(2)));
__device__ __forceinline__ f32x2 gelu_pk(f32x2 v) {
    const f32x2 av = __builtin_elementwise_abs(v), d = av * 0.2316418882f + 1.0f;
    f32x2 t; t.x = __builtin_amdgcn_rcpf(d.x); t.y = __builtin_amdgcn_rcpf(d.y);
    f32x2 q = t * 0.5307027145f + (-0.7265760135f); q = q * t + 0.7107068705f; q = q * t + (-0.142248368f); q = q * t + 0.127414796f; q = q * t;
    const f32x2 s = (v * v) * (-0.72134752044f);
    f32x2 e; e.x = __builtin_amdgcn_exp2f(s.x); e.y = __builtin_amdgcn_exp2f(s.y);
    const f32x2 m = v * (q * e), r = v - m;
    f32x2 o; o.x = v.x < 0.f ? m.x : r.x; o.y = v.y < 0.f ? m.y : r.y; return o;
}

struct EpiF32 {
    static constexpr bool PERM = false, AFTER_DRAIN = false;
    float* C; int ldc; const float* bias;
    __device__ __forceinline__ void operator()(const f32x4 (&acc)[2][2][4][2], const Unit& u, int wr, int wc, int fr, int fq) const {
        const int row0 = u.pm * BM + wr * 64 + fr, col0 = u.pn * BM + wc * 32 + 4 * fq;
        f32x4 bv[2][2];
#pragma unroll
        for (int bj = 0; bj < 2; ++bj)
#pragma unroll
            for (int n = 0; n < 2; ++n) bv[bj][n] = bias ? *(const f32x4*)(bias + col0 + bj * HALF + n * 16) : (f32x4){0.f, 0.f, 0.f, 0.f};
#pragma unroll
        for (int ai = 0; ai < 2; ++ai)
#pragma unroll
            for (int m = 0; m < 4; ++m) { float* rowp = C + (size_t)(row0 + ai * HALF + m * 16) * ldc + col0;
#pragma unroll
                for (int bj = 0; bj < 2; ++bj)
#pragma unroll
                    for (int n = 0; n < 2; ++n) *(f32x4*)(rowp + bj * HALF + n * 16) = acc[ai][bj][m][n] + bv[bj][n]; }
    }
};
template <int ACT  > struct EpiBf16 {
    static constexpr bool PERM = true, AFTER_DRAIN = false;
    bf16_t* O; int ldc; const float* bias; int split_cols; size_t split_stride;
    __device__ __forceinline__ void operator()(const f32x4 (&acc)[2][2][4][2], const Unit& u, int wr, int wc, int fr, int fq) const {
        const int row0 = u.pm * BM + wr * 64 + fr; int colt = u.pn * BM; bf16_t* base = O;
        if (split_cols) { const int t = colt / split_cols; base += (size_t)t * split_stride; colt -= t * split_cols; }
        const int col0 = colt + wc * 32 + 8 * fq, bcol0 = u.pn * BM + wc * 32 + 8 * fq;
        f32x4 bv[2][2];
#pragma unroll
        for (int bj = 0; bj < 2; ++bj)
#pragma unroll
            for (int n = 0; n < 2; ++n) bv[bj][n] = bias ? *(const f32x4*)(bias + bcol0 + bj * HALF + 4 * n) : (f32x4){0.f, 0.f, 0.f, 0.f};
#pragma unroll
        for (int ai = 0; ai < 2; ++ai)
#pragma unroll
            for (int m = 0; m < 4; ++m) { bf16_t* rowp = base + (size_t)(row0 + ai * HALF + m * 16) * ldc + col0;
#pragma unroll
                for (int bj = 0; bj < 2; ++bj) { f32x4 v0 = acc[ai][bj][m][0] + bv[bj][0], v1 = acc[ai][bj][m][1] + bv[bj][1];
                    if (ACT == 1) { f32x2 a = gelu_pk((f32x2){v0[0], v0[1]}), b = gelu_pk((f32x2){v0[2], v0[3]}), c = gelu_pk((f32x2){v1[0], v1[1]}), d = gelu_pk((f32x2){v1[2], v1[3]});
                        v0 = (f32x4){a.x, a.y, b.x, b.y}; v1 = (f32x4){c.x, c.y, d.x, d.y}; }
                    if (ACT == 2) {
#pragma unroll
                        for (int j = 0; j < 4; ++j) { v0[j] = 0.5f * v0[j] * (1.0f + erff(v0[j] * 0.70710678f)); v1[j] = 0.5f * v1[j] * (1.0f + erff(v1[j] * 0.70710678f)); } }
                    u32x4 w; w.x = cvt_pk_bf16(v0[0], v0[1]); w.y = cvt_pk_bf16(v0[2], v0[3]); w.z = cvt_pk_bf16(v1[0], v1[1]); w.w = cvt_pk_bf16(v1[2], v1[3]);
                    *(u32x4*)(rowp + bj * HALF) = w; } }
    }
};

struct PanelStats {
    unsigned* xbuf;
    unsigned* cnt;
    unsigned* tmo;
    int ntn; float eps;
    unsigned code;
    __device__ __forceinline__ bool run(const f32x4 (&v)[2][2][4][2], const Unit& u, int wr, int wc, int fr, int fq, PG8_LAS unsigned char* lds, int wid, int lane) const {
        typedef float f32x2v __attribute__((ext_vector_type(2)));
        PG8_LAS f32x2v* P = (PG8_LAS f32x2v*)lds;
        PG8_LAS f32x2v* S = (PG8_LAS f32x2v*)(lds + 8192);
        PG8_LAS unsigned* flag = (PG8_LAS unsigned*)(lds + 8192 + 2048);
#pragma unroll
        for (int ai = 0; ai < 2; ++ai)
#pragma unroll
            for (int m = 0; m < 4; ++m) {
                float s = 0.f;
#pragma unroll
                for (int bj = 0; bj < 2; ++bj)
#pragma unroll
                    for (int n = 0; n < 2; ++n) { const f32x4 x = v[ai][bj][m][n]; s += (x[0] + x[1]) + (x[2] + x[3]); }
                s += __shfl_xor(s, 16); s += __shfl_xor(s, 32);
                const float mw = s * (1.0f / 64.0f); float q = 0.f;
#pragma unroll
                for (int bj = 0; bj < 2; ++bj)
#pragma unroll
                    for (int n = 0; n < 2; ++n) { const f32x4 d = v[ai][bj][m][n] - mw; q += (d[0] * d[0] + d[1] * d[1]) + (d[2] * d[2] + d[3] * d[3]); }
                q += __shfl_xor(q, 16); q += __shfl_xor(q, 32);
                if (fq == 0) P[(ai * HALF + wr * 64 + m * 16 + fr) * 4 + wc] = (f32x2v){mw, q};
            }
        asm volatile("s_waitcnt lgkmcnt(0)" ::: "memory"); __builtin_amdgcn_s_barrier(); asm volatile("" ::: "memory");
#if defined(BROKEN_NO_WAIT)
        if (blockIdx.x >= 64) { const long long t0 = clock64(); while (clock64() - t0 < 60000) __builtin_amdgcn_s_sleep(8); }
#endif
        const int row = wid * 32 + (lane & 31);
        if (lane < 32) {
            const f32x2v a = P[row * 4 + 0], b = P[row * 4 + 1], c = P[row * 4 + 2], d = P[row * 4 + 3];
            const float mt = (a.x + b.x + c.x + d.x) * 0.25f;
            const float da = a.x - mt, db = b.x - mt, dc = c.x - mt, dd = d.x - mt;
            const float m2 = (a.y + b.y) + (c.y + d.y) + 64.0f * ((da * da + db * db) + (dc * dc + dd * dd));
            unsigned long long* slot = (unsigned long long*)xbuf + ((size_t)(u.pm * BM + row) * 4 + u.pn);
            __hip_atomic_store(slot, ((unsigned long long)__float_as_uint(m2) << 32) | __float_as_uint(mt), __ATOMIC_RELAXED, __HIP_MEMORY_SCOPE_AGENT);
        }
        asm volatile("s_waitcnt vmcnt(0)" ::: "memory");
        if (lane == 0) __hip_atomic_fetch_add(cnt + 64 * u.pm, 1u, __ATOMIC_RELAXED, __HIP_MEMORY_SCOPE_AGENT);
        if (wid == 0) {
            bool dead = false; const unsigned long long t0 = __builtin_amdgcn_s_memrealtime(); const unsigned want = 8u * (unsigned)ntn;
            for (;;) {
#if defined(BROKEN_NO_WAIT)
                break;
#endif
                if ((unsigned)__builtin_amdgcn_readfirstlane(__hip_atomic_load(cnt + 64 * u.pm, __ATOMIC_RELAXED, __HIP_MEMORY_SCOPE_AGENT)) >= want) break;
                if (__builtin_amdgcn_s_memrealtime() - t0 > 2000000ull) {
                    if (lane == 0) { unsigned expect = 0u; __hip_atomic_compare_exchange_strong(tmo + 1, &expect, code | (unsigned)(u.pm & 0xff), __ATOMIC_RELAXED, __ATOMIC_RELAXED, __HIP_MEMORY_SCOPE_AGENT);
                                     __hip_atomic_store(tmo, 1u, __ATOMIC_RELAXED, __HIP_MEMORY_SCOPE_AGENT); }
                    dead = true; break; }
                __builtin_amdgcn_s_sleep(2);
            }
            __builtin_amdgcn_fence(__ATOMIC_ACQUIRE, "agent");
            if (lane == 0) flag[0] = dead ? 1u : 0u;
        }
        asm volatile("s_waitcnt vmcnt(0) lgkmcnt(0)" ::: "memory"); __builtin_amdgcn_s_barrier(); asm volatile("" ::: "memory");
        const bool bad = flag[0] != 0u;
        if (lane < 32) {
            const unsigned long long* slot = (const unsigned long long*)xbuf + (size_t)(u.pm * BM + row) * 4; float mt[4], m2[4]; float ms = 0.f;
#pragma unroll
            for (int t = 0; t < 4; ++t) { if (t < ntn) { const unsigned long long w = __hip_atomic_load(slot + t, __ATOMIC_RELAXED, __HIP_MEMORY_SCOPE_AGENT); mt[t] = __uint_as_float((unsigned)w); m2[t] = __uint_as_float((unsigned)(w >> 32)); } else { mt[t] = 0.f; m2[t] = 0.f; } ms += mt[t]; }
            const float mean = ms / (float)ntn; float q = 0.f;
#pragma unroll
            for (int t = 0; t < 4; ++t) if (t < ntn) { const float dm = mt[t] - mean; q += m2[t] + 256.0f * dm * dm; }
            S[row] = (f32x2v){mean, 1.0f / sqrtf(q / (256.0f * (float)ntn) + eps)};
        }
        asm volatile("s_waitcnt lgkmcnt(0)" ::: "memory"); __builtin_amdgcn_s_barrier(); asm volatile("" ::: "memory");
        return bad;
    }
};
struct EpiLnRes {
    static constexpr bool PERM = false, AFTER_DRAIN = true;
    const float* base; float* out; int ldc; const float* bias; PanelStats st; unsigned poison;
    __device__ __forceinline__ void refuse(size_t i0, size_t stride, int M, int N) const { const float q = __builtin_nanf(""); for (size_t i = i0; i < (size_t)M * N; i += stride) out[(i / N) * ldc + i % N] = q;
        if (i0 == 0) { unsigned expect = 0u; __hip_atomic_compare_exchange_strong(st.tmo + 1, &expect, 0x7f0u, __ATOMIC_RELAXED, __ATOMIC_RELAXED, __HIP_MEMORY_SCOPE_AGENT); __hip_atomic_store(st.tmo, 1u, __ATOMIC_RELAXED, __HIP_MEMORY_SCOPE_AGENT); } }
    __device__ __forceinline__ void fused(f32x4 (&acc)[2][2][4][2], const Unit& u, int wr, int wc, int fr, int fq, PG8_LAS unsigned char* lds, int wid, int lane) const {
        typedef float f32x2v __attribute__((ext_vector_type(2)));
        const PG8_LAS f32x2v* S = (const PG8_LAS f32x2v*)(lds + 8192);
        const int col0 = u.pn * BM + wc * 32 + 4 * fq;
#pragma unroll
        for (int bj = 0; bj < 2; ++bj)
#pragma unroll
            for (int n = 0; n < 2; ++n) { const f32x4 bv = bias ? *(const f32x4*)(bias + col0 + bj * HALF + n * 16) : (f32x4){0.f, 0.f, 0.f, 0.f};
#pragma unroll
                for (int ai = 0; ai < 2; ++ai)
#pragma unroll
                    for (int m = 0; m < 4; ++m) acc[ai][bj][m][n] += bv; }
        const bool bad = st.run(acc, u, wr, wc, fr, fq, lds, wid, lane) || poison != 0u;
        const float qnan = __builtin_nanf("");
#pragma unroll
        for (int ai = 0; ai < 2; ++ai)
#pragma unroll
            for (int m = 0; m < 4; ++m) { const int r = ai * HALF + wr * 64 + m * 16 + fr; const f32x2v sr = S[r]; const size_t off = (size_t)(u.pm * BM + r) * ldc + col0;
#pragma unroll
                for (int bj = 0; bj < 2; ++bj)
#pragma unroll
                    for (int n = 0; n < 2; ++n) { const f32x4 bs = *(const f32x4*)(base + off + bj * HALF + n * 16); f32x4 o = bs + (acc[ai][bj][m][n] - sr.x) * sr.y;
                        if (bad) o = (f32x4){qnan, qnan, qnan, qnan}; *(f32x4*)(out + off + bj * HALF + n * 16) = o; }
                asm volatile("" ::: "memory"); }
    }
};
struct EpiLnResLn {
    static constexpr bool PERM = false, AFTER_DRAIN = true;
    const float* base; float* out; bf16_t* xn; int ldc; const float* bias; PanelStats st1, st2; unsigned poison;
    __device__ __forceinline__ void refuse(size_t i0, size_t stride, int M, int N) const { const float q = __builtin_nanf(""); for (size_t i = i0; i < (size_t)M * N; i += stride) { const size_t o = (i / N) * ldc + i % N; out[o] = q; xn[o] = (bf16_t)0x7fc0u; }
        if (i0 == 0) { unsigned expect = 0u; __hip_atomic_compare_exchange_strong(st1.tmo + 1, &expect, 0x7f0u, __ATOMIC_RELAXED, __ATOMIC_RELAXED, __HIP_MEMORY_SCOPE_AGENT); __hip_atomic_store(st1.tmo, 1u, __ATOMIC_RELAXED, __HIP_MEMORY_SCOPE_AGENT); } }
    __device__ __forceinline__ void fused(f32x4 (&acc)[2][2][4][2], const Unit& u, int wr, int wc, int fr, int fq, PG8_LAS unsigned char* lds, int wid, int lane) const {
        typedef float f32x2v __attribute__((ext_vector_type(2))); typedef unsigned u32x2v __attribute__((ext_vector_type(2)));
        const PG8_LAS f32x2v* S = (const PG8_LAS f32x2v*)(lds + 8192);
        const int col0 = u.pn * BM + wc * 32 + 4 * fq;
#pragma unroll
        for (int bj = 0; bj < 2; ++bj)
#pragma unroll
            for (int n = 0; n < 2; ++n) { const f32x4 bv = bias ? *(const f32x4*)(bias + col0 + bj * HALF + n * 16) : (f32x4){0.f, 0.f, 0.f, 0.f};
#pragma unroll
                for (int ai = 0; ai < 2; ++ai)
#pragma unroll
                    for (int m = 0; m < 4; ++m) acc[ai][bj][m][n] += bv; }
        bool bad = st1.run(acc, u, wr, wc, fr, fq, lds, wid, lane) || poison != 0u;
        const float qnan = __builtin_nanf("");
#pragma unroll
        for (int ai = 0; ai < 2; ++ai)
#pragma unroll
            for (int m = 0; m < 4; ++m) { const int r = ai * HALF + wr * 64 + m * 16 + fr; const f32x2v sr = S[r]; const size_t off = (size_t)(u.pm * BM + r) * ldc + col0;
#pragma unroll
                for (int bj = 0; bj < 2; ++bj)
#pragma unroll
                    for (int n = 0; n < 2; ++n) { const f32x4 bs = *(const f32x4*)(base + off + bj * HALF + n * 16); acc[ai][bj][m][n] = bs + (acc[ai][bj][m][n] - sr.x) * sr.y; }
                asm volatile("" : "+v"(acc[ai][0][m][0]), "+v"(acc[ai][0][m][1]), "+v"(acc[ai][1][m][0]), "+v"(acc[ai][1][m][1]));
                if (m & 1) asm volatile("" ::: "memory"); }
        const bool bad1 = bad;
        bad = st2.run(acc, u, wr, wc, fr, fq, lds, wid, lane) || bad;
#pragma unroll
        for (int ai = 0; ai < 2; ++ai)
#pragma unroll
            for (int m = 0; m < 4; ++m) { const int r = ai * HALF + wr * 64 + m * 16 + fr; const f32x2v sr = S[r]; const size_t off = (size_t)(u.pm * BM + r) * ldc + col0;
#pragma unroll
                for (int bj = 0; bj < 2; ++bj)
#pragma unroll
                    for (int n = 0; n < 2; ++n) { const f32x4 x1 = acc[ai][bj][m][n]; *(f32x4*)(out + off + bj * HALF + n * 16) = bad1 ? (f32x4){qnan, qnan, qnan, qnan} : x1;
                        const f32x4 o = (x1 - sr.x) * sr.y; u32x2v w; w.x = cvt_pk_bf16(o[0], o[1]); w.y = cvt_pk_bf16(o[2], o[3]);
                        if (bad) { w.x = 0x7fc07fc0u; w.y = 0x7fc07fc0u; } *(u32x2v*)(xn + off + bj * HALF + n * 16) = w; }
                asm volatile("" ::: "memory"); }
    }
};

template <class Epi, class Sched, bool STAMP = false>
__device__ __forceinline__ void gemm_phase(PG8_LAS unsigned char* lds, const Gemm g, const Sched& S, const Epi& E, unsigned long long* stamps) {
    const int tid = threadIdx.x, wid = __builtin_amdgcn_readfirstlane(tid >> 6), lane = tid & 63, wr = wid >> 2, wc = wid & 3, fr = lane & 15, fq = lane >> 4;
    const int K = g.K, nt = K / BK;
    int ts_lo = 0, ts_hi = 0, nts = 0; const unsigned long long rt_entry = STAMP ? (unsigned long long)wall_clock64() : 0ull;
#define PG8_STAMP() do { if (STAMP && wid == 0 && nts < 64) { const unsigned long long _c = (unsigned long long)clock64(); \
        ts_lo = (lane == nts) ? (int)(unsigned)_c : ts_lo; ts_hi = (lane == nts) ? (int)(unsigned)(_c >> 32) : ts_hi; ++nts; } } while (0)
    PG8_STAMP();
    unsigned voffA[2], voffB[2];
#pragma unroll
    for (int i = 0; i < 2; ++i) { int R, C; stage_rc(tid * 16 + i * 8192, R, C); const int Rb = Epi::PERM ? ((R & ~31) + perm32(R & 31)) : R;
        voffA[i] = (unsigned)(R * K + C) * 2u; voffB[i] = (unsigned)(Rb * K + C) * 2u; }
    const size_t kstep = (size_t)(BK * 2);
    const size_t hstep = (size_t)HALF * K * 2;
    const size_t tstep = 2 * hstep;
    const unsigned ldsw = (unsigned)wid * 1024u;
    const int aoff = lds_byte(wr * 64 + fr, fq * 8), boff = lds_byte(wc * 32 + fr, fq * 8);
#define PG8_SA(b, h) (((b) * 2 + (h)) * HTB)
#define PG8_SB(b, h) ((4 + (b) * 2 + (h)) * HTB)
#define PG8_STAGE(bufoff, gbase, voff) do { _Pragma("unroll") for (int _i = 0; _i < 2; ++_i) \
        __builtin_amdgcn_global_load_lds((const unsigned*)((const char*)(gbase) + (voff)[_i]), (PG8_LAS unsigned*)(lds + (bufoff) + ldsw + _i * 8192), 16, 0, 0); } while (0)
#define PG8_LDA(dst, b, h) do { _Pragma("unroll") for (int m = 0; m < 4; ++m) _Pragma("unroll") for (int k = 0; k < 2; ++k) dst[m][k] = *(const PG8_LAS bf16x8*)(lds + PG8_SA(b, h) + aoff + m * 2048 + k * 1024); } while (0)
#define PG8_LDB(dst, b, h) do { _Pragma("unroll") for (int n = 0; n < 2; ++n) _Pragma("unroll") for (int k = 0; k < 2; ++k) dst[n][k] = *(const PG8_LAS bf16x8*)(lds + PG8_SB(b, h) + boff + n * 2048 + k * 1024); } while (0)
#define PG8_MMA(ai, bj, At, Bt) do { __builtin_amdgcn_s_setprio(1); _Pragma("unroll") for (int m = 0; m < 4; ++m) _Pragma("unroll") for (int n = 0; n < 2; ++n) _Pragma("unroll") for (int k = 0; k < 2; ++k) \
        acc[ai][bj][m][n] = __builtin_amdgcn_mfma_f32_16x16x32_bf16(Bt[n][k], At[m][k], acc[ai][bj][m][n], 0, 0, 0); __builtin_amdgcn_s_setprio(0); } while (0)
#define PG8_WAIT_V(n) asm volatile("s_waitcnt vmcnt(" #n ")" ::: "memory")
#define PG8_WAIT_L(n) asm volatile("s_waitcnt lgkmcnt(" #n ")" ::: "memory")
#define PG8_BAR __builtin_amdgcn_s_barrier()
#define PG8_SCHED __builtin_amdgcn_sched_barrier(0)
    Unit cur, nxt; int ui = 0;
    if (!S.next(0, cur)) return;
    f32x4 acc[2][2][4][2];
#pragma unroll
    for (int a = 0; a < 2; ++a)
#pragma unroll
        for (int b = 0; b < 2; ++b)
#pragma unroll
            for (int m = 0; m < 4; ++m)
#pragma unroll
                for (int n = 0; n < 2; ++n) acc[a][b][m][n] = (f32x4){0.f, 0.f, 0.f, 0.f};
    bf16x8 At[4][2], B0[2][2], B1[2][2];
    const char* cA = (const char*)g.A + (size_t)cur.pm * tstep; const char* cB = (const char*)g.Bt + (size_t)cur.pn * tstep;
    S.a_ready(cur);
    PG8_STAGE(PG8_SB(0, 0), cB, voffB); PG8_STAGE(PG8_SA(0, 0), cA, voffA); PG8_STAGE(PG8_SB(0, 1), cB + hstep, voffB); PG8_STAGE(PG8_SA(0, 1), cA + hstep, voffA);
    if (wr == 1) PG8_BAR;
    PG8_WAIT_V(4); PG8_BAR;
    PG8_STAGE(PG8_SB(1, 0), cB + kstep, voffB); PG8_STAGE(PG8_SA(1, 0), cA + kstep, voffA); PG8_STAGE(PG8_SB(1, 1), cB + hstep + kstep, voffB);
    PG8_WAIT_V(6); PG8_BAR;
    PG8_STAMP();
    for (;;) {
        const bool has_next = S.next(ui + 1, nxt);
        const char* nA = has_next ? (const char*)g.A + (size_t)nxt.pm * tstep : cA; const char* nB = has_next ? (const char*)g.Bt + (size_t)nxt.pn * tstep : cB;
        for (int t = 0; t < nt; t += 2) {
            const bool last = (t == nt - 2);
            const char* a1 = cA + (size_t)(t + 1) * kstep;
            const char* a2 = last ? nA : cA + (size_t)(t + 2) * kstep; const char* b2 = last ? nB : cB + (size_t)(t + 2) * kstep;
            const char* a3 = a2 + kstep; const char* b3 = b2 + kstep;
            if (last && has_next) S.a_ready(nxt);
            PG8_LDB(B0, 0, 0); PG8_SCHED; PG8_LDA(At, 0, 0); PG8_STAGE(PG8_SA(1, 1), a1 + hstep, voffA);
            PG8_WAIT_L(8); PG8_BAR; PG8_WAIT_L(0); PG8_MMA(0, 0, At, B0); PG8_BAR; PG8_SCHED;
            PG8_LDB(B1, 0, 1); PG8_STAGE(PG8_SB(0, 0), b2, voffB);
            PG8_BAR; PG8_WAIT_L(0); PG8_MMA(0, 1, At, B1); PG8_BAR;
            PG8_LDA(At, 0, 1); PG8_STAGE(PG8_SA(0, 0), a2, voffA);
            PG8_BAR; PG8_WAIT_L(0); PG8_MMA(1, 0, At, B0); PG8_BAR; PG8_SCHED;
            PG8_STAGE(PG8_SB(0, 1), b2 + hstep, voffB);
            PG8_WAIT_V(6); PG8_BAR; PG8_MMA(1, 1, At, B1); PG8_BAR;
            PG8_LDB(B0, 1, 0); PG8_SCHED; PG8_LDA(At, 1, 0); PG8_STAGE(PG8_SA(0, 1), a2 + hstep, voffA);
            PG8_WAIT_L(8); PG8_BAR; PG8_WAIT_L(0); PG8_MMA(0, 0, At, B0); PG8_BAR; PG8_SCHED;
            PG8_LDB(B1, 1, 1); PG8_STAGE(PG8_SB(1, 0), b3, voffB);
            PG8_BAR; PG8_WAIT_L(0); PG8_MMA(0, 1, At, B1); PG8_BAR;
            PG8_LDA(At, 1, 1); PG8_STAGE(PG8_SA(1, 0), a3, voffA);
            PG8_BAR; PG8_WAIT_L(0); PG8_MMA(1, 0, At, B0); PG8_BAR; PG8_SCHED;
            PG8_STAGE(PG8_SB(1, 1), b3 + hstep, voffB);
            PG8_WAIT_V(6); PG8_BAR; PG8_MMA(1, 1, At, B1); PG8_BAR;
        }
        PG8_STAMP();
        if constexpr (!Epi::AFTER_DRAIN) { E(acc, cur, wr, wc, fr, fq); S.done(cur); }
        PG8_STAMP();
        if (!has_next) break;
#pragma unroll
        for (int a = 0; a < 2; ++a)
#pragma unroll
            for (int b = 0; b < 2; ++b)
#pragma unroll
                for (int m = 0; m < 4; ++m)
#pragma unroll
                    for (int n = 0; n < 2; ++n) acc[a][b][m][n] = (f32x4){0.f, 0.f, 0.f, 0.f};
        cur = nxt; cA = nA; cB = nB; ++ui;
    }
    PG8_WAIT_V(0);
    if (wr == 0) PG8_BAR;
    PG8_BAR;
    if constexpr (Epi::AFTER_DRAIN) { E.fused(acc, cur, wr, wc, fr, fq, lds, wid, lane); S.done(cur); }
    PG8_STAMP();
    if (STAMP && wid == 0) { stamps[lane] = lane < nts ? (((unsigned long long)(unsigned)ts_hi << 32) | (unsigned)ts_lo) : 0ull;
        if (lane == 62) stamps[62] = rt_entry; if (lane == 63) stamps[63] = (unsigned long long)wall_clock64(); }
#undef PG8_STAMP
#undef PG8_SA
#undef PG8_SB
#undef PG8_STAGE
#undef PG8_LDA
#undef PG8_LDB
#undef PG8_MMA
#undef PG8_WAIT_V
#undef PG8_WAIT_L
#undef PG8_BAR
#undef PG8_SCHED
}
}

constexpr int D = 1024, NB = 16, S = 2048, T = NB * S;
constexpr int NCOL = 2840, NPAD = 3072;
constexpr int C_Q = 0, C_KC = 512, C_VC = 640, C_KS = 768, C_VS = 896, C_KW = 1024, C_VW = 1152, C_GT = 1280, C_CB = 1304, C_CC = 1816, C_CH = 2328;
constexpr int NCMP = 127;
constexpr int NEXP = 16384;
constexpr float EPS = 1e-6f;
constexpr int NTHREADS = 512, NWAVES = 8;

constexpr size_t al256(size_t x) { return (x + 255) & ~(size_t)255; }
constexpr size_t WS_CTL   = 0;                                   constexpr size_t CTL_BYTES = 65536;
constexpr size_t WS_MOD   = WS_CTL + CTL_BYTES;
constexpr size_t WS_WIN   = al256(WS_MOD + (size_t)16 * 6144 * 4);
constexpr size_t WS_WOUT  = al256(WS_WIN + (size_t)NPAD * D * 2);
constexpr size_t WS_WQ    = al256(WS_WOUT + (size_t)D * D * 2);
constexpr size_t WS_KEYS  = al256(WS_WQ + (size_t)D * D * 2);
constexpr size_t WS_U8S   = al256(WS_KEYS + (size_t)16 * 128 * 64 * 2);
constexpr size_t WS_V8S   = al256(WS_U8S + (size_t)NEXP * D);
constexpr size_t WS_X8S   = al256(WS_V8S + (size_t)NEXP * D);
constexpr size_t WS_SU    = al256(WS_X8S + (size_t)T * D);
constexpr size_t WS_SV    = al256(WS_SU + (size_t)NEXP * 4);
constexpr size_t WS_SX    = al256(WS_SV + (size_t)NEXP * 4);
constexpr size_t WS_W1T   = al256(WS_SX + (size_t)T * 4);
constexpr size_t WS_W2T   = al256(WS_W1T + (size_t)2 * 64 * 2048 * 2);
constexpr size_t WS_PEC   = al256(WS_W2T + (size_t)2 * 64 * 64 * 2);
constexpr size_t WS_KC    = al256(WS_PEC + (size_t)2 * 8 * 64 * 4);
constexpr size_t WS_VC    = al256(WS_KC + (size_t)16 * 2 * 128 * 64 * 2);
constexpr size_t WS_H     = al256(WS_VC + (size_t)16 * 2 * 128 * 64 * 2);
constexpr size_t WS_CQ8   = WS_H;
constexpr size_t WS_CMAX  = WS_H + (size_t)32 * 1024 * 1024;
constexpr size_t WS_SSQP  = WS_H + (size_t)33 * 1024 * 1024;
constexpr size_t WS_OATT  = al256(WS_H + (size_t)T * D * 2);
constexpr size_t WS_PROJ  = al256(WS_OATT + (size_t)T * 512 * 2);
constexpr size_t WS_QP    = WS_PROJ;
constexpr size_t WS_PART  = WS_PROJ;
constexpr size_t WS_PO    = WS_PROJ;
constexpr size_t WS_E16   = WS_PROJ + (size_t)160 * 1024 * 1024;
constexpr size_t WS_EW    = WS_E16 + (size_t)T * 128 * 4;
constexpr size_t WS_Y     = al256(WS_PROJ + (size_t)T * NPAD * 2);
constexpr size_t WS_END   = al256(WS_Y + (size_t)T * D * 2);
static_assert(WS_EW + (size_t)T * 128 * 4 <= WS_Y, "alias region");
static_assert((size_t)8 * T * 128 * 4 <= (size_t)160 * 1024 * 1024, "PART fits under EIDX");
constexpr int CTL_CTR_A = 16384, CTL_CTR_B = 16384 + 8 * 256;

constexpr int LDS_STAGE = 147456;
constexpr int LDS_MISC_OFF = LDS_STAGE;
constexpr int LDS_BYTES = LDS_STAGE + 256;

typedef unsigned short bf16_t;
typedef short bf16x8 __attribute__((ext_vector_type(8)));
typedef short s16x4 __attribute__((ext_vector_type(4)));
typedef float f32x4 __attribute__((ext_vector_type(4)));
typedef unsigned u32x4v __attribute__((ext_vector_type(4)));
__device__ __forceinline__ float bf2f(bf16_t b) { return __uint_as_float(((unsigned)b) << 16); }
__device__ __forceinline__ bf16_t f2bf(float f) { unsigned u = __float_as_uint(f); u += 0x7FFFu + ((u >> 16) & 1u); return (bf16_t)(u >> 16); }
__device__ __forceinline__ float bflo(unsigned w) { return __uint_as_float(w << 16); }
__device__ __forceinline__ float bfhi(unsigned w) { return __uint_as_float(w & 0xFFFF0000u); }
__device__ __forceinline__ unsigned pack2(float lo, float hi) { return (unsigned)f2bf(lo) | ((unsigned)f2bf(hi) << 16); }
__device__ __forceinline__ float gelu_tanh(float x) { const float u = 0.7978845608028654f * (x + 0.044715f * x * x * x); return 0.5f * x * (1.0f + tanhf(u)); }
__device__ __forceinline__ float sigmoidf_(float x) { return 1.0f / (1.0f + __expf(-x)); }
__device__ __forceinline__ float wave_sum(float v) {
#pragma unroll
    for (int o = 32; o >= 1; o >>= 1) v += __shfl_xor(v, o);
    return v; }
__device__ __forceinline__ float wave_max(float v) {
#pragma unroll
    for (int o = 32; o >= 1; o >>= 1) v = fmaxf(v, __shfl_xor(v, o));
    return v; }
__device__ __forceinline__ void lds_wave_sync() { asm volatile("s_waitcnt lgkmcnt(0)" ::: "memory"); }
#ifdef PROBE_STAMP
#define STAMP_DECL unsigned long long tprev_ = 0ull; const bool dbg_ = (PROBE_PHASE == 12 || blockIdx.x == PROBE_BLOCK) && (threadIdx.x == 0);
#define STAMP_START() do { if (dbg_) tprev_ = __builtin_amdgcn_s_memtime(); } while (0)
#define STAMP(k) do { if (dbg_) { const unsigned long long tn_ = __builtin_amdgcn_s_memtime(); volatile LAS unsigned* c_ = (volatile LAS unsigned*)(F_lds_ + LDS_MISC_OFF + 128); c_[k] += (unsigned)(tn_ - tprev_); tprev_ = tn_; } } while (0)
#define STAMP_COUNT(k) do { if (dbg_) { volatile LAS unsigned* c_ = (volatile LAS unsigned*)(F_lds_ + LDS_MISC_OFF + 128); c_[k] += 1u; } } while (0)
#else
#define STAMP_DECL
#define STAMP_START() do {} while (0)
#define STAMP(k) do {} while (0)
#define STAMP_COUNT(k) do {} while (0)
#endif
#ifndef PROBE_BLOCK
#define PROBE_BLOCK 0
#endif
#ifndef PROBE_PHASE
#define PROBE_PHASE 4
#endif

__device__ __forceinline__ int rel_bucket(int dist) {
    const int n = dist > 0 ? dist : 0;
    if (n < 16) return n;
    const float lr = logf((float)n / 16.0f) / 2.0794415416798357f;
    const int large = 16 + (int)(lr * 16.0f);
    return large < 31 ? large : 31;
}

struct Frame {
    const float* in[23]; float* out; unsigned char* ws;
    LAS unsigned char* lds; int tid, lane, wave, G;
};


typedef int i32x4v __attribute__((ext_vector_type(4)));
constexpr int PEER_CHUNK_TOK = 128, PEER_NCHUNK = T / PEER_CHUNK_TOK;

__device__ __forceinline__ void quant_row_sliced(const float* row, unsigned char* dst8  , size_t nrows, size_t r, float* scale_out, int bias, int lane) {
    float4 v[4]; float am = 0.f;
#pragma unroll
    for (int i = 0; i < 4; ++i) { v[i] = *(const float4*)(row + (lane + 64 * i) * 4); am = fmaxf(am, fmaxf(fmaxf(fabsf(v[i].x), fabsf(v[i].y)), fmaxf(fabsf(v[i].z), fabsf(v[i].w)))); }
    am = wave_max(am); const float inv = am > 0.f ? 127.0f / am : 0.f;
    if (lane == 0) *scale_out = am > 0.f ? am / 127.0f : 0.f;
#pragma unroll
    for (int i = 0; i < 4; ++i) { const int col = (lane + 64 * i) * 4; const int sl = col >> 7, off = col & 127;
        const int q0 = (int)rintf(v[i].x * inv) + bias, q1 = (int)rintf(v[i].y * inv) + bias, q2 = (int)rintf(v[i].z * inv) + bias, q3 = (int)rintf(v[i].w * inv) + bias;
        *(unsigned*)(dst8 + ((size_t)sl * nrows + r) * 128 + off) = (unsigned)(q0 & 0xFF) | ((unsigned)(q1 & 0xFF) << 8) | ((unsigned)(q2 & 0xFF) << 16) | ((unsigned)(q3 & 0xFF) << 24); }
}

constexpr int PEER_NGRP = T / 16;
__device__ __forceinline__ int grab_item(unsigned* ctr, int slice, int lane) {
    unsigned v = 0u; if (lane == 0) v = __hip_atomic_fetch_add(ctr + slice * 64, 1u, __ATOMIC_RELAXED, __HIP_MEMORY_SCOPE_AGENT);
    return (int)__builtin_amdgcn_readfirstlane(v);
}
__device__ __forceinline__ void gather_rows16(u32x4v (&vv)[16], const unsigned char* base, const LAS unsigned* le) {
    const u32x4v e0 = *(const LAS u32x4v*)le, e1 = *(const LAS u32x4v*)(le + 4);
#pragma unroll
    for (int ld = 0; ld < 16; ++ld) { const unsigned w = ld < 8 ? e0[ld >> 1] : e1[(ld - 8) >> 1]; const unsigned e = (ld & 1) ? (w >> 16) : (w & 0xFFFFu);
        vv[ld] = *(const u32x4v*)(base + (size_t)e * 128); }
}
__device__ __forceinline__ void udot_item(const u32x4v (&uv)[16], const i32x4v xq, int* part_row  , int c) {
    i32x4v res[4];
#pragma unroll
    for (int ld = 0; ld < 16; ++ld) { int p = __builtin_amdgcn_sdot4((int)uv[ld][0], xq[0], 0, false); p = __builtin_amdgcn_sdot4((int)uv[ld][1], xq[1], p, false);
        p = __builtin_amdgcn_sdot4((int)uv[ld][2], xq[2], p, false); p = __builtin_amdgcn_sdot4((int)uv[ld][3], xq[3], p, false);
        p += __shfl_xor(p, 1); p += __shfl_xor(p, 2); p += __shfl_xor(p, 4); res[ld >> 2][ld & 3] = p; }
    if (c == 0) {
#pragma unroll
        for (int q = 0; q < 4; ++q) *(i32x4v*)(part_row + 4 * q) = res[q]; }
}
__device__ __forceinline__ void p10a_udots(const Frame& F) {
    const unsigned char* U8S = F.ws + WS_U8S; const unsigned char* X8S = F.ws + WS_X8S; const unsigned short* E16 = (const unsigned short*)(F.ws + WS_E16); int* PART = (int*)(F.ws + WS_PART);
    unsigned* ctr = (unsigned*)(F.ws + WS_CTL + CTL_CTR_A);
    const int lane = F.lane, j = lane >> 3, c = lane & 7; const int xcc = (int)(xb_xcc_id() & 7u);
    LAS unsigned char* wl = F.lds + F.wave * 8192;
    const LAS unsigned* le = (const LAS unsigned*)wl + 8 * j;
    for (int so = 0; so < 8; ++so) { const int x = (xcc + so) & 7;
        const unsigned char* ub = U8S + (size_t)x * NEXP * 128 + c * 16;
        int nxt = grab_item(ctr, x, lane);
        for (;;) { const int cur = nxt; if (cur >= PEER_NGRP) break;
            nxt = grab_item(ctr, x, lane);
            const int t0 = cur * 16;
            { const u32x4v* src = (const u32x4v*)(E16 + (size_t)t0 * 128);
#pragma unroll
                for (int i = 0; i < 4; ++i) *(LAS u32x4v*)(wl + (lane + 64 * i) * 16) = src[lane + 64 * i]; }
            lds_wave_sync();
            const unsigned char* xb = X8S + ((size_t)x * T + t0) * 128 + c * 16; int* pr = PART + ((size_t)x * T + t0) * 128 + 16 * j;
            u32x4v va[16], vb[16];
            gather_rows16(va, ub, le);
#pragma unroll 1
            for (int tt = 0; tt < 16; tt += 2) {
                const i32x4v xqa = *(const i32x4v*)(xb + (size_t)tt * 128), xqb = *(const i32x4v*)(xb + (size_t)(tt + 1) * 128);
                gather_rows16(vb, ub, le + (tt + 1) * 64);
                udot_item(va, xqa, pr + (size_t)tt * 128, c);
                if (tt + 2 < 16) gather_rows16(va, ub, le + (tt + 2) * 64);
                udot_item(vb, xqb, pr + (size_t)(tt + 1) * 128, c);
            }
            lds_wave_sync();
        }
    }
}

__device__ __forceinline__ void p10b_coef(const Frame& F) {
    const unsigned short* E16 = (const unsigned short*)(F.ws + WS_E16); const float* EW = (const float*)(F.ws + WS_EW); const int* PART = (const int*)(F.ws + WS_PART);
    const float* SU = (const float*)(F.ws + WS_SU); const float* SV = (const float*)(F.ws + WS_SV); const float* SX = (const float*)(F.ws + WS_SX);
    signed char* CQ8 = (signed char*)(F.ws + WS_CQ8); float* CMAX = (float*)(F.ws + WS_CMAX);
    const int gw = blockIdx.x * NWAVES + F.wave, nw = F.G * NWAVES, lane = F.lane;
    for (int t = gw; t < T; t += nw) { const float sx = SX[t]; float cs[2]; float am = 0.f;
#pragma unroll
        for (int hh = 0; hh < 2; ++hh) { const int i = lane + 64 * hh; int s = 0;
#pragma unroll
            for (int x = 0; x < 8; ++x) s += PART[((size_t)x * T + t) * 128 + i];
            const int e = E16[(size_t)t * 128 + i]; const float dot = (float)s * sx * SU[e];
            cs[hh] = EW[(size_t)t * 128 + i] * gelu_tanh(dot) * SV[e]; am = fmaxf(am, fabsf(cs[hh])); }
        am = wave_max(am); const float inv = am > 0.f ? 127.0f / am : 0.f;
#pragma unroll
        for (int hh = 0; hh < 2; ++hh) CQ8[(size_t)t * 128 + lane + 64 * hh] = (signed char)(int)rintf(cs[hh] * inv);
        if (lane == 0) CMAX[t] = am > 0.f ? am / 127.0f : 0.f; }
}

struct VsumPre { float sc; };
__device__ __forceinline__ void vsum_item(const u32x4v (&vv)[16], const LAS unsigned* lq  , const VsumPre& pre, unsigned* pop, int lane) {
    const u32x4v cq = *(const LAS u32x4v*)lq;
    int acc[16];
#pragma unroll
    for (int k = 0; k < 16; ++k) acc[k] = 0;
#pragma unroll
    for (int g = 0; g < 4; ++g) { const int cw = (int)cq[g];
#pragma unroll
        for (int w = 0; w < 4; ++w) { const unsigned r0 = vv[4 * g][w], r1 = vv[4 * g + 1][w], r2 = vv[4 * g + 2][w], r3 = vv[4 * g + 3][w];
            const unsigned t0 = __builtin_amdgcn_perm(r1, r0, 0x05010400u), t1 = __builtin_amdgcn_perm(r1, r0, 0x07030602u), t2 = __builtin_amdgcn_perm(r3, r2, 0x05010400u), t3 = __builtin_amdgcn_perm(r3, r2, 0x07030602u);
            const unsigned c0 = __builtin_amdgcn_perm(t2, t0, 0x05040100u), c1 = __builtin_amdgcn_perm(t2, t0, 0x07060302u), c2 = __builtin_amdgcn_perm(t3, t1, 0x05040100u), c3 = __builtin_amdgcn_perm(t3, t1, 0x07060302u);
            acc[4 * w + 0] = __builtin_amdgcn_sdot4((int)c0, cw, acc[4 * w + 0], false); acc[4 * w + 1] = __builtin_amdgcn_sdot4((int)c1, cw, acc[4 * w + 1], false);
            acc[4 * w + 2] = __builtin_amdgcn_sdot4((int)c2, cw, acc[4 * w + 2], false); acc[4 * w + 3] = __builtin_amdgcn_sdot4((int)c3, cw, acc[4 * w + 3], false); } }
    int a8[8], a4[4], a2[2];
    { const bool hi = (lane & 32) != 0;
#pragma unroll
        for (int k = 0; k < 8; ++k) { const int snd = hi ? acc[k] : acc[k + 8]; const int rcv = __shfl_xor(snd, 32); a8[k] = (hi ? acc[k + 8] : acc[k]) + rcv; } }
    { const bool hi = (lane & 16) != 0;
#pragma unroll
        for (int k = 0; k < 4; ++k) { const int snd = hi ? a8[k] : a8[k + 4]; const int rcv = __shfl_xor(snd, 16); a4[k] = (hi ? a8[k + 4] : a8[k]) + rcv; } }
    { const bool hi = (lane & 8) != 0;
#pragma unroll
        for (int k = 0; k < 2; ++k) { const int snd = hi ? a4[k] : a4[k + 2]; const int rcv = __shfl_xor(snd, 8); a2[k] = (hi ? a4[k + 2] : a4[k]) + rcv; } }
    *pop = pg8::cvt_pk_bf16((float)a2[0] * pre.sc, (float)a2[1] * pre.sc);
}
__device__ __forceinline__ void p10c_vsum(const Frame& F) {
    const unsigned char* V8S = F.ws + WS_V8S; const unsigned short* E16 = (const unsigned short*)(F.ws + WS_E16); const signed char* CQ8 = (const signed char*)(F.ws + WS_CQ8); const float* CMAX = (const float*)(F.ws + WS_CMAX);
    bf16_t* PO = (bf16_t*)(F.ws + WS_PO);
    unsigned* ctr = (unsigned*)(F.ws + WS_CTL + CTL_CTR_B);
    const int lane = F.lane, j = lane >> 3, c = lane & 7; const int xcc = (int)(xb_xcc_id() & 7u);
    const int ocol = 16 * c + 8 * ((lane >> 5) & 1) + 4 * ((lane >> 4) & 1) + 2 * ((lane >> 3) & 1);
    LAS unsigned char* wl = F.lds + F.wave * 8192;
    const LAS unsigned* le = (const LAS unsigned*)wl + 8 * j; const LAS unsigned* lq = (const LAS unsigned*)(wl + 4096) + 4 * j;
    for (int so = 0; so < 8; ++so) { const int x = (xcc + so) & 7;
        const unsigned char* vb = V8S + (size_t)x * NEXP * 128 + c * 16;
        const int col = x * 128 + ocol;
        int nxt = grab_item(ctr, x, lane);
        for (;;) { const int cur = nxt; if (cur >= PEER_NGRP) break;
            nxt = grab_item(ctr, x, lane);
            const int t0 = cur * 16;
            { const u32x4v* src = (const u32x4v*)(E16 + (size_t)t0 * 128); const u32x4v* srq = (const u32x4v*)(CQ8 + (size_t)t0 * 128);
#pragma unroll
                for (int i = 0; i < 4; ++i) *(LAS u32x4v*)(wl + (lane + 64 * i) * 16) = src[lane + 64 * i];
#pragma unroll
                for (int i = 0; i < 2; ++i) *(LAS u32x4v*)(wl + 4096 + (lane + 64 * i) * 16) = srq[lane + 64 * i]; }
            lds_wave_sync();
            u32x4v va[16], vbb[16];
            gather_rows16(va, vb, le);
#pragma unroll 1
            for (int tt = 0; tt < 16; tt += 2) {
                { VsumPre pa; pa.sc = CMAX[t0 + tt];
                  gather_rows16(vbb, vb, le + (tt + 1) * 64);
                  vsum_item(va, lq + tt * 32, pa, (unsigned*)(PO + (size_t)(t0 + tt) * D + col), lane); }
                { VsumPre pb; pb.sc = CMAX[t0 + tt + 1];
                  if (tt + 2 < 16) gather_rows16(va, vb, le + (tt + 2) * 64);
                  vsum_item(vbb, lq + (tt + 1) * 32, pb, (unsigned*)(PO + (size_t)(t0 + tt + 1) * D + col), lane); }
            }
            lds_wave_sync();
        }
    }
}

__device__ __forceinline__ void p10d_final(const Frame& F) {
    const bf16_t* PO = (const bf16_t*)(F.ws + WS_PO); const float* MOD = (const float*)(F.ws + WS_MOD); const float* gfin = F.in[22]; float* out = F.out;
    const int gw = blockIdx.x * NWAVES + F.wave, nw = F.G * NWAVES, lane = F.lane;
    const float* xin = F.in[0]; const bf16_t* Y = (const bf16_t*)(F.ws + WS_Y);
    float4 xn[4]; uint2 pn[4], yn[4];
    if (gw < T) {
#pragma unroll
        for (int i = 0; i < 4; ++i) { const int col = (lane + 64 * i) * 4; xn[i] = *(const float4*)(xin + (size_t)gw * D + col); pn[i] = *(const uint2*)(PO + (size_t)gw * D + col); yn[i] = *(const uint2*)(Y + (size_t)gw * D + col); } }
    for (int t = gw; t < T; t += nw) { const int b = t / S;
        float4 v[4], xc[4]; uint2 pc[4], yc[4]; float ss = 0.f;
#pragma unroll
        for (int i = 0; i < 4; ++i) { xc[i] = xn[i]; pc[i] = pn[i]; yc[i] = yn[i]; }
        { const int tn = t + nw < T ? t + nw : t;
#pragma unroll
            for (int i = 0; i < 4; ++i) { const int col = (lane + 64 * i) * 4; xn[i] = *(const float4*)(xin + (size_t)tn * D + col); pn[i] = *(const uint2*)(PO + (size_t)tn * D + col); yn[i] = *(const uint2*)(Y + (size_t)tn * D + col); } }
#pragma unroll
        for (int i = 0; i < 4; ++i) { const int col = (lane + 64 * i) * 4; const float4 g1 = *(const float4*)(MOD + b * 6144 + 2048 + col), gt = *(const float4*)(MOD + b * 6144 + 5120 + col);
            const uint2 pw = pc[i], yw = yc[i];
            v[i].x = xc[i].x + g1.x * bflo(yw.x) + gt.x * bflo(pw.x); v[i].y = xc[i].y + g1.y * bfhi(yw.x) + gt.y * bfhi(pw.x); v[i].z = xc[i].z + g1.z * bflo(yw.y) + gt.z * bflo(pw.y); v[i].w = xc[i].w + g1.w * bfhi(yw.y) + gt.w * bfhi(pw.y);
            ss += v[i].x * v[i].x + v[i].y * v[i].y + v[i].z * v[i].z + v[i].w * v[i].w; }
        ss = wave_sum(ss);
#ifdef PROBE_STAMP
        const unsigned* dg = (const unsigned*)(F.ws + WS_CTL + 32768); const float pnum = (float)dg[PROBE_STAMP]; const float pden = PROBE_DEN >= 0 ? (float)dg[PROBE_DEN >= 0 ? PROBE_DEN : 0] : (float)PROBE_ABS;
        const float rstd = rsqrtf(ss * (1.0f / D) + EPS) * (1.0f + 0.5f * pnum / pden);
#else
        const float rstd = rsqrtf(ss * (1.0f / D) + EPS);
#endif
#pragma unroll
        for (int i = 0; i < 4; ++i) { const int col = (lane + 64 * i) * 4; const float4 gg = *(const float4*)(gfin + col);
            *(float4*)(out + (size_t)t * D + col) = make_float4(v[i].x * rstd * gg.x, v[i].y * rstd * gg.y, v[i].z * rstd * gg.z, v[i].w * rstd * gg.w); }
    }
}

__device__ __forceinline__ void transpose_tile(const Frame& F, const float* src, int srcK, int srcN, bf16_t* dst, int dstK, int kt, int nt) {
    LAS float* tile = (LAS float*)F.lds;
    const int k0 = kt * 64, n0 = nt * 64;
    for (int i = F.tid; i < 4096; i += NTHREADS) { const int r = i >> 6, c = i & 63; const int k = k0 + r, n = n0 + c;
        tile[r * 65 + c] = (k < srcK && n < srcN) ? src[(size_t)k * srcN + n] : 0.0f; }
    __syncthreads();
    for (int i = F.tid; i < 4096; i += NTHREADS) { const int r = i >> 6, c = i & 63;
        dst[(size_t)(n0 + r) * dstK + k0 + c] = f2bf(tile[c * 65 + r]); }
    __syncthreads();
}
__device__ __forceinline__ void p0_prologue(const Frame& F, int item_lo = 0, int item_hi = 1 << 30) {
    const float* c = F.in[1]; const float* w_mod = F.in[4]; const float* b_mod = F.in[5];
    float* MOD = (float*)(F.ws + WS_MOD);
    constexpr int I_MOD = 96, I_WIN = 16 * 48, I_WOUT = 256, I_WQ = 256, I_U = 256, I_V = 256, I_KEYS = 32, I_CMP = 32 + 32 + 1 + 1 + 16;
    constexpr int O_WIN = I_MOD, O_WOUT = O_WIN + I_WIN, O_WQ = O_WOUT + I_WOUT, O_U = O_WQ + I_WQ, O_V = O_U + I_U, O_KEYS = O_V + I_V, O_CMP = O_KEYS + I_KEYS, N_ITEMS = O_CMP + I_CMP;
    for (int vit = item_lo + blockIdx.x; vit < N_ITEMS && vit < item_hi; vit += F.G) {
        int it = vit;
        if (vit >= O_WIN) { const int v = vit - O_WIN; constexpr int NO = I_KEYS + I_CMP, NQ = I_U + I_V;
            it = v < NO ? O_KEYS + v : (v < NO + NQ ? O_U + (v - NO) : O_WIN + (v - NO - NQ)); }
        if (it < O_WIN) {
            LAS float* sl = (LAS float*)F.lds; LAS float* red = (LAS float*)(F.lds + 65536);
            for (int q = F.tid; q < 16 * D; q += NTHREADS) { const float cv = c[q]; sl[q] = cv / (1.0f + __expf(-cv)); }
            __syncthreads();
            const int kg = F.tid >> 6, cl = F.tid & 63, j0 = it * 64;
            float acc[16];
#pragma unroll
            for (int bb = 0; bb < 16; ++bb) acc[bb] = 0.f;
            const float* wp = w_mod + (size_t)(kg * 128) * 6144 + j0 + cl;
#pragma unroll 4
            for (int kk = 0; kk < 128; ++kk) { const float w = wp[(size_t)kk * 6144]; const int k = kg * 128 + kk;
#pragma unroll
                for (int bb = 0; bb < 16; ++bb) acc[bb] += sl[bb * D + k] * w; }
#pragma unroll
            for (int bb = 0; bb < 16; ++bb) red[(kg * 16 + bb) * 64 + cl] = acc[bb];
            __syncthreads();
#pragma unroll
            for (int q = 0; q < 2; ++q) { const int o = F.tid + 512 * q; const int bb = o >> 6, cc = o & 63; float s = b_mod[j0 + cc];
#pragma unroll
                for (int g8 = 0; g8 < 8; ++g8) s += red[(g8 * 16 + bb) * 64 + cc];
                MOD[bb * 6144 + j0 + cc] = s; }
            __syncthreads();
        } else if (it < O_WOUT) { const int i = it - O_WIN; transpose_tile(F, F.in[6], D, NCOL, (bf16_t*)(F.ws + WS_WIN), D, i % 16, i / 16); }
        else if (it < O_WQ) { const int i = it - O_WOUT; transpose_tile(F, F.in[16], D, D, (bf16_t*)(F.ws + WS_WOUT), D, i % 16, i / 16); }
        else if (it < O_U) { const int i = it - O_WQ; transpose_tile(F, F.in[17], D, D, (bf16_t*)(F.ws + WS_WQ), D, i % 16, i / 16); }
        else if (it < O_KEYS) {
            const bool isv = it >= O_V; const int i = isv ? it - O_V : it - O_U;
            for (int rr = 0; rr < 8; ++rr) { const size_t r = (size_t)i * 64 + rr * 8 + F.wave;
                quant_row_sliced((isv ? F.in[20] : F.in[19]) + r * D, F.ws + (isv ? WS_V8S : WS_U8S), NEXP, r, (float*)(F.ws + (isv ? WS_SV : WS_SU)) + r, 0, F.lane); }
        } else if (it >= O_CMP) {
            const int i = it - O_CMP;
            if (i < 64) { const int kv = i >> 5; transpose_tile(F, kv ? F.in[11] : F.in[9], 2048, 64, (bf16_t*)(F.ws + WS_W1T) + (size_t)kv * 64 * 2048, 2048, i & 31, 0); }
            else if (i < 66) { const int kv = i - 64; transpose_tile(F, kv ? F.in[12] : F.in[10], 64, 64, (bf16_t*)(F.ws + WS_W2T) + (size_t)kv * 64 * 64, 64, 0, 0); }
            else { const int kv = (i - 66) >> 3, kq = (i - 66) & 7; const float* pe = kv ? F.in[8] : F.in[7]; const float* w1 = kv ? F.in[11] : F.in[9];
                LAS float* red = (LAS float*)F.lds; const int jj = F.tid & 63, kg = F.tid >> 6; float a = 0.f;
#pragma unroll
                for (int kk = 0; kk < 32; ++kk) { const int k = kq * 256 + kg * 32 + kk; a += pe[k] * w1[(size_t)k * 64 + jj]; }
                red[kg * 64 + jj] = a; __syncthreads();
                if (F.tid < 64) { float s = 0.f;
#pragma unroll
                    for (int g8 = 0; g8 < 8; ++g8) s += red[g8 * 64 + F.tid];
                    ((float*)(F.ws + WS_PEC))[(kv * 8 + kq) * 64 + F.tid] = s; }
                __syncthreads(); }
        } else {
            const int i = it - O_KEYS; const float4* src = (const float4*)F.in[18] + (size_t)i * 1024; uint2* dst = (uint2*)(F.ws + WS_KEYS) + (size_t)i * 1024;
#pragma unroll
            for (int q = 0; q < 2; ++q) { const float4 v = src[F.tid + 512 * q]; dst[F.tid + 512 * q] = make_uint2(pack2(v.x, v.y), pack2(v.z, v.w)); }
        }
    }
}

__device__ __forceinline__ void norm_mod_rows(const Frame& F, const float* x, const float* g, int sh_off, int sc_off, bf16_t* dst) {
    const float* MOD = (const float*)(F.ws + WS_MOD);
    const int gw = blockIdx.x * NWAVES + F.wave, nw = F.G * NWAVES;
    float4 vn[4];
    if (gw < T) {
#pragma unroll
        for (int i = 0; i < 4; ++i) vn[i] = ((const float4*)(x + (size_t)gw * D))[F.lane + 64 * i]; }
    for (int t = gw; t < T; t += nw) {
        const int b = t / S;
        float4 v[4]; float ss = 0.f;
#pragma unroll
        for (int i = 0; i < 4; ++i) { v[i] = vn[i]; ss += v[i].x * v[i].x + v[i].y * v[i].y + v[i].z * v[i].z + v[i].w * v[i].w; }
        { const int tn = t + nw < T ? t + nw : t;
#pragma unroll
            for (int i = 0; i < 4; ++i) vn[i] = ((const float4*)(x + (size_t)tn * D))[F.lane + 64 * i]; }
        ss = wave_sum(ss); const float rstd = rsqrtf(ss * (1.0f / D) + EPS);
#pragma unroll
        for (int i = 0; i < 4; ++i) { const int col = (F.lane + 64 * i) * 4;
            const float4 gg = *(const float4*)(g + col), sc = *(const float4*)(MOD + b * 6144 + sc_off + col), sh = *(const float4*)(MOD + b * 6144 + sh_off + col);
            const float o0 = v[i].x * rstd * gg.x * (1.f + sc.x) + sh.x, o1 = v[i].y * rstd * gg.y * (1.f + sc.y) + sh.y, o2 = v[i].z * rstd * gg.z * (1.f + sc.z) + sh.z, o3 = v[i].w * rstd * gg.w * (1.f + sc.w) + sh.w;
            *(uint2*)(dst + (size_t)t * D + col) = make_uint2(pack2(o0, o1), pack2(o2, o3)); }
    }
}

__device__ __forceinline__ void norm_mod_rows_q(const Frame& F, const float* x, const float* g, int sh_off, int sc_off, bf16_t* dst) {
    const float* MOD = (const float*)(F.ws + WS_MOD);
    const int gw = blockIdx.x * NWAVES + F.wave, nw = F.G * NWAVES;
    const bf16_t* Y = (const bf16_t*)(F.ws + WS_Y);
    float4 vn[4]; uint2 yn[4];
    if (gw < T) {
#pragma unroll
        for (int i = 0; i < 4; ++i) { vn[i] = ((const float4*)(x + (size_t)gw * D))[F.lane + 64 * i]; yn[i] = ((const uint2*)(Y + (size_t)gw * D))[F.lane + 64 * i]; } }
    for (int t = gw; t < T; t += nw) {
        const int b = t / S;
        float4 v[4]; float ss = 0.f;
#pragma unroll
        for (int i = 0; i < 4; ++i) { const int col = (F.lane + 64 * i) * 4; const float4 gt = *(const float4*)(MOD + b * 6144 + 2048 + col);
            v[i].x = vn[i].x + gt.x * bflo(yn[i].x); v[i].y = vn[i].y + gt.y * bfhi(yn[i].x); v[i].z = vn[i].z + gt.z * bflo(yn[i].y); v[i].w = vn[i].w + gt.w * bfhi(yn[i].y);
            ss += v[i].x * v[i].x + v[i].y * v[i].y + v[i].z * v[i].z + v[i].w * v[i].w; }
        { const int tn = t + nw < T ? t + nw : t;
#pragma unroll
            for (int i = 0; i < 4; ++i) { vn[i] = ((const float4*)(x + (size_t)tn * D))[F.lane + 64 * i]; yn[i] = ((const uint2*)(Y + (size_t)tn * D))[F.lane + 64 * i]; } }
        ss = wave_sum(ss); const float rstd = rsqrtf(ss * (1.0f / D) + EPS);
        float am = 0.f;
#pragma unroll
        for (int i = 0; i < 4; ++i) { const int col = (F.lane + 64 * i) * 4;
            const float4 gg = *(const float4*)(g + col), sc = *(const float4*)(MOD + b * 6144 + sc_off + col), sh = *(const float4*)(MOD + b * 6144 + sh_off + col);
            v[i].x = v[i].x * rstd * gg.x * (1.f + sc.x) + sh.x; v[i].y = v[i].y * rstd * gg.y * (1.f + sc.y) + sh.y; v[i].z = v[i].z * rstd * gg.z * (1.f + sc.z) + sh.z; v[i].w = v[i].w * rstd * gg.w * (1.f + sc.w) + sh.w;
            *(uint2*)(dst + (size_t)t * D + col) = make_uint2(pack2(v[i].x, v[i].y), pack2(v[i].z, v[i].w));
            am = fmaxf(am, fmaxf(fmaxf(fabsf(v[i].x), fabsf(v[i].y)), fmaxf(fabsf(v[i].z), fabsf(v[i].w)))); }
        am = wave_max(am); const float inv = am > 0.f ? 127.0f / am : 0.f;
        if (F.lane == 0) ((float*)(F.ws + WS_SX))[t] = am > 0.f ? am / 127.0f : 0.f;
#pragma unroll
        for (int i = 0; i < 4; ++i) { const int col = (F.lane + 64 * i) * 4; const int sl = col >> 7, off = col & 127;
            const int q0 = (int)rintf(v[i].x * inv), q1 = (int)rintf(v[i].y * inv), q2 = (int)rintf(v[i].z * inv), q3 = (int)rintf(v[i].w * inv);
            *(unsigned*)(F.ws + WS_X8S + ((size_t)sl * T + t) * 128 + off) = (unsigned)(q0 & 0xFF) | ((unsigned)(q1 & 0xFF) << 8) | ((unsigned)(q2 & 0xFF) << 16) | ((unsigned)(q3 & 0xFF) << 24); }
    }
}

__device__ __forceinline__ void p3_compress_naive(const Frame& F) {
    const bf16_t* PROJ = (const bf16_t*)(F.ws + WS_PROJ);
    LAS float* hid = (LAS float*)F.lds + F.wave * 64;
    const int gw = blockIdx.x * NWAVES + F.wave, nw = F.G * NWAVES;
    if (gw < 64) { bf16_t* dz = (bf16_t*)(F.ws + ((gw & 1) ? WS_VC : WS_KC)); dz[((size_t)(gw >> 1) * 128 + 127) * 64 + F.lane] = 0; }
    for (int u = gw; u < NB * NCMP * 2 * 2; u += nw) {
        const int kv = u & 1, g = (u >> 1) & 1, n = (u >> 2) % NCMP, b = (u >> 2) / NCMP;
        const float* pe = kv ? F.in[8] : F.in[7]; const float* w1 = kv ? F.in[11] : F.in[9]; const float* w2 = kv ? F.in[12] : F.in[10];
        const int cbase = (kv ? C_VC : C_KC) + g * 64;
        float acc = 0.f;
        for (int l = 0; l < 32; ++l) {
            const bf16_t* row = PROJ + (size_t)(b * S + 16 * n + l) * NPAD + cbase;
            for (int d = 0; d < 64; ++d) { const float a = bf2f(row[d]) + pe[l * 64 + d]; acc += a * w1[(size_t)(l * 64 + d) * 64 + F.lane]; }
        }
        hid[F.lane] = gelu_tanh(acc); lds_wave_sync();
        float o = 0.f;
        for (int j = 0; j < 64; ++j) o += hid[j] * w2[j * 64 + F.lane];
        bf16_t* dst = (bf16_t*)(F.ws + (kv ? WS_VC : WS_KC)); dst[((size_t)(b * 2 + g) * 128 + n) * 64 + F.lane] = f2bf(o);
        lds_wave_sync();
    }
}


__device__ __forceinline__ void p3_compress_mfma(const Frame& F) {
    const bf16_t* PROJ = (const bf16_t*)(F.ws + WS_PROJ);
    const int lane = F.lane, tid = F.tid, wave = F.wave, grp = lane >> 4, col = lane & 15;
    LAS float* red = (LAS float*)F.lds;
    LAS bf16_t* hid = (LAS bf16_t*)(F.lds + 32768);
    if (blockIdx.x * NWAVES + wave < 64) { const int gw = blockIdx.x * NWAVES + wave; bf16_t* dz = (bf16_t*)(F.ws + ((gw & 1) ? WS_VC : WS_KC)); dz[((size_t)(gw >> 1) * 128 + 127) * 64 + lane] = 0; }
    for (int u = blockIdx.x; u < NB * 2 * 2 * 8; u += F.G) {
        const int nt8 = u & 7, kv = (u >> 3) & 1, g = (u >> 4) & 1, b = u >> 5; const int n0 = nt8 * 16;
        const bf16_t* W1T = (const bf16_t*)(F.ws + WS_W1T) + (size_t)kv * 64 * 2048; const bf16_t* W2T = (const bf16_t*)(F.ws + WS_W2T) + (size_t)kv * 64 * 64;
        const float* pec = (const float*)(F.ws + WS_PEC) + kv * 512;
        const int cbase = (kv ? C_VC : C_KC) + g * 64;
        const int nrow = (n0 + col) < NCMP ? (n0 + col) : (NCMP - 1);
        f32x4 acc[4];
#pragma unroll
        for (int nt = 0; nt < 4; ++nt) acc[nt] = (f32x4){0.f, 0.f, 0.f, 0.f};
#pragma unroll
        for (int ks = 0; ks < 8; ++ks) { const int l = 4 * wave + (ks >> 1), d0 = (ks & 1) * 32 + 8 * grp;
            const bf16x8 af = *(const bf16x8*)(PROJ + (size_t)(b * S + 16 * nrow + l) * NPAD + cbase + d0);
#pragma unroll
            for (int nt = 0; nt < 4; ++nt) { const bf16x8 bfr = *(const bf16x8*)(W1T + (size_t)(nt * 16 + col) * 2048 + l * 64 + d0);
                acc[nt] = __builtin_amdgcn_mfma_f32_16x16x32_bf16(af, bfr, acc[nt], 0, 0, 0); } }
#pragma unroll
        for (int nt = 0; nt < 4; ++nt)
#pragma unroll
            for (int rg = 0; rg < 4; ++rg) red[(wave * 16 + 4 * grp + rg) * 64 + nt * 16 + col] = acc[nt][rg];
        __syncthreads();
#pragma unroll
        for (int q = 0; q < 2; ++q) { const int idx = tid + 512 * q; float s = 0.f;
#pragma unroll
            for (int g8 = 0; g8 < 8; ++g8) s += pec[g8 * 64 + (idx & 63)];
#pragma unroll
            for (int w = 0; w < 8; ++w) s += red[w * 1024 + idx];
            hid[idx] = f2bf(gelu_tanh(s)); }
        __syncthreads();
        if (wave < 4) { f32x4 o = (f32x4){0.f, 0.f, 0.f, 0.f};
#pragma unroll
            for (int ks = 0; ks < 2; ++ks) { const bf16x8 af = *(const LAS bf16x8*)(hid + col * 64 + ks * 32 + 8 * grp); const bf16x8 bfr = *(const bf16x8*)(W2T + (size_t)(wave * 16 + col) * 64 + ks * 32 + 8 * grp);
                o = __builtin_amdgcn_mfma_f32_16x16x32_bf16(af, bfr, o, 0, 0, 0); }
            bf16_t* dst = (bf16_t*)(F.ws + (kv ? WS_VC : WS_KC));
#pragma unroll
            for (int rg = 0; rg < 4; ++rg) { const int n = n0 + 4 * grp + rg; if (n < NCMP) dst[((size_t)(b * 2 + g) * 128 + n) * 64 + wave * 16 + col] = f2bf(o[rg]); } }
        __syncthreads();
    }
}

__device__ __forceinline__ void dot4_row(const bf16_t* krow, const LAS float* qs, float (&acc)[4]) {
    const uint4* kr = (const uint4*)krow;
#pragma unroll 1
    for (int c = 0; c < 8; ++c) { asm volatile("" ::: "memory"); const uint4 w = kr[c]; const unsigned ww[4] = {w.x, w.y, w.z, w.w};
#pragma unroll
        for (int e = 0; e < 4; ++e) { const float k0 = bflo(ww[e]), k1 = bfhi(ww[e]); const int d = c * 8 + e * 2;
#pragma unroll
            for (int r = 0; r < 4; ++r) acc[r] += qs[r * 64 + d] * k0 + qs[r * 64 + d + 1] * k1; } }
}
__device__ __forceinline__ void p4_attn_naive(const Frame& F) {
    const bf16_t* PROJ = (const bf16_t*)(F.ws + WS_PROJ); const bf16_t* KC = (const bf16_t*)(F.ws + WS_KC); const bf16_t* VC = (const bf16_t*)(F.ws + WS_VC);
    bf16_t* OATT = (bf16_t*)(F.ws + WS_OATT); const float* rel = F.in[21];
    LAS float* wl = (LAS float*)F.lds + F.wave * (256 + 512 + 2048 + 16);
    LAS float* qs = wl; LAS float* pc = wl + 256; LAS float* ps = wl + 768; LAS int* pbase = (LAS int*)(wl + 768 + 2048);
    const int gw = blockIdx.x * NWAVES + F.wave, nw = F.G * NWAVES, lane = F.lane;
    for (int u = gw; u < T * 2; u += nw) {
        const int g = u & 1, tok = u >> 1, b = tok / S, t = tok % S;
        const bf16_t* prow = PROJ + (size_t)tok * NPAD;
#pragma unroll
        for (int r = 0; r < 4; ++r) qs[r * 64 + lane] = bf2f(prow[C_Q + (g * 4 + r) * 64 + lane]) * 0.125f;
        lds_wave_sync();
        const int nv = t >= 31 ? ((t - 31) >> 4) + 1 : 0;
        float sc[2][4]; bool va[2];
#pragma unroll
        for (int i = 0; i < 2; ++i) { const int n = lane + 64 * i; va[i] = n < nv; float a[4] = {0.f, 0.f, 0.f, 0.f};
            if (va[i]) { dot4_row(KC + ((size_t)(b * 2 + g) * 128 + n) * 64, qs, a); const int bk = rel_bucket(t - (16 * n + 31));
#pragma unroll
                for (int r = 0; r < 4; ++r) a[r] += rel[bk * 8 + g * 4 + r]; }
#pragma unroll
            for (int r = 0; r < 4; ++r) sc[i][r] = va[i] ? a[r] : -1e30f; }
        float ocmp[4];
#pragma unroll
        for (int r = 0; r < 4; ++r) { const float m = wave_max(fmaxf(sc[0][r], sc[1][r]));
            const float e0 = va[0] ? __expf(sc[0][r] - m) : 0.f, e1 = va[1] ? __expf(sc[1][r] - m) : 0.f; const float sum = wave_sum(e0 + e1);
            const float inv = nv > 0 ? 1.0f / sum : 0.f; pc[r * 128 + lane] = e0 * inv; pc[r * 128 + 64 + lane] = e1 * inv; }
        lds_wave_sync();
        { float o[4] = {0.f, 0.f, 0.f, 0.f}; const bf16_t* vb = VC + ((size_t)(b * 2 + g) * 128) * 64 + lane;
            for (int n = 0; n < nv; ++n) { const float v = bf2f(vb[n * 64]);
#pragma unroll
                for (int r = 0; r < 4; ++r) o[r] += pc[r * 128 + n] * v; }
#pragma unroll
            for (int r = 0; r < 4; ++r) ocmp[r] = o[r]; }
        const int cur = t >> 6; float val;
        { const int j = lane & 31; float imp = 0.f;
#pragma unroll
            for (int r = 0; r < 4; ++r) for (int n = 4 * j - 1; n <= 4 * j + 3; ++n) if (n >= 0 && n < NCMP) imp += pc[r * 128 + n];
            const bool forced = (j == 0) || (j == cur) || (j == cur - 1); const bool allowed = j <= cur;
            val = forced ? 1e4f : (allowed ? imp : -INFINITY); }
        int rank = 0;
        for (int jp = 0; jp < 32; ++jp) { const float vp = __shfl(val, jp); rank += ((vp > val) || (vp == val && jp < (lane & 31))) ? 1 : 0; }
        unsigned selmask = (unsigned)(__ballot(lane < 32 && rank < 8) & 0xFFFFFFFFull);
        float oslc[4], owin[4];
#pragma unroll
        for (int br = 0; br < 2; ++br) {
            const int ck = br == 0 ? C_KS : C_KW, cv = br == 0 ? C_VS : C_VW;
            unsigned mk = selmask;
#pragma unroll 1
            for (int c = 0; c < 8; ++c) {
                int kpos, bs;
                if (br == 0) { const int j = __builtin_ctz(mk | 0x80000000u); mk &= mk - 1; bs = 64 * j; } else { bs = t - 511 + 64 * c; }
                kpos = bs + lane; if (lane == 0) pbase[c] = bs;
                const int dist = t - kpos; const bool vv = (dist >= 0) && (kpos >= 0) && (kpos < S);
                float a[4] = {0.f, 0.f, 0.f, 0.f};
                if (vv) { dot4_row(PROJ + (size_t)(b * S + kpos) * NPAD + ck + g * 64, qs, a); const int bk = rel_bucket(dist);
#pragma unroll
                    for (int r = 0; r < 4; ++r) a[r] += rel[bk * 8 + g * 4 + r]; }
#pragma unroll
                for (int r = 0; r < 4; ++r) ps[r * 512 + c * 64 + lane] = vv ? a[r] : -1e30f;
            }
            lds_wave_sync();
#pragma unroll 1
            for (int r = 0; r < 4; ++r) { float m = -1e30f;
#pragma unroll
                for (int c = 0; c < 8; ++c) m = fmaxf(m, ps[r * 512 + c * 64 + lane]);
                m = wave_max(m); float e[8], sum = 0.f;
#pragma unroll
                for (int c = 0; c < 8; ++c) { const float sv = ps[r * 512 + c * 64 + lane]; e[c] = sv > -1e29f ? __expf(sv - m) : 0.f; sum += e[c]; }
                sum = wave_sum(sum); const float inv = sum > 0.f ? 1.0f / sum : 0.f;
#pragma unroll
                for (int c = 0; c < 8; ++c) ps[r * 512 + c * 64 + lane] = e[c] * inv; }
            lds_wave_sync();
            float o[4] = {0.f, 0.f, 0.f, 0.f};
#pragma unroll 1
            for (int c = 0; c < 8; ++c) {
                const int bsc = pbase[c];
                for (int kk = 0; kk < 64; ++kk) { const int kpos = bsc + kk; if (kpos < 0 || kpos > t) continue;
                    const float v = bf2f(PROJ[(size_t)(b * S + kpos) * NPAD + cv + g * 64 + lane]);
#pragma unroll
                    for (int r = 0; r < 4; ++r) o[r] += ps[r * 512 + c * 64 + kk] * v; } }
            lds_wave_sync();
#pragma unroll
            for (int r = 0; r < 4; ++r) { if (br == 0) oslc[r] = o[r]; else owin[r] = o[r]; }
        }
#pragma unroll
        for (int r = 0; r < 4; ++r) { const int h = g * 4 + r;
            const float g0 = sigmoidf_(bf2f(prow[C_GT + h * 3 + 0])), g1 = sigmoidf_(bf2f(prow[C_GT + h * 3 + 1])), g2 = sigmoidf_(bf2f(prow[C_GT + h * 3 + 2]));
            OATT[(size_t)tok * 512 + h * 64 + lane] = f2bf(g0 * ocmp[r] + g1 * oslc[r] + g2 * owin[r]); }
    }
}


constexpr float LOG2E = 1.4426950408889634f;
constexpr int AT_KC = 0, AT_VC = 16384, AT_KV = 32768  , AT_BTAB = 65536, AT_IMP = 69888, AT_SEL = 78336, AT_OUT = 78592  , AT_END = 78592 + 65536;
constexpr int BT_STRIDE = 132;
__device__ __forceinline__ int tile_off(int row, int chunk) { return row * 128 + ((chunk ^ (row & 7)) << 4); }
__device__ __forceinline__ bf16x8 mk_frag(unsigned a, unsigned b, unsigned c, unsigned d) { u32x4v v = {a, b, c, d}; return __builtin_bit_cast(bf16x8, v); }
struct LaneOffs { int koff[2]; int voff[4]; int soff; };
__device__ __forceinline__ LaneOffs lane_offs(int lane, int tid) {
    LaneOffs L; const int grp = lane >> 4, rowi = lane & 15, q4 = rowi >> 2, p = lane & 3;
#pragma unroll
    for (int ks = 0; ks < 2; ++ks) L.koff[ks] = tile_off(rowi, ks * 4 + grp);
#pragma unroll
    for (int dt = 0; dt < 4; ++dt) L.voff[dt] = tile_off(4 * grp + q4, 2 * dt + (p >> 1)) + 8 * (p & 1);
    L.soff = tile_off(tid >> 3, tid & 7); return L;
}
__device__ __forceinline__ bf16x8 vfrag_read(const LAS unsigned char* vt, int voff_dt, int row0) {
    const s16x4 a = __builtin_amdgcn_ds_read_tr16_b64_v4i16((LAS s16x4*)(vt + voff_dt + row0 * 128));
    const s16x4 b = __builtin_amdgcn_ds_read_tr16_b64_v4i16((LAS s16x4*)(vt + voff_dt + row0 * 128 + 2048));
    bf16x8 f = {a[0], a[1], a[2], a[3], b[0], b[1], b[2], b[3]}; return f;
}


struct AttnState {
    f32x4 o[4][2]; float m[2], l[2];
};

__device__ __forceinline__ void at_qk(f32x4 (&sacc)[4][2], const LAS unsigned char* kt_lds, const bf16x8 (&qf)[2][2], const LaneOffs& Lu) {
    int ln_ = threadIdx.x & 63; asm volatile("" : "+v"(ln_)); const LaneOffs L = lane_offs(ln_, 0); (void)Lu;
#pragma unroll
    for (int kt = 0; kt < 4; ++kt) { sacc[kt][0] = (f32x4){0.f, 0.f, 0.f, 0.f}; sacc[kt][1] = (f32x4){0.f, 0.f, 0.f, 0.f}; }
#pragma unroll
    for (int kt = 0; kt < 4; ++kt)
#pragma unroll
        for (int ks = 0; ks < 2; ++ks) { const bf16x8 kf = *(const LAS bf16x8*)(kt_lds + L.koff[ks] + kt * 2048);
            sacc[kt][0] = __builtin_amdgcn_mfma_f32_16x16x32_bf16(kf, qf[0][ks], sacc[kt][0], 0, 0, 0);
            sacc[kt][1] = __builtin_amdgcn_mfma_f32_16x16x32_bf16(kf, qf[1][ks], sacc[kt][1], 0, 0, 0); }
}
__device__ __forceinline__ void at_pv(AttnState& st, const LAS unsigned char* vt_lds, const bf16x8 (&pf)[2][2], const LaneOffs& Lu) {
    int ln_ = threadIdx.x & 63; asm volatile("" : "+v"(ln_)); const LaneOffs L = lane_offs(ln_, 0); (void)Lu;
#pragma unroll
    for (int ks = 0; ks < 2; ++ks)
#pragma unroll
        for (int dt = 0; dt < 4; ++dt) { const bf16x8 vf = vfrag_read(vt_lds, L.voff[dt], 32 * ks);
            st.o[dt][0] = __builtin_amdgcn_mfma_f32_16x16x32_bf16(vf, pf[0][ks], st.o[dt][0], 0, 0, 0);
            st.o[dt][1] = __builtin_amdgcn_mfma_f32_16x16x32_bf16(vf, pf[1][ks], st.o[dt][1], 0, 0, 0); }
}
template <int BR>
__device__ __forceinline__ void at_softmax(f32x4 (&sacc)[4][2], bf16x8 (&pf)[2][2], const LAS float* btab_h, const int (&tq)[2], const unsigned (&sel)[2], int j, bool near, AttnState& st, int lane) {
    const int grp = lane >> 4, kbase = 64 * j;
    const float SC = 0.125f * LOG2E; const float bfar = btab_h[128];
    const int cur_blk = tq[0] >> 6;
    const bool full = BR == 0 ? (j == cur_blk) : (j == cur_blk || j + 8 == cur_blk);
    const bool fast = !near && !full;
    const bool selq[2] = {BR == 0 ? ((sel[0] >> j) & 1u) != 0u : true, BR == 0 ? ((sel[1] >> j) & 1u) != 0u : true};
    float tmax[2];
    if (fast) {
#pragma unroll
        for (int qt = 0; qt < 2; ++qt) {
            float r0 = fmaxf(fmaxf(sacc[0][qt][0], sacc[0][qt][1]), fmaxf(sacc[0][qt][2], sacc[0][qt][3]));
#pragma unroll
            for (int kt = 1; kt < 4; ++kt) r0 = fmaxf(r0, fmaxf(fmaxf(sacc[kt][qt][0], sacc[kt][qt][1]), fmaxf(sacc[kt][qt][2], sacc[kt][qt][3])));
            tmax[qt] = selq[qt] ? r0 * SC + bfar : -1e30f; }
    } else {
#pragma unroll
        for (int qt = 0; qt < 2; ++qt) {
            float tm = -1e30f;
            int d0 = tq[qt] - 4 * grp - kbase; asm volatile("" : "+v"(d0));
#pragma unroll
            for (int kt = 0; kt < 4; ++kt)
#pragma unroll
                for (int rg = 0; rg < 4; ++rg) { const int c = kt * 16 + rg;
                    float bias = bfar; if (near) { const int dist = d0 - c; const int dd = dist < 0 ? 0 : (dist > 128 ? 128 : dist); bias = btab_h[dd]; }
                    const bool valid = BR == 0 ? (selq[qt] && d0 >= c) : (d0 >= c && d0 < 512 + c);
                    const float sx = sacc[kt][qt][rg] * SC + bias; const float s = valid ? sx : -1e30f; sacc[kt][qt][rg] = s; tm = fmaxf(tm, s); }
            tmax[qt] = tm; }
    }
    { const float a0 = __shfl_xor(tmax[0], 16), a1 = __shfl_xor(tmax[1], 16); tmax[0] = fmaxf(tmax[0], a0); tmax[1] = fmaxf(tmax[1], a1); }
    { const float a0 = __shfl_xor(tmax[0], 32), a1 = __shfl_xor(tmax[1], 32); tmax[0] = fmaxf(tmax[0], a0); tmax[1] = fmaxf(tmax[1], a1); }
    float alpha[2], muse[2];
#pragma unroll
    for (int qt = 0; qt < 2; ++qt) { const float mnew = fmaxf(st.m[qt], tmax[qt]); alpha[qt] = __builtin_amdgcn_exp2f(st.m[qt] - mnew); st.m[qt] = mnew; muse[qt] = mnew < -1e29f ? 0.f : mnew; }
#pragma unroll
    for (int qt = 0; qt < 2; ++qt) { const float mul = fast ? SC : 1.0f; const float add = fast ? (selq[qt] ? bfar - muse[qt] : -1e30f) : -muse[qt];
#pragma unroll
        for (int kt = 0; kt < 4; ++kt)
#pragma unroll
            for (int rg = 0; rg < 4; ++rg) sacc[kt][qt][rg] = __builtin_amdgcn_exp2f(sacc[kt][qt][rg] * mul + add); }
#pragma unroll
    for (int qt = 0; qt < 2; ++qt) {
        float ls = 0.f; unsigned pk[4][2];
#pragma unroll
        for (int kt = 0; kt < 4; ++kt) { ls += (sacc[kt][qt][0] + sacc[kt][qt][1]) + (sacc[kt][qt][2] + sacc[kt][qt][3]);
            pk[kt][0] = pg8::cvt_pk_bf16(sacc[kt][qt][0], sacc[kt][qt][1]); pk[kt][1] = pg8::cvt_pk_bf16(sacc[kt][qt][2], sacc[kt][qt][3]); }
        st.l[qt] = st.l[qt] * alpha[qt] + ls;
        pf[qt][0] = mk_frag(pk[0][0], pk[0][1], pk[1][0], pk[1][1]); pf[qt][1] = mk_frag(pk[2][0], pk[2][1], pk[3][0], pk[3][1]); }
    if (!__all(alpha[0] == 1.0f && alpha[1] == 1.0f)) {
#pragma unroll
        for (int qt = 0; qt < 2; ++qt)
#pragma unroll
            for (int dt = 0; dt < 4; ++dt) st.o[dt][qt] *= alpha[qt]; }
    __builtin_amdgcn_sched_barrier(0);
}
template <int BR>
__device__ __forceinline__ void attn_tile(const LAS unsigned char* kt_lds, const LAS unsigned char* vt_lds, const LAS float* btab_h, const bf16x8 (&qf)[2][2], const int (&tq)[2], const unsigned (&sel)[2],
                                          int j, bool near, AttnState& st, int lane, const LaneOffs& L, LAS unsigned char* F_lds_, unsigned wsel = 0xFFFFFFFFu) {
#if defined(PROBE_STAMP) && PROBE_LEVEL >= 2
    STAMP_DECL; STAMP_START();
#define TSTAMP(k) STAMP(k)
#else
#define TSTAMP(k) do {} while (0)
#endif
    if (BR == 0 && ((wsel >> j) & 1u) == 0u) return;
    f32x4 sacc[4][2]; bf16x8 pf[2][2];
    at_qk(sacc, kt_lds, qf, L);
    __builtin_amdgcn_sched_barrier(0);
    TSTAMP(0);
#if defined(PROBE_STAMP) && PROBE_LEVEL >= 3
    { float x_ = sacc[3][1][3]; asm volatile("" :: "v"(x_)); }
    TSTAMP(3);
#endif
    at_softmax<BR>(sacc, pf, btab_h, tq, sel, j, near, st, lane);
    TSTAMP(1);
    at_pv(st, vt_lds, pf, L);
    TSTAMP(2);
#undef TSTAMP
}

template <int BR>
__device__ __forceinline__ void attn_branch(const Frame& F, const bf16_t* PROJ, int b, int g, int t0, unsigned tiles  , const LAS float* btab_h,
                                            const bf16x8 (&qf)[2][2], const int (&tq)[2], const unsigned (&sel)[2], const float (&gate)[2], const LaneOffs& L) {
    const int lane = F.lane, tid = F.tid;
    unsigned wsel = sel[0] | sel[1];
#pragma unroll
    for (int o = 32; o >= 1; o >>= 1) wsel |= __shfl_xor(wsel, o);
    wsel = __builtin_amdgcn_readfirstlane(wsel);
    const int ck = (BR == 0 ? C_KS : C_KW) + g * 64, cv = (BR == 0 ? C_VS : C_VW) + g * 64;
    const int srow = tid >> 3, sch = tid & 7;
    LAS unsigned char* F_lds_ = F.lds; STAMP_DECL; STAMP_START();
    AttnState st;
#pragma unroll
    for (int dt = 0; dt < 4; ++dt) { st.o[dt][0] = (f32x4){0.f, 0.f, 0.f, 0.f}; st.o[dt][1] = (f32x4){0.f, 0.f, 0.f, 0.f}; }
    st.m[0] = st.m[1] = -1e30f; st.l[0] = st.l[1] = 0.f;
    unsigned rem = tiles; int cur = 0;
#ifdef PROBE_SHALLOW
    u32x4v rk0, rv0;
#else
    u32x4v rk0, rv0, rk1, rv1;
#endif
    const bf16_t* srcb = PROJ + (size_t)(b * S + srow) * NPAD + sch * 8;
#define AT_LOAD(RK, RV, jj) do { const bf16_t* rowp = srcb + (size_t)(64 * (jj)) * NPAD; RK = *(const u32x4v*)(rowp + ck); RV = *(const u32x4v*)(rowp + cv); } while (0)
#define AT_WRITE(RK, RV, bufi) do { *(LAS u32x4v*)(F.lds + AT_KV + (bufi) * 16384 + L.soff) = RK; *(LAS u32x4v*)(F.lds + AT_KV + (bufi) * 16384 + 8192 + L.soff) = RV; } while (0)
#define AT_COMPUTE(jj) do { STAMP_COUNT(4); const bool near = (t0 + 8 * F.wave) - (64 * (jj) + 63) < 128; \
        attn_tile<BR>(F.lds + AT_KV + cur * 16384, F.lds + AT_KV + cur * 16384 + 8192, btab_h, qf, tq, sel, (jj), near, st, lane, L, F.lds, wsel); } while (0)
#ifdef PROBE_SHALLOW
    { int j = __builtin_ctz(rem); rem &= rem - 1;
      AT_LOAD(rk0, rv0, j); AT_WRITE(rk0, rv0, 0);
      __syncthreads();
      for (;;) {
          int jn = j; const bool hn = rem != 0u; if (hn) { jn = __builtin_ctz(rem); rem &= rem - 1; }
          STAMP(12);
          AT_LOAD(rk0, rv0, jn);
          AT_COMPUTE(j);
          STAMP(13);
          AT_WRITE(rk0, rv0, cur ^ 1);
          asm volatile("s_waitcnt lgkmcnt(0)" ::: "memory");
          STAMP(8);
          __syncthreads(); cur ^= 1;
          STAMP(9);
          if (!hn) break;
          j = jn; } }
#else
    int j = __builtin_ctz(rem); rem &= rem - 1;
    AT_LOAD(rk0, rv0, j); AT_WRITE(rk0, rv0, 0);
    int j1 = j; bool h1 = rem != 0u; if (h1) { j1 = __builtin_ctz(rem); rem &= rem - 1; }
    AT_LOAD(rk0, rv0, j1);
    __syncthreads();
    for (;;) {
        int j2 = j1; bool h2 = rem != 0u; if (h2) { j2 = __builtin_ctz(rem); rem &= rem - 1; }
        AT_LOAD(rk1, rv1, j2);
        AT_COMPUTE(j);
        AT_WRITE(rk0, rv0, cur ^ 1);
        __syncthreads(); cur ^= 1;
        if (!h1) break;
        int j3 = j2; bool h3 = rem != 0u; if (h3) { j3 = __builtin_ctz(rem); rem &= rem - 1; }
        AT_LOAD(rk0, rv0, j3);
        AT_COMPUTE(j1);
        AT_WRITE(rk1, rv1, cur ^ 1);
        __syncthreads(); cur ^= 1;
        if (!h2) break;
        j = j2; j1 = j3; h1 = h3;
    }
#endif
    STAMP(5 + BR);
#undef AT_LOAD
#undef AT_WRITE
#undef AT_COMPUTE
    int pob = AT_OUT + tid * 4; asm volatile("" : "+v"(pob));
    LAS float* po = (LAS float*)(F.lds + pob);
#pragma unroll
    for (int qt = 0; qt < 2; ++qt) { float l = st.l[qt]; l += __shfl_xor(l, 16); l += __shfl_xor(l, 32); const float sc = l > 0.f ? gate[qt] / l : 0.f;
#pragma unroll
        for (int dt = 0; dt < 4; ++dt)
#pragma unroll
            for (int e = 0; e < 4; ++e) po[((qt * 4 + dt) * 4 + e) * 512] += st.o[dt][qt][e] * sc; }
}


template <int BR>
__device__ __forceinline__ void attn_branch_stag(const Frame& F, const bf16_t* PROJ, int b, int g, int t0, unsigned tiles, const LAS float* btab_h,
                                                 const bf16x8 (&qf)[2][2], const int (&tq)[2], const unsigned (&sel)[2], int hcol  , const LaneOffs& L) {
    const int lane = F.lane, tid = F.tid;
    const bool isB = F.wave >= 4;
    const int ck = (BR == 0 ? C_KS : C_KW) + g * 64, cv = (BR == 0 ? C_VS : C_VW) + g * 64;
    const int srow = tid >> 3, sch = tid & 7;
    AttnState st;
#pragma unroll
    for (int dt = 0; dt < 4; ++dt) { st.o[dt][0] = (f32x4){0.f, 0.f, 0.f, 0.f}; st.o[dt][1] = (f32x4){0.f, 0.f, 0.f, 0.f}; }
    st.m[0] = st.m[1] = -1e30f; st.l[0] = st.l[1] = 0.f;
    const bf16_t* srcb = PROJ + (size_t)(b * S + srow) * NPAD + sch * 8;
    LAS unsigned char* KB = F.lds + AT_KV;
#define SG_LOADK(R, jj) do { R = *(const u32x4v*)(srcb + (size_t)(64 * (jj)) * NPAD + ck); } while (0)
#define SG_LOADV(R, jj) do { R = *(const u32x4v*)(srcb + (size_t)(64 * (jj)) * NPAD + cv); } while (0)
#define SG_BAR() do { asm volatile("s_waitcnt lgkmcnt(0)" ::: "memory"); __builtin_amdgcn_s_barrier(); asm volatile("" ::: "memory"); } while (0)
    unsigned rem = tiles;
    int j0 = __builtin_ctz(rem); rem &= rem - 1;
    bool h1 = rem != 0u; int j1 = j0; if (h1) { j1 = __builtin_ctz(rem); rem &= rem - 1; }
    bool h2 = rem != 0u; int j2 = j1; if (h2) { j2 = __builtin_ctz(rem); rem &= rem - 1; }
    u32x4v rk, rv;
    { u32x4v a, c2, d2; SG_LOADK(a, j0); SG_LOADV(c2, j0); SG_LOADK(d2, j1);
      *(LAS u32x4v*)(KB + L.soff) = a; *(LAS u32x4v*)(KB + 16384 + L.soff) = c2; *(LAS u32x4v*)(KB + 8192 + L.soff) = d2; }
    SG_LOADK(rk, j2); SG_LOADV(rv, j1);
    SG_BAR();
    f32x4 sacc[4][2]; bf16x8 pf[2][2];
    at_qk(sacc, KB, qf, L);
    if (isB) SG_BAR();
    int i = 0;
    for (;;) {
        { const bool near = (t0 + 8 * F.wave) - (64 * j0 + 63) < 128; at_softmax<BR>(sacc, pf, btab_h, tq, sel, j0, near, st, lane); }
        SG_BAR();
        at_pv(st, KB + 16384 + (i & 1) * 8192, pf, L);
        if (h1) at_qk(sacc, KB + ((i + 1) & 1) * 8192, qf, L);
        *(LAS u32x4v*)(KB + (i & 1) * 8192 + L.soff) = rk; *(LAS u32x4v*)(KB + 16384 + ((i + 1) & 1) * 8192 + L.soff) = rv;
        bool h3 = rem != 0u; int j3 = j2; if (h3) { j3 = __builtin_ctz(rem); rem &= rem - 1; }
        SG_LOADK(rk, j3); SG_LOADV(rv, j2);
        SG_BAR();
        if (!h1) break;
        j0 = j1; j1 = j2; j2 = j3; h1 = h2; h2 = h3; ++i;
    }
    if (!isB) SG_BAR();
#undef SG_LOADK
#undef SG_LOADV
#undef SG_BAR
    int pob = AT_OUT + tid * 4; asm volatile("" : "+v"(pob));
    LAS float* po = (LAS float*)(F.lds + pob);
#pragma unroll
    for (int qt = 0; qt < 2; ++qt) { float l = st.l[qt]; l += __shfl_xor(l, 16); l += __shfl_xor(l, 32);
        const float gq = sigmoidf_(bf2f(PROJ[(size_t)(b * S + tq[qt]) * NPAD + C_GT + hcol * 3 + 1 + BR]));
        const float sc = l > 0.f ? gq / l : 0.f;
#pragma unroll
        for (int dt = 0; dt < 4; ++dt)
#pragma unroll
            for (int e = 0; e < 4; ++e) po[((qt * 4 + dt) * 4 + e) * 512] += st.o[dt][qt][e] * sc; }
}

template <int MODE>
__device__ __forceinline__ void p4_attn_mfma_t(const Frame& F) {
    const bf16_t* PROJ = (const bf16_t*)(F.ws + WS_PROJ); const bf16_t* KC = (const bf16_t*)(F.ws + WS_KC); const bf16_t* VC = (const bf16_t*)(F.ws + WS_VC);
    bf16_t* OATT = (bf16_t*)(F.ws + (MODE == 0 ? WS_OATT : WS_H)); const float* rel = F.in[21];
    const int lane = F.lane, tid = F.tid, wave = F.wave, grp = lane >> 4, col = lane & 15, qi = col >> 2, r = col & 3;
    LAS float* btab = (LAS float*)(F.lds + AT_BTAB); LAS float* impq = (LAS float*)(F.lds + AT_IMP); LAS unsigned* selm = (LAS unsigned*)(F.lds + AT_SEL);
    const LaneOffs L = lane_offs(lane, tid);
    for (int i = tid; i < 8 * 129; i += NTHREADS) { const int hh = i / 129, dd = i % 129; btab[hh * BT_STRIDE + dd] = rel[rel_bucket(dd) * 8 + hh] * LOG2E; }
    __syncthreads();
    LAS unsigned char* F_lds_ = F.lds; STAMP_DECL;
#ifdef PROBE_STAMP
    if (tid < 16) ((volatile LAS unsigned*)(F.lds + LDS_MISC_OFF + 128))[tid] = 0u;
    __syncthreads();
#endif
    STAMP_START();
    for (int uu = blockIdx.x; uu < 1024; uu += F.G) {
        int qb, bg;
        if (F.G == 256) { const int round = uu >> 8, k = uu & 255; const int a = k >> 5; bg = k & 31;
            qb = (a == 0) ? (round == 0 ? 25 : round == 1 ? 23 : round == 2 ? 17 : 0) : (a == 1) ? (round == 0 ? 27 : round == 1 ? 19 : round == 2 ? 18 : 1) : (a == 2) ? (round == 0 ? 31 : round == 1 ? 13 : round == 2 ? 12 : 5)
               : (a == 3) ? (round == 0 ? 26 : round == 1 ? 21 : round == 2 ? 15 : 2) : (a == 4) ? (round == 0 ? 30 : round == 1 ? 22 : round == 2 ? 8 : 3) : (a == 5) ? (round == 0 ? 28 : round == 1 ? 20 : round == 2 ? 9 : 4)
               : (a == 6) ? (round == 0 ? 29 : round == 1 ? 14 : round == 2 ? 10 : 6) : (round == 0 ? 24 : round == 1 ? 16 : round == 2 ? 11 : 7); }
        else { qb = 31 - (uu >> 5); bg = uu & 31; }
        const int b = bg >> 1, g = bg & 1, t0 = qb * 64, h = g * 4 + r;
        const LAS float* btab_h = btab + h * BT_STRIDE;
        int tq[2]; bf16x8 qf[2][2]; float gate[3][2];
#pragma unroll
        for (int qt = 0; qt < 2; ++qt) { tq[qt] = t0 + 8 * wave + 4 * qt + qi; const bf16_t* prow = PROJ + (size_t)(b * S + tq[qt]) * NPAD;
#pragma unroll
            for (int ks = 0; ks < 2; ++ks) qf[qt][ks] = *(const bf16x8*)(prow + C_Q + h * 64 + ks * 32 + 8 * grp);
#pragma unroll
            for (int jg = 0; jg < 3; ++jg) gate[jg][qt] = sigmoidf_(bf2f(prow[C_GT + h * 3 + jg])); }
#pragma unroll
        for (int i = 0; i < 2; ++i) { const int c2 = tid + 512 * i, row = c2 >> 3, ch = c2 & 7; const size_t src = ((size_t)(b * 2 + g) * 128 + row) * 64 + ch * 8;
            *(LAS u32x4v*)(F.lds + AT_KC + L.soff + 8192 * i) = *(const u32x4v*)(KC + src); *(LAS u32x4v*)(F.lds + AT_VC + L.soff + 8192 * i) = *(const u32x4v*)(VC + src); }
        __syncthreads();
#ifndef AT_SKIP_CMP
        {
            const int nvmax = t0 + 63 >= 31 ? ((t0 + 63 - 31) >> 4) + 1 : 0;
            const float SC = 0.125f * LOG2E; const int srcl = (lane + 48) & 63;
            int pob = AT_OUT + tid * 4; asm volatile("" : "+v"(pob));
            LAS float* po = (LAS float*)(F.lds + pob);
#pragma unroll
            for (int qt = 0; qt < 2; ++qt) {
                f32x4 sa[8];
#pragma unroll
                for (int kt = 0; kt < 8; ++kt) sa[kt] = (f32x4){0.f, 0.f, 0.f, 0.f};
#pragma unroll
                for (int kt = 0; kt < 8; ++kt) if (kt * 16 < nvmax) {
#pragma unroll
                    for (int ks = 0; ks < 2; ++ks) { const bf16x8 kf = *(const LAS bf16x8*)(F.lds + AT_KC + L.koff[ks] + kt * 2048);
                        sa[kt] = __builtin_amdgcn_mfma_f32_16x16x32_bf16(kf, qf[qt][ks], sa[kt], 0, 0, 0); } }
                __builtin_amdgcn_sched_barrier(0);
                int d0 = tq[qt] - 31 - 64 * grp; asm volatile("" : "+v"(d0));
                float mx = -1e30f;
#pragma unroll
                for (int kt = 0; kt < 8; ++kt)
#pragma unroll
                    for (int rg = 0; rg < 4; ++rg) { const int c = 256 * kt + 16 * rg; const int dist = d0 - c; const int dd = dist < 0 ? 0 : (dist > 128 ? 128 : dist);
                        const float sx = sa[kt][rg] * SC + btab_h[dd]; const float s = d0 >= c ? sx : -1e30f; sa[kt][rg] = s; mx = fmaxf(mx, s); }
                mx = fmaxf(mx, __shfl_xor(mx, 16)); mx = fmaxf(mx, __shfl_xor(mx, 32));
                float sum = 0.f;
#pragma unroll
                for (int kt = 0; kt < 8; ++kt)
#pragma unroll
                    for (int rg = 0; rg < 4; ++rg) { const int c = 256 * kt + 16 * rg; const float ex = __builtin_amdgcn_exp2f(sa[kt][rg] - mx); const float e = d0 >= c ? ex : 0.f; sa[kt][rg] = e; sum += e; }
                __builtin_amdgcn_sched_barrier(0);
                sum += __shfl_xor(sum, 16); sum += __shfl_xor(sum, 32);
                const float inv = sum > 0.f ? 1.0f / sum : 0.f;
                float prev3 = 0.f;
#pragma unroll
                for (int kt = 0; kt < 8; ++kt) { const float p3 = sa[kt][3] * inv; const float part = (sa[kt][0] * inv + sa[kt][1] * inv) + (sa[kt][2] * inv + p3);
                    const float xa = __shfl(p3, srcl), xb = __shfl(prev3, srcl); float tot = part + (grp >= 1 ? xa : xb);
                    tot += __shfl_xor(tot, 1); tot += __shfl_xor(tot, 2);
                    if (r == 0) impq[(8 * wave + 4 * qt + qi) * 33 + 4 * kt + grp] = tot;
                    prev3 = p3; }
                __builtin_amdgcn_sched_barrier(0);
                f32x4 oc[4];
#pragma unroll
                for (int dt = 0; dt < 4; ++dt) oc[dt] = (f32x4){0.f, 0.f, 0.f, 0.f};
#pragma unroll
                for (int ks = 0; ks < 4; ++ks) if (ks * 32 < nvmax) {
                    const bf16x8 pfr = mk_frag(pg8::cvt_pk_bf16(sa[2 * ks][0], sa[2 * ks][1]), pg8::cvt_pk_bf16(sa[2 * ks][2], sa[2 * ks][3]),
                                               pg8::cvt_pk_bf16(sa[2 * ks + 1][0], sa[2 * ks + 1][1]), pg8::cvt_pk_bf16(sa[2 * ks + 1][2], sa[2 * ks + 1][3]));
#pragma unroll
                    for (int dt = 0; dt < 4; ++dt) { const bf16x8 vf = vfrag_read(F.lds + AT_VC, L.voff[dt], 32 * ks); oc[dt] = __builtin_amdgcn_mfma_f32_16x16x32_bf16(vf, pfr, oc[dt], 0, 0, 0); } }
                const float scq = inv * gate[0][qt];
#pragma unroll
                for (int dt = 0; dt < 4; ++dt)
#pragma unroll
                    for (int e = 0; e < 4; ++e) po[((qt * 4 + dt) * 4 + e) * 512] = oc[dt][e] * scq;
                __builtin_amdgcn_sched_barrier(0);
            }
        }
#endif
        __syncthreads();
#ifndef AT_SKIP_SEL
        {
            const int q = tid >> 3, jj = tid & 7, cur = qb; unsigned bits = 0u;
            float vj[4];
#pragma unroll
            for (int e = 0; e < 4; ++e) { const int j = jj * 4 + e; const bool forced = (j == 0) || (j == cur) || (j == cur - 1); vj[e] = forced ? 1e4f : (j <= cur ? impq[q * 33 + j] : -INFINITY); }
            int rk[4] = {0, 0, 0, 0};
            for (int jp = 0; jp < 32; ++jp) { const bool forced = (jp == 0) || (jp == cur) || (jp == cur - 1); const float vp = forced ? 1e4f : (jp <= cur ? impq[q * 33 + jp] : -INFINITY);
#pragma unroll
                for (int e = 0; e < 4; ++e) rk[e] += ((vp > vj[e]) || (vp == vj[e] && jp < jj * 4 + e)) ? 1 : 0; }
#pragma unroll
            for (int e = 0; e < 4; ++e) bits |= (rk[e] < 8 ? 1u : 0u) << (jj * 4 + e);
            bits |= __shfl_xor(bits, 1); bits |= __shfl_xor(bits, 2); bits |= __shfl_xor(bits, 4);
            if (jj == 0) selm[q] = bits;
        }
#endif
        __syncthreads();
        unsigned sel[2] = {selm[8 * wave + qi], selm[8 * wave + 4 + qi]};
        unsigned un = selm[lane];
#pragma unroll
        for (int o = 32; o >= 1; o >>= 1) un |= __shfl_xor(un, o);
        un = __builtin_amdgcn_readfirstlane(un);
        const unsigned causal = qb == 31 ? 0xFFFFFFFFu : ((2u << qb) - 1u);
        if (MODE != 1 && MODE != 2) { const float gt1[2] = {gate[1][0], gate[1][1]};
#ifndef ATTN_STAGGER
            attn_branch<0>(F, PROJ, b, g, t0, un & causal, btab_h, qf, tq, sel, gt1, L);
#else
            attn_branch_stag<0>(F, PROJ, b, g, t0, un & causal, btab_h, qf, tq, sel, h, L);
#endif
        }
        if (MODE != 2) { const int jlo = qb >= 8 ? qb - 8 : 0; const unsigned wmask = causal & ~((1u << jlo) - 1u); const float gt2[2] = {gate[2][0], gate[2][1]};

#ifndef ATTN_STAGGER
            attn_branch<1>(F, PROJ, b, g, t0, wmask, btab_h, qf, tq, sel, gt2, L);
#else
            attn_branch_stag<1>(F, PROJ, b, g, t0, wmask, btab_h, qf, tq, sel, h, L);
#endif
        }
        int pob2 = AT_OUT + tid * 4; asm volatile("" : "+v"(pob2));
#pragma unroll
        for (int qt = 0; qt < 2; ++qt) { bf16_t* orow = OATT + (size_t)(b * S + tq[qt]) * 512 + h * 64 + 4 * grp;
#pragma unroll
            for (int dt = 0; dt < 4; ++dt) { const LAS float* po = (const LAS float*)(F.lds + pob2) + (qt * 4 + dt) * 4 * 512;
                *(uint2*)(orow + dt * 16) = make_uint2(pg8::cvt_pk_bf16(po[0], po[512]), pg8::cvt_pk_bf16(po[1024], po[1536])); } }
    }
    STAMP(7);
#ifdef PROBE_STAMP
    __syncthreads();
    if (PROBE_PHASE == 4 && MODE == 0 && blockIdx.x == PROBE_BLOCK && tid < 16) ((unsigned*)(F.ws + WS_CTL + 32768))[tid] = ((volatile LAS unsigned*)(F.lds + LDS_MISC_OFF + 128))[tid];
#endif
}

__device__ __forceinline__ void p5_mixed(const Frame& F) {
    const bf16_t* PROJ = (const bf16_t*)(F.ws + WS_PROJ); const bf16_t* OATT = (const bf16_t*)(F.ws + WS_OATT); bf16_t* MIX = (bf16_t*)(F.ws + WS_H);
    const float* cw = F.in[13]; const float* ga = F.in[14]; const float* gc = F.in[15];
    const int gw = blockIdx.x * NWAVES + F.wave, nw = F.G * NWAVES, lane = F.lane, c0 = lane * 8;
    float w0[8], w1[8], w2[8], gav[8], gcv[8];
#pragma unroll
    for (int e = 0; e < 8; ++e) { w0[e] = cw[c0 + e]; w1[e] = cw[512 + c0 + e]; w2[e] = cw[1024 + c0 + e]; gav[e] = ga[c0 + e]; gcv[e] = gc[c0 + e]; }
    for (int chunk = gw; chunk < T / 16; chunk += nw) {
        const int t0 = chunk * 16, s0 = t0 % S;
        float z1[8], z2[8];
#pragma unroll
        for (int e = 0; e < 8; ++e) { z1[e] = 0.f; z2[e] = 0.f; }
        if (s0 > 0) {
#pragma unroll
            for (int back = 1; back <= 2; ++back) { const bf16_t* row = PROJ + (size_t)(t0 - back) * NPAD;
                const u32x4v wc = *(const u32x4v*)(row + C_CC + c0), wh = *(const u32x4v*)(row + C_CH + c0);
#pragma unroll
                for (int e = 0; e < 4; ++e) { const float a = bflo(wc[e]) * bflo(wh[e]), bq = bfhi(wc[e]) * bfhi(wh[e]); if (back == 1) { z1[2 * e] = a; z1[2 * e + 1] = bq; } else { z2[2 * e] = a; z2[2 * e + 1] = bq; } } } }
        u32x4v na, nc, nh, nb;
        { const bf16_t* row = PROJ + (size_t)t0 * NPAD; na = *(const u32x4v*)(OATT + (size_t)t0 * 512 + c0); nc = *(const u32x4v*)(row + C_CC + c0); nh = *(const u32x4v*)(row + C_CH + c0); nb = *(const u32x4v*)(row + C_CB + c0); }
#pragma unroll 1
        for (int i = 0; i < 16; ++i) { const int tok = t0 + i;
            const u32x4v wa = na, wc = nc, wh = nh, wb = nb;
            { const int tn = i < 15 ? tok + 1 : tok; const bf16_t* row = PROJ + (size_t)tn * NPAD;
                na = *(const u32x4v*)(OATT + (size_t)tn * 512 + c0); nc = *(const u32x4v*)(row + C_CC + c0); nh = *(const u32x4v*)(row + C_CH + c0); nb = *(const u32x4v*)(row + C_CB + c0); }
            float a[8], y[8], z0[8];
#pragma unroll
            for (int e = 0; e < 4; ++e) { a[2 * e] = bflo(wa[e]); a[2 * e + 1] = bfhi(wa[e]); z0[2 * e] = bflo(wc[e]) * bflo(wh[e]); z0[2 * e + 1] = bfhi(wc[e]) * bfhi(wh[e]); }
#pragma unroll
            for (int e = 0; e < 8; ++e) y[e] = w0[e] * z2[e] + w1[e] * z1[e] + w2[e] * z0[e];
#pragma unroll
            for (int e = 0; e < 4; ++e) { y[2 * e] *= bflo(wb[e]); y[2 * e + 1] *= bfhi(wb[e]); }
            float sa = 0.f, sy = 0.f;
#pragma unroll
            for (int e = 0; e < 8; ++e) { sa += a[e] * a[e]; sy += y[e] * y[e]; }
            sa = wave_sum(sa); sy = wave_sum(sy);
            const float ra = rsqrtf(sa * (1.0f / 512) + EPS), ry = rsqrtf(sy * (1.0f / 512) + EPS);
            unsigned oa[4], oy[4];
#pragma unroll
            for (int e = 0; e < 4; ++e) { oa[e] = pack2(a[2 * e] * ra * gav[2 * e], a[2 * e + 1] * ra * gav[2 * e + 1]); oy[e] = pack2(y[2 * e] * ry * gcv[2 * e], y[2 * e + 1] * ry * gcv[2 * e + 1]); }
            *(uint4*)(MIX + (size_t)tok * D + c0) = make_uint4(oa[0], oa[1], oa[2], oa[3]);
            *(uint4*)(MIX + (size_t)tok * D + 512 + c0) = make_uint4(oy[0], oy[1], oy[2], oy[3]);
#pragma unroll
            for (int e = 0; e < 8; ++e) { z2[e] = z1[e]; z1[e] = z0[e]; }
        }
    }
}

struct EpiResGate {
    static constexpr bool PERM = false, AFTER_DRAIN = false;
    float* C; const float* X; const float* MOD; int gate_off;
    __device__ __forceinline__ void operator()(const pg8::f32x4 (&acc)[2][2][4][2], const pg8::Unit& u, int wr, int wc, int fr, int fq) const {
        using pg8::f32x4; using pg8::HALF; using pg8::BM;
        const int row0 = u.pm * BM + wr * 64 + fr, col0 = u.pn * BM + wc * 32 + 4 * fq;
        const int b = (u.pm * BM) / S;
        f32x4 gv[2][2];
#pragma unroll
        for (int bj = 0; bj < 2; ++bj)
#pragma unroll
            for (int n = 0; n < 2; ++n) gv[bj][n] = *(const f32x4*)(MOD + b * 6144 + gate_off + col0 + bj * HALF + n * 16);
#pragma unroll
        for (int ai = 0; ai < 2; ++ai)
#pragma unroll
            for (int m = 0; m < 4; ++m) { const size_t ro = (size_t)(row0 + ai * HALF + m * 16) * D + col0;
#pragma unroll
                for (int bj = 0; bj < 2; ++bj)
#pragma unroll
                    for (int n = 0; n < 2; ++n) { const f32x4 xv = *(const f32x4*)(X + ro + bj * HALF + n * 16); *(f32x4*)(C + ro + bj * HALF + n * 16) = xv + gv[bj][n] * acc[ai][bj][m][n]; } }
    }
};

__device__ __forceinline__ int ord_i(float f) { const int u = __float_as_int(f); return u >= 0 ? u : (u ^ 0x7FFFFFFF); }
__device__ __forceinline__ float unord_f(int i) { const int u = i >= 0 ? i : (i ^ 0x7FFFFFFF); return __int_as_float(u); }
#define INT_MIN_ (-2147483647 - 1)
struct CandTab { int a[50], b[50]; };
constexpr CandTab make_cand() { CandTab t{}; int n = 0; for (int a = 0; a < 16; ++a) for (int b = 0; b < 16; ++b) if ((a + 1) * (b + 1) <= 16) { t.a[n] = a; t.b[n] = b; ++n; } return t; }
constexpr CandTab CAND = make_cand();

template <int N, bool DESC> __device__ __forceinline__ void bitonic_sort_i(int (&v)[N]) {
#pragma unroll
    for (int k = 2; k <= N; k <<= 1)
#pragma unroll
        for (int j = k >> 1; j > 0; j >>= 1)
#pragma unroll
            for (int i = 0; i < N; ++i) { const int l = i ^ j; if (l > i) { const bool up = ((i & k) == 0) != DESC; const int lo = min(v[i], v[l]), hi = max(v[i], v[l]); v[i] = up ? lo : hi; v[l] = up ? hi : lo; } }
}
struct Net16 { int a[60], b[60]; };
constexpr Net16 NET16 = {{0,1,2,3,4,5,7,9,0,1,2,3,6,8,10,11,0,2,4,6,7,10,12,14,0,1,4,5,6,8,12,13,1,3,4,5,8,9,13,1,2,5,7,9,11,2,3,9,11,3,6,7,10,3,5,7,9,11,6,8}, {13,12,15,14,8,6,11,10,5,7,9,4,13,14,15,12,1,3,5,8,9,11,13,15,2,3,10,11,7,9,14,15,2,12,6,7,10,11,14,4,6,8,10,13,14,4,6,12,13,5,8,9,12,4,6,8,10,12,7,9}};
template <bool DESC> __device__ __forceinline__ void sort16_net(int (&v)[16]) {
#pragma unroll
    for (int c = 0; c < 60; ++c) { const int lo = min(v[NET16.a[c]], v[NET16.b[c]]), hi = max(v[NET16.a[c]], v[NET16.b[c]]); v[NET16.a[c]] = DESC ? hi : lo; v[NET16.b[c]] = DESC ? lo : hi; }
}
template <int N, bool DESC> __device__ __forceinline__ void bitonic_merge_i(int (&v)[N]) {
#pragma unroll
    for (int j = N >> 1; j > 0; j >>= 1)
#pragma unroll
        for (int i = 0; i < N; ++i) { const int l = i ^ j; if (l > i) { const int lo = min(v[i], v[l]), hi = max(v[i], v[l]); v[i] = DESC ? hi : lo; v[l] = DESC ? lo : hi; } }
}
__device__ __forceinline__ void merge_top16_across(int (&t)[16]) {
#pragma unroll
    for (int m = 16; m <= 32; m <<= 1) { int y[16];
#pragma unroll
        for (int i = 0; i < 16; ++i) y[i] = max(t[i], __shfl_xor(t[15 - i], m));
        bitonic_merge_i<16, true>(y);
#pragma unroll
        for (int i = 0; i < 16; ++i) t[i] = y[i]; }
}
constexpr int RT2_KEYS = 0  , RT2_ITAB = 65536  ;
__device__ __forceinline__ void p9_route_sort(const Frame& F) {
    const bf16_t* QP = (const bf16_t*)(F.ws + WS_QP); const bf16_t* KEYS = (const bf16_t*)(F.ws + WS_KEYS);
    unsigned short* E16 = (unsigned short*)(F.ws + WS_E16); float* EW = (float*)(F.ws + WS_EW);
    const int lane = F.lane, tid = F.tid, grp = lane >> 4, col = lane & 15;
    const LaneOffs L = lane_offs(lane, tid);
    LAS int* itab = (LAS int*)(F.lds + RT2_ITAB + F.wave * 2048) + col * 32;
    const bool g1 = grp == 1, g2 = grp == 2, g3 = grp == 3;
    for (int tile = blockIdx.x * NWAVES + F.wave; tile < T / 16; tile += F.G * NWAVES) {
        const int tok = tile * 16 + col;
        {
#pragma unroll
            for (int i = 0; i < 4; ++i) { const int q = tid + 512 * i; *(LAS u32x4v*)(F.lds + RT2_KEYS + tile_off(q >> 3, q & 7)) = *(const u32x4v*)(KEYS + (size_t)q * 8); } }
        bf16x8 qf[2][2];
#pragma unroll
        for (int p = 0; p < 2; ++p)
#pragma unroll
            for (int ks = 0; ks < 2; ++ks) qf[p][ks] = *(const bf16x8*)(QP + (size_t)tok * D + p * 64 + ks * 32 + 8 * grp);
        __syncthreads();
#pragma unroll 1
        for (int h = 0; h < 8; ++h) {
            const int kb = RT2_KEYS + (h & 1) * 32768;
            u32x4v stg[4]; bf16x8 qn[2][2];
            if (h < 7) {
#pragma unroll
                for (int i = 0; i < 4; ++i) { const int q = tid + 512 * i; stg[i] = *(const u32x4v*)(KEYS + (size_t)(h + 1) * 16384 + (size_t)q * 8); }
#pragma unroll
                for (int p = 0; p < 2; ++p)
#pragma unroll
                    for (int ks = 0; ks < 2; ++ks) qn[p][ks] = *(const bf16x8*)(QP + (size_t)tok * D + (h + 1) * 128 + p * 64 + ks * 32 + 8 * grp);
            }
            int lst[2][16];
#pragma unroll
            for (int p = 0; p < 2; ++p) {
                f32x4 sc[8];
#pragma unroll
                for (int kt = 0; kt < 8; ++kt) { sc[kt] = (f32x4){0.f, 0.f, 0.f, 0.f};
#pragma unroll
                    for (int ks = 0; ks < 2; ++ks) { const bf16x8 kf = *(const LAS bf16x8*)(F.lds + kb + p * 16384 + L.koff[ks] + kt * 2048);
                        sc[kt] = __builtin_amdgcn_mfma_f32_16x16x32_bf16(kf, qf[p][ks], sc[kt], 0, 0, 0); } }
                int ra[16], rb[16];
#pragma unroll
                for (int kt = 0; kt < 4; ++kt)
#pragma unroll
                    for (int rg = 0; rg < 4; ++rg) { ra[kt * 4 + rg] = (ord_i(sc[kt][rg]) & ~0x7F) | (127 - (kt * 16 + 4 * grp + rg)); rb[kt * 4 + rg] = (ord_i(sc[kt + 4][rg]) & ~0x7F) | (127 - ((kt + 4) * 16 + 4 * grp + rg)); }
                sort16_net<true>(ra); sort16_net<false>(rb);
#pragma unroll
                for (int i = 0; i < 16; ++i) ra[i] = max(ra[i], rb[i]);
                bitonic_merge_i<16, true>(ra);
                merge_top16_across(ra);
#pragma unroll
                for (int i = 0; i < 16; ++i) lst[p][i] = ra[i];
                if (grp == 0) {
#pragma unroll
                    for (int it = 0; it < 16; ++it) itab[p * 16 + it] = 127 - (ra[it] & 0x7F);
                }
            }
            float v0[16], v1[16];
#pragma unroll
            for (int i = 0; i < 16; ++i) { v0[i] = unord_f(lst[0][i] & ~0x7F); v1[i] = unord_f(lst[1][i] & ~0x7F); }
            int ck[16];
#pragma unroll
            for (int i = 0; i < 13; ++i) {
                constexpr int NC = 50;
                const int k0 = 4 * i, k1 = 4 * i + 1 < NC ? 4 * i + 1 : NC - 1, k2 = 4 * i + 2 < NC ? 4 * i + 2 : NC - 1, k3 = 4 * i + 3 < NC ? 4 * i + 3 : NC - 1;
                float va = v0[CAND.a[k0]], vb = v1[CAND.b[k0]]; int fl = 255 - (CAND.a[k0] * 16 + CAND.b[k0]);
                va = g1 ? v0[CAND.a[k1]] : va; vb = g1 ? v1[CAND.b[k1]] : vb; fl = g1 ? 255 - (CAND.a[k1] * 16 + CAND.b[k1]) : fl;
                va = g2 ? v0[CAND.a[k2]] : va; vb = g2 ? v1[CAND.b[k2]] : vb; fl = g2 ? 255 - (CAND.a[k2] * 16 + CAND.b[k2]) : fl;
                va = g3 ? v0[CAND.a[k3]] : va; vb = g3 ? v1[CAND.b[k3]] : vb; fl = g3 ? 255 - (CAND.a[k3] * 16 + CAND.b[k3]) : fl;
                int key = (ord_i(va + vb) & ~0xFF) | fl;
                if (4 * i + 1 >= NC) key = g1 ? INT_MIN_ : key;
                if (4 * i + 2 >= NC) key = g2 ? INT_MIN_ : key;
                if (4 * i + 3 >= NC) key = g3 ? INT_MIN_ : key;
                ck[i] = key; }
            ck[13] = INT_MIN_; ck[14] = INT_MIN_; ck[15] = INT_MIN_;
            sort16_net<true>(ck);
            merge_top16_across(ck);
            lds_wave_sync();
            const float smax = unord_f(ck[0] & ~0xFF);
            float ex[16], sum = 0.f;
#pragma unroll
            for (int it = 0; it < 16; ++it) { ex[it] = __expf(unord_f(ck[it] & ~0xFF) - smax); sum += ex[it]; }
            const float inv = 1.0f / sum;
            if (grp == 0) {
#pragma unroll
                for (int it = 0; it < 16; ++it) { const int flat = 255 - (ck[it] & 0xFF); const int i1 = itab[flat >> 4], i2 = itab[16 + (flat & 15)];
                    E16[(size_t)tok * 128 + h * 16 + it] = (unsigned short)(i1 * 128 + i2); EW[(size_t)tok * 128 + h * 16 + it] = ex[it] * inv; }
            }
            lds_wave_sync();
            if (h < 7) {
                const int kn = RT2_KEYS + ((h + 1) & 1) * 32768;
#pragma unroll
                for (int i = 0; i < 4; ++i) { const int q = tid + 512 * i; *(LAS u32x4v*)(F.lds + kn + tile_off(q >> 3, q & 7)) = stg[i]; }
#pragma unroll
                for (int p = 0; p < 2; ++p)
#pragma unroll
                    for (int ks = 0; ks < 2; ++ks) qf[p][ks] = qn[p][ks];
            }
            __syncthreads();
        }
    }
}

constexpr int N_PHASES = 14;
struct Args { const float* in[23]; float* out; unsigned char* ws; int ph_lo, ph_hi; };
__global__ void __launch_bounds__(NTHREADS, 2) fwd(Args args) {
    extern __shared__ __attribute__((aligned(16))) unsigned char lds_raw[];
    Frame F;
#pragma unroll
    for (int i = 0; i < 23; ++i) F.in[i] = args.in[i];
    F.out = args.out; F.ws = args.ws; F.lds = (LAS unsigned char*)lds_raw;
    F.tid = threadIdx.x; F.lane = F.tid & 63; F.wave = __builtin_amdgcn_readfirstlane(F.tid >> 6); F.G = gridDim.x;
    volatile LAS unsigned* misc = (volatile LAS unsigned*)(F.lds + LDS_MISC_OFF);
    if (F.tid < 64) misc[F.tid] = 0u;
    __syncthreads();
    XcdBarrier bar; bar.bar = (unsigned*)(F.ws + WS_CTL); bar.x = 0; bar.st = misc;
    const int lo = args.ph_lo, hi = args.ph_hi;
    if (hi - lo > 1) bar = xcd_barrier_post((unsigned*)(F.ws + WS_CTL), misc);
#ifndef PH_MASK
#define PH_MASK 0xFFFF
#endif
#define IN(k) (((PH_MASK >> (k)) & 1) && lo <= (k) && (k) < hi)
#ifdef PROBE_SEAM
    const unsigned long long kt0_ = __builtin_amdgcn_s_memrealtime();
    unsigned* dgm_ = (unsigned*)(F.ws + WS_CTL + 57344);
#define SEAM(k) do { if (IN(k) && IN((k) + 1)) { if (F.tid == 0) { const unsigned dt_ = (unsigned)(__builtin_amdgcn_s_memrealtime() - kt0_); atomicMax(dgm_ + (k), dt_); atomicAdd(dgm_ + 16 + (k), dt_); } xcd_barrier(bar); } } while (0)
#else
#define SEAM(k) do { if (IN(k) && IN((k) + 1)) xcd_barrier(bar); } while (0)
#endif
    const float* MOD = (const float*)(F.ws + WS_MOD);
    if (IN(0)) { p0_prologue(F, 0, 210); } SEAM(0);
    if (IN(1)) { p0_prologue(F, 210, 1 << 30);        norm_mod_rows(F, F.in[0], F.in[2], 0, 1024, (bf16_t*)(F.ws + WS_H)); } SEAM(1);
    if (IN(2)) { pg8::Gemm g{(const pg8::bf16_t*)(F.ws + WS_H), (const pg8::bf16_t*)(F.ws + WS_WIN), T, NPAD, D}; pg8::StaticOrder So; So.init(T, NPAD, F.G, (int)blockIdx.x);
        pg8::EpiBf16<0> E{(pg8::bf16_t*)(F.ws + WS_PROJ), NPAD, nullptr, 0, 0};
        pg8::gemm_phase<pg8::EpiBf16<0>, pg8::StaticOrder>(F.lds, g, So, E, nullptr); } SEAM(2);
#ifdef COMPRESS_NAIVE
    if (IN(3)) { p3_compress_naive(F); } SEAM(3);
#else
    if (IN(3)) { p3_compress_mfma(F); } SEAM(3);
#endif
    #ifdef ATTN_NAIVE
    if (IN(4)) { p4_attn_naive(F); } SEAM(4);
#else
    if (IN(4)) { p4_attn_mfma_t<0>(F); } SEAM(4);
#ifdef PROBE_ATTN_MODE
    if (IN(14)) { p4_attn_mfma_t<PROBE_ATTN_MODE>(F); }
#endif
#ifdef PROBE_P0_LO
    if (IN(14)) { p0_prologue(F, PROBE_P0_LO, PROBE_P0_HI); }
#endif
#endif
    if (IN(5)) { p5_mixed(F); } SEAM(5);
    if (IN(6)) { pg8::Gemm g{(const pg8::bf16_t*)(F.ws + WS_H), (const pg8::bf16_t*)(F.ws + WS_WOUT), T, D, D}; pg8::StaticOrder So; So.init(T, D, F.G, (int)blockIdx.x);
        pg8::EpiBf16<0> E{(pg8::bf16_t*)(F.ws + WS_Y), D, nullptr, 0, 0};
        pg8::gemm_phase<pg8::EpiBf16<0>, pg8::StaticOrder>(F.lds, g, So, E, nullptr); } SEAM(6);
    if (IN(7)) { norm_mod_rows_q(F, F.in[0], F.in[3], 3072, 4096, (bf16_t*)(F.ws + WS_H)); } SEAM(7);
    if (IN(8)) { pg8::Gemm g{(const pg8::bf16_t*)(F.ws + WS_H), (const pg8::bf16_t*)(F.ws + WS_WQ), T, D, D}; pg8::StaticOrder So; So.init(T, D, F.G, (int)blockIdx.x);
        pg8::EpiBf16<0> E{(pg8::bf16_t*)(F.ws + WS_QP), D, nullptr, 0, 0};
        pg8::gemm_phase<pg8::EpiBf16<0>, pg8::StaticOrder>(F.lds, g, So, E, nullptr); } SEAM(8);
        if (IN(9)) { p9_route_sort(F); } SEAM(9);
    if (IN(10)) { p10a_udots(F); } SEAM(10);
    if (IN(11)) { p10b_coef(F); } SEAM(11);
    if (IN(12)) { p10c_vsum(F); } SEAM(12);
    if (IN(13)) { p10d_final(F); }
#ifdef PROBE_SEAM
    if (blockIdx.x == 0 && F.tid == 0) {
        unsigned long long tot = 0ull;
        for (int s = 0; s < 13; ++s) { if (PROBE_SEAM >= 0 && s != PROBE_SEAM) continue;
            const unsigned mx = __hip_atomic_load(dgm_ + s, __ATOMIC_RELAXED, __HIP_MEMORY_SCOPE_AGENT), sm = __hip_atomic_load(dgm_ + 16 + s, __ATOMIC_RELAXED, __HIP_MEMORY_SCOPE_AGENT);
            tot += (unsigned long long)(mx - sm / F.G); }
        const unsigned long long t1 = __builtin_amdgcn_s_memrealtime();
        while (__builtin_amdgcn_s_memrealtime() - t1 < tot * PROBE_SEAM_MUL) __builtin_amdgcn_s_sleep(8);
    }
#endif
#undef IN
#undef SEAM
}

extern "C" void kernel_launch(void* const* d_in, const int* in_sizes, int n_in, void* d_out, int out_size, void* d_ws, size_t ws_size, hipStream_t stream) {
    static int grid = 0;
    if (grid == 0) {
        if (n_in != 23 || out_size != T * D || ws_size < WS_END) { fprintf(stderr, "kernel_launch: unexpected shapes: n_in %d out %d ws %zu (need %zu)\n", n_in, out_size, ws_size, (size_t)WS_END); grid = -1; return; }
        int dev = 0, cus = 0, per_cu = 0;
        if (hipGetDevice(&dev) != hipSuccess || hipDeviceGetAttribute(&cus, hipDeviceAttributeMultiprocessorCount, dev) != hipSuccess) { grid = -1; return; }
        if (hipFuncSetAttribute((const void*)fwd, hipFuncAttributeMaxDynamicSharedMemorySize, LDS_BYTES) != hipSuccess) { fprintf(stderr, "kernel_launch: hipFuncSetAttribute failed\n"); grid = -1; return; }
        if (hipOccupancyMaxActiveBlocksPerMultiprocessor(&per_cu, (const void*)fwd, NTHREADS, LDS_BYTES) != hipSuccess || per_cu < 1) { fprintf(stderr, "kernel_launch: occupancy query says %d\n", per_cu); (void)hipGetLastError(); per_cu = 1; }
        grid = cus;
    }
    if (grid < 0) return;
    (void)hipMemsetAsync((char*)d_ws + WS_CTL, 0, CTL_BYTES, stream);
    Args a{};
    for (int i = 0; i < 23; ++i) a.in[i] = (const float*)d_in[i];
    a.out = (float*)d_out; a.ws = (unsigned char*)d_ws;
#if MK_N_LAUNCHES == 1
    a.ph_lo = 0; a.ph_hi = N_PHASES;
    hipLaunchKernelGGL(fwd, dim3(grid), dim3(NTHREADS), LDS_BYTES, stream, a);
#else
#ifdef PROBE_LIST
    { const int plist[] = PROBE_LIST; for (int p : plist) { if (p < 0) { (void)hipMemsetAsync((char*)d_ws + WS_CTL, 0, CTL_BYTES, stream); continue; } a.ph_lo = p; a.ph_hi = p + 1; hipLaunchKernelGGL(fwd, dim3(grid), dim3(NTHREADS), LDS_BYTES, stream, a); } }
#else
    for (int p = 0; p < N_PHASES; ++p) { a.ph_lo = p; a.ph_hi = p + 1; hipLaunchKernelGGL(fwd, dim3(grid), dim3(NTHREADS), LDS_BYTES, stream, a); }
#endif
#endif
}
```
